# Optimizing an MI355X kernel written in HIP

```python
import jax
import jax.numpy as jnp
from jax import lax
import numpy as np

D_MODEL = 1024
BATCH = 8
SEQ = 4096
DEPTH = 2

A_HEADS = 8
A_HEAD_DIM = 64
A_OUT = A_HEADS * A_HEAD_DIM
IDX_HEADS = 4
IDX_DIM = 64
TOPK_MAX = 256
Q_BLOCK = 128
ROPE_THETA = 500000.0
ROT_DIM = A_HEAD_DIM // 4
B_HEADS = 4
B_KEY_DIM = 64
B_VAL_DIM = 128
B_OUT = B_HEADS * B_VAL_DIM
B_GATE_RANK = 16
B_GATE_TAU = 16.0
B_CHUNK = 64
C_GROUPS = 4
C_GROUP_DIM = 128
C_OUT = C_GROUPS * C_GROUP_DIM
C_CHUNK = 128
N_GROUPS = 4
EXPERTS_PER_GROUP = 8
N_EXPERTS = N_GROUPS * EXPERTS_PER_GROUP
D_EXPERT = 256
TOP_K_INNER = 2
DN_ALPHA = (2 * DEPTH) ** 0.25
DN_BETA = (8 * DEPTH) ** -0.25
LN_EPS = 1e-5
RMS_EPS = 1e-6

SPLIT_WIDTHS = (A_OUT, A_HEAD_DIM, A_HEAD_DIM,
                IDX_HEADS * IDX_DIM, IDX_DIM, IDX_HEADS,
                B_HEADS * B_KEY_DIM, B_HEADS * B_KEY_DIM,
                B_OUT, B_GATE_RANK, B_OUT,
                2 * C_OUT,
                D_MODEL, D_MODEL, D_MODEL)
N_IN = sum(SPLIT_WIDTHS)

kernel_name = 'hybrid_dsa_gla_gmlp_hmoe'


def layer_norm(x, g, b=None):
    xf = x.astype(jnp.float32)
    mu = jnp.mean(xf, axis=-1, keepdims=True)
    var = jnp.mean(jnp.square(xf - mu), axis=-1, keepdims=True)
    y = (xf - mu) * lax.rsqrt(var + LN_EPS) * g.astype(jnp.float32)
    if b is not None:
        y = y + b.astype(jnp.float32)
    return y.astype(x.dtype)


def rms_norm(x, g):
    xf = x.astype(jnp.float32)
    y = xf * lax.rsqrt(jnp.mean(jnp.square(xf), axis=-1, keepdims=True) + RMS_EPS)
    return (y * g.astype(jnp.float32)).astype(x.dtype)


def rope_tables(positions):
    inv_freq = ROPE_THETA ** (-jnp.arange(0, ROT_DIM, 2, dtype=jnp.float32) / ROT_DIM)
    ang = positions.astype(jnp.float32)[..., None] * inv_freq
    return jnp.cos(ang), jnp.sin(ang)


def apply_partial_rope(x, cos, sin):
    half = ROT_DIM // 2
    c = cos[:, :, None, :].astype(x.dtype)
    s = sin[:, :, None, :].astype(x.dtype)
    x1 = x[..., :half]
    x2 = x[..., half:ROT_DIM]
    return jnp.concatenate([x1 * c - x2 * s, x1 * s + x2 * c, x[..., ROT_DIM:]], axis=-1)


def dsa_attention(q, k, v, qi, ki, wi):
    f32 = jnp.float32
    bsz, seq_len = q.shape[0], q.shape[1]
    n_sel = min(TOPK_MAX, seq_len // 4)
    n_blk = seq_len // Q_BLOCK
    scale = A_HEAD_DIM ** -0.5
    key_pos = jnp.arange(seq_len, dtype=jnp.int32)
    ki32 = ki.astype(f32)

    def to_blocks(t):
        return jnp.moveaxis(t.reshape((bsz, n_blk, Q_BLOCK) + t.shape[2:]), 1, 0)

    def block_fn(args):
        qb, qib, wib, start = args
        qpos = start + jnp.arange(Q_BLOCK, dtype=jnp.int32)
        causal = key_pos[None, :] <= qpos[:, None]
        dots = jnp.einsum('bqhd,bsd->bqhs', qib.astype(f32), ki32)
        score = jnp.einsum('bqhs,bqh->bqs', jax.nn.relu(dots), wib.astype(f32))
        score = jnp.where(causal[None], score, -jnp.inf)
        _, sel = lax.top_k(score, n_sel)
        valid = sel <= qpos[None, :, None]
        k_sel = jax.vmap(lambda kk, ii: kk[ii])(k, sel)
        v_sel = jax.vmap(lambda vv, ii: vv[ii])(v, sel)
        logits = jnp.einsum('bqhd,bqkd->bqhk', qb, k_sel).astype(f32) * scale
        logits = jnp.where(valid[:, :, None, :], logits, -jnp.inf)
        p = jax.nn.softmax(logits, axis=-1)
        return jnp.einsum('bqhk,bqkd->bqhd', p.astype(v.dtype), v_sel)

    starts = jnp.arange(n_blk, dtype=jnp.int32) * Q_BLOCK
    out = lax.map(block_fn, (to_blocks(q), to_blocks(qi), to_blocks(wi), starts))
    return jnp.moveaxis(out, 0, 1).reshape(bsz, seq_len, A_OUT)


def gla_chunked(q, k, v, log_a):
    f32 = jnp.float32
    bsz, seq_len, n_h, dk = q.shape
    dv = v.shape[-1]
    n_c = seq_len // B_CHUNK

    def chunks(t):
        return t.astype(f32).reshape(bsz, n_c, B_CHUNK, n_h, t.shape[-1]).transpose(1, 0, 3, 2, 4)

    tri = jnp.tril(jnp.ones((B_CHUNK, B_CHUNK), dtype=bool))

    def step(state, inp):
        qc, kc, vc, gc = inp
        b = jnp.cumsum(gc, axis=2)
        diff = b[:, :, :, None, :] - b[:, :, None, :, :]
        decay = jnp.exp(jnp.where(tri[:, :, None], diff, -jnp.inf))
        att = jnp.einsum('bhtk,bhtsk,bhsk->bhts', qc, decay, kc)
        o = jnp.einsum('bhts,bhsv->bhtv', att, vc) + jnp.einsum('bhtk,bhkv->bhtv', qc * jnp.exp(b), state)
        b_last = b[:, :, -1:, :]
        state = jnp.exp(b_last[:, :, 0, :])[..., None] * state + jnp.einsum('bhsk,bhsv->bhkv', kc * jnp.exp(b_last - b), vc)
        return state, o

    s0 = jnp.zeros((bsz, n_h, dk, dv), f32)
    _, o = lax.scan(step, s0, (chunks(q), chunks(k), chunks(v), chunks(log_a)))
    return o.transpose(1, 0, 3, 2, 4).reshape(bsz, seq_len, n_h, dv)


def chunked_spatial_gating(c_uv, ln_g, ln_b, w_s, b_s):
    bsz, seq_len = c_uv.shape[0], c_uv.shape[1]
    z = jax.nn.gelu(c_uv)
    u, v = z[..., :C_OUT], z[..., C_OUT:]
    v = layer_norm(v, ln_g, ln_b)
    n_c = seq_len // C_CHUNK
    vb = v.reshape(bsz, n_c, C_CHUNK, C_GROUPS, C_GROUP_DIM)
    w = w_s * jnp.tril(jnp.ones((C_CHUNK, C_CHUNK), dtype=w_s.dtype))[None]
    mixed = jnp.einsum('gts,bcsgd->bctgd', w, vb) + b_s.T[:, :, None]
    return u * mixed.reshape(bsz, seq_len, C_OUT)


def mixer_sublayer(x, cos, sin, w_in, idx_k_g, gla_wa2, gla_ba, gla_norm_g,
                   gm_ln_g, gm_ln_b, gm_ws, gm_bs, w_branch_a, w_branch_b, w_branch_c, w_out):
    bsz, seq_len, _ = x.shape
    points = np.cumsum(SPLIT_WIDTHS)[:-1].tolist()
    (a_q, a_k, a_v, i_q, i_k, i_w, b_q, b_k, b_v, b_glr, b_r, c_uv,
     g_a, g_b, g_c) = jnp.split(x @ w_in, points, axis=-1)

    q = apply_partial_rope(a_q.reshape(bsz, seq_len, A_HEADS, A_HEAD_DIM), cos, sin)
    k = apply_partial_rope(a_k[:, :, None, :], cos, sin)[:, :, 0]
    qi = apply_partial_rope(i_q.reshape(bsz, seq_len, IDX_HEADS, IDX_DIM), cos, sin)
    ki = apply_partial_rope(layer_norm(i_k, idx_k_g)[:, :, None, :], cos, sin)[:, :, 0]
    wi = i_w * (IDX_HEADS ** -0.5 * IDX_DIM ** -0.5)
    y_a = dsa_attention(q, k, a_v, qi, ki, wi)

    log_a = jax.nn.log_sigmoid((b_glr @ gla_wa2 + gla_ba).astype(jnp.float32)) / B_GATE_TAU
    o_b = gla_chunked(b_q.reshape(bsz, seq_len, B_HEADS, B_KEY_DIM) * (B_KEY_DIM ** -0.5),
                      b_k.reshape(bsz, seq_len, B_HEADS, B_KEY_DIM),
                      b_v.reshape(bsz, seq_len, B_HEADS, B_VAL_DIM),
                      log_a.reshape(bsz, seq_len, B_HEADS, B_KEY_DIM)).astype(x.dtype)
    y_b = jax.nn.silu(b_r) * rms_norm(o_b, gla_norm_g).reshape(bsz, seq_len, B_OUT)

    y_c = chunked_spatial_gating(c_uv, gm_ln_g, gm_ln_b, gm_ws, gm_bs)

    h = (jax.nn.sigmoid(g_a) * (y_a @ w_branch_a)
         + jax.nn.sigmoid(g_b) * (y_b @ w_branch_b)
         + jax.nn.sigmoid(g_c) * (y_c @ w_branch_c))
    return h @ w_out


def moe_sublayer(x, w_rg, b_rg, w_re, b_re, w_gate, w_up, w_down):
    bsz, seq_len, d = x.shape
    xf = x.reshape(-1, d)
    n_tok = xf.shape[0]
    g_prob = jax.nn.softmax((xf @ w_rg + b_rg).astype(jnp.float32), axis=-1)
    g_p, g_idx = lax.top_k(g_prob, 1)
    e_logits = (xf @ w_re + b_re).astype(jnp.float32).reshape(n_tok, N_GROUPS, EXPERTS_PER_GROUP)
    e_in = e_logits[jnp.arange(n_tok), g_idx[:, 0]]
    e_top, e_idx = lax.top_k(e_in, TOP_K_INNER)
    e_w = jax.nn.softmax(e_top, axis=-1) * g_p
    expert_id = g_idx * EXPERTS_PER_GROUP + e_idx
    combine = jnp.sum(jax.nn.one_hot(expert_id, N_EXPERTS, dtype=jnp.float32) * e_w[..., None], axis=1)
    combine = combine.astype(x.dtype).reshape(bsz, seq_len, N_EXPERTS)
    w_down_flat = w_down.reshape(N_EXPERTS * D_EXPERT, d)

    def per_seq(args):
        xs, cs = args
        hid = jax.nn.silu(jnp.einsum('ld,edf->lef', xs, w_gate)) * jnp.einsum('ld,edf->lef', xs, w_up)
        hid = hid * cs[:, :, None]
        return hid.reshape(xs.shape[0], N_EXPERTS * D_EXPERT) @ w_down_flat

    return lax.map(per_seq, (x, combine))


def setup_inputs(seed: int = 0) -> dict:
    key = jax.random.key(seed)
    ks = jax.random.split(key, 32)
    f32 = jnp.float32

    def nrm(k, shape, scale):
        return jax.random.normal(k, shape, f32) * scale

    def gain(k, shape):
        return 1.0 + 0.02 * jax.random.normal(k, shape, f32)

    def small(k, shape, s=0.02):
        return s * jax.random.normal(k, shape, f32)

    L = DEPTH
    x = jax.random.normal(ks[0], (BATCH, SEQ, D_MODEL), f32)
    offs = jax.random.randint(ks[1], (BATCH, 1), 0, 1024, dtype=jnp.int32)
    positions = offs + jnp.arange(SEQ, dtype=jnp.int32)[None, :]
    return {
        'x': x,
        'positions': positions,
        'ln_in_g': gain(ks[2], (D_MODEL,)),
        'ln_in_b': small(ks[3], (D_MODEL,)),
        'w_in': nrm(ks[4], (L, D_MODEL, N_IN), D_MODEL ** -0.5),
        'idx_k_g': gain(ks[5], (L, IDX_DIM)),
        'gla_wa2': nrm(ks[6], (L, B_GATE_RANK, B_HEADS * B_KEY_DIM), B_GATE_RANK ** -0.5),
        'gla_ba': small(ks[7], (L, B_HEADS * B_KEY_DIM), 0.1),
        'gla_norm_g': gain(ks[8], (L, B_VAL_DIM)),
        'gm_ln_g': gain(ks[9], (L, C_OUT)),
        'gm_ln_b': small(ks[10], (L, C_OUT)),
        'gm_ws': nrm(ks[11], (L, C_GROUPS, C_CHUNK, C_CHUNK), 0.5 * C_CHUNK ** -0.5),
        'gm_bs': gain(ks[12], (L, C_GROUPS, C_CHUNK)),
        'w_branch_a': nrm(ks[13], (L, A_OUT, D_MODEL), DN_BETA * A_OUT ** -0.5),
        'w_branch_b': nrm(ks[14], (L, B_OUT, D_MODEL), DN_BETA * B_OUT ** -0.5),
        'w_branch_c': nrm(ks[15], (L, C_OUT, D_MODEL), DN_BETA * C_OUT ** -0.5),
        'w_out': nrm(ks[16], (L, D_MODEL, D_MODEL), DN_BETA * D_MODEL ** -0.5),
        'ln1_g': gain(ks[17], (L, D_MODEL)),
        'ln1_b': small(ks[18], (L, D_MODEL)),
        'w_rg': nrm(ks[19], (L, D_MODEL, N_GROUPS), D_MODEL ** -0.5),
        'b_rg': small(ks[20], (L, N_GROUPS), 0.01),
        'w_re': nrm(ks[21], (L, D_MODEL, N_EXPERTS), D_MODEL ** -0.5),
        'b_re': small(ks[22], (L, N_EXPERTS), 0.01),
        'w_gate': nrm(ks[23], (L, N_EXPERTS, D_MODEL, D_EXPERT), D_MODEL ** -0.5),
        'w_up': nrm(ks[24], (L, N_EXPERTS, D_MODEL, D_EXPERT), D_MODEL ** -0.5),
        'w_down': nrm(ks[25], (L, N_EXPERTS, D_EXPERT, D_MODEL), DN_BETA * D_EXPERT ** -0.5),
        'ln2_g': gain(ks[26], (L, D_MODEL)),
        'ln2_b': small(ks[27], (L, D_MODEL)),
    }


def reference(x, positions, ln_in_g, ln_in_b, w_in, idx_k_g, gla_wa2, gla_ba, gla_norm_g,
              gm_ln_g, gm_ln_b, gm_ws, gm_bs, w_branch_a, w_branch_b, w_branch_c, w_out,
              ln1_g, ln1_b, w_rg, b_rg, w_re, b_re, w_gate, w_up, w_down, ln2_g, ln2_b):
    cos, sin = rope_tables(positions)
    h = layer_norm(x, ln_in_g, ln_in_b)
    for l in range(DEPTH):
        mix = mixer_sublayer(h, cos, sin, w_in[l], idx_k_g[l], gla_wa2[l], gla_ba[l], gla_norm_g[l],
                             gm_ln_g[l], gm_ln_b[l], gm_ws[l], gm_bs[l],
                             w_branch_a[l], w_branch_b[l], w_branch_c[l], w_out[l])
        h = layer_norm(DN_ALPHA * h + mix, ln1_g[l], ln1_b[l])
        ffn = moe_sublayer(h, w_rg[l], b_rg[l], w_re[l], b_re[l], w_gate[l], w_up[l], w_down[l])
        h = layer_norm(DN_ALPHA * h + ffn, ln2_g[l], ln2_b[l])
    return h
```

```cpp
#define MK_ONE_LAUNCH 1
#include <hip/hip_runtime.h>
#include <cstdio>
#include <cstdint>

#define LAS __attribute__((address_space(3)))
#define GAS __attribute__((address_space(1)))
typedef unsigned short bf16;
typedef short bf16x8 __attribute__((ext_vector_type(8)));
typedef float f32x4 __attribute__((ext_vector_type(4)));
typedef float f32x2 __attribute__((ext_vector_type(2)));
typedef unsigned u32x4 __attribute__((ext_vector_type(4)));
typedef unsigned u32x2 __attribute__((ext_vector_type(2)));
typedef GAS unsigned gu32;

constexpr int NB = 8, SEQ = 4096, NTOK = NB * SEQ, DM = 1024, NIN = 6612, DEPTH = 2;
constexpr int NPA = 3584;
constexpr int NGT = 3072;
constexpr int NEXP = 32, DEXP = 256;
constexpr int MAXTILES = 288;
constexpr float DN_ALPHA = 1.41421356237309515f;
constexpr float LN_EPS = 1e-5f, RMS_EPS = 1e-6f;
constexpr int PA_Q = 0, PA_QI = 768, PA_BQ = 1024, PA_BK = 1280, PA_BV = 1536, PA_BR = 2048, PA_CU = 2560, PA_CV = 3072;

__device__ __forceinline__ unsigned f2bf(float f) { unsigned u = __builtin_bit_cast(unsigned, f); return (u + 0x7fffu + ((u >> 16) & 1u)) >> 16; }
__device__ __forceinline__ unsigned pk2(float lo, float hi) { return f2bf(lo) | (f2bf(hi) << 16); }
__device__ __forceinline__ float bflo(unsigned w) { return __builtin_bit_cast(float, w << 16); }
__device__ __forceinline__ float bfhi(unsigned w) { return __builtin_bit_cast(float, w & 0xffff0000u); }
__device__ __forceinline__ float bf1(bf16 h) { return __builtin_bit_cast(float, ((unsigned)h) << 16); }
typedef __bf16 bf16x2_t __attribute__((ext_vector_type(2)));
__device__ __forceinline__ unsigned cvt_pk_bf16(float lo, float hi) { const f32x2 v = {lo, hi}; const bf16x2_t b = __builtin_convertvector(v, bf16x2_t); return __builtin_bit_cast(unsigned, b); }
__device__ __forceinline__ float shx(float v, int mask, int lane) { return __builtin_bit_cast(float, __builtin_amdgcn_ds_bpermute((lane ^ mask) << 2, __builtin_bit_cast(int, v))); }
__device__ __forceinline__ int shxi(int v, int mask, int lane) { return __builtin_amdgcn_ds_bpermute((lane ^ mask) << 2, v); }
__device__ __forceinline__ float wave_sum(float v, int lane) {
#pragma unroll
    for (int o = 1; o < 64; o <<= 1) v += shx(v, o, lane);
    return v;
}
__device__ __forceinline__ float wave_max(float v, int lane) {
#pragma unroll
    for (int o = 1; o < 64; o <<= 1) v = fmaxf(v, shx(v, o, lane));
    return v;
}
__device__ __forceinline__ int wave_sum_i(int v, int lane) {
#pragma unroll
    for (int o = 1; o < 64; o <<= 1) v += shxi(v, o, lane);
    return v;
}
__device__ __forceinline__ int ld_i32(const GAS int* p) { return __hip_atomic_load(p, __ATOMIC_RELAXED, __HIP_MEMORY_SCOPE_AGENT); }
__device__ __forceinline__ float ld_f32(const GAS float* p) { return __hip_atomic_load(p, __ATOMIC_RELAXED, __HIP_MEMORY_SCOPE_AGENT); }
__device__ __forceinline__ float sigmoidf_(float x) { return __builtin_amdgcn_rcpf(1.0f + __expf(-x)); }
__device__ __forceinline__ float siluf_(float x) { return x * sigmoidf_(x); }
__device__ __forceinline__ float gelu_tanh_(float x) { const float u = 0.7978845608028654f * (x + 0.044715f * x * x * x); return x * sigmoidf_(2.0f * u); }

namespace pg8 {
constexpr int BM = 256, BK = 64, HALF = 128, HTB = HALF * BK * 2, STAGE_BYTES = 8 * HTB;
__host__ __device__ __forceinline__ int lds_byte(int r, int c) { const int st = (r >> 4) * 2 + (c >> 5), rr = r & 15, cc = c & 31, ob = rr * 64 + cc * 2; return st * 1024 + (ob ^ (((ob >> 9) & 1) << 5)); }
__host__ __device__ __forceinline__ void stage_rc(int b, int& R, int& C) { const int st = b / 1024, sb = b % 1024, swz = sb ^ (((sb >> 9) & 1) << 5); R = (st >> 1) * 16 + swz / 64; C = (st & 1) * 32 + (swz % 64) / 2; }
__host__ __device__ __forceinline__ int perm32(int rho) { const int n = rho >> 4, i = rho & 15; return 8 * (i >> 2) + 4 * n + (i & 3); }

struct Unit { int pm, pn, e, slot; };

template <class Epi, class Sched, bool GATHER>
__device__ __forceinline__ void gemm_phase(LAS unsigned char* lds, const Sched& S, const Epi& E, const int K, const int lda, const int wave) {
    unsigned z0_ = 0u; asm volatile("" : "+v"(z0_)); const int lane_ = (int)__builtin_amdgcn_mbcnt_hi(~0u, __builtin_amdgcn_mbcnt_lo(~0u, z0_));
    const int wid = wave, lane = lane_, tid = wid * 64 + lane, wr = wid >> 2, wc = wid & 3, fr = lane & 15, fq = lane >> 4;
    const int nt = K / BK;
    int Rr[2], Cc[2];
    unsigned voffB[2];
#pragma unroll
    for (int i = 0; i < 2; ++i) { int R, C; stage_rc(tid * 16 + i * 8192, R, C); Rr[i] = R; Cc[i] = C; const int Rb = Epi::PERM ? ((R & ~31) + perm32(R & 31)) : R; voffB[i] = (unsigned)(Rb * K + C) * 2u; }
    const size_t kstep = (size_t)(BK * 2);
    const size_t hstepB = (size_t)HALF * K * 2;
    const unsigned ldsw = (unsigned)wid * 1024u;
    const int aoff = lds_byte(wr * 64 + fr, fq * 8), boff = lds_byte(wc * 32 + fr, fq * 8);
#define PG8_SA(b, h) (((b) * 2 + (h)) * HTB)
#define PG8_SB(b, h) ((4 + (b) * 2 + (h)) * HTB)
#define PG8_STAGE(bufoff, gbase, voff) do { _Pragma("unroll") for (int _i = 0; _i < 2; ++_i) \
        __builtin_amdgcn_global_load_lds((const unsigned*)((const char*)(gbase) + (voff)[_i]), (LAS unsigned*)(lds + (bufoff) + ldsw + _i * 8192), 16, 0, 0); } while (0)
#define PG8_LDA(dst, b, h) do { _Pragma("unroll") for (int m = 0; m < 4; ++m) _Pragma("unroll") for (int k = 0; k < 2; ++k) dst[m][k] = *(const LAS bf16x8*)(lds + PG8_SA(b, h) + aoff + m * 2048 + k * 1024); } while (0)
#define PG8_LDB(dst, b, h) do { _Pragma("unroll") for (int n = 0; n < 2; ++n) _Pragma("unroll") for (int k = 0; k < 2; ++k) dst[n][k] = *(const LAS bf16x8*)(lds + PG8_SB(b, h) + boff + n * 2048 + k * 1024); } while (0)
#define PG8_MMA(ai, bj, At, Bt) do { __builtin_amdgcn_s_setprio(1); _Pragma("unroll") for (int m = 0; m < 4; ++m) _Pragma("unroll") for (int n = 0; n < 2; ++n) _Pragma("unroll") for (int k = 0; k < 2; ++k) \
        acc[ai][bj][m][n] = __builtin_amdgcn_mfma_f32_16x16x32_bf16(Bt[n][k], At[m][k], acc[ai][bj][m][n], 0, 0, 0); __builtin_amdgcn_s_setprio(0); } while (0)
#define PG8_WAIT_V(n) asm volatile("s_waitcnt vmcnt(" #n ")" ::: "memory")
#define PG8_WAIT_L(n) asm volatile("s_waitcnt lgkmcnt(" #n ")" ::: "memory")
#define PG8_BAR do { asm volatile("" ::: "memory"); __builtin_amdgcn_s_barrier(); asm volatile("" ::: "memory"); } while (0)
#define PG8_SCHED __builtin_amdgcn_sched_barrier(0)
    Unit cur, nxt; int ui = 0;
    if (!S.next(0, cur)) return;
    f32x4 acc[2][2][4][2];
#pragma unroll
    for (int a = 0; a < 2; ++a)
#pragma unroll
        for (int b = 0; b < 2; ++b)
#pragma unroll
            for (int m = 0; m < 4; ++m)
#pragma unroll
                for (int n = 0; n < 2; ++n) acc[a][b][m][n] = (f32x4){0.f, 0.f, 0.f, 0.f};
    bf16x8 At[4][2], B0[2][2], B1[2][2];
    unsigned cA0[2], cA1[2], nA0[2], nA1[2];
#pragma unroll
    for (int i = 0; i < 2; ++i) {
        if (GATHER) { cA0[i] = (unsigned)(S.row_of(cur, Rr[i]) * lda + Cc[i]) * 2u; cA1[i] = (unsigned)(S.row_of(cur, HALF + Rr[i]) * lda + Cc[i]) * 2u; }
        else { cA0[i] = (unsigned)(Rr[i] * lda + Cc[i]) * 2u; cA1[i] = (unsigned)((HALF + Rr[i]) * lda + Cc[i]) * 2u; }
        nA0[i] = cA0[i]; nA1[i] = cA1[i];
    }
    const char* cA = S.a_base(cur); const char* cB = S.b_base(cur);
    PG8_STAGE(PG8_SB(0, 0), cB, voffB); PG8_STAGE(PG8_SB(0, 1), cB + hstepB, voffB); PG8_STAGE(PG8_SA(0, 0), cA, cA0); PG8_STAGE(PG8_SA(0, 1), cA, cA1);
    if (wr == 1) PG8_BAR;
    PG8_WAIT_V(2); PG8_BAR;
    PG8_STAGE(PG8_SB(1, 0), cB + kstep, voffB); PG8_STAGE(PG8_SA(1, 0), cA + kstep, cA0); PG8_STAGE(PG8_SB(1, 1), cB + hstepB + kstep, voffB);
    PG8_WAIT_V(6); PG8_BAR;
    for (;;) {
        const bool has_next = S.next(ui + 1, nxt);
        const char* nA = has_next ? S.a_base(nxt) : cA; const char* nB = has_next ? S.b_base(nxt) : cB;
        if (GATHER) {
#pragma unroll
            for (int i = 0; i < 2; ++i) {
                if (has_next) { nA0[i] = (unsigned)(S.row_of(nxt, Rr[i]) * lda + Cc[i]) * 2u; nA1[i] = (unsigned)(S.row_of(nxt, HALF + Rr[i]) * lda + Cc[i]) * 2u; }
                else { nA0[i] = cA0[i]; nA1[i] = cA1[i]; }
            }
        }
#pragma unroll 1
        for (int t = 0; t < nt; t += 2) {
            const bool last = (t == nt - 2);
            const char* a1 = cA + (size_t)(t + 1) * kstep;
            const char* a2 = last ? nA : cA + (size_t)(t + 2) * kstep; const char* b2 = last ? nB : cB + (size_t)(t + 2) * kstep;
            const char* a3 = a2 + kstep; const char* b3 = b2 + kstep;
            unsigned x0[2], x1[2];
#pragma unroll
            for (int i = 0; i < 2; ++i) { x0[i] = (GATHER && last) ? nA0[i] : cA0[i]; x1[i] = (GATHER && last) ? nA1[i] : cA1[i]; }
            PG8_LDB(B0, 0, 0); PG8_LDB(B1, 0, 1); PG8_SCHED; PG8_LDA(At, 0, 0); PG8_STAGE(PG8_SA(1, 1), a1, cA1);
            PG8_WAIT_V(8); PG8_WAIT_L(0); PG8_BAR; PG8_MMA(0, 0, At, B0); PG8_MMA(0, 1, At, B1); PG8_BAR; PG8_SCHED;
            PG8_LDA(At, 0, 1); PG8_STAGE(PG8_SB(0, 0), b2, voffB); PG8_STAGE(PG8_SB(0, 1), b2 + hstepB, voffB); PG8_STAGE(PG8_SA(0, 0), a2, x0);
            PG8_WAIT_V(8); PG8_WAIT_L(0); PG8_BAR; PG8_MMA(1, 0, At, B0); PG8_MMA(1, 1, At, B1); PG8_BAR; PG8_SCHED;
            PG8_LDB(B0, 1, 0); PG8_LDB(B1, 1, 1); PG8_SCHED; PG8_LDA(At, 1, 0); PG8_STAGE(PG8_SA(0, 1), a2, x1);
            PG8_WAIT_V(8); PG8_WAIT_L(0); PG8_BAR; PG8_MMA(0, 0, At, B0); PG8_MMA(0, 1, At, B1); PG8_BAR; PG8_SCHED;
            PG8_LDA(At, 1, 1); PG8_STAGE(PG8_SB(1, 0), b3, voffB); PG8_STAGE(PG8_SB(1, 1), b3 + hstepB, voffB); PG8_STAGE(PG8_SA(1, 0), a3, x0);
            PG8_WAIT_V(8); PG8_WAIT_L(0); PG8_BAR; PG8_MMA(1, 0, At, B0); PG8_MMA(1, 1, At, B1); PG8_BAR; PG8_SCHED;
        }
        if (wr == 0) PG8_BAR;
        E(acc, cur, wr, wc, fr, fq);
        if (!has_next) break;
#pragma unroll
        for (int a = 0; a < 2; ++a)
#pragma unroll
            for (int b = 0; b < 2; ++b)
#pragma unroll
                for (int m = 0; m < 4; ++m)
#pragma unroll
                    for (int n = 0; n < 2; ++n) acc[a][b][m][n] = (f32x4){0.f, 0.f, 0.f, 0.f};
        cur = nxt; cA = nA; cB = nB; ++ui;
#pragma unroll
        for (int i = 0; i < 2; ++i) { cA0[i] = nA0[i]; cA1[i] = nA1[i]; }
        if (wr == 1) PG8_BAR;
    }
    PG8_WAIT_V(0);
    PG8_BAR;
#undef PG8_SA
#undef PG8_SB
#undef PG8_STAGE
#undef PG8_LDA
#undef PG8_LDB
#undef PG8_MMA
#undef PG8_WAIT_V
#undef PG8_WAIT_L
#undef PG8_BAR
#undef PG8_SCHED
}
}

#define XB_TMO      128
#define XB_XCNT(j)  (256  + 64 * (j))
#define XB_XSUB(j)  (1280 + 64 * (j))
#define XB_XGEN(j)  (2304 + 64 * (j))
#define XB_TOP      3328
#define XB_TOPGEN   3392
#define XCD_BAR_WORDS 3456
#define XB_SPIN_CAP (1u << 20)

__device__ __forceinline__ unsigned xb_ld(unsigned* p)              { return __hip_atomic_load(p, __ATOMIC_RELAXED, __HIP_MEMORY_SCOPE_AGENT); }
__device__ __forceinline__ unsigned xb_add(unsigned* p, unsigned v) { return __hip_atomic_fetch_add(p, v, __ATOMIC_RELAXED, __HIP_MEMORY_SCOPE_AGENT); }
__device__ __forceinline__ unsigned xb_xcc_id() { return (unsigned)__builtin_amdgcn_s_getreg((3 << 11) | 20) & 0xFu; }
#define XB_SPIN(cond, bar) do { unsigned _sp = 0; while (cond) { __builtin_amdgcn_s_sleep(1); \
    if ((++_sp & 255u) == 0u) { if (xb_ld(&(bar)[XB_TMO])) break; if (_sp > XB_SPIN_CAP) { atomicAdd(&(bar)[XB_TMO], 1u); break; } } } } while (0)

struct XcdBarrier { unsigned* bar; unsigned x; volatile LAS unsigned* st; };

__device__ __forceinline__ XcdBarrier xcd_barrier_post(unsigned* bar, volatile LAS unsigned* st) {
    XcdBarrier b; b.bar = bar; b.x = xb_xcc_id(); b.st = st;
    if (threadIdx.x == 0) (void)xb_add(&bar[XB_XCNT(b.x)], 1u);
    return b;
}
__device__ __forceinline__ void xcd_barrier_complete(unsigned* bar, unsigned x, unsigned& nloc, unsigned& nx) {
    const unsigned G = gridDim.x * gridDim.y * gridDim.z;
    unsigned sum, cnt, mine, sp = 0u;
    for (;;) {
        sum = 0u; cnt = 0u; mine = 0u;
#pragma unroll
        for (unsigned j = 0; j < 16; ++j) { const unsigned c = xb_ld(&bar[XB_XCNT(j)]); sum += c; cnt += (c > 0u) ? 1u : 0u; mine = (j == x) ? c : mine; }
        if (sum == G) break;
        __builtin_amdgcn_s_sleep(1);
        if ((++sp & 255u) == 0u) { if (xb_ld(&bar[XB_TMO])) break; if (sp > XB_SPIN_CAP) { atomicAdd(&bar[XB_TMO], 1u); break; } }
    }
    nloc = mine > 0u ? mine : 1u; nx = cnt > 0u ? cnt : 1u;
}
__device__ __forceinline__ void xcd_barrier(const XcdBarrier& b) {
    asm volatile("s_waitcnt vmcnt(0)" ::: "memory");
    __syncthreads();
    if (threadIdx.x == 0) {
        unsigned* bar = b.bar;
        __builtin_amdgcn_s_waitcnt(0);
        unsigned nloc = b.st[0], nx = b.st[1];
        if (nloc == 0u) { xcd_barrier_complete(bar, b.x, nloc, nx); b.st[0] = nloc; b.st[1] = nx; }
        const unsigned old = xb_add(&bar[XB_XSUB(b.x)], 1u);
        const unsigned gen = old / nloc;
        if (old + 1u == (gen + 1u) * nloc) {
            __builtin_amdgcn_fence(__ATOMIC_RELEASE, "agent");
            asm volatile("s_waitcnt vmcnt(0)" ::: "memory");
            const unsigned og = xb_add(&bar[XB_TOP], 1u);
            const unsigned tg = og / nx;
            if (og + 1u == (tg + 1u) * nx) xb_add(&bar[XB_TOPGEN], 1u);
            else XB_SPIN(xb_ld(&bar[XB_TOPGEN]) == tg, bar);
            __builtin_amdgcn_fence(__ATOMIC_ACQUIRE, "agent");
            xb_add(&bar[XB_XGEN(b.x)], 1u);
            asm volatile("s_waitcnt vmcnt(0)" ::: "memory");
        } else {
            XB_SPIN(xb_ld(&bar[XB_XGEN(b.x)]) == gen, bar);
            __builtin_amdgcn_fence(__ATOMIC_ACQUIRE, "agent");
            asm volatile("s_waitcnt vmcnt(0)" ::: "memory");
        }
    }
    __syncthreads();
}

constexpr size_t MiB = 1u << 20;
constexpr size_t WS_CTL = 0, CTL_ZERO_BYTES = 1 * MiB;
constexpr size_t WS_ROPE = 1 * MiB;
constexpr size_t WS_WI   = 3 * MiB;
constexpr size_t WS_ROUTE = 3 * MiB + 512 * 1024;
constexpr size_t WS_SROW = 4 * MiB;
constexpr size_t WS_ROWMAP = 4 * MiB + 256 * 1024;
constexpr size_t WS_CWROW = 4 * MiB + 640 * 1024;
constexpr size_t WS_CNTWG = 5 * MiB;
constexpr size_t WS_META = 5 * MiB + 64 * 1024;
constexpr size_t WS_WR = 5 * MiB + 128 * 1024;
constexpr size_t WS_GLR = 6 * MiB;
constexpr size_t WS_WDENSE = 8 * MiB;
constexpr size_t WD_WA = 0, WD_WG = 7 * MiB, WD_WBR = 13 * MiB, WD_WOUT = 16 * MiB, WD_LAYER = 18 * MiB;
constexpr size_t WS_WMOE = 44 * MiB;
constexpr size_t WM_GU = 0, WM_DN = 32 * MiB;
constexpr size_t WS_HB = 92 * MiB;
constexpr size_t WS_PA = 156 * MiB;
constexpr size_t WS_HID = WS_PA;
constexpr size_t WS_FF2 = WS_PA + 40 * MiB;
constexpr size_t WS_Y = 380 * MiB;
constexpr size_t WS_KA = 476 * MiB, WS_VA = 480 * MiB, WS_KI = 484 * MiB;
constexpr size_t WS_END = 512 * MiB;
static_assert(WS_WDENSE + 2 * WD_LAYER <= WS_WMOE && WS_WMOE + 48 * MiB <= WS_HB && WS_HB + 64 * MiB <= WS_PA && WS_PA + 224 * MiB <= WS_Y && WS_Y + 96 * MiB <= WS_KA && WS_KI + 4 * MiB <= WS_END, "ws map");
static_assert(WS_FF2 + (size_t)73728 * 1024 * 2 <= WS_Y, "ff2 fits");
constexpr int CW_BAR = 4096;
constexpr int CW_QUEUE = 16384;

constexpr int RING_BYTES = 131072;
constexpr int AUX_OFF = 131072;
constexpr int MISC_OFF = 147456;
constexpr int LDS_BYTES = 148480;

struct Frame {
    LAS unsigned char* lds;
    volatile LAS unsigned* MISC;
    gu32* ctl;
    int tid, lane, wave, G, wg;
    const float* const* in;
    const GAS int* pos;
    GAS float* H;
    GAS unsigned char* ws;
};

#define LDS_WAIT() asm volatile("s_waitcnt lgkmcnt(0)" ::: "memory")
#define VM_WAIT() asm volatile("s_waitcnt vmcnt(0)" ::: "memory")

__device__ __forceinline__ int pa_src_col(int c) {
    if (c < 512) return c;
    if (c < 768) { const int x = c - 512, half = x >> 7, y = x & 127, grp = y >> 5, d = (y & 31) + 32 * half;
        if (grp == 0) return 512 + d;
        if (grp == 1) return 576 + d;
        if (grp == 2) return 896 + d;
        if (half == 0) { const int z = y - 96; if (z < 4) return 960 + z; if (z < 20) return 1988 + (z - 4); }
        return -1; }
    if (c < 1024) return 640 + (c - 768);
    if (c < 1280) return 964 + (c - 1024);
    if (c < 1536) return 1220 + (c - 1280);
    if (c < 2048) return 1476 + (c - 1536);
    if (c < 2560) return 2004 + (c - 2048);
    return 2516 + (c - 2560);
}
__device__ __forceinline__ void transpose_item(const GAS float* W, int ldw, int K, GAS bf16* WT, int n0, int k0, int sc, LAS float* scr, int lane) {
#pragma unroll 8
    for (int i = 0; i < 32; ++i) { const int kk = 2 * i + (lane >> 5); scr[kk * 33 + (lane & 31)] = (sc >= 0) ? W[(size_t)(k0 + kk) * ldw + sc] : 0.f; }
    LDS_WAIT(); asm volatile("" ::: "memory");
    const int c = lane & 7;
#pragma unroll
    for (int j = 0; j < 4; ++j) { const int n = (lane >> 3) + 8 * j; const LAS float* s = scr + (8 * c) * 33 + n;
        u32x4 o; o.x = pk2(s[0 * 33], s[1 * 33]); o.y = pk2(s[2 * 33], s[3 * 33]); o.z = pk2(s[4 * 33], s[5 * 33]); o.w = pk2(s[6 * 33], s[7 * 33]);
        *(GAS u32x4*)(WT + (size_t)(n0 + n) * K + k0 + 8 * c) = o; }
    LDS_WAIT(); asm volatile("" ::: "memory");
}
__device__ __forceinline__ void conv_dense_item(Frame& F, int l, int it, LAS float* scr) {
    GAS bf16* base = (GAS bf16*)(F.ws + WS_WDENSE + (size_t)l * WD_LAYER);
    const int lane = F.lane;
    if (it < 1792) { const int kb = it / 112, nb = it % 112; const int sc = pa_src_col(32 * nb + (lane & 31));
        transpose_item(((const GAS float*)F.in[4]) + (size_t)l * DM * NIN, NIN, DM, base + WD_WA / 2, 32 * nb, 64 * kb, sc, scr, lane); return; }
    it -= 1792;
    if (it < 1536) { const int kb = it / 96, nb = it % 96; const int sc = 3540 + 32 * nb + (lane & 31);
        transpose_item(((const GAS float*)F.in[4]) + (size_t)l * DM * NIN, NIN, DM, base + WD_WG / 2, 32 * nb, 64 * kb, sc, scr, lane); return; }
    it -= 1536;
    if (it < 768) { const int br = it / 256, r = it % 256, kb = r / 32, nb = r % 32; const int sc = 32 * nb + (lane & 31);
        transpose_item((br == 0 ? ((const GAS float*)F.in[13]) : br == 1 ? ((const GAS float*)F.in[14]) : ((const GAS float*)F.in[15])) + (size_t)l * 512 * DM, DM, 512, base + WD_WBR / 2 + (size_t)br * 1024 * 512, 32 * nb, 64 * kb, sc, scr, lane); return; }
    it -= 768;
    { const int kb = it / 32, nb = it % 32; const int sc = 32 * nb + (lane & 31);
        transpose_item(((const GAS float*)F.in[16]) + (size_t)l * DM * DM, DM, DM, base + WD_WOUT / 2, 32 * nb, 64 * kb, sc, scr, lane); }
}
__device__ __forceinline__ void conv_moe_item(Frame& F, int l, int it, LAS float* scr) {
    const int lane = F.lane; const int e = it / 384; int r = it % 384;
    if (r < 256) { const int sub = r / 64, q = r % 64, ct = sub >> 1, bj = sub & 1, kb = q / 4, nb = q % 4;
        const GAS float* src = (bj ? ((const GAS float*)F.in[24]) : ((const GAS float*)F.in[23])) + (size_t)(l * NEXP + e) * DM * DEXP;
        GAS bf16* dst = (GAS bf16*)(F.ws + WS_WMOE + WM_GU) + (size_t)e * 512 * DM;
        transpose_item(src, DEXP, DM, dst, 256 * ct + 128 * bj + 32 * nb, 64 * kb, 128 * ct + 32 * nb + (lane & 31), scr, lane); return; }
    r -= 256;
    { const int kb = r / 32, nb = r % 32;
        const GAS float* src = ((const GAS float*)F.in[25]) + (size_t)(l * NEXP + e) * DEXP * DM;
        GAS bf16* dst = (GAS bf16*)(F.ws + WS_WMOE + WM_DN) + (size_t)e * DM * DEXP;
        transpose_item(src, DM, DEXP, dst, 32 * nb, 64 * kb, 32 * nb + (lane & 31), scr, lane); }
}

__device__ __forceinline__ void ln_row_regs(f32x4 (&v)[4], const GAS float* g, const GAS float* b, int lane) {
    float s = 0.f;
#pragma unroll
    for (int j = 0; j < 4; ++j) s += (v[j].x + v[j].y) + (v[j].z + v[j].w);
    const float mean = wave_sum(s, lane) * (1.f / DM); float s2 = 0.f;
#pragma unroll
    for (int j = 0; j < 4; ++j) { v[j] = v[j] - mean; s2 += (v[j].x * v[j].x + v[j].y * v[j].y) + (v[j].z * v[j].z + v[j].w * v[j].w); }
    const float rstd = 1.f / sqrtf(wave_sum(s2, lane) * (1.f / DM) + LN_EPS);
#pragma unroll
    for (int j = 0; j < 4; ++j) { const f32x4 gg = *(const GAS f32x4*)(g + 4 * lane + 256 * j), bb = *(const GAS f32x4*)(b + 4 * lane + 256 * j); v[j] = v[j] * rstd * gg + bb; }
}
__device__ __forceinline__ void store_row_f32_bf16(const f32x4 (&v)[4], GAS float* hrow, GAS bf16* brow, int lane) {
#pragma unroll
    for (int j = 0; j < 4; ++j) {
        if (hrow) *(GAS f32x4*)(hrow + 4 * lane + 256 * j) = v[j];
        if (brow) { u32x2 w; w.x = pk2(v[j].x, v[j].y); w.y = pk2(v[j].z, v[j].w); *(GAS u32x2*)(brow + 4 * lane + 256 * j) = w; }
    }
}

__device__ __forceinline__ void phase_prologue(Frame& F) {
    LAS float* scr = (LAS float*)(F.lds + F.wave * 16384);
    const int gw = F.wg * 8 + F.wave, NGW = F.G * 8;
    for (int it = gw; it < 2 * 4608; it += NGW) conv_dense_item(F, it / 4608, it % 4608, scr);
    { GAS float* WR = (GAS float*)(F.ws + WS_WR);
      for (int i = gw * 64 + F.lane; i < DEPTH * 36 * DM; i += NGW * 64) { const int l = i / (36 * DM), r = i % (36 * DM), o = r / DM, k = r % DM;
          WR[i] = (o < 4) ? ((const GAS float*)F.in[19])[(size_t)l * DM * 4 + k * 4 + o] : ((const GAS float*)F.in[21])[(size_t)l * DM * 32 + k * 32 + (o - 4)]; } }
    { GAS float* RT = (GAS float*)(F.ws + WS_ROPE);
      for (int i = gw * 64 + F.lane; i < NTOK * 8; i += NGW * 64) { const int n = i >> 3, j = i & 7;
          const float invf[8] = {1.000000000e+00f, 1.939227432e-01f, 3.760603070e-02f, 7.292664610e-03f, 1.414213562e-03f, 2.742481884e-04f, 5.318295734e-05f, 1.031338525e-05f};
          float inv = invf[0];
#pragma unroll
          for (int q = 1; q < 8; ++q) inv = (j == q) ? invf[q] : inv;
          const float ang = (float)F.pos[n] * inv;
          const double kq = __builtin_rint((double)ang * 0.15915494309189535);
          double r = (double)ang - kq * 6.283185307179586; double csign = 1.0;
          if (r > 1.5707963267948966) { r = 3.141592653589793 - r; csign = -1.0; } else if (r < -1.5707963267948966) { r = -3.141592653589793 - r; csign = -1.0; }
          const double x2 = r * r;
          const double sn = r * (1.0 + x2 * (-1.0 / 6 + x2 * (1.0 / 120 + x2 * (-1.0 / 5040 + x2 * (1.0 / 362880 + x2 * (-1.0 / 39916800 + x2 * (1.0 / 6227020800.0 + x2 * (-1.0 / 1307674368000.0))))))));
          const double cs = 1.0 + x2 * (-0.5 + x2 * (1.0 / 24 + x2 * (-1.0 / 720 + x2 * (1.0 / 40320 + x2 * (-1.0 / 3628800 + x2 * (1.0 / 479001600.0 + x2 * (-1.0 / 87178291200.0 + x2 * (1.0 / 20922789888000.0))))))));
          RT[n * 16 + j] = (float)(csign * cs); RT[n * 16 + 8 + j] = (float)sn; } }
    GAS bf16* HB = (GAS bf16*)(F.ws + WS_HB);
    for (int m = gw; m < NTOK; m += NGW) { f32x4 v[4];
#pragma unroll
        for (int j = 0; j < 4; ++j) v[j] = *(const GAS f32x4*)(((const GAS float*)F.in[0]) + (size_t)m * DM + 4 * F.lane + 256 * j);
        ln_row_regs(v, ((const GAS float*)F.in[2]), ((const GAS float*)F.in[3]), F.lane);
        store_row_f32_bf16(v, F.H + (size_t)m * DM, HB + (size_t)m * DM, F.lane); }
}

struct DenseSched {
    int nM, nN, nwg, G, c; const char* A; const char* B; size_t atile, btile;
    __device__ void init(int nM_, int nN_, int G_, int c_, const void* A_, size_t atile_, const void* B_, size_t btile_) { nM = nM_; nN = nN_; nwg = nM * nN; G = G_; c = c_; A = (const char*)A_; B = (const char*)B_; atile = atile_; btile = btile_; }
    __device__ __forceinline__ bool next(int i, pg8::Unit& u) const {
        const long L = (long)i * G + c; if (L >= nwg) return false;
        int wgid = (int)L; { const int q = nwg / 8, r = nwg % 8, xcd = wgid % 8, off = wgid / 8; wgid = (xcd < r ? xcd * (q + 1) : r * (q + 1) + (xcd - r) * q) + off; }
        const int nig = 8 * nN, gid = wgid / nig, fm = gid * 8, gsz = (nM - fm) < 8 ? (nM - fm) : 8;
        u.pm = fm + ((wgid % nig) % gsz); u.pn = (wgid % nig) / gsz; u.e = 0; u.slot = i; return true;
    }
    __device__ __forceinline__ const char* a_base(const pg8::Unit& u) const { return A + (size_t)u.pm * atile; }
    __device__ __forceinline__ const char* b_base(const pg8::Unit& u) const { return B + (size_t)u.pn * btile; }
    __device__ __forceinline__ int row_of(const pg8::Unit&, int) const { return 0; }
};
struct GroupSched {
    int NU, G, c, ncol; const char* A; const char* B; size_t atile, erows_bytes, btile; const LAS int* meta; const LAS int* rows;
    __device__ __forceinline__ bool next(int i, pg8::Unit& u) const {
        const int L = i * G + c; if (L >= NU) return false;
        u.pm = L / ncol; u.pn = L % ncol; u.slot = i; u.e = meta[i]; return true;
    }
    __device__ __forceinline__ const char* a_base(const pg8::Unit& u) const { return A + (size_t)u.pm * atile; }
    __device__ __forceinline__ const char* b_base(const pg8::Unit& u) const { return B + (size_t)u.e * erows_bytes + (size_t)u.pn * btile; }
    __device__ __forceinline__ int row_of(const pg8::Unit& u, int r) const { return rows[u.slot * 256 + r]; }
};

struct EpiA {
    static constexpr bool PERM = true;
    GAS bf16* PA; GAS bf16* KA; GAS bf16* VA; GAS bf16* KI; GAS float* WI; GAS float* GLR; const GAS float* ROPE; const GAS float* ikg;
    __device__ __forceinline__ static void rope8(float (&x)[8], const GAS float* rt, int fq, int lane) {
        const f32x4 c0 = *(const GAS f32x4*)(rt), c1 = *(const GAS f32x4*)(rt + 4), s0 = *(const GAS f32x4*)(rt + 8), s1 = *(const GAS f32x4*)(rt + 12);
#pragma unroll
        for (int i = 0; i < 8; ++i) { const float p = shx(x[i], 16, lane); const float cc = (i < 4) ? c0[i & 3] : c1[i & 3], ss = (i < 4) ? s0[i & 3] : s1[i & 3];
            const float r = x[i] * cc + ((fq == 0) ? -p : p) * ss; x[i] = (fq < 2) ? r : x[i]; }
    }
    __device__ __forceinline__ static u32x4 pack8(const float (&x)[8]) { u32x4 w; w.x = cvt_pk_bf16(x[0], x[1]); w.y = cvt_pk_bf16(x[2], x[3]); w.z = cvt_pk_bf16(x[4], x[5]); w.w = cvt_pk_bf16(x[6], x[7]); return w; }
    __device__ __forceinline__ void operator()(const f32x4 (&acc)[2][2][4][2], const pg8::Unit& u, int wr, int wc, int fr, int fq) const {
        const int pn = u.pn; const int rowb = u.pm * 256 + wr * 64 + fr; const int lane = fq * 16 + fr;
        if (pn == 2) {
#pragma unroll
            for (int ai = 0; ai < 2; ++ai)
#pragma unroll
                for (int m = 0; m < 4; ++m) {
                    const int row = rowb + ai * 128 + m * 16;
                    float x0[8], x1[8];
#pragma unroll
                    for (int i = 0; i < 8; ++i) { x0[i] = acc[ai][0][m][i >> 2][i & 3]; x1[i] = acc[ai][1][m][i >> 2][i & 3]; }
                    if (wc == 2) {
                        float s = 0.f;
#pragma unroll
                        for (int i = 0; i < 8; ++i) s += x0[i] + x1[i];
                        s += shx(s, 16, lane); s += shx(s, 32, lane);
                        const float mean = s * (1.f / 64.f); float q = 0.f;
#pragma unroll
                        for (int i = 0; i < 8; ++i) { x0[i] -= mean; x1[i] -= mean; q += x0[i] * x0[i] + x1[i] * x1[i]; }
                        q += shx(q, 16, lane); q += shx(q, 32, lane);
                        const float rstd = 1.f / sqrtf(q * (1.f / 64.f) + LN_EPS);
#pragma unroll
                        for (int i = 0; i < 8; ++i) { x0[i] = x0[i] * rstd * ikg[8 * fq + i]; x1[i] = x1[i] * rstd * ikg[32 + 8 * fq + i]; }
                    }
                    if (wc == 0 || wc == 2) rope8(x0, ROPE + (size_t)row * 16, fq, lane);
                    if (wc < 3) {
                        GAS bf16* dst = (wc == 0) ? KA : (wc == 1) ? VA : KI;
                        *(GAS u32x4*)(dst + (size_t)row * 64 + 8 * fq) = pack8(x0); *(GAS u32x4*)(dst + (size_t)row * 64 + 32 + 8 * fq) = pack8(x1);
                    } else {
                        if (fq == 0) { *(GAS f32x4*)(WI + (size_t)row * 4) = (f32x4){x0[0], x0[1], x0[2], x0[3]} * 0.0625f; *(GAS f32x4*)(GLR + (size_t)row * 16) = (f32x4){x0[4], x0[5], x0[6], x0[7]}; }
                        else if (fq == 1) { *(GAS f32x4*)(GLR + (size_t)row * 16 + 4) = (f32x4){x0[0], x0[1], x0[2], x0[3]}; *(GAS f32x4*)(GLR + (size_t)row * 16 + 8) = (f32x4){x0[4], x0[5], x0[6], x0[7]}; }
                        else if (fq == 2) { *(GAS f32x4*)(GLR + (size_t)row * 16 + 12) = (f32x4){x0[0], x0[1], x0[2], x0[3]}; }
                    }
                    asm volatile("" ::: "memory");
                }
        } else if (pn < 2 || pn == 3) {
            const float sc = (pn == 3) ? 1.0f : 0.125f; const bool rope = !(wc & 1);
#pragma unroll
            for (int ai = 0; ai < 2; ++ai)
#pragma unroll
                for (int m = 0; m < 4; ++m) {
                    const int row = rowb + ai * 128 + m * 16;
#pragma unroll
                    for (int bj = 0; bj < 2; ++bj) { float x[8];
#pragma unroll
                        for (int i = 0; i < 8; ++i) x[i] = acc[ai][bj][m][i >> 2][i & 3];
                        if (rope) rope8(x, ROPE + (size_t)row * 16, fq, lane);
#pragma unroll
                        for (int i = 0; i < 8; ++i) x[i] *= sc;
                        *(GAS u32x4*)(PA + (size_t)row * NPA + 256 * pn + 128 * bj + 32 * wc + 8 * fq) = pack8(x); }
                    asm volatile("" ::: "memory");
                }
        } else {
            const int act = (pn == 8 || pn == 9) ? 1 : (pn >= 10) ? 2 : 0; const float sc = (pn == 4) ? 0.125f : 1.0f;
#pragma unroll
            for (int ai = 0; ai < 2; ++ai)
#pragma unroll
                for (int m = 0; m < 4; ++m) {
                    const int row = rowb + ai * 128 + m * 16;
#pragma unroll
                    for (int bj = 0; bj < 2; ++bj) { float x[8];
#pragma unroll
                        for (int i = 0; i < 8; ++i) { const float v = acc[ai][bj][m][i >> 2][i & 3]; x[i] = (act == 1) ? siluf_(v) : (act == 2) ? gelu_tanh_(v) : v * sc; }
                        *(GAS u32x4*)(PA + (size_t)row * NPA + 256 * pn + 128 * bj + 32 * wc + 8 * fq) = pack8(x); }
                    asm volatile("" ::: "memory");
                }
        }
    }
};
struct EpiG {
    static constexpr bool PERM = true;
    GAS bf16* G;
    __device__ __forceinline__ void operator()(const f32x4 (&acc)[2][2][4][2], const pg8::Unit& u, int wr, int wc, int fr, int fq) const {
        const int rowb = u.pm * 256 + wr * 64 + fr;
#pragma unroll
        for (int ai = 0; ai < 2; ++ai)
#pragma unroll
            for (int m = 0; m < 4; ++m) { const int row = rowb + ai * 128 + m * 16;
#pragma unroll
                for (int bj = 0; bj < 2; ++bj) { float x[8];
#pragma unroll
                    for (int i = 0; i < 8; ++i) x[i] = sigmoidf_(acc[ai][bj][m][i >> 2][i & 3]);
                    u32x4 w; w.x = cvt_pk_bf16(x[0], x[1]); w.y = cvt_pk_bf16(x[2], x[3]); w.z = cvt_pk_bf16(x[4], x[5]); w.w = cvt_pk_bf16(x[6], x[7]);
                    *(GAS u32x4*)(G + (size_t)row * NGT + 256 * u.pn + 128 * bj + 32 * wc + 8 * fq) = w; }
#ifdef EPIG_DRAIN
                asm volatile("s_waitcnt vmcnt(0)" ::: "memory");
#endif
            }
    }
};
struct EpiM {
    static constexpr bool PERM = true;
    const GAS bf16* G; GAS bf16* HM; int br;
    __device__ __forceinline__ void operator()(const f32x4 (&acc)[2][2][4][2], const pg8::Unit& u, int wr, int wc, int fr, int fq) const {
        const int rowb = u.pm * 256 + wr * 64 + fr;
#pragma unroll
        for (int ai = 0; ai < 2; ++ai)
#pragma unroll
            for (int m = 0; m < 4; ++m) { const int row = rowb + ai * 128 + m * 16;
#pragma unroll
                for (int bj = 0; bj < 2; ++bj) { const int col = 256 * u.pn + 128 * bj + 32 * wc + 8 * fq;
                    const u32x4 g = *(const GAS u32x4*)(G + (size_t)row * NGT + 1024 * br + col);
                    float x[8];
                    x[0] = bflo(g.x) * acc[ai][bj][m][0][0]; x[1] = bfhi(g.x) * acc[ai][bj][m][0][1]; x[2] = bflo(g.y) * acc[ai][bj][m][0][2]; x[3] = bfhi(g.y) * acc[ai][bj][m][0][3];
                    x[4] = bflo(g.z) * acc[ai][bj][m][1][0]; x[5] = bfhi(g.z) * acc[ai][bj][m][1][1]; x[6] = bflo(g.w) * acc[ai][bj][m][1][2]; x[7] = bfhi(g.w) * acc[ai][bj][m][1][3];
                    if (br > 0) { const u32x4 o = *(const GAS u32x4*)(HM + (size_t)row * DM + col);
                        x[0] += bflo(o.x); x[1] += bfhi(o.x); x[2] += bflo(o.y); x[3] += bfhi(o.y); x[4] += bflo(o.z); x[5] += bfhi(o.z); x[6] += bflo(o.w); x[7] += bfhi(o.w); }
                    u32x4 w; w.x = cvt_pk_bf16(x[0], x[1]); w.y = cvt_pk_bf16(x[2], x[3]); w.z = cvt_pk_bf16(x[4], x[5]); w.w = cvt_pk_bf16(x[6], x[7]);
                    *(GAS u32x4*)(HM + (size_t)row * DM + col) = w; }
                asm volatile("" ::: "memory"); }
    }
};
struct EpiO {
    static constexpr bool PERM = false;
    GAS float* H;
    __device__ __forceinline__ void operator()(const f32x4 (&acc)[2][2][4][2], const pg8::Unit& u, int wr, int wc, int fr, int fq) const {
        const int rowb = u.pm * 256 + wr * 64 + fr, col0 = u.pn * 256 + wc * 32 + 4 * fq;
#pragma unroll
        for (int ai = 0; ai < 2; ++ai)
#pragma unroll
            for (int m = 0; m < 4; ++m) { GAS float* rp = H + (size_t)(rowb + ai * 128 + m * 16) * DM + col0;
#pragma unroll
                for (int bj = 0; bj < 2; ++bj)
#pragma unroll
                    for (int n = 0; n < 2; ++n) { const f32x4 h = *(const GAS f32x4*)(rp + bj * 128 + n * 16); *(GAS f32x4*)(rp + bj * 128 + n * 16) = h * DN_ALPHA + acc[ai][bj][m][n]; }
                asm volatile("" ::: "memory"); }
    }
};
struct EpiGU {
    static constexpr bool PERM = true;
    GAS bf16* HID; const GAS float* CW;
    __device__ __forceinline__ void operator()(const f32x4 (&acc)[2][2][4][2], const pg8::Unit& u, int wr, int wc, int fr, int fq) const {
        const int rowb = u.pm * 256 + wr * 64 + fr;
#pragma unroll
        for (int ai = 0; ai < 2; ++ai)
#pragma unroll
            for (int m = 0; m < 4; ++m) { const int row = rowb + ai * 128 + m * 16; const float cw = CW[row];
                float x[8];
#pragma unroll
                for (int i = 0; i < 8; ++i) x[i] = siluf_(acc[ai][0][m][i >> 2][i & 3]) * acc[ai][1][m][i >> 2][i & 3] * cw;
                u32x4 w; w.x = cvt_pk_bf16(x[0], x[1]); w.y = cvt_pk_bf16(x[2], x[3]); w.z = cvt_pk_bf16(x[4], x[5]); w.w = cvt_pk_bf16(x[6], x[7]);
                *(GAS u32x4*)(HID + (size_t)row * DEXP + 128 * u.pn + 32 * wc + 8 * fq) = w; }
    }
};
struct EpiDN {
    static constexpr bool PERM = true;
    GAS bf16* FF2;
    __device__ __forceinline__ void operator()(const f32x4 (&acc)[2][2][4][2], const pg8::Unit& u, int wr, int wc, int fr, int fq) const {
        const int rowb = u.pm * 256 + wr * 64 + fr;
#pragma unroll
        for (int ai = 0; ai < 2; ++ai)
#pragma unroll
            for (int m = 0; m < 4; ++m) { const int row = rowb + ai * 128 + m * 16;
#pragma unroll
                for (int bj = 0; bj < 2; ++bj) { u32x4 w; w.x = cvt_pk_bf16(acc[ai][bj][m][0][0], acc[ai][bj][m][0][1]); w.y = cvt_pk_bf16(acc[ai][bj][m][0][2], acc[ai][bj][m][0][3]);
                    w.z = cvt_pk_bf16(acc[ai][bj][m][1][0], acc[ai][bj][m][1][1]); w.w = cvt_pk_bf16(acc[ai][bj][m][1][2], acc[ai][bj][m][1][3]);
                    *(GAS u32x4*)(FF2 + (size_t)row * DM + 256 * u.pn + 128 * bj + 32 * wc + 8 * fq) = w; } }
    }
};
#ifndef EN_B1
#define EN_B1 1
#endif
#ifndef EN_B2
#define EN_B2 1
#endif
#ifndef EN_B3
#define EN_B3 1
#endif

__device__ __forceinline__ void gmlp_unit(Frame& F, int l, int unit) {
    int tid = F.tid; asm volatile("" : "+v"(tid)); const int lane = tid & 63;
    const int chunk = unit >> 2, g = unit & 3, n0 = chunk * 128;
    const GAS bf16* PA = (const GAS bf16*)(F.ws + WS_PA); GAS bf16* Y = (GAS bf16*)(F.ws + WS_Y);
    LAS float* vln = (LAS float*)F.lds;
    LAS float* wl = (LAS float*)(F.lds + 65536);
    LAS float* st = (LAS float*)(F.lds + AUX_OFF);
    const GAS float* lng = ((const GAS float*)F.in[9]) + l * 512; const GAS float* lnb = ((const GAS float*)F.in[10]) + l * 512;
    for (int j = 0; j < 16; ++j) { const int s = F.wave * 16 + j;
        const u32x4 w = *(const GAS u32x4*)(PA + (size_t)(n0 + s) * NPA + PA_CV + 8 * lane);
        float x[8] = {bflo(w.x), bfhi(w.x), bflo(w.y), bfhi(w.y), bflo(w.z), bfhi(w.z), bflo(w.w), bfhi(w.w)};
        float sm = 0.f;
#pragma unroll
        for (int i = 0; i < 8; ++i) sm += x[i];
        const float mean = wave_sum(sm, lane) * (1.f / 512.f); float q = 0.f;
#pragma unroll
        for (int i = 0; i < 8; ++i) { const float d = x[i] - mean; q += d * d; }
        const float rstd = 1.f / sqrtf(wave_sum(q, lane) * (1.f / 512.f) + LN_EPS);
        if (lane == 0) { st[2 * s] = mean; st[2 * s + 1] = rstd; } }
    __syncthreads();
#pragma unroll
    for (int i = 0; i < 4; ++i) { const int q = tid + 512 * i, s = q >> 4, d0 = (q & 15) * 8;
        const u32x4 w = *(const GAS u32x4*)(PA + (size_t)(n0 + s) * NPA + PA_CV + g * 128 + d0);
        const float mean = st[2 * s], rstd = st[2 * s + 1];
        float x[8] = {bflo(w.x), bfhi(w.x), bflo(w.y), bfhi(w.y), bflo(w.z), bfhi(w.z), bflo(w.w), bfhi(w.w)};
#pragma unroll
        for (int k = 0; k < 8; ++k) x[k] = (x[k] - mean) * rstd * lng[g * 128 + d0 + k] + lnb[g * 128 + d0 + k];
        *(LAS f32x4*)(vln + s * 128 + d0) = (f32x4){x[0], x[1], x[2], x[3]}; *(LAS f32x4*)(vln + s * 128 + d0 + 4) = (f32x4){x[4], x[5], x[6], x[7]}; }
    const GAS float* ws = ((const GAS float*)F.in[11]) + ((size_t)l * 4 + g) * 128 * 128;
#pragma unroll
    for (int i = 0; i < 8; ++i) { const int q = tid + 512 * i, t = q >> 5, s0 = (q & 31) * 4;
        f32x4 w = *(const GAS f32x4*)(ws + t * 128 + s0);
        if (s0 + 0 > t) w.x = 0.f; if (s0 + 1 > t) w.y = 0.f; if (s0 + 2 > t) w.z = 0.f; if (s0 + 3 > t) w.w = 0.f;
        *(LAS f32x4*)(wl + t * 128 + s0) = w; }
    __syncthreads();
    const int d = tid & 127, tq = __builtin_amdgcn_readfirstlane(tid >> 7);
    float vr[128];
#pragma unroll
    for (int sb = 0; sb < 4; ++sb)
        if (sb <= tq) {
#pragma unroll
            for (int s = 0; s < 32; ++s) vr[sb * 32 + s] = vln[(sb * 32 + s) * 128 + d];
        } else {
#pragma unroll
            for (int s = 0; s < 32; ++s) vr[sb * 32 + s] = 0.f;
        }
    const GAS float* bs = ((const GAS float*)F.in[12]) + ((size_t)l * 4 + g) * 128;
#pragma unroll 1
    for (int ti = 0; ti < 32; ++ti) { const int t = tq * 32 + ti; float a = 0.f;
#pragma unroll
        for (int sb = 0; sb < 4; ++sb)
            if (sb <= tq) {
#pragma unroll
                for (int s4 = 0; s4 < 8; ++s4) { const f32x4 w = *(const LAS f32x4*)(wl + t * 128 + sb * 32 + s4 * 4);
                    a += w.x * vr[sb * 32 + s4 * 4] + w.y * vr[sb * 32 + s4 * 4 + 1] + w.z * vr[sb * 32 + s4 * 4 + 2] + w.w * vr[sb * 32 + s4 * 4 + 3]; }
            }
        const float uu = bf1(PA[(size_t)(n0 + t) * NPA + PA_CU + g * 128 + d]);
        Y[(size_t)(n0 + t) * 1536 + 1024 + g * 128 + d] = (bf16)f2bf(uu * (a + bs[t])); }
    __syncthreads();
}

__device__ __forceinline__ void gla_unit(Frame& F, int l, int unit) {
    int tid = F.tid; asm volatile("" : "+v"(tid));
    const int b = unit >> 2, h = unit & 3;
    const GAS bf16* PA = (const GAS bf16*)(F.ws + WS_PA); GAS bf16* Y = (GAS bf16*)(F.ws + WS_Y); const GAS float* GLR = (const GAS float*)(F.ws + WS_GLR);
    LAS float* wa = (LAS float*)F.lds;
    LAS float* ba = wa + 1024;
    LAS float* as_ = ba + 64;
    LAS float* qs = as_ + 1024;
    LAS float* ks = qs + 1024;
    LAS float* vs = ks + 1024;
    LAS float* part = vs + 2048;
    for (int i = tid; i < 1024; i += 512) wa[i] = ((const GAS float*)F.in[6])[(size_t)l * 16 * 256 + (i >> 6) * 256 + h * 64 + (i & 63)];
    if (tid < 64) ba[tid] = ((const GAS float*)F.in[7])[l * 256 + h * 64 + tid];
    const GAS float* gng = ((const GAS float*)F.in[8]) + l * 128;
    const int v = tid & 127, kq = __builtin_amdgcn_readfirstlane(tid >> 7);
    float S[16];
#pragma unroll
    for (int j = 0; j < 16; ++j) S[j] = 0.f;
    __syncthreads();
    for (int t0 = 0; t0 < SEQ; t0 += 16) {
        const size_t nb = (size_t)b * SEQ + t0;
#pragma unroll
        for (int i = 0; i < 2; ++i) { const int e = tid + 512 * i, t = e >> 6, k = e & 63; float z = ba[k];
#pragma unroll
            for (int r = 0; r < 16; ++r) z += GLR[(nb + t) * 16 + r] * wa[r * 64 + k];
            const float ls = fminf(z, 0.f) - log1pf(__expf(-fabsf(z)));
            as_[e] = __expf(ls * (1.f / 16.f));
            qs[e] = bf1(PA[(nb + t) * NPA + PA_BQ + h * 64 + k]); ks[e] = bf1(PA[(nb + t) * NPA + PA_BK + h * 64 + k]); }
#pragma unroll
        for (int i = 0; i < 4; ++i) { const int e = tid + 512 * i, t = e >> 7, vv = e & 127; vs[e] = bf1(PA[(nb + t) * NPA + PA_BV + h * 128 + vv]); }
        __syncthreads();
#pragma unroll 4
        for (int t = 0; t < 16; ++t) { const float vt = vs[t * 128 + v]; float p = 0.f;
#pragma unroll
            for (int j4 = 0; j4 < 4; ++j4) { const f32x4 a4 = *(const LAS f32x4*)(as_ + t * 64 + kq * 16 + j4 * 4), k4 = *(const LAS f32x4*)(ks + t * 64 + kq * 16 + j4 * 4), q4 = *(const LAS f32x4*)(qs + t * 64 + kq * 16 + j4 * 4);
#pragma unroll
                for (int j = 0; j < 4; ++j) { S[j4 * 4 + j] = a4[j] * S[j4 * 4 + j] + k4[j] * vt; p += q4[j] * S[j4 * 4 + j]; } }
            part[(kq * 16 + t) * 128 + v] = p; }
        __syncthreads();
        { const int t = tid >> 5, v4 = (tid & 31) * 4;
          f32x4 o = *(const LAS f32x4*)(part + (0 * 16 + t) * 128 + v4);
#pragma unroll
          for (int q = 1; q < 4; ++q) o += *(const LAS f32x4*)(part + (q * 16 + t) * 128 + v4);
          float ss = o.x * o.x + o.y * o.y + o.z * o.z + o.w * o.w;
#pragma unroll
          for (int sh = 1; sh < 32; sh <<= 1) ss += shx(ss, sh, tid & 63);
          const float r = 1.f / sqrtf(ss * (1.f / 128.f) + RMS_EPS);
          const f32x4 gg = *(const GAS f32x4*)(gng + v4);
          const u32x2 brw = *(const GAS u32x2*)(PA + (nb + t) * NPA + PA_BR + h * 128 + v4);
          u32x2 w; w.x = pk2(o.x * r * gg.x * bflo(brw.x), o.y * r * gg.y * bfhi(brw.x)); w.y = pk2(o.z * r * gg.z * bflo(brw.y), o.w * r * gg.w * bfhi(brw.y));
          *(GAS u32x2*)(Y + (nb + t) * 1536 + 512 + h * 128 + v4) = w; }
        __syncthreads();
    }
}

constexpr int DSA_WAVE_LDS = 17920;
__device__ __forceinline__ void dsa_unit(Frame& F, int unit) {
    int lane = F.lane; asm volatile("" : "+v"(lane)); const int w = F.wave;
    const int qb = 4095 - unit;
    const int b = qb & 7, t = (qb >> 3) * 8 + w;
    const size_t n = (size_t)b * SEQ + t, nb0 = (size_t)b * SEQ;
    const GAS bf16* PA = (const GAS bf16*)(F.ws + WS_PA); GAS bf16* Y = (GAS bf16*)(F.ws + WS_Y);
    const GAS bf16* KI = (const GAS bf16*)(F.ws + WS_KI); const GAS bf16* KA = (const GAS bf16*)(F.ws + WS_KA); const GAS bf16* VA = (const GAS bf16*)(F.ws + WS_VA);
    const GAS float* WI = (const GAS float*)(F.ws + WS_WI);
    LAS unsigned char* base = F.lds + w * DSA_WAVE_LDS;
    LAS unsigned* sc = (LAS unsigned*)base;
    LAS float* qi = (LAS float*)(base + 16384);
    LAS unsigned short* list = (LAS unsigned short*)(base + 16384 + 1024);
    { const u32x2 q2 = *(const GAS u32x2*)(PA + n * NPA + PA_QI + 4 * lane);
      *(LAS f32x4*)(qi + 4 * lane) = (f32x4){bflo(q2.x), bfhi(q2.x), bflo(q2.y), bfhi(q2.y)}; }
    asm volatile("s_waitcnt lgkmcnt(0)" ::: "memory");
    const f32x4 wi = {ld_f32(WI + n * 4), ld_f32(WI + n * 4 + 1), ld_f32(WI + n * 4 + 2), ld_f32(WI + n * 4 + 3)};
    const int nbat = (t >> 6) + 1;
    for (int kb = 0; kb < nbat; ++kb) { const int key = kb * 64 + lane, kc = key <= t ? key : t;
        const GAS u32x4* kp = (const GAS u32x4*)(KI + (nb0 + kc) * 64);
        float kf[64];
#pragma unroll
        for (int c = 0; c < 8; ++c) { const u32x4 kk = kp[c]; kf[8 * c] = bflo(kk.x); kf[8 * c + 1] = bfhi(kk.x); kf[8 * c + 2] = bflo(kk.y); kf[8 * c + 3] = bfhi(kk.y); kf[8 * c + 4] = bflo(kk.z); kf[8 * c + 5] = bfhi(kk.z); kf[8 * c + 6] = bflo(kk.w); kf[8 * c + 7] = bfhi(kk.w); }
        float score = 0.f;
#pragma unroll
        for (int h = 0; h < 4; ++h) { float d = 0.f;
#pragma unroll
            for (int c = 0; c < 16; ++c) { const f32x4 q4 = *(const LAS f32x4*)(qi + h * 64 + 4 * c); d += q4.x * kf[4 * c] + q4.y * kf[4 * c + 1] + q4.z * kf[4 * c + 2] + q4.w * kf[4 * c + 3]; }
            score += wi[h] * fmaxf(d, 0.f); }
        if (score == 0.f) score = 0.f;
        unsigned u = __builtin_bit_cast(unsigned, score); u = (u & 0x80000000u) ? ~u : (u | 0x80000000u);
        sc[key] = key <= t ? u : 0u; }
    asm volatile("s_waitcnt lgkmcnt(0)" ::: "memory");
    int nsel;
    if (t >= 256) {
        unsigned T = 0u;
        for (int bit = 31; bit >= 0; --bit) { const unsigned cand = T | (1u << bit); int cnt = 0;
            for (int j = 0; j < nbat; ++j) cnt += (sc[j * 64 + lane] >= cand) ? 1 : 0;
            if (wave_sum_i(cnt, lane) >= 256) T = cand; }
        int cgt = 0;
        for (int j = 0; j < nbat; ++j) cgt += (sc[j * 64 + lane] > T) ? 1 : 0;
        const int need = 256 - wave_sum_i(cgt, lane);
        int selbase = 0, tiebase = 0;
        for (int j = 0; j < nbat; ++j) { const unsigned x = sc[j * 64 + lane]; const bool eq = (x == T), gt = (x > T);
            const unsigned long long beq = __ballot(eq); const unsigned long long lt = (1ull << lane) - 1ull;
            const int trank = tiebase + __popcll(beq & lt);
            const bool sel = gt || (eq && trank < need);
            const unsigned long long bsel = __ballot(sel);
            if (sel) list[selbase + __popcll(bsel & lt)] = (unsigned short)(j * 64 + lane);
            selbase += __popcll(bsel); tiebase += __popcll(beq); }
        nsel = 256;
    } else {
        nsel = t + 1;
        for (int i = lane; i < 256; i += 64) list[i] = (unsigned short)(i <= t ? i : 0);
    }
    asm volatile("s_waitcnt lgkmcnt(0)" ::: "memory");
    LAS float* qm = (LAS float*)base;
    LAS float* Pl = (LAS float*)(base + 2048);
    { const u32x4 q8 = *(const GAS u32x4*)(PA + n * NPA + PA_Q + 8 * lane);
      *(LAS f32x4*)(qm + 8 * lane) = (f32x4){bflo(q8.x), bfhi(q8.x), bflo(q8.y), bfhi(q8.y)}; *(LAS f32x4*)(qm + 8 * lane + 4) = (f32x4){bflo(q8.z), bfhi(q8.z), bflo(q8.w), bfhi(q8.w)}; }
    asm volatile("s_waitcnt lgkmcnt(0)" ::: "memory");
#pragma unroll 1
    for (int bb = 0; bb < 4; ++bb) { const int i = bb * 64 + lane; const bool valid = i < nsel; const int key = valid ? (int)list[i] : 0;
        const GAS u32x4* kp = (const GAS u32x4*)(KA + (nb0 + key) * 64);
        float kf[64];
#pragma unroll
        for (int c = 0; c < 8; ++c) { const u32x4 kk = kp[c]; kf[8 * c] = bflo(kk.x); kf[8 * c + 1] = bfhi(kk.x); kf[8 * c + 2] = bflo(kk.y); kf[8 * c + 3] = bfhi(kk.y); kf[8 * c + 4] = bflo(kk.z); kf[8 * c + 5] = bfhi(kk.z); kf[8 * c + 6] = bflo(kk.w); kf[8 * c + 7] = bfhi(kk.w); }
        float lgv[8];
#pragma unroll
        for (int h = 0; h < 8; ++h) { float d = 0.f;
#pragma unroll
            for (int c = 0; c < 16; ++c) { const f32x4 q4 = *(const LAS f32x4*)(qm + h * 64 + 4 * c); d += q4.x * kf[4 * c] + q4.y * kf[4 * c + 1] + q4.z * kf[4 * c + 2] + q4.w * kf[4 * c + 3]; }
            lgv[h] = valid ? d : -INFINITY; }
        *(LAS f32x4*)(Pl + i * 8) = (f32x4){lgv[0], lgv[1], lgv[2], lgv[3]}; *(LAS f32x4*)(Pl + i * 8 + 4) = (f32x4){lgv[4], lgv[5], lgv[6], lgv[7]}; }
    asm volatile("s_waitcnt lgkmcnt(0)" ::: "memory");
    float lg[4][8];
#pragma unroll
    for (int bb = 0; bb < 4; ++bb) { const f32x4 a = *(const LAS f32x4*)(Pl + (bb * 64 + lane) * 8), c = *(const LAS f32x4*)(Pl + (bb * 64 + lane) * 8 + 4);
        lg[bb][0] = a.x; lg[bb][1] = a.y; lg[bb][2] = a.z; lg[bb][3] = a.w; lg[bb][4] = c.x; lg[bb][5] = c.y; lg[bb][6] = c.z; lg[bb][7] = c.w; }
    float den[8];
#pragma unroll
    for (int h = 0; h < 8; ++h) { float m = fmaxf(fmaxf(lg[0][h], lg[1][h]), fmaxf(lg[2][h], lg[3][h])); m = wave_max(m, lane); float s = 0.f;
#pragma unroll
        for (int bb = 0; bb < 4; ++bb) { lg[bb][h] = __expf(lg[bb][h] - m); s += lg[bb][h]; }
        den[h] = wave_sum(s, lane); }
#pragma unroll
    for (int bb = 0; bb < 4; ++bb) { const int i = bb * 64 + lane;
        *(LAS f32x4*)(Pl + i * 8) = (f32x4){lg[bb][0], lg[bb][1], lg[bb][2], lg[bb][3]}; *(LAS f32x4*)(Pl + i * 8 + 4) = (f32x4){lg[bb][4], lg[bb][5], lg[bb][6], lg[bb][7]}; }
    asm volatile("s_waitcnt lgkmcnt(0)" ::: "memory");
    float o[8];
#pragma unroll
    for (int h = 0; h < 8; ++h) o[h] = 0.f;
#pragma unroll 4
    for (int i = 0; i < nsel; ++i) { const int key = (int)list[i]; const float vv = bf1(VA[(nb0 + key) * 64 + lane]);
        const f32x4 p0 = *(const LAS f32x4*)(Pl + i * 8), p1 = *(const LAS f32x4*)(Pl + i * 8 + 4);
        o[0] += p0.x * vv; o[1] += p0.y * vv; o[2] += p0.z * vv; o[3] += p0.w * vv; o[4] += p1.x * vv; o[5] += p1.y * vv; o[6] += p1.z * vv; o[7] += p1.w * vv; }
#pragma unroll
    for (int h = 0; h < 8; ++h) Y[n * 1536 + h * 64 + lane] = (bf16)f2bf(o[h] / den[h]);
}

__device__ __forceinline__ void phase_mixer(Frame& F, int l) {
    gu32* head = F.ctl + CW_QUEUE + 64 * l;
    for (;;) {
        __syncthreads();
        if (F.tid == 0) F.MISC[64] = __hip_atomic_fetch_add(head, 1u, __ATOMIC_RELAXED, __HIP_MEMORY_SCOPE_AGENT);
        __syncthreads();
        const int u = (int)F.MISC[64];
        if (u >= 32 + 4096 + 1024) break;
        if (u < 32) { if (EN_B1) gla_unit(F, l, u); }
        else if (u < 32 + 4096) { if (EN_B2) dsa_unit(F, u - 32); }
        else { if (EN_B3) gmlp_unit(F, l, u - 32 - 4096); }
    }
}

__device__ __forceinline__ void phase_ln_router(Frame& F, int l) {
    const GAS float* WR = (const GAS float*)(F.ws + WS_WR) + (size_t)l * 36 * DM;
    LAS float* wr = (LAS float*)F.lds;
    for (int i = F.tid; i < 36 * 256; i += 512) ((LAS f32x4*)wr)[i] = ((const GAS f32x4*)WR)[i];
    if (F.tid < 32) F.MISC[16 + F.tid] = 0u;
    __syncthreads();
    GAS bf16* HB = (GAS bf16*)(F.ws + WS_HB); GAS int* EID = (GAS int*)(F.ws + WS_ROUTE); GAS float* EW = (GAS float*)(F.ws + WS_ROUTE + 256 * 1024);
    const GAS float* g = ((const GAS float*)F.in[17]) + l * DM; const GAS float* bb = ((const GAS float*)F.in[18]) + l * DM; const GAS float* brg = ((const GAS float*)F.in[20]) + l * 4; const GAS float* bre = ((const GAS float*)F.in[22]) + l * 32;
    const int lane = F.lane;
    for (int r0 = F.wg * 128; r0 < NTOK; r0 += F.G * 128)
        for (int j = 0; j < 16; ++j) { const int m = r0 + F.wave * 16 + j;
            f32x4 v[4];
#pragma unroll
            for (int q = 0; q < 4; ++q) v[q] = *(const GAS f32x4*)(F.H + (size_t)m * DM + 4 * lane + 256 * q);
            ln_row_regs(v, g, bb, lane);
            store_row_f32_bf16(v, F.H + (size_t)m * DM, HB + (size_t)m * DM, lane);
            float lgt[36];
#pragma unroll
            for (int o = 0; o < 36; ++o) { float p = 0.f;
#pragma unroll
                for (int q = 0; q < 4; ++q) { const f32x4 w4 = *(const LAS f32x4*)(wr + o * DM + 4 * lane + 256 * q); p += v[q].x * w4.x + v[q].y * w4.y + v[q].z * w4.z + v[q].w * w4.w; }
                lgt[o] = wave_sum(p, lane); }
            int gi = 0; float gm = lgt[0] + brg[0];
#pragma unroll
            for (int q = 1; q < 4; ++q) { const float x = lgt[q] + brg[q]; if (x > gm) { gm = x; gi = q; } }
            float gs = 0.f;
#pragma unroll
            for (int q = 0; q < 4; ++q) gs += __expf(lgt[q] + brg[q] - gm);
            const float gp = 1.f / gs;
            float el[8];
#pragma unroll
            for (int q = 0; q < 8; ++q) { float x = lgt[4 + q] + bre[q];
                x = (gi == 1) ? lgt[12 + q] + bre[8 + q] : x; x = (gi == 2) ? lgt[20 + q] + bre[16 + q] : x; x = (gi == 3) ? lgt[28 + q] + bre[24 + q] : x; el[q] = x; }
            int i0 = 0; float v0 = el[0];
#pragma unroll
            for (int q = 1; q < 8; ++q) if (el[q] > v0) { v0 = el[q]; i0 = q; }
            int i1 = -1; float v1 = -INFINITY;
#pragma unroll
            for (int q = 0; q < 8; ++q) if (q != i0 && el[q] > v1) { v1 = el[q]; i1 = q; }
            const float ex = __expf(v1 - v0), w0 = gp / (1.f + ex), w1 = gp * ex / (1.f + ex);
            if (lane == 0) { const int e0 = gi * 8 + i0, e1 = gi * 8 + i1;
                EID[2 * m] = e0; EID[2 * m + 1] = e1; EW[2 * m] = w0; EW[2 * m + 1] = w1;
                __hip_atomic_fetch_add((LAS unsigned*)(F.lds + MISC_OFF) + 16 + e0, 1u, __ATOMIC_RELAXED, __HIP_MEMORY_SCOPE_WORKGROUP);
                __hip_atomic_fetch_add((LAS unsigned*)(F.lds + MISC_OFF) + 16 + e1, 1u, __ATOMIC_RELAXED, __HIP_MEMORY_SCOPE_WORKGROUP); } }
    __syncthreads();
    if (F.tid < 32) ((GAS int*)(F.ws + WS_CNTWG))[F.wg * 32 + F.tid] = (int)F.MISC[16 + F.tid];
}
__device__ __forceinline__ void phase_dispatch(Frame& F) {
    const GAS int* CNT = (const GAS int*)(F.ws + WS_CNTWG); const GAS int* EID = (const GAS int*)(F.ws + WS_ROUTE); const GAS float* EW = (const GAS float*)(F.ws + WS_ROUTE + 256 * 1024);
    GAS int* SROW = (GAS int*)(F.ws + WS_SROW); GAS int* ROWMAP = (GAS int*)(F.ws + WS_ROWMAP); GAS float* CWROW = (GAS float*)(F.ws + WS_CWROW); GAS int* META = (GAS int*)(F.ws + WS_META);
    LAS int* tot = (LAS int*)(F.lds + AUX_OFF);
    if (F.tid < 32) { int t = 0, mine = 0; for (int w = 0; w < F.G; ++w) { const int c = ld_i32(CNT + w * 32 + F.tid); t += c; if (w < F.wg) mine += c; } tot[F.tid] = t; tot[32 + F.tid] = mine; tot[96 + F.tid] = 0; }
    __syncthreads();
    if (F.tid == 0) { int rb = 0;
#pragma clang loop unroll(disable) vectorize(disable)
        for (int e = 0; e < 32; ++e) { tot[64 + e] = rb; rb += ((tot[e] + 255) >> 8) << 8; }
        tot[128] = rb; }
    __syncthreads();
    if (F.wg == 0) { const int nt = tot[128] >> 8; if (F.tid == 0) META[0] = nt;
        if (F.tid < nt) { int e = 0;
#pragma clang loop unroll(disable) vectorize(disable)
            for (int q = 1; q < 32; ++q) if (tot[64 + q] <= F.tid * 256) e = q;
            META[16 + F.tid] = e; } }
    for (int r0 = F.wg * 128; r0 < NTOK; r0 += F.G * 128) {
        if (F.tid < 256) { const int tok = r0 + (F.tid >> 1), slot = F.tid & 1; const int e = EID[2 * tok + slot];
            const int pos = (int)__hip_atomic_fetch_add((LAS unsigned*)&tot[96 + e], 1u, __ATOMIC_RELAXED, __HIP_MEMORY_SCOPE_WORKGROUP);
            const int sr = tot[64 + e] + tot[32 + e] + pos;
            ROWMAP[sr] = tok; CWROW[sr] = EW[2 * tok + slot]; SROW[2 * tok + slot] = sr; } }
    if (F.wg < 32) { const int e = F.wg; const int lo = tot[64 + e] + tot[e], hi = tot[64 + e] + (((tot[e] + 255) >> 8) << 8);
        for (int r = lo + F.tid; r < hi; r += 512) { ROWMAP[r] = 0; CWROW[r] = 0.f; } }
}
__device__ __forceinline__ void phase_ln2(Frame& F, int l) {
    GAS bf16* HB = (GAS bf16*)(F.ws + WS_HB); const GAS int* SROW = (const GAS int*)(F.ws + WS_SROW); const GAS bf16* FF2 = (const GAS bf16*)(F.ws + WS_FF2);
    const GAS float* g = ((const GAS float*)F.in[26]) + l * DM; const GAS float* bb = ((const GAS float*)F.in[27]) + l * DM; int lane = F.lane; asm volatile("" : "+v"(lane));
    const int gw = F.wg * 8 + F.wave, NGW = F.G * 8;
    for (int m = gw; m < NTOK; m += NGW) { const int s0 = ld_i32(SROW + 2 * m), s1 = ld_i32(SROW + 2 * m + 1);
        f32x4 v[4];
#pragma unroll
        for (int q = 0; q < 4; ++q) { const f32x4 h = *(const GAS f32x4*)(F.H + (size_t)m * DM + 4 * lane + 256 * q);
            const u32x2 a = *(const GAS u32x2*)(FF2 + (size_t)s0 * DM + 4 * lane + 256 * q), c = *(const GAS u32x2*)(FF2 + (size_t)s1 * DM + 4 * lane + 256 * q);
            v[q] = h * DN_ALPHA + (f32x4){bflo(a.x) + bflo(c.x), bfhi(a.x) + bfhi(c.x), bflo(a.y) + bflo(c.y), bfhi(a.y) + bfhi(c.y)}; }
        ln_row_regs(v, g, bb, lane);
        store_row_f32_bf16(v, F.H + (size_t)m * DM, HB + (size_t)m * DM, lane); }
}

#ifndef EN_P
#define EN_P 1
#endif
#ifndef EN_A
#define EN_A 1
#endif
#ifndef EN_B
#define EN_B 1
#endif
#ifndef EN_C
#define EN_C 1
#endif
#ifndef EN_D
#define EN_D 1
#endif
#ifndef EN_E
#define EN_E 1
#endif
#ifndef EN_F
#define EN_F 1
#endif
#ifndef EN_G
#define EN_G 1
#endif
#ifndef EN_H
#define EN_H 1
#endif
#ifndef EN_I
#define EN_I 1
#endif
#ifndef EN_J
#define EN_J 1
#endif
constexpr int N_PHASES = 1 + 10 * DEPTH;
#ifndef MK_ONE_LAUNCH
#define MK_ONE_LAUNCH 0
#endif
struct Args { const float* in[28]; float* out; unsigned char* ws; int ph_lo, ph_hi; };
static_assert(sizeof(Args) == 28 * 8 + 8 + 8 + 8, "no padding bytes in the argument struct");


__device__ __forceinline__ unsigned opaque_u32(unsigned x) { asm volatile("" : "+v"(x)); return (unsigned)__builtin_amdgcn_readfirstlane((int)x); }
__device__ __forceinline__ unsigned long long opaque_u64(unsigned long long x) { return ((unsigned long long)opaque_u32((unsigned)(x >> 32)) << 32) | opaque_u32((unsigned)x); }
__device__ __forceinline__ void launder(Frame& F) {
    F.ws = (GAS unsigned char*)opaque_u64((unsigned long long)F.ws); F.H = (GAS float*)opaque_u64((unsigned long long)F.H);
    F.ctl = (gu32*)opaque_u64((unsigned long long)F.ctl);
    unsigned z0 = 0u; asm volatile("" : "+v"(z0)); int ln = (int)__builtin_amdgcn_mbcnt_hi(~0u, __builtin_amdgcn_mbcnt_lo(~0u, z0));
    F.wave = (int)opaque_u32((unsigned)F.wave); F.lane = ln; F.tid = F.wave * 64 + ln;
    F.G = (int)opaque_u32((unsigned)F.G); F.wg = (int)opaque_u32((unsigned)F.wg);
}
__global__ void __launch_bounds__(512, 2) mk_fwd(Args args) {
    extern __shared__ __attribute__((aligned(16))) unsigned char lds_raw[];
    Frame F;
    F.lds = (LAS unsigned char*)lds_raw;
    F.MISC = (volatile LAS unsigned*)(F.lds + MISC_OFF);
    F.tid = threadIdx.x; F.lane = F.tid & 63; F.wave = __builtin_amdgcn_readfirstlane(F.tid >> 6);
    F.G = gridDim.x; F.wg = blockIdx.x;
    F.in = args.in;
    F.pos = (const GAS int*)args.in[1];
    F.H = (GAS float*)args.out; F.ws = (GAS unsigned char*)args.ws;
    F.ctl = (gu32*)(args.ws + WS_CTL);
    for (int u = F.tid; u < (LDS_BYTES - MISC_OFF) / 4; u += 512) ((LAS unsigned*)(F.lds + MISC_OFF))[u] = 0u;
    __syncthreads();
    const int lo = args.ph_lo, hi = args.ph_hi;
    const bool multi = (hi - lo) > 1;
    XcdBarrier bar; bar.bar = (unsigned*)(F.ctl + CW_BAR); bar.x = 0; bar.st = nullptr;
    if (multi) bar = xcd_barrier_post((unsigned*)(F.ctl + CW_BAR), F.MISC + 8);
#define IN(k) (lo <= (k) && (k) < hi)
#define SEAM(k) do { if (IN(k) && IN((k) + 1)) xcd_barrier(bar); } while (0)

    if (EN_P && IN(0)) { launder(F); phase_prologue(F); }
    SEAM(0);
#define HB ((GAS bf16*)(F.ws + WS_HB))
#define PA ((GAS bf16*)(F.ws + WS_PA))
#define Y ((GAS bf16*)(F.ws + WS_Y))
    for (int l = 0; l < DEPTH; ++l) {
        const int pb = 1 + 10 * l;
#define wd (F.ws + WS_WDENSE + (size_t)l * WD_LAYER)
        if (EN_A && IN(pb + 0)) { launder(F);
            { LAS float* scr = (LAS float*)(F.lds + F.wave * 16384); const int gw = F.wg * 8 + F.wave, NGW = F.G * 8;
              for (int it = gw; it < 12288; it += NGW) conv_moe_item(F, l, it, scr);
              __syncthreads(); }
            DenseSched S; S.init(NTOK / 256, NPA / 256, F.G, F.wg, (const void*)HB, (size_t)256 * DM * 2, (const void*)(wd + WD_WA), (size_t)256 * DM * 2);
            EpiA E{PA, (GAS bf16*)(F.ws + WS_KA), (GAS bf16*)(F.ws + WS_VA), (GAS bf16*)(F.ws + WS_KI), (GAS float*)(F.ws + WS_WI), (GAS float*)(F.ws + WS_GLR), (const GAS float*)(F.ws + WS_ROPE), ((const GAS float*)F.in[5]) + l * 64};
            pg8::gemm_phase<EpiA, DenseSched, false>(F.lds, S, E, DM, DM, F.wave);
        }
        SEAM(pb + 0);
        if (EN_B && IN(pb + 1)) { launder(F); phase_mixer(F, l); }
        SEAM(pb + 1);
        if (EN_C && IN(pb + 2)) { launder(F);
            DenseSched S; S.init(NTOK / 256, NGT / 256, F.G, F.wg, (const void*)HB, (size_t)256 * DM * 2, (const void*)(wd + WD_WG), (size_t)256 * DM * 2);
            EpiG E{PA};
            pg8::gemm_phase<EpiG, DenseSched, false>(F.lds, S, E, DM, DM, F.wave);
        }
        SEAM(pb + 2);
        if (EN_D && IN(pb + 3)) { launder(F);
#pragma unroll 1
            for (int br = 0; br < 3; ++br) {
                DenseSched S; S.init(NTOK / 256, DM / 256, F.G, F.wg, (const void*)(Y + 512 * br), (size_t)256 * 1536 * 2, (const void*)(wd + WD_WBR + (size_t)br * 1024 * 512 * 2), (size_t)256 * 512 * 2);
                EpiM E{PA, HB, br};
                pg8::gemm_phase<EpiM, DenseSched, false>(F.lds, S, E, 512, 1536, F.wave);
            }
        }
        SEAM(pb + 3);
        if (EN_E && IN(pb + 4)) { launder(F);
            DenseSched S; S.init(NTOK / 256, DM / 256, F.G, F.wg, (const void*)HB, (size_t)256 * DM * 2, (const void*)(wd + WD_WOUT), (size_t)256 * DM * 2);
            EpiO E{F.H};
            pg8::gemm_phase<EpiO, DenseSched, false>(F.lds, S, E, DM, DM, F.wave);
        }
        SEAM(pb + 4);
        if (EN_F && IN(pb + 5)) { launder(F); phase_ln_router(F, l); }
        SEAM(pb + 5);
        if (EN_G && IN(pb + 6)) { launder(F); phase_dispatch(F); }
        SEAM(pb + 6);
        if (EN_H && IN(pb + 7)) { launder(F);
            const GAS int* META = (const GAS int*)(F.ws + WS_META); const GAS int* ROWMAP = (const GAS int*)(F.ws + WS_ROWMAP);
            const int NT = ld_i32(META), NU = NT * 2;
            LAS int* meta = (LAS int*)(F.lds + AUX_OFF); LAS int* rows = (LAS int*)(F.lds + AUX_OFF + 64);
            for (int i = 0; i * F.G + F.wg < NU && i < 8; ++i) { const int L = i * F.G + F.wg, gt = L >> 1;
                if (F.tid == 0) meta[i] = ld_i32(META + 16 + gt);
                if (F.tid < 256) rows[i * 256 + F.tid] = ROWMAP[gt * 256 + F.tid]; }
            __syncthreads();
            GroupSched S{NU, F.G, F.wg, 2, (const char*)HB, (const char*)(F.ws + WS_WMOE + WM_GU), 0, (size_t)512 * DM * 2, (size_t)256 * DM * 2, meta, rows};
            EpiGU E{(GAS bf16*)(F.ws + WS_HID), (const GAS float*)(F.ws + WS_CWROW)};
            pg8::gemm_phase<EpiGU, GroupSched, true>(F.lds, S, E, DM, DM, F.wave);
        }
        SEAM(pb + 7);
        if (EN_I && IN(pb + 8)) { launder(F);
            const GAS int* META = (const GAS int*)(F.ws + WS_META);
            const int NT = ld_i32(META), NU = NT * 4;
            LAS int* meta = (LAS int*)(F.lds + AUX_OFF);
            for (int i = 0; i * F.G + F.wg < NU && i < 8; ++i) { const int L = i * F.G + F.wg, gt = L >> 2; if (F.tid == 0) meta[i] = ld_i32(META + 16 + gt); }
            __syncthreads();
            GroupSched S{NU, F.G, F.wg, 4, (const char*)(F.ws + WS_HID), (const char*)(F.ws + WS_WMOE + WM_DN), (size_t)256 * DEXP * 2, (size_t)DM * DEXP * 2, (size_t)256 * DEXP * 2, meta, nullptr};
            EpiDN E{(GAS bf16*)(F.ws + WS_FF2)};
            pg8::gemm_phase<EpiDN, GroupSched, false>(F.lds, S, E, DEXP, DEXP, F.wave);
        }
        SEAM(pb + 8);
        if (EN_J && IN(pb + 9)) { launder(F); phase_ln2(F, l); }
        SEAM(pb + 9);
    }
#undef IN
#undef SEAM
#undef HB
#undef PA
#undef Y
#undef wd
}


#ifdef DUMP_OFF
__global__ void dump_k(const unsigned short* src, float* out) {
    for (size_t i = (size_t)blockIdx.x * blockDim.x + threadIdx.x; i < (size_t)NTOK * 1024; i += (size_t)gridDim.x * blockDim.x) { const size_t n = i >> 10, c = i & 1023; out[i] = __builtin_bit_cast(float, ((unsigned)src[n * DUMP_PITCH + c]) << 16); }
}
#endif
extern "C" void kernel_launch(void* const* d_in, const int* in_sizes, int n_in, void* d_out, int out_size, void* d_ws, size_t ws_size, hipStream_t stream) {
    static int grid = 0;
    if (grid == 0) {
        if (n_in != 28 || out_size != NTOK * DM || ws_size < WS_END) { fprintf(stderr, "kernel_launch: unexpected shapes (n_in %d out %d ws %zu); nothing launched\n", n_in, out_size, ws_size); grid = -1; return; }
        int dev = 0, cus = 0;
        if (hipGetDevice(&dev) != hipSuccess || hipDeviceGetAttribute(&cus, hipDeviceAttributeMultiprocessorCount, dev) != hipSuccess) { grid = -1; return; }
        if (hipFuncSetAttribute((const void*)mk_fwd, hipFuncAttributeMaxDynamicSharedMemorySize, LDS_BYTES) != hipSuccess) { fprintf(stderr, "kernel_launch: hipFuncSetAttribute failed\n"); grid = -1; return; }
        int per_cu = 0;
        if (hipOccupancyMaxActiveBlocksPerMultiprocessor(&per_cu, (const void*)mk_fwd, 512, LDS_BYTES) != hipSuccess || per_cu < 1) { fprintf(stderr, "kernel_launch: occupancy query says %d\n", per_cu); }
        (void)hipGetLastError();
        grid = cus;
        if (grid != 256) fprintf(stderr, "kernel_launch: %d CUs (built for 256)\n", grid);
    }
    if (grid < 0) return;
    if (hipMemsetAsync((char*)d_ws + WS_CTL, 0, CTL_ZERO_BYTES, stream) != hipSuccess) return;
    Args a{};
    for (int i = 0; i < 28; ++i) a.in[i] = (const float*)d_in[i];
    a.out = (float*)d_out; a.ws = (unsigned char*)d_ws;
#if MK_ONE_LAUNCH
    a.ph_lo = 0; a.ph_hi = N_PHASES;
    hipLaunchKernelGGL(mk_fwd, dim3(grid), dim3(512), LDS_BYTES, stream, a);
#else
#ifndef STOP_AFTER
#define STOP_AFTER (N_PHASES - 1)
#endif
#ifndef PHASE_MASK
#define PHASE_MASK 0xffffffffu
#endif
    for (int p = 0; p <= STOP_AFTER; ++p) { if (!((PHASE_MASK >> p) & 1u)) continue; a.ph_lo = p; a.ph_hi = p + 1; hipLaunchKernelGGL(mk_fwd, dim3(grid), dim3(512), LDS_BYTES, stream, a); }
#ifdef DUMP_OFF
    hipLaunchKernelGGL(dump_k, dim3(2048), dim3(256), 0, stream, (const unsigned short*)((const char*)d_ws + (size_t)(DUMP_OFF)), (float*)d_out);
#endif
#endif
}
```

```cpp
#define MK_ONE_LAUNCH 1
#include <hip/hip_runtime.h>
#include <cstdio>
#include <cstdint>

#define LAS __attribute__((address_space(3)))
#define GAS __attribute__((address_space(1)))
typedef unsigned short bf16;
typedef short bf16x8 __attribute__((ext_vector_type(8)));
typedef float f32x4 __attribute__((ext_vector_type(4)));
typedef float f32x2 __attribute__((ext_vector_type(2)));
typedef unsigned u32x4 __attribute__((ext_vector_type(4)));
typedef unsigned u32x2 __attribute__((ext_vector_type(2)));
typedef GAS unsigned gu32;

constexpr int NB = 8, SEQ = 4096, NTOK = NB * SEQ, DM = 1024, NIN = 6612, DEPTH = 2;
constexpr int NPA = 3584;
constexpr int NGT = 3072;
constexpr int NEXP = 32, DEXP = 256;
constexpr int MAXTILES = 288;
constexpr float DN_ALPHA = 1.41421356237309515f;
constexpr float LN_EPS = 1e-5f, RMS_EPS = 1e-6f;
constexpr int PA_Q = 0, PA_QI = 768, PA_BQ = 1024, PA_BK = 1280, PA_BV = 1536, PA_BR = 2048, PA_CU = 2560, PA_CV = 3072;

__device__ __forceinline__ unsigned f2bf(float f) { unsigned u = __builtin_bit_cast(unsigned, f); return (u + 0x7fffu + ((u >> 16) & 1u)) >> 16; }
__device__ __forceinline__ unsigned pk2(float lo, float hi) { return f2bf(lo) | (f2bf(hi) << 16); }
__device__ __forceinline__ float bflo(unsigned w) { return __builtin_bit_cast(float, w << 16); }
__device__ __forceinline__ float bfhi(unsigned w) { return __builtin_bit_cast(float, w & 0xffff0000u); }
__device__ __forceinline__ float bf1(bf16 h) { return __builtin_bit_cast(float, ((unsigned)h) << 16); }
typedef __bf16 bf16x2_t __attribute__((ext_vector_type(2)));
__device__ __forceinline__ unsigned cvt_pk_bf16(float lo, float hi) { const f32x2 v = {lo, hi}; const bf16x2_t b = __builtin_convertvector(v, bf16x2_t); return __builtin_bit_cast(unsigned, b); }
__device__ __forceinline__ float shx(float v, int mask, int lane) { return __builtin_bit_cast(float, __builtin_amdgcn_ds_bpermute((lane ^ mask) << 2, __builtin_bit_cast(int, v))); }
__device__ __forceinline__ int shxi(int v, int mask, int lane) { return __builtin_amdgcn_ds_bpermute((lane ^ mask) << 2, v); }
__device__ __forceinline__ float wave_sum(float v, int lane) {
#pragma unroll
    for (int o = 1; o < 64; o <<= 1) v += shx(v, o, lane);
    return v;
}
__device__ __forceinline__ float wave_max(float v, int lane) {
#pragma unroll
    for (int o = 1; o < 64; o <<= 1) v = fmaxf(v, shx(v, o, lane));
    return v;
}
__device__ __forceinline__ int wave_sum_i(int v, int lane) {
#pragma unroll
    for (int o = 1; o < 64; o <<= 1) v += shxi(v, o, lane);
    return v;
}
__device__ __forceinline__ int ld_i32(const GAS int* p) { return __hip_atomic_load(p, __ATOMIC_RELAXED, __HIP_MEMORY_SCOPE_AGENT); }
__device__ __forceinline__ float ld_f32(const GAS float* p) { return __hip_atomic_load(p, __ATOMIC_RELAXED, __HIP_MEMORY_SCOPE_AGENT); }
__device__ __forceinline__ float sigmoidf_(float x) { return __builtin_amdgcn_rcpf(1.0f + __expf(-x)); }
__device__ __forceinline__ float siluf_(float x) { return x * sigmoidf_(x); }
__device__ __forceinline__ float gelu_tanh_(float x) { const float u = 0.7978845608028654f * (x + 0.044715f * x * x * x); return x * sigmoidf_(2.0f * u); }

namespace pg8 {
constexpr int BM = 256, BK = 64, HALF = 128, HTB = HALF * BK * 2, STAGE_BYTES = 8 * HTB;
__host__ __device__ __forceinline__ int lds_byte(int r, int c) { const int st = (r >> 4) * 2 + (c >> 5), rr = r & 15, cc = c & 31, ob = rr * 64 + cc * 2; return st * 1024 + (ob ^ (((ob >> 9) & 1) << 5)); }
__host__ __device__ __forceinline__ void stage_rc(int b, int& R, int& C) { const int st = b / 1024, sb = b % 1024, swz = sb ^ (((sb >> 9) & 1) << 5); R = (st >> 1) * 16 + swz / 64; C = (st & 1) * 32 + (swz % 64) / 2; }
__host__ __device__ __forceinline__ int perm32(int rho) { const int n = rho >> 4, i = rho & 15; return 8 * (i >> 2) + 4 * n + (i & 3); }

struct Unit { int pm, pn, e, slot; };

template <class Epi, class Sched, bool GATHER>
__device__ __forceinline__ void gemm_phase(LAS unsigned char* lds, const Sched& S, const Epi& E, const int K, const int lda, const int wave) {
    unsigned z0_ = 0u; asm volatile("" : "+v"(z0_)); const int lane_ = (int)__builtin_amdgcn_mbcnt_hi(~0u, __builtin_amdgcn_mbcnt_lo(~0u, z0_));
    const int wid = wave, lane = lane_, tid = wid * 64 + lane, wr = wid >> 2, wc = wid & 3, fr = lane & 15, fq = lane >> 4;
    const int nt = K / BK;
    int Rr[2], Cc[2];
    unsigned voffB[2];
#pragma unroll
    for (int i = 0; i < 2; ++i) { int R, C; stage_rc(tid * 16 + i * 8192, R, C); Rr[i] = R; Cc[i] = C; const int Rb = Epi::PERM ? ((R & ~31) + perm32(R & 31)) : R; voffB[i] = (unsigned)(Rb * K + C) * 2u; }
    const size_t kstep = (size_t)(BK * 2);
    const size_t hstepB = (size_t)HALF * K * 2;
    const unsigned ldsw = (unsigned)wid * 1024u;
    const int aoff = lds_byte(wr * 64 + fr, fq * 8), boff = lds_byte(wc * 32 + fr, fq * 8);
#define PG8_SA(b, h) (((b) * 2 + (h)) * HTB)
#define PG8_SB(b, h) ((4 + (b) * 2 + (h)) * HTB)
#define PG8_STAGE(bufoff, gbase, voff) do { _Pragma("unroll") for (int _i = 0; _i < 2; ++_i) \
        __builtin_amdgcn_global_load_lds((const unsigned*)((const char*)(gbase) + (voff)[_i]), (LAS unsigned*)(lds + (bufoff) + ldsw + _i * 8192), 16, 0, 0); } while (0)
#define PG8_LDA(dst, b, h) do { _Pragma("unroll") for (int m = 0; m < 4; ++m) _Pragma("unroll") for (int k = 0; k < 2; ++k) dst[m][k] = *(const LAS bf16x8*)(lds + PG8_SA(b, h) + aoff + m * 2048 + k * 1024); } while (0)
#define PG8_LDB(dst, b, h) do { _Pragma("unroll") for (int n = 0; n < 2; ++n) _Pragma("unroll") for (int k = 0; k < 2; ++k) dst[n][k] = *(const LAS bf16x8*)(lds + PG8_SB(b, h) + boff + n * 2048 + k * 1024); } while (0)
#define PG8_MMA(ai, bj, At, Bt) do { __builtin_amdgcn_s_setprio(1); _Pragma("unroll") for (int m = 0; m < 4; ++m) _Pragma("unroll") for (int n = 0; n < 2; ++n) _Pragma("unroll") for (int k = 0; k < 2; ++k) \
        acc[ai][bj][m][n] = __builtin_amdgcn_mfma_f32_16x16x32_bf16(Bt[n][k], At[m][k], acc[ai][bj][m][n], 0, 0, 0); __builtin_amdgcn_s_setprio(0); } while (0)
#define PG8_WAIT_V(n) asm volatile("s_waitcnt vmcnt(" #n ")" ::: "memory")
#define PG8_WAIT_L(n) asm volatile("s_waitcnt lgkmcnt(" #n ")" ::: "memory")
#define PG8_BAR do { asm volatile("" ::: "memory"); __builtin_amdgcn_s_barrier(); asm volatile("" ::: "memory"); } while (0)
#define PG8_SCHED __builtin_amdgcn_sched_barrier(0)
    Unit cur, nxt; int ui = 0;
    if (!S.next(0, cur)) return;
    f32x4 acc[2][2][4][2];
#pragma unroll
    for (int a = 0; a < 2; ++a)
#pragma unroll
        for (int b = 0; b < 2; ++b)
#pragma unroll
            for (int m = 0; m < 4; ++m)
#pragma unroll
                for (int n = 0; n < 2; ++n) acc[a][b][m][n] = (f32x4){0.f, 0.f, 0.f, 0.f};
    bf16x8 At[4][2], B0[2][2], B1[2][2];
    unsigned cA0[2], cA1[2], nA0[2], nA1[2];
#pragma unroll
    for (int i = 0; i < 2; ++i) {
        if (GATHER) { cA0[i] = (unsigned)(S.row_of(cur, Rr[i]) * lda + Cc[i]) * 2u; cA1[i] = (unsigned)(S.row_of(cur, HALF + Rr[i]) * lda + Cc[i]) * 2u; }
        else { cA0[i] = (unsigned)(Rr[i] * lda + Cc[i]) * 2u; cA1[i] = (unsigned)((HALF + Rr[i]) * lda + Cc[i]) * 2u; }
        nA0[i] = cA0[i]; nA1[i] = cA1[i];
    }
    const char* cA = S.a_base(cur); const char* cB = S.b_base(cur);
    PG8_STAGE(PG8_SB(0, 0), cB, voffB); PG8_STAGE(PG8_SB(0, 1), cB + hstepB, voffB); PG8_STAGE(PG8_SA(0, 0), cA, cA0); PG8_STAGE(PG8_SA(0, 1), cA, cA1);
    if (wr == 1) PG8_BAR;
    PG8_WAIT_V(2); PG8_BAR;
    PG8_STAGE(PG8_SB(1, 0), cB + kstep, voffB); PG8_STAGE(PG8_SA(1, 0), cA + kstep, cA0); PG8_STAGE(PG8_SB(1, 1), cB + hstepB + kstep, voffB);
    PG8_WAIT_V(6); PG8_BAR;
    for (;;) {
        const bool has_next = S.next(ui + 1, nxt);
        const char* nA = has_next ? S.a_base(nxt) : cA; const char* nB = has_next ? S.b_base(nxt) : cB;
        if (GATHER) {
#pragma unroll
            for (int i = 0; i < 2; ++i) {
                if (has_next) { nA0[i] = (unsigned)(S.row_of(nxt, Rr[i]) * lda + Cc[i]) * 2u; nA1[i] = (unsigned)(S.row_of(nxt, HALF + Rr[i]) * lda + Cc[i]) * 2u; }
                else { nA0[i] = cA0[i]; nA1[i] = cA1[i]; }
            }
        }
#pragma unroll 1
        for (int t = 0; t < nt; t += 2) {
            const bool last = (t == nt - 2);
            const char* a1 = cA + (size_t)(t + 1) * kstep;
            const char* a2 = last ? nA : cA + (size_t)(t + 2) * kstep; const char* b2 = last ? nB : cB + (size_t)(t + 2) * kstep;
            const char* a3 = a2 + kstep; const char* b3 = b2 + kstep;
            unsigned x0[2], x1[2];
#pragma unroll
            for (int i = 0; i < 2; ++i) { x0[i] = (GATHER && last) ? nA0[i] : cA0[i]; x1[i] = (GATHER && last) ? nA1[i] : cA1[i]; }
            PG8_LDB(B0, 0, 0); PG8_LDB(B1, 0, 1); PG8_SCHED; PG8_LDA(At, 0, 0); PG8_STAGE(PG8_SA(1, 1), a1, cA1);
            PG8_WAIT_V(8); PG8_WAIT_L(0); PG8_BAR; PG8_MMA(0, 0, At, B0); PG8_MMA(0, 1, At, B1); PG8_BAR; PG8_SCHED;
            PG8_LDA(At, 0, 1); PG8_STAGE(PG8_SB(0, 0), b2, voffB); PG8_STAGE(PG8_SB(0, 1), b2 + hstepB, voffB); PG8_STAGE(PG8_SA(0, 0), a2, x0);
            PG8_WAIT_V(8); PG8_WAIT_L(0); PG8_BAR; PG8_MMA(1, 0, At, B0); PG8_MMA(1, 1, At, B1); PG8_BAR; PG8_SCHED;
            PG8_LDB(B0, 1, 0); PG8_LDB(B1, 1, 1); PG8_SCHED; PG8_LDA(At, 1, 0); PG8_STAGE(PG8_SA(0, 1), a2, x1);
            PG8_WAIT_V(8); PG8_WAIT_L(0); PG8_BAR; PG8_MMA(0, 0, At, B0); PG8_MMA(0, 1, At, B1); PG8_BAR; PG8_SCHED;
            PG8_LDA(At, 1, 1); PG8_STAGE(PG8_SB(1, 0), b3, voffB); PG8_STAGE(PG8_SB(1, 1), b3 + hstepB, voffB); PG8_STAGE(PG8_SA(1, 0), a3, x0);
            PG8_WAIT_V(8); PG8_WAIT_L(0); PG8_BAR; PG8_MMA(1, 0, At, B0); PG8_MMA(1, 1, At, B1); PG8_BAR; PG8_SCHED;
        }
        if (wr == 0) PG8_BAR;
        E(acc, cur, wr, wc, fr, fq);
        if (!has_next) break;
#pragma unroll
        for (int a = 0; a < 2; ++a)
#pragma unroll
            for (int b = 0; b < 2; ++b)
#pragma unroll
                for (int m = 0; m < 4; ++m)
#pragma unroll
                    for (int n = 0; n < 2; ++n) acc[a][b][m][n] = (f32x4){0.f, 0.f, 0.f, 0.f};
        cur = nxt; cA = nA; cB = nB; ++ui;
#pragma unroll
        for (int i = 0; i < 2; ++i) { cA0[i] = nA0[i]; cA1[i] = nA1[i]; }
        if (wr == 1) PG8_BAR;
    }
    PG8_WAIT_V(0);
    PG8_BAR;
#undef PG8_SA
#undef PG8_SB
#undef PG8_STAGE
#undef PG8_LDA
#undef PG8_LDB
#undef PG8_MMA
#undef PG8_WAIT_V
#undef PG8_WAIT_L
#undef PG8_BAR
#undef PG8_SCHED
}
}

#define XB_TMO      128
#define XB_XCNT(j)  (256  + 64 * (j))
#define XB_XSUB(j)  (1280 + 64 * (j))
#define XB_XGEN(j)  (2304 + 64 * (j))
#define XB_TOP      3328
#define XB_TOPGEN   3392
#define XCD_BAR_WORDS 3456
#define XB_SPIN_CAP (1u << 20)

__device__ __forceinline__ unsigned xb_ld(unsigned* p)              { return __hip_atomic_load(p, __ATOMIC_RELAXED, __HIP_MEMORY_SCOPE_AGENT); }
__device__ __forceinline__ unsigned xb_add(unsigned* p, unsigned v) { return __hip_atomic_fetch_add(p, v, __ATOMIC_RELAXED, __HIP_MEMORY_SCOPE_AGENT); }
__device__ __forceinline__ unsigned xb_xcc_id() { return (unsigned)__builtin_amdgcn_s_getreg((3 << 11) | 20) & 0xFu; }
#define XB_SPIN(cond, bar) do { unsigned _sp = 0; while (cond) { __builtin_amdgcn_s_sleep(1); \
    if ((++_sp & 255u) == 0u) { if (xb_ld(&(bar)[XB_TMO])) break; if (_sp > XB_SPIN_CAP) { atomicAdd(&(bar)[XB_TMO], 1u); break; } } } } while (0)

struct XcdBarrier { unsigned* bar; unsigned x; volatile LAS unsigned* st; };

__device__ __forceinline__ XcdBarrier xcd_barrier_post(unsigned* bar, volatile LAS unsigned* st) {
    XcdBarrier b; b.bar = bar; b.x = xb_xcc_id(); b.st = st;
    if (threadIdx.x == 0) (void)xb_add(&bar[XB_XCNT(b.x)], 1u);
    return b;
}
__device__ __forceinline__ void xcd_barrier_complete(unsigned* bar, unsigned x, unsigned& nloc, unsigned& nx) {
    const unsigned G = gridDim.x * gridDim.y * gridDim.z;
    unsigned sum, cnt, mine, sp = 0u;
    for (;;) {
        sum = 0u; cnt = 0u; mine = 0u;
#pragma unroll
        for (unsigned j = 0; j < 16; ++j) { const unsigned c = xb_ld(&bar[XB_XCNT(j)]); sum += c; cnt += (c > 0u) ? 1u : 0u; mine = (j == x) ? c : mine; }
        if (sum == G) break;
        __builtin_amdgcn_s_sleep(1);
        if ((++sp & 255u) == 0u) { if (xb_ld(&bar[XB_TMO])) break; if (sp > XB_SPIN_CAP) { atomicAdd(&bar[XB_TMO], 1u); break; } }
    }
    nloc = mine > 0u ? mine : 1u; nx = cnt > 0u ? cnt : 1u;
}
__device__ __forceinline__ void xcd_barrier(const XcdBarrier& b) {
    asm volatile("s_waitcnt vmcnt(0)" ::: "memory");
    __syncthreads();
    if (threadIdx.x == 0) {
        unsigned* bar = b.bar;
        __builtin_amdgcn_s_waitcnt(0);
        unsigned nloc = b.st[0], nx = b.st[1];
        if (nloc == 0u) { xcd_barrier_complete(bar, b.x, nloc, nx); b.st[0] = nloc; b.st[1] = nx; }
        const unsigned old = xb_add(&bar[XB_XSUB(b.x)], 1u);
        const unsigned gen = old / nloc;
        if (old + 1u == (gen + 1u) * nloc) {
            __builtin_amdgcn_fence(__ATOMIC_RELEASE, "agent");
            asm volatile("s_waitcnt vmcnt(0)" ::: "memory");
            const unsigned og = xb_add(&bar[XB_TOP], 1u);
            const unsigned tg = og / nx;
            if (og + 1u == (tg + 1u) * nx) xb_add(&bar[XB_TOPGEN], 1u);
            else XB_SPIN(xb_ld(&bar[XB_TOPGEN]) == tg, bar);
            __builtin_amdgcn_fence(__ATOMIC_ACQUIRE, "agent");
            xb_add(&bar[XB_XGEN(b.x)], 1u);
            asm volatile("s_waitcnt vmcnt(0)" ::: "memory");
        } else {
            XB_SPIN(xb_ld(&bar[XB_XGEN(b.x)]) == gen, bar);
            __builtin_amdgcn_fence(__ATOMIC_ACQUIRE, "agent");
            asm volatile("s_waitcnt vmcnt(0)" ::: "memory");
        }
    }
    __syncthreads();
}

constexpr size_t MiB = 1u << 20;
constexpr size_t WS_CTL = 0, CTL_ZERO_BYTES = 1 * MiB;
constexpr size_t WS_ROPE = 1 * MiB;
constexpr size_t WS_WI   = 3 * MiB;
constexpr size_t WS_ROUTE = 3 * MiB + 512 * 1024;
constexpr size_t WS_SROW = 4 * MiB;
constexpr size_t WS_ROWMAP = 4 * MiB + 256 * 1024;
constexpr size_t WS_CWROW = 4 * MiB + 640 * 1024;
constexpr size_t WS_CNTWG = 5 * MiB;
constexpr size_t WS_META = 5 * MiB + 64 * 1024;
constexpr size_t WS_WR = 5 * MiB + 128 * 1024;
constexpr size_t WS_GLR = 6 * MiB;
constexpr size_t WS_WDENSE = 8 * MiB;
constexpr size_t WD_WA = 0, WD_WG = 7 * MiB, WD_WBR = 13 * MiB, WD_WOUT = 16 * MiB, WD_LAYER = 18 * MiB;
constexpr size_t WS_WMOE = 44 * MiB;
constexpr size_t WM_GU = 0, WM_DN = 32 * MiB;
constexpr size_t WS_HB = 92 * MiB;
constexpr size_t WS_PA = 156 * MiB;
constexpr size_t WS_HID = WS_PA;
constexpr size_t WS_FF2 = WS_PA + 40 * MiB;
constexpr size_t WS_Y = 380 * MiB;
constexpr size_t WS_KA = 476 * MiB, WS_VA = 480 * MiB, WS_KI = 484 * MiB;
constexpr size_t WS_END = 512 * MiB;
static_assert(WS_WDENSE + 2 * WD_LAYER <= WS_WMOE && WS_WMOE + 48 * MiB <= WS_HB && WS_HB + 64 * MiB <= WS_PA && WS_PA + 224 * MiB <= WS_Y && WS_Y + 96 * MiB <= WS_KA && WS_KI + 4 * MiB <= WS_END, "ws map");
static_assert(WS_FF2 + (size_t)73728 * 1024 * 2 <= WS_Y, "ff2 fits");
constexpr int CW_BAR = 4096;
constexpr int CW_QUEUE = 16384;

constexpr int RING_BYTES = 131072;
constexpr int AUX_OFF = 131072;
constexpr int MISC_OFF = 147456;
constexpr int LDS_BYTES = 148480;

struct Frame {
    LAS unsigned char* lds;
    volatile LAS unsigned* MISC;
    gu32* ctl;
    int tid, lane, wave, G, wg;
    const float* const* in;
    const GAS int* pos;
    GAS float* H;
    GAS unsigned char* ws;
};

#define LDS_WAIT() asm volatile("s_waitcnt lgkmcnt(0)" ::: "memory")
#define VM_WAIT() asm volatile("s_waitcnt vmcnt(0)" ::: "memory")

__device__ __forceinline__ int pa_src_col(int c) {
    if (c < 512) return c;
    if (c < 768) { const int x = c - 512, half = x >> 7, y = x & 127, grp = y >> 5, d = (y & 31) + 32 * half;
        if (grp == 0) return 512 + d;
        if (grp == 1) return 576 + d;
        if (grp == 2) return 896 + d;
        if (half == 0) { const int z = y - 96; if (z < 4) return 960 + z; if (z < 20) return 1988 + (z - 4); }
        return -1; }
    if (c < 1024) return 640 + (c - 768);
    if (c < 1280) return 964 + (c - 1024);
    if (c < 1536) return 1220 + (c - 1280);
    if (c < 2048) return 1476 + (c - 1536);
    if (c < 2560) return 2004 + (c - 2048);
    return 2516 + (c - 2560);
}
__device__ __forceinline__ void transpose_item(const GAS float* W, int ldw, int K, GAS bf16* WT, int n0, int k0, int sc, LAS float* scr, int lane) {
#pragma unroll 8
    for (int i = 0; i < 32; ++i) { const int kk = 2 * i + (lane >> 5); scr[kk * 33 + (lane & 31)] = (sc >= 0) ? W[(size_t)(k0 + kk) * ldw + sc] : 0.f; }
    LDS_WAIT(); asm volatile("" ::: "memory");
    const int c = lane & 7;
#pragma unroll
    for (int j = 0; j < 4; ++j) { const int n = (lane >> 3) + 8 * j; const LAS float* s = scr + (8 * c) * 33 + n;
        u32x4 o; o.x = pk2(s[0 * 33], s[1 * 33]); o.y = pk2(s[2 * 33], s[3 * 33]); o.z = pk2(s[4 * 33], s[5 * 33]); o.w = pk2(s[6 * 33], s[7 * 33]);
        *(GAS u32x4*)(WT + (size_t)(n0 + n) * K + k0 + 8 * c) = o; }
    LDS_WAIT(); asm volatile("" ::: "memory");
}
__device__ __forceinline__ void conv_dense_item(Frame& F, int l, int it, LAS float* scr) {
    GAS bf16* base = (GAS bf16*)(F.ws + WS_WDENSE + (size_t)l * WD_LAYER);
    const int lane = F.lane;
    if (it < 1792) { const int kb = it / 112, nb = it % 112; const int sc = pa_src_col(32 * nb + (lane & 31));
        transpose_item(((const GAS float*)F.in[4]) + (size_t)l * DM * NIN, NIN, DM, base + WD_WA / 2, 32 * nb, 64 * kb, sc, scr, lane); return; }
    it -= 1792;
    if (it < 1536) { const int kb = it / 96, nb = it % 96; const int sc = 3540 + 32 * nb + (lane & 31);
        transpose_item(((const GAS float*)F.in[4]) + (size_t)l * DM * NIN, NIN, DM, base + WD_WG / 2, 32 * nb, 64 * kb, sc, scr, lane); return; }
    it -= 1536;
    if (it < 768) { const int br = it / 256, r = it % 256, kb = r / 32, nb = r % 32; const int sc = 32 * nb + (lane & 31);
        transpose_item((br == 0 ? ((const GAS float*)F.in[13]) : br == 1 ? ((const GAS float*)F.in[14]) : ((const GAS float*)F.in[15])) + (size_t)l * 512 * DM, DM, 512, base + WD_WBR / 2 + (size_t)br * 1024 * 512, 32 * nb, 64 * kb, sc, scr, lane); return; }
    it -= 768;
    { const int kb = it / 32, nb = it % 32; const int sc = 32 * nb + (lane & 31);
        transpose_item(((const GAS float*)F.in[16]) + (size_t)l * DM * DM, DM, DM, base + WD_WOUT / 2, 32 * nb, 64 * kb, sc, scr, lane); }
}
__device__ __forceinline__ void conv_moe_item(Frame& F, int l, int it, LAS float* scr) {
    const int lane = F.lane; const int e = it / 384; int r = it % 384;
    if (r < 256) { const int sub = r / 64, q = r % 64, ct = sub >> 1, bj = sub & 1, kb = q / 4, nb = q % 4;
        const GAS float* src = (bj ? ((const GAS float*)F.in[24]) : ((const GAS float*)F.in[23])) + (size_t)(l * NEXP + e) * DM * DEXP;
        GAS bf16* dst = (GAS bf16*)(F.ws + WS_WMOE + WM_GU) + (size_t)e * 512 * DM;
        transpose_item(src, DEXP, DM, dst, 256 * ct + 128 * bj + 32 * nb, 64 * kb, 128 * ct + 32 * nb + (lane & 31), scr, lane); return; }
    r -= 256;
    { const int kb = r / 32, nb = r % 32;
        const GAS float* src = ((const GAS float*)F.in[25]) + (size_t)(l * NEXP + e) * DEXP * DM;
        GAS bf16* dst = (GAS bf16*)(F.ws + WS_WMOE + WM_DN) + (size_t)e * DM * DEXP;
        transpose_item(src, DM, DEXP, dst, 32 * nb, 64 * kb, 32 * nb + (lane & 31), scr, lane); }
}

__device__ __forceinline__ void ln_row_regs(f32x4 (&v)[4], const GAS float* g, const GAS float* b, int lane) {
    float s = 0.f;
#pragma unroll
    for (int j = 0; j < 4; ++j) s += (v[j].x + v[j].y) + (v[j].z + v[j].w);
    const float mean = wave_sum(s, lane) * (1.f / DM); float s2 = 0.f;
#pragma unroll
    for (int j = 0; j < 4; ++j) { v[j] = v[j] - mean; s2 += (v[j].x * v[j].x + v[j].y * v[j].y) + (v[j].z * v[j].z + v[j].w * v[j].w); }
    const float rstd = 1.f / sqrtf(wave_sum(s2, lane) * (1.f / DM) + LN_EPS);
#pragma unroll
    for (int j = 0; j < 4; ++j) { const f32x4 gg = *(const GAS f32x4*)(g + 4 * lane + 256 * j), bb = *(const GAS f32x4*)(b + 4 * lane + 256 * j); v[j] = v[j] * rstd * gg + bb; }
}
__device__ __forceinline__ void store_row_f32_bf16(const f32x4 (&v)[4], GAS float* hrow, GAS bf16* brow, int lane) {
#pragma unroll
    for (int j = 0; j < 4; ++j) {
        if (hrow) *(GAS f32x4*)(hrow + 4 * lane + 256 * j) = v[j];
        if (brow) { u32x2 w; w.x = pk2(v[j].x, v[j].y); w.y = pk2(v[j].z, v[j].w); *(GAS u32x2*)(brow + 4 * lane + 256 * j) = w; }
    }
}

__device__ __forceinline__ void phase_prologue(Frame& F) {
    LAS float* scr = (LAS float*)(F.lds + F.wave * 16384);
    const int gw = F.wg * 8 + F.wave, NGW = F.G * 8;
    for (int it = gw; it < 2 * 4608; it += NGW) conv_dense_item(F, it / 4608, it % 4608, scr);
    { GAS float* WR = (GAS float*)(F.ws + WS_WR);
      for (int i = gw * 64 + F.lane; i < DEPTH * 36 * DM; i += NGW * 64) { const int l = i / (36 * DM), r = i % (36 * DM), o = r / DM, k = r % DM;
          WR[i] = (o < 4) ? ((const GAS float*)F.in[19])[(size_t)l * DM * 4 + k * 4 + o] : ((const GAS float*)F.in[21])[(size_t)l * DM * 32 + k * 32 + (o - 4)]; } }
    { GAS float* RT = (GAS float*)(F.ws + WS_ROPE);
      for (int i = gw * 64 + F.lane; i < NTOK * 8; i += NGW * 64) { const int n = i >> 3, j = i & 7;
          const float invf[8] = {1.000000000e+00f, 1.939227432e-01f, 3.760603070e-02f, 7.292664610e-03f, 1.414213562e-03f, 2.742481884e-04f, 5.318295734e-05f, 1.031338525e-05f};
          float inv = invf[0];
#pragma unroll
          for (int q = 1; q < 8; ++q) inv = (j == q) ? invf[q] : inv;
          const float ang = (float)F.pos[n] * inv;
          const double kq = __builtin_rint((double)ang * 0.15915494309189535);
          double r = (double)ang - kq * 6.283185307179586; double csign = 1.0;
          if (r > 1.5707963267948966) { r = 3.141592653589793 - r; csign = -1.0; } else if (r < -1.5707963267948966) { r = -3.141592653589793 - r; csign = -1.0; }
          const double x2 = r * r;
          const double sn = r * (1.0 + x2 * (-1.0 / 6 + x2 * (1.0 / 120 + x2 * (-1.0 / 5040 + x2 * (1.0 / 362880 + x2 * (-1.0 / 39916800 + x2 * (1.0 / 6227020800.0 + x2 * (-1.0 / 1307674368000.0))))))));
          const double cs = 1.0 + x2 * (-0.5 + x2 * (1.0 / 24 + x2 * (-1.0 / 720 + x2 * (1.0 / 40320 + x2 * (-1.0 / 3628800 + x2 * (1.0 / 479001600.0 + x2 * (-1.0 / 87178291200.0 + x2 * (1.0 / 20922789888000.0))))))));
          RT[n * 16 + j] = (float)(csign * cs); RT[n * 16 + 8 + j] = (float)sn; } }
    GAS bf16* HB = (GAS bf16*)(F.ws + WS_HB);
    for (int m = gw; m < NTOK; m += NGW) { f32x4 v[4];
#pragma unroll
        for (int j = 0; j < 4; ++j) v[j] = *(const GAS f32x4*)(((const GAS float*)F.in[0]) + (size_t)m * DM + 4 * F.lane + 256 * j);
        ln_row_regs(v, ((const GAS float*)F.in[2]), ((const GAS float*)F.in[3]), F.lane);
        store_row_f32_bf16(v, F.H + (size_t)m * DM, HB + (size_t)m * DM, F.lane); }
}

struct DenseSched {
    int nM, nN, nwg, G, c; const char* A; const char* B; size_t atile, btile;
    __device__ void init(int nM_, int nN_, int G_, int c_, const void* A_, size_t atile_, const void* B_, size_t btile_) { nM = nM_; nN = nN_; nwg = nM * nN; G = G_; c = c_; A = (const char*)A_; B = (const char*)B_; atile = atile_; btile = btile_; }
    __device__ __forceinline__ bool next(int i, pg8::Unit& u) const {
        const long L = (long)i * G + c; if (L >= nwg) return false;
        int wgid = (int)L; { const int q = nwg / 8, r = nwg % 8, xcd = wgid % 8, off = wgid / 8; wgid = (xcd < r ? xcd * (q + 1) : r * (q + 1) + (xcd - r) * q) + off; }
        const int nig = 8 * nN, gid = wgid / nig, fm = gid * 8, gsz = (nM - fm) < 8 ? (nM - fm) : 8;
        u.pm = fm + ((wgid % nig) % gsz); u.pn = (wgid % nig) / gsz; u.e = 0; u.slot = i; return true;
    }
    __device__ __forceinline__ const char* a_base(const pg8::Unit& u) const { return A + (size_t)u.pm * atile; }
    __device__ __forceinline__ const char* b_base(const pg8::Unit& u) const { return B + (size_t)u.pn * btile; }
    __device__ __forceinline__ int row_of(const pg8::Unit&, int) const { return 0; }
};
struct GroupSched {
    int NU, G, c, ncol; const char* A; const char* B; size_t atile, erows_bytes, btile; const LAS int* meta; const LAS int* rows;
    __device__ __forceinline__ bool next(int i, pg8::Unit& u) const {
        const int L = i * G + c; if (L >= NU) return false;
        u.pm = L / ncol; u.pn = L % ncol; u.slot = i; u.e = meta[i]; return true;
    }
    __device__ __forceinline__ const char* a_base(const pg8::Unit& u) const { return A + (size_t)u.pm * atile; }
    __device__ __forceinline__ const char* b_base(const pg8::Unit& u) const { return B + (size_t)u.e * erows_bytes + (size_t)u.pn * btile; }
    __device__ __forceinline__ int row_of(const pg8::Unit& u, int r) const { return rows[u.slot * 256 + r]; }
};

struct EpiA {
    static constexpr bool PERM = true;
    GAS bf16* PA; GAS bf16* KA; GAS bf16* VA; GAS bf16* KI; GAS float* WI; GAS float* GLR; const GAS float* ROPE; const GAS float* ikg;
    __device__ __forceinline__ static void rope8(float (&x)[8], const GAS float* rt, int fq, int lane) {
        const f32x4 c0 = *(const GAS f32x4*)(rt), c1 = *(const GAS f32x4*)(rt + 4), s0 = *(const GAS f32x4*)(rt + 8), s1 = *(const GAS f32x4*)(rt + 12);
#pragma unroll
        for (int i = 0; i < 8; ++i) { const float p = shx(x[i], 16, lane); const float cc = (i < 4) ? c0[i & 3] : c1[i & 3], ss = (i < 4) ? s0[i & 3] : s1[i & 3];
            const float r = x[i] * cc + ((fq == 0) ? -p : p) * ss; x[i] = (fq < 2) ? r : x[i]; }
    }
    __device__ __forceinline__ static u32x4 pack8(const float (&x)[8]) { u32x4 w; w.x = cvt_pk_bf16(x[0], x[1]); w.y = cvt_pk_bf16(x[2], x[3]); w.z = cvt_pk_bf16(x[4], x[5]); w.w = cvt_pk_bf16(x[6], x[7]); return w; }
    __device__ __forceinline__ void operator()(const f32x4 (&acc)[2][2][4][2], const pg8::Unit& u, int wr, int wc, int fr, int fq) const {
        const int pn = u.pn; const int rowb = u.pm * 256 + wr * 64 + fr; const int lane = fq * 16 + fr;
        if (pn == 2) {
#pragma unroll
            for (int ai = 0; ai < 2; ++ai)
#pragma unroll
                for (int m = 0; m < 4; ++m) {
                    const int row = rowb + ai * 128 + m * 16;
                    float x0[8], x1[8];
#pragma unroll
                    for (int i = 0; i < 8; ++i) { x0[i] = acc[ai][0][m][i >> 2][i & 3]; x1[i] = acc[ai][1][m][i >> 2][i & 3]; }
                    if (wc == 2) {
                        float s = 0.f;
#pragma unroll
                        for (int i = 0; i < 8; ++i) s += x0[i] + x1[i];
                        s += shx(s, 16, lane); s += shx(s, 32, lane);
                        const float mean = s * (1.f / 64.f); float q = 0.f;
#pragma unroll
                        for (int i = 0; i < 8; ++i) { x0[i] -= mean; x1[i] -= mean; q += x0[i] * x0[i] + x1[i] * x1[i]; }
                        q += shx(q, 16, lane); q += shx(q, 32, lane);
                        const float rstd = 1.f / sqrtf(q * (1.f / 64.f) + LN_EPS);
#pragma unroll
                        for (int i = 0; i < 8; ++i) { x0[i] = x0[i] * rstd * ikg[8 * fq + i]; x1[i] = x1[i] * rstd * ikg[32 + 8 * fq + i]; }
                    }
                    if (wc == 0 || wc == 2) rope8(x0, ROPE + (size_t)row * 16, fq, lane);
                    if (wc < 3) {
                        GAS bf16* dst = (wc == 0) ? KA : (wc == 1) ? VA : KI;
                        *(GAS u32x4*)(dst + (size_t)row * 64 + 8 * fq) = pack8(x0); *(GAS u32x4*)(dst + (size_t)row * 64 + 32 + 8 * fq) = pack8(x1);
                    } else {
                        if (fq == 0) { *(GAS f32x4*)(WI + (size_t)row * 4) = (f32x4){x0[0], x0[1], x0[2], x0[3]} * 0.0625f; *(GAS f32x4*)(GLR + (size_t)row * 16) = (f32x4){x0[4], x0[5], x0[6], x0[7]}; }
                        else if (fq == 1) { *(GAS f32x4*)(GLR + (size_t)row * 16 + 4) = (f32x4){x0[0], x0[1], x0[2], x0[3]}; *(GAS f32x4*)(GLR + (size_t)row * 16 + 8) = (f32x4){x0[4], x0[5], x0[6], x0[7]}; }
                        else if (fq == 2) { *(GAS f32x4*)(GLR + (size_t)row * 16 + 12) = (f32x4){x0[0], x0[1], x0[2], x0[3]}; }
                    }
                    asm volatile("" ::: "memory");
                }
        } else if (pn < 2 || pn == 3) {
            const float sc = (pn == 3) ? 1.0f : 0.125f; const bool rope = !(wc & 1);
#pragma unroll
            for (int ai = 0; ai < 2; ++ai)
#pragma unroll
                for (int m = 0; m < 4; ++m) {
                    const int row = rowb + ai * 128 + m * 16;
#pragma unroll
                    for (int bj = 0; bj < 2; ++bj) { float x[8];
#pragma unroll
                        for (int i = 0; i < 8; ++i) x[i] = acc[ai][bj][m][i >> 2][i & 3];
                        if (rope) rope8(x, ROPE + (size_t)row * 16, fq, lane);
#pragma unroll
                        for (int i = 0; i < 8; ++i) x[i] *= sc;
                        *(GAS u32x4*)(PA + (size_t)row * NPA + 256 * pn + 128 * bj + 32 * wc + 8 * fq) = pack8(x); }
                    asm volatile("" ::: "memory");
                }
        } else {
            const int act = (pn == 8 || pn == 9) ? 1 : (pn >= 10) ? 2 : 0; const float sc = (pn == 4) ? 0.125f : 1.0f;
#pragma unroll
            for (int ai = 0; ai < 2; ++ai)
#pragma unroll
                for (int m = 0; m < 4; ++m) {
                    const int row = rowb + ai * 128 + m * 16;
#pragma unroll
                    for (int bj = 0; bj < 2; ++bj) { float x[8];
#pragma unroll
                        for (int i = 0; i < 8; ++i) { const float v = acc[ai][bj][m][i >> 2][i & 3]; x[i] = (act == 1) ? siluf_(v) : (act == 2) ? gelu_tanh_(v) : v * sc; }
                        *(GAS u32x4*)(PA + (size_t)row * NPA + 256 * pn + 128 * bj + 32 * wc + 8 * fq) = pack8(x); }
                    asm volatile("" ::: "memory");
                }
        }
    }
};
struct EpiG {
    static constexpr bool PERM = true;
    GAS bf16* G;
    __device__ __forceinline__ void operator()(const f32x4 (&acc)[2][2][4][2], const pg8::Unit& u, int wr, int wc, int fr, int fq) const {
        const int rowb = u.pm * 256 + wr * 64 + fr;
#pragma unroll
        for (int ai = 0; ai < 2; ++ai)
#pragma unroll
            for (int m = 0; m < 4; ++m) { const int row = rowb + ai * 128 + m * 16;
#pragma unroll
                for (int bj = 0; bj < 2; ++bj) { float x[8];
#pragma unroll
                    for (int i = 0; i < 8; ++i) x[i] = sigmoidf_(acc[ai][bj][m][i >> 2][i & 3]);
                    u32x4 w; w.x = cvt_pk_bf16(x[0], x[1]); w.y = cvt_pk_bf16(x[2], x[3]); w.z = cvt_pk_bf16(x[4], x[5]); w.w = cvt_pk_bf16(x[6], x[7]);
                    *(GAS u32x4*)(G + (size_t)row * NGT + 256 * u.pn + 128 * bj + 32 * wc + 8 * fq) = w; }
#ifdef EPIG_DRAIN
                asm volatile("s_waitcnt vmcnt(0)" ::: "memory");
#endif
            }
    }
};
struct EpiM {
    static constexpr bool PERM = true;
    const GAS bf16* G; GAS bf16* HM; int br;
    __device__ __forceinline__ void operator()(const f32x4 (&acc)[2][2][4][2], const pg8::Unit& u, int wr, int wc, int fr, int fq) const {
        const int rowb = u.pm * 256 + wr * 64 + fr;
#pragma unroll
        for (int ai = 0; ai < 2; ++ai)
#pragma unroll
            for (int m = 0; m < 4; ++m) { const int row = rowb + ai * 128 + m * 16;
#pragma unroll
                for (int bj = 0; bj < 2; ++bj) { const int col = 256 * u.pn + 128 * bj + 32 * wc + 8 * fq;
                    const u32x4 g = *(const GAS u32x4*)(G + (size_t)row * NGT + 1024 * br + col);
                    float x[8];
                    x[0] = bflo(g.x) * acc[ai][bj][m][0][0]; x[1] = bfhi(g.x) * acc[ai][bj][m][0][1]; x[2] = bflo(g.y) * acc[ai][bj][m][0][2]; x[3] = bfhi(g.y) * acc[ai][bj][m][0][3];
                    x[4] = bflo(g.z) * acc[ai][bj][m][1][0]; x[5] = bfhi(g.z) * acc[ai][bj][m][1][1]; x[6] = bflo(g.w) * acc[ai][bj][m][1][2]; x[7] = bfhi(g.w) * acc[ai][bj][m][1][3];
                    if (br > 0) { const u32x4 o = *(const GAS u32x4*)(HM + (size_t)row * DM + col);
                        x[0] += bflo(o.x); x[1] += bfhi(o.x); x[2] += bflo(o.y); x[3] += bfhi(o.y); x[4] += bflo(o.z); x[5] += bfhi(o.z); x[6] += bflo(o.w); x[7] += bfhi(o.w); }
                    u32x4 w; w.x = cvt_pk_bf16(x[0], x[1]); w.y = cvt_pk_bf16(x[2], x[3]); w.z = cvt_pk_bf16(x[4], x[5]); w.w = cvt_pk_bf16(x[6], x[7]);
                    *(GAS u32x4*)(HM + (size_t)row * DM + col) = w; }
                asm volatile("" ::: "memory"); }
    }
};
struct EpiO {
    static constexpr bool PERM = false;
    GAS float* H;
    __device__ __forceinline__ void operator()(const f32x4 (&acc)[2][2][4][2], const pg8::Unit& u, int wr, int wc, int fr, int fq) const {
        const int rowb = u.pm * 256 + wr * 64 + fr, col0 = u.pn * 256 + wc * 32 + 4 * fq;
#pragma unroll
        for (int ai = 0; ai < 2; ++ai)
#pragma unroll
            for (int m = 0; m < 4; ++m) { GAS float* rp = H + (size_t)(rowb + ai * 128 + m * 16) * DM + col0;
#pragma unroll
                for (int bj = 0; bj < 2; ++bj)
#pragma unroll
                    for (int n = 0; n < 2; ++n) { const f32x4 h = *(const GAS f32x4*)(rp + bj * 128 + n * 16); *(GAS f32x4*)(rp + bj * 128 + n * 16) = h * DN_ALPHA + acc[ai][bj][m][n]; }
                asm volatile("" ::: "memory"); }
    }
};
struct EpiGU {
    static constexpr bool PERM = true;
    GAS bf16* HID; const GAS float* CW;
    __device__ __forceinline__ void operator()(const f32x4 (&acc)[2][2][4][2], const pg8::Unit& u, int wr, int wc, int fr, int fq) const {
        const int rowb = u.pm * 256 + wr * 64 + fr;
#pragma unroll
        for (int ai = 0; ai < 2; ++ai)
#pragma unroll
            for (int m = 0; m < 4; ++m) { const int row = rowb + ai * 128 + m * 16; const float cw = CW[row];
                float x[8];
#pragma unroll
                for (int i = 0; i < 8; ++i) x[i] = siluf_(acc[ai][0][m][i >> 2][i & 3]) * acc[ai][1][m][i >> 2][i & 3] * cw;
                u32x4 w; w.x = cvt_pk_bf16(x[0], x[1]); w.y = cvt_pk_bf16(x[2], x[3]); w.z = cvt_pk_bf16(x[4], x[5]); w.w = cvt_pk_bf16(x[6], x[7]);
                *(GAS u32x4*)(HID + (size_t)row * DEXP + 128 * u.pn + 32 * wc + 8 * fq) = w; }
    }
};
struct EpiDN {
    static constexpr bool PERM = true;
    GAS bf16* FF2;
    __device__ __forceinline__ void operator()(const f32x4 (&acc)[2][2][4][2], const pg8::Unit& u, int wr, int wc, int fr, int fq) const {
        const int rowb = u.pm * 256 + wr * 64 + fr;
#pragma unroll
        for (int ai = 0; ai < 2; ++ai)
#pragma unroll
            for (int m = 0; m < 4; ++m) { const int row = rowb + ai * 128 + m * 16;
#pragma unroll
                for (int bj = 0; bj < 2; ++bj) { u32x4 w; w.x = cvt_pk_bf16(acc[ai][bj][m][0][0], acc[ai][bj][m][0][1]); w.y = cvt_pk_bf16(acc[ai][bj][m][0][2], acc[ai][bj][m][0][3]);
                    w.z = cvt_pk_bf16(acc[ai][bj][m][1][0], acc[ai][bj][m][1][1]); w.w = cvt_pk_bf16(acc[ai][bj][m][1][2], acc[ai][bj][m][1][3]);
                    *(GAS u32x4*)(FF2 + (size_t)row * DM + 256 * u.pn + 128 * bj + 32 * wc + 8 * fq) = w; } }
    }
};
#ifndef EN_B1
#define EN_B1 1
#endif
#ifndef EN_B2
#define EN_B2 1
#endif
#ifndef EN_B3
#define EN_B3 1
#endif

__device__ __forceinline__ void gmlp_unit(Frame& F, int l, int unit) {
    int tid = F.tid; asm volatile("" : "+v"(tid)); const int lane = tid & 63;
    const int chunk = unit >> 2, g = unit & 3, n0 = chunk * 128;
    const GAS bf16* PA = (const GAS bf16*)(F.ws + WS_PA); GAS bf16* Y = (GAS bf16*)(F.ws + WS_Y);
    LAS float* vln = (LAS float*)F.lds;
    LAS float* wl = (LAS float*)(F.lds + 65536);
    LAS float* st = (LAS float*)(F.lds + AUX_OFF);
    const GAS float* lng = ((const GAS float*)F.in[9]) + l * 512; const GAS float* lnb = ((const GAS float*)F.in[10]) + l * 512;
    for (int j = 0; j < 16; ++j) { const int s = F.wave * 16 + j;
        const u32x4 w = *(const GAS u32x4*)(PA + (size_t)(n0 + s) * NPA + PA_CV + 8 * lane);
        float x[8] = {bflo(w.x), bfhi(w.x), bflo(w.y), bfhi(w.y), bflo(w.z), bfhi(w.z), bflo(w.w), bfhi(w.w)};
        float sm = 0.f;
#pragma unroll
        for (int i = 0; i < 8; ++i) sm += x[i];
        const float mean = wave_sum(sm, lane) * (1.f / 512.f); float q = 0.f;
#pragma unroll
        for (int i = 0; i < 8; ++i) { const float d = x[i] - mean; q += d * d; }
        const float rstd = 1.f / sqrtf(wave_sum(q, lane) * (1.f / 512.f) + LN_EPS);
        if (lane == 0) { st[2 * s] = mean; st[2 * s + 1] = rstd; } }
    __syncthreads();
#pragma unroll
    for (int i = 0; i < 4; ++i) { const int q = tid + 512 * i, s = q >> 4, d0 = (q & 15) * 8;
        const u32x4 w = *(const GAS u32x4*)(PA + (size_t)(n0 + s) * NPA + PA_CV + g * 128 + d0);
        const float mean = st[2 * s], rstd = st[2 * s + 1];
        float x[8] = {bflo(w.x), bfhi(w.x), bflo(w.y), bfhi(w.y), bflo(w.z), bfhi(w.z), bflo(w.w), bfhi(w.w)};
#pragma unroll
        for (int k = 0; k < 8; ++k) x[k] = (x[k] - mean) * rstd * lng[g * 128 + d0 + k] + lnb[g * 128 + d0 + k];
        *(LAS f32x4*)(vln + s * 128 + d0) = (f32x4){x[0], x[1], x[2], x[3]}; *(LAS f32x4*)(vln + s * 128 + d0 + 4) = (f32x4){x[4], x[5], x[6], x[7]}; }
    const GAS float* ws = ((const GAS float*)F.in[11]) + ((size_t)l * 4 + g) * 128 * 128;
#pragma unroll
    for (int i = 0; i < 8; ++i) { const int q = tid + 512 * i, t = q >> 5, s0 = (q & 31) * 4;
        f32x4 w = *(const GAS f32x4*)(ws + t * 128 + s0);
        if (s0 + 0 > t) w.x = 0.f; if (s0 + 1 > t) w.y = 0.f; if (s0 + 2 > t) w.z = 0.f; if (s0 + 3 > t) w.w = 0.f;
        *(LAS f32x4*)(wl + t * 128 + s0) = w; }
    __syncthreads();
    const int d = tid & 127, tq = __builtin_amdgcn_readfirstlane(tid >> 7);
    float vr[128];
#pragma unroll
    for (int sb = 0; sb < 4; ++sb)
        if (sb <= tq) {
#pragma unroll
            for (int s = 0; s < 32; ++s) vr[sb * 32 + s] = vln[(sb * 32 + s) * 128 + d];
        } else {
#pragma unroll
            for (int s = 0; s < 32; ++s) vr[sb * 32 + s] = 0.f;
        }
    const GAS float* bs = ((const GAS float*)F.in[12]) + ((size_t)l * 4 + g) * 128;
#pragma unroll 1
    for (int ti = 0; ti < 32; ++ti) { const int t = tq * 32 + ti; float a = 0.f;
#pragma unroll
        for (int sb = 0; sb < 4; ++sb)
            if (sb <= tq) {
#pragma unroll
                for (int s4 = 0; s4 < 8; ++s4) { const f32x4 w = *(const LAS f32x4*)(wl + t * 128 + sb * 32 + s4 * 4);
                    a += w.x * vr[sb * 32 + s4 * 4] + w.y * vr[sb * 32 + s4 * 4 + 1] + w.z * vr[sb * 32 + s4 * 4 + 2] + w.w * vr[sb * 32 + s4 * 4 + 3]; }
            }
        const float uu = bf1(PA[(size_t)(n0 + t) * NPA + PA_CU + g * 128 + d]);
        Y[(size_t)(n0 + t) * 1536 + 1024 + g * 128 + d] = (bf16)f2bf(uu * (a + bs[t])); }
    __syncthreads();
}

__device__ __forceinline__ void gla_unit(Frame& F, int l, int unit) {
    int tid = F.tid; asm volatile("" : "+v"(tid));
    const int b = unit >> 2, h = unit & 3;
    const GAS bf16* PA = (const GAS bf16*)(F.ws + WS_PA); GAS bf16* Y = (GAS bf16*)(F.ws + WS_Y); const GAS float* GLR = (const GAS float*)(F.ws + WS_GLR);
    LAS float* wa = (LAS float*)F.lds;
    LAS float* ba = wa + 1024;
    LAS float* as_ = ba + 64;
    LAS float* qs = as_ + 1024;
    LAS float* ks = qs + 1024;
    LAS float* vs = ks + 1024;
    LAS float* part = vs + 2048;
    for (int i = tid; i < 1024; i += 512) wa[i] = ((const GAS float*)F.in[6])[(size_t)l * 16 * 256 + (i >> 6) * 256 + h * 64 + (i & 63)];
    if (tid < 64) ba[tid] = ((const GAS float*)F.in[7])[l * 256 + h * 64 + tid];
    const GAS float* gng = ((const GAS float*)F.in[8]) + l * 128;
    const int v = tid & 127, kq = __builtin_amdgcn_readfirstlane(tid >> 7);
    float S[16];
#pragma unroll
    for (int j = 0; j < 16; ++j) S[j] = 0.f;
    __syncthreads();
    for (int t0 = 0; t0 < SEQ; t0 += 16) {
        const size_t nb = (size_t)b * SEQ + t0;
#pragma unroll
        for (int i = 0; i < 2; ++i) { const int e = tid + 512 * i, t = e >> 6, k = e & 63; float z = ba[k];
#pragma unroll
            for (int r = 0; r < 16; ++r) z += GLR[(nb + t) * 16 + r] * wa[r * 64 + k];
            const float ls = fminf(z, 0.f) - log1pf(__expf(-fabsf(z)));
            as_[e] = __expf(ls * (1.f / 16.f));
            qs[e] = bf1(PA[(nb + t) * NPA + PA_BQ + h * 64 + k]); ks[e] = bf1(PA[(nb + t) * NPA + PA_BK + h * 64 + k]); }
#pragma unroll
        for (int i = 0; i < 4; ++i) { const int e = tid + 512 * i, t = e >> 7, vv = e & 127; vs[e] = bf1(PA[(nb + t) * NPA + PA_BV + h * 128 + vv]); }
        __syncthreads();
#pragma unroll 4
        for (int t = 0; t < 16; ++t) { const float vt = vs[t * 128 + v]; float p = 0.f;
#pragma unroll
            for (int j4 = 0; j4 < 4; ++j4) { const f32x4 a4 = *(const LAS f32x4*)(as_ + t * 64 + kq * 16 + j4 * 4), k4 = *(const LAS f32x4*)(ks + t * 64 + kq * 16 + j4 * 4), q4 = *(const LAS f32x4*)(qs + t * 64 + kq * 16 + j4 * 4);
#pragma unroll
                for (int j = 0; j < 4; ++j) { S[j4 * 4 + j] = a4[j] * S[j4 * 4 + j] + k4[j] * vt; p += q4[j] * S[j4 * 4 + j]; } }
            part[(kq * 16 + t) * 128 + v] = p; }
        __syncthreads();
        { const int t = tid >> 5, v4 = (tid & 31) * 4;
          f32x4 o = *(const LAS f32x4*)(part + (0 * 16 + t) * 128 + v4);
#pragma unroll
          for (int q = 1; q < 4; ++q) o += *(const LAS f32x4*)(part + (q * 16 + t) * 128 + v4);
          float ss = o.x * o.x + o.y * o.y + o.z * o.z + o.w * o.w;
#pragma unroll
          for (int sh = 1; sh < 32; sh <<= 1) ss += shx(ss, sh, tid & 63);
          const float r = 1.f / sqrtf(ss * (1.f / 128.f) + RMS_EPS);
          const f32x4 gg = *(const GAS f32x4*)(gng + v4);
          const u32x2 brw = *(const GAS u32x2*)(PA + (nb + t) * NPA + PA_BR + h * 128 + v4);
          u32x2 w; w.x = pk2(o.x * r * gg.x * bflo(brw.x), o.y * r * gg.y * bfhi(brw.x)); w.y = pk2(o.z * r * gg.z * bflo(brw.y), o.w * r * gg.w * bfhi(brw.y));
          *(GAS u32x2*)(Y + (nb + t) * 1536 + 512 + h * 128 + v4) = w; }
        __syncthreads();
    }
}

constexpr int DSA_WAVE_LDS = 17920;
__device__ __forceinline__ void dsa_unit(Frame& F, int unit) {
    int lane = F.lane; asm volatile("" : "+v"(lane)); const int w = F.wave;
    const int qb = 4095 - unit;
    const int b = qb & 7, t = (qb >> 3) * 8 + w;
    const size_t n = (size_t)b * SEQ + t, nb0 = (size_t)b * SEQ;
    const GAS bf16* PA = (const GAS bf16*)(F.ws + WS_PA); GAS bf16* Y = (GAS bf16*)(F.ws + WS_Y);
    const GAS bf16* KI = (const GAS bf16*)(F.ws + WS_KI); const GAS bf16* KA = (const GAS bf16*)(F.ws + WS_KA); const GAS bf16* VA = (const GAS bf16*)(F.ws + WS_VA);
    const GAS float* WI = (const GAS float*)(F.ws + WS_WI);
    LAS unsigned char* base = F.lds + w * DSA_WAVE_LDS;
    LAS unsigned* sc = (LAS unsigned*)base;
    LAS float* qi = (LAS float*)(base + 16384);
    LAS unsigned short* list = (LAS unsigned short*)(base + 16384 + 1024);
    { const u32x2 q2 = *(const GAS u32x2*)(PA + n * NPA + PA_QI + 4 * lane);
      *(LAS f32x4*)(qi + 4 * lane) = (f32x4){bflo(q2.x), bfhi(q2.x), bflo(q2.y), bfhi(q2.y)}; }
    asm volatile("s_waitcnt lgkmcnt(0)" ::: "memory");
    const f32x4 wi = {ld_f32(WI + n * 4), ld_f32(WI + n * 4 + 1), ld_f32(WI + n * 4 + 2), ld_f32(WI + n * 4 + 3)};
    const int nbat = (t >> 6) + 1;
    for (int kb = 0; kb < nbat; ++kb) { const int key = kb * 64 + lane, kc = key <= t ? key : t;
        const GAS u32x4* kp = (const GAS u32x4*)(KI + (nb0 + kc) * 64);
        float kf[64];
#pragma unroll
        for (int c = 0; c < 8; ++c) { const u32x4 kk = kp[c]; kf[8 * c] = bflo(kk.x); kf[8 * c + 1] = bfhi(kk.x); kf[8 * c + 2] = bflo(kk.y); kf[8 * c + 3] = bfhi(kk.y); kf[8 * c + 4] = bflo(kk.z); kf[8 * c + 5] = bfhi(kk.z); kf[8 * c + 6] = bflo(kk.w); kf[8 * c + 7] = bfhi(kk.w); }
        float score = 0.f;
#pragma unroll
        for (int h = 0; h < 4; ++h) { float d = 0.f;
#pragma unroll
            for (int c = 0; c < 16; ++c) { const f32x4 q4 = *(const LAS f32x4*)(qi + h * 64 + 4 * c); d += q4.x * kf[4 * c] + q4.y * kf[4 * c + 1] + q4.z * kf[4 * c + 2] + q4.w * kf[4 * c + 3]; }
            score += wi[h] * fmaxf(d, 0.f); }
        if (score == 0.f) score = 0.f;
        unsigned u = __builtin_bit_cast(unsigned, score); u = (u & 0x80000000u) ? ~u : (u | 0x80000000u);
        sc[key] = key <= t ? u : 0u; }
    asm volatile("s_waitcnt lgkmcnt(0)" ::: "memory");
    int nsel;
    if (t >= 256) {
        unsigned T = 0u;
        for (int bit = 31; bit >= 0; --bit) { const unsigned cand = T | (1u << bit); int cnt = 0;
            for (int j = 0; j < nbat; ++j) cnt += (sc[j * 64 + lane] >= cand) ? 1 : 0;
            if (wave_sum_i(cnt, lane) >= 256) T = cand; }
        int cgt = 0;
        for (int j = 0; j < nbat; ++j) cgt += (sc[j * 64 + lane] > T) ? 1 : 0;
        const int need = 256 - wave_sum_i(cgt, lane);
        int selbase = 0, tiebase = 0;
        for (int j = 0; j < nbat; ++j) { const unsigned x = sc[j * 64 + lane]; const bool eq = (x == T), gt = (x > T);
            const unsigned long long beq = __ballot(eq); const unsigned long long lt = (1ull << lane) - 1ull;
            const int trank = tiebase + __popcll(beq & lt);
            const bool sel = gt || (eq && trank < need);
            const unsigned long long bsel = __ballot(sel);
            if (sel) list[selbase + __popcll(bsel & lt)] = (unsigned short)(j * 64 + lane);
            selbase += __popcll(bsel); tiebase += __popcll(beq); }
        nsel = 256;
    } else {
        nsel = t + 1;
        for (int i = lane; i < 256; i += 64) list[i] = (unsigned short)(i <= t ? i : 0);
    }
    asm volatile("s_waitcnt lgkmcnt(0)" ::: "memory");
    LAS float* qm = (LAS float*)base;
    LAS float* Pl = (LAS float*)(base + 2048);
    { const u32x4 q8 = *(const GAS u32x4*)(PA + n * NPA + PA_Q + 8 * lane);
      *(LAS f32x4*)(qm + 8 * lane) = (f32x4){bflo(q8.x), bfhi(q8.x), bflo(q8.y), bfhi(q8.y)}; *(LAS f32x4*)(qm + 8 * lane + 4) = (f32x4){bflo(q8.z), bfhi(q8.z), bflo(q8.w), bfhi(q8.w)}; }
    asm volatile("s_waitcnt lgkmcnt(0)" ::: "memory");
#pragma unroll 1
    for (int bb = 0; bb < 4; ++bb) { const int i = bb * 64 + lane; const bool valid = i < nsel; const int key = valid ? (int)list[i] : 0;
        const GAS u32x4* kp = (const GAS u32x4*)(KA + (nb0 + key) * 64);
        float kf[64];
#pragma unroll
        for (int c = 0; c < 8; ++c) { const u32x4 kk = kp[c]; kf[8 * c] = bflo(kk.x); kf[8 * c + 1] = bfhi(kk.x); kf[8 * c + 2] = bflo(kk.y); kf[8 * c + 3] = bfhi(kk.y); kf[8 * c + 4] = bflo(kk.z); kf[8 * c + 5] = bfhi(kk.z); kf[8 * c + 6] = bflo(kk.w); kf[8 * c + 7] = bfhi(kk.w); }
        float lgv[8];
#pragma unroll
        for (int h = 0; h < 8; ++h) { float d = 0.f;
#pragma unroll
            for (int c = 0; c < 16; ++c) { const f32x4 q4 = *(const LAS f32x4*)(qm + h * 64 + 4 * c); d += q4.x * kf[4 * c] + q4.y * kf[4 * c + 1] + q4.z * kf[4 * c + 2] + q4.w * kf[4 * c + 3]; }
            lgv[h] = valid ? d : -INFINITY; }
        *(LAS f32x4*)(Pl + i * 8) = (f32x4){lgv[0], lgv[1], lgv[2], lgv[3]}; *(LAS f32x4*)(Pl + i * 8 + 4) = (f32x4){lgv[4], lgv[5], lgv[6], lgv[7]}; }
    asm volatile("s_waitcnt lgkmcnt(0)" ::: "memory");
    float lg[4][8];
#pragma unroll
    for (int bb = 0; bb < 4; ++bb) { const f32x4 a = *(const LAS f32x4*)(Pl + (bb * 64 + lane) * 8), c = *(const LAS f32x4*)(Pl + (bb * 64 + lane) * 8 + 4);
        lg[bb][0] = a.x; lg[bb][1] = a.y; lg[bb][2] = a.z; lg[bb][3] = a.w; lg[bb][4] = c.x; lg[bb][5] = c.y; lg[bb][6] = c.z; lg[bb][7] = c.w; }
    float den[8];
#pragma unroll
    for (int h = 0; h < 8; ++h) { float m = fmaxf(fmaxf(lg[0][h], lg[1][h]), fmaxf(lg[2][h], lg[3][h])); m = wave_max(m, lane); float s = 0.f;
#pragma unroll
        for (int bb = 0; bb < 4; ++bb) { lg[bb][h] = __expf(lg[bb][h] - m); s += lg[bb][h]; }
        den[h] = wave_sum(s, lane); }
#pragma unroll
    for (int bb = 0; bb < 4; ++bb) { const int i = bb * 64 + lane;
        *(LAS f32x4*)(Pl + i * 8) = (f32x4){lg[bb][0], lg[bb][1], lg[bb][2], lg[bb][3]}; *(LAS f32x4*)(Pl + i * 8 + 4) = (f32x4){lg[bb][4], lg[bb][5], lg[bb][6], lg[bb][7]}; }
    asm volatile("s_waitcnt lgkmcnt(0)" ::: "memory");
    float o[8];
#pragma unroll
    for (int h = 0; h < 8; ++h) o[h] = 0.f;
#pragma unroll 4
    for (int i = 0; i < nsel; ++i) { const int key = (int)list[i]; const float vv = bf1(VA[(nb0 + key) * 64 + lane]);
        const f32x4 p0 = *(const LAS f32x4*)(Pl + i * 8), p1 = *(const LAS f32x4*)(Pl + i * 8 + 4);
        o[0] += p0.x * vv; o[1] += p0.y * vv; o[2] += p0.z * vv; o[3] += p0.w * vv; o[4] += p1.x * vv; o[5] += p1.y * vv; o[6] += p1.z * vv; o[7] += p1.w * vv; }
#pragma unroll
    for (int h = 0; h < 8; ++h) Y[n * 1536 + h * 64 + lane] = (bf16)f2bf(o[h] / den[h]);
}

template <int CTRL> __device__ __forceinline__ float dppf(float x) { return __builtin_bit_cast(float, __builtin_amdgcn_mov_dpp(__builtin_bit_cast(int, x), CTRL, 0xf, 0xf, true)); }
typedef short v4i16_t __attribute__((ext_vector_type(4)));
__device__ __forceinline__ bf16x8 scale_pack8(u32x4 raw, float s) {
    u32x4 o; o.x = cvt_pk_bf16(bflo(raw.x) * s, bfhi(raw.x) * s); o.y = cvt_pk_bf16(bflo(raw.y) * s, bfhi(raw.y) * s); o.z = cvt_pk_bf16(bflo(raw.z) * s, bfhi(raw.z) * s); o.w = cvt_pk_bf16(bflo(raw.w) * s, bfhi(raw.w) * s);
    return __builtin_bit_cast(bf16x8, o);
}
__device__ __forceinline__ void dsa16_unit(Frame& F, int unit) {
    int lane = F.lane; asm volatile("" : "+v"(lane)); const int w = F.wave;
    const int qb = 2047 - unit;
    const int b = qb & 7, t0 = (qb >> 3) * 16;
    const size_t nb0 = (size_t)b * SEQ;
    const GAS bf16* PA = (const GAS bf16*)(F.ws + WS_PA); GAS bf16* Y = (GAS bf16*)(F.ws + WS_Y);
    const GAS bf16* KI = (const GAS bf16*)(F.ws + WS_KI); const GAS bf16* KA = (const GAS bf16*)(F.ws + WS_KA); const GAS bf16* VA = (const GAS bf16*)(F.ws + WS_VA);
    const GAS float* WI = (const GAS float*)(F.ws + WS_WI);
    LAS unsigned char* K16 = F.lds;
    LAS unsigned short* LIST = (LAS unsigned short*)(F.lds + AUX_OFF);
    const int fr = lane & 15, fq = lane >> 4;
    {
        const int ql = fr >> 2, h = fr & 3;
        bf16x8 Bf[4][2]; float Linf[4];
#pragma unroll
        for (int g = 0; g < 4; ++g) { const size_t nq = nb0 + t0 + 4 * g + ql; const float wv = WI[nq * 4 + h];
#pragma unroll
            for (int ks = 0; ks < 2; ++ks) Bf[g][ks] = scale_pack8(*(const GAS u32x4*)(PA + nq * NPA + PA_QI + h * 64 + 8 * fq + 32 * ks), wv);
            Linf[g] = (wv >= 0.f) ? INFINITY : -INFINITY; }
        const int ntiles = (t0 >> 4) + 1;
        for (int tile = w; tile < ntiles; tile += 8) {
            const size_t krow = (nb0 + 16 * tile + fr) * 64;
            const bf16x8 A0 = *(const GAS bf16x8*)(KI + krow + 8 * fq), A1 = *(const GAS bf16x8*)(KI + krow + 32 + 8 * fq);
            const int kpos = 16 * tile + 4 * fq + h;
            const int g7 = kpos >> 7, hf = (kpos >> 6) & 1, ln = kpos & 63;
            const int koff = (g7 >> 2) * 1024 + ln * 16 + (g7 & 3) * 4 + hf * 2;
#pragma unroll
            for (int g = 0; g < 4; ++g) {
                f32x4 d = __builtin_amdgcn_mfma_f32_16x16x32_bf16(A0, Bf[g][0], (f32x4){0.f, 0.f, 0.f, 0.f}, 0, 0, 0);
                d = __builtin_amdgcn_mfma_f32_16x16x32_bf16(A1, Bf[g][1], d, 0, 0, 0);
                const float a0 = __builtin_amdgcn_fmed3f(d[0], 0.f, Linf[g]), a1 = __builtin_amdgcn_fmed3f(d[1], 0.f, Linf[g]), a2 = __builtin_amdgcn_fmed3f(d[2], 0.f, Linf[g]), a3 = __builtin_amdgcn_fmed3f(d[3], 0.f, Linf[g]);
                const float u0 = a0 + dppf<0xB1>(a0), u1 = a1 + dppf<0xB1>(a1), u2 = a2 + dppf<0xB1>(a2), u3 = a3 + dppf<0xB1>(a3);
                const float b0 = (h & 1) ? u1 : u0, b1 = (h & 1) ? u3 : u2;
                const float c0 = b0 + dppf<0x4E>(b0), c1 = b1 + dppf<0x4E>(b1);
                float s = (h & 2) ? c1 : c0;
                if (s == 0.f) s = 0.f;
                const _Float16 hh = (_Float16)s; const unsigned hb = (unsigned)__builtin_bit_cast(unsigned short, hh);
                const unsigned key = (hb & 0x8000u) ? (hb ^ 0xffffu) : (hb | 0x8000u);
                const bool valid = kpos <= t0 + 4 * g + ql;
                *(LAS unsigned short*)(K16 + (4 * g + ql) * 8192 + koff) = (unsigned short)(valid ? key : 0u);
            }
        }
    }
    __syncthreads();
#pragma unroll 1
    for (int qq = 0; qq < 2; ++qq) {
        const int q = 2 * w + qq, nvalid = t0 + q + 1;
        LAS unsigned short* list = LIST + q * 256;
        if (nvalid <= 256) {
            for (int i = lane; i < 256; i += 64) list[i] = (unsigned short)(i < nvalid ? i : 0);
        } else {
            const int ngrp = (nvalid + 511) >> 9;
            unsigned v[64];
#pragma unroll
            for (int grp = 0; grp < 8; ++grp) {
                if (grp < ngrp) { const u32x4 r = *(const LAS u32x4*)(K16 + q * 8192 + grp * 1024 + lane * 16);
#pragma unroll
                    for (int i = 0; i < 4; ++i) { const int g = 4 * grp + i; const unsigned rr = r[i]; const int thr = nvalid - 128 * g;
                        v[2 * g] = (lane < thr) ? (rr & 0xffffu) : 0u; v[2 * g + 1] = (lane < thr - 64) ? (rr >> 16) : 0u; }
                } else {
#pragma unroll
                    for (int i = 0; i < 8; ++i) v[8 * grp + i] = 0u;
                }
            }
            unsigned T = 0u;
#pragma unroll 1
            for (int bit = 15; bit >= 0; --bit) { const unsigned cand = T | (1u << bit); int cnt = 0;
#pragma unroll
                for (int grp = 0; grp < 8; ++grp) if (grp < ngrp) {
#pragma unroll
                    for (int i = 0; i < 8; ++i) cnt += (v[8 * grp + i] >= cand) ? 1 : 0; }
                if (wave_sum_i(cnt, lane) >= 256) T = cand; }
            int cgt = 0;
#pragma unroll
            for (int grp = 0; grp < 8; ++grp) if (grp < ngrp) {
#pragma unroll
                for (int i = 0; i < 8; ++i) cgt += (v[8 * grp + i] > T) ? 1 : 0; }
            const int need = 256 - wave_sum_i(cgt, lane);
            int selbase = 0, tiebase = 0; const unsigned long long lt = (1ull << lane) - 1ull;
#pragma unroll
            for (int grp = 0; grp < 8; ++grp) if (grp < ngrp) {
#pragma unroll
                for (int i = 0; i < 8; ++i) { const int j = 8 * grp + i; const unsigned x = v[j]; const bool eq = (x == T), gt = (x > T);
                    const unsigned long long beq = __ballot(eq);
                    const int trank = tiebase + __popcll(beq & lt);
                    const bool sel = gt || (eq && trank < need);
                    const unsigned long long bsel = __ballot(sel);
                    if (sel) list[selbase + __popcll(bsel & lt)] = (unsigned short)(j * 64 + lane);
                    selbase += __popcll(bsel); tiebase += __popcll(beq); } }
        }
    }
    __syncthreads();
    LAS unsigned char* Vs = F.lds + w * 16384;
#pragma unroll 1
    for (int qq = 0; qq < 2; ++qq) {
        const int q = 2 * w + qq, tq = t0 + q; const int nsel = (tq + 1 < 256) ? tq + 1 : 256;
        const size_t nq = nb0 + tq;
        const LAS unsigned short* list = LIST + q * 256;
        bf16x8 Qf[2];
#pragma unroll
        for (int ks = 0; ks < 2; ++ks) { u32x4 raw = {0u, 0u, 0u, 0u}; if (fr < 8) raw = *(const GAS u32x4*)(PA + nq * NPA + PA_Q + fr * 64 + 8 * fq + 32 * ks); Qf[ks] = __builtin_bit_cast(bf16x8, raw); }
        float lg[16][4];
#pragma unroll
        for (int tt = 0; tt < 16; ++tt) { const int pos = 16 * tt + fr; const int key = (pos < nsel) ? (int)list[pos] : 0;
            const size_t krow = (nb0 + key) * 64;
            const bf16x8 A0 = *(const GAS bf16x8*)(KA + krow + 8 * fq), A1 = *(const GAS bf16x8*)(KA + krow + 32 + 8 * fq);
            f32x4 d = __builtin_amdgcn_mfma_f32_16x16x32_bf16(A0, Qf[0], (f32x4){0.f, 0.f, 0.f, 0.f}, 0, 0, 0);
            d = __builtin_amdgcn_mfma_f32_16x16x32_bf16(A1, Qf[1], d, 0, 0, 0);
#pragma unroll
            for (int r = 0; r < 4; ++r) lg[tt][r] = (16 * tt + 4 * fq + r < nsel) ? d[r] : -INFINITY; }
        float m = lg[0][0];
#pragma unroll
        for (int tt = 0; tt < 16; ++tt)
#pragma unroll
            for (int r = 0; r < 4; ++r) m = fmaxf(m, lg[tt][r]);
        m = fmaxf(m, shx(m, 16, lane)); m = fmaxf(m, shx(m, 32, lane));
        float den = 0.f;
#pragma unroll
        for (int tt = 0; tt < 16; ++tt)
#pragma unroll
            for (int r = 0; r < 4; ++r) { lg[tt][r] = __expf(lg[tt][r] - m); den += lg[tt][r]; }
        den += shx(den, 16, lane); den += shx(den, 32, lane);
        f32x4 acc[4];
#pragma unroll
        for (int nt = 0; nt < 4; ++nt) acc[nt] = (f32x4){0.f, 0.f, 0.f, 0.f};
#pragma unroll
        for (int hh = 0; hh < 2; ++hh) {
#pragma unroll
            for (int i = 0; i < 16; ++i) { const int piece = i * 64 + lane, row = piece >> 3, c = piece & 7; const int pos = 128 * hh + row; const int key = (pos < nsel) ? (int)list[pos] : 0;
                const u32x4 vv = *(const GAS u32x4*)(VA + (nb0 + key) * 64 + 8 * c);
                *(LAS u32x4*)(Vs + row * 128 + c * 16) = vv; }
            asm volatile("s_waitcnt lgkmcnt(0)" ::: "memory");
#pragma unroll
            for (int s4 = 0; s4 < 4; ++s4) { const int s = 4 * hh + s4;
                u32x4 pa; pa.x = cvt_pk_bf16(lg[2 * s][0], lg[2 * s][1]); pa.y = cvt_pk_bf16(lg[2 * s][2], lg[2 * s][3]); pa.z = cvt_pk_bf16(lg[2 * s + 1][0], lg[2 * s + 1][1]); pa.w = cvt_pk_bf16(lg[2 * s + 1][2], lg[2 * s + 1][3]);
                const bf16x8 Pa = __builtin_bit_cast(bf16x8, pa);
                const int rowa = 32 * s4 + 4 * fq + (fr >> 2);
#pragma unroll
                for (int nt = 0; nt < 4; ++nt) {
                    const v4i16_t lo = __builtin_amdgcn_ds_read_tr16_b64_v4i16((LAS v4i16_t*)(Vs + rowa * 128 + (16 * nt + 4 * (fr & 3)) * 2));
                    const v4i16_t hi = __builtin_amdgcn_ds_read_tr16_b64_v4i16((LAS v4i16_t*)(Vs + (rowa + 16) * 128 + (16 * nt + 4 * (fr & 3)) * 2));
                    bf16x8 Bv; Bv[0] = lo[0]; Bv[1] = lo[1]; Bv[2] = lo[2]; Bv[3] = lo[3]; Bv[4] = hi[0]; Bv[5] = hi[1]; Bv[6] = hi[2]; Bv[7] = hi[3];
                    acc[nt] = __builtin_amdgcn_mfma_f32_16x16x32_bf16(Pa, Bv, acc[nt], 0, 0, 0); } }
            asm volatile("s_waitcnt lgkmcnt(0)" ::: "memory");
        }
        float dn[4];
#pragma unroll
        for (int r = 0; r < 4; ++r) dn[r] = __builtin_bit_cast(float, __builtin_amdgcn_ds_bpermute((4 * (fq & 1) + r) << 2, __builtin_bit_cast(int, den)));
        if (fq < 2) {
#pragma unroll
            for (int nt = 0; nt < 4; ++nt)
#pragma unroll
                for (int r = 0; r < 4; ++r) Y[nq * 1536 + (4 * fq + r) * 64 + 16 * nt + fr] = (bf16)f2bf(acc[nt][r] / dn[r]);
        }
    }
}

__device__ __forceinline__ void phase_mixer(Frame& F, int l, int slot = 0, int types = 7) {
    gu32* head = F.ctl + CW_QUEUE + 64 * (l + 2 * slot);
    for (;;) {
        __syncthreads();
        if (F.tid == 0) F.MISC[64] = __hip_atomic_fetch_add(head, 1u, __ATOMIC_RELAXED, __HIP_MEMORY_SCOPE_AGENT);
        __syncthreads();
        const int u = (int)F.MISC[64];
#ifdef DSA_NAIVE
        constexpr int NDSA = 4096;
#else
        constexpr int NDSA = 2048;
#endif
        if (u >= 32 + NDSA + 1024) break;
        if (u < 32) { if (EN_B1 && (types & 1)) gla_unit(F, l, u); }
        else if (u < 32 + NDSA) { if (EN_B2 && (types & 2)) {
#ifdef DSA_NAIVE
            dsa_unit(F, u - 32);
#else
            dsa16_unit(F, u - 32);
#endif
        } }
        else { if (EN_B3 && (types & 4)) gmlp_unit(F, l, u - 32 - NDSA); }
    }
}

__device__ __forceinline__ void phase_ln_router(Frame& F, int l) {
    const GAS float* WR = (const GAS float*)(F.ws + WS_WR) + (size_t)l * 36 * DM;
    LAS float* wr = (LAS float*)F.lds;
    for (int i = F.tid; i < 36 * 256; i += 512) ((LAS f32x4*)wr)[i] = ((const GAS f32x4*)WR)[i];
    if (F.tid < 32) F.MISC[16 + F.tid] = 0u;
    __syncthreads();
    GAS bf16* HB = (GAS bf16*)(F.ws + WS_HB); GAS int* EID = (GAS int*)(F.ws + WS_ROUTE); GAS float* EW = (GAS float*)(F.ws + WS_ROUTE + 256 * 1024);
    const GAS float* g = ((const GAS float*)F.in[17]) + l * DM; const GAS float* bb = ((const GAS float*)F.in[18]) + l * DM; const GAS float* brg = ((const GAS float*)F.in[20]) + l * 4; const GAS float* bre = ((const GAS float*)F.in[22]) + l * 32;
    const int lane = F.lane;
    for (int r0 = F.wg * 128; r0 < NTOK; r0 += F.G * 128)
        for (int j = 0; j < 16; ++j) { const int m = r0 + F.wave * 16 + j;
            f32x4 v[4];
#pragma unroll
            for (int q = 0; q < 4; ++q) v[q] = *(const GAS f32x4*)(F.H + (size_t)m * DM + 4 * lane + 256 * q);
            ln_row_regs(v, g, bb, lane);
            store_row_f32_bf16(v, F.H + (size_t)m * DM, HB + (size_t)m * DM, lane);
            float lgt[36];
#pragma unroll
            for (int o = 0; o < 36; ++o) { float p = 0.f;
#pragma unroll
                for (int q = 0; q < 4; ++q) { const f32x4 w4 = *(const LAS f32x4*)(wr + o * DM + 4 * lane + 256 * q); p += v[q].x * w4.x + v[q].y * w4.y + v[q].z * w4.z + v[q].w * w4.w; }
                lgt[o] = wave_sum(p, lane); }
            int gi = 0; float gm = lgt[0] + brg[0];
#pragma unroll
            for (int q = 1; q < 4; ++q) { const float x = lgt[q] + brg[q]; if (x > gm) { gm = x; gi = q; } }
            float gs = 0.f;
#pragma unroll
            for (int q = 0; q < 4; ++q) gs += __expf(lgt[q] + brg[q] - gm);
            const float gp = 1.f / gs;
            float el[8];
#pragma unroll
            for (int q = 0; q < 8; ++q) { float x = lgt[4 + q] + bre[q];
                x = (gi == 1) ? lgt[12 + q] + bre[8 + q] : x; x = (gi == 2) ? lgt[20 + q] + bre[16 + q] : x; x = (gi == 3) ? lgt[28 + q] + bre[24 + q] : x; el[q] = x; }
            int i0 = 0; float v0 = el[0];
#pragma unroll
            for (int q = 1; q < 8; ++q) if (el[q] > v0) { v0 = el[q]; i0 = q; }
            int i1 = -1; float v1 = -INFINITY;
#pragma unroll
            for (int q = 0; q < 8; ++q) if (q != i0 && el[q] > v1) { v1 = el[q]; i1 = q; }
            const float ex = __expf(v1 - v0), w0 = gp / (1.f + ex), w1 = gp * ex / (1.f + ex);
            if (lane == 0) { const int e0 = gi * 8 + i0, e1 = gi * 8 + i1;
                EID[2 * m] = e0; EID[2 * m + 1] = e1; EW[2 * m] = w0; EW[2 * m + 1] = w1;
                __hip_atomic_fetch_add((LAS unsigned*)(F.lds + MISC_OFF) + 16 + e0, 1u, __ATOMIC_RELAXED, __HIP_MEMORY_SCOPE_WORKGROUP);
                __hip_atomic_fetch_add((LAS unsigned*)(F.lds + MISC_OFF) + 16 + e1, 1u, __ATOMIC_RELAXED, __HIP_MEMORY_SCOPE_WORKGROUP); } }
    __syncthreads();
    if (F.tid < 32) ((GAS int*)(F.ws + WS_CNTWG))[F.wg * 32 + F.tid] = (int)F.MISC[16 + F.tid];
}
__device__ __forceinline__ void phase_dispatch(Frame& F) {
    const GAS int* CNT = (const GAS int*)(F.ws + WS_CNTWG); const GAS int* EID = (const GAS int*)(F.ws + WS_ROUTE); const GAS float* EW = (const GAS float*)(F.ws + WS_ROUTE + 256 * 1024);
    GAS int* SROW = (GAS int*)(F.ws + WS_SROW); GAS int* ROWMAP = (GAS int*)(F.ws + WS_ROWMAP); GAS float* CWROW = (GAS float*)(F.ws + WS_CWROW); GAS int* META = (GAS int*)(F.ws + WS_META);
    LAS int* tot = (LAS int*)(F.lds + AUX_OFF);
    if (F.tid < 32) { int t = 0, mine = 0; for (int w = 0; w < F.G; ++w) { const int c = ld_i32(CNT + w * 32 + F.tid); t += c; if (w < F.wg) mine += c; } tot[F.tid] = t; tot[32 + F.tid] = mine; tot[96 + F.tid] = 0; }
    __syncthreads();
    if (F.tid == 0) { int rb = 0;
#pragma clang loop unroll(disable) vectorize(disable)
        for (int e = 0; e < 32; ++e) { tot[64 + e] = rb; rb += ((tot[e] + 255) >> 8) << 8; }
        tot[128] = rb; }
    __syncthreads();
    if (F.wg == 0) { const int nt = tot[128] >> 8; if (F.tid == 0) META[0] = nt;
        if (F.tid < nt) { int e = 0;
#pragma clang loop unroll(disable) vectorize(disable)
            for (int q = 1; q < 32; ++q) if (tot[64 + q] <= F.tid * 256) e = q;
            META[16 + F.tid] = e; } }
    for (int r0 = F.wg * 128; r0 < NTOK; r0 += F.G * 128) {
        if (F.tid < 256) { const int tok = r0 + (F.tid >> 1), slot = F.tid & 1; const int e = EID[2 * tok + slot];
            const int pos = (int)__hip_atomic_fetch_add((LAS unsigned*)&tot[96 + e], 1u, __ATOMIC_RELAXED, __HIP_MEMORY_SCOPE_WORKGROUP);
            const int sr = tot[64 + e] + tot[32 + e] + pos;
            ROWMAP[sr] = tok; CWROW[sr] = EW[2 * tok + slot]; SROW[2 * tok + slot] = sr; } }
    if (F.wg < 32) { const int e = F.wg; const int lo = tot[64 + e] + tot[e], hi = tot[64 + e] + (((tot[e] + 255) >> 8) << 8);
        for (int r = lo + F.tid; r < hi; r += 512) { ROWMAP[r] = 0; CWROW[r] = 0.f; } }
}
__device__ __forceinline__ void phase_ln2(Frame& F, int l) {
    GAS bf16* HB = (GAS bf16*)(F.ws + WS_HB); const GAS int* SROW = (const GAS int*)(F.ws + WS_SROW); const GAS bf16* FF2 = (const GAS bf16*)(F.ws + WS_FF2);
    const GAS float* g = ((const GAS float*)F.in[26]) + l * DM; const GAS float* bb = ((const GAS float*)F.in[27]) + l * DM; int lane = F.lane; asm volatile("" : "+v"(lane));
    const int gw = F.wg * 8 + F.wave, NGW = F.G * 8;
    for (int m = gw; m < NTOK; m += NGW) { const int s0 = ld_i32(SROW + 2 * m), s1 = ld_i32(SROW + 2 * m + 1);
        f32x4 v[4];
#pragma unroll
        for (int q = 0; q < 4; ++q) { const f32x4 h = *(const GAS f32x4*)(F.H + (size_t)m * DM + 4 * lane + 256 * q);
            const u32x2 a = *(const GAS u32x2*)(FF2 + (size_t)s0 * DM + 4 * lane + 256 * q), c = *(const GAS u32x2*)(FF2 + (size_t)s1 * DM + 4 * lane + 256 * q);
            v[q] = h * DN_ALPHA + (f32x4){bflo(a.x) + bflo(c.x), bfhi(a.x) + bfhi(c.x), bflo(a.y) + bflo(c.y), bfhi(a.y) + bfhi(c.y)}; }
        ln_row_regs(v, g, bb, lane);
        store_row_f32_bf16(v, F.H + (size_t)m * DM, HB + (size_t)m * DM, lane); }
}

#ifndef EN_P
#define EN_P 1
#endif
#ifndef EN_A
#define EN_A 1
#endif
#ifndef EN_B
#define EN_B 1
#endif
#ifndef EN_C
#define EN_C 1
#endif
#ifndef EN_D
#define EN_D 1
#endif
#ifndef EN_E
#define EN_E 1
#endif
#ifndef EN_F
#define EN_F 1
#endif
#ifndef EN_G
#define EN_G 1
#endif
#ifndef EN_H
#define EN_H 1
#endif
#ifndef EN_I
#define EN_I 1
#endif
#ifndef EN_J
#define EN_J 1
#endif
constexpr int N_PHASES = 1 + 10 * DEPTH;
#ifndef MK_ONE_LAUNCH
#define MK_ONE_LAUNCH 0
#endif
struct Args { const float* in[28]; float* out; unsigned char* ws; int ph_lo, ph_hi; };
static_assert(sizeof(Args) == 28 * 8 + 8 + 8 + 8, "no padding bytes in the argument struct");


__device__ __forceinline__ unsigned opaque_u32(unsigned x) { asm volatile("" : "+v"(x)); return (unsigned)__builtin_amdgcn_readfirstlane((int)x); }
__device__ __forceinline__ unsigned long long opaque_u64(unsigned long long x) { return ((unsigned long long)opaque_u32((unsigned)(x >> 32)) << 32) | opaque_u32((unsigned)x); }
__device__ __forceinline__ void launder(Frame& F) {
    F.ws = (GAS unsigned char*)opaque_u64((unsigned long long)F.ws); F.H = (GAS float*)opaque_u64((unsigned long long)F.H);
    F.ctl = (gu32*)opaque_u64((unsigned long long)F.ctl);
    unsigned z0 = 0u; asm volatile("" : "+v"(z0)); int ln = (int)__builtin_amdgcn_mbcnt_hi(~0u, __builtin_amdgcn_mbcnt_lo(~0u, z0));
    F.wave = (int)opaque_u32((unsigned)F.wave); F.lane = ln; F.tid = F.wave * 64 + ln;
    F.G = (int)opaque_u32((unsigned)F.G); F.wg = (int)opaque_u32((unsigned)F.wg);
}
__global__ void __launch_bounds__(512, 2) mk_fwd(Args args) {
    extern __shared__ __attribute__((aligned(16))) unsigned char lds_raw[];
    Frame F;
    F.lds = (LAS unsigned char*)lds_raw;
    F.MISC = (volatile LAS unsigned*)(F.lds + MISC_OFF);
    F.tid = threadIdx.x; F.lane = F.tid & 63; F.wave = __builtin_amdgcn_readfirstlane(F.tid >> 6);
    F.G = gridDim.x; F.wg = blockIdx.x;
    F.in = args.in;
    F.pos = (const GAS int*)args.in[1];
    F.H = (GAS float*)args.out; F.ws = (GAS unsigned char*)args.ws;
    F.ctl = (gu32*)(args.ws + WS_CTL);
    for (int u = F.tid; u < (LDS_BYTES - MISC_OFF) / 4; u += 512) ((LAS unsigned*)(F.lds + MISC_OFF))[u] = 0u;
    __syncthreads();
    const int lo = args.ph_lo, hi = args.ph_hi;
    const bool multi = (hi - lo) > 1;
    XcdBarrier bar; bar.bar = (unsigned*)(F.ctl + CW_BAR); bar.x = 0; bar.st = nullptr;
    if (multi) bar = xcd_barrier_post((unsigned*)(F.ctl + CW_BAR), F.MISC + 8);
#define IN(k) (lo <= (k) && (k) < hi)
#define SEAM(k) do { if (IN(k) && IN((k) + 1)) xcd_barrier(bar); } while (0)

#ifdef DUP_P
    for (int rep = 0; rep < 2; ++rep)
#endif
    if (EN_P && IN(0)) { launder(F); phase_prologue(F); }
    SEAM(0);
#define HB ((GAS bf16*)(F.ws + WS_HB))
#define PA ((GAS bf16*)(F.ws + WS_PA))
#define Y ((GAS bf16*)(F.ws + WS_Y))
    for (int l = 0; l < DEPTH; ++l) {
        const int pb = 1 + 10 * l;
#define wd (F.ws + WS_WDENSE + (size_t)l * WD_LAYER)
#ifdef DUP_A
        for (int rep = 0; rep < 2; ++rep)
#endif
        if (EN_A && IN(pb + 0)) { launder(F);
            { LAS float* scr = (LAS float*)(F.lds + F.wave * 16384); const int gw = F.wg * 8 + F.wave, NGW = F.G * 8;
              for (int it = gw; it < 12288; it += NGW) conv_moe_item(F, l, it, scr);
              __syncthreads(); }
            DenseSched S; S.init(NTOK / 256, NPA / 256, F.G, F.wg, (const void*)HB, (size_t)256 * DM * 2, (const void*)(wd + WD_WA), (size_t)256 * DM * 2);
            EpiA E{PA, (GAS bf16*)(F.ws + WS_KA), (GAS bf16*)(F.ws + WS_VA), (GAS bf16*)(F.ws + WS_KI), (GAS float*)(F.ws + WS_WI), (GAS float*)(F.ws + WS_GLR), (const GAS float*)(F.ws + WS_ROPE), ((const GAS float*)F.in[5]) + l * 64};
            pg8::gemm_phase<EpiA, DenseSched, false>(F.lds, S, E, DM, DM, F.wave);
        }
        SEAM(pb + 0);
        if (EN_B && IN(pb + 1)) { launder(F); phase_mixer(F, l);
#ifdef DUP_B
            launder(F); phase_mixer(F, l, 1, DUP_B);
#endif
        }
        SEAM(pb + 1);
#ifdef DUP_C
        for (int rep = 0; rep < 2; ++rep)
#endif
        if (EN_C && IN(pb + 2)) { launder(F);
            DenseSched S; S.init(NTOK / 256, NGT / 256, F.G, F.wg, (const void*)HB, (size_t)256 * DM * 2, (const void*)(wd + WD_WG), (size_t)256 * DM * 2);
            EpiG E{PA};
            pg8::gemm_phase<EpiG, DenseSched, false>(F.lds, S, E, DM, DM, F.wave);
        }
        SEAM(pb + 2);
#ifdef DUP_D
        for (int rep = 0; rep < 2; ++rep)
#endif
        if (EN_D && IN(pb + 3)) { launder(F);
#pragma unroll 1
            for (int br = 0; br < 3; ++br) {
                DenseSched S; S.init(NTOK / 256, DM / 256, F.G, F.wg, (const void*)(Y + 512 * br), (size_t)256 * 1536 * 2, (const void*)(wd + WD_WBR + (size_t)br * 1024 * 512 * 2), (size_t)256 * 512 * 2);
                EpiM E{PA, HB, br};
                pg8::gemm_phase<EpiM, DenseSched, false>(F.lds, S, E, 512, 1536, F.wave);
            }
        }
        SEAM(pb + 3);
        if (EN_E && IN(pb + 4)) { launder(F);
            DenseSched S; S.init(NTOK / 256, DM / 256, F.G, F.wg, (const void*)HB, (size_t)256 * DM * 2, (const void*)(wd + WD_WOUT), (size_t)256 * DM * 2);
            EpiO E{F.H};
            pg8::gemm_phase<EpiO, DenseSched, false>(F.lds, S, E, DM, DM, F.wave);
        }
        SEAM(pb + 4);
        if (EN_F && IN(pb + 5)) { launder(F); phase_ln_router(F, l); }
        SEAM(pb + 5);
        if (EN_G && IN(pb + 6)) { launder(F); phase_dispatch(F); }
        SEAM(pb + 6);
#ifdef DUP_H
        for (int rep = 0; rep < 2; ++rep)
#endif
        if (EN_H && IN(pb + 7)) { launder(F);
            const GAS int* META = (const GAS int*)(F.ws + WS_META); const GAS int* ROWMAP = (const GAS int*)(F.ws + WS_ROWMAP);
            const int NT = ld_i32(META), NU = NT * 2;
            LAS int* meta = (LAS int*)(F.lds + AUX_OFF); LAS int* rows = (LAS int*)(F.lds + AUX_OFF + 64);
            for (int i = 0; i * F.G + F.wg < NU && i < 8; ++i) { const int L = i * F.G + F.wg, gt = L >> 1;
                if (F.tid == 0) meta[i] = ld_i32(META + 16 + gt);
                if (F.tid < 256) rows[i * 256 + F.tid] = ROWMAP[gt * 256 + F.tid]; }
            __syncthreads();
            GroupSched S{NU, F.G, F.wg, 2, (const char*)HB, (const char*)(F.ws + WS_WMOE + WM_GU), 0, (size_t)512 * DM * 2, (size_t)256 * DM * 2, meta, rows};
            EpiGU E{(GAS bf16*)(F.ws + WS_HID), (const GAS float*)(F.ws + WS_CWROW)};
            pg8::gemm_phase<EpiGU, GroupSched, true>(F.lds, S, E, DM, DM, F.wave);
        }
        SEAM(pb + 7);
#ifdef DUP_I
        for (int rep = 0; rep < 2; ++rep)
#endif
        if (EN_I && IN(pb + 8)) { launder(F);
            const GAS int* META = (const GAS int*)(F.ws + WS_META);
            const int NT = ld_i32(META), NU = NT * 4;
            LAS int* meta = (LAS int*)(F.lds + AUX_OFF);
            for (int i = 0; i * F.G + F.wg < NU && i < 8; ++i) { const int L = i * F.G + F.wg, gt = L >> 2; if (F.tid == 0) meta[i] = ld_i32(META + 16 + gt); }
            __syncthreads();
            GroupSched S{NU, F.G, F.wg, 4, (const char*)(F.ws + WS_HID), (const char*)(F.ws + WS_WMOE + WM_DN), (size_t)256 * DEXP * 2, (size_t)DM * DEXP * 2, (size_t)256 * DEXP * 2, meta, nullptr};
            EpiDN E{(GAS bf16*)(F.ws + WS_FF2)};
            pg8::gemm_phase<EpiDN, GroupSched, false>(F.lds, S, E, DEXP, DEXP, F.wave);
        }
        SEAM(pb + 8);
        if (EN_J && IN(pb + 9)) { launder(F); phase_ln2(F, l); }
        SEAM(pb + 9);
    }
#undef IN
#undef SEAM
#undef HB
#undef PA
#undef Y
#undef wd
}


#ifdef DUMP_OFF
__global__ void dump_k(const unsigned short* src, float* out) {
    for (size_t i = (size_t)blockIdx.x * blockDim.x + threadIdx.x; i < (size_t)NTOK * 1024; i += (size_t)gridDim.x * blockDim.x) { const size_t n = i >> 10, c = i & 1023; out[i] = __builtin_bit_cast(float, ((unsigned)src[n * DUMP_PITCH + c]) << 16); }
}
#endif
extern "C" void kernel_launch(void* const* d_in, const int* in_sizes, int n_in, void* d_out, int out_size, void* d_ws, size_t ws_size, hipStream_t stream) {
    static int grid = 0;
    if (grid == 0) {
        if (n_in != 28 || out_size != NTOK * DM || ws_size < WS_END) { fprintf(stderr, "kernel_launch: unexpected shapes (n_in %d out %d ws %zu); nothing launched\n", n_in, out_size, ws_size); grid = -1; return; }
        int dev = 0, cus = 0;
        if (hipGetDevice(&dev) != hipSuccess || hipDeviceGetAttribute(&cus, hipDeviceAttributeMultiprocessorCount, dev) != hipSuccess) { grid = -1; return; }
        if (hipFuncSetAttribute((const void*)mk_fwd, hipFuncAttributeMaxDynamicSharedMemorySize, LDS_BYTES) != hipSuccess) { fprintf(stderr, "kernel_launch: hipFuncSetAttribute failed\n"); grid = -1; return; }
        int per_cu = 0;
        if (hipOccupancyMaxActiveBlocksPerMultiprocessor(&per_cu, (const void*)mk_fwd, 512, LDS_BYTES) != hipSuccess || per_cu < 1) { fprintf(stderr, "kernel_launch: occupancy query says %d\n", per_cu); }
        (void)hipGetLastError();
        grid = cus;
        if (grid != 256) fprintf(stderr, "kernel_launch: %d CUs (built for 256)\n", grid);
    }
    if (grid < 0) return;
    if (hipMemsetAsync((char*)d_ws + WS_CTL, 0, CTL_ZERO_BYTES, stream) != hipSuccess) return;
    Args a{};
    for (int i = 0; i < 28; ++i) a.in[i] = (const float*)d_in[i];
    a.out = (float*)d_out; a.ws = (unsigned char*)d_ws;
#if MK_ONE_LAUNCH
    a.ph_lo = 0; a.ph_hi = N_PHASES;
    hipLaunchKernelGGL(mk_fwd, dim3(grid), dim3(512), LDS_BYTES, stream, a);
#else
#ifndef STOP_AFTER
#define STOP_AFTER (N_PHASES - 1)
#endif
#ifndef PHASE_MASK
#define PHASE_MASK 0xffffffffu
#endif
    for (int p = 0; p <= STOP_AFTER; ++p) { if (!((PHASE_MASK >> p) & 1u)) continue; a.ph_lo = p; a.ph_hi = p + 1; hipLaunchKernelGGL(mk_fwd, dim3(grid), dim3(512), LDS_BYTES, stream, a); }
#ifdef DUMP_OFF
    hipLaunchKernelGGL(dump_k, dim3(2048), dim3(256), 0, stream, (const unsigned short*)((const char*)d_ws + (size_t)(DUMP_OFF)), (float*)d_out);
#endif
#endif
}
```

```cpp
#define MK_ONE_LAUNCH 1
#include <hip/hip_runtime.h>
#include <cstdio>
#include <cstdint>

#define LAS __attribute__((address_space(3)))
#define GAS __attribute__((address_space(1)))
typedef unsigned short bf16;
typedef short bf16x8 __attribute__((ext_vector_type(8)));
typedef float f32x4 __attribute__((ext_vector_type(4)));
typedef float f32x2 __attribute__((ext_vector_type(2)));
typedef unsigned u32x4 __attribute__((ext_vector_type(4)));
typedef unsigned u32x2 __attribute__((ext_vector_type(2)));
typedef GAS unsigned gu32;

constexpr int NB = 8, SEQ = 4096, NTOK = NB * SEQ, DM = 1024, NIN = 6612, DEPTH = 2;
constexpr int NPA = 3584;
constexpr int NGT = 3072;
constexpr int NEXP = 32, DEXP = 256;
constexpr int MAXTILES = 288;
constexpr float DN_ALPHA = 1.41421356237309515f;
constexpr float LN_EPS = 1e-5f, RMS_EPS = 1e-6f;
constexpr int PA_Q = 0, PA_QI = 768, PA_BQ = 1024, PA_BK = 1280, PA_BV = 1536, PA_BR = 2048, PA_CU = 2560, PA_CV = 3072;

__device__ __forceinline__ unsigned f2bf(float f) { unsigned u = __builtin_bit_cast(unsigned, f); return (u + 0x7fffu + ((u >> 16) & 1u)) >> 16; }
__device__ __forceinline__ unsigned pk2(float lo, float hi) { return f2bf(lo) | (f2bf(hi) << 16); }
__device__ __forceinline__ float bflo(unsigned w) { return __builtin_bit_cast(float, w << 16); }
__device__ __forceinline__ float bfhi(unsigned w) { return __builtin_bit_cast(float, w & 0xffff0000u); }
__device__ __forceinline__ float bf1(bf16 h) { return __builtin_bit_cast(float, ((unsigned)h) << 16); }
typedef __bf16 bf16x2_t __attribute__((ext_vector_type(2)));
__device__ __forceinline__ unsigned cvt_pk_bf16(float lo, float hi) { const f32x2 v = {lo, hi}; const bf16x2_t b = __builtin_convertvector(v, bf16x2_t); return __builtin_bit_cast(unsigned, b); }
__device__ __forceinline__ float shx(float v, int mask, int lane) { return __builtin_bit_cast(float, __builtin_amdgcn_ds_bpermute((lane ^ mask) << 2, __builtin_bit_cast(int, v))); }
__device__ __forceinline__ int shxi(int v, int mask, int lane) { return __builtin_amdgcn_ds_bpermute((lane ^ mask) << 2, v); }
__device__ __forceinline__ float wave_sum(float v, int lane) {
#pragma unroll
    for (int o = 1; o < 64; o <<= 1) v += shx(v, o, lane);
    return v;
}
__device__ __forceinline__ float wave_max(float v, int lane) {
#pragma unroll
    for (int o = 1; o < 64; o <<= 1) v = fmaxf(v, shx(v, o, lane));
    return v;
}
__device__ __forceinline__ int wave_sum_i(int v, int lane) {
#pragma unroll
    for (int o = 1; o < 64; o <<= 1) v += shxi(v, o, lane);
    return v;
}
__device__ __forceinline__ int ld_i32(const GAS int* p) { return __hip_atomic_load(p, __ATOMIC_RELAXED, __HIP_MEMORY_SCOPE_AGENT); }
__device__ __forceinline__ float ld_f32(const GAS float* p) { return __hip_atomic_load(p, __ATOMIC_RELAXED, __HIP_MEMORY_SCOPE_AGENT); }
__device__ __forceinline__ float sigmoidf_(float x) { return __builtin_amdgcn_rcpf(1.0f + __expf(-x)); }
__device__ __forceinline__ float siluf_(float x) { return x * sigmoidf_(x); }
__device__ __forceinline__ float gelu_tanh_(float x) { const float u = 0.7978845608028654f * (x + 0.044715f * x * x * x); return x * sigmoidf_(2.0f * u); }

namespace pg8 {
constexpr int BM = 256, BK = 64, HALF = 128, HTB = HALF * BK * 2, STAGE_BYTES = 8 * HTB;
__host__ __device__ __forceinline__ int lds_byte(int r, int c) { const int st = (r >> 4) * 2 + (c >> 5), rr = r & 15, cc = c & 31, ob = rr * 64 + cc * 2; return st * 1024 + (ob ^ (((ob >> 9) & 1) << 5)); }
__host__ __device__ __forceinline__ void stage_rc(int b, int& R, int& C) { const int st = b / 1024, sb = b % 1024, swz = sb ^ (((sb >> 9) & 1) << 5); R = (st >> 1) * 16 + swz / 64; C = (st & 1) * 32 + (swz % 64) / 2; }
__host__ __device__ __forceinline__ int perm32(int rho) { const int n = rho >> 4, i = rho & 15; return 8 * (i >> 2) + 4 * n + (i & 3); }

struct Unit { int pm, pn, e, slot; };

template <class Epi, class Sched, bool GATHER>
__device__ __forceinline__ void gemm_phase(LAS unsigned char* lds, const Sched& S, const Epi& E, const int K, const int lda, const int wave) {
    unsigned z0_ = 0u; asm volatile("" : "+v"(z0_)); const int lane_ = (int)__builtin_amdgcn_mbcnt_hi(~0u, __builtin_amdgcn_mbcnt_lo(~0u, z0_));
    const int wid = wave, lane = lane_, tid = wid * 64 + lane, wr = wid >> 2, wc = wid & 3, fr = lane & 15, fq = lane >> 4;
    const int nt = K / BK;
    int Rr[2], Cc[2];
    unsigned voffB[2];
#pragma unroll
    for (int i = 0; i < 2; ++i) { int R, C; stage_rc(tid * 16 + i * 8192, R, C); Rr[i] = R; Cc[i] = C; const int Rb = Epi::PERM ? ((R & ~31) + perm32(R & 31)) : R; voffB[i] = (unsigned)(Rb * K + C) * 2u; }
    const size_t kstep = (size_t)(BK * 2);
    const size_t hstepB = (size_t)HALF * K * 2;
    const unsigned ldsw = (unsigned)wid * 1024u;
    const int aoff = lds_byte(wr * 64 + fr, fq * 8), boff = lds_byte(wc * 32 + fr, fq * 8);
#define PG8_SA(b, h) (((b) * 2 + (h)) * HTB)
#define PG8_SB(b, h) ((4 + (b) * 2 + (h)) * HTB)
#define PG8_STAGE(bufoff, gbase, voff) do { _Pragma("unroll") for (int _i = 0; _i < 2; ++_i) \
        __builtin_amdgcn_global_load_lds((const unsigned*)((const char*)(gbase) + (voff)[_i]), (LAS unsigned*)(lds + (bufoff) + ldsw + _i * 8192), 16, 0, 0); } while (0)
#define PG8_LDA(dst, b, h) do { _Pragma("unroll") for (int m = 0; m < 4; ++m) _Pragma("unroll") for (int k = 0; k < 2; ++k) dst[m][k] = *(const LAS bf16x8*)(lds + PG8_SA(b, h) + aoff + m * 2048 + k * 1024); } while (0)
#define PG8_LDB(dst, b, h) do { _Pragma("unroll") for (int n = 0; n < 2; ++n) _Pragma("unroll") for (int k = 0; k < 2; ++k) dst[n][k] = *(const LAS bf16x8*)(lds + PG8_SB(b, h) + boff + n * 2048 + k * 1024); } while (0)
#define PG8_MMA(ai, bj, At, Bt) do { __builtin_amdgcn_s_setprio(1); _Pragma("unroll") for (int m = 0; m < 4; ++m) _Pragma("unroll") for (int n = 0; n < 2; ++n) _Pragma("unroll") for (int k = 0; k < 2; ++k) \
        acc[ai][bj][m][n] = __builtin_amdgcn_mfma_f32_16x16x32_bf16(Bt[n][k], At[m][k], acc[ai][bj][m][n], 0, 0, 0); __builtin_amdgcn_s_setprio(0); } while (0)
#define PG8_WAIT_V(n) asm volatile("s_waitcnt vmcnt(" #n ")" ::: "memory")
#define PG8_WAIT_L(n) asm volatile("s_waitcnt lgkmcnt(" #n ")" ::: "memory")
#define PG8_BAR do { asm volatile("" ::: "memory"); __builtin_amdgcn_s_barrier(); asm volatile("" ::: "memory"); } while (0)
#define PG8_SCHED __builtin_amdgcn_sched_barrier(0)
    Unit cur, nxt; int ui = 0;
    if (!S.next(0, cur)) return;
    f32x4 acc[2][2][4][2];
#pragma unroll
    for (int a = 0; a < 2; ++a)
#pragma unroll
        for (int b = 0; b < 2; ++b)
#pragma unroll
            for (int m = 0; m < 4; ++m)
#pragma unroll
                for (int n = 0; n < 2; ++n) acc[a][b][m][n] = (f32x4){0.f, 0.f, 0.f, 0.f};
    bf16x8 At[4][2], B0[2][2], B1[2][2];
    unsigned cA0[2], cA1[2], nA0[2], nA1[2];
#pragma unroll
    for (int i = 0; i < 2; ++i) {
        if (GATHER) { cA0[i] = (unsigned)(S.row_of(cur, Rr[i]) * lda + Cc[i]) * 2u; cA1[i] = (unsigned)(S.row_of(cur, HALF + Rr[i]) * lda + Cc[i]) * 2u; }
        else { cA0[i] = (unsigned)(Rr[i] * lda + Cc[i]) * 2u; cA1[i] = (unsigned)((HALF + Rr[i]) * lda + Cc[i]) * 2u; }
        nA0[i] = cA0[i]; nA1[i] = cA1[i];
    }
    const char* cA = S.a_base(cur); const char* cB = S.b_base(cur);
    PG8_STAGE(PG8_SB(0, 0), cB, voffB); PG8_STAGE(PG8_SB(0, 1), cB + hstepB, voffB); PG8_STAGE(PG8_SA(0, 0), cA, cA0); PG8_STAGE(PG8_SA(0, 1), cA, cA1);
    if (wr == 1) PG8_BAR;
    PG8_WAIT_V(2); PG8_BAR;
    PG8_STAGE(PG8_SB(1, 0), cB + kstep, voffB); PG8_STAGE(PG8_SA(1, 0), cA + kstep, cA0); PG8_STAGE(PG8_SB(1, 1), cB + hstepB + kstep, voffB);
    PG8_WAIT_V(6); PG8_BAR;
    for (;;) {
        const bool has_next = S.next(ui + 1, nxt);
        const char* nA = has_next ? S.a_base(nxt) : cA; const char* nB = has_next ? S.b_base(nxt) : cB;
        if (GATHER) {
#pragma unroll
            for (int i = 0; i < 2; ++i) {
                if (has_next) { nA0[i] = (unsigned)(S.row_of(nxt, Rr[i]) * lda + Cc[i]) * 2u; nA1[i] = (unsigned)(S.row_of(nxt, HALF + Rr[i]) * lda + Cc[i]) * 2u; }
                else { nA0[i] = cA0[i]; nA1[i] = cA1[i]; }
            }
        }
#pragma unroll 1
        for (int t = 0; t < nt; t += 2) {
            const bool last = (t == nt - 2);
            const char* a1 = cA + (size_t)(t + 1) * kstep;
            const char* a2 = last ? nA : cA + (size_t)(t + 2) * kstep; const char* b2 = last ? nB : cB + (size_t)(t + 2) * kstep;
            const char* a3 = a2 + kstep; const char* b3 = b2 + kstep;
            unsigned x0[2], x1[2];
#pragma unroll
            for (int i = 0; i < 2; ++i) { x0[i] = (GATHER && last) ? nA0[i] : cA0[i]; x1[i] = (GATHER && last) ? nA1[i] : cA1[i]; }
            PG8_LDB(B0, 0, 0); PG8_LDB(B1, 0, 1); PG8_SCHED; PG8_LDA(At, 0, 0); PG8_STAGE(PG8_SA(1, 1), a1, cA1);
            PG8_WAIT_V(8); PG8_WAIT_L(0); PG8_BAR; PG8_MMA(0, 0, At, B0); PG8_MMA(0, 1, At, B1); PG8_BAR; PG8_SCHED;
            PG8_LDA(At, 0, 1); PG8_STAGE(PG8_SB(0, 0), b2, voffB); PG8_STAGE(PG8_SB(0, 1), b2 + hstepB, voffB); PG8_STAGE(PG8_SA(0, 0), a2, x0);
            PG8_WAIT_V(8); PG8_WAIT_L(0); PG8_BAR; PG8_MMA(1, 0, At, B0); PG8_MMA(1, 1, At, B1); PG8_BAR; PG8_SCHED;
            PG8_LDB(B0, 1, 0); PG8_LDB(B1, 1, 1); PG8_SCHED; PG8_LDA(At, 1, 0); PG8_STAGE(PG8_SA(0, 1), a2, x1);
            PG8_WAIT_V(8); PG8_WAIT_L(0); PG8_BAR; PG8_MMA(0, 0, At, B0); PG8_MMA(0, 1, At, B1); PG8_BAR; PG8_SCHED;
            PG8_LDA(At, 1, 1); PG8_STAGE(PG8_SB(1, 0), b3, voffB); PG8_STAGE(PG8_SB(1, 1), b3 + hstepB, voffB); PG8_STAGE(PG8_SA(1, 0), a3, x0);
            PG8_WAIT_V(8); PG8_WAIT_L(0); PG8_BAR; PG8_MMA(1, 0, At, B0); PG8_MMA(1, 1, At, B1); PG8_BAR; PG8_SCHED;
        }
        if (wr == 0) PG8_BAR;
        E(acc, cur, wr, wc, fr, fq);
        if (!has_next) break;
#pragma unroll
        for (int a = 0; a < 2; ++a)
#pragma unroll
            for (int b = 0; b < 2; ++b)
#pragma unroll
                for (int m = 0; m < 4; ++m)
#pragma unroll
                    for (int n = 0; n < 2; ++n) acc[a][b][m][n] = (f32x4){0.f, 0.f, 0.f, 0.f};
        cur = nxt; cA = nA; cB = nB; ++ui;
#pragma unroll
        for (int i = 0; i < 2; ++i) { cA0[i] = nA0[i]; cA1[i] = nA1[i]; }
        if (wr == 1) PG8_BAR;
    }
    PG8_WAIT_V(0);
    PG8_BAR;
#undef PG8_SA
#undef PG8_SB
#undef PG8_STAGE
#undef PG8_LDA
#undef PG8_LDB
#undef PG8_MMA
#undef PG8_WAIT_V
#undef PG8_WAIT_L
#undef PG8_BAR
#undef PG8_SCHED
}
}

#define XB_TMO      128
#define XB_XCNT(j)  (256  + 64 * (j))
#define XB_XSUB(j)  (1280 + 64 * (j))
#define XB_XGEN(j)  (2304 + 64 * (j))
#define XB_TOP      3328
#define XB_TOPGEN   3392
#define XCD_BAR_WORDS 3456
#define XB_SPIN_CAP (1u << 20)

__device__ __forceinline__ unsigned xb_ld(unsigned* p)              { return __hip_atomic_load(p, __ATOMIC_RELAXED, __HIP_MEMORY_SCOPE_AGENT); }
__device__ __forceinline__ unsigned xb_add(unsigned* p, unsigned v) { return __hip_atomic_fetch_add(p, v, __ATOMIC_RELAXED, __HIP_MEMORY_SCOPE_AGENT); }
__device__ __forceinline__ unsigned xb_xcc_id() { return (unsigned)__builtin_amdgcn_s_getreg((3 << 11) | 20) & 0xFu; }
#define XB_SPIN(cond, bar) do { unsigned _sp = 0; while (cond) { __builtin_amdgcn_s_sleep(1); \
    if ((++_sp & 255u) == 0u) { if (xb_ld(&(bar)[XB_TMO])) break; if (_sp > XB_SPIN_CAP) { atomicAdd(&(bar)[XB_TMO], 1u); break; } } } } while (0)

struct XcdBarrier { unsigned* bar; unsigned x; volatile LAS unsigned* st; };

__device__ __forceinline__ XcdBarrier xcd_barrier_post(unsigned* bar, volatile LAS unsigned* st) {
    XcdBarrier b; b.bar = bar; b.x = xb_xcc_id(); b.st = st;
    if (threadIdx.x == 0) (void)xb_add(&bar[XB_XCNT(b.x)], 1u);
    return b;
}
__device__ __forceinline__ void xcd_barrier_complete(unsigned* bar, unsigned x, unsigned& nloc, unsigned& nx) {
    const unsigned G = gridDim.x * gridDim.y * gridDim.z;
    unsigned sum, cnt, mine, sp = 0u;
    for (;;) {
        sum = 0u; cnt = 0u; mine = 0u;
#pragma unroll
        for (unsigned j = 0; j < 16; ++j) { const unsigned c = xb_ld(&bar[XB_XCNT(j)]); sum += c; cnt += (c > 0u) ? 1u : 0u; mine = (j == x) ? c : mine; }
        if (sum == G) break;
        __builtin_amdgcn_s_sleep(1);
        if ((++sp & 255u) == 0u) { if (xb_ld(&bar[XB_TMO])) break; if (sp > XB_SPIN_CAP) { atomicAdd(&bar[XB_TMO], 1u); break; } }
    }
    nloc = mine > 0u ? mine : 1u; nx = cnt > 0u ? cnt : 1u;
}
__device__ __forceinline__ void xcd_barrier(const XcdBarrier& b) {
    asm volatile("s_waitcnt vmcnt(0)" ::: "memory");
    __syncthreads();
    if (threadIdx.x == 0) {
        unsigned* bar = b.bar;
        __builtin_amdgcn_s_waitcnt(0);
        unsigned nloc = b.st[0], nx = b.st[1];
        if (nloc == 0u) { xcd_barrier_complete(bar, b.x, nloc, nx); b.st[0] = nloc; b.st[1] = nx; }
        const unsigned old = xb_add(&bar[XB_XSUB(b.x)], 1u);
        const unsigned gen = old / nloc;
        if (old + 1u == (gen + 1u) * nloc) {
            __builtin_amdgcn_fence(__ATOMIC_RELEASE, "agent");
            asm volatile("s_waitcnt vmcnt(0)" ::: "memory");
            const unsigned og = xb_add(&bar[XB_TOP], 1u);
            const unsigned tg = og / nx;
            if (og + 1u == (tg + 1u) * nx) xb_add(&bar[XB_TOPGEN], 1u);
            else XB_SPIN(xb_ld(&bar[XB_TOPGEN]) == tg, bar);
            __builtin_amdgcn_fence(__ATOMIC_ACQUIRE, "agent");
            xb_add(&bar[XB_XGEN(b.x)], 1u);
            asm volatile("s_waitcnt vmcnt(0)" ::: "memory");
        } else {
            XB_SPIN(xb_ld(&bar[XB_XGEN(b.x)]) == gen, bar);
            __builtin_amdgcn_fence(__ATOMIC_ACQUIRE, "agent");
            asm volatile("s_waitcnt vmcnt(0)" ::: "memory");
        }
    }
    __syncthreads();
}

constexpr size_t MiB = 1u << 20;
constexpr size_t WS_CTL = 0, CTL_ZERO_BYTES = 1 * MiB;
constexpr size_t WS_ROPE = 1 * MiB;
constexpr size_t WS_WI   = 3 * MiB;
constexpr size_t WS_ROUTE = 3 * MiB + 512 * 1024;
constexpr size_t WS_SROW = 4 * MiB;
constexpr size_t WS_ROWMAP = 4 * MiB + 256 * 1024;
constexpr size_t WS_CWROW = 4 * MiB + 640 * 1024;
constexpr size_t WS_CNTWG = 5 * MiB;
constexpr size_t WS_META = 5 * MiB + 64 * 1024;
constexpr size_t WS_WR = 5 * MiB + 128 * 1024;
constexpr size_t WS_GLR = 6 * MiB;
constexpr size_t WS_WDENSE = 8 * MiB;
constexpr size_t WD_WA = 0, WD_WG = 7 * MiB, WD_WBR = 13 * MiB, WD_WOUT = 16 * MiB, WD_LAYER = 18 * MiB;
constexpr size_t WS_WMOE = 44 * MiB;
constexpr size_t WM_GU = 0, WM_DN = 32 * MiB;
constexpr size_t WS_HB = 92 * MiB;
constexpr size_t WS_PA = 156 * MiB;
constexpr size_t WS_HID = WS_PA;
constexpr size_t WS_FF2 = WS_PA + 40 * MiB;
constexpr size_t WS_Y = 380 * MiB;
constexpr size_t WS_KA = 476 * MiB, WS_VA = 480 * MiB, WS_KI = 484 * MiB;
constexpr size_t WS_END = 512 * MiB;
static_assert(WS_WDENSE + 2 * WD_LAYER <= WS_WMOE && WS_WMOE + 48 * MiB <= WS_HB && WS_HB + 64 * MiB <= WS_PA && WS_PA + 224 * MiB <= WS_Y && WS_Y + 96 * MiB <= WS_KA && WS_KI + 4 * MiB <= WS_END, "ws map");
static_assert(WS_FF2 + (size_t)73728 * 1024 * 2 <= WS_Y, "ff2 fits");
constexpr int CW_BAR = 4096;
constexpr int CW_QUEUE = 16384;

constexpr int RING_BYTES = 131072;
constexpr int AUX_OFF = 131072;
constexpr int MISC_OFF = 147456;
constexpr int LDS_BYTES = 148480;

struct Frame {
    LAS unsigned char* lds;
    volatile LAS unsigned* MISC;
    gu32* ctl;
    int tid, lane, wave, G, wg;
    const float* const* in;
    const GAS int* pos;
    GAS float* H;
    GAS unsigned char* ws;
};

#define LDS_WAIT() asm volatile("s_waitcnt lgkmcnt(0)" ::: "memory")
#define VM_WAIT() asm volatile("s_waitcnt vmcnt(0)" ::: "memory")

__device__ __forceinline__ int pa_src_col(int c) {
    if (c < 512) return c;
    if (c < 768) { const int x = c - 512, half = x >> 7, y = x & 127, grp = y >> 5, d = (y & 31) + 32 * half;
        if (grp == 0) return 512 + d;
        if (grp == 1) return 576 + d;
        if (grp == 2) return 896 + d;
        if (half == 0) { const int z = y - 96; if (z < 4) return 960 + z; if (z < 20) return 1988 + (z - 4); }
        return -1; }
    if (c < 1024) return 640 + (c - 768);
    if (c < 1280) return 964 + (c - 1024);
    if (c < 1536) return 1220 + (c - 1280);
    if (c < 2048) return 1476 + (c - 1536);
    if (c < 2560) return 2004 + (c - 2048);
    return 2516 + (c - 2560);
}
__device__ __forceinline__ void transpose_item(const GAS float* W, int ldw, int K, GAS bf16* WT, int n0, int k0, int sc, LAS float* scr, int lane) {
#pragma unroll 8
    for (int i = 0; i < 32; ++i) { const int kk = 2 * i + (lane >> 5); scr[kk * 33 + (lane & 31)] = (sc >= 0) ? W[(size_t)(k0 + kk) * ldw + sc] : 0.f; }
    LDS_WAIT(); asm volatile("" ::: "memory");
    const int c = lane & 7;
#pragma unroll
    for (int j = 0; j < 4; ++j) { const int n = (lane >> 3) + 8 * j; const LAS float* s = scr + (8 * c) * 33 + n;
        u32x4 o; o.x = pk2(s[0 * 33], s[1 * 33]); o.y = pk2(s[2 * 33], s[3 * 33]); o.z = pk2(s[4 * 33], s[5 * 33]); o.w = pk2(s[6 * 33], s[7 * 33]);
        *(GAS u32x4*)(WT + (size_t)(n0 + n) * K + k0 + 8 * c) = o; }
    LDS_WAIT(); asm volatile("" ::: "memory");
}
__device__ __forceinline__ void conv_dense_item(Frame& F, int l, int it, LAS float* scr) {
    GAS bf16* base = (GAS bf16*)(F.ws + WS_WDENSE + (size_t)l * WD_LAYER);
    const int lane = F.lane;
    if (it < 1792) { const int kb = it / 112, nb = it % 112; const int sc = pa_src_col(32 * nb + (lane & 31));
        transpose_item(((const GAS float*)F.in[4]) + (size_t)l * DM * NIN, NIN, DM, base + WD_WA / 2, 32 * nb, 64 * kb, sc, scr, lane); return; }
    it -= 1792;
    if (it < 1536) { const int kb = it / 96, nb = it % 96; const int sc = 3540 + 32 * nb + (lane & 31);
        transpose_item(((const GAS float*)F.in[4]) + (size_t)l * DM * NIN, NIN, DM, base + WD_WG / 2, 32 * nb, 64 * kb, sc, scr, lane); return; }
    it -= 1536;
    if (it < 768) { const int br = it / 256, r = it % 256, kb = r / 32, nb = r % 32; const int sc = 32 * nb + (lane & 31);
        transpose_item((br == 0 ? ((const GAS float*)F.in[13]) : br == 1 ? ((const GAS float*)F.in[14]) : ((const GAS float*)F.in[15])) + (size_t)l * 512 * DM, DM, 512, base + WD_WBR / 2 + (size_t)br * 1024 * 512, 32 * nb, 64 * kb, sc, scr, lane); return; }
    it -= 768;
    { const int kb = it / 32, nb = it % 32; const int sc = 32 * nb + (lane & 31);
        transpose_item(((const GAS float*)F.in[16]) + (size_t)l * DM * DM, DM, DM, base + WD_WOUT / 2, 32 * nb, 64 * kb, sc, scr, lane); }
}
__device__ __forceinline__ void conv_moe_item(Frame& F, int l, int it, LAS float* scr) {
    const int lane = F.lane; const int e = it / 384; int r = it % 384;
    if (r < 256) { const int sub = r / 64, q = r % 64, ct = sub >> 1, bj = sub & 1, kb = q / 4, nb = q % 4;
        const GAS float* src = (bj ? ((const GAS float*)F.in[24]) : ((const GAS float*)F.in[23])) + (size_t)(l * NEXP + e) * DM * DEXP;
        GAS bf16* dst = (GAS bf16*)(F.ws + WS_WMOE + WM_GU) + (size_t)e * 512 * DM;
        transpose_item(src, DEXP, DM, dst, 256 * ct + 128 * bj + 32 * nb, 64 * kb, 128 * ct + 32 * nb + (lane & 31), scr, lane); return; }
    r -= 256;
    { const int kb = r / 32, nb = r % 32;
        const GAS float* src = ((const GAS float*)F.in[25]) + (size_t)(l * NEXP + e) * DEXP * DM;
        GAS bf16* dst = (GAS bf16*)(F.ws + WS_WMOE + WM_DN) + (size_t)e * DM * DEXP;
        transpose_item(src, DM, DEXP, dst, 32 * nb, 64 * kb, 32 * nb + (lane & 31), scr, lane); }
}

__device__ __forceinline__ void ln_row_regs(f32x4 (&v)[4], const GAS float* g, const GAS float* b, int lane) {
    float s = 0.f;
#pragma unroll
    for (int j = 0; j < 4; ++j) s += (v[j].x + v[j].y) + (v[j].z + v[j].w);
    const float mean = wave_sum(s, lane) * (1.f / DM); float s2 = 0.f;
#pragma unroll
    for (int j = 0; j < 4; ++j) { v[j] = v[j] - mean; s2 += (v[j].x * v[j].x + v[j].y * v[j].y) + (v[j].z * v[j].z + v[j].w * v[j].w); }
    const float rstd = 1.f / sqrtf(wave_sum(s2, lane) * (1.f / DM) + LN_EPS);
#pragma unroll
    for (int j = 0; j < 4; ++j) { const f32x4 gg = *(const GAS f32x4*)(g + 4 * lane + 256 * j), bb = *(const GAS f32x4*)(b + 4 * lane + 256 * j); v[j] = v[j] * rstd * gg + bb; }
}
__device__ __forceinline__ void store_row_f32_bf16(const f32x4 (&v)[4], GAS float* hrow, GAS bf16* brow, int lane) {
#pragma unroll
    for (int j = 0; j < 4; ++j) {
        if (hrow) *(GAS f32x4*)(hrow + 4 * lane + 256 * j) = v[j];
        if (brow) { u32x2 w; w.x = pk2(v[j].x, v[j].y); w.y = pk2(v[j].z, v[j].w); *(GAS u32x2*)(brow + 4 * lane + 256 * j) = w; }
    }
}

__device__ __forceinline__ void phase_prologue(Frame& F) {
    LAS float* scr = (LAS float*)(F.lds + F.wave * 16384);
    const int gw = F.wg * 8 + F.wave, NGW = F.G * 8;
    for (int it = gw; it < 2 * 4608; it += NGW) conv_dense_item(F, it / 4608, it % 4608, scr);
    { GAS float* WR = (GAS float*)(F.ws + WS_WR);
      for (int i = gw * 64 + F.lane; i < DEPTH * 36 * DM; i += NGW * 64) { const int l = i / (36 * DM), r = i % (36 * DM), o = r / DM, k = r % DM;
          WR[i] = (o < 4) ? ((const GAS float*)F.in[19])[(size_t)l * DM * 4 + k * 4 + o] : ((const GAS float*)F.in[21])[(size_t)l * DM * 32 + k * 32 + (o - 4)]; } }
    { GAS float* RT = (GAS float*)(F.ws + WS_ROPE);
      for (int i = gw * 64 + F.lane; i < NTOK * 8; i += NGW * 64) { const int n = i >> 3, j = i & 7;
          const float invf[8] = {1.000000000e+00f, 1.939227432e-01f, 3.760603070e-02f, 7.292664610e-03f, 1.414213562e-03f, 2.742481884e-04f, 5.318295734e-05f, 1.031338525e-05f};
          float inv = invf[0];
#pragma unroll
          for (int q = 1; q < 8; ++q) inv = (j == q) ? invf[q] : inv;
          const float ang = (float)F.pos[n] * inv;
          const double kq = __builtin_rint((double)ang * 0.15915494309189535);
          double r = (double)ang - kq * 6.283185307179586; double csign = 1.0;
          if (r > 1.5707963267948966) { r = 3.141592653589793 - r; csign = -1.0; } else if (r < -1.5707963267948966) { r = -3.141592653589793 - r; csign = -1.0; }
          const double x2 = r * r;
          const double sn = r * (1.0 + x2 * (-1.0 / 6 + x2 * (1.0 / 120 + x2 * (-1.0 / 5040 + x2 * (1.0 / 362880 + x2 * (-1.0 / 39916800 + x2 * (1.0 / 6227020800.0 + x2 * (-1.0 / 1307674368000.0))))))));
          const double cs = 1.0 + x2 * (-0.5 + x2 * (1.0 / 24 + x2 * (-1.0 / 720 + x2 * (1.0 / 40320 + x2 * (-1.0 / 3628800 + x2 * (1.0 / 479001600.0 + x2 * (-1.0 / 87178291200.0 + x2 * (1.0 / 20922789888000.0))))))));
          RT[n * 16 + j] = (float)(csign * cs); RT[n * 16 + 8 + j] = (float)sn; } }
    GAS bf16* HB = (GAS bf16*)(F.ws + WS_HB);
    for (int m = gw; m < NTOK; m += NGW) { f32x4 v[4];
#pragma unroll
        for (int j = 0; j < 4; ++j) v[j] = *(const GAS f32x4*)(((const GAS float*)F.in[0]) + (size_t)m * DM + 4 * F.lane + 256 * j);
        ln_row_regs(v, ((const GAS float*)F.in[2]), ((const GAS float*)F.in[3]), F.lane);
        store_row_f32_bf16(v, F.H + (size_t)m * DM, HB + (size_t)m * DM, F.lane); }
}

struct DenseSched {
    int nM, nN, nwg, G, c; const char* A; const char* B; size_t atile, btile;
    __device__ void init(int nM_, int nN_, int G_, int c_, const void* A_, size_t atile_, const void* B_, size_t btile_) { nM = nM_; nN = nN_; nwg = nM * nN; G = G_; c = c_; A = (const char*)A_; B = (const char*)B_; atile = atile_; btile = btile_; }
    __device__ __forceinline__ bool next(int i, pg8::Unit& u) const {
        const long L = (long)i * G + c; if (L >= nwg) return false;
        int wgid = (int)L; { const int q = nwg / 8, r = nwg % 8, xcd = wgid % 8, off = wgid / 8; wgid = (xcd < r ? xcd * (q + 1) : r * (q + 1) + (xcd - r) * q) + off; }
        const int nig = 8 * nN, gid = wgid / nig, fm = gid * 8, gsz = (nM - fm) < 8 ? (nM - fm) : 8;
        u.pm = fm + ((wgid % nig) % gsz); u.pn = (wgid % nig) / gsz; u.e = 0; u.slot = i; return true;
    }
    __device__ __forceinline__ const char* a_base(const pg8::Unit& u) const { return A + (size_t)u.pm * atile; }
    __device__ __forceinline__ const char* b_base(const pg8::Unit& u) const { return B + (size_t)u.pn * btile; }
    __device__ __forceinline__ int row_of(const pg8::Unit&, int) const { return 0; }
};
struct GroupSched {
    int NU, G, c, ncol; const char* A; const char* B; size_t atile, erows_bytes, btile; const LAS int* meta; const LAS int* rows;
    __device__ __forceinline__ bool next(int i, pg8::Unit& u) const {
        const int L = i * G + c; if (L >= NU) return false;
        u.pm = L / ncol; u.pn = L % ncol; u.slot = i; u.e = meta[i]; return true;
    }
    __device__ __forceinline__ const char* a_base(const pg8::Unit& u) const { return A + (size_t)u.pm * atile; }
    __device__ __forceinline__ const char* b_base(const pg8::Unit& u) const { return B + (size_t)u.e * erows_bytes + (size_t)u.pn * btile; }
    __device__ __forceinline__ int row_of(const pg8::Unit& u, int r) const { return rows[u.slot * 256 + r]; }
};

struct EpiA {
    static constexpr bool PERM = true;
    GAS bf16* PA; GAS bf16* KA; GAS bf16* VA; GAS bf16* KI; GAS float* WI; GAS float* GLR; const GAS float* ROPE; const GAS float* ikg;
    __device__ __forceinline__ static void rope8(float (&x)[8], const GAS float* rt, int fq, int lane) {
        const f32x4 c0 = *(const GAS f32x4*)(rt), c1 = *(const GAS f32x4*)(rt + 4), s0 = *(const GAS f32x4*)(rt + 8), s1 = *(const GAS f32x4*)(rt + 12);
#pragma unroll
        for (int i = 0; i < 8; ++i) { const float p = shx(x[i], 16, lane); const float cc = (i < 4) ? c0[i & 3] : c1[i & 3], ss = (i < 4) ? s0[i & 3] : s1[i & 3];
            const float r = x[i] * cc + ((fq == 0) ? -p : p) * ss; x[i] = (fq < 2) ? r : x[i]; }
    }
    __device__ __forceinline__ static u32x4 pack8(const float (&x)[8]) { u32x4 w; w.x = cvt_pk_bf16(x[0], x[1]); w.y = cvt_pk_bf16(x[2], x[3]); w.z = cvt_pk_bf16(x[4], x[5]); w.w = cvt_pk_bf16(x[6], x[7]); return w; }
    __device__ __forceinline__ void operator()(const f32x4 (&acc)[2][2][4][2], const pg8::Unit& u, int wr, int wc, int fr, int fq) const {
        const int pn = u.pn; const int rowb = u.pm * 256 + wr * 64 + fr; const int lane = fq * 16 + fr;
        if (pn == 2) {
#pragma unroll
            for (int ai = 0; ai < 2; ++ai)
#pragma unroll
                for (int m = 0; m < 4; ++m) {
                    const int row = rowb + ai * 128 + m * 16;
                    float x0[8], x1[8];
#pragma unroll
                    for (int i = 0; i < 8; ++i) { x0[i] = acc[ai][0][m][i >> 2][i & 3]; x1[i] = acc[ai][1][m][i >> 2][i & 3]; }
                    if (wc == 2) {
                        float s = 0.f;
#pragma unroll
                        for (int i = 0; i < 8; ++i) s += x0[i] + x1[i];
                        s += shx(s, 16, lane); s += shx(s, 32, lane);
                        const float mean = s * (1.f / 64.f); float q = 0.f;
#pragma unroll
                        for (int i = 0; i < 8; ++i) { x0[i] -= mean; x1[i] -= mean; q += x0[i] * x0[i] + x1[i] * x1[i]; }
                        q += shx(q, 16, lane); q += shx(q, 32, lane);
                        const float rstd = 1.f / sqrtf(q * (1.f / 64.f) + LN_EPS);
#pragma unroll
                        for (int i = 0; i < 8; ++i) { x0[i] = x0[i] * rstd * ikg[8 * fq + i]; x1[i] = x1[i] * rstd * ikg[32 + 8 * fq + i]; }
                    }
                    if (wc == 0 || wc == 2) rope8(x0, ROPE + (size_t)row * 16, fq, lane);
                    if (wc < 3) {
                        GAS bf16* dst = (wc == 0) ? KA : (wc == 1) ? VA : KI;
                        *(GAS u32x4*)(dst + (size_t)row * 64 + 8 * fq) = pack8(x0); *(GAS u32x4*)(dst + (size_t)row * 64 + 32 + 8 * fq) = pack8(x1);
                    } else {
                        if (fq == 0) { *(GAS f32x4*)(WI + (size_t)row * 4) = (f32x4){x0[0], x0[1], x0[2], x0[3]} * 0.0625f; *(GAS f32x4*)(GLR + (size_t)row * 16) = (f32x4){x0[4], x0[5], x0[6], x0[7]}; }
                        else if (fq == 1) { *(GAS f32x4*)(GLR + (size_t)row * 16 + 4) = (f32x4){x0[0], x0[1], x0[2], x0[3]}; *(GAS f32x4*)(GLR + (size_t)row * 16 + 8) = (f32x4){x0[4], x0[5], x0[6], x0[7]}; }
                        else if (fq == 2) { *(GAS f32x4*)(GLR + (size_t)row * 16 + 12) = (f32x4){x0[0], x0[1], x0[2], x0[3]}; }
                    }
                    asm volatile("" ::: "memory");
                }
        } else if (pn < 2 || pn == 3) {
            const float sc = (pn == 3) ? 1.0f : 0.125f; const bool rope = !(wc & 1);
#pragma unroll
            for (int ai = 0; ai < 2; ++ai)
#pragma unroll
                for (int m = 0; m < 4; ++m) {
                    const int row = rowb + ai * 128 + m * 16;
#pragma unroll
                    for (int bj = 0; bj < 2; ++bj) { float x[8];
#pragma unroll
                        for (int i = 0; i < 8; ++i) x[i] = acc[ai][bj][m][i >> 2][i & 3];
                        if (rope) rope8(x, ROPE + (size_t)row * 16, fq, lane);
#pragma unroll
                        for (int i = 0; i < 8; ++i) x[i] *= sc;
                        *(GAS u32x4*)(PA + (size_t)row * NPA + 256 * pn + 128 * bj + 32 * wc + 8 * fq) = pack8(x); }
                    asm volatile("" ::: "memory");
                }
        } else {
            const int act = (pn == 8 || pn == 9) ? 1 : (pn >= 10) ? 2 : 0; const float sc = (pn == 4) ? 0.125f : 1.0f;
#pragma unroll
            for (int ai = 0; ai < 2; ++ai)
#pragma unroll
                for (int m = 0; m < 4; ++m) {
                    const int row = rowb + ai * 128 + m * 16;
#pragma unroll
                    for (int bj = 0; bj < 2; ++bj) { float x[8];
#pragma unroll
                        for (int i = 0; i < 8; ++i) { const float v = acc[ai][bj][m][i >> 2][i & 3]; x[i] = (act == 1) ? siluf_(v) : (act == 2) ? gelu_tanh_(v) : v * sc; }
                        *(GAS u32x4*)(PA + (size_t)row * NPA + 256 * pn + 128 * bj + 32 * wc + 8 * fq) = pack8(x); }
                    asm volatile("" ::: "memory");
                }
        }
    }
};
struct EpiG {
    static constexpr bool PERM = true;
    GAS bf16* G;
    __device__ __forceinline__ void operator()(const f32x4 (&acc)[2][2][4][2], const pg8::Unit& u, int wr, int wc, int fr, int fq) const {
        const int rowb = u.pm * 256 + wr * 64 + fr;
#pragma unroll
        for (int ai = 0; ai < 2; ++ai)
#pragma unroll
            for (int m = 0; m < 4; ++m) { const int row = rowb + ai * 128 + m * 16;
#pragma unroll
                for (int bj = 0; bj < 2; ++bj) { float x[8];
#pragma unroll
                    for (int i = 0; i < 8; ++i) x[i] = sigmoidf_(acc[ai][bj][m][i >> 2][i & 3]);
                    u32x4 w; w.x = cvt_pk_bf16(x[0], x[1]); w.y = cvt_pk_bf16(x[2], x[3]); w.z = cvt_pk_bf16(x[4], x[5]); w.w = cvt_pk_bf16(x[6], x[7]);
                    *(GAS u32x4*)(G + (size_t)row * NGT + 256 * u.pn + 128 * bj + 32 * wc + 8 * fq) = w; }
#ifdef EPIG_DRAIN
                asm volatile("s_waitcnt vmcnt(0)" ::: "memory");
#endif
            }
    }
};
struct EpiM {
    static constexpr bool PERM = true;
    const GAS bf16* G; GAS bf16* HM; int br;
    __device__ __forceinline__ void operator()(const f32x4 (&acc)[2][2][4][2], const pg8::Unit& u, int wr, int wc, int fr, int fq) const {
        const int rowb = u.pm * 256 + wr * 64 + fr;
#pragma unroll
        for (int ai = 0; ai < 2; ++ai)
#pragma unroll
            for (int m = 0; m < 4; ++m) { const int row = rowb + ai * 128 + m * 16;
#pragma unroll
                for (int bj = 0; bj < 2; ++bj) { const int col = 256 * u.pn + 128 * bj + 32 * wc + 8 * fq;
                    const u32x4 g = *(const GAS u32x4*)(G + (size_t)row * NGT + 1024 * br + col);
                    float x[8];
                    x[0] = bflo(g.x) * acc[ai][bj][m][0][0]; x[1] = bfhi(g.x) * acc[ai][bj][m][0][1]; x[2] = bflo(g.y) * acc[ai][bj][m][0][2]; x[3] = bfhi(g.y) * acc[ai][bj][m][0][3];
                    x[4] = bflo(g.z) * acc[ai][bj][m][1][0]; x[5] = bfhi(g.z) * acc[ai][bj][m][1][1]; x[6] = bflo(g.w) * acc[ai][bj][m][1][2]; x[7] = bfhi(g.w) * acc[ai][bj][m][1][3];
                    if (br > 0) { const u32x4 o = *(const GAS u32x4*)(HM + (size_t)row * DM + col);
                        x[0] += bflo(o.x); x[1] += bfhi(o.x); x[2] += bflo(o.y); x[3] += bfhi(o.y); x[4] += bflo(o.z); x[5] += bfhi(o.z); x[6] += bflo(o.w); x[7] += bfhi(o.w); }
                    u32x4 w; w.x = cvt_pk_bf16(x[0], x[1]); w.y = cvt_pk_bf16(x[2], x[3]); w.z = cvt_pk_bf16(x[4], x[5]); w.w = cvt_pk_bf16(x[6], x[7]);
                    *(GAS u32x4*)(HM + (size_t)row * DM + col) = w; }
                asm volatile("" ::: "memory"); }
    }
};
struct EpiO {
    static constexpr bool PERM = false;
    GAS float* H;
    __device__ __forceinline__ void operator()(const f32x4 (&acc)[2][2][4][2], const pg8::Unit& u, int wr, int wc, int fr, int fq) const {
        const int rowb = u.pm * 256 + wr * 64 + fr, col0 = u.pn * 256 + wc * 32 + 4 * fq;
#pragma unroll
        for (int ai = 0; ai < 2; ++ai)
#pragma unroll
            for (int m = 0; m < 4; ++m) { GAS float* rp = H + (size_t)(rowb + ai * 128 + m * 16) * DM + col0;
#pragma unroll
                for (int bj = 0; bj < 2; ++bj)
#pragma unroll
                    for (int n = 0; n < 2; ++n) { const f32x4 h = *(const GAS f32x4*)(rp + bj * 128 + n * 16); *(GAS f32x4*)(rp + bj * 128 + n * 16) = h * DN_ALPHA + acc[ai][bj][m][n]; }
                asm volatile("" ::: "memory"); }
    }
};
struct EpiGU {
    static constexpr bool PERM = true;
    GAS bf16* HID; const GAS float* CW;
    __device__ __forceinline__ void operator()(const f32x4 (&acc)[2][2][4][2], const pg8::Unit& u, int wr, int wc, int fr, int fq) const {
        const int rowb = u.pm * 256 + wr * 64 + fr;
#pragma unroll
        for (int ai = 0; ai < 2; ++ai)
#pragma unroll
            for (int m = 0; m < 4; ++m) { const int row = rowb + ai * 128 + m * 16; const float cw = CW[row];
                float x[8];
#pragma unroll
                for (int i = 0; i < 8; ++i) x[i] = siluf_(acc[ai][0][m][i >> 2][i & 3]) * acc[ai][1][m][i >> 2][i & 3] * cw;
                u32x4 w; w.x = cvt_pk_bf16(x[0], x[1]); w.y = cvt_pk_bf16(x[2], x[3]); w.z = cvt_pk_bf16(x[4], x[5]); w.w = cvt_pk_bf16(x[6], x[7]);
                *(GAS u32x4*)(HID + (size_t)row * DEXP + 128 * u.pn + 32 * wc + 8 * fq) = w; }
    }
};
struct EpiDN {
    static constexpr bool PERM = true;
    GAS bf16* FF2;
    __device__ __forceinline__ void operator()(const f32x4 (&acc)[2][2][4][2], const pg8::Unit& u, int wr, int wc, int fr, int fq) const {
        const int rowb = u.pm * 256 + wr * 64 + fr;
#pragma unroll
        for (int ai = 0; ai < 2; ++ai)
#pragma unroll
            for (int m = 0; m < 4; ++m) { const int row = rowb + ai * 128 + m * 16;
#pragma unroll
                for (int bj = 0; bj < 2; ++bj) { u32x4 w; w.x = cvt_pk_bf16(acc[ai][bj][m][0][0], acc[ai][bj][m][0][1]); w.y = cvt_pk_bf16(acc[ai][bj][m][0][2], acc[ai][bj][m][0][3]);
                    w.z = cvt_pk_bf16(acc[ai][bj][m][1][0], acc[ai][bj][m][1][1]); w.w = cvt_pk_bf16(acc[ai][bj][m][1][2], acc[ai][bj][m][1][3]);
                    *(GAS u32x4*)(FF2 + (size_t)row * DM + 256 * u.pn + 128 * bj + 32 * wc + 8 * fq) = w; } }
    }
};
#ifndef EN_B1
#define EN_B1 1
#endif
#ifndef EN_B2
#define EN_B2 1
#endif
#ifndef EN_B3
#define EN_B3 1
#endif

__device__ __forceinline__ void gmlp_unit(Frame& F, int l, int unit) {
    int tid = F.tid; asm volatile("" : "+v"(tid)); const int lane = tid & 63;
    const int chunk = unit >> 2, g = unit & 3, n0 = chunk * 128;
    const GAS bf16* PA = (const GAS bf16*)(F.ws + WS_PA); GAS bf16* Y = (GAS bf16*)(F.ws + WS_Y);
    LAS float* vln = (LAS float*)F.lds;
    LAS float* wl = (LAS float*)(F.lds + 65536);
    LAS float* st = (LAS float*)(F.lds + AUX_OFF);
    const GAS float* lng = ((const GAS float*)F.in[9]) + l * 512; const GAS float* lnb = ((const GAS float*)F.in[10]) + l * 512;
    for (int j = 0; j < 16; ++j) { const int s = F.wave * 16 + j;
        const u32x4 w = *(const GAS u32x4*)(PA + (size_t)(n0 + s) * NPA + PA_CV + 8 * lane);
        float x[8] = {bflo(w.x), bfhi(w.x), bflo(w.y), bfhi(w.y), bflo(w.z), bfhi(w.z), bflo(w.w), bfhi(w.w)};
        float sm = 0.f;
#pragma unroll
        for (int i = 0; i < 8; ++i) sm += x[i];
        const float mean = wave_sum(sm, lane) * (1.f / 512.f); float q = 0.f;
#pragma unroll
        for (int i = 0; i < 8; ++i) { const float d = x[i] - mean; q += d * d; }
        const float rstd = 1.f / sqrtf(wave_sum(q, lane) * (1.f / 512.f) + LN_EPS);
        if (lane == 0) { st[2 * s] = mean; st[2 * s + 1] = rstd; } }
    __syncthreads();
#pragma unroll
    for (int i = 0; i < 4; ++i) { const int q = tid + 512 * i, s = q >> 4, d0 = (q & 15) * 8;
        const u32x4 w = *(const GAS u32x4*)(PA + (size_t)(n0 + s) * NPA + PA_CV + g * 128 + d0);
        const float mean = st[2 * s], rstd = st[2 * s + 1];
        float x[8] = {bflo(w.x), bfhi(w.x), bflo(w.y), bfhi(w.y), bflo(w.z), bfhi(w.z), bflo(w.w), bfhi(w.w)};
#pragma unroll
        for (int k = 0; k < 8; ++k) x[k] = (x[k] - mean) * rstd * lng[g * 128 + d0 + k] + lnb[g * 128 + d0 + k];
        *(LAS f32x4*)(vln + s * 128 + d0) = (f32x4){x[0], x[1], x[2], x[3]}; *(LAS f32x4*)(vln + s * 128 + d0 + 4) = (f32x4){x[4], x[5], x[6], x[7]}; }
    const GAS float* ws = ((const GAS float*)F.in[11]) + ((size_t)l * 4 + g) * 128 * 128;
#pragma unroll
    for (int i = 0; i < 8; ++i) { const int q = tid + 512 * i, t = q >> 5, s0 = (q & 31) * 4;
        f32x4 w = *(const GAS f32x4*)(ws + t * 128 + s0);
        if (s0 + 0 > t) w.x = 0.f; if (s0 + 1 > t) w.y = 0.f; if (s0 + 2 > t) w.z = 0.f; if (s0 + 3 > t) w.w = 0.f;
        *(LAS f32x4*)(wl + t * 128 + s0) = w; }
    __syncthreads();
    const int d = tid & 127, tq = __builtin_amdgcn_readfirstlane(tid >> 7);
    float vr[128];
#pragma unroll
    for (int sb = 0; sb < 4; ++sb)
        if (sb <= tq) {
#pragma unroll
            for (int s = 0; s < 32; ++s) vr[sb * 32 + s] = vln[(sb * 32 + s) * 128 + d];
        } else {
#pragma unroll
            for (int s = 0; s < 32; ++s) vr[sb * 32 + s] = 0.f;
        }
    const GAS float* bs = ((const GAS float*)F.in[12]) + ((size_t)l * 4 + g) * 128;
#pragma unroll 1
    for (int ti = 0; ti < 32; ++ti) { const int t = tq * 32 + ti; float a = 0.f;
#pragma unroll
        for (int sb = 0; sb < 4; ++sb)
            if (sb <= tq) {
#pragma unroll
                for (int s4 = 0; s4 < 8; ++s4) { const f32x4 w = *(const LAS f32x4*)(wl + t * 128 + sb * 32 + s4 * 4);
                    a += w.x * vr[sb * 32 + s4 * 4] + w.y * vr[sb * 32 + s4 * 4 + 1] + w.z * vr[sb * 32 + s4 * 4 + 2] + w.w * vr[sb * 32 + s4 * 4 + 3]; }
            }
        const float uu = bf1(PA[(size_t)(n0 + t) * NPA + PA_CU + g * 128 + d]);
        Y[(size_t)(n0 + t) * 1536 + 1024 + g * 128 + d] = (bf16)f2bf(uu * (a + bs[t])); }
    __syncthreads();
}

__device__ __forceinline__ void gla_unit(Frame& F, int l, int unit) {
    int tid = F.tid; asm volatile("" : "+v"(tid));
    const int b = unit >> 2, h = unit & 3;
    const GAS bf16* PA = (const GAS bf16*)(F.ws + WS_PA); GAS bf16* Y = (GAS bf16*)(F.ws + WS_Y); const GAS float* GLR = (const GAS float*)(F.ws + WS_GLR);
    LAS float* wa = (LAS float*)F.lds;
    LAS float* ba = wa + 1024;
    LAS float* as_ = ba + 64;
    LAS float* qs = as_ + 1024;
    LAS float* ks = qs + 1024;
    LAS float* vs = ks + 1024;
    LAS float* part = vs + 2048;
    for (int i = tid; i < 1024; i += 512) wa[i] = ((const GAS float*)F.in[6])[(size_t)l * 16 * 256 + (i >> 6) * 256 + h * 64 + (i & 63)];
    if (tid < 64) ba[tid] = ((const GAS float*)F.in[7])[l * 256 + h * 64 + tid];
    const GAS float* gng = ((const GAS float*)F.in[8]) + l * 128;
    const int v = tid & 127, kq = __builtin_amdgcn_readfirstlane(tid >> 7);
    float S[16];
#pragma unroll
    for (int j = 0; j < 16; ++j) S[j] = 0.f;
    __syncthreads();
    for (int t0 = 0; t0 < SEQ; t0 += 16) {
        const size_t nb = (size_t)b * SEQ + t0;
#pragma unroll
        for (int i = 0; i < 2; ++i) { const int e = tid + 512 * i, t = e >> 6, k = e & 63; float z = ba[k];
#pragma unroll
            for (int r = 0; r < 16; ++r) z += GLR[(nb + t) * 16 + r] * wa[r * 64 + k];
            const float ls = fminf(z, 0.f) - log1pf(__expf(-fabsf(z)));
            as_[e] = __expf(ls * (1.f / 16.f));
            qs[e] = bf1(PA[(nb + t) * NPA + PA_BQ + h * 64 + k]); ks[e] = bf1(PA[(nb + t) * NPA + PA_BK + h * 64 + k]); }
#pragma unroll
        for (int i = 0; i < 4; ++i) { const int e = tid + 512 * i, t = e >> 7, vv = e & 127; vs[e] = bf1(PA[(nb + t) * NPA + PA_BV + h * 128 + vv]); }
        __syncthreads();
#pragma unroll 4
        for (int t = 0; t < 16; ++t) { const float vt = vs[t * 128 + v]; float p = 0.f;
#pragma unroll
            for (int j4 = 0; j4 < 4; ++j4) { const f32x4 a4 = *(const LAS f32x4*)(as_ + t * 64 + kq * 16 + j4 * 4), k4 = *(const LAS f32x4*)(ks + t * 64 + kq * 16 + j4 * 4), q4 = *(const LAS f32x4*)(qs + t * 64 + kq * 16 + j4 * 4);
#pragma unroll
                for (int j = 0; j < 4; ++j) { S[j4 * 4 + j] = a4[j] * S[j4 * 4 + j] + k4[j] * vt; p += q4[j] * S[j4 * 4 + j]; } }
            part[(kq * 16 + t) * 128 + v] = p; }
        __syncthreads();
        { const int t = tid >> 5, v4 = (tid & 31) * 4;
          f32x4 o = *(const LAS f32x4*)(part + (0 * 16 + t) * 128 + v4);
#pragma unroll
          for (int q = 1; q < 4; ++q) o += *(const LAS f32x4*)(part + (q * 16 + t) * 128 + v4);
          float ss = o.x * o.x + o.y * o.y + o.z * o.z + o.w * o.w;
#pragma unroll
          for (int sh = 1; sh < 32; sh <<= 1) ss += shx(ss, sh, tid & 63);
          const float r = 1.f / sqrtf(ss * (1.f / 128.f) + RMS_EPS);
          const f32x4 gg = *(const GAS f32x4*)(gng + v4);
          const u32x2 brw = *(const GAS u32x2*)(PA + (nb + t) * NPA + PA_BR + h * 128 + v4);
          u32x2 w; w.x = pk2(o.x * r * gg.x * bflo(brw.x), o.y * r * gg.y * bfhi(brw.x)); w.y = pk2(o.z * r * gg.z * bflo(brw.y), o.w * r * gg.w * bfhi(brw.y));
          *(GAS u32x2*)(Y + (nb + t) * 1536 + 512 + h * 128 + v4) = w; }
        __syncthreads();
    }
}

template <int CTRL> __device__ __forceinline__ float dppf(float x) { return __builtin_bit_cast(float, __builtin_amdgcn_mov_dpp(__builtin_bit_cast(int, x), CTRL, 0xf, 0xf, true)); }
typedef short v4i16_t __attribute__((ext_vector_type(4)));
constexpr size_t WS_US = WS_WMOE, WS_DEC = WS_WMOE + 32 * MiB;
__device__ __forceinline__ v4i16_t ldtr(const LAS unsigned char* p) { return __builtin_amdgcn_ds_read_tr16_b64_v4i16((LAS v4i16_t*)p); }
__device__ __forceinline__ bf16x8 cat8(v4i16_t lo, v4i16_t hi) { bf16x8 r; r[0] = lo[0]; r[1] = lo[1]; r[2] = lo[2]; r[3] = lo[3]; r[4] = hi[0]; r[5] = hi[1]; r[6] = hi[2]; r[7] = hi[3]; return r; }
__device__ __forceinline__ void gla_local_unit(Frame& F, int l, int unit) {
    int tid = F.tid; asm volatile("" : "+v"(tid)); const int lane = tid & 63, w = F.wave, fr = lane & 15, fq = lane >> 4;
    const int b = unit >> 8, h = (unit >> 6) & 3, c = unit & 63; const size_t n0 = (size_t)b * SEQ + 64 * c;
    GAS bf16* PA = (GAS bf16*)(F.ws + WS_PA); GAS bf16* Y = (GAS bf16*)(F.ws + WS_Y); const GAS float* GLR = (const GAS float*)(F.ws + WS_GLR);
    GAS bf16* US = (GAS bf16*)(F.ws + WS_US) + (size_t)unit * 8192; GAS float* DEC = (GAS float*)(F.ws + WS_DEC) + unit * 64;
    LAS unsigned char* QT = F.lds; LAS unsigned char* KT = F.lds + 8192; LAS unsigned char* KD = F.lds + 16384; LAS unsigned char* VV = F.lds + 24576; LAS unsigned char* ATT = F.lds + 40960;
    LAS float* SEG = (LAS float*)(F.lds + 65536); LAS float* WA = (LAS float*)(F.lds + 67584); LAS float* BA = (LAS float*)(F.lds + 71680);
#pragma unroll
    for (int i = 0; i < 2; ++i) { const int e = tid + 512 * i; WA[e] = ((const GAS float*)F.in[6])[(size_t)l * 16 * 256 + (e >> 6) * 256 + h * 64 + (e & 63)]; }
    if (tid < 64) BA[tid] = ((const GAS float*)F.in[7])[l * 256 + h * 64 + tid];
#pragma unroll
    for (int i = 0; i < 2; ++i) { const int piece = tid + 512 * i, row = piece >> 4, c16 = piece & 15;
        *(LAS u32x4*)(VV + row * 256 + c16 * 16) = *(const GAS u32x4*)(PA + (n0 + row) * NPA + PA_BV + h * 128 + 8 * c16); }
    __syncthreads();
    const int k = tid & 63, seg = w;
    float cum[8];
    { float run = 0.f;
#pragma unroll
      for (int i = 0; i < 8; ++i) { const int t = 8 * seg + i; float z = BA[k];
          const f32x4 g0 = *(const GAS f32x4*)(GLR + (n0 + t) * 16), g1 = *(const GAS f32x4*)(GLR + (n0 + t) * 16 + 4), g2 = *(const GAS f32x4*)(GLR + (n0 + t) * 16 + 8), g3 = *(const GAS f32x4*)(GLR + (n0 + t) * 16 + 12);
#pragma unroll
          for (int r = 0; r < 4; ++r) { z += g0[r] * WA[r * 64 + k]; z += g1[r] * WA[(4 + r) * 64 + k]; z += g2[r] * WA[(8 + r) * 64 + k]; z += g3[r] * WA[(12 + r) * 64 + k]; }
          const float ls = fminf(z, 0.f) - log1pf(__expf(-fabsf(z)));
          run += ls * (1.f / 16.f); cum[i] = run; }
      SEG[seg * 64 + k] = run; }
    __syncthreads();
    { float off = 0.f, blast = 0.f;
#pragma unroll
      for (int s2 = 0; s2 < 8; ++s2) { const float sv = SEG[s2 * 64 + k]; blast += sv; off += (s2 < seg) ? sv : 0.f; }
#pragma unroll
      for (int i = 0; i < 8; ++i) { const int t = 8 * seg + i; const float bb = cum[i] + off;
          const float qv = bf1(PA[(n0 + t) * NPA + PA_BQ + h * 64 + k]), kv = bf1(PA[(n0 + t) * NPA + PA_BK + h * 64 + k]);
          const unsigned qt = f2bf(qv * __expf(bb));
          ((LAS unsigned short*)QT)[t * 64 + k] = (unsigned short)qt; ((LAS unsigned short*)KT)[t * 64 + k] = (unsigned short)f2bf(kv * __expf(-bb)); ((LAS unsigned short*)KD)[t * 64 + k] = (unsigned short)f2bf(kv * __expf(blast - bb));
          PA[(n0 + t) * NPA + PA_BQ + h * 64 + k] = (bf16)qt; }
      if (seg == 0) DEC[k] = __expf(blast); }
    __syncthreads();
#pragma unroll
    for (int ii = 0; ii < 2; ++ii) { const int id = 2 * w + ii, ts = id >> 2, tt = id & 3;
        f32x4 d = {0.f, 0.f, 0.f, 0.f};
        if (ts <= tt) {
#pragma unroll
            for (int ks = 0; ks < 2; ++ks) { const bf16x8 a = *(const LAS bf16x8*)(KT + (16 * ts + fr) * 128 + (8 * fq + 32 * ks) * 2), bq = *(const LAS bf16x8*)(QT + (16 * tt + fr) * 128 + (8 * fq + 32 * ks) * 2);
                d = __builtin_amdgcn_mfma_f32_16x16x32_bf16(a, bq, d, 0, 0, 0); } }
        const int t = 16 * tt + fr, s0 = 16 * ts + 4 * fq;
        u32x2 pk; pk.x = cvt_pk_bf16((s0 <= t) ? d[0] : 0.f, (s0 + 1 <= t) ? d[1] : 0.f); pk.y = cvt_pk_bf16((s0 + 2 <= t) ? d[2] : 0.f, (s0 + 3 <= t) ? d[3] : 0.f);
        *(LAS u32x2*)(ATT + t * 128 + s0 * 2) = pk; }
    __syncthreads();
    { const int tr = w & 3, nh = w >> 2;
      f32x4 ao[4], au[4];
#pragma unroll
      for (int j = 0; j < 4; ++j) { ao[j] = (f32x4){0.f, 0.f, 0.f, 0.f}; au[j] = (f32x4){0.f, 0.f, 0.f, 0.f}; }
#pragma unroll
      for (int ks = 0; ks < 2; ++ks) {
          const bf16x8 aA = *(const LAS bf16x8*)(ATT + (16 * tr + fr) * 128 + (8 * fq + 32 * ks) * 2);
          const int srow = 32 * ks + 8 * fq + (fr >> 2);
          const bf16x8 aK = cat8(ldtr(KD + srow * 128 + (16 * tr + 4 * (fr & 3)) * 2), ldtr(KD + (srow + 4) * 128 + (16 * tr + 4 * (fr & 3)) * 2));
#pragma unroll
          for (int j = 0; j < 4; ++j) { const int nt = 4 * nh + j;
              const bf16x8 bv = cat8(ldtr(VV + srow * 256 + (16 * nt + 4 * (fr & 3)) * 2), ldtr(VV + (srow + 4) * 256 + (16 * nt + 4 * (fr & 3)) * 2));
              ao[j] = __builtin_amdgcn_mfma_f32_16x16x32_bf16(aA, bv, ao[j], 0, 0, 0);
              au[j] = __builtin_amdgcn_mfma_f32_16x16x32_bf16(aK, bv, au[j], 0, 0, 0); } }
#pragma unroll
      for (int j = 0; j < 4; ++j) { const int v = 16 * (4 * nh + j) + fr;
#pragma unroll
          for (int r = 0; r < 4; ++r) { const int row = 16 * tr + 4 * fq + r;
              Y[(n0 + row) * 1536 + 512 + h * 128 + v] = (bf16)f2bf(ao[j][r]);
              US[row * 128 + v] = (bf16)f2bf(au[j][r]); } } }
    __syncthreads();
}
__device__ __forceinline__ void gla_scan_phase(Frame& F) {
    GAS bf16* USb = (GAS bf16*)(F.ws + WS_US); const GAS float* DECb = (const GAS float*)(F.ws + WS_DEC);
    for (int gt = F.wg * 512 + F.tid; gt < 131072; gt += F.G * 512) { const int e0 = 2 * gt, bh = e0 >> 13, kv = e0 & 8191, k = kv >> 7;
        GAS unsigned* p = (GAS unsigned*)(USb + (size_t)bh * 64 * 8192 + kv); const GAS float* dp = DECb + bh * 64 * 64 + k;
        float s0 = 0.f, s1 = 0.f;
#pragma unroll 8
        for (int c = 0; c < 64; ++c) { const unsigned u = p[(size_t)c * 4096]; const float d = dp[c * 64];
            p[(size_t)c * 4096] = pk2(s0, s1);
            s0 = d * s0 + bflo(u); s1 = d * s1 + bfhi(u); } }
}
__device__ __forceinline__ void gla_out_unit(Frame& F, int l, int unit) {
    int tid = F.tid; asm volatile("" : "+v"(tid)); const int lane = tid & 63, w = F.wave, fr = lane & 15, fq = lane >> 4;
    const int b = unit >> 8, h = (unit >> 6) & 3, c = unit & 63; const size_t n0 = (size_t)b * SEQ + 64 * c;
    const GAS bf16* PA = (const GAS bf16*)(F.ws + WS_PA); GAS bf16* Y = (GAS bf16*)(F.ws + WS_Y);
    const GAS bf16* US = (const GAS bf16*)(F.ws + WS_US) + (size_t)unit * 8192;
    LAS unsigned char* SS = F.lds;
    LAS float* PS = (LAS float*)(F.lds + 16384);
    const GAS float* gng = ((const GAS float*)F.in[8]) + l * 128;
#pragma unroll
    for (int i = 0; i < 2; ++i) { const int piece = tid + 512 * i; *(LAS u32x4*)(SS + piece * 16) = *(const GAS u32x4*)(US + piece * 8); }
    __syncthreads();
    const int tr = w >> 1, nh = w & 1;
    f32x4 acc[4];
#pragma unroll
    for (int j = 0; j < 4; ++j) acc[j] = (f32x4){0.f, 0.f, 0.f, 0.f};
#pragma unroll
    for (int ks = 0; ks < 2; ++ks) {
        const bf16x8 aq = *(const GAS bf16x8*)(PA + (n0 + 16 * tr + fr) * NPA + PA_BQ + h * 64 + 8 * fq + 32 * ks);
        const int krow = 32 * ks + 8 * fq + (fr >> 2);
#pragma unroll
        for (int j = 0; j < 4; ++j) { const int nt = 4 * nh + j;
            const bf16x8 bs = cat8(ldtr(SS + krow * 256 + (16 * nt + 4 * (fr & 3)) * 2), ldtr(SS + (krow + 4) * 256 + (16 * nt + 4 * (fr & 3)) * 2));
            acc[j] = __builtin_amdgcn_mfma_f32_16x16x32_bf16(aq, bs, acc[j], 0, 0, 0); } }
    float ss[4] = {0.f, 0.f, 0.f, 0.f};
#pragma unroll
    for (int j = 0; j < 4; ++j) { const int v = 16 * (4 * nh + j) + fr;
#pragma unroll
        for (int r = 0; r < 4; ++r) { const int row = 16 * tr + 4 * fq + r; acc[j][r] += bf1(Y[(n0 + row) * 1536 + 512 + h * 128 + v]); ss[r] += acc[j][r] * acc[j][r]; } }
#pragma unroll
    for (int r = 0; r < 4; ++r) { float s = ss[r]; s += dppf<0xB1>(s); s += dppf<0x4E>(s); s += shx(s, 4, lane); s += shx(s, 8, lane); ss[r] = s; }
    if (fr == 0) {
#pragma unroll
        for (int r = 0; r < 4; ++r) PS[(16 * tr + 4 * fq + r) * 2 + nh] = ss[r]; }
    __syncthreads();
#pragma unroll
    for (int r = 0; r < 4; ++r) { const int row = 16 * tr + 4 * fq + r; const float rinv = 1.f / sqrtf((PS[row * 2] + PS[row * 2 + 1]) * (1.f / 128.f) + RMS_EPS);
#pragma unroll
        for (int j = 0; j < 4; ++j) { const int v = 16 * (4 * nh + j) + fr;
            const float br = bf1(PA[(n0 + row) * NPA + PA_BR + h * 128 + v]);
            Y[(n0 + row) * 1536 + 512 + h * 128 + v] = (bf16)f2bf(acc[j][r] * rinv * gng[v] * br); } }
    __syncthreads();
}

constexpr int DSA_WAVE_LDS = 17920;
__device__ __forceinline__ void dsa_unit(Frame& F, int unit) {
    int lane = F.lane; asm volatile("" : "+v"(lane)); const int w = F.wave;
    const int qb = 4095 - unit;
    const int b = qb & 7, t = (qb >> 3) * 8 + w;
    const size_t n = (size_t)b * SEQ + t, nb0 = (size_t)b * SEQ;
    const GAS bf16* PA = (const GAS bf16*)(F.ws + WS_PA); GAS bf16* Y = (GAS bf16*)(F.ws + WS_Y);
    const GAS bf16* KI = (const GAS bf16*)(F.ws + WS_KI); const GAS bf16* KA = (const GAS bf16*)(F.ws + WS_KA); const GAS bf16* VA = (const GAS bf16*)(F.ws + WS_VA);
    const GAS float* WI = (const GAS float*)(F.ws + WS_WI);
    LAS unsigned char* base = F.lds + w * DSA_WAVE_LDS;
    LAS unsigned* sc = (LAS unsigned*)base;
    LAS float* qi = (LAS float*)(base + 16384);
    LAS unsigned short* list = (LAS unsigned short*)(base + 16384 + 1024);
    { const u32x2 q2 = *(const GAS u32x2*)(PA + n * NPA + PA_QI + 4 * lane);
      *(LAS f32x4*)(qi + 4 * lane) = (f32x4){bflo(q2.x), bfhi(q2.x), bflo(q2.y), bfhi(q2.y)}; }
    asm volatile("s_waitcnt lgkmcnt(0)" ::: "memory");
    const f32x4 wi = {ld_f32(WI + n * 4), ld_f32(WI + n * 4 + 1), ld_f32(WI + n * 4 + 2), ld_f32(WI + n * 4 + 3)};
    const int nbat = (t >> 6) + 1;
    for (int kb = 0; kb < nbat; ++kb) { const int key = kb * 64 + lane, kc = key <= t ? key : t;
        const GAS u32x4* kp = (const GAS u32x4*)(KI + (nb0 + kc) * 64);
        float kf[64];
#pragma unroll
        for (int c = 0; c < 8; ++c) { const u32x4 kk = kp[c]; kf[8 * c] = bflo(kk.x); kf[8 * c + 1] = bfhi(kk.x); kf[8 * c + 2] = bflo(kk.y); kf[8 * c + 3] = bfhi(kk.y); kf[8 * c + 4] = bflo(kk.z); kf[8 * c + 5] = bfhi(kk.z); kf[8 * c + 6] = bflo(kk.w); kf[8 * c + 7] = bfhi(kk.w); }
        float score = 0.f;
#pragma unroll
        for (int h = 0; h < 4; ++h) { float d = 0.f;
#pragma unroll
            for (int c = 0; c < 16; ++c) { const f32x4 q4 = *(const LAS f32x4*)(qi + h * 64 + 4 * c); d += q4.x * kf[4 * c] + q4.y * kf[4 * c + 1] + q4.z * kf[4 * c + 2] + q4.w * kf[4 * c + 3]; }
            score += wi[h] * fmaxf(d, 0.f); }
        if (score == 0.f) score = 0.f;
        unsigned u = __builtin_bit_cast(unsigned, score); u = (u & 0x80000000u) ? ~u : (u | 0x80000000u);
        sc[key] = key <= t ? u : 0u; }
    asm volatile("s_waitcnt lgkmcnt(0)" ::: "memory");
    int nsel;
    if (t >= 256) {
        unsigned T = 0u;
        for (int bit = 31; bit >= 0; --bit) { const unsigned cand = T | (1u << bit); int cnt = 0;
            for (int j = 0; j < nbat; ++j) cnt += (sc[j * 64 + lane] >= cand) ? 1 : 0;
            if (wave_sum_i(cnt, lane) >= 256) T = cand; }
        int cgt = 0;
        for (int j = 0; j < nbat; ++j) cgt += (sc[j * 64 + lane] > T) ? 1 : 0;
        const int need = 256 - wave_sum_i(cgt, lane);
        int selbase = 0, tiebase = 0;
        for (int j = 0; j < nbat; ++j) { const unsigned x = sc[j * 64 + lane]; const bool eq = (x == T), gt = (x > T);
            const unsigned long long beq = __ballot(eq); const unsigned long long lt = (1ull << lane) - 1ull;
            const int trank = tiebase + __popcll(beq & lt);
            const bool sel = gt || (eq && trank < need);
            const unsigned long long bsel = __ballot(sel);
            if (sel) list[selbase + __popcll(bsel & lt)] = (unsigned short)(j * 64 + lane);
            selbase += __popcll(bsel); tiebase += __popcll(beq); }
        nsel = 256;
    } else {
        nsel = t + 1;
        for (int i = lane; i < 256; i += 64) list[i] = (unsigned short)(i <= t ? i : 0);
    }
    asm volatile("s_waitcnt lgkmcnt(0)" ::: "memory");
    LAS float* qm = (LAS float*)base;
    LAS float* Pl = (LAS float*)(base + 2048);
    { const u32x4 q8 = *(const GAS u32x4*)(PA + n * NPA + PA_Q + 8 * lane);
      *(LAS f32x4*)(qm + 8 * lane) = (f32x4){bflo(q8.x), bfhi(q8.x), bflo(q8.y), bfhi(q8.y)}; *(LAS f32x4*)(qm + 8 * lane + 4) = (f32x4){bflo(q8.z), bfhi(q8.z), bflo(q8.w), bfhi(q8.w)}; }
    asm volatile("s_waitcnt lgkmcnt(0)" ::: "memory");
#pragma unroll 1
    for (int bb = 0; bb < 4; ++bb) { const int i = bb * 64 + lane; const bool valid = i < nsel; const int key = valid ? (int)list[i] : 0;
        const GAS u32x4* kp = (const GAS u32x4*)(KA + (nb0 + key) * 64);
        float kf[64];
#pragma unroll
        for (int c = 0; c < 8; ++c) { const u32x4 kk = kp[c]; kf[8 * c] = bflo(kk.x); kf[8 * c + 1] = bfhi(kk.x); kf[8 * c + 2] = bflo(kk.y); kf[8 * c + 3] = bfhi(kk.y); kf[8 * c + 4] = bflo(kk.z); kf[8 * c + 5] = bfhi(kk.z); kf[8 * c + 6] = bflo(kk.w); kf[8 * c + 7] = bfhi(kk.w); }
        float lgv[8];
#pragma unroll
        for (int h = 0; h < 8; ++h) { float d = 0.f;
#pragma unroll
            for (int c = 0; c < 16; ++c) { const f32x4 q4 = *(const LAS f32x4*)(qm + h * 64 + 4 * c); d += q4.x * kf[4 * c] + q4.y * kf[4 * c + 1] + q4.z * kf[4 * c + 2] + q4.w * kf[4 * c + 3]; }
            lgv[h] = valid ? d : -INFINITY; }
        *(LAS f32x4*)(Pl + i * 8) = (f32x4){lgv[0], lgv[1], lgv[2], lgv[3]}; *(LAS f32x4*)(Pl + i * 8 + 4) = (f32x4){lgv[4], lgv[5], lgv[6], lgv[7]}; }
    asm volatile("s_waitcnt lgkmcnt(0)" ::: "memory");
    float lg[4][8];
#pragma unroll
    for (int bb = 0; bb < 4; ++bb) { const f32x4 a = *(const LAS f32x4*)(Pl + (bb * 64 + lane) * 8), c = *(const LAS f32x4*)(Pl + (bb * 64 + lane) * 8 + 4);
        lg[bb][0] = a.x; lg[bb][1] = a.y; lg[bb][2] = a.z; lg[bb][3] = a.w; lg[bb][4] = c.x; lg[bb][5] = c.y; lg[bb][6] = c.z; lg[bb][7] = c.w; }
    float den[8];
#pragma unroll
    for (int h = 0; h < 8; ++h) { float m = fmaxf(fmaxf(lg[0][h], lg[1][h]), fmaxf(lg[2][h], lg[3][h])); m = wave_max(m, lane); float s = 0.f;
#pragma unroll
        for (int bb = 0; bb < 4; ++bb) { lg[bb][h] = __expf(lg[bb][h] - m); s += lg[bb][h]; }
        den[h] = wave_sum(s, lane); }
#pragma unroll
    for (int bb = 0; bb < 4; ++bb) { const int i = bb * 64 + lane;
        *(LAS f32x4*)(Pl + i * 8) = (f32x4){lg[bb][0], lg[bb][1], lg[bb][2], lg[bb][3]}; *(LAS f32x4*)(Pl + i * 8 + 4) = (f32x4){lg[bb][4], lg[bb][5], lg[bb][6], lg[bb][7]}; }
    asm volatile("s_waitcnt lgkmcnt(0)" ::: "memory");
    float o[8];
#pragma unroll
    for (int h = 0; h < 8; ++h) o[h] = 0.f;
#pragma unroll 4
    for (int i = 0; i < nsel; ++i) { const int key = (int)list[i]; const float vv = bf1(VA[(nb0 + key) * 64 + lane]);
        const f32x4 p0 = *(const LAS f32x4*)(Pl + i * 8), p1 = *(const LAS f32x4*)(Pl + i * 8 + 4);
        o[0] += p0.x * vv; o[1] += p0.y * vv; o[2] += p0.z * vv; o[3] += p0.w * vv; o[4] += p1.x * vv; o[5] += p1.y * vv; o[6] += p1.z * vv; o[7] += p1.w * vv; }
#pragma unroll
    for (int h = 0; h < 8; ++h) Y[n * 1536 + h * 64 + lane] = (bf16)f2bf(o[h] / den[h]);
}

__device__ __forceinline__ bf16x8 scale_pack8(u32x4 raw, float s) {
    u32x4 o; o.x = cvt_pk_bf16(bflo(raw.x) * s, bfhi(raw.x) * s); o.y = cvt_pk_bf16(bflo(raw.y) * s, bfhi(raw.y) * s); o.z = cvt_pk_bf16(bflo(raw.z) * s, bfhi(raw.z) * s); o.w = cvt_pk_bf16(bflo(raw.w) * s, bfhi(raw.w) * s);
    return __builtin_bit_cast(bf16x8, o);
}
__device__ __forceinline__ void dsa16_unit(Frame& F, int unit) {
    int lane = F.lane; asm volatile("" : "+v"(lane)); const int w = F.wave;
    const int qb = 2047 - unit;
    const int b = qb & 7, t0 = (qb >> 3) * 16;
    const size_t nb0 = (size_t)b * SEQ;
    const GAS bf16* PA = (const GAS bf16*)(F.ws + WS_PA); GAS bf16* Y = (GAS bf16*)(F.ws + WS_Y);
    const GAS bf16* KI = (const GAS bf16*)(F.ws + WS_KI); const GAS bf16* KA = (const GAS bf16*)(F.ws + WS_KA); const GAS bf16* VA = (const GAS bf16*)(F.ws + WS_VA);
    const GAS float* WI = (const GAS float*)(F.ws + WS_WI);
    LAS unsigned char* K16 = F.lds;
    LAS unsigned short* LIST = (LAS unsigned short*)(F.lds + AUX_OFF);
    const int fr = lane & 15, fq = lane >> 4;
    {
        const int ql = fr >> 2, h = fr & 3;
        bf16x8 Bf[4][2]; float Linf[4];
#pragma unroll
        for (int g = 0; g < 4; ++g) { const size_t nq = nb0 + t0 + 4 * g + ql; const float wv = WI[nq * 4 + h];
#pragma unroll
            for (int ks = 0; ks < 2; ++ks) Bf[g][ks] = scale_pack8(*(const GAS u32x4*)(PA + nq * NPA + PA_QI + h * 64 + 8 * fq + 32 * ks), wv);
            Linf[g] = (wv >= 0.f) ? INFINITY : -INFINITY; }
        const int ntiles = (t0 >> 4) + 1;
        for (int tile = w; tile < ntiles; tile += 8) {
            const size_t krow = (nb0 + 16 * tile + fr) * 64;
            const bf16x8 A0 = *(const GAS bf16x8*)(KI + krow + 8 * fq), A1 = *(const GAS bf16x8*)(KI + krow + 32 + 8 * fq);
            const int kpos = 16 * tile + 4 * fq + h;
            const int g7 = kpos >> 7, hf = (kpos >> 6) & 1, ln = kpos & 63;
            const int koff = (g7 >> 2) * 1024 + ln * 16 + (g7 & 3) * 4 + hf * 2;
#pragma unroll
            for (int g = 0; g < 4; ++g) {
                f32x4 d = __builtin_amdgcn_mfma_f32_16x16x32_bf16(A0, Bf[g][0], (f32x4){0.f, 0.f, 0.f, 0.f}, 0, 0, 0);
                d = __builtin_amdgcn_mfma_f32_16x16x32_bf16(A1, Bf[g][1], d, 0, 0, 0);
                const float a0 = __builtin_amdgcn_fmed3f(d[0], 0.f, Linf[g]), a1 = __builtin_amdgcn_fmed3f(d[1], 0.f, Linf[g]), a2 = __builtin_amdgcn_fmed3f(d[2], 0.f, Linf[g]), a3 = __builtin_amdgcn_fmed3f(d[3], 0.f, Linf[g]);
                const float u0 = a0 + dppf<0xB1>(a0), u1 = a1 + dppf<0xB1>(a1), u2 = a2 + dppf<0xB1>(a2), u3 = a3 + dppf<0xB1>(a3);
                const float b0 = (h & 1) ? u1 : u0, b1 = (h & 1) ? u3 : u2;
                const float c0 = b0 + dppf<0x4E>(b0), c1 = b1 + dppf<0x4E>(b1);
                float s = (h & 2) ? c1 : c0;
                if (s == 0.f) s = 0.f;
                const _Float16 hh = (_Float16)s; const unsigned hb = (unsigned)__builtin_bit_cast(unsigned short, hh);
                const unsigned key = (hb & 0x8000u) ? (hb ^ 0xffffu) : (hb | 0x8000u);
                const bool valid = kpos <= t0 + 4 * g + ql;
                *(LAS unsigned short*)(K16 + (4 * g + ql) * 8192 + koff) = (unsigned short)(valid ? key : 0u);
            }
        }
    }
    __syncthreads();
#pragma unroll 1
    for (int qq = 0; qq < 2; ++qq) {
        const int q = 2 * w + qq, nvalid = t0 + q + 1;
        LAS unsigned short* list = LIST + q * 256;
        if (nvalid <= 256) {
            for (int i = lane; i < 256; i += 64) list[i] = (unsigned short)(i < nvalid ? i : 0);
        } else {
            const int ngrp = (nvalid + 511) >> 9;
            unsigned v[64];
#pragma unroll
            for (int grp = 0; grp < 8; ++grp) {
                if (grp < ngrp) { const u32x4 r = *(const LAS u32x4*)(K16 + q * 8192 + grp * 1024 + lane * 16);
#pragma unroll
                    for (int i = 0; i < 4; ++i) { const int g = 4 * grp + i; const unsigned rr = r[i]; const int thr = nvalid - 128 * g;
                        v[2 * g] = (lane < thr) ? (rr & 0xffffu) : 0u; v[2 * g + 1] = (lane < thr - 64) ? (rr >> 16) : 0u; }
                } else {
#pragma unroll
                    for (int i = 0; i < 8; ++i) v[8 * grp + i] = 0u;
                }
            }
            unsigned T = 0u;
#pragma unroll 1
            for (int bit = 15; bit >= 0; --bit) { const unsigned cand = T | (1u << bit); int cnt = 0;
#pragma unroll
                for (int grp = 0; grp < 8; ++grp) if (grp < ngrp) {
#pragma unroll
                    for (int i = 0; i < 8; ++i) cnt += (v[8 * grp + i] >= cand) ? 1 : 0; }
                if (wave_sum_i(cnt, lane) >= 256) T = cand; }
            int cgt = 0;
#pragma unroll
            for (int grp = 0; grp < 8; ++grp) if (grp < ngrp) {
#pragma unroll
                for (int i = 0; i < 8; ++i) cgt += (v[8 * grp + i] > T) ? 1 : 0; }
            const int need = 256 - wave_sum_i(cgt, lane);
            int selbase = 0, tiebase = 0; const unsigned long long lt = (1ull << lane) - 1ull;
#pragma unroll
            for (int grp = 0; grp < 8; ++grp) if (grp < ngrp) {
#pragma unroll
                for (int i = 0; i < 8; ++i) { const int j = 8 * grp + i; const unsigned x = v[j]; const bool eq = (x == T), gt = (x > T);
                    const unsigned long long beq = __ballot(eq);
                    const int trank = tiebase + __popcll(beq & lt);
                    const bool sel = gt || (eq && trank < need);
                    const unsigned long long bsel = __ballot(sel);
                    if (sel) list[selbase + __popcll(bsel & lt)] = (unsigned short)(j * 64 + lane);
                    selbase += __popcll(bsel); tiebase += __popcll(beq); } }
        }
    }
    __syncthreads();
    LAS unsigned char* Vs = F.lds + w * 16384;
#pragma unroll 1
    for (int qq = 0; qq < 2; ++qq) {
        const int q = 2 * w + qq, tq = t0 + q; const int nsel = (tq + 1 < 256) ? tq + 1 : 256;
        const size_t nq = nb0 + tq;
        const LAS unsigned short* list = LIST + q * 256;
        bf16x8 Qf[2];
#pragma unroll
        for (int ks = 0; ks < 2; ++ks) { u32x4 raw = {0u, 0u, 0u, 0u}; if (fr < 8) raw = *(const GAS u32x4*)(PA + nq * NPA + PA_Q + fr * 64 + 8 * fq + 32 * ks); Qf[ks] = __builtin_bit_cast(bf16x8, raw); }
        float lg[16][4];
#pragma unroll
        for (int tt = 0; tt < 16; ++tt) { const int pos = 16 * tt + fr; const int key = (pos < nsel) ? (int)list[pos] : 0;
            const size_t krow = (nb0 + key) * 64;
            const bf16x8 A0 = *(const GAS bf16x8*)(KA + krow + 8 * fq), A1 = *(const GAS bf16x8*)(KA + krow + 32 + 8 * fq);
            f32x4 d = __builtin_amdgcn_mfma_f32_16x16x32_bf16(A0, Qf[0], (f32x4){0.f, 0.f, 0.f, 0.f}, 0, 0, 0);
            d = __builtin_amdgcn_mfma_f32_16x16x32_bf16(A1, Qf[1], d, 0, 0, 0);
#pragma unroll
            for (int r = 0; r < 4; ++r) lg[tt][r] = (16 * tt + 4 * fq + r < nsel) ? d[r] : -INFINITY; }
        float m = lg[0][0];
#pragma unroll
        for (int tt = 0; tt < 16; ++tt)
#pragma unroll
            for (int r = 0; r < 4; ++r) m = fmaxf(m, lg[tt][r]);
        m = fmaxf(m, shx(m, 16, lane)); m = fmaxf(m, shx(m, 32, lane));
        float den = 0.f;
#pragma unroll
        for (int tt = 0; tt < 16; ++tt)
#pragma unroll
            for (int r = 0; r < 4; ++r) { lg[tt][r] = __expf(lg[tt][r] - m); den += lg[tt][r]; }
        den += shx(den, 16, lane); den += shx(den, 32, lane);
        f32x4 acc[4];
#pragma unroll
        for (int nt = 0; nt < 4; ++nt) acc[nt] = (f32x4){0.f, 0.f, 0.f, 0.f};
#pragma unroll
        for (int hh = 0; hh < 2; ++hh) {
#pragma unroll
            for (int i = 0; i < 16; ++i) { const int piece = i * 64 + lane, row = piece >> 3, c = piece & 7; const int pos = 128 * hh + row; const int key = (pos < nsel) ? (int)list[pos] : 0;
                const u32x4 vv = *(const GAS u32x4*)(VA + (nb0 + key) * 64 + 8 * c);
                *(LAS u32x4*)(Vs + row * 128 + c * 16) = vv; }
            asm volatile("s_waitcnt lgkmcnt(0)" ::: "memory");
#pragma unroll
            for (int s4 = 0; s4 < 4; ++s4) { const int s = 4 * hh + s4;
                u32x4 pa; pa.x = cvt_pk_bf16(lg[2 * s][0], lg[2 * s][1]); pa.y = cvt_pk_bf16(lg[2 * s][2], lg[2 * s][3]); pa.z = cvt_pk_bf16(lg[2 * s + 1][0], lg[2 * s + 1][1]); pa.w = cvt_pk_bf16(lg[2 * s + 1][2], lg[2 * s + 1][3]);
                const bf16x8 Pa = __builtin_bit_cast(bf16x8, pa);
                const int rowa = 32 * s4 + 4 * fq + (fr >> 2);
#pragma unroll
                for (int nt = 0; nt < 4; ++nt) {
                    const v4i16_t lo = __builtin_amdgcn_ds_read_tr16_b64_v4i16((LAS v4i16_t*)(Vs + rowa * 128 + (16 * nt + 4 * (fr & 3)) * 2));
                    const v4i16_t hi = __builtin_amdgcn_ds_read_tr16_b64_v4i16((LAS v4i16_t*)(Vs + (rowa + 16) * 128 + (16 * nt + 4 * (fr & 3)) * 2));
                    bf16x8 Bv; Bv[0] = lo[0]; Bv[1] = lo[1]; Bv[2] = lo[2]; Bv[3] = lo[3]; Bv[4] = hi[0]; Bv[5] = hi[1]; Bv[6] = hi[2]; Bv[7] = hi[3];
                    acc[nt] = __builtin_amdgcn_mfma_f32_16x16x32_bf16(Pa, Bv, acc[nt], 0, 0, 0); } }
            asm volatile("s_waitcnt lgkmcnt(0)" ::: "memory");
        }
        float dn[4];
#pragma unroll
        for (int r = 0; r < 4; ++r) dn[r] = __builtin_bit_cast(float, __builtin_amdgcn_ds_bpermute((4 * (fq & 1) + r) << 2, __builtin_bit_cast(int, den)));
        if (fq < 2) {
#pragma unroll
            for (int nt = 0; nt < 4; ++nt)
#pragma unroll
                for (int r = 0; r < 4; ++r) Y[nq * 1536 + (4 * fq + r) * 64 + 16 * nt + fr] = (bf16)f2bf(acc[nt][r] / dn[r]);
        }
    }
}

#ifdef GLA_NAIVE
constexpr int NGLA = 32;
#else
constexpr int NGLA = 2048;
#endif
#ifdef DSA_NAIVE
constexpr int NDSA = 4096;
#else
constexpr int NDSA = 2048;
#endif
__device__ __forceinline__ void phase_mixer(Frame& F, int l, int slot = 0, int types = 7) {
    gu32* head = F.ctl + CW_QUEUE + 64 * (l + 2 * slot);
    for (;;) {
        __syncthreads();
        if (F.tid == 0) F.MISC[64] = __hip_atomic_fetch_add(head, 1u, __ATOMIC_RELAXED, __HIP_MEMORY_SCOPE_AGENT);
        __syncthreads();
        const int u = (int)F.MISC[64];
        if (u >= NDSA + NGLA + 1024) break;
        if (u < NDSA) { if (EN_B2 && (types & 2)) {
#ifdef DSA_NAIVE
            dsa_unit(F, u);
#else
            dsa16_unit(F, u);
#endif
        } }
        else if (u < NDSA + NGLA) { if (EN_B1 && (types & 1)) {
#ifdef GLA_NAIVE
            gla_unit(F, l, u - NDSA);
#else
            gla_local_unit(F, l, u - NDSA);
#endif
        } }
        else { if (EN_B3 && (types & 4)) gmlp_unit(F, l, u - NDSA - NGLA); }
    }
}
__device__ __forceinline__ void phase_gla_out(Frame& F, int l) {
#ifndef GLA_NAIVE
    for (int u = F.wg; u < 2048; u += F.G) gla_out_unit(F, l, u);
#endif
}

__device__ __forceinline__ void phase_ln_router(Frame& F, int l) {
    const GAS float* WR = (const GAS float*)(F.ws + WS_WR) + (size_t)l * 36 * DM;
    LAS float* wr = (LAS float*)F.lds;
    for (int i = F.tid; i < 36 * 256; i += 512) ((LAS f32x4*)wr)[i] = ((const GAS f32x4*)WR)[i];
    if (F.tid < 32) F.MISC[16 + F.tid] = 0u;
    __syncthreads();
    GAS bf16* HB = (GAS bf16*)(F.ws + WS_HB); GAS int* EID = (GAS int*)(F.ws + WS_ROUTE); GAS float* EW = (GAS float*)(F.ws + WS_ROUTE + 256 * 1024);
    const GAS float* g = ((const GAS float*)F.in[17]) + l * DM; const GAS float* bb = ((const GAS float*)F.in[18]) + l * DM; const GAS float* brg = ((const GAS float*)F.in[20]) + l * 4; const GAS float* bre = ((const GAS float*)F.in[22]) + l * 32;
    const int lane = F.lane;
    for (int r0 = F.wg * 128; r0 < NTOK; r0 += F.G * 128)
        for (int j = 0; j < 16; ++j) { const int m = r0 + F.wave * 16 + j;
            f32x4 v[4];
#pragma unroll
            for (int q = 0; q < 4; ++q) v[q] = *(const GAS f32x4*)(F.H + (size_t)m * DM + 4 * lane + 256 * q);
            ln_row_regs(v, g, bb, lane);
            store_row_f32_bf16(v, F.H + (size_t)m * DM, HB + (size_t)m * DM, lane);
            float lgt[36];
#pragma unroll
            for (int o = 0; o < 36; ++o) { float p = 0.f;
#pragma unroll
                for (int q = 0; q < 4; ++q) { const f32x4 w4 = *(const LAS f32x4*)(wr + o * DM + 4 * lane + 256 * q); p += v[q].x * w4.x + v[q].y * w4.y + v[q].z * w4.z + v[q].w * w4.w; }
                lgt[o] = wave_sum(p, lane); }
            int gi = 0; float gm = lgt[0] + brg[0];
#pragma unroll
            for (int q = 1; q < 4; ++q) { const float x = lgt[q] + brg[q]; if (x > gm) { gm = x; gi = q; } }
            float gs = 0.f;
#pragma unroll
            for (int q = 0; q < 4; ++q) gs += __expf(lgt[q] + brg[q] - gm);
            const float gp = 1.f / gs;
            float el[8];
#pragma unroll
            for (int q = 0; q < 8; ++q) { float x = lgt[4 + q] + bre[q];
                x = (gi == 1) ? lgt[12 + q] + bre[8 + q] : x; x = (gi == 2) ? lgt[20 + q] + bre[16 + q] : x; x = (gi == 3) ? lgt[28 + q] + bre[24 + q] : x; el[q] = x; }
            int i0 = 0; float v0 = el[0];
#pragma unroll
            for (int q = 1; q < 8; ++q) if (el[q] > v0) { v0 = el[q]; i0 = q; }
            int i1 = -1; float v1 = -INFINITY;
#pragma unroll
            for (int q = 0; q < 8; ++q) if (q != i0 && el[q] > v1) { v1 = el[q]; i1 = q; }
            const float ex = __expf(v1 - v0), w0 = gp / (1.f + ex), w1 = gp * ex / (1.f + ex);
            if (lane == 0) { const int e0 = gi * 8 + i0, e1 = gi * 8 + i1;
                EID[2 * m] = e0; EID[2 * m + 1] = e1; EW[2 * m] = w0; EW[2 * m + 1] = w1;
                __hip_atomic_fetch_add((LAS unsigned*)(F.lds + MISC_OFF) + 16 + e0, 1u, __ATOMIC_RELAXED, __HIP_MEMORY_SCOPE_WORKGROUP);
                __hip_atomic_fetch_add((LAS unsigned*)(F.lds + MISC_OFF) + 16 + e1, 1u, __ATOMIC_RELAXED, __HIP_MEMORY_SCOPE_WORKGROUP); } }
    __syncthreads();
    if (F.tid < 32) ((GAS int*)(F.ws + WS_CNTWG))[F.wg * 32 + F.tid] = (int)F.MISC[16 + F.tid];
}
__device__ __forceinline__ void phase_dispatch(Frame& F) {
    const GAS int* CNT = (const GAS int*)(F.ws + WS_CNTWG); const GAS int* EID = (const GAS int*)(F.ws + WS_ROUTE); const GAS float* EW = (const GAS float*)(F.ws + WS_ROUTE + 256 * 1024);
    GAS int* SROW = (GAS int*)(F.ws + WS_SROW); GAS int* ROWMAP = (GAS int*)(F.ws + WS_ROWMAP); GAS float* CWROW = (GAS float*)(F.ws + WS_CWROW); GAS int* META = (GAS int*)(F.ws + WS_META);
    LAS int* tot = (LAS int*)(F.lds + AUX_OFF);
    if (F.tid < 32) { int t = 0, mine = 0; for (int w = 0; w < F.G; ++w) { const int c = ld_i32(CNT + w * 32 + F.tid); t += c; if (w < F.wg) mine += c; } tot[F.tid] = t; tot[32 + F.tid] = mine; tot[96 + F.tid] = 0; }
    __syncthreads();
    if (F.tid == 0) { int rb = 0;
#pragma clang loop unroll(disable) vectorize(disable)
        for (int e = 0; e < 32; ++e) { tot[64 + e] = rb; rb += ((tot[e] + 255) >> 8) << 8; }
        tot[128] = rb; }
    __syncthreads();
    if (F.wg == 0) { const int nt = tot[128] >> 8; if (F.tid == 0) META[0] = nt;
        if (F.tid < nt) { int e = 0;
#pragma clang loop unroll(disable) vectorize(disable)
            for (int q = 1; q < 32; ++q) if (tot[64 + q] <= F.tid * 256) e = q;
            META[16 + F.tid] = e; } }
    for (int r0 = F.wg * 128; r0 < NTOK; r0 += F.G * 128) {
        if (F.tid < 256) { const int tok = r0 + (F.tid >> 1), slot = F.tid & 1; const int e = EID[2 * tok + slot];
            const int pos = (int)__hip_atomic_fetch_add((LAS unsigned*)&tot[96 + e], 1u, __ATOMIC_RELAXED, __HIP_MEMORY_SCOPE_WORKGROUP);
            const int sr = tot[64 + e] + tot[32 + e] + pos;
            ROWMAP[sr] = tok; CWROW[sr] = EW[2 * tok + slot]; SROW[2 * tok + slot] = sr; } }
    if (F.wg < 32) { const int e = F.wg; const int lo = tot[64 + e] + tot[e], hi = tot[64 + e] + (((tot[e] + 255) >> 8) << 8);
        for (int r = lo + F.tid; r < hi; r += 512) { ROWMAP[r] = 0; CWROW[r] = 0.f; } }
}
__device__ __forceinline__ void phase_ln2(Frame& F, int l) {
    GAS bf16* HB = (GAS bf16*)(F.ws + WS_HB); const GAS int* SROW = (const GAS int*)(F.ws + WS_SROW); const GAS bf16* FF2 = (const GAS bf16*)(F.ws + WS_FF2);
    const GAS float* g = ((const GAS float*)F.in[26]) + l * DM; const GAS float* bb = ((const GAS float*)F.in[27]) + l * DM; int lane = F.lane; asm volatile("" : "+v"(lane));
    const int gw = F.wg * 8 + F.wave, NGW = F.G * 8;
    for (int m = gw; m < NTOK; m += NGW) { const int s0 = ld_i32(SROW + 2 * m), s1 = ld_i32(SROW + 2 * m + 1);
        f32x4 v[4];
#pragma unroll
        for (int q = 0; q < 4; ++q) { const f32x4 h = *(const GAS f32x4*)(F.H + (size_t)m * DM + 4 * lane + 256 * q);
            const u32x2 a = *(const GAS u32x2*)(FF2 + (size_t)s0 * DM + 4 * lane + 256 * q), c = *(const GAS u32x2*)(FF2 + (size_t)s1 * DM + 4 * lane + 256 * q);
            v[q] = h * DN_ALPHA + (f32x4){bflo(a.x) + bflo(c.x), bfhi(a.x) + bfhi(c.x), bflo(a.y) + bflo(c.y), bfhi(a.y) + bfhi(c.y)}; }
        ln_row_regs(v, g, bb, lane);
        store_row_f32_bf16(v, F.H + (size_t)m * DM, HB + (size_t)m * DM, lane); }
}

#ifndef EN_P
#define EN_P 1
#endif
#ifndef EN_A
#define EN_A 1
#endif
#ifndef EN_B
#define EN_B 1
#endif
#ifndef EN_C
#define EN_C 1
#endif
#ifndef EN_D
#define EN_D 1
#endif
#ifndef EN_E
#define EN_E 1
#endif
#ifndef EN_F
#define EN_F 1
#endif
#ifndef EN_G
#define EN_G 1
#endif
#ifndef EN_H
#define EN_H 1
#endif
#ifndef EN_I
#define EN_I 1
#endif
#ifndef EN_J
#define EN_J 1
#endif
constexpr int PPL = 12;
constexpr int N_PHASES = 1 + PPL * DEPTH;
#ifndef MK_ONE_LAUNCH
#define MK_ONE_LAUNCH 0
#endif
struct Args { const float* in[28]; float* out; unsigned char* ws; int ph_lo, ph_hi; };
static_assert(sizeof(Args) == 28 * 8 + 8 + 8 + 8, "no padding bytes in the argument struct");


__device__ __forceinline__ unsigned opaque_u32(unsigned x) { asm volatile("" : "+v"(x)); return (unsigned)__builtin_amdgcn_readfirstlane((int)x); }
__device__ __forceinline__ unsigned long long opaque_u64(unsigned long long x) { return ((unsigned long long)opaque_u32((unsigned)(x >> 32)) << 32) | opaque_u32((unsigned)x); }
__device__ __forceinline__ void launder(Frame& F) {
    F.ws = (GAS unsigned char*)opaque_u64((unsigned long long)F.ws); F.H = (GAS float*)opaque_u64((unsigned long long)F.H);
    F.ctl = (gu32*)opaque_u64((unsigned long long)F.ctl);
    unsigned z0 = 0u; asm volatile("" : "+v"(z0)); int ln = (int)__builtin_amdgcn_mbcnt_hi(~0u, __builtin_amdgcn_mbcnt_lo(~0u, z0));
    F.wave = (int)opaque_u32((unsigned)F.wave); F.lane = ln; F.tid = F.wave * 64 + ln;
    F.G = (int)opaque_u32((unsigned)F.G); F.wg = (int)opaque_u32((unsigned)F.wg);
}
__global__ void __launch_bounds__(512, 2) mk_fwd(Args args) {
    extern __shared__ __attribute__((aligned(16))) unsigned char lds_raw[];
    Frame F;
    F.lds = (LAS unsigned char*)lds_raw;
    F.MISC = (volatile LAS unsigned*)(F.lds + MISC_OFF);
    F.tid = threadIdx.x; F.lane = F.tid & 63; F.wave = __builtin_amdgcn_readfirstlane(F.tid >> 6);
    F.G = gridDim.x; F.wg = blockIdx.x;
    F.in = args.in;
    F.pos = (const GAS int*)args.in[1];
    F.H = (GAS float*)args.out; F.ws = (GAS unsigned char*)args.ws;
    F.ctl = (gu32*)(args.ws + WS_CTL);
    for (int u = F.tid; u < (LDS_BYTES - MISC_OFF) / 4; u += 512) ((LAS unsigned*)(F.lds + MISC_OFF))[u] = 0u;
    __syncthreads();
    const int lo = args.ph_lo, hi = args.ph_hi;
    const bool multi = (hi - lo) > 1;
    XcdBarrier bar; bar.bar = (unsigned*)(F.ctl + CW_BAR); bar.x = 0; bar.st = nullptr;
    if (multi) bar = xcd_barrier_post((unsigned*)(F.ctl + CW_BAR), F.MISC + 8);
#define IN(k) (lo <= (k) && (k) < hi)
#define SEAM(k) do { if (IN(k) && IN((k) + 1)) xcd_barrier(bar); } while (0)

#ifdef DUP_P
    for (int rep = 0; rep < 2; ++rep)
#endif
    if (EN_P && IN(0)) { launder(F); phase_prologue(F); }
    SEAM(0);
#define HB ((GAS bf16*)(F.ws + WS_HB))
#define PA ((GAS bf16*)(F.ws + WS_PA))
#define Y ((GAS bf16*)(F.ws + WS_Y))
    for (int l = 0; l < DEPTH; ++l) {
        const int pb = 1 + PPL * l;
#define wd (F.ws + WS_WDENSE + (size_t)l * WD_LAYER)
#ifdef DUP_A
        for (int rep = 0; rep < 2; ++rep)
#endif
        if (EN_A && IN(pb + 0)) { launder(F);
            DenseSched S; S.init(NTOK / 256, NPA / 256, F.G, F.wg, (const void*)HB, (size_t)256 * DM * 2, (const void*)(wd + WD_WA), (size_t)256 * DM * 2);
            EpiA E{PA, (GAS bf16*)(F.ws + WS_KA), (GAS bf16*)(F.ws + WS_VA), (GAS bf16*)(F.ws + WS_KI), (GAS float*)(F.ws + WS_WI), (GAS float*)(F.ws + WS_GLR), (const GAS float*)(F.ws + WS_ROPE), ((const GAS float*)F.in[5]) + l * 64};
            pg8::gemm_phase<EpiA, DenseSched, false>(F.lds, S, E, DM, DM, F.wave);
        }
        SEAM(pb + 0);
        if (EN_B && IN(pb + 1)) { launder(F); phase_mixer(F, l);
#ifdef DUP_B
            launder(F); phase_mixer(F, l, 1, DUP_B);
#endif
        }
        SEAM(pb + 1);
        if (EN_B && IN(pb + 2)) { launder(F); gla_scan_phase(F); }
        SEAM(pb + 2);
        if (EN_B && IN(pb + 3)) { launder(F); phase_gla_out(F, l); }
        SEAM(pb + 3);
#ifdef DUP_C
        for (int rep = 0; rep < 2; ++rep)
#endif
        if (EN_C && IN(pb + 4)) { launder(F);
            DenseSched S; S.init(NTOK / 256, NGT / 256, F.G, F.wg, (const void*)HB, (size_t)256 * DM * 2, (const void*)(wd + WD_WG), (size_t)256 * DM * 2);
            EpiG E{PA};
            pg8::gemm_phase<EpiG, DenseSched, false>(F.lds, S, E, DM, DM, F.wave);
        }
        SEAM(pb + 4);
#ifdef DUP_D
        for (int rep = 0; rep < 2; ++rep)
#endif
        if (EN_D && IN(pb + 5)) { launder(F);
#pragma unroll 1
            for (int br = 0; br < 3; ++br) {
                DenseSched S; S.init(NTOK / 256, DM / 256, F.G, F.wg, (const void*)(Y + 512 * br), (size_t)256 * 1536 * 2, (const void*)(wd + WD_WBR + (size_t)br * 1024 * 512 * 2), (size_t)256 * 512 * 2);
                EpiM E{PA, HB, br};
                pg8::gemm_phase<EpiM, DenseSched, false>(F.lds, S, E, 512, 1536, F.wave);
            }
        }
        SEAM(pb + 5);
        if (EN_E && IN(pb + 6)) { launder(F);
            DenseSched S; S.init(NTOK / 256, DM / 256, F.G, F.wg, (const void*)HB, (size_t)256 * DM * 2, (const void*)(wd + WD_WOUT), (size_t)256 * DM * 2);
            EpiO E{F.H};
            pg8::gemm_phase<EpiO, DenseSched, false>(F.lds, S, E, DM, DM, F.wave);
        }
        SEAM(pb + 6);
        if (EN_F && IN(pb + 7)) { launder(F); phase_ln_router(F, l); }
        SEAM(pb + 7);
        if (EN_G && IN(pb + 8)) { launder(F);
            { LAS float* scr = (LAS float*)(F.lds + F.wave * 16384); const int gw = F.wg * 8 + F.wave, NGW = F.G * 8;
              for (int it = gw; it < 12288; it += NGW) conv_moe_item(F, l, it, scr);
              __syncthreads(); }
            phase_dispatch(F); }
        SEAM(pb + 8);
#ifdef DUP_H
        for (int rep = 0; rep < 2; ++rep)
#endif
        if (EN_H && IN(pb + 9)) { launder(F);
            const GAS int* META = (const GAS int*)(F.ws + WS_META); const GAS int* ROWMAP = (const GAS int*)(F.ws + WS_ROWMAP);
            const int NT = ld_i32(META), NU = NT * 2;
            LAS int* meta = (LAS int*)(F.lds + AUX_OFF); LAS int* rows = (LAS int*)(F.lds + AUX_OFF + 64);
            for (int i = 0; i * F.G + F.wg < NU && i < 8; ++i) { const int L = i * F.G + F.wg, gt = L >> 1;
                if (F.tid == 0) meta[i] = ld_i32(META + 16 + gt);
                if (F.tid < 256) rows[i * 256 + F.tid] = ROWMAP[gt * 256 + F.tid]; }
            __syncthreads();
            GroupSched S{NU, F.G, F.wg, 2, (const char*)HB, (const char*)(F.ws + WS_WMOE + WM_GU), 0, (size_t)512 * DM * 2, (size_t)256 * DM * 2, meta, rows};
            EpiGU E{(GAS bf16*)(F.ws + WS_HID), (const GAS float*)(F.ws + WS_CWROW)};
            pg8::gemm_phase<EpiGU, GroupSched, true>(F.lds, S, E, DM, DM, F.wave);
        }
        SEAM(pb + 9);
#ifdef DUP_I
        for (int rep = 0; rep < 2; ++rep)
#endif
        if (EN_I && IN(pb + 10)) { launder(F);
            const GAS int* META = (const GAS int*)(F.ws + WS_META);
            const int NT = ld_i32(META), NU = NT * 4;
            LAS int* meta = (LAS int*)(F.lds + AUX_OFF);
            for (int i = 0; i * F.G + F.wg < NU && i < 8; ++i) { const int L = i * F.G + F.wg, gt = L >> 2; if (F.tid == 0) meta[i] = ld_i32(META + 16 + gt); }
            __syncthreads();
            GroupSched S{NU, F.G, F.wg, 4, (const char*)(F.ws + WS_HID), (const char*)(F.ws + WS_WMOE + WM_DN), (size_t)256 * DEXP * 2, (size_t)DM * DEXP * 2, (size_t)256 * DEXP * 2, meta, nullptr};
            EpiDN E{(GAS bf16*)(F.ws + WS_FF2)};
            pg8::gemm_phase<EpiDN, GroupSched, false>(F.lds, S, E, DEXP, DEXP, F.wave);
        }
        SEAM(pb + 10);
        if (EN_J && IN(pb + 11)) { launder(F); phase_ln2(F, l); }
        SEAM(pb + 11);
    }
#undef IN
#undef SEAM
#undef HB
#undef PA
#undef Y
#undef wd
}


#ifdef DUMP_OFF
__global__ void dump_k(const unsigned short* src, float* out) {
    for (size_t i = (size_t)blockIdx.x * blockDim.x + threadIdx.x; i < (size_t)NTOK * 1024; i += (size_t)gridDim.x * blockDim.x) { const size_t n = i >> 10, c = i & 1023; out[i] = __builtin_bit_cast(float, ((unsigned)src[n * DUMP_PITCH + c]) << 16); }
}
#endif
extern "C" void kernel_launch(void* const* d_in, const int* in_sizes, int n_in, void* d_out, int out_size, void* d_ws, size_t ws_size, hipStream_t stream) {
    static int grid = 0;
    if (grid == 0) {
        if (n_in != 28 || out_size != NTOK * DM || ws_size < WS_END) { fprintf(stderr, "kernel_launch: unexpected shapes (n_in %d out %d ws %zu); nothing launched\n", n_in, out_size, ws_size); grid = -1; return; }
        int dev = 0, cus = 0;
        if (hipGetDevice(&dev) != hipSuccess || hipDeviceGetAttribute(&cus, hipDeviceAttributeMultiprocessorCount, dev) != hipSuccess) { grid = -1; return; }
        if (hipFuncSetAttribute((const void*)mk_fwd, hipFuncAttributeMaxDynamicSharedMemorySize, LDS_BYTES) != hipSuccess) { fprintf(stderr, "kernel_launch: hipFuncSetAttribute failed\n"); grid = -1; return; }
        int per_cu = 0;
        if (hipOccupancyMaxActiveBlocksPerMultiprocessor(&per_cu, (const void*)mk_fwd, 512, LDS_BYTES) != hipSuccess || per_cu < 1) { fprintf(stderr, "kernel_launch: occupancy query says %d\n", per_cu); }
        (void)hipGetLastError();
        grid = cus;
        if (grid != 256) fprintf(stderr, "kernel_launch: %d CUs (built for 256)\n", grid);
    }
    if (grid < 0) return;
    if (hipMemsetAsync((char*)d_ws + WS_CTL, 0, CTL_ZERO_BYTES, stream) != hipSuccess) return;
    Args a{};
    for (int i = 0; i < 28; ++i) a.in[i] = (const float*)d_in[i];
    a.out = (float*)d_out; a.ws = (unsigned char*)d_ws;
#if MK_ONE_LAUNCH
    a.ph_lo = 0; a.ph_hi = N_PHASES;
    hipLaunchKernelGGL(mk_fwd, dim3(grid), dim3(512), LDS_BYTES, stream, a);
#else
#ifndef STOP_AFTER
#define STOP_AFTER (N_PHASES - 1)
#endif
#ifndef PHASE_MASK
#define PHASE_MASK 0xffffffffu
#endif
    for (int p = 0; p <= STOP_AFTER; ++p) { if (!((PHASE_MASK >> p) & 1u)) continue; a.ph_lo = p; a.ph_hi = p + 1; hipLaunchKernelGGL(mk_fwd, dim3(grid), dim3(512), LDS_BYTES, stream, a); }
#ifdef DUMP_OFF
    hipLaunchKernelGGL(dump_k, dim3(2048), dim3(256), 0, stream, (const unsigned short*)((const char*)d_ws + (size_t)(DUMP_OFF)), (float*)d_out);
#endif
#endif
}
```

```cpp
#define MK_ONE_LAUNCH 1
#include <hip/hip_runtime.h>
#include <cstdio>
#include <cstdint>

#define LAS __attribute__((address_space(3)))
#define GAS __attribute__((address_space(1)))
typedef unsigned short bf16;
typedef short bf16x8 __attribute__((ext_vector_type(8)));
typedef float f32x4 __attribute__((ext_vector_type(4)));
typedef float f32x2 __attribute__((ext_vector_type(2)));
typedef unsigned u32x4 __attribute__((ext_vector_type(4)));
typedef unsigned u32x2 __attribute__((ext_vector_type(2)));
typedef GAS unsigned gu32;

constexpr int NB = 8, SEQ = 4096, NTOK = NB * SEQ, DM = 1024, NIN = 6612, DEPTH = 2;
constexpr int NPA = 3584;
constexpr int NGT = 3072;
constexpr int NEXP = 32, DEXP = 256;
constexpr int MAXTILES = 288;
constexpr float DN_ALPHA = 1.41421356237309515f;
constexpr float LN_EPS = 1e-5f, RMS_EPS = 1e-6f;
constexpr int PA_Q = 0, PA_QI = 768, PA_BQ = 1024, PA_BK = 1280, PA_BV = 1536, PA_BR = 2048, PA_CU = 2560, PA_CV = 3072;

__device__ __forceinline__ unsigned f2bf(float f) { unsigned u = __builtin_bit_cast(unsigned, f); return (u + 0x7fffu + ((u >> 16) & 1u)) >> 16; }
__device__ __forceinline__ unsigned pk2(float lo, float hi) { return f2bf(lo) | (f2bf(hi) << 16); }
__device__ __forceinline__ float bflo(unsigned w) { return __builtin_bit_cast(float, w << 16); }
__device__ __forceinline__ float bfhi(unsigned w) { return __builtin_bit_cast(float, w & 0xffff0000u); }
__device__ __forceinline__ float bf1(bf16 h) { return __builtin_bit_cast(float, ((unsigned)h) << 16); }
typedef __bf16 bf16x2_t __attribute__((ext_vector_type(2)));
__device__ __forceinline__ unsigned cvt_pk_bf16(float lo, float hi) { const f32x2 v = {lo, hi}; const bf16x2_t b = __builtin_convertvector(v, bf16x2_t); return __builtin_bit_cast(unsigned, b); }
__device__ __forceinline__ float shx(float v, int mask, int lane) { return __builtin_bit_cast(float, __builtin_amdgcn_ds_bpermute((lane ^ mask) << 2, __builtin_bit_cast(int, v))); }
__device__ __forceinline__ int shxi(int v, int mask, int lane) { return __builtin_amdgcn_ds_bpermute((lane ^ mask) << 2, v); }
__device__ __forceinline__ float wave_sum(float v, int lane) {
#pragma unroll
    for (int o = 1; o < 64; o <<= 1) v += shx(v, o, lane);
    return v;
}
__device__ __forceinline__ float wave_max(float v, int lane) {
#pragma unroll
    for (int o = 1; o < 64; o <<= 1) v = fmaxf(v, shx(v, o, lane));
    return v;
}
__device__ __forceinline__ int wave_sum_i(int v, int lane) {
#pragma unroll
    for (int o = 1; o < 64; o <<= 1) v += shxi(v, o, lane);
    return v;
}
__device__ __forceinline__ int ld_i32(const GAS int* p) { return __hip_atomic_load(p, __ATOMIC_RELAXED, __HIP_MEMORY_SCOPE_AGENT); }
__device__ __forceinline__ float ld_f32(const GAS float* p) { return __hip_atomic_load(p, __ATOMIC_RELAXED, __HIP_MEMORY_SCOPE_AGENT); }
__device__ __forceinline__ float sigmoidf_(float x) { return __builtin_amdgcn_rcpf(1.0f + __expf(-x)); }
__device__ __forceinline__ float siluf_(float x) { return x * sigmoidf_(x); }
__device__ __forceinline__ float gelu_tanh_(float x) { const float u = 0.7978845608028654f * (x + 0.044715f * x * x * x); return x * sigmoidf_(2.0f * u); }

namespace pg8 {
constexpr int BM = 256, BK = 64, HALF = 128, HTB = HALF * BK * 2, STAGE_BYTES = 8 * HTB;
__host__ __device__ __forceinline__ int lds_byte(int r, int c) { const int st = (r >> 4) * 2 + (c >> 5), rr = r & 15, cc = c & 31, ob = rr * 64 + cc * 2; return st * 1024 + (ob ^ (((ob >> 9) & 1) << 5)); }
__host__ __device__ __forceinline__ void stage_rc(int b, int& R, int& C) { const int st = b / 1024, sb = b % 1024, swz = sb ^ (((sb >> 9) & 1) << 5); R = (st >> 1) * 16 + swz / 64; C = (st & 1) * 32 + (swz % 64) / 2; }
__host__ __device__ __forceinline__ int perm32(int rho) { const int n = rho >> 4, i = rho & 15; return 8 * (i >> 2) + 4 * n + (i & 3); }

struct Unit { int pm, pn, e, slot; };

template <class Epi, class Sched, bool GATHER>
__device__ __forceinline__ void gemm_phase(LAS unsigned char* lds, const Sched& S, const Epi& E, const int K, const int lda, const int wave) {
    unsigned z0_ = 0u; asm volatile("" : "+v"(z0_)); const int lane_ = (int)__builtin_amdgcn_mbcnt_hi(~0u, __builtin_amdgcn_mbcnt_lo(~0u, z0_));
    const int wid = wave, lane = lane_, tid = wid * 64 + lane, wr = wid >> 2, wc = wid & 3, fr = lane & 15, fq = lane >> 4;
    const int nt = K / BK;
    int Rr[2], Cc[2];
    unsigned voffB[2];
#pragma unroll
    for (int i = 0; i < 2; ++i) { int R, C; stage_rc(tid * 16 + i * 8192, R, C); Rr[i] = R; Cc[i] = C; const int Rb = Epi::PERM ? ((R & ~31) + perm32(R & 31)) : R; voffB[i] = (unsigned)(Rb * K + C) * 2u; }
    const size_t kstep = (size_t)(BK * 2);
    const size_t hstepB = (size_t)HALF * K * 2;
    const unsigned ldsw = (unsigned)wid * 1024u;
    const int aoff = lds_byte(wr * 64 + fr, fq * 8), boff = lds_byte(wc * 32 + fr, fq * 8);
#define PG8_SA(b, h) (((b) * 2 + (h)) * HTB)
#define PG8_SB(b, h) ((4 + (b) * 2 + (h)) * HTB)
#define PG8_STAGE(bufoff, gbase, voff) do { _Pragma("unroll") for (int _i = 0; _i < 2; ++_i) \
        __builtin_amdgcn_global_load_lds((const unsigned*)((const char*)(gbase) + (voff)[_i]), (LAS unsigned*)(lds + (bufoff) + ldsw + _i * 8192), 16, 0, 0); } while (0)
#define PG8_LDA(dst, b, h) do { _Pragma("unroll") for (int m = 0; m < 4; ++m) _Pragma("unroll") for (int k = 0; k < 2; ++k) dst[m][k] = *(const LAS bf16x8*)(lds + PG8_SA(b, h) + aoff + m * 2048 + k * 1024); } while (0)
#define PG8_LDB(dst, b, h) do { _Pragma("unroll") for (int n = 0; n < 2; ++n) _Pragma("unroll") for (int k = 0; k < 2; ++k) dst[n][k] = *(const LAS bf16x8*)(lds + PG8_SB(b, h) + boff + n * 2048 + k * 1024); } while (0)
#define PG8_MMA(ai, bj, At, Bt) do { __builtin_amdgcn_s_setprio(1); _Pragma("unroll") for (int m = 0; m < 4; ++m) _Pragma("unroll") for (int n = 0; n < 2; ++n) _Pragma("unroll") for (int k = 0; k < 2; ++k) \
        acc[ai][bj][m][n] = __builtin_amdgcn_mfma_f32_16x16x32_bf16(Bt[n][k], At[m][k], acc[ai][bj][m][n], 0, 0, 0); __builtin_amdgcn_s_setprio(0); } while (0)
#define PG8_WAIT_V(n) asm volatile("s_waitcnt vmcnt(" #n ")" ::: "memory")
#define PG8_WAIT_L(n) asm volatile("s_waitcnt lgkmcnt(" #n ")" ::: "memory")
#define PG8_BAR do { asm volatile("" ::: "memory"); __builtin_amdgcn_s_barrier(); asm volatile("" ::: "memory"); } while (0)
#define PG8_SCHED __builtin_amdgcn_sched_barrier(0)
    Unit cur, nxt; int ui = 0;
    if (!S.next(0, cur)) return;
    f32x4 acc[2][2][4][2];
#pragma unroll
    for (int a = 0; a < 2; ++a)
#pragma unroll
        for (int b = 0; b < 2; ++b)
#pragma unroll
            for (int m = 0; m < 4; ++m)
#pragma unroll
                for (int n = 0; n < 2; ++n) acc[a][b][m][n] = (f32x4){0.f, 0.f, 0.f, 0.f};
    bf16x8 At[4][2], B0[2][2], B1[2][2];
    unsigned cA0[2], cA1[2], nA0[2], nA1[2];
#pragma unroll
    for (int i = 0; i < 2; ++i) {
        if (GATHER) { cA0[i] = (unsigned)(S.row_of(cur, Rr[i]) * lda + Cc[i]) * 2u; cA1[i] = (unsigned)(S.row_of(cur, HALF + Rr[i]) * lda + Cc[i]) * 2u; }
        else { cA0[i] = (unsigned)(Rr[i] * lda + Cc[i]) * 2u; cA1[i] = (unsigned)((HALF + Rr[i]) * lda + Cc[i]) * 2u; }
        nA0[i] = cA0[i]; nA1[i] = cA1[i];
    }
    const char* cA = S.a_base(cur); const char* cB = S.b_base(cur);
    PG8_STAGE(PG8_SB(0, 0), cB, voffB); PG8_STAGE(PG8_SB(0, 1), cB + hstepB, voffB); PG8_STAGE(PG8_SA(0, 0), cA, cA0); PG8_STAGE(PG8_SA(0, 1), cA, cA1);
    if (wr == 1) PG8_BAR;
    PG8_WAIT_V(2); PG8_BAR;
    PG8_STAGE(PG8_SB(1, 0), cB + kstep, voffB); PG8_STAGE(PG8_SA(1, 0), cA + kstep, cA0); PG8_STAGE(PG8_SB(1, 1), cB + hstepB + kstep, voffB);
    PG8_WAIT_V(6); PG8_BAR;
    for (;;) {
        const bool has_next = S.next(ui + 1, nxt);
        const char* nA = has_next ? S.a_base(nxt) : cA; const char* nB = has_next ? S.b_base(nxt) : cB;
        if (GATHER) {
#pragma unroll
            for (int i = 0; i < 2; ++i) {
                if (has_next) { nA0[i] = (unsigned)(S.row_of(nxt, Rr[i]) * lda + Cc[i]) * 2u; nA1[i] = (unsigned)(S.row_of(nxt, HALF + Rr[i]) * lda + Cc[i]) * 2u; }
                else { nA0[i] = cA0[i]; nA1[i] = cA1[i]; }
            }
        }
#pragma unroll 1
        for (int t = 0; t < nt; t += 2) {
            const bool last = (t == nt - 2);
            const char* a1 = cA + (size_t)(t + 1) * kstep;
            const char* a2 = last ? nA : cA + (size_t)(t + 2) * kstep; const char* b2 = last ? nB : cB + (size_t)(t + 2) * kstep;
            const char* a3 = a2 + kstep; const char* b3 = b2 + kstep;
            unsigned x0[2], x1[2];
#pragma unroll
            for (int i = 0; i < 2; ++i) { x0[i] = (GATHER && last) ? nA0[i] : cA0[i]; x1[i] = (GATHER && last) ? nA1[i] : cA1[i]; }
            PG8_LDB(B0, 0, 0); PG8_LDB(B1, 0, 1); PG8_SCHED; PG8_LDA(At, 0, 0); PG8_STAGE(PG8_SA(1, 1), a1, cA1);
            PG8_WAIT_V(8); PG8_WAIT_L(0); PG8_BAR; PG8_MMA(0, 0, At, B0); PG8_MMA(0, 1, At, B1); PG8_BAR; PG8_SCHED;
            PG8_LDA(At, 0, 1); PG8_STAGE(PG8_SB(0, 0), b2, voffB); PG8_STAGE(PG8_SB(0, 1), b2 + hstepB, voffB); PG8_STAGE(PG8_SA(0, 0), a2, x0);
            PG8_WAIT_V(8); PG8_WAIT_L(0); PG8_BAR; PG8_MMA(1, 0, At, B0); PG8_MMA(1, 1, At, B1); PG8_BAR; PG8_SCHED;
            PG8_LDB(B0, 1, 0); PG8_LDB(B1, 1, 1); PG8_SCHED; PG8_LDA(At, 1, 0); PG8_STAGE(PG8_SA(0, 1), a2, x1);
            PG8_WAIT_V(8); PG8_WAIT_L(0); PG8_BAR; PG8_MMA(0, 0, At, B0); PG8_MMA(0, 1, At, B1); PG8_BAR; PG8_SCHED;
            PG8_LDA(At, 1, 1); PG8_STAGE(PG8_SB(1, 0), b3, voffB); PG8_STAGE(PG8_SB(1, 1), b3 + hstepB, voffB); PG8_STAGE(PG8_SA(1, 0), a3, x0);
            PG8_WAIT_V(8); PG8_WAIT_L(0); PG8_BAR; PG8_MMA(1, 0, At, B0); PG8_MMA(1, 1, At, B1); PG8_BAR; PG8_SCHED;
        }
        if (wr == 0) PG8_BAR;
        E(acc, cur, wr, wc, fr, fq);
        if (!has_next) break;
#pragma unroll
        for (int a = 0; a < 2; ++a)
#pragma unroll
            for (int b = 0; b < 2; ++b)
#pragma unroll
                for (int m = 0; m < 4; ++m)
#pragma unroll
                    for (int n = 0; n < 2; ++n) acc[a][b][m][n] = (f32x4){0.f, 0.f, 0.f, 0.f};
        cur = nxt; cA = nA; cB = nB; ++ui;
#pragma unroll
        for (int i = 0; i < 2; ++i) { cA0[i] = nA0[i]; cA1[i] = nA1[i]; }
        if (wr == 1) PG8_BAR;
    }
    PG8_WAIT_V(0);
    PG8_BAR;
#undef PG8_SA
#undef PG8_SB
#undef PG8_STAGE
#undef PG8_LDA
#undef PG8_LDB
#undef PG8_MMA
#undef PG8_WAIT_V
#undef PG8_WAIT_L
#undef PG8_BAR
#undef PG8_SCHED
}
}

#define XB_TMO      128
#define XB_XCNT(j)  (256  + 64 * (j))
#define XB_XSUB(j)  (1280 + 64 * (j))
#define XB_XGEN(j)  (2304 + 64 * (j))
#define XB_TOP      3328
#define XB_TOPGEN   3392
#define XCD_BAR_WORDS 3456
#define XB_SPIN_CAP (1u << 20)

__device__ __forceinline__ unsigned xb_ld(unsigned* p)              { return __hip_atomic_load(p, __ATOMIC_RELAXED, __HIP_MEMORY_SCOPE_AGENT); }
__device__ __forceinline__ unsigned xb_add(unsigned* p, unsigned v) { return __hip_atomic_fetch_add(p, v, __ATOMIC_RELAXED, __HIP_MEMORY_SCOPE_AGENT); }
__device__ __forceinline__ unsigned xb_xcc_id() { return (unsigned)__builtin_amdgcn_s_getreg((3 << 11) | 20) & 0xFu; }
#define XB_SPIN(cond, bar) do { unsigned _sp = 0; while (cond) { __builtin_amdgcn_s_sleep(1); \
    if ((++_sp & 255u) == 0u) { if (xb_ld(&(bar)[XB_TMO])) break; if (_sp > XB_SPIN_CAP) { atomicAdd(&(bar)[XB_TMO], 1u); break; } } } } while (0)

struct XcdBarrier { unsigned* bar; unsigned x; volatile LAS unsigned* st; };

__device__ __forceinline__ XcdBarrier xcd_barrier_post(unsigned* bar, volatile LAS unsigned* st) {
    XcdBarrier b; b.bar = bar; b.x = xb_xcc_id(); b.st = st;
    if (threadIdx.x == 0) (void)xb_add(&bar[XB_XCNT(b.x)], 1u);
    return b;
}
__device__ __forceinline__ void xcd_barrier_complete(unsigned* bar, unsigned x, unsigned& nloc, unsigned& nx) {
    const unsigned G = gridDim.x * gridDim.y * gridDim.z;
    unsigned sum, cnt, mine, sp = 0u;
    for (;;) {
        sum = 0u; cnt = 0u; mine = 0u;
#pragma unroll
        for (unsigned j = 0; j < 16; ++j) { const unsigned c = xb_ld(&bar[XB_XCNT(j)]); sum += c; cnt += (c > 0u) ? 1u : 0u; mine = (j == x) ? c : mine; }
        if (sum == G) break;
        __builtin_amdgcn_s_sleep(1);
        if ((++sp & 255u) == 0u) { if (xb_ld(&bar[XB_TMO])) break; if (sp > XB_SPIN_CAP) { atomicAdd(&bar[XB_TMO], 1u); break; } }
    }
    nloc = mine > 0u ? mine : 1u; nx = cnt > 0u ? cnt : 1u;
}
__device__ __forceinline__ void xcd_barrier(const XcdBarrier& b) {
    asm volatile("s_waitcnt vmcnt(0)" ::: "memory");
    __syncthreads();
    if (threadIdx.x == 0) {
        unsigned* bar = b.bar;
        __builtin_amdgcn_s_waitcnt(0);
        unsigned nloc = b.st[0], nx = b.st[1];
        if (nloc == 0u) { xcd_barrier_complete(bar, b.x, nloc, nx); b.st[0] = nloc; b.st[1] = nx; }
        const unsigned old = xb_add(&bar[XB_XSUB(b.x)], 1u);
        const unsigned gen = old / nloc;
        if (old + 1u == (gen + 1u) * nloc) {
            __builtin_amdgcn_fence(__ATOMIC_RELEASE, "agent");
            asm volatile("s_waitcnt vmcnt(0)" ::: "memory");
            const unsigned og = xb_add(&bar[XB_TOP], 1u);
            const unsigned tg = og / nx;
            if (og + 1u == (tg + 1u) * nx) xb_add(&bar[XB_TOPGEN], 1u);
            else XB_SPIN(xb_ld(&bar[XB_TOPGEN]) == tg, bar);
            __builtin_amdgcn_fence(__ATOMIC_ACQUIRE, "agent");
            xb_add(&bar[XB_XGEN(b.x)], 1u);
            asm volatile("s_waitcnt vmcnt(0)" ::: "memory");
        } else {
            XB_SPIN(xb_ld(&bar[XB_XGEN(b.x)]) == gen, bar);
            __builtin_amdgcn_fence(__ATOMIC_ACQUIRE, "agent");
            asm volatile("s_waitcnt vmcnt(0)" ::: "memory");
        }
    }
    __syncthreads();
}

constexpr size_t MiB = 1u << 20;
constexpr size_t WS_CTL = 0, CTL_ZERO_BYTES = 1 * MiB;
constexpr size_t WS_ROPE = 1 * MiB;
constexpr size_t WS_WI   = 3 * MiB;
constexpr size_t WS_ROUTE = 3 * MiB + 512 * 1024;
constexpr size_t WS_SROW = 4 * MiB;
constexpr size_t WS_ROWMAP = 4 * MiB + 256 * 1024;
constexpr size_t WS_CWROW = 4 * MiB + 640 * 1024;
constexpr size_t WS_CNTWG = 5 * MiB;
constexpr size_t WS_META = 5 * MiB + 64 * 1024;
constexpr size_t WS_WR = 5 * MiB + 128 * 1024;
constexpr size_t WS_GLR = 6 * MiB;
constexpr size_t WS_WDENSE = 8 * MiB;
constexpr size_t WD_WA = 0, WD_WG = 7 * MiB, WD_WBR = 13 * MiB, WD_WOUT = 16 * MiB, WD_LAYER = 18 * MiB;
constexpr size_t WS_WMOE = 44 * MiB;
constexpr size_t WM_GU = 0, WM_DN = 32 * MiB;
constexpr size_t WS_HB = 92 * MiB;
constexpr size_t WS_PA = 156 * MiB;
constexpr size_t WS_HID = WS_PA;
constexpr size_t WS_FF2 = WS_PA + 40 * MiB;
constexpr size_t WS_Y = 380 * MiB;
constexpr size_t WS_KA = 476 * MiB, WS_VA = 480 * MiB, WS_KI = 484 * MiB;
constexpr size_t WS_END = 512 * MiB;
static_assert(WS_WDENSE + 2 * WD_LAYER <= WS_WMOE && WS_WMOE + 48 * MiB <= WS_HB && WS_HB + 64 * MiB <= WS_PA && WS_PA + 224 * MiB <= WS_Y && WS_Y + 96 * MiB <= WS_KA && WS_KI + 4 * MiB <= WS_END, "ws map");
static_assert(WS_FF2 + (size_t)73728 * 1024 * 2 <= WS_Y, "ff2 fits");
constexpr int CW_BAR = 4096;
constexpr int CW_QUEUE = 16384;

constexpr int RING_BYTES = 131072;
constexpr int AUX_OFF = 131072;
constexpr int MISC_OFF = 147456;
constexpr int LDS_BYTES = 148480;

struct Frame {
    LAS unsigned char* lds;
    volatile LAS unsigned* MISC;
    gu32* ctl;
    int tid, lane, wave, G, wg;
    const float* const* in;
    const GAS int* pos;
    GAS float* H;
    GAS unsigned char* ws;
};

#define LDS_WAIT() asm volatile("s_waitcnt lgkmcnt(0)" ::: "memory")
#define VM_WAIT() asm volatile("s_waitcnt vmcnt(0)" ::: "memory")

__device__ __forceinline__ int pa_src_col(int c) {
    if (c < 512) return c;
    if (c < 768) { const int x = c - 512, half = x >> 7, y = x & 127, grp = y >> 5, d = (y & 31) + 32 * half;
        if (grp == 0) return 512 + d;
        if (grp == 1) return 576 + d;
        if (grp == 2) return 896 + d;
        if (half == 0) { const int z = y - 96; if (z < 4) return 960 + z; if (z < 20) return 1988 + (z - 4); }
        return -1; }
    if (c < 1024) return 640 + (c - 768);
    if (c < 1280) return 964 + (c - 1024);
    if (c < 1536) return 1220 + (c - 1280);
    if (c < 2048) return 1476 + (c - 1536);
    if (c < 2560) return 2004 + (c - 2048);
    return 2516 + (c - 2560);
}
__device__ __forceinline__ void transpose_item(const GAS float* W, int ldw, int K, GAS bf16* WT, int n0, int k0, int sc, LAS float* scr, int lane) {
#pragma unroll 8
    for (int i = 0; i < 32; ++i) { const int kk = 2 * i + (lane >> 5); scr[kk * 33 + (lane & 31)] = (sc >= 0) ? W[(size_t)(k0 + kk) * ldw + sc] : 0.f; }
    LDS_WAIT(); asm volatile("" ::: "memory");
    const int c = lane & 7;
#pragma unroll
    for (int j = 0; j < 4; ++j) { const int n = (lane >> 3) + 8 * j; const LAS float* s = scr + (8 * c) * 33 + n;
        u32x4 o; o.x = pk2(s[0 * 33], s[1 * 33]); o.y = pk2(s[2 * 33], s[3 * 33]); o.z = pk2(s[4 * 33], s[5 * 33]); o.w = pk2(s[6 * 33], s[7 * 33]);
        *(GAS u32x4*)(WT + (size_t)(n0 + n) * K + k0 + 8 * c) = o; }
    LDS_WAIT(); asm volatile("" ::: "memory");
}
__device__ __forceinline__ void conv_dense_item(Frame& F, int l, int it, LAS float* scr) {
    GAS bf16* base = (GAS bf16*)(F.ws + WS_WDENSE + (size_t)l * WD_LAYER);
    const int lane = F.lane;
    if (it < 1792) { const int kb = it / 112, nb = it % 112; const int sc = pa_src_col(32 * nb + (lane & 31));
        transpose_item(((const GAS float*)F.in[4]) + (size_t)l * DM * NIN, NIN, DM, base + WD_WA / 2, 32 * nb, 64 * kb, sc, scr, lane); return; }
    it -= 1792;
    if (it < 1536) { const int kb = it / 96, nb = it % 96; const int sc = 3540 + 32 * nb + (lane & 31);
        transpose_item(((const GAS float*)F.in[4]) + (size_t)l * DM * NIN, NIN, DM, base + WD_WG / 2, 32 * nb, 64 * kb, sc, scr, lane); return; }
    it -= 1536;
    if (it < 768) { const int br = it / 256, r = it % 256, kb = r / 32, nb = r % 32; const int sc = 32 * nb + (lane & 31);
        transpose_item((br == 0 ? ((const GAS float*)F.in[13]) : br == 1 ? ((const GAS float*)F.in[14]) : ((const GAS float*)F.in[15])) + (size_t)l * 512 * DM, DM, 512, base + WD_WBR / 2 + (size_t)br * 1024 * 512, 32 * nb, 64 * kb, sc, scr, lane); return; }
    it -= 768;
    { const int kb = it / 32, nb = it % 32; const int sc = 32 * nb + (lane & 31);
        transpose_item(((const GAS float*)F.in[16]) + (size_t)l * DM * DM, DM, DM, base + WD_WOUT / 2, 32 * nb, 64 * kb, sc, scr, lane); }
}
__device__ __forceinline__ void conv_moe_item(Frame& F, int l, int it, LAS float* scr) {
    const int lane = F.lane; const int e = it / 384; int r = it % 384;
    if (r < 256) { const int sub = r / 64, q = r % 64, ct = sub >> 1, bj = sub & 1, kb = q / 4, nb = q % 4;
        const GAS float* src = (bj ? ((const GAS float*)F.in[24]) : ((const GAS float*)F.in[23])) + (size_t)(l * NEXP + e) * DM * DEXP;
        GAS bf16* dst = (GAS bf16*)(F.ws + WS_WMOE + WM_GU) + (size_t)e * 512 * DM;
        transpose_item(src, DEXP, DM, dst, 256 * ct + 128 * bj + 32 * nb, 64 * kb, 128 * ct + 32 * nb + (lane & 31), scr, lane); return; }
    r -= 256;
    { const int kb = r / 32, nb = r % 32;
        const GAS float* src = ((const GAS float*)F.in[25]) + (size_t)(l * NEXP + e) * DEXP * DM;
        GAS bf16* dst = (GAS bf16*)(F.ws + WS_WMOE + WM_DN) + (size_t)e * DM * DEXP;
        transpose_item(src, DM, DEXP, dst, 32 * nb, 64 * kb, 32 * nb + (lane & 31), scr, lane); }
}

__device__ __forceinline__ void ln_row_regs(f32x4 (&v)[4], const GAS float* g, const GAS float* b, int lane) {
    float s = 0.f;
#pragma unroll
    for (int j = 0; j < 4; ++j) s += (v[j].x + v[j].y) + (v[j].z + v[j].w);
    const float mean = wave_sum(s, lane) * (1.f / DM); float s2 = 0.f;
#pragma unroll
    for (int j = 0; j < 4; ++j) { v[j] = v[j] - mean; s2 += (v[j].x * v[j].x + v[j].y * v[j].y) + (v[j].z * v[j].z + v[j].w * v[j].w); }
    const float rstd = 1.f / sqrtf(wave_sum(s2, lane) * (1.f / DM) + LN_EPS);
#pragma unroll
    for (int j = 0; j < 4; ++j) { const f32x4 gg = *(const GAS f32x4*)(g + 4 * lane + 256 * j), bb = *(const GAS f32x4*)(b + 4 * lane + 256 * j); v[j] = v[j] * rstd * gg + bb; }
}
__device__ __forceinline__ void store_row_f32_bf16(const f32x4 (&v)[4], GAS float* hrow, GAS bf16* brow, int lane) {
#pragma unroll
    for (int j = 0; j < 4; ++j) {
        if (hrow) *(GAS f32x4*)(hrow + 4 * lane + 256 * j) = v[j];
        if (brow) { u32x2 w; w.x = pk2(v[j].x, v[j].y); w.y = pk2(v[j].z, v[j].w); *(GAS u32x2*)(brow + 4 * lane + 256 * j) = w; }
    }
}

__device__ __forceinline__ void phase_prologue(Frame& F) {
    LAS float* scr = (LAS float*)(F.lds + F.wave * 16384);
    const int gw = F.wg * 8 + F.wave, NGW = F.G * 8;
    for (int it = gw; it < 2 * 4608; it += NGW) conv_dense_item(F, it / 4608, it % 4608, scr);
    { GAS float* WR = (GAS float*)(F.ws + WS_WR);
      for (int i = gw * 64 + F.lane; i < DEPTH * 36 * DM; i += NGW * 64) { const int l = i / (36 * DM), r = i % (36 * DM), o = r / DM, k = r % DM;
          WR[i] = (o < 4) ? ((const GAS float*)F.in[19])[(size_t)l * DM * 4 + k * 4 + o] : ((const GAS float*)F.in[21])[(size_t)l * DM * 32 + k * 32 + (o - 4)]; } }
    { GAS float* RT = (GAS float*)(F.ws + WS_ROPE);
      for (int i = gw * 64 + F.lane; i < NTOK * 8; i += NGW * 64) { const int n = i >> 3, j = i & 7;
          const float invf[8] = {1.000000000e+00f, 1.939227432e-01f, 3.760603070e-02f, 7.292664610e-03f, 1.414213562e-03f, 2.742481884e-04f, 5.318295734e-05f, 1.031338525e-05f};
          float inv = invf[0];
#pragma unroll
          for (int q = 1; q < 8; ++q) inv = (j == q) ? invf[q] : inv;
          const float ang = (float)F.pos[n] * inv;
          const double kq = __builtin_rint((double)ang * 0.15915494309189535);
          double r = (double)ang - kq * 6.283185307179586; double csign = 1.0;
          if (r > 1.5707963267948966) { r = 3.141592653589793 - r; csign = -1.0; } else if (r < -1.5707963267948966) { r = -3.141592653589793 - r; csign = -1.0; }
          const double x2 = r * r;
          const double sn = r * (1.0 + x2 * (-1.0 / 6 + x2 * (1.0 / 120 + x2 * (-1.0 / 5040 + x2 * (1.0 / 362880 + x2 * (-1.0 / 39916800 + x2 * (1.0 / 6227020800.0 + x2 * (-1.0 / 1307674368000.0))))))));
          const double cs = 1.0 + x2 * (-0.5 + x2 * (1.0 / 24 + x2 * (-1.0 / 720 + x2 * (1.0 / 40320 + x2 * (-1.0 / 3628800 + x2 * (1.0 / 479001600.0 + x2 * (-1.0 / 87178291200.0 + x2 * (1.0 / 20922789888000.0))))))));
          RT[n * 16 + j] = (float)(csign * cs); RT[n * 16 + 8 + j] = (float)sn; } }
    GAS bf16* HB = (GAS bf16*)(F.ws + WS_HB);
    for (int m = gw; m < NTOK; m += NGW) { f32x4 v[4];
#pragma unroll
        for (int j = 0; j < 4; ++j) v[j] = *(const GAS f32x4*)(((const GAS float*)F.in[0]) + (size_t)m * DM + 4 * F.lane + 256 * j);
        ln_row_regs(v, ((const GAS float*)F.in[2]), ((const GAS float*)F.in[3]), F.lane);
        store_row_f32_bf16(v, F.H + (size_t)m * DM, HB + (size_t)m * DM, F.lane); }
}

struct DenseSched {
    int nM, nN, nwg, G, c; const char* A; const char* B; size_t atile, btile; int nsub = 1; size_t asub = 0, bsub = 0;
    __device__ void init(int nM_, int nN_, int G_, int c_, const void* A_, size_t atile_, const void* B_, size_t btile_) { nM = nM_; nN = nN_; nwg = nM * nN; G = G_; c = c_; A = (const char*)A_; B = (const char*)B_; atile = atile_; btile = btile_; }
    __device__ __forceinline__ bool next(int i, pg8::Unit& u) const {
        const int it = i / nsub, sb = i - it * nsub;
        const long L = (long)it * G + c; if (L >= nwg) return false;
        int wgid = (int)L; { const int q = nwg / 8, r = nwg % 8, xcd = wgid % 8, off = wgid / 8; wgid = (xcd < r ? xcd * (q + 1) : r * (q + 1) + (xcd - r) * q) + off; }
        const int nig = 8 * nN, gid = wgid / nig, fm = gid * 8, gsz = (nM - fm) < 8 ? (nM - fm) : 8;
        u.pm = fm + ((wgid % nig) % gsz); u.pn = (wgid % nig) / gsz; u.e = sb; u.slot = i; return true;
    }
    __device__ __forceinline__ const char* a_base(const pg8::Unit& u) const { return A + (size_t)u.pm * atile + (size_t)u.e * asub; }
    __device__ __forceinline__ const char* b_base(const pg8::Unit& u) const { return B + (size_t)u.pn * btile + (size_t)u.e * bsub; }
    __device__ __forceinline__ int row_of(const pg8::Unit&, int) const { return 0; }
};
struct GroupSched {
    int NU, G, c, ncol; const char* A; const char* B; size_t atile, erows_bytes, btile; const LAS int* meta; const LAS int* rows;
    __device__ __forceinline__ bool next(int i, pg8::Unit& u) const {
        const int L = i * G + c; if (L >= NU) return false;
        u.pm = L / ncol; u.pn = L % ncol; u.slot = i; u.e = meta[i]; return true;
    }
    __device__ __forceinline__ const char* a_base(const pg8::Unit& u) const { return A + (size_t)u.pm * atile; }
    __device__ __forceinline__ const char* b_base(const pg8::Unit& u) const { return B + (size_t)u.e * erows_bytes + (size_t)u.pn * btile; }
    __device__ __forceinline__ int row_of(const pg8::Unit& u, int r) const { return rows[u.slot * 256 + r]; }
};

struct EpiA {
    static constexpr bool PERM = true;
    GAS bf16* PA; GAS bf16* KA; GAS bf16* VA; GAS bf16* KI; GAS float* WI; GAS float* GLR; const GAS float* ROPE; const GAS float* ikg;
    __device__ __forceinline__ static void rope8(float (&x)[8], const GAS float* rt, int fq, int lane) {
        const f32x4 c0 = *(const GAS f32x4*)(rt), c1 = *(const GAS f32x4*)(rt + 4), s0 = *(const GAS f32x4*)(rt + 8), s1 = *(const GAS f32x4*)(rt + 12);
#pragma unroll
        for (int i = 0; i < 8; ++i) { const float p = shx(x[i], 16, lane); const float cc = (i < 4) ? c0[i & 3] : c1[i & 3], ss = (i < 4) ? s0[i & 3] : s1[i & 3];
            const float r = x[i] * cc + ((fq == 0) ? -p : p) * ss; x[i] = (fq < 2) ? r : x[i]; }
    }
    __device__ __forceinline__ static u32x4 pack8(const float (&x)[8]) { u32x4 w; w.x = cvt_pk_bf16(x[0], x[1]); w.y = cvt_pk_bf16(x[2], x[3]); w.z = cvt_pk_bf16(x[4], x[5]); w.w = cvt_pk_bf16(x[6], x[7]); return w; }
    __device__ __forceinline__ void operator()(const f32x4 (&acc)[2][2][4][2], const pg8::Unit& u, int wr, int wc, int fr, int fq) const {
        const int pn = u.pn; const int rowb = u.pm * 256 + wr * 64 + fr; const int lane = fq * 16 + fr;
        if (pn == 2) {
#pragma unroll
            for (int ai = 0; ai < 2; ++ai)
#pragma unroll
                for (int m = 0; m < 4; ++m) {
                    const int row = rowb + ai * 128 + m * 16;
                    float x0[8], x1[8];
#pragma unroll
                    for (int i = 0; i < 8; ++i) { x0[i] = acc[ai][0][m][i >> 2][i & 3]; x1[i] = acc[ai][1][m][i >> 2][i & 3]; }
                    if (wc == 2) {
                        float s = 0.f;
#pragma unroll
                        for (int i = 0; i < 8; ++i) s += x0[i] + x1[i];
                        s += shx(s, 16, lane); s += shx(s, 32, lane);
                        const float mean = s * (1.f / 64.f); float q = 0.f;
#pragma unroll
                        for (int i = 0; i < 8; ++i) { x0[i] -= mean; x1[i] -= mean; q += x0[i] * x0[i] + x1[i] * x1[i]; }
                        q += shx(q, 16, lane); q += shx(q, 32, lane);
                        const float rstd = 1.f / sqrtf(q * (1.f / 64.f) + LN_EPS);
#pragma unroll
                        for (int i = 0; i < 8; ++i) { x0[i] = x0[i] * rstd * ikg[8 * fq + i]; x1[i] = x1[i] * rstd * ikg[32 + 8 * fq + i]; }
                    }
                    if (wc == 0 || wc == 2) rope8(x0, ROPE + (size_t)row * 16, fq, lane);
                    if (wc < 3) {
                        GAS bf16* dst = (wc == 0) ? KA : (wc == 1) ? VA : KI;
                        *(GAS u32x4*)(dst + (size_t)row * 64 + 8 * fq) = pack8(x0); *(GAS u32x4*)(dst + (size_t)row * 64 + 32 + 8 * fq) = pack8(x1);
                    } else {
                        if (fq == 0) { *(GAS f32x4*)(WI + (size_t)row * 4) = (f32x4){x0[0], x0[1], x0[2], x0[3]} * 0.0625f; *(GAS f32x4*)(GLR + (size_t)row * 16) = (f32x4){x0[4], x0[5], x0[6], x0[7]}; }
                        else if (fq == 1) { *(GAS f32x4*)(GLR + (size_t)row * 16 + 4) = (f32x4){x0[0], x0[1], x0[2], x0[3]}; *(GAS f32x4*)(GLR + (size_t)row * 16 + 8) = (f32x4){x0[4], x0[5], x0[6], x0[7]}; }
                        else if (fq == 2) { *(GAS f32x4*)(GLR + (size_t)row * 16 + 12) = (f32x4){x0[0], x0[1], x0[2], x0[3]}; }
                    }
                    asm volatile("" ::: "memory");
                }
        } else if (pn < 2 || pn == 3) {
            const float sc = (pn == 3) ? 1.0f : 0.125f; const bool rope = !(wc & 1);
#pragma unroll
            for (int ai = 0; ai < 2; ++ai)
#pragma unroll
                for (int m = 0; m < 4; ++m) {
                    const int row = rowb + ai * 128 + m * 16;
#pragma unroll
                    for (int bj = 0; bj < 2; ++bj) { float x[8];
#pragma unroll
                        for (int i = 0; i < 8; ++i) x[i] = acc[ai][bj][m][i >> 2][i & 3];
                        if (rope) rope8(x, ROPE + (size_t)row * 16, fq, lane);
#pragma unroll
                        for (int i = 0; i < 8; ++i) x[i] *= sc;
                        *(GAS u32x4*)(PA + (size_t)row * NPA + 256 * pn + 128 * bj + 32 * wc + 8 * fq) = pack8(x); }
                    asm volatile("" ::: "memory");
                }
        } else {
            const int act = (pn == 8 || pn == 9) ? 1 : (pn >= 10) ? 2 : 0; const float sc = (pn == 4) ? 0.125f : 1.0f;
#pragma unroll
            for (int ai = 0; ai < 2; ++ai)
#pragma unroll
                for (int m = 0; m < 4; ++m) {
                    const int row = rowb + ai * 128 + m * 16;
#pragma unroll
                    for (int bj = 0; bj < 2; ++bj) { float x[8];
#pragma unroll
                        for (int i = 0; i < 8; ++i) { const float v = acc[ai][bj][m][i >> 2][i & 3]; x[i] = (act == 1) ? siluf_(v) : (act == 2) ? gelu_tanh_(v) : v * sc; }
                        *(GAS u32x4*)(PA + (size_t)row * NPA + 256 * pn + 128 * bj + 32 * wc + 8 * fq) = pack8(x); }
                    asm volatile("" ::: "memory");
                }
        }
    }
};
struct EpiG {
    static constexpr bool PERM = true;
    GAS bf16* G;
    __device__ __forceinline__ void operator()(const f32x4 (&acc)[2][2][4][2], const pg8::Unit& u, int wr, int wc, int fr, int fq) const {
        const int rowb = u.pm * 256 + wr * 64 + fr;
#pragma unroll
        for (int ai = 0; ai < 2; ++ai)
#pragma unroll
            for (int m = 0; m < 4; ++m) { const int row = rowb + ai * 128 + m * 16;
#pragma unroll
                for (int bj = 0; bj < 2; ++bj) { float x[8];
#pragma unroll
                    for (int i = 0; i < 8; ++i) x[i] = sigmoidf_(acc[ai][bj][m][i >> 2][i & 3]);
                    u32x4 w; w.x = cvt_pk_bf16(x[0], x[1]); w.y = cvt_pk_bf16(x[2], x[3]); w.z = cvt_pk_bf16(x[4], x[5]); w.w = cvt_pk_bf16(x[6], x[7]);
                    *(GAS u32x4*)(G + (size_t)row * NGT + 256 * u.pn + 128 * bj + 32 * wc + 8 * fq) = w; }
#ifdef EPIG_DRAIN
                asm volatile("s_waitcnt vmcnt(0)" ::: "memory");
#endif
            }
    }
};
struct EpiM {
    static constexpr bool PERM = true;
    const GAS bf16* G; GAS bf16* HM;
    __device__ __forceinline__ void operator()(const f32x4 (&acc)[2][2][4][2], const pg8::Unit& u, int wr, int wc, int fr, int fq) const {
        const int rowb = u.pm * 256 + wr * 64 + fr; const int br = u.e;
#pragma unroll
        for (int ai = 0; ai < 2; ++ai)
#pragma unroll
            for (int m = 0; m < 4; ++m) { const int row = rowb + ai * 128 + m * 16;
#pragma unroll
                for (int bj = 0; bj < 2; ++bj) { const int col = 256 * u.pn + 128 * bj + 32 * wc + 8 * fq;
                    const u32x4 g = *(const GAS u32x4*)(G + (size_t)row * NGT + 1024 * br + col);
                    float x[8];
                    x[0] = bflo(g.x) * acc[ai][bj][m][0][0]; x[1] = bfhi(g.x) * acc[ai][bj][m][0][1]; x[2] = bflo(g.y) * acc[ai][bj][m][0][2]; x[3] = bfhi(g.y) * acc[ai][bj][m][0][3];
                    x[4] = bflo(g.z) * acc[ai][bj][m][1][0]; x[5] = bfhi(g.z) * acc[ai][bj][m][1][1]; x[6] = bflo(g.w) * acc[ai][bj][m][1][2]; x[7] = bfhi(g.w) * acc[ai][bj][m][1][3];
                    if (br > 0) { const u32x4 o = *(const GAS u32x4*)(HM + (size_t)row * DM + col);
                        x[0] += bflo(o.x); x[1] += bfhi(o.x); x[2] += bflo(o.y); x[3] += bfhi(o.y); x[4] += bflo(o.z); x[5] += bfhi(o.z); x[6] += bflo(o.w); x[7] += bfhi(o.w); }
                    u32x4 w; w.x = cvt_pk_bf16(x[0], x[1]); w.y = cvt_pk_bf16(x[2], x[3]); w.z = cvt_pk_bf16(x[4], x[5]); w.w = cvt_pk_bf16(x[6], x[7]);
                    *(GAS u32x4*)(HM + (size_t)row * DM + col) = w; }
                asm volatile("" ::: "memory"); }
    }
};
struct EpiO {
    static constexpr bool PERM = false;
    GAS float* H;
    __device__ __forceinline__ void operator()(const f32x4 (&acc)[2][2][4][2], const pg8::Unit& u, int wr, int wc, int fr, int fq) const {
        const int rowb = u.pm * 256 + wr * 64 + fr, col0 = u.pn * 256 + wc * 32 + 4 * fq;
#pragma unroll
        for (int ai = 0; ai < 2; ++ai)
#pragma unroll
            for (int m = 0; m < 4; ++m) { GAS float* rp = H + (size_t)(rowb + ai * 128 + m * 16) * DM + col0;
#pragma unroll
                for (int bj = 0; bj < 2; ++bj)
#pragma unroll
                    for (int n = 0; n < 2; ++n) { const f32x4 h = *(const GAS f32x4*)(rp + bj * 128 + n * 16); *(GAS f32x4*)(rp + bj * 128 + n * 16) = h * DN_ALPHA + acc[ai][bj][m][n]; }
                asm volatile("" ::: "memory"); }
    }
};
struct EpiGU {
    static constexpr bool PERM = true;
    GAS bf16* HID; const GAS float* CW;
    __device__ __forceinline__ void operator()(const f32x4 (&acc)[2][2][4][2], const pg8::Unit& u, int wr, int wc, int fr, int fq) const {
        const int rowb = u.pm * 256 + wr * 64 + fr;
#pragma unroll
        for (int ai = 0; ai < 2; ++ai)
#pragma unroll
            for (int m = 0; m < 4; ++m) { const int row = rowb + ai * 128 + m * 16; const float cw = CW[row];
                float x[8];
#pragma unroll
                for (int i = 0; i < 8; ++i) x[i] = siluf_(acc[ai][0][m][i >> 2][i & 3]) * acc[ai][1][m][i >> 2][i & 3] * cw;
                u32x4 w; w.x = cvt_pk_bf16(x[0], x[1]); w.y = cvt_pk_bf16(x[2], x[3]); w.z = cvt_pk_bf16(x[4], x[5]); w.w = cvt_pk_bf16(x[6], x[7]);
                *(GAS u32x4*)(HID + (size_t)row * DEXP + 128 * u.pn + 32 * wc + 8 * fq) = w; }
    }
};
struct EpiDN {
    static constexpr bool PERM = true;
    GAS bf16* FF2;
    __device__ __forceinline__ void operator()(const f32x4 (&acc)[2][2][4][2], const pg8::Unit& u, int wr, int wc, int fr, int fq) const {
        const int rowb = u.pm * 256 + wr * 64 + fr;
#pragma unroll
        for (int ai = 0; ai < 2; ++ai)
#pragma unroll
            for (int m = 0; m < 4; ++m) { const int row = rowb + ai * 128 + m * 16;
#pragma unroll
                for (int bj = 0; bj < 2; ++bj) { u32x4 w; w.x = cvt_pk_bf16(acc[ai][bj][m][0][0], acc[ai][bj][m][0][1]); w.y = cvt_pk_bf16(acc[ai][bj][m][0][2], acc[ai][bj][m][0][3]);
                    w.z = cvt_pk_bf16(acc[ai][bj][m][1][0], acc[ai][bj][m][1][1]); w.w = cvt_pk_bf16(acc[ai][bj][m][1][2], acc[ai][bj][m][1][3]);
                    *(GAS u32x4*)(FF2 + (size_t)row * DM + 256 * u.pn + 128 * bj + 32 * wc + 8 * fq) = w; } }
    }
};
#ifndef EN_B1
#define EN_B1 1
#endif
#ifndef EN_B2
#define EN_B2 1
#endif
#ifndef EN_B3
#define EN_B3 1
#endif

template <int CTRL> __device__ __forceinline__ float dppf(float x) { return __builtin_bit_cast(float, __builtin_amdgcn_mov_dpp(__builtin_bit_cast(int, x), CTRL, 0xf, 0xf, true)); }
template <int CTRL> __device__ __forceinline__ int dppi(int x) { return __builtin_amdgcn_mov_dpp(x, CTRL, 0xf, 0xf, true); }
typedef short v4i16_t __attribute__((ext_vector_type(4)));
__device__ __forceinline__ v4i16_t ldtr(const LAS unsigned char* p) { return __builtin_amdgcn_ds_read_tr16_b64_v4i16((LAS v4i16_t*)p); }
__device__ __forceinline__ bf16x8 cat8(v4i16_t lo, v4i16_t hi) { bf16x8 r; r[0] = lo[0]; r[1] = lo[1]; r[2] = lo[2]; r[3] = lo[3]; r[4] = hi[0]; r[5] = hi[1]; r[6] = hi[2]; r[7] = hi[3]; return r; }
__device__ __forceinline__ int wave_total_i(int v) {
    v += dppi<0xB1>(v); v += dppi<0x4E>(v); v += dppi<0x141>(v); v += dppi<0x140>(v);
    return __builtin_amdgcn_readlane(v, 0) + __builtin_amdgcn_readlane(v, 16) + __builtin_amdgcn_readlane(v, 32) + __builtin_amdgcn_readlane(v, 48);
}
__device__ __forceinline__ void gmlp_unit(Frame& F, int l, int unit) {
    int tid = F.tid; asm volatile("" : "+v"(tid)); const int lane = tid & 63;
    const int chunk = unit >> 2, g = unit & 3, n0 = chunk * 128;
    const GAS bf16* PA = (const GAS bf16*)(F.ws + WS_PA); GAS bf16* Y = (GAS bf16*)(F.ws + WS_Y);
    LAS float* vln = (LAS float*)F.lds;
    LAS float* wl = (LAS float*)(F.lds + 65536);
    LAS float* st = (LAS float*)(F.lds + AUX_OFF);
    const GAS float* lng = ((const GAS float*)F.in[9]) + l * 512; const GAS float* lnb = ((const GAS float*)F.in[10]) + l * 512;
    for (int j = 0; j < 16; ++j) { const int s = F.wave * 16 + j;
        const u32x4 w = *(const GAS u32x4*)(PA + (size_t)(n0 + s) * NPA + PA_CV + 8 * lane);
        float x[8] = {bflo(w.x), bfhi(w.x), bflo(w.y), bfhi(w.y), bflo(w.z), bfhi(w.z), bflo(w.w), bfhi(w.w)};
        float sm = 0.f;
#pragma unroll
        for (int i = 0; i < 8; ++i) sm += x[i];
        const float mean = wave_sum(sm, lane) * (1.f / 512.f); float q = 0.f;
#pragma unroll
        for (int i = 0; i < 8; ++i) { const float d = x[i] - mean; q += d * d; }
        const float rstd = 1.f / sqrtf(wave_sum(q, lane) * (1.f / 512.f) + LN_EPS);
        if (lane == 0) { st[2 * s] = mean; st[2 * s + 1] = rstd; } }
    __syncthreads();
#pragma unroll
    for (int i = 0; i < 4; ++i) { const int q = tid + 512 * i, s = q >> 4, d0 = (q & 15) * 8;
        const u32x4 w = *(const GAS u32x4*)(PA + (size_t)(n0 + s) * NPA + PA_CV + g * 128 + d0);
        const float mean = st[2 * s], rstd = st[2 * s + 1];
        float x[8] = {bflo(w.x), bfhi(w.x), bflo(w.y), bfhi(w.y), bflo(w.z), bfhi(w.z), bflo(w.w), bfhi(w.w)};
#pragma unroll
        for (int k = 0; k < 8; ++k) x[k] = (x[k] - mean) * rstd * lng[g * 128 + d0 + k] + lnb[g * 128 + d0 + k];
        *(LAS f32x4*)(vln + s * 128 + d0) = (f32x4){x[0], x[1], x[2], x[3]}; *(LAS f32x4*)(vln + s * 128 + d0 + 4) = (f32x4){x[4], x[5], x[6], x[7]}; }
    const GAS float* ws = ((const GAS float*)F.in[11]) + ((size_t)l * 4 + g) * 128 * 128;
#pragma unroll
    for (int i = 0; i < 8; ++i) { const int q = tid + 512 * i, t = q >> 5, s0 = (q & 31) * 4;
        f32x4 w = *(const GAS f32x4*)(ws + t * 128 + s0);
        if (s0 + 0 > t) w.x = 0.f; if (s0 + 1 > t) w.y = 0.f; if (s0 + 2 > t) w.z = 0.f; if (s0 + 3 > t) w.w = 0.f;
        *(LAS f32x4*)(wl + t * 128 + s0) = w; }
    __syncthreads();
    const int d = tid & 127, tq = __builtin_amdgcn_readfirstlane(tid >> 7);
    float vr[128];
#pragma unroll
    for (int sb = 0; sb < 4; ++sb)
        if (sb <= tq) {
#pragma unroll
            for (int s = 0; s < 32; ++s) vr[sb * 32 + s] = vln[(sb * 32 + s) * 128 + d];
        } else {
#pragma unroll
            for (int s = 0; s < 32; ++s) vr[sb * 32 + s] = 0.f;
        }
    const GAS float* bs = ((const GAS float*)F.in[12]) + ((size_t)l * 4 + g) * 128;
#pragma unroll 1
    for (int ti = 0; ti < 32; ++ti) { const int t = tq * 32 + ti; float a = 0.f;
#pragma unroll
        for (int sb = 0; sb < 4; ++sb)
            if (sb <= tq) {
#pragma unroll
                for (int s4 = 0; s4 < 8; ++s4) { const f32x4 w = *(const LAS f32x4*)(wl + t * 128 + sb * 32 + s4 * 4);
                    a += w.x * vr[sb * 32 + s4 * 4] + w.y * vr[sb * 32 + s4 * 4 + 1] + w.z * vr[sb * 32 + s4 * 4 + 2] + w.w * vr[sb * 32 + s4 * 4 + 3]; }
            }
        const float uu = bf1(PA[(size_t)(n0 + t) * NPA + PA_CU + g * 128 + d]);
        Y[(size_t)(n0 + t) * 1536 + 1024 + g * 128 + d] = (bf16)f2bf(uu * (a + bs[t])); }
    __syncthreads();
}

__device__ __forceinline__ void gmlp16_unit(Frame& F, int l, int chunk) {
    int tid = F.tid; asm volatile("" : "+v"(tid)); const int lane = tid & 63, w = F.wave, fr = lane & 15, fq = lane >> 4;
    const size_t n0 = (size_t)chunk * 128;
    const GAS bf16* PA = (const GAS bf16*)(F.ws + WS_PA); GAS bf16* Y = (GAS bf16*)(F.ws + WS_Y);
    LAS unsigned char* VT = F.lds;
    LAS unsigned char* WT = F.lds + 32768;
    LAS float* st = (LAS float*)(F.lds + AUX_OFF);
    const GAS float* lng = ((const GAS float*)F.in[9]) + l * 512; const GAS float* lnb = ((const GAS float*)F.in[10]) + l * 512;
    for (int j = 0; j < 16; ++j) { const int s = w * 16 + j;
        const u32x4 x4 = *(const GAS u32x4*)(PA + (n0 + s) * NPA + PA_CV + 8 * lane);
        float x[8] = {bflo(x4.x), bfhi(x4.x), bflo(x4.y), bfhi(x4.y), bflo(x4.z), bfhi(x4.z), bflo(x4.w), bfhi(x4.w)};
        float sm = 0.f;
#pragma unroll
        for (int i = 0; i < 8; ++i) sm += x[i];
        const float mean = wave_sum(sm, lane) * (1.f / 512.f); float q = 0.f;
#pragma unroll
        for (int i = 0; i < 8; ++i) { const float d = x[i] - mean; q += d * d; }
        const float rstd = 1.f / sqrtf(wave_sum(q, lane) * (1.f / 512.f) + LN_EPS);
        if (lane == 0) { st[2 * s] = mean; st[2 * s + 1] = rstd; } }
    __syncthreads();
#pragma unroll 1
    for (int g = 0; g < 4; ++g) {
        const GAS float* ws = ((const GAS float*)F.in[11]) + ((size_t)l * 4 + g) * 128 * 128;
#pragma unroll
        for (int i = 0; i < 4; ++i) { const int q = tid + 512 * i, s = q >> 4, d0 = (q & 15) * 8;
            const u32x4 x4 = *(const GAS u32x4*)(PA + (n0 + s) * NPA + PA_CV + g * 128 + d0);
            const float mean = st[2 * s], rstd = st[2 * s + 1];
            float x[8] = {bflo(x4.x), bfhi(x4.x), bflo(x4.y), bfhi(x4.y), bflo(x4.z), bfhi(x4.z), bflo(x4.w), bfhi(x4.w)};
            const f32x4 g0 = *(const GAS f32x4*)(lng + g * 128 + d0), g1 = *(const GAS f32x4*)(lng + g * 128 + d0 + 4), b0 = *(const GAS f32x4*)(lnb + g * 128 + d0), b1 = *(const GAS f32x4*)(lnb + g * 128 + d0 + 4);
#pragma unroll
            for (int k = 0; k < 8; ++k) x[k] = (x[k] - mean) * rstd * ((k < 4) ? g0[k & 3] : g1[k & 3]) + ((k < 4) ? b0[k & 3] : b1[k & 3]);
            u32x4 o; o.x = cvt_pk_bf16(x[0], x[1]); o.y = cvt_pk_bf16(x[2], x[3]); o.z = cvt_pk_bf16(x[4], x[5]); o.w = cvt_pk_bf16(x[6], x[7]);
            *(LAS u32x4*)(VT + s * 256 + d0 * 2) = o;
            const int t = s, s0 = d0;
            f32x4 w0 = *(const GAS f32x4*)(ws + t * 128 + s0), w1 = *(const GAS f32x4*)(ws + t * 128 + s0 + 4);
            float wv[8] = {w0.x, w0.y, w0.z, w0.w, w1.x, w1.y, w1.z, w1.w};
#pragma unroll
            for (int k = 0; k < 8; ++k) wv[k] = (s0 + k <= t) ? wv[k] : 0.f;
            u32x4 ow; ow.x = cvt_pk_bf16(wv[0], wv[1]); ow.y = cvt_pk_bf16(wv[2], wv[3]); ow.z = cvt_pk_bf16(wv[4], wv[5]); ow.w = cvt_pk_bf16(wv[6], wv[7]);
            *(LAS u32x4*)(WT + t * 256 + s0 * 2) = ow; }
        __syncthreads();
        f32x4 acc[8];
#pragma unroll
        for (int nt = 0; nt < 8; ++nt) acc[nt] = (f32x4){0.f, 0.f, 0.f, 0.f};
        const int nks = (16 * w + 15) / 32 + 1;
#pragma unroll
        for (int ks = 0; ks < 4; ++ks) if (ks < nks) {
            const bf16x8 a = *(const LAS bf16x8*)(WT + (16 * w + fr) * 256 + (8 * fq + 32 * ks) * 2);
            const int srow = 32 * ks + 8 * fq + (fr >> 2);
#pragma unroll
            for (int nt = 0; nt < 8; ++nt) { const bf16x8 bv = cat8(ldtr(VT + srow * 256 + (16 * nt + 4 * (fr & 3)) * 2), ldtr(VT + (srow + 4) * 256 + (16 * nt + 4 * (fr & 3)) * 2));
                acc[nt] = __builtin_amdgcn_mfma_f32_16x16x32_bf16(a, bv, acc[nt], 0, 0, 0); } }
        const GAS float* bs = ((const GAS float*)F.in[12]) + ((size_t)l * 4 + g) * 128;
#pragma unroll
        for (int r = 0; r < 4; ++r) { const int t = 16 * w + 4 * fq + r; const float bt = bs[t];
#pragma unroll
            for (int nt = 0; nt < 8; ++nt) { const int d = 16 * nt + fr;
                const float uu = bf1(PA[(n0 + t) * NPA + PA_CU + g * 128 + d]);
                Y[(n0 + t) * 1536 + 1024 + g * 128 + d] = (bf16)f2bf(uu * (acc[nt][r] + bt)); } }
        __syncthreads();
    }
}

__device__ __forceinline__ void gla_unit(Frame& F, int l, int unit) {
    int tid = F.tid; asm volatile("" : "+v"(tid));
    const int b = unit >> 2, h = unit & 3;
    const GAS bf16* PA = (const GAS bf16*)(F.ws + WS_PA); GAS bf16* Y = (GAS bf16*)(F.ws + WS_Y); const GAS float* GLR = (const GAS float*)(F.ws + WS_GLR);
    LAS float* wa = (LAS float*)F.lds;
    LAS float* ba = wa + 1024;
    LAS float* as_ = ba + 64;
    LAS float* qs = as_ + 1024;
    LAS float* ks = qs + 1024;
    LAS float* vs = ks + 1024;
    LAS float* part = vs + 2048;
    for (int i = tid; i < 1024; i += 512) wa[i] = ((const GAS float*)F.in[6])[(size_t)l * 16 * 256 + (i >> 6) * 256 + h * 64 + (i & 63)];
    if (tid < 64) ba[tid] = ((const GAS float*)F.in[7])[l * 256 + h * 64 + tid];
    const GAS float* gng = ((const GAS float*)F.in[8]) + l * 128;
    const int v = tid & 127, kq = __builtin_amdgcn_readfirstlane(tid >> 7);
    float S[16];
#pragma unroll
    for (int j = 0; j < 16; ++j) S[j] = 0.f;
    __syncthreads();
    for (int t0 = 0; t0 < SEQ; t0 += 16) {
        const size_t nb = (size_t)b * SEQ + t0;
#pragma unroll
        for (int i = 0; i < 2; ++i) { const int e = tid + 512 * i, t = e >> 6, k = e & 63; float z = ba[k];
#pragma unroll
            for (int r = 0; r < 16; ++r) z += GLR[(nb + t) * 16 + r] * wa[r * 64 + k];
            const float ls = fminf(z, 0.f) - log1pf(__expf(-fabsf(z)));
            as_[e] = __expf(ls * (1.f / 16.f));
            qs[e] = bf1(PA[(nb + t) * NPA + PA_BQ + h * 64 + k]); ks[e] = bf1(PA[(nb + t) * NPA + PA_BK + h * 64 + k]); }
#pragma unroll
        for (int i = 0; i < 4; ++i) { const int e = tid + 512 * i, t = e >> 7, vv = e & 127; vs[e] = bf1(PA[(nb + t) * NPA + PA_BV + h * 128 + vv]); }
        __syncthreads();
#pragma unroll 4
        for (int t = 0; t < 16; ++t) { const float vt = vs[t * 128 + v]; float p = 0.f;
#pragma unroll
            for (int j4 = 0; j4 < 4; ++j4) { const f32x4 a4 = *(const LAS f32x4*)(as_ + t * 64 + kq * 16 + j4 * 4), k4 = *(const LAS f32x4*)(ks + t * 64 + kq * 16 + j4 * 4), q4 = *(const LAS f32x4*)(qs + t * 64 + kq * 16 + j4 * 4);
#pragma unroll
                for (int j = 0; j < 4; ++j) { S[j4 * 4 + j] = a4[j] * S[j4 * 4 + j] + k4[j] * vt; p += q4[j] * S[j4 * 4 + j]; } }
            part[(kq * 16 + t) * 128 + v] = p; }
        __syncthreads();
        { const int t = tid >> 5, v4 = (tid & 31) * 4;
          f32x4 o = *(const LAS f32x4*)(part + (0 * 16 + t) * 128 + v4);
#pragma unroll
          for (int q = 1; q < 4; ++q) o += *(const LAS f32x4*)(part + (q * 16 + t) * 128 + v4);
          float ss = o.x * o.x + o.y * o.y + o.z * o.z + o.w * o.w;
#pragma unroll
          for (int sh = 1; sh < 32; sh <<= 1) ss += shx(ss, sh, tid & 63);
          const float r = 1.f / sqrtf(ss * (1.f / 128.f) + RMS_EPS);
          const f32x4 gg = *(const GAS f32x4*)(gng + v4);
          const u32x2 brw = *(const GAS u32x2*)(PA + (nb + t) * NPA + PA_BR + h * 128 + v4);
          u32x2 w; w.x = pk2(o.x * r * gg.x * bflo(brw.x), o.y * r * gg.y * bfhi(brw.x)); w.y = pk2(o.z * r * gg.z * bflo(brw.y), o.w * r * gg.w * bfhi(brw.y));
          *(GAS u32x2*)(Y + (nb + t) * 1536 + 512 + h * 128 + v4) = w; }
        __syncthreads();
    }
}

constexpr size_t WS_US = WS_WMOE, WS_DEC = WS_WMOE + 32 * MiB;
__device__ __forceinline__ void gla_local_unit(Frame& F, int l, int unit) {
    int tid = F.tid; asm volatile("" : "+v"(tid)); const int lane = tid & 63, w = F.wave, fr = lane & 15, fq = lane >> 4;
    const int b = unit >> 8, h = (unit >> 6) & 3, c = unit & 63; const size_t n0 = (size_t)b * SEQ + 64 * c;
    GAS bf16* PA = (GAS bf16*)(F.ws + WS_PA); GAS bf16* Y = (GAS bf16*)(F.ws + WS_Y); const GAS float* GLR = (const GAS float*)(F.ws + WS_GLR);
    GAS bf16* US = (GAS bf16*)(F.ws + WS_US) + (size_t)unit * 8192; GAS float* DEC = (GAS float*)(F.ws + WS_DEC) + unit * 64;
    LAS unsigned char* QT = F.lds; LAS unsigned char* KT = F.lds + 8192; LAS unsigned char* KD = F.lds + 16384; LAS unsigned char* VV = F.lds + 24576; LAS unsigned char* ATT = F.lds + 40960;
    LAS float* SEG = (LAS float*)(F.lds + 65536); LAS float* WA = (LAS float*)(F.lds + 67584); LAS float* BA = (LAS float*)(F.lds + 71680);
#pragma unroll
    for (int i = 0; i < 2; ++i) { const int e = tid + 512 * i; WA[e] = ((const GAS float*)F.in[6])[(size_t)l * 16 * 256 + (e >> 6) * 256 + h * 64 + (e & 63)]; }
    if (tid < 64) BA[tid] = ((const GAS float*)F.in[7])[l * 256 + h * 64 + tid];
#pragma unroll
    for (int i = 0; i < 2; ++i) { const int piece = tid + 512 * i, row = piece >> 4, c16 = piece & 15;
        *(LAS u32x4*)(VV + row * 256 + c16 * 16) = *(const GAS u32x4*)(PA + (n0 + row) * NPA + PA_BV + h * 128 + 8 * c16); }
    __syncthreads();
    const int k = tid & 63, seg = w;
    float cum[8];
    { float run = 0.f;
#pragma unroll
      for (int i = 0; i < 8; ++i) { const int t = 8 * seg + i; float z = BA[k];
          const f32x4 g0 = *(const GAS f32x4*)(GLR + (n0 + t) * 16), g1 = *(const GAS f32x4*)(GLR + (n0 + t) * 16 + 4), g2 = *(const GAS f32x4*)(GLR + (n0 + t) * 16 + 8), g3 = *(const GAS f32x4*)(GLR + (n0 + t) * 16 + 12);
#pragma unroll
          for (int r = 0; r < 4; ++r) { z += g0[r] * WA[r * 64 + k]; z += g1[r] * WA[(4 + r) * 64 + k]; z += g2[r] * WA[(8 + r) * 64 + k]; z += g3[r] * WA[(12 + r) * 64 + k]; }
          const float ls = fminf(z, 0.f) - log1pf(__expf(-fabsf(z)));
          run += ls * (1.f / 16.f); cum[i] = run; }
      SEG[seg * 64 + k] = run; }
    __syncthreads();
    { float off = 0.f, blast = 0.f;
#pragma unroll
      for (int s2 = 0; s2 < 8; ++s2) { const float sv = SEG[s2 * 64 + k]; blast += sv; off += (s2 < seg) ? sv : 0.f; }
#pragma unroll
      for (int i = 0; i < 8; ++i) { const int t = 8 * seg + i; const float bb = cum[i] + off;
          const float qv = bf1(PA[(n0 + t) * NPA + PA_BQ + h * 64 + k]), kv = bf1(PA[(n0 + t) * NPA + PA_BK + h * 64 + k]);
          const unsigned qt = f2bf(qv * __expf(bb));
          ((LAS unsigned short*)QT)[t * 64 + k] = (unsigned short)qt; ((LAS unsigned short*)KT)[t * 64 + k] = (unsigned short)f2bf(kv * __expf(-bb)); ((LAS unsigned short*)KD)[t * 64 + k] = (unsigned short)f2bf(kv * __expf(blast - bb));
          PA[(n0 + t) * NPA + PA_BQ + h * 64 + k] = (bf16)qt; }
      if (seg == 0) DEC[k] = __expf(blast); }
    __syncthreads();
#pragma unroll
    for (int ii = 0; ii < 2; ++ii) { const int id = 2 * w + ii, ts = id >> 2, tt = id & 3;
        f32x4 d = {0.f, 0.f, 0.f, 0.f};
        if (ts <= tt) {
#pragma unroll
            for (int ks = 0; ks < 2; ++ks) { const bf16x8 a = *(const LAS bf16x8*)(KT + (16 * ts + fr) * 128 + (8 * fq + 32 * ks) * 2), bq = *(const LAS bf16x8*)(QT + (16 * tt + fr) * 128 + (8 * fq + 32 * ks) * 2);
                d = __builtin_amdgcn_mfma_f32_16x16x32_bf16(a, bq, d, 0, 0, 0); } }
        const int t = 16 * tt + fr, s0 = 16 * ts + 4 * fq;
        u32x2 pk; pk.x = cvt_pk_bf16((s0 <= t) ? d[0] : 0.f, (s0 + 1 <= t) ? d[1] : 0.f); pk.y = cvt_pk_bf16((s0 + 2 <= t) ? d[2] : 0.f, (s0 + 3 <= t) ? d[3] : 0.f);
        *(LAS u32x2*)(ATT + t * 128 + s0 * 2) = pk; }
    __syncthreads();
    { const int tr = w & 3, nh = w >> 2;
      f32x4 ao[4], au[4];
#pragma unroll
      for (int j = 0; j < 4; ++j) { ao[j] = (f32x4){0.f, 0.f, 0.f, 0.f}; au[j] = (f32x4){0.f, 0.f, 0.f, 0.f}; }
#pragma unroll
      for (int ks = 0; ks < 2; ++ks) {
          const bf16x8 aA = *(const LAS bf16x8*)(ATT + (16 * tr + fr) * 128 + (8 * fq + 32 * ks) * 2);
          const int srow = 32 * ks + 8 * fq + (fr >> 2);
          const bf16x8 aK = cat8(ldtr(KD + srow * 128 + (16 * tr + 4 * (fr & 3)) * 2), ldtr(KD + (srow + 4) * 128 + (16 * tr + 4 * (fr & 3)) * 2));
#pragma unroll
          for (int j = 0; j < 4; ++j) { const int nt = 4 * nh + j;
              const bf16x8 bv = cat8(ldtr(VV + srow * 256 + (16 * nt + 4 * (fr & 3)) * 2), ldtr(VV + (srow + 4) * 256 + (16 * nt + 4 * (fr & 3)) * 2));
              ao[j] = __builtin_amdgcn_mfma_f32_16x16x32_bf16(aA, bv, ao[j], 0, 0, 0);
              au[j] = __builtin_amdgcn_mfma_f32_16x16x32_bf16(aK, bv, au[j], 0, 0, 0); } }
#pragma unroll
      for (int j = 0; j < 4; ++j) { const int v = 16 * (4 * nh + j) + fr;
#pragma unroll
          for (int r = 0; r < 4; ++r) { const int row = 16 * tr + 4 * fq + r;
              Y[(n0 + row) * 1536 + 512 + h * 128 + v] = (bf16)f2bf(ao[j][r]);
              US[row * 128 + v] = (bf16)f2bf(au[j][r]); } } }
    __syncthreads();
}
__device__ __forceinline__ void gla_scan_phase(Frame& F) {
    GAS bf16* USb = (GAS bf16*)(F.ws + WS_US); const GAS float* DECb = (const GAS float*)(F.ws + WS_DEC);
    for (int gt = F.wg * 512 + F.tid; gt < 131072; gt += F.G * 512) { const int e0 = 2 * gt, bh = e0 >> 13, kv = e0 & 8191, k = kv >> 7;
        GAS unsigned* p = (GAS unsigned*)(USb + (size_t)bh * 64 * 8192 + kv); const GAS float* dp = DECb + bh * 64 * 64 + k;
        float s0 = 0.f, s1 = 0.f;
#pragma unroll 8
        for (int c = 0; c < 64; ++c) { const unsigned u = p[(size_t)c * 4096]; const float d = dp[c * 64];
            p[(size_t)c * 4096] = pk2(s0, s1);
            s0 = d * s0 + bflo(u); s1 = d * s1 + bfhi(u); } }
}
__device__ __forceinline__ void gla_out_unit(Frame& F, int l, int unit) {
    int tid = F.tid; asm volatile("" : "+v"(tid)); const int lane = tid & 63, w = F.wave, fr = lane & 15, fq = lane >> 4;
    const int b = unit >> 8, h = (unit >> 6) & 3, c = unit & 63; const size_t n0 = (size_t)b * SEQ + 64 * c;
    const GAS bf16* PA = (const GAS bf16*)(F.ws + WS_PA); GAS bf16* Y = (GAS bf16*)(F.ws + WS_Y);
    const GAS bf16* US = (const GAS bf16*)(F.ws + WS_US) + (size_t)unit * 8192;
    LAS unsigned char* SS = F.lds;
    LAS float* PS = (LAS float*)(F.lds + 16384);
    const GAS float* gng = ((const GAS float*)F.in[8]) + l * 128;
#pragma unroll
    for (int i = 0; i < 2; ++i) { const int piece = tid + 512 * i; *(LAS u32x4*)(SS + piece * 16) = *(const GAS u32x4*)(US + piece * 8); }
    __syncthreads();
    const int tr = w >> 1, nh = w & 1;
    f32x4 acc[4];
#pragma unroll
    for (int j = 0; j < 4; ++j) acc[j] = (f32x4){0.f, 0.f, 0.f, 0.f};
#pragma unroll
    for (int ks = 0; ks < 2; ++ks) {
        const bf16x8 aq = *(const GAS bf16x8*)(PA + (n0 + 16 * tr + fr) * NPA + PA_BQ + h * 64 + 8 * fq + 32 * ks);
        const int krow = 32 * ks + 8 * fq + (fr >> 2);
#pragma unroll
        for (int j = 0; j < 4; ++j) { const int nt = 4 * nh + j;
            const bf16x8 bs = cat8(ldtr(SS + krow * 256 + (16 * nt + 4 * (fr & 3)) * 2), ldtr(SS + (krow + 4) * 256 + (16 * nt + 4 * (fr & 3)) * 2));
            acc[j] = __builtin_amdgcn_mfma_f32_16x16x32_bf16(aq, bs, acc[j], 0, 0, 0); } }
    float ss[4] = {0.f, 0.f, 0.f, 0.f};
#pragma unroll
    for (int j = 0; j < 4; ++j) { const int v = 16 * (4 * nh + j) + fr;
#pragma unroll
        for (int r = 0; r < 4; ++r) { const int row = 16 * tr + 4 * fq + r; acc[j][r] += bf1(Y[(n0 + row) * 1536 + 512 + h * 128 + v]); ss[r] += acc[j][r] * acc[j][r]; } }
#pragma unroll
    for (int r = 0; r < 4; ++r) { float s = ss[r]; s += dppf<0xB1>(s); s += dppf<0x4E>(s); s += shx(s, 4, lane); s += shx(s, 8, lane); ss[r] = s; }
    if (fr == 0) {
#pragma unroll
        for (int r = 0; r < 4; ++r) PS[(16 * tr + 4 * fq + r) * 2 + nh] = ss[r]; }
    __syncthreads();
#pragma unroll
    for (int r = 0; r < 4; ++r) { const int row = 16 * tr + 4 * fq + r; const float rinv = 1.f / sqrtf((PS[row * 2] + PS[row * 2 + 1]) * (1.f / 128.f) + RMS_EPS);
#pragma unroll
        for (int j = 0; j < 4; ++j) { const int v = 16 * (4 * nh + j) + fr;
            const float br = bf1(PA[(n0 + row) * NPA + PA_BR + h * 128 + v]);
            Y[(n0 + row) * 1536 + 512 + h * 128 + v] = (bf16)f2bf(acc[j][r] * rinv * gng[v] * br); } }
    __syncthreads();
}

constexpr int DSA_WAVE_LDS = 17920;
__device__ __forceinline__ void dsa_unit(Frame& F, int unit) {
    int lane = F.lane; asm volatile("" : "+v"(lane)); const int w = F.wave;
    const int qb = 4095 - unit;
    const int b = qb & 7, t = (qb >> 3) * 8 + w;
    const size_t n = (size_t)b * SEQ + t, nb0 = (size_t)b * SEQ;
    const GAS bf16* PA = (const GAS bf16*)(F.ws + WS_PA); GAS bf16* Y = (GAS bf16*)(F.ws + WS_Y);
    const GAS bf16* KI = (const GAS bf16*)(F.ws + WS_KI); const GAS bf16* KA = (const GAS bf16*)(F.ws + WS_KA); const GAS bf16* VA = (const GAS bf16*)(F.ws + WS_VA);
    const GAS float* WI = (const GAS float*)(F.ws + WS_WI);
    LAS unsigned char* base = F.lds + w * DSA_WAVE_LDS;
    LAS unsigned* sc = (LAS unsigned*)base;
    LAS float* qi = (LAS float*)(base + 16384);
    LAS unsigned short* list = (LAS unsigned short*)(base + 16384 + 1024);
    { const u32x2 q2 = *(const GAS u32x2*)(PA + n * NPA + PA_QI + 4 * lane);
      *(LAS f32x4*)(qi + 4 * lane) = (f32x4){bflo(q2.x), bfhi(q2.x), bflo(q2.y), bfhi(q2.y)}; }
    asm volatile("s_waitcnt lgkmcnt(0)" ::: "memory");
    const f32x4 wi = {ld_f32(WI + n * 4), ld_f32(WI + n * 4 + 1), ld_f32(WI + n * 4 + 2), ld_f32(WI + n * 4 + 3)};
    const int nbat = (t >> 6) + 1;
    for (int kb = 0; kb < nbat; ++kb) { const int key = kb * 64 + lane, kc = key <= t ? key : t;
        const GAS u32x4* kp = (const GAS u32x4*)(KI + (nb0 + kc) * 64);
        float kf[64];
#pragma unroll
        for (int c = 0; c < 8; ++c) { const u32x4 kk = kp[c]; kf[8 * c] = bflo(kk.x); kf[8 * c + 1] = bfhi(kk.x); kf[8 * c + 2] = bflo(kk.y); kf[8 * c + 3] = bfhi(kk.y); kf[8 * c + 4] = bflo(kk.z); kf[8 * c + 5] = bfhi(kk.z); kf[8 * c + 6] = bflo(kk.w); kf[8 * c + 7] = bfhi(kk.w); }
        float score = 0.f;
#pragma unroll
        for (int h = 0; h < 4; ++h) { float d = 0.f;
#pragma unroll
            for (int c = 0; c < 16; ++c) { const f32x4 q4 = *(const LAS f32x4*)(qi + h * 64 + 4 * c); d += q4.x * kf[4 * c] + q4.y * kf[4 * c + 1] + q4.z * kf[4 * c + 2] + q4.w * kf[4 * c + 3]; }
            score += wi[h] * fmaxf(d, 0.f); }
        if (score == 0.f) score = 0.f;
        unsigned u = __builtin_bit_cast(unsigned, score); u = (u & 0x80000000u) ? ~u : (u | 0x80000000u);
        sc[key] = key <= t ? u : 0u; }
    asm volatile("s_waitcnt lgkmcnt(0)" ::: "memory");
    int nsel;
    if (t >= 256) {
        unsigned T = 0u;
        for (int bit = 31; bit >= 0; --bit) { const unsigned cand = T | (1u << bit); int cnt = 0;
            for (int j = 0; j < nbat; ++j) cnt += (sc[j * 64 + lane] >= cand) ? 1 : 0;
            if (wave_sum_i(cnt, lane) >= 256) T = cand; }
        int cgt = 0;
        for (int j = 0; j < nbat; ++j) cgt += (sc[j * 64 + lane] > T) ? 1 : 0;
        const int need = 256 - wave_sum_i(cgt, lane);
        int selbase = 0, tiebase = 0;
        for (int j = 0; j < nbat; ++j) { const unsigned x = sc[j * 64 + lane]; const bool eq = (x == T), gt = (x > T);
            const unsigned long long beq = __ballot(eq); const unsigned long long lt = (1ull << lane) - 1ull;
            const int trank = tiebase + __popcll(beq & lt);
            const bool sel = gt || (eq && trank < need);
            const unsigned long long bsel = __ballot(sel);
            if (sel) list[selbase + __popcll(bsel & lt)] = (unsigned short)(j * 64 + lane);
            selbase += __popcll(bsel); tiebase += __popcll(beq); }
        nsel = 256;
    } else {
        nsel = t + 1;
        for (int i = lane; i < 256; i += 64) list[i] = (unsigned short)(i <= t ? i : 0);
    }
    asm volatile("s_waitcnt lgkmcnt(0)" ::: "memory");
    LAS float* qm = (LAS float*)base;
    LAS float* Pl = (LAS float*)(base + 2048);
    { const u32x4 q8 = *(const GAS u32x4*)(PA + n * NPA + PA_Q + 8 * lane);
      *(LAS f32x4*)(qm + 8 * lane) = (f32x4){bflo(q8.x), bfhi(q8.x), bflo(q8.y), bfhi(q8.y)}; *(LAS f32x4*)(qm + 8 * lane + 4) = (f32x4){bflo(q8.z), bfhi(q8.z), bflo(q8.w), bfhi(q8.w)}; }
    asm volatile("s_waitcnt lgkmcnt(0)" ::: "memory");
#pragma unroll 1
    for (int bb = 0; bb < 4; ++bb) { const int i = bb * 64 + lane; const bool valid = i < nsel; const int key = valid ? (int)list[i] : 0;
        const GAS u32x4* kp = (const GAS u32x4*)(KA + (nb0 + key) * 64);
        float kf[64];
#pragma unroll
        for (int c = 0; c < 8; ++c) { const u32x4 kk = kp[c]; kf[8 * c] = bflo(kk.x); kf[8 * c + 1] = bfhi(kk.x); kf[8 * c + 2] = bflo(kk.y); kf[8 * c + 3] = bfhi(kk.y); kf[8 * c + 4] = bflo(kk.z); kf[8 * c + 5] = bfhi(kk.z); kf[8 * c + 6] = bflo(kk.w); kf[8 * c + 7] = bfhi(kk.w); }
        float lgv[8];
#pragma unroll
        for (int h = 0; h < 8; ++h) { float d = 0.f;
#pragma unroll
            for (int c = 0; c < 16; ++c) { const f32x4 q4 = *(const LAS f32x4*)(qm + h * 64 + 4 * c); d += q4.x * kf[4 * c] + q4.y * kf[4 * c + 1] + q4.z * kf[4 * c + 2] + q4.w * kf[4 * c + 3]; }
            lgv[h] = valid ? d : -INFINITY; }
        *(LAS f32x4*)(Pl + i * 8) = (f32x4){lgv[0], lgv[1], lgv[2], lgv[3]}; *(LAS f32x4*)(Pl + i * 8 + 4) = (f32x4){lgv[4], lgv[5], lgv[6], lgv[7]}; }
    asm volatile("s_waitcnt lgkmcnt(0)" ::: "memory");
    float lg[4][8];
#pragma unroll
    for (int bb = 0; bb < 4; ++bb) { const f32x4 a = *(const LAS f32x4*)(Pl + (bb * 64 + lane) * 8), c = *(const LAS f32x4*)(Pl + (bb * 64 + lane) * 8 + 4);
        lg[bb][0] = a.x; lg[bb][1] = a.y; lg[bb][2] = a.z; lg[bb][3] = a.w; lg[bb][4] = c.x; lg[bb][5] = c.y; lg[bb][6] = c.z; lg[bb][7] = c.w; }
    float den[8];
#pragma unroll
    for (int h = 0; h < 8; ++h) { float m = fmaxf(fmaxf(lg[0][h], lg[1][h]), fmaxf(lg[2][h], lg[3][h])); m = wave_max(m, lane); float s = 0.f;
#pragma unroll
        for (int bb = 0; bb < 4; ++bb) { lg[bb][h] = __expf(lg[bb][h] - m); s += lg[bb][h]; }
        den[h] = wave_sum(s, lane); }
#pragma unroll
    for (int bb = 0; bb < 4; ++bb) { const int i = bb * 64 + lane;
        *(LAS f32x4*)(Pl + i * 8) = (f32x4){lg[bb][0], lg[bb][1], lg[bb][2], lg[bb][3]}; *(LAS f32x4*)(Pl + i * 8 + 4) = (f32x4){lg[bb][4], lg[bb][5], lg[bb][6], lg[bb][7]}; }
    asm volatile("s_waitcnt lgkmcnt(0)" ::: "memory");
    float o[8];
#pragma unroll
    for (int h = 0; h < 8; ++h) o[h] = 0.f;
#pragma unroll 4
    for (int i = 0; i < nsel; ++i) { const int key = (int)list[i]; const float vv = bf1(VA[(nb0 + key) * 64 + lane]);
        const f32x4 p0 = *(const LAS f32x4*)(Pl + i * 8), p1 = *(const LAS f32x4*)(Pl + i * 8 + 4);
        o[0] += p0.x * vv; o[1] += p0.y * vv; o[2] += p0.z * vv; o[3] += p0.w * vv; o[4] += p1.x * vv; o[5] += p1.y * vv; o[6] += p1.z * vv; o[7] += p1.w * vv; }
#pragma unroll
    for (int h = 0; h < 8; ++h) Y[n * 1536 + h * 64 + lane] = (bf16)f2bf(o[h] / den[h]);
}

__device__ __forceinline__ bf16x8 scale_pack8(u32x4 raw, float s) {
    u32x4 o; o.x = cvt_pk_bf16(bflo(raw.x) * s, bfhi(raw.x) * s); o.y = cvt_pk_bf16(bflo(raw.y) * s, bfhi(raw.y) * s); o.z = cvt_pk_bf16(bflo(raw.z) * s, bfhi(raw.z) * s); o.w = cvt_pk_bf16(bflo(raw.w) * s, bfhi(raw.w) * s);
    return __builtin_bit_cast(bf16x8, o);
}
__device__ __forceinline__ void dsa16_unit(Frame& F, int unit) {
    int lane = F.lane; asm volatile("" : "+v"(lane)); const int w = F.wave;
    const int qb = 2047 - unit;
    const int b = qb & 7, t0 = (qb >> 3) * 16;
    const size_t nb0 = (size_t)b * SEQ;
    const GAS bf16* PA = (const GAS bf16*)(F.ws + WS_PA); GAS bf16* Y = (GAS bf16*)(F.ws + WS_Y);
    const GAS bf16* KI = (const GAS bf16*)(F.ws + WS_KI); const GAS bf16* KA = (const GAS bf16*)(F.ws + WS_KA); const GAS bf16* VA = (const GAS bf16*)(F.ws + WS_VA);
    const GAS float* WI = (const GAS float*)(F.ws + WS_WI);
    LAS unsigned char* K16 = F.lds;
    LAS unsigned short* LIST = (LAS unsigned short*)(F.lds + AUX_OFF);
    const int fr = lane & 15, fq = lane >> 4;
#ifdef REP_S1
    for (int rep_ = 0; rep_ < REP_S1; ++rep_)
#endif
    {
        const int ql = fr >> 2, h = fr & 3;
        bf16x8 Bf[4][2]; float Linf[4];
#pragma unroll
        for (int g = 0; g < 4; ++g) { const size_t nq = nb0 + t0 + 4 * g + ql; const float wv = WI[nq * 4 + h];
#pragma unroll
            for (int ks = 0; ks < 2; ++ks) Bf[g][ks] = scale_pack8(*(const GAS u32x4*)(PA + nq * NPA + PA_QI + h * 64 + 8 * fq + 32 * ks), wv);
            Linf[g] = (wv >= 0.f) ? INFINITY : -INFINITY; }
        const int ntiles = (t0 >> 4) + 1;
        bf16x8 A0[4], A1[4];
#pragma unroll
        for (int j = 0; j < 4; ++j) { const int tile = (w + 8 * j < ntiles) ? w + 8 * j : ntiles - 1; const size_t krow = (nb0 + 16 * tile + fr) * 64;
            A0[j] = *(const GAS bf16x8*)(KI + krow + 8 * fq); A1[j] = *(const GAS bf16x8*)(KI + krow + 32 + 8 * fq); }
#pragma unroll 1
        for (int tb = w; tb < ntiles; tb += 32) {
            bf16x8 N0[4], N1[4];
#pragma unroll
            for (int j = 0; j < 4; ++j) { const int tn = tb + 32 + 8 * j; const int tile = (tn < ntiles) ? tn : ntiles - 1; const size_t krow = (nb0 + 16 * tile + fr) * 64;
                N0[j] = *(const GAS bf16x8*)(KI + krow + 8 * fq); N1[j] = *(const GAS bf16x8*)(KI + krow + 32 + 8 * fq); }
#pragma unroll
            for (int j = 0; j < 4; ++j) { const int tile = tb + 8 * j;
                if (tile < ntiles) {
                    const int kpos = 16 * tile + 4 * fq + h;
                    const int g7 = kpos >> 7, hf = (kpos >> 6) & 1, ln = kpos & 63;
                    const int koff = (g7 >> 2) * 1024 + ln * 16 + (g7 & 3) * 4 + hf * 2;
                    const bool lastt = (tile == ntiles - 1);
#pragma unroll
                    for (int g = 0; g < 4; ++g) {
                        f32x4 d = __builtin_amdgcn_mfma_f32_16x16x32_bf16(A0[j], Bf[g][0], (f32x4){0.f, 0.f, 0.f, 0.f}, 0, 0, 0);
                        d = __builtin_amdgcn_mfma_f32_16x16x32_bf16(A1[j], Bf[g][1], d, 0, 0, 0);
                        const float a0 = __builtin_amdgcn_fmed3f(d[0], 0.f, Linf[g]), a1 = __builtin_amdgcn_fmed3f(d[1], 0.f, Linf[g]), a2 = __builtin_amdgcn_fmed3f(d[2], 0.f, Linf[g]), a3 = __builtin_amdgcn_fmed3f(d[3], 0.f, Linf[g]);
                        const float u0 = a0 + dppf<0xB1>(a0), u1 = a1 + dppf<0xB1>(a1), u2 = a2 + dppf<0xB1>(a2), u3 = a3 + dppf<0xB1>(a3);
                        const float b0 = (h & 1) ? u1 : u0, b1 = (h & 1) ? u3 : u2;
                        const float c0 = b0 + dppf<0x4E>(b0), c1 = b1 + dppf<0x4E>(b1);
                        const float s = ((h & 2) ? c1 : c0) + 0.0f;
                        const _Float16 hh = (_Float16)s; const unsigned hb = (unsigned)__builtin_bit_cast(unsigned short, hh);
                        unsigned key = hb ^ ((unsigned)((int)(hb << 16) >> 31) | 0x8000u);
                        if (lastt) key = (kpos <= t0 + 4 * g + ql) ? key : 0u;
                        *(LAS unsigned short*)(K16 + (4 * g + ql) * 8192 + koff) = (unsigned short)key;
                    }
                }
            }
#pragma unroll
            for (int j = 0; j < 4; ++j) { A0[j] = N0[j]; A1[j] = N1[j]; }
        }
    }
    __syncthreads();
#ifndef REP_S2
#define REP_S2 1
#endif
#pragma unroll 1
    for (int qq = 0; qq < 2 * REP_S2; ++qq) {
        const int q = 2 * w + (qq & 1), nvalid = t0 + q + 1;
        LAS unsigned short* list = LIST + q * 256;
        if (nvalid <= 256) {
            for (int i = lane; i < 256; i += 64) list[i] = (unsigned short)(i < nvalid ? i : 0);
        } else {
            const int ngrp = (nvalid + 511) >> 9;
            unsigned v[64];
#pragma unroll
            for (int grp = 0; grp < 8; ++grp) {
                if (grp < ngrp) { const u32x4 r = *(const LAS u32x4*)(K16 + q * 8192 + grp * 1024 + lane * 16);
#pragma unroll
                    for (int i = 0; i < 4; ++i) { const int g = 4 * grp + i; const unsigned rr = r[i]; const int thr = nvalid - 128 * g;
                        v[2 * g] = (lane < thr) ? (rr & 0xffffu) : 0u; v[2 * g + 1] = (lane < thr - 64) ? (rr >> 16) : 0u; }
                } else {
#pragma unroll
                    for (int i = 0; i < 8; ++i) v[8 * grp + i] = 0u;
                }
            }
            unsigned T = 0u;
#pragma unroll 1
            for (int bit = 15; bit >= 0; --bit) { const unsigned cand = T | (1u << bit); int cnt = 0;
#pragma unroll
                for (int grp = 0; grp < 8; ++grp) if (grp < ngrp) {
#pragma unroll
                    for (int i = 0; i < 8; ++i) cnt += (v[8 * grp + i] >= cand) ? 1 : 0; }
                if (wave_total_i(cnt) >= 256) T = cand; }
            int cgt = 0;
#pragma unroll
            for (int grp = 0; grp < 8; ++grp) if (grp < ngrp) {
#pragma unroll
                for (int i = 0; i < 8; ++i) cgt += (v[8 * grp + i] > T) ? 1 : 0; }
            const int need = 256 - wave_total_i(cgt);
            int selbase = 0, tiebase = 0; const unsigned long long lt = (1ull << lane) - 1ull;
#pragma unroll
            for (int grp = 0; grp < 8; ++grp) if (grp < ngrp) {
#pragma unroll
                for (int i = 0; i < 8; ++i) { const int j = 8 * grp + i; const unsigned x = v[j]; const bool eq = (x == T), gt = (x > T);
                    const unsigned long long beq = __ballot(eq);
                    const int trank = tiebase + __popcll(beq & lt);
                    const bool sel = gt || (eq && trank < need);
                    const unsigned long long bsel = __ballot(sel);
                    if (sel) list[selbase + __popcll(bsel & lt)] = (unsigned short)(j * 64 + lane);
                    selbase += __popcll(bsel); tiebase += __popcll(beq); } }
        }
    }
    __syncthreads();
    LAS unsigned char* Vs = F.lds + w * 16384;
#ifndef REP_S3
#define REP_S3 1
#endif
#pragma unroll 1
    for (int qq = 0; qq < 2 * REP_S3; ++qq) {
        const int q = 2 * w + (qq & 1), tq = t0 + q; const int nsel = (tq + 1 < 256) ? tq + 1 : 256;
        const size_t nq = nb0 + tq;
        const LAS unsigned short* list = LIST + q * 256;
        bf16x8 Qf[2];
#pragma unroll
        for (int ks = 0; ks < 2; ++ks) { u32x4 raw = {0u, 0u, 0u, 0u}; if (fr < 8) raw = *(const GAS u32x4*)(PA + nq * NPA + PA_Q + fr * 64 + 8 * fq + 32 * ks); Qf[ks] = __builtin_bit_cast(bf16x8, raw); }
        float lg[16][4];
        int keyv[16];
#pragma unroll
        for (int tt = 0; tt < 16; ++tt) keyv[tt] = (int)list[16 * tt + fr];
#pragma unroll
        for (int hb = 0; hb < 4; ++hb) {
            bf16x8 A0[4], A1[4];
#pragma unroll
            for (int j = 0; j < 4; ++j) { const size_t krow = (nb0 + keyv[4 * hb + j]) * 64; A0[j] = *(const GAS bf16x8*)(KA + krow + 8 * fq); A1[j] = *(const GAS bf16x8*)(KA + krow + 32 + 8 * fq); }
            __builtin_amdgcn_sched_barrier(0);
#pragma unroll
            for (int j = 0; j < 4; ++j) { const int tt = 4 * hb + j;
                f32x4 d = __builtin_amdgcn_mfma_f32_16x16x32_bf16(A0[j], Qf[0], (f32x4){0.f, 0.f, 0.f, 0.f}, 0, 0, 0);
                d = __builtin_amdgcn_mfma_f32_16x16x32_bf16(A1[j], Qf[1], d, 0, 0, 0);
#pragma unroll
                for (int r = 0; r < 4; ++r) lg[tt][r] = (16 * tt + 4 * fq + r < nsel) ? d[r] : -INFINITY; }
        }
        float m = lg[0][0];
#pragma unroll
        for (int tt = 0; tt < 16; ++tt)
#pragma unroll
            for (int r = 0; r < 4; ++r) m = fmaxf(m, lg[tt][r]);
        m = fmaxf(m, shx(m, 16, lane)); m = fmaxf(m, shx(m, 32, lane));
        float den = 0.f;
#pragma unroll
        for (int tt = 0; tt < 16; ++tt)
#pragma unroll
            for (int r = 0; r < 4; ++r) { lg[tt][r] = __expf(lg[tt][r] - m); den += lg[tt][r]; }
        den += shx(den, 16, lane); den += shx(den, 32, lane);
        f32x4 acc[4];
#pragma unroll
        for (int nt = 0; nt < 4; ++nt) acc[nt] = (f32x4){0.f, 0.f, 0.f, 0.f};
#pragma unroll
        for (int hh = 0; hh < 2; ++hh) {
#pragma unroll
            for (int ib = 0; ib < 2; ++ib) {
                u32x4 vv[8];
#pragma unroll
                for (int i = 0; i < 8; ++i) { const int piece = (8 * ib + i) * 64 + lane, row = piece >> 3, c = piece & 7; const int key = (int)list[128 * hh + row];
                    vv[i] = *(const GAS u32x4*)(VA + (nb0 + key) * 64 + 8 * c); }
                __builtin_amdgcn_sched_barrier(0);
#pragma unroll
                for (int i = 0; i < 8; ++i) { const int piece = (8 * ib + i) * 64 + lane; *(LAS u32x4*)(Vs + piece * 16) = vv[i]; }
            }
            asm volatile("s_waitcnt lgkmcnt(0)" ::: "memory");
#pragma unroll
            for (int s4 = 0; s4 < 4; ++s4) { const int s = 4 * hh + s4;
                u32x4 pa; pa.x = cvt_pk_bf16(lg[2 * s][0], lg[2 * s][1]); pa.y = cvt_pk_bf16(lg[2 * s][2], lg[2 * s][3]); pa.z = cvt_pk_bf16(lg[2 * s + 1][0], lg[2 * s + 1][1]); pa.w = cvt_pk_bf16(lg[2 * s + 1][2], lg[2 * s + 1][3]);
                const bf16x8 Pa = __builtin_bit_cast(bf16x8, pa);
                const int rowa = 32 * s4 + 4 * fq + (fr >> 2);
#pragma unroll
                for (int nt = 0; nt < 4; ++nt) {
                    const v4i16_t lo = __builtin_amdgcn_ds_read_tr16_b64_v4i16((LAS v4i16_t*)(Vs + rowa * 128 + (16 * nt + 4 * (fr & 3)) * 2));
                    const v4i16_t hi = __builtin_amdgcn_ds_read_tr16_b64_v4i16((LAS v4i16_t*)(Vs + (rowa + 16) * 128 + (16 * nt + 4 * (fr & 3)) * 2));
                    bf16x8 Bv; Bv[0] = lo[0]; Bv[1] = lo[1]; Bv[2] = lo[2]; Bv[3] = lo[3]; Bv[4] = hi[0]; Bv[5] = hi[1]; Bv[6] = hi[2]; Bv[7] = hi[3];
                    acc[nt] = __builtin_amdgcn_mfma_f32_16x16x32_bf16(Pa, Bv, acc[nt], 0, 0, 0); } }
            asm volatile("s_waitcnt lgkmcnt(0)" ::: "memory");
        }
        float dn[4];
#pragma unroll
        for (int r = 0; r < 4; ++r) dn[r] = __builtin_bit_cast(float, __builtin_amdgcn_ds_bpermute((4 * (fq & 1) + r) << 2, __builtin_bit_cast(int, den)));
        if (fq < 2) {
#pragma unroll
            for (int nt = 0; nt < 4; ++nt)
#pragma unroll
                for (int r = 0; r < 4; ++r) Y[nq * 1536 + (4 * fq + r) * 64 + 16 * nt + fr] = (bf16)f2bf(acc[nt][r] / dn[r]);
        }
    }
}

#ifdef GLA_NAIVE
constexpr int NGLA = 32;
#else
constexpr int NGLA = 2048;
#endif
#ifdef DSA_NAIVE
constexpr int NDSA = 4096;
#else
constexpr int NDSA = 2048;
#endif
#ifdef GMLP_NAIVE
constexpr int NGM = 1024;
#else
constexpr int NGM = 256;
#endif
__device__ __forceinline__ void phase_mixer(Frame& F, int l, int slot = 0, int types = 7) {
    gu32* head = F.ctl + CW_QUEUE + 64 * (l + 2 * slot);
    for (;;) {
        __syncthreads();
        if (F.tid == 0) F.MISC[64] = __hip_atomic_fetch_add(head, 1u, __ATOMIC_RELAXED, __HIP_MEMORY_SCOPE_AGENT);
        __syncthreads();
        const int u = (int)F.MISC[64];
        if (u >= NDSA + NGLA + NGM) break;
        if (u < NDSA) { if (EN_B2 && (types & 2)) {
#ifdef DSA_NAIVE
            dsa_unit(F, u);
#else
            dsa16_unit(F, u);
#endif
        } }
        else if (u < NDSA + NGLA) { if (EN_B1 && (types & 1)) {
#ifdef GLA_NAIVE
            gla_unit(F, l, u - NDSA);
#else
            gla_local_unit(F, l, u - NDSA);
#endif
        } }
        else { if (EN_B3 && (types & 4)) {
#ifdef GMLP_NAIVE
            gmlp_unit(F, l, u - NDSA - NGLA);
#else
            gmlp16_unit(F, l, u - NDSA - NGLA);
#endif
        } }
    }
}
__device__ __forceinline__ void phase_gla_out(Frame& F, int l) {
#ifndef GLA_NAIVE
    for (int u = F.wg; u < 2048; u += F.G) gla_out_unit(F, l, u);
#endif
}

template <int CTRL> __device__ __forceinline__ float dpp_add(float v) { return v + dppf<CTRL>(v); }
__device__ __forceinline__ float row16_sum(float v) { v = dpp_add<0xB1>(v); v = dpp_add<0x4E>(v); v = dpp_add<0x141>(v); v = dpp_add<0x140>(v); return v; }
__device__ __forceinline__ void phase_ln_router(Frame& F, int l, bool dry = false) {
    const GAS float* WR = (const GAS float*)(F.ws + WS_WR) + (size_t)l * 36 * DM;
    LAS float* wr = (LAS float*)F.lds;
    for (int i = F.tid; i < 36 * 256; i += 512) ((LAS f32x4*)wr)[i] = ((const GAS f32x4*)WR)[i];
    if (F.tid < 32) F.MISC[16 + F.tid] = 0u;
    __syncthreads();
    GAS bf16* HB = (GAS bf16*)(F.ws + (dry ? WS_PA + 160 * MiB : WS_HB)); GAS int* EID = (GAS int*)(F.ws + (dry ? WS_PA + 130 * MiB : WS_ROUTE)); GAS float* EW = (GAS float*)(F.ws + (dry ? WS_PA + 131 * MiB : WS_ROUTE + 256 * 1024));
    GAS float* HO = dry ? (GAS float*)(F.ws + WS_PA) : F.H;
    const GAS float* g = ((const GAS float*)F.in[17]) + l * DM; const GAS float* bb = ((const GAS float*)F.in[18]) + l * DM; const GAS float* brg = ((const GAS float*)F.in[20]) + l * 4; const GAS float* bre = ((const GAS float*)F.in[22]) + l * 32;
    int lane = F.lane; asm volatile("" : "+v"(lane));
    const int sub = lane & 15, rr = lane >> 4;
    for (int r0 = F.wg * 128; r0 < NTOK; r0 += F.G * 128)
#pragma unroll 1
        for (int j = 0; j < 4; ++j) { const int m = r0 + F.wave * 16 + 4 * j + rr;
            f32x4 v[16]; float s = 0.f;
#pragma unroll
            for (int q = 0; q < 16; ++q) { v[q] = *(const GAS f32x4*)(F.H + (size_t)m * DM + 4 * (sub + 16 * q)); s += (v[q].x + v[q].y) + (v[q].z + v[q].w); }
            const float mean = row16_sum(s) * (1.f / DM); float s2 = 0.f;
#pragma unroll
            for (int q = 0; q < 16; ++q) { v[q] = v[q] - mean; s2 += (v[q].x * v[q].x + v[q].y * v[q].y) + (v[q].z * v[q].z + v[q].w * v[q].w); }
            const float rstd = 1.f / sqrtf(row16_sum(s2) * (1.f / DM) + LN_EPS);
#pragma unroll
            for (int q = 0; q < 16; ++q) { const int c = 4 * (sub + 16 * q); const f32x4 gg = *(const GAS f32x4*)(g + c), bv = *(const GAS f32x4*)(bb + c); v[q] = v[q] * rstd * gg + bv;
                *(GAS f32x4*)(HO + (size_t)m * DM + c) = v[q];
                u32x2 wv; wv.x = pk2(v[q].x, v[q].y); wv.y = pk2(v[q].z, v[q].w); *(GAS u32x2*)(HB + (size_t)m * DM + c) = wv; }
            float lgt[36];
#pragma unroll
            for (int o = 0; o < 36; ++o) { float p = 0.f;
#pragma unroll
                for (int q = 0; q < 16; ++q) { const f32x4 w4 = *(const LAS f32x4*)(wr + o * DM + 4 * (sub + 16 * q)); p += v[q].x * w4.x + v[q].y * w4.y + v[q].z * w4.z + v[q].w * w4.w; }
                lgt[o] = row16_sum(p); }
            int gi = 0; float gm = lgt[0] + brg[0];
#pragma unroll
            for (int q = 1; q < 4; ++q) { const float x = lgt[q] + brg[q]; if (x > gm) { gm = x; gi = q; } }
            float gs = 0.f;
#pragma unroll
            for (int q = 0; q < 4; ++q) gs += __expf(lgt[q] + brg[q] - gm);
            const float gp = 1.f / gs;
            float el[8];
#pragma unroll
            for (int q = 0; q < 8; ++q) { float x = lgt[4 + q] + bre[q];
                x = (gi == 1) ? lgt[12 + q] + bre[8 + q] : x; x = (gi == 2) ? lgt[20 + q] + bre[16 + q] : x; x = (gi == 3) ? lgt[28 + q] + bre[24 + q] : x; el[q] = x; }
            int i0 = 0; float v0 = el[0];
#pragma unroll
            for (int q = 1; q < 8; ++q) if (el[q] > v0) { v0 = el[q]; i0 = q; }
            int i1 = -1; float v1 = -INFINITY;
#pragma unroll
            for (int q = 0; q < 8; ++q) if (q != i0 && el[q] > v1) { v1 = el[q]; i1 = q; }
            const float ex = __expf(v1 - v0), w0 = gp / (1.f + ex), w1 = gp * ex / (1.f + ex);
            if (sub == 0) { const int e0 = gi * 8 + i0, e1 = gi * 8 + i1;
                EID[2 * m] = e0; EID[2 * m + 1] = e1; EW[2 * m] = w0; EW[2 * m + 1] = w1;
                __hip_atomic_fetch_add((LAS unsigned*)(F.lds + MISC_OFF) + 16 + e0, 1u, __ATOMIC_RELAXED, __HIP_MEMORY_SCOPE_WORKGROUP);
                __hip_atomic_fetch_add((LAS unsigned*)(F.lds + MISC_OFF) + 16 + e1, 1u, __ATOMIC_RELAXED, __HIP_MEMORY_SCOPE_WORKGROUP); } }
    __syncthreads();
    if (F.tid < 32 && !dry) ((GAS int*)(F.ws + WS_CNTWG))[F.wg * 32 + F.tid] = (int)F.MISC[16 + F.tid];
}
__device__ __forceinline__ void phase_dispatch(Frame& F) {
    const GAS int* CNT = (const GAS int*)(F.ws + WS_CNTWG); const GAS int* EID = (const GAS int*)(F.ws + WS_ROUTE); const GAS float* EW = (const GAS float*)(F.ws + WS_ROUTE + 256 * 1024);
    GAS int* SROW = (GAS int*)(F.ws + WS_SROW); GAS int* ROWMAP = (GAS int*)(F.ws + WS_ROWMAP); GAS float* CWROW = (GAS float*)(F.ws + WS_CWROW); GAS int* META = (GAS int*)(F.ws + WS_META);
    LAS int* tot = (LAS int*)(F.lds + AUX_OFF);
    if (F.tid < 32) { int t = 0, mine = 0; for (int w = 0; w < F.G; ++w) { const int c = ld_i32(CNT + w * 32 + F.tid); t += c; if (w < F.wg) mine += c; } tot[F.tid] = t; tot[32 + F.tid] = mine; tot[96 + F.tid] = 0; }
    __syncthreads();
    if (F.tid == 0) { int rb = 0;
#pragma clang loop unroll(disable) vectorize(disable)
        for (int e = 0; e < 32; ++e) { tot[64 + e] = rb; rb += ((tot[e] + 255) >> 8) << 8; }
        tot[128] = rb; }
    __syncthreads();
    if (F.wg == 0) { const int nt = tot[128] >> 8; if (F.tid == 0) META[0] = nt;
        if (F.tid < nt) { int e = 0;
#pragma clang loop unroll(disable) vectorize(disable)
            for (int q = 1; q < 32; ++q) if (tot[64 + q] <= F.tid * 256) e = q;
            META[16 + F.tid] = e; } }
    for (int r0 = F.wg * 128; r0 < NTOK; r0 += F.G * 128) {
        if (F.tid < 256) { const int tok = r0 + (F.tid >> 1), slot = F.tid & 1; const int e = EID[2 * tok + slot];
            const int pos = (int)__hip_atomic_fetch_add((LAS unsigned*)&tot[96 + e], 1u, __ATOMIC_RELAXED, __HIP_MEMORY_SCOPE_WORKGROUP);
            const int sr = tot[64 + e] + tot[32 + e] + pos;
            ROWMAP[sr] = tok; CWROW[sr] = EW[2 * tok + slot]; SROW[2 * tok + slot] = sr; } }
    if (F.wg < 32) { const int e = F.wg; const int lo = tot[64 + e] + tot[e], hi = tot[64 + e] + (((tot[e] + 255) >> 8) << 8);
        for (int r = lo + F.tid; r < hi; r += 512) { ROWMAP[r] = 0; CWROW[r] = 0.f; } }
}
__device__ __forceinline__ void phase_ln2(Frame& F, int l, bool dry = false) {
    GAS bf16* HB = (GAS bf16*)(F.ws + WS_HB); GAS float* HO = dry ? (GAS float*)(F.ws + WS_Y) : F.H; const GAS int* SROW = (const GAS int*)(F.ws + WS_SROW); const GAS bf16* FF2 = (const GAS bf16*)(F.ws + WS_FF2);
    const GAS float* g = ((const GAS float*)F.in[26]) + l * DM; const GAS float* bb = ((const GAS float*)F.in[27]) + l * DM; int lane = F.lane; asm volatile("" : "+v"(lane));
    const int gw = F.wg * 8 + F.wave, NGW = F.G * 8;
    for (int m = gw; m < NTOK; m += NGW) { const int s0 = ld_i32(SROW + 2 * m), s1 = ld_i32(SROW + 2 * m + 1);
        f32x4 v[4];
#pragma unroll
        for (int q = 0; q < 4; ++q) { const f32x4 h = *(const GAS f32x4*)(F.H + (size_t)m * DM + 4 * lane + 256 * q);
            const u32x2 a = *(const GAS u32x2*)(FF2 + (size_t)s0 * DM + 4 * lane + 256 * q), c = *(const GAS u32x2*)(FF2 + (size_t)s1 * DM + 4 * lane + 256 * q);
            v[q] = h * DN_ALPHA + (f32x4){bflo(a.x) + bflo(c.x), bfhi(a.x) + bfhi(c.x), bflo(a.y) + bflo(c.y), bfhi(a.y) + bfhi(c.y)}; }
        ln_row_regs(v, g, bb, lane);
        store_row_f32_bf16(v, HO + (size_t)(dry ? (m % 24576) : m) * DM, dry ? (GAS bf16*)nullptr : HB + (size_t)m * DM, lane); }
}

#ifndef EN_P
#define EN_P 1
#endif
#ifndef EN_A
#define EN_A 1
#endif
#ifndef EN_B
#define EN_B 1
#endif
#ifndef EN_C
#define EN_C 1
#endif
#ifndef EN_D
#define EN_D 1
#endif
#ifndef EN_E
#define EN_E 1
#endif
#ifndef EN_F
#define EN_F 1
#endif
#ifndef EN_G
#define EN_G 1
#endif
#ifndef EN_H
#define EN_H 1
#endif
#ifndef EN_I
#define EN_I 1
#endif
#ifndef EN_J
#define EN_J 1
#endif
constexpr int PPL = 12;
constexpr int N_PHASES = 1 + PPL * DEPTH;
#ifndef MK_ONE_LAUNCH
#define MK_ONE_LAUNCH 0
#endif
struct Args { const float* in[28]; float* out; unsigned char* ws; int ph_lo, ph_hi; };
static_assert(sizeof(Args) == 28 * 8 + 8 + 8 + 8, "no padding bytes in the argument struct");


__device__ __forceinline__ unsigned opaque_u32(unsigned x) { asm volatile("" : "+v"(x)); return (unsigned)__builtin_amdgcn_readfirstlane((int)x); }
__device__ __forceinline__ unsigned long long opaque_u64(unsigned long long x) { return ((unsigned long long)opaque_u32((unsigned)(x >> 32)) << 32) | opaque_u32((unsigned)x); }
__device__ __forceinline__ void launder(Frame& F) {
    F.ws = (GAS unsigned char*)opaque_u64((unsigned long long)F.ws); F.H = (GAS float*)opaque_u64((unsigned long long)F.H);
    F.ctl = (gu32*)opaque_u64((unsigned long long)F.ctl);
    unsigned z0 = 0u; asm volatile("" : "+v"(z0)); int ln = (int)__builtin_amdgcn_mbcnt_hi(~0u, __builtin_amdgcn_mbcnt_lo(~0u, z0));
    F.wave = (int)opaque_u32((unsigned)F.wave); F.lane = ln; F.tid = F.wave * 64 + ln;
    F.G = (int)opaque_u32((unsigned)F.G); F.wg = (int)opaque_u32((unsigned)F.wg);
}
__global__ void __launch_bounds__(512, 2) mk_fwd(Args args) {
    extern __shared__ __attribute__((aligned(16))) unsigned char lds_raw[];
    Frame F;
    F.lds = (LAS unsigned char*)lds_raw;
    F.MISC = (volatile LAS unsigned*)(F.lds + MISC_OFF);
    F.tid = threadIdx.x; F.lane = F.tid & 63; F.wave = __builtin_amdgcn_readfirstlane(F.tid >> 6);
    F.G = gridDim.x; F.wg = blockIdx.x;
    F.in = args.in;
    F.pos = (const GAS int*)args.in[1];
    F.H = (GAS float*)args.out; F.ws = (GAS unsigned char*)args.ws;
    F.ctl = (gu32*)(args.ws + WS_CTL);
    for (int u = F.tid; u < (LDS_BYTES - MISC_OFF) / 4; u += 512) ((LAS unsigned*)(F.lds + MISC_OFF))[u] = 0u;
    __syncthreads();
    const int lo = args.ph_lo, hi = args.ph_hi;
    const bool multi = (hi - lo) > 1;
    XcdBarrier bar; bar.bar = (unsigned*)(F.ctl + CW_BAR); bar.x = 0; bar.st = nullptr;
    if (multi) bar = xcd_barrier_post((unsigned*)(F.ctl + CW_BAR), F.MISC + 8);
#define IN(k) (lo <= (k) && (k) < hi)
#define SEAM(k) do { if (IN(k) && IN((k) + 1)) xcd_barrier(bar); } while (0)

#ifdef DUP_P
    for (int rep = 0; rep < 2; ++rep)
#endif
    if (EN_P && IN(0)) { launder(F); phase_prologue(F); }
    SEAM(0);
#define HB ((GAS bf16*)(F.ws + WS_HB))
#define PA ((GAS bf16*)(F.ws + WS_PA))
#define Y ((GAS bf16*)(F.ws + WS_Y))
    for (int l = 0; l < DEPTH; ++l) {
        const int pb = 1 + PPL * l;
#define wd (F.ws + WS_WDENSE + (size_t)l * WD_LAYER)
#ifdef DUP_A
        for (int rep = 0; rep < 2; ++rep)
#endif
        if (EN_A && IN(pb + 0)) { launder(F);
            DenseSched S; S.init(NTOK / 256, NPA / 256, F.G, F.wg, (const void*)HB, (size_t)256 * DM * 2, (const void*)(wd + WD_WA), (size_t)256 * DM * 2);
            EpiA E{PA, (GAS bf16*)(F.ws + WS_KA), (GAS bf16*)(F.ws + WS_VA), (GAS bf16*)(F.ws + WS_KI), (GAS float*)(F.ws + WS_WI), (GAS float*)(F.ws + WS_GLR), (const GAS float*)(F.ws + WS_ROPE), ((const GAS float*)F.in[5]) + l * 64};
            pg8::gemm_phase<EpiA, DenseSched, false>(F.lds, S, E, DM, DM, F.wave);
        }
        SEAM(pb + 0);
        if (EN_B && IN(pb + 1)) { launder(F); phase_mixer(F, l);
#ifdef DUP_B
            launder(F); phase_mixer(F, l, 1, DUP_B);
#endif
        }
        SEAM(pb + 1);
        if (EN_B && IN(pb + 2)) { launder(F); gla_scan_phase(F); }
        SEAM(pb + 2);
        if (EN_B && IN(pb + 3)) { launder(F); phase_gla_out(F, l); }
        SEAM(pb + 3);
#ifdef DUP_C
        for (int rep = 0; rep < 2; ++rep)
#endif
        if (EN_C && IN(pb + 4)) { launder(F);
            DenseSched S; S.init(NTOK / 256, NGT / 256, F.G, F.wg, (const void*)HB, (size_t)256 * DM * 2, (const void*)(wd + WD_WG), (size_t)256 * DM * 2);
            EpiG E{PA};
            pg8::gemm_phase<EpiG, DenseSched, false>(F.lds, S, E, DM, DM, F.wave);
        }
        SEAM(pb + 4);
#ifdef DUP_D
        for (int rep = 0; rep < 2; ++rep)
#endif
        if (EN_D && IN(pb + 5)) { launder(F);
            DenseSched S; S.init(NTOK / 256, DM / 256, F.G, F.wg, (const void*)Y, (size_t)256 * 1536 * 2, (const void*)(wd + WD_WBR), (size_t)256 * 512 * 2);
            S.nsub = 3; S.asub = 512 * 2; S.bsub = (size_t)1024 * 512 * 2;
            EpiM E{PA, HB};
            pg8::gemm_phase<EpiM, DenseSched, false>(F.lds, S, E, 512, 1536, F.wave);
        }
        SEAM(pb + 5);
        if (EN_E && IN(pb + 6)) { launder(F);
            DenseSched S; S.init(NTOK / 256, DM / 256, F.G, F.wg, (const void*)HB, (size_t)256 * DM * 2, (const void*)(wd + WD_WOUT), (size_t)256 * DM * 2);
#ifdef DUP_E
            { EpiO E0{(GAS float*)(F.ws + WS_PA)}; pg8::gemm_phase<EpiO, DenseSched, false>(F.lds, S, E0, DM, DM, F.wave); }
#endif
            EpiO E{F.H};
            pg8::gemm_phase<EpiO, DenseSched, false>(F.lds, S, E, DM, DM, F.wave);
        }
        SEAM(pb + 6);
        if (EN_F && IN(pb + 7)) { launder(F);
#ifdef DUP_F
            phase_ln_router(F, l, true); launder(F);
#endif
            phase_ln_router(F, l); }
        SEAM(pb + 7);
        if (EN_G && IN(pb + 8)) { launder(F);
            { LAS float* scr = (LAS float*)(F.lds + F.wave * 16384); const int gw = F.wg * 8 + F.wave, NGW = F.G * 8;
              for (int it = gw; it < 12288; it += NGW) conv_moe_item(F, l, it, scr);
              __syncthreads(); }
            phase_dispatch(F); }
        SEAM(pb + 8);
#ifdef DUP_H
        for (int rep = 0; rep < 2; ++rep)
#endif
        if (EN_H && IN(pb + 9)) { launder(F);
            const GAS int* META = (const GAS int*)(F.ws + WS_META); const GAS int* ROWMAP = (const GAS int*)(F.ws + WS_ROWMAP);
            const int NT = ld_i32(META), NU = NT * 2;
            LAS int* meta = (LAS int*)(F.lds + AUX_OFF); LAS int* rows = (LAS int*)(F.lds + AUX_OFF + 64);
            for (int i = 0; i * F.G + F.wg < NU && i < 8; ++i) { const int L = i * F.G + F.wg, gt = L >> 1;
                if (F.tid == 0) meta[i] = ld_i32(META + 16 + gt);
                if (F.tid < 256) rows[i * 256 + F.tid] = ROWMAP[gt * 256 + F.tid]; }
            __syncthreads();
            GroupSched S{NU, F.G, F.wg, 2, (const char*)HB, (const char*)(F.ws + WS_WMOE + WM_GU), 0, (size_t)512 * DM * 2, (size_t)256 * DM * 2, meta, rows};
            EpiGU E{(GAS bf16*)(F.ws + WS_HID), (const GAS float*)(F.ws + WS_CWROW)};
            pg8::gemm_phase<EpiGU, GroupSched, true>(F.lds, S, E, DM, DM, F.wave);
        }
        SEAM(pb + 9);
#ifdef DUP_I
        for (int rep = 0; rep < 2; ++rep)
#endif
        if (EN_I && IN(pb + 10)) { launder(F);
            const GAS int* META = (const GAS int*)(F.ws + WS_META);
            const int NT = ld_i32(META), NU = NT * 4;
            LAS int* meta = (LAS int*)(F.lds + AUX_OFF);
            for (int i = 0; i * F.G + F.wg < NU && i < 8; ++i) { const int L = i * F.G + F.wg, gt = L >> 2; if (F.tid == 0) meta[i] = ld_i32(META + 16 + gt); }
            __syncthreads();
            GroupSched S{NU, F.G, F.wg, 4, (const char*)(F.ws + WS_HID), (const char*)(F.ws + WS_WMOE + WM_DN), (size_t)256 * DEXP * 2, (size_t)DM * DEXP * 2, (size_t)256 * DEXP * 2, meta, nullptr};
            EpiDN E{(GAS bf16*)(F.ws + WS_FF2)};
            pg8::gemm_phase<EpiDN, GroupSched, false>(F.lds, S, E, DEXP, DEXP, F.wave);
        }
        SEAM(pb + 10);
        if (EN_J && IN(pb + 11)) { launder(F);
#ifdef DUP_J
            phase_ln2(F, l, true); launder(F);
#endif
            phase_ln2(F, l); }
        SEAM(pb + 11);
    }
#undef IN
#undef SEAM
#undef HB
#undef PA
#undef Y
#undef wd
}


#ifdef DUMP_OFF
__global__ void dump_k(const unsigned short* src, float* out) {
    for (size_t i = (size_t)blockIdx.x * blockDim.x + threadIdx.x; i < (size_t)NTOK * 1024; i += (size_t)gridDim.x * blockDim.x) { const size_t n = i >> 10, c = i & 1023; out[i] = __builtin_bit_cast(float, ((unsigned)src[n * DUMP_PITCH + c]) << 16); }
}
#endif
extern "C" void kernel_launch(void* const* d_in, const int* in_sizes, int n_in, void* d_out, int out_size, void* d_ws, size_t ws_size, hipStream_t stream) {
    static int grid = 0;
    if (grid == 0) {
        if (n_in != 28 || out_size != NTOK * DM || ws_size < WS_END) { fprintf(stderr, "kernel_launch: unexpected shapes (n_in %d out %d ws %zu); nothing launched\n", n_in, out_size, ws_size); grid = -1; return; }
        int dev = 0, cus = 0;
        if (hipGetDevice(&dev) != hipSuccess || hipDeviceGetAttribute(&cus, hipDeviceAttributeMultiprocessorCount, dev) != hipSuccess) { grid = -1; return; }
        if (hipFuncSetAttribute((const void*)mk_fwd, hipFuncAttributeMaxDynamicSharedMemorySize, LDS_BYTES) != hipSuccess) { fprintf(stderr, "kernel_launch: hipFuncSetAttribute failed\n"); grid = -1; return; }
        int per_cu = 0;
        if (hipOccupancyMaxActiveBlocksPerMultiprocessor(&per_cu, (const void*)mk_fwd, 512, LDS_BYTES) != hipSuccess || per_cu < 1) { fprintf(stderr, "kernel_launch: occupancy query says %d\n", per_cu); }
        (void)hipGetLastError();
        grid = cus;
        if (grid != 256) fprintf(stderr, "kernel_launch: %d CUs (built for 256)\n", grid);
    }
    if (grid < 0) return;
    if (hipMemsetAsync((char*)d_ws + WS_CTL, 0, CTL_ZERO_BYTES, stream) != hipSuccess) return;
    Args a{};
    for (int i = 0; i < 28; ++i) a.in[i] = (const float*)d_in[i];
    a.out = (float*)d_out; a.ws = (unsigned char*)d_ws;
#if MK_ONE_LAUNCH
    a.ph_lo = 0; a.ph_hi = N_PHASES;
    hipLaunchKernelGGL(mk_fwd, dim3(grid), dim3(512), LDS_BYTES, stream, a);
#else
#ifndef STOP_AFTER
#define STOP_AFTER (N_PHASES - 1)
#endif
#ifndef PHASE_MASK
#define PHASE_MASK 0xffffffffu
#endif
    for (int p = 0; p <= STOP_AFTER; ++p) { if (!((PHASE_MASK >> p) & 1u)) continue; a.ph_lo = p; a.ph_hi = p + 1; hipLaunchKernelGGL(mk_fwd, dim3(grid), dim3(512), LDS_BYTES, stream, a); }
#ifdef DUMP_OFF
    hipLaunchKernelGGL(dump_k, dim3(2048), dim3(256), 0, stream, (const unsigned short*)((const char*)d_ws + (size_t)(DUMP_OFF)), (float*)d_out);
#endif
#endif
}
```

```cpp
#define MK_ONE_LAUNCH 1
#include <hip/hip_runtime.h>
#include <cstdio>
#include <cstdint>

#define LAS __attribute__((address_space(3)))
#define GAS __attribute__((address_space(1)))
typedef unsigned short bf16;
typedef short bf16x8 __attribute__((ext_vector_type(8)));
typedef float f32x4 __attribute__((ext_vector_type(4)));
typedef float f32x2 __attribute__((ext_vector_type(2)));
typedef unsigned u32x4 __attribute__((ext_vector_type(4)));
typedef unsigned u32x2 __attribute__((ext_vector_type(2)));
typedef GAS unsigned gu32;

constexpr int NB = 8, SEQ = 4096, NTOK = NB * SEQ, DM = 1024, NIN = 6612, DEPTH = 2;
constexpr int NPA = 3584;
constexpr int NGT = 3072;
constexpr int NEXP = 32, DEXP = 256;
constexpr int MAXTILES = 288;
constexpr float DN_ALPHA = 1.41421356237309515f;
constexpr float LN_EPS = 1e-5f, RMS_EPS = 1e-6f;
constexpr int PA_Q = 0, PA_QI = 768, PA_BQ = 1024, PA_BK = 1280, PA_BV = 1536, PA_BR = 2048, PA_CU = 2560, PA_CV = 3072;

__device__ __forceinline__ unsigned f2bf(float f) { unsigned u = __builtin_bit_cast(unsigned, f); return (u + 0x7fffu + ((u >> 16) & 1u)) >> 16; }
__device__ __forceinline__ unsigned pk2(float lo, float hi) { return f2bf(lo) | (f2bf(hi) << 16); }
__device__ __forceinline__ float bflo(unsigned w) { return __builtin_bit_cast(float, w << 16); }
__device__ __forceinline__ float bfhi(unsigned w) { return __builtin_bit_cast(float, w & 0xffff0000u); }
__device__ __forceinline__ float bf1(bf16 h) { return __builtin_bit_cast(float, ((unsigned)h) << 16); }
typedef __bf16 bf16x2_t __attribute__((ext_vector_type(2)));
__device__ __forceinline__ unsigned cvt_pk_bf16(float lo, float hi) { const f32x2 v = {lo, hi}; const bf16x2_t b = __builtin_convertvector(v, bf16x2_t); return __builtin_bit_cast(unsigned, b); }
__device__ __forceinline__ float shx(float v, int mask, int lane) { return __builtin_bit_cast(float, __builtin_amdgcn_ds_bpermute((lane ^ mask) << 2, __builtin_bit_cast(int, v))); }
__device__ __forceinline__ int shxi(int v, int mask, int lane) { return __builtin_amdgcn_ds_bpermute((lane ^ mask) << 2, v); }
__device__ __forceinline__ float wave_sum(float v, int lane) {
#pragma unroll
    for (int o = 1; o < 64; o <<= 1) v += shx(v, o, lane);
    return v;
}
__device__ __forceinline__ float wave_max(float v, int lane) {
#pragma unroll
    for (int o = 1; o < 64; o <<= 1) v = fmaxf(v, shx(v, o, lane));
    return v;
}
__device__ __forceinline__ int wave_sum_i(int v, int lane) {
#pragma unroll
    for (int o = 1; o < 64; o <<= 1) v += shxi(v, o, lane);
    return v;
}
__device__ __forceinline__ int ld_i32(const GAS int* p) { return __hip_atomic_load(p, __ATOMIC_RELAXED, __HIP_MEMORY_SCOPE_AGENT); }
__device__ __forceinline__ float ld_f32(const GAS float* p) { return __hip_atomic_load(p, __ATOMIC_RELAXED, __HIP_MEMORY_SCOPE_AGENT); }
__device__ __forceinline__ float sigmoidf_(float x) { return __builtin_amdgcn_rcpf(1.0f + __expf(-x)); }
__device__ __forceinline__ float siluf_(float x) { return x * sigmoidf_(x); }
__device__ __forceinline__ float gelu_tanh_(float x) { const float u = 0.7978845608028654f * (x + 0.044715f * x * x * x); return x * sigmoidf_(2.0f * u); }

namespace pg8 {
constexpr int BM = 256, BK = 64, HALF = 128, HTB = HALF * BK * 2, STAGE_BYTES = 8 * HTB;
__host__ __device__ __forceinline__ int lds_byte(int r, int c) { const int st = (r >> 4) * 2 + (c >> 5), rr = r & 15, cc = c & 31, ob = rr * 64 + cc * 2; return st * 1024 + (ob ^ (((ob >> 9) & 1) << 5)); }
__host__ __device__ __forceinline__ void stage_rc(int b, int& R, int& C) { const int st = b / 1024, sb = b % 1024, swz = sb ^ (((sb >> 9) & 1) << 5); R = (st >> 1) * 16 + swz / 64; C = (st & 1) * 32 + (swz % 64) / 2; }
__host__ __device__ __forceinline__ int perm32(int rho) { const int n = rho >> 4, i = rho & 15; return 8 * (i >> 2) + 4 * n + (i & 3); }

struct Unit { int pm, pn, e, slot; };

template <class Epi, class Sched, bool GATHER>
__device__ __forceinline__ void gemm_phase(LAS unsigned char* lds, const Sched& S, const Epi& E, const int K, const int lda, const int wave) {
    unsigned z0_ = 0u; asm volatile("" : "+v"(z0_)); const int lane_ = (int)__builtin_amdgcn_mbcnt_hi(~0u, __builtin_amdgcn_mbcnt_lo(~0u, z0_));
    const int wid = wave, lane = lane_, tid = wid * 64 + lane, wr = wid >> 2, wc = wid & 3, fr = lane & 15, fq = lane >> 4;
    const int nt = K / BK;
    int Rr[2], Cc[2];
    unsigned voffB[2];
#pragma unroll
    for (int i = 0; i < 2; ++i) { int R, C; stage_rc(tid * 16 + i * 8192, R, C); Rr[i] = R; Cc[i] = C; const int Rb = Epi::PERM ? ((R & ~31) + perm32(R & 31)) : R; voffB[i] = (unsigned)(Rb * K + C) * 2u; }
    const size_t kstep = (size_t)(BK * 2);
    const size_t hstepB = (size_t)HALF * K * 2;
    const unsigned ldsw = (unsigned)wid * 1024u;
    const int aoff = lds_byte(wr * 64 + fr, fq * 8), boff = lds_byte(wc * 32 + fr, fq * 8);
#define PG8_SA(b, h) (((b) * 2 + (h)) * HTB)
#define PG8_SB(b, h) ((4 + (b) * 2 + (h)) * HTB)
#define PG8_STAGE(bufoff, gbase, voff) do { _Pragma("unroll") for (int _i = 0; _i < 2; ++_i) \
        __builtin_amdgcn_global_load_lds((const unsigned*)((const char*)(gbase) + (voff)[_i]), (LAS unsigned*)(lds + (bufoff) + ldsw + _i * 8192), 16, 0, 0); } while (0)
#define PG8_LDA(dst, b, h) do { _Pragma("unroll") for (int m = 0; m < 4; ++m) _Pragma("unroll") for (int k = 0; k < 2; ++k) dst[m][k] = *(const LAS bf16x8*)(lds + PG8_SA(b, h) + aoff + m * 2048 + k * 1024); } while (0)
#define PG8_LDB(dst, b, h) do { _Pragma("unroll") for (int n = 0; n < 2; ++n) _Pragma("unroll") for (int k = 0; k < 2; ++k) dst[n][k] = *(const LAS bf16x8*)(lds + PG8_SB(b, h) + boff + n * 2048 + k * 1024); } while (0)
#define PG8_MMA(ai, bj, At, Bt) do { __builtin_amdgcn_s_setprio(1); _Pragma("unroll") for (int m = 0; m < 4; ++m) _Pragma("unroll") for (int n = 0; n < 2; ++n) _Pragma("unroll") for (int k = 0; k < 2; ++k) \
        acc[ai][bj][m][n] = __builtin_amdgcn_mfma_f32_16x16x32_bf16(Bt[n][k], At[m][k], acc[ai][bj][m][n], 0, 0, 0); __builtin_amdgcn_s_setprio(0); } while (0)
#define PG8_WAIT_V(n) asm volatile("s_waitcnt vmcnt(" #n ")" ::: "memory")
#define PG8_WAIT_L(n) asm volatile("s_waitcnt lgkmcnt(" #n ")" ::: "memory")
#define PG8_BAR do { asm volatile("" ::: "memory"); __builtin_amdgcn_s_barrier(); asm volatile("" ::: "memory"); } while (0)
#define PG8_SCHED __builtin_amdgcn_sched_barrier(0)
    Unit cur, nxt; int ui = 0;
    if (!S.next(0, cur)) return;
    f32x4 acc[2][2][4][2];
#pragma unroll
    for (int a = 0; a < 2; ++a)
#pragma unroll
        for (int b = 0; b < 2; ++b)
#pragma unroll
            for (int m = 0; m < 4; ++m)
#pragma unroll
                for (int n = 0; n < 2; ++n) acc[a][b][m][n] = (f32x4){0.f, 0.f, 0.f, 0.f};
    bf16x8 At[4][2], B0[2][2], B1[2][2];
    unsigned cA0[2], cA1[2], nA0[2], nA1[2];
#pragma unroll
    for (int i = 0; i < 2; ++i) {
        if (GATHER) { cA0[i] = (unsigned)(S.row_of(cur, Rr[i]) * lda + Cc[i]) * 2u; cA1[i] = (unsigned)(S.row_of(cur, HALF + Rr[i]) * lda + Cc[i]) * 2u; }
        else { cA0[i] = (unsigned)(Rr[i] * lda + Cc[i]) * 2u; cA1[i] = (unsigned)((HALF + Rr[i]) * lda + Cc[i]) * 2u; }
        nA0[i] = cA0[i]; nA1[i] = cA1[i];
    }
    const char* cA = S.a_base(cur); const char* cB = S.b_base(cur);
    PG8_STAGE(PG8_SB(0, 0), cB, voffB); PG8_STAGE(PG8_SB(0, 1), cB + hstepB, voffB); PG8_STAGE(PG8_SA(0, 0), cA, cA0); PG8_STAGE(PG8_SA(0, 1), cA, cA1);
    if (wr == 1) PG8_BAR;
    PG8_WAIT_V(2); PG8_BAR;
    PG8_STAGE(PG8_SB(1, 0), cB + kstep, voffB); PG8_STAGE(PG8_SA(1, 0), cA + kstep, cA0); PG8_STAGE(PG8_SB(1, 1), cB + hstepB + kstep, voffB);
    PG8_WAIT_V(6); PG8_BAR;
    for (;;) {
        const bool has_next = S.next(ui + 1, nxt);
        const char* nA = has_next ? S.a_base(nxt) : cA; const char* nB = has_next ? S.b_base(nxt) : cB;
        if (GATHER) {
#pragma unroll
            for (int i = 0; i < 2; ++i) {
                if (has_next) { nA0[i] = (unsigned)(S.row_of(nxt, Rr[i]) * lda + Cc[i]) * 2u; nA1[i] = (unsigned)(S.row_of(nxt, HALF + Rr[i]) * lda + Cc[i]) * 2u; }
                else { nA0[i] = cA0[i]; nA1[i] = cA1[i]; }
            }
        }
#pragma unroll 1
        for (int t = 0; t < nt; t += 2) {
            const bool last = (t == nt - 2);
            const char* a1 = cA + (size_t)(t + 1) * kstep;
            const char* a2 = last ? nA : cA + (size_t)(t + 2) * kstep; const char* b2 = last ? nB : cB + (size_t)(t + 2) * kstep;
            const char* a3 = a2 + kstep; const char* b3 = b2 + kstep;
            unsigned x0[2], x1[2];
#pragma unroll
            for (int i = 0; i < 2; ++i) { x0[i] = (GATHER && last) ? nA0[i] : cA0[i]; x1[i] = (GATHER && last) ? nA1[i] : cA1[i]; }
            PG8_LDB(B0, 0, 0); PG8_LDB(B1, 0, 1); PG8_SCHED; PG8_LDA(At, 0, 0); PG8_STAGE(PG8_SA(1, 1), a1, cA1);
            PG8_WAIT_V(8); PG8_WAIT_L(0); PG8_BAR; PG8_MMA(0, 0, At, B0); PG8_MMA(0, 1, At, B1); PG8_BAR; PG8_SCHED;
            PG8_LDA(At, 0, 1); PG8_STAGE(PG8_SB(0, 0), b2, voffB); PG8_STAGE(PG8_SB(0, 1), b2 + hstepB, voffB); PG8_STAGE(PG8_SA(0, 0), a2, x0);
            PG8_WAIT_V(8); PG8_WAIT_L(0); PG8_BAR; PG8_MMA(1, 0, At, B0); PG8_MMA(1, 1, At, B1); PG8_BAR; PG8_SCHED;
            PG8_LDB(B0, 1, 0); PG8_LDB(B1, 1, 1); PG8_SCHED; PG8_LDA(At, 1, 0); PG8_STAGE(PG8_SA(0, 1), a2, x1);
            PG8_WAIT_V(8); PG8_WAIT_L(0); PG8_BAR; PG8_MMA(0, 0, At, B0); PG8_MMA(0, 1, At, B1); PG8_BAR; PG8_SCHED;
            PG8_LDA(At, 1, 1); PG8_STAGE(PG8_SB(1, 0), b3, voffB); PG8_STAGE(PG8_SB(1, 1), b3 + hstepB, voffB); PG8_STAGE(PG8_SA(1, 0), a3, x0);
            PG8_WAIT_V(8); PG8_WAIT_L(0); PG8_BAR; PG8_MMA(1, 0, At, B0); PG8_MMA(1, 1, At, B1); PG8_BAR; PG8_SCHED;
        }
        if (wr == 0) PG8_BAR;
        E(acc, cur, wr, wc, fr, fq);
        if (!has_next) break;
#pragma unroll
        for (int a = 0; a < 2; ++a)
#pragma unroll
            for (int b = 0; b < 2; ++b)
#pragma unroll
                for (int m = 0; m < 4; ++m)
#pragma unroll
                    for (int n = 0; n < 2; ++n) acc[a][b][m][n] = (f32x4){0.f, 0.f, 0.f, 0.f};
        cur = nxt; cA = nA; cB = nB; ++ui;
#pragma unroll
        for (int i = 0; i < 2; ++i) { cA0[i] = nA0[i]; cA1[i] = nA1[i]; }
        if (wr == 1) PG8_BAR;
    }
    PG8_WAIT_V(0);
    PG8_BAR;
#undef PG8_SA
#undef PG8_SB
#undef PG8_STAGE
#undef PG8_LDA
#undef PG8_LDB
#undef PG8_MMA
#undef PG8_WAIT_V
#undef PG8_WAIT_L
#undef PG8_BAR
#undef PG8_SCHED
}
}

#define XB_TMO      128
#define XB_XCNT(j)  (256  + 64 * (j))
#define XB_XSUB(j)  (1280 + 64 * (j))
#define XB_XGEN(j)  (2304 + 64 * (j))
#define XB_TOP      3328
#define XB_TOPGEN   3392
#define XCD_BAR_WORDS 3456
#define XB_SPIN_CAP (1u << 20)

__device__ __forceinline__ unsigned xb_ld(unsigned* p)              { return __hip_atomic_load(p, __ATOMIC_RELAXED, __HIP_MEMORY_SCOPE_AGENT); }
__device__ __forceinline__ unsigned xb_add(unsigned* p, unsigned v) { return __hip_atomic_fetch_add(p, v, __ATOMIC_RELAXED, __HIP_MEMORY_SCOPE_AGENT); }
__device__ __forceinline__ unsigned xb_xcc_id() { return (unsigned)__builtin_amdgcn_s_getreg((3 << 11) | 20) & 0xFu; }
#define XB_SPIN(cond, bar) do { unsigned _sp = 0; while (cond) { __builtin_amdgcn_s_sleep(1); \
    if ((++_sp & 255u) == 0u) { if (xb_ld(&(bar)[XB_TMO])) break; if (_sp > XB_SPIN_CAP) { atomicAdd(&(bar)[XB_TMO], 1u); break; } } } } while (0)

struct XcdBarrier { unsigned* bar; unsigned x; volatile LAS unsigned* st; };

__device__ __forceinline__ XcdBarrier xcd_barrier_post(unsigned* bar, volatile LAS unsigned* st) {
    XcdBarrier b; b.bar = bar; b.x = xb_xcc_id(); b.st = st;
    if (threadIdx.x == 0) (void)xb_add(&bar[XB_XCNT(b.x)], 1u);
    return b;
}
__device__ __forceinline__ void xcd_barrier_complete(unsigned* bar, unsigned x, unsigned& nloc, unsigned& nx) {
    const unsigned G = gridDim.x * gridDim.y * gridDim.z;
    unsigned sum, cnt, mine, sp = 0u;
    for (;;) {
        sum = 0u; cnt = 0u; mine = 0u;
#pragma unroll
        for (unsigned j = 0; j < 16; ++j) { const unsigned c = xb_ld(&bar[XB_XCNT(j)]); sum += c; cnt += (c > 0u) ? 1u : 0u; mine = (j == x) ? c : mine; }
        if (sum == G) break;
        __builtin_amdgcn_s_sleep(1);
        if ((++sp & 255u) == 0u) { if (xb_ld(&bar[XB_TMO])) break; if (sp > XB_SPIN_CAP) { atomicAdd(&bar[XB_TMO], 1u); break; } }
    }
    nloc = mine > 0u ? mine : 1u; nx = cnt > 0u ? cnt : 1u;
}
__device__ __forceinline__ void xcd_barrier(const XcdBarrier& b) {
    asm volatile("s_waitcnt vmcnt(0)" ::: "memory");
    __syncthreads();
    if (threadIdx.x == 0) {
        unsigned* bar = b.bar;
        __builtin_amdgcn_s_waitcnt(0);
        unsigned nloc = b.st[0], nx = b.st[1];
        if (nloc == 0u) { xcd_barrier_complete(bar, b.x, nloc, nx); b.st[0] = nloc; b.st[1] = nx; }
        const unsigned old = xb_add(&bar[XB_XSUB(b.x)], 1u);
        const unsigned gen = old / nloc;
        if (old + 1u == (gen + 1u) * nloc) {
            __builtin_amdgcn_fence(__ATOMIC_RELEASE, "agent");
            asm volatile("s_waitcnt vmcnt(0)" ::: "memory");
            const unsigned og = xb_add(&bar[XB_TOP], 1u);
            const unsigned tg = og / nx;
            if (og + 1u == (tg + 1u) * nx) xb_add(&bar[XB_TOPGEN], 1u);
            else XB_SPIN(xb_ld(&bar[XB_TOPGEN]) == tg, bar);
            __builtin_amdgcn_fence(__ATOMIC_ACQUIRE, "agent");
            xb_add(&bar[XB_XGEN(b.x)], 1u);
            asm volatile("s_waitcnt vmcnt(0)" ::: "memory");
        } else {
            XB_SPIN(xb_ld(&bar[XB_XGEN(b.x)]) == gen, bar);
            __builtin_amdgcn_fence(__ATOMIC_ACQUIRE, "agent");
            asm volatile("s_waitcnt vmcnt(0)" ::: "memory");
        }
    }
    __syncthreads();
}

constexpr size_t MiB = 1u << 20;
constexpr size_t WS_CTL = 0, CTL_ZERO_BYTES = 1 * MiB;
constexpr size_t WS_ROPE = 1 * MiB;
constexpr size_t WS_WI   = 3 * MiB;
constexpr size_t WS_ROUTE = 3 * MiB + 512 * 1024;
constexpr size_t WS_SROW = 4 * MiB;
constexpr size_t WS_ROWMAP = 4 * MiB + 256 * 1024;
constexpr size_t WS_CWROW = 4 * MiB + 640 * 1024;
constexpr size_t WS_CNTWG = 5 * MiB;
constexpr size_t WS_META = 5 * MiB + 64 * 1024;
constexpr size_t WS_WR = 5 * MiB + 128 * 1024;
constexpr size_t WS_GLR = 6 * MiB;
constexpr size_t WS_WDENSE = 8 * MiB;
constexpr size_t WD_WA = 0, WD_WG = 7 * MiB, WD_WBR = 13 * MiB, WD_WOUT = 16 * MiB, WD_LAYER = 18 * MiB;
constexpr size_t WS_WMOE = 44 * MiB;
constexpr size_t WM_GU = 0, WM_DN = 32 * MiB;
constexpr size_t WS_HB = 92 * MiB;
constexpr size_t WS_PA = 156 * MiB;
constexpr size_t WS_HID = WS_PA;
constexpr size_t WS_FF2 = WS_PA + 40 * MiB;
constexpr size_t WS_Y = 380 * MiB;
constexpr size_t WS_KA = 476 * MiB, WS_VA = 480 * MiB, WS_KI = 484 * MiB;
constexpr size_t WS_END = 512 * MiB;
static_assert(WS_WDENSE + 2 * WD_LAYER <= WS_WMOE && WS_WMOE + 48 * MiB <= WS_HB && WS_HB + 64 * MiB <= WS_PA && WS_PA + 224 * MiB <= WS_Y && WS_Y + 96 * MiB <= WS_KA && WS_KI + 4 * MiB <= WS_END, "ws map");
static_assert(WS_FF2 + (size_t)73728 * 1024 * 2 <= WS_Y, "ff2 fits");
constexpr int CW_BAR = 4096;
constexpr int CW_QUEUE = 16384;

constexpr int RING_BYTES = 131072;
constexpr int AUX_OFF = 131072;
constexpr int MISC_OFF = 147456;
constexpr int LDS_BYTES = 148480;

struct Frame {
    LAS unsigned char* lds;
    volatile LAS unsigned* MISC;
    gu32* ctl;
    int tid, lane, wave, G, wg;
    const float* const* in;
    const GAS int* pos;
    GAS float* H;
    GAS unsigned char* ws;
};

#define LDS_WAIT() asm volatile("s_waitcnt lgkmcnt(0)" ::: "memory")
#define VM_WAIT() asm volatile("s_waitcnt vmcnt(0)" ::: "memory")

__device__ __forceinline__ int pa_src_col(int c) {
    if (c < 512) return c;
    if (c < 768) { const int x = c - 512, half = x >> 7, y = x & 127, grp = y >> 5, d = (y & 31) + 32 * half;
        if (grp == 0) return 512 + d;
        if (grp == 1) return 576 + d;
        if (grp == 2) return 896 + d;
        if (half == 0) { const int z = y - 96; if (z < 4) return 960 + z; if (z < 20) return 1988 + (z - 4); }
        return -1; }
    if (c < 1024) return 640 + (c - 768);
    if (c < 1280) return 964 + (c - 1024);
    if (c < 1536) return 1220 + (c - 1280);
    if (c < 2048) return 1476 + (c - 1536);
    if (c < 2560) return 2004 + (c - 2048);
    return 2516 + (c - 2560);
}
__device__ __forceinline__ void transpose_item(const GAS float* W, int ldw, int K, GAS bf16* WT, int n0, int k0, int sc, LAS float* scr, int lane) {
#pragma unroll 8
    for (int i = 0; i < 32; ++i) { const int kk = 2 * i + (lane >> 5); scr[kk * 33 + (lane & 31)] = (sc >= 0) ? W[(size_t)(k0 + kk) * ldw + sc] : 0.f; }
    LDS_WAIT(); asm volatile("" ::: "memory");
    const int c = lane & 7;
#pragma unroll
    for (int j = 0; j < 4; ++j) { const int n = (lane >> 3) + 8 * j; const LAS float* s = scr + (8 * c) * 33 + n;
        u32x4 o; o.x = pk2(s[0 * 33], s[1 * 33]); o.y = pk2(s[2 * 33], s[3 * 33]); o.z = pk2(s[4 * 33], s[5 * 33]); o.w = pk2(s[6 * 33], s[7 * 33]);
        *(GAS u32x4*)(WT + (size_t)(n0 + n) * K + k0 + 8 * c) = o; }
    LDS_WAIT(); asm volatile("" ::: "memory");
}
__device__ __forceinline__ void conv_dense_item(Frame& F, int l, int it, LAS float* scr) {
    GAS bf16* base = (GAS bf16*)(F.ws + WS_WDENSE + (size_t)l * WD_LAYER);
    const int lane = F.lane;
    if (it < 1792) { const int kb = it / 112, nb = it % 112; const int sc = pa_src_col(32 * nb + (lane & 31));
        transpose_item(((const GAS float*)F.in[4]) + (size_t)l * DM * NIN, NIN, DM, base + WD_WA / 2, 32 * nb, 64 * kb, sc, scr, lane); return; }
    it -= 1792;
    if (it < 1536) { const int kb = it / 96, nb = it % 96; const int sc = 3540 + 32 * nb + (lane & 31);
        transpose_item(((const GAS float*)F.in[4]) + (size_t)l * DM * NIN, NIN, DM, base + WD_WG / 2, 32 * nb, 64 * kb, sc, scr, lane); return; }
    it -= 1536;
    if (it < 768) { const int br = it / 256, r = it % 256, kb = r / 32, nb = r % 32; const int sc = 32 * nb + (lane & 31);
        transpose_item((br == 0 ? ((const GAS float*)F.in[13]) : br == 1 ? ((const GAS float*)F.in[14]) : ((const GAS float*)F.in[15])) + (size_t)l * 512 * DM, DM, 512, base + WD_WBR / 2 + (size_t)br * 1024 * 512, 32 * nb, 64 * kb, sc, scr, lane); return; }
    it -= 768;
    { const int kb = it / 32, nb = it % 32; const int sc = 32 * nb + (lane & 31);
        transpose_item(((const GAS float*)F.in[16]) + (size_t)l * DM * DM, DM, DM, base + WD_WOUT / 2, 32 * nb, 64 * kb, sc, scr, lane); }
}
__device__ __forceinline__ void conv_moe_item(Frame& F, int l, int it, LAS float* scr) {
    const int lane = F.lane; const int e = it / 384; int r = it % 384;
    if (r < 256) { const int sub = r / 64, q = r % 64, ct = sub >> 1, bj = sub & 1, kb = q / 4, nb = q % 4;
        const GAS float* src = (bj ? ((const GAS float*)F.in[24]) : ((const GAS float*)F.in[23])) + (size_t)(l * NEXP + e) * DM * DEXP;
        GAS bf16* dst = (GAS bf16*)(F.ws + WS_WMOE + WM_GU) + (size_t)e * 512 * DM;
        transpose_item(src, DEXP, DM, dst, 256 * ct + 128 * bj + 32 * nb, 64 * kb, 128 * ct + 32 * nb + (lane & 31), scr, lane); return; }
    r -= 256;
    { const int kb = r / 32, nb = r % 32;
        const GAS float* src = ((const GAS float*)F.in[25]) + (size_t)(l * NEXP + e) * DEXP * DM;
        GAS bf16* dst = (GAS bf16*)(F.ws + WS_WMOE + WM_DN) + (size_t)e * DM * DEXP;
        transpose_item(src, DM, DEXP, dst, 32 * nb, 64 * kb, 32 * nb + (lane & 31), scr, lane); }
}

__device__ __forceinline__ void ln_row_regs(f32x4 (&v)[4], const GAS float* g, const GAS float* b, int lane) {
    float s = 0.f;
#pragma unroll
    for (int j = 0; j < 4; ++j) s += (v[j].x + v[j].y) + (v[j].z + v[j].w);
    const float mean = wave_sum(s, lane) * (1.f / DM); float s2 = 0.f;
#pragma unroll
    for (int j = 0; j < 4; ++j) { v[j] = v[j] - mean; s2 += (v[j].x * v[j].x + v[j].y * v[j].y) + (v[j].z * v[j].z + v[j].w * v[j].w); }
    const float rstd = 1.f / sqrtf(wave_sum(s2, lane) * (1.f / DM) + LN_EPS);
#pragma unroll
    for (int j = 0; j < 4; ++j) { const f32x4 gg = *(const GAS f32x4*)(g + 4 * lane + 256 * j), bb = *(const GAS f32x4*)(b + 4 * lane + 256 * j); v[j] = v[j] * rstd * gg + bb; }
}
__device__ __forceinline__ void store_row_f32_bf16(const f32x4 (&v)[4], GAS float* hrow, GAS bf16* brow, int lane) {
#pragma unroll
    for (int j = 0; j < 4; ++j) {
        if (hrow) *(GAS f32x4*)(hrow + 4 * lane + 256 * j) = v[j];
        if (brow) { u32x2 w; w.x = pk2(v[j].x, v[j].y); w.y = pk2(v[j].z, v[j].w); *(GAS u32x2*)(brow + 4 * lane + 256 * j) = w; }
    }
}

__device__ __forceinline__ void phase_prologue(Frame& F) {
    LAS float* scr = (LAS float*)(F.lds + F.wave * 16384);
    const int gw = F.wg * 8 + F.wave, NGW = F.G * 8;
    for (int it = gw; it < 2 * 4608; it += NGW) conv_dense_item(F, it / 4608, it % 4608, scr);
    { GAS float* WR = (GAS float*)(F.ws + WS_WR);
      for (int i = gw * 64 + F.lane; i < DEPTH * 36 * DM; i += NGW * 64) { const int l = i / (36 * DM), r = i % (36 * DM), o = r / DM, k = r % DM;
          WR[i] = (o < 4) ? ((const GAS float*)F.in[19])[(size_t)l * DM * 4 + k * 4 + o] : ((const GAS float*)F.in[21])[(size_t)l * DM * 32 + k * 32 + (o - 4)]; } }
    { GAS float* RT = (GAS float*)(F.ws + WS_ROPE);
      for (int i = gw * 64 + F.lane; i < NTOK * 8; i += NGW * 64) { const int n = i >> 3, j = i & 7;
          const float invf[8] = {1.000000000e+00f, 1.939227432e-01f, 3.760603070e-02f, 7.292664610e-03f, 1.414213562e-03f, 2.742481884e-04f, 5.318295734e-05f, 1.031338525e-05f};
          float inv = invf[0];
#pragma unroll
          for (int q = 1; q < 8; ++q) inv = (j == q) ? invf[q] : inv;
          const float ang = (float)F.pos[n] * inv;
          const double kq = __builtin_rint((double)ang * 0.15915494309189535);
          double r = (double)ang - kq * 6.283185307179586; double csign = 1.0;
          if (r > 1.5707963267948966) { r = 3.141592653589793 - r; csign = -1.0; } else if (r < -1.5707963267948966) { r = -3.141592653589793 - r; csign = -1.0; }
          const double x2 = r * r;
          const double sn = r * (1.0 + x2 * (-1.0 / 6 + x2 * (1.0 / 120 + x2 * (-1.0 / 5040 + x2 * (1.0 / 362880 + x2 * (-1.0 / 39916800 + x2 * (1.0 / 6227020800.0 + x2 * (-1.0 / 1307674368000.0))))))));
          const double cs = 1.0 + x2 * (-0.5 + x2 * (1.0 / 24 + x2 * (-1.0 / 720 + x2 * (1.0 / 40320 + x2 * (-1.0 / 3628800 + x2 * (1.0 / 479001600.0 + x2 * (-1.0 / 87178291200.0 + x2 * (1.0 / 20922789888000.0))))))));
          RT[n * 16 + j] = (float)(csign * cs); RT[n * 16 + 8 + j] = (float)sn; } }
    GAS bf16* HB = (GAS bf16*)(F.ws + WS_HB);
    for (int m = gw; m < NTOK; m += NGW) { f32x4 v[4];
#pragma unroll
        for (int j = 0; j < 4; ++j) v[j] = *(const GAS f32x4*)(((const GAS float*)F.in[0]) + (size_t)m * DM + 4 * F.lane + 256 * j);
        ln_row_regs(v, ((const GAS float*)F.in[2]), ((const GAS float*)F.in[3]), F.lane);
        store_row_f32_bf16(v, (GAS float*)nullptr, HB + (size_t)m * DM, F.lane); }
}

struct DenseSched {
    int nM, nN, nwg, G, c; const char* A; const char* B; size_t atile, btile; int nsub = 1; size_t asub = 0, bsub = 0;
    __device__ void init(int nM_, int nN_, int G_, int c_, const void* A_, size_t atile_, const void* B_, size_t btile_) { nM = nM_; nN = nN_; nwg = nM * nN; G = G_; c = c_; A = (const char*)A_; B = (const char*)B_; atile = atile_; btile = btile_; }
    __device__ __forceinline__ bool next(int i, pg8::Unit& u) const {
        const int it = i / nsub, sb = i - it * nsub;
        const long L = (long)it * G + c; if (L >= nwg) return false;
        int wgid = (int)L; { const int q = nwg / 8, r = nwg % 8, xcd = wgid % 8, off = wgid / 8; wgid = (xcd < r ? xcd * (q + 1) : r * (q + 1) + (xcd - r) * q) + off; }
        const int nig = 8 * nN, gid = wgid / nig, fm = gid * 8, gsz = (nM - fm) < 8 ? (nM - fm) : 8;
        u.pm = fm + ((wgid % nig) % gsz); u.pn = (wgid % nig) / gsz; u.e = sb; u.slot = i; return true;
    }
    __device__ __forceinline__ const char* a_base(const pg8::Unit& u) const { return A + (size_t)u.pm * atile + (size_t)u.e * asub; }
    __device__ __forceinline__ const char* b_base(const pg8::Unit& u) const { return B + (size_t)u.pn * btile + (size_t)u.e * bsub; }
    __device__ __forceinline__ int row_of(const pg8::Unit&, int) const { return 0; }
};
struct GroupSched {
    int NU, G, c, ncol; const char* A; const char* B; size_t atile, erows_bytes, btile; const LAS int* meta; const LAS int* rows;
    __device__ __forceinline__ bool next(int i, pg8::Unit& u) const {
        const int L = i * G + c; if (L >= NU) return false;
        u.pm = L / ncol; u.pn = L % ncol; u.slot = i; u.e = meta[i]; return true;
    }
    __device__ __forceinline__ const char* a_base(const pg8::Unit& u) const { return A + (size_t)u.pm * atile; }
    __device__ __forceinline__ const char* b_base(const pg8::Unit& u) const { return B + (size_t)u.e * erows_bytes + (size_t)u.pn * btile; }
    __device__ __forceinline__ int row_of(const pg8::Unit& u, int r) const { return rows[u.slot * 256 + r]; }
};

struct EpiA {
    static constexpr bool PERM = true;
    GAS bf16* PA; GAS bf16* KA; GAS bf16* VA; GAS bf16* KI; GAS float* WI; GAS float* GLR; const GAS float* ROPE; const GAS float* ikg;
    __device__ __forceinline__ static void rope8(float (&x)[8], const GAS float* rt, int fq, int lane) {
        const f32x4 c0 = *(const GAS f32x4*)(rt), c1 = *(const GAS f32x4*)(rt + 4), s0 = *(const GAS f32x4*)(rt + 8), s1 = *(const GAS f32x4*)(rt + 12);
#pragma unroll
        for (int i = 0; i < 8; ++i) { const float p = shx(x[i], 16, lane); const float cc = (i < 4) ? c0[i & 3] : c1[i & 3], ss = (i < 4) ? s0[i & 3] : s1[i & 3];
            const float r = x[i] * cc + ((fq == 0) ? -p : p) * ss; x[i] = (fq < 2) ? r : x[i]; }
    }
    __device__ __forceinline__ static u32x4 pack8(const float (&x)[8]) { u32x4 w; w.x = cvt_pk_bf16(x[0], x[1]); w.y = cvt_pk_bf16(x[2], x[3]); w.z = cvt_pk_bf16(x[4], x[5]); w.w = cvt_pk_bf16(x[6], x[7]); return w; }
    __device__ __forceinline__ void operator()(const f32x4 (&acc)[2][2][4][2], const pg8::Unit& u, int wr, int wc, int fr, int fq) const {
        const int pn = u.pn; const int rowb = u.pm * 256 + wr * 64 + fr; const int lane = fq * 16 + fr;
        if (pn == 2) {
#pragma unroll
            for (int ai = 0; ai < 2; ++ai)
#pragma unroll
                for (int m = 0; m < 4; ++m) {
                    const int row = rowb + ai * 128 + m * 16;
                    float x0[8], x1[8];
#pragma unroll
                    for (int i = 0; i < 8; ++i) { x0[i] = acc[ai][0][m][i >> 2][i & 3]; x1[i] = acc[ai][1][m][i >> 2][i & 3]; }
                    if (wc == 2) {
                        float s = 0.f;
#pragma unroll
                        for (int i = 0; i < 8; ++i) s += x0[i] + x1[i];
                        s += shx(s, 16, lane); s += shx(s, 32, lane);
                        const float mean = s * (1.f / 64.f); float q = 0.f;
#pragma unroll
                        for (int i = 0; i < 8; ++i) { x0[i] -= mean; x1[i] -= mean; q += x0[i] * x0[i] + x1[i] * x1[i]; }
                        q += shx(q, 16, lane); q += shx(q, 32, lane);
                        const float rstd = 1.f / sqrtf(q * (1.f / 64.f) + LN_EPS);
#pragma unroll
                        for (int i = 0; i < 8; ++i) { x0[i] = x0[i] * rstd * ikg[8 * fq + i]; x1[i] = x1[i] * rstd * ikg[32 + 8 * fq + i]; }
                    }
                    if (wc == 0 || wc == 2) rope8(x0, ROPE + (size_t)row * 16, fq, lane);
                    if (wc < 3) {
                        GAS bf16* dst = (wc == 0) ? KA : (wc == 1) ? VA : KI;
                        *(GAS u32x4*)(dst + (size_t)row * 64 + 8 * fq) = pack8(x0); *(GAS u32x4*)(dst + (size_t)row * 64 + 32 + 8 * fq) = pack8(x1);
                    } else {
                        if (fq == 0) { *(GAS f32x4*)(WI + (size_t)row * 4) = (f32x4){x0[0], x0[1], x0[2], x0[3]} * 0.0625f; *(GAS f32x4*)(GLR + (size_t)row * 16) = (f32x4){x0[4], x0[5], x0[6], x0[7]}; }
                        else if (fq == 1) { *(GAS f32x4*)(GLR + (size_t)row * 16 + 4) = (f32x4){x0[0], x0[1], x0[2], x0[3]}; *(GAS f32x4*)(GLR + (size_t)row * 16 + 8) = (f32x4){x0[4], x0[5], x0[6], x0[7]}; }
                        else if (fq == 2) { *(GAS f32x4*)(GLR + (size_t)row * 16 + 12) = (f32x4){x0[0], x0[1], x0[2], x0[3]}; }
                    }
                    asm volatile("" ::: "memory");
                }
        } else if (pn < 2 || pn == 3) {
            const float sc = (pn == 3) ? 1.0f : 0.125f; const bool rope = !(wc & 1);
#pragma unroll
            for (int ai = 0; ai < 2; ++ai)
#pragma unroll
                for (int m = 0; m < 4; ++m) {
                    const int row = rowb + ai * 128 + m * 16;
#pragma unroll
                    for (int bj = 0; bj < 2; ++bj) { float x[8];
#pragma unroll
                        for (int i = 0; i < 8; ++i) x[i] = acc[ai][bj][m][i >> 2][i & 3];
                        if (rope) rope8(x, ROPE + (size_t)row * 16, fq, lane);
#pragma unroll
                        for (int i = 0; i < 8; ++i) x[i] *= sc;
                        *(GAS u32x4*)(PA + (size_t)row * NPA + 256 * pn + 128 * bj + 32 * wc + 8 * fq) = pack8(x); }
                    asm volatile("" ::: "memory");
                }
        } else {
            const int act = (pn == 8 || pn == 9) ? 1 : (pn >= 10) ? 2 : 0; const float sc = (pn == 4) ? 0.125f : 1.0f;
#pragma unroll
            for (int ai = 0; ai < 2; ++ai)
#pragma unroll
                for (int m = 0; m < 4; ++m) {
                    const int row = rowb + ai * 128 + m * 16;
#pragma unroll
                    for (int bj = 0; bj < 2; ++bj) { float x[8];
#pragma unroll
                        for (int i = 0; i < 8; ++i) { const float v = acc[ai][bj][m][i >> 2][i & 3]; x[i] = (act == 1) ? siluf_(v) : (act == 2) ? gelu_tanh_(v) : v * sc; }
                        *(GAS u32x4*)(PA + (size_t)row * NPA + 256 * pn + 128 * bj + 32 * wc + 8 * fq) = pack8(x); }
                    asm volatile("" ::: "memory");
                }
        }
    }
};
struct EpiG {
    static constexpr bool PERM = true;
    GAS bf16* G;
    __device__ __forceinline__ void operator()(const f32x4 (&acc)[2][2][4][2], const pg8::Unit& u, int wr, int wc, int fr, int fq) const {
        const int rowb = u.pm * 256 + wr * 64 + fr;
#pragma unroll
        for (int ai = 0; ai < 2; ++ai)
#pragma unroll
            for (int m = 0; m < 4; ++m) { const int row = rowb + ai * 128 + m * 16;
#pragma unroll
                for (int bj = 0; bj < 2; ++bj) { float x[8];
#pragma unroll
                    for (int i = 0; i < 8; ++i) x[i] = sigmoidf_(acc[ai][bj][m][i >> 2][i & 3]);
                    u32x4 w; w.x = cvt_pk_bf16(x[0], x[1]); w.y = cvt_pk_bf16(x[2], x[3]); w.z = cvt_pk_bf16(x[4], x[5]); w.w = cvt_pk_bf16(x[6], x[7]);
                    *(GAS u32x4*)(G + (size_t)row * NGT + 256 * u.pn + 128 * bj + 32 * wc + 8 * fq) = w; }
#ifdef EPIG_DRAIN
                asm volatile("s_waitcnt vmcnt(0)" ::: "memory");
#endif
            }
    }
};
struct EpiM {
    static constexpr bool PERM = true;
    const GAS bf16* G; GAS bf16* HM;
    __device__ __forceinline__ void operator()(const f32x4 (&acc)[2][2][4][2], const pg8::Unit& u, int wr, int wc, int fr, int fq) const {
        const int rowb = u.pm * 256 + wr * 64 + fr; const int br = u.e;
#pragma unroll
        for (int ai = 0; ai < 2; ++ai)
#pragma unroll
            for (int m = 0; m < 4; ++m) { const int row = rowb + ai * 128 + m * 16;
#pragma unroll
                for (int bj = 0; bj < 2; ++bj) { const int col = 256 * u.pn + 128 * bj + 32 * wc + 8 * fq;
                    const u32x4 g = *(const GAS u32x4*)(G + (size_t)row * NGT + 1024 * br + col);
                    float x[8];
                    x[0] = bflo(g.x) * acc[ai][bj][m][0][0]; x[1] = bfhi(g.x) * acc[ai][bj][m][0][1]; x[2] = bflo(g.y) * acc[ai][bj][m][0][2]; x[3] = bfhi(g.y) * acc[ai][bj][m][0][3];
                    x[4] = bflo(g.z) * acc[ai][bj][m][1][0]; x[5] = bfhi(g.z) * acc[ai][bj][m][1][1]; x[6] = bflo(g.w) * acc[ai][bj][m][1][2]; x[7] = bfhi(g.w) * acc[ai][bj][m][1][3];
                    if (br > 0) { const u32x4 o = *(const GAS u32x4*)(HM + (size_t)row * DM + col);
                        x[0] += bflo(o.x); x[1] += bfhi(o.x); x[2] += bflo(o.y); x[3] += bfhi(o.y); x[4] += bflo(o.z); x[5] += bfhi(o.z); x[6] += bflo(o.w); x[7] += bfhi(o.w); }
                    u32x4 w; w.x = cvt_pk_bf16(x[0], x[1]); w.y = cvt_pk_bf16(x[2], x[3]); w.z = cvt_pk_bf16(x[4], x[5]); w.w = cvt_pk_bf16(x[6], x[7]);
                    *(GAS u32x4*)(HM + (size_t)row * DM + col) = w; }
                asm volatile("" ::: "memory"); }
    }
};
struct EpiO {
    static constexpr bool PERM = true;
    const GAS bf16* HBr; GAS bf16* T;
    __device__ __forceinline__ void operator()(const f32x4 (&acc)[2][2][4][2], const pg8::Unit& u, int wr, int wc, int fr, int fq) const {
        const int rowb = u.pm * 256 + wr * 64 + fr;
#pragma unroll
        for (int ai = 0; ai < 2; ++ai)
#pragma unroll
            for (int m = 0; m < 4; ++m) { const int row = rowb + ai * 128 + m * 16;
#pragma unroll
                for (int bj = 0; bj < 2; ++bj) { const size_t off = (size_t)row * DM + 256 * u.pn + 128 * bj + 32 * wc + 8 * fq;
                    const u32x4 h = *(const GAS u32x4*)(HBr + off);
                    u32x4 w; w.x = cvt_pk_bf16(bflo(h.x) * DN_ALPHA + acc[ai][bj][m][0][0], bfhi(h.x) * DN_ALPHA + acc[ai][bj][m][0][1]); w.y = cvt_pk_bf16(bflo(h.y) * DN_ALPHA + acc[ai][bj][m][0][2], bfhi(h.y) * DN_ALPHA + acc[ai][bj][m][0][3]);
                    w.z = cvt_pk_bf16(bflo(h.z) * DN_ALPHA + acc[ai][bj][m][1][0], bfhi(h.z) * DN_ALPHA + acc[ai][bj][m][1][1]); w.w = cvt_pk_bf16(bflo(h.w) * DN_ALPHA + acc[ai][bj][m][1][2], bfhi(h.w) * DN_ALPHA + acc[ai][bj][m][1][3]);
                    *(GAS u32x4*)(T + off) = w; }
                asm volatile("" ::: "memory"); }
    }
};
struct EpiGU {
    static constexpr bool PERM = true;
    GAS bf16* HID; const GAS float* CW;
    __device__ __forceinline__ void operator()(const f32x4 (&acc)[2][2][4][2], const pg8::Unit& u, int wr, int wc, int fr, int fq) const {
        const int rowb = u.pm * 256 + wr * 64 + fr;
#pragma unroll
        for (int ai = 0; ai < 2; ++ai)
#pragma unroll
            for (int m = 0; m < 4; ++m) { const int row = rowb + ai * 128 + m * 16; const float cw = CW[row];
                float x[8];
#pragma unroll
                for (int i = 0; i < 8; ++i) x[i] = siluf_(acc[ai][0][m][i >> 2][i & 3]) * acc[ai][1][m][i >> 2][i & 3] * cw;
                u32x4 w; w.x = cvt_pk_bf16(x[0], x[1]); w.y = cvt_pk_bf16(x[2], x[3]); w.z = cvt_pk_bf16(x[4], x[5]); w.w = cvt_pk_bf16(x[6], x[7]);
                *(GAS u32x4*)(HID + (size_t)row * DEXP + 128 * u.pn + 32 * wc + 8 * fq) = w; }
    }
};
struct EpiDN {
    static constexpr bool PERM = true;
    GAS bf16* FF2;
    __device__ __forceinline__ void operator()(const f32x4 (&acc)[2][2][4][2], const pg8::Unit& u, int wr, int wc, int fr, int fq) const {
        const int rowb = u.pm * 256 + wr * 64 + fr;
#pragma unroll
        for (int ai = 0; ai < 2; ++ai)
#pragma unroll
            for (int m = 0; m < 4; ++m) { const int row = rowb + ai * 128 + m * 16;
#pragma unroll
                for (int bj = 0; bj < 2; ++bj) { u32x4 w; w.x = cvt_pk_bf16(acc[ai][bj][m][0][0], acc[ai][bj][m][0][1]); w.y = cvt_pk_bf16(acc[ai][bj][m][0][2], acc[ai][bj][m][0][3]);
                    w.z = cvt_pk_bf16(acc[ai][bj][m][1][0], acc[ai][bj][m][1][1]); w.w = cvt_pk_bf16(acc[ai][bj][m][1][2], acc[ai][bj][m][1][3]);
                    *(GAS u32x4*)(FF2 + (size_t)row * DM + 256 * u.pn + 128 * bj + 32 * wc + 8 * fq) = w; } }
    }
};
#ifndef EN_B1
#define EN_B1 1
#endif
#ifndef EN_B2
#define EN_B2 1
#endif
#ifndef EN_B3
#define EN_B3 1
#endif

template <int CTRL> __device__ __forceinline__ float dppf(float x) { return __builtin_bit_cast(float, __builtin_amdgcn_mov_dpp(__builtin_bit_cast(int, x), CTRL, 0xf, 0xf, true)); }
template <int CTRL> __device__ __forceinline__ int dppi(int x) { return __builtin_amdgcn_mov_dpp(x, CTRL, 0xf, 0xf, true); }
typedef short v4i16_t __attribute__((ext_vector_type(4)));
__device__ __forceinline__ v4i16_t ldtr(const LAS unsigned char* p) { return __builtin_amdgcn_ds_read_tr16_b64_v4i16((LAS v4i16_t*)p); }
__device__ __forceinline__ bf16x8 cat8(v4i16_t lo, v4i16_t hi) { bf16x8 r; r[0] = lo[0]; r[1] = lo[1]; r[2] = lo[2]; r[3] = lo[3]; r[4] = hi[0]; r[5] = hi[1]; r[6] = hi[2]; r[7] = hi[3]; return r; }
__device__ __forceinline__ int wave_total_i(int v) {
    v += dppi<0xB1>(v); v += dppi<0x4E>(v); v += dppi<0x141>(v); v += dppi<0x140>(v);
    return __builtin_amdgcn_readlane(v, 0) + __builtin_amdgcn_readlane(v, 16) + __builtin_amdgcn_readlane(v, 32) + __builtin_amdgcn_readlane(v, 48);
}
__device__ __forceinline__ void gmlp_unit(Frame& F, int l, int unit) {
    int tid = F.tid; asm volatile("" : "+v"(tid)); const int lane = tid & 63;
    const int chunk = unit >> 2, g = unit & 3, n0 = chunk * 128;
    const GAS bf16* PA = (const GAS bf16*)(F.ws + WS_PA); GAS bf16* Y = (GAS bf16*)(F.ws + WS_Y);
    LAS float* vln = (LAS float*)F.lds;
    LAS float* wl = (LAS float*)(F.lds + 65536);
    LAS float* st = (LAS float*)(F.lds + AUX_OFF);
    const GAS float* lng = ((const GAS float*)F.in[9]) + l * 512; const GAS float* lnb = ((const GAS float*)F.in[10]) + l * 512;
    for (int j = 0; j < 16; ++j) { const int s = F.wave * 16 + j;
        const u32x4 w = *(const GAS u32x4*)(PA + (size_t)(n0 + s) * NPA + PA_CV + 8 * lane);
        float x[8] = {bflo(w.x), bfhi(w.x), bflo(w.y), bfhi(w.y), bflo(w.z), bfhi(w.z), bflo(w.w), bfhi(w.w)};
        float sm = 0.f;
#pragma unroll
        for (int i = 0; i < 8; ++i) sm += x[i];
        const float mean = wave_sum(sm, lane) * (1.f / 512.f); float q = 0.f;
#pragma unroll
        for (int i = 0; i < 8; ++i) { const float d = x[i] - mean; q += d * d; }
        const float rstd = 1.f / sqrtf(wave_sum(q, lane) * (1.f / 512.f) + LN_EPS);
        if (lane == 0) { st[2 * s] = mean; st[2 * s + 1] = rstd; } }
    __syncthreads();
#pragma unroll
    for (int i = 0; i < 4; ++i) { const int q = tid + 512 * i, s = q >> 4, d0 = (q & 15) * 8;
        const u32x4 w = *(const GAS u32x4*)(PA + (size_t)(n0 + s) * NPA + PA_CV + g * 128 + d0);
        const float mean = st[2 * s], rstd = st[2 * s + 1];
        float x[8] = {bflo(w.x), bfhi(w.x), bflo(w.y), bfhi(w.y), bflo(w.z), bfhi(w.z), bflo(w.w), bfhi(w.w)};
#pragma unroll
        for (int k = 0; k < 8; ++k) x[k] = (x[k] - mean) * rstd * lng[g * 128 + d0 + k] + lnb[g * 128 + d0 + k];
        *(LAS f32x4*)(vln + s * 128 + d0) = (f32x4){x[0], x[1], x[2], x[3]}; *(LAS f32x4*)(vln + s * 128 + d0 + 4) = (f32x4){x[4], x[5], x[6], x[7]}; }
    const GAS float* ws = ((const GAS float*)F.in[11]) + ((size_t)l * 4 + g) * 128 * 128;
#pragma unroll
    for (int i = 0; i < 8; ++i) { const int q = tid + 512 * i, t = q >> 5, s0 = (q & 31) * 4;
        f32x4 w = *(const GAS f32x4*)(ws + t * 128 + s0);
        if (s0 + 0 > t) w.x = 0.f; if (s0 + 1 > t) w.y = 0.f; if (s0 + 2 > t) w.z = 0.f; if (s0 + 3 > t) w.w = 0.f;
        *(LAS f32x4*)(wl + t * 128 + s0) = w; }
    __syncthreads();
    const int d = tid & 127, tq = __builtin_amdgcn_readfirstlane(tid >> 7);
    float vr[128];
#pragma unroll
    for (int sb = 0; sb < 4; ++sb)
        if (sb <= tq) {
#pragma unroll
            for (int s = 0; s < 32; ++s) vr[sb * 32 + s] = vln[(sb * 32 + s) * 128 + d];
        } else {
#pragma unroll
            for (int s = 0; s < 32; ++s) vr[sb * 32 + s] = 0.f;
        }
    const GAS float* bs = ((const GAS float*)F.in[12]) + ((size_t)l * 4 + g) * 128;
#pragma unroll 1
    for (int ti = 0; ti < 32; ++ti) { const int t = tq * 32 + ti; float a = 0.f;
#pragma unroll
        for (int sb = 0; sb < 4; ++sb)
            if (sb <= tq) {
#pragma unroll
                for (int s4 = 0; s4 < 8; ++s4) { const f32x4 w = *(const LAS f32x4*)(wl + t * 128 + sb * 32 + s4 * 4);
                    a += w.x * vr[sb * 32 + s4 * 4] + w.y * vr[sb * 32 + s4 * 4 + 1] + w.z * vr[sb * 32 + s4 * 4 + 2] + w.w * vr[sb * 32 + s4 * 4 + 3]; }
            }
        const float uu = bf1(PA[(size_t)(n0 + t) * NPA + PA_CU + g * 128 + d]);
        Y[(size_t)(n0 + t) * 1536 + 1024 + g * 128 + d] = (bf16)f2bf(uu * (a + bs[t])); }
    __syncthreads();
}

__device__ __forceinline__ void gmlp16_unit(Frame& F, int l, int chunk) {
    int tid = F.tid; asm volatile("" : "+v"(tid)); const int lane = tid & 63, w = F.wave, fr = lane & 15, fq = lane >> 4;
    const size_t n0 = (size_t)chunk * 128;
    const GAS bf16* PA = (const GAS bf16*)(F.ws + WS_PA); GAS bf16* Y = (GAS bf16*)(F.ws + WS_Y);
    LAS unsigned char* VT = F.lds;
    LAS unsigned char* WT = F.lds + 32768;
    LAS float* st = (LAS float*)(F.lds + AUX_OFF);
    const GAS float* lng = ((const GAS float*)F.in[9]) + l * 512; const GAS float* lnb = ((const GAS float*)F.in[10]) + l * 512;
    for (int j = 0; j < 16; ++j) { const int s = w * 16 + j;
        const u32x4 x4 = *(const GAS u32x4*)(PA + (n0 + s) * NPA + PA_CV + 8 * lane);
        float x[8] = {bflo(x4.x), bfhi(x4.x), bflo(x4.y), bfhi(x4.y), bflo(x4.z), bfhi(x4.z), bflo(x4.w), bfhi(x4.w)};
        float sm = 0.f;
#pragma unroll
        for (int i = 0; i < 8; ++i) sm += x[i];
        const float mean = wave_sum(sm, lane) * (1.f / 512.f); float q = 0.f;
#pragma unroll
        for (int i = 0; i < 8; ++i) { const float d = x[i] - mean; q += d * d; }
        const float rstd = 1.f / sqrtf(wave_sum(q, lane) * (1.f / 512.f) + LN_EPS);
        if (lane == 0) { st[2 * s] = mean; st[2 * s + 1] = rstd; } }
    __syncthreads();
#pragma unroll 1
    for (int g = 0; g < 4; ++g) {
        const GAS float* ws = ((const GAS float*)F.in[11]) + ((size_t)l * 4 + g) * 128 * 128;
#pragma unroll
        for (int i = 0; i < 4; ++i) { const int q = tid + 512 * i, s = q >> 4, d0 = (q & 15) * 8;
            const u32x4 x4 = *(const GAS u32x4*)(PA + (n0 + s) * NPA + PA_CV + g * 128 + d0);
            const float mean = st[2 * s], rstd = st[2 * s + 1];
            float x[8] = {bflo(x4.x), bfhi(x4.x), bflo(x4.y), bfhi(x4.y), bflo(x4.z), bfhi(x4.z), bflo(x4.w), bfhi(x4.w)};
            const f32x4 g0 = *(const GAS f32x4*)(lng + g * 128 + d0), g1 = *(const GAS f32x4*)(lng + g * 128 + d0 + 4), b0 = *(const GAS f32x4*)(lnb + g * 128 + d0), b1 = *(const GAS f32x4*)(lnb + g * 128 + d0 + 4);
#pragma unroll
            for (int k = 0; k < 8; ++k) x[k] = (x[k] - mean) * rstd * ((k < 4) ? g0[k & 3] : g1[k & 3]) + ((k < 4) ? b0[k & 3] : b1[k & 3]);
            u32x4 o; o.x = cvt_pk_bf16(x[0], x[1]); o.y = cvt_pk_bf16(x[2], x[3]); o.z = cvt_pk_bf16(x[4], x[5]); o.w = cvt_pk_bf16(x[6], x[7]);
            *(LAS u32x4*)(VT + s * 256 + d0 * 2) = o;
            const int t = s, s0 = d0;
            f32x4 w0 = *(const GAS f32x4*)(ws + t * 128 + s0), w1 = *(const GAS f32x4*)(ws + t * 128 + s0 + 4);
            float wv[8] = {w0.x, w0.y, w0.z, w0.w, w1.x, w1.y, w1.z, w1.w};
#pragma unroll
            for (int k = 0; k < 8; ++k) wv[k] = (s0 + k <= t) ? wv[k] : 0.f;
            u32x4 ow; ow.x = cvt_pk_bf16(wv[0], wv[1]); ow.y = cvt_pk_bf16(wv[2], wv[3]); ow.z = cvt_pk_bf16(wv[4], wv[5]); ow.w = cvt_pk_bf16(wv[6], wv[7]);
            *(LAS u32x4*)(WT + t * 256 + s0 * 2) = ow; }
        __syncthreads();
        f32x4 acc[8];
#pragma unroll
        for (int nt = 0; nt < 8; ++nt) acc[nt] = (f32x4){0.f, 0.f, 0.f, 0.f};
        const int nks = (16 * w + 15) / 32 + 1;
#pragma unroll
        for (int ks = 0; ks < 4; ++ks) if (ks < nks) {
            const bf16x8 a = *(const LAS bf16x8*)(WT + (16 * w + fr) * 256 + (8 * fq + 32 * ks) * 2);
            const int srow = 32 * ks + 8 * fq + (fr >> 2);
#pragma unroll
            for (int nt = 0; nt < 8; ++nt) { const bf16x8 bv = cat8(ldtr(VT + srow * 256 + (16 * nt + 4 * (fr & 3)) * 2), ldtr(VT + (srow + 4) * 256 + (16 * nt + 4 * (fr & 3)) * 2));
                acc[nt] = __builtin_amdgcn_mfma_f32_16x16x32_bf16(a, bv, acc[nt], 0, 0, 0); } }
        const GAS float* bs = ((const GAS float*)F.in[12]) + ((size_t)l * 4 + g) * 128;
#pragma unroll
        for (int r = 0; r < 4; ++r) { const int t = 16 * w + 4 * fq + r; const float bt = bs[t];
#pragma unroll
            for (int nt = 0; nt < 8; ++nt) { const int d = 16 * nt + fr;
                const float uu = bf1(PA[(n0 + t) * NPA + PA_CU + g * 128 + d]);
                Y[(n0 + t) * 1536 + 1024 + g * 128 + d] = (bf16)f2bf(uu * (acc[nt][r] + bt)); } }
        __syncthreads();
    }
}

__device__ __forceinline__ void gla_unit(Frame& F, int l, int unit) {
    int tid = F.tid; asm volatile("" : "+v"(tid));
    const int b = unit >> 2, h = unit & 3;
    const GAS bf16* PA = (const GAS bf16*)(F.ws + WS_PA); GAS bf16* Y = (GAS bf16*)(F.ws + WS_Y); const GAS float* GLR = (const GAS float*)(F.ws + WS_GLR);
    LAS float* wa = (LAS float*)F.lds;
    LAS float* ba = wa + 1024;
    LAS float* as_ = ba + 64;
    LAS float* qs = as_ + 1024;
    LAS float* ks = qs + 1024;
    LAS float* vs = ks + 1024;
    LAS float* part = vs + 2048;
    for (int i = tid; i < 1024; i += 512) wa[i] = ((const GAS float*)F.in[6])[(size_t)l * 16 * 256 + (i >> 6) * 256 + h * 64 + (i & 63)];
    if (tid < 64) ba[tid] = ((const GAS float*)F.in[7])[l * 256 + h * 64 + tid];
    const GAS float* gng = ((const GAS float*)F.in[8]) + l * 128;
    const int v = tid & 127, kq = __builtin_amdgcn_readfirstlane(tid >> 7);
    float S[16];
#pragma unroll
    for (int j = 0; j < 16; ++j) S[j] = 0.f;
    __syncthreads();
    for (int t0 = 0; t0 < SEQ; t0 += 16) {
        const size_t nb = (size_t)b * SEQ + t0;
#pragma unroll
        for (int i = 0; i < 2; ++i) { const int e = tid + 512 * i, t = e >> 6, k = e & 63; float z = ba[k];
#pragma unroll
            for (int r = 0; r < 16; ++r) z += GLR[(nb + t) * 16 + r] * wa[r * 64 + k];
            const float ls = fminf(z, 0.f) - log1pf(__expf(-fabsf(z)));
            as_[e] = __expf(ls * (1.f / 16.f));
            qs[e] = bf1(PA[(nb + t) * NPA + PA_BQ + h * 64 + k]); ks[e] = bf1(PA[(nb + t) * NPA + PA_BK + h * 64 + k]); }
#pragma unroll
        for (int i = 0; i < 4; ++i) { const int e = tid + 512 * i, t = e >> 7, vv = e & 127; vs[e] = bf1(PA[(nb + t) * NPA + PA_BV + h * 128 + vv]); }
        __syncthreads();
#pragma unroll 4
        for (int t = 0; t < 16; ++t) { const float vt = vs[t * 128 + v]; float p = 0.f;
#pragma unroll
            for (int j4 = 0; j4 < 4; ++j4) { const f32x4 a4 = *(const LAS f32x4*)(as_ + t * 64 + kq * 16 + j4 * 4), k4 = *(const LAS f32x4*)(ks + t * 64 + kq * 16 + j4 * 4), q4 = *(const LAS f32x4*)(qs + t * 64 + kq * 16 + j4 * 4);
#pragma unroll
                for (int j = 0; j < 4; ++j) { S[j4 * 4 + j] = a4[j] * S[j4 * 4 + j] + k4[j] * vt; p += q4[j] * S[j4 * 4 + j]; } }
            part[(kq * 16 + t) * 128 + v] = p; }
        __syncthreads();
        { const int t = tid >> 5, v4 = (tid & 31) * 4;
          f32x4 o = *(const LAS f32x4*)(part + (0 * 16 + t) * 128 + v4);
#pragma unroll
          for (int q = 1; q < 4; ++q) o += *(const LAS f32x4*)(part + (q * 16 + t) * 128 + v4);
          float ss = o.x * o.x + o.y * o.y + o.z * o.z + o.w * o.w;
#pragma unroll
          for (int sh = 1; sh < 32; sh <<= 1) ss += shx(ss, sh, tid & 63);
          const float r = 1.f / sqrtf(ss * (1.f / 128.f) + RMS_EPS);
          const f32x4 gg = *(const GAS f32x4*)(gng + v4);
          const u32x2 brw = *(const GAS u32x2*)(PA + (nb + t) * NPA + PA_BR + h * 128 + v4);
          u32x2 w; w.x = pk2(o.x * r * gg.x * bflo(brw.x), o.y * r * gg.y * bfhi(brw.x)); w.y = pk2(o.z * r * gg.z * bflo(brw.y), o.w * r * gg.w * bfhi(brw.y));
          *(GAS u32x2*)(Y + (nb + t) * 1536 + 512 + h * 128 + v4) = w; }
        __syncthreads();
    }
}

constexpr size_t WS_US = WS_WMOE, WS_DEC = WS_WMOE + 32 * MiB;
__device__ __forceinline__ void gla_local_unit(Frame& F, int l, int unit) {
    int tid = F.tid; asm volatile("" : "+v"(tid)); const int lane = tid & 63, w = F.wave, fr = lane & 15, fq = lane >> 4;
    const int b = unit >> 8, h = (unit >> 6) & 3, c = unit & 63; const size_t n0 = (size_t)b * SEQ + 64 * c;
    GAS bf16* PA = (GAS bf16*)(F.ws + WS_PA); GAS bf16* Y = (GAS bf16*)(F.ws + WS_Y); const GAS float* GLR = (const GAS float*)(F.ws + WS_GLR);
    GAS bf16* US = (GAS bf16*)(F.ws + WS_US) + (size_t)unit * 8192; GAS float* DEC = (GAS float*)(F.ws + WS_DEC) + unit * 64;
    LAS unsigned char* QT = F.lds; LAS unsigned char* KT = F.lds + 8192; LAS unsigned char* KD = F.lds + 16384; LAS unsigned char* VV = F.lds + 24576; LAS unsigned char* ATT = F.lds + 40960;
    LAS float* SEG = (LAS float*)(F.lds + 65536); LAS float* WA = (LAS float*)(F.lds + 67584); LAS float* BA = (LAS float*)(F.lds + 71680);
#pragma unroll
    for (int i = 0; i < 2; ++i) { const int e = tid + 512 * i; WA[e] = ((const GAS float*)F.in[6])[(size_t)l * 16 * 256 + (e >> 6) * 256 + h * 64 + (e & 63)]; }
    if (tid < 64) BA[tid] = ((const GAS float*)F.in[7])[l * 256 + h * 64 + tid];
#pragma unroll
    for (int i = 0; i < 2; ++i) { const int piece = tid + 512 * i, row = piece >> 4, c16 = piece & 15;
        *(LAS u32x4*)(VV + row * 256 + c16 * 16) = *(const GAS u32x4*)(PA + (n0 + row) * NPA + PA_BV + h * 128 + 8 * c16); }
    __syncthreads();
    const int k = tid & 63, seg = w;
    float cum[8];
    { float run = 0.f;
#pragma unroll
      for (int i = 0; i < 8; ++i) { const int t = 8 * seg + i; float z = BA[k];
          const f32x4 g0 = *(const GAS f32x4*)(GLR + (n0 + t) * 16), g1 = *(const GAS f32x4*)(GLR + (n0 + t) * 16 + 4), g2 = *(const GAS f32x4*)(GLR + (n0 + t) * 16 + 8), g3 = *(const GAS f32x4*)(GLR + (n0 + t) * 16 + 12);
#pragma unroll
          for (int r = 0; r < 4; ++r) { z += g0[r] * WA[r * 64 + k]; z += g1[r] * WA[(4 + r) * 64 + k]; z += g2[r] * WA[(8 + r) * 64 + k]; z += g3[r] * WA[(12 + r) * 64 + k]; }
          const float ls = fminf(z, 0.f) - log1pf(__expf(-fabsf(z)));
          run += ls * (1.f / 16.f); cum[i] = run; }
      SEG[seg * 64 + k] = run; }
    __syncthreads();
    { float off = 0.f, blast = 0.f;
#pragma unroll
      for (int s2 = 0; s2 < 8; ++s2) { const float sv = SEG[s2 * 64 + k]; blast += sv; off += (s2 < seg) ? sv : 0.f; }
#pragma unroll
      for (int i = 0; i < 8; ++i) { const int t = 8 * seg + i; const float bb = cum[i] + off;
          const float qv = bf1(PA[(n0 + t) * NPA + PA_BQ + h * 64 + k]), kv = bf1(PA[(n0 + t) * NPA + PA_BK + h * 64 + k]);
          const unsigned qt = f2bf(qv * __expf(bb));
          ((LAS unsigned short*)QT)[t * 64 + k] = (unsigned short)qt; ((LAS unsigned short*)KT)[t * 64 + k] = (unsigned short)f2bf(kv * __expf(-bb)); ((LAS unsigned short*)KD)[t * 64 + k] = (unsigned short)f2bf(kv * __expf(blast - bb));
          PA[(n0 + t) * NPA + PA_BQ + h * 64 + k] = (bf16)qt; }
      if (seg == 0) DEC[k] = __expf(blast); }
    __syncthreads();
#pragma unroll
    for (int ii = 0; ii < 2; ++ii) { const int id = 2 * w + ii, ts = id >> 2, tt = id & 3;
        f32x4 d = {0.f, 0.f, 0.f, 0.f};
        if (ts <= tt) {
#pragma unroll
            for (int ks = 0; ks < 2; ++ks) { const bf16x8 a = *(const LAS bf16x8*)(KT + (16 * ts + fr) * 128 + (8 * fq + 32 * ks) * 2), bq = *(const LAS bf16x8*)(QT + (16 * tt + fr) * 128 + (8 * fq + 32 * ks) * 2);
                d = __builtin_amdgcn_mfma_f32_16x16x32_bf16(a, bq, d, 0, 0, 0); } }
        const int t = 16 * tt + fr, s0 = 16 * ts + 4 * fq;
        u32x2 pk; pk.x = cvt_pk_bf16((s0 <= t) ? d[0] : 0.f, (s0 + 1 <= t) ? d[1] : 0.f); pk.y = cvt_pk_bf16((s0 + 2 <= t) ? d[2] : 0.f, (s0 + 3 <= t) ? d[3] : 0.f);
        *(LAS u32x2*)(ATT + t * 128 + s0 * 2) = pk; }
    __syncthreads();
    { const int tr = w & 3, nh = w >> 2;
      f32x4 ao[4], au[4];
#pragma unroll
      for (int j = 0; j < 4; ++j) { ao[j] = (f32x4){0.f, 0.f, 0.f, 0.f}; au[j] = (f32x4){0.f, 0.f, 0.f, 0.f}; }
#pragma unroll
      for (int ks = 0; ks < 2; ++ks) {
          const bf16x8 aA = *(const LAS bf16x8*)(ATT + (16 * tr + fr) * 128 + (8 * fq + 32 * ks) * 2);
          const int srow = 32 * ks + 8 * fq + (fr >> 2);
          const bf16x8 aK = cat8(ldtr(KD + srow * 128 + (16 * tr + 4 * (fr & 3)) * 2), ldtr(KD + (srow + 4) * 128 + (16 * tr + 4 * (fr & 3)) * 2));
#pragma unroll
          for (int j = 0; j < 4; ++j) { const int nt = 4 * nh + j;
              const bf16x8 bv = cat8(ldtr(VV + srow * 256 + (16 * nt + 4 * (fr & 3)) * 2), ldtr(VV + (srow + 4) * 256 + (16 * nt + 4 * (fr & 3)) * 2));
              ao[j] = __builtin_amdgcn_mfma_f32_16x16x32_bf16(aA, bv, ao[j], 0, 0, 0);
              au[j] = __builtin_amdgcn_mfma_f32_16x16x32_bf16(aK, bv, au[j], 0, 0, 0); } }
#pragma unroll
      for (int j = 0; j < 4; ++j) { const int v = 16 * (4 * nh + j) + fr;
#pragma unroll
          for (int r = 0; r < 4; ++r) { const int row = 16 * tr + 4 * fq + r;
              Y[(n0 + row) * 1536 + 512 + h * 128 + v] = (bf16)f2bf(ao[j][r]);
              US[row * 128 + v] = (bf16)f2bf(au[j][r]); } } }
    __syncthreads();
}
__device__ __forceinline__ void gla_scan_phase(Frame& F) {
    GAS bf16* USb = (GAS bf16*)(F.ws + WS_US); const GAS float* DECb = (const GAS float*)(F.ws + WS_DEC);
    for (int gt = F.wg * 512 + F.tid; gt < 131072; gt += F.G * 512) { const int e0 = 2 * gt, bh = e0 >> 13, kv = e0 & 8191, k = kv >> 7;
        GAS unsigned* p = (GAS unsigned*)(USb + (size_t)bh * 64 * 8192 + kv); const GAS float* dp = DECb + bh * 64 * 64 + k;
        float s0 = 0.f, s1 = 0.f;
#pragma unroll 8
        for (int c = 0; c < 64; ++c) { const unsigned u = p[(size_t)c * 4096]; const float d = dp[c * 64];
            p[(size_t)c * 4096] = pk2(s0, s1);
            s0 = d * s0 + bflo(u); s1 = d * s1 + bfhi(u); } }
}
__device__ __forceinline__ void gla_out_unit(Frame& F, int l, int unit) {
    int tid = F.tid; asm volatile("" : "+v"(tid)); const int lane = tid & 63, w = F.wave, fr = lane & 15, fq = lane >> 4;
    const int b = unit >> 8, h = (unit >> 6) & 3, c = unit & 63; const size_t n0 = (size_t)b * SEQ + 64 * c;
    const GAS bf16* PA = (const GAS bf16*)(F.ws + WS_PA); GAS bf16* Y = (GAS bf16*)(F.ws + WS_Y);
    const GAS bf16* US = (const GAS bf16*)(F.ws + WS_US) + (size_t)unit * 8192;
    LAS unsigned char* SS = F.lds;
    LAS float* PS = (LAS float*)(F.lds + 16384);
    const GAS float* gng = ((const GAS float*)F.in[8]) + l * 128;
#pragma unroll
    for (int i = 0; i < 2; ++i) { const int piece = tid + 512 * i; *(LAS u32x4*)(SS + piece * 16) = *(const GAS u32x4*)(US + piece * 8); }
    __syncthreads();
    const int tr = w >> 1, nh = w & 1;
    f32x4 acc[4];
#pragma unroll
    for (int j = 0; j < 4; ++j) acc[j] = (f32x4){0.f, 0.f, 0.f, 0.f};
#pragma unroll
    for (int ks = 0; ks < 2; ++ks) {
        const bf16x8 aq = *(const GAS bf16x8*)(PA + (n0 + 16 * tr + fr) * NPA + PA_BQ + h * 64 + 8 * fq + 32 * ks);
        const int krow = 32 * ks + 8 * fq + (fr >> 2);
#pragma unroll
        for (int j = 0; j < 4; ++j) { const int nt = 4 * nh + j;
            const bf16x8 bs = cat8(ldtr(SS + krow * 256 + (16 * nt + 4 * (fr & 3)) * 2), ldtr(SS + (krow + 4) * 256 + (16 * nt + 4 * (fr & 3)) * 2));
            acc[j] = __builtin_amdgcn_mfma_f32_16x16x32_bf16(aq, bs, acc[j], 0, 0, 0); } }
    float ss[4] = {0.f, 0.f, 0.f, 0.f};
#pragma unroll
    for (int j = 0; j < 4; ++j) { const int v = 16 * (4 * nh + j) + fr;
#pragma unroll
        for (int r = 0; r < 4; ++r) { const int row = 16 * tr + 4 * fq + r; acc[j][r] += bf1(Y[(n0 + row) * 1536 + 512 + h * 128 + v]); ss[r] += acc[j][r] * acc[j][r]; } }
#pragma unroll
    for (int r = 0; r < 4; ++r) { float s = ss[r]; s += dppf<0xB1>(s); s += dppf<0x4E>(s); s += shx(s, 4, lane); s += shx(s, 8, lane); ss[r] = s; }
    if (fr == 0) {
#pragma unroll
        for (int r = 0; r < 4; ++r) PS[(16 * tr + 4 * fq + r) * 2 + nh] = ss[r]; }
    __syncthreads();
#pragma unroll
    for (int r = 0; r < 4; ++r) { const int row = 16 * tr + 4 * fq + r; const float rinv = 1.f / sqrtf((PS[row * 2] + PS[row * 2 + 1]) * (1.f / 128.f) + RMS_EPS);
#pragma unroll
        for (int j = 0; j < 4; ++j) { const int v = 16 * (4 * nh + j) + fr;
            const float br = bf1(PA[(n0 + row) * NPA + PA_BR + h * 128 + v]);
            Y[(n0 + row) * 1536 + 512 + h * 128 + v] = (bf16)f2bf(acc[j][r] * rinv * gng[v] * br); } }
    __syncthreads();
}

constexpr int DSA_WAVE_LDS = 17920;
__device__ __forceinline__ void dsa_unit(Frame& F, int unit) {
    int lane = F.lane; asm volatile("" : "+v"(lane)); const int w = F.wave;
    const int qb = 4095 - unit;
    const int b = qb & 7, t = (qb >> 3) * 8 + w;
    const size_t n = (size_t)b * SEQ + t, nb0 = (size_t)b * SEQ;
    const GAS bf16* PA = (const GAS bf16*)(F.ws + WS_PA); GAS bf16* Y = (GAS bf16*)(F.ws + WS_Y);
    const GAS bf16* KI = (const GAS bf16*)(F.ws + WS_KI); const GAS bf16* KA = (const GAS bf16*)(F.ws + WS_KA); const GAS bf16* VA = (const GAS bf16*)(F.ws + WS_VA);
    const GAS float* WI = (const GAS float*)(F.ws + WS_WI);
    LAS unsigned char* base = F.lds + w * DSA_WAVE_LDS;
    LAS unsigned* sc = (LAS unsigned*)base;
    LAS float* qi = (LAS float*)(base + 16384);
    LAS unsigned short* list = (LAS unsigned short*)(base + 16384 + 1024);
    { const u32x2 q2 = *(const GAS u32x2*)(PA + n * NPA + PA_QI + 4 * lane);
      *(LAS f32x4*)(qi + 4 * lane) = (f32x4){bflo(q2.x), bfhi(q2.x), bflo(q2.y), bfhi(q2.y)}; }
    asm volatile("s_waitcnt lgkmcnt(0)" ::: "memory");
    const f32x4 wi = {ld_f32(WI + n * 4), ld_f32(WI + n * 4 + 1), ld_f32(WI + n * 4 + 2), ld_f32(WI + n * 4 + 3)};
    const int nbat = (t >> 6) + 1;
    for (int kb = 0; kb < nbat; ++kb) { const int key = kb * 64 + lane, kc = key <= t ? key : t;
        const GAS u32x4* kp = (const GAS u32x4*)(KI + (nb0 + kc) * 64);
        float kf[64];
#pragma unroll
        for (int c = 0; c < 8; ++c) { const u32x4 kk = kp[c]; kf[8 * c] = bflo(kk.x); kf[8 * c + 1] = bfhi(kk.x); kf[8 * c + 2] = bflo(kk.y); kf[8 * c + 3] = bfhi(kk.y); kf[8 * c + 4] = bflo(kk.z); kf[8 * c + 5] = bfhi(kk.z); kf[8 * c + 6] = bflo(kk.w); kf[8 * c + 7] = bfhi(kk.w); }
        float score = 0.f;
#pragma unroll
        for (int h = 0; h < 4; ++h) { float d = 0.f;
#pragma unroll
            for (int c = 0; c < 16; ++c) { const f32x4 q4 = *(const LAS f32x4*)(qi + h * 64 + 4 * c); d += q4.x * kf[4 * c] + q4.y * kf[4 * c + 1] + q4.z * kf[4 * c + 2] + q4.w * kf[4 * c + 3]; }
            score += wi[h] * fmaxf(d, 0.f); }
        if (score == 0.f) score = 0.f;
        unsigned u = __builtin_bit_cast(unsigned, score); u = (u & 0x80000000u) ? ~u : (u | 0x80000000u);
        sc[key] = key <= t ? u : 0u; }
    asm volatile("s_waitcnt lgkmcnt(0)" ::: "memory");
    int nsel;
    if (t >= 256) {
        unsigned T = 0u;
        for (int bit = 31; bit >= 0; --bit) { const unsigned cand = T | (1u << bit); int cnt = 0;
            for (int j = 0; j < nbat; ++j) cnt += (sc[j * 64 + lane] >= cand) ? 1 : 0;
            if (wave_sum_i(cnt, lane) >= 256) T = cand; }
        int cgt = 0;
        for (int j = 0; j < nbat; ++j) cgt += (sc[j * 64 + lane] > T) ? 1 : 0;
        const int need = 256 - wave_sum_i(cgt, lane);
        int selbase = 0, tiebase = 0;
        for (int j = 0; j < nbat; ++j) { const unsigned x = sc[j * 64 + lane]; const bool eq = (x == T), gt = (x > T);
            const unsigned long long beq = __ballot(eq); const unsigned long long lt = (1ull << lane) - 1ull;
            const int trank = tiebase + __popcll(beq & lt);
            const bool sel = gt || (eq && trank < need);
            const unsigned long long bsel = __ballot(sel);
            if (sel) list[selbase + __popcll(bsel & lt)] = (unsigned short)(j * 64 + lane);
            selbase += __popcll(bsel); tiebase += __popcll(beq); }
        nsel = 256;
    } else {
        nsel = t + 1;
        for (int i = lane; i < 256; i += 64) list[i] = (unsigned short)(i <= t ? i : 0);
    }
    asm volatile("s_waitcnt lgkmcnt(0)" ::: "memory");
    LAS float* qm = (LAS float*)base;
    LAS float* Pl = (LAS float*)(base + 2048);
    { const u32x4 q8 = *(const GAS u32x4*)(PA + n * NPA + PA_Q + 8 * lane);
      *(LAS f32x4*)(qm + 8 * lane) = (f32x4){bflo(q8.x), bfhi(q8.x), bflo(q8.y), bfhi(q8.y)}; *(LAS f32x4*)(qm + 8 * lane + 4) = (f32x4){bflo(q8.z), bfhi(q8.z), bflo(q8.w), bfhi(q8.w)}; }
    asm volatile("s_waitcnt lgkmcnt(0)" ::: "memory");
#pragma unroll 1
    for (int bb = 0; bb < 4; ++bb) { const int i = bb * 64 + lane; const bool valid = i < nsel; const int key = valid ? (int)list[i] : 0;
        const GAS u32x4* kp = (const GAS u32x4*)(KA + (nb0 + key) * 64);
        float kf[64];
#pragma unroll
        for (int c = 0; c < 8; ++c) { const u32x4 kk = kp[c]; kf[8 * c] = bflo(kk.x); kf[8 * c + 1] = bfhi(kk.x); kf[8 * c + 2] = bflo(kk.y); kf[8 * c + 3] = bfhi(kk.y); kf[8 * c + 4] = bflo(kk.z); kf[8 * c + 5] = bfhi(kk.z); kf[8 * c + 6] = bflo(kk.w); kf[8 * c + 7] = bfhi(kk.w); }
        float lgv[8];
#pragma unroll
        for (int h = 0; h < 8; ++h) { float d = 0.f;
#pragma unroll
            for (int c = 0; c < 16; ++c) { const f32x4 q4 = *(const LAS f32x4*)(qm + h * 64 + 4 * c); d += q4.x * kf[4 * c] + q4.y * kf[4 * c + 1] + q4.z * kf[4 * c + 2] + q4.w * kf[4 * c + 3]; }
            lgv[h] = valid ? d : -INFINITY; }
        *(LAS f32x4*)(Pl + i * 8) = (f32x4){lgv[0], lgv[1], lgv[2], lgv[3]}; *(LAS f32x4*)(Pl + i * 8 + 4) = (f32x4){lgv[4], lgv[5], lgv[6], lgv[7]}; }
    asm volatile("s_waitcnt lgkmcnt(0)" ::: "memory");
    float lg[4][8];
#pragma unroll
    for (int bb = 0; bb < 4; ++bb) { const f32x4 a = *(const LAS f32x4*)(Pl + (bb * 64 + lane) * 8), c = *(const LAS f32x4*)(Pl + (bb * 64 + lane) * 8 + 4);
        lg[bb][0] = a.x; lg[bb][1] = a.y; lg[bb][2] = a.z; lg[bb][3] = a.w; lg[bb][4] = c.x; lg[bb][5] = c.y; lg[bb][6] = c.z; lg[bb][7] = c.w; }
    float den[8];
#pragma unroll
    for (int h = 0; h < 8; ++h) { float m = fmaxf(fmaxf(lg[0][h], lg[1][h]), fmaxf(lg[2][h], lg[3][h])); m = wave_max(m, lane); float s = 0.f;
#pragma unroll
        for (int bb = 0; bb < 4; ++bb) { lg[bb][h] = __expf(lg[bb][h] - m); s += lg[bb][h]; }
        den[h] = wave_sum(s, lane); }
#pragma unroll
    for (int bb = 0; bb < 4; ++bb) { const int i = bb * 64 + lane;
        *(LAS f32x4*)(Pl + i * 8) = (f32x4){lg[bb][0], lg[bb][1], lg[bb][2], lg[bb][3]}; *(LAS f32x4*)(Pl + i * 8 + 4) = (f32x4){lg[bb][4], lg[bb][5], lg[bb][6], lg[bb][7]}; }
    asm volatile("s_waitcnt lgkmcnt(0)" ::: "memory");
    float o[8];
#pragma unroll
    for (int h = 0; h < 8; ++h) o[h] = 0.f;
#pragma unroll 4
    for (int i = 0; i < nsel; ++i) { const int key = (int)list[i]; const float vv = bf1(VA[(nb0 + key) * 64 + lane]);
        const f32x4 p0 = *(const LAS f32x4*)(Pl + i * 8), p1 = *(const LAS f32x4*)(Pl + i * 8 + 4);
        o[0] += p0.x * vv; o[1] += p0.y * vv; o[2] += p0.z * vv; o[3] += p0.w * vv; o[4] += p1.x * vv; o[5] += p1.y * vv; o[6] += p1.z * vv; o[7] += p1.w * vv; }
#pragma unroll
    for (int h = 0; h < 8; ++h) Y[n * 1536 + h * 64 + lane] = (bf16)f2bf(o[h] / den[h]);
}

__device__ __forceinline__ bf16x8 scale_pack8(u32x4 raw, float s) {
    u32x4 o; o.x = cvt_pk_bf16(bflo(raw.x) * s, bfhi(raw.x) * s); o.y = cvt_pk_bf16(bflo(raw.y) * s, bfhi(raw.y) * s); o.z = cvt_pk_bf16(bflo(raw.z) * s, bfhi(raw.z) * s); o.w = cvt_pk_bf16(bflo(raw.w) * s, bfhi(raw.w) * s);
    return __builtin_bit_cast(bf16x8, o);
}
__device__ __forceinline__ void dsa16_unit(Frame& F, int unit) {
    int lane = F.lane; asm volatile("" : "+v"(lane)); const int w = F.wave;
    const int qb = 2047 - unit;
    const int b = qb & 7, t0 = (qb >> 3) * 16;
    const size_t nb0 = (size_t)b * SEQ;
    const GAS bf16* PA = (const GAS bf16*)(F.ws + WS_PA); GAS bf16* Y = (GAS bf16*)(F.ws + WS_Y);
    const GAS bf16* KI = (const GAS bf16*)(F.ws + WS_KI); const GAS bf16* KA = (const GAS bf16*)(F.ws + WS_KA); const GAS bf16* VA = (const GAS bf16*)(F.ws + WS_VA);
    const GAS float* WI = (const GAS float*)(F.ws + WS_WI);
    LAS unsigned char* K16 = F.lds;
    LAS unsigned short* LIST = (LAS unsigned short*)(F.lds + AUX_OFF);
    const int fr = lane & 15, fq = lane >> 4;
#ifdef REP_S1
    for (int rep_ = 0; rep_ < REP_S1; ++rep_)
#endif
    {
        const int ql = fr >> 2, h = fr & 3;
        bf16x8 Bf[4][2]; float Linf[4];
#pragma unroll
        for (int g = 0; g < 4; ++g) { const size_t nq = nb0 + t0 + 4 * g + ql; const float wv = WI[nq * 4 + h];
#pragma unroll
            for (int ks = 0; ks < 2; ++ks) Bf[g][ks] = scale_pack8(*(const GAS u32x4*)(PA + nq * NPA + PA_QI + h * 64 + 8 * fq + 32 * ks), wv);
            Linf[g] = (wv >= 0.f) ? INFINITY : -INFINITY; }
        const int ntiles = (t0 >> 4) + 1;
        bf16x8 A0[4], A1[4];
#pragma unroll
        for (int j = 0; j < 4; ++j) { const int tile = (w + 8 * j < ntiles) ? w + 8 * j : ntiles - 1; const size_t krow = (nb0 + 16 * tile + fr) * 64;
            A0[j] = *(const GAS bf16x8*)(KI + krow + 8 * fq); A1[j] = *(const GAS bf16x8*)(KI + krow + 32 + 8 * fq); }
#pragma unroll 1
        for (int tb = w; tb < ntiles; tb += 32) {
            bf16x8 N0[4], N1[4];
#pragma unroll
            for (int j = 0; j < 4; ++j) { const int tn = tb + 32 + 8 * j; const int tile = (tn < ntiles) ? tn : ntiles - 1; const size_t krow = (nb0 + 16 * tile + fr) * 64;
                N0[j] = *(const GAS bf16x8*)(KI + krow + 8 * fq); N1[j] = *(const GAS bf16x8*)(KI + krow + 32 + 8 * fq); }
#pragma unroll
            for (int j = 0; j < 4; ++j) { const int tile = tb + 8 * j;
                if (tile < ntiles) {
                    const int kpos = 16 * tile + 4 * fq + h;
                    const int g7 = kpos >> 7, hf = (kpos >> 6) & 1, ln = kpos & 63;
                    const int koff = (g7 >> 2) * 1024 + ln * 16 + (g7 & 3) * 4 + hf * 2;
                    const bool lastt = (tile == ntiles - 1);
#pragma unroll
                    for (int g = 0; g < 4; ++g) {
                        f32x4 d = __builtin_amdgcn_mfma_f32_16x16x32_bf16(A0[j], Bf[g][0], (f32x4){0.f, 0.f, 0.f, 0.f}, 0, 0, 0);
                        d = __builtin_amdgcn_mfma_f32_16x16x32_bf16(A1[j], Bf[g][1], d, 0, 0, 0);
                        const float a0 = __builtin_amdgcn_fmed3f(d[0], 0.f, Linf[g]), a1 = __builtin_amdgcn_fmed3f(d[1], 0.f, Linf[g]), a2 = __builtin_amdgcn_fmed3f(d[2], 0.f, Linf[g]), a3 = __builtin_amdgcn_fmed3f(d[3], 0.f, Linf[g]);
                        const float u0 = a0 + dppf<0xB1>(a0), u1 = a1 + dppf<0xB1>(a1), u2 = a2 + dppf<0xB1>(a2), u3 = a3 + dppf<0xB1>(a3);
                        const float b0 = (h & 1) ? u1 : u0, b1 = (h & 1) ? u3 : u2;
                        const float c0 = b0 + dppf<0x4E>(b0), c1 = b1 + dppf<0x4E>(b1);
                        const float s = ((h & 2) ? c1 : c0) + 0.0f;
                        const _Float16 hh = (_Float16)s; const unsigned hb = (unsigned)__builtin_bit_cast(unsigned short, hh);
                        unsigned key = hb ^ ((unsigned)((int)(hb << 16) >> 31) | 0x8000u);
                        if (lastt) key = (kpos <= t0 + 4 * g + ql) ? key : 0u;
                        *(LAS unsigned short*)(K16 + (4 * g + ql) * 8192 + koff) = (unsigned short)key;
                    }
                }
            }
#pragma unroll
            for (int j = 0; j < 4; ++j) { A0[j] = N0[j]; A1[j] = N1[j]; }
        }
    }
    __syncthreads();
#ifndef REP_S2
#define REP_S2 1
#endif
#pragma unroll 1
    for (int qq = 0; qq < 2 * REP_S2; ++qq) {
        const int q = 2 * w + (qq & 1), nvalid = t0 + q + 1;
        LAS unsigned short* list = LIST + q * 256;
        if (nvalid <= 256) {
            for (int i = lane; i < 256; i += 64) list[i] = (unsigned short)(i < nvalid ? i : 0);
        } else {
            const int ngrp = (nvalid + 511) >> 9;
            unsigned v[64];
#pragma unroll
            for (int grp = 0; grp < 8; ++grp) {
                if (grp < ngrp) { const u32x4 r = *(const LAS u32x4*)(K16 + q * 8192 + grp * 1024 + lane * 16);
#pragma unroll
                    for (int i = 0; i < 4; ++i) { const int g = 4 * grp + i; const unsigned rr = r[i]; const int thr = nvalid - 128 * g;
                        v[2 * g] = (lane < thr) ? (rr & 0xffffu) : 0u; v[2 * g + 1] = (lane < thr - 64) ? (rr >> 16) : 0u; }
                } else {
#pragma unroll
                    for (int i = 0; i < 8; ++i) v[8 * grp + i] = 0u;
                }
            }
            unsigned T = 0u;
#pragma unroll 1
            for (int bit = 15; bit >= 0; --bit) { const unsigned cand = T | (1u << bit); int cnt = 0;
#pragma unroll
                for (int grp = 0; grp < 8; ++grp) if (grp < ngrp) {
#pragma unroll
                    for (int i = 0; i < 8; ++i) cnt += (v[8 * grp + i] >= cand) ? 1 : 0; }
                if (wave_total_i(cnt) >= 256) T = cand; }
            int cgt = 0;
#pragma unroll
            for (int grp = 0; grp < 8; ++grp) if (grp < ngrp) {
#pragma unroll
                for (int i = 0; i < 8; ++i) cgt += (v[8 * grp + i] > T) ? 1 : 0; }
            const int need = 256 - wave_total_i(cgt);
            int selbase = 0, tiebase = 0; const unsigned long long lt = (1ull << lane) - 1ull;
#pragma unroll
            for (int grp = 0; grp < 8; ++grp) if (grp < ngrp) {
#pragma unroll
                for (int i = 0; i < 8; ++i) { const int j = 8 * grp + i; const unsigned x = v[j]; const bool eq = (x == T), gt = (x > T);
                    const unsigned long long beq = __ballot(eq);
                    const int trank = tiebase + __popcll(beq & lt);
                    const bool sel = gt || (eq && trank < need);
                    const unsigned long long bsel = __ballot(sel);
                    if (sel) list[selbase + __popcll(bsel & lt)] = (unsigned short)(j * 64 + lane);
                    selbase += __popcll(bsel); tiebase += __popcll(beq); } }
        }
    }
    __syncthreads();
    LAS unsigned char* Vs = F.lds + w * 16384;
#ifndef REP_S3
#define REP_S3 1
#endif
#pragma unroll 1
    for (int qq = 0; qq < 2 * REP_S3; ++qq) {
        const int q = 2 * w + (qq & 1), tq = t0 + q; const int nsel = (tq + 1 < 256) ? tq + 1 : 256;
        const size_t nq = nb0 + tq;
        const LAS unsigned short* list = LIST + q * 256;
        bf16x8 Qf[2];
#pragma unroll
        for (int ks = 0; ks < 2; ++ks) { u32x4 raw = {0u, 0u, 0u, 0u}; if (fr < 8) raw = *(const GAS u32x4*)(PA + nq * NPA + PA_Q + fr * 64 + 8 * fq + 32 * ks); Qf[ks] = __builtin_bit_cast(bf16x8, raw); }
        float lg[16][4];
        int keyv[16];
#pragma unroll
        for (int tt = 0; tt < 16; ++tt) keyv[tt] = (int)list[16 * tt + fr];
#pragma unroll
        for (int hb = 0; hb < 4; ++hb) {
            bf16x8 A0[4], A1[4];
#pragma unroll
            for (int j = 0; j < 4; ++j) { const size_t krow = (nb0 + keyv[4 * hb + j]) * 64; A0[j] = *(const GAS bf16x8*)(KA + krow + 8 * fq); A1[j] = *(const GAS bf16x8*)(KA + krow + 32 + 8 * fq); }
            __builtin_amdgcn_sched_barrier(0);
#pragma unroll
            for (int j = 0; j < 4; ++j) { const int tt = 4 * hb + j;
                f32x4 d = __builtin_amdgcn_mfma_f32_16x16x32_bf16(A0[j], Qf[0], (f32x4){0.f, 0.f, 0.f, 0.f}, 0, 0, 0);
                d = __builtin_amdgcn_mfma_f32_16x16x32_bf16(A1[j], Qf[1], d, 0, 0, 0);
#pragma unroll
                for (int r = 0; r < 4; ++r) lg[tt][r] = (16 * tt + 4 * fq + r < nsel) ? d[r] : -INFINITY; }
        }
        float m = lg[0][0];
#pragma unroll
        for (int tt = 0; tt < 16; ++tt)
#pragma unroll
            for (int r = 0; r < 4; ++r) m = fmaxf(m, lg[tt][r]);
        m = fmaxf(m, shx(m, 16, lane)); m = fmaxf(m, shx(m, 32, lane));
        float den = 0.f;
#pragma unroll
        for (int tt = 0; tt < 16; ++tt)
#pragma unroll
            for (int r = 0; r < 4; ++r) { lg[tt][r] = __expf(lg[tt][r] - m); den += lg[tt][r]; }
        den += shx(den, 16, lane); den += shx(den, 32, lane);
        f32x4 acc[4];
#pragma unroll
        for (int nt = 0; nt < 4; ++nt) acc[nt] = (f32x4){0.f, 0.f, 0.f, 0.f};
#pragma unroll
        for (int hh = 0; hh < 2; ++hh) {
#pragma unroll
            for (int ib = 0; ib < 2; ++ib) {
                u32x4 vv[8];
#pragma unroll
                for (int i = 0; i < 8; ++i) { const int piece = (8 * ib + i) * 64 + lane, row = piece >> 3, c = piece & 7; const int key = (int)list[128 * hh + row];
                    vv[i] = *(const GAS u32x4*)(VA + (nb0 + key) * 64 + 8 * c); }
                __builtin_amdgcn_sched_barrier(0);
#pragma unroll
                for (int i = 0; i < 8; ++i) { const int piece = (8 * ib + i) * 64 + lane; *(LAS u32x4*)(Vs + piece * 16) = vv[i]; }
            }
            asm volatile("s_waitcnt lgkmcnt(0)" ::: "memory");
#pragma unroll
            for (int s4 = 0; s4 < 4; ++s4) { const int s = 4 * hh + s4;
                u32x4 pa; pa.x = cvt_pk_bf16(lg[2 * s][0], lg[2 * s][1]); pa.y = cvt_pk_bf16(lg[2 * s][2], lg[2 * s][3]); pa.z = cvt_pk_bf16(lg[2 * s + 1][0], lg[2 * s + 1][1]); pa.w = cvt_pk_bf16(lg[2 * s + 1][2], lg[2 * s + 1][3]);
                const bf16x8 Pa = __builtin_bit_cast(bf16x8, pa);
                const int rowa = 32 * s4 + 4 * fq + (fr >> 2);
#pragma unroll
                for (int nt = 0; nt < 4; ++nt) {
                    const v4i16_t lo = __builtin_amdgcn_ds_read_tr16_b64_v4i16((LAS v4i16_t*)(Vs + rowa * 128 + (16 * nt + 4 * (fr & 3)) * 2));
                    const v4i16_t hi = __builtin_amdgcn_ds_read_tr16_b64_v4i16((LAS v4i16_t*)(Vs + (rowa + 16) * 128 + (16 * nt + 4 * (fr & 3)) * 2));
                    bf16x8 Bv; Bv[0] = lo[0]; Bv[1] = lo[1]; Bv[2] = lo[2]; Bv[3] = lo[3]; Bv[4] = hi[0]; Bv[5] = hi[1]; Bv[6] = hi[2]; Bv[7] = hi[3];
                    acc[nt] = __builtin_amdgcn_mfma_f32_16x16x32_bf16(Pa, Bv, acc[nt], 0, 0, 0); } }
            asm volatile("s_waitcnt lgkmcnt(0)" ::: "memory");
        }
        float dn[4];
#pragma unroll
        for (int r = 0; r < 4; ++r) dn[r] = __builtin_bit_cast(float, __builtin_amdgcn_ds_bpermute((4 * (fq & 1) + r) << 2, __builtin_bit_cast(int, den)));
        if (fq < 2) {
#pragma unroll
            for (int nt = 0; nt < 4; ++nt)
#pragma unroll
                for (int r = 0; r < 4; ++r) Y[nq * 1536 + (4 * fq + r) * 64 + 16 * nt + fr] = (bf16)f2bf(acc[nt][r] / dn[r]);
        }
    }
}

#ifdef GLA_NAIVE
constexpr int NGLA = 32;
#else
constexpr int NGLA = 2048;
#endif
#ifdef DSA_NAIVE
constexpr int NDSA = 4096;
#else
constexpr int NDSA = 2048;
#endif
#ifdef GMLP_NAIVE
constexpr int NGM = 1024;
#else
constexpr int NGM = 256;
#endif
__device__ __forceinline__ void phase_mixer(Frame& F, int l, int slot = 0, int types = 7) {
    gu32* head = F.ctl + CW_QUEUE + 64 * (l + 2 * slot);
    for (;;) {
        __syncthreads();
        if (F.tid == 0) F.MISC[64] = __hip_atomic_fetch_add(head, 1u, __ATOMIC_RELAXED, __HIP_MEMORY_SCOPE_AGENT);
        __syncthreads();
        const int u = (int)F.MISC[64];
        if (u >= NDSA + NGLA + NGM) break;
        if (u < NDSA) { if (EN_B2 && (types & 2)) {
#ifdef DSA_NAIVE
            dsa_unit(F, u);
#else
            dsa16_unit(F, u);
#endif
        } }
        else if (u < NDSA + NGLA) { if (EN_B1 && (types & 1)) {
#ifdef GLA_NAIVE
            gla_unit(F, l, u - NDSA);
#else
            gla_local_unit(F, l, u - NDSA);
#endif
        } }
        else { if (EN_B3 && (types & 4)) {
#ifdef GMLP_NAIVE
            gmlp_unit(F, l, u - NDSA - NGLA);
#else
            gmlp16_unit(F, l, u - NDSA - NGLA);
#endif
        } }
    }
}
__device__ __forceinline__ void phase_gla_out(Frame& F, int l) {
#ifndef GLA_NAIVE
    for (int u = F.wg; u < 2048; u += F.G) gla_out_unit(F, l, u);
#endif
}

template <int CTRL> __device__ __forceinline__ float dpp_add(float v) { return v + dppf<CTRL>(v); }
__device__ __forceinline__ float row16_sum(float v) { v = dpp_add<0xB1>(v); v = dpp_add<0x4E>(v); v = dpp_add<0x141>(v); v = dpp_add<0x140>(v); return v; }
__device__ __forceinline__ void phase_ln_router(Frame& F, int l) {
    const GAS float* WR = (const GAS float*)(F.ws + WS_WR) + (size_t)l * 36 * DM;
    LAS float* wr = (LAS float*)F.lds;
    for (int i = F.tid; i < 36 * 256; i += 512) ((LAS f32x4*)wr)[i] = ((const GAS f32x4*)WR)[i];
    if (F.tid < 32) F.MISC[16 + F.tid] = 0u;
    __syncthreads();
    GAS bf16* HB = (GAS bf16*)(F.ws + WS_HB); const GAS bf16* T = (const GAS bf16*)F.H; GAS int* EID = (GAS int*)(F.ws + WS_ROUTE); GAS float* EW = (GAS float*)(F.ws + WS_ROUTE + 256 * 1024);
    const GAS float* g = ((const GAS float*)F.in[17]) + l * DM; const GAS float* bb = ((const GAS float*)F.in[18]) + l * DM; const GAS float* brg = ((const GAS float*)F.in[20]) + l * 4; const GAS float* bre = ((const GAS float*)F.in[22]) + l * 32;
    int lane = F.lane; asm volatile("" : "+v"(lane));
    const int sub = lane & 15, rr = lane >> 4;
    for (int r0 = F.wg * 128; r0 < NTOK; r0 += F.G * 128) {
        u32x4 nx[8];
#pragma unroll
        for (int q = 0; q < 8; ++q) nx[q] = *(const GAS u32x4*)(T + (size_t)(r0 + F.wave * 16 + rr) * DM + 8 * (sub + 16 * q));
#pragma unroll 1
        for (int j = 0; j < 4; ++j) { const int m = r0 + F.wave * 16 + 4 * j + rr;
            float v[64]; float s = 0.f;
#pragma unroll
            for (int q = 0; q < 8; ++q) { const u32x4 x = nx[q]; v[8 * q] = bflo(x.x); v[8 * q + 1] = bfhi(x.x); v[8 * q + 2] = bflo(x.y); v[8 * q + 3] = bfhi(x.y); v[8 * q + 4] = bflo(x.z); v[8 * q + 5] = bfhi(x.z); v[8 * q + 6] = bflo(x.w); v[8 * q + 7] = bfhi(x.w); }
            { const int mn = (j < 3) ? m + 4 : m;
#pragma unroll
              for (int q = 0; q < 8; ++q) nx[q] = *(const GAS u32x4*)(T + (size_t)mn * DM + 8 * (sub + 16 * q)); }
#pragma unroll
            for (int i = 0; i < 64; ++i) s += v[i];
            const float mean = row16_sum(s) * (1.f / DM); float s2 = 0.f;
#pragma unroll
            for (int i = 0; i < 64; ++i) { v[i] -= mean; s2 += v[i] * v[i]; }
            const float rstd = 1.f / sqrtf(row16_sum(s2) * (1.f / DM) + LN_EPS);
#pragma unroll
            for (int q = 0; q < 8; ++q) { const int c = 8 * (sub + 16 * q); const f32x4 g0 = *(const GAS f32x4*)(g + c), g1 = *(const GAS f32x4*)(g + c + 4), b0 = *(const GAS f32x4*)(bb + c), b1 = *(const GAS f32x4*)(bb + c + 4);
#pragma unroll
                for (int i = 0; i < 4; ++i) { v[8 * q + i] = v[8 * q + i] * rstd * g0[i] + b0[i]; v[8 * q + 4 + i] = v[8 * q + 4 + i] * rstd * g1[i] + b1[i]; }
                u32x4 wv; wv.x = pk2(v[8 * q], v[8 * q + 1]); wv.y = pk2(v[8 * q + 2], v[8 * q + 3]); wv.z = pk2(v[8 * q + 4], v[8 * q + 5]); wv.w = pk2(v[8 * q + 6], v[8 * q + 7]);
                *(GAS u32x4*)(HB + (size_t)m * DM + c) = wv; }
            float lgt[36];
#pragma unroll
            for (int o = 0; o < 36; ++o) { float p = 0.f;
#pragma unroll
                for (int q = 0; q < 8; ++q) { const f32x4 w0 = *(const LAS f32x4*)(wr + o * DM + 8 * (sub + 16 * q)), w1 = *(const LAS f32x4*)(wr + o * DM + 8 * (sub + 16 * q) + 4);
                    p += v[8 * q] * w0.x + v[8 * q + 1] * w0.y + v[8 * q + 2] * w0.z + v[8 * q + 3] * w0.w + v[8 * q + 4] * w1.x + v[8 * q + 5] * w1.y + v[8 * q + 6] * w1.z + v[8 * q + 7] * w1.w; }
                lgt[o] = row16_sum(p); }
            int gi = 0; float gm = lgt[0] + brg[0];
#pragma unroll
            for (int q = 1; q < 4; ++q) { const float x = lgt[q] + brg[q]; if (x > gm) { gm = x; gi = q; } }
            float gs = 0.f;
#pragma unroll
            for (int q = 0; q < 4; ++q) gs += __expf(lgt[q] + brg[q] - gm);
            const float gp = 1.f / gs;
            float el[8];
#pragma unroll
            for (int q = 0; q < 8; ++q) { float x = lgt[4 + q] + bre[q];
                x = (gi == 1) ? lgt[12 + q] + bre[8 + q] : x; x = (gi == 2) ? lgt[20 + q] + bre[16 + q] : x; x = (gi == 3) ? lgt[28 + q] + bre[24 + q] : x; el[q] = x; }
            int i0 = 0; float v0 = el[0];
#pragma unroll
            for (int q = 1; q < 8; ++q) if (el[q] > v0) { v0 = el[q]; i0 = q; }
            int i1 = -1; float v1 = -INFINITY;
#pragma unroll
            for (int q = 0; q < 8; ++q) if (q != i0 && el[q] > v1) { v1 = el[q]; i1 = q; }
            const float ex = __expf(v1 - v0), w0 = gp / (1.f + ex), w1 = gp * ex / (1.f + ex);
            if (sub == 0) { const int e0 = gi * 8 + i0, e1 = gi * 8 + i1;
                EID[2 * m] = e0; EID[2 * m + 1] = e1; EW[2 * m] = w0; EW[2 * m + 1] = w1;
                __hip_atomic_fetch_add((LAS unsigned*)(F.lds + MISC_OFF) + 16 + e0, 1u, __ATOMIC_RELAXED, __HIP_MEMORY_SCOPE_WORKGROUP);
                __hip_atomic_fetch_add((LAS unsigned*)(F.lds + MISC_OFF) + 16 + e1, 1u, __ATOMIC_RELAXED, __HIP_MEMORY_SCOPE_WORKGROUP); } }
    }
    __syncthreads();
    if (F.tid < 32) ((GAS int*)(F.ws + WS_CNTWG))[F.wg * 32 + F.tid] = (int)F.MISC[16 + F.tid];
}
__device__ __forceinline__ void phase_dispatch(Frame& F) {
    const GAS int* CNT = (const GAS int*)(F.ws + WS_CNTWG); const GAS int* EID = (const GAS int*)(F.ws + WS_ROUTE); const GAS float* EW = (const GAS float*)(F.ws + WS_ROUTE + 256 * 1024);
    GAS int* SROW = (GAS int*)(F.ws + WS_SROW); GAS int* ROWMAP = (GAS int*)(F.ws + WS_ROWMAP); GAS float* CWROW = (GAS float*)(F.ws + WS_CWROW); GAS int* META = (GAS int*)(F.ws + WS_META);
    LAS int* tot = (LAS int*)(F.lds + AUX_OFF);
    if (F.tid < 32) { int t = 0, mine = 0; for (int w = 0; w < F.G; ++w) { const int c = ld_i32(CNT + w * 32 + F.tid); t += c; if (w < F.wg) mine += c; } tot[F.tid] = t; tot[32 + F.tid] = mine; tot[96 + F.tid] = 0; }
    __syncthreads();
    if (F.tid == 0) { int rb = 0;
#pragma clang loop unroll(disable) vectorize(disable)
        for (int e = 0; e < 32; ++e) { tot[64 + e] = rb; rb += ((tot[e] + 255) >> 8) << 8; }
        tot[128] = rb; }
    __syncthreads();
    if (F.wg == 0) { const int nt = tot[128] >> 8; if (F.tid == 0) META[0] = nt;
        if (F.tid < nt) { int e = 0;
#pragma clang loop unroll(disable) vectorize(disable)
            for (int q = 1; q < 32; ++q) if (tot[64 + q] <= F.tid * 256) e = q;
            META[16 + F.tid] = e; } }
    for (int r0 = F.wg * 128; r0 < NTOK; r0 += F.G * 128) {
        if (F.tid < 256) { const int tok = r0 + (F.tid >> 1), slot = F.tid & 1; const int e = EID[2 * tok + slot];
            const int pos = (int)__hip_atomic_fetch_add((LAS unsigned*)&tot[96 + e], 1u, __ATOMIC_RELAXED, __HIP_MEMORY_SCOPE_WORKGROUP);
            const int sr = tot[64 + e] + tot[32 + e] + pos;
            ROWMAP[sr] = tok; CWROW[sr] = EW[2 * tok + slot]; SROW[2 * tok + slot] = sr; } }
    if (F.wg < 32) { const int e = F.wg; const int lo = tot[64 + e] + tot[e], hi = tot[64 + e] + (((tot[e] + 255) >> 8) << 8);
        for (int r = lo + F.tid; r < hi; r += 512) { ROWMAP[r] = 0; CWROW[r] = 0.f; } }
}
__device__ __forceinline__ void phase_ln2(Frame& F, int l) {
    GAS bf16* HB = (GAS bf16*)(F.ws + WS_HB); const GAS int* SROW = (const GAS int*)(F.ws + WS_SROW); const GAS bf16* FF2 = (const GAS bf16*)(F.ws + WS_FF2);
    const GAS float* g = ((const GAS float*)F.in[26]) + l * DM; const GAS float* bb = ((const GAS float*)F.in[27]) + l * DM; int lane = F.lane; asm volatile("" : "+v"(lane));
    const int gw = F.wg * 8 + F.wave, NGW = F.G * 8; const bool last = (l == DEPTH - 1);
    int m = gw;
    u32x4 hn[2], an[2], cn[2];
    if (m < NTOK) { const int s0 = ld_i32(SROW + 2 * m), s1 = ld_i32(SROW + 2 * m + 1);
#pragma unroll
        for (int j = 0; j < 2; ++j) { hn[j] = *(const GAS u32x4*)(HB + (size_t)m * DM + 8 * lane + 512 * j); an[j] = *(const GAS u32x4*)(FF2 + (size_t)s0 * DM + 8 * lane + 512 * j); cn[j] = *(const GAS u32x4*)(FF2 + (size_t)s1 * DM + 8 * lane + 512 * j); } }
#pragma unroll 1
    for (; m < NTOK; m += NGW) {
        float v[16];
#pragma unroll
        for (int j = 0; j < 2; ++j) { const u32x4 h = hn[j], a = an[j], c = cn[j];
            v[8 * j] = bflo(h.x) * DN_ALPHA + (bflo(a.x) + bflo(c.x)); v[8 * j + 1] = bfhi(h.x) * DN_ALPHA + (bfhi(a.x) + bfhi(c.x)); v[8 * j + 2] = bflo(h.y) * DN_ALPHA + (bflo(a.y) + bflo(c.y)); v[8 * j + 3] = bfhi(h.y) * DN_ALPHA + (bfhi(a.y) + bfhi(c.y));
            v[8 * j + 4] = bflo(h.z) * DN_ALPHA + (bflo(a.z) + bflo(c.z)); v[8 * j + 5] = bfhi(h.z) * DN_ALPHA + (bfhi(a.z) + bfhi(c.z)); v[8 * j + 6] = bflo(h.w) * DN_ALPHA + (bflo(a.w) + bflo(c.w)); v[8 * j + 7] = bfhi(h.w) * DN_ALPHA + (bfhi(a.w) + bfhi(c.w)); }
        const int mn = m + NGW;
        if (mn < NTOK) { const int s0 = ld_i32(SROW + 2 * mn), s1 = ld_i32(SROW + 2 * mn + 1);
#pragma unroll
            for (int j = 0; j < 2; ++j) { hn[j] = *(const GAS u32x4*)(HB + (size_t)mn * DM + 8 * lane + 512 * j); an[j] = *(const GAS u32x4*)(FF2 + (size_t)s0 * DM + 8 * lane + 512 * j); cn[j] = *(const GAS u32x4*)(FF2 + (size_t)s1 * DM + 8 * lane + 512 * j); } }
        float s = 0.f;
#pragma unroll
        for (int i = 0; i < 16; ++i) s += v[i];
        const float mean = wave_sum(s, lane) * (1.f / DM); float s2 = 0.f;
#pragma unroll
        for (int i = 0; i < 16; ++i) { v[i] -= mean; s2 += v[i] * v[i]; }
        const float rstd = 1.f / sqrtf(wave_sum(s2, lane) * (1.f / DM) + LN_EPS);
#pragma unroll
        for (int j = 0; j < 2; ++j) { const int c = 8 * lane + 512 * j; const f32x4 g0 = *(const GAS f32x4*)(g + c), g1 = *(const GAS f32x4*)(g + c + 4), b0 = *(const GAS f32x4*)(bb + c), b1 = *(const GAS f32x4*)(bb + c + 4);
#pragma unroll
            for (int i = 0; i < 4; ++i) { v[8 * j + i] = v[8 * j + i] * rstd * g0[i] + b0[i]; v[8 * j + 4 + i] = v[8 * j + 4 + i] * rstd * g1[i] + b1[i]; }
            if (last) { *(GAS f32x4*)(F.H + (size_t)m * DM + c) = (f32x4){v[8 * j], v[8 * j + 1], v[8 * j + 2], v[8 * j + 3]}; *(GAS f32x4*)(F.H + (size_t)m * DM + c + 4) = (f32x4){v[8 * j + 4], v[8 * j + 5], v[8 * j + 6], v[8 * j + 7]}; }
            else { u32x4 wv; wv.x = pk2(v[8 * j], v[8 * j + 1]); wv.y = pk2(v[8 * j + 2], v[8 * j + 3]); wv.z = pk2(v[8 * j + 4], v[8 * j + 5]); wv.w = pk2(v[8 * j + 6], v[8 * j + 7]); *(GAS u32x4*)(HB + (size_t)m * DM + c) = wv; } }
    }
}

#ifndef EN_P
#define EN_P 1
#endif
#ifndef EN_A
#define EN_A 1
#endif
#ifndef EN_B
#define EN_B 1
#endif
#ifndef EN_C
#define EN_C 1
#endif
#ifndef EN_D
#define EN_D 1
#endif
#ifndef EN_E
#define EN_E 1
#endif
#ifndef EN_F
#define EN_F 1
#endif
#ifndef EN_G
#define EN_G 1
#endif
#ifndef EN_H
#define EN_H 1
#endif
#ifndef EN_I
#define EN_I 1
#endif
#ifndef EN_J
#define EN_J 1
#endif
constexpr int PPL = 12;
constexpr int N_PHASES = 1 + PPL * DEPTH;
#ifndef MK_ONE_LAUNCH
#define MK_ONE_LAUNCH 0
#endif
struct Args { const float* in[28]; float* out; unsigned char* ws; int ph_lo, ph_hi; };
static_assert(sizeof(Args) == 28 * 8 + 8 + 8 + 8, "no padding bytes in the argument struct");


__device__ __forceinline__ unsigned opaque_u32(unsigned x) { asm volatile("" : "+v"(x)); return (unsigned)__builtin_amdgcn_readfirstlane((int)x); }
__device__ __forceinline__ unsigned long long opaque_u64(unsigned long long x) { return ((unsigned long long)opaque_u32((unsigned)(x >> 32)) << 32) | opaque_u32((unsigned)x); }
__device__ __forceinline__ void launder(Frame& F) {
    F.ws = (GAS unsigned char*)opaque_u64((unsigned long long)F.ws); F.H = (GAS float*)opaque_u64((unsigned long long)F.H);
    F.ctl = (gu32*)opaque_u64((unsigned long long)F.ctl);
    unsigned z0 = 0u; asm volatile("" : "+v"(z0)); int ln = (int)__builtin_amdgcn_mbcnt_hi(~0u, __builtin_amdgcn_mbcnt_lo(~0u, z0));
    F.wave = (int)opaque_u32((unsigned)F.wave); F.lane = ln; F.tid = F.wave * 64 + ln;
    F.G = (int)opaque_u32((unsigned)F.G); F.wg = (int)opaque_u32((unsigned)F.wg);
}
__global__ void __launch_bounds__(512, 2) mk_fwd(Args args) {
    extern __shared__ __attribute__((aligned(16))) unsigned char lds_raw[];
    Frame F;
    F.lds = (LAS unsigned char*)lds_raw;
    F.MISC = (volatile LAS unsigned*)(F.lds + MISC_OFF);
    F.tid = threadIdx.x; F.lane = F.tid & 63; F.wave = __builtin_amdgcn_readfirstlane(F.tid >> 6);
    F.G = gridDim.x; F.wg = blockIdx.x;
    F.in = args.in;
    F.pos = (const GAS int*)args.in[1];
    F.H = (GAS float*)args.out; F.ws = (GAS unsigned char*)args.ws;
    F.ctl = (gu32*)(args.ws + WS_CTL);
    for (int u = F.tid; u < (LDS_BYTES - MISC_OFF) / 4; u += 512) ((LAS unsigned*)(F.lds + MISC_OFF))[u] = 0u;
    __syncthreads();
    const int lo = args.ph_lo, hi = args.ph_hi;
    const bool multi = (hi - lo) > 1;
    XcdBarrier bar; bar.bar = (unsigned*)(F.ctl + CW_BAR); bar.x = 0; bar.st = nullptr;
    if (multi) bar = xcd_barrier_post((unsigned*)(F.ctl + CW_BAR), F.MISC + 8);
#define IN(k) (lo <= (k) && (k) < hi)
#define SEAM(k) do { if (IN(k) && IN((k) + 1)) xcd_barrier(bar); } while (0)

#ifdef DUP_P
    for (int rep = 0; rep < 2; ++rep)
#endif
    if (EN_P && IN(0)) { launder(F); phase_prologue(F); }
    SEAM(0);
#define HB ((GAS bf16*)(F.ws + WS_HB))
#define PA ((GAS bf16*)(F.ws + WS_PA))
#define Y ((GAS bf16*)(F.ws + WS_Y))
#define HM ((GAS bf16*)F.H + (size_t)NTOK * DM)
#define TT ((GAS bf16*)F.H)
    for (int l = 0; l < DEPTH; ++l) {
        const int pb = 1 + PPL * l;
#define wd (F.ws + WS_WDENSE + (size_t)l * WD_LAYER)
#ifdef DUP_A
        for (int rep = 0; rep < 2; ++rep)
#endif
        if (EN_A && IN(pb + 0)) { launder(F);
            DenseSched S; S.init(NTOK / 256, NPA / 256, F.G, F.wg, (const void*)HB, (size_t)256 * DM * 2, (const void*)(wd + WD_WA), (size_t)256 * DM * 2);
            EpiA E{PA, (GAS bf16*)(F.ws + WS_KA), (GAS bf16*)(F.ws + WS_VA), (GAS bf16*)(F.ws + WS_KI), (GAS float*)(F.ws + WS_WI), (GAS float*)(F.ws + WS_GLR), (const GAS float*)(F.ws + WS_ROPE), ((const GAS float*)F.in[5]) + l * 64};
            pg8::gemm_phase<EpiA, DenseSched, false>(F.lds, S, E, DM, DM, F.wave);
        }
        SEAM(pb + 0);
        if (EN_B && IN(pb + 1)) { launder(F); phase_mixer(F, l);
#ifdef DUP_B
            launder(F); phase_mixer(F, l, 1, DUP_B);
#endif
        }
        SEAM(pb + 1);
        if (EN_B && IN(pb + 2)) { launder(F); gla_scan_phase(F); }
        SEAM(pb + 2);
        if (EN_B && IN(pb + 3)) { launder(F); phase_gla_out(F, l); }
        SEAM(pb + 3);
#ifdef DUP_C
        for (int rep = 0; rep < 2; ++rep)
#endif
        if (EN_C && IN(pb + 4)) { launder(F);
            DenseSched S; S.init(NTOK / 256, NGT / 256, F.G, F.wg, (const void*)HB, (size_t)256 * DM * 2, (const void*)(wd + WD_WG), (size_t)256 * DM * 2);
            EpiG E{PA};
            pg8::gemm_phase<EpiG, DenseSched, false>(F.lds, S, E, DM, DM, F.wave);
        }
        SEAM(pb + 4);
#ifdef DUP_D
        for (int rep = 0; rep < 2; ++rep)
#endif
        if (EN_D && IN(pb + 5)) { launder(F);
            DenseSched S; S.init(NTOK / 256, DM / 256, F.G, F.wg, (const void*)Y, (size_t)256 * 1536 * 2, (const void*)(wd + WD_WBR), (size_t)256 * 512 * 2);
            S.nsub = 3; S.asub = 512 * 2; S.bsub = (size_t)1024 * 512 * 2;
            EpiM E{PA, HM};
            pg8::gemm_phase<EpiM, DenseSched, false>(F.lds, S, E, 512, 1536, F.wave);
        }
        SEAM(pb + 5);
        if (EN_E && IN(pb + 6)) { launder(F);
            DenseSched S; S.init(NTOK / 256, DM / 256, F.G, F.wg, (const void*)HM, (size_t)256 * DM * 2, (const void*)(wd + WD_WOUT), (size_t)256 * DM * 2);
            EpiO E{HB, TT};
            pg8::gemm_phase<EpiO, DenseSched, false>(F.lds, S, E, DM, DM, F.wave);
        }
        SEAM(pb + 6);
        if (EN_F && IN(pb + 7)) { launder(F); phase_ln_router(F, l); }
        SEAM(pb + 7);
        if (EN_G && IN(pb + 8)) { launder(F);
            { LAS float* scr = (LAS float*)(F.lds + F.wave * 16384); const int gw = F.wg * 8 + F.wave, NGW = F.G * 8;
              for (int it = gw; it < 12288; it += NGW) conv_moe_item(F, l, it, scr);
              __syncthreads(); }
            phase_dispatch(F); }
        SEAM(pb + 8);
#ifdef DUP_H
        for (int rep = 0; rep < 2; ++rep)
#endif
        if (EN_H && IN(pb + 9)) { launder(F);
            const GAS int* META = (const GAS int*)(F.ws + WS_META); const GAS int* ROWMAP = (const GAS int*)(F.ws + WS_ROWMAP);
            const int NT = ld_i32(META), NU = NT * 2;
            LAS int* meta = (LAS int*)(F.lds + AUX_OFF); LAS int* rows = (LAS int*)(F.lds + AUX_OFF + 64);
            for (int i = 0; i * F.G + F.wg < NU && i < 8; ++i) { const int L = i * F.G + F.wg, gt = L >> 1;
                if (F.tid == 0) meta[i] = ld_i32(META + 16 + gt);
                if (F.tid < 256) rows[i * 256 + F.tid] = ROWMAP[gt * 256 + F.tid]; }
            __syncthreads();
            GroupSched S{NU, F.G, F.wg, 2, (const char*)HB, (const char*)(F.ws + WS_WMOE + WM_GU), 0, (size_t)512 * DM * 2, (size_t)256 * DM * 2, meta, rows};
            EpiGU E{(GAS bf16*)(F.ws + WS_HID), (const GAS float*)(F.ws + WS_CWROW)};
            pg8::gemm_phase<EpiGU, GroupSched, true>(F.lds, S, E, DM, DM, F.wave);
        }
        SEAM(pb + 9);
#ifdef DUP_I
        for (int rep = 0; rep < 2; ++rep)
#endif
        if (EN_I && IN(pb + 10)) { launder(F);
            const GAS int* META = (const GAS int*)(F.ws + WS_META);
            const int NT = ld_i32(META), NU = NT * 4;
            LAS int* meta = (LAS int*)(F.lds + AUX_OFF);
            for (int i = 0; i * F.G + F.wg < NU && i < 8; ++i) { const int L = i * F.G + F.wg, gt = L >> 2; if (F.tid == 0) meta[i] = ld_i32(META + 16 + gt); }
            __syncthreads();
            GroupSched S{NU, F.G, F.wg, 4, (const char*)(F.ws + WS_HID), (const char*)(F.ws + WS_WMOE + WM_DN), (size_t)256 * DEXP * 2, (size_t)DM * DEXP * 2, (size_t)256 * DEXP * 2, meta, nullptr};
            EpiDN E{(GAS bf16*)(F.ws + WS_FF2)};
            pg8::gemm_phase<EpiDN, GroupSched, false>(F.lds, S, E, DEXP, DEXP, F.wave);
        }
        SEAM(pb + 10);
        if (EN_J && IN(pb + 11)) { launder(F); phase_ln2(F, l); }
        SEAM(pb + 11);
    }
#undef IN
#undef SEAM
#undef HB
#undef HM
#undef TT
#undef PA
#undef Y
#undef wd
}


#ifdef DUMP_OFF
__global__ void dump_k(const unsigned short* src, float* out) {
    for (size_t i = (size_t)blockIdx.x * blockDim.x + threadIdx.x; i < (size_t)NTOK * 1024; i += (size_t)gridDim.x * blockDim.x) { const size_t n = i >> 10, c = i & 1023; out[i] = __builtin_bit_cast(float, ((unsigned)src[n * DUMP_PITCH + c]) << 16); }
}
#endif
extern "C" void kernel_launch(void* const* d_in, const int* in_sizes, int n_in, void* d_out, int out_size, void* d_ws, size_t ws_size, hipStream_t stream) {
    static int grid = 0;
    if (grid == 0) {
        if (n_in != 28 || out_size != NTOK * DM || ws_size < WS_END) { fprintf(stderr, "kernel_launch: unexpected shapes (n_in %d out %d ws %zu); nothing launched\n", n_in, out_size, ws_size); grid = -1; return; }
        int dev = 0, cus = 0;
        if (hipGetDevice(&dev) != hipSuccess || hipDeviceGetAttribute(&cus, hipDeviceAttributeMultiprocessorCount, dev) != hipSuccess) { grid = -1; return; }
        if (hipFuncSetAttribute((const void*)mk_fwd, hipFuncAttributeMaxDynamicSharedMemorySize, LDS_BYTES) != hipSuccess) { fprintf(stderr, "kernel_launch: hipFuncSetAttribute failed\n"); grid = -1; return; }
        int per_cu = 0;
        if (hipOccupancyMaxActiveBlocksPerMultiprocessor(&per_cu, (const void*)mk_fwd, 512, LDS_BYTES) != hipSuccess || per_cu < 1) { fprintf(stderr, "kernel_launch: occupancy query says %d\n", per_cu); }
        (void)hipGetLastError();
        grid = cus;
        if (grid != 256) fprintf(stderr, "kernel_launch: %d CUs (built for 256)\n", grid);
    }
    if (grid < 0) return;
    if (hipMemsetAsync((char*)d_ws + WS_CTL, 0, CTL_ZERO_BYTES, stream) != hipSuccess) return;
    Args a{};
    for (int i = 0; i < 28; ++i) a.in[i] = (const float*)d_in[i];
    a.out = (float*)d_out; a.ws = (unsigned char*)d_ws;
#if MK_ONE_LAUNCH
    a.ph_lo = 0; a.ph_hi = N_PHASES;
    hipLaunchKernelGGL(mk_fwd, dim3(grid), dim3(512), LDS_BYTES, stream, a);
#else
#ifndef STOP_AFTER
#define STOP_AFTER (N_PHASES - 1)
#endif
#ifndef PHASE_MASK
#define PHASE_MASK 0xffffffffu
#endif
    for (int p = 0; p <= STOP_AFTER; ++p) { if (!((PHASE_MASK >> p) & 1u)) continue; a.ph_lo = p; a.ph_hi = p + 1; hipLaunchKernelGGL(mk_fwd, dim3(grid), dim3(512), LDS_BYTES, stream, a); }
#ifdef DUMP_OFF
    hipLaunchKernelGGL(dump_k, dim3(2048), dim3(256), 0, stream, (const unsigned short*)((const char*)d_ws + (size_t)(DUMP_OFF)), (float*)d_out);
#endif
#endif
}
```

```cpp
#define MK_ONE_LAUNCH 1
#include <hip/hip_runtime.h>
#include <cstdio>
#include <cstdint>

#define LAS __attribute__((address_space(3)))
#define GAS __attribute__((address_space(1)))
typedef unsigned short bf16;
typedef short bf16x8 __attribute__((ext_vector_type(8)));
typedef float f32x4 __attribute__((ext_vector_type(4)));
typedef float f32x2 __attribute__((ext_vector_type(2)));
typedef unsigned u32x4 __attribute__((ext_vector_type(4)));
typedef unsigned u32x2 __attribute__((ext_vector_type(2)));
typedef GAS unsigned gu32;

constexpr int NB = 8, SEQ = 4096, NTOK = NB * SEQ, DM = 1024, NIN = 6612, DEPTH = 2;
constexpr int NPA = 3584;
constexpr int NGT = 3072;
constexpr int NEXP = 32, DEXP = 256;
constexpr int MAXTILES = 288;
constexpr float DN_ALPHA = 1.41421356237309515f;
constexpr float LN_EPS = 1e-5f, RMS_EPS = 1e-6f;
constexpr int PA_Q = 0, PA_QI = 768, PA_BQ = 1024, PA_BK = 1280, PA_BV = 1536, PA_BR = 2048, PA_CU = 2560, PA_CV = 3072;

__device__ __forceinline__ unsigned f2bf(float f) { unsigned u = __builtin_bit_cast(unsigned, f); return (u + 0x7fffu + ((u >> 16) & 1u)) >> 16; }
__device__ __forceinline__ unsigned pk2(float lo, float hi) { return f2bf(lo) | (f2bf(hi) << 16); }
__device__ __forceinline__ float bflo(unsigned w) { return __builtin_bit_cast(float, w << 16); }
__device__ __forceinline__ float bfhi(unsigned w) { return __builtin_bit_cast(float, w & 0xffff0000u); }
__device__ __forceinline__ float bf1(bf16 h) { return __builtin_bit_cast(float, ((unsigned)h) << 16); }
typedef __bf16 bf16x2_t __attribute__((ext_vector_type(2)));
__device__ __forceinline__ unsigned cvt_pk_bf16(float lo, float hi) { const f32x2 v = {lo, hi}; const bf16x2_t b = __builtin_convertvector(v, bf16x2_t); return __builtin_bit_cast(unsigned, b); }
__device__ __forceinline__ float shx(float v, int mask, int lane) { return __builtin_bit_cast(float, __builtin_amdgcn_ds_bpermute((lane ^ mask) << 2, __builtin_bit_cast(int, v))); }
__device__ __forceinline__ int shxi(int v, int mask, int lane) { return __builtin_amdgcn_ds_bpermute((lane ^ mask) << 2, v); }
__device__ __forceinline__ float wave_sum(float v, int lane) {
#pragma unroll
    for (int o = 1; o < 64; o <<= 1) v += shx(v, o, lane);
    return v;
}
__device__ __forceinline__ float wave_max(float v, int lane) {
#pragma unroll
    for (int o = 1; o < 64; o <<= 1) v = fmaxf(v, shx(v, o, lane));
    return v;
}
__device__ __forceinline__ int wave_sum_i(int v, int lane) {
#pragma unroll
    for (int o = 1; o < 64; o <<= 1) v += shxi(v, o, lane);
    return v;
}
__device__ __forceinline__ int ld_i32(const GAS int* p) { return __hip_atomic_load(p, __ATOMIC_RELAXED, __HIP_MEMORY_SCOPE_AGENT); }
__device__ __forceinline__ float ld_f32(const GAS float* p) { return __hip_atomic_load(p, __ATOMIC_RELAXED, __HIP_MEMORY_SCOPE_AGENT); }
__device__ __forceinline__ float sigmoidf_(float x) { return __builtin_amdgcn_rcpf(1.0f + __expf(-x)); }
__device__ __forceinline__ float siluf_(float x) { return x * sigmoidf_(x); }
__device__ __forceinline__ float gelu_tanh_(float x) { const float u = 0.7978845608028654f * (x + 0.044715f * x * x * x); return x * sigmoidf_(2.0f * u); }

namespace pg8 {
constexpr int BM = 256, BK = 64, HALF = 128, HTB = HALF * BK * 2, STAGE_BYTES = 8 * HTB;
__host__ __device__ __forceinline__ int lds_byte(int r, int c) { const int st = (r >> 4) * 2 + (c >> 5), rr = r & 15, cc = c & 31, ob = rr * 64 + cc * 2; return st * 1024 + (ob ^ (((ob >> 9) & 1) << 5)); }
__host__ __device__ __forceinline__ void stage_rc(int b, int& R, int& C) { const int st = b / 1024, sb = b % 1024, swz = sb ^ (((sb >> 9) & 1) << 5); R = (st >> 1) * 16 + swz / 64; C = (st & 1) * 32 + (swz % 64) / 2; }
__host__ __device__ __forceinline__ int perm32(int rho) { const int n = rho >> 4, i = rho & 15; return 8 * (i >> 2) + 4 * n + (i & 3); }

struct Unit { int pm, pn, e, slot; };

template <class Epi, class Sched, bool GATHER>
__device__ __forceinline__ void gemm_phase(LAS unsigned char* lds, const Sched& S, const Epi& E, const int K, const int lda, const int wave) {
    unsigned z0_ = 0u; asm volatile("" : "+v"(z0_)); const int lane_ = (int)__builtin_amdgcn_mbcnt_hi(~0u, __builtin_amdgcn_mbcnt_lo(~0u, z0_));
    const int wid = wave, lane = lane_, tid = wid * 64 + lane, wr = wid >> 2, wc = wid & 3, fr = lane & 15, fq = lane >> 4;
    const int nt = K / BK;
    int Rr[2], Cc[2];
    unsigned voffB[2];
#pragma unroll
    for (int i = 0; i < 2; ++i) { int R, C; stage_rc(tid * 16 + i * 8192, R, C); Rr[i] = R; Cc[i] = C; const int Rb = Epi::PERM ? ((R & ~31) + perm32(R & 31)) : R; voffB[i] = (unsigned)(Rb * K + C) * 2u; }
    const size_t kstep = (size_t)(BK * 2);
    const size_t hstepB = (size_t)HALF * K * 2;
    const unsigned ldsw = (unsigned)wid * 1024u;
    const int aoff = lds_byte(wr * 64 + fr, fq * 8), boff = lds_byte(wc * 32 + fr, fq * 8);
#define PG8_SA(b, h) (((b) * 2 + (h)) * HTB)
#define PG8_SB(b, h) ((4 + (b) * 2 + (h)) * HTB)
#define PG8_STAGE(bufoff, gbase, voff) do { _Pragma("unroll") for (int _i = 0; _i < 2; ++_i) \
        __builtin_amdgcn_global_load_lds((const unsigned*)((const char*)(gbase) + (voff)[_i]), (LAS unsigned*)(lds + (bufoff) + ldsw + _i * 8192), 16, 0, 0); } while (0)
#define PG8_LDA(dst, b, h) do { _Pragma("unroll") for (int m = 0; m < 4; ++m) _Pragma("unroll") for (int k = 0; k < 2; ++k) dst[m][k] = *(const LAS bf16x8*)(lds + PG8_SA(b, h) + aoff + m * 2048 + k * 1024); } while (0)
#define PG8_LDB(dst, b, h) do { _Pragma("unroll") for (int n = 0; n < 2; ++n) _Pragma("unroll") for (int k = 0; k < 2; ++k) dst[n][k] = *(const LAS bf16x8*)(lds + PG8_SB(b, h) + boff + n * 2048 + k * 1024); } while (0)
#define PG8_MMA(ai, bj, At, Bt) do { __builtin_amdgcn_s_setprio(1); _Pragma("unroll") for (int m = 0; m < 4; ++m) _Pragma("unroll") for (int n = 0; n < 2; ++n) _Pragma("unroll") for (int k = 0; k < 2; ++k) \
        acc[ai][bj][m][n] = __builtin_amdgcn_mfma_f32_16x16x32_bf16(Bt[n][k], At[m][k], acc[ai][bj][m][n], 0, 0, 0); __builtin_amdgcn_s_setprio(0); } while (0)
#define PG8_WAIT_V(n) asm volatile("s_waitcnt vmcnt(" #n ")" ::: "memory")
#define PG8_WAIT_L(n) asm volatile("s_waitcnt lgkmcnt(" #n ")" ::: "memory")
#define PG8_BAR do { asm volatile("" ::: "memory"); __builtin_amdgcn_s_barrier(); asm volatile("" ::: "memory"); } while (0)
#define PG8_SCHED __builtin_amdgcn_sched_barrier(0)
    Unit cur, nxt; int ui = 0;
    if (!S.next(0, cur)) return;
    f32x4 acc[2][2][4][2];
#pragma unroll
    for (int a = 0; a < 2; ++a)
#pragma unroll
        for (int b = 0; b < 2; ++b)
#pragma unroll
            for (int m = 0; m < 4; ++m)
#pragma unroll
                for (int n = 0; n < 2; ++n) acc[a][b][m][n] = (f32x4){0.f, 0.f, 0.f, 0.f};
    bf16x8 At[4][2], B0[2][2], B1[2][2];
    unsigned cA0[2], cA1[2], nA0[2], nA1[2];
#pragma unroll
    for (int i = 0; i < 2; ++i) {
        if (GATHER) { cA0[i] = (unsigned)(S.row_of(cur, Rr[i]) * lda + Cc[i]) * 2u; cA1[i] = (unsigned)(S.row_of(cur, HALF + Rr[i]) * lda + Cc[i]) * 2u; }
        else { cA0[i] = (unsigned)(Rr[i] * lda + Cc[i]) * 2u; cA1[i] = (unsigned)((HALF + Rr[i]) * lda + Cc[i]) * 2u; }
        nA0[i] = cA0[i]; nA1[i] = cA1[i];
    }
    const char* cA = S.a_base(cur); const char* cB = S.b_base(cur);
    PG8_STAGE(PG8_SB(0, 0), cB, voffB); PG8_STAGE(PG8_SB(0, 1), cB + hstepB, voffB); PG8_STAGE(PG8_SA(0, 0), cA, cA0); PG8_STAGE(PG8_SA(0, 1), cA, cA1);
    if (wr == 1) PG8_BAR;
    PG8_WAIT_V(2); PG8_BAR;
    PG8_STAGE(PG8_SB(1, 0), cB + kstep, voffB); PG8_STAGE(PG8_SA(1, 0), cA + kstep, cA0); PG8_STAGE(PG8_SB(1, 1), cB + hstepB + kstep, voffB);
    PG8_WAIT_V(6); PG8_BAR;
    for (;;) {
        const bool has_next = S.next(ui + 1, nxt);
        const char* nA = has_next ? S.a_base(nxt) : cA; const char* nB = has_next ? S.b_base(nxt) : cB;
        if (GATHER) {
#pragma unroll
            for (int i = 0; i < 2; ++i) {
                if (has_next) { nA0[i] = (unsigned)(S.row_of(nxt, Rr[i]) * lda + Cc[i]) * 2u; nA1[i] = (unsigned)(S.row_of(nxt, HALF + Rr[i]) * lda + Cc[i]) * 2u; }
                else { nA0[i] = cA0[i]; nA1[i] = cA1[i]; }
            }
        }
#pragma unroll 1
        for (int t = 0; t < nt; t += 2) {
            const bool last = (t == nt - 2);
            const char* a1 = cA + (size_t)(t + 1) * kstep;
            const char* a2 = last ? nA : cA + (size_t)(t + 2) * kstep; const char* b2 = last ? nB : cB + (size_t)(t + 2) * kstep;
            const char* a3 = a2 + kstep; const char* b3 = b2 + kstep;
            unsigned x0[2], x1[2];
#pragma unroll
            for (int i = 0; i < 2; ++i) { x0[i] = (GATHER && last) ? nA0[i] : cA0[i]; x1[i] = (GATHER && last) ? nA1[i] : cA1[i]; }
            PG8_LDB(B0, 0, 0); PG8_LDB(B1, 0, 1); PG8_SCHED; PG8_LDA(At, 0, 0); PG8_STAGE(PG8_SA(1, 1), a1, cA1);
            PG8_WAIT_V(8); PG8_WAIT_L(0); PG8_BAR; PG8_MMA(0, 0, At, B0); PG8_MMA(0, 1, At, B1); PG8_BAR; PG8_SCHED;
            PG8_LDA(At, 0, 1); PG8_STAGE(PG8_SB(0, 0), b2, voffB); PG8_STAGE(PG8_SB(0, 1), b2 + hstepB, voffB); PG8_STAGE(PG8_SA(0, 0), a2, x0);
            PG8_WAIT_V(8); PG8_WAIT_L(0); PG8_BAR; PG8_MMA(1, 0, At, B0); PG8_MMA(1, 1, At, B1); PG8_BAR; PG8_SCHED;
            PG8_LDB(B0, 1, 0); PG8_LDB(B1, 1, 1); PG8_SCHED; PG8_LDA(At, 1, 0); PG8_STAGE(PG8_SA(0, 1), a2, x1);
            PG8_WAIT_V(8); PG8_WAIT_L(0); PG8_BAR; PG8_MMA(0, 0, At, B0); PG8_MMA(0, 1, At, B1); PG8_BAR; PG8_SCHED;
            PG8_LDA(At, 1, 1); PG8_STAGE(PG8_SB(1, 0), b3, voffB); PG8_STAGE(PG8_SB(1, 1), b3 + hstepB, voffB); PG8_STAGE(PG8_SA(1, 0), a3, x0);
            PG8_WAIT_V(8); PG8_WAIT_L(0); PG8_BAR; PG8_MMA(1, 0, At, B0); PG8_MMA(1, 1, At, B1); PG8_BAR; PG8_SCHED;
        }
        if (wr == 0) PG8_BAR;
        E(acc, cur, wr, wc, fr, fq);
        if (!has_next) break;
#pragma unroll
        for (int a = 0; a < 2; ++a)
#pragma unroll
            for (int b = 0; b < 2; ++b)
#pragma unroll
                for (int m = 0; m < 4; ++m)
#pragma unroll
                    for (int n = 0; n < 2; ++n) acc[a][b][m][n] = (f32x4){0.f, 0.f, 0.f, 0.f};
        cur = nxt; cA = nA; cB = nB; ++ui;
#pragma unroll
        for (int i = 0; i < 2; ++i) { cA0[i] = nA0[i]; cA1[i] = nA1[i]; }
        if (wr == 1) PG8_BAR;
    }
    PG8_WAIT_V(0);
    PG8_BAR;
#undef PG8_SA
#undef PG8_SB
#undef PG8_STAGE
#undef PG8_LDA
#undef PG8_LDB
#undef PG8_MMA
#undef PG8_WAIT_V
#undef PG8_WAIT_L
#undef PG8_BAR
#undef PG8_SCHED
}
}

#define XB_TMO      128
#define XB_XCNT(j)  (256  + 64 * (j))
#define XB_XSUB(j)  (1280 + 64 * (j))
#define XB_XGEN(j)  (2304 + 64 * (j))
#define XB_TOP      3328
#define XB_TOPGEN   3392
#define XCD_BAR_WORDS 3456
#define XB_SPIN_CAP (1u << 20)

__device__ __forceinline__ unsigned xb_ld(unsigned* p)              { return __hip_atomic_load(p, __ATOMIC_RELAXED, __HIP_MEMORY_SCOPE_AGENT); }
__device__ __forceinline__ unsigned xb_add(unsigned* p, unsigned v) { return __hip_atomic_fetch_add(p, v, __ATOMIC_RELAXED, __HIP_MEMORY_SCOPE_AGENT); }
__device__ __forceinline__ unsigned xb_xcc_id() { return (unsigned)__builtin_amdgcn_s_getreg((3 << 11) | 20) & 0xFu; }
#define XB_SPIN(cond, bar) do { unsigned _sp = 0; while (cond) { __builtin_amdgcn_s_sleep(1); \
    if ((++_sp & 255u) == 0u) { if (xb_ld(&(bar)[XB_TMO])) break; if (_sp > XB_SPIN_CAP) { atomicAdd(&(bar)[XB_TMO], 1u); break; } } } } while (0)

struct XcdBarrier { unsigned* bar; unsigned x; volatile LAS unsigned* st; };

__device__ __forceinline__ XcdBarrier xcd_barrier_post(unsigned* bar, volatile LAS unsigned* st) {
    XcdBarrier b; b.bar = bar; b.x = xb_xcc_id(); b.st = st;
    if (threadIdx.x == 0) (void)xb_add(&bar[XB_XCNT(b.x)], 1u);
    return b;
}
__device__ __forceinline__ void xcd_barrier_complete(unsigned* bar, unsigned x, unsigned& nloc, unsigned& nx) {
    const unsigned G = gridDim.x * gridDim.y * gridDim.z;
    unsigned sum, cnt, mine, sp = 0u;
    for (;;) {
        sum = 0u; cnt = 0u; mine = 0u;
#pragma unroll
        for (unsigned j = 0; j < 16; ++j) { const unsigned c = xb_ld(&bar[XB_XCNT(j)]); sum += c; cnt += (c > 0u) ? 1u : 0u; mine = (j == x) ? c : mine; }
        if (sum == G) break;
        __builtin_amdgcn_s_sleep(1);
        if ((++sp & 255u) == 0u) { if (xb_ld(&bar[XB_TMO])) break; if (sp > XB_SPIN_CAP) { atomicAdd(&bar[XB_TMO], 1u); break; } }
    }
    nloc = mine > 0u ? mine : 1u; nx = cnt > 0u ? cnt : 1u;
}
__device__ __forceinline__ void xcd_barrier(const XcdBarrier& b) {
    asm volatile("s_waitcnt vmcnt(0)" ::: "memory");
    __syncthreads();
    if (threadIdx.x == 0) {
        unsigned* bar = b.bar;
        __builtin_amdgcn_s_waitcnt(0);
        unsigned nloc = b.st[0], nx = b.st[1];
        if (nloc == 0u) { xcd_barrier_complete(bar, b.x, nloc, nx); b.st[0] = nloc; b.st[1] = nx; }
        const unsigned old = xb_add(&bar[XB_XSUB(b.x)], 1u);
        const unsigned gen = old / nloc;
        if (old + 1u == (gen + 1u) * nloc) {
            __builtin_amdgcn_fence(__ATOMIC_RELEASE, "agent");
            asm volatile("s_waitcnt vmcnt(0)" ::: "memory");
            const unsigned og = xb_add(&bar[XB_TOP], 1u);
            const unsigned tg = og / nx;
            if (og + 1u == (tg + 1u) * nx) xb_add(&bar[XB_TOPGEN], 1u);
            else XB_SPIN(xb_ld(&bar[XB_TOPGEN]) == tg, bar);
            __builtin_amdgcn_fence(__ATOMIC_ACQUIRE, "agent");
            xb_add(&bar[XB_XGEN(b.x)], 1u);
            asm volatile("s_waitcnt vmcnt(0)" ::: "memory");
        } else {
            XB_SPIN(xb_ld(&bar[XB_XGEN(b.x)]) == gen, bar);
            __builtin_amdgcn_fence(__ATOMIC_ACQUIRE, "agent");
            asm volatile("s_waitcnt vmcnt(0)" ::: "memory");
        }
    }
    __syncthreads();
}

constexpr size_t MiB = 1u << 20;
constexpr size_t WS_CTL = 0, CTL_ZERO_BYTES = 1 * MiB;
constexpr size_t WS_ROPE = 1 * MiB;
constexpr size_t WS_WI   = 3 * MiB;
constexpr size_t WS_ROUTE = 3 * MiB + 512 * 1024;
constexpr size_t WS_SROW = 4 * MiB;
constexpr size_t WS_ROWMAP = 4 * MiB + 256 * 1024;
constexpr size_t WS_CWROW = 4 * MiB + 640 * 1024;
constexpr size_t WS_CNTWG = 5 * MiB;
constexpr size_t WS_META = 5 * MiB + 64 * 1024;
constexpr size_t WS_WR = 5 * MiB + 128 * 1024;
constexpr size_t WS_GLR = 6 * MiB;
constexpr size_t WS_WDENSE = 8 * MiB;
constexpr size_t WD_WA = 0, WD_WG = 7 * MiB, WD_WBR = 13 * MiB, WD_WOUT = 16 * MiB, WD_LAYER = 18 * MiB;
constexpr size_t WS_WMOE = 44 * MiB;
constexpr size_t WM_GU = 0, WM_DN = 32 * MiB;
constexpr size_t WS_HB = 92 * MiB;
constexpr size_t WS_PA = 156 * MiB;
constexpr size_t WS_HID = WS_PA;
constexpr size_t WS_FF2 = WS_PA + 40 * MiB;
constexpr size_t WS_Y = 380 * MiB;
constexpr size_t WS_KA = 476 * MiB, WS_VA = 480 * MiB, WS_KI = 484 * MiB;
constexpr size_t WS_END = 512 * MiB;
static_assert(WS_WDENSE + 2 * WD_LAYER <= WS_WMOE && WS_WMOE + 48 * MiB <= WS_HB && WS_HB + 64 * MiB <= WS_PA && WS_PA + 224 * MiB <= WS_Y && WS_Y + 96 * MiB <= WS_KA && WS_KI + 4 * MiB <= WS_END, "ws map");
static_assert(WS_FF2 + (size_t)73728 * 1024 * 2 <= WS_Y, "ff2 fits");
constexpr int CW_BAR = 4096;
constexpr int CW_QUEUE = 16384;

constexpr int RING_BYTES = 131072;
constexpr int AUX_OFF = 131072;
constexpr int MISC_OFF = 147456;
constexpr int LDS_BYTES = 148480;

struct Frame {
    LAS unsigned char* lds;
    volatile LAS unsigned* MISC;
    gu32* ctl;
    int tid, lane, wave, G, wg;
    const float* const* in;
    const GAS int* pos;
    GAS float* H;
    GAS unsigned char* ws;
};

#define LDS_WAIT() asm volatile("s_waitcnt lgkmcnt(0)" ::: "memory")
#define VM_WAIT() asm volatile("s_waitcnt vmcnt(0)" ::: "memory")

__device__ __forceinline__ int pa_src_col(int c) {
    if (c < 512) return c;
    if (c < 768) { const int x = c - 512, half = x >> 7, y = x & 127, grp = y >> 5, d = (y & 31) + 32 * half;
        if (grp == 0) return 512 + d;
        if (grp == 1) return 576 + d;
        if (grp == 2) return 896 + d;
        if (half == 0) { const int z = y - 96; if (z < 4) return 960 + z; if (z < 20) return 1988 + (z - 4); }
        return -1; }
    if (c < 1024) return 640 + (c - 768);
    if (c < 1280) return 964 + (c - 1024);
    if (c < 1536) return 1220 + (c - 1280);
    if (c < 2048) return 1476 + (c - 1536);
    if (c < 2560) return 2004 + (c - 2048);
    return 2516 + (c - 2560);
}
__device__ __forceinline__ void transpose_item(const GAS float* W, int ldw, int K, GAS bf16* WT, int n0, int k0, int sc, LAS float* scr, int lane) {
#pragma unroll 8
    for (int i = 0; i < 32; ++i) { const int kk = 2 * i + (lane >> 5); scr[kk * 33 + (lane & 31)] = (sc >= 0) ? W[(size_t)(k0 + kk) * ldw + sc] : 0.f; }
    LDS_WAIT(); asm volatile("" ::: "memory");
    const int c = lane & 7;
#pragma unroll
    for (int j = 0; j < 4; ++j) { const int n = (lane >> 3) + 8 * j; const LAS float* s = scr + (8 * c) * 33 + n;
        u32x4 o; o.x = pk2(s[0 * 33], s[1 * 33]); o.y = pk2(s[2 * 33], s[3 * 33]); o.z = pk2(s[4 * 33], s[5 * 33]); o.w = pk2(s[6 * 33], s[7 * 33]);
        *(GAS u32x4*)(WT + (size_t)(n0 + n) * K + k0 + 8 * c) = o; }
    LDS_WAIT(); asm volatile("" ::: "memory");
}
__device__ __forceinline__ void conv_dense_item(Frame& F, int l, int it, LAS float* scr) {
    GAS bf16* base = (GAS bf16*)(F.ws + WS_WDENSE + (size_t)l * WD_LAYER);
    const int lane = F.lane;
    if (it < 1792) { const int kb = it / 112, nb = it % 112; const int sc = pa_src_col(32 * nb + (lane & 31));
        transpose_item(((const GAS float*)F.in[4]) + (size_t)l * DM * NIN, NIN, DM, base + WD_WA / 2, 32 * nb, 64 * kb, sc, scr, lane); return; }
    it -= 1792;
    if (it < 1536) { const int kb = it / 96, nb = it % 96; const int sc = 3540 + 32 * nb + (lane & 31);
        transpose_item(((const GAS float*)F.in[4]) + (size_t)l * DM * NIN, NIN, DM, base + WD_WG / 2, 32 * nb, 64 * kb, sc, scr, lane); return; }
    it -= 1536;
    if (it < 768) { const int br = it / 256, r = it % 256, kb = r / 32, nb = r % 32; const int sc = 32 * nb + (lane & 31);
        transpose_item((br == 0 ? ((const GAS float*)F.in[13]) : br == 1 ? ((const GAS float*)F.in[14]) : ((const GAS float*)F.in[15])) + (size_t)l * 512 * DM, DM, 512, base + WD_WBR / 2 + (size_t)br * 1024 * 512, 32 * nb, 64 * kb, sc, scr, lane); return; }
    it -= 768;
    { const int kb = it / 32, nb = it % 32; const int sc = 32 * nb + (lane & 31);
        transpose_item(((const GAS float*)F.in[16]) + (size_t)l * DM * DM, DM, DM, base + WD_WOUT / 2, 32 * nb, 64 * kb, sc, scr, lane); }
}
__device__ __forceinline__ void conv_moe_item(Frame& F, int l, int it, LAS float* scr) {
    const int lane = F.lane; const int e = it / 384; int r = it % 384;
    if (r < 256) { const int sub = r / 64, q = r % 64, ct = sub >> 1, bj = sub & 1, kb = q / 4, nb = q % 4;
        const GAS float* src = (bj ? ((const GAS float*)F.in[24]) : ((const GAS float*)F.in[23])) + (size_t)(l * NEXP + e) * DM * DEXP;
        GAS bf16* dst = (GAS bf16*)(F.ws + WS_WMOE + WM_GU) + (size_t)e * 512 * DM;
        transpose_item(src, DEXP, DM, dst, 256 * ct + 128 * bj + 32 * nb, 64 * kb, 128 * ct + 32 * nb + (lane & 31), scr, lane); return; }
    r -= 256;
    { const int kb = r / 32, nb = r % 32;
        const GAS float* src = ((const GAS float*)F.in[25]) + (size_t)(l * NEXP + e) * DEXP * DM;
        GAS bf16* dst = (GAS bf16*)(F.ws + WS_WMOE + WM_DN) + (size_t)e * DM * DEXP;
        transpose_item(src, DM, DEXP, dst, 32 * nb, 64 * kb, 32 * nb + (lane & 31), scr, lane); }
}

__device__ __forceinline__ void ln_row_regs(f32x4 (&v)[4], const GAS float* g, const GAS float* b, int lane) {
    float s = 0.f;
#pragma unroll
    for (int j = 0; j < 4; ++j) s += (v[j].x + v[j].y) + (v[j].z + v[j].w);
    const float mean = wave_sum(s, lane) * (1.f / DM); float s2 = 0.f;
#pragma unroll
    for (int j = 0; j < 4; ++j) { v[j] = v[j] - mean; s2 += (v[j].x * v[j].x + v[j].y * v[j].y) + (v[j].z * v[j].z + v[j].w * v[j].w); }
    const float rstd = 1.f / sqrtf(wave_sum(s2, lane) * (1.f / DM) + LN_EPS);
#pragma unroll
    for (int j = 0; j < 4; ++j) { const f32x4 gg = *(const GAS f32x4*)(g + 4 * lane + 256 * j), bb = *(const GAS f32x4*)(b + 4 * lane + 256 * j); v[j] = v[j] * rstd * gg + bb; }
}
__device__ __forceinline__ void store_row_f32_bf16(const f32x4 (&v)[4], GAS float* hrow, GAS bf16* brow, int lane) {
#pragma unroll
    for (int j = 0; j < 4; ++j) {
        if (hrow) *(GAS f32x4*)(hrow + 4 * lane + 256 * j) = v[j];
        if (brow) { u32x2 w; w.x = pk2(v[j].x, v[j].y); w.y = pk2(v[j].z, v[j].w); *(GAS u32x2*)(brow + 4 * lane + 256 * j) = w; }
    }
}

__device__ __forceinline__ void phase_prologue(Frame& F) {
    LAS float* scr = (LAS float*)(F.lds + F.wave * 16384);
    const int gw = F.wg * 8 + F.wave, NGW = F.G * 8;
    for (int it = gw; it < 2 * 4608; it += NGW) conv_dense_item(F, it / 4608, it % 4608, scr);
    { GAS float* WR = (GAS float*)(F.ws + WS_WR);
      for (int i = gw * 64 + F.lane; i < DEPTH * 36 * DM; i += NGW * 64) { const int l = i / (36 * DM), r = i % (36 * DM), o = r / DM, k = r % DM;
          WR[i] = (o < 4) ? ((const GAS float*)F.in[19])[(size_t)l * DM * 4 + k * 4 + o] : ((const GAS float*)F.in[21])[(size_t)l * DM * 32 + k * 32 + (o - 4)]; } }
    { GAS float* RT = (GAS float*)(F.ws + WS_ROPE);
      for (int i = gw * 64 + F.lane; i < NTOK * 8; i += NGW * 64) { const int n = i >> 3, j = i & 7;
          const float invf[8] = {1.000000000e+00f, 1.939227432e-01f, 3.760603070e-02f, 7.292664610e-03f, 1.414213562e-03f, 2.742481884e-04f, 5.318295734e-05f, 1.031338525e-05f};
          float inv = invf[0];
#pragma unroll
          for (int q = 1; q < 8; ++q) inv = (j == q) ? invf[q] : inv;
          const float ang = (float)F.pos[n] * inv;
          const double kq = __builtin_rint((double)ang * 0.15915494309189535);
          double r = (double)ang - kq * 6.283185307179586; double csign = 1.0;
          if (r > 1.5707963267948966) { r = 3.141592653589793 - r; csign = -1.0; } else if (r < -1.5707963267948966) { r = -3.141592653589793 - r; csign = -1.0; }
          const double x2 = r * r;
          const double sn = r * (1.0 + x2 * (-1.0 / 6 + x2 * (1.0 / 120 + x2 * (-1.0 / 5040 + x2 * (1.0 / 362880 + x2 * (-1.0 / 39916800 + x2 * (1.0 / 6227020800.0 + x2 * (-1.0 / 1307674368000.0))))))));
          const double cs = 1.0 + x2 * (-0.5 + x2 * (1.0 / 24 + x2 * (-1.0 / 720 + x2 * (1.0 / 40320 + x2 * (-1.0 / 3628800 + x2 * (1.0 / 479001600.0 + x2 * (-1.0 / 87178291200.0 + x2 * (1.0 / 20922789888000.0))))))));
          RT[n * 16 + j] = (float)(csign * cs); RT[n * 16 + 8 + j] = (float)sn; } }
    GAS bf16* HB = (GAS bf16*)(F.ws + WS_HB);
    for (int m = gw; m < NTOK; m += NGW) { f32x4 v[4];
#pragma unroll
        for (int j = 0; j < 4; ++j) v[j] = *(const GAS f32x4*)(((const GAS float*)F.in[0]) + (size_t)m * DM + 4 * F.lane + 256 * j);
        ln_row_regs(v, ((const GAS float*)F.in[2]), ((const GAS float*)F.in[3]), F.lane);
        store_row_f32_bf16(v, (GAS float*)nullptr, HB + (size_t)m * DM, F.lane); }
}

struct DenseSched {
    int nM, nN, nwg, G, c; const char* A; const char* B; size_t atile, btile; int nsub = 1; size_t asub = 0, bsub = 0;
    __device__ void init(int nM_, int nN_, int G_, int c_, const void* A_, size_t atile_, const void* B_, size_t btile_) { nM = nM_; nN = nN_; nwg = nM * nN; G = G_; c = c_; A = (const char*)A_; B = (const char*)B_; atile = atile_; btile = btile_; }
    __device__ __forceinline__ bool next(int i, pg8::Unit& u) const {
        const int it = i / nsub, sb = i - it * nsub;
        const long L = (long)it * G + c; if (L >= nwg) return false;
        int wgid = (int)L; { const int q = nwg / 8, r = nwg % 8, xcd = wgid % 8, off = wgid / 8; wgid = (xcd < r ? xcd * (q + 1) : r * (q + 1) + (xcd - r) * q) + off; }
        const int nig = 8 * nN, gid = wgid / nig, fm = gid * 8, gsz = (nM - fm) < 8 ? (nM - fm) : 8;
        u.pm = fm + ((wgid % nig) % gsz); u.pn = (wgid % nig) / gsz; u.e = sb; u.slot = i; return true;
    }
    __device__ __forceinline__ const char* a_base(const pg8::Unit& u) const { return A + (size_t)u.pm * atile + (size_t)u.e * asub; }
    __device__ __forceinline__ const char* b_base(const pg8::Unit& u) const { return B + (size_t)u.pn * btile + (size_t)u.e * bsub; }
    __device__ __forceinline__ int row_of(const pg8::Unit&, int) const { return 0; }
};
struct GroupSched {
    int NU, G, c, ncol; const char* A; const char* B; size_t atile, erows_bytes, btile; const LAS int* meta; const LAS int* rows;
    __device__ __forceinline__ bool next(int i, pg8::Unit& u) const {
        const int L = i * G + c; if (L >= NU) return false;
        u.pm = L / ncol; u.pn = L % ncol; u.slot = i; u.e = meta[i]; return true;
    }
    __device__ __forceinline__ const char* a_base(const pg8::Unit& u) const { return A + (size_t)u.pm * atile; }
    __device__ __forceinline__ const char* b_base(const pg8::Unit& u) const { return B + (size_t)u.e * erows_bytes + (size_t)u.pn * btile; }
    __device__ __forceinline__ int row_of(const pg8::Unit& u, int r) const { return rows[u.slot * 256 + r]; }
};

struct EpiA {
    static constexpr bool PERM = true;
    GAS bf16* PA; GAS bf16* KA; GAS bf16* VA; GAS bf16* KI; GAS float* WI; GAS float* GLR; const GAS float* ROPE; const GAS float* ikg;
    __device__ __forceinline__ static void rope8(float (&x)[8], const GAS float* rt, int fq, int lane) {
        const f32x4 c0 = *(const GAS f32x4*)(rt), c1 = *(const GAS f32x4*)(rt + 4), s0 = *(const GAS f32x4*)(rt + 8), s1 = *(const GAS f32x4*)(rt + 12);
#pragma unroll
        for (int i = 0; i < 8; ++i) { const float p = shx(x[i], 16, lane); const float cc = (i < 4) ? c0[i & 3] : c1[i & 3], ss = (i < 4) ? s0[i & 3] : s1[i & 3];
            const float r = x[i] * cc + ((fq == 0) ? -p : p) * ss; x[i] = (fq < 2) ? r : x[i]; }
    }
    __device__ __forceinline__ static u32x4 pack8(const float (&x)[8]) { u32x4 w; w.x = cvt_pk_bf16(x[0], x[1]); w.y = cvt_pk_bf16(x[2], x[3]); w.z = cvt_pk_bf16(x[4], x[5]); w.w = cvt_pk_bf16(x[6], x[7]); return w; }
    __device__ __forceinline__ void operator()(const f32x4 (&acc)[2][2][4][2], const pg8::Unit& u, int wr, int wc, int fr, int fq) const {
        const int pn = u.pn; const int rowb = u.pm * 256 + wr * 64 + fr; const int lane = fq * 16 + fr;
        if (pn == 2) {
#pragma unroll
            for (int ai = 0; ai < 2; ++ai)
#pragma unroll
                for (int m = 0; m < 4; ++m) {
                    const int row = rowb + ai * 128 + m * 16;
                    float x0[8], x1[8];
#pragma unroll
                    for (int i = 0; i < 8; ++i) { x0[i] = acc[ai][0][m][i >> 2][i & 3]; x1[i] = acc[ai][1][m][i >> 2][i & 3]; }
                    if (wc == 2) {
                        float s = 0.f;
#pragma unroll
                        for (int i = 0; i < 8; ++i) s += x0[i] + x1[i];
                        s += shx(s, 16, lane); s += shx(s, 32, lane);
                        const float mean = s * (1.f / 64.f); float q = 0.f;
#pragma unroll
                        for (int i = 0; i < 8; ++i) { x0[i] -= mean; x1[i] -= mean; q += x0[i] * x0[i] + x1[i] * x1[i]; }
                        q += shx(q, 16, lane); q += shx(q, 32, lane);
                        const float rstd = 1.f / sqrtf(q * (1.f / 64.f) + LN_EPS);
#pragma unroll
                        for (int i = 0; i < 8; ++i) { x0[i] = x0[i] * rstd * ikg[8 * fq + i]; x1[i] = x1[i] * rstd * ikg[32 + 8 * fq + i]; }
                    }
                    if (wc == 0 || wc == 2) rope8(x0, ROPE + (size_t)row * 16, fq, lane);
                    if (wc < 3) {
                        GAS bf16* dst = (wc == 0) ? KA : (wc == 1) ? VA : KI;
                        *(GAS u32x4*)(dst + (size_t)row * 64 + 8 * fq) = pack8(x0); *(GAS u32x4*)(dst + (size_t)row * 64 + 32 + 8 * fq) = pack8(x1);
                    } else {
                        if (fq == 0) { *(GAS f32x4*)(WI + (size_t)row * 4) = (f32x4){x0[0], x0[1], x0[2], x0[3]} * 0.0625f; *(GAS f32x4*)(GLR + (size_t)row * 16) = (f32x4){x0[4], x0[5], x0[6], x0[7]}; }
                        else if (fq == 1) { *(GAS f32x4*)(GLR + (size_t)row * 16 + 4) = (f32x4){x0[0], x0[1], x0[2], x0[3]}; *(GAS f32x4*)(GLR + (size_t)row * 16 + 8) = (f32x4){x0[4], x0[5], x0[6], x0[7]}; }
                        else if (fq == 2) { *(GAS f32x4*)(GLR + (size_t)row * 16 + 12) = (f32x4){x0[0], x0[1], x0[2], x0[3]}; }
                    }
                    asm volatile("" ::: "memory");
                }
        } else if (pn < 2 || pn == 3) {
            const float sc = (pn == 3) ? 1.0f : 0.125f; const bool rope = !(wc & 1);
#pragma unroll
            for (int ai = 0; ai < 2; ++ai)
#pragma unroll
                for (int m = 0; m < 4; ++m) {
                    const int row = rowb + ai * 128 + m * 16;
#pragma unroll
                    for (int bj = 0; bj < 2; ++bj) { float x[8];
#pragma unroll
                        for (int i = 0; i < 8; ++i) x[i] = acc[ai][bj][m][i >> 2][i & 3];
                        if (rope) rope8(x, ROPE + (size_t)row * 16, fq, lane);
#pragma unroll
                        for (int i = 0; i < 8; ++i) x[i] *= sc;
                        *(GAS u32x4*)(PA + (size_t)row * NPA + 256 * pn + 128 * bj + 32 * wc + 8 * fq) = pack8(x); }
                    asm volatile("" ::: "memory");
                }
        } else {
            const int act = (pn == 8 || pn == 9) ? 1 : (pn >= 10) ? 2 : 0; const float sc = (pn == 4) ? 0.125f : 1.0f;
#pragma unroll
            for (int ai = 0; ai < 2; ++ai)
#pragma unroll
                for (int m = 0; m < 4; ++m) {
                    const int row = rowb + ai * 128 + m * 16;
#pragma unroll
                    for (int bj = 0; bj < 2; ++bj) { float x[8];
#pragma unroll
                        for (int i = 0; i < 8; ++i) { const float v = acc[ai][bj][m][i >> 2][i & 3]; x[i] = (act == 1) ? siluf_(v) : (act == 2) ? gelu_tanh_(v) : v * sc; }
                        *(GAS u32x4*)(PA + (size_t)row * NPA + 256 * pn + 128 * bj + 32 * wc + 8 * fq) = pack8(x); }
                    asm volatile("" ::: "memory");
                }
        }
    }
};
struct EpiP {
    static constexpr bool PERM = true;
    GAS bf16* P;
    __device__ __forceinline__ void operator()(const f32x4 (&acc)[2][2][4][2], const pg8::Unit& u, int wr, int wc, int fr, int fq) const {
        const int rowb = u.pm * 256 + wr * 64 + fr; GAS bf16* Pb = P + (size_t)u.e * NTOK * DM;
#pragma unroll
        for (int ai = 0; ai < 2; ++ai)
#pragma unroll
            for (int m = 0; m < 4; ++m) { const int row = rowb + ai * 128 + m * 16;
#pragma unroll
                for (int bj = 0; bj < 2; ++bj) { u32x4 w; w.x = cvt_pk_bf16(acc[ai][bj][m][0][0], acc[ai][bj][m][0][1]); w.y = cvt_pk_bf16(acc[ai][bj][m][0][2], acc[ai][bj][m][0][3]);
                    w.z = cvt_pk_bf16(acc[ai][bj][m][1][0], acc[ai][bj][m][1][1]); w.w = cvt_pk_bf16(acc[ai][bj][m][1][2], acc[ai][bj][m][1][3]);
                    *(GAS u32x4*)(Pb + (size_t)row * DM + 256 * u.pn + 128 * bj + 32 * wc + 8 * fq) = w; } }
    }
};
struct EpiGM {
    static constexpr bool PERM = true;
    const GAS bf16* P; GAS bf16* HM;
    __device__ __forceinline__ void operator()(const f32x4 (&acc)[2][2][4][2], const pg8::Unit& u, int wr, int wc, int fr, int fq) const {
        const int rowb = u.pm * 256 + wr * 64 + fr; const int br = u.e; const GAS bf16* Pb = P + (size_t)br * NTOK * DM;
        const int colb = 256 * u.pn + 32 * wc + 8 * fq;
#pragma unroll
        for (int ai = 0; ai < 2; ++ai) {
            u32x4 pv[4][2], ov[4][2];
#pragma unroll
            for (int m = 0; m < 4; ++m)
#pragma unroll
                for (int bj = 0; bj < 2; ++bj) { const size_t off = (size_t)(rowb + ai * 128 + m * 16) * DM + colb + 128 * bj;
                    pv[m][bj] = *(const GAS u32x4*)(Pb + off); ov[m][bj] = (br > 0) ? *(const GAS u32x4*)(HM + off) : (u32x4){0u, 0u, 0u, 0u}; }
            __builtin_amdgcn_sched_barrier(0);
#pragma unroll
            for (int m = 0; m < 4; ++m)
#pragma unroll
                for (int bj = 0; bj < 2; ++bj) { const size_t off = (size_t)(rowb + ai * 128 + m * 16) * DM + colb + 128 * bj;
                    const u32x4 p = pv[m][bj], o = ov[m][bj];
                    float x[8];
                    x[0] = bflo(p.x) * sigmoidf_(acc[ai][bj][m][0][0]) + bflo(o.x); x[1] = bfhi(p.x) * sigmoidf_(acc[ai][bj][m][0][1]) + bfhi(o.x); x[2] = bflo(p.y) * sigmoidf_(acc[ai][bj][m][0][2]) + bflo(o.y); x[3] = bfhi(p.y) * sigmoidf_(acc[ai][bj][m][0][3]) + bfhi(o.y);
                    x[4] = bflo(p.z) * sigmoidf_(acc[ai][bj][m][1][0]) + bflo(o.z); x[5] = bfhi(p.z) * sigmoidf_(acc[ai][bj][m][1][1]) + bfhi(o.z); x[6] = bflo(p.w) * sigmoidf_(acc[ai][bj][m][1][2]) + bflo(o.w); x[7] = bfhi(p.w) * sigmoidf_(acc[ai][bj][m][1][3]) + bfhi(o.w);
                    u32x4 w; w.x = cvt_pk_bf16(x[0], x[1]); w.y = cvt_pk_bf16(x[2], x[3]); w.z = cvt_pk_bf16(x[4], x[5]); w.w = cvt_pk_bf16(x[6], x[7]);
                    *(GAS u32x4*)(HM + off) = w; }
            asm volatile("" ::: "memory");
        }
    }
};
struct EpiO {
    static constexpr bool PERM = true;
    const GAS bf16* HBr; GAS bf16* T;
    __device__ __forceinline__ void operator()(const f32x4 (&acc)[2][2][4][2], const pg8::Unit& u, int wr, int wc, int fr, int fq) const {
        const int rowb = u.pm * 256 + wr * 64 + fr; const int colb = 256 * u.pn + 32 * wc + 8 * fq;
#pragma unroll
        for (int ai = 0; ai < 2; ++ai) {
            u32x4 hv[4][2];
#pragma unroll
            for (int m = 0; m < 4; ++m)
#pragma unroll
                for (int bj = 0; bj < 2; ++bj) hv[m][bj] = *(const GAS u32x4*)(HBr + (size_t)(rowb + ai * 128 + m * 16) * DM + colb + 128 * bj);
            __builtin_amdgcn_sched_barrier(0);
#pragma unroll
            for (int m = 0; m < 4; ++m)
#pragma unroll
                for (int bj = 0; bj < 2; ++bj) { const u32x4 h = hv[m][bj];
                    u32x4 w; w.x = cvt_pk_bf16(bflo(h.x) * DN_ALPHA + acc[ai][bj][m][0][0], bfhi(h.x) * DN_ALPHA + acc[ai][bj][m][0][1]); w.y = cvt_pk_bf16(bflo(h.y) * DN_ALPHA + acc[ai][bj][m][0][2], bfhi(h.y) * DN_ALPHA + acc[ai][bj][m][0][3]);
                    w.z = cvt_pk_bf16(bflo(h.z) * DN_ALPHA + acc[ai][bj][m][1][0], bfhi(h.z) * DN_ALPHA + acc[ai][bj][m][1][1]); w.w = cvt_pk_bf16(bflo(h.w) * DN_ALPHA + acc[ai][bj][m][1][2], bfhi(h.w) * DN_ALPHA + acc[ai][bj][m][1][3]);
                    *(GAS u32x4*)(T + (size_t)(rowb + ai * 128 + m * 16) * DM + colb + 128 * bj) = w; }
            asm volatile("" ::: "memory");
        }
    }
};
struct EpiGU {
    static constexpr bool PERM = true;
    GAS bf16* HID; const GAS float* CW;
    __device__ __forceinline__ void operator()(const f32x4 (&acc)[2][2][4][2], const pg8::Unit& u, int wr, int wc, int fr, int fq) const {
        const int rowb = u.pm * 256 + wr * 64 + fr;
        float cwv[2][4];
#pragma unroll
        for (int ai = 0; ai < 2; ++ai)
#pragma unroll
            for (int m = 0; m < 4; ++m) cwv[ai][m] = CW[rowb + ai * 128 + m * 16];
#pragma unroll
        for (int ai = 0; ai < 2; ++ai)
#pragma unroll
            for (int m = 0; m < 4; ++m) { const int row = rowb + ai * 128 + m * 16; const float cw = cwv[ai][m];
                float x[8];
#pragma unroll
                for (int i = 0; i < 8; ++i) x[i] = siluf_(acc[ai][0][m][i >> 2][i & 3]) * acc[ai][1][m][i >> 2][i & 3] * cw;
                u32x4 w; w.x = cvt_pk_bf16(x[0], x[1]); w.y = cvt_pk_bf16(x[2], x[3]); w.z = cvt_pk_bf16(x[4], x[5]); w.w = cvt_pk_bf16(x[6], x[7]);
                *(GAS u32x4*)(HID + (size_t)row * DEXP + 128 * u.pn + 32 * wc + 8 * fq) = w; }
    }
};
struct EpiDN {
    static constexpr bool PERM = true;
    GAS bf16* FF2;
    __device__ __forceinline__ void operator()(const f32x4 (&acc)[2][2][4][2], const pg8::Unit& u, int wr, int wc, int fr, int fq) const {
        const int rowb = u.pm * 256 + wr * 64 + fr;
#pragma unroll
        for (int ai = 0; ai < 2; ++ai)
#pragma unroll
            for (int m = 0; m < 4; ++m) { const int row = rowb + ai * 128 + m * 16;
#pragma unroll
                for (int bj = 0; bj < 2; ++bj) { u32x4 w; w.x = cvt_pk_bf16(acc[ai][bj][m][0][0], acc[ai][bj][m][0][1]); w.y = cvt_pk_bf16(acc[ai][bj][m][0][2], acc[ai][bj][m][0][3]);
                    w.z = cvt_pk_bf16(acc[ai][bj][m][1][0], acc[ai][bj][m][1][1]); w.w = cvt_pk_bf16(acc[ai][bj][m][1][2], acc[ai][bj][m][1][3]);
                    *(GAS u32x4*)(FF2 + (size_t)row * DM + 256 * u.pn + 128 * bj + 32 * wc + 8 * fq) = w; } }
    }
};
#ifndef EN_B1
#define EN_B1 1
#endif
#ifndef EN_B2
#define EN_B2 1
#endif
#ifndef EN_B3
#define EN_B3 1
#endif

template <int CTRL> __device__ __forceinline__ float dppf(float x) { return __builtin_bit_cast(float, __builtin_amdgcn_mov_dpp(__builtin_bit_cast(int, x), CTRL, 0xf, 0xf, true)); }
template <int CTRL> __device__ __forceinline__ int dppi(int x) { return __builtin_amdgcn_mov_dpp(x, CTRL, 0xf, 0xf, true); }
typedef short v4i16_t __attribute__((ext_vector_type(4)));
typedef unsigned short u16x2 __attribute__((ext_vector_type(2)));
__device__ __forceinline__ v4i16_t ldtr(const LAS unsigned char* p) { return __builtin_amdgcn_ds_read_tr16_b64_v4i16((LAS v4i16_t*)p); }
__device__ __forceinline__ bf16x8 cat8(v4i16_t lo, v4i16_t hi) { bf16x8 r; r[0] = lo[0]; r[1] = lo[1]; r[2] = lo[2]; r[3] = lo[3]; r[4] = hi[0]; r[5] = hi[1]; r[6] = hi[2]; r[7] = hi[3]; return r; }
__device__ __forceinline__ int wave_total_i(int v) {
    v += dppi<0xB1>(v); v += dppi<0x4E>(v); v += dppi<0x141>(v); v += dppi<0x140>(v);
    return __builtin_amdgcn_readlane(v, 0) + __builtin_amdgcn_readlane(v, 16) + __builtin_amdgcn_readlane(v, 32) + __builtin_amdgcn_readlane(v, 48);
}
__device__ __forceinline__ void gmlp_unit(Frame& F, int l, int unit) {
    int tid = F.tid; asm volatile("" : "+v"(tid)); const int lane = tid & 63;
    const int chunk = unit >> 2, g = unit & 3, n0 = chunk * 128;
    const GAS bf16* PA = (const GAS bf16*)(F.ws + WS_PA); GAS bf16* Y = (GAS bf16*)(F.ws + WS_Y);
    LAS float* vln = (LAS float*)F.lds;
    LAS float* wl = (LAS float*)(F.lds + 65536);
    LAS float* st = (LAS float*)(F.lds + AUX_OFF);
    const GAS float* lng = ((const GAS float*)F.in[9]) + l * 512; const GAS float* lnb = ((const GAS float*)F.in[10]) + l * 512;
    for (int j = 0; j < 16; ++j) { const int s = F.wave * 16 + j;
        const u32x4 w = *(const GAS u32x4*)(PA + (size_t)(n0 + s) * NPA + PA_CV + 8 * lane);
        float x[8] = {bflo(w.x), bfhi(w.x), bflo(w.y), bfhi(w.y), bflo(w.z), bfhi(w.z), bflo(w.w), bfhi(w.w)};
        float sm = 0.f;
#pragma unroll
        for (int i = 0; i < 8; ++i) sm += x[i];
        const float mean = wave_sum(sm, lane) * (1.f / 512.f); float q = 0.f;
#pragma unroll
        for (int i = 0; i < 8; ++i) { const float d = x[i] - mean; q += d * d; }
        const float rstd = 1.f / sqrtf(wave_sum(q, lane) * (1.f / 512.f) + LN_EPS);
        if (lane == 0) { st[2 * s] = mean; st[2 * s + 1] = rstd; } }
    __syncthreads();
#pragma unroll
    for (int i = 0; i < 4; ++i) { const int q = tid + 512 * i, s = q >> 4, d0 = (q & 15) * 8;
        const u32x4 w = *(const GAS u32x4*)(PA + (size_t)(n0 + s) * NPA + PA_CV + g * 128 + d0);
        const float mean = st[2 * s], rstd = st[2 * s + 1];
        float x[8] = {bflo(w.x), bfhi(w.x), bflo(w.y), bfhi(w.y), bflo(w.z), bfhi(w.z), bflo(w.w), bfhi(w.w)};
#pragma unroll
        for (int k = 0; k < 8; ++k) x[k] = (x[k] - mean) * rstd * lng[g * 128 + d0 + k] + lnb[g * 128 + d0 + k];
        *(LAS f32x4*)(vln + s * 128 + d0) = (f32x4){x[0], x[1], x[2], x[3]}; *(LAS f32x4*)(vln + s * 128 + d0 + 4) = (f32x4){x[4], x[5], x[6], x[7]}; }
    const GAS float* ws = ((const GAS float*)F.in[11]) + ((size_t)l * 4 + g) * 128 * 128;
#pragma unroll
    for (int i = 0; i < 8; ++i) { const int q = tid + 512 * i, t = q >> 5, s0 = (q & 31) * 4;
        f32x4 w = *(const GAS f32x4*)(ws + t * 128 + s0);
        if (s0 + 0 > t) w.x = 0.f; if (s0 + 1 > t) w.y = 0.f; if (s0 + 2 > t) w.z = 0.f; if (s0 + 3 > t) w.w = 0.f;
        *(LAS f32x4*)(wl + t * 128 + s0) = w; }
    __syncthreads();
    const int d = tid & 127, tq = __builtin_amdgcn_readfirstlane(tid >> 7);
    float vr[128];
#pragma unroll
    for (int sb = 0; sb < 4; ++sb)
        if (sb <= tq) {
#pragma unroll
            for (int s = 0; s < 32; ++s) vr[sb * 32 + s] = vln[(sb * 32 + s) * 128 + d];
        } else {
#pragma unroll
            for (int s = 0; s < 32; ++s) vr[sb * 32 + s] = 0.f;
        }
    const GAS float* bs = ((const GAS float*)F.in[12]) + ((size_t)l * 4 + g) * 128;
#pragma unroll 1
    for (int ti = 0; ti < 32; ++ti) { const int t = tq * 32 + ti; float a = 0.f;
#pragma unroll
        for (int sb = 0; sb < 4; ++sb)
            if (sb <= tq) {
#pragma unroll
                for (int s4 = 0; s4 < 8; ++s4) { const f32x4 w = *(const LAS f32x4*)(wl + t * 128 + sb * 32 + s4 * 4);
                    a += w.x * vr[sb * 32 + s4 * 4] + w.y * vr[sb * 32 + s4 * 4 + 1] + w.z * vr[sb * 32 + s4 * 4 + 2] + w.w * vr[sb * 32 + s4 * 4 + 3]; }
            }
        const float uu = bf1(PA[(size_t)(n0 + t) * NPA + PA_CU + g * 128 + d]);
        Y[(size_t)(n0 + t) * 1536 + 1024 + g * 128 + d] = (bf16)f2bf(uu * (a + bs[t])); }
    __syncthreads();
}

__device__ __forceinline__ void gmlp16_unit(Frame& F, int l, int chunk) {
    int tid = F.tid; asm volatile("" : "+v"(tid)); const int lane = tid & 63, w = F.wave, fr = lane & 15, fq = lane >> 4;
    const size_t n0 = (size_t)chunk * 128;
    const GAS bf16* PA = (const GAS bf16*)(F.ws + WS_PA); GAS bf16* Y = (GAS bf16*)(F.ws + WS_Y);
    LAS unsigned char* VT = F.lds;
    LAS unsigned char* WT = F.lds + 32768;
    LAS float* st = (LAS float*)(F.lds + AUX_OFF);
    const GAS float* lng = ((const GAS float*)F.in[9]) + l * 512; const GAS float* lnb = ((const GAS float*)F.in[10]) + l * 512;
    for (int j = 0; j < 16; ++j) { const int s = w * 16 + j;
        const u32x4 x4 = *(const GAS u32x4*)(PA + (n0 + s) * NPA + PA_CV + 8 * lane);
        float x[8] = {bflo(x4.x), bfhi(x4.x), bflo(x4.y), bfhi(x4.y), bflo(x4.z), bfhi(x4.z), bflo(x4.w), bfhi(x4.w)};
        float sm = 0.f;
#pragma unroll
        for (int i = 0; i < 8; ++i) sm += x[i];
        const float mean = wave_sum(sm, lane) * (1.f / 512.f); float q = 0.f;
#pragma unroll
        for (int i = 0; i < 8; ++i) { const float d = x[i] - mean; q += d * d; }
        const float rstd = 1.f / sqrtf(wave_sum(q, lane) * (1.f / 512.f) + LN_EPS);
        if (lane == 0) { st[2 * s] = mean; st[2 * s + 1] = rstd; } }
    __syncthreads();
#pragma unroll 1
    for (int g = 0; g < 4; ++g) {
        const GAS float* ws = ((const GAS float*)F.in[11]) + ((size_t)l * 4 + g) * 128 * 128;
#pragma unroll
        for (int i = 0; i < 4; ++i) { const int q = tid + 512 * i, s = q >> 4, d0 = (q & 15) * 8;
            const u32x4 x4 = *(const GAS u32x4*)(PA + (n0 + s) * NPA + PA_CV + g * 128 + d0);
            const float mean = st[2 * s], rstd = st[2 * s + 1];
            float x[8] = {bflo(x4.x), bfhi(x4.x), bflo(x4.y), bfhi(x4.y), bflo(x4.z), bfhi(x4.z), bflo(x4.w), bfhi(x4.w)};
            const f32x4 g0 = *(const GAS f32x4*)(lng + g * 128 + d0), g1 = *(const GAS f32x4*)(lng + g * 128 + d0 + 4), b0 = *(const GAS f32x4*)(lnb + g * 128 + d0), b1 = *(const GAS f32x4*)(lnb + g * 128 + d0 + 4);
#pragma unroll
            for (int k = 0; k < 8; ++k) x[k] = (x[k] - mean) * rstd * ((k < 4) ? g0[k & 3] : g1[k & 3]) + ((k < 4) ? b0[k & 3] : b1[k & 3]);
            u32x4 o; o.x = cvt_pk_bf16(x[0], x[1]); o.y = cvt_pk_bf16(x[2], x[3]); o.z = cvt_pk_bf16(x[4], x[5]); o.w = cvt_pk_bf16(x[6], x[7]);
            *(LAS u32x4*)(VT + s * 256 + d0 * 2) = o;
            const int t = s, s0 = d0;
            f32x4 w0 = *(const GAS f32x4*)(ws + t * 128 + s0), w1 = *(const GAS f32x4*)(ws + t * 128 + s0 + 4);
            float wv[8] = {w0.x, w0.y, w0.z, w0.w, w1.x, w1.y, w1.z, w1.w};
#pragma unroll
            for (int k = 0; k < 8; ++k) wv[k] = (s0 + k <= t) ? wv[k] : 0.f;
            u32x4 ow; ow.x = cvt_pk_bf16(wv[0], wv[1]); ow.y = cvt_pk_bf16(wv[2], wv[3]); ow.z = cvt_pk_bf16(wv[4], wv[5]); ow.w = cvt_pk_bf16(wv[6], wv[7]);
            *(LAS u32x4*)(WT + t * 256 + s0 * 2) = ow; }
        __syncthreads();
        f32x4 acc[8];
#pragma unroll
        for (int nt = 0; nt < 8; ++nt) acc[nt] = (f32x4){0.f, 0.f, 0.f, 0.f};
        const int nks = (16 * w + 15) / 32 + 1;
#pragma unroll
        for (int ks = 0; ks < 4; ++ks) if (ks < nks) {
            const bf16x8 a = *(const LAS bf16x8*)(WT + (16 * w + fr) * 256 + (8 * fq + 32 * ks) * 2);
            const int srow = 32 * ks + 8 * fq + (fr >> 2);
#pragma unroll
            for (int nt = 0; nt < 8; ++nt) { const bf16x8 bv = cat8(ldtr(VT + srow * 256 + (16 * nt + 4 * (fr & 3)) * 2), ldtr(VT + (srow + 4) * 256 + (16 * nt + 4 * (fr & 3)) * 2));
                acc[nt] = __builtin_amdgcn_mfma_f32_16x16x32_bf16(a, bv, acc[nt], 0, 0, 0); } }
        const GAS float* bs = ((const GAS float*)F.in[12]) + ((size_t)l * 4 + g) * 128;
#pragma unroll
        for (int r = 0; r < 4; ++r) { const int t = 16 * w + 4 * fq + r; const float bt = bs[t];
#pragma unroll
            for (int nt = 0; nt < 8; ++nt) { const int d = 16 * nt + fr;
                const float uu = bf1(PA[(n0 + t) * NPA + PA_CU + g * 128 + d]);
                Y[(n0 + t) * 1536 + 1024 + g * 128 + d] = (bf16)f2bf(uu * (acc[nt][r] + bt)); } }
        __syncthreads();
    }
}

__device__ __forceinline__ void gla_unit(Frame& F, int l, int unit) {
    int tid = F.tid; asm volatile("" : "+v"(tid));
    const int b = unit >> 2, h = unit & 3;
    const GAS bf16* PA = (const GAS bf16*)(F.ws + WS_PA); GAS bf16* Y = (GAS bf16*)(F.ws + WS_Y); const GAS float* GLR = (const GAS float*)(F.ws + WS_GLR);
    LAS float* wa = (LAS float*)F.lds;
    LAS float* ba = wa + 1024;
    LAS float* as_ = ba + 64;
    LAS float* qs = as_ + 1024;
    LAS float* ks = qs + 1024;
    LAS float* vs = ks + 1024;
    LAS float* part = vs + 2048;
    for (int i = tid; i < 1024; i += 512) wa[i] = ((const GAS float*)F.in[6])[(size_t)l * 16 * 256 + (i >> 6) * 256 + h * 64 + (i & 63)];
    if (tid < 64) ba[tid] = ((const GAS float*)F.in[7])[l * 256 + h * 64 + tid];
    const GAS float* gng = ((const GAS float*)F.in[8]) + l * 128;
    const int v = tid & 127, kq = __builtin_amdgcn_readfirstlane(tid >> 7);
    float S[16];
#pragma unroll
    for (int j = 0; j < 16; ++j) S[j] = 0.f;
    __syncthreads();
    for (int t0 = 0; t0 < SEQ; t0 += 16) {
        const size_t nb = (size_t)b * SEQ + t0;
#pragma unroll
        for (int i = 0; i < 2; ++i) { const int e = tid + 512 * i, t = e >> 6, k = e & 63; float z = ba[k];
#pragma unroll
            for (int r = 0; r < 16; ++r) z += GLR[(nb + t) * 16 + r] * wa[r * 64 + k];
            const float ls = fminf(z, 0.f) - log1pf(__expf(-fabsf(z)));
            as_[e] = __expf(ls * (1.f / 16.f));
            qs[e] = bf1(PA[(nb + t) * NPA + PA_BQ + h * 64 + k]); ks[e] = bf1(PA[(nb + t) * NPA + PA_BK + h * 64 + k]); }
#pragma unroll
        for (int i = 0; i < 4; ++i) { const int e = tid + 512 * i, t = e >> 7, vv = e & 127; vs[e] = bf1(PA[(nb + t) * NPA + PA_BV + h * 128 + vv]); }
        __syncthreads();
#pragma unroll 4
        for (int t = 0; t < 16; ++t) { const float vt = vs[t * 128 + v]; float p = 0.f;
#pragma unroll
            for (int j4 = 0; j4 < 4; ++j4) { const f32x4 a4 = *(const LAS f32x4*)(as_ + t * 64 + kq * 16 + j4 * 4), k4 = *(const LAS f32x4*)(ks + t * 64 + kq * 16 + j4 * 4), q4 = *(const LAS f32x4*)(qs + t * 64 + kq * 16 + j4 * 4);
#pragma unroll
                for (int j = 0; j < 4; ++j) { S[j4 * 4 + j] = a4[j] * S[j4 * 4 + j] + k4[j] * vt; p += q4[j] * S[j4 * 4 + j]; } }
            part[(kq * 16 + t) * 128 + v] = p; }
        __syncthreads();
        { const int t = tid >> 5, v4 = (tid & 31) * 4;
          f32x4 o = *(const LAS f32x4*)(part + (0 * 16 + t) * 128 + v4);
#pragma unroll
          for (int q = 1; q < 4; ++q) o += *(const LAS f32x4*)(part + (q * 16 + t) * 128 + v4);
          float ss = o.x * o.x + o.y * o.y + o.z * o.z + o.w * o.w;
#pragma unroll
          for (int sh = 1; sh < 32; sh <<= 1) ss += shx(ss, sh, tid & 63);
          const float r = 1.f / sqrtf(ss * (1.f / 128.f) + RMS_EPS);
          const f32x4 gg = *(const GAS f32x4*)(gng + v4);
          const u32x2 brw = *(const GAS u32x2*)(PA + (nb + t) * NPA + PA_BR + h * 128 + v4);
          u32x2 w; w.x = pk2(o.x * r * gg.x * bflo(brw.x), o.y * r * gg.y * bfhi(brw.x)); w.y = pk2(o.z * r * gg.z * bflo(brw.y), o.w * r * gg.w * bfhi(brw.y));
          *(GAS u32x2*)(Y + (nb + t) * 1536 + 512 + h * 128 + v4) = w; }
        __syncthreads();
    }
}

constexpr size_t WS_US = WS_WMOE, WS_DEC = WS_WMOE + 32 * MiB;
__device__ __forceinline__ void gla_local_unit(Frame& F, int l, int unit) {
    int tid = F.tid; asm volatile("" : "+v"(tid)); const int lane = tid & 63, w = F.wave, fr = lane & 15, fq = lane >> 4;
    const int b = unit >> 8, h = (unit >> 6) & 3, c = unit & 63; const size_t n0 = (size_t)b * SEQ + 64 * c;
    GAS bf16* PA = (GAS bf16*)(F.ws + WS_PA); GAS bf16* Y = (GAS bf16*)(F.ws + WS_Y); const GAS float* GLR = (const GAS float*)(F.ws + WS_GLR);
    GAS bf16* US = (GAS bf16*)(F.ws + WS_US) + (size_t)unit * 8192; GAS float* DEC = (GAS float*)(F.ws + WS_DEC) + unit * 64;
    LAS unsigned char* QT = F.lds; LAS unsigned char* KT = F.lds + 8192; LAS unsigned char* KD = F.lds + 16384; LAS unsigned char* VV = F.lds + 24576; LAS unsigned char* ATT = F.lds + 40960;
    LAS float* SEG = (LAS float*)(F.lds + 65536); LAS float* WA = (LAS float*)(F.lds + 67584); LAS float* BA = (LAS float*)(F.lds + 71680);
#pragma unroll
    for (int i = 0; i < 2; ++i) { const int e = tid + 512 * i; WA[e] = ((const GAS float*)F.in[6])[(size_t)l * 16 * 256 + (e >> 6) * 256 + h * 64 + (e & 63)]; }
    if (tid < 64) BA[tid] = ((const GAS float*)F.in[7])[l * 256 + h * 64 + tid];
#pragma unroll
    for (int i = 0; i < 2; ++i) { const int piece = tid + 512 * i, row = piece >> 4, c16 = piece & 15;
        *(LAS u32x4*)(VV + row * 256 + c16 * 16) = *(const GAS u32x4*)(PA + (n0 + row) * NPA + PA_BV + h * 128 + 8 * c16); }
    __syncthreads();
    const int k = tid & 63, seg = w;
    float cum[8];
    { float run = 0.f;
#pragma unroll
      for (int i = 0; i < 8; ++i) { const int t = 8 * seg + i; float z = BA[k];
          const f32x4 g0 = *(const GAS f32x4*)(GLR + (n0 + t) * 16), g1 = *(const GAS f32x4*)(GLR + (n0 + t) * 16 + 4), g2 = *(const GAS f32x4*)(GLR + (n0 + t) * 16 + 8), g3 = *(const GAS f32x4*)(GLR + (n0 + t) * 16 + 12);
#pragma unroll
          for (int r = 0; r < 4; ++r) { z += g0[r] * WA[r * 64 + k]; z += g1[r] * WA[(4 + r) * 64 + k]; z += g2[r] * WA[(8 + r) * 64 + k]; z += g3[r] * WA[(12 + r) * 64 + k]; }
          const float ls = fminf(z, 0.f) - log1pf(__expf(-fabsf(z)));
          run += ls * (1.f / 16.f); cum[i] = run; }
      SEG[seg * 64 + k] = run; }
    __syncthreads();
    { float off = 0.f, blast = 0.f;
#pragma unroll
      for (int s2 = 0; s2 < 8; ++s2) { const float sv = SEG[s2 * 64 + k]; blast += sv; off += (s2 < seg) ? sv : 0.f; }
#pragma unroll
      for (int i = 0; i < 8; ++i) { const int t = 8 * seg + i; const float bb = cum[i] + off;
          const float qv = bf1(PA[(n0 + t) * NPA + PA_BQ + h * 64 + k]), kv = bf1(PA[(n0 + t) * NPA + PA_BK + h * 64 + k]);
          const unsigned qt = f2bf(qv * __expf(bb));
          ((LAS unsigned short*)QT)[t * 64 + k] = (unsigned short)qt; ((LAS unsigned short*)KT)[t * 64 + k] = (unsigned short)f2bf(kv * __expf(-bb)); ((LAS unsigned short*)KD)[t * 64 + k] = (unsigned short)f2bf(kv * __expf(blast - bb));
          PA[(n0 + t) * NPA + PA_BQ + h * 64 + k] = (bf16)qt; }
      if (seg == 0) DEC[k] = __expf(blast); }
    __syncthreads();
#pragma unroll
    for (int ii = 0; ii < 2; ++ii) { const int id = 2 * w + ii, ts = id >> 2, tt = id & 3;
        f32x4 d = {0.f, 0.f, 0.f, 0.f};
        if (ts <= tt) {
#pragma unroll
            for (int ks = 0; ks < 2; ++ks) { const bf16x8 a = *(const LAS bf16x8*)(KT + (16 * ts + fr) * 128 + (8 * fq + 32 * ks) * 2), bq = *(const LAS bf16x8*)(QT + (16 * tt + fr) * 128 + (8 * fq + 32 * ks) * 2);
                d = __builtin_amdgcn_mfma_f32_16x16x32_bf16(a, bq, d, 0, 0, 0); } }
        const int t = 16 * tt + fr, s0 = 16 * ts + 4 * fq;
        u32x2 pk; pk.x = cvt_pk_bf16((s0 <= t) ? d[0] : 0.f, (s0 + 1 <= t) ? d[1] : 0.f); pk.y = cvt_pk_bf16((s0 + 2 <= t) ? d[2] : 0.f, (s0 + 3 <= t) ? d[3] : 0.f);
        *(LAS u32x2*)(ATT + t * 128 + s0 * 2) = pk; }
    __syncthreads();
    { const int tr = w & 3, nh = w >> 2;
      f32x4 ao[4], au[4];
#pragma unroll
      for (int j = 0; j < 4; ++j) { ao[j] = (f32x4){0.f, 0.f, 0.f, 0.f}; au[j] = (f32x4){0.f, 0.f, 0.f, 0.f}; }
#pragma unroll
      for (int ks = 0; ks < 2; ++ks) {
          const bf16x8 aA = *(const LAS bf16x8*)(ATT + (16 * tr + fr) * 128 + (8 * fq + 32 * ks) * 2);
          const int srow = 32 * ks + 8 * fq + (fr >> 2);
          const bf16x8 aK = cat8(ldtr(KD + srow * 128 + (16 * tr + 4 * (fr & 3)) * 2), ldtr(KD + (srow + 4) * 128 + (16 * tr + 4 * (fr & 3)) * 2));
#pragma unroll
          for (int j = 0; j < 4; ++j) { const int nt = 4 * nh + j;
              const bf16x8 bv = cat8(ldtr(VV + srow * 256 + (16 * nt + 4 * (fr & 3)) * 2), ldtr(VV + (srow + 4) * 256 + (16 * nt + 4 * (fr & 3)) * 2));
              ao[j] = __builtin_amdgcn_mfma_f32_16x16x32_bf16(aA, bv, ao[j], 0, 0, 0);
              au[j] = __builtin_amdgcn_mfma_f32_16x16x32_bf16(aK, bv, au[j], 0, 0, 0); } }
#pragma unroll
      for (int j = 0; j < 4; ++j) { const int v = 16 * (4 * nh + j) + fr;
#pragma unroll
          for (int r = 0; r < 4; ++r) { const int row = 16 * tr + 4 * fq + r;
              Y[(n0 + row) * 1536 + 512 + h * 128 + v] = (bf16)f2bf(ao[j][r]);
              US[row * 128 + v] = (bf16)f2bf(au[j][r]); } } }
    __syncthreads();
}
__device__ __forceinline__ void gla_scan_phase(Frame& F) {
    GAS bf16* USb = (GAS bf16*)(F.ws + WS_US); const GAS float* DECb = (const GAS float*)(F.ws + WS_DEC);
    for (int gt = F.wg * 512 + F.tid; gt < 131072; gt += F.G * 512) { const int e0 = 2 * gt, bh = e0 >> 13, kv = e0 & 8191, k = kv >> 7;
        GAS unsigned* p = (GAS unsigned*)(USb + (size_t)bh * 64 * 8192 + kv); const GAS float* dp = DECb + bh * 64 * 64 + k;
        float s0 = 0.f, s1 = 0.f;
#pragma unroll 8
        for (int c = 0; c < 64; ++c) { const unsigned u = p[(size_t)c * 4096]; const float d = dp[c * 64];
            p[(size_t)c * 4096] = pk2(s0, s1);
            s0 = d * s0 + bflo(u); s1 = d * s1 + bfhi(u); } }
}
__device__ __forceinline__ void gla_out_unit(Frame& F, int l, int unit) {
    int tid = F.tid; asm volatile("" : "+v"(tid)); const int lane = tid & 63, w = F.wave, fr = lane & 15, fq = lane >> 4;
    const int b = unit >> 8, h = (unit >> 6) & 3, c = unit & 63; const size_t n0 = (size_t)b * SEQ + 64 * c;
    const GAS bf16* PA = (const GAS bf16*)(F.ws + WS_PA); GAS bf16* Y = (GAS bf16*)(F.ws + WS_Y);
    const GAS bf16* US = (const GAS bf16*)(F.ws + WS_US) + (size_t)unit * 8192;
    LAS unsigned char* SS = F.lds;
    LAS float* PS = (LAS float*)(F.lds + 16384);
    const GAS float* gng = ((const GAS float*)F.in[8]) + l * 128;
#pragma unroll
    for (int i = 0; i < 2; ++i) { const int piece = tid + 512 * i; *(LAS u32x4*)(SS + piece * 16) = *(const GAS u32x4*)(US + piece * 8); }
    __syncthreads();
    const int tr = w >> 1, nh = w & 1;
    f32x4 acc[4];
#pragma unroll
    for (int j = 0; j < 4; ++j) acc[j] = (f32x4){0.f, 0.f, 0.f, 0.f};
#pragma unroll
    for (int ks = 0; ks < 2; ++ks) {
        const bf16x8 aq = *(const GAS bf16x8*)(PA + (n0 + 16 * tr + fr) * NPA + PA_BQ + h * 64 + 8 * fq + 32 * ks);
        const int krow = 32 * ks + 8 * fq + (fr >> 2);
#pragma unroll
        for (int j = 0; j < 4; ++j) { const int nt = 4 * nh + j;
            const bf16x8 bs = cat8(ldtr(SS + krow * 256 + (16 * nt + 4 * (fr & 3)) * 2), ldtr(SS + (krow + 4) * 256 + (16 * nt + 4 * (fr & 3)) * 2));
            acc[j] = __builtin_amdgcn_mfma_f32_16x16x32_bf16(aq, bs, acc[j], 0, 0, 0); } }
    float ss[4] = {0.f, 0.f, 0.f, 0.f};
#pragma unroll
    for (int j = 0; j < 4; ++j) { const int v = 16 * (4 * nh + j) + fr;
#pragma unroll
        for (int r = 0; r < 4; ++r) { const int row = 16 * tr + 4 * fq + r; acc[j][r] += bf1(Y[(n0 + row) * 1536 + 512 + h * 128 + v]); ss[r] += acc[j][r] * acc[j][r]; } }
#pragma unroll
    for (int r = 0; r < 4; ++r) { float s = ss[r]; s += dppf<0xB1>(s); s += dppf<0x4E>(s); s += shx(s, 4, lane); s += shx(s, 8, lane); ss[r] = s; }
    if (fr == 0) {
#pragma unroll
        for (int r = 0; r < 4; ++r) PS[(16 * tr + 4 * fq + r) * 2 + nh] = ss[r]; }
    __syncthreads();
#pragma unroll
    for (int r = 0; r < 4; ++r) { const int row = 16 * tr + 4 * fq + r; const float rinv = 1.f / sqrtf((PS[row * 2] + PS[row * 2 + 1]) * (1.f / 128.f) + RMS_EPS);
#pragma unroll
        for (int j = 0; j < 4; ++j) { const int v = 16 * (4 * nh + j) + fr;
            const float br = bf1(PA[(n0 + row) * NPA + PA_BR + h * 128 + v]);
            Y[(n0 + row) * 1536 + 512 + h * 128 + v] = (bf16)f2bf(acc[j][r] * rinv * gng[v] * br); } }
    __syncthreads();
}

constexpr int DSA_WAVE_LDS = 17920;
__device__ __forceinline__ void dsa_unit(Frame& F, int unit) {
    int lane = F.lane; asm volatile("" : "+v"(lane)); const int w = F.wave;
    const int qb = 4095 - unit;
    const int b = qb & 7, t = (qb >> 3) * 8 + w;
    const size_t n = (size_t)b * SEQ + t, nb0 = (size_t)b * SEQ;
    const GAS bf16* PA = (const GAS bf16*)(F.ws + WS_PA); GAS bf16* Y = (GAS bf16*)(F.ws + WS_Y);
    const GAS bf16* KI = (const GAS bf16*)(F.ws + WS_KI); const GAS bf16* KA = (const GAS bf16*)(F.ws + WS_KA); const GAS bf16* VA = (const GAS bf16*)(F.ws + WS_VA);
    const GAS float* WI = (const GAS float*)(F.ws + WS_WI);
    LAS unsigned char* base = F.lds + w * DSA_WAVE_LDS;
    LAS unsigned* sc = (LAS unsigned*)base;
    LAS float* qi = (LAS float*)(base + 16384);
    LAS unsigned short* list = (LAS unsigned short*)(base + 16384 + 1024);
    { const u32x2 q2 = *(const GAS u32x2*)(PA + n * NPA + PA_QI + 4 * lane);
      *(LAS f32x4*)(qi + 4 * lane) = (f32x4){bflo(q2.x), bfhi(q2.x), bflo(q2.y), bfhi(q2.y)}; }
    asm volatile("s_waitcnt lgkmcnt(0)" ::: "memory");
    const f32x4 wi = {ld_f32(WI + n * 4), ld_f32(WI + n * 4 + 1), ld_f32(WI + n * 4 + 2), ld_f32(WI + n * 4 + 3)};
    const int nbat = (t >> 6) + 1;
    for (int kb = 0; kb < nbat; ++kb) { const int key = kb * 64 + lane, kc = key <= t ? key : t;
        const GAS u32x4* kp = (const GAS u32x4*)(KI + (nb0 + kc) * 64);
        float kf[64];
#pragma unroll
        for (int c = 0; c < 8; ++c) { const u32x4 kk = kp[c]; kf[8 * c] = bflo(kk.x); kf[8 * c + 1] = bfhi(kk.x); kf[8 * c + 2] = bflo(kk.y); kf[8 * c + 3] = bfhi(kk.y); kf[8 * c + 4] = bflo(kk.z); kf[8 * c + 5] = bfhi(kk.z); kf[8 * c + 6] = bflo(kk.w); kf[8 * c + 7] = bfhi(kk.w); }
        float score = 0.f;
#pragma unroll
        for (int h = 0; h < 4; ++h) { float d = 0.f;
#pragma unroll
            for (int c = 0; c < 16; ++c) { const f32x4 q4 = *(const LAS f32x4*)(qi + h * 64 + 4 * c); d += q4.x * kf[4 * c] + q4.y * kf[4 * c + 1] + q4.z * kf[4 * c + 2] + q4.w * kf[4 * c + 3]; }
            score += wi[h] * fmaxf(d, 0.f); }
        if (score == 0.f) score = 0.f;
        unsigned u = __builtin_bit_cast(unsigned, score); u = (u & 0x80000000u) ? ~u : (u | 0x80000000u);
        sc[key] = key <= t ? u : 0u; }
    asm volatile("s_waitcnt lgkmcnt(0)" ::: "memory");
    int nsel;
    if (t >= 256) {
        unsigned T = 0u;
        for (int bit = 31; bit >= 0; --bit) { const unsigned cand = T | (1u << bit); int cnt = 0;
            for (int j = 0; j < nbat; ++j) cnt += (sc[j * 64 + lane] >= cand) ? 1 : 0;
            if (wave_sum_i(cnt, lane) >= 256) T = cand; }
        int cgt = 0;
        for (int j = 0; j < nbat; ++j) cgt += (sc[j * 64 + lane] > T) ? 1 : 0;
        const int need = 256 - wave_sum_i(cgt, lane);
        int selbase = 0, tiebase = 0;
        for (int j = 0; j < nbat; ++j) { const unsigned x = sc[j * 64 + lane]; const bool eq = (x == T), gt = (x > T);
            const unsigned long long beq = __ballot(eq); const unsigned long long lt = (1ull << lane) - 1ull;
            const int trank = tiebase + __popcll(beq & lt);
            const bool sel = gt || (eq && trank < need);
            const unsigned long long bsel = __ballot(sel);
            if (sel) list[selbase + __popcll(bsel & lt)] = (unsigned short)(j * 64 + lane);
            selbase += __popcll(bsel); tiebase += __popcll(beq); }
        nsel = 256;
    } else {
        nsel = t + 1;
        for (int i = lane; i < 256; i += 64) list[i] = (unsigned short)(i <= t ? i : 0);
    }
    asm volatile("s_waitcnt lgkmcnt(0)" ::: "memory");
    LAS float* qm = (LAS float*)base;
    LAS float* Pl = (LAS float*)(base + 2048);
    { const u32x4 q8 = *(const GAS u32x4*)(PA + n * NPA + PA_Q + 8 * lane);
      *(LAS f32x4*)(qm + 8 * lane) = (f32x4){bflo(q8.x), bfhi(q8.x), bflo(q8.y), bfhi(q8.y)}; *(LAS f32x4*)(qm + 8 * lane + 4) = (f32x4){bflo(q8.z), bfhi(q8.z), bflo(q8.w), bfhi(q8.w)}; }
    asm volatile("s_waitcnt lgkmcnt(0)" ::: "memory");
#pragma unroll 1
    for (int bb = 0; bb < 4; ++bb) { const int i = bb * 64 + lane; const bool valid = i < nsel; const int key = valid ? (int)list[i] : 0;
        const GAS u32x4* kp = (const GAS u32x4*)(KA + (nb0 + key) * 64);
        float kf[64];
#pragma unroll
        for (int c = 0; c < 8; ++c) { const u32x4 kk = kp[c]; kf[8 * c] = bflo(kk.x); kf[8 * c + 1] = bfhi(kk.x); kf[8 * c + 2] = bflo(kk.y); kf[8 * c + 3] = bfhi(kk.y); kf[8 * c + 4] = bflo(kk.z); kf[8 * c + 5] = bfhi(kk.z); kf[8 * c + 6] = bflo(kk.w); kf[8 * c + 7] = bfhi(kk.w); }
        float lgv[8];
#pragma unroll
        for (int h = 0; h < 8; ++h) { float d = 0.f;
#pragma unroll
            for (int c = 0; c < 16; ++c) { const f32x4 q4 = *(const LAS f32x4*)(qm + h * 64 + 4 * c); d += q4.x * kf[4 * c] + q4.y * kf[4 * c + 1] + q4.z * kf[4 * c + 2] + q4.w * kf[4 * c + 3]; }
            lgv[h] = valid ? d : -INFINITY; }
        *(LAS f32x4*)(Pl + i * 8) = (f32x4){lgv[0], lgv[1], lgv[2], lgv[3]}; *(LAS f32x4*)(Pl + i * 8 + 4) = (f32x4){lgv[4], lgv[5], lgv[6], lgv[7]}; }
    asm volatile("s_waitcnt lgkmcnt(0)" ::: "memory");
    float lg[4][8];
#pragma unroll
    for (int bb = 0; bb < 4; ++bb) { const f32x4 a = *(const LAS f32x4*)(Pl + (bb * 64 + lane) * 8), c = *(const LAS f32x4*)(Pl + (bb * 64 + lane) * 8 + 4);
        lg[bb][0] = a.x; lg[bb][1] = a.y; lg[bb][2] = a.z; lg[bb][3] = a.w; lg[bb][4] = c.x; lg[bb][5] = c.y; lg[bb][6] = c.z; lg[bb][7] = c.w; }
    float den[8];
#pragma unroll
    for (int h = 0; h < 8; ++h) { float m = fmaxf(fmaxf(lg[0][h], lg[1][h]), fmaxf(lg[2][h], lg[3][h])); m = wave_max(m, lane); float s = 0.f;
#pragma unroll
        for (int bb = 0; bb < 4; ++bb) { lg[bb][h] = __expf(lg[bb][h] - m); s += lg[bb][h]; }
        den[h] = wave_sum(s, lane); }
#pragma unroll
    for (int bb = 0; bb < 4; ++bb) { const int i = bb * 64 + lane;
        *(LAS f32x4*)(Pl + i * 8) = (f32x4){lg[bb][0], lg[bb][1], lg[bb][2], lg[bb][3]}; *(LAS f32x4*)(Pl + i * 8 + 4) = (f32x4){lg[bb][4], lg[bb][5], lg[bb][6], lg[bb][7]}; }
    asm volatile("s_waitcnt lgkmcnt(0)" ::: "memory");
    float o[8];
#pragma unroll
    for (int h = 0; h < 8; ++h) o[h] = 0.f;
#pragma unroll 4
    for (int i = 0; i < nsel; ++i) { const int key = (int)list[i]; const float vv = bf1(VA[(nb0 + key) * 64 + lane]);
        const f32x4 p0 = *(const LAS f32x4*)(Pl + i * 8), p1 = *(const LAS f32x4*)(Pl + i * 8 + 4);
        o[0] += p0.x * vv; o[1] += p0.y * vv; o[2] += p0.z * vv; o[3] += p0.w * vv; o[4] += p1.x * vv; o[5] += p1.y * vv; o[6] += p1.z * vv; o[7] += p1.w * vv; }
#pragma unroll
    for (int h = 0; h < 8; ++h) Y[n * 1536 + h * 64 + lane] = (bf16)f2bf(o[h] / den[h]);
}

__device__ __forceinline__ bf16x8 scale_pack8(u32x4 raw, float s) {
    u32x4 o; o.x = cvt_pk_bf16(bflo(raw.x) * s, bfhi(raw.x) * s); o.y = cvt_pk_bf16(bflo(raw.y) * s, bfhi(raw.y) * s); o.z = cvt_pk_bf16(bflo(raw.z) * s, bfhi(raw.z) * s); o.w = cvt_pk_bf16(bflo(raw.w) * s, bfhi(raw.w) * s);
    return __builtin_bit_cast(bf16x8, o);
}
__device__ __forceinline__ void dsa16_unit(Frame& F, int unit) {
    int lane = F.lane; asm volatile("" : "+v"(lane)); const int w = F.wave;
    const int qb = 2047 - unit;
    const int b = qb & 7, t0 = (qb >> 3) * 16;
    const size_t nb0 = (size_t)b * SEQ;
    const GAS bf16* PA = (const GAS bf16*)(F.ws + WS_PA); GAS bf16* Y = (GAS bf16*)(F.ws + WS_Y);
    const GAS bf16* KI = (const GAS bf16*)(F.ws + WS_KI); const GAS bf16* KA = (const GAS bf16*)(F.ws + WS_KA); const GAS bf16* VA = (const GAS bf16*)(F.ws + WS_VA);
    const GAS float* WI = (const GAS float*)(F.ws + WS_WI);
    LAS unsigned char* K16 = F.lds;
    LAS unsigned short* LIST = (LAS unsigned short*)(F.lds + AUX_OFF);
    const int fr = lane & 15, fq = lane >> 4;
#ifdef REP_S1
    for (int rep_ = 0; rep_ < REP_S1; ++rep_)
#endif
    {
        const int ql = fr >> 2, h = fr & 3;
        bf16x8 Bf[4][2]; float Linf[4];
#pragma unroll
        for (int g = 0; g < 4; ++g) { const size_t nq = nb0 + t0 + 4 * g + ql; const float wv = WI[nq * 4 + h];
#pragma unroll
            for (int ks = 0; ks < 2; ++ks) Bf[g][ks] = scale_pack8(*(const GAS u32x4*)(PA + nq * NPA + PA_QI + h * 64 + 8 * fq + 32 * ks), wv);
            Linf[g] = (wv >= 0.f) ? INFINITY : -INFINITY; }
        const int ntiles = (t0 >> 4) + 1;
        bf16x8 A0[4], A1[4];
#pragma unroll
        for (int j = 0; j < 4; ++j) { const int tile = (w + 8 * j < ntiles) ? w + 8 * j : ntiles - 1; const size_t krow = (nb0 + 16 * tile + fr) * 64;
            A0[j] = *(const GAS bf16x8*)(KI + krow + 8 * fq); A1[j] = *(const GAS bf16x8*)(KI + krow + 32 + 8 * fq); }
#pragma unroll 1
        for (int tb = w; tb < ntiles; tb += 32) {
            bf16x8 N0[4], N1[4];
#pragma unroll
            for (int j = 0; j < 4; ++j) { const int tn = tb + 32 + 8 * j; const int tile = (tn < ntiles) ? tn : ntiles - 1; const size_t krow = (nb0 + 16 * tile + fr) * 64;
                N0[j] = *(const GAS bf16x8*)(KI + krow + 8 * fq); N1[j] = *(const GAS bf16x8*)(KI + krow + 32 + 8 * fq); }
#pragma unroll
            for (int j = 0; j < 4; ++j) { const int tile = tb + 8 * j;
                if (tile < ntiles) {
                    const int kpos = 16 * tile + 4 * fq + h;
                    const int g7 = kpos >> 7, hf = (kpos >> 6) & 1, ln = kpos & 63;
                    const int koff = (g7 >> 2) * 1024 + ln * 16 + (g7 & 3) * 4 + hf * 2;
                    const bool lastt = (tile == ntiles - 1);
#pragma unroll
                    for (int g = 0; g < 4; ++g) {
                        f32x4 d = __builtin_amdgcn_mfma_f32_16x16x32_bf16(A0[j], Bf[g][0], (f32x4){0.f, 0.f, 0.f, 0.f}, 0, 0, 0);
                        d = __builtin_amdgcn_mfma_f32_16x16x32_bf16(A1[j], Bf[g][1], d, 0, 0, 0);
                        const float a0 = __builtin_amdgcn_fmed3f(d[0], 0.f, Linf[g]), a1 = __builtin_amdgcn_fmed3f(d[1], 0.f, Linf[g]), a2 = __builtin_amdgcn_fmed3f(d[2], 0.f, Linf[g]), a3 = __builtin_amdgcn_fmed3f(d[3], 0.f, Linf[g]);
                        const float u0 = a0 + dppf<0xB1>(a0), u1 = a1 + dppf<0xB1>(a1), u2 = a2 + dppf<0xB1>(a2), u3 = a3 + dppf<0xB1>(a3);
                        const float b0 = (h & 1) ? u1 : u0, b1 = (h & 1) ? u3 : u2;
                        const float c0 = b0 + dppf<0x4E>(b0), c1 = b1 + dppf<0x4E>(b1);
                        const float s = ((h & 2) ? c1 : c0) + 0.0f;
                        const _Float16 hh = (_Float16)s; const unsigned hb = (unsigned)__builtin_bit_cast(unsigned short, hh);
                        unsigned key = hb ^ ((unsigned)((int)(hb << 16) >> 31) | 0x8000u);
                        if (lastt) key = (kpos <= t0 + 4 * g + ql) ? key : 0u;
                        *(LAS unsigned short*)(K16 + (4 * g + ql) * 8192 + koff) = (unsigned short)key;
                    }
                }
            }
#pragma unroll
            for (int j = 0; j < 4; ++j) { A0[j] = N0[j]; A1[j] = N1[j]; }
        }
    }
    __syncthreads();
    if (t0 < 256) {
#pragma unroll 1
        for (int qq = 0; qq < 2; ++qq) { const int q = 2 * w + qq, nvalid = t0 + q + 1; LAS unsigned short* list = LIST + q * 256;
            for (int i = lane; i < 256; i += 64) list[i] = (unsigned short)(i < nvalid ? i : 0); }
    } else {
#ifndef REP_S2
#define REP_S2 1
#endif
#pragma unroll 1
        for (int qq = 0; qq < 2 * REP_S2; ++qq) {
            const int q = 2 * w + (qq & 1), nvalid = t0 + q + 1;
            LAS unsigned short* list = LIST + q * 256;
            const int ngrp = (nvalid + 511) >> 9;
            unsigned P[32];
#pragma unroll
            for (int grp = 0; grp < 8; ++grp) {
                if (grp < ngrp) { const u32x4 r = *(const LAS u32x4*)(K16 + q * 8192 + grp * 1024 + lane * 16);
#pragma unroll
                    for (int i = 0; i < 4; ++i) { const int g = 4 * grp + i; const int thr = nvalid - 128 * g; unsigned rr = r[i];
                        if (thr < 128) rr &= ((lane < thr) ? 0xffffu : 0u) | ((lane < thr - 64) ? 0xffff0000u : 0u);
                        P[g] = rr; }
                } else {
#pragma unroll
                    for (int i = 0; i < 4; ++i) P[4 * grp + i] = 0u;
                }
            }
            unsigned one2 = 0x00010001u; asm volatile("" : "+v"(one2));
#define DSA_PKCOUNT(dst, c1) do { const unsigned c1p_ = (c1) | ((c1) << 16); unsigned a_ = 0u; \
                _Pragma("unroll") for (int grp = 0; grp < 8; ++grp) if (grp < ngrp) { _Pragma("unroll") for (int i = 0; i < 4; ++i) { unsigned y_; \
                    asm("v_pk_sub_u16 %0, %1, %2 clamp\n\tv_pk_min_u16 %0, %0, %3" : "=&v"(y_) : "v"(P[4 * grp + i]), "v"(c1p_), "v"(one2)); a_ += y_; } } \
                dst = (int)((a_ & 0xffffu) + (a_ >> 16)); } while (0)
            LAS unsigned* hist = (LAS unsigned*)(F.lds + AUX_OFF + 8192) + w * 256;
            unsigned T; int tot_gt;
            { unsigned hi8 = 0u; int above = 0;
#pragma unroll
              for (int lvl = 0; lvl < 2; ++lvl) {
                  *(LAS u32x4*)(hist + 4 * lane) = (u32x4){0u, 0u, 0u, 0u};
                  asm volatile("s_waitcnt lgkmcnt(0)" ::: "memory");
#pragma unroll
                  for (int grp = 0; grp < 8; ++grp) if (grp < ngrp) {
#pragma unroll
                      for (int i = 0; i < 4; ++i) { const unsigned lo = P[4 * grp + i] & 0xffffu, hi = P[4 * grp + i] >> 16;
                          if (lvl == 0) { __hip_atomic_fetch_add(hist + (lo >> 8), 1u, __ATOMIC_RELAXED, __HIP_MEMORY_SCOPE_WAVEFRONT); __hip_atomic_fetch_add(hist + (hi >> 8), 1u, __ATOMIC_RELAXED, __HIP_MEMORY_SCOPE_WAVEFRONT); }
                          else { if ((lo >> 8) == hi8) __hip_atomic_fetch_add(hist + (lo & 0xffu), 1u, __ATOMIC_RELAXED, __HIP_MEMORY_SCOPE_WAVEFRONT);
                                 if ((hi >> 8) == hi8) __hip_atomic_fetch_add(hist + (hi & 0xffu), 1u, __ATOMIC_RELAXED, __HIP_MEMORY_SCOPE_WAVEFRONT); } } }
                  asm volatile("s_waitcnt lgkmcnt(0)" ::: "memory");
                  const u32x4 hb = *(const LAS u32x4*)(hist + 4 * lane);
                  const int sl = (int)(hb.x + hb.y + hb.z + hb.w);
                  int inc = sl;
                  inc += __builtin_amdgcn_update_dpp(0, inc, 0x111, 0xf, 0xf, false); inc += __builtin_amdgcn_update_dpp(0, inc, 0x112, 0xf, 0xf, false);
                  inc += __builtin_amdgcn_update_dpp(0, inc, 0x114, 0xf, 0xf, false); inc += __builtin_amdgcn_update_dpp(0, inc, 0x118, 0xf, 0xf, false);
                  const int r0 = __builtin_amdgcn_readlane(inc, 15), r1 = __builtin_amdgcn_readlane(inc, 31), r2 = __builtin_amdgcn_readlane(inc, 47), r3 = __builtin_amdgcn_readlane(inc, 63);
                  inc += (fq >= 1 ? r0 : 0) + (fq >= 2 ? r1 : 0) + (fq >= 3 ? r2 : 0);
                  const int total = r0 + r1 + r2 + r3;
                  const int want = 256 - above;
                  int run = total - inc;
                  int fb = -1, fa = 0;
                  { const int h3 = (int)hb.w, h2 = (int)hb.z, h1 = (int)hb.y, h0 = (int)hb.x;
                    if (run < want && run + h3 >= want) { fb = 3; fa = run; } run += h3;
                    if (run < want && run + h2 >= want) { fb = 2; fa = run; } run += h2;
                    if (run < want && run + h1 >= want) { fb = 1; fa = run; } run += h1;
                    if (run < want && run + h0 >= want) { fb = 0; fa = run; } }
                  const unsigned long long fm = __ballot(fb >= 0);
                  const int src = (int)__builtin_ctzll(fm);
                  const int bstar = __builtin_amdgcn_readlane(4 * lane + fb, src), abv = __builtin_amdgcn_readlane(fa, src);
                  if (lvl == 0) { hi8 = (unsigned)bstar; above = abv; } else { T = (hi8 << 8) | (unsigned)bstar; tot_gt = above + abv; }
              } }
            int cge_l, cgt_l; DSA_PKCOUNT(cge_l, T - 1u); DSA_PKCOUNT(cgt_l, T);
            const int tot_ge = wave_total_i(cge_l);
            const bool alltie = (tot_ge == 256);
            const int c_l = alltie ? cge_l : cgt_l; const unsigned thrT = alltie ? T : T + 1u;
            int inc = c_l;
            inc += __builtin_amdgcn_update_dpp(0, inc, 0x111, 0xf, 0xf, false); inc += __builtin_amdgcn_update_dpp(0, inc, 0x112, 0xf, 0xf, false);
            inc += __builtin_amdgcn_update_dpp(0, inc, 0x114, 0xf, 0xf, false); inc += __builtin_amdgcn_update_dpp(0, inc, 0x118, 0xf, 0xf, false);
            { const int r0 = __builtin_amdgcn_readlane(inc, 15), r1 = __builtin_amdgcn_readlane(inc, 31), r2 = __builtin_amdgcn_readlane(inc, 47);
              inc += (fq >= 1 ? r0 : 0) + (fq >= 2 ? r1 : 0) + (fq >= 3 ? r2 : 0); }
            int kpos_ = inc - c_l;
#pragma unroll
            for (int grp = 0; grp < 8; ++grp) if (grp < ngrp) {
#pragma unroll
                for (int i = 0; i < 4; ++i) { const int g = 4 * grp + i; const unsigned lo = P[g] & 0xffffu, hi = P[g] >> 16;
                    if (lo >= thrT) { list[kpos_] = (unsigned short)(128 * g + lane); ++kpos_; }
                    if (hi >= thrT) { list[kpos_] = (unsigned short)(128 * g + 64 + lane); ++kpos_; } } }
            if (!alltie) {
                int rem = 256 - tot_gt, pos = tot_gt; const unsigned long long lt = (1ull << lane) - 1ull;
#pragma unroll
                for (int grp = 0; grp < 8; ++grp) if (grp < ngrp) {
#pragma unroll
                    for (int i = 0; i < 8; ++i) { const int g = 4 * grp + (i >> 1); const unsigned val = (i & 1) ? (P[g] >> 16) : (P[g] & 0xffffu);
                        const bool eq = (val == T); const unsigned long long beq = __ballot(eq);
                        if (beq != 0ull) { const int rank = __popcll(beq & lt); if (eq && rank < rem) list[pos + rank] = (unsigned short)(128 * g + 64 * (i & 1) + lane);
                            const int n = __popcll(beq), take = n < rem ? n : rem; pos += take; rem -= take; } } }
            }
#undef DSA_PKCOUNT
        }
    }
    __syncthreads();
    LAS unsigned char* Vs = F.lds + w * 16384;
#ifndef REP_S3
#define REP_S3 1
#endif
#pragma unroll 1
    for (int qq = 0; qq < 2 * REP_S3; ++qq) {
        const int q = 2 * w + (qq & 1), tq = t0 + q; const int nsel = (tq + 1 < 256) ? tq + 1 : 256;
        const size_t nq = nb0 + tq;
        const LAS unsigned short* list = LIST + q * 256;
        bf16x8 Qf[2];
#pragma unroll
        for (int ks = 0; ks < 2; ++ks) { u32x4 raw = {0u, 0u, 0u, 0u}; if (fr < 8) raw = *(const GAS u32x4*)(PA + nq * NPA + PA_Q + fr * 64 + 8 * fq + 32 * ks); Qf[ks] = __builtin_bit_cast(bf16x8, raw); }
        float lg[16][4];
        int keyv[16];
#pragma unroll
        for (int tt = 0; tt < 16; ++tt) keyv[tt] = (int)list[16 * tt + fr];
#pragma unroll
        for (int hb = 0; hb < 4; ++hb) {
            bf16x8 A0[4], A1[4];
#pragma unroll
            for (int j = 0; j < 4; ++j) { const size_t krow = (nb0 + keyv[4 * hb + j]) * 64; A0[j] = *(const GAS bf16x8*)(KA + krow + 8 * fq); A1[j] = *(const GAS bf16x8*)(KA + krow + 32 + 8 * fq); }
            __builtin_amdgcn_sched_barrier(0);
#pragma unroll
            for (int j = 0; j < 4; ++j) { const int tt = 4 * hb + j;
                f32x4 d = __builtin_amdgcn_mfma_f32_16x16x32_bf16(A0[j], Qf[0], (f32x4){0.f, 0.f, 0.f, 0.f}, 0, 0, 0);
                d = __builtin_amdgcn_mfma_f32_16x16x32_bf16(A1[j], Qf[1], d, 0, 0, 0);
#pragma unroll
                for (int r = 0; r < 4; ++r) lg[tt][r] = (16 * tt + 4 * fq + r < nsel) ? d[r] : -INFINITY; }
        }
        float m = lg[0][0];
#pragma unroll
        for (int tt = 0; tt < 16; ++tt)
#pragma unroll
            for (int r = 0; r < 4; ++r) m = fmaxf(m, lg[tt][r]);
        m = fmaxf(m, shx(m, 16, lane)); m = fmaxf(m, shx(m, 32, lane));
        float den = 0.f;
#pragma unroll
        for (int tt = 0; tt < 16; ++tt)
#pragma unroll
            for (int r = 0; r < 4; ++r) { lg[tt][r] = __expf(lg[tt][r] - m); den += lg[tt][r]; }
        den += shx(den, 16, lane); den += shx(den, 32, lane);
        f32x4 acc[4];
#pragma unroll
        for (int nt = 0; nt < 4; ++nt) acc[nt] = (f32x4){0.f, 0.f, 0.f, 0.f};
#pragma unroll
        for (int hh = 0; hh < 2; ++hh) {
#pragma unroll
            for (int ib = 0; ib < 2; ++ib) {
                u32x4 vv[8];
#pragma unroll
                for (int i = 0; i < 8; ++i) { const int piece = (8 * ib + i) * 64 + lane, row = piece >> 3, c = piece & 7; const int key = (int)list[128 * hh + row];
                    vv[i] = *(const GAS u32x4*)(VA + (nb0 + key) * 64 + 8 * c); }
                __builtin_amdgcn_sched_barrier(0);
#pragma unroll
                for (int i = 0; i < 8; ++i) { const int piece = (8 * ib + i) * 64 + lane; *(LAS u32x4*)(Vs + piece * 16) = vv[i]; }
            }
            asm volatile("s_waitcnt lgkmcnt(0)" ::: "memory");
#pragma unroll
            for (int s4 = 0; s4 < 4; ++s4) { const int s = 4 * hh + s4;
                u32x4 pa; pa.x = cvt_pk_bf16(lg[2 * s][0], lg[2 * s][1]); pa.y = cvt_pk_bf16(lg[2 * s][2], lg[2 * s][3]); pa.z = cvt_pk_bf16(lg[2 * s + 1][0], lg[2 * s + 1][1]); pa.w = cvt_pk_bf16(lg[2 * s + 1][2], lg[2 * s + 1][3]);
                const bf16x8 Pa = __builtin_bit_cast(bf16x8, pa);
                const int rowa = 32 * s4 + 4 * fq + (fr >> 2);
#pragma unroll
                for (int nt = 0; nt < 4; ++nt) {
                    const v4i16_t lo = __builtin_amdgcn_ds_read_tr16_b64_v4i16((LAS v4i16_t*)(Vs + rowa * 128 + (16 * nt + 4 * (fr & 3)) * 2));
                    const v4i16_t hi = __builtin_amdgcn_ds_read_tr16_b64_v4i16((LAS v4i16_t*)(Vs + (rowa + 16) * 128 + (16 * nt + 4 * (fr & 3)) * 2));
                    bf16x8 Bv; Bv[0] = lo[0]; Bv[1] = lo[1]; Bv[2] = lo[2]; Bv[3] = lo[3]; Bv[4] = hi[0]; Bv[5] = hi[1]; Bv[6] = hi[2]; Bv[7] = hi[3];
                    acc[nt] = __builtin_amdgcn_mfma_f32_16x16x32_bf16(Pa, Bv, acc[nt], 0, 0, 0); } }
            asm volatile("s_waitcnt lgkmcnt(0)" ::: "memory");
        }
        float dn[4];
#pragma unroll
        for (int r = 0; r < 4; ++r) dn[r] = __builtin_bit_cast(float, __builtin_amdgcn_ds_bpermute((4 * (fq & 1) + r) << 2, __builtin_bit_cast(int, den)));
        if (fq < 2) {
#pragma unroll
            for (int nt = 0; nt < 4; ++nt)
#pragma unroll
                for (int r = 0; r < 4; ++r) Y[nq * 1536 + (4 * fq + r) * 64 + 16 * nt + fr] = (bf16)f2bf(acc[nt][r] / dn[r]);
        }
    }
}

#ifdef GLA_NAIVE
constexpr int NGLA = 32;
#else
constexpr int NGLA = 2048;
#endif
#ifdef DSA_NAIVE
constexpr int NDSA = 4096;
#else
constexpr int NDSA = 2048;
#endif
#ifdef GMLP_NAIVE
constexpr int NGM = 1024;
#else
constexpr int NGM = 256;
#endif
__device__ __forceinline__ void phase_mixer(Frame& F, int l, int slot = 0, int types = 7) {
    gu32* head = F.ctl + CW_QUEUE + 64 * (l + 2 * slot);
    for (;;) {
        __syncthreads();
        if (F.tid == 0) F.MISC[64] = __hip_atomic_fetch_add(head, 1u, __ATOMIC_RELAXED, __HIP_MEMORY_SCOPE_AGENT);
        __syncthreads();
        const int u = (int)F.MISC[64];
        if (u >= NDSA + NGLA + NGM) break;
        if (u < NDSA) { if (EN_B2 && (types & 2)) {
#ifdef DSA_NAIVE
            dsa_unit(F, u);
#else
            dsa16_unit(F, u);
#endif
        } }
        else if (u < NDSA + NGLA) { if (EN_B1 && (types & 1)) {
#ifdef GLA_NAIVE
            gla_unit(F, l, u - NDSA);
#else
            gla_local_unit(F, l, u - NDSA);
#endif
        } }
        else { if (EN_B3 && (types & 4)) {
#ifdef GMLP_NAIVE
            gmlp_unit(F, l, u - NDSA - NGLA);
#else
            gmlp16_unit(F, l, u - NDSA - NGLA);
#endif
        } }
    }
}
__device__ __forceinline__ void phase_gla_out(Frame& F, int l) {
#ifndef GLA_NAIVE
    for (int u = F.wg; u < 2048; u += F.G) gla_out_unit(F, l, u);
#endif
}

template <int CTRL> __device__ __forceinline__ float dpp_add(float v) { return v + dppf<CTRL>(v); }
__device__ __forceinline__ float row16_sum(float v) { v = dpp_add<0xB1>(v); v = dpp_add<0x4E>(v); v = dpp_add<0x141>(v); v = dpp_add<0x140>(v); return v; }
__device__ __forceinline__ void phase_ln_router(Frame& F, int l) {
    const GAS float* WR = (const GAS float*)(F.ws + WS_WR) + (size_t)l * 36 * DM;
    LAS float* wr = (LAS float*)F.lds;
    for (int i = F.tid; i < 36 * 256; i += 512) ((LAS f32x4*)wr)[i] = ((const GAS f32x4*)WR)[i];
    if (F.tid < 32) F.MISC[16 + F.tid] = 0u;
    __syncthreads();
    GAS bf16* HB = (GAS bf16*)(F.ws + WS_HB); const GAS bf16* T = (const GAS bf16*)F.H; GAS int* EID = (GAS int*)(F.ws + WS_ROUTE); GAS float* EW = (GAS float*)(F.ws + WS_ROUTE + 256 * 1024);
    const GAS float* g = ((const GAS float*)F.in[17]) + l * DM; const GAS float* bb = ((const GAS float*)F.in[18]) + l * DM; const GAS float* brg = ((const GAS float*)F.in[20]) + l * 4; const GAS float* bre = ((const GAS float*)F.in[22]) + l * 32;
    int lane = F.lane; asm volatile("" : "+v"(lane));
    const int sub = lane & 15, rr = lane >> 4;
    for (int r0 = F.wg * 128; r0 < NTOK; r0 += F.G * 128) {
        u32x4 nx[8];
#pragma unroll
        for (int q = 0; q < 8; ++q) nx[q] = *(const GAS u32x4*)(T + (size_t)(r0 + F.wave * 16 + rr) * DM + 8 * (sub + 16 * q));
#pragma unroll 1
        for (int j = 0; j < 4; ++j) { const int m = r0 + F.wave * 16 + 4 * j + rr;
            float v[64]; float s = 0.f;
#pragma unroll
            for (int q = 0; q < 8; ++q) { const u32x4 x = nx[q]; v[8 * q] = bflo(x.x); v[8 * q + 1] = bfhi(x.x); v[8 * q + 2] = bflo(x.y); v[8 * q + 3] = bfhi(x.y); v[8 * q + 4] = bflo(x.z); v[8 * q + 5] = bfhi(x.z); v[8 * q + 6] = bflo(x.w); v[8 * q + 7] = bfhi(x.w); }
            { const int mn = (j < 3) ? m + 4 : m;
#pragma unroll
              for (int q = 0; q < 8; ++q) nx[q] = *(const GAS u32x4*)(T + (size_t)mn * DM + 8 * (sub + 16 * q)); }
#pragma unroll
            for (int i = 0; i < 64; ++i) s += v[i];
            const float mean = row16_sum(s) * (1.f / DM); float s2 = 0.f;
#pragma unroll
            for (int i = 0; i < 64; ++i) { v[i] -= mean; s2 += v[i] * v[i]; }
            const float rstd = 1.f / sqrtf(row16_sum(s2) * (1.f / DM) + LN_EPS);
#pragma unroll
            for (int q = 0; q < 8; ++q) { const int c = 8 * (sub + 16 * q); const f32x4 g0 = *(const GAS f32x4*)(g + c), g1 = *(const GAS f32x4*)(g + c + 4), b0 = *(const GAS f32x4*)(bb + c), b1 = *(const GAS f32x4*)(bb + c + 4);
#pragma unroll
                for (int i = 0; i < 4; ++i) { v[8 * q + i] = v[8 * q + i] * rstd * g0[i] + b0[i]; v[8 * q + 4 + i] = v[8 * q + 4 + i] * rstd * g1[i] + b1[i]; }
                u32x4 wv; wv.x = pk2(v[8 * q], v[8 * q + 1]); wv.y = pk2(v[8 * q + 2], v[8 * q + 3]); wv.z = pk2(v[8 * q + 4], v[8 * q + 5]); wv.w = pk2(v[8 * q + 6], v[8 * q + 7]);
                *(GAS u32x4*)(HB + (size_t)m * DM + c) = wv; }
            float lgt[36];
#pragma unroll
            for (int o = 0; o < 36; ++o) { float p = 0.f;
#pragma unroll
                for (int q = 0; q < 8; ++q) { const f32x4 w0 = *(const LAS f32x4*)(wr + o * DM + 8 * (sub + 16 * q)), w1 = *(const LAS f32x4*)(wr + o * DM + 8 * (sub + 16 * q) + 4);
                    p += v[8 * q] * w0.x + v[8 * q + 1] * w0.y + v[8 * q + 2] * w0.z + v[8 * q + 3] * w0.w + v[8 * q + 4] * w1.x + v[8 * q + 5] * w1.y + v[8 * q + 6] * w1.z + v[8 * q + 7] * w1.w; }
                lgt[o] = row16_sum(p); }
            int gi = 0; float gm = lgt[0] + brg[0];
#pragma unroll
            for (int q = 1; q < 4; ++q) { const float x = lgt[q] + brg[q]; if (x > gm) { gm = x; gi = q; } }
            float gs = 0.f;
#pragma unroll
            for (int q = 0; q < 4; ++q) gs += __expf(lgt[q] + brg[q] - gm);
            const float gp = 1.f / gs;
            float el[8];
#pragma unroll
            for (int q = 0; q < 8; ++q) { float x = lgt[4 + q] + bre[q];
                x = (gi == 1) ? lgt[12 + q] + bre[8 + q] : x; x = (gi == 2) ? lgt[20 + q] + bre[16 + q] : x; x = (gi == 3) ? lgt[28 + q] + bre[24 + q] : x; el[q] = x; }
            int i0 = 0; float v0 = el[0];
#pragma unroll
            for (int q = 1; q < 8; ++q) if (el[q] > v0) { v0 = el[q]; i0 = q; }
            int i1 = -1; float v1 = -INFINITY;
#pragma unroll
            for (int q = 0; q < 8; ++q) if (q != i0 && el[q] > v1) { v1 = el[q]; i1 = q; }
            const float ex = __expf(v1 - v0), w0 = gp / (1.f + ex), w1 = gp * ex / (1.f + ex);
            if (sub == 0) { const int e0 = gi * 8 + i0, e1 = gi * 8 + i1;
                EID[2 * m] = e0; EID[2 * m + 1] = e1; EW[2 * m] = w0; EW[2 * m + 1] = w1;
                __hip_atomic_fetch_add((LAS unsigned*)(F.lds + MISC_OFF) + 16 + e0, 1u, __ATOMIC_RELAXED, __HIP_MEMORY_SCOPE_WORKGROUP);
                __hip_atomic_fetch_add((LAS unsigned*)(F.lds + MISC_OFF) + 16 + e1, 1u, __ATOMIC_RELAXED, __HIP_MEMORY_SCOPE_WORKGROUP); } }
    }
    __syncthreads();
    if (F.tid < 32) ((GAS int*)(F.ws + WS_CNTWG))[F.wg * 32 + F.tid] = (int)F.MISC[16 + F.tid];
}
__device__ __forceinline__ void phase_dispatch(Frame& F) {
    const GAS int* CNT = (const GAS int*)(F.ws + WS_CNTWG); const GAS int* EID = (const GAS int*)(F.ws + WS_ROUTE); const GAS float* EW = (const GAS float*)(F.ws + WS_ROUTE + 256 * 1024);
    GAS int* SROW = (GAS int*)(F.ws + WS_SROW); GAS int* ROWMAP = (GAS int*)(F.ws + WS_ROWMAP); GAS float* CWROW = (GAS float*)(F.ws + WS_CWROW); GAS int* META = (GAS int*)(F.ws + WS_META);
    LAS int* tot = (LAS int*)(F.lds + AUX_OFF);
    if (F.tid < 32) { int t = 0, mine = 0; for (int w = 0; w < F.G; ++w) { const int c = ld_i32(CNT + w * 32 + F.tid); t += c; if (w < F.wg) mine += c; } tot[F.tid] = t; tot[32 + F.tid] = mine; tot[96 + F.tid] = 0; }
    __syncthreads();
    if (F.tid == 0) { int rb = 0;
#pragma clang loop unroll(disable) vectorize(disable)
        for (int e = 0; e < 32; ++e) { tot[64 + e] = rb; rb += ((tot[e] + 255) >> 8) << 8; }
        tot[128] = rb; }
    __syncthreads();
    if (F.wg == 0) { const int nt = tot[128] >> 8; if (F.tid == 0) META[0] = nt;
        if (F.tid < nt) { int e = 0;
#pragma clang loop unroll(disable) vectorize(disable)
            for (int q = 1; q < 32; ++q) if (tot[64 + q] <= F.tid * 256) e = q;
            META[16 + F.tid] = e; } }
    for (int r0 = F.wg * 128; r0 < NTOK; r0 += F.G * 128) {
        if (F.tid < 256) { const int tok = r0 + (F.tid >> 1), slot = F.tid & 1; const int e = EID[2 * tok + slot];
            const int pos = (int)__hip_atomic_fetch_add((LAS unsigned*)&tot[96 + e], 1u, __ATOMIC_RELAXED, __HIP_MEMORY_SCOPE_WORKGROUP);
            const int sr = tot[64 + e] + tot[32 + e] + pos;
            ROWMAP[sr] = tok; CWROW[sr] = EW[2 * tok + slot]; SROW[2 * tok + slot] = sr; } }
    if (F.wg < 32) { const int e = F.wg; const int lo = tot[64 + e] + tot[e], hi = tot[64 + e] + (((tot[e] + 255) >> 8) << 8);
        for (int r = lo + F.tid; r < hi; r += 512) { ROWMAP[r] = 0; CWROW[r] = 0.f; } }
}
__device__ __forceinline__ void phase_ln2(Frame& F, int l) {
    GAS bf16* HB = (GAS bf16*)(F.ws + WS_HB); const GAS int* SROW = (const GAS int*)(F.ws + WS_SROW); const GAS bf16* FF2 = (const GAS bf16*)(F.ws + WS_FF2);
    const GAS float* g = ((const GAS float*)F.in[26]) + l * DM; const GAS float* bb = ((const GAS float*)F.in[27]) + l * DM; int lane = F.lane; asm volatile("" : "+v"(lane));
    const int gw = F.wg * 8 + F.wave, NGW = F.G * 8; const bool last = (l == DEPTH - 1);
    int m = gw;
    u32x4 hn[2], an[2], cn[2];
    if (m < NTOK) { const int s0 = ld_i32(SROW + 2 * m), s1 = ld_i32(SROW + 2 * m + 1);
#pragma unroll
        for (int j = 0; j < 2; ++j) { hn[j] = *(const GAS u32x4*)(HB + (size_t)m * DM + 8 * lane + 512 * j); an[j] = *(const GAS u32x4*)(FF2 + (size_t)s0 * DM + 8 * lane + 512 * j); cn[j] = *(const GAS u32x4*)(FF2 + (size_t)s1 * DM + 8 * lane + 512 * j); } }
#pragma unroll 1
    for (; m < NTOK; m += NGW) {
        float v[16];
#pragma unroll
        for (int j = 0; j < 2; ++j) { const u32x4 h = hn[j], a = an[j], c = cn[j];
            v[8 * j] = bflo(h.x) * DN_ALPHA + (bflo(a.x) + bflo(c.x)); v[8 * j + 1] = bfhi(h.x) * DN_ALPHA + (bfhi(a.x) + bfhi(c.x)); v[8 * j + 2] = bflo(h.y) * DN_ALPHA + (bflo(a.y) + bflo(c.y)); v[8 * j + 3] = bfhi(h.y) * DN_ALPHA + (bfhi(a.y) + bfhi(c.y));
            v[8 * j + 4] = bflo(h.z) * DN_ALPHA + (bflo(a.z) + bflo(c.z)); v[8 * j + 5] = bfhi(h.z) * DN_ALPHA + (bfhi(a.z) + bfhi(c.z)); v[8 * j + 6] = bflo(h.w) * DN_ALPHA + (bflo(a.w) + bflo(c.w)); v[8 * j + 7] = bfhi(h.w) * DN_ALPHA + (bfhi(a.w) + bfhi(c.w)); }
        const int mn = m + NGW;
        if (mn < NTOK) { const int s0 = ld_i32(SROW + 2 * mn), s1 = ld_i32(SROW + 2 * mn + 1);
#pragma unroll
            for (int j = 0; j < 2; ++j) { hn[j] = *(const GAS u32x4*)(HB + (size_t)mn * DM + 8 * lane + 512 * j); an[j] = *(const GAS u32x4*)(FF2 + (size_t)s0 * DM + 8 * lane + 512 * j); cn[j] = *(const GAS u32x4*)(FF2 + (size_t)s1 * DM + 8 * lane + 512 * j); } }
        float s = 0.f;
#pragma unroll
        for (int i = 0; i < 16; ++i) s += v[i];
        const float mean = wave_sum(s, lane) * (1.f / DM); float s2 = 0.f;
#pragma unroll
        for (int i = 0; i < 16; ++i) { v[i] -= mean; s2 += v[i] * v[i]; }
        const float rstd = 1.f / sqrtf(wave_sum(s2, lane) * (1.f / DM) + LN_EPS);
#pragma unroll
        for (int j = 0; j < 2; ++j) { const int c = 8 * lane + 512 * j; const f32x4 g0 = *(const GAS f32x4*)(g + c), g1 = *(const GAS f32x4*)(g + c + 4), b0 = *(const GAS f32x4*)(bb + c), b1 = *(const GAS f32x4*)(bb + c + 4);
#pragma unroll
            for (int i = 0; i < 4; ++i) { v[8 * j + i] = v[8 * j + i] * rstd * g0[i] + b0[i]; v[8 * j + 4 + i] = v[8 * j + 4 + i] * rstd * g1[i] + b1[i]; }
            if (last) { *(GAS f32x4*)(F.H + (size_t)m * DM + c) = (f32x4){v[8 * j], v[8 * j + 1], v[8 * j + 2], v[8 * j + 3]}; *(GAS f32x4*)(F.H + (size_t)m * DM + c + 4) = (f32x4){v[8 * j + 4], v[8 * j + 5], v[8 * j + 6], v[8 * j + 7]}; }
            else { u32x4 wv; wv.x = pk2(v[8 * j], v[8 * j + 1]); wv.y = pk2(v[8 * j + 2], v[8 * j + 3]); wv.z = pk2(v[8 * j + 4], v[8 * j + 5]); wv.w = pk2(v[8 * j + 6], v[8 * j + 7]); *(GAS u32x4*)(HB + (size_t)m * DM + c) = wv; } }
    }
}

#ifndef EN_P
#define EN_P 1
#endif
#ifndef EN_A
#define EN_A 1
#endif
#ifndef EN_B
#define EN_B 1
#endif
#ifndef EN_C
#define EN_C 1
#endif
#ifndef EN_D
#define EN_D 1
#endif
#ifndef EN_E
#define EN_E 1
#endif
#ifndef EN_F
#define EN_F 1
#endif
#ifndef EN_G
#define EN_G 1
#endif
#ifndef EN_H
#define EN_H 1
#endif
#ifndef EN_I
#define EN_I 1
#endif
#ifndef EN_J
#define EN_J 1
#endif
constexpr int PPL = 12;
constexpr int N_PHASES = 1 + PPL * DEPTH;
#ifndef MK_ONE_LAUNCH
#define MK_ONE_LAUNCH 0
#endif
struct Args { const float* in[28]; float* out; unsigned char* ws; int ph_lo, ph_hi; };
static_assert(sizeof(Args) == 28 * 8 + 8 + 8 + 8, "no padding bytes in the argument struct");


__device__ __forceinline__ unsigned opaque_u32(unsigned x) { asm volatile("" : "+v"(x)); return (unsigned)__builtin_amdgcn_readfirstlane((int)x); }
__device__ __forceinline__ unsigned long long opaque_u64(unsigned long long x) { return ((unsigned long long)opaque_u32((unsigned)(x >> 32)) << 32) | opaque_u32((unsigned)x); }
__device__ __forceinline__ void launder(Frame& F) {
    F.ws = (GAS unsigned char*)opaque_u64((unsigned long long)F.ws); F.H = (GAS float*)opaque_u64((unsigned long long)F.H);
    F.ctl = (gu32*)opaque_u64((unsigned long long)F.ctl);
    unsigned z0 = 0u; asm volatile("" : "+v"(z0)); int ln = (int)__builtin_amdgcn_mbcnt_hi(~0u, __builtin_amdgcn_mbcnt_lo(~0u, z0));
    F.wave = (int)opaque_u32((unsigned)F.wave); F.lane = ln; F.tid = F.wave * 64 + ln;
    F.G = (int)opaque_u32((unsigned)F.G); F.wg = (int)opaque_u32((unsigned)F.wg);
}
__global__ void __launch_bounds__(512, 2) mk_fwd(Args args) {
    extern __shared__ __attribute__((aligned(16))) unsigned char lds_raw[];
    Frame F;
    F.lds = (LAS unsigned char*)lds_raw;
    F.MISC = (volatile LAS unsigned*)(F.lds + MISC_OFF);
    F.tid = threadIdx.x; F.lane = F.tid & 63; F.wave = __builtin_amdgcn_readfirstlane(F.tid >> 6);
    F.G = gridDim.x; F.wg = blockIdx.x;
    F.in = args.in;
    F.pos = (const GAS int*)args.in[1];
    F.H = (GAS float*)args.out; F.ws = (GAS unsigned char*)args.ws;
    F.ctl = (gu32*)(args.ws + WS_CTL);
    for (int u = F.tid; u < (LDS_BYTES - MISC_OFF) / 4; u += 512) ((LAS unsigned*)(F.lds + MISC_OFF))[u] = 0u;
    __syncthreads();
    const int lo = args.ph_lo, hi = args.ph_hi;
    const bool multi = (hi - lo) > 1;
    XcdBarrier bar; bar.bar = (unsigned*)(F.ctl + CW_BAR); bar.x = 0; bar.st = nullptr;
    if (multi) bar = xcd_barrier_post((unsigned*)(F.ctl + CW_BAR), F.MISC + 8);
#define IN(k) (lo <= (k) && (k) < hi)
#define SEAM(k) do { if (IN(k) && IN((k) + 1)) xcd_barrier(bar); } while (0)

#ifdef DUP_P
    for (int rep = 0; rep < 2; ++rep)
#endif
    if (EN_P && IN(0)) { launder(F); phase_prologue(F); }
    SEAM(0);
#define HB ((GAS bf16*)(F.ws + WS_HB))
#define PA ((GAS bf16*)(F.ws + WS_PA))
#define Y ((GAS bf16*)(F.ws + WS_Y))
#define HM ((GAS bf16*)F.H + (size_t)NTOK * DM)
#define TT ((GAS bf16*)F.H)
    for (int l = 0; l < DEPTH; ++l) {
        const int pb = 1 + PPL * l;
#define wd (F.ws + WS_WDENSE + (size_t)l * WD_LAYER)
#ifdef DUP_A
        for (int rep = 0; rep < 2; ++rep)
#endif
        if (EN_A && IN(pb + 0)) { launder(F);
            DenseSched S; S.init(NTOK / 256, NPA / 256, F.G, F.wg, (const void*)HB, (size_t)256 * DM * 2, (const void*)(wd + WD_WA), (size_t)256 * DM * 2);
            EpiA E{PA, (GAS bf16*)(F.ws + WS_KA), (GAS bf16*)(F.ws + WS_VA), (GAS bf16*)(F.ws + WS_KI), (GAS float*)(F.ws + WS_WI), (GAS float*)(F.ws + WS_GLR), (const GAS float*)(F.ws + WS_ROPE), ((const GAS float*)F.in[5]) + l * 64};
            pg8::gemm_phase<EpiA, DenseSched, false>(F.lds, S, E, DM, DM, F.wave);
        }
        SEAM(pb + 0);
        if (EN_B && IN(pb + 1)) { launder(F); phase_mixer(F, l);
#ifdef DUP_B
            launder(F); phase_mixer(F, l, 1, DUP_B);
#endif
        }
        SEAM(pb + 1);
        if (EN_B && IN(pb + 2)) { launder(F); gla_scan_phase(F); }
        SEAM(pb + 2);
        if (EN_B && IN(pb + 3)) { launder(F); phase_gla_out(F, l); }
        SEAM(pb + 3);
#ifdef DUP_D
        for (int rep = 0; rep < 2; ++rep)
#endif
        if (EN_D && IN(pb + 4)) { launder(F);
            DenseSched S; S.init(NTOK / 256, DM / 256, F.G, F.wg, (const void*)Y, (size_t)256 * 1536 * 2, (const void*)(wd + WD_WBR), (size_t)256 * 512 * 2);
            S.nsub = 3; S.asub = 512 * 2; S.bsub = (size_t)1024 * 512 * 2;
            EpiP E{PA};
            pg8::gemm_phase<EpiP, DenseSched, false>(F.lds, S, E, 512, 1536, F.wave);
        }
        SEAM(pb + 4);
#ifdef DUP_C
        for (int rep = 0; rep < 2; ++rep)
#endif
        if (EN_C && IN(pb + 5)) { launder(F);
            DenseSched S; S.init(NTOK / 256, DM / 256, F.G, F.wg, (const void*)HB, (size_t)256 * DM * 2, (const void*)(wd + WD_WG), (size_t)256 * DM * 2);
            S.nsub = 3; S.asub = 0; S.bsub = (size_t)1024 * DM * 2;
            EpiGM E{PA, HM};
            pg8::gemm_phase<EpiGM, DenseSched, false>(F.lds, S, E, DM, DM, F.wave);
        }
        SEAM(pb + 5);
        if (EN_E && IN(pb + 6)) { launder(F);
            DenseSched S; S.init(NTOK / 256, DM / 256, F.G, F.wg, (const void*)HM, (size_t)256 * DM * 2, (const void*)(wd + WD_WOUT), (size_t)256 * DM * 2);
            EpiO E{HB, TT};
            pg8::gemm_phase<EpiO, DenseSched, false>(F.lds, S, E, DM, DM, F.wave);
        }
        SEAM(pb + 6);
        if (EN_F && IN(pb + 7)) { launder(F); phase_ln_router(F, l); }
        SEAM(pb + 7);
        if (EN_G && IN(pb + 8)) { launder(F);
            { LAS float* scr = (LAS float*)(F.lds + F.wave * 16384); const int gw = F.wg * 8 + F.wave, NGW = F.G * 8;
              for (int it = gw; it < 12288; it += NGW) conv_moe_item(F, l, it, scr);
              __syncthreads(); }
            phase_dispatch(F); }
        SEAM(pb + 8);
#ifdef DUP_H
        for (int rep = 0; rep < 2; ++rep)
#endif
        if (EN_H && IN(pb + 9)) { launder(F);
            const GAS int* META = (const GAS int*)(F.ws + WS_META); const GAS int* ROWMAP = (const GAS int*)(F.ws + WS_ROWMAP);
            const int NT = ld_i32(META), NU = NT * 2;
            LAS int* meta = (LAS int*)(F.lds + AUX_OFF); LAS int* rows = (LAS int*)(F.lds + AUX_OFF + 64);
            for (int i = 0; i * F.G + F.wg < NU && i < 8; ++i) { const int L = i * F.G + F.wg, gt = L >> 1;
                if (F.tid == 0) meta[i] = ld_i32(META + 16 + gt);
                if (F.tid < 256) rows[i * 256 + F.tid] = ROWMAP[gt * 256 + F.tid]; }
            __syncthreads();
            GroupSched S{NU, F.G, F.wg, 2, (const char*)HB, (const char*)(F.ws + WS_WMOE + WM_GU), 0, (size_t)512 * DM * 2, (size_t)256 * DM * 2, meta, rows};
            EpiGU E{(GAS bf16*)(F.ws + WS_HID), (const GAS float*)(F.ws + WS_CWROW)};
            pg8::gemm_phase<EpiGU, GroupSched, true>(F.lds, S, E, DM, DM, F.wave);
        }
        SEAM(pb + 9);
#ifdef DUP_I
        for (int rep = 0; rep < 2; ++rep)
#endif
        if (EN_I && IN(pb + 10)) { launder(F);
            const GAS int* META = (const GAS int*)(F.ws + WS_META);
            const int NT = ld_i32(META), NU = NT * 4;
            LAS int* meta = (LAS int*)(F.lds + AUX_OFF);
            for (int i = 0; i * F.G + F.wg < NU && i < 8; ++i) { const int L = i * F.G + F.wg, gt = L >> 2; if (F.tid == 0) meta[i] = ld_i32(META + 16 + gt); }
            __syncthreads();
            GroupSched S{NU, F.G, F.wg, 4, (const char*)(F.ws + WS_HID), (const char*)(F.ws + WS_WMOE + WM_DN), (size_t)256 * DEXP * 2, (size_t)DM * DEXP * 2, (size_t)256 * DEXP * 2, meta, nullptr};
            EpiDN E{(GAS bf16*)(F.ws + WS_FF2)};
            pg8::gemm_phase<EpiDN, GroupSched, false>(F.lds, S, E, DEXP, DEXP, F.wave);
        }
        SEAM(pb + 10);
        if (EN_J && IN(pb + 11)) { launder(F); phase_ln2(F, l); }
        SEAM(pb + 11);
    }
#undef IN
#undef SEAM
#undef HB
#undef HM
#undef TT
#undef PA
#undef Y
#undef wd
}


#ifdef DUMP_OFF
__global__ void dump_k(const unsigned short* src, float* out) {
    for (size_t i = (size_t)blockIdx.x * blockDim.x + threadIdx.x; i < (size_t)NTOK * 1024; i += (size_t)gridDim.x * blockDim.x) { const size_t n = i >> 10, c = i & 1023; out[i] = __builtin_bit_cast(float, ((unsigned)src[n * DUMP_PITCH + c]) << 16); }
}
#endif
extern "C" void kernel_launch(void* const* d_in, const int* in_sizes, int n_in, void* d_out, int out_size, void* d_ws, size_t ws_size, hipStream_t stream) {
    static int grid = 0;
    if (grid == 0) {
        if (n_in != 28 || out_size != NTOK * DM || ws_size < WS_END) { fprintf(stderr, "kernel_launch: unexpected shapes (n_in %d out %d ws %zu); nothing launched\n", n_in, out_size, ws_size); grid = -1; return; }
        int dev = 0, cus = 0;
        if (hipGetDevice(&dev) != hipSuccess || hipDeviceGetAttribute(&cus, hipDeviceAttributeMultiprocessorCount, dev) != hipSuccess) { grid = -1; return; }
        if (hipFuncSetAttribute((const void*)mk_fwd, hipFuncAttributeMaxDynamicSharedMemorySize, LDS_BYTES) != hipSuccess) { fprintf(stderr, "kernel_launch: hipFuncSetAttribute failed\n"); grid = -1; return; }
        int per_cu = 0;
        if (hipOccupancyMaxActiveBlocksPerMultiprocessor(&per_cu, (const void*)mk_fwd, 512, LDS_BYTES) != hipSuccess || per_cu < 1) { fprintf(stderr, "kernel_launch: occupancy query says %d\n", per_cu); }
        (void)hipGetLastError();
        grid = cus;
        if (grid != 256) fprintf(stderr, "kernel_launch: %d CUs (built for 256)\n", grid);
    }
    if (grid < 0) return;
    if (hipMemsetAsync((char*)d_ws + WS_CTL, 0, CTL_ZERO_BYTES, stream) != hipSuccess) return;
    Args a{};
    for (int i = 0; i < 28; ++i) a.in[i] = (const float*)d_in[i];
    a.out = (float*)d_out; a.ws = (unsigned char*)d_ws;
#if MK_ONE_LAUNCH
    a.ph_lo = 0; a.ph_hi = N_PHASES;
    hipLaunchKernelGGL(mk_fwd, dim3(grid), dim3(512), LDS_BYTES, stream, a);
#else
#ifndef STOP_AFTER
#define STOP_AFTER (N_PHASES - 1)
#endif
#ifndef PHASE_MASK
#define PHASE_MASK 0xffffffffu
#endif
    for (int p = 0; p <= STOP_AFTER; ++p) { if (!((PHASE_MASK >> p) & 1u)) continue; a.ph_lo = p; a.ph_hi = p + 1; hipLaunchKernelGGL(mk_fwd, dim3(grid), dim3(512), LDS_BYTES, stream, a); }
#ifdef DUMP_OFF
    hipLaunchKernelGGL(dump_k, dim3(2048), dim3(256), 0, stream, (const unsigned short*)((const char*)d_ws + (size_t)(DUMP_OFF)), (float*)d_out);
#endif
#endif
}
```

```cpp
#define MK_ONE_LAUNCH 1
#include <hip/hip_runtime.h>
#include <cstdio>
#include <cstdint>

#define LAS __attribute__((address_space(3)))
#define GAS __attribute__((address_space(1)))
typedef unsigned short bf16;
typedef short bf16x8 __attribute__((ext_vector_type(8)));
typedef float f32x4 __attribute__((ext_vector_type(4)));
typedef float f32x2 __attribute__((ext_vector_type(2)));
typedef unsigned u32x4 __attribute__((ext_vector_type(4)));
typedef unsigned u32x2 __attribute__((ext_vector_type(2)));
typedef GAS unsigned gu32;

constexpr int NB = 8, SEQ = 4096, NTOK = NB * SEQ, DM = 1024, NIN = 6612, DEPTH = 2;
constexpr int NPA = 3584;
constexpr int NGT = 3072;
constexpr int NEXP = 32, DEXP = 256;
constexpr int MAXTILES = 288;
constexpr float DN_ALPHA = 1.41421356237309515f;
constexpr float LN_EPS = 1e-5f, RMS_EPS = 1e-6f;
constexpr int PA_Q = 0, PA_QI = 768, PA_BQ = 1024, PA_BK = 1280, PA_BV = 1536, PA_BR = 2048, PA_CU = 2560, PA_CV = 3072;

__device__ __forceinline__ unsigned f2bf(float f) { unsigned u = __builtin_bit_cast(unsigned, f); return (u + 0x7fffu + ((u >> 16) & 1u)) >> 16; }
__device__ __forceinline__ unsigned pk2(float lo, float hi) { return f2bf(lo) | (f2bf(hi) << 16); }
__device__ __forceinline__ float bflo(unsigned w) { return __builtin_bit_cast(float, w << 16); }
__device__ __forceinline__ float bfhi(unsigned w) { return __builtin_bit_cast(float, w & 0xffff0000u); }
__device__ __forceinline__ float bf1(bf16 h) { return __builtin_bit_cast(float, ((unsigned)h) << 16); }
typedef __bf16 bf16x2_t __attribute__((ext_vector_type(2)));
__device__ __forceinline__ unsigned cvt_pk_bf16(float lo, float hi) { const f32x2 v = {lo, hi}; const bf16x2_t b = __builtin_convertvector(v, bf16x2_t); return __builtin_bit_cast(unsigned, b); }
__device__ __forceinline__ float shx(float v, int mask, int lane) { return __builtin_bit_cast(float, __builtin_amdgcn_ds_bpermute((lane ^ mask) << 2, __builtin_bit_cast(int, v))); }
__device__ __forceinline__ int shxi(int v, int mask, int lane) { return __builtin_amdgcn_ds_bpermute((lane ^ mask) << 2, v); }
__device__ __forceinline__ float wave_sum(float v, int lane) {
#pragma unroll
    for (int o = 1; o < 64; o <<= 1) v += shx(v, o, lane);
    return v;
}
__device__ __forceinline__ float wave_max(float v, int lane) {
#pragma unroll
    for (int o = 1; o < 64; o <<= 1) v = fmaxf(v, shx(v, o, lane));
    return v;
}
__device__ __forceinline__ int wave_sum_i(int v, int lane) {
#pragma unroll
    for (int o = 1; o < 64; o <<= 1) v += shxi(v, o, lane);
    return v;
}
__device__ __forceinline__ int fresh_lane() { unsigned z0 = 0u; asm volatile("" : "+v"(z0)); return (int)__builtin_amdgcn_mbcnt_hi(~0u, __builtin_amdgcn_mbcnt_lo(~0u, z0)); }
__device__ __forceinline__ int ld_i32(const GAS int* p) { return __hip_atomic_load(p, __ATOMIC_RELAXED, __HIP_MEMORY_SCOPE_AGENT); }
__device__ __forceinline__ float ld_f32(const GAS float* p) { return __hip_atomic_load(p, __ATOMIC_RELAXED, __HIP_MEMORY_SCOPE_AGENT); }
__device__ __forceinline__ float sigmoidf_(float x) { return __builtin_amdgcn_rcpf(1.0f + __expf(-x)); }
__device__ __forceinline__ float siluf_(float x) { return x * sigmoidf_(x); }
__device__ __forceinline__ float gelu_tanh_(float x) { const float u = 0.7978845608028654f * (x + 0.044715f * x * x * x); return x * sigmoidf_(2.0f * u); }

namespace pg8 {
constexpr int BM = 256, BK = 64, HALF = 128, HTB = HALF * BK * 2, STAGE_BYTES = 8 * HTB;
__host__ __device__ __forceinline__ int lds_byte(int r, int c) { const int st = (r >> 4) * 2 + (c >> 5), rr = r & 15, cc = c & 31, ob = rr * 64 + cc * 2; return st * 1024 + (ob ^ (((ob >> 9) & 1) << 5)); }
__host__ __device__ __forceinline__ void stage_rc(int b, int& R, int& C) { const int st = b / 1024, sb = b % 1024, swz = sb ^ (((sb >> 9) & 1) << 5); R = (st >> 1) * 16 + swz / 64; C = (st & 1) * 32 + (swz % 64) / 2; }
__host__ __device__ __forceinline__ int perm32(int rho) { const int n = rho >> 4, i = rho & 15; return 8 * (i >> 2) + 4 * n + (i & 3); }

struct Unit { int pm, pn, e, slot; };

template <class Epi, class Sched, bool GATHER>
__device__ __forceinline__ void gemm_phase(LAS unsigned char* lds, const Sched& S, const Epi& E, const int K, const int lda, const int wave) {
    unsigned z0_ = 0u; asm volatile("" : "+v"(z0_)); const int lane_ = (int)__builtin_amdgcn_mbcnt_hi(~0u, __builtin_amdgcn_mbcnt_lo(~0u, z0_));
    const int wid = wave, lane = lane_, tid = wid * 64 + lane, wr = wid >> 2, wc = wid & 3, fr = lane & 15, fq = lane >> 4;
    const int nt = K / BK;
    int Rr[2], Cc[2];
    unsigned voffB[2];
#pragma unroll
    for (int i = 0; i < 2; ++i) { int R, C; stage_rc(tid * 16 + i * 8192, R, C); Rr[i] = R; Cc[i] = C; const int Rb = Epi::PERM ? ((R & ~31) + perm32(R & 31)) : R; voffB[i] = (unsigned)(Rb * K + C) * 2u; }
    const size_t kstep = (size_t)(BK * 2);
    const size_t hstepB = (size_t)HALF * K * 2;
    const unsigned ldsw = (unsigned)wid * 1024u;
    const int aoff = lds_byte(wr * 64 + fr, fq * 8), boff = lds_byte(wc * 32 + fr, fq * 8);
#define PG8_SA(b, h) (((b) * 2 + (h)) * HTB)
#define PG8_SB(b, h) ((4 + (b) * 2 + (h)) * HTB)
#define PG8_STAGE(bufoff, gbase, voff) do { _Pragma("unroll") for (int _i = 0; _i < 2; ++_i) \
        __builtin_amdgcn_global_load_lds((const unsigned*)((const char*)(gbase) + (voff)[_i]), (LAS unsigned*)(lds + (bufoff) + ldsw + _i * 8192), 16, 0, 0); } while (0)
#define PG8_LDA(dst, b, h) do { _Pragma("unroll") for (int m = 0; m < 4; ++m) _Pragma("unroll") for (int k = 0; k < 2; ++k) dst[m][k] = *(const LAS bf16x8*)(lds + PG8_SA(b, h) + aoff + m * 2048 + k * 1024); } while (0)
#define PG8_LDB(dst, b, h) do { _Pragma("unroll") for (int n = 0; n < 2; ++n) _Pragma("unroll") for (int k = 0; k < 2; ++k) dst[n][k] = *(const LAS bf16x8*)(lds + PG8_SB(b, h) + boff + n * 2048 + k * 1024); } while (0)
#define PG8_MMA(ai, bj, At, Bt) do { __builtin_amdgcn_s_setprio(1); _Pragma("unroll") for (int m = 0; m < 4; ++m) _Pragma("unroll") for (int n = 0; n < 2; ++n) _Pragma("unroll") for (int k = 0; k < 2; ++k) \
        acc[ai][bj][m][n] = __builtin_amdgcn_mfma_f32_16x16x32_bf16(Bt[n][k], At[m][k], acc[ai][bj][m][n], 0, 0, 0); __builtin_amdgcn_s_setprio(0); } while (0)
#define PG8_WAIT_V(n) asm volatile("s_waitcnt vmcnt(" #n ")" ::: "memory")
#define PG8_WAIT_L(n) asm volatile("s_waitcnt lgkmcnt(" #n ")" ::: "memory")
#define PG8_BAR do { asm volatile("" ::: "memory"); __builtin_amdgcn_s_barrier(); asm volatile("" ::: "memory"); } while (0)
#define PG8_SCHED __builtin_amdgcn_sched_barrier(0)
    Unit cur, nxt; int ui = 0;
    if (!S.next(0, cur)) return;
    f32x4 acc[2][2][4][2];
#pragma unroll
    for (int a = 0; a < 2; ++a)
#pragma unroll
        for (int b = 0; b < 2; ++b)
#pragma unroll
            for (int m = 0; m < 4; ++m)
#pragma unroll
                for (int n = 0; n < 2; ++n) acc[a][b][m][n] = (f32x4){0.f, 0.f, 0.f, 0.f};
    bf16x8 At[4][2], B0[2][2], B1[2][2];
    unsigned cA0[2], cA1[2], nA0[2], nA1[2];
#pragma unroll
    for (int i = 0; i < 2; ++i) {
        if (GATHER) { cA0[i] = (unsigned)(S.row_of(cur, Rr[i]) * lda + Cc[i]) * 2u; cA1[i] = (unsigned)(S.row_of(cur, HALF + Rr[i]) * lda + Cc[i]) * 2u; }
        else { cA0[i] = (unsigned)(Rr[i] * lda + Cc[i]) * 2u; cA1[i] = (unsigned)((HALF + Rr[i]) * lda + Cc[i]) * 2u; }
        nA0[i] = cA0[i]; nA1[i] = cA1[i];
    }
    const char* cA = S.a_base(cur); const char* cB = S.b_base(cur);
    PG8_STAGE(PG8_SB(0, 0), cB, voffB); PG8_STAGE(PG8_SB(0, 1), cB + hstepB, voffB); PG8_STAGE(PG8_SA(0, 0), cA, cA0); PG8_STAGE(PG8_SA(0, 1), cA, cA1);
    if (wr == 1) PG8_BAR;
    PG8_WAIT_V(2); PG8_BAR;
    PG8_STAGE(PG8_SB(1, 0), cB + kstep, voffB); PG8_STAGE(PG8_SA(1, 0), cA + kstep, cA0); PG8_STAGE(PG8_SB(1, 1), cB + hstepB + kstep, voffB);
    PG8_WAIT_V(6); PG8_BAR;
    for (;;) {
        const bool has_next = S.next(ui + 1, nxt);
        const char* nA = has_next ? S.a_base(nxt) : cA; const char* nB = has_next ? S.b_base(nxt) : cB;
        if (GATHER) {
#pragma unroll
            for (int i = 0; i < 2; ++i) {
                if (has_next) { nA0[i] = (unsigned)(S.row_of(nxt, Rr[i]) * lda + Cc[i]) * 2u; nA1[i] = (unsigned)(S.row_of(nxt, HALF + Rr[i]) * lda + Cc[i]) * 2u; }
                else { nA0[i] = cA0[i]; nA1[i] = cA1[i]; }
            }
        }
#pragma unroll 1
        for (int t = 0; t < nt; t += 2) {
            const bool last = (t == nt - 2);
            const char* a1 = cA + (size_t)(t + 1) * kstep;
            const char* a2 = last ? nA : cA + (size_t)(t + 2) * kstep; const char* b2 = last ? nB : cB + (size_t)(t + 2) * kstep;
            const char* a3 = a2 + kstep; const char* b3 = b2 + kstep;
            unsigned x0[2], x1[2];
#pragma unroll
            for (int i = 0; i < 2; ++i) { x0[i] = (GATHER && last) ? nA0[i] : cA0[i]; x1[i] = (GATHER && last) ? nA1[i] : cA1[i]; }
            PG8_LDB(B0, 0, 0); PG8_LDB(B1, 0, 1); PG8_SCHED; PG8_LDA(At, 0, 0); PG8_STAGE(PG8_SA(1, 1), a1, cA1);
            PG8_WAIT_V(8); PG8_WAIT_L(0); PG8_BAR; PG8_MMA(0, 0, At, B0); PG8_MMA(0, 1, At, B1); PG8_BAR; PG8_SCHED;
            PG8_LDA(At, 0, 1); PG8_STAGE(PG8_SB(0, 0), b2, voffB); PG8_STAGE(PG8_SB(0, 1), b2 + hstepB, voffB); PG8_STAGE(PG8_SA(0, 0), a2, x0);
            PG8_WAIT_V(8); PG8_WAIT_L(0); PG8_BAR; PG8_MMA(1, 0, At, B0); PG8_MMA(1, 1, At, B1); PG8_BAR; PG8_SCHED;
            PG8_LDB(B0, 1, 0); PG8_LDB(B1, 1, 1); PG8_SCHED; PG8_LDA(At, 1, 0); PG8_STAGE(PG8_SA(0, 1), a2, x1);
            PG8_WAIT_V(8); PG8_WAIT_L(0); PG8_BAR; PG8_MMA(0, 0, At, B0); PG8_MMA(0, 1, At, B1); PG8_BAR; PG8_SCHED;
            PG8_LDA(At, 1, 1); PG8_STAGE(PG8_SB(1, 0), b3, voffB); PG8_STAGE(PG8_SB(1, 1), b3 + hstepB, voffB); PG8_STAGE(PG8_SA(1, 0), a3, x0);
            PG8_WAIT_V(8); PG8_WAIT_L(0); PG8_BAR; PG8_MMA(1, 0, At, B0); PG8_MMA(1, 1, At, B1); PG8_BAR; PG8_SCHED;
        }
        if (wr == 0) PG8_BAR;
        E(acc, cur, wr, wc, fr, fq);
        if (!has_next) break;
#pragma unroll
        for (int a = 0; a < 2; ++a)
#pragma unroll
            for (int b = 0; b < 2; ++b)
#pragma unroll
                for (int m = 0; m < 4; ++m)
#pragma unroll
                    for (int n = 0; n < 2; ++n) acc[a][b][m][n] = (f32x4){0.f, 0.f, 0.f, 0.f};
        cur = nxt; cA = nA; cB = nB; ++ui;
#pragma unroll
        for (int i = 0; i < 2; ++i) { cA0[i] = nA0[i]; cA1[i] = nA1[i]; }
        if (wr == 1) PG8_BAR;
    }
    PG8_WAIT_V(0);
    PG8_BAR;
#undef PG8_SA
#undef PG8_SB
#undef PG8_STAGE
#undef PG8_LDA
#undef PG8_LDB
#undef PG8_MMA
#undef PG8_WAIT_V
#undef PG8_WAIT_L
#undef PG8_BAR
#undef PG8_SCHED
}
}

#define XB_TMO      128
#define XB_XCNT(j)  (256  + 64 * (j))
#define XB_XSUB(j)  (1280 + 64 * (j))
#define XB_XGEN(j)  (2304 + 64 * (j))
#define XB_TOP      3328
#define XB_TOPGEN   3392
#define XCD_BAR_WORDS 3456
#define XB_SPIN_CAP (1u << 20)

__device__ __forceinline__ unsigned xb_ld(unsigned* p)              { return __hip_atomic_load(p, __ATOMIC_RELAXED, __HIP_MEMORY_SCOPE_AGENT); }
__device__ __forceinline__ unsigned xb_add(unsigned* p, unsigned v) { return __hip_atomic_fetch_add(p, v, __ATOMIC_RELAXED, __HIP_MEMORY_SCOPE_AGENT); }
__device__ __forceinline__ unsigned xb_xcc_id() { return (unsigned)__builtin_amdgcn_s_getreg((3 << 11) | 20) & 0xFu; }
#define XB_SPIN(cond, bar) do { unsigned _sp = 0; while (cond) { __builtin_amdgcn_s_sleep(1); \
    if ((++_sp & 255u) == 0u) { if (xb_ld(&(bar)[XB_TMO])) break; if (_sp > XB_SPIN_CAP) { atomicAdd(&(bar)[XB_TMO], 1u); break; } } } } while (0)

struct XcdBarrier { unsigned* bar; unsigned x; volatile LAS unsigned* st; };

__device__ __forceinline__ XcdBarrier xcd_barrier_post(unsigned* bar, volatile LAS unsigned* st) {
    XcdBarrier b; b.bar = bar; b.x = xb_xcc_id(); b.st = st;
    if (threadIdx.x == 0) (void)xb_add(&bar[XB_XCNT(b.x)], 1u);
    return b;
}
__device__ __forceinline__ void xcd_barrier_complete(unsigned* bar, unsigned x, unsigned& nloc, unsigned& nx) {
    const unsigned G = gridDim.x * gridDim.y * gridDim.z;
    unsigned sum, cnt, mine, sp = 0u;
    for (;;) {
        sum = 0u; cnt = 0u; mine = 0u;
#pragma unroll
        for (unsigned j = 0; j < 16; ++j) { const unsigned c = xb_ld(&bar[XB_XCNT(j)]); sum += c; cnt += (c > 0u) ? 1u : 0u; mine = (j == x) ? c : mine; }
        if (sum == G) break;
        __builtin_amdgcn_s_sleep(1);
        if ((++sp & 255u) == 0u) { if (xb_ld(&bar[XB_TMO])) break; if (sp > XB_SPIN_CAP) { atomicAdd(&bar[XB_TMO], 1u); break; } }
    }
    nloc = mine > 0u ? mine : 1u; nx = cnt > 0u ? cnt : 1u;
}
__device__ __forceinline__ void xcd_barrier(const XcdBarrier& b) {
    asm volatile("s_waitcnt vmcnt(0)" ::: "memory");
    __syncthreads();
    if (threadIdx.x == 0) {
        unsigned* bar = b.bar;
        __builtin_amdgcn_s_waitcnt(0);
        unsigned nloc = b.st[0], nx = b.st[1];
        if (nloc == 0u) { xcd_barrier_complete(bar, b.x, nloc, nx); b.st[0] = nloc; b.st[1] = nx; }
        const unsigned old = xb_add(&bar[XB_XSUB(b.x)], 1u);
        const unsigned gen = old / nloc;
        if (old + 1u == (gen + 1u) * nloc) {
            __builtin_amdgcn_fence(__ATOMIC_RELEASE, "agent");
            asm volatile("s_waitcnt vmcnt(0)" ::: "memory");
            const unsigned og = xb_add(&bar[XB_TOP], 1u);
            const unsigned tg = og / nx;
            if (og + 1u == (tg + 1u) * nx) xb_add(&bar[XB_TOPGEN], 1u);
            else XB_SPIN(xb_ld(&bar[XB_TOPGEN]) == tg, bar);
            __builtin_amdgcn_fence(__ATOMIC_ACQUIRE, "agent");
            xb_add(&bar[XB_XGEN(b.x)], 1u);
            asm volatile("s_waitcnt vmcnt(0)" ::: "memory");
        } else {
            XB_SPIN(xb_ld(&bar[XB_XGEN(b.x)]) == gen, bar);
            __builtin_amdgcn_fence(__ATOMIC_ACQUIRE, "agent");
            asm volatile("s_waitcnt vmcnt(0)" ::: "memory");
        }
    }
    __syncthreads();
}

constexpr size_t MiB = 1u << 20;
constexpr size_t WS_CTL = 0, CTL_ZERO_BYTES = 1 * MiB;
constexpr size_t WS_ROPE = 1 * MiB;
constexpr size_t WS_WI   = 3 * MiB;
constexpr size_t WS_ROUTE = 3 * MiB + 512 * 1024;
constexpr size_t WS_SROW = 4 * MiB;
constexpr size_t WS_ROWMAP = 4 * MiB + 256 * 1024;
constexpr size_t WS_CWROW = 4 * MiB + 640 * 1024;
constexpr size_t WS_CNTWG = 5 * MiB;
constexpr size_t WS_META = 5 * MiB + 64 * 1024;
constexpr size_t WS_WR = 5 * MiB + 128 * 1024;
constexpr size_t WS_GLR = 6 * MiB;
constexpr size_t WS_WDENSE = 8 * MiB;
constexpr size_t WD_WA = 0, WD_WG = 7 * MiB, WD_WBR = 13 * MiB, WD_WOUT = 16 * MiB, WD_LAYER = 18 * MiB;
constexpr size_t WS_WMOE = 44 * MiB;
constexpr size_t WM_GU = 0, WM_DN = 32 * MiB;
constexpr size_t WS_HB = 92 * MiB;
constexpr size_t WS_PA = 156 * MiB;
constexpr size_t WS_HID = WS_PA;
constexpr size_t WS_FF2 = WS_PA + 40 * MiB;
constexpr size_t WS_Y = 380 * MiB;
constexpr size_t WS_KA = 476 * MiB, WS_VA = 480 * MiB, WS_KI = 484 * MiB;
constexpr size_t WS_END = 512 * MiB;
static_assert(WS_WDENSE + 2 * WD_LAYER <= WS_WMOE && WS_WMOE + 48 * MiB <= WS_HB && WS_HB + 64 * MiB <= WS_PA && WS_PA + 224 * MiB <= WS_Y && WS_Y + 96 * MiB <= WS_KA && WS_KI + 4 * MiB <= WS_END, "ws map");
static_assert(WS_FF2 + (size_t)73728 * 1024 * 2 <= WS_Y, "ff2 fits");
constexpr int CW_BAR = 4096;
constexpr int CW_QUEUE = 16384;

constexpr int RING_BYTES = 131072;
constexpr int AUX_OFF = 131072;
constexpr int MISC_OFF = 147456;
constexpr int LDS_BYTES = 148480;

struct Frame {
    LAS unsigned char* lds;
    volatile LAS unsigned* MISC;
    gu32* ctl;
    int tid, lane, wave, G, wg;
    const float* const* in;
    const GAS int* pos;
    GAS float* H;
    GAS unsigned char* ws;
};

#define LDS_WAIT() asm volatile("s_waitcnt lgkmcnt(0)" ::: "memory")
#define VM_WAIT() asm volatile("s_waitcnt vmcnt(0)" ::: "memory")

__device__ __forceinline__ int pa_src_col(int c) {
    if (c < 512) return c;
    if (c < 768) { const int x = c - 512, half = x >> 7, y = x & 127, grp = y >> 5, d = (y & 31) + 32 * half;
        if (grp == 0) return 512 + d;
        if (grp == 1) return 576 + d;
        if (grp == 2) return 896 + d;
        if (half == 0) { const int z = y - 96; if (z < 4) return 960 + z; if (z < 20) return 1988 + (z - 4); }
        return -1; }
    if (c < 1024) return 640 + (c - 768);
    if (c < 1280) return 964 + (c - 1024);
    if (c < 1536) return 1220 + (c - 1280);
    if (c < 2048) return 1476 + (c - 1536);
    if (c < 2560) return 2004 + (c - 2048);
    return 2516 + (c - 2560);
}
__device__ __forceinline__ void transpose_item(const GAS float* W, int ldw, int K, GAS bf16* WT, int n0, int k0, int sc, LAS float* scr, int lane) {
#pragma unroll 8
    for (int i = 0; i < 32; ++i) { const int kk = 2 * i + (lane >> 5); scr[kk * 33 + (lane & 31)] = (sc >= 0) ? W[(size_t)(k0 + kk) * ldw + sc] : 0.f; }
    LDS_WAIT(); asm volatile("" ::: "memory");
    const int c = lane & 7;
#pragma unroll
    for (int j = 0; j < 4; ++j) { const int n = (lane >> 3) + 8 * j; const LAS float* s = scr + (8 * c) * 33 + n;
        u32x4 o; o.x = pk2(s[0 * 33], s[1 * 33]); o.y = pk2(s[2 * 33], s[3 * 33]); o.z = pk2(s[4 * 33], s[5 * 33]); o.w = pk2(s[6 * 33], s[7 * 33]);
        *(GAS u32x4*)(WT + (size_t)(n0 + n) * K + k0 + 8 * c) = o; }
    LDS_WAIT(); asm volatile("" ::: "memory");
}
__device__ __forceinline__ void conv_dense_item(Frame& F, int l, int it, LAS float* scr) {
    GAS bf16* base = (GAS bf16*)(F.ws + WS_WDENSE + (size_t)l * WD_LAYER);
    const int lane = F.lane;
    if (it < 1792) { const int kb = it / 112, nb = it % 112; const int sc = pa_src_col(32 * nb + (lane & 31));
        transpose_item(((const GAS float*)F.in[4]) + (size_t)l * DM * NIN, NIN, DM, base + WD_WA / 2, 32 * nb, 64 * kb, sc, scr, lane); return; }
    it -= 1792;
    if (it < 1536) { const int kb = it / 96, nb = it % 96; const int sc = 3540 + 32 * nb + (lane & 31);
        transpose_item(((const GAS float*)F.in[4]) + (size_t)l * DM * NIN, NIN, DM, base + WD_WG / 2, 32 * nb, 64 * kb, sc, scr, lane); return; }
    it -= 1536;
    if (it < 768) { const int br = it / 256, r = it % 256, kb = r / 32, nb = r % 32; const int sc = 32 * nb + (lane & 31);
        transpose_item((br == 0 ? ((const GAS float*)F.in[13]) : br == 1 ? ((const GAS float*)F.in[14]) : ((const GAS float*)F.in[15])) + (size_t)l * 512 * DM, DM, 512, base + WD_WBR / 2 + (size_t)br * 1024 * 512, 32 * nb, 64 * kb, sc, scr, lane); return; }
    it -= 768;
    { const int kb = it / 32, nb = it % 32; const int sc = 32 * nb + (lane & 31);
        transpose_item(((const GAS float*)F.in[16]) + (size_t)l * DM * DM, DM, DM, base + WD_WOUT / 2, 32 * nb, 64 * kb, sc, scr, lane); }
}
__device__ __forceinline__ void conv_moe_item(Frame& F, int l, int it, LAS float* scr) {
    const int lane = F.lane; const int e = it / 384; int r = it % 384;
    if (r < 256) { const int sub = r / 64, q = r % 64, ct = sub >> 1, bj = sub & 1, kb = q / 4, nb = q % 4;
        const GAS float* src = (bj ? ((const GAS float*)F.in[24]) : ((const GAS float*)F.in[23])) + (size_t)(l * NEXP + e) * DM * DEXP;
        GAS bf16* dst = (GAS bf16*)(F.ws + WS_WMOE + WM_GU) + (size_t)e * 512 * DM;
        transpose_item(src, DEXP, DM, dst, 256 * ct + 128 * bj + 32 * nb, 64 * kb, 128 * ct + 32 * nb + (lane & 31), scr, lane); return; }
    r -= 256;
    { const int kb = r / 32, nb = r % 32;
        const GAS float* src = ((const GAS float*)F.in[25]) + (size_t)(l * NEXP + e) * DEXP * DM;
        GAS bf16* dst = (GAS bf16*)(F.ws + WS_WMOE + WM_DN) + (size_t)e * DM * DEXP;
        transpose_item(src, DM, DEXP, dst, 32 * nb, 64 * kb, 32 * nb + (lane & 31), scr, lane); }
}

__device__ __forceinline__ void ln_row_regs(f32x4 (&v)[4], const GAS float* g, const GAS float* b, int lane) {
    float s = 0.f;
#pragma unroll
    for (int j = 0; j < 4; ++j) s += (v[j].x + v[j].y) + (v[j].z + v[j].w);
    const float mean = wave_sum(s, lane) * (1.f / DM); float s2 = 0.f;
#pragma unroll
    for (int j = 0; j < 4; ++j) { v[j] = v[j] - mean; s2 += (v[j].x * v[j].x + v[j].y * v[j].y) + (v[j].z * v[j].z + v[j].w * v[j].w); }
    const float rstd = 1.f / sqrtf(wave_sum(s2, lane) * (1.f / DM) + LN_EPS);
#pragma unroll
    for (int j = 0; j < 4; ++j) { const f32x4 gg = *(const GAS f32x4*)(g + 4 * lane + 256 * j), bb = *(const GAS f32x4*)(b + 4 * lane + 256 * j); v[j] = v[j] * rstd * gg + bb; }
}
__device__ __forceinline__ void store_row_f32_bf16(const f32x4 (&v)[4], GAS float* hrow, GAS bf16* brow, int lane) {
#pragma unroll
    for (int j = 0; j < 4; ++j) {
        if (hrow) *(GAS f32x4*)(hrow + 4 * lane + 256 * j) = v[j];
        if (brow) { u32x2 w; w.x = pk2(v[j].x, v[j].y); w.y = pk2(v[j].z, v[j].w); *(GAS u32x2*)(brow + 4 * lane + 256 * j) = w; }
    }
}

__device__ __forceinline__ void phase_prologue(Frame& F) {
    LAS float* scr = (LAS float*)(F.lds + F.wave * 16384);
    const int gw = F.wg * 8 + F.wave, NGW = F.G * 8;
    for (int it = gw; it < 2 * 4608; it += NGW) conv_dense_item(F, it / 4608, it % 4608, scr);
    { GAS float* WR = (GAS float*)(F.ws + WS_WR);
      for (int i = gw * 64 + F.lane; i < DEPTH * 36 * DM; i += NGW * 64) { const int l = i / (36 * DM), r = i % (36 * DM), o = r / DM, k = r % DM;
          WR[i] = (o < 4) ? ((const GAS float*)F.in[19])[(size_t)l * DM * 4 + k * 4 + o] : ((const GAS float*)F.in[21])[(size_t)l * DM * 32 + k * 32 + (o - 4)]; } }
    { GAS float* RT = (GAS float*)(F.ws + WS_ROPE);
      for (int i = gw * 64 + F.lane; i < NTOK * 8; i += NGW * 64) { const int n = i >> 3, j = i & 7;
          const float invf[8] = {1.000000000e+00f, 1.939227432e-01f, 3.760603070e-02f, 7.292664610e-03f, 1.414213562e-03f, 2.742481884e-04f, 5.318295734e-05f, 1.031338525e-05f};
          float inv = invf[0];
#pragma unroll
          for (int q = 1; q < 8; ++q) inv = (j == q) ? invf[q] : inv;
          const float ang = (float)F.pos[n] * inv;
          const double kq = __builtin_rint((double)ang * 0.15915494309189535);
          double r = (double)ang - kq * 6.283185307179586; double csign = 1.0;
          if (r > 1.5707963267948966) { r = 3.141592653589793 - r; csign = -1.0; } else if (r < -1.5707963267948966) { r = -3.141592653589793 - r; csign = -1.0; }
          const double x2 = r * r;
          const double sn = r * (1.0 + x2 * (-1.0 / 6 + x2 * (1.0 / 120 + x2 * (-1.0 / 5040 + x2 * (1.0 / 362880 + x2 * (-1.0 / 39916800 + x2 * (1.0 / 6227020800.0 + x2 * (-1.0 / 1307674368000.0))))))));
          const double cs = 1.0 + x2 * (-0.5 + x2 * (1.0 / 24 + x2 * (-1.0 / 720 + x2 * (1.0 / 40320 + x2 * (-1.0 / 3628800 + x2 * (1.0 / 479001600.0 + x2 * (-1.0 / 87178291200.0 + x2 * (1.0 / 20922789888000.0))))))));
          RT[n * 16 + j] = (float)(csign * cs); RT[n * 16 + 8 + j] = (float)sn; } }
    GAS bf16* HB = (GAS bf16*)(F.ws + WS_HB);
    for (int m = gw; m < NTOK; m += NGW) { f32x4 v[4];
#pragma unroll
        for (int j = 0; j < 4; ++j) v[j] = *(const GAS f32x4*)(((const GAS float*)F.in[0]) + (size_t)m * DM + 4 * F.lane + 256 * j);
        ln_row_regs(v, ((const GAS float*)F.in[2]), ((const GAS float*)F.in[3]), F.lane);
        store_row_f32_bf16(v, (GAS float*)nullptr, HB + (size_t)m * DM, F.lane); }
}

struct DenseSched {
    int nM, nN, nwg, G, c; const char* A; const char* B; size_t atile, btile; int nsub = 1; size_t asub = 0, bsub = 0;
    __device__ void init(int nM_, int nN_, int G_, int c_, const void* A_, size_t atile_, const void* B_, size_t btile_) { nM = nM_; nN = nN_; nwg = nM * nN; G = G_; c = c_; A = (const char*)A_; B = (const char*)B_; atile = atile_; btile = btile_; }
    __device__ __forceinline__ bool next(int i, pg8::Unit& u) const {
        const int it = i / nsub, sb = i - it * nsub;
        const long L = (long)it * G + c; if (L >= nwg) return false;
        int wgid = (int)L; { const int q = nwg / 8, r = nwg % 8, xcd = wgid % 8, off = wgid / 8; wgid = (xcd < r ? xcd * (q + 1) : r * (q + 1) + (xcd - r) * q) + off; }
        const int nig = 8 * nN, gid = wgid / nig, fm = gid * 8, gsz = (nM - fm) < 8 ? (nM - fm) : 8;
        u.pm = fm + ((wgid % nig) % gsz); u.pn = (wgid % nig) / gsz; u.e = sb; u.slot = i; return true;
    }
    __device__ __forceinline__ const char* a_base(const pg8::Unit& u) const { return A + (size_t)u.pm * atile + (size_t)u.e * asub; }
    __device__ __forceinline__ const char* b_base(const pg8::Unit& u) const { return B + (size_t)u.pn * btile + (size_t)u.e * bsub; }
    __device__ __forceinline__ int row_of(const pg8::Unit&, int) const { return 0; }
};
struct GroupSched {
    int NU, G, c, ncol; const char* A; const char* B; size_t atile, erows_bytes, btile; const LAS int* meta; const LAS int* rows;
    __device__ __forceinline__ bool next(int i, pg8::Unit& u) const {
        const int L = i * G + c; if (L >= NU) return false;
        u.pm = L / ncol; u.pn = L % ncol; u.slot = i; u.e = meta[i]; return true;
    }
    __device__ __forceinline__ const char* a_base(const pg8::Unit& u) const { return A + (size_t)u.pm * atile; }
    __device__ __forceinline__ const char* b_base(const pg8::Unit& u) const { return B + (size_t)u.e * erows_bytes + (size_t)u.pn * btile; }
    __device__ __forceinline__ int row_of(const pg8::Unit& u, int r) const { return rows[u.slot * 256 + r]; }
};

struct EpiA {
    static constexpr bool PERM = true;
    GAS bf16* PA; GAS bf16* KA; GAS bf16* VA; GAS bf16* KI; GAS float* WI; GAS float* GLR; const GAS float* ROPE; const GAS float* ikg;
    __device__ __forceinline__ static void rope8(float (&x)[8], const GAS float* rt, int fq, int lane) {
        const f32x4 c0 = *(const GAS f32x4*)(rt), c1 = *(const GAS f32x4*)(rt + 4), s0 = *(const GAS f32x4*)(rt + 8), s1 = *(const GAS f32x4*)(rt + 12);
#pragma unroll
        for (int i = 0; i < 8; ++i) { const float p = shx(x[i], 16, lane); const float cc = (i < 4) ? c0[i & 3] : c1[i & 3], ss = (i < 4) ? s0[i & 3] : s1[i & 3];
            const float r = x[i] * cc + ((fq == 0) ? -p : p) * ss; x[i] = (fq < 2) ? r : x[i]; }
    }
    __device__ __forceinline__ static u32x4 pack8(const float (&x)[8]) { u32x4 w; w.x = cvt_pk_bf16(x[0], x[1]); w.y = cvt_pk_bf16(x[2], x[3]); w.z = cvt_pk_bf16(x[4], x[5]); w.w = cvt_pk_bf16(x[6], x[7]); return w; }
    __device__ __forceinline__ void operator()(const f32x4 (&acc)[2][2][4][2], const pg8::Unit& u, int wr, int wc, int fr, int fq) const {
        const int pn = u.pn; const int rowb = u.pm * 256 + wr * 64 + fr; const int lane = fq * 16 + fr;
        if (pn == 2) {
#pragma unroll
            for (int ai = 0; ai < 2; ++ai)
#pragma unroll
                for (int m = 0; m < 4; ++m) {
                    const int row = rowb + ai * 128 + m * 16;
                    float x0[8], x1[8];
#pragma unroll
                    for (int i = 0; i < 8; ++i) { x0[i] = acc[ai][0][m][i >> 2][i & 3]; x1[i] = acc[ai][1][m][i >> 2][i & 3]; }
                    if (wc == 2) {
                        float s = 0.f;
#pragma unroll
                        for (int i = 0; i < 8; ++i) s += x0[i] + x1[i];
                        s += shx(s, 16, lane); s += shx(s, 32, lane);
                        const float mean = s * (1.f / 64.f); float q = 0.f;
#pragma unroll
                        for (int i = 0; i < 8; ++i) { x0[i] -= mean; x1[i] -= mean; q += x0[i] * x0[i] + x1[i] * x1[i]; }
                        q += shx(q, 16, lane); q += shx(q, 32, lane);
                        const float rstd = 1.f / sqrtf(q * (1.f / 64.f) + LN_EPS);
#pragma unroll
                        for (int i = 0; i < 8; ++i) { x0[i] = x0[i] * rstd * ikg[8 * fq + i]; x1[i] = x1[i] * rstd * ikg[32 + 8 * fq + i]; }
                    }
                    if (wc == 0 || wc == 2) rope8(x0, ROPE + (size_t)row * 16, fq, lane);
                    if (wc < 3) {
                        GAS bf16* dst = (wc == 0) ? KA : (wc == 1) ? VA : KI;
                        *(GAS u32x4*)(dst + (size_t)row * 64 + 8 * fq) = pack8(x0); *(GAS u32x4*)(dst + (size_t)row * 64 + 32 + 8 * fq) = pack8(x1);
                    } else {
                        if (fq == 0) { *(GAS f32x4*)(WI + (size_t)row * 4) = (f32x4){x0[0], x0[1], x0[2], x0[3]} * 0.0625f; *(GAS f32x4*)(GLR + (size_t)row * 16) = (f32x4){x0[4], x0[5], x0[6], x0[7]}; }
                        else if (fq == 1) { *(GAS f32x4*)(GLR + (size_t)row * 16 + 4) = (f32x4){x0[0], x0[1], x0[2], x0[3]}; *(GAS f32x4*)(GLR + (size_t)row * 16 + 8) = (f32x4){x0[4], x0[5], x0[6], x0[7]}; }
                        else if (fq == 2) { *(GAS f32x4*)(GLR + (size_t)row * 16 + 12) = (f32x4){x0[0], x0[1], x0[2], x0[3]}; }
                    }
                    asm volatile("" ::: "memory");
                }
        } else if (pn < 2 || pn == 3) {
            const float sc = (pn == 3) ? 1.0f : 0.125f; const bool rope = !(wc & 1);
#pragma unroll
            for (int ai = 0; ai < 2; ++ai)
#pragma unroll
                for (int m = 0; m < 4; ++m) {
                    const int row = rowb + ai * 128 + m * 16;
#pragma unroll
                    for (int bj = 0; bj < 2; ++bj) { float x[8];
#pragma unroll
                        for (int i = 0; i < 8; ++i) x[i] = acc[ai][bj][m][i >> 2][i & 3];
                        if (rope) rope8(x, ROPE + (size_t)row * 16, fq, lane);
#pragma unroll
                        for (int i = 0; i < 8; ++i) x[i] *= sc;
                        *(GAS u32x4*)(PA + (size_t)row * NPA + 256 * pn + 128 * bj + 32 * wc + 8 * fq) = pack8(x); }
                    asm volatile("" ::: "memory");
                }
        } else {
            const int act = (pn == 8 || pn == 9) ? 1 : (pn >= 10) ? 2 : 0; const float sc = (pn == 4) ? 0.125f : 1.0f;
#pragma unroll
            for (int ai = 0; ai < 2; ++ai)
#pragma unroll
                for (int m = 0; m < 4; ++m) {
                    const int row = rowb + ai * 128 + m * 16;
#pragma unroll
                    for (int bj = 0; bj < 2; ++bj) { float x[8];
#pragma unroll
                        for (int i = 0; i < 8; ++i) { const float v = acc[ai][bj][m][i >> 2][i & 3]; x[i] = (act == 1) ? siluf_(v) : (act == 2) ? gelu_tanh_(v) : v * sc; }
                        *(GAS u32x4*)(PA + (size_t)row * NPA + 256 * pn + 128 * bj + 32 * wc + 8 * fq) = pack8(x); }
                    asm volatile("" ::: "memory");
                }
        }
    }
};
struct EpiP {
    static constexpr bool PERM = true;
    GAS bf16* P;
    __device__ __forceinline__ void operator()(const f32x4 (&acc)[2][2][4][2], const pg8::Unit& u, int wr, int wc, int fr, int fq) const {
        const int rowb = u.pm * 256 + wr * 64 + fr; GAS bf16* Pb = P + (size_t)u.e * NTOK * DM;
#pragma unroll
        for (int ai = 0; ai < 2; ++ai)
#pragma unroll
            for (int m = 0; m < 4; ++m) { const int row = rowb + ai * 128 + m * 16;
#pragma unroll
                for (int bj = 0; bj < 2; ++bj) { u32x4 w; w.x = cvt_pk_bf16(acc[ai][bj][m][0][0], acc[ai][bj][m][0][1]); w.y = cvt_pk_bf16(acc[ai][bj][m][0][2], acc[ai][bj][m][0][3]);
                    w.z = cvt_pk_bf16(acc[ai][bj][m][1][0], acc[ai][bj][m][1][1]); w.w = cvt_pk_bf16(acc[ai][bj][m][1][2], acc[ai][bj][m][1][3]);
                    *(GAS u32x4*)(Pb + (size_t)row * DM + 256 * u.pn + 128 * bj + 32 * wc + 8 * fq) = w; } }
    }
};
struct EpiGM {
    static constexpr bool PERM = true;
    const GAS bf16* P; GAS bf16* HM;
    __device__ __forceinline__ void operator()(const f32x4 (&acc)[2][2][4][2], const pg8::Unit& u, int wr, int wc, int fr, int fq) const {
        const int rowb = u.pm * 256 + wr * 64 + fr; const int br = u.e; const GAS bf16* Pb = P + (size_t)br * NTOK * DM;
        const int colb = 256 * u.pn + 32 * wc + 8 * fq;
#pragma unroll
        for (int ai = 0; ai < 2; ++ai) {
            u32x4 pv[4][2], ov[4][2];
#pragma unroll
            for (int m = 0; m < 4; ++m)
#pragma unroll
                for (int bj = 0; bj < 2; ++bj) { const size_t off = (size_t)(rowb + ai * 128 + m * 16) * DM + colb + 128 * bj;
                    pv[m][bj] = *(const GAS u32x4*)(Pb + off); ov[m][bj] = (br > 0) ? *(const GAS u32x4*)(HM + off) : (u32x4){0u, 0u, 0u, 0u}; }
            __builtin_amdgcn_sched_barrier(0);
#pragma unroll
            for (int m = 0; m < 4; ++m)
#pragma unroll
                for (int bj = 0; bj < 2; ++bj) { const size_t off = (size_t)(rowb + ai * 128 + m * 16) * DM + colb + 128 * bj;
                    const u32x4 p = pv[m][bj], o = ov[m][bj];
                    float x[8];
                    x[0] = bflo(p.x) * sigmoidf_(acc[ai][bj][m][0][0]) + bflo(o.x); x[1] = bfhi(p.x) * sigmoidf_(acc[ai][bj][m][0][1]) + bfhi(o.x); x[2] = bflo(p.y) * sigmoidf_(acc[ai][bj][m][0][2]) + bflo(o.y); x[3] = bfhi(p.y) * sigmoidf_(acc[ai][bj][m][0][3]) + bfhi(o.y);
                    x[4] = bflo(p.z) * sigmoidf_(acc[ai][bj][m][1][0]) + bflo(o.z); x[5] = bfhi(p.z) * sigmoidf_(acc[ai][bj][m][1][1]) + bfhi(o.z); x[6] = bflo(p.w) * sigmoidf_(acc[ai][bj][m][1][2]) + bflo(o.w); x[7] = bfhi(p.w) * sigmoidf_(acc[ai][bj][m][1][3]) + bfhi(o.w);
                    u32x4 w; w.x = cvt_pk_bf16(x[0], x[1]); w.y = cvt_pk_bf16(x[2], x[3]); w.z = cvt_pk_bf16(x[4], x[5]); w.w = cvt_pk_bf16(x[6], x[7]);
                    *(GAS u32x4*)(HM + off) = w; }
            asm volatile("" ::: "memory");
        }
    }
};
struct EpiO {
    static constexpr bool PERM = true;
    const GAS bf16* HBr; GAS bf16* T;
    __device__ __forceinline__ void operator()(const f32x4 (&acc)[2][2][4][2], const pg8::Unit& u, int wr, int wc, int fr, int fq) const {
        const int rowb = u.pm * 256 + wr * 64 + fr; const int colb = 256 * u.pn + 32 * wc + 8 * fq;
#pragma unroll
        for (int ai = 0; ai < 2; ++ai) {
            u32x4 hv[4][2];
#pragma unroll
            for (int m = 0; m < 4; ++m)
#pragma unroll
                for (int bj = 0; bj < 2; ++bj) hv[m][bj] = *(const GAS u32x4*)(HBr + (size_t)(rowb + ai * 128 + m * 16) * DM + colb + 128 * bj);
            __builtin_amdgcn_sched_barrier(0);
#pragma unroll
            for (int m = 0; m < 4; ++m)
#pragma unroll
                for (int bj = 0; bj < 2; ++bj) { const u32x4 h = hv[m][bj];
                    u32x4 w; w.x = cvt_pk_bf16(bflo(h.x) * DN_ALPHA + acc[ai][bj][m][0][0], bfhi(h.x) * DN_ALPHA + acc[ai][bj][m][0][1]); w.y = cvt_pk_bf16(bflo(h.y) * DN_ALPHA + acc[ai][bj][m][0][2], bfhi(h.y) * DN_ALPHA + acc[ai][bj][m][0][3]);
                    w.z = cvt_pk_bf16(bflo(h.z) * DN_ALPHA + acc[ai][bj][m][1][0], bfhi(h.z) * DN_ALPHA + acc[ai][bj][m][1][1]); w.w = cvt_pk_bf16(bflo(h.w) * DN_ALPHA + acc[ai][bj][m][1][2], bfhi(h.w) * DN_ALPHA + acc[ai][bj][m][1][3]);
                    *(GAS u32x4*)(T + (size_t)(rowb + ai * 128 + m * 16) * DM + colb + 128 * bj) = w; }
            asm volatile("" ::: "memory");
        }
    }
};
struct EpiGU {
    static constexpr bool PERM = true;
    GAS bf16* HID; const GAS float* CW;
    __device__ __forceinline__ void operator()(const f32x4 (&acc)[2][2][4][2], const pg8::Unit& u, int wr, int wc, int fr, int fq) const {
        const int rowb = u.pm * 256 + wr * 64 + fr;
        float cwv[2][4];
#pragma unroll
        for (int ai = 0; ai < 2; ++ai)
#pragma unroll
            for (int m = 0; m < 4; ++m) cwv[ai][m] = CW[rowb + ai * 128 + m * 16];
#pragma unroll
        for (int ai = 0; ai < 2; ++ai)
#pragma unroll
            for (int m = 0; m < 4; ++m) { const int row = rowb + ai * 128 + m * 16; const float cw = cwv[ai][m];
                float x[8];
#pragma unroll
                for (int i = 0; i < 8; ++i) x[i] = siluf_(acc[ai][0][m][i >> 2][i & 3]) * acc[ai][1][m][i >> 2][i & 3] * cw;
                u32x4 w; w.x = cvt_pk_bf16(x[0], x[1]); w.y = cvt_pk_bf16(x[2], x[3]); w.z = cvt_pk_bf16(x[4], x[5]); w.w = cvt_pk_bf16(x[6], x[7]);
                *(GAS u32x4*)(HID + (size_t)row * DEXP + 128 * u.pn + 32 * wc + 8 * fq) = w; }
    }
};
struct EpiDN {
    static constexpr bool PERM = true;
    GAS bf16* FF2;
    __device__ __forceinline__ void operator()(const f32x4 (&acc)[2][2][4][2], const pg8::Unit& u, int wr, int wc, int fr, int fq) const {
        const int rowb = u.pm * 256 + wr * 64 + fr;
#pragma unroll
        for (int ai = 0; ai < 2; ++ai)
#pragma unroll
            for (int m = 0; m < 4; ++m) { const int row = rowb + ai * 128 + m * 16;
#pragma unroll
                for (int bj = 0; bj < 2; ++bj) { u32x4 w; w.x = cvt_pk_bf16(acc[ai][bj][m][0][0], acc[ai][bj][m][0][1]); w.y = cvt_pk_bf16(acc[ai][bj][m][0][2], acc[ai][bj][m][0][3]);
                    w.z = cvt_pk_bf16(acc[ai][bj][m][1][0], acc[ai][bj][m][1][1]); w.w = cvt_pk_bf16(acc[ai][bj][m][1][2], acc[ai][bj][m][1][3]);
                    *(GAS u32x4*)(FF2 + (size_t)row * DM + 256 * u.pn + 128 * bj + 32 * wc + 8 * fq) = w; } }
    }
};
#ifndef EN_B1
#define EN_B1 1
#endif
#ifndef EN_B2
#define EN_B2 1
#endif
#ifndef EN_B3
#define EN_B3 1
#endif

template <int CTRL> __device__ __forceinline__ float dppf(float x) { return __builtin_bit_cast(float, __builtin_amdgcn_mov_dpp(__builtin_bit_cast(int, x), CTRL, 0xf, 0xf, true)); }
template <int CTRL> __device__ __forceinline__ int dppi(int x) { return __builtin_amdgcn_mov_dpp(x, CTRL, 0xf, 0xf, true); }
typedef short v4i16_t __attribute__((ext_vector_type(4)));
typedef unsigned short u16x2 __attribute__((ext_vector_type(2)));
__device__ __forceinline__ v4i16_t ldtr(const LAS unsigned char* p) { return __builtin_amdgcn_ds_read_tr16_b64_v4i16((LAS v4i16_t*)p); }
__device__ __forceinline__ bf16x8 cat8(v4i16_t lo, v4i16_t hi) { bf16x8 r; r[0] = lo[0]; r[1] = lo[1]; r[2] = lo[2]; r[3] = lo[3]; r[4] = hi[0]; r[5] = hi[1]; r[6] = hi[2]; r[7] = hi[3]; return r; }
__device__ __forceinline__ int wave_total_i(int v) {
    v += dppi<0xB1>(v); v += dppi<0x4E>(v); v += dppi<0x141>(v); v += dppi<0x140>(v);
    return __builtin_amdgcn_readlane(v, 0) + __builtin_amdgcn_readlane(v, 16) + __builtin_amdgcn_readlane(v, 32) + __builtin_amdgcn_readlane(v, 48);
}
__device__ __forceinline__ void gmlp_unit(Frame& F, int l, int unit) {
    int tid = F.tid; asm volatile("" : "+v"(tid)); const int lane = tid & 63;
    const int chunk = unit >> 2, g = unit & 3, n0 = chunk * 128;
    const GAS bf16* PA = (const GAS bf16*)(F.ws + WS_PA); GAS bf16* Y = (GAS bf16*)(F.ws + WS_Y);
    LAS float* vln = (LAS float*)F.lds;
    LAS float* wl = (LAS float*)(F.lds + 65536);
    LAS float* st = (LAS float*)(F.lds + AUX_OFF);
    const GAS float* lng = ((const GAS float*)F.in[9]) + l * 512; const GAS float* lnb = ((const GAS float*)F.in[10]) + l * 512;
    for (int j = 0; j < 16; ++j) { const int s = F.wave * 16 + j;
        const u32x4 w = *(const GAS u32x4*)(PA + (size_t)(n0 + s) * NPA + PA_CV + 8 * lane);
        float x[8] = {bflo(w.x), bfhi(w.x), bflo(w.y), bfhi(w.y), bflo(w.z), bfhi(w.z), bflo(w.w), bfhi(w.w)};
        float sm = 0.f;
#pragma unroll
        for (int i = 0; i < 8; ++i) sm += x[i];
        const float mean = wave_sum(sm, lane) * (1.f / 512.f); float q = 0.f;
#pragma unroll
        for (int i = 0; i < 8; ++i) { const float d = x[i] - mean; q += d * d; }
        const float rstd = 1.f / sqrtf(wave_sum(q, lane) * (1.f / 512.f) + LN_EPS);
        if (lane == 0) { st[2 * s] = mean; st[2 * s + 1] = rstd; } }
    __syncthreads();
#pragma unroll
    for (int i = 0; i < 4; ++i) { const int q = tid + 512 * i, s = q >> 4, d0 = (q & 15) * 8;
        const u32x4 w = *(const GAS u32x4*)(PA + (size_t)(n0 + s) * NPA + PA_CV + g * 128 + d0);
        const float mean = st[2 * s], rstd = st[2 * s + 1];
        float x[8] = {bflo(w.x), bfhi(w.x), bflo(w.y), bfhi(w.y), bflo(w.z), bfhi(w.z), bflo(w.w), bfhi(w.w)};
#pragma unroll
        for (int k = 0; k < 8; ++k) x[k] = (x[k] - mean) * rstd * lng[g * 128 + d0 + k] + lnb[g * 128 + d0 + k];
        *(LAS f32x4*)(vln + s * 128 + d0) = (f32x4){x[0], x[1], x[2], x[3]}; *(LAS f32x4*)(vln + s * 128 + d0 + 4) = (f32x4){x[4], x[5], x[6], x[7]}; }
    const GAS float* ws = ((const GAS float*)F.in[11]) + ((size_t)l * 4 + g) * 128 * 128;
#pragma unroll
    for (int i = 0; i < 8; ++i) { const int q = tid + 512 * i, t = q >> 5, s0 = (q & 31) * 4;
        f32x4 w = *(const GAS f32x4*)(ws + t * 128 + s0);
        if (s0 + 0 > t) w.x = 0.f; if (s0 + 1 > t) w.y = 0.f; if (s0 + 2 > t) w.z = 0.f; if (s0 + 3 > t) w.w = 0.f;
        *(LAS f32x4*)(wl + t * 128 + s0) = w; }
    __syncthreads();
    const int d = tid & 127, tq = __builtin_amdgcn_readfirstlane(tid >> 7);
    float vr[128];
#pragma unroll
    for (int sb = 0; sb < 4; ++sb)
        if (sb <= tq) {
#pragma unroll
            for (int s = 0; s < 32; ++s) vr[sb * 32 + s] = vln[(sb * 32 + s) * 128 + d];
        } else {
#pragma unroll
            for (int s = 0; s < 32; ++s) vr[sb * 32 + s] = 0.f;
        }
    const GAS float* bs = ((const GAS float*)F.in[12]) + ((size_t)l * 4 + g) * 128;
#pragma unroll 1
    for (int ti = 0; ti < 32; ++ti) { const int t = tq * 32 + ti; float a = 0.f;
#pragma unroll
        for (int sb = 0; sb < 4; ++sb)
            if (sb <= tq) {
#pragma unroll
                for (int s4 = 0; s4 < 8; ++s4) { const f32x4 w = *(const LAS f32x4*)(wl + t * 128 + sb * 32 + s4 * 4);
                    a += w.x * vr[sb * 32 + s4 * 4] + w.y * vr[sb * 32 + s4 * 4 + 1] + w.z * vr[sb * 32 + s4 * 4 + 2] + w.w * vr[sb * 32 + s4 * 4 + 3]; }
            }
        const float uu = bf1(PA[(size_t)(n0 + t) * NPA + PA_CU + g * 128 + d]);
        Y[(size_t)(n0 + t) * 1536 + 1024 + g * 128 + d] = (bf16)f2bf(uu * (a + bs[t])); }
    __syncthreads();
}

__device__ __forceinline__ void gmlp16_unit(Frame& F, int l, int chunk) {
    const int lane = fresh_lane(), w = F.wave, tid = w * 64 + lane, fr = lane & 15, fq = lane >> 4;
    const size_t n0 = (size_t)chunk * 128;
    const GAS bf16* PA = (const GAS bf16*)(F.ws + WS_PA); GAS bf16* Y = (GAS bf16*)(F.ws + WS_Y);
    LAS unsigned char* VT = F.lds;
    LAS unsigned char* WT = F.lds + 32768;
    LAS float* st = (LAS float*)(F.lds + AUX_OFF);
    const GAS float* lng = ((const GAS float*)F.in[9]) + l * 512; const GAS float* lnb = ((const GAS float*)F.in[10]) + l * 512;
    for (int j = 0; j < 16; ++j) { const int s = w * 16 + j;
        const u32x4 x4 = *(const GAS u32x4*)(PA + (n0 + s) * NPA + PA_CV + 8 * lane);
        float x[8] = {bflo(x4.x), bfhi(x4.x), bflo(x4.y), bfhi(x4.y), bflo(x4.z), bfhi(x4.z), bflo(x4.w), bfhi(x4.w)};
        float sm = 0.f;
#pragma unroll
        for (int i = 0; i < 8; ++i) sm += x[i];
        const float mean = wave_sum(sm, lane) * (1.f / 512.f); float q = 0.f;
#pragma unroll
        for (int i = 0; i < 8; ++i) { const float d = x[i] - mean; q += d * d; }
        const float rstd = 1.f / sqrtf(wave_sum(q, lane) * (1.f / 512.f) + LN_EPS);
        if (lane == 0) { st[2 * s] = mean; st[2 * s + 1] = rstd; } }
    __syncthreads();
#pragma unroll 1
    for (int g = 0; g < 4; ++g) {
        const GAS float* ws = ((const GAS float*)F.in[11]) + ((size_t)l * 4 + g) * 128 * 128;
#pragma unroll
        for (int i = 0; i < 4; ++i) { const int q = tid + 512 * i, s = q >> 4, d0 = (q & 15) * 8;
            const u32x4 x4 = *(const GAS u32x4*)(PA + (n0 + s) * NPA + PA_CV + g * 128 + d0);
            const float mean = st[2 * s], rstd = st[2 * s + 1];
            float x[8] = {bflo(x4.x), bfhi(x4.x), bflo(x4.y), bfhi(x4.y), bflo(x4.z), bfhi(x4.z), bflo(x4.w), bfhi(x4.w)};
            const f32x4 g0 = *(const GAS f32x4*)(lng + g * 128 + d0), g1 = *(const GAS f32x4*)(lng + g * 128 + d0 + 4), b0 = *(const GAS f32x4*)(lnb + g * 128 + d0), b1 = *(const GAS f32x4*)(lnb + g * 128 + d0 + 4);
#pragma unroll
            for (int k = 0; k < 8; ++k) x[k] = (x[k] - mean) * rstd * ((k < 4) ? g0[k & 3] : g1[k & 3]) + ((k < 4) ? b0[k & 3] : b1[k & 3]);
            u32x4 o; o.x = cvt_pk_bf16(x[0], x[1]); o.y = cvt_pk_bf16(x[2], x[3]); o.z = cvt_pk_bf16(x[4], x[5]); o.w = cvt_pk_bf16(x[6], x[7]);
            *(LAS u32x4*)(VT + s * 256 + d0 * 2) = o;
            const int t = s, s0 = d0;
            f32x4 w0 = *(const GAS f32x4*)(ws + t * 128 + s0), w1 = *(const GAS f32x4*)(ws + t * 128 + s0 + 4);
            float wv[8] = {w0.x, w0.y, w0.z, w0.w, w1.x, w1.y, w1.z, w1.w};
#pragma unroll
            for (int k = 0; k < 8; ++k) wv[k] = (s0 + k <= t) ? wv[k] : 0.f;
            u32x4 ow; ow.x = cvt_pk_bf16(wv[0], wv[1]); ow.y = cvt_pk_bf16(wv[2], wv[3]); ow.z = cvt_pk_bf16(wv[4], wv[5]); ow.w = cvt_pk_bf16(wv[6], wv[7]);
            *(LAS u32x4*)(WT + t * 256 + s0 * 2) = ow; }
        __syncthreads();
        f32x4 acc[8];
#pragma unroll
        for (int nt = 0; nt < 8; ++nt) acc[nt] = (f32x4){0.f, 0.f, 0.f, 0.f};
        const int nks = (16 * w + 15) / 32 + 1;
#pragma unroll
        for (int ks = 0; ks < 4; ++ks) if (ks < nks) {
            const bf16x8 a = *(const LAS bf16x8*)(WT + (16 * w + fr) * 256 + (8 * fq + 32 * ks) * 2);
            const int srow = 32 * ks + 8 * fq + (fr >> 2);
#pragma unroll
            for (int nt = 0; nt < 8; ++nt) { const bf16x8 bv = cat8(ldtr(VT + srow * 256 + (16 * nt + 4 * (fr & 3)) * 2), ldtr(VT + (srow + 4) * 256 + (16 * nt + 4 * (fr & 3)) * 2));
                acc[nt] = __builtin_amdgcn_mfma_f32_16x16x32_bf16(a, bv, acc[nt], 0, 0, 0); } }
        const GAS float* bs = ((const GAS float*)F.in[12]) + ((size_t)l * 4 + g) * 128;
#pragma unroll
        for (int r = 0; r < 4; ++r) { const int t = 16 * w + 4 * fq + r; const float bt = bs[t];
#pragma unroll
            for (int nt = 0; nt < 8; ++nt) { const int d = 16 * nt + fr;
                const float uu = bf1(PA[(n0 + t) * NPA + PA_CU + g * 128 + d]);
                Y[(n0 + t) * 1536 + 1024 + g * 128 + d] = (bf16)f2bf(uu * (acc[nt][r] + bt)); } }
        __syncthreads();
    }
}

__device__ __forceinline__ void gla_unit(Frame& F, int l, int unit) {
    int tid = F.tid; asm volatile("" : "+v"(tid));
    const int b = unit >> 2, h = unit & 3;
    const GAS bf16* PA = (const GAS bf16*)(F.ws + WS_PA); GAS bf16* Y = (GAS bf16*)(F.ws + WS_Y); const GAS float* GLR = (const GAS float*)(F.ws + WS_GLR);
    LAS float* wa = (LAS float*)F.lds;
    LAS float* ba = wa + 1024;
    LAS float* as_ = ba + 64;
    LAS float* qs = as_ + 1024;
    LAS float* ks = qs + 1024;
    LAS float* vs = ks + 1024;
    LAS float* part = vs + 2048;
    for (int i = tid; i < 1024; i += 512) wa[i] = ((const GAS float*)F.in[6])[(size_t)l * 16 * 256 + (i >> 6) * 256 + h * 64 + (i & 63)];
    if (tid < 64) ba[tid] = ((const GAS float*)F.in[7])[l * 256 + h * 64 + tid];
    const GAS float* gng = ((const GAS float*)F.in[8]) + l * 128;
    const int v = tid & 127, kq = __builtin_amdgcn_readfirstlane(tid >> 7);
    float S[16];
#pragma unroll
    for (int j = 0; j < 16; ++j) S[j] = 0.f;
    __syncthreads();
    for (int t0 = 0; t0 < SEQ; t0 += 16) {
        const size_t nb = (size_t)b * SEQ + t0;
#pragma unroll
        for (int i = 0; i < 2; ++i) { const int e = tid + 512 * i, t = e >> 6, k = e & 63; float z = ba[k];
#pragma unroll
            for (int r = 0; r < 16; ++r) z += GLR[(nb + t) * 16 + r] * wa[r * 64 + k];
            const float ls = fminf(z, 0.f) - log1pf(__expf(-fabsf(z)));
            as_[e] = __expf(ls * (1.f / 16.f));
            qs[e] = bf1(PA[(nb + t) * NPA + PA_BQ + h * 64 + k]); ks[e] = bf1(PA[(nb + t) * NPA + PA_BK + h * 64 + k]); }
#pragma unroll
        for (int i = 0; i < 4; ++i) { const int e = tid + 512 * i, t = e >> 7, vv = e & 127; vs[e] = bf1(PA[(nb + t) * NPA + PA_BV + h * 128 + vv]); }
        __syncthreads();
#pragma unroll 4
        for (int t = 0; t < 16; ++t) { const float vt = vs[t * 128 + v]; float p = 0.f;
#pragma unroll
            for (int j4 = 0; j4 < 4; ++j4) { const f32x4 a4 = *(const LAS f32x4*)(as_ + t * 64 + kq * 16 + j4 * 4), k4 = *(const LAS f32x4*)(ks + t * 64 + kq * 16 + j4 * 4), q4 = *(const LAS f32x4*)(qs + t * 64 + kq * 16 + j4 * 4);
#pragma unroll
                for (int j = 0; j < 4; ++j) { S[j4 * 4 + j] = a4[j] * S[j4 * 4 + j] + k4[j] * vt; p += q4[j] * S[j4 * 4 + j]; } }
            part[(kq * 16 + t) * 128 + v] = p; }
        __syncthreads();
        { const int t = tid >> 5, v4 = (tid & 31) * 4;
          f32x4 o = *(const LAS f32x4*)(part + (0 * 16 + t) * 128 + v4);
#pragma unroll
          for (int q = 1; q < 4; ++q) o += *(const LAS f32x4*)(part + (q * 16 + t) * 128 + v4);
          float ss = o.x * o.x + o.y * o.y + o.z * o.z + o.w * o.w;
#pragma unroll
          for (int sh = 1; sh < 32; sh <<= 1) ss += shx(ss, sh, tid & 63);
          const float r = 1.f / sqrtf(ss * (1.f / 128.f) + RMS_EPS);
          const f32x4 gg = *(const GAS f32x4*)(gng + v4);
          const u32x2 brw = *(const GAS u32x2*)(PA + (nb + t) * NPA + PA_BR + h * 128 + v4);
          u32x2 w; w.x = pk2(o.x * r * gg.x * bflo(brw.x), o.y * r * gg.y * bfhi(brw.x)); w.y = pk2(o.z * r * gg.z * bflo(brw.y), o.w * r * gg.w * bfhi(brw.y));
          *(GAS u32x2*)(Y + (nb + t) * 1536 + 512 + h * 128 + v4) = w; }
        __syncthreads();
    }
}

constexpr size_t WS_US = WS_WMOE, WS_DEC = WS_WMOE + 32 * MiB;
__device__ __forceinline__ void gla_local_unit(Frame& F, int l, int unit) {
    const int lane = fresh_lane(), w = F.wave, tid = w * 64 + lane, fr = lane & 15, fq = lane >> 4;
    const int b = unit >> 8, h = (unit >> 6) & 3, c = unit & 63; const size_t n0 = (size_t)b * SEQ + 64 * c;
    GAS bf16* PA = (GAS bf16*)(F.ws + WS_PA); GAS bf16* Y = (GAS bf16*)(F.ws + WS_Y); const GAS float* GLR = (const GAS float*)(F.ws + WS_GLR);
    GAS bf16* US = (GAS bf16*)(F.ws + WS_US) + (size_t)unit * 8192; GAS float* DEC = (GAS float*)(F.ws + WS_DEC) + unit * 64;
    LAS unsigned char* QT = F.lds; LAS unsigned char* KT = F.lds + 8192; LAS unsigned char* KD = F.lds + 16384; LAS unsigned char* VV = F.lds + 24576; LAS unsigned char* ATT = F.lds + 40960;
    LAS float* SEG = (LAS float*)(F.lds + 65536); LAS float* WA = (LAS float*)(F.lds + 67584); LAS float* BA = (LAS float*)(F.lds + 71680);
#pragma unroll
    for (int i = 0; i < 2; ++i) { const int e = tid + 512 * i; WA[e] = ((const GAS float*)F.in[6])[(size_t)l * 16 * 256 + (e >> 6) * 256 + h * 64 + (e & 63)]; }
    if (tid < 64) BA[tid] = ((const GAS float*)F.in[7])[l * 256 + h * 64 + tid];
#pragma unroll
    for (int i = 0; i < 2; ++i) { const int piece = tid + 512 * i, row = piece >> 4, c16 = piece & 15;
        *(LAS u32x4*)(VV + row * 256 + c16 * 16) = *(const GAS u32x4*)(PA + (n0 + row) * NPA + PA_BV + h * 128 + 8 * c16); }
    __syncthreads();
    const int k = tid & 63, seg = w;
    float cum[8];
    { float run = 0.f;
#pragma unroll
      for (int i = 0; i < 8; ++i) { const int t = 8 * seg + i; float z = BA[k];
          const f32x4 g0 = *(const GAS f32x4*)(GLR + (n0 + t) * 16), g1 = *(const GAS f32x4*)(GLR + (n0 + t) * 16 + 4), g2 = *(const GAS f32x4*)(GLR + (n0 + t) * 16 + 8), g3 = *(const GAS f32x4*)(GLR + (n0 + t) * 16 + 12);
#pragma unroll
          for (int r = 0; r < 4; ++r) { z += g0[r] * WA[r * 64 + k]; z += g1[r] * WA[(4 + r) * 64 + k]; z += g2[r] * WA[(8 + r) * 64 + k]; z += g3[r] * WA[(12 + r) * 64 + k]; }
          const float ls = fminf(z, 0.f) - log1pf(__expf(-fabsf(z)));
          run += ls * (1.f / 16.f); cum[i] = run; }
      SEG[seg * 64 + k] = run; }
    __syncthreads();
    { float off = 0.f, blast = 0.f;
#pragma unroll
      for (int s2 = 0; s2 < 8; ++s2) { const float sv = SEG[s2 * 64 + k]; blast += sv; off += (s2 < seg) ? sv : 0.f; }
#pragma unroll
      for (int i = 0; i < 8; ++i) { const int t = 8 * seg + i; const float bb = cum[i] + off;
          const float qv = bf1(PA[(n0 + t) * NPA + PA_BQ + h * 64 + k]), kv = bf1(PA[(n0 + t) * NPA + PA_BK + h * 64 + k]);
          const unsigned qt = f2bf(qv * __expf(bb));
          ((LAS unsigned short*)QT)[t * 64 + k] = (unsigned short)qt; ((LAS unsigned short*)KT)[t * 64 + k] = (unsigned short)f2bf(kv * __expf(-bb)); ((LAS unsigned short*)KD)[t * 64 + k] = (unsigned short)f2bf(kv * __expf(blast - bb));
          PA[(n0 + t) * NPA + PA_BQ + h * 64 + k] = (bf16)qt; }
      if (seg == 0) DEC[k] = __expf(blast); }
    __syncthreads();
#pragma unroll
    for (int ii = 0; ii < 2; ++ii) { const int id = 2 * w + ii, ts = id >> 2, tt = id & 3;
        f32x4 d = {0.f, 0.f, 0.f, 0.f};
        if (ts <= tt) {
#pragma unroll
            for (int ks = 0; ks < 2; ++ks) { const bf16x8 a = *(const LAS bf16x8*)(KT + (16 * ts + fr) * 128 + (8 * fq + 32 * ks) * 2), bq = *(const LAS bf16x8*)(QT + (16 * tt + fr) * 128 + (8 * fq + 32 * ks) * 2);
                d = __builtin_amdgcn_mfma_f32_16x16x32_bf16(a, bq, d, 0, 0, 0); } }
        const int t = 16 * tt + fr, s0 = 16 * ts + 4 * fq;
        u32x2 pk; pk.x = cvt_pk_bf16((s0 <= t) ? d[0] : 0.f, (s0 + 1 <= t) ? d[1] : 0.f); pk.y = cvt_pk_bf16((s0 + 2 <= t) ? d[2] : 0.f, (s0 + 3 <= t) ? d[3] : 0.f);
        *(LAS u32x2*)(ATT + t * 128 + s0 * 2) = pk; }
    __syncthreads();
    { const int tr = w & 3, nh = w >> 2;
      f32x4 ao[4], au[4];
#pragma unroll
      for (int j = 0; j < 4; ++j) { ao[j] = (f32x4){0.f, 0.f, 0.f, 0.f}; au[j] = (f32x4){0.f, 0.f, 0.f, 0.f}; }
#pragma unroll
      for (int ks = 0; ks < 2; ++ks) {
          const bf16x8 aA = *(const LAS bf16x8*)(ATT + (16 * tr + fr) * 128 + (8 * fq + 32 * ks) * 2);
          const int srow = 32 * ks + 8 * fq + (fr >> 2);
          const bf16x8 aK = cat8(ldtr(KD + srow * 128 + (16 * tr + 4 * (fr & 3)) * 2), ldtr(KD + (srow + 4) * 128 + (16 * tr + 4 * (fr & 3)) * 2));
#pragma unroll
          for (int j = 0; j < 4; ++j) { const int nt = 4 * nh + j;
              const bf16x8 bv = cat8(ldtr(VV + srow * 256 + (16 * nt + 4 * (fr & 3)) * 2), ldtr(VV + (srow + 4) * 256 + (16 * nt + 4 * (fr & 3)) * 2));
              ao[j] = __builtin_amdgcn_mfma_f32_16x16x32_bf16(aA, bv, ao[j], 0, 0, 0);
              au[j] = __builtin_amdgcn_mfma_f32_16x16x32_bf16(aK, bv, au[j], 0, 0, 0); } }
#pragma unroll
      for (int j = 0; j < 4; ++j) { const int v = 16 * (4 * nh + j) + fr;
#pragma unroll
          for (int r = 0; r < 4; ++r) { const int row = 16 * tr + 4 * fq + r;
              Y[(n0 + row) * 1536 + 512 + h * 128 + v] = (bf16)f2bf(ao[j][r]);
              US[row * 128 + v] = (bf16)f2bf(au[j][r]); } } }
    __syncthreads();
}
__device__ __forceinline__ void gla_scan_phase(Frame& F) {
    GAS bf16* USb = (GAS bf16*)(F.ws + WS_US); const GAS float* DECb = (const GAS float*)(F.ws + WS_DEC);
    for (int gt = F.wg * 512 + F.tid; gt < 131072; gt += F.G * 512) { const int e0 = 2 * gt, bh = e0 >> 13, kv = e0 & 8191, k = kv >> 7;
        GAS unsigned* p = (GAS unsigned*)(USb + (size_t)bh * 64 * 8192 + kv); const GAS float* dp = DECb + bh * 64 * 64 + k;
        float s0 = 0.f, s1 = 0.f;
#pragma unroll 8
        for (int c = 0; c < 64; ++c) { const unsigned u = p[(size_t)c * 4096]; const float d = dp[c * 64];
            p[(size_t)c * 4096] = pk2(s0, s1);
            s0 = d * s0 + bflo(u); s1 = d * s1 + bfhi(u); } }
}
__device__ __forceinline__ void gla_out_unit(Frame& F, int l, int unit) {
    const int lane = fresh_lane(), w = F.wave, tid = w * 64 + lane, fr = lane & 15, fq = lane >> 4;
    const int b = unit >> 8, h = (unit >> 6) & 3, c = unit & 63; const size_t n0 = (size_t)b * SEQ + 64 * c;
    const GAS bf16* PA = (const GAS bf16*)(F.ws + WS_PA); GAS bf16* Y = (GAS bf16*)(F.ws + WS_Y);
    const GAS bf16* US = (const GAS bf16*)(F.ws + WS_US) + (size_t)unit * 8192;
    LAS unsigned char* SS = F.lds;
    LAS float* PS = (LAS float*)(F.lds + 16384);
    const GAS float* gng = ((const GAS float*)F.in[8]) + l * 128;
#pragma unroll
    for (int i = 0; i < 2; ++i) { const int piece = tid + 512 * i; *(LAS u32x4*)(SS + piece * 16) = *(const GAS u32x4*)(US + piece * 8); }
    __syncthreads();
    const int tr = w >> 1, nh = w & 1;
    f32x4 acc[4];
#pragma unroll
    for (int j = 0; j < 4; ++j) acc[j] = (f32x4){0.f, 0.f, 0.f, 0.f};
#pragma unroll
    for (int ks = 0; ks < 2; ++ks) {
        const bf16x8 aq = *(const GAS bf16x8*)(PA + (n0 + 16 * tr + fr) * NPA + PA_BQ + h * 64 + 8 * fq + 32 * ks);
        const int krow = 32 * ks + 8 * fq + (fr >> 2);
#pragma unroll
        for (int j = 0; j < 4; ++j) { const int nt = 4 * nh + j;
            const bf16x8 bs = cat8(ldtr(SS + krow * 256 + (16 * nt + 4 * (fr & 3)) * 2), ldtr(SS + (krow + 4) * 256 + (16 * nt + 4 * (fr & 3)) * 2));
            acc[j] = __builtin_amdgcn_mfma_f32_16x16x32_bf16(aq, bs, acc[j], 0, 0, 0); } }
    float ss[4] = {0.f, 0.f, 0.f, 0.f};
#pragma unroll
    for (int j = 0; j < 4; ++j) { const int v = 16 * (4 * nh + j) + fr;
#pragma unroll
        for (int r = 0; r < 4; ++r) { const int row = 16 * tr + 4 * fq + r; acc[j][r] += bf1(Y[(n0 + row) * 1536 + 512 + h * 128 + v]); ss[r] += acc[j][r] * acc[j][r]; } }
#pragma unroll
    for (int r = 0; r < 4; ++r) { float s = ss[r]; s += dppf<0xB1>(s); s += dppf<0x4E>(s); s += shx(s, 4, lane); s += shx(s, 8, lane); ss[r] = s; }
    if (fr == 0) {
#pragma unroll
        for (int r = 0; r < 4; ++r) PS[(16 * tr + 4 * fq + r) * 2 + nh] = ss[r]; }
    __syncthreads();
#pragma unroll
    for (int r = 0; r < 4; ++r) { const int row = 16 * tr + 4 * fq + r; const float rinv = 1.f / sqrtf((PS[row * 2] + PS[row * 2 + 1]) * (1.f / 128.f) + RMS_EPS);
#pragma unroll
        for (int j = 0; j < 4; ++j) { const int v = 16 * (4 * nh + j) + fr;
            const float br = bf1(PA[(n0 + row) * NPA + PA_BR + h * 128 + v]);
            Y[(n0 + row) * 1536 + 512 + h * 128 + v] = (bf16)f2bf(acc[j][r] * rinv * gng[v] * br); } }
    __syncthreads();
}

constexpr int DSA_WAVE_LDS = 17920;
__device__ __forceinline__ void dsa_unit(Frame& F, int unit) {
    int lane = F.lane; asm volatile("" : "+v"(lane)); const int w = F.wave;
    const int qb = 4095 - unit;
    const int b = qb & 7, t = (qb >> 3) * 8 + w;
    const size_t n = (size_t)b * SEQ + t, nb0 = (size_t)b * SEQ;
    const GAS bf16* PA = (const GAS bf16*)(F.ws + WS_PA); GAS bf16* Y = (GAS bf16*)(F.ws + WS_Y);
    const GAS bf16* KI = (const GAS bf16*)(F.ws + WS_KI); const GAS bf16* KA = (const GAS bf16*)(F.ws + WS_KA); const GAS bf16* VA = (const GAS bf16*)(F.ws + WS_VA);
    const GAS float* WI = (const GAS float*)(F.ws + WS_WI);
    LAS unsigned char* base = F.lds + w * DSA_WAVE_LDS;
    LAS unsigned* sc = (LAS unsigned*)base;
    LAS float* qi = (LAS float*)(base + 16384);
    LAS unsigned short* list = (LAS unsigned short*)(base + 16384 + 1024);
    { const u32x2 q2 = *(const GAS u32x2*)(PA + n * NPA + PA_QI + 4 * lane);
      *(LAS f32x4*)(qi + 4 * lane) = (f32x4){bflo(q2.x), bfhi(q2.x), bflo(q2.y), bfhi(q2.y)}; }
    asm volatile("s_waitcnt lgkmcnt(0)" ::: "memory");
    const f32x4 wi = {ld_f32(WI + n * 4), ld_f32(WI + n * 4 + 1), ld_f32(WI + n * 4 + 2), ld_f32(WI + n * 4 + 3)};
    const int nbat = (t >> 6) + 1;
    for (int kb = 0; kb < nbat; ++kb) { const int key = kb * 64 + lane, kc = key <= t ? key : t;
        const GAS u32x4* kp = (const GAS u32x4*)(KI + (nb0 + kc) * 64);
        float kf[64];
#pragma unroll
        for (int c = 0; c < 8; ++c) { const u32x4 kk = kp[c]; kf[8 * c] = bflo(kk.x); kf[8 * c + 1] = bfhi(kk.x); kf[8 * c + 2] = bflo(kk.y); kf[8 * c + 3] = bfhi(kk.y); kf[8 * c + 4] = bflo(kk.z); kf[8 * c + 5] = bfhi(kk.z); kf[8 * c + 6] = bflo(kk.w); kf[8 * c + 7] = bfhi(kk.w); }
        float score = 0.f;
#pragma unroll
        for (int h = 0; h < 4; ++h) { float d = 0.f;
#pragma unroll
            for (int c = 0; c < 16; ++c) { const f32x4 q4 = *(const LAS f32x4*)(qi + h * 64 + 4 * c); d += q4.x * kf[4 * c] + q4.y * kf[4 * c + 1] + q4.z * kf[4 * c + 2] + q4.w * kf[4 * c + 3]; }
            score += wi[h] * fmaxf(d, 0.f); }
        if (score == 0.f) score = 0.f;
        unsigned u = __builtin_bit_cast(unsigned, score); u = (u & 0x80000000u) ? ~u : (u | 0x80000000u);
        sc[key] = key <= t ? u : 0u; }
    asm volatile("s_waitcnt lgkmcnt(0)" ::: "memory");
    int nsel;
    if (t >= 256) {
        unsigned T = 0u;
        for (int bit = 31; bit >= 0; --bit) { const unsigned cand = T | (1u << bit); int cnt = 0;
            for (int j = 0; j < nbat; ++j) cnt += (sc[j * 64 + lane] >= cand) ? 1 : 0;
            if (wave_sum_i(cnt, lane) >= 256) T = cand; }
        int cgt = 0;
        for (int j = 0; j < nbat; ++j) cgt += (sc[j * 64 + lane] > T) ? 1 : 0;
        const int need = 256 - wave_sum_i(cgt, lane);
        int selbase = 0, tiebase = 0;
        for (int j = 0; j < nbat; ++j) { const unsigned x = sc[j * 64 + lane]; const bool eq = (x == T), gt = (x > T);
            const unsigned long long beq = __ballot(eq); const unsigned long long lt = (1ull << lane) - 1ull;
            const int trank = tiebase + __popcll(beq & lt);
            const bool sel = gt || (eq && trank < need);
            const unsigned long long bsel = __ballot(sel);
            if (sel) list[selbase + __popcll(bsel & lt)] = (unsigned short)(j * 64 + lane);
            selbase += __popcll(bsel); tiebase += __popcll(beq); }
        nsel = 256;
    } else {
        nsel = t + 1;
        for (int i = lane; i < 256; i += 64) list[i] = (unsigned short)(i <= t ? i : 0);
    }
    asm volatile("s_waitcnt lgkmcnt(0)" ::: "memory");
    LAS float* qm = (LAS float*)base;
    LAS float* Pl = (LAS float*)(base + 2048);
    { const u32x4 q8 = *(const GAS u32x4*)(PA + n * NPA + PA_Q + 8 * lane);
      *(LAS f32x4*)(qm + 8 * lane) = (f32x4){bflo(q8.x), bfhi(q8.x), bflo(q8.y), bfhi(q8.y)}; *(LAS f32x4*)(qm + 8 * lane + 4) = (f32x4){bflo(q8.z), bfhi(q8.z), bflo(q8.w), bfhi(q8.w)}; }
    asm volatile("s_waitcnt lgkmcnt(0)" ::: "memory");
#pragma unroll 1
    for (int bb = 0; bb < 4; ++bb) { const int i = bb * 64 + lane; const bool valid = i < nsel; const int key = valid ? (int)list[i] : 0;
        const GAS u32x4* kp = (const GAS u32x4*)(KA + (nb0 + key) * 64);
        float kf[64];
#pragma unroll
        for (int c = 0; c < 8; ++c) { const u32x4 kk = kp[c]; kf[8 * c] = bflo(kk.x); kf[8 * c + 1] = bfhi(kk.x); kf[8 * c + 2] = bflo(kk.y); kf[8 * c + 3] = bfhi(kk.y); kf[8 * c + 4] = bflo(kk.z); kf[8 * c + 5] = bfhi(kk.z); kf[8 * c + 6] = bflo(kk.w); kf[8 * c + 7] = bfhi(kk.w); }
        float lgv[8];
#pragma unroll
        for (int h = 0; h < 8; ++h) { float d = 0.f;
#pragma unroll
            for (int c = 0; c < 16; ++c) { const f32x4 q4 = *(const LAS f32x4*)(qm + h * 64 + 4 * c); d += q4.x * kf[4 * c] + q4.y * kf[4 * c + 1] + q4.z * kf[4 * c + 2] + q4.w * kf[4 * c + 3]; }
            lgv[h] = valid ? d : -INFINITY; }
        *(LAS f32x4*)(Pl + i * 8) = (f32x4){lgv[0], lgv[1], lgv[2], lgv[3]}; *(LAS f32x4*)(Pl + i * 8 + 4) = (f32x4){lgv[4], lgv[5], lgv[6], lgv[7]}; }
    asm volatile("s_waitcnt lgkmcnt(0)" ::: "memory");
    float lg[4][8];
#pragma unroll
    for (int bb = 0; bb < 4; ++bb) { const f32x4 a = *(const LAS f32x4*)(Pl + (bb * 64 + lane) * 8), c = *(const LAS f32x4*)(Pl + (bb * 64 + lane) * 8 + 4);
        lg[bb][0] = a.x; lg[bb][1] = a.y; lg[bb][2] = a.z; lg[bb][3] = a.w; lg[bb][4] = c.x; lg[bb][5] = c.y; lg[bb][6] = c.z; lg[bb][7] = c.w; }
    float den[8];
#pragma unroll
    for (int h = 0; h < 8; ++h) { float m = fmaxf(fmaxf(lg[0][h], lg[1][h]), fmaxf(lg[2][h], lg[3][h])); m = wave_max(m, lane); float s = 0.f;
#pragma unroll
        for (int bb = 0; bb < 4; ++bb) { lg[bb][h] = __expf(lg[bb][h] - m); s += lg[bb][h]; }
        den[h] = wave_sum(s, lane); }
#pragma unroll
    for (int bb = 0; bb < 4; ++bb) { const int i = bb * 64 + lane;
        *(LAS f32x4*)(Pl + i * 8) = (f32x4){lg[bb][0], lg[bb][1], lg[bb][2], lg[bb][3]}; *(LAS f32x4*)(Pl + i * 8 + 4) = (f32x4){lg[bb][4], lg[bb][5], lg[bb][6], lg[bb][7]}; }
    asm volatile("s_waitcnt lgkmcnt(0)" ::: "memory");
    float o[8];
#pragma unroll
    for (int h = 0; h < 8; ++h) o[h] = 0.f;
#pragma unroll 4
    for (int i = 0; i < nsel; ++i) { const int key = (int)list[i]; const float vv = bf1(VA[(nb0 + key) * 64 + lane]);
        const f32x4 p0 = *(const LAS f32x4*)(Pl + i * 8), p1 = *(const LAS f32x4*)(Pl + i * 8 + 4);
        o[0] += p0.x * vv; o[1] += p0.y * vv; o[2] += p0.z * vv; o[3] += p0.w * vv; o[4] += p1.x * vv; o[5] += p1.y * vv; o[6] += p1.z * vv; o[7] += p1.w * vv; }
#pragma unroll
    for (int h = 0; h < 8; ++h) Y[n * 1536 + h * 64 + lane] = (bf16)f2bf(o[h] / den[h]);
}

__device__ __forceinline__ bf16x8 scale_pack8(u32x4 raw, float s) {
    u32x4 o; o.x = cvt_pk_bf16(bflo(raw.x) * s, bfhi(raw.x) * s); o.y = cvt_pk_bf16(bflo(raw.y) * s, bfhi(raw.y) * s); o.z = cvt_pk_bf16(bflo(raw.z) * s, bfhi(raw.z) * s); o.w = cvt_pk_bf16(bflo(raw.w) * s, bfhi(raw.w) * s);
    return __builtin_bit_cast(bf16x8, o);
}
__device__ __forceinline__ void dsa16_unit(Frame& F, int unit) {
    const int lane = fresh_lane(); const int w = F.wave;
    const int qb = 2047 - unit;
    const int b = qb & 7, t0 = (qb >> 3) * 16;
    const size_t nb0 = (size_t)b * SEQ;
    const GAS bf16* PA = (const GAS bf16*)(F.ws + WS_PA); GAS bf16* Y = (GAS bf16*)(F.ws + WS_Y);
    const GAS bf16* KI = (const GAS bf16*)(F.ws + WS_KI); const GAS bf16* KA = (const GAS bf16*)(F.ws + WS_KA); const GAS bf16* VA = (const GAS bf16*)(F.ws + WS_VA);
    const GAS float* WI = (const GAS float*)(F.ws + WS_WI);
    LAS unsigned char* K16 = F.lds;
    LAS unsigned short* LIST = (LAS unsigned short*)(F.lds + AUX_OFF);
    const int fr = lane & 15, fq = lane >> 4;
#ifdef REP_S1
    for (int rep_ = 0; rep_ < REP_S1; ++rep_)
#endif
    {
        const int ql = fr >> 2, h = fr & 3;
        bf16x8 Bf[4][2]; float Linf[4];
#pragma unroll
        for (int g = 0; g < 4; ++g) { const size_t nq = nb0 + t0 + 4 * g + ql; const float wv = WI[nq * 4 + h];
#pragma unroll
            for (int ks = 0; ks < 2; ++ks) Bf[g][ks] = scale_pack8(*(const GAS u32x4*)(PA + nq * NPA + PA_QI + h * 64 + 8 * fq + 32 * ks), wv);
            Linf[g] = (wv >= 0.f) ? INFINITY : -INFINITY; }
        const int ntiles = (t0 >> 4) + 1;
        bf16x8 A0[4], A1[4];
#pragma unroll
        for (int j = 0; j < 4; ++j) { const int tile = (w + 8 * j < ntiles) ? w + 8 * j : ntiles - 1; const size_t krow = (nb0 + 16 * tile + fr) * 64;
            A0[j] = *(const GAS bf16x8*)(KI + krow + 8 * fq); A1[j] = *(const GAS bf16x8*)(KI + krow + 32 + 8 * fq); }
#pragma unroll 1
        for (int tb = w; tb < ntiles; tb += 32) {
            bf16x8 N0[4], N1[4];
#pragma unroll
            for (int j = 0; j < 4; ++j) { const int tn = tb + 32 + 8 * j; const int tile = (tn < ntiles) ? tn : ntiles - 1; const size_t krow = (nb0 + 16 * tile + fr) * 64;
                N0[j] = *(const GAS bf16x8*)(KI + krow + 8 * fq); N1[j] = *(const GAS bf16x8*)(KI + krow + 32 + 8 * fq); }
#pragma unroll
            for (int j = 0; j < 4; ++j) { const int tile = tb + 8 * j;
                if (tile < ntiles) {
                    const int kpos = 16 * tile + 4 * fq + h;
                    const int g7 = kpos >> 7, hf = (kpos >> 6) & 1, ln = kpos & 63;
                    const int koff = (g7 >> 2) * 1024 + ln * 16 + (g7 & 3) * 4 + hf * 2;
                    const bool lastt = (tile == ntiles - 1);
                    f32x4 d[4];
#pragma unroll
                    for (int g = 0; g < 4; ++g) d[g] = __builtin_amdgcn_mfma_f32_16x16x32_bf16(A0[j], Bf[g][0], (f32x4){0.f, 0.f, 0.f, 0.f}, 0, 0, 0);
#pragma unroll
                    for (int g = 0; g < 4; ++g) d[g] = __builtin_amdgcn_mfma_f32_16x16x32_bf16(A1[j], Bf[g][1], d[g], 0, 0, 0);
#define S1_STEP(g) const float a0##g = __builtin_amdgcn_fmed3f(d[g][0], 0.f, Linf[g]), a1##g = __builtin_amdgcn_fmed3f(d[g][1], 0.f, Linf[g]), a2##g = __builtin_amdgcn_fmed3f(d[g][2], 0.f, Linf[g]), a3##g = __builtin_amdgcn_fmed3f(d[g][3], 0.f, Linf[g]);
                    S1_STEP(0) S1_STEP(1) S1_STEP(2) S1_STEP(3)
#undef S1_STEP
#define S1_STEP(g) const float u0##g = a0##g + dppf<0xB1>(a0##g), u1##g = a1##g + dppf<0xB1>(a1##g), u2##g = a2##g + dppf<0xB1>(a2##g), u3##g = a3##g + dppf<0xB1>(a3##g);
                    S1_STEP(0) S1_STEP(1) S1_STEP(2) S1_STEP(3)
#undef S1_STEP
#define S1_STEP(g) const float p0##g = (h & 1) ? u1##g : u0##g, p1##g = (h & 1) ? u3##g : u2##g;
                    S1_STEP(0) S1_STEP(1) S1_STEP(2) S1_STEP(3)
#undef S1_STEP
#define S1_STEP(g) const float c0##g = p0##g + dppf<0x4E>(p0##g), c1##g = p1##g + dppf<0x4E>(p1##g);
                    S1_STEP(0) S1_STEP(1) S1_STEP(2) S1_STEP(3)
#undef S1_STEP
#define S1_STEP(g) const float s##g = ((h & 2) ? c1##g : c0##g) + 0.0f; const _Float16 hh##g = (_Float16)s##g; const unsigned hb##g = (unsigned)__builtin_bit_cast(unsigned short, hh##g); \
                    unsigned key##g = hb##g ^ ((unsigned)((int)(hb##g << 16) >> 31) | 0x8000u); if (lastt) key##g = (kpos <= t0 + 4 * g + ql) ? key##g : 0u;
                    S1_STEP(0) S1_STEP(1) S1_STEP(2) S1_STEP(3)
#undef S1_STEP
#define S1_STEP(g) *(LAS unsigned short*)(K16 + (4 * g + ql) * 8192 + koff) = (unsigned short)key##g;
                    S1_STEP(0) S1_STEP(1) S1_STEP(2) S1_STEP(3)
#undef S1_STEP
                }
            }
#pragma unroll
            for (int j = 0; j < 4; ++j) { A0[j] = N0[j]; A1[j] = N1[j]; }
        }
    }
    __syncthreads();
    if (t0 < 256) {
#pragma unroll 1
        for (int qq = 0; qq < 2; ++qq) { const int q = 2 * w + qq, nvalid = t0 + q + 1; LAS unsigned short* list = LIST + q * 256;
            for (int i = lane; i < 256; i += 64) list[i] = (unsigned short)(i < nvalid ? i : 0); }
    } else {
#ifndef REP_S2
#define REP_S2 1
#endif
#pragma unroll 1
        for (int qq = 0; qq < 2 * REP_S2; ++qq) {
            const int q = 2 * w + (qq & 1), nvalid = t0 + q + 1;
            LAS unsigned short* list = LIST + q * 256;
            const int ngrp = (nvalid + 511) >> 9;
            unsigned P[32];
#pragma unroll
            for (int grp = 0; grp < 8; ++grp) {
                if (grp < ngrp) { const u32x4 r = *(const LAS u32x4*)(K16 + q * 8192 + grp * 1024 + lane * 16);
#pragma unroll
                    for (int i = 0; i < 4; ++i) { const int g = 4 * grp + i; const int thr = nvalid - 128 * g; unsigned rr = r[i];
                        if (thr < 128) rr &= ((lane < thr) ? 0xffffu : 0u) | ((lane < thr - 64) ? 0xffff0000u : 0u);
                        P[g] = rr; }
                } else {
#pragma unroll
                    for (int i = 0; i < 4; ++i) P[4 * grp + i] = 0u;
                }
            }
            unsigned one2 = 0x00010001u; asm volatile("" : "+v"(one2));
#define DSA_PKCOUNT(dst, c1) do { const unsigned c1p_ = (c1) | ((c1) << 16); unsigned a_ = 0u; \
                _Pragma("unroll") for (int grp = 0; grp < 8; ++grp) if (grp < ngrp) { _Pragma("unroll") for (int i = 0; i < 4; ++i) { unsigned y_; \
                    asm("v_pk_sub_u16 %0, %1, %2 clamp\n\tv_pk_min_u16 %0, %0, %3" : "=&v"(y_) : "v"(P[4 * grp + i]), "v"(c1p_), "v"(one2)); a_ += y_; } } \
                dst = (int)((a_ & 0xffffu) + (a_ >> 16)); } while (0)
            LAS unsigned* hist = (LAS unsigned*)(F.lds + AUX_OFF + 8192) + w * 256;
            unsigned T; int tot_gt;
            { unsigned hi8 = 0u; int above = 0;
#pragma unroll
              for (int lvl = 0; lvl < 2; ++lvl) {
                  { unsigned z_ = 0u; asm volatile("" : "+v"(z_)); *(LAS u32x4*)(hist + 4 * lane) = (u32x4){z_, z_, z_, z_}; }
                  asm volatile("s_waitcnt lgkmcnt(0)" ::: "memory");
#pragma unroll
                  for (int grp = 0; grp < 8; ++grp) if (grp < ngrp) {
#pragma unroll
                      for (int i = 0; i < 4; ++i) { const unsigned lo = P[4 * grp + i] & 0xffffu, hi = P[4 * grp + i] >> 16;
                          if (lvl == 0) { __hip_atomic_fetch_add(hist + (lo >> 8), 1u, __ATOMIC_RELAXED, __HIP_MEMORY_SCOPE_WAVEFRONT); __hip_atomic_fetch_add(hist + (hi >> 8), 1u, __ATOMIC_RELAXED, __HIP_MEMORY_SCOPE_WAVEFRONT); }
                          else { if ((lo >> 8) == hi8) __hip_atomic_fetch_add(hist + (lo & 0xffu), 1u, __ATOMIC_RELAXED, __HIP_MEMORY_SCOPE_WAVEFRONT);
                                 if ((hi >> 8) == hi8) __hip_atomic_fetch_add(hist + (hi & 0xffu), 1u, __ATOMIC_RELAXED, __HIP_MEMORY_SCOPE_WAVEFRONT); } } }
                  asm volatile("s_waitcnt lgkmcnt(0)" ::: "memory");
                  const u32x4 hb = *(const LAS u32x4*)(hist + 4 * lane);
                  const int sl = (int)(hb.x + hb.y + hb.z + hb.w);
                  int inc = sl;
                  inc += __builtin_amdgcn_update_dpp(0, inc, 0x111, 0xf, 0xf, false); inc += __builtin_amdgcn_update_dpp(0, inc, 0x112, 0xf, 0xf, false);
                  inc += __builtin_amdgcn_update_dpp(0, inc, 0x114, 0xf, 0xf, false); inc += __builtin_amdgcn_update_dpp(0, inc, 0x118, 0xf, 0xf, false);
                  const int r0 = __builtin_amdgcn_readlane(inc, 15), r1 = __builtin_amdgcn_readlane(inc, 31), r2 = __builtin_amdgcn_readlane(inc, 47), r3 = __builtin_amdgcn_readlane(inc, 63);
                  inc += (fq >= 1 ? r0 : 0) + (fq >= 2 ? r1 : 0) + (fq >= 3 ? r2 : 0);
                  const int total = r0 + r1 + r2 + r3;
                  const int want = 256 - above;
                  int run = total - inc;
                  int fb = -1, fa = 0;
                  { const int h3 = (int)hb.w, h2 = (int)hb.z, h1 = (int)hb.y, h0 = (int)hb.x;
                    if (run < want && run + h3 >= want) { fb = 3; fa = run; } run += h3;
                    if (run < want && run + h2 >= want) { fb = 2; fa = run; } run += h2;
                    if (run < want && run + h1 >= want) { fb = 1; fa = run; } run += h1;
                    if (run < want && run + h0 >= want) { fb = 0; fa = run; } }
                  const unsigned long long fm = __ballot(fb >= 0);
                  const int src = (int)__builtin_ctzll(fm);
                  const int bstar = __builtin_amdgcn_readlane(4 * lane + fb, src), abv = __builtin_amdgcn_readlane(fa, src);
                  if (lvl == 0) { hi8 = (unsigned)bstar; above = abv; } else { T = (hi8 << 8) | (unsigned)bstar; tot_gt = above + abv; }
              } }
            int cge_l, cgt_l; DSA_PKCOUNT(cge_l, T - 1u); DSA_PKCOUNT(cgt_l, T);
            const int tot_ge = wave_total_i(cge_l);
            const bool alltie = (tot_ge == 256);
            const int c_l = alltie ? cge_l : cgt_l; const unsigned thrT = alltie ? T : T + 1u;
            int inc = c_l;
            inc += __builtin_amdgcn_update_dpp(0, inc, 0x111, 0xf, 0xf, false); inc += __builtin_amdgcn_update_dpp(0, inc, 0x112, 0xf, 0xf, false);
            inc += __builtin_amdgcn_update_dpp(0, inc, 0x114, 0xf, 0xf, false); inc += __builtin_amdgcn_update_dpp(0, inc, 0x118, 0xf, 0xf, false);
            { const int r0 = __builtin_amdgcn_readlane(inc, 15), r1 = __builtin_amdgcn_readlane(inc, 31), r2 = __builtin_amdgcn_readlane(inc, 47);
              inc += (fq >= 1 ? r0 : 0) + (fq >= 2 ? r1 : 0) + (fq >= 3 ? r2 : 0); }
            int kpos_ = inc - c_l;
#pragma unroll
            for (int grp = 0; grp < 8; ++grp) if (grp < ngrp) {
#pragma unroll
                for (int i = 0; i < 4; ++i) { const int g = 4 * grp + i; const unsigned lo = P[g] & 0xffffu, hi = P[g] >> 16;
                    if (lo >= thrT) { list[kpos_] = (unsigned short)(128 * g + lane); ++kpos_; }
                    if (hi >= thrT) { list[kpos_] = (unsigned short)(128 * g + 64 + lane); ++kpos_; } } }
            if (!alltie) {
                int rem = 256 - tot_gt, pos = tot_gt; const unsigned long long lt = (1ull << lane) - 1ull;
#pragma unroll
                for (int grp = 0; grp < 8; ++grp) if (grp < ngrp) {
#pragma unroll
                    for (int i = 0; i < 8; ++i) { const int g = 4 * grp + (i >> 1); const unsigned val = (i & 1) ? (P[g] >> 16) : (P[g] & 0xffffu);
                        const bool eq = (val == T); const unsigned long long beq = __ballot(eq);
                        if (beq != 0ull) { const int rank = __popcll(beq & lt); if (eq && rank < rem) list[pos + rank] = (unsigned short)(128 * g + 64 * (i & 1) + lane);
                            const int n = __popcll(beq), take = n < rem ? n : rem; pos += take; rem -= take; } } }
            }
#undef DSA_PKCOUNT
        }
    }
    __syncthreads();
    LAS unsigned char* Vs = F.lds + w * 16384;
#ifndef REP_S3
#define REP_S3 1
#endif
#pragma unroll 1
    for (int qq = 0; qq < 2 * REP_S3; ++qq) {
        const int q = 2 * w + (qq & 1), tq = t0 + q; const int nsel = (tq + 1 < 256) ? tq + 1 : 256;
        const size_t nq = nb0 + tq;
        const LAS unsigned short* list = LIST + q * 256;
        bf16x8 Qf[2];
#pragma unroll
        for (int ks = 0; ks < 2; ++ks) { u32x4 raw = {0u, 0u, 0u, 0u}; if (fr < 8) raw = *(const GAS u32x4*)(PA + nq * NPA + PA_Q + fr * 64 + 8 * fq + 32 * ks); Qf[ks] = __builtin_bit_cast(bf16x8, raw); }
        float lg[16][4];
#ifdef REP_S3K
#pragma unroll 1
        for (int repk = 0; repk < REP_S3K; ++repk)
#endif
        const int st_off = (lane >> 3) * 128 + (((lane & 7) ^ ((lane >> 3) & 7)) * 16);
        const int rd0 = fr * 128 + ((fq ^ (fr & 7)) * 16), rd1 = fr * 128 + (((fq + 4) ^ (fr & 7)) * 16);
#pragma unroll
        for (int hb = 0; hb < 2; ++hb) {
#pragma unroll
            for (int ib = 0; ib < 2; ++ib) { u32x4 kv[8];
#pragma unroll
                for (int i = 0; i < 8; ++i) { const int piece = (8 * ib + i) * 64 + lane; const int key = (int)list[128 * hb + (piece >> 3)];
                    kv[i] = *(const GAS u32x4*)(KA + (nb0 + key) * 64 + 8 * (lane & 7)); }
                __builtin_amdgcn_sched_barrier(0);
#pragma unroll
                for (int i = 0; i < 8; ++i) *(LAS u32x4*)(Vs + st_off + (8 * ib + i) * 1024) = kv[i];
            }
            asm volatile("s_waitcnt lgkmcnt(0)" ::: "memory");
#pragma unroll
            for (int j = 0; j < 8; ++j) { const int tt = 8 * hb + j;
                const bf16x8 A0 = *(const LAS bf16x8*)(Vs + rd0 + j * 2048), A1 = *(const LAS bf16x8*)(Vs + rd1 + j * 2048);
                f32x4 d = __builtin_amdgcn_mfma_f32_16x16x32_bf16(A0, Qf[0], (f32x4){0.f, 0.f, 0.f, 0.f}, 0, 0, 0);
                d = __builtin_amdgcn_mfma_f32_16x16x32_bf16(A1, Qf[1], d, 0, 0, 0);
#pragma unroll
                for (int r = 0; r < 4; ++r) lg[tt][r] = (16 * tt + 4 * fq + r < nsel) ? d[r] : -INFINITY; }
            asm volatile("s_waitcnt lgkmcnt(0)" ::: "memory");
        }
        float m = lg[0][0];
#pragma unroll
        for (int tt = 0; tt < 16; ++tt)
#pragma unroll
            for (int r = 0; r < 4; ++r) m = fmaxf(m, lg[tt][r]);
        m = fmaxf(m, shx(m, 16, lane)); m = fmaxf(m, shx(m, 32, lane));
        float den = 0.f;
#pragma unroll
        for (int tt = 0; tt < 16; ++tt)
#pragma unroll
            for (int r = 0; r < 4; ++r) { lg[tt][r] = __expf(lg[tt][r] - m); den += lg[tt][r]; }
        den += shx(den, 16, lane); den += shx(den, 32, lane);
        f32x4 acc[4];
#pragma unroll
        for (int nt = 0; nt < 4; ++nt) acc[nt] = (f32x4){0.f, 0.f, 0.f, 0.f};
#ifdef REP_S3V
#pragma unroll 1
        for (int repv = 0; repv < REP_S3V; ++repv) {
#pragma unroll
        for (int nt = 0; nt < 4; ++nt) acc[nt] = (f32x4){0.f, 0.f, 0.f, 0.f};
#endif
#pragma unroll
        for (int hh = 0; hh < 2; ++hh) {
#pragma unroll
            for (int ib = 0; ib < 2; ++ib) {
                u32x4 vv[8];
#pragma unroll
                for (int i = 0; i < 8; ++i) { const int piece = (8 * ib + i) * 64 + lane, row = piece >> 3, c = piece & 7; const int key = (int)list[128 * hh + row];
                    vv[i] = *(const GAS u32x4*)(VA + (nb0 + key) * 64 + 8 * c); }
                __builtin_amdgcn_sched_barrier(0);
#pragma unroll
                for (int i = 0; i < 8; ++i) { const int piece = (8 * ib + i) * 64 + lane; *(LAS u32x4*)(Vs + piece * 16) = vv[i]; }
            }
            asm volatile("s_waitcnt lgkmcnt(0)" ::: "memory");
#pragma unroll
            for (int s4 = 0; s4 < 4; ++s4) { const int s = 4 * hh + s4;
                u32x4 pa; pa.x = cvt_pk_bf16(lg[2 * s][0], lg[2 * s][1]); pa.y = cvt_pk_bf16(lg[2 * s][2], lg[2 * s][3]); pa.z = cvt_pk_bf16(lg[2 * s + 1][0], lg[2 * s + 1][1]); pa.w = cvt_pk_bf16(lg[2 * s + 1][2], lg[2 * s + 1][3]);
                const bf16x8 Pa = __builtin_bit_cast(bf16x8, pa);
                const int rowa = 32 * s4 + 4 * fq + (fr >> 2);
#pragma unroll
                for (int nt = 0; nt < 4; ++nt) {
                    const v4i16_t lo = __builtin_amdgcn_ds_read_tr16_b64_v4i16((LAS v4i16_t*)(Vs + rowa * 128 + (16 * nt + 4 * (fr & 3)) * 2));
                    const v4i16_t hi = __builtin_amdgcn_ds_read_tr16_b64_v4i16((LAS v4i16_t*)(Vs + (rowa + 16) * 128 + (16 * nt + 4 * (fr & 3)) * 2));
                    bf16x8 Bv; Bv[0] = lo[0]; Bv[1] = lo[1]; Bv[2] = lo[2]; Bv[3] = lo[3]; Bv[4] = hi[0]; Bv[5] = hi[1]; Bv[6] = hi[2]; Bv[7] = hi[3];
                    acc[nt] = __builtin_amdgcn_mfma_f32_16x16x32_bf16(Pa, Bv, acc[nt], 0, 0, 0); } }
            asm volatile("s_waitcnt lgkmcnt(0)" ::: "memory");
        }
#ifdef REP_S3V
        }
#endif
        float dn[4];
#pragma unroll
        for (int r = 0; r < 4; ++r) dn[r] = __builtin_bit_cast(float, __builtin_amdgcn_ds_bpermute((4 * (fq & 1) + r) << 2, __builtin_bit_cast(int, den)));
        if (fq < 2) {
#pragma unroll
            for (int nt = 0; nt < 4; ++nt)
#pragma unroll
                for (int r = 0; r < 4; ++r) Y[nq * 1536 + (4 * fq + r) * 64 + 16 * nt + fr] = (bf16)f2bf(acc[nt][r] / dn[r]);
        }
    }
}

#ifdef GLA_NAIVE
constexpr int NGLA = 32;
#else
constexpr int NGLA = 2048;
#endif
#ifdef DSA_NAIVE
constexpr int NDSA = 4096;
#else
constexpr int NDSA = 2048;
#endif
#ifdef GMLP_NAIVE
constexpr int NGM = 1024;
#else
constexpr int NGM = 256;
#endif
__device__ __forceinline__ void phase_mixer(Frame& F, int l, int slot = 0, int types = 7) {
    gu32* head = F.ctl + CW_QUEUE + 64 * (l + 2 * slot);
    for (;;) {
        __syncthreads();
        if (F.wave == 0 && fresh_lane() == 0) F.MISC[64] = __hip_atomic_fetch_add(head, 1u, __ATOMIC_RELAXED, __HIP_MEMORY_SCOPE_AGENT);
        __syncthreads();
        const int u = (int)F.MISC[64];
        if (u >= NDSA + NGLA + NGM) break;
        if (u < NDSA) { if (EN_B2 && (types & 2)) {
#ifdef DSA_NAIVE
            dsa_unit(F, u);
#else
            dsa16_unit(F, u);
#endif
        } }
        else if (u < NDSA + NGLA) { if (EN_B1 && (types & 1)) {
#ifdef GLA_NAIVE
            gla_unit(F, l, u - NDSA);
#else
            gla_local_unit(F, l, u - NDSA);
#endif
        } }
        else { if (EN_B3 && (types & 4)) {
#ifdef GMLP_NAIVE
            gmlp_unit(F, l, u - NDSA - NGLA);
#else
            gmlp16_unit(F, l, u - NDSA - NGLA);
#endif
        } }
    }
}
__device__ __forceinline__ void phase_gla_out(Frame& F, int l) {
#ifndef GLA_NAIVE
    for (int u = F.wg; u < 2048; u += F.G) gla_out_unit(F, l, u);
#endif
}

template <int CTRL> __device__ __forceinline__ float dpp_add(float v) { return v + dppf<CTRL>(v); }
__device__ __forceinline__ float row16_sum(float v) { v = dpp_add<0xB1>(v); v = dpp_add<0x4E>(v); v = dpp_add<0x141>(v); v = dpp_add<0x140>(v); return v; }
__device__ __forceinline__ void phase_ln_router(Frame& F, int l) {
    const GAS float* WR = (const GAS float*)(F.ws + WS_WR) + (size_t)l * 36 * DM;
    LAS float* wr = (LAS float*)F.lds;
    for (int i = F.tid; i < 36 * 256; i += 512) ((LAS f32x4*)wr)[i] = ((const GAS f32x4*)WR)[i];
    if (F.tid < 32) F.MISC[16 + F.tid] = 0u;
    __syncthreads();
    GAS bf16* HB = (GAS bf16*)(F.ws + WS_HB); const GAS bf16* T = (const GAS bf16*)F.H; GAS int* EID = (GAS int*)(F.ws + WS_ROUTE); GAS float* EW = (GAS float*)(F.ws + WS_ROUTE + 256 * 1024);
    const GAS float* g = ((const GAS float*)F.in[17]) + l * DM; const GAS float* bb = ((const GAS float*)F.in[18]) + l * DM; const GAS float* brg = ((const GAS float*)F.in[20]) + l * 4; const GAS float* bre = ((const GAS float*)F.in[22]) + l * 32;
    int lane = F.lane; asm volatile("" : "+v"(lane));
    const int sub = lane & 15, rr = lane >> 4;
    for (int r0 = F.wg * 128; r0 < NTOK; r0 += F.G * 128) {
        u32x4 nx[8];
#pragma unroll
        for (int q = 0; q < 8; ++q) nx[q] = *(const GAS u32x4*)(T + (size_t)(r0 + F.wave * 16 + rr) * DM + 8 * (sub + 16 * q));
#pragma unroll 1
        for (int j = 0; j < 4; ++j) { const int m = r0 + F.wave * 16 + 4 * j + rr;
            float v[64]; float s = 0.f;
#pragma unroll
            for (int q = 0; q < 8; ++q) { const u32x4 x = nx[q]; v[8 * q] = bflo(x.x); v[8 * q + 1] = bfhi(x.x); v[8 * q + 2] = bflo(x.y); v[8 * q + 3] = bfhi(x.y); v[8 * q + 4] = bflo(x.z); v[8 * q + 5] = bfhi(x.z); v[8 * q + 6] = bflo(x.w); v[8 * q + 7] = bfhi(x.w); }
            { const int mn = (j < 3) ? m + 4 : m;
#pragma unroll
              for (int q = 0; q < 8; ++q) nx[q] = *(const GAS u32x4*)(T + (size_t)mn * DM + 8 * (sub + 16 * q)); }
#pragma unroll
            for (int i = 0; i < 64; ++i) s += v[i];
            const float mean = row16_sum(s) * (1.f / DM); float s2 = 0.f;
#pragma unroll
            for (int i = 0; i < 64; ++i) { v[i] -= mean; s2 += v[i] * v[i]; }
            const float rstd = 1.f / sqrtf(row16_sum(s2) * (1.f / DM) + LN_EPS);
#pragma unroll
            for (int q = 0; q < 8; ++q) { const int c = 8 * (sub + 16 * q); const f32x4 g0 = *(const GAS f32x4*)(g + c), g1 = *(const GAS f32x4*)(g + c + 4), b0 = *(const GAS f32x4*)(bb + c), b1 = *(const GAS f32x4*)(bb + c + 4);
#pragma unroll
                for (int i = 0; i < 4; ++i) { v[8 * q + i] = v[8 * q + i] * rstd * g0[i] + b0[i]; v[8 * q + 4 + i] = v[8 * q + 4 + i] * rstd * g1[i] + b1[i]; }
                u32x4 wv; wv.x = pk2(v[8 * q], v[8 * q + 1]); wv.y = pk2(v[8 * q + 2], v[8 * q + 3]); wv.z = pk2(v[8 * q + 4], v[8 * q + 5]); wv.w = pk2(v[8 * q + 6], v[8 * q + 7]);
                *(GAS u32x4*)(HB + (size_t)m * DM + c) = wv; }
            float lgt[36];
#pragma unroll
            for (int o = 0; o < 36; ++o) { float p = 0.f;
#pragma unroll
                for (int q = 0; q < 8; ++q) { const f32x4 w0 = *(const LAS f32x4*)(wr + o * DM + 8 * (sub + 16 * q)), w1 = *(const LAS f32x4*)(wr + o * DM + 8 * (sub + 16 * q) + 4);
                    p += v[8 * q] * w0.x + v[8 * q + 1] * w0.y + v[8 * q + 2] * w0.z + v[8 * q + 3] * w0.w + v[8 * q + 4] * w1.x + v[8 * q + 5] * w1.y + v[8 * q + 6] * w1.z + v[8 * q + 7] * w1.w; }
                lgt[o] = row16_sum(p); }
            int gi = 0; float gm = lgt[0] + brg[0];
#pragma unroll
            for (int q = 1; q < 4; ++q) { const float x = lgt[q] + brg[q]; if (x > gm) { gm = x; gi = q; } }
            float gs = 0.f;
#pragma unroll
            for (int q = 0; q < 4; ++q) gs += __expf(lgt[q] + brg[q] - gm);
            const float gp = 1.f / gs;
            float el[8];
#pragma unroll
            for (int q = 0; q < 8; ++q) { float x = lgt[4 + q] + bre[q];
                x = (gi == 1) ? lgt[12 + q] + bre[8 + q] : x; x = (gi == 2) ? lgt[20 + q] + bre[16 + q] : x; x = (gi == 3) ? lgt[28 + q] + bre[24 + q] : x; el[q] = x; }
            int i0 = 0; float v0 = el[0];
#pragma unroll
            for (int q = 1; q < 8; ++q) if (el[q] > v0) { v0 = el[q]; i0 = q; }
            int i1 = -1; float v1 = -INFINITY;
#pragma unroll
            for (int q = 0; q < 8; ++q) if (q != i0 && el[q] > v1) { v1 = el[q]; i1 = q; }
            const float ex = __expf(v1 - v0), w0 = gp / (1.f + ex), w1 = gp * ex / (1.f + ex);
            if (sub == 0) { const int e0 = gi * 8 + i0, e1 = gi * 8 + i1;
                EID[2 * m] = e0; EID[2 * m + 1] = e1; EW[2 * m] = w0; EW[2 * m + 1] = w1;
                __hip_atomic_fetch_add((LAS unsigned*)(F.lds + MISC_OFF) + 16 + e0, 1u, __ATOMIC_RELAXED, __HIP_MEMORY_SCOPE_WORKGROUP);
                __hip_atomic_fetch_add((LAS unsigned*)(F.lds + MISC_OFF) + 16 + e1, 1u, __ATOMIC_RELAXED, __HIP_MEMORY_SCOPE_WORKGROUP); } }
    }
    __syncthreads();
    if (F.tid < 32) ((GAS int*)(F.ws + WS_CNTWG))[F.wg * 32 + F.tid] = (int)F.MISC[16 + F.tid];
}
__device__ __forceinline__ void phase_dispatch(Frame& F) {
    const GAS int* CNT = (const GAS int*)(F.ws + WS_CNTWG); const GAS int* EID = (const GAS int*)(F.ws + WS_ROUTE); const GAS float* EW = (const GAS float*)(F.ws + WS_ROUTE + 256 * 1024);
    GAS int* SROW = (GAS int*)(F.ws + WS_SROW); GAS int* ROWMAP = (GAS int*)(F.ws + WS_ROWMAP); GAS float* CWROW = (GAS float*)(F.ws + WS_CWROW); GAS int* META = (GAS int*)(F.ws + WS_META);
    LAS int* tot = (LAS int*)(F.lds + AUX_OFF);
    if (F.tid < 32) { int t = 0, mine = 0; for (int w = 0; w < F.G; ++w) { const int c = ld_i32(CNT + w * 32 + F.tid); t += c; if (w < F.wg) mine += c; } tot[F.tid] = t; tot[32 + F.tid] = mine; tot[96 + F.tid] = 0; }
    __syncthreads();
    if (F.tid == 0) { int rb = 0;
#pragma clang loop unroll(disable) vectorize(disable)
        for (int e = 0; e < 32; ++e) { tot[64 + e] = rb; rb += ((tot[e] + 255) >> 8) << 8; }
        tot[128] = rb; }
    __syncthreads();
    if (F.wg == 0) { const int nt = tot[128] >> 8; if (F.tid == 0) META[0] = nt;
        if (F.tid < nt) { int e = 0;
#pragma clang loop unroll(disable) vectorize(disable)
            for (int q = 1; q < 32; ++q) if (tot[64 + q] <= F.tid * 256) e = q;
            META[16 + F.tid] = e; } }
    for (int r0 = F.wg * 128; r0 < NTOK; r0 += F.G * 128) {
        if (F.tid < 256) { const int tok = r0 + (F.tid >> 1), slot = F.tid & 1; const int e = EID[2 * tok + slot];
            const int pos = (int)__hip_atomic_fetch_add((LAS unsigned*)&tot[96 + e], 1u, __ATOMIC_RELAXED, __HIP_MEMORY_SCOPE_WORKGROUP);
            const int sr = tot[64 + e] + tot[32 + e] + pos;
            ROWMAP[sr] = tok; CWROW[sr] = EW[2 * tok + slot]; SROW[2 * tok + slot] = sr; } }
    if (F.wg < 32) { const int e = F.wg; const int lo = tot[64 + e] + tot[e], hi = tot[64 + e] + (((tot[e] + 255) >> 8) << 8);
        for (int r = lo + F.tid; r < hi; r += 512) { ROWMAP[r] = 0; CWROW[r] = 0.f; } }
}
__device__ __forceinline__ void phase_ln2(Frame& F, int l) {
    GAS bf16* HB = (GAS bf16*)(F.ws + WS_HB); const GAS int* SROW = (const GAS int*)(F.ws + WS_SROW); const GAS bf16* FF2 = (const GAS bf16*)(F.ws + WS_FF2);
    const GAS float* g = ((const GAS float*)F.in[26]) + l * DM; const GAS float* bb = ((const GAS float*)F.in[27]) + l * DM; int lane = F.lane; asm volatile("" : "+v"(lane));
    const int gw = F.wg * 8 + F.wave, NGW = F.G * 8; const bool last = (l == DEPTH - 1);
    int m = gw;
    u32x4 hn[2], an[2], cn[2];
    if (m < NTOK) { const int s0 = ld_i32(SROW + 2 * m), s1 = ld_i32(SROW + 2 * m + 1);
#pragma unroll
        for (int j = 0; j < 2; ++j) { hn[j] = *(const GAS u32x4*)(HB + (size_t)m * DM + 8 * lane + 512 * j); an[j] = *(const GAS u32x4*)(FF2 + (size_t)s0 * DM + 8 * lane + 512 * j); cn[j] = *(const GAS u32x4*)(FF2 + (size_t)s1 * DM + 8 * lane + 512 * j); } }
#pragma unroll 1
    for (; m < NTOK; m += NGW) {
        float v[16];
#pragma unroll
        for (int j = 0; j < 2; ++j) { const u32x4 h = hn[j], a = an[j], c = cn[j];
            v[8 * j] = bflo(h.x) * DN_ALPHA + (bflo(a.x) + bflo(c.x)); v[8 * j + 1] = bfhi(h.x) * DN_ALPHA + (bfhi(a.x) + bfhi(c.x)); v[8 * j + 2] = bflo(h.y) * DN_ALPHA + (bflo(a.y) + bflo(c.y)); v[8 * j + 3] = bfhi(h.y) * DN_ALPHA + (bfhi(a.y) + bfhi(c.y));
            v[8 * j + 4] = bflo(h.z) * DN_ALPHA + (bflo(a.z) + bflo(c.z)); v[8 * j + 5] = bfhi(h.z) * DN_ALPHA + (bfhi(a.z) + bfhi(c.z)); v[8 * j + 6] = bflo(h.w) * DN_ALPHA + (bflo(a.w) + bflo(c.w)); v[8 * j + 7] = bfhi(h.w) * DN_ALPHA + (bfhi(a.w) + bfhi(c.w)); }
        const int mn = m + NGW;
        if (mn < NTOK) { const int s0 = ld_i32(SROW + 2 * mn), s1 = ld_i32(SROW + 2 * mn + 1);
#pragma unroll
            for (int j = 0; j < 2; ++j) { hn[j] = *(const GAS u32x4*)(HB + (size_t)mn * DM + 8 * lane + 512 * j); an[j] = *(const GAS u32x4*)(FF2 + (size_t)s0 * DM + 8 * lane + 512 * j); cn[j] = *(const GAS u32x4*)(FF2 + (size_t)s1 * DM + 8 * lane + 512 * j); } }
        float s = 0.f;
#pragma unroll
        for (int i = 0; i < 16; ++i) s += v[i];
        const float mean = wave_sum(s, lane) * (1.f / DM); float s2 = 0.f;
#pragma unroll
        for (int i = 0; i < 16; ++i) { v[i] -= mean; s2 += v[i] * v[i]; }
        const float rstd = 1.f / sqrtf(wave_sum(s2, lane) * (1.f / DM) + LN_EPS);
#pragma unroll
        for (int j = 0; j < 2; ++j) { const int c = 8 * lane + 512 * j; const f32x4 g0 = *(const GAS f32x4*)(g + c), g1 = *(const GAS f32x4*)(g + c + 4), b0 = *(const GAS f32x4*)(bb + c), b1 = *(const GAS f32x4*)(bb + c + 4);
#pragma unroll
            for (int i = 0; i < 4; ++i) { v[8 * j + i] = v[8 * j + i] * rstd * g0[i] + b0[i]; v[8 * j + 4 + i] = v[8 * j + 4 + i] * rstd * g1[i] + b1[i]; }
            if (last) { *(GAS f32x4*)(F.H + (size_t)m * DM + c) = (f32x4){v[8 * j], v[8 * j + 1], v[8 * j + 2], v[8 * j + 3]}; *(GAS f32x4*)(F.H + (size_t)m * DM + c + 4) = (f32x4){v[8 * j + 4], v[8 * j + 5], v[8 * j + 6], v[8 * j + 7]}; }
            else { u32x4 wv; wv.x = pk2(v[8 * j], v[8 * j + 1]); wv.y = pk2(v[8 * j + 2], v[8 * j + 3]); wv.z = pk2(v[8 * j + 4], v[8 * j + 5]); wv.w = pk2(v[8 * j + 6], v[8 * j + 7]); *(GAS u32x4*)(HB + (size_t)m * DM + c) = wv; } }
    }
}

#ifndef EN_P
#define EN_P 1
#endif
#ifndef EN_A
#define EN_A 1
#endif
#ifndef EN_B
#define EN_B 1
#endif
#ifndef EN_C
#define EN_C 1
#endif
#ifndef EN_D
#define EN_D 1
#endif
#ifndef EN_E
#define EN_E 1
#endif
#ifndef EN_F
#define EN_F 1
#endif
#ifndef EN_G
#define EN_G 1
#endif
#ifndef EN_H
#define EN_H 1
#endif
#ifndef EN_I
#define EN_I 1
#endif
#ifndef EN_J
#define EN_J 1
#endif
constexpr int PPL = 12;
constexpr int N_PHASES = 1 + PPL * DEPTH;
#ifndef MK_ONE_LAUNCH
#define MK_ONE_LAUNCH 0
#endif
struct Args { const float* in[28]; float* out; unsigned char* ws; int ph_lo, ph_hi; };
static_assert(sizeof(Args) == 28 * 8 + 8 + 8 + 8, "no padding bytes in the argument struct");


__device__ __forceinline__ unsigned opaque_u32(unsigned x) { unsigned v; asm volatile("v_mov_b32 %0, %1" : "=v"(v) : "s"(x)); return (unsigned)__builtin_amdgcn_readfirstlane((int)v); }
__device__ __forceinline__ unsigned long long opaque_u64(unsigned long long x) { return ((unsigned long long)opaque_u32((unsigned)(x >> 32)) << 32) | opaque_u32((unsigned)x); }
__device__ __forceinline__ void launder(Frame& F) {
    F.ws = (GAS unsigned char*)opaque_u64((unsigned long long)F.ws); F.H = (GAS float*)opaque_u64((unsigned long long)F.H);
    F.ctl = (gu32*)opaque_u64((unsigned long long)F.ctl);
    unsigned z0 = 0u; asm volatile("" : "+v"(z0)); int ln = (int)__builtin_amdgcn_mbcnt_hi(~0u, __builtin_amdgcn_mbcnt_lo(~0u, z0));
    F.wave = (int)opaque_u32((unsigned)F.wave); F.lane = ln; F.tid = F.wave * 64 + ln;
    F.G = (int)opaque_u32((unsigned)F.G); F.wg = (int)opaque_u32((unsigned)F.wg);
}
__global__ void __launch_bounds__(512, 2) mk_fwd(Args args) {
    extern __shared__ __attribute__((aligned(16))) unsigned char lds_raw[];
    Frame F;
    F.lds = (LAS unsigned char*)lds_raw;
    F.MISC = (volatile LAS unsigned*)(F.lds + MISC_OFF);
    F.tid = threadIdx.x; F.lane = F.tid & 63; F.wave = __builtin_amdgcn_readfirstlane(F.tid >> 6);
    F.G = gridDim.x; F.wg = blockIdx.x;
    F.in = args.in;
    F.pos = (const GAS int*)args.in[1];
    F.H = (GAS float*)args.out; F.ws = (GAS unsigned char*)args.ws;
    F.ctl = (gu32*)(args.ws + WS_CTL);
    for (int u = F.tid; u < (LDS_BYTES - MISC_OFF) / 4; u += 512) ((LAS unsigned*)(F.lds + MISC_OFF))[u] = 0u;
    __syncthreads();
    const int lo = args.ph_lo, hi = args.ph_hi;
    const bool multi = (hi - lo) > 1;
    XcdBarrier bar; bar.bar = (unsigned*)(F.ctl + CW_BAR); bar.x = 0; bar.st = nullptr;
    if (multi) bar = xcd_barrier_post((unsigned*)(F.ctl + CW_BAR), F.MISC + 8);
#define IN(k) (lo <= (k) && (k) < hi)
#define SEAM(k) do { if (IN(k) && IN((k) + 1)) xcd_barrier(bar); } while (0)

#ifdef DUP_P
    for (int rep = 0; rep < 2; ++rep)
#endif
    if (EN_P && IN(0)) { launder(F); phase_prologue(F); }
    SEAM(0);
#define HB ((GAS bf16*)(F.ws + WS_HB))
#define PA ((GAS bf16*)(F.ws + WS_PA))
#define Y ((GAS bf16*)(F.ws + WS_Y))
#define HM ((GAS bf16*)F.H + (size_t)NTOK * DM)
#define TT ((GAS bf16*)F.H)
    for (int l = 0; l < DEPTH; ++l) {
        const int pb = 1 + PPL * l;
#define wd (F.ws + WS_WDENSE + (size_t)l * WD_LAYER)
#ifdef DUP_A
        for (int rep = 0; rep < 2; ++rep)
#endif
        if (EN_A && IN(pb + 0)) { launder(F);
            DenseSched S; S.init(NTOK / 256, NPA / 256, F.G, F.wg, (const void*)HB, (size_t)256 * DM * 2, (const void*)(wd + WD_WA), (size_t)256 * DM * 2);
            EpiA E{PA, (GAS bf16*)(F.ws + WS_KA), (GAS bf16*)(F.ws + WS_VA), (GAS bf16*)(F.ws + WS_KI), (GAS float*)(F.ws + WS_WI), (GAS float*)(F.ws + WS_GLR), (const GAS float*)(F.ws + WS_ROPE), ((const GAS float*)F.in[5]) + l * 64};
            pg8::gemm_phase<EpiA, DenseSched, false>(F.lds, S, E, DM, DM, F.wave);
        }
        SEAM(pb + 0);
        if (EN_B && IN(pb + 1)) { launder(F); phase_mixer(F, l);
#ifdef DUP_B
            launder(F); phase_mixer(F, l, 1, DUP_B);
#endif
        }
        SEAM(pb + 1);
        if (EN_B && IN(pb + 2)) { launder(F); gla_scan_phase(F); }
        SEAM(pb + 2);
        if (EN_B && IN(pb + 3)) { launder(F); phase_gla_out(F, l); }
        SEAM(pb + 3);
#ifdef DUP_D
        for (int rep = 0; rep < 2; ++rep)
#endif
        if (EN_D && IN(pb + 4)) { launder(F);
            DenseSched S; S.init(NTOK / 256, DM / 256, F.G, F.wg, (const void*)Y, (size_t)256 * 1536 * 2, (const void*)(wd + WD_WBR), (size_t)256 * 512 * 2);
            S.nsub = 3; S.asub = 512 * 2; S.bsub = (size_t)1024 * 512 * 2;
            EpiP E{PA};
            pg8::gemm_phase<EpiP, DenseSched, false>(F.lds, S, E, 512, 1536, F.wave);
        }
        SEAM(pb + 4);
#ifdef DUP_C
        for (int rep = 0; rep < 2; ++rep)
#endif
        if (EN_C && IN(pb + 5)) { launder(F);
            DenseSched S; S.init(NTOK / 256, DM / 256, F.G, F.wg, (const void*)HB, (size_t)256 * DM * 2, (const void*)(wd + WD_WG), (size_t)256 * DM * 2);
            S.nsub = 3; S.asub = 0; S.bsub = (size_t)1024 * DM * 2;
            EpiGM E{PA, HM};
            pg8::gemm_phase<EpiGM, DenseSched, false>(F.lds, S, E, DM, DM, F.wave);
        }
        SEAM(pb + 5);
        if (EN_E && IN(pb + 6)) { launder(F);
            DenseSched S; S.init(NTOK / 256, DM / 256, F.G, F.wg, (const void*)HM, (size_t)256 * DM * 2, (const void*)(wd + WD_WOUT), (size_t)256 * DM * 2);
            EpiO E{HB, TT};
            pg8::gemm_phase<EpiO, DenseSched, false>(F.lds, S, E, DM, DM, F.wave);
        }
        SEAM(pb + 6);
        if (EN_F && IN(pb + 7)) { launder(F); phase_ln_router(F, l); }
        SEAM(pb + 7);
        if (EN_G && IN(pb + 8)) { launder(F);
            { LAS float* scr = (LAS float*)(F.lds + F.wave * 16384); const int gw = F.wg * 8 + F.wave, NGW = F.G * 8;
              for (int it = gw; it < 12288; it += NGW) conv_moe_item(F, l, it, scr);
              __syncthreads(); }
            phase_dispatch(F); }
        SEAM(pb + 8);
#ifdef DUP_H
        for (int rep = 0; rep < 2; ++rep)
#endif
        if (EN_H && IN(pb + 9)) { launder(F);
            const GAS int* META = (const GAS int*)(F.ws + WS_META); const GAS int* ROWMAP = (const GAS int*)(F.ws + WS_ROWMAP);
            const int NT = ld_i32(META), NU = NT * 2;
            LAS int* meta = (LAS int*)(F.lds + AUX_OFF); LAS int* rows = (LAS int*)(F.lds + AUX_OFF + 64);
            for (int i = 0; i * F.G + F.wg < NU && i < 8; ++i) { const int L = i * F.G + F.wg, gt = L >> 1;
                if (F.tid == 0) meta[i] = ld_i32(META + 16 + gt);
                if (F.tid < 256) rows[i * 256 + F.tid] = ROWMAP[gt * 256 + F.tid]; }
            __syncthreads();
            GroupSched S{NU, F.G, F.wg, 2, (const char*)HB, (const char*)(F.ws + WS_WMOE + WM_GU), 0, (size_t)512 * DM * 2, (size_t)256 * DM * 2, meta, rows};
            EpiGU E{(GAS bf16*)(F.ws + WS_HID), (const GAS float*)(F.ws + WS_CWROW)};
            pg8::gemm_phase<EpiGU, GroupSched, true>(F.lds, S, E, DM, DM, F.wave);
        }
        SEAM(pb + 9);
#ifdef DUP_I
        for (int rep = 0; rep < 2; ++rep)
#endif
        if (EN_I && IN(pb + 10)) { launder(F);
            const GAS int* META = (const GAS int*)(F.ws + WS_META);
            const int NT = ld_i32(META), NU = NT * 4;
            LAS int* meta = (LAS int*)(F.lds + AUX_OFF);
            for (int i = 0; i * F.G + F.wg < NU && i < 8; ++i) { const int L = i * F.G + F.wg, gt = L >> 2; if (F.tid == 0) meta[i] = ld_i32(META + 16 + gt); }
            __syncthreads();
            GroupSched S{NU, F.G, F.wg, 4, (const char*)(F.ws + WS_HID), (const char*)(F.ws + WS_WMOE + WM_DN), (size_t)256 * DEXP * 2, (size_t)DM * DEXP * 2, (size_t)256 * DEXP * 2, meta, nullptr};
            EpiDN E{(GAS bf16*)(F.ws + WS_FF2)};
            pg8::gemm_phase<EpiDN, GroupSched, false>(F.lds, S, E, DEXP, DEXP, F.wave);
        }
        SEAM(pb + 10);
        if (EN_J && IN(pb + 11)) { launder(F); phase_ln2(F, l); }
        SEAM(pb + 11);
    }
#undef IN
#undef SEAM
#undef HB
#undef HM
#undef TT
#undef PA
#undef Y
#undef wd
}


#ifdef DUMP_OFF
__global__ void dump_k(const unsigned short* src, float* out) {
    for (size_t i = (size_t)blockIdx.x * blockDim.x + threadIdx.x; i < (size_t)NTOK * 1024; i += (size_t)gridDim.x * blockDim.x) { const size_t n = i >> 10, c = i & 1023; out[i] = __builtin_bit_cast(float, ((unsigned)src[n * DUMP_PITCH + c]) << 16); }
}
#endif
extern "C" void kernel_launch(void* const* d_in, const int* in_sizes, int n_in, void* d_out, int out_size, void* d_ws, size_t ws_size, hipStream_t stream) {
    static int grid = 0;
    if (grid == 0) {
        if (n_in != 28 || out_size != NTOK * DM || ws_size < WS_END) { fprintf(stderr, "kernel_launch: unexpected shapes (n_in %d out %d ws %zu); nothing launched\n", n_in, out_size, ws_size); grid = -1; return; }
        int dev = 0, cus = 0;
        if (hipGetDevice(&dev) != hipSuccess || hipDeviceGetAttribute(&cus, hipDeviceAttributeMultiprocessorCount, dev) != hipSuccess) { grid = -1; return; }
        if (hipFuncSetAttribute((const void*)mk_fwd, hipFuncAttributeMaxDynamicSharedMemorySize, LDS_BYTES) != hipSuccess) { fprintf(stderr, "kernel_launch: hipFuncSetAttribute failed\n"); grid = -1; return; }
        int per_cu = 0;
        if (hipOccupancyMaxActiveBlocksPerMultiprocessor(&per_cu, (const void*)mk_fwd, 512, LDS_BYTES) != hipSuccess || per_cu < 1) { fprintf(stderr, "kernel_launch: occupancy query says %d\n", per_cu); }
        (void)hipGetLastError();
        grid = cus;
        if (grid != 256) fprintf(stderr, "kernel_launch: %d CUs (built for 256)\n", grid);
    }
    if (grid < 0) return;
    if (hipMemsetAsync((char*)d_ws + WS_CTL, 0, CTL_ZERO_BYTES, stream) != hipSuccess) return;
    Args a{};
    for (int i = 0; i < 28; ++i) a.in[i] = (const float*)d_in[i];
    a.out = (float*)d_out; a.ws = (unsigned char*)d_ws;
#if MK_ONE_LAUNCH
    a.ph_lo = 0; a.ph_hi = N_PHASES;
    hipLaunchKernelGGL(mk_fwd, dim3(grid), dim3(512), LDS_BYTES, stream, a);
#else
#ifndef STOP_AFTER
#define STOP_AFTER (N_PHASES - 1)
#endif
#ifndef PHASE_MASK
#define PHASE_MASK 0xffffffffu
#endif
    for (int p = 0; p <= STOP_AFTER; ++p) { if (!((PHASE_MASK >> p) & 1u)) continue; a.ph_lo = p; a.ph_hi = p + 1; hipLaunchKernelGGL(mk_fwd, dim3(grid), dim3(512), LDS_BYTES, stream, a); }
#ifdef DUMP_OFF
    hipLaunchKernelGGL(dump_k, dim3(2048), dim3(256), 0, stream, (const unsigned short*)((const char*)d_ws + (size_t)(DUMP_OFF)), (float*)d_out);
#endif
#endif
}
```

```cpp
#define MK_ONE_LAUNCH 1
#include <hip/hip_runtime.h>
#include <cstdio>
#include <cstdint>

#define LAS __attribute__((address_space(3)))
#define GAS __attribute__((address_space(1)))
typedef unsigned short bf16;
typedef short bf16x8 __attribute__((ext_vector_type(8)));
typedef float f32x4 __attribute__((ext_vector_type(4)));
typedef float f32x2 __attribute__((ext_vector_type(2)));
typedef unsigned u32x4 __attribute__((ext_vector_type(4)));
typedef unsigned u32x2 __attribute__((ext_vector_type(2)));
typedef GAS unsigned gu32;

constexpr int NB = 8, SEQ = 4096, NTOK = NB * SEQ, DM = 1024, NIN = 6612, DEPTH = 2;
constexpr int NPA = 3584;
constexpr int NGT = 3072;
constexpr int NEXP = 32, DEXP = 256;
constexpr int MAXTILES = 288;
constexpr float DN_ALPHA = 1.41421356237309515f;
constexpr float LN_EPS = 1e-5f, RMS_EPS = 1e-6f;
constexpr int PA_Q = 0, PA_QI = 768, PA_BQ = 1024, PA_BK = 1280, PA_BV = 1536, PA_BR = 2048, PA_CU = 2560, PA_CV = 3072;

__device__ __forceinline__ unsigned f2bf(float f) { unsigned u = __builtin_bit_cast(unsigned, f); return (u + 0x7fffu + ((u >> 16) & 1u)) >> 16; }
__device__ __forceinline__ unsigned pk2(float lo, float hi) { return f2bf(lo) | (f2bf(hi) << 16); }
__device__ __forceinline__ float bflo(unsigned w) { return __builtin_bit_cast(float, w << 16); }
__device__ __forceinline__ float bfhi(unsigned w) { return __builtin_bit_cast(float, w & 0xffff0000u); }
__device__ __forceinline__ float bf1(bf16 h) { return __builtin_bit_cast(float, ((unsigned)h) << 16); }
typedef __bf16 bf16x2_t __attribute__((ext_vector_type(2)));
__device__ __forceinline__ unsigned cvt_pk_bf16(float lo, float hi) { const f32x2 v = {lo, hi}; const bf16x2_t b = __builtin_convertvector(v, bf16x2_t); return __builtin_bit_cast(unsigned, b); }
__device__ __forceinline__ float shx(float v, int mask, int lane) { return __builtin_bit_cast(float, __builtin_amdgcn_ds_bpermute((lane ^ mask) << 2, __builtin_bit_cast(int, v))); }
__device__ __forceinline__ int shxi(int v, int mask, int lane) { return __builtin_amdgcn_ds_bpermute((lane ^ mask) << 2, v); }
__device__ __forceinline__ float wave_sum(float v, int lane) {
#pragma unroll
    for (int o = 1; o < 64; o <<= 1) v += shx(v, o, lane);
    return v;
}
__device__ __forceinline__ float wave_max(float v, int lane) {
#pragma unroll
    for (int o = 1; o < 64; o <<= 1) v = fmaxf(v, shx(v, o, lane));
    return v;
}
__device__ __forceinline__ int wave_sum_i(int v, int lane) {
#pragma unroll
    for (int o = 1; o < 64; o <<= 1) v += shxi(v, o, lane);
    return v;
}
__device__ __forceinline__ int fresh_lane() { unsigned z0 = 0u; asm volatile("" : "+v"(z0)); return (int)__builtin_amdgcn_mbcnt_hi(~0u, __builtin_amdgcn_mbcnt_lo(~0u, z0)); }
__device__ __forceinline__ int ld_i32(const GAS int* p) { return __hip_atomic_load(p, __ATOMIC_RELAXED, __HIP_MEMORY_SCOPE_AGENT); }
__device__ __forceinline__ float ld_f32(const GAS float* p) { return __hip_atomic_load(p, __ATOMIC_RELAXED, __HIP_MEMORY_SCOPE_AGENT); }
__device__ __forceinline__ float sigmoidf_(float x) { return __builtin_amdgcn_rcpf(1.0f + __expf(-x)); }
__device__ __forceinline__ float siluf_(float x) { return x * sigmoidf_(x); }
__device__ __forceinline__ float gelu_tanh_(float x) { const float u = 0.7978845608028654f * (x + 0.044715f * x * x * x); return x * sigmoidf_(2.0f * u); }

namespace pg8 {
constexpr int BM = 256, BK = 64, HALF = 128, HTB = HALF * BK * 2, STAGE_BYTES = 8 * HTB;
__host__ __device__ __forceinline__ int lds_byte(int r, int c) { const int st = (r >> 4) * 2 + (c >> 5), rr = r & 15, cc = c & 31, ob = rr * 64 + cc * 2; return st * 1024 + (ob ^ (((ob >> 9) & 1) << 5)); }
__host__ __device__ __forceinline__ void stage_rc(int b, int& R, int& C) { const int st = b / 1024, sb = b % 1024, swz = sb ^ (((sb >> 9) & 1) << 5); R = (st >> 1) * 16 + swz / 64; C = (st & 1) * 32 + (swz % 64) / 2; }
__host__ __device__ __forceinline__ int perm32(int rho) { const int n = rho >> 4, i = rho & 15; return 8 * (i >> 2) + 4 * n + (i & 3); }

struct Unit { int pm, pn, e, slot; };

template <class Epi, class Sched, bool GATHER>
__device__ __forceinline__ void gemm_phase(LAS unsigned char* lds, const Sched& S, const Epi& E, const int K, const int lda, const int wave) {
    unsigned z0_ = 0u; asm volatile("" : "+v"(z0_)); const int lane_ = (int)__builtin_amdgcn_mbcnt_hi(~0u, __builtin_amdgcn_mbcnt_lo(~0u, z0_));
    const int wid = wave, lane = lane_, tid = wid * 64 + lane, wr = wid >> 2, wc = wid & 3, fr = lane & 15, fq = lane >> 4;
    const int nt = K / BK;
    int Rr[2], Cc[2];
    unsigned voffB[2];
#pragma unroll
    for (int i = 0; i < 2; ++i) { int R, C; stage_rc(tid * 16 + i * 8192, R, C); Rr[i] = R; Cc[i] = C; const int Rb = Epi::PERM ? ((R & ~31) + perm32(R & 31)) : R; voffB[i] = (unsigned)(Rb * K + C) * 2u; }
    const size_t kstep = (size_t)(BK * 2);
    const size_t hstepB = (size_t)HALF * K * 2;
    const unsigned ldsw = (unsigned)wid * 1024u;
    const int aoff = lds_byte(wr * 64 + fr, fq * 8), boff = lds_byte(wc * 32 + fr, fq * 8);
#define PG8_SA(b, h) (((b) * 2 + (h)) * HTB)
#define PG8_SB(b, h) ((4 + (b) * 2 + (h)) * HTB)
#define PG8_STAGE(bufoff, gbase, voff) do { _Pragma("unroll") for (int _i = 0; _i < 2; ++_i) \
        __builtin_amdgcn_global_load_lds((const unsigned*)((const char*)(gbase) + (voff)[_i]), (LAS unsigned*)(lds + (bufoff) + ldsw + _i * 8192), 16, 0, 0); } while (0)
#define PG8_LDA(dst, b, h) do { _Pragma("unroll") for (int m = 0; m < 4; ++m) _Pragma("unroll") for (int k = 0; k < 2; ++k) dst[m][k] = *(const LAS bf16x8*)(lds + PG8_SA(b, h) + aoff + m * 2048 + k * 1024); } while (0)
#define PG8_LDB(dst, b, h) do { _Pragma("unroll") for (int n = 0; n < 2; ++n) _Pragma("unroll") for (int k = 0; k < 2; ++k) dst[n][k] = *(const LAS bf16x8*)(lds + PG8_SB(b, h) + boff + n * 2048 + k * 1024); } while (0)
#define PG8_MMA(ai, bj, At, Bt) do { __builtin_amdgcn_s_setprio(1); _Pragma("unroll") for (int m = 0; m < 4; ++m) _Pragma("unroll") for (int n = 0; n < 2; ++n) _Pragma("unroll") for (int k = 0; k < 2; ++k) \
        acc[ai][bj][m][n] = __builtin_amdgcn_mfma_f32_16x16x32_bf16(Bt[n][k], At[m][k], acc[ai][bj][m][n], 0, 0, 0); __builtin_amdgcn_s_setprio(0); } while (0)
#define PG8_WAIT_V(n) asm volatile("s_waitcnt vmcnt(" #n ")" ::: "memory")
#define PG8_WAIT_L(n) asm volatile("s_waitcnt lgkmcnt(" #n ")" ::: "memory")
#define PG8_BAR do { asm volatile("" ::: "memory"); __builtin_amdgcn_s_barrier(); asm volatile("" ::: "memory"); } while (0)
#define PG8_SCHED __builtin_amdgcn_sched_barrier(0)
    Unit cur, nxt; int ui = 0;
    if (!S.next(0, cur)) return;
    f32x4 acc[2][2][4][2];
#pragma unroll
    for (int a = 0; a < 2; ++a)
#pragma unroll
        for (int b = 0; b < 2; ++b)
#pragma unroll
            for (int m = 0; m < 4; ++m)
#pragma unroll
                for (int n = 0; n < 2; ++n) acc[a][b][m][n] = (f32x4){0.f, 0.f, 0.f, 0.f};
    bf16x8 At[4][2], B0[2][2], B1[2][2];
    unsigned cA0[2], cA1[2], nA0[2], nA1[2];
#pragma unroll
    for (int i = 0; i < 2; ++i) {
        if (GATHER) { cA0[i] = (unsigned)(S.row_of(cur, Rr[i]) * lda + Cc[i]) * 2u; cA1[i] = (unsigned)(S.row_of(cur, HALF + Rr[i]) * lda + Cc[i]) * 2u; }
        else { cA0[i] = (unsigned)(Rr[i] * lda + Cc[i]) * 2u; cA1[i] = (unsigned)((HALF + Rr[i]) * lda + Cc[i]) * 2u; }
        nA0[i] = cA0[i]; nA1[i] = cA1[i];
    }
    const char* cA = S.a_base(cur); const char* cB = S.b_base(cur);
    PG8_STAGE(PG8_SB(0, 0), cB, voffB); PG8_STAGE(PG8_SB(0, 1), cB + hstepB, voffB); PG8_STAGE(PG8_SA(0, 0), cA, cA0); PG8_STAGE(PG8_SA(0, 1), cA, cA1);
    if (wr == 1) PG8_BAR;
    PG8_WAIT_V(2); PG8_BAR;
    PG8_STAGE(PG8_SB(1, 0), cB + kstep, voffB); PG8_STAGE(PG8_SA(1, 0), cA + kstep, cA0); PG8_STAGE(PG8_SB(1, 1), cB + hstepB + kstep, voffB);
    PG8_WAIT_V(6); PG8_BAR;
    for (;;) {
        const bool has_next = S.next(ui + 1, nxt);
        const char* nA = has_next ? S.a_base(nxt) : cA; const char* nB = has_next ? S.b_base(nxt) : cB;
        if (GATHER) {
#pragma unroll
            for (int i = 0; i < 2; ++i) {
                if (has_next) { nA0[i] = (unsigned)(S.row_of(nxt, Rr[i]) * lda + Cc[i]) * 2u; nA1[i] = (unsigned)(S.row_of(nxt, HALF + Rr[i]) * lda + Cc[i]) * 2u; }
                else { nA0[i] = cA0[i]; nA1[i] = cA1[i]; }
            }
        }
#pragma unroll 1
        for (int t = 0; t < nt; t += 2) {
            const bool last = (t == nt - 2);
            const char* a1 = cA + (size_t)(t + 1) * kstep;
            const char* a2 = last ? nA : cA + (size_t)(t + 2) * kstep; const char* b2 = last ? nB : cB + (size_t)(t + 2) * kstep;
            const char* a3 = a2 + kstep; const char* b3 = b2 + kstep;
            unsigned x0[2], x1[2];
#pragma unroll
            for (int i = 0; i < 2; ++i) { x0[i] = (GATHER && last) ? nA0[i] : cA0[i]; x1[i] = (GATHER && last) ? nA1[i] : cA1[i]; }
            PG8_LDB(B0, 0, 0); PG8_LDB(B1, 0, 1); PG8_SCHED; PG8_LDA(At, 0, 0); PG8_STAGE(PG8_SA(1, 1), a1, cA1);
            PG8_WAIT_V(8); PG8_WAIT_L(0); PG8_BAR; PG8_MMA(0, 0, At, B0); PG8_MMA(0, 1, At, B1); PG8_BAR; PG8_SCHED;
            PG8_LDA(At, 0, 1); PG8_STAGE(PG8_SB(0, 0), b2, voffB); PG8_STAGE(PG8_SB(0, 1), b2 + hstepB, voffB); PG8_STAGE(PG8_SA(0, 0), a2, x0);
            PG8_WAIT_V(8); PG8_WAIT_L(0); PG8_BAR; PG8_MMA(1, 0, At, B0); PG8_MMA(1, 1, At, B1); PG8_BAR; PG8_SCHED;
            PG8_LDB(B0, 1, 0); PG8_LDB(B1, 1, 1); PG8_SCHED; PG8_LDA(At, 1, 0); PG8_STAGE(PG8_SA(0, 1), a2, x1);
            PG8_WAIT_V(8); PG8_WAIT_L(0); PG8_BAR; PG8_MMA(0, 0, At, B0); PG8_MMA(0, 1, At, B1); PG8_BAR; PG8_SCHED;
            PG8_LDA(At, 1, 1); PG8_STAGE(PG8_SB(1, 0), b3, voffB); PG8_STAGE(PG8_SB(1, 1), b3 + hstepB, voffB); PG8_STAGE(PG8_SA(1, 0), a3, x0);
            PG8_WAIT_V(8); PG8_WAIT_L(0); PG8_BAR; PG8_MMA(1, 0, At, B0); PG8_MMA(1, 1, At, B1); PG8_BAR; PG8_SCHED;
        }
        if (wr == 0) PG8_BAR;
        E(acc, cur, wr, wc, fr, fq);
        if (!has_next) break;
#pragma unroll
        for (int a = 0; a < 2; ++a)
#pragma unroll
            for (int b = 0; b < 2; ++b)
#pragma unroll
                for (int m = 0; m < 4; ++m)
#pragma unroll
                    for (int n = 0; n < 2; ++n) acc[a][b][m][n] = (f32x4){0.f, 0.f, 0.f, 0.f};
        cur = nxt; cA = nA; cB = nB; ++ui;
#pragma unroll
        for (int i = 0; i < 2; ++i) { cA0[i] = nA0[i]; cA1[i] = nA1[i]; }
        if (wr == 1) PG8_BAR;
    }
    PG8_WAIT_V(0);
    PG8_BAR;
#undef PG8_SA
#undef PG8_SB
#undef PG8_STAGE
#undef PG8_LDA
#undef PG8_LDB
#undef PG8_MMA
#undef PG8_WAIT_V
#undef PG8_WAIT_L
#undef PG8_BAR
#undef PG8_SCHED
}
}

#define XB_TMO      128
#define XB_XCNT(j)  (256  + 64 * (j))
#define XB_XSUB(j)  (1280 + 64 * (j))
#define XB_XGEN(j)  (2304 + 64 * (j))
#define XB_TOP      3328
#define XB_TOPGEN   3392
#define XCD_BAR_WORDS 3456
#define XB_SPIN_CAP (1u << 20)

__device__ __forceinline__ unsigned xb_ld(unsigned* p)              { return __hip_atomic_load(p, __ATOMIC_RELAXED, __HIP_MEMORY_SCOPE_AGENT); }
__device__ __forceinline__ unsigned xb_add(unsigned* p, unsigned v) { return __hip_atomic_fetch_add(p, v, __ATOMIC_RELAXED, __HIP_MEMORY_SCOPE_AGENT); }
__device__ __forceinline__ unsigned xb_xcc_id() { return (unsigned)__builtin_amdgcn_s_getreg((3 << 11) | 20) & 0xFu; }
#define XB_SPIN(cond, bar) do { unsigned _sp = 0; while (cond) { __builtin_amdgcn_s_sleep(1); \
    if ((++_sp & 255u) == 0u) { if (xb_ld(&(bar)[XB_TMO])) break; if (_sp > XB_SPIN_CAP) { atomicAdd(&(bar)[XB_TMO], 1u); break; } } } } while (0)

struct XcdBarrier { unsigned* bar; unsigned x; volatile LAS unsigned* st; };

__device__ __forceinline__ XcdBarrier xcd_barrier_post(unsigned* bar, volatile LAS unsigned* st) {
    XcdBarrier b; b.bar = bar; b.x = xb_xcc_id(); b.st = st;
    if (threadIdx.x == 0) (void)xb_add(&bar[XB_XCNT(b.x)], 1u);
    return b;
}
__device__ __forceinline__ void xcd_barrier_complete(unsigned* bar, unsigned x, unsigned& nloc, unsigned& nx) {
    const unsigned G = gridDim.x * gridDim.y * gridDim.z;
    unsigned sum, cnt, mine, sp = 0u;
    for (;;) {
        sum = 0u; cnt = 0u; mine = 0u;
#pragma unroll
        for (unsigned j = 0; j < 16; ++j) { const unsigned c = xb_ld(&bar[XB_XCNT(j)]); sum += c; cnt += (c > 0u) ? 1u : 0u; mine = (j == x) ? c : mine; }
        if (sum == G) break;
        __builtin_amdgcn_s_sleep(1);
        if ((++sp & 255u) == 0u) { if (xb_ld(&bar[XB_TMO])) break; if (sp > XB_SPIN_CAP) { atomicAdd(&bar[XB_TMO], 1u); break; } }
    }
    nloc = mine > 0u ? mine : 1u; nx = cnt > 0u ? cnt : 1u;
}
__device__ __forceinline__ void xcd_barrier(const XcdBarrier& b) {
    asm volatile("s_waitcnt vmcnt(0)" ::: "memory");
    __syncthreads();
    if (threadIdx.x == 0) {
        unsigned* bar = b.bar;
        __builtin_amdgcn_s_waitcnt(0);
        unsigned nloc = b.st[0], nx = b.st[1];
        if (nloc == 0u) { xcd_barrier_complete(bar, b.x, nloc, nx); b.st[0] = nloc; b.st[1] = nx; }
        const unsigned old = xb_add(&bar[XB_XSUB(b.x)], 1u);
        const unsigned gen = old / nloc;
        if (old + 1u == (gen + 1u) * nloc) {
            __builtin_amdgcn_fence(__ATOMIC_RELEASE, "agent");
            asm volatile("s_waitcnt vmcnt(0)" ::: "memory");
            const unsigned og = xb_add(&bar[XB_TOP], 1u);
            const unsigned tg = og / nx;
            if (og + 1u == (tg + 1u) * nx) xb_add(&bar[XB_TOPGEN], 1u);
            else XB_SPIN(xb_ld(&bar[XB_TOPGEN]) == tg, bar);
            __builtin_amdgcn_fence(__ATOMIC_ACQUIRE, "agent");
            xb_add(&bar[XB_XGEN(b.x)], 1u);
            asm volatile("s_waitcnt vmcnt(0)" ::: "memory");
        } else {
            XB_SPIN(xb_ld(&bar[XB_XGEN(b.x)]) == gen, bar);
            __builtin_amdgcn_fence(__ATOMIC_ACQUIRE, "agent");
            asm volatile("s_waitcnt vmcnt(0)" ::: "memory");
        }
    }
    __syncthreads();
}

constexpr size_t MiB = 1u << 20;
constexpr size_t WS_CTL = 0, CTL_ZERO_BYTES = 1 * MiB;
constexpr size_t WS_ROPE = 1 * MiB;
constexpr size_t WS_WI   = 3 * MiB;
constexpr size_t WS_ROUTE = 3 * MiB + 512 * 1024;
constexpr size_t WS_SROW = 4 * MiB;
constexpr size_t WS_ROWMAP = 4 * MiB + 256 * 1024;
constexpr size_t WS_CWROW = 4 * MiB + 640 * 1024;
constexpr size_t WS_CNTWG = 5 * MiB;
constexpr size_t WS_META = 5 * MiB + 64 * 1024;
constexpr size_t WS_WR = 5 * MiB + 128 * 1024;
constexpr size_t WS_GLR = 6 * MiB;
constexpr size_t WS_WDENSE = 8 * MiB;
constexpr size_t WD_WA = 0, WD_WG = 7 * MiB, WD_WBR = 13 * MiB, WD_WOUT = 16 * MiB, WD_LAYER = 18 * MiB;
constexpr size_t WS_WMOE = 44 * MiB;
constexpr size_t WM_GU = 0, WM_DN = 32 * MiB;
constexpr size_t WS_HB = 92 * MiB;
constexpr size_t WS_PA = 156 * MiB;
constexpr size_t WS_HID = WS_PA;
constexpr size_t WS_FF2 = WS_PA + 40 * MiB;
constexpr size_t WS_Y = 380 * MiB;
constexpr size_t WS_KA = 476 * MiB, WS_VA = 480 * MiB, WS_KI = 484 * MiB;
constexpr size_t WS_END = 512 * MiB;
static_assert(WS_WDENSE + 2 * WD_LAYER <= WS_WMOE && WS_WMOE + 48 * MiB <= WS_HB && WS_HB + 64 * MiB <= WS_PA && WS_PA + 224 * MiB <= WS_Y && WS_Y + 96 * MiB <= WS_KA && WS_KI + 4 * MiB <= WS_END, "ws map");
static_assert(WS_FF2 + (size_t)73728 * 1024 * 2 <= WS_Y, "ff2 fits");
constexpr int CW_BAR = 4096;
constexpr int CW_QUEUE = 16384;

constexpr int RING_BYTES = 131072;
constexpr int AUX_OFF = 131072;
constexpr int MISC_OFF = 147456;
constexpr int LDS_BYTES = 148480;

struct Frame {
    LAS unsigned char* lds;
    volatile LAS unsigned* MISC;
    gu32* ctl;
    int tid, lane, wave, G, wg;
    const float* const* in;
    const GAS int* pos;
    GAS float* H;
    GAS unsigned char* ws;
};

#define LDS_WAIT() asm volatile("s_waitcnt lgkmcnt(0)" ::: "memory")
#define VM_WAIT() asm volatile("s_waitcnt vmcnt(0)" ::: "memory")

__device__ __forceinline__ int pa_src_col(int c) {
    if (c < 512) return c;
    if (c < 768) { const int x = c - 512, half = x >> 7, y = x & 127, grp = y >> 5, d = (y & 31) + 32 * half;
        if (grp == 0) return 512 + d;
        if (grp == 1) return 576 + d;
        if (grp == 2) return 896 + d;
        if (half == 0) { const int z = y - 96; if (z < 4) return 960 + z; if (z < 20) return 1988 + (z - 4); }
        return -1; }
    if (c < 1024) return 640 + (c - 768);
    if (c < 1280) return 964 + (c - 1024);
    if (c < 1536) return 1220 + (c - 1280);
    if (c < 2048) return 1476 + (c - 1536);
    if (c < 2560) return 2004 + (c - 2048);
    return 2516 + (c - 2560);
}
__device__ __forceinline__ void transpose_item(const GAS float* W, int ldw, int K, GAS bf16* WT, int n0, int k0, int sc, LAS float* scr, int lane) {
#pragma unroll 8
    for (int i = 0; i < 32; ++i) { const int kk = 2 * i + (lane >> 5); scr[kk * 33 + (lane & 31)] = (sc >= 0) ? W[(size_t)(k0 + kk) * ldw + sc] : 0.f; }
    LDS_WAIT(); asm volatile("" ::: "memory");
    const int c = lane & 7;
#pragma unroll
    for (int j = 0; j < 4; ++j) { const int n = (lane >> 3) + 8 * j; const LAS float* s = scr + (8 * c) * 33 + n;
        u32x4 o; o.x = pk2(s[0 * 33], s[1 * 33]); o.y = pk2(s[2 * 33], s[3 * 33]); o.z = pk2(s[4 * 33], s[5 * 33]); o.w = pk2(s[6 * 33], s[7 * 33]);
        *(GAS u32x4*)(WT + (size_t)(n0 + n) * K + k0 + 8 * c) = o; }
    LDS_WAIT(); asm volatile("" ::: "memory");
}
__device__ __forceinline__ void conv_dense_item(Frame& F, int l, int it, LAS float* scr) {
    GAS bf16* base = (GAS bf16*)(F.ws + WS_WDENSE + (size_t)l * WD_LAYER);
    const int lane = F.lane;
    if (it < 1792) { const int kb = it / 112, nb = it % 112; const int sc = pa_src_col(32 * nb + (lane & 31));
        transpose_item(((const GAS float*)F.in[4]) + (size_t)l * DM * NIN, NIN, DM, base + WD_WA / 2, 32 * nb, 64 * kb, sc, scr, lane); return; }
    it -= 1792;
    if (it < 1536) { const int kb = it / 96, nb = it % 96; const int sc = 3540 + 32 * nb + (lane & 31);
        transpose_item(((const GAS float*)F.in[4]) + (size_t)l * DM * NIN, NIN, DM, base + WD_WG / 2, 32 * nb, 64 * kb, sc, scr, lane); return; }
    it -= 1536;
    if (it < 768) { const int br = it / 256, r = it % 256, kb = r / 32, nb = r % 32; const int sc = 32 * nb + (lane & 31);
        transpose_item((br == 0 ? ((const GAS float*)F.in[13]) : br == 1 ? ((const GAS float*)F.in[14]) : ((const GAS float*)F.in[15])) + (size_t)l * 512 * DM, DM, 512, base + WD_WBR / 2 + (size_t)br * 1024 * 512, 32 * nb, 64 * kb, sc, scr, lane); return; }
    it -= 768;
    { const int kb = it / 32, nb = it % 32; const int sc = 32 * nb + (lane & 31);
        transpose_item(((const GAS float*)F.in[16]) + (size_t)l * DM * DM, DM, DM, base + WD_WOUT / 2, 32 * nb, 64 * kb, sc, scr, lane); }
}
__device__ __forceinline__ void conv_moe_item(Frame& F, int l, int it, LAS float* scr) {
    const int lane = F.lane; const int e = it / 384; int r = it % 384;
    if (r < 256) { const int sub = r / 64, q = r % 64, ct = sub >> 1, bj = sub & 1, kb = q / 4, nb = q % 4;
        const GAS float* src = (bj ? ((const GAS float*)F.in[24]) : ((const GAS float*)F.in[23])) + (size_t)(l * NEXP + e) * DM * DEXP;
        GAS bf16* dst = (GAS bf16*)(F.ws + WS_WMOE + WM_GU) + (size_t)e * 512 * DM;
        transpose_item(src, DEXP, DM, dst, 256 * ct + 128 * bj + 32 * nb, 64 * kb, 128 * ct + 32 * nb + (lane & 31), scr, lane); return; }
    r -= 256;
    { const int kb = r / 32, nb = r % 32;
        const GAS float* src = ((const GAS float*)F.in[25]) + (size_t)(l * NEXP + e) * DEXP * DM;
        GAS bf16* dst = (GAS bf16*)(F.ws + WS_WMOE + WM_DN) + (size_t)e * DM * DEXP;
        transpose_item(src, DM, DEXP, dst, 32 * nb, 64 * kb, 32 * nb + (lane & 31), scr, lane); }
}

__device__ __forceinline__ void ln_row_regs(f32x4 (&v)[4], const GAS float* g, const GAS float* b, int lane) {
    float s = 0.f;
#pragma unroll
    for (int j = 0; j < 4; ++j) s += (v[j].x + v[j].y) + (v[j].z + v[j].w);
    const float mean = wave_sum(s, lane) * (1.f / DM); float s2 = 0.f;
#pragma unroll
    for (int j = 0; j < 4; ++j) { v[j] = v[j] - mean; s2 += (v[j].x * v[j].x + v[j].y * v[j].y) + (v[j].z * v[j].z + v[j].w * v[j].w); }
    const float rstd = 1.f / sqrtf(wave_sum(s2, lane) * (1.f / DM) + LN_EPS);
#pragma unroll
    for (int j = 0; j < 4; ++j) { const f32x4 gg = *(const GAS f32x4*)(g + 4 * lane + 256 * j), bb = *(const GAS f32x4*)(b + 4 * lane + 256 * j); v[j] = v[j] * rstd * gg + bb; }
}
__device__ __forceinline__ void store_row_f32_bf16(const f32x4 (&v)[4], GAS float* hrow, GAS bf16* brow, int lane) {
#pragma unroll
    for (int j = 0; j < 4; ++j) {
        if (hrow) *(GAS f32x4*)(hrow + 4 * lane + 256 * j) = v[j];
        if (brow) { u32x2 w; w.x = pk2(v[j].x, v[j].y); w.y = pk2(v[j].z, v[j].w); *(GAS u32x2*)(brow + 4 * lane + 256 * j) = w; }
    }
}

__device__ __forceinline__ void phase_prologue(Frame& F) {
    LAS float* scr = (LAS float*)(F.lds + F.wave * 16384);
    const int gw = F.wg * 8 + F.wave, NGW = F.G * 8;
    for (int it = gw; it < 2 * 4608; it += NGW) conv_dense_item(F, it / 4608, it % 4608, scr);
    { GAS float* WR = (GAS float*)(F.ws + WS_WR);
      for (int i = gw * 64 + F.lane; i < DEPTH * 36 * DM; i += NGW * 64) { const int l = i / (36 * DM), r = i % (36 * DM), o = r / DM, k = r % DM;
          WR[i] = (o < 4) ? ((const GAS float*)F.in[19])[(size_t)l * DM * 4 + k * 4 + o] : ((const GAS float*)F.in[21])[(size_t)l * DM * 32 + k * 32 + (o - 4)]; } }
    { GAS float* RT = (GAS float*)(F.ws + WS_ROPE);
      for (int i = gw * 64 + F.lane; i < NTOK * 8; i += NGW * 64) { const int n = i >> 3, j = i & 7;
          const float invf[8] = {1.000000000e+00f, 1.939227432e-01f, 3.760603070e-02f, 7.292664610e-03f, 1.414213562e-03f, 2.742481884e-04f, 5.318295734e-05f, 1.031338525e-05f};
          float inv = invf[0];
#pragma unroll
          for (int q = 1; q < 8; ++q) inv = (j == q) ? invf[q] : inv;
          const float ang = (float)F.pos[n] * inv;
          const double kq = __builtin_rint((double)ang * 0.15915494309189535);
          double r = (double)ang - kq * 6.283185307179586; double csign = 1.0;
          if (r > 1.5707963267948966) { r = 3.141592653589793 - r; csign = -1.0; } else if (r < -1.5707963267948966) { r = -3.141592653589793 - r; csign = -1.0; }
          const double x2 = r * r;
          const double sn = r * (1.0 + x2 * (-1.0 / 6 + x2 * (1.0 / 120 + x2 * (-1.0 / 5040 + x2 * (1.0 / 362880 + x2 * (-1.0 / 39916800 + x2 * (1.0 / 6227020800.0 + x2 * (-1.0 / 1307674368000.0))))))));
          const double cs = 1.0 + x2 * (-0.5 + x2 * (1.0 / 24 + x2 * (-1.0 / 720 + x2 * (1.0 / 40320 + x2 * (-1.0 / 3628800 + x2 * (1.0 / 479001600.0 + x2 * (-1.0 / 87178291200.0 + x2 * (1.0 / 20922789888000.0))))))));
          RT[n * 16 + j] = (float)(csign * cs); RT[n * 16 + 8 + j] = (float)sn; } }
    GAS bf16* HB = (GAS bf16*)(F.ws + WS_HB);
    for (int m = gw; m < NTOK; m += NGW) { f32x4 v[4];
#pragma unroll
        for (int j = 0; j < 4; ++j) v[j] = *(const GAS f32x4*)(((const GAS float*)F.in[0]) + (size_t)m * DM + 4 * F.lane + 256 * j);
        ln_row_regs(v, ((const GAS float*)F.in[2]), ((const GAS float*)F.in[3]), F.lane);
        store_row_f32_bf16(v, (GAS float*)nullptr, HB + (size_t)m * DM, F.lane); }
}

struct DenseSched {
    int nM, nN, nwg, G, c; const char* A; const char* B; size_t atile, btile; int nsub = 1; size_t asub = 0, bsub = 0;
    __device__ void init(int nM_, int nN_, int G_, int c_, const void* A_, size_t atile_, const void* B_, size_t btile_) { nM = nM_; nN = nN_; nwg = nM * nN; G = G_; c = c_; A = (const char*)A_; B = (const char*)B_; atile = atile_; btile = btile_; }
    __device__ __forceinline__ bool next(int i, pg8::Unit& u) const {
        const int it = i / nsub, sb = i - it * nsub;
        const long L = (long)it * G + c; if (L >= nwg) return false;
        int wgid = (int)L; { const int q = nwg / 8, r = nwg % 8, xcd = wgid % 8, off = wgid / 8; wgid = (xcd < r ? xcd * (q + 1) : r * (q + 1) + (xcd - r) * q) + off; }
        const int nig = 8 * nN, gid = wgid / nig, fm = gid * 8, gsz = (nM - fm) < 8 ? (nM - fm) : 8;
        u.pm = fm + ((wgid % nig) % gsz); u.pn = (wgid % nig) / gsz; u.e = sb; u.slot = i; return true;
    }
    __device__ __forceinline__ const char* a_base(const pg8::Unit& u) const { return A + (size_t)u.pm * atile + (size_t)u.e * asub; }
    __device__ __forceinline__ const char* b_base(const pg8::Unit& u) const { return B + (size_t)u.pn * btile + (size_t)u.e * bsub; }
    __device__ __forceinline__ int row_of(const pg8::Unit&, int) const { return 0; }
};
struct GroupSched {
    int NU, G, c, ncol; const char* A; const char* B; size_t atile, erows_bytes, btile; const LAS int* meta; const LAS int* rows;
    __device__ __forceinline__ bool next(int i, pg8::Unit& u) const {
        const int L = i * G + c; if (L >= NU) return false;
        u.pm = L / ncol; u.pn = L % ncol; u.slot = i; u.e = meta[i]; return true;
    }
    __device__ __forceinline__ const char* a_base(const pg8::Unit& u) const { return A + (size_t)u.pm * atile; }
    __device__ __forceinline__ const char* b_base(const pg8::Unit& u) const { return B + (size_t)u.e * erows_bytes + (size_t)u.pn * btile; }
    __device__ __forceinline__ int row_of(const pg8::Unit& u, int r) const { return rows[u.slot * 256 + r]; }
};

struct EpiA {
    static constexpr bool PERM = true;
    GAS bf16* PA; GAS bf16* KA; GAS bf16* VA; GAS bf16* KI; GAS float* WI; GAS float* GLR; const GAS float* ROPE; const GAS float* ikg;
    __device__ __forceinline__ static void rope8(float (&x)[8], const GAS float* rt, int fq, int lane) {
        const f32x4 c0 = *(const GAS f32x4*)(rt), c1 = *(const GAS f32x4*)(rt + 4), s0 = *(const GAS f32x4*)(rt + 8), s1 = *(const GAS f32x4*)(rt + 12);
#pragma unroll
        for (int i = 0; i < 8; ++i) { const float p = shx(x[i], 16, lane); const float cc = (i < 4) ? c0[i & 3] : c1[i & 3], ss = (i < 4) ? s0[i & 3] : s1[i & 3];
            const float r = x[i] * cc + ((fq == 0) ? -p : p) * ss; x[i] = (fq < 2) ? r : x[i]; }
    }
    __device__ __forceinline__ static u32x4 pack8(const float (&x)[8]) { u32x4 w; w.x = cvt_pk_bf16(x[0], x[1]); w.y = cvt_pk_bf16(x[2], x[3]); w.z = cvt_pk_bf16(x[4], x[5]); w.w = cvt_pk_bf16(x[6], x[7]); return w; }
    __device__ __forceinline__ void operator()(const f32x4 (&acc)[2][2][4][2], const pg8::Unit& u, int wr, int wc, int fr, int fq) const {
        const int pn = u.pn; const int rowb = u.pm * 256 + wr * 64 + fr; const int lane = fq * 16 + fr;
        if (pn == 2) {
#pragma unroll
            for (int ai = 0; ai < 2; ++ai)
#pragma unroll
                for (int m = 0; m < 4; ++m) {
                    const int row = rowb + ai * 128 + m * 16;
                    float x0[8], x1[8];
#pragma unroll
                    for (int i = 0; i < 8; ++i) { x0[i] = acc[ai][0][m][i >> 2][i & 3]; x1[i] = acc[ai][1][m][i >> 2][i & 3]; }
                    if (wc == 2) {
                        float s = 0.f;
#pragma unroll
                        for (int i = 0; i < 8; ++i) s += x0[i] + x1[i];
                        s += shx(s, 16, lane); s += shx(s, 32, lane);
                        const float mean = s * (1.f / 64.f); float q = 0.f;
#pragma unroll
                        for (int i = 0; i < 8; ++i) { x0[i] -= mean; x1[i] -= mean; q += x0[i] * x0[i] + x1[i] * x1[i]; }
                        q += shx(q, 16, lane); q += shx(q, 32, lane);
                        const float rstd = 1.f / sqrtf(q * (1.f / 64.f) + LN_EPS);
#pragma unroll
                        for (int i = 0; i < 8; ++i) { x0[i] = x0[i] * rstd * ikg[8 * fq + i]; x1[i] = x1[i] * rstd * ikg[32 + 8 * fq + i]; }
                    }
                    if (wc == 0 || wc == 2) rope8(x0, ROPE + (size_t)row * 16, fq, lane);
                    if (wc < 3) {
                        GAS bf16* dst = (wc == 0) ? KA : (wc == 1) ? VA : KI;
                        *(GAS u32x4*)(dst + (size_t)row * 64 + 8 * fq) = pack8(x0); *(GAS u32x4*)(dst + (size_t)row * 64 + 32 + 8 * fq) = pack8(x1);
                    } else {
                        if (fq == 0) { *(GAS f32x4*)(WI + (size_t)row * 4) = (f32x4){x0[0], x0[1], x0[2], x0[3]} * 0.0625f; *(GAS f32x4*)(GLR + (size_t)row * 16) = (f32x4){x0[4], x0[5], x0[6], x0[7]}; }
                        else if (fq == 1) { *(GAS f32x4*)(GLR + (size_t)row * 16 + 4) = (f32x4){x0[0], x0[1], x0[2], x0[3]}; *(GAS f32x4*)(GLR + (size_t)row * 16 + 8) = (f32x4){x0[4], x0[5], x0[6], x0[7]}; }
                        else if (fq == 2) { *(GAS f32x4*)(GLR + (size_t)row * 16 + 12) = (f32x4){x0[0], x0[1], x0[2], x0[3]}; }
                    }
                    asm volatile("" ::: "memory");
                }
        } else if (pn < 2 || pn == 3) {
            const float sc = (pn == 3) ? 1.0f : 0.125f; const bool rope = !(wc & 1);
#pragma unroll
            for (int ai = 0; ai < 2; ++ai)
#pragma unroll
                for (int m = 0; m < 4; ++m) {
                    const int row = rowb + ai * 128 + m * 16;
#pragma unroll
                    for (int bj = 0; bj < 2; ++bj) { float x[8];
#pragma unroll
                        for (int i = 0; i < 8; ++i) x[i] = acc[ai][bj][m][i >> 2][i & 3];
                        if (rope) rope8(x, ROPE + (size_t)row * 16, fq, lane);
#pragma unroll
                        for (int i = 0; i < 8; ++i) x[i] *= sc;
                        *(GAS u32x4*)(PA + (size_t)row * NPA + 256 * pn + 128 * bj + 32 * wc + 8 * fq) = pack8(x); }
                    asm volatile("" ::: "memory");
                }
        } else {
            const int act = (pn == 8 || pn == 9) ? 1 : (pn >= 10) ? 2 : 0; const float sc = (pn == 4) ? 0.125f : 1.0f;
#pragma unroll
            for (int ai = 0; ai < 2; ++ai)
#pragma unroll
                for (int m = 0; m < 4; ++m) {
                    const int row = rowb + ai * 128 + m * 16;
#pragma unroll
                    for (int bj = 0; bj < 2; ++bj) { float x[8];
#pragma unroll
                        for (int i = 0; i < 8; ++i) { const float v = acc[ai][bj][m][i >> 2][i & 3]; x[i] = (act == 1) ? siluf_(v) : (act == 2) ? gelu_tanh_(v) : v * sc; }
                        *(GAS u32x4*)(PA + (size_t)row * NPA + 256 * pn + 128 * bj + 32 * wc + 8 * fq) = pack8(x); }
                    asm volatile("" ::: "memory");
                }
        }
    }
};
struct EpiP {
    static constexpr bool PERM = true;
    GAS bf16* P;
    __device__ __forceinline__ void operator()(const f32x4 (&acc)[2][2][4][2], const pg8::Unit& u, int wr, int wc, int fr, int fq) const {
        const int rowb = u.pm * 256 + wr * 64 + fr; GAS bf16* Pb = P + (size_t)u.e * NTOK * DM;
#pragma unroll
        for (int ai = 0; ai < 2; ++ai)
#pragma unroll
            for (int m = 0; m < 4; ++m) { const int row = rowb + ai * 128 + m * 16;
#pragma unroll
                for (int bj = 0; bj < 2; ++bj) { u32x4 w; w.x = cvt_pk_bf16(acc[ai][bj][m][0][0], acc[ai][bj][m][0][1]); w.y = cvt_pk_bf16(acc[ai][bj][m][0][2], acc[ai][bj][m][0][3]);
                    w.z = cvt_pk_bf16(acc[ai][bj][m][1][0], acc[ai][bj][m][1][1]); w.w = cvt_pk_bf16(acc[ai][bj][m][1][2], acc[ai][bj][m][1][3]);
                    *(GAS u32x4*)(Pb + (size_t)row * DM + 256 * u.pn + 128 * bj + 32 * wc + 8 * fq) = w; } }
    }
};
struct EpiGM {
    static constexpr bool PERM = true;
    const GAS bf16* P; GAS bf16* HM;
    __device__ __forceinline__ void operator()(const f32x4 (&acc)[2][2][4][2], const pg8::Unit& u, int wr, int wc, int fr, int fq) const {
        const int rowb = u.pm * 256 + wr * 64 + fr; const int br = u.e; const GAS bf16* Pb = P + (size_t)br * NTOK * DM;
        const int colb = 256 * u.pn + 32 * wc + 8 * fq;
#pragma unroll
        for (int ai = 0; ai < 2; ++ai) {
            u32x4 pv[4][2], ov[4][2];
#pragma unroll
            for (int m = 0; m < 4; ++m)
#pragma unroll
                for (int bj = 0; bj < 2; ++bj) { const size_t off = (size_t)(rowb + ai * 128 + m * 16) * DM + colb + 128 * bj;
                    pv[m][bj] = *(const GAS u32x4*)(Pb + off); ov[m][bj] = (br > 0) ? *(const GAS u32x4*)(HM + off) : (u32x4){0u, 0u, 0u, 0u}; }
            __builtin_amdgcn_sched_barrier(0);
#pragma unroll
            for (int m = 0; m < 4; ++m)
#pragma unroll
                for (int bj = 0; bj < 2; ++bj) { const size_t off = (size_t)(rowb + ai * 128 + m * 16) * DM + colb + 128 * bj;
                    const u32x4 p = pv[m][bj], o = ov[m][bj];
                    float x[8];
                    x[0] = bflo(p.x) * sigmoidf_(acc[ai][bj][m][0][0]) + bflo(o.x); x[1] = bfhi(p.x) * sigmoidf_(acc[ai][bj][m][0][1]) + bfhi(o.x); x[2] = bflo(p.y) * sigmoidf_(acc[ai][bj][m][0][2]) + bflo(o.y); x[3] = bfhi(p.y) * sigmoidf_(acc[ai][bj][m][0][3]) + bfhi(o.y);
                    x[4] = bflo(p.z) * sigmoidf_(acc[ai][bj][m][1][0]) + bflo(o.z); x[5] = bfhi(p.z) * sigmoidf_(acc[ai][bj][m][1][1]) + bfhi(o.z); x[6] = bflo(p.w) * sigmoidf_(acc[ai][bj][m][1][2]) + bflo(o.w); x[7] = bfhi(p.w) * sigmoidf_(acc[ai][bj][m][1][3]) + bfhi(o.w);
                    u32x4 w; w.x = cvt_pk_bf16(x[0], x[1]); w.y = cvt_pk_bf16(x[2], x[3]); w.z = cvt_pk_bf16(x[4], x[5]); w.w = cvt_pk_bf16(x[6], x[7]);
                    *(GAS u32x4*)(HM + off) = w; }
            asm volatile("" ::: "memory");
        }
    }
};
struct EpiO {
    static constexpr bool PERM = true;
    const GAS bf16* HBr; GAS bf16* T;
    __device__ __forceinline__ void operator()(const f32x4 (&acc)[2][2][4][2], const pg8::Unit& u, int wr, int wc, int fr, int fq) const {
        const int rowb = u.pm * 256 + wr * 64 + fr; const int colb = 256 * u.pn + 32 * wc + 8 * fq;
#pragma unroll
        for (int ai = 0; ai < 2; ++ai) {
            u32x4 hv[4][2];
#pragma unroll
            for (int m = 0; m < 4; ++m)
#pragma unroll
                for (int bj = 0; bj < 2; ++bj) hv[m][bj] = *(const GAS u32x4*)(HBr + (size_t)(rowb + ai * 128 + m * 16) * DM + colb + 128 * bj);
            __builtin_amdgcn_sched_barrier(0);
#pragma unroll
            for (int m = 0; m < 4; ++m)
#pragma unroll
                for (int bj = 0; bj < 2; ++bj) { const u32x4 h = hv[m][bj];
                    u32x4 w; w.x = cvt_pk_bf16(bflo(h.x) * DN_ALPHA + acc[ai][bj][m][0][0], bfhi(h.x) * DN_ALPHA + acc[ai][bj][m][0][1]); w.y = cvt_pk_bf16(bflo(h.y) * DN_ALPHA + acc[ai][bj][m][0][2], bfhi(h.y) * DN_ALPHA + acc[ai][bj][m][0][3]);
                    w.z = cvt_pk_bf16(bflo(h.z) * DN_ALPHA + acc[ai][bj][m][1][0], bfhi(h.z) * DN_ALPHA + acc[ai][bj][m][1][1]); w.w = cvt_pk_bf16(bflo(h.w) * DN_ALPHA + acc[ai][bj][m][1][2], bfhi(h.w) * DN_ALPHA + acc[ai][bj][m][1][3]);
                    *(GAS u32x4*)(T + (size_t)(rowb + ai * 128 + m * 16) * DM + colb + 128 * bj) = w; }
            asm volatile("" ::: "memory");
        }
    }
};
struct EpiGU {
    static constexpr bool PERM = true;
    GAS bf16* HID; const GAS float* CW;
    __device__ __forceinline__ void operator()(const f32x4 (&acc)[2][2][4][2], const pg8::Unit& u, int wr, int wc, int fr, int fq) const {
        const int rowb = u.pm * 256 + wr * 64 + fr;
        float cwv[2][4];
#pragma unroll
        for (int ai = 0; ai < 2; ++ai)
#pragma unroll
            for (int m = 0; m < 4; ++m) cwv[ai][m] = CW[rowb + ai * 128 + m * 16];
#pragma unroll
        for (int ai = 0; ai < 2; ++ai)
#pragma unroll
            for (int m = 0; m < 4; ++m) { const int row = rowb + ai * 128 + m * 16; const float cw = cwv[ai][m];
                float x[8];
#pragma unroll
                for (int i = 0; i < 8; ++i) x[i] = siluf_(acc[ai][0][m][i >> 2][i & 3]) * acc[ai][1][m][i >> 2][i & 3] * cw;
                u32x4 w; w.x = cvt_pk_bf16(x[0], x[1]); w.y = cvt_pk_bf16(x[2], x[3]); w.z = cvt_pk_bf16(x[4], x[5]); w.w = cvt_pk_bf16(x[6], x[7]);
                *(GAS u32x4*)(HID + (size_t)row * DEXP + 128 * u.pn + 32 * wc + 8 * fq) = w; }
    }
};
struct EpiDN {
    static constexpr bool PERM = true;
    GAS bf16* FF2;
    __device__ __forceinline__ void operator()(const f32x4 (&acc)[2][2][4][2], const pg8::Unit& u, int wr, int wc, int fr, int fq) const {
        const int rowb = u.pm * 256 + wr * 64 + fr;
#pragma unroll
        for (int ai = 0; ai < 2; ++ai)
#pragma unroll
            for (int m = 0; m < 4; ++m) { const int row = rowb + ai * 128 + m * 16;
#pragma unroll
                for (int bj = 0; bj < 2; ++bj) { u32x4 w; w.x = cvt_pk_bf16(acc[ai][bj][m][0][0], acc[ai][bj][m][0][1]); w.y = cvt_pk_bf16(acc[ai][bj][m][0][2], acc[ai][bj][m][0][3]);
                    w.z = cvt_pk_bf16(acc[ai][bj][m][1][0], acc[ai][bj][m][1][1]); w.w = cvt_pk_bf16(acc[ai][bj][m][1][2], acc[ai][bj][m][1][3]);
                    *(GAS u32x4*)(FF2 + (size_t)row * DM + 256 * u.pn + 128 * bj + 32 * wc + 8 * fq) = w; } }
    }
};
#ifndef EN_B1
#define EN_B1 1
#endif
#ifndef EN_B2
#define EN_B2 1
#endif
#ifndef EN_B3
#define EN_B3 1
#endif

template <int CTRL> __device__ __forceinline__ float dppf(float x) { return __builtin_bit_cast(float, __builtin_amdgcn_mov_dpp(__builtin_bit_cast(int, x), CTRL, 0xf, 0xf, true)); }
template <int CTRL> __device__ __forceinline__ int dppi(int x) { return __builtin_amdgcn_mov_dpp(x, CTRL, 0xf, 0xf, true); }
typedef short v4i16_t __attribute__((ext_vector_type(4)));
typedef unsigned short u16x2 __attribute__((ext_vector_type(2)));
__device__ __forceinline__ v4i16_t ldtr(const LAS unsigned char* p) { return __builtin_amdgcn_ds_read_tr16_b64_v4i16((LAS v4i16_t*)p); }
__device__ __forceinline__ bf16x8 cat8(v4i16_t lo, v4i16_t hi) { bf16x8 r; r[0] = lo[0]; r[1] = lo[1]; r[2] = lo[2]; r[3] = lo[3]; r[4] = hi[0]; r[5] = hi[1]; r[6] = hi[2]; r[7] = hi[3]; return r; }
__device__ __forceinline__ int wave_total_i(int v) {
    v += dppi<0xB1>(v); v += dppi<0x4E>(v); v += dppi<0x141>(v); v += dppi<0x140>(v);
    return __builtin_amdgcn_readlane(v, 0) + __builtin_amdgcn_readlane(v, 16) + __builtin_amdgcn_readlane(v, 32) + __builtin_amdgcn_readlane(v, 48);
}
__device__ __forceinline__ void gmlp_unit(Frame& F, int l, int unit) {
    int tid = F.tid; asm volatile("" : "+v"(tid)); const int lane = tid & 63;
    const int chunk = unit >> 2, g = unit & 3, n0 = chunk * 128;
    const GAS bf16* PA = (const GAS bf16*)(F.ws + WS_PA); GAS bf16* Y = (GAS bf16*)(F.ws + WS_Y);
    LAS float* vln = (LAS float*)F.lds;
    LAS float* wl = (LAS float*)(F.lds + 65536);
    LAS float* st = (LAS float*)(F.lds + AUX_OFF);
    const GAS float* lng = ((const GAS float*)F.in[9]) + l * 512; const GAS float* lnb = ((const GAS float*)F.in[10]) + l * 512;
    for (int j = 0; j < 16; ++j) { const int s = F.wave * 16 + j;
        const u32x4 w = *(const GAS u32x4*)(PA + (size_t)(n0 + s) * NPA + PA_CV + 8 * lane);
        float x[8] = {bflo(w.x), bfhi(w.x), bflo(w.y), bfhi(w.y), bflo(w.z), bfhi(w.z), bflo(w.w), bfhi(w.w)};
        float sm = 0.f;
#pragma unroll
        for (int i = 0; i < 8; ++i) sm += x[i];
        const float mean = wave_sum(sm, lane) * (1.f / 512.f); float q = 0.f;
#pragma unroll
        for (int i = 0; i < 8; ++i) { const float d = x[i] - mean; q += d * d; }
        const float rstd = 1.f / sqrtf(wave_sum(q, lane) * (1.f / 512.f) + LN_EPS);
        if (lane == 0) { st[2 * s] = mean; st[2 * s + 1] = rstd; } }
    __syncthreads();
#pragma unroll
    for (int i = 0; i < 4; ++i) { const int q = tid + 512 * i, s = q >> 4, d0 = (q & 15) * 8;
        const u32x4 w = *(const GAS u32x4*)(PA + (size_t)(n0 + s) * NPA + PA_CV + g * 128 + d0);
        const float mean = st[2 * s], rstd = st[2 * s + 1];
        float x[8] = {bflo(w.x), bfhi(w.x), bflo(w.y), bfhi(w.y), bflo(w.z), bfhi(w.z), bflo(w.w), bfhi(w.w)};
#pragma unroll
        for (int k = 0; k < 8; ++k) x[k] = (x[k] - mean) * rstd * lng[g * 128 + d0 + k] + lnb[g * 128 + d0 + k];
        *(LAS f32x4*)(vln + s * 128 + d0) = (f32x4){x[0], x[1], x[2], x[3]}; *(LAS f32x4*)(vln + s * 128 + d0 + 4) = (f32x4){x[4], x[5], x[6], x[7]}; }
    const GAS float* ws = ((const GAS float*)F.in[11]) + ((size_t)l * 4 + g) * 128 * 128;
#pragma unroll
    for (int i = 0; i < 8; ++i) { const int q = tid + 512 * i, t = q >> 5, s0 = (q & 31) * 4;
        f32x4 w = *(const GAS f32x4*)(ws + t * 128 + s0);
        if (s0 + 0 > t) w.x = 0.f; if (s0 + 1 > t) w.y = 0.f; if (s0 + 2 > t) w.z = 0.f; if (s0 + 3 > t) w.w = 0.f;
        *(LAS f32x4*)(wl + t * 128 + s0) = w; }
    __syncthreads();
    const int d = tid & 127, tq = __builtin_amdgcn_readfirstlane(tid >> 7);
    float vr[128];
#pragma unroll
    for (int sb = 0; sb < 4; ++sb)
        if (sb <= tq) {
#pragma unroll
            for (int s = 0; s < 32; ++s) vr[sb * 32 + s] = vln[(sb * 32 + s) * 128 + d];
        } else {
#pragma unroll
            for (int s = 0; s < 32; ++s) vr[sb * 32 + s] = 0.f;
        }
    const GAS float* bs = ((const GAS float*)F.in[12]) + ((size_t)l * 4 + g) * 128;
#pragma unroll 1
    for (int ti = 0; ti < 32; ++ti) { const int t = tq * 32 + ti; float a = 0.f;
#pragma unroll
        for (int sb = 0; sb < 4; ++sb)
            if (sb <= tq) {
#pragma unroll
                for (int s4 = 0; s4 < 8; ++s4) { const f32x4 w = *(const LAS f32x4*)(wl + t * 128 + sb * 32 + s4 * 4);
                    a += w.x * vr[sb * 32 + s4 * 4] + w.y * vr[sb * 32 + s4 * 4 + 1] + w.z * vr[sb * 32 + s4 * 4 + 2] + w.w * vr[sb * 32 + s4 * 4 + 3]; }
            }
        const float uu = bf1(PA[(size_t)(n0 + t) * NPA + PA_CU + g * 128 + d]);
        Y[(size_t)(n0 + t) * 1536 + 1024 + g * 128 + d] = (bf16)f2bf(uu * (a + bs[t])); }
    __syncthreads();
}

__device__ __forceinline__ void gmlp16_unit(Frame& F, int l, int chunk) {
    const int lane = fresh_lane(), w = F.wave, tid = w * 64 + lane, fr = lane & 15, fq = lane >> 4;
    const size_t n0 = (size_t)chunk * 128;
    const GAS bf16* PA = (const GAS bf16*)(F.ws + WS_PA); GAS bf16* Y = (GAS bf16*)(F.ws + WS_Y);
    LAS unsigned char* VT = F.lds;
    LAS unsigned char* WT = F.lds + 32768;
    LAS float* st = (LAS float*)(F.lds + AUX_OFF);
    const GAS float* lng = ((const GAS float*)F.in[9]) + l * 512; const GAS float* lnb = ((const GAS float*)F.in[10]) + l * 512;
    for (int j = 0; j < 16; ++j) { const int s = w * 16 + j;
        const u32x4 x4 = *(const GAS u32x4*)(PA + (n0 + s) * NPA + PA_CV + 8 * lane);
        float x[8] = {bflo(x4.x), bfhi(x4.x), bflo(x4.y), bfhi(x4.y), bflo(x4.z), bfhi(x4.z), bflo(x4.w), bfhi(x4.w)};
        float sm = 0.f;
#pragma unroll
        for (int i = 0; i < 8; ++i) sm += x[i];
        const float mean = wave_sum(sm, lane) * (1.f / 512.f); float q = 0.f;
#pragma unroll
        for (int i = 0; i < 8; ++i) { const float d = x[i] - mean; q += d * d; }
        const float rstd = 1.f / sqrtf(wave_sum(q, lane) * (1.f / 512.f) + LN_EPS);
        if (lane == 0) { st[2 * s] = mean; st[2 * s + 1] = rstd; } }
    __syncthreads();
#pragma unroll 1
    for (int g = 0; g < 4; ++g) {
        const GAS float* ws = ((const GAS float*)F.in[11]) + ((size_t)l * 4 + g) * 128 * 128;
#pragma unroll
        for (int i = 0; i < 4; ++i) { const int q = tid + 512 * i, s = q >> 4, d0 = (q & 15) * 8;
            const u32x4 x4 = *(const GAS u32x4*)(PA + (n0 + s) * NPA + PA_CV + g * 128 + d0);
            const float mean = st[2 * s], rstd = st[2 * s + 1];
            float x[8] = {bflo(x4.x), bfhi(x4.x), bflo(x4.y), bfhi(x4.y), bflo(x4.z), bfhi(x4.z), bflo(x4.w), bfhi(x4.w)};
            const f32x4 g0 = *(const GAS f32x4*)(lng + g * 128 + d0), g1 = *(const GAS f32x4*)(lng + g * 128 + d0 + 4), b0 = *(const GAS f32x4*)(lnb + g * 128 + d0), b1 = *(const GAS f32x4*)(lnb + g * 128 + d0 + 4);
#pragma unroll
            for (int k = 0; k < 8; ++k) x[k] = (x[k] - mean) * rstd * ((k < 4) ? g0[k & 3] : g1[k & 3]) + ((k < 4) ? b0[k & 3] : b1[k & 3]);
            u32x4 o; o.x = cvt_pk_bf16(x[0], x[1]); o.y = cvt_pk_bf16(x[2], x[3]); o.z = cvt_pk_bf16(x[4], x[5]); o.w = cvt_pk_bf16(x[6], x[7]);
            *(LAS u32x4*)(VT + s * 256 + d0 * 2) = o;
            const int t = s, s0 = d0;
            f32x4 w0 = *(const GAS f32x4*)(ws + t * 128 + s0), w1 = *(const GAS f32x4*)(ws + t * 128 + s0 + 4);
            float wv[8] = {w0.x, w0.y, w0.z, w0.w, w1.x, w1.y, w1.z, w1.w};
#pragma unroll
            for (int k = 0; k < 8; ++k) wv[k] = (s0 + k <= t) ? wv[k] : 0.f;
            u32x4 ow; ow.x = cvt_pk_bf16(wv[0], wv[1]); ow.y = cvt_pk_bf16(wv[2], wv[3]); ow.z = cvt_pk_bf16(wv[4], wv[5]); ow.w = cvt_pk_bf16(wv[6], wv[7]);
            *(LAS u32x4*)(WT + t * 256 + s0 * 2) = ow; }
        __syncthreads();
        f32x4 acc[8];
#pragma unroll
        for (int nt = 0; nt < 8; ++nt) acc[nt] = (f32x4){0.f, 0.f, 0.f, 0.f};
        const int nks = (16 * w + 15) / 32 + 1;
#pragma unroll
        for (int ks = 0; ks < 4; ++ks) if (ks < nks) {
            const bf16x8 a = *(const LAS bf16x8*)(WT + (16 * w + fr) * 256 + (8 * fq + 32 * ks) * 2);
            const int srow = 32 * ks + 8 * fq + (fr >> 2);
#pragma unroll
            for (int nt = 0; nt < 8; ++nt) { const bf16x8 bv = cat8(ldtr(VT + srow * 256 + (16 * nt + 4 * (fr & 3)) * 2), ldtr(VT + (srow + 4) * 256 + (16 * nt + 4 * (fr & 3)) * 2));
                acc[nt] = __builtin_amdgcn_mfma_f32_16x16x32_bf16(bv, a, acc[nt], 0, 0, 0); } }
        const GAS float* bs = ((const GAS float*)F.in[12]) + ((size_t)l * 4 + g) * 128;
        { const int t = 16 * w + fr; const float bt = bs[t];
#pragma unroll
          for (int nt = 0; nt < 8; ++nt) { const int d0 = 16 * nt + 4 * fq;
              const u32x2 uu = *(const GAS u32x2*)(PA + (n0 + t) * NPA + PA_CU + g * 128 + d0);
              u32x2 wv; wv.x = pk2(bflo(uu.x) * (acc[nt][0] + bt), bfhi(uu.x) * (acc[nt][1] + bt)); wv.y = pk2(bflo(uu.y) * (acc[nt][2] + bt), bfhi(uu.y) * (acc[nt][3] + bt));
              *(GAS u32x2*)(Y + (n0 + t) * 1536 + 1024 + g * 128 + d0) = wv; } }
        __syncthreads();
    }
}

__device__ __forceinline__ void gla_unit(Frame& F, int l, int unit) {
    int tid = F.tid; asm volatile("" : "+v"(tid));
    const int b = unit >> 2, h = unit & 3;
    const GAS bf16* PA = (const GAS bf16*)(F.ws + WS_PA); GAS bf16* Y = (GAS bf16*)(F.ws + WS_Y); const GAS float* GLR = (const GAS float*)(F.ws + WS_GLR);
    LAS float* wa = (LAS float*)F.lds;
    LAS float* ba = wa + 1024;
    LAS float* as_ = ba + 64;
    LAS float* qs = as_ + 1024;
    LAS float* ks = qs + 1024;
    LAS float* vs = ks + 1024;
    LAS float* part = vs + 2048;
    for (int i = tid; i < 1024; i += 512) wa[i] = ((const GAS float*)F.in[6])[(size_t)l * 16 * 256 + (i >> 6) * 256 + h * 64 + (i & 63)];
    if (tid < 64) ba[tid] = ((const GAS float*)F.in[7])[l * 256 + h * 64 + tid];
    const GAS float* gng = ((const GAS float*)F.in[8]) + l * 128;
    const int v = tid & 127, kq = __builtin_amdgcn_readfirstlane(tid >> 7);
    float S[16];
#pragma unroll
    for (int j = 0; j < 16; ++j) S[j] = 0.f;
    __syncthreads();
    for (int t0 = 0; t0 < SEQ; t0 += 16) {
        const size_t nb = (size_t)b * SEQ + t0;
#pragma unroll
        for (int i = 0; i < 2; ++i) { const int e = tid + 512 * i, t = e >> 6, k = e & 63; float z = ba[k];
#pragma unroll
            for (int r = 0; r < 16; ++r) z += GLR[(nb + t) * 16 + r] * wa[r * 64 + k];
            const float ls = fminf(z, 0.f) - log1pf(__expf(-fabsf(z)));
            as_[e] = __expf(ls * (1.f / 16.f));
            qs[e] = bf1(PA[(nb + t) * NPA + PA_BQ + h * 64 + k]); ks[e] = bf1(PA[(nb + t) * NPA + PA_BK + h * 64 + k]); }
#pragma unroll
        for (int i = 0; i < 4; ++i) { const int e = tid + 512 * i, t = e >> 7, vv = e & 127; vs[e] = bf1(PA[(nb + t) * NPA + PA_BV + h * 128 + vv]); }
        __syncthreads();
#pragma unroll 4
        for (int t = 0; t < 16; ++t) { const float vt = vs[t * 128 + v]; float p = 0.f;
#pragma unroll
            for (int j4 = 0; j4 < 4; ++j4) { const f32x4 a4 = *(const LAS f32x4*)(as_ + t * 64 + kq * 16 + j4 * 4), k4 = *(const LAS f32x4*)(ks + t * 64 + kq * 16 + j4 * 4), q4 = *(const LAS f32x4*)(qs + t * 64 + kq * 16 + j4 * 4);
#pragma unroll
                for (int j = 0; j < 4; ++j) { S[j4 * 4 + j] = a4[j] * S[j4 * 4 + j] + k4[j] * vt; p += q4[j] * S[j4 * 4 + j]; } }
            part[(kq * 16 + t) * 128 + v] = p; }
        __syncthreads();
        { const int t = tid >> 5, v4 = (tid & 31) * 4;
          f32x4 o = *(const LAS f32x4*)(part + (0 * 16 + t) * 128 + v4);
#pragma unroll
          for (int q = 1; q < 4; ++q) o += *(const LAS f32x4*)(part + (q * 16 + t) * 128 + v4);
          float ss = o.x * o.x + o.y * o.y + o.z * o.z + o.w * o.w;
#pragma unroll
          for (int sh = 1; sh < 32; sh <<= 1) ss += shx(ss, sh, tid & 63);
          const float r = 1.f / sqrtf(ss * (1.f / 128.f) + RMS_EPS);
          const f32x4 gg = *(const GAS f32x4*)(gng + v4);
          const u32x2 brw = *(const GAS u32x2*)(PA + (nb + t) * NPA + PA_BR + h * 128 + v4);
          u32x2 w; w.x = pk2(o.x * r * gg.x * bflo(brw.x), o.y * r * gg.y * bfhi(brw.x)); w.y = pk2(o.z * r * gg.z * bflo(brw.y), o.w * r * gg.w * bfhi(brw.y));
          *(GAS u32x2*)(Y + (nb + t) * 1536 + 512 + h * 128 + v4) = w; }
        __syncthreads();
    }
}

constexpr size_t WS_US = WS_WMOE, WS_DEC = WS_WMOE + 32 * MiB;
__device__ __forceinline__ void gla_local_unit(Frame& F, int l, int unit) {
    const int lane = fresh_lane(), w = F.wave, tid = w * 64 + lane, fr = lane & 15, fq = lane >> 4;
    const int b = unit >> 8, h = (unit >> 6) & 3, c = unit & 63; const size_t n0 = (size_t)b * SEQ + 64 * c;
    GAS bf16* PA = (GAS bf16*)(F.ws + WS_PA); GAS bf16* Y = (GAS bf16*)(F.ws + WS_Y); const GAS float* GLR = (const GAS float*)(F.ws + WS_GLR);
    GAS bf16* US = (GAS bf16*)(F.ws + WS_US) + (size_t)unit * 8192; GAS float* DEC = (GAS float*)(F.ws + WS_DEC) + unit * 64;
    LAS unsigned char* QT = F.lds; LAS unsigned char* KT = F.lds + 8192; LAS unsigned char* KD = F.lds + 16384; LAS unsigned char* VV = F.lds + 24576; LAS unsigned char* ATT = F.lds + 40960;
    LAS float* SEG = (LAS float*)(F.lds + 65536); LAS float* WA = (LAS float*)(F.lds + 67584); LAS float* BA = (LAS float*)(F.lds + 71680);
#pragma unroll
    for (int i = 0; i < 2; ++i) { const int e = tid + 512 * i; WA[e] = ((const GAS float*)F.in[6])[(size_t)l * 16 * 256 + (e >> 6) * 256 + h * 64 + (e & 63)]; }
    if (tid < 64) BA[tid] = ((const GAS float*)F.in[7])[l * 256 + h * 64 + tid];
#pragma unroll
    for (int i = 0; i < 2; ++i) { const int piece = tid + 512 * i, row = piece >> 4, c16 = piece & 15;
        *(LAS u32x4*)(VV + row * 256 + c16 * 16) = *(const GAS u32x4*)(PA + (n0 + row) * NPA + PA_BV + h * 128 + 8 * c16); }
    __syncthreads();
    const int k = tid & 63, seg = w;
    float cum[8];
    { float run = 0.f;
#pragma unroll
      for (int i = 0; i < 8; ++i) { const int t = 8 * seg + i; float z = BA[k];
          const f32x4 g0 = *(const GAS f32x4*)(GLR + (n0 + t) * 16), g1 = *(const GAS f32x4*)(GLR + (n0 + t) * 16 + 4), g2 = *(const GAS f32x4*)(GLR + (n0 + t) * 16 + 8), g3 = *(const GAS f32x4*)(GLR + (n0 + t) * 16 + 12);
#pragma unroll
          for (int r = 0; r < 4; ++r) { z += g0[r] * WA[r * 64 + k]; z += g1[r] * WA[(4 + r) * 64 + k]; z += g2[r] * WA[(8 + r) * 64 + k]; z += g3[r] * WA[(12 + r) * 64 + k]; }
          const float ls = fminf(z, 0.f) - log1pf(__expf(-fabsf(z)));
          run += ls * (1.f / 16.f); cum[i] = run; }
      SEG[seg * 64 + k] = run; }
    __syncthreads();
    { float off = 0.f, blast = 0.f;
#pragma unroll
      for (int s2 = 0; s2 < 8; ++s2) { const float sv = SEG[s2 * 64 + k]; blast += sv; off += (s2 < seg) ? sv : 0.f; }
#pragma unroll
      for (int i = 0; i < 8; ++i) { const int t = 8 * seg + i; const float bb = cum[i] + off;
          const float qv = bf1(PA[(n0 + t) * NPA + PA_BQ + h * 64 + k]), kv = bf1(PA[(n0 + t) * NPA + PA_BK + h * 64 + k]);
          const unsigned qt = f2bf(qv * __expf(bb));
          ((LAS unsigned short*)QT)[t * 64 + k] = (unsigned short)qt; ((LAS unsigned short*)KT)[t * 64 + k] = (unsigned short)f2bf(kv * __expf(-bb)); ((LAS unsigned short*)KD)[t * 64 + k] = (unsigned short)f2bf(kv * __expf(blast - bb));
          PA[(n0 + t) * NPA + PA_BQ + h * 64 + k] = (bf16)qt; }
      if (seg == 0) DEC[k] = __expf(blast); }
    __syncthreads();
#pragma unroll
    for (int ii = 0; ii < 2; ++ii) { const int id = 2 * w + ii, ts = id >> 2, tt = id & 3;
        f32x4 d = {0.f, 0.f, 0.f, 0.f};
        if (ts <= tt) {
#pragma unroll
            for (int ks = 0; ks < 2; ++ks) { const bf16x8 a = *(const LAS bf16x8*)(KT + (16 * ts + fr) * 128 + (8 * fq + 32 * ks) * 2), bq = *(const LAS bf16x8*)(QT + (16 * tt + fr) * 128 + (8 * fq + 32 * ks) * 2);
                d = __builtin_amdgcn_mfma_f32_16x16x32_bf16(a, bq, d, 0, 0, 0); } }
        const int t = 16 * tt + fr, s0 = 16 * ts + 4 * fq;
        u32x2 pk; pk.x = cvt_pk_bf16((s0 <= t) ? d[0] : 0.f, (s0 + 1 <= t) ? d[1] : 0.f); pk.y = cvt_pk_bf16((s0 + 2 <= t) ? d[2] : 0.f, (s0 + 3 <= t) ? d[3] : 0.f);
        *(LAS u32x2*)(ATT + t * 128 + s0 * 2) = pk; }
    __syncthreads();
    { const int tr = w & 3, nh = w >> 2;
      f32x4 ao[4], au[4];
#pragma unroll
      for (int j = 0; j < 4; ++j) { ao[j] = (f32x4){0.f, 0.f, 0.f, 0.f}; au[j] = (f32x4){0.f, 0.f, 0.f, 0.f}; }
#pragma unroll
      for (int ks = 0; ks < 2; ++ks) {
          const bf16x8 aA = *(const LAS bf16x8*)(ATT + (16 * tr + fr) * 128 + (8 * fq + 32 * ks) * 2);
          const int srow = 32 * ks + 8 * fq + (fr >> 2);
          const bf16x8 aK = cat8(ldtr(KD + srow * 128 + (16 * tr + 4 * (fr & 3)) * 2), ldtr(KD + (srow + 4) * 128 + (16 * tr + 4 * (fr & 3)) * 2));
#pragma unroll
          for (int j = 0; j < 4; ++j) { const int nt = 4 * nh + j;
              const bf16x8 bv = cat8(ldtr(VV + srow * 256 + (16 * nt + 4 * (fr & 3)) * 2), ldtr(VV + (srow + 4) * 256 + (16 * nt + 4 * (fr & 3)) * 2));
              ao[j] = __builtin_amdgcn_mfma_f32_16x16x32_bf16(bv, aA, ao[j], 0, 0, 0);
              au[j] = __builtin_amdgcn_mfma_f32_16x16x32_bf16(bv, aK, au[j], 0, 0, 0); } }
#pragma unroll
      for (int j = 0; j < 4; ++j) { const int v0 = 16 * (4 * nh + j) + 4 * fq, row = 16 * tr + fr;
          u32x2 wo; wo.x = pk2(ao[j][0], ao[j][1]); wo.y = pk2(ao[j][2], ao[j][3]); *(GAS u32x2*)(Y + (n0 + row) * 1536 + 512 + h * 128 + v0) = wo;
          u32x2 wu; wu.x = pk2(au[j][0], au[j][1]); wu.y = pk2(au[j][2], au[j][3]); *(GAS u32x2*)(US + row * 128 + v0) = wu; } }
    __syncthreads();
}
__device__ __forceinline__ void gla_scan_phase(Frame& F) {
    GAS bf16* USb = (GAS bf16*)(F.ws + WS_US); const GAS float* DECb = (const GAS float*)(F.ws + WS_DEC);
    for (int gt = F.wg * 512 + F.tid; gt < 131072; gt += F.G * 512) { const int e0 = 2 * gt, bh = e0 >> 13, kv = e0 & 8191, k = kv >> 7;
        GAS unsigned* p = (GAS unsigned*)(USb + (size_t)bh * 64 * 8192 + kv); const GAS float* dp = DECb + bh * 64 * 64 + k;
        float s0 = 0.f, s1 = 0.f;
#pragma unroll 8
        for (int c = 0; c < 64; ++c) { const unsigned u = p[(size_t)c * 4096]; const float d = dp[c * 64];
            p[(size_t)c * 4096] = pk2(s0, s1);
            s0 = d * s0 + bflo(u); s1 = d * s1 + bfhi(u); } }
}
__device__ __forceinline__ void gla_out_unit(Frame& F, int l, int unit) {
    const int lane = fresh_lane(), w = F.wave, tid = w * 64 + lane, fr = lane & 15, fq = lane >> 4;
    const int b = unit >> 8, h = (unit >> 6) & 3, c = unit & 63; const size_t n0 = (size_t)b * SEQ + 64 * c;
    const GAS bf16* PA = (const GAS bf16*)(F.ws + WS_PA); GAS bf16* Y = (GAS bf16*)(F.ws + WS_Y);
    const GAS bf16* US = (const GAS bf16*)(F.ws + WS_US) + (size_t)unit * 8192;
    LAS unsigned char* SS = F.lds;
    LAS float* PS = (LAS float*)(F.lds + 16384);
    const GAS float* gng = ((const GAS float*)F.in[8]) + l * 128;
#pragma unroll
    for (int i = 0; i < 2; ++i) { const int piece = tid + 512 * i; *(LAS u32x4*)(SS + piece * 16) = *(const GAS u32x4*)(US + piece * 8); }
    __syncthreads();
    const int tr = w >> 1, nh = w & 1;
    f32x4 acc[4];
#pragma unroll
    for (int j = 0; j < 4; ++j) acc[j] = (f32x4){0.f, 0.f, 0.f, 0.f};
#pragma unroll
    for (int ks = 0; ks < 2; ++ks) {
        const bf16x8 aq = *(const GAS bf16x8*)(PA + (n0 + 16 * tr + fr) * NPA + PA_BQ + h * 64 + 8 * fq + 32 * ks);
        const int krow = 32 * ks + 8 * fq + (fr >> 2);
#pragma unroll
        for (int j = 0; j < 4; ++j) { const int nt = 4 * nh + j;
            const bf16x8 bs = cat8(ldtr(SS + krow * 256 + (16 * nt + 4 * (fr & 3)) * 2), ldtr(SS + (krow + 4) * 256 + (16 * nt + 4 * (fr & 3)) * 2));
            acc[j] = __builtin_amdgcn_mfma_f32_16x16x32_bf16(bs, aq, acc[j], 0, 0, 0); } }
    const int row = 16 * tr + fr;
    float ss = 0.f;
#pragma unroll
    for (int j = 0; j < 4; ++j) { const int v0 = 16 * (4 * nh + j) + 4 * fq; const u32x2 oi = *(const GAS u32x2*)(Y + (n0 + row) * 1536 + 512 + h * 128 + v0);
        acc[j][0] += bflo(oi.x); acc[j][1] += bfhi(oi.x); acc[j][2] += bflo(oi.y); acc[j][3] += bfhi(oi.y);
        ss += (acc[j][0] * acc[j][0] + acc[j][1] * acc[j][1]) + (acc[j][2] * acc[j][2] + acc[j][3] * acc[j][3]); }
    ss += shx(ss, 16, lane); ss += shx(ss, 32, lane);
    if (fq == 0) PS[row * 2 + nh] = ss;
    __syncthreads();
    { const float rinv = 1.f / sqrtf((PS[row * 2] + PS[row * 2 + 1]) * (1.f / 128.f) + RMS_EPS);
#pragma unroll
      for (int j = 0; j < 4; ++j) { const int v0 = 16 * (4 * nh + j) + 4 * fq; const f32x4 gg = *(const GAS f32x4*)(gng + v0);
          const u32x2 br = *(const GAS u32x2*)(PA + (n0 + row) * NPA + PA_BR + h * 128 + v0);
          u32x2 wv; wv.x = pk2(acc[j][0] * rinv * gg[0] * bflo(br.x), acc[j][1] * rinv * gg[1] * bfhi(br.x)); wv.y = pk2(acc[j][2] * rinv * gg[2] * bflo(br.y), acc[j][3] * rinv * gg[3] * bfhi(br.y));
          *(GAS u32x2*)(Y + (n0 + row) * 1536 + 512 + h * 128 + v0) = wv; } }
    __syncthreads();
}

constexpr int DSA_WAVE_LDS = 17920;
__device__ __forceinline__ void dsa_unit(Frame& F, int unit) {
    int lane = F.lane; asm volatile("" : "+v"(lane)); const int w = F.wave;
    const int qb = 4095 - unit;
    const int b = qb & 7, t = (qb >> 3) * 8 + w;
    const size_t n = (size_t)b * SEQ + t, nb0 = (size_t)b * SEQ;
    const GAS bf16* PA = (const GAS bf16*)(F.ws + WS_PA); GAS bf16* Y = (GAS bf16*)(F.ws + WS_Y);
    const GAS bf16* KI = (const GAS bf16*)(F.ws + WS_KI); const GAS bf16* KA = (const GAS bf16*)(F.ws + WS_KA); const GAS bf16* VA = (const GAS bf16*)(F.ws + WS_VA);
    const GAS float* WI = (const GAS float*)(F.ws + WS_WI);
    LAS unsigned char* base = F.lds + w * DSA_WAVE_LDS;
    LAS unsigned* sc = (LAS unsigned*)base;
    LAS float* qi = (LAS float*)(base + 16384);
    LAS unsigned short* list = (LAS unsigned short*)(base + 16384 + 1024);
    { const u32x2 q2 = *(const GAS u32x2*)(PA + n * NPA + PA_QI + 4 * lane);
      *(LAS f32x4*)(qi + 4 * lane) = (f32x4){bflo(q2.x), bfhi(q2.x), bflo(q2.y), bfhi(q2.y)}; }
    asm volatile("s_waitcnt lgkmcnt(0)" ::: "memory");
    const f32x4 wi = {ld_f32(WI + n * 4), ld_f32(WI + n * 4 + 1), ld_f32(WI + n * 4 + 2), ld_f32(WI + n * 4 + 3)};
    const int nbat = (t >> 6) + 1;
    for (int kb = 0; kb < nbat; ++kb) { const int key = kb * 64 + lane, kc = key <= t ? key : t;
        const GAS u32x4* kp = (const GAS u32x4*)(KI + (nb0 + kc) * 64);
        float kf[64];
#pragma unroll
        for (int c = 0; c < 8; ++c) { const u32x4 kk = kp[c]; kf[8 * c] = bflo(kk.x); kf[8 * c + 1] = bfhi(kk.x); kf[8 * c + 2] = bflo(kk.y); kf[8 * c + 3] = bfhi(kk.y); kf[8 * c + 4] = bflo(kk.z); kf[8 * c + 5] = bfhi(kk.z); kf[8 * c + 6] = bflo(kk.w); kf[8 * c + 7] = bfhi(kk.w); }
        float score = 0.f;
#pragma unroll
        for (int h = 0; h < 4; ++h) { float d = 0.f;
#pragma unroll
            for (int c = 0; c < 16; ++c) { const f32x4 q4 = *(const LAS f32x4*)(qi + h * 64 + 4 * c); d += q4.x * kf[4 * c] + q4.y * kf[4 * c + 1] + q4.z * kf[4 * c + 2] + q4.w * kf[4 * c + 3]; }
            score += wi[h] * fmaxf(d, 0.f); }
        if (score == 0.f) score = 0.f;
        unsigned u = __builtin_bit_cast(unsigned, score); u = (u & 0x80000000u) ? ~u : (u | 0x80000000u);
        sc[key] = key <= t ? u : 0u; }
    asm volatile("s_waitcnt lgkmcnt(0)" ::: "memory");
    int nsel;
    if (t >= 256) {
        unsigned T = 0u;
        for (int bit = 31; bit >= 0; --bit) { const unsigned cand = T | (1u << bit); int cnt = 0;
            for (int j = 0; j < nbat; ++j) cnt += (sc[j * 64 + lane] >= cand) ? 1 : 0;
            if (wave_sum_i(cnt, lane) >= 256) T = cand; }
        int cgt = 0;
        for (int j = 0; j < nbat; ++j) cgt += (sc[j * 64 + lane] > T) ? 1 : 0;
        const int need = 256 - wave_sum_i(cgt, lane);
        int selbase = 0, tiebase = 0;
        for (int j = 0; j < nbat; ++j) { const unsigned x = sc[j * 64 + lane]; const bool eq = (x == T), gt = (x > T);
            const unsigned long long beq = __ballot(eq); const unsigned long long lt = (1ull << lane) - 1ull;
            const int trank = tiebase + __popcll(beq & lt);
            const bool sel = gt || (eq && trank < need);
            const unsigned long long bsel = __ballot(sel);
            if (sel) list[selbase + __popcll(bsel & lt)] = (unsigned short)(j * 64 + lane);
            selbase += __popcll(bsel); tiebase += __popcll(beq); }
        nsel = 256;
    } else {
        nsel = t + 1;
        for (int i = lane; i < 256; i += 64) list[i] = (unsigned short)(i <= t ? i : 0);
    }
    asm volatile("s_waitcnt lgkmcnt(0)" ::: "memory");
    LAS float* qm = (LAS float*)base;
    LAS float* Pl = (LAS float*)(base + 2048);
    { const u32x4 q8 = *(const GAS u32x4*)(PA + n * NPA + PA_Q + 8 * lane);
      *(LAS f32x4*)(qm + 8 * lane) = (f32x4){bflo(q8.x), bfhi(q8.x), bflo(q8.y), bfhi(q8.y)}; *(LAS f32x4*)(qm + 8 * lane + 4) = (f32x4){bflo(q8.z), bfhi(q8.z), bflo(q8.w), bfhi(q8.w)}; }
    asm volatile("s_waitcnt lgkmcnt(0)" ::: "memory");
#pragma unroll 1
    for (int bb = 0; bb < 4; ++bb) { const int i = bb * 64 + lane; const bool valid = i < nsel; const int key = valid ? (int)list[i] : 0;
        const GAS u32x4* kp = (const GAS u32x4*)(KA + (nb0 + key) * 64);
        float kf[64];
#pragma unroll
        for (int c = 0; c < 8; ++c) { const u32x4 kk = kp[c]; kf[8 * c] = bflo(kk.x); kf[8 * c + 1] = bfhi(kk.x); kf[8 * c + 2] = bflo(kk.y); kf[8 * c + 3] = bfhi(kk.y); kf[8 * c + 4] = bflo(kk.z); kf[8 * c + 5] = bfhi(kk.z); kf[8 * c + 6] = bflo(kk.w); kf[8 * c + 7] = bfhi(kk.w); }
        float lgv[8];
#pragma unroll
        for (int h = 0; h < 8; ++h) { float d = 0.f;
#pragma unroll
            for (int c = 0; c < 16; ++c) { const f32x4 q4 = *(const LAS f32x4*)(qm + h * 64 + 4 * c); d += q4.x * kf[4 * c] + q4.y * kf[4 * c + 1] + q4.z * kf[4 * c + 2] + q4.w * kf[4 * c + 3]; }
            lgv[h] = valid ? d : -INFINITY; }
        *(LAS f32x4*)(Pl + i * 8) = (f32x4){lgv[0], lgv[1], lgv[2], lgv[3]}; *(LAS f32x4*)(Pl + i * 8 + 4) = (f32x4){lgv[4], lgv[5], lgv[6], lgv[7]}; }
    asm volatile("s_waitcnt lgkmcnt(0)" ::: "memory");
    float lg[4][8];
#pragma unroll
    for (int bb = 0; bb < 4; ++bb) { const f32x4 a = *(const LAS f32x4*)(Pl + (bb * 64 + lane) * 8), c = *(const LAS f32x4*)(Pl + (bb * 64 + lane) * 8 + 4);
        lg[bb][0] = a.x; lg[bb][1] = a.y; lg[bb][2] = a.z; lg[bb][3] = a.w; lg[bb][4] = c.x; lg[bb][5] = c.y; lg[bb][6] = c.z; lg[bb][7] = c.w; }
    float den[8];
#pragma unroll
    for (int h = 0; h < 8; ++h) { float m = fmaxf(fmaxf(lg[0][h], lg[1][h]), fmaxf(lg[2][h], lg[3][h])); m = wave_max(m, lane); float s = 0.f;
#pragma unroll
        for (int bb = 0; bb < 4; ++bb) { lg[bb][h] = __expf(lg[bb][h] - m); s += lg[bb][h]; }
        den[h] = wave_sum(s, lane); }
#pragma unroll
    for (int bb = 0; bb < 4; ++bb) { const int i = bb * 64 + lane;
        *(LAS f32x4*)(Pl + i * 8) = (f32x4){lg[bb][0], lg[bb][1], lg[bb][2], lg[bb][3]}; *(LAS f32x4*)(Pl + i * 8 + 4) = (f32x4){lg[bb][4], lg[bb][5], lg[bb][6], lg[bb][7]}; }
    asm volatile("s_waitcnt lgkmcnt(0)" ::: "memory");
    float o[8];
#pragma unroll
    for (int h = 0; h < 8; ++h) o[h] = 0.f;
#pragma unroll 4
    for (int i = 0; i < nsel; ++i) { const int key = (int)list[i]; const float vv = bf1(VA[(nb0 + key) * 64 + lane]);
        const f32x4 p0 = *(const LAS f32x4*)(Pl + i * 8), p1 = *(const LAS f32x4*)(Pl + i * 8 + 4);
        o[0] += p0.x * vv; o[1] += p0.y * vv; o[2] += p0.z * vv; o[3] += p0.w * vv; o[4] += p1.x * vv; o[5] += p1.y * vv; o[6] += p1.z * vv; o[7] += p1.w * vv; }
#pragma unroll
    for (int h = 0; h < 8; ++h) Y[n * 1536 + h * 64 + lane] = (bf16)f2bf(o[h] / den[h]);
}

__device__ __forceinline__ bf16x8 scale_pack8(u32x4 raw, float s) {
    u32x4 o; o.x = cvt_pk_bf16(bflo(raw.x) * s, bfhi(raw.x) * s); o.y = cvt_pk_bf16(bflo(raw.y) * s, bfhi(raw.y) * s); o.z = cvt_pk_bf16(bflo(raw.z) * s, bfhi(raw.z) * s); o.w = cvt_pk_bf16(bflo(raw.w) * s, bfhi(raw.w) * s);
    return __builtin_bit_cast(bf16x8, o);
}
__device__ __forceinline__ void dsa16_unit(Frame& F, int unit) {
    const int lane = fresh_lane(); const int w = F.wave;
    const int qb = 2047 - unit;
    const int b = qb & 7, t0 = (qb >> 3) * 16;
    const size_t nb0 = (size_t)b * SEQ;
    const GAS bf16* PA = (const GAS bf16*)(F.ws + WS_PA); GAS bf16* Y = (GAS bf16*)(F.ws + WS_Y);
    const GAS bf16* KI = (const GAS bf16*)(F.ws + WS_KI); const GAS bf16* KA = (const GAS bf16*)(F.ws + WS_KA); const GAS bf16* VA = (const GAS bf16*)(F.ws + WS_VA);
    const GAS float* WI = (const GAS float*)(F.ws + WS_WI);
    LAS unsigned char* K16 = F.lds;
    LAS unsigned short* LIST = (LAS unsigned short*)(F.lds + AUX_OFF);
    const int fr = lane & 15, fq = lane >> 4;
#ifdef REP_S1
    for (int rep_ = 0; rep_ < REP_S1; ++rep_)
#endif
    {
        const int ql = fr >> 2, h = fr & 3;
        bf16x8 Bf[4][2]; float Linf[4];
#pragma unroll
        for (int g = 0; g < 4; ++g) { const size_t nq = nb0 + t0 + 4 * g + ql; const float wv = WI[nq * 4 + h];
#pragma unroll
            for (int ks = 0; ks < 2; ++ks) Bf[g][ks] = scale_pack8(*(const GAS u32x4*)(PA + nq * NPA + PA_QI + h * 64 + 8 * fq + 32 * ks), wv);
            Linf[g] = (wv >= 0.f) ? INFINITY : -INFINITY; }
        const int ntiles = (t0 >> 4) + 1;
        bf16x8 A0[4], A1[4];
#pragma unroll
        for (int j = 0; j < 4; ++j) { const int tile = (w + 8 * j < ntiles) ? w + 8 * j : ntiles - 1; const size_t krow = (nb0 + 16 * tile + fr) * 64;
            A0[j] = *(const GAS bf16x8*)(KI + krow + 8 * fq); A1[j] = *(const GAS bf16x8*)(KI + krow + 32 + 8 * fq); }
#pragma unroll 1
        for (int tb = w; tb < ntiles; tb += 32) {
            bf16x8 N0[4], N1[4];
#pragma unroll
            for (int j = 0; j < 4; ++j) { const int tn = tb + 32 + 8 * j; const int tile = (tn < ntiles) ? tn : ntiles - 1; const size_t krow = (nb0 + 16 * tile + fr) * 64;
                N0[j] = *(const GAS bf16x8*)(KI + krow + 8 * fq); N1[j] = *(const GAS bf16x8*)(KI + krow + 32 + 8 * fq); }
#pragma unroll
            for (int j = 0; j < 4; ++j) { const int tile = tb + 8 * j;
                if (tile < ntiles) {
                    const int kpos = 16 * tile + 4 * fq + h;
                    const int g7 = kpos >> 7, hf = (kpos >> 6) & 1, ln = kpos & 63;
                    const int koff = (g7 >> 2) * 1024 + ln * 16 + (g7 & 3) * 4 + hf * 2;
                    const bool lastt = (tile == ntiles - 1);
                    f32x4 d[4];
#pragma unroll
                    for (int g = 0; g < 4; ++g) d[g] = __builtin_amdgcn_mfma_f32_16x16x32_bf16(A0[j], Bf[g][0], (f32x4){0.f, 0.f, 0.f, 0.f}, 0, 0, 0);
#pragma unroll
                    for (int g = 0; g < 4; ++g) d[g] = __builtin_amdgcn_mfma_f32_16x16x32_bf16(A1[j], Bf[g][1], d[g], 0, 0, 0);
#define S1_STEP(g) const float a0##g = __builtin_amdgcn_fmed3f(d[g][0], 0.f, Linf[g]), a1##g = __builtin_amdgcn_fmed3f(d[g][1], 0.f, Linf[g]), a2##g = __builtin_amdgcn_fmed3f(d[g][2], 0.f, Linf[g]), a3##g = __builtin_amdgcn_fmed3f(d[g][3], 0.f, Linf[g]);
                    S1_STEP(0) S1_STEP(1) S1_STEP(2) S1_STEP(3)
#undef S1_STEP
#define S1_STEP(g) const float u0##g = a0##g + dppf<0xB1>(a0##g), u1##g = a1##g + dppf<0xB1>(a1##g), u2##g = a2##g + dppf<0xB1>(a2##g), u3##g = a3##g + dppf<0xB1>(a3##g);
                    S1_STEP(0) S1_STEP(1) S1_STEP(2) S1_STEP(3)
#undef S1_STEP
#define S1_STEP(g) const float p0##g = (h & 1) ? u1##g : u0##g, p1##g = (h & 1) ? u3##g : u2##g;
                    S1_STEP(0) S1_STEP(1) S1_STEP(2) S1_STEP(3)
#undef S1_STEP
#define S1_STEP(g) const float c0##g = p0##g + dppf<0x4E>(p0##g), c1##g = p1##g + dppf<0x4E>(p1##g);
                    S1_STEP(0) S1_STEP(1) S1_STEP(2) S1_STEP(3)
#undef S1_STEP
#define S1_STEP(g) const float s##g = ((h & 2) ? c1##g : c0##g) + 0.0f; const _Float16 hh##g = (_Float16)s##g; const unsigned hb##g = (unsigned)__builtin_bit_cast(unsigned short, hh##g); \
                    unsigned key##g = hb##g ^ ((unsigned)((int)(hb##g << 16) >> 31) | 0x8000u); if (lastt) key##g = (kpos <= t0 + 4 * g + ql) ? key##g : 0u;
                    S1_STEP(0) S1_STEP(1) S1_STEP(2) S1_STEP(3)
#undef S1_STEP
#define S1_STEP(g) *(LAS unsigned short*)(K16 + (4 * g + ql) * 8192 + koff) = (unsigned short)key##g;
                    S1_STEP(0) S1_STEP(1) S1_STEP(2) S1_STEP(3)
#undef S1_STEP
                }
            }
#pragma unroll
            for (int j = 0; j < 4; ++j) { A0[j] = N0[j]; A1[j] = N1[j]; }
        }
    }
    __syncthreads();
    if (t0 < 256) {
#pragma unroll 1
        for (int qq = 0; qq < 2; ++qq) { const int q = 2 * w + qq, nvalid = t0 + q + 1; LAS unsigned short* list = LIST + q * 256;
            for (int i = lane; i < 256; i += 64) list[i] = (unsigned short)(i < nvalid ? i : 0); }
    } else {
#ifndef REP_S2
#define REP_S2 1
#endif
#pragma unroll 1
        for (int qq = 0; qq < 2 * REP_S2; ++qq) {
            const int q = 2 * w + (qq & 1), nvalid = t0 + q + 1;
            LAS unsigned short* list = LIST + q * 256;
            const int ngrp = (nvalid + 511) >> 9;
            unsigned P[32];
#pragma unroll
            for (int grp = 0; grp < 8; ++grp) {
                if (grp < ngrp) { const u32x4 r = *(const LAS u32x4*)(K16 + q * 8192 + grp * 1024 + lane * 16);
#pragma unroll
                    for (int i = 0; i < 4; ++i) { const int g = 4 * grp + i; const int thr = nvalid - 128 * g; unsigned rr = r[i];
                        if (thr < 128) rr &= ((lane < thr) ? 0xffffu : 0u) | ((lane < thr - 64) ? 0xffff0000u : 0u);
                        P[g] = rr; }
                } else {
#pragma unroll
                    for (int i = 0; i < 4; ++i) P[4 * grp + i] = 0u;
                }
            }
            unsigned one2 = 0x00010001u; asm volatile("" : "+v"(one2));
#define DSA_PKCOUNT(dst, c1) do { const unsigned c1p_ = (c1) | ((c1) << 16); unsigned a_ = 0u; \
                _Pragma("unroll") for (int grp = 0; grp < 8; ++grp) if (grp < ngrp) { _Pragma("unroll") for (int i = 0; i < 4; ++i) { unsigned y_; \
                    asm("v_pk_sub_u16 %0, %1, %2 clamp\n\tv_pk_min_u16 %0, %0, %3" : "=&v"(y_) : "v"(P[4 * grp + i]), "v"(c1p_), "v"(one2)); a_ += y_; } } \
                dst = (int)((a_ & 0xffffu) + (a_ >> 16)); } while (0)
            LAS unsigned* hist = (LAS unsigned*)(F.lds + AUX_OFF + 8192) + w * 256;
            unsigned T; int tot_gt;
            { unsigned hi8 = 0u; int above = 0;
#pragma unroll
              for (int lvl = 0; lvl < 2; ++lvl) {
                  { unsigned z_ = 0u; asm volatile("" : "+v"(z_)); *(LAS u32x4*)(hist + 4 * lane) = (u32x4){z_, z_, z_, z_}; }
                  asm volatile("s_waitcnt lgkmcnt(0)" ::: "memory");
#pragma unroll
                  for (int grp = 0; grp < 8; ++grp) if (grp < ngrp) {
#pragma unroll
                      for (int i = 0; i < 4; ++i) { const unsigned lo = P[4 * grp + i] & 0xffffu, hi = P[4 * grp + i] >> 16;
                          if (lvl == 0) { __hip_atomic_fetch_add(hist + (lo >> 8), 1u, __ATOMIC_RELAXED, __HIP_MEMORY_SCOPE_WAVEFRONT); __hip_atomic_fetch_add(hist + (hi >> 8), 1u, __ATOMIC_RELAXED, __HIP_MEMORY_SCOPE_WAVEFRONT); }
                          else { if ((lo >> 8) == hi8) __hip_atomic_fetch_add(hist + (lo & 0xffu), 1u, __ATOMIC_RELAXED, __HIP_MEMORY_SCOPE_WAVEFRONT);
                                 if ((hi >> 8) == hi8) __hip_atomic_fetch_add(hist + (hi & 0xffu), 1u, __ATOMIC_RELAXED, __HIP_MEMORY_SCOPE_WAVEFRONT); } } }
                  asm volatile("s_waitcnt lgkmcnt(0)" ::: "memory");
                  const u32x4 hb = *(const LAS u32x4*)(hist + 4 * lane);
                  const int sl = (int)(hb.x + hb.y + hb.z + hb.w);
                  int inc = sl;
                  inc += __builtin_amdgcn_update_dpp(0, inc, 0x111, 0xf, 0xf, false); inc += __builtin_amdgcn_update_dpp(0, inc, 0x112, 0xf, 0xf, false);
                  inc += __builtin_amdgcn_update_dpp(0, inc, 0x114, 0xf, 0xf, false); inc += __builtin_amdgcn_update_dpp(0, inc, 0x118, 0xf, 0xf, false);
                  const int r0 = __builtin_amdgcn_readlane(inc, 15), r1 = __builtin_amdgcn_readlane(inc, 31), r2 = __builtin_amdgcn_readlane(inc, 47), r3 = __builtin_amdgcn_readlane(inc, 63);
                  inc += (fq >= 1 ? r0 : 0) + (fq >= 2 ? r1 : 0) + (fq >= 3 ? r2 : 0);
                  const int total = r0 + r1 + r2 + r3;
                  const int want = 256 - above;
                  int run = total - inc;
                  int fb = -1, fa = 0;
                  { const int h3 = (int)hb.w, h2 = (int)hb.z, h1 = (int)hb.y, h0 = (int)hb.x;
                    if (run < want && run + h3 >= want) { fb = 3; fa = run; } run += h3;
                    if (run < want && run + h2 >= want) { fb = 2; fa = run; } run += h2;
                    if (run < want && run + h1 >= want) { fb = 1; fa = run; } run += h1;
                    if (run < want && run + h0 >= want) { fb = 0; fa = run; } }
                  const unsigned long long fm = __ballot(fb >= 0);
                  const int src = (int)__builtin_ctzll(fm);
                  const int bstar = __builtin_amdgcn_readlane(4 * lane + fb, src), abv = __builtin_amdgcn_readlane(fa, src);
                  if (lvl == 0) { hi8 = (unsigned)bstar; above = abv; } else { T = (hi8 << 8) | (unsigned)bstar; tot_gt = above + abv; }
              } }
            int cge_l, cgt_l; DSA_PKCOUNT(cge_l, T - 1u); DSA_PKCOUNT(cgt_l, T);
            const int tot_ge = wave_total_i(cge_l);
            const bool alltie = (tot_ge == 256);
            const int c_l = alltie ? cge_l : cgt_l; const unsigned thrT = alltie ? T : T + 1u;
            int inc = c_l;
            inc += __builtin_amdgcn_update_dpp(0, inc, 0x111, 0xf, 0xf, false); inc += __builtin_amdgcn_update_dpp(0, inc, 0x112, 0xf, 0xf, false);
            inc += __builtin_amdgcn_update_dpp(0, inc, 0x114, 0xf, 0xf, false); inc += __builtin_amdgcn_update_dpp(0, inc, 0x118, 0xf, 0xf, false);
            { const int r0 = __builtin_amdgcn_readlane(inc, 15), r1 = __builtin_amdgcn_readlane(inc, 31), r2 = __builtin_amdgcn_readlane(inc, 47);
              inc += (fq >= 1 ? r0 : 0) + (fq >= 2 ? r1 : 0) + (fq >= 3 ? r2 : 0); }
            int kpos_ = inc - c_l;
#pragma unroll
            for (int grp = 0; grp < 8; ++grp) if (grp < ngrp) {
#pragma unroll
                for (int i = 0; i < 4; ++i) { const int g = 4 * grp + i; const unsigned lo = P[g] & 0xffffu, hi = P[g] >> 16;
                    if (lo >= thrT) { list[kpos_] = (unsigned short)(128 * g + lane); ++kpos_; }
                    if (hi >= thrT) { list[kpos_] = (unsigned short)(128 * g + 64 + lane); ++kpos_; } } }
            if (!alltie) {
                int rem = 256 - tot_gt, pos = tot_gt; const unsigned long long lt = (1ull << lane) - 1ull;
#pragma unroll
                for (int grp = 0; grp < 8; ++grp) if (grp < ngrp) {
#pragma unroll
                    for (int i = 0; i < 8; ++i) { const int g = 4 * grp + (i >> 1); const unsigned val = (i & 1) ? (P[g] >> 16) : (P[g] & 0xffffu);
                        const bool eq = (val == T); const unsigned long long beq = __ballot(eq);
                        if (beq != 0ull) { const int rank = __popcll(beq & lt); if (eq && rank < rem) list[pos + rank] = (unsigned short)(128 * g + 64 * (i & 1) + lane);
                            const int n = __popcll(beq), take = n < rem ? n : rem; pos += take; rem -= take; } } }
            }
#undef DSA_PKCOUNT
        }
    }
    asm volatile("s_waitcnt lgkmcnt(0)" ::: "memory");
    LAS unsigned char* Vs = F.lds + w * 16384;
#ifndef REP_S3
#define REP_S3 1
#endif
#pragma unroll 1
    for (int qq = 0; qq < 2 * REP_S3; ++qq) {
        const int q = 2 * w + (qq & 1), tq = t0 + q; const int nsel = (tq + 1 < 256) ? tq + 1 : 256;
        const size_t nq = nb0 + tq;
        const LAS unsigned short* list = LIST + q * 256;
        bf16x8 Qf[2];
#pragma unroll
        for (int ks = 0; ks < 2; ++ks) { u32x4 raw = {0u, 0u, 0u, 0u}; if (fr < 8) raw = *(const GAS u32x4*)(PA + nq * NPA + PA_Q + fr * 64 + 8 * fq + 32 * ks); Qf[ks] = __builtin_bit_cast(bf16x8, raw); }
        float lg[16][4];
#ifdef REP_S3K
#pragma unroll 1
        for (int repk = 0; repk < REP_S3K; ++repk)
#endif
        const int st_off = (lane >> 3) * 128 + (((lane & 7) ^ ((lane >> 3) & 7)) * 16);
        const int rd0 = fr * 128 + ((fq ^ (fr & 7)) * 16), rd1 = fr * 128 + (((fq + 4) ^ (fr & 7)) * 16);
#pragma unroll
        for (int hb = 0; hb < 2; ++hb) {
#pragma unroll
            for (int ib = 0; ib < 2; ++ib) { u32x4 kv[8];
#pragma unroll
                for (int i = 0; i < 8; ++i) { const int piece = (8 * ib + i) * 64 + lane; const int key = (int)list[128 * hb + (piece >> 3)];
                    kv[i] = *(const GAS u32x4*)(KA + (nb0 + key) * 64 + 8 * (lane & 7)); }
                __builtin_amdgcn_sched_barrier(0);
#pragma unroll
                for (int i = 0; i < 8; ++i) *(LAS u32x4*)(Vs + st_off + (8 * ib + i) * 1024) = kv[i];
            }
            asm volatile("s_waitcnt lgkmcnt(0)" ::: "memory");
#pragma unroll
            for (int j = 0; j < 8; ++j) { const int tt = 8 * hb + j;
                const bf16x8 A0 = *(const LAS bf16x8*)(Vs + rd0 + j * 2048), A1 = *(const LAS bf16x8*)(Vs + rd1 + j * 2048);
                f32x4 d = __builtin_amdgcn_mfma_f32_16x16x32_bf16(A0, Qf[0], (f32x4){0.f, 0.f, 0.f, 0.f}, 0, 0, 0);
                d = __builtin_amdgcn_mfma_f32_16x16x32_bf16(A1, Qf[1], d, 0, 0, 0);
#pragma unroll
                for (int r = 0; r < 4; ++r) lg[tt][r] = (16 * tt + 4 * fq + r < nsel) ? d[r] : -INFINITY; }
            asm volatile("s_waitcnt lgkmcnt(0)" ::: "memory");
        }
        float m = lg[0][0];
#pragma unroll
        for (int tt = 0; tt < 16; ++tt)
#pragma unroll
            for (int r = 0; r < 4; ++r) m = fmaxf(m, lg[tt][r]);
        m = fmaxf(m, shx(m, 16, lane)); m = fmaxf(m, shx(m, 32, lane));
        float den = 0.f;
#pragma unroll
        for (int tt = 0; tt < 16; ++tt)
#pragma unroll
            for (int r = 0; r < 4; ++r) { lg[tt][r] = __expf(lg[tt][r] - m); den += lg[tt][r]; }
        den += shx(den, 16, lane); den += shx(den, 32, lane);
        f32x4 acc[4];
#pragma unroll
        for (int nt = 0; nt < 4; ++nt) acc[nt] = (f32x4){0.f, 0.f, 0.f, 0.f};
#ifdef REP_S3V
#pragma unroll 1
        for (int repv = 0; repv < REP_S3V; ++repv) {
#pragma unroll
        for (int nt = 0; nt < 4; ++nt) acc[nt] = (f32x4){0.f, 0.f, 0.f, 0.f};
#endif
#pragma unroll
        for (int hh = 0; hh < 2; ++hh) {
#pragma unroll
            for (int ib = 0; ib < 2; ++ib) {
                u32x4 vv[8];
#pragma unroll
                for (int i = 0; i < 8; ++i) { const int piece = (8 * ib + i) * 64 + lane, row = piece >> 3, c = piece & 7; const int key = (int)list[128 * hh + row];
                    vv[i] = *(const GAS u32x4*)(VA + (nb0 + key) * 64 + 8 * c); }
                __builtin_amdgcn_sched_barrier(0);
#pragma unroll
                for (int i = 0; i < 8; ++i) { const int piece = (8 * ib + i) * 64 + lane; *(LAS u32x4*)(Vs + piece * 16) = vv[i]; }
            }
            asm volatile("s_waitcnt lgkmcnt(0)" ::: "memory");
#pragma unroll
            for (int s4 = 0; s4 < 4; ++s4) { const int s = 4 * hh + s4;
                u32x4 pa; pa.x = cvt_pk_bf16(lg[2 * s][0], lg[2 * s][1]); pa.y = cvt_pk_bf16(lg[2 * s][2], lg[2 * s][3]); pa.z = cvt_pk_bf16(lg[2 * s + 1][0], lg[2 * s + 1][1]); pa.w = cvt_pk_bf16(lg[2 * s + 1][2], lg[2 * s + 1][3]);
                const bf16x8 Pa = __builtin_bit_cast(bf16x8, pa);
                const int rowa = 32 * s4 + 4 * fq + (fr >> 2);
#pragma unroll
                for (int nt = 0; nt < 4; ++nt) {
                    const v4i16_t lo = __builtin_amdgcn_ds_read_tr16_b64_v4i16((LAS v4i16_t*)(Vs + rowa * 128 + (16 * nt + 4 * (fr & 3)) * 2));
                    const v4i16_t hi = __builtin_amdgcn_ds_read_tr16_b64_v4i16((LAS v4i16_t*)(Vs + (rowa + 16) * 128 + (16 * nt + 4 * (fr & 3)) * 2));
                    bf16x8 Bv; Bv[0] = lo[0]; Bv[1] = lo[1]; Bv[2] = lo[2]; Bv[3] = lo[3]; Bv[4] = hi[0]; Bv[5] = hi[1]; Bv[6] = hi[2]; Bv[7] = hi[3];
                    acc[nt] = __builtin_amdgcn_mfma_f32_16x16x32_bf16(Bv, Pa, acc[nt], 0, 0, 0); } }
            asm volatile("s_waitcnt lgkmcnt(0)" ::: "memory");
        }
#ifdef REP_S3V
        }
#endif
        if (fr < 8) { const float rden = 1.f / den;
#pragma unroll
            for (int nt = 0; nt < 4; ++nt) { u32x2 wv; wv.x = pk2(acc[nt][0] * rden, acc[nt][1] * rden); wv.y = pk2(acc[nt][2] * rden, acc[nt][3] * rden);
                *(GAS u32x2*)(Y + nq * 1536 + fr * 64 + 16 * nt + 4 * fq) = wv; } }
    }
}

#ifdef GLA_NAIVE
constexpr int NGLA = 32;
#else
constexpr int NGLA = 2048;
#endif
#ifdef DSA_NAIVE
constexpr int NDSA = 4096;
#else
constexpr int NDSA = 2048;
#endif
#ifdef GMLP_NAIVE
constexpr int NGM = 1024;
#else
constexpr int NGM = 256;
#endif
__device__ __forceinline__ void phase_mixer(Frame& F, int l, int slot = 0, int types = 7) {
    gu32* head = F.ctl + CW_QUEUE + 64 * (l + 2 * slot);
    for (;;) {
        __syncthreads();
        if (F.wave == 0 && fresh_lane() == 0) F.MISC[64] = __hip_atomic_fetch_add(head, 1u, __ATOMIC_RELAXED, __HIP_MEMORY_SCOPE_AGENT);
        __syncthreads();
        const int u = (int)F.MISC[64];
        if (u >= NDSA + NGLA + NGM) break;
        if (u < NDSA) { if (EN_B2 && (types & 2)) {
#ifdef DSA_NAIVE
            dsa_unit(F, u);
#else
            dsa16_unit(F, u);
#endif
        } }
        else if (u < NDSA + NGLA) { if (EN_B1 && (types & 1)) {
#ifdef GLA_NAIVE
            gla_unit(F, l, u - NDSA);
#else
            gla_local_unit(F, l, u - NDSA);
#endif
        } }
        else { if (EN_B3 && (types & 4)) {
#ifdef GMLP_NAIVE
            gmlp_unit(F, l, u - NDSA - NGLA);
#else
            gmlp16_unit(F, l, u - NDSA - NGLA);
#endif
        } }
    }
}
__device__ __forceinline__ void phase_gla_out(Frame& F, int l) {
#ifndef GLA_NAIVE
    for (int u = F.wg; u < 2048; u += F.G) gla_out_unit(F, l, u);
#endif
}

template <int CTRL> __device__ __forceinline__ float dpp_add(float v) { return v + dppf<CTRL>(v); }
__device__ __forceinline__ float row16_sum(float v) { v = dpp_add<0xB1>(v); v = dpp_add<0x4E>(v); v = dpp_add<0x141>(v); v = dpp_add<0x140>(v); return v; }
__device__ __forceinline__ void phase_ln_router(Frame& F, int l) {
    const GAS float* WR = (const GAS float*)(F.ws + WS_WR) + (size_t)l * 36 * DM;
    LAS float* wr = (LAS float*)F.lds;
    for (int i = F.tid; i < 36 * 256; i += 512) ((LAS f32x4*)wr)[i] = ((const GAS f32x4*)WR)[i];
    if (F.tid < 32) F.MISC[16 + F.tid] = 0u;
    __syncthreads();
    GAS bf16* HB = (GAS bf16*)(F.ws + WS_HB); const GAS bf16* T = (const GAS bf16*)F.H; GAS int* EID = (GAS int*)(F.ws + WS_ROUTE); GAS float* EW = (GAS float*)(F.ws + WS_ROUTE + 256 * 1024);
    const GAS float* g = ((const GAS float*)F.in[17]) + l * DM; const GAS float* bb = ((const GAS float*)F.in[18]) + l * DM; const GAS float* brg = ((const GAS float*)F.in[20]) + l * 4; const GAS float* bre = ((const GAS float*)F.in[22]) + l * 32;
    int lane = F.lane; asm volatile("" : "+v"(lane));
    const int sub = lane & 15, rr = lane >> 4;
    for (int r0 = F.wg * 128; r0 < NTOK; r0 += F.G * 128) {
        u32x4 nx[8];
#pragma unroll
        for (int q = 0; q < 8; ++q) nx[q] = *(const GAS u32x4*)(T + (size_t)(r0 + F.wave * 16 + rr) * DM + 8 * (sub + 16 * q));
#pragma unroll 1
        for (int j = 0; j < 4; ++j) { const int m = r0 + F.wave * 16 + 4 * j + rr;
            float v[64]; float s = 0.f;
#pragma unroll
            for (int q = 0; q < 8; ++q) { const u32x4 x = nx[q]; v[8 * q] = bflo(x.x); v[8 * q + 1] = bfhi(x.x); v[8 * q + 2] = bflo(x.y); v[8 * q + 3] = bfhi(x.y); v[8 * q + 4] = bflo(x.z); v[8 * q + 5] = bfhi(x.z); v[8 * q + 6] = bflo(x.w); v[8 * q + 7] = bfhi(x.w); }
            { const int mn = (j < 3) ? m + 4 : m;
#pragma unroll
              for (int q = 0; q < 8; ++q) nx[q] = *(const GAS u32x4*)(T + (size_t)mn * DM + 8 * (sub + 16 * q)); }
#pragma unroll
            for (int i = 0; i < 64; ++i) s += v[i];
            const float mean = row16_sum(s) * (1.f / DM); float s2 = 0.f;
#pragma unroll
            for (int i = 0; i < 64; ++i) { v[i] -= mean; s2 += v[i] * v[i]; }
            const float rstd = 1.f / sqrtf(row16_sum(s2) * (1.f / DM) + LN_EPS);
#pragma unroll
            for (int q = 0; q < 8; ++q) { const int c = 8 * (sub + 16 * q); const f32x4 g0 = *(const GAS f32x4*)(g + c), g1 = *(const GAS f32x4*)(g + c + 4), b0 = *(const GAS f32x4*)(bb + c), b1 = *(const GAS f32x4*)(bb + c + 4);
#pragma unroll
                for (int i = 0; i < 4; ++i) { v[8 * q + i] = v[8 * q + i] * rstd * g0[i] + b0[i]; v[8 * q + 4 + i] = v[8 * q + 4 + i] * rstd * g1[i] + b1[i]; }
                u32x4 wv; wv.x = pk2(v[8 * q], v[8 * q + 1]); wv.y = pk2(v[8 * q + 2], v[8 * q + 3]); wv.z = pk2(v[8 * q + 4], v[8 * q + 5]); wv.w = pk2(v[8 * q + 6], v[8 * q + 7]);
                *(GAS u32x4*)(HB + (size_t)m * DM + c) = wv; }
            float lgt[36];
#pragma unroll
            for (int o = 0; o < 36; ++o) { float p = 0.f;
#pragma unroll
                for (int q = 0; q < 8; ++q) { const f32x4 w0 = *(const LAS f32x4*)(wr + o * DM + 8 * (sub + 16 * q)), w1 = *(const LAS f32x4*)(wr + o * DM + 8 * (sub + 16 * q) + 4);
                    p += v[8 * q] * w0.x + v[8 * q + 1] * w0.y + v[8 * q + 2] * w0.z + v[8 * q + 3] * w0.w + v[8 * q + 4] * w1.x + v[8 * q + 5] * w1.y + v[8 * q + 6] * w1.z + v[8 * q + 7] * w1.w; }
                lgt[o] = row16_sum(p); }
            int gi = 0; float gm = lgt[0] + brg[0];
#pragma unroll
            for (int q = 1; q < 4; ++q) { const float x = lgt[q] + brg[q]; if (x > gm) { gm = x; gi = q; } }
            float gs = 0.f;
#pragma unroll
            for (int q = 0; q < 4; ++q) gs += __expf(lgt[q] + brg[q] - gm);
            const float gp = 1.f / gs;
            float el[8];
#pragma unroll
            for (int q = 0; q < 8; ++q) { float x = lgt[4 + q] + bre[q];
                x = (gi == 1) ? lgt[12 + q] + bre[8 + q] : x; x = (gi == 2) ? lgt[20 + q] + bre[16 + q] : x; x = (gi == 3) ? lgt[28 + q] + bre[24 + q] : x; el[q] = x; }
            int i0 = 0; float v0 = el[0];
#pragma unroll
            for (int q = 1; q < 8; ++q) if (el[q] > v0) { v0 = el[q]; i0 = q; }
            int i1 = -1; float v1 = -INFINITY;
#pragma unroll
            for (int q = 0; q < 8; ++q) if (q != i0 && el[q] > v1) { v1 = el[q]; i1 = q; }
            const float ex = __expf(v1 - v0), w0 = gp / (1.f + ex), w1 = gp * ex / (1.f + ex);
            if (sub == 0) { const int e0 = gi * 8 + i0, e1 = gi * 8 + i1;
                EID[2 * m] = e0; EID[2 * m + 1] = e1; EW[2 * m] = w0; EW[2 * m + 1] = w1;
                __hip_atomic_fetch_add((LAS unsigned*)(F.lds + MISC_OFF) + 16 + e0, 1u, __ATOMIC_RELAXED, __HIP_MEMORY_SCOPE_WORKGROUP);
                __hip_atomic_fetch_add((LAS unsigned*)(F.lds + MISC_OFF) + 16 + e1, 1u, __ATOMIC_RELAXED, __HIP_MEMORY_SCOPE_WORKGROUP); } }
    }
    __syncthreads();
    if (F.tid < 32) ((GAS int*)(F.ws + WS_CNTWG))[F.wg * 32 + F.tid] = (int)F.MISC[16 + F.tid];
}
__device__ __forceinline__ void phase_dispatch(Frame& F) {
    const GAS int* CNT = (const GAS int*)(F.ws + WS_CNTWG); const GAS int* EID = (const GAS int*)(F.ws + WS_ROUTE); const GAS float* EW = (const GAS float*)(F.ws + WS_ROUTE + 256 * 1024);
    GAS int* SROW = (GAS int*)(F.ws + WS_SROW); GAS int* ROWMAP = (GAS int*)(F.ws + WS_ROWMAP); GAS float* CWROW = (GAS float*)(F.ws + WS_CWROW); GAS int* META = (GAS int*)(F.ws + WS_META);
    LAS int* tot = (LAS int*)(F.lds + AUX_OFF);
    if (F.tid < 32) { int t = 0, mine = 0; for (int w = 0; w < F.G; ++w) { const int c = ld_i32(CNT + w * 32 + F.tid); t += c; if (w < F.wg) mine += c; } tot[F.tid] = t; tot[32 + F.tid] = mine; tot[96 + F.tid] = 0; }
    __syncthreads();
    if (F.tid == 0) { int rb = 0;
#pragma clang loop unroll(disable) vectorize(disable)
        for (int e = 0; e < 32; ++e) { tot[64 + e] = rb; rb += ((tot[e] + 255) >> 8) << 8; }
        tot[128] = rb; }
    __syncthreads();
    if (F.wg == 0) { const int nt = tot[128] >> 8; if (F.tid == 0) META[0] = nt;
        if (F.tid < nt) { int e = 0;
#pragma clang loop unroll(disable) vectorize(disable)
            for (int q = 1; q < 32; ++q) if (tot[64 + q] <= F.tid * 256) e = q;
            META[16 + F.tid] = e; } }
    for (int r0 = F.wg * 128; r0 < NTOK; r0 += F.G * 128) {
        if (F.tid < 256) { const int tok = r0 + (F.tid >> 1), slot = F.tid & 1; const int e = EID[2 * tok + slot];
            const int pos = (int)__hip_atomic_fetch_add((LAS unsigned*)&tot[96 + e], 1u, __ATOMIC_RELAXED, __HIP_MEMORY_SCOPE_WORKGROUP);
            const int sr = tot[64 + e] + tot[32 + e] + pos;
            ROWMAP[sr] = tok; CWROW[sr] = EW[2 * tok + slot]; SROW[2 * tok + slot] = sr; } }
    if (F.wg < 32) { const int e = F.wg; const int lo = tot[64 + e] + tot[e], hi = tot[64 + e] + (((tot[e] + 255) >> 8) << 8);
        for (int r = lo + F.tid; r < hi; r += 512) { ROWMAP[r] = 0; CWROW[r] = 0.f; } }
}
__device__ __forceinline__ void phase_ln2(Frame& F, int l) {
    GAS bf16* HB = (GAS bf16*)(F.ws + WS_HB); const GAS int* SROW = (const GAS int*)(F.ws + WS_SROW); const GAS bf16* FF2 = (const GAS bf16*)(F.ws + WS_FF2);
    const GAS float* g = ((const GAS float*)F.in[26]) + l * DM; const GAS float* bb = ((const GAS float*)F.in[27]) + l * DM; int lane = F.lane; asm volatile("" : "+v"(lane));
    const int gw = F.wg * 8 + F.wave, NGW = F.G * 8; const bool last = (l == DEPTH - 1);
    int m = gw;
    u32x4 hn[2], an[2], cn[2];
    if (m < NTOK) { const int s0 = ld_i32(SROW + 2 * m), s1 = ld_i32(SROW + 2 * m + 1);
#pragma unroll
        for (int j = 0; j < 2; ++j) { hn[j] = *(const GAS u32x4*)(HB + (size_t)m * DM + 8 * lane + 512 * j); an[j] = *(const GAS u32x4*)(FF2 + (size_t)s0 * DM + 8 * lane + 512 * j); cn[j] = *(const GAS u32x4*)(FF2 + (size_t)s1 * DM + 8 * lane + 512 * j); } }
#pragma unroll 1
    for (; m < NTOK; m += NGW) {
        float v[16];
#pragma unroll
        for (int j = 0; j < 2; ++j) { const u32x4 h = hn[j], a = an[j], c = cn[j];
            v[8 * j] = bflo(h.x) * DN_ALPHA + (bflo(a.x) + bflo(c.x)); v[8 * j + 1] = bfhi(h.x) * DN_ALPHA + (bfhi(a.x) + bfhi(c.x)); v[8 * j + 2] = bflo(h.y) * DN_ALPHA + (bflo(a.y) + bflo(c.y)); v[8 * j + 3] = bfhi(h.y) * DN_ALPHA + (bfhi(a.y) + bfhi(c.y));
            v[8 * j + 4] = bflo(h.z) * DN_ALPHA + (bflo(a.z) + bflo(c.z)); v[8 * j + 5] = bfhi(h.z) * DN_ALPHA + (bfhi(a.z) + bfhi(c.z)); v[8 * j + 6] = bflo(h.w) * DN_ALPHA + (bflo(a.w) + bflo(c.w)); v[8 * j + 7] = bfhi(h.w) * DN_ALPHA + (bfhi(a.w) + bfhi(c.w)); }
        const int mn = m + NGW;
        if (mn < NTOK) { const int s0 = ld_i32(SROW + 2 * mn), s1 = ld_i32(SROW + 2 * mn + 1);
#pragma unroll
            for (int j = 0; j < 2; ++j) { hn[j] = *(const GAS u32x4*)(HB + (size_t)mn * DM + 8 * lane + 512 * j); an[j] = *(const GAS u32x4*)(FF2 + (size_t)s0 * DM + 8 * lane + 512 * j); cn[j] = *(const GAS u32x4*)(FF2 + (size_t)s1 * DM + 8 * lane + 512 * j); } }
        float s = 0.f;
#pragma unroll
        for (int i = 0; i < 16; ++i) s += v[i];
        const float mean = wave_sum(s, lane) * (1.f / DM); float s2 = 0.f;
#pragma unroll
        for (int i = 0; i < 16; ++i) { v[i] -= mean; s2 += v[i] * v[i]; }
        const float rstd = 1.f / sqrtf(wave_sum(s2, lane) * (1.f / DM) + LN_EPS);
#pragma unroll
        for (int j = 0; j < 2; ++j) { const int c = 8 * lane + 512 * j; const f32x4 g0 = *(const GAS f32x4*)(g + c), g1 = *(const GAS f32x4*)(g + c + 4), b0 = *(const GAS f32x4*)(bb + c), b1 = *(const GAS f32x4*)(bb + c + 4);
#pragma unroll
            for (int i = 0; i < 4; ++i) { v[8 * j + i] = v[8 * j + i] * rstd * g0[i] + b0[i]; v[8 * j + 4 + i] = v[8 * j + 4 + i] * rstd * g1[i] + b1[i]; }
            if (last) { *(GAS f32x4*)(F.H + (size_t)m * DM + c) = (f32x4){v[8 * j], v[8 * j + 1], v[8 * j + 2], v[8 * j + 3]}; *(GAS f32x4*)(F.H + (size_t)m * DM + c + 4) = (f32x4){v[8 * j + 4], v[8 * j + 5], v[8 * j + 6], v[8 * j + 7]}; }
            else { u32x4 wv; wv.x = pk2(v[8 * j], v[8 * j + 1]); wv.y = pk2(v[8 * j + 2], v[8 * j + 3]); wv.z = pk2(v[8 * j + 4], v[8 * j + 5]); wv.w = pk2(v[8 * j + 6], v[8 * j + 7]); *(GAS u32x4*)(HB + (size_t)m * DM + c) = wv; } }
    }
}

#ifndef EN_P
#define EN_P 1
#endif
#ifndef EN_A
#define EN_A 1
#endif
#ifndef EN_B
#define EN_B 1
#endif
#ifndef EN_C
#define EN_C 1
#endif
#ifndef EN_D
#define EN_D 1
#endif
#ifndef EN_E
#define EN_E 1
#endif
#ifndef EN_F
#define EN_F 1
#endif
#ifndef EN_G
#define EN_G 1
#endif
#ifndef EN_H
#define EN_H 1
#endif
#ifndef EN_I
#define EN_I 1
#endif
#ifndef EN_J
#define EN_J 1
#endif
constexpr int PPL = 12;
constexpr int N_PHASES = 1 + PPL * DEPTH;
#ifndef MK_ONE_LAUNCH
#define MK_ONE_LAUNCH 0
#endif
struct Args { const float* in[28]; float* out; unsigned char* ws; int ph_lo, ph_hi; };
static_assert(sizeof(Args) == 28 * 8 + 8 + 8 + 8, "no padding bytes in the argument struct");


__device__ __forceinline__ unsigned opaque_u32(unsigned x) { unsigned v; asm volatile("v_mov_b32 %0, %1" : "=v"(v) : "s"(x)); return (unsigned)__builtin_amdgcn_readfirstlane((int)v); }
__device__ __forceinline__ unsigned long long opaque_u64(unsigned long long x) { return ((unsigned long long)opaque_u32((unsigned)(x >> 32)) << 32) | opaque_u32((unsigned)x); }
__device__ __forceinline__ void launder(Frame& F) {
    F.ws = (GAS unsigned char*)opaque_u64((unsigned long long)F.ws); F.H = (GAS float*)opaque_u64((unsigned long long)F.H);
    F.ctl = (gu32*)opaque_u64((unsigned long long)F.ctl);
    unsigned z0 = 0u; asm volatile("" : "+v"(z0)); int ln = (int)__builtin_amdgcn_mbcnt_hi(~0u, __builtin_amdgcn_mbcnt_lo(~0u, z0));
    F.wave = (int)opaque_u32((unsigned)F.wave); F.lane = ln; F.tid = F.wave * 64 + ln;
    F.G = (int)opaque_u32((unsigned)F.G); F.wg = (int)opaque_u32((unsigned)F.wg);
}
__global__ void __launch_bounds__(512, 2) mk_fwd(Args args) {
    extern __shared__ __attribute__((aligned(16))) unsigned char lds_raw[];
    Frame F;
    F.lds = (LAS unsigned char*)lds_raw;
    F.MISC = (volatile LAS unsigned*)(F.lds + MISC_OFF);
    F.tid = threadIdx.x; F.lane = F.tid & 63; F.wave = __builtin_amdgcn_readfirstlane(F.tid >> 6);
    F.G = gridDim.x; F.wg = blockIdx.x;
    F.in = args.in;
    F.pos = (const GAS int*)args.in[1];
    F.H = (GAS float*)args.out; F.ws = (GAS unsigned char*)args.ws;
    F.ctl = (gu32*)(args.ws + WS_CTL);
    for (int u = F.tid; u < (LDS_BYTES - MISC_OFF) / 4; u += 512) ((LAS unsigned*)(F.lds + MISC_OFF))[u] = 0u;
    __syncthreads();
    const int lo = args.ph_lo, hi = args.ph_hi;
    const bool multi = (hi - lo) > 1;
    XcdBarrier bar; bar.bar = (unsigned*)(F.ctl + CW_BAR); bar.x = 0; bar.st = nullptr;
    if (multi) bar = xcd_barrier_post((unsigned*)(F.ctl + CW_BAR), F.MISC + 8);
#define IN(k) (lo <= (k) && (k) < hi)
#define SEAM(k) do { if (IN(k) && IN((k) + 1)) xcd_barrier(bar); } while (0)

#ifdef DUP_P
    for (int rep = 0; rep < 2; ++rep)
#endif
    if (EN_P && IN(0)) { launder(F); phase_prologue(F); }
    SEAM(0);
#define HB ((GAS bf16*)(F.ws + WS_HB))
#define PA ((GAS bf16*)(F.ws + WS_PA))
#define Y ((GAS bf16*)(F.ws + WS_Y))
#define HM ((GAS bf16*)F.H + (size_t)NTOK * DM)
#define TT ((GAS bf16*)F.H)
    for (int l = 0; l < DEPTH; ++l) {
        const int pb = 1 + PPL * l;
#define wd (F.ws + WS_WDENSE + (size_t)l * WD_LAYER)
#ifdef DUP_A
        for (int rep = 0; rep < 2; ++rep)
#endif
        if (EN_A && IN(pb + 0)) { launder(F);
            DenseSched S; S.init(NTOK / 256, NPA / 256, F.G, F.wg, (const void*)HB, (size_t)256 * DM * 2, (const void*)(wd + WD_WA), (size_t)256 * DM * 2);
            EpiA E{PA, (GAS bf16*)(F.ws + WS_KA), (GAS bf16*)(F.ws + WS_VA), (GAS bf16*)(F.ws + WS_KI), (GAS float*)(F.ws + WS_WI), (GAS float*)(F.ws + WS_GLR), (const GAS float*)(F.ws + WS_ROPE), ((const GAS float*)F.in[5]) + l * 64};
            pg8::gemm_phase<EpiA, DenseSched, false>(F.lds, S, E, DM, DM, F.wave);
        }
        SEAM(pb + 0);
        if (EN_B && IN(pb + 1)) { launder(F); phase_mixer(F, l);
#ifdef DUP_B
            launder(F); phase_mixer(F, l, 1, DUP_B);
#endif
        }
        SEAM(pb + 1);
        if (EN_B && IN(pb + 2)) { launder(F); gla_scan_phase(F); }
        SEAM(pb + 2);
        if (EN_B && IN(pb + 3)) { launder(F); phase_gla_out(F, l); }
        SEAM(pb + 3);
#ifdef DUP_D
        for (int rep = 0; rep < 2; ++rep)
#endif
        if (EN_D && IN(pb + 4)) { launder(F);
            DenseSched S; S.init(NTOK / 256, DM / 256, F.G, F.wg, (const void*)Y, (size_t)256 * 1536 * 2, (const void*)(wd + WD_WBR), (size_t)256 * 512 * 2);
            S.nsub = 3; S.asub = 512 * 2; S.bsub = (size_t)1024 * 512 * 2;
            EpiP E{PA};
            pg8::gemm_phase<EpiP, DenseSched, false>(F.lds, S, E, 512, 1536, F.wave);
        }
#ifdef DUP_C
        for (int rep = 0; rep < 2; ++rep)
#endif
        if (EN_C && IN(pb + 4)) { launder(F);
            DenseSched S; S.init(NTOK / 256, DM / 256, F.G, F.wg, (const void*)HB, (size_t)256 * DM * 2, (const void*)(wd + WD_WG), (size_t)256 * DM * 2);
            S.nsub = 3; S.asub = 0; S.bsub = (size_t)1024 * DM * 2;
            EpiGM E{PA, HM};
            pg8::gemm_phase<EpiGM, DenseSched, false>(F.lds, S, E, DM, DM, F.wave);
        }
        SEAM(pb + 4);
        if (EN_E && IN(pb + 6)) { launder(F);
            DenseSched S; S.init(NTOK / 256, DM / 256, F.G, F.wg, (const void*)HM, (size_t)256 * DM * 2, (const void*)(wd + WD_WOUT), (size_t)256 * DM * 2);
            EpiO E{HB, TT};
            pg8::gemm_phase<EpiO, DenseSched, false>(F.lds, S, E, DM, DM, F.wave);
        }
        SEAM(pb + 6);
        if (EN_F && IN(pb + 7)) { launder(F); phase_ln_router(F, l); }
        SEAM(pb + 7);
        if (EN_G && IN(pb + 8)) { launder(F);
            { LAS float* scr = (LAS float*)(F.lds + F.wave * 16384); const int gw = F.wg * 8 + F.wave, NGW = F.G * 8;
              for (int it = gw; it < 12288; it += NGW) conv_moe_item(F, l, it, scr);
              __syncthreads(); }
            phase_dispatch(F); }
        SEAM(pb + 8);
#ifdef DUP_H
        for (int rep = 0; rep < 2; ++rep)
#endif
        if (EN_H && IN(pb + 9)) { launder(F);
            const GAS int* META = (const GAS int*)(F.ws + WS_META); const GAS int* ROWMAP = (const GAS int*)(F.ws + WS_ROWMAP);
            const int NT = ld_i32(META), NU = NT * 2;
            LAS int* meta = (LAS int*)(F.lds + AUX_OFF); LAS int* rows = (LAS int*)(F.lds + AUX_OFF + 64);
            for (int i = 0; i * F.G + F.wg < NU && i < 8; ++i) { const int L = i * F.G + F.wg, gt = L >> 1;
                if (F.tid == 0) meta[i] = ld_i32(META + 16 + gt);
                if (F.tid < 256) rows[i * 256 + F.tid] = ROWMAP[gt * 256 + F.tid]; }
            __syncthreads();
            GroupSched S{NU, F.G, F.wg, 2, (const char*)HB, (const char*)(F.ws + WS_WMOE + WM_GU), 0, (size_t)512 * DM * 2, (size_t)256 * DM * 2, meta, rows};
            EpiGU E{(GAS bf16*)(F.ws + WS_HID), (const GAS float*)(F.ws + WS_CWROW)};
            pg8::gemm_phase<EpiGU, GroupSched, true>(F.lds, S, E, DM, DM, F.wave);
        }
        SEAM(pb + 9);
#ifdef DUP_I
        for (int rep = 0; rep < 2; ++rep)
#endif
        if (EN_I && IN(pb + 10)) { launder(F);
            const GAS int* META = (const GAS int*)(F.ws + WS_META);
            const int NT = ld_i32(META), NU = NT * 4;
            LAS int* meta = (LAS int*)(F.lds + AUX_OFF);
            for (int i = 0; i * F.G + F.wg < NU && i < 8; ++i) { const int L = i * F.G + F.wg, gt = L >> 2; if (F.tid == 0) meta[i] = ld_i32(META + 16 + gt); }
            __syncthreads();
            GroupSched S{NU, F.G, F.wg, 4, (const char*)(F.ws + WS_HID), (const char*)(F.ws + WS_WMOE + WM_DN), (size_t)256 * DEXP * 2, (size_t)DM * DEXP * 2, (size_t)256 * DEXP * 2, meta, nullptr};
            EpiDN E{(GAS bf16*)(F.ws + WS_FF2)};
            pg8::gemm_phase<EpiDN, GroupSched, false>(F.lds, S, E, DEXP, DEXP, F.wave);
        }
        SEAM(pb + 10);
        if (EN_J && IN(pb + 11)) { launder(F); phase_ln2(F, l); }
        SEAM(pb + 11);
    }
#undef IN
#undef SEAM
#undef HB
#undef HM
#undef TT
#undef PA
#undef Y
#undef wd
}


#ifdef DUMP_OFF
__global__ void dump_k(const unsigned short* src, float* out) {
    for (size_t i = (size_t)blockIdx.x * blockDim.x + threadIdx.x; i < (size_t)NTOK * 1024; i += (size_t)gridDim.x * blockDim.x) { const size_t n = i >> 10, c = i & 1023; out[i] = __builtin_bit_cast(float, ((unsigned)src[n * DUMP_PITCH + c]) << 16); }
}
#endif
extern "C" void kernel_launch(void* const* d_in, const int* in_sizes, int n_in, void* d_out, int out_size, void* d_ws, size_t ws_size, hipStream_t stream) {
    static int grid = 0;
    if (grid == 0) {
        if (n_in != 28 || out_size != NTOK * DM || ws_size < WS_END) { fprintf(stderr, "kernel_launch: unexpected shapes (n_in %d out %d ws %zu); nothing launched\n", n_in, out_size, ws_size); grid = -1; return; }
        int dev = 0, cus = 0;
        if (hipGetDevice(&dev) != hipSuccess || hipDeviceGetAttribute(&cus, hipDeviceAttributeMultiprocessorCount, dev) != hipSuccess) { grid = -1; return; }
        if (hipFuncSetAttribute((const void*)mk_fwd, hipFuncAttributeMaxDynamicSharedMemorySize, LDS_BYTES) != hipSuccess) { fprintf(stderr, "kernel_launch: hipFuncSetAttribute failed\n"); grid = -1; return; }
        int per_cu = 0;
        if (hipOccupancyMaxActiveBlocksPerMultiprocessor(&per_cu, (const void*)mk_fwd, 512, LDS_BYTES) != hipSuccess || per_cu < 1) { fprintf(stderr, "kernel_launch: occupancy query says %d\n", per_cu); }
        (void)hipGetLastError();
        grid = cus;
        if (grid != 256) fprintf(stderr, "kernel_launch: %d CUs (built for 256)\n", grid);
    }
    if (grid < 0) return;
    if (hipMemsetAsync((char*)d_ws + WS_CTL, 0, CTL_ZERO_BYTES, stream) != hipSuccess) return;
    Args a{};
    for (int i = 0; i < 28; ++i) a.in[i] = (const float*)d_in[i];
    a.out = (float*)d_out; a.ws = (unsigned char*)d_ws;
#if MK_ONE_LAUNCH
    a.ph_lo = 0; a.ph_hi = N_PHASES;
    hipLaunchKernelGGL(mk_fwd, dim3(grid), dim3(512), LDS_BYTES, stream, a);
#else
#ifndef STOP_AFTER
#define STOP_AFTER (N_PHASES - 1)
#endif
#ifndef PHASE_MASK
#define PHASE_MASK 0xffffffffu
#endif
    for (int p = 0; p <= STOP_AFTER; ++p) { if (!((PHASE_MASK >> p) & 1u)) continue; a.ph_lo = p; a.ph_hi = p + 1; hipLaunchKernelGGL(mk_fwd, dim3(grid), dim3(512), LDS_BYTES, stream, a); }
#ifdef DUMP_OFF
    hipLaunchKernelGGL(dump_k, dim3(2048), dim3(256), 0, stream, (const unsigned short*)((const char*)d_ws + (size_t)(DUMP_OFF)), (float*)d_out);
#endif
#endif
}
```

```cpp
#define MK_ONE_LAUNCH 1
#include <hip/hip_runtime.h>
#include <cstdio>
#include <cstdint>

#define LAS __attribute__((address_space(3)))
#define GAS __attribute__((address_space(1)))
typedef unsigned short bf16;
typedef short bf16x8 __attribute__((ext_vector_type(8)));
typedef float f32x4 __attribute__((ext_vector_type(4)));
typedef float f32x2 __attribute__((ext_vector_type(2)));
typedef unsigned u32x4 __attribute__((ext_vector_type(4)));
typedef unsigned u32x2 __attribute__((ext_vector_type(2)));
typedef GAS unsigned gu32;

constexpr int NB = 8, SEQ = 4096, NTOK = NB * SEQ, DM = 1024, NIN = 6612, DEPTH = 2;
constexpr int NPA = 3584;
constexpr int NGT = 3072;
constexpr int NEXP = 32, DEXP = 256;
constexpr int MAXTILES = 288;
constexpr float DN_ALPHA = 1.41421356237309515f;
constexpr float LN_EPS = 1e-5f, RMS_EPS = 1e-6f;
constexpr int PA_Q = 0, PA_QI = 768, PA_BQ = 1024, PA_BK = 1280, PA_BV = 1536, PA_BR = 2048, PA_CU = 2560, PA_CV = 3072;

__device__ __forceinline__ unsigned f2bf(float f) { unsigned u = __builtin_bit_cast(unsigned, f); return (u + 0x7fffu + ((u >> 16) & 1u)) >> 16; }
__device__ __forceinline__ unsigned pk2(float lo, float hi) { return f2bf(lo) | (f2bf(hi) << 16); }
__device__ __forceinline__ float bflo(unsigned w) { return __builtin_bit_cast(float, w << 16); }
__device__ __forceinline__ float bfhi(unsigned w) { return __builtin_bit_cast(float, w & 0xffff0000u); }
__device__ __forceinline__ float bf1(bf16 h) { return __builtin_bit_cast(float, ((unsigned)h) << 16); }
typedef __bf16 bf16x2_t __attribute__((ext_vector_type(2)));
__device__ __forceinline__ unsigned cvt_pk_bf16(float lo, float hi) { const f32x2 v = {lo, hi}; const bf16x2_t b = __builtin_convertvector(v, bf16x2_t); return __builtin_bit_cast(unsigned, b); }
__device__ __forceinline__ float shx(float v, int mask, int lane) { return __builtin_bit_cast(float, __builtin_amdgcn_ds_bpermute((lane ^ mask) << 2, __builtin_bit_cast(int, v))); }
__device__ __forceinline__ int shxi(int v, int mask, int lane) { return __builtin_amdgcn_ds_bpermute((lane ^ mask) << 2, v); }
__device__ __forceinline__ float wave_sum(float v, int lane) {
#pragma unroll
    for (int o = 1; o < 64; o <<= 1) v += shx(v, o, lane);
    return v;
}
__device__ __forceinline__ float wave_max(float v, int lane) {
#pragma unroll
    for (int o = 1; o < 64; o <<= 1) v = fmaxf(v, shx(v, o, lane));
    return v;
}
__device__ __forceinline__ int wave_sum_i(int v, int lane) {
#pragma unroll
    for (int o = 1; o < 64; o <<= 1) v += shxi(v, o, lane);
    return v;
}
__device__ __forceinline__ int fresh_lane() { unsigned z0 = 0u; asm volatile("" : "+v"(z0)); return (int)__builtin_amdgcn_mbcnt_hi(~0u, __builtin_amdgcn_mbcnt_lo(~0u, z0)); }
__device__ __forceinline__ int ld_i32(const GAS int* p) { return __hip_atomic_load(p, __ATOMIC_RELAXED, __HIP_MEMORY_SCOPE_AGENT); }
__device__ __forceinline__ float ld_f32(const GAS float* p) { return __hip_atomic_load(p, __ATOMIC_RELAXED, __HIP_MEMORY_SCOPE_AGENT); }
__device__ __forceinline__ float sigmoidf_(float x) { return __builtin_amdgcn_rcpf(1.0f + __expf(-x)); }
__device__ __forceinline__ float siluf_(float x) { return x * sigmoidf_(x); }
__device__ __forceinline__ float gelu_tanh_(float x) { const float u = 0.7978845608028654f * (x + 0.044715f * x * x * x); return x * sigmoidf_(2.0f * u); }

namespace pg8 {
constexpr int BM = 256, BK = 64, HALF = 128, HTB = HALF * BK * 2, STAGE_BYTES = 8 * HTB;
__host__ __device__ __forceinline__ int lds_byte(int r, int c) { const int st = (r >> 4) * 2 + (c >> 5), rr = r & 15, cc = c & 31, ob = rr * 64 + cc * 2; return st * 1024 + (ob ^ (((ob >> 9) & 1) << 5)); }
__host__ __device__ __forceinline__ void stage_rc(int b, int& R, int& C) { const int st = b / 1024, sb = b % 1024, swz = sb ^ (((sb >> 9) & 1) << 5); R = (st >> 1) * 16 + swz / 64; C = (st & 1) * 32 + (swz % 64) / 2; }
__host__ __device__ __forceinline__ int perm32(int rho) { const int n = rho >> 4, i = rho & 15; return 8 * (i >> 2) + 4 * n + (i & 3); }

struct Unit { int pm, pn, e, slot; };

template <class Epi, class Sched, bool GATHER>
__device__ __forceinline__ void gemm_phase(LAS unsigned char* lds, const Sched& S, const Epi& E, const int K, const int lda, const int wave) {
    unsigned z0_ = 0u; asm volatile("" : "+v"(z0_)); const int lane_ = (int)__builtin_amdgcn_mbcnt_hi(~0u, __builtin_amdgcn_mbcnt_lo(~0u, z0_));
    const int wid = wave, lane = lane_, tid = wid * 64 + lane, wr = wid >> 2, wc = wid & 3, fr = lane & 15, fq = lane >> 4;
    const int nt = K / BK;
    int Rr[2], Cc[2];
    unsigned voffB[2];
#pragma unroll
    for (int i = 0; i < 2; ++i) { int R, C; stage_rc(tid * 16 + i * 8192, R, C); Rr[i] = R; Cc[i] = C; const int Rb = Epi::PERM ? ((R & ~31) + perm32(R & 31)) : R; voffB[i] = (unsigned)(Rb * K + C) * 2u; }
    const size_t kstep = (size_t)(BK * 2);
    const size_t hstepB = (size_t)HALF * K * 2;
    const unsigned ldsw = (unsigned)wid * 1024u;
    const int aoff = lds_byte(wr * 64 + fr, fq * 8), boff = lds_byte(wc * 32 + fr, fq * 8);
#define PG8_SA(b, h) (((b) * 2 + (h)) * HTB)
#define PG8_SB(b, h) ((4 + (b) * 2 + (h)) * HTB)
#define PG8_STAGE(bufoff, gbase, voff) do { _Pragma("unroll") for (int _i = 0; _i < 2; ++_i) \
        __builtin_amdgcn_global_load_lds((const unsigned*)((const char*)(gbase) + (voff)[_i]), (LAS unsigned*)(lds + (bufoff) + ldsw + _i * 8192), 16, 0, 0); } while (0)
#define PG8_LDA(dst, b, h) do { _Pragma("unroll") for (int m = 0; m < 4; ++m) _Pragma("unroll") for (int k = 0; k < 2; ++k) dst[m][k] = *(const LAS bf16x8*)(lds + PG8_SA(b, h) + aoff + m * 2048 + k * 1024); } while (0)
#define PG8_LDB(dst, b, h) do { _Pragma("unroll") for (int n = 0; n < 2; ++n) _Pragma("unroll") for (int k = 0; k < 2; ++k) dst[n][k] = *(const LAS bf16x8*)(lds + PG8_SB(b, h) + boff + n * 2048 + k * 1024); } while (0)
#define PG8_MMA(ai, bj, At, Bt) do { __builtin_amdgcn_s_setprio(1); _Pragma("unroll") for (int m = 0; m < 4; ++m) _Pragma("unroll") for (int n = 0; n < 2; ++n) _Pragma("unroll") for (int k = 0; k < 2; ++k) \
        acc[ai][bj][m][n] = __builtin_amdgcn_mfma_f32_16x16x32_bf16(Bt[n][k], At[m][k], acc[ai][bj][m][n], 0, 0, 0); __builtin_amdgcn_s_setprio(0); } while (0)
#define PG8_WAIT_V(n) asm volatile("s_waitcnt vmcnt(" #n ")" ::: "memory")
#define PG8_WAIT_L(n) asm volatile("s_waitcnt lgkmcnt(" #n ")" ::: "memory")
#define PG8_BAR do { asm volatile("" ::: "memory"); __builtin_amdgcn_s_barrier(); asm volatile("" ::: "memory"); } while (0)
#define PG8_SCHED __builtin_amdgcn_sched_barrier(0)
    Unit cur, nxt; int ui = 0;
    if (!S.next(0, cur)) return;
    f32x4 acc[2][2][4][2];
#pragma unroll
    for (int a = 0; a < 2; ++a)
#pragma unroll
        for (int b = 0; b < 2; ++b)
#pragma unroll
            for (int m = 0; m < 4; ++m)
#pragma unroll
                for (int n = 0; n < 2; ++n) acc[a][b][m][n] = (f32x4){0.f, 0.f, 0.f, 0.f};
    bf16x8 At[4][2], B0[2][2], B1[2][2];
    unsigned cA0[2], cA1[2], nA0[2], nA1[2];
#pragma unroll
    for (int i = 0; i < 2; ++i) {
        if (GATHER) { cA0[i] = (unsigned)(S.row_of(cur, Rr[i]) * lda + Cc[i]) * 2u; cA1[i] = (unsigned)(S.row_of(cur, HALF + Rr[i]) * lda + Cc[i]) * 2u; }
        else { cA0[i] = (unsigned)(Rr[i] * lda + Cc[i]) * 2u; cA1[i] = (unsigned)((HALF + Rr[i]) * lda + Cc[i]) * 2u; }
        nA0[i] = cA0[i]; nA1[i] = cA1[i];
    }
    const char* cA = S.a_base(cur); const char* cB = S.b_base(cur);
    PG8_STAGE(PG8_SB(0, 0), cB, voffB); PG8_STAGE(PG8_SB(0, 1), cB + hstepB, voffB); PG8_STAGE(PG8_SA(0, 0), cA, cA0); PG8_STAGE(PG8_SA(0, 1), cA, cA1);
    if (wr == 1) PG8_BAR;
    PG8_WAIT_V(2); PG8_BAR;
    PG8_STAGE(PG8_SB(1, 0), cB + kstep, voffB); PG8_STAGE(PG8_SA(1, 0), cA + kstep, cA0); PG8_STAGE(PG8_SB(1, 1), cB + hstepB + kstep, voffB);
    PG8_WAIT_V(6); PG8_BAR;
    for (;;) {
        const bool has_next = S.next(ui + 1, nxt);
        const char* nA = has_next ? S.a_base(nxt) : cA; const char* nB = has_next ? S.b_base(nxt) : cB;
        if (GATHER) {
#pragma unroll
            for (int i = 0; i < 2; ++i) {
                if (has_next) { nA0[i] = (unsigned)(S.row_of(nxt, Rr[i]) * lda + Cc[i]) * 2u; nA1[i] = (unsigned)(S.row_of(nxt, HALF + Rr[i]) * lda + Cc[i]) * 2u; }
                else { nA0[i] = cA0[i]; nA1[i] = cA1[i]; }
            }
        }
#pragma unroll 1
        for (int t = 0; t < nt; t += 2) {
            const bool last = (t == nt - 2);
            const char* a1 = cA + (size_t)(t + 1) * kstep;
            const char* a2 = last ? nA : cA + (size_t)(t + 2) * kstep; const char* b2 = last ? nB : cB + (size_t)(t + 2) * kstep;
            const char* a3 = a2 + kstep; const char* b3 = b2 + kstep;
            unsigned x0[2], x1[2];
#pragma unroll
            for (int i = 0; i < 2; ++i) { x0[i] = (GATHER && last) ? nA0[i] : cA0[i]; x1[i] = (GATHER && last) ? nA1[i] : cA1[i]; }
            PG8_LDB(B0, 0, 0); PG8_LDB(B1, 0, 1); PG8_SCHED; PG8_LDA(At, 0, 0); PG8_STAGE(PG8_SA(1, 1), a1, cA1);
            PG8_WAIT_V(8); PG8_WAIT_L(0); PG8_BAR; PG8_MMA(0, 0, At, B0); PG8_MMA(0, 1, At, B1); PG8_BAR; PG8_SCHED;
            PG8_LDA(At, 0, 1); PG8_STAGE(PG8_SB(0, 0), b2, voffB); PG8_STAGE(PG8_SB(0, 1), b2 + hstepB, voffB); PG8_STAGE(PG8_SA(0, 0), a2, x0);
            PG8_WAIT_V(8); PG8_WAIT_L(0); PG8_BAR; PG8_MMA(1, 0, At, B0); PG8_MMA(1, 1, At, B1); PG8_BAR; PG8_SCHED;
            PG8_LDB(B0, 1, 0); PG8_LDB(B1, 1, 1); PG8_SCHED; PG8_LDA(At, 1, 0); PG8_STAGE(PG8_SA(0, 1), a2, x1);
            PG8_WAIT_V(8); PG8_WAIT_L(0); PG8_BAR; PG8_MMA(0, 0, At, B0); PG8_MMA(0, 1, At, B1); PG8_BAR; PG8_SCHED;
            PG8_LDA(At, 1, 1); PG8_STAGE(PG8_SB(1, 0), b3, voffB); PG8_STAGE(PG8_SB(1, 1), b3 + hstepB, voffB); PG8_STAGE(PG8_SA(1, 0), a3, x0);
            PG8_WAIT_V(8); PG8_WAIT_L(0); PG8_BAR; PG8_MMA(1, 0, At, B0); PG8_MMA(1, 1, At, B1); PG8_BAR; PG8_SCHED;
        }
        if (wr == 0) PG8_BAR;
        E(acc, cur, wr, wc, fr, fq);
        if (!has_next) break;
#pragma unroll
        for (int a = 0; a < 2; ++a)
#pragma unroll
            for (int b = 0; b < 2; ++b)
#pragma unroll
                for (int m = 0; m < 4; ++m)
#pragma unroll
                    for (int n = 0; n < 2; ++n) acc[a][b][m][n] = (f32x4){0.f, 0.f, 0.f, 0.f};
        cur = nxt; cA = nA; cB = nB; ++ui;
#pragma unroll
        for (int i = 0; i < 2; ++i) { cA0[i] = nA0[i]; cA1[i] = nA1[i]; }
        if (wr == 1) PG8_BAR;
    }
    PG8_WAIT_V(0);
    PG8_BAR;
#undef PG8_SA
#undef PG8_SB
#undef PG8_STAGE
#undef PG8_LDA
#undef PG8_LDB
#undef PG8_MMA
#undef PG8_WAIT_V
#undef PG8_WAIT_L
#undef PG8_BAR
#undef PG8_SCHED
}
}

#define XB_TMO      128
#define XB_XCNT(j)  (256  + 64 * (j))
#define XB_XSUB(j)  (1280 + 64 * (j))
#define XB_XGEN(j)  (2304 + 64 * (j))
#define XB_TOP      3328
#define XB_TOPGEN   3392
#define XCD_BAR_WORDS 3456
#define XB_SPIN_CAP (1u << 20)

__device__ __forceinline__ unsigned xb_ld(unsigned* p)              { return __hip_atomic_load(p, __ATOMIC_RELAXED, __HIP_MEMORY_SCOPE_AGENT); }
__device__ __forceinline__ unsigned xb_add(unsigned* p, unsigned v) { return __hip_atomic_fetch_add(p, v, __ATOMIC_RELAXED, __HIP_MEMORY_SCOPE_AGENT); }
__device__ __forceinline__ unsigned xb_xcc_id() { return (unsigned)__builtin_amdgcn_s_getreg((3 << 11) | 20) & 0xFu; }
#define XB_SPIN(cond, bar) do { unsigned _sp = 0; while (cond) { __builtin_amdgcn_s_sleep(1); \
    if ((++_sp & 255u) == 0u) { if (xb_ld(&(bar)[XB_TMO])) break; if (_sp > XB_SPIN_CAP) { atomicAdd(&(bar)[XB_TMO], 1u); break; } } } } while (0)

struct XcdBarrier { unsigned* bar; unsigned x; volatile LAS unsigned* st; };

__device__ __forceinline__ XcdBarrier xcd_barrier_post(unsigned* bar, volatile LAS unsigned* st) {
    XcdBarrier b; b.bar = bar; b.x = xb_xcc_id(); b.st = st;
    if (threadIdx.x == 0) (void)xb_add(&bar[XB_XCNT(b.x)], 1u);
    return b;
}
__device__ __forceinline__ void xcd_barrier_complete(unsigned* bar, unsigned x, unsigned& nloc, unsigned& nx) {
    const unsigned G = gridDim.x * gridDim.y * gridDim.z;
    unsigned sum, cnt, mine, sp = 0u;
    for (;;) {
        sum = 0u; cnt = 0u; mine = 0u;
#pragma unroll
        for (unsigned j = 0; j < 16; ++j) { const unsigned c = xb_ld(&bar[XB_XCNT(j)]); sum += c; cnt += (c > 0u) ? 1u : 0u; mine = (j == x) ? c : mine; }
        if (sum == G) break;
        __builtin_amdgcn_s_sleep(1);
        if ((++sp & 255u) == 0u) { if (xb_ld(&bar[XB_TMO])) break; if (sp > XB_SPIN_CAP) { atomicAdd(&bar[XB_TMO], 1u); break; } }
    }
    nloc = mine > 0u ? mine : 1u; nx = cnt > 0u ? cnt : 1u;
}
__device__ __forceinline__ void xcd_barrier(const XcdBarrier& b) {
    asm volatile("s_waitcnt vmcnt(0)" ::: "memory");
    __syncthreads();
    if (threadIdx.x == 0) {
        unsigned* bar = b.bar;
        __builtin_amdgcn_s_waitcnt(0);
        unsigned nloc = b.st[0], nx = b.st[1];
        if (nloc == 0u) { xcd_barrier_complete(bar, b.x, nloc, nx); b.st[0] = nloc; b.st[1] = nx; }
        const unsigned old = xb_add(&bar[XB_XSUB(b.x)], 1u);
        const unsigned gen = old / nloc;
        if (old + 1u == (gen + 1u) * nloc) {
            __builtin_amdgcn_fence(__ATOMIC_RELEASE, "agent");
            asm volatile("s_waitcnt vmcnt(0)" ::: "memory");
            const unsigned og = xb_add(&bar[XB_TOP], 1u);
            const unsigned tg = og / nx;
            if (og + 1u == (tg + 1u) * nx) xb_add(&bar[XB_TOPGEN], 1u);
            else XB_SPIN(xb_ld(&bar[XB_TOPGEN]) == tg, bar);
            __builtin_amdgcn_fence(__ATOMIC_ACQUIRE, "agent");
            xb_add(&bar[XB_XGEN(b.x)], 1u);
            asm volatile("s_waitcnt vmcnt(0)" ::: "memory");
        } else {
            XB_SPIN(xb_ld(&bar[XB_XGEN(b.x)]) == gen, bar);
            __builtin_amdgcn_fence(__ATOMIC_ACQUIRE, "agent");
            asm volatile("s_waitcnt vmcnt(0)" ::: "memory");
        }
    }
    __syncthreads();
}

constexpr size_t MiB = 1u << 20;
constexpr size_t WS_CTL = 0, CTL_ZERO_BYTES = 1 * MiB;
constexpr size_t WS_ROPE = 1 * MiB;
constexpr size_t WS_WI   = 3 * MiB;
constexpr size_t WS_ROUTE = 3 * MiB + 512 * 1024;
constexpr size_t WS_SROW = 4 * MiB;
constexpr size_t WS_ROWMAP = 4 * MiB + 256 * 1024;
constexpr size_t WS_CWROW = 4 * MiB + 640 * 1024;
constexpr size_t WS_CNTWG = 5 * MiB;
constexpr size_t WS_META = 5 * MiB + 64 * 1024;
constexpr size_t WS_WR = 5 * MiB + 128 * 1024;
constexpr size_t WS_GLR = 6 * MiB;
constexpr size_t WS_WDENSE = 8 * MiB;
constexpr size_t WD_WA = 0, WD_WG = 7 * MiB, WD_WBR = 13 * MiB, WD_WOUT = 16 * MiB, WD_LAYER = 18 * MiB;
constexpr size_t WS_WMOE = 44 * MiB;
constexpr size_t WM_GU = 0, WM_DN = 32 * MiB;
constexpr size_t WS_HB = 92 * MiB;
constexpr size_t WS_PA = 156 * MiB;
constexpr size_t WS_HID = WS_PA;
constexpr size_t WS_FF2 = WS_PA + 40 * MiB;
constexpr size_t WS_Y = 380 * MiB;
constexpr size_t WS_KA = 476 * MiB, WS_VA = 480 * MiB, WS_KI = 484 * MiB;
constexpr size_t WS_END = 512 * MiB;
static_assert(WS_WDENSE + 2 * WD_LAYER <= WS_WMOE && WS_WMOE + 48 * MiB <= WS_HB && WS_HB + 64 * MiB <= WS_PA && WS_PA + 224 * MiB <= WS_Y && WS_Y + 96 * MiB <= WS_KA && WS_KI + 4 * MiB <= WS_END, "ws map");
static_assert(WS_FF2 + (size_t)73728 * 1024 * 2 <= WS_Y, "ff2 fits");
constexpr int CW_BAR = 4096;
constexpr int CW_QUEUE = 16384;

constexpr int RING_BYTES = 131072;
constexpr int AUX_OFF = 131072;
constexpr int MISC_OFF = 147456;
constexpr int LDS_BYTES = 148480;

struct Frame {
    LAS unsigned char* lds;
    volatile LAS unsigned* MISC;
    gu32* ctl;
    int tid, lane, wave, G, wg;
    const float* const* in;
    const GAS int* pos;
    GAS float* H;
    GAS unsigned char* ws;
};

#define LDS_WAIT() asm volatile("s_waitcnt lgkmcnt(0)" ::: "memory")
#define VM_WAIT() asm volatile("s_waitcnt vmcnt(0)" ::: "memory")

__device__ __forceinline__ int pa_src_col(int c) {
    if (c < 512) return c;
    if (c < 768) { const int x = c - 512, half = x >> 7, y = x & 127, grp = y >> 5, d = (y & 31) + 32 * half;
        if (grp == 0) return 512 + d;
        if (grp == 1) return 576 + d;
        if (grp == 2) return 896 + d;
        if (half == 0) { const int z = y - 96; if (z < 4) return 960 + z; if (z < 20) return 1988 + (z - 4); }
        return -1; }
    if (c < 1024) return 640 + (c - 768);
    if (c < 1280) return 964 + (c - 1024);
    if (c < 1536) return 1220 + (c - 1280);
    if (c < 2048) return 1476 + (c - 1536);
    if (c < 2560) return 2004 + (c - 2048);
    return 2516 + (c - 2560);
}
__device__ __forceinline__ void transpose_item(const GAS float* W, int ldw, int K, GAS bf16* WT, int n0, int k0, int sc, LAS float* scr, int lane) {
#pragma unroll 8
    for (int i = 0; i < 32; ++i) { const int kk = 2 * i + (lane >> 5); scr[kk * 33 + (lane & 31)] = (sc >= 0) ? W[(size_t)(k0 + kk) * ldw + sc] : 0.f; }
    LDS_WAIT(); asm volatile("" ::: "memory");
    const int c = lane & 7;
#pragma unroll
    for (int j = 0; j < 4; ++j) { const int n = (lane >> 3) + 8 * j; const LAS float* s = scr + (8 * c) * 33 + n;
        u32x4 o; o.x = pk2(s[0 * 33], s[1 * 33]); o.y = pk2(s[2 * 33], s[3 * 33]); o.z = pk2(s[4 * 33], s[5 * 33]); o.w = pk2(s[6 * 33], s[7 * 33]);
        *(GAS u32x4*)(WT + (size_t)(n0 + n) * K + k0 + 8 * c) = o; }
    LDS_WAIT(); asm volatile("" ::: "memory");
}
__device__ __forceinline__ void conv_dense_item(Frame& F, int l, int it, LAS float* scr) {
    GAS bf16* base = (GAS bf16*)(F.ws + WS_WDENSE + (size_t)l * WD_LAYER);
    const int lane = F.lane;
    if (it < 1792) { const int kb = it / 112, nb = it % 112; const int sc = pa_src_col(32 * nb + (lane & 31));
        transpose_item(((const GAS float*)F.in[4]) + (size_t)l * DM * NIN, NIN, DM, base + WD_WA / 2, 32 * nb, 64 * kb, sc, scr, lane); return; }
    it -= 1792;
    if (it < 1536) { const int kb = it / 96, nb = it % 96; const int sc = 3540 + 32 * nb + (lane & 31);
        transpose_item(((const GAS float*)F.in[4]) + (size_t)l * DM * NIN, NIN, DM, base + WD_WG / 2, 32 * nb, 64 * kb, sc, scr, lane); return; }
    it -= 1536;
    if (it < 768) { const int br = it / 256, r = it % 256, kb = r / 32, nb = r % 32; const int sc = 32 * nb + (lane & 31);
        transpose_item((br == 0 ? ((const GAS float*)F.in[13]) : br == 1 ? ((const GAS float*)F.in[14]) : ((const GAS float*)F.in[15])) + (size_t)l * 512 * DM, DM, 512, base + WD_WBR / 2 + (size_t)br * 1024 * 512, 32 * nb, 64 * kb, sc, scr, lane); return; }
    it -= 768;
    { const int kb = it / 32, nb = it % 32; const int sc = 32 * nb + (lane & 31);
        transpose_item(((const GAS float*)F.in[16]) + (size_t)l * DM * DM, DM, DM, base + WD_WOUT / 2, 32 * nb, 64 * kb, sc, scr, lane); }
}
__device__ __forceinline__ void conv_moe_item(Frame& F, int l, int it, LAS float* scr) {
    const int lane = F.lane; const int e = it / 384; int r = it % 384;
    if (r < 256) { const int sub = r / 64, q = r % 64, ct = sub >> 1, bj = sub & 1, kb = q / 4, nb = q % 4;
        const GAS float* src = (bj ? ((const GAS float*)F.in[24]) : ((const GAS float*)F.in[23])) + (size_t)(l * NEXP + e) * DM * DEXP;
        GAS bf16* dst = (GAS bf16*)(F.ws + WS_WMOE + WM_GU) + (size_t)e * 512 * DM;
        transpose_item(src, DEXP, DM, dst, 256 * ct + 128 * bj + 32 * nb, 64 * kb, 128 * ct + 32 * nb + (lane & 31), scr, lane); return; }
    r -= 256;
    { const int kb = r / 32, nb = r % 32;
        const GAS float* src = ((const GAS float*)F.in[25]) + (size_t)(l * NEXP + e) * DEXP * DM;
        GAS bf16* dst = (GAS bf16*)(F.ws + WS_WMOE + WM_DN) + (size_t)e * DM * DEXP;
        transpose_item(src, DM, DEXP, dst, 32 * nb, 64 * kb, 32 * nb + (lane & 31), scr, lane); }
}

__device__ __forceinline__ void ln_row_regs(f32x4 (&v)[4], const GAS float* g, const GAS float* b, int lane) {
    float s = 0.f;
#pragma unroll
    for (int j = 0; j < 4; ++j) s += (v[j].x + v[j].y) + (v[j].z + v[j].w);
    const float mean = wave_sum(s, lane) * (1.f / DM); float s2 = 0.f;
#pragma unroll
    for (int j = 0; j < 4; ++j) { v[j] = v[j] - mean; s2 += (v[j].x * v[j].x + v[j].y * v[j].y) + (v[j].z * v[j].z + v[j].w * v[j].w); }
    const float rstd = 1.f / sqrtf(wave_sum(s2, lane) * (1.f / DM) + LN_EPS);
#pragma unroll
    for (int j = 0; j < 4; ++j) { const f32x4 gg = *(const GAS f32x4*)(g + 4 * lane + 256 * j), bb = *(const GAS f32x4*)(b + 4 * lane + 256 * j); v[j] = v[j] * rstd * gg + bb; }
}
__device__ __forceinline__ void store_row_f32_bf16(const f32x4 (&v)[4], GAS float* hrow, GAS bf16* brow, int lane) {
#pragma unroll
    for (int j = 0; j < 4; ++j) {
        if (hrow) *(GAS f32x4*)(hrow + 4 * lane + 256 * j) = v[j];
        if (brow) { u32x2 w; w.x = pk2(v[j].x, v[j].y); w.y = pk2(v[j].z, v[j].w); *(GAS u32x2*)(brow + 4 * lane + 256 * j) = w; }
    }
}

__device__ __forceinline__ void phase_prologue(Frame& F) {
    LAS float* scr = (LAS float*)(F.lds + F.wave * 16384);
    const int gw = F.wg * 8 + F.wave, NGW = F.G * 8;
    for (int it = gw; it < 2 * 4608; it += NGW) conv_dense_item(F, it / 4608, it % 4608, scr);
    { GAS bf16* WRB = (GAS bf16*)(F.ws + WS_WR);
      for (int i = gw * 64 + F.lane; i < DEPTH * 48 * DM; i += NGW * 64) { const int l = i / (48 * DM), r = i % (48 * DM), o = r / DM, k = r % DM;
          const float v = (o < 4) ? ((const GAS float*)F.in[19])[(size_t)l * DM * 4 + k * 4 + o] : (o < 36) ? ((const GAS float*)F.in[21])[(size_t)l * DM * 32 + k * 32 + (o - 4)] : 0.f;
          WRB[i] = (bf16)f2bf(v); } }
    { GAS float* RT = (GAS float*)(F.ws + WS_ROPE);
      for (int i = gw * 64 + F.lane; i < NTOK * 8; i += NGW * 64) { const int n = i >> 3, j = i & 7;
          const float invf[8] = {1.000000000e+00f, 1.939227432e-01f, 3.760603070e-02f, 7.292664610e-03f, 1.414213562e-03f, 2.742481884e-04f, 5.318295734e-05f, 1.031338525e-05f};
          float inv = invf[0];
#pragma unroll
          for (int q = 1; q < 8; ++q) inv = (j == q) ? invf[q] : inv;
          const float ang = (float)F.pos[n] * inv;
          const double kq = __builtin_rint((double)ang * 0.15915494309189535);
          double r = (double)ang - kq * 6.283185307179586; double csign = 1.0;
          if (r > 1.5707963267948966) { r = 3.141592653589793 - r; csign = -1.0; } else if (r < -1.5707963267948966) { r = -3.141592653589793 - r; csign = -1.0; }
          const double x2 = r * r;
          const double sn = r * (1.0 + x2 * (-1.0 / 6 + x2 * (1.0 / 120 + x2 * (-1.0 / 5040 + x2 * (1.0 / 362880 + x2 * (-1.0 / 39916800 + x2 * (1.0 / 6227020800.0 + x2 * (-1.0 / 1307674368000.0))))))));
          const double cs = 1.0 + x2 * (-0.5 + x2 * (1.0 / 24 + x2 * (-1.0 / 720 + x2 * (1.0 / 40320 + x2 * (-1.0 / 3628800 + x2 * (1.0 / 479001600.0 + x2 * (-1.0 / 87178291200.0 + x2 * (1.0 / 20922789888000.0))))))));
          RT[n * 16 + j] = (float)(csign * cs); RT[n * 16 + 8 + j] = (float)sn; } }
    GAS bf16* HB = (GAS bf16*)(F.ws + WS_HB);
    for (int m = gw; m < NTOK; m += NGW) { f32x4 v[4];
#pragma unroll
        for (int j = 0; j < 4; ++j) v[j] = *(const GAS f32x4*)(((const GAS float*)F.in[0]) + (size_t)m * DM + 4 * F.lane + 256 * j);
        ln_row_regs(v, ((const GAS float*)F.in[2]), ((const GAS float*)F.in[3]), F.lane);
        store_row_f32_bf16(v, (GAS float*)nullptr, HB + (size_t)m * DM, F.lane); }
}

struct DenseSched {
    int nM, nN, nwg, G, c; const char* A; const char* B; size_t atile, btile; int nsub = 1; size_t asub = 0, bsub = 0;
    __device__ void init(int nM_, int nN_, int G_, int c_, const void* A_, size_t atile_, const void* B_, size_t btile_) { nM = nM_; nN = nN_; nwg = nM * nN; G = G_; c = c_; A = (const char*)A_; B = (const char*)B_; atile = atile_; btile = btile_; }
    __device__ __forceinline__ bool next(int i, pg8::Unit& u) const {
        const int it = i / nsub, sb = i - it * nsub;
        const long L = (long)it * G + c; if (L >= nwg) return false;
        int wgid = (int)L; { const int q = nwg / 8, r = nwg % 8, xcd = wgid % 8, off = wgid / 8; wgid = (xcd < r ? xcd * (q + 1) : r * (q + 1) + (xcd - r) * q) + off; }
        const int nig = 8 * nN, gid = wgid / nig, fm = gid * 8, gsz = (nM - fm) < 8 ? (nM - fm) : 8;
        u.pm = fm + ((wgid % nig) % gsz); u.pn = (wgid % nig) / gsz; u.e = sb; u.slot = i; return true;
    }
    __device__ __forceinline__ const char* a_base(const pg8::Unit& u) const { return A + (size_t)u.pm * atile + (size_t)u.e * asub; }
    __device__ __forceinline__ const char* b_base(const pg8::Unit& u) const { return B + (size_t)u.pn * btile + (size_t)u.e * bsub; }
    __device__ __forceinline__ int row_of(const pg8::Unit&, int) const { return 0; }
};
struct GroupSched {
    int NU, G, c, ncol; const char* A; const char* B; size_t atile, erows_bytes, btile; const LAS int* meta; const LAS int* rows;
    __device__ __forceinline__ bool next(int i, pg8::Unit& u) const {
        const int L = i * G + c; if (L >= NU) return false;
        u.pm = L / ncol; u.pn = L % ncol; u.slot = i; u.e = meta[i]; return true;
    }
    __device__ __forceinline__ const char* a_base(const pg8::Unit& u) const { return A + (size_t)u.pm * atile; }
    __device__ __forceinline__ const char* b_base(const pg8::Unit& u) const { return B + (size_t)u.e * erows_bytes + (size_t)u.pn * btile; }
    __device__ __forceinline__ int row_of(const pg8::Unit& u, int r) const { return rows[u.slot * 256 + r]; }
};

struct EpiA {
    static constexpr bool PERM = true;
    GAS bf16* PA; GAS bf16* KA; GAS bf16* VA; GAS bf16* KI; GAS float* WI; GAS float* GLR; const GAS float* ROPE; const GAS float* ikg;
    __device__ __forceinline__ static void rope8(float (&x)[8], const GAS float* rt, int fq, int lane) {
        const f32x4 c0 = *(const GAS f32x4*)(rt), c1 = *(const GAS f32x4*)(rt + 4), s0 = *(const GAS f32x4*)(rt + 8), s1 = *(const GAS f32x4*)(rt + 12);
#pragma unroll
        for (int i = 0; i < 8; ++i) { const float p = shx(x[i], 16, lane); const float cc = (i < 4) ? c0[i & 3] : c1[i & 3], ss = (i < 4) ? s0[i & 3] : s1[i & 3];
            const float r = x[i] * cc + ((fq == 0) ? -p : p) * ss; x[i] = (fq < 2) ? r : x[i]; }
    }
    __device__ __forceinline__ static u32x4 pack8(const float (&x)[8]) { u32x4 w; w.x = cvt_pk_bf16(x[0], x[1]); w.y = cvt_pk_bf16(x[2], x[3]); w.z = cvt_pk_bf16(x[4], x[5]); w.w = cvt_pk_bf16(x[6], x[7]); return w; }
    __device__ __forceinline__ void operator()(const f32x4 (&acc)[2][2][4][2], const pg8::Unit& u, int wr, int wc, int fr, int fq) const {
        const int pn = u.pn; const int rowb = u.pm * 256 + wr * 64 + fr; const int lane = fq * 16 + fr;
        if (pn == 2) {
#pragma unroll
            for (int ai = 0; ai < 2; ++ai)
#pragma unroll
                for (int m = 0; m < 4; ++m) {
                    const int row = rowb + ai * 128 + m * 16;
                    float x0[8], x1[8];
#pragma unroll
                    for (int i = 0; i < 8; ++i) { x0[i] = acc[ai][0][m][i >> 2][i & 3]; x1[i] = acc[ai][1][m][i >> 2][i & 3]; }
                    if (wc == 2) {
                        float s = 0.f;
#pragma unroll
                        for (int i = 0; i < 8; ++i) s += x0[i] + x1[i];
                        s += shx(s, 16, lane); s += shx(s, 32, lane);
                        const float mean = s * (1.f / 64.f); float q = 0.f;
#pragma unroll
                        for (int i = 0; i < 8; ++i) { x0[i] -= mean; x1[i] -= mean; q += x0[i] * x0[i] + x1[i] * x1[i]; }
                        q += shx(q, 16, lane); q += shx(q, 32, lane);
                        const float rstd = 1.f / sqrtf(q * (1.f / 64.f) + LN_EPS);
#pragma unroll
                        for (int i = 0; i < 8; ++i) { x0[i] = x0[i] * rstd * ikg[8 * fq + i]; x1[i] = x1[i] * rstd * ikg[32 + 8 * fq + i]; }
                    }
                    if (wc == 0 || wc == 2) rope8(x0, ROPE + (size_t)row * 16, fq, lane);
                    if (wc < 3) {
                        GAS bf16* dst = (wc == 0) ? KA : (wc == 1) ? VA : KI;
                        *(GAS u32x4*)(dst + (size_t)row * 64 + 8 * fq) = pack8(x0); *(GAS u32x4*)(dst + (size_t)row * 64 + 32 + 8 * fq) = pack8(x1);
                    } else {
                        if (fq == 0) { *(GAS f32x4*)(WI + (size_t)row * 4) = (f32x4){x0[0], x0[1], x0[2], x0[3]} * 0.0625f; *(GAS f32x4*)(GLR + (size_t)row * 16) = (f32x4){x0[4], x0[5], x0[6], x0[7]}; }
                        else if (fq == 1) { *(GAS f32x4*)(GLR + (size_t)row * 16 + 4) = (f32x4){x0[0], x0[1], x0[2], x0[3]}; *(GAS f32x4*)(GLR + (size_t)row * 16 + 8) = (f32x4){x0[4], x0[5], x0[6], x0[7]}; }
                        else if (fq == 2) { *(GAS f32x4*)(GLR + (size_t)row * 16 + 12) = (f32x4){x0[0], x0[1], x0[2], x0[3]}; }
                    }
                    asm volatile("" ::: "memory");
                }
        } else if (pn < 2 || pn == 3) {
            const float sc = (pn == 3) ? 1.0f : 0.125f; const bool rope = !(wc & 1);
#pragma unroll
            for (int ai = 0; ai < 2; ++ai)
#pragma unroll
                for (int m = 0; m < 4; ++m) {
                    const int row = rowb + ai * 128 + m * 16;
#pragma unroll
                    for (int bj = 0; bj < 2; ++bj) { float x[8];
#pragma unroll
                        for (int i = 0; i < 8; ++i) x[i] = acc[ai][bj][m][i >> 2][i & 3];
                        if (rope) rope8(x, ROPE + (size_t)row * 16, fq, lane);
#pragma unroll
                        for (int i = 0; i < 8; ++i) x[i] *= sc;
                        *(GAS u32x4*)(PA + (size_t)row * NPA + 256 * pn + 128 * bj + 32 * wc + 8 * fq) = pack8(x); }
                    asm volatile("" ::: "memory");
                }
        } else {
            const int act = (pn == 8 || pn == 9) ? 1 : (pn >= 10) ? 2 : 0; const float sc = (pn == 4) ? 0.125f : 1.0f;
#pragma unroll
            for (int ai = 0; ai < 2; ++ai)
#pragma unroll
                for (int m = 0; m < 4; ++m) {
                    const int row = rowb + ai * 128 + m * 16;
#pragma unroll
                    for (int bj = 0; bj < 2; ++bj) { float x[8];
#pragma unroll
                        for (int i = 0; i < 8; ++i) { const float v = acc[ai][bj][m][i >> 2][i & 3]; x[i] = (act == 1) ? siluf_(v) : (act == 2) ? gelu_tanh_(v) : v * sc; }
                        *(GAS u32x4*)(PA + (size_t)row * NPA + 256 * pn + 128 * bj + 32 * wc + 8 * fq) = pack8(x); }
                    asm volatile("" ::: "memory");
                }
        }
    }
};
struct EpiP {
    static constexpr bool PERM = true;
    GAS bf16* P;
    __device__ __forceinline__ void operator()(const f32x4 (&acc)[2][2][4][2], const pg8::Unit& u, int wr, int wc, int fr, int fq) const {
        const int rowb = u.pm * 256 + wr * 64 + fr; GAS bf16* Pb = P + (size_t)u.e * NTOK * DM;
#pragma unroll
        for (int ai = 0; ai < 2; ++ai)
#pragma unroll
            for (int m = 0; m < 4; ++m) { const int row = rowb + ai * 128 + m * 16;
#pragma unroll
                for (int bj = 0; bj < 2; ++bj) { u32x4 w; w.x = cvt_pk_bf16(acc[ai][bj][m][0][0], acc[ai][bj][m][0][1]); w.y = cvt_pk_bf16(acc[ai][bj][m][0][2], acc[ai][bj][m][0][3]);
                    w.z = cvt_pk_bf16(acc[ai][bj][m][1][0], acc[ai][bj][m][1][1]); w.w = cvt_pk_bf16(acc[ai][bj][m][1][2], acc[ai][bj][m][1][3]);
                    *(GAS u32x4*)(Pb + (size_t)row * DM + 256 * u.pn + 128 * bj + 32 * wc + 8 * fq) = w; } }
    }
};
struct EpiGM {
    static constexpr bool PERM = true;
    const GAS bf16* P; GAS bf16* HM;
    __device__ __forceinline__ void operator()(const f32x4 (&acc)[2][2][4][2], const pg8::Unit& u, int wr, int wc, int fr, int fq) const {
        const int rowb = u.pm * 256 + wr * 64 + fr; const int br = u.e; const GAS bf16* Pb = P + (size_t)br * NTOK * DM;
        const int colb = 256 * u.pn + 32 * wc + 8 * fq;
#pragma unroll
        for (int ai = 0; ai < 2; ++ai) {
            u32x4 pv[4][2], ov[4][2];
#pragma unroll
            for (int m = 0; m < 4; ++m)
#pragma unroll
                for (int bj = 0; bj < 2; ++bj) { const size_t off = (size_t)(rowb + ai * 128 + m * 16) * DM + colb + 128 * bj;
                    pv[m][bj] = *(const GAS u32x4*)(Pb + off); ov[m][bj] = (br > 0) ? *(const GAS u32x4*)(HM + off) : (u32x4){0u, 0u, 0u, 0u}; }
            __builtin_amdgcn_sched_barrier(0);
#pragma unroll
            for (int m = 0; m < 4; ++m)
#pragma unroll
                for (int bj = 0; bj < 2; ++bj) { const size_t off = (size_t)(rowb + ai * 128 + m * 16) * DM + colb + 128 * bj;
                    const u32x4 p = pv[m][bj], o = ov[m][bj];
                    float x[8];
                    x[0] = bflo(p.x) * sigmoidf_(acc[ai][bj][m][0][0]) + bflo(o.x); x[1] = bfhi(p.x) * sigmoidf_(acc[ai][bj][m][0][1]) + bfhi(o.x); x[2] = bflo(p.y) * sigmoidf_(acc[ai][bj][m][0][2]) + bflo(o.y); x[3] = bfhi(p.y) * sigmoidf_(acc[ai][bj][m][0][3]) + bfhi(o.y);
                    x[4] = bflo(p.z) * sigmoidf_(acc[ai][bj][m][1][0]) + bflo(o.z); x[5] = bfhi(p.z) * sigmoidf_(acc[ai][bj][m][1][1]) + bfhi(o.z); x[6] = bflo(p.w) * sigmoidf_(acc[ai][bj][m][1][2]) + bflo(o.w); x[7] = bfhi(p.w) * sigmoidf_(acc[ai][bj][m][1][3]) + bfhi(o.w);
                    u32x4 w; w.x = cvt_pk_bf16(x[0], x[1]); w.y = cvt_pk_bf16(x[2], x[3]); w.z = cvt_pk_bf16(x[4], x[5]); w.w = cvt_pk_bf16(x[6], x[7]);
                    *(GAS u32x4*)(HM + off) = w; }
            asm volatile("" ::: "memory");
        }
    }
};
struct EpiO {
    static constexpr bool PERM = true;
    const GAS bf16* HBr; GAS bf16* T;
    __device__ __forceinline__ void operator()(const f32x4 (&acc)[2][2][4][2], const pg8::Unit& u, int wr, int wc, int fr, int fq) const {
        const int rowb = u.pm * 256 + wr * 64 + fr; const int colb = 256 * u.pn + 32 * wc + 8 * fq;
#pragma unroll
        for (int ai = 0; ai < 2; ++ai) {
            u32x4 hv[4][2];
#pragma unroll
            for (int m = 0; m < 4; ++m)
#pragma unroll
                for (int bj = 0; bj < 2; ++bj) hv[m][bj] = *(const GAS u32x4*)(HBr + (size_t)(rowb + ai * 128 + m * 16) * DM + colb + 128 * bj);
            __builtin_amdgcn_sched_barrier(0);
#pragma unroll
            for (int m = 0; m < 4; ++m)
#pragma unroll
                for (int bj = 0; bj < 2; ++bj) { const u32x4 h = hv[m][bj];
                    u32x4 w; w.x = cvt_pk_bf16(bflo(h.x) * DN_ALPHA + acc[ai][bj][m][0][0], bfhi(h.x) * DN_ALPHA + acc[ai][bj][m][0][1]); w.y = cvt_pk_bf16(bflo(h.y) * DN_ALPHA + acc[ai][bj][m][0][2], bfhi(h.y) * DN_ALPHA + acc[ai][bj][m][0][3]);
                    w.z = cvt_pk_bf16(bflo(h.z) * DN_ALPHA + acc[ai][bj][m][1][0], bfhi(h.z) * DN_ALPHA + acc[ai][bj][m][1][1]); w.w = cvt_pk_bf16(bflo(h.w) * DN_ALPHA + acc[ai][bj][m][1][2], bfhi(h.w) * DN_ALPHA + acc[ai][bj][m][1][3]);
                    *(GAS u32x4*)(T + (size_t)(rowb + ai * 128 + m * 16) * DM + colb + 128 * bj) = w; }
            asm volatile("" ::: "memory");
        }
    }
};
struct EpiGU {
    static constexpr bool PERM = true;
    GAS bf16* HID; const GAS float* CW;
    __device__ __forceinline__ void operator()(const f32x4 (&acc)[2][2][4][2], const pg8::Unit& u, int wr, int wc, int fr, int fq) const {
        const int rowb = u.pm * 256 + wr * 64 + fr;
        float cwv[2][4];
#pragma unroll
        for (int ai = 0; ai < 2; ++ai)
#pragma unroll
            for (int m = 0; m < 4; ++m) cwv[ai][m] = CW[rowb + ai * 128 + m * 16];
#pragma unroll
        for (int ai = 0; ai < 2; ++ai)
#pragma unroll
            for (int m = 0; m < 4; ++m) { const int row = rowb + ai * 128 + m * 16; const float cw = cwv[ai][m];
                float x[8];
#pragma unroll
                for (int i = 0; i < 8; ++i) x[i] = siluf_(acc[ai][0][m][i >> 2][i & 3]) * acc[ai][1][m][i >> 2][i & 3] * cw;
                u32x4 w; w.x = cvt_pk_bf16(x[0], x[1]); w.y = cvt_pk_bf16(x[2], x[3]); w.z = cvt_pk_bf16(x[4], x[5]); w.w = cvt_pk_bf16(x[6], x[7]);
                *(GAS u32x4*)(HID + (size_t)row * DEXP + 128 * u.pn + 32 * wc + 8 * fq) = w; }
    }
};
struct EpiDN {
    static constexpr bool PERM = true;
    GAS bf16* FF2;
    __device__ __forceinline__ void operator()(const f32x4 (&acc)[2][2][4][2], const pg8::Unit& u, int wr, int wc, int fr, int fq) const {
        const int rowb = u.pm * 256 + wr * 64 + fr;
#pragma unroll
        for (int ai = 0; ai < 2; ++ai)
#pragma unroll
            for (int m = 0; m < 4; ++m) { const int row = rowb + ai * 128 + m * 16;
#pragma unroll
                for (int bj = 0; bj < 2; ++bj) { u32x4 w; w.x = cvt_pk_bf16(acc[ai][bj][m][0][0], acc[ai][bj][m][0][1]); w.y = cvt_pk_bf16(acc[ai][bj][m][0][2], acc[ai][bj][m][0][3]);
                    w.z = cvt_pk_bf16(acc[ai][bj][m][1][0], acc[ai][bj][m][1][1]); w.w = cvt_pk_bf16(acc[ai][bj][m][1][2], acc[ai][bj][m][1][3]);
                    *(GAS u32x4*)(FF2 + (size_t)row * DM + 256 * u.pn + 128 * bj + 32 * wc + 8 * fq) = w; } }
    }
};
#ifndef EN_B1
#define EN_B1 1
#endif
#ifndef EN_B2
#define EN_B2 1
#endif
#ifndef EN_B3
#define EN_B3 1
#endif

template <int CTRL> __device__ __forceinline__ float dppf(float x) { return __builtin_bit_cast(float, __builtin_amdgcn_mov_dpp(__builtin_bit_cast(int, x), CTRL, 0xf, 0xf, true)); }
template <int CTRL> __device__ __forceinline__ int dppi(int x) { return __builtin_amdgcn_mov_dpp(x, CTRL, 0xf, 0xf, true); }
typedef short v4i16_t __attribute__((ext_vector_type(4)));
typedef unsigned short u16x2 __attribute__((ext_vector_type(2)));
__device__ __forceinline__ v4i16_t ldtr(const LAS unsigned char* p) { return __builtin_amdgcn_ds_read_tr16_b64_v4i16((LAS v4i16_t*)p); }
__device__ __forceinline__ bf16x8 cat8(v4i16_t lo, v4i16_t hi) { bf16x8 r; r[0] = lo[0]; r[1] = lo[1]; r[2] = lo[2]; r[3] = lo[3]; r[4] = hi[0]; r[5] = hi[1]; r[6] = hi[2]; r[7] = hi[3]; return r; }
__device__ __forceinline__ int wave_total_i(int v) {
    v += dppi<0xB1>(v); v += dppi<0x4E>(v); v += dppi<0x141>(v); v += dppi<0x140>(v);
    return __builtin_amdgcn_readlane(v, 0) + __builtin_amdgcn_readlane(v, 16) + __builtin_amdgcn_readlane(v, 32) + __builtin_amdgcn_readlane(v, 48);
}
__device__ __forceinline__ void gmlp_unit(Frame& F, int l, int unit) {
    int tid = F.tid; asm volatile("" : "+v"(tid)); const int lane = tid & 63;
    const int chunk = unit >> 2, g = unit & 3, n0 = chunk * 128;
    const GAS bf16* PA = (const GAS bf16*)(F.ws + WS_PA); GAS bf16* Y = (GAS bf16*)(F.ws + WS_Y);
    LAS float* vln = (LAS float*)F.lds;
    LAS float* wl = (LAS float*)(F.lds + 65536);
    LAS float* st = (LAS float*)(F.lds + AUX_OFF);
    const GAS float* lng = ((const GAS float*)F.in[9]) + l * 512; const GAS float* lnb = ((const GAS float*)F.in[10]) + l * 512;
    for (int j = 0; j < 16; ++j) { const int s = F.wave * 16 + j;
        const u32x4 w = *(const GAS u32x4*)(PA + (size_t)(n0 + s) * NPA + PA_CV + 8 * lane);
        float x[8] = {bflo(w.x), bfhi(w.x), bflo(w.y), bfhi(w.y), bflo(w.z), bfhi(w.z), bflo(w.w), bfhi(w.w)};
        float sm = 0.f;
#pragma unroll
        for (int i = 0; i < 8; ++i) sm += x[i];
        const float mean = wave_sum(sm, lane) * (1.f / 512.f); float q = 0.f;
#pragma unroll
        for (int i = 0; i < 8; ++i) { const float d = x[i] - mean; q += d * d; }
        const float rstd = 1.f / sqrtf(wave_sum(q, lane) * (1.f / 512.f) + LN_EPS);
        if (lane == 0) { st[2 * s] = mean; st[2 * s + 1] = rstd; } }
    __syncthreads();
#pragma unroll
    for (int i = 0; i < 4; ++i) { const int q = tid + 512 * i, s = q >> 4, d0 = (q & 15) * 8;
        const u32x4 w = *(const GAS u32x4*)(PA + (size_t)(n0 + s) * NPA + PA_CV + g * 128 + d0);
        const float mean = st[2 * s], rstd = st[2 * s + 1];
        float x[8] = {bflo(w.x), bfhi(w.x), bflo(w.y), bfhi(w.y), bflo(w.z), bfhi(w.z), bflo(w.w), bfhi(w.w)};
#pragma unroll
        for (int k = 0; k < 8; ++k) x[k] = (x[k] - mean) * rstd * lng[g * 128 + d0 + k] + lnb[g * 128 + d0 + k];
        *(LAS f32x4*)(vln + s * 128 + d0) = (f32x4){x[0], x[1], x[2], x[3]}; *(LAS f32x4*)(vln + s * 128 + d0 + 4) = (f32x4){x[4], x[5], x[6], x[7]}; }
    const GAS float* ws = ((const GAS float*)F.in[11]) + ((size_t)l * 4 + g) * 128 * 128;
#pragma unroll
    for (int i = 0; i < 8; ++i) { const int q = tid + 512 * i, t = q >> 5, s0 = (q & 31) * 4;
        f32x4 w = *(const GAS f32x4*)(ws + t * 128 + s0);
        if (s0 + 0 > t) w.x = 0.f; if (s0 + 1 > t) w.y = 0.f; if (s0 + 2 > t) w.z = 0.f; if (s0 + 3 > t) w.w = 0.f;
        *(LAS f32x4*)(wl + t * 128 + s0) = w; }
    __syncthreads();
    const int d = tid & 127, tq = __builtin_amdgcn_readfirstlane(tid >> 7);
    float vr[128];
#pragma unroll
    for (int sb = 0; sb < 4; ++sb)
        if (sb <= tq) {
#pragma unroll
            for (int s = 0; s < 32; ++s) vr[sb * 32 + s] = vln[(sb * 32 + s) * 128 + d];
        } else {
#pragma unroll
            for (int s = 0; s < 32; ++s) vr[sb * 32 + s] = 0.f;
        }
    const GAS float* bs = ((const GAS float*)F.in[12]) + ((size_t)l * 4 + g) * 128;
#pragma unroll 1
    for (int ti = 0; ti < 32; ++ti) { const int t = tq * 32 + ti; float a = 0.f;
#pragma unroll
        for (int sb = 0; sb < 4; ++sb)
            if (sb <= tq) {
#pragma unroll
                for (int s4 = 0; s4 < 8; ++s4) { const f32x4 w = *(const LAS f32x4*)(wl + t * 128 + sb * 32 + s4 * 4);
                    a += w.x * vr[sb * 32 + s4 * 4] + w.y * vr[sb * 32 + s4 * 4 + 1] + w.z * vr[sb * 32 + s4 * 4 + 2] + w.w * vr[sb * 32 + s4 * 4 + 3]; }
            }
        const float uu = bf1(PA[(size_t)(n0 + t) * NPA + PA_CU + g * 128 + d]);
        Y[(size_t)(n0 + t) * 1536 + 1024 + g * 128 + d] = (bf16)f2bf(uu * (a + bs[t])); }
    __syncthreads();
}

__device__ __forceinline__ void gmlp16_unit(Frame& F, int l, int chunk) {
    const int lane = fresh_lane(), w = F.wave, tid = w * 64 + lane, fr = lane & 15, fq = lane >> 4;
    const size_t n0 = (size_t)chunk * 128;
    const GAS bf16* PA = (const GAS bf16*)(F.ws + WS_PA); GAS bf16* Y = (GAS bf16*)(F.ws + WS_Y);
    LAS unsigned char* VT = F.lds;
    LAS unsigned char* WT = F.lds + 32768;
    LAS float* st = (LAS float*)(F.lds + AUX_OFF);
    const GAS float* lng = ((const GAS float*)F.in[9]) + l * 512; const GAS float* lnb = ((const GAS float*)F.in[10]) + l * 512;
    for (int j = 0; j < 16; ++j) { const int s = w * 16 + j;
        const u32x4 x4 = *(const GAS u32x4*)(PA + (n0 + s) * NPA + PA_CV + 8 * lane);
        float x[8] = {bflo(x4.x), bfhi(x4.x), bflo(x4.y), bfhi(x4.y), bflo(x4.z), bfhi(x4.z), bflo(x4.w), bfhi(x4.w)};
        float sm = 0.f;
#pragma unroll
        for (int i = 0; i < 8; ++i) sm += x[i];
        const float mean = wave_sum(sm, lane) * (1.f / 512.f); float q = 0.f;
#pragma unroll
        for (int i = 0; i < 8; ++i) { const float d = x[i] - mean; q += d * d; }
        const float rstd = 1.f / sqrtf(wave_sum(q, lane) * (1.f / 512.f) + LN_EPS);
        if (lane == 0) { st[2 * s] = mean; st[2 * s + 1] = rstd; } }
    __syncthreads();
#pragma unroll 1
    for (int g = 0; g < 4; ++g) {
        const GAS float* ws = ((const GAS float*)F.in[11]) + ((size_t)l * 4 + g) * 128 * 128;
#pragma unroll
        for (int i = 0; i < 4; ++i) { const int q = tid + 512 * i, s = q >> 4, d0 = (q & 15) * 8;
            const u32x4 x4 = *(const GAS u32x4*)(PA + (n0 + s) * NPA + PA_CV + g * 128 + d0);
            const float mean = st[2 * s], rstd = st[2 * s + 1];
            float x[8] = {bflo(x4.x), bfhi(x4.x), bflo(x4.y), bfhi(x4.y), bflo(x4.z), bfhi(x4.z), bflo(x4.w), bfhi(x4.w)};
            const f32x4 g0 = *(const GAS f32x4*)(lng + g * 128 + d0), g1 = *(const GAS f32x4*)(lng + g * 128 + d0 + 4), b0 = *(const GAS f32x4*)(lnb + g * 128 + d0), b1 = *(const GAS f32x4*)(lnb + g * 128 + d0 + 4);
#pragma unroll
            for (int k = 0; k < 8; ++k) x[k] = (x[k] - mean) * rstd * ((k < 4) ? g0[k & 3] : g1[k & 3]) + ((k < 4) ? b0[k & 3] : b1[k & 3]);
            u32x4 o; o.x = cvt_pk_bf16(x[0], x[1]); o.y = cvt_pk_bf16(x[2], x[3]); o.z = cvt_pk_bf16(x[4], x[5]); o.w = cvt_pk_bf16(x[6], x[7]);
            *(LAS u32x4*)(VT + s * 256 + d0 * 2) = o;
            const int t = s, s0 = d0;
            f32x4 w0 = *(const GAS f32x4*)(ws + t * 128 + s0), w1 = *(const GAS f32x4*)(ws + t * 128 + s0 + 4);
            float wv[8] = {w0.x, w0.y, w0.z, w0.w, w1.x, w1.y, w1.z, w1.w};
#pragma unroll
            for (int k = 0; k < 8; ++k) wv[k] = (s0 + k <= t) ? wv[k] : 0.f;
            u32x4 ow; ow.x = cvt_pk_bf16(wv[0], wv[1]); ow.y = cvt_pk_bf16(wv[2], wv[3]); ow.z = cvt_pk_bf16(wv[4], wv[5]); ow.w = cvt_pk_bf16(wv[6], wv[7]);
            *(LAS u32x4*)(WT + t * 256 + s0 * 2) = ow; }
        __syncthreads();
        f32x4 acc[8];
#pragma unroll
        for (int nt = 0; nt < 8; ++nt) acc[nt] = (f32x4){0.f, 0.f, 0.f, 0.f};
        const int nks = (16 * w + 15) / 32 + 1;
#pragma unroll
        for (int ks = 0; ks < 4; ++ks) if (ks < nks) {
            const bf16x8 a = *(const LAS bf16x8*)(WT + (16 * w + fr) * 256 + (8 * fq + 32 * ks) * 2);
            const int srow = 32 * ks + 8 * fq + (fr >> 2);
#pragma unroll
            for (int nt = 0; nt < 8; ++nt) { const bf16x8 bv = cat8(ldtr(VT + srow * 256 + (16 * nt + 4 * (fr & 3)) * 2), ldtr(VT + (srow + 4) * 256 + (16 * nt + 4 * (fr & 3)) * 2));
                acc[nt] = __builtin_amdgcn_mfma_f32_16x16x32_bf16(bv, a, acc[nt], 0, 0, 0); } }
        const GAS float* bs = ((const GAS float*)F.in[12]) + ((size_t)l * 4 + g) * 128;
        { const int t = 16 * w + fr; const float bt = bs[t];
#pragma unroll
          for (int nt = 0; nt < 8; ++nt) { const int d0 = 16 * nt + 4 * fq;
              const u32x2 uu = *(const GAS u32x2*)(PA + (n0 + t) * NPA + PA_CU + g * 128 + d0);
              u32x2 wv; wv.x = pk2(bflo(uu.x) * (acc[nt][0] + bt), bfhi(uu.x) * (acc[nt][1] + bt)); wv.y = pk2(bflo(uu.y) * (acc[nt][2] + bt), bfhi(uu.y) * (acc[nt][3] + bt));
              *(GAS u32x2*)(Y + (n0 + t) * 1536 + 1024 + g * 128 + d0) = wv; } }
        __syncthreads();
    }
}

__device__ __forceinline__ void gla_unit(Frame& F, int l, int unit) {
    int tid = F.tid; asm volatile("" : "+v"(tid));
    const int b = unit >> 2, h = unit & 3;
    const GAS bf16* PA = (const GAS bf16*)(F.ws + WS_PA); GAS bf16* Y = (GAS bf16*)(F.ws + WS_Y); const GAS float* GLR = (const GAS float*)(F.ws + WS_GLR);
    LAS float* wa = (LAS float*)F.lds;
    LAS float* ba = wa + 1024;
    LAS float* as_ = ba + 64;
    LAS float* qs = as_ + 1024;
    LAS float* ks = qs + 1024;
    LAS float* vs = ks + 1024;
    LAS float* part = vs + 2048;
    for (int i = tid; i < 1024; i += 512) wa[i] = ((const GAS float*)F.in[6])[(size_t)l * 16 * 256 + (i >> 6) * 256 + h * 64 + (i & 63)];
    if (tid < 64) ba[tid] = ((const GAS float*)F.in[7])[l * 256 + h * 64 + tid];
    const GAS float* gng = ((const GAS float*)F.in[8]) + l * 128;
    const int v = tid & 127, kq = __builtin_amdgcn_readfirstlane(tid >> 7);
    float S[16];
#pragma unroll
    for (int j = 0; j < 16; ++j) S[j] = 0.f;
    __syncthreads();
    for (int t0 = 0; t0 < SEQ; t0 += 16) {
        const size_t nb = (size_t)b * SEQ + t0;
#pragma unroll
        for (int i = 0; i < 2; ++i) { const int e = tid + 512 * i, t = e >> 6, k = e & 63; float z = ba[k];
#pragma unroll
            for (int r = 0; r < 16; ++r) z += GLR[(nb + t) * 16 + r] * wa[r * 64 + k];
            const float ls = fminf(z, 0.f) - log1pf(__expf(-fabsf(z)));
            as_[e] = __expf(ls * (1.f / 16.f));
            qs[e] = bf1(PA[(nb + t) * NPA + PA_BQ + h * 64 + k]); ks[e] = bf1(PA[(nb + t) * NPA + PA_BK + h * 64 + k]); }
#pragma unroll
        for (int i = 0; i < 4; ++i) { const int e = tid + 512 * i, t = e >> 7, vv = e & 127; vs[e] = bf1(PA[(nb + t) * NPA + PA_BV + h * 128 + vv]); }
        __syncthreads();
#pragma unroll 4
        for (int t = 0; t < 16; ++t) { const float vt = vs[t * 128 + v]; float p = 0.f;
#pragma unroll
            for (int j4 = 0; j4 < 4; ++j4) { const f32x4 a4 = *(const LAS f32x4*)(as_ + t * 64 + kq * 16 + j4 * 4), k4 = *(const LAS f32x4*)(ks + t * 64 + kq * 16 + j4 * 4), q4 = *(const LAS f32x4*)(qs + t * 64 + kq * 16 + j4 * 4);
#pragma unroll
                for (int j = 0; j < 4; ++j) { S[j4 * 4 + j] = a4[j] * S[j4 * 4 + j] + k4[j] * vt; p += q4[j] * S[j4 * 4 + j]; } }
            part[(kq * 16 + t) * 128 + v] = p; }
        __syncthreads();
        { const int t = tid >> 5, v4 = (tid & 31) * 4;
          f32x4 o = *(const LAS f32x4*)(part + (0 * 16 + t) * 128 + v4);
#pragma unroll
          for (int q = 1; q < 4; ++q) o += *(const LAS f32x4*)(part + (q * 16 + t) * 128 + v4);
          float ss = o.x * o.x + o.y * o.y + o.z * o.z + o.w * o.w;
#pragma unroll
          for (int sh = 1; sh < 32; sh <<= 1) ss += shx(ss, sh, tid & 63);
          const float r = 1.f / sqrtf(ss * (1.f / 128.f) + RMS_EPS);
          const f32x4 gg = *(const GAS f32x4*)(gng + v4);
          const u32x2 brw = *(const GAS u32x2*)(PA + (nb + t) * NPA + PA_BR + h * 128 + v4);
          u32x2 w; w.x = pk2(o.x * r * gg.x * bflo(brw.x), o.y * r * gg.y * bfhi(brw.x)); w.y = pk2(o.z * r * gg.z * bflo(brw.y), o.w * r * gg.w * bfhi(brw.y));
          *(GAS u32x2*)(Y + (nb + t) * 1536 + 512 + h * 128 + v4) = w; }
        __syncthreads();
    }
}

constexpr size_t WS_US = WS_WMOE, WS_DEC = WS_WMOE + 32 * MiB;
__device__ __forceinline__ void gla_local_unit(Frame& F, int l, int unit) {
    const int lane = fresh_lane(), w = F.wave, tid = w * 64 + lane, fr = lane & 15, fq = lane >> 4;
    const int b = unit >> 8, h = (unit >> 6) & 3, c = unit & 63; const size_t n0 = (size_t)b * SEQ + 64 * c;
    GAS bf16* PA = (GAS bf16*)(F.ws + WS_PA); GAS bf16* Y = (GAS bf16*)(F.ws + WS_Y); const GAS float* GLR = (const GAS float*)(F.ws + WS_GLR);
    GAS bf16* US = (GAS bf16*)(F.ws + WS_US) + (size_t)unit * 8192; GAS float* DEC = (GAS float*)(F.ws + WS_DEC) + unit * 64;
    LAS unsigned char* QT = F.lds; LAS unsigned char* KT = F.lds + 8192; LAS unsigned char* KD = F.lds + 16384; LAS unsigned char* VV = F.lds + 24576; LAS unsigned char* ATT = F.lds + 40960;
    LAS float* SEG = (LAS float*)(F.lds + 65536); LAS float* WA = (LAS float*)(F.lds + 67584); LAS float* BA = (LAS float*)(F.lds + 71680); LAS float* GL = (LAS float*)(F.lds + 71936);
    const int k = tid & 63, seg = w;
    float qv8[8], kv8[8];
#pragma unroll
    for (int i = 0; i < 8; ++i) { const int t = 8 * seg + i; qv8[i] = bf1(PA[(n0 + t) * NPA + PA_BQ + h * 64 + k]); kv8[i] = bf1(PA[(n0 + t) * NPA + PA_BK + h * 64 + k]); }
    if (tid < 256) *(LAS f32x4*)(GL + 4 * tid) = *(const GAS f32x4*)(GLR + n0 * 16 + 4 * tid);
#pragma unroll
    for (int i = 0; i < 2; ++i) { const int e = tid + 512 * i; WA[e] = ((const GAS float*)F.in[6])[(size_t)l * 16 * 256 + (e >> 6) * 256 + h * 64 + (e & 63)]; }
    if (tid < 64) BA[tid] = ((const GAS float*)F.in[7])[l * 256 + h * 64 + tid];
#pragma unroll
    for (int i = 0; i < 2; ++i) { const int piece = tid + 512 * i, row = piece >> 4, c16 = piece & 15;
        *(LAS u32x4*)(VV + row * 256 + c16 * 16) = *(const GAS u32x4*)(PA + (n0 + row) * NPA + PA_BV + h * 128 + 8 * c16); }
    __syncthreads();
    float cum[8];
    { float run = 0.f;
#pragma unroll
      for (int i = 0; i < 8; ++i) { const int t = 8 * seg + i; float z = BA[k];
          const f32x4 g0 = *(const LAS f32x4*)(GL + t * 16), g1 = *(const LAS f32x4*)(GL + t * 16 + 4), g2 = *(const LAS f32x4*)(GL + t * 16 + 8), g3 = *(const LAS f32x4*)(GL + t * 16 + 12);
#pragma unroll
          for (int r = 0; r < 4; ++r) { z += g0[r] * WA[r * 64 + k]; z += g1[r] * WA[(4 + r) * 64 + k]; z += g2[r] * WA[(8 + r) * 64 + k]; z += g3[r] * WA[(12 + r) * 64 + k]; }
          const float ls = fminf(z, 0.f) - log1pf(__expf(-fabsf(z)));
          run += ls * (1.f / 16.f); cum[i] = run; }
      SEG[seg * 64 + k] = run; }
    __syncthreads();
    { float off = 0.f, blast = 0.f;
#pragma unroll
      for (int s2 = 0; s2 < 8; ++s2) { const float sv = SEG[s2 * 64 + k]; blast += sv; off += (s2 < seg) ? sv : 0.f; }
#pragma unroll
      for (int i = 0; i < 8; ++i) { const int t = 8 * seg + i; const float bb = cum[i] + off;
          const float qv = qv8[i], kv = kv8[i];
          const unsigned qt = f2bf(qv * __expf(bb));
          ((LAS unsigned short*)QT)[t * 64 + k] = (unsigned short)qt; ((LAS unsigned short*)KT)[t * 64 + k] = (unsigned short)f2bf(kv * __expf(-bb)); ((LAS unsigned short*)KD)[t * 64 + k] = (unsigned short)f2bf(kv * __expf(blast - bb));
          PA[(n0 + t) * NPA + PA_BQ + h * 64 + k] = (bf16)qt; }
      if (seg == 0) DEC[k] = __expf(blast); }
    __syncthreads();
#pragma unroll
    for (int ii = 0; ii < 2; ++ii) { const int id = 2 * w + ii, ts = id >> 2, tt = id & 3;
        f32x4 d = {0.f, 0.f, 0.f, 0.f};
        if (ts <= tt) {
#pragma unroll
            for (int ks = 0; ks < 2; ++ks) { const bf16x8 a = *(const LAS bf16x8*)(KT + (16 * ts + fr) * 128 + (8 * fq + 32 * ks) * 2), bq = *(const LAS bf16x8*)(QT + (16 * tt + fr) * 128 + (8 * fq + 32 * ks) * 2);
                d = __builtin_amdgcn_mfma_f32_16x16x32_bf16(a, bq, d, 0, 0, 0); } }
        const int t = 16 * tt + fr, s0 = 16 * ts + 4 * fq;
        u32x2 pk; pk.x = cvt_pk_bf16((s0 <= t) ? d[0] : 0.f, (s0 + 1 <= t) ? d[1] : 0.f); pk.y = cvt_pk_bf16((s0 + 2 <= t) ? d[2] : 0.f, (s0 + 3 <= t) ? d[3] : 0.f);
        *(LAS u32x2*)(ATT + t * 128 + s0 * 2) = pk; }
    __syncthreads();
    { const int tr = w & 3, nh = w >> 2;
      f32x4 ao[4], au[4];
#pragma unroll
      for (int j = 0; j < 4; ++j) { ao[j] = (f32x4){0.f, 0.f, 0.f, 0.f}; au[j] = (f32x4){0.f, 0.f, 0.f, 0.f}; }
#pragma unroll
      for (int ks = 0; ks < 2; ++ks) {
          const bf16x8 aA = *(const LAS bf16x8*)(ATT + (16 * tr + fr) * 128 + (8 * fq + 32 * ks) * 2);
          const int srow = 32 * ks + 8 * fq + (fr >> 2);
          const bf16x8 aK = cat8(ldtr(KD + srow * 128 + (16 * tr + 4 * (fr & 3)) * 2), ldtr(KD + (srow + 4) * 128 + (16 * tr + 4 * (fr & 3)) * 2));
#pragma unroll
          for (int j = 0; j < 4; ++j) { const int nt = 4 * nh + j;
              const bf16x8 bv = cat8(ldtr(VV + srow * 256 + (16 * nt + 4 * (fr & 3)) * 2), ldtr(VV + (srow + 4) * 256 + (16 * nt + 4 * (fr & 3)) * 2));
              ao[j] = __builtin_amdgcn_mfma_f32_16x16x32_bf16(bv, aA, ao[j], 0, 0, 0);
              au[j] = __builtin_amdgcn_mfma_f32_16x16x32_bf16(bv, aK, au[j], 0, 0, 0); } }
#pragma unroll
      for (int j = 0; j < 4; ++j) { const int v0 = 16 * (4 * nh + j) + 4 * fq, row = 16 * tr + fr;
          u32x2 wo; wo.x = pk2(ao[j][0], ao[j][1]); wo.y = pk2(ao[j][2], ao[j][3]); *(GAS u32x2*)(Y + (n0 + row) * 1536 + 512 + h * 128 + v0) = wo;
          u32x2 wu; wu.x = pk2(au[j][0], au[j][1]); wu.y = pk2(au[j][2], au[j][3]); *(GAS u32x2*)(US + row * 128 + v0) = wu; } }
    __syncthreads();
}
__device__ __forceinline__ void gla_scan_phase(Frame& F) {
    GAS bf16* USb = (GAS bf16*)(F.ws + WS_US); const GAS float* DECb = (const GAS float*)(F.ws + WS_DEC);
    for (int gt = F.wg * 512 + F.tid; gt < 131072; gt += F.G * 512) { const int e0 = 2 * gt, bh = e0 >> 13, kv = e0 & 8191, k = kv >> 7;
        GAS unsigned* p = (GAS unsigned*)(USb + (size_t)bh * 64 * 8192 + kv); const GAS float* dp = DECb + bh * 64 * 64 + k;
        float s0 = 0.f, s1 = 0.f;
#pragma unroll 8
        for (int c = 0; c < 64; ++c) { const unsigned u = p[(size_t)c * 4096]; const float d = dp[c * 64];
            p[(size_t)c * 4096] = pk2(s0, s1);
            s0 = d * s0 + bflo(u); s1 = d * s1 + bfhi(u); } }
}
struct GlaOutRegs { u32x4 us[2]; bf16x8 aq[2]; u32x2 oi[4]; u32x2 br[4]; };
__device__ __forceinline__ void gla_out_load(Frame& F, int unit, int tid, int w, int fr, int fq, GlaOutRegs& R) {
    const int b = unit >> 8, h = (unit >> 6) & 3, c = unit & 63; const size_t n0 = (size_t)b * SEQ + 64 * c;
    const GAS bf16* PA = (const GAS bf16*)(F.ws + WS_PA); const GAS bf16* Y = (const GAS bf16*)(F.ws + WS_Y);
    const GAS bf16* US = (const GAS bf16*)(F.ws + WS_US) + (size_t)unit * 8192;
    const int tr = w >> 1, nh = w & 1, row = 16 * tr + fr;
#pragma unroll
    for (int i = 0; i < 2; ++i) R.us[i] = *(const GAS u32x4*)(US + (tid + 512 * i) * 8);
#pragma unroll
    for (int ks = 0; ks < 2; ++ks) R.aq[ks] = *(const GAS bf16x8*)(PA + (n0 + row) * NPA + PA_BQ + h * 64 + 8 * fq + 32 * ks);
#pragma unroll
    for (int j = 0; j < 4; ++j) { const int v0 = 16 * (4 * nh + j) + 4 * fq; R.oi[j] = *(const GAS u32x2*)(Y + (n0 + row) * 1536 + 512 + h * 128 + v0); R.br[j] = *(const GAS u32x2*)(PA + (n0 + row) * NPA + PA_BR + h * 128 + v0); }
}
__device__ __forceinline__ void gla_out_compute(Frame& F, int l, int unit, int tid, int lane, int w, int fr, int fq, const GlaOutRegs& R) {
    const int b = unit >> 8, h = (unit >> 6) & 3, c = unit & 63; const size_t n0 = (size_t)b * SEQ + 64 * c;
    GAS bf16* Y = (GAS bf16*)(F.ws + WS_Y);
    LAS unsigned char* SS = F.lds;
    LAS float* PS = (LAS float*)(F.lds + 16384);
    const GAS float* gng = ((const GAS float*)F.in[8]) + l * 128;
#pragma unroll
    for (int i = 0; i < 2; ++i) *(LAS u32x4*)(SS + (tid + 512 * i) * 16) = R.us[i];
    __syncthreads();
    const int tr = w >> 1, nh = w & 1, row = 16 * tr + fr;
    f32x4 acc[4];
#pragma unroll
    for (int j = 0; j < 4; ++j) acc[j] = (f32x4){0.f, 0.f, 0.f, 0.f};
#pragma unroll
    for (int ks = 0; ks < 2; ++ks) { const int krow = 32 * ks + 8 * fq + (fr >> 2);
#pragma unroll
        for (int j = 0; j < 4; ++j) { const int nt = 4 * nh + j;
            const bf16x8 bs = cat8(ldtr(SS + krow * 256 + (16 * nt + 4 * (fr & 3)) * 2), ldtr(SS + (krow + 4) * 256 + (16 * nt + 4 * (fr & 3)) * 2));
            acc[j] = __builtin_amdgcn_mfma_f32_16x16x32_bf16(bs, R.aq[ks], acc[j], 0, 0, 0); } }
    float ss = 0.f;
#pragma unroll
    for (int j = 0; j < 4; ++j) { const u32x2 oi = R.oi[j];
        acc[j][0] += bflo(oi.x); acc[j][1] += bfhi(oi.x); acc[j][2] += bflo(oi.y); acc[j][3] += bfhi(oi.y);
        ss += (acc[j][0] * acc[j][0] + acc[j][1] * acc[j][1]) + (acc[j][2] * acc[j][2] + acc[j][3] * acc[j][3]); }
    ss += shx(ss, 16, lane); ss += shx(ss, 32, lane);
    if (fq == 0) PS[row * 2 + nh] = ss;
    __syncthreads();
    { const float rinv = 1.f / sqrtf((PS[row * 2] + PS[row * 2 + 1]) * (1.f / 128.f) + RMS_EPS);
#pragma unroll
      for (int j = 0; j < 4; ++j) { const int v0 = 16 * (4 * nh + j) + 4 * fq; const f32x4 gg = *(const GAS f32x4*)(gng + v0); const u32x2 br = R.br[j];
          u32x2 wv; wv.x = pk2(acc[j][0] * rinv * gg[0] * bflo(br.x), acc[j][1] * rinv * gg[1] * bfhi(br.x)); wv.y = pk2(acc[j][2] * rinv * gg[2] * bflo(br.y), acc[j][3] * rinv * gg[3] * bfhi(br.y));
          *(GAS u32x2*)(Y + (n0 + row) * 1536 + 512 + h * 128 + v0) = wv; } }
    __syncthreads();
}
constexpr int DSA_WAVE_LDS = 17920;
__device__ __forceinline__ void dsa_unit(Frame& F, int unit) {
    int lane = F.lane; asm volatile("" : "+v"(lane)); const int w = F.wave;
    const int qb = 4095 - unit;
    const int b = qb & 7, t = (qb >> 3) * 8 + w;
    const size_t n = (size_t)b * SEQ + t, nb0 = (size_t)b * SEQ;
    const GAS bf16* PA = (const GAS bf16*)(F.ws + WS_PA); GAS bf16* Y = (GAS bf16*)(F.ws + WS_Y);
    const GAS bf16* KI = (const GAS bf16*)(F.ws + WS_KI); const GAS bf16* KA = (const GAS bf16*)(F.ws + WS_KA); const GAS bf16* VA = (const GAS bf16*)(F.ws + WS_VA);
    const GAS float* WI = (const GAS float*)(F.ws + WS_WI);
    LAS unsigned char* base = F.lds + w * DSA_WAVE_LDS;
    LAS unsigned* sc = (LAS unsigned*)base;
    LAS float* qi = (LAS float*)(base + 16384);
    LAS unsigned short* list = (LAS unsigned short*)(base + 16384 + 1024);
    { const u32x2 q2 = *(const GAS u32x2*)(PA + n * NPA + PA_QI + 4 * lane);
      *(LAS f32x4*)(qi + 4 * lane) = (f32x4){bflo(q2.x), bfhi(q2.x), bflo(q2.y), bfhi(q2.y)}; }
    asm volatile("s_waitcnt lgkmcnt(0)" ::: "memory");
    const f32x4 wi = {ld_f32(WI + n * 4), ld_f32(WI + n * 4 + 1), ld_f32(WI + n * 4 + 2), ld_f32(WI + n * 4 + 3)};
    const int nbat = (t >> 6) + 1;
    for (int kb = 0; kb < nbat; ++kb) { const int key = kb * 64 + lane, kc = key <= t ? key : t;
        const GAS u32x4* kp = (const GAS u32x4*)(KI + (nb0 + kc) * 64);
        float kf[64];
#pragma unroll
        for (int c = 0; c < 8; ++c) { const u32x4 kk = kp[c]; kf[8 * c] = bflo(kk.x); kf[8 * c + 1] = bfhi(kk.x); kf[8 * c + 2] = bflo(kk.y); kf[8 * c + 3] = bfhi(kk.y); kf[8 * c + 4] = bflo(kk.z); kf[8 * c + 5] = bfhi(kk.z); kf[8 * c + 6] = bflo(kk.w); kf[8 * c + 7] = bfhi(kk.w); }
        float score = 0.f;
#pragma unroll
        for (int h = 0; h < 4; ++h) { float d = 0.f;
#pragma unroll
            for (int c = 0; c < 16; ++c) { const f32x4 q4 = *(const LAS f32x4*)(qi + h * 64 + 4 * c); d += q4.x * kf[4 * c] + q4.y * kf[4 * c + 1] + q4.z * kf[4 * c + 2] + q4.w * kf[4 * c + 3]; }
            score += wi[h] * fmaxf(d, 0.f); }
        if (score == 0.f) score = 0.f;
        unsigned u = __builtin_bit_cast(unsigned, score); u = (u & 0x80000000u) ? ~u : (u | 0x80000000u);
        sc[key] = key <= t ? u : 0u; }
    asm volatile("s_waitcnt lgkmcnt(0)" ::: "memory");
    int nsel;
    if (t >= 256) {
        unsigned T = 0u;
        for (int bit = 31; bit >= 0; --bit) { const unsigned cand = T | (1u << bit); int cnt = 0;
            for (int j = 0; j < nbat; ++j) cnt += (sc[j * 64 + lane] >= cand) ? 1 : 0;
            if (wave_sum_i(cnt, lane) >= 256) T = cand; }
        int cgt = 0;
        for (int j = 0; j < nbat; ++j) cgt += (sc[j * 64 + lane] > T) ? 1 : 0;
        const int need = 256 - wave_sum_i(cgt, lane);
        int selbase = 0, tiebase = 0;
        for (int j = 0; j < nbat; ++j) { const unsigned x = sc[j * 64 + lane]; const bool eq = (x == T), gt = (x > T);
            const unsigned long long beq = __ballot(eq); const unsigned long long lt = (1ull << lane) - 1ull;
            const int trank = tiebase + __popcll(beq & lt);
            const bool sel = gt || (eq && trank < need);
            const unsigned long long bsel = __ballot(sel);
            if (sel) list[selbase + __popcll(bsel & lt)] = (unsigned short)(j * 64 + lane);
            selbase += __popcll(bsel); tiebase += __popcll(beq); }
        nsel = 256;
    } else {
        nsel = t + 1;
        for (int i = lane; i < 256; i += 64) list[i] = (unsigned short)(i <= t ? i : 0);
    }
    asm volatile("s_waitcnt lgkmcnt(0)" ::: "memory");
    LAS float* qm = (LAS float*)base;
    LAS float* Pl = (LAS float*)(base + 2048);
    { const u32x4 q8 = *(const GAS u32x4*)(PA + n * NPA + PA_Q + 8 * lane);
      *(LAS f32x4*)(qm + 8 * lane) = (f32x4){bflo(q8.x), bfhi(q8.x), bflo(q8.y), bfhi(q8.y)}; *(LAS f32x4*)(qm + 8 * lane + 4) = (f32x4){bflo(q8.z), bfhi(q8.z), bflo(q8.w), bfhi(q8.w)}; }
    asm volatile("s_waitcnt lgkmcnt(0)" ::: "memory");
#pragma unroll 1
    for (int bb = 0; bb < 4; ++bb) { const int i = bb * 64 + lane; const bool valid = i < nsel; const int key = valid ? (int)list[i] : 0;
        const GAS u32x4* kp = (const GAS u32x4*)(KA + (nb0 + key) * 64);
        float kf[64];
#pragma unroll
        for (int c = 0; c < 8; ++c) { const u32x4 kk = kp[c]; kf[8 * c] = bflo(kk.x); kf[8 * c + 1] = bfhi(kk.x); kf[8 * c + 2] = bflo(kk.y); kf[8 * c + 3] = bfhi(kk.y); kf[8 * c + 4] = bflo(kk.z); kf[8 * c + 5] = bfhi(kk.z); kf[8 * c + 6] = bflo(kk.w); kf[8 * c + 7] = bfhi(kk.w); }
        float lgv[8];
#pragma unroll
        for (int h = 0; h < 8; ++h) { float d = 0.f;
#pragma unroll
            for (int c = 0; c < 16; ++c) { const f32x4 q4 = *(const LAS f32x4*)(qm + h * 64 + 4 * c); d += q4.x * kf[4 * c] + q4.y * kf[4 * c + 1] + q4.z * kf[4 * c + 2] + q4.w * kf[4 * c + 3]; }
            lgv[h] = valid ? d : -INFINITY; }
        *(LAS f32x4*)(Pl + i * 8) = (f32x4){lgv[0], lgv[1], lgv[2], lgv[3]}; *(LAS f32x4*)(Pl + i * 8 + 4) = (f32x4){lgv[4], lgv[5], lgv[6], lgv[7]}; }
    asm volatile("s_waitcnt lgkmcnt(0)" ::: "memory");
    float lg[4][8];
#pragma unroll
    for (int bb = 0; bb < 4; ++bb) { const f32x4 a = *(const LAS f32x4*)(Pl + (bb * 64 + lane) * 8), c = *(const LAS f32x4*)(Pl + (bb * 64 + lane) * 8 + 4);
        lg[bb][0] = a.x; lg[bb][1] = a.y; lg[bb][2] = a.z; lg[bb][3] = a.w; lg[bb][4] = c.x; lg[bb][5] = c.y; lg[bb][6] = c.z; lg[bb][7] = c.w; }
    float den[8];
#pragma unroll
    for (int h = 0; h < 8; ++h) { float m = fmaxf(fmaxf(lg[0][h], lg[1][h]), fmaxf(lg[2][h], lg[3][h])); m = wave_max(m, lane); float s = 0.f;
#pragma unroll
        for (int bb = 0; bb < 4; ++bb) { lg[bb][h] = __expf(lg[bb][h] - m); s += lg[bb][h]; }
        den[h] = wave_sum(s, lane); }
#pragma unroll
    for (int bb = 0; bb < 4; ++bb) { const int i = bb * 64 + lane;
        *(LAS f32x4*)(Pl + i * 8) = (f32x4){lg[bb][0], lg[bb][1], lg[bb][2], lg[bb][3]}; *(LAS f32x4*)(Pl + i * 8 + 4) = (f32x4){lg[bb][4], lg[bb][5], lg[bb][6], lg[bb][7]}; }
    asm volatile("s_waitcnt lgkmcnt(0)" ::: "memory");
    float o[8];
#pragma unroll
    for (int h = 0; h < 8; ++h) o[h] = 0.f;
#pragma unroll 4
    for (int i = 0; i < nsel; ++i) { const int key = (int)list[i]; const float vv = bf1(VA[(nb0 + key) * 64 + lane]);
        const f32x4 p0 = *(const LAS f32x4*)(Pl + i * 8), p1 = *(const LAS f32x4*)(Pl + i * 8 + 4);
        o[0] += p0.x * vv; o[1] += p0.y * vv; o[2] += p0.z * vv; o[3] += p0.w * vv; o[4] += p1.x * vv; o[5] += p1.y * vv; o[6] += p1.z * vv; o[7] += p1.w * vv; }
#pragma unroll
    for (int h = 0; h < 8; ++h) Y[n * 1536 + h * 64 + lane] = (bf16)f2bf(o[h] / den[h]);
}

__device__ __forceinline__ bf16x8 scale_pack8(u32x4 raw, float s) {
    u32x4 o; o.x = cvt_pk_bf16(bflo(raw.x) * s, bfhi(raw.x) * s); o.y = cvt_pk_bf16(bflo(raw.y) * s, bfhi(raw.y) * s); o.z = cvt_pk_bf16(bflo(raw.z) * s, bfhi(raw.z) * s); o.w = cvt_pk_bf16(bflo(raw.w) * s, bfhi(raw.w) * s);
    return __builtin_bit_cast(bf16x8, o);
}
__device__ __forceinline__ void dsa16_unit(Frame& F, int unit) {
    const int lane = fresh_lane(); const int w = F.wave;
    const int qb = 2047 - unit;
    const int b = qb & 7, t0 = (qb >> 3) * 16;
    const size_t nb0 = (size_t)b * SEQ;
    const GAS bf16* PA = (const GAS bf16*)(F.ws + WS_PA); GAS bf16* Y = (GAS bf16*)(F.ws + WS_Y);
    const GAS bf16* KI = (const GAS bf16*)(F.ws + WS_KI); const GAS bf16* KA = (const GAS bf16*)(F.ws + WS_KA); const GAS bf16* VA = (const GAS bf16*)(F.ws + WS_VA);
    const GAS float* WI = (const GAS float*)(F.ws + WS_WI);
    LAS unsigned char* K16 = F.lds;
    LAS unsigned short* LIST = (LAS unsigned short*)(F.lds + AUX_OFF);
    const int fr = lane & 15, fq = lane >> 4;
#ifdef REP_S1
    for (int rep_ = 0; rep_ < REP_S1; ++rep_)
#endif
    {
        const int ql = fr >> 2, h = fr & 3;
        bf16x8 Bf[4][2]; float Linf[4];
#pragma unroll
        for (int g = 0; g < 4; ++g) { const size_t nq = nb0 + t0 + 4 * g + ql; const float wv = WI[nq * 4 + h];
#pragma unroll
            for (int ks = 0; ks < 2; ++ks) Bf[g][ks] = scale_pack8(*(const GAS u32x4*)(PA + nq * NPA + PA_QI + h * 64 + 8 * fq + 32 * ks), wv);
            Linf[g] = (wv >= 0.f) ? INFINITY : -INFINITY; }
        const int ntiles = (t0 >> 4) + 1;
        bf16x8 A0[4], A1[4];
#pragma unroll
        for (int j = 0; j < 4; ++j) { const int tile = (w + 8 * j < ntiles) ? w + 8 * j : ntiles - 1; const size_t krow = (nb0 + 16 * tile + fr) * 64;
            A0[j] = *(const GAS bf16x8*)(KI + krow + 8 * fq); A1[j] = *(const GAS bf16x8*)(KI + krow + 32 + 8 * fq); }
#pragma unroll 1
        for (int tb = w; tb < ntiles; tb += 32) {
            bf16x8 N0[4], N1[4];
#pragma unroll
            for (int j = 0; j < 4; ++j) { const int tn = tb + 32 + 8 * j; const int tile = (tn < ntiles) ? tn : ntiles - 1; const size_t krow = (nb0 + 16 * tile + fr) * 64;
                N0[j] = *(const GAS bf16x8*)(KI + krow + 8 * fq); N1[j] = *(const GAS bf16x8*)(KI + krow + 32 + 8 * fq); }
#pragma unroll
            for (int j = 0; j < 4; ++j) { const int tile = tb + 8 * j;
                if (tile < ntiles) {
                    const int kpos = 16 * tile + 4 * fq + h;
                    const int g7 = kpos >> 7, hf = (kpos >> 6) & 1, ln = kpos & 63;
                    const int koff = (g7 >> 2) * 1024 + ln * 16 + (g7 & 3) * 4 + hf * 2;
                    const bool lastt = (tile == ntiles - 1);
                    f32x4 d[4];
#pragma unroll
                    for (int g = 0; g < 4; ++g) d[g] = __builtin_amdgcn_mfma_f32_16x16x32_bf16(A0[j], Bf[g][0], (f32x4){0.f, 0.f, 0.f, 0.f}, 0, 0, 0);
#pragma unroll
                    for (int g = 0; g < 4; ++g) d[g] = __builtin_amdgcn_mfma_f32_16x16x32_bf16(A1[j], Bf[g][1], d[g], 0, 0, 0);
#define S1_STEP(g) const float a0##g = __builtin_amdgcn_fmed3f(d[g][0], 0.f, Linf[g]), a1##g = __builtin_amdgcn_fmed3f(d[g][1], 0.f, Linf[g]), a2##g = __builtin_amdgcn_fmed3f(d[g][2], 0.f, Linf[g]), a3##g = __builtin_amdgcn_fmed3f(d[g][3], 0.f, Linf[g]);
                    S1_STEP(0) S1_STEP(1) S1_STEP(2) S1_STEP(3)
#undef S1_STEP
#define S1_STEP(g) const float u0##g = a0##g + dppf<0xB1>(a0##g), u1##g = a1##g + dppf<0xB1>(a1##g), u2##g = a2##g + dppf<0xB1>(a2##g), u3##g = a3##g + dppf<0xB1>(a3##g);
                    S1_STEP(0) S1_STEP(1) S1_STEP(2) S1_STEP(3)
#undef S1_STEP
#define S1_STEP(g) const float p0##g = (h & 1) ? u1##g : u0##g, p1##g = (h & 1) ? u3##g : u2##g;
                    S1_STEP(0) S1_STEP(1) S1_STEP(2) S1_STEP(3)
#undef S1_STEP
#define S1_STEP(g) const float c0##g = p0##g + dppf<0x4E>(p0##g), c1##g = p1##g + dppf<0x4E>(p1##g);
                    S1_STEP(0) S1_STEP(1) S1_STEP(2) S1_STEP(3)
#undef S1_STEP
#define S1_STEP(g) const float s##g = ((h & 2) ? c1##g : c0##g) + 0.0f; const _Float16 hh##g = (_Float16)s##g; const unsigned hb##g = (unsigned)__builtin_bit_cast(unsigned short, hh##g); \
                    unsigned key##g = hb##g ^ ((unsigned)((int)(hb##g << 16) >> 31) | 0x8000u); if (lastt) key##g = (kpos <= t0 + 4 * g + ql) ? key##g : 0u;
                    S1_STEP(0) S1_STEP(1) S1_STEP(2) S1_STEP(3)
#undef S1_STEP
#define S1_STEP(g) *(LAS unsigned short*)(K16 + (4 * g + ql) * 8192 + koff) = (unsigned short)key##g;
                    S1_STEP(0) S1_STEP(1) S1_STEP(2) S1_STEP(3)
#undef S1_STEP
                }
            }
#pragma unroll
            for (int j = 0; j < 4; ++j) { A0[j] = N0[j]; A1[j] = N1[j]; }
        }
    }
    __syncthreads();
    if (t0 < 256) {
#pragma unroll 1
        for (int qq = 0; qq < 2; ++qq) { const int q = 2 * w + qq, nvalid = t0 + q + 1; LAS unsigned short* list = LIST + q * 256;
            for (int i = lane; i < 256; i += 64) list[i] = (unsigned short)(i < nvalid ? i : 0); }
    } else {
#ifndef REP_S2
#define REP_S2 1
#endif
#pragma unroll 1
        for (int qq = 0; qq < 2 * REP_S2; ++qq) {
            const int q = 2 * w + (qq & 1), nvalid = t0 + q + 1;
            LAS unsigned short* list = LIST + q * 256;
            const int ngrp = (nvalid + 511) >> 9;
            unsigned P[32];
#pragma unroll
            for (int grp = 0; grp < 8; ++grp) {
                if (grp < ngrp) { const u32x4 r = *(const LAS u32x4*)(K16 + q * 8192 + grp * 1024 + lane * 16);
#pragma unroll
                    for (int i = 0; i < 4; ++i) { const int g = 4 * grp + i; const int thr = nvalid - 128 * g; unsigned rr = r[i];
                        if (thr < 128) rr &= ((lane < thr) ? 0xffffu : 0u) | ((lane < thr - 64) ? 0xffff0000u : 0u);
                        P[g] = rr; }
                } else {
#pragma unroll
                    for (int i = 0; i < 4; ++i) P[4 * grp + i] = 0u;
                }
            }
            unsigned one2 = 0x00010001u; asm volatile("" : "+v"(one2));
#define DSA_PKCOUNT(dst, c1) do { const unsigned c1p_ = (c1) | ((c1) << 16); unsigned a_ = 0u; \
                _Pragma("unroll") for (int grp = 0; grp < 8; ++grp) if (grp < ngrp) { _Pragma("unroll") for (int i = 0; i < 4; ++i) { unsigned y_; \
                    asm("v_pk_sub_u16 %0, %1, %2 clamp\n\tv_pk_min_u16 %0, %0, %3" : "=&v"(y_) : "v"(P[4 * grp + i]), "v"(c1p_), "v"(one2)); a_ += y_; } } \
                dst = (int)((a_ & 0xffffu) + (a_ >> 16)); } while (0)
            LAS unsigned* hist = (LAS unsigned*)(F.lds + AUX_OFF + 8192) + w * 256;
            unsigned T; int tot_gt;
            { unsigned hi8 = 0u; int above = 0;
#pragma unroll
              for (int lvl = 0; lvl < 2; ++lvl) {
                  { unsigned z_ = 0u; asm volatile("" : "+v"(z_)); *(LAS u32x4*)(hist + 4 * lane) = (u32x4){z_, z_, z_, z_}; }
                  asm volatile("s_waitcnt lgkmcnt(0)" ::: "memory");
#pragma unroll
                  for (int grp = 0; grp < 8; ++grp) if (grp < ngrp) {
#pragma unroll
                      for (int i = 0; i < 4; ++i) { const unsigned lo = P[4 * grp + i] & 0xffffu, hi = P[4 * grp + i] >> 16;
                          if (lvl == 0) { __hip_atomic_fetch_add(hist + (lo >> 8), 1u, __ATOMIC_RELAXED, __HIP_MEMORY_SCOPE_WAVEFRONT); __hip_atomic_fetch_add(hist + (hi >> 8), 1u, __ATOMIC_RELAXED, __HIP_MEMORY_SCOPE_WAVEFRONT); }
                          else { if ((lo >> 8) == hi8) __hip_atomic_fetch_add(hist + (lo & 0xffu), 1u, __ATOMIC_RELAXED, __HIP_MEMORY_SCOPE_WAVEFRONT);
                                 if ((hi >> 8) == hi8) __hip_atomic_fetch_add(hist + (hi & 0xffu), 1u, __ATOMIC_RELAXED, __HIP_MEMORY_SCOPE_WAVEFRONT); } } }
                  asm volatile("s_waitcnt lgkmcnt(0)" ::: "memory");
                  const u32x4 hb = *(const LAS u32x4*)(hist + 4 * lane);
                  const int sl = (int)(hb.x + hb.y + hb.z + hb.w);
                  int inc = sl;
                  inc += __builtin_amdgcn_update_dpp(0, inc, 0x111, 0xf, 0xf, false); inc += __builtin_amdgcn_update_dpp(0, inc, 0x112, 0xf, 0xf, false);
                  inc += __builtin_amdgcn_update_dpp(0, inc, 0x114, 0xf, 0xf, false); inc += __builtin_amdgcn_update_dpp(0, inc, 0x118, 0xf, 0xf, false);
                  const int r0 = __builtin_amdgcn_readlane(inc, 15), r1 = __builtin_amdgcn_readlane(inc, 31), r2 = __builtin_amdgcn_readlane(inc, 47), r3 = __builtin_amdgcn_readlane(inc, 63);
                  inc += (fq >= 1 ? r0 : 0) + (fq >= 2 ? r1 : 0) + (fq >= 3 ? r2 : 0);
                  const int total = r0 + r1 + r2 + r3;
                  const int want = 256 - above;
                  int run = total - inc;
                  int fb = -1, fa = 0;
                  { const int h3 = (int)hb.w, h2 = (int)hb.z, h1 = (int)hb.y, h0 = (int)hb.x;
                    if (run < want && run + h3 >= want) { fb = 3; fa = run; } run += h3;
                    if (run < want && run + h2 >= want) { fb = 2; fa = run; } run += h2;
                    if (run < want && run + h1 >= want) { fb = 1; fa = run; } run += h1;
                    if (run < want && run + h0 >= want) { fb = 0; fa = run; } }
                  const unsigned long long fm = __ballot(fb >= 0);
                  const int src = (int)__builtin_ctzll(fm);
                  const int bstar = __builtin_amdgcn_readlane(4 * lane + fb, src), abv = __builtin_amdgcn_readlane(fa, src);
                  if (lvl == 0) { hi8 = (unsigned)bstar; above = abv; } else { T = (hi8 << 8) | (unsigned)bstar; tot_gt = above + abv; }
              } }
            int cge_l, cgt_l; DSA_PKCOUNT(cge_l, T - 1u); DSA_PKCOUNT(cgt_l, T);
            const int tot_ge = wave_total_i(cge_l);
            const bool alltie = (tot_ge == 256);
            const int c_l = alltie ? cge_l : cgt_l; const unsigned thrT = alltie ? T : T + 1u;
            int inc = c_l;
            inc += __builtin_amdgcn_update_dpp(0, inc, 0x111, 0xf, 0xf, false); inc += __builtin_amdgcn_update_dpp(0, inc, 0x112, 0xf, 0xf, false);
            inc += __builtin_amdgcn_update_dpp(0, inc, 0x114, 0xf, 0xf, false); inc += __builtin_amdgcn_update_dpp(0, inc, 0x118, 0xf, 0xf, false);
            { const int r0 = __builtin_amdgcn_readlane(inc, 15), r1 = __builtin_amdgcn_readlane(inc, 31), r2 = __builtin_amdgcn_readlane(inc, 47);
              inc += (fq >= 1 ? r0 : 0) + (fq >= 2 ? r1 : 0) + (fq >= 3 ? r2 : 0); }
            int kpos_ = inc - c_l;
#pragma unroll
            for (int grp = 0; grp < 8; ++grp) if (grp < ngrp) {
#pragma unroll
                for (int i = 0; i < 4; ++i) { const int g = 4 * grp + i; const unsigned lo = P[g] & 0xffffu, hi = P[g] >> 16;
                    if (lo >= thrT) { list[kpos_] = (unsigned short)(128 * g + lane); ++kpos_; }
                    if (hi >= thrT) { list[kpos_] = (unsigned short)(128 * g + 64 + lane); ++kpos_; } } }
            if (!alltie) {
                int rem = 256 - tot_gt, pos = tot_gt; const unsigned long long lt = (1ull << lane) - 1ull;
#pragma unroll
                for (int grp = 0; grp < 8; ++grp) if (grp < ngrp) {
#pragma unroll
                    for (int i = 0; i < 8; ++i) { const int g = 4 * grp + (i >> 1); const unsigned val = (i & 1) ? (P[g] >> 16) : (P[g] & 0xffffu);
                        const bool eq = (val == T); const unsigned long long beq = __ballot(eq);
                        if (beq != 0ull) { const int rank = __popcll(beq & lt); if (eq && rank < rem) list[pos + rank] = (unsigned short)(128 * g + 64 * (i & 1) + lane);
                            const int n = __popcll(beq), take = n < rem ? n : rem; pos += take; rem -= take; } } }
            }
#undef DSA_PKCOUNT
        }
    }
    asm volatile("s_waitcnt lgkmcnt(0)" ::: "memory");
    LAS unsigned char* Vs = F.lds + w * 16384;
#ifndef REP_S3
#define REP_S3 1
#endif
#pragma unroll 1
    for (int qq = 0; qq < 2 * REP_S3; ++qq) {
        const int q = 2 * w + (qq & 1), tq = t0 + q; const int nsel = (tq + 1 < 256) ? tq + 1 : 256;
        const size_t nq = nb0 + tq;
        const LAS unsigned short* list = LIST + q * 256;
        bf16x8 Qf[2];
#pragma unroll
        for (int ks = 0; ks < 2; ++ks) { u32x4 raw = {0u, 0u, 0u, 0u}; if (fr < 8) raw = *(const GAS u32x4*)(PA + nq * NPA + PA_Q + fr * 64 + 8 * fq + 32 * ks); Qf[ks] = __builtin_bit_cast(bf16x8, raw); }
        float lg[16][4];
#ifdef REP_S3K
#pragma unroll 1
        for (int repk = 0; repk < REP_S3K; ++repk)
#endif
        const int st_off = (lane >> 3) * 128 + (((lane & 7) ^ ((lane >> 3) & 7)) * 16);
        const int rd0 = fr * 128 + ((fq ^ (fr & 7)) * 16), rd1 = fr * 128 + (((fq + 4) ^ (fr & 7)) * 16);
#pragma unroll
        for (int hb = 0; hb < 2; ++hb) {
#pragma unroll
            for (int ib = 0; ib < 2; ++ib) { u32x4 kv[8];
#pragma unroll
                for (int i = 0; i < 8; ++i) { const int piece = (8 * ib + i) * 64 + lane; const int key = (int)list[128 * hb + (piece >> 3)];
                    kv[i] = *(const GAS u32x4*)(KA + (nb0 + key) * 64 + 8 * (lane & 7)); }
                __builtin_amdgcn_sched_barrier(0);
#pragma unroll
                for (int i = 0; i < 8; ++i) *(LAS u32x4*)(Vs + st_off + (8 * ib + i) * 1024) = kv[i];
            }
            asm volatile("s_waitcnt lgkmcnt(0)" ::: "memory");
#pragma unroll
            for (int j = 0; j < 8; ++j) { const int tt = 8 * hb + j;
                const bf16x8 A0 = *(const LAS bf16x8*)(Vs + rd0 + j * 2048), A1 = *(const LAS bf16x8*)(Vs + rd1 + j * 2048);
                f32x4 d = __builtin_amdgcn_mfma_f32_16x16x32_bf16(A0, Qf[0], (f32x4){0.f, 0.f, 0.f, 0.f}, 0, 0, 0);
                d = __builtin_amdgcn_mfma_f32_16x16x32_bf16(A1, Qf[1], d, 0, 0, 0);
#pragma unroll
                for (int r = 0; r < 4; ++r) lg[tt][r] = (16 * tt + 4 * fq + r < nsel) ? d[r] : -INFINITY; }
            asm volatile("s_waitcnt lgkmcnt(0)" ::: "memory");
        }
        float m = lg[0][0];
#pragma unroll
        for (int tt = 0; tt < 16; ++tt)
#pragma unroll
            for (int r = 0; r < 4; ++r) m = fmaxf(m, lg[tt][r]);
        m = fmaxf(m, shx(m, 16, lane)); m = fmaxf(m, shx(m, 32, lane));
        float den = 0.f;
#pragma unroll
        for (int tt = 0; tt < 16; ++tt)
#pragma unroll
            for (int r = 0; r < 4; ++r) { lg[tt][r] = __expf(lg[tt][r] - m); den += lg[tt][r]; }
        den += shx(den, 16, lane); den += shx(den, 32, lane);
        f32x4 acc[4];
#pragma unroll
        for (int nt = 0; nt < 4; ++nt) acc[nt] = (f32x4){0.f, 0.f, 0.f, 0.f};
#ifdef REP_S3V
#pragma unroll 1
        for (int repv = 0; repv < REP_S3V; ++repv) {
#pragma unroll
        for (int nt = 0; nt < 4; ++nt) acc[nt] = (f32x4){0.f, 0.f, 0.f, 0.f};
#endif
#pragma unroll
        for (int hh = 0; hh < 2; ++hh) {
#pragma unroll
            for (int ib = 0; ib < 2; ++ib) {
                u32x4 vv[8];
#pragma unroll
                for (int i = 0; i < 8; ++i) { const int piece = (8 * ib + i) * 64 + lane, row = piece >> 3, c = piece & 7; const int key = (int)list[128 * hh + row];
                    vv[i] = *(const GAS u32x4*)(VA + (nb0 + key) * 64 + 8 * c); }
                __builtin_amdgcn_sched_barrier(0);
#pragma unroll
                for (int i = 0; i < 8; ++i) { const int piece = (8 * ib + i) * 64 + lane; *(LAS u32x4*)(Vs + piece * 16) = vv[i]; }
            }
            asm volatile("s_waitcnt lgkmcnt(0)" ::: "memory");
#pragma unroll
            for (int s4 = 0; s4 < 4; ++s4) { const int s = 4 * hh + s4;
                u32x4 pa; pa.x = cvt_pk_bf16(lg[2 * s][0], lg[2 * s][1]); pa.y = cvt_pk_bf16(lg[2 * s][2], lg[2 * s][3]); pa.z = cvt_pk_bf16(lg[2 * s + 1][0], lg[2 * s + 1][1]); pa.w = cvt_pk_bf16(lg[2 * s + 1][2], lg[2 * s + 1][3]);
                const bf16x8 Pa = __builtin_bit_cast(bf16x8, pa);
                const int rowa = 32 * s4 + 4 * fq + (fr >> 2);
#pragma unroll
                for (int nt = 0; nt < 4; ++nt) {
                    const v4i16_t lo = __builtin_amdgcn_ds_read_tr16_b64_v4i16((LAS v4i16_t*)(Vs + rowa * 128 + (16 * nt + 4 * (fr & 3)) * 2));
                    const v4i16_t hi = __builtin_amdgcn_ds_read_tr16_b64_v4i16((LAS v4i16_t*)(Vs + (rowa + 16) * 128 + (16 * nt + 4 * (fr & 3)) * 2));
                    bf16x8 Bv; Bv[0] = lo[0]; Bv[1] = lo[1]; Bv[2] = lo[2]; Bv[3] = lo[3]; Bv[4] = hi[0]; Bv[5] = hi[1]; Bv[6] = hi[2]; Bv[7] = hi[3];
                    acc[nt] = __builtin_amdgcn_mfma_f32_16x16x32_bf16(Bv, Pa, acc[nt], 0, 0, 0); } }
            asm volatile("s_waitcnt lgkmcnt(0)" ::: "memory");
        }
#ifdef REP_S3V
        }
#endif
        if (fr < 8) { const float rden = 1.f / den;
#pragma unroll
            for (int nt = 0; nt < 4; ++nt) { u32x2 wv; wv.x = pk2(acc[nt][0] * rden, acc[nt][1] * rden); wv.y = pk2(acc[nt][2] * rden, acc[nt][3] * rden);
                *(GAS u32x2*)(Y + nq * 1536 + fr * 64 + 16 * nt + 4 * fq) = wv; } }
    }
}

#ifdef GLA_NAIVE
constexpr int NGLA = 32;
#else
constexpr int NGLA = 2048;
#endif
#ifdef DSA_NAIVE
constexpr int NDSA = 4096;
#else
constexpr int NDSA = 2048;
#endif
#ifdef GMLP_NAIVE
constexpr int NGM = 1024;
#else
constexpr int NGM = 256;
#endif
__device__ __forceinline__ void phase_mixer(Frame& F, int l, int slot = 0, int types = 7) {
    gu32* head = F.ctl + CW_QUEUE + 64 * (l + 2 * slot);
    for (;;) {
        __syncthreads();
        if (F.wave == 0 && fresh_lane() == 0) F.MISC[64] = __hip_atomic_fetch_add(head, 1u, __ATOMIC_RELAXED, __HIP_MEMORY_SCOPE_AGENT);
        __syncthreads();
        const int u = (int)F.MISC[64];
        if (u >= NDSA + NGLA + NGM) break;
        if (u < NDSA) { if (EN_B2 && (types & 2)) {
#ifdef DSA_NAIVE
            dsa_unit(F, u);
#else
            dsa16_unit(F, u);
#endif
        } }
        else if (u < NDSA + NGLA) { if (EN_B1 && (types & 1)) {
#ifdef GLA_NAIVE
            gla_unit(F, l, u - NDSA);
#else
            gla_local_unit(F, l, u - NDSA);
#endif
        } }
        else { if (EN_B3 && (types & 4)) {
#ifdef GMLP_NAIVE
            gmlp_unit(F, l, u - NDSA - NGLA);
#else
            gmlp16_unit(F, l, u - NDSA - NGLA);
#endif
        } }
    }
}
__device__ __forceinline__ void phase_gla_out(Frame& F, int l) {
#ifndef GLA_NAIVE
    const int lane = fresh_lane(), w = F.wave, tid = w * 64 + lane, fr = lane & 15, fq = lane >> 4;
    GlaOutRegs R, N;
    if (F.wg < 2048) gla_out_load(F, F.wg, tid, w, fr, fq, R);
#pragma unroll 1
    for (int u = F.wg; u < 2048; u += F.G) { const int un = (u + F.G < 2048) ? u + F.G : u;
        gla_out_load(F, un, tid, w, fr, fq, N);
        gla_out_compute(F, l, u, tid, lane, w, fr, fq, R);
        R = N; }
#endif
}

template <int CTRL> __device__ __forceinline__ float dpp_add(float v) { return v + dppf<CTRL>(v); }
__device__ __forceinline__ float row16_sum(float v) { v = dpp_add<0xB1>(v); v = dpp_add<0x4E>(v); v = dpp_add<0x141>(v); v = dpp_add<0x140>(v); return v; }
__device__ __forceinline__ void phase_ln_router(Frame& F, int l) {
    const GAS bf16* WRB = (const GAS bf16*)(F.ws + WS_WR) + (size_t)l * 48 * DM;
    LAS unsigned char* WB = F.lds;
    for (int i = F.tid; i < 48 * 128; i += 512) { const int n = i >> 7, c = i & 127; *(LAS u32x4*)(WB + n * 2048 + ((c ^ (n & 7)) * 16)) = *(const GAS u32x4*)(WRB + n * DM + 8 * c); }
    if (F.tid < 32) F.MISC[16 + F.tid] = 0u;
    __syncthreads();
    GAS bf16* HB = (GAS bf16*)(F.ws + WS_HB); const GAS bf16* T = (const GAS bf16*)F.H; GAS int* EID = (GAS int*)(F.ws + WS_ROUTE); GAS float* EW = (GAS float*)(F.ws + WS_ROUTE + 256 * 1024);
    const GAS float* g = ((const GAS float*)F.in[17]) + l * DM; const GAS float* bb = ((const GAS float*)F.in[18]) + l * DM; const GAS float* brg = ((const GAS float*)F.in[20]) + l * 4; const GAS float* bre = ((const GAS float*)F.in[22]) + l * 32;
    const int lane = fresh_lane();
    const int sub = lane & 15, rr = lane >> 4, fr = sub, fq = rr;
    LAS float* LG = (LAS float*)(F.lds + 98304) + F.wave * 768;
    for (int r0 = F.wg * 128; r0 < NTOK; r0 += F.G * 128) {
        const int m0 = r0 + F.wave * 16;
        u32x4 nx[8];
#pragma unroll
        for (int q = 0; q < 8; ++q) nx[q] = *(const GAS u32x4*)(T + (size_t)(m0 + rr) * DM + 8 * (sub + 16 * q));
#pragma unroll 1
        for (int j = 0; j < 4; ++j) { const int m = m0 + 4 * j + rr;
            float v[64]; float s = 0.f;
#pragma unroll
            for (int q = 0; q < 8; ++q) { const u32x4 x = nx[q]; v[8 * q] = bflo(x.x); v[8 * q + 1] = bfhi(x.x); v[8 * q + 2] = bflo(x.y); v[8 * q + 3] = bfhi(x.y); v[8 * q + 4] = bflo(x.z); v[8 * q + 5] = bfhi(x.z); v[8 * q + 6] = bflo(x.w); v[8 * q + 7] = bfhi(x.w); }
            { const int mn = (j < 3) ? m + 4 : m;
#pragma unroll
              for (int q = 0; q < 8; ++q) nx[q] = *(const GAS u32x4*)(T + (size_t)mn * DM + 8 * (sub + 16 * q)); }
#pragma unroll
            for (int i = 0; i < 64; ++i) s += v[i];
            const float mean = row16_sum(s) * (1.f / DM); float s2 = 0.f;
#pragma unroll
            for (int i = 0; i < 64; ++i) { v[i] -= mean; s2 += v[i] * v[i]; }
            const float rstd = 1.f / sqrtf(row16_sum(s2) * (1.f / DM) + LN_EPS);
#pragma unroll
            for (int q = 0; q < 8; ++q) { const int c = 8 * (sub + 16 * q); const f32x4 g0 = *(const GAS f32x4*)(g + c), g1 = *(const GAS f32x4*)(g + c + 4), b0 = *(const GAS f32x4*)(bb + c), b1 = *(const GAS f32x4*)(bb + c + 4);
#pragma unroll
                for (int i = 0; i < 4; ++i) { v[8 * q + i] = v[8 * q + i] * rstd * g0[i] + b0[i]; v[8 * q + 4 + i] = v[8 * q + 4 + i] * rstd * g1[i] + b1[i]; }
                u32x4 wv; wv.x = pk2(v[8 * q], v[8 * q + 1]); wv.y = pk2(v[8 * q + 2], v[8 * q + 3]); wv.z = pk2(v[8 * q + 4], v[8 * q + 5]); wv.w = pk2(v[8 * q + 6], v[8 * q + 7]);
                *(GAS u32x4*)(HB + (size_t)m * DM + c) = wv; } }
        asm volatile("s_waitcnt vmcnt(0)" ::: "memory");
        f32x4 acc[3];
#pragma unroll
        for (int nt = 0; nt < 3; ++nt) acc[nt] = (f32x4){0.f, 0.f, 0.f, 0.f};
#pragma unroll 1
        for (int kb = 0; kb < 4; ++kb) {
            bf16x8 af[8];
#pragma unroll
            for (int ks = 0; ks < 8; ++ks) af[ks] = *(const GAS bf16x8*)(HB + (size_t)(m0 + fr) * DM + 8 * fq + 32 * (8 * kb + ks));
#pragma unroll
            for (int ks = 0; ks < 8; ++ks) { const int c = fq + 4 * (8 * kb + ks);
#pragma unroll
                for (int nt = 0; nt < 3; ++nt) { const int n = 16 * nt + fr; const bf16x8 bw = *(const LAS bf16x8*)(WB + n * 2048 + ((c ^ (n & 7)) * 16));
                    acc[nt] = __builtin_amdgcn_mfma_f32_16x16x32_bf16(af[ks], bw, acc[nt], 0, 0, 0); } } }
#pragma unroll
        for (int nt = 0; nt < 3; ++nt)
#pragma unroll
            for (int r = 0; r < 4; ++r) LG[(4 * fq + r) * 48 + 16 * nt + fr] = acc[nt][r];
        asm volatile("s_waitcnt lgkmcnt(0)" ::: "memory");
        if (lane < 16) { const int m = m0 + lane; const LAS float* lgt = LG + lane * 48;
            int gi = 0; float gm = lgt[0] + brg[0];
#pragma unroll
            for (int q = 1; q < 4; ++q) { const float x = lgt[q] + brg[q]; if (x > gm) { gm = x; gi = q; } }
            float gs = 0.f;
#pragma unroll
            for (int q = 0; q < 4; ++q) gs += __expf(lgt[q] + brg[q] - gm);
            const float gp = 1.f / gs;
            float el[8];
#pragma unroll
            for (int q = 0; q < 8; ++q) el[q] = lgt[4 + 8 * gi + q] + bre[8 * gi + q];
            int i0 = 0; float v0 = el[0];
#pragma unroll
            for (int q = 1; q < 8; ++q) if (el[q] > v0) { v0 = el[q]; i0 = q; }
            int i1 = -1; float v1 = -INFINITY;
#pragma unroll
            for (int q = 0; q < 8; ++q) if (q != i0 && el[q] > v1) { v1 = el[q]; i1 = q; }
            const float ex = __expf(v1 - v0), w0 = gp / (1.f + ex), w1 = gp * ex / (1.f + ex);
            const int e0 = gi * 8 + i0, e1 = gi * 8 + i1;
            EID[2 * m] = e0; EID[2 * m + 1] = e1; EW[2 * m] = w0; EW[2 * m + 1] = w1;
            __hip_atomic_fetch_add((LAS unsigned*)(F.lds + MISC_OFF) + 16 + e0, 1u, __ATOMIC_RELAXED, __HIP_MEMORY_SCOPE_WORKGROUP);
            __hip_atomic_fetch_add((LAS unsigned*)(F.lds + MISC_OFF) + 16 + e1, 1u, __ATOMIC_RELAXED, __HIP_MEMORY_SCOPE_WORKGROUP); }
        asm volatile("s_waitcnt lgkmcnt(0)" ::: "memory");
    }
    __syncthreads();
    if (F.tid < 32) ((GAS int*)(F.ws + WS_CNTWG))[F.wg * 32 + F.tid] = (int)F.MISC[16 + F.tid];
}
__device__ __forceinline__ void phase_dispatch(Frame& F) {
    const GAS int* CNT = (const GAS int*)(F.ws + WS_CNTWG); const GAS int* EID = (const GAS int*)(F.ws + WS_ROUTE); const GAS float* EW = (const GAS float*)(F.ws + WS_ROUTE + 256 * 1024);
    GAS int* SROW = (GAS int*)(F.ws + WS_SROW); GAS int* ROWMAP = (GAS int*)(F.ws + WS_ROWMAP); GAS float* CWROW = (GAS float*)(F.ws + WS_CWROW); GAS int* META = (GAS int*)(F.ws + WS_META);
    LAS int* tot = (LAS int*)(F.lds + AUX_OFF);
    if (F.tid < 32) { int t = 0, mine = 0; for (int w = 0; w < F.G; ++w) { const int c = ld_i32(CNT + w * 32 + F.tid); t += c; if (w < F.wg) mine += c; } tot[F.tid] = t; tot[32 + F.tid] = mine; tot[96 + F.tid] = 0; }
    __syncthreads();
    if (F.tid == 0) { int rb = 0;
#pragma clang loop unroll(disable) vectorize(disable)
        for (int e = 0; e < 32; ++e) { tot[64 + e] = rb; rb += ((tot[e] + 255) >> 8) << 8; }
        tot[128] = rb; }
    __syncthreads();
    if (F.wg == 0) { const int nt = tot[128] >> 8; if (F.tid == 0) META[0] = nt;
        if (F.tid < nt) { int e = 0;
#pragma clang loop unroll(disable) vectorize(disable)
            for (int q = 1; q < 32; ++q) if (tot[64 + q] <= F.tid * 256) e = q;
            META[16 + F.tid] = e; } }
    for (int r0 = F.wg * 128; r0 < NTOK; r0 += F.G * 128) {
        if (F.tid < 256) { const int tok = r0 + (F.tid >> 1), slot = F.tid & 1; const int e = EID[2 * tok + slot];
            const int pos = (int)__hip_atomic_fetch_add((LAS unsigned*)&tot[96 + e], 1u, __ATOMIC_RELAXED, __HIP_MEMORY_SCOPE_WORKGROUP);
            const int sr = tot[64 + e] + tot[32 + e] + pos;
            ROWMAP[sr] = tok; CWROW[sr] = EW[2 * tok + slot]; SROW[2 * tok + slot] = sr; } }
    if (F.wg < 32) { const int e = F.wg; const int lo = tot[64 + e] + tot[e], hi = tot[64 + e] + (((tot[e] + 255) >> 8) << 8);
        for (int r = lo + F.tid; r < hi; r += 512) { ROWMAP[r] = 0; CWROW[r] = 0.f; } }
}
__device__ __forceinline__ void phase_ln2(Frame& F, int l) {
    GAS bf16* HB = (GAS bf16*)(F.ws + WS_HB); const GAS int* SROW = (const GAS int*)(F.ws + WS_SROW); const GAS bf16* FF2 = (const GAS bf16*)(F.ws + WS_FF2);
    const GAS float* g = ((const GAS float*)F.in[26]) + l * DM; const GAS float* bb = ((const GAS float*)F.in[27]) + l * DM; int lane = F.lane; asm volatile("" : "+v"(lane));
    const int gw = F.wg * 8 + F.wave, NGW = F.G * 8; const bool last = (l == DEPTH - 1);
    int m = gw;
    u32x4 hn[2], an[2], cn[2];
    if (m < NTOK) { const int s0 = ld_i32(SROW + 2 * m), s1 = ld_i32(SROW + 2 * m + 1);
#pragma unroll
        for (int j = 0; j < 2; ++j) { hn[j] = *(const GAS u32x4*)(HB + (size_t)m * DM + 8 * lane + 512 * j); an[j] = *(const GAS u32x4*)(FF2 + (size_t)s0 * DM + 8 * lane + 512 * j); cn[j] = *(const GAS u32x4*)(FF2 + (size_t)s1 * DM + 8 * lane + 512 * j); } }
#pragma unroll 1
    for (; m < NTOK; m += NGW) {
        float v[16];
#pragma unroll
        for (int j = 0; j < 2; ++j) { const u32x4 h = hn[j], a = an[j], c = cn[j];
            v[8 * j] = bflo(h.x) * DN_ALPHA + (bflo(a.x) + bflo(c.x)); v[8 * j + 1] = bfhi(h.x) * DN_ALPHA + (bfhi(a.x) + bfhi(c.x)); v[8 * j + 2] = bflo(h.y) * DN_ALPHA + (bflo(a.y) + bflo(c.y)); v[8 * j + 3] = bfhi(h.y) * DN_ALPHA + (bfhi(a.y) + bfhi(c.y));
            v[8 * j + 4] = bflo(h.z) * DN_ALPHA + (bflo(a.z) + bflo(c.z)); v[8 * j + 5] = bfhi(h.z) * DN_ALPHA + (bfhi(a.z) + bfhi(c.z)); v[8 * j + 6] = bflo(h.w) * DN_ALPHA + (bflo(a.w) + bflo(c.w)); v[8 * j + 7] = bfhi(h.w) * DN_ALPHA + (bfhi(a.w) + bfhi(c.w)); }
        const int mn = m + NGW;
        if (mn < NTOK) { const int s0 = ld_i32(SROW + 2 * mn), s1 = ld_i32(SROW + 2 * mn + 1);
#pragma unroll
            for (int j = 0; j < 2; ++j) { hn[j] = *(const GAS u32x4*)(HB + (size_t)mn * DM + 8 * lane + 512 * j); an[j] = *(const GAS u32x4*)(FF2 + (size_t)s0 * DM + 8 * lane + 512 * j); cn[j] = *(const GAS u32x4*)(FF2 + (size_t)s1 * DM + 8 * lane + 512 * j); } }
        float s = 0.f;
#pragma unroll
        for (int i = 0; i < 16; ++i) s += v[i];
        const float mean = wave_sum(s, lane) * (1.f / DM); float s2 = 0.f;
#pragma unroll
        for (int i = 0; i < 16; ++i) { v[i] -= mean; s2 += v[i] * v[i]; }
        const float rstd = 1.f / sqrtf(wave_sum(s2, lane) * (1.f / DM) + LN_EPS);
#pragma unroll
        for (int j = 0; j < 2; ++j) { const int c = 8 * lane + 512 * j; const f32x4 g0 = *(const GAS f32x4*)(g + c), g1 = *(const GAS f32x4*)(g + c + 4), b0 = *(const GAS f32x4*)(bb + c), b1 = *(const GAS f32x4*)(bb + c + 4);
#pragma unroll
            for (int i = 0; i < 4; ++i) { v[8 * j + i] = v[8 * j + i] * rstd * g0[i] + b0[i]; v[8 * j + 4 + i] = v[8 * j + 4 + i] * rstd * g1[i] + b1[i]; }
            if (last) { *(GAS f32x4*)(F.H + (size_t)m * DM + c) = (f32x4){v[8 * j], v[8 * j + 1], v[8 * j + 2], v[8 * j + 3]}; *(GAS f32x4*)(F.H + (size_t)m * DM + c + 4) = (f32x4){v[8 * j + 4], v[8 * j + 5], v[8 * j + 6], v[8 * j + 7]}; }
            else { u32x4 wv; wv.x = pk2(v[8 * j], v[8 * j + 1]); wv.y = pk2(v[8 * j + 2], v[8 * j + 3]); wv.z = pk2(v[8 * j + 4], v[8 * j + 5]); wv.w = pk2(v[8 * j + 6], v[8 * j + 7]); *(GAS u32x4*)(HB + (size_t)m * DM + c) = wv; } }
    }
}

#ifndef EN_P
#define EN_P 1
#endif
#ifndef EN_A
#define EN_A 1
#endif
#ifndef EN_B
#define EN_B 1
#endif
#ifndef EN_C
#define EN_C 1
#endif
#ifndef EN_D
#define EN_D 1
#endif
#ifndef EN_E
#define EN_E 1
#endif
#ifndef EN_F
#define EN_F 1
#endif
#ifndef EN_G
#define EN_G 1
#endif
#ifndef EN_H
#define EN_H 1
#endif
#ifndef EN_I
#define EN_I 1
#endif
#ifndef EN_J
#define EN_J 1
#endif
constexpr int PPL = 12;
constexpr int N_PHASES = 1 + PPL * DEPTH;
#ifndef MK_ONE_LAUNCH
#define MK_ONE_LAUNCH 0
#endif
struct Args { const float* in[28]; float* out; unsigned char* ws; int ph_lo, ph_hi; };
static_assert(sizeof(Args) == 28 * 8 + 8 + 8 + 8, "no padding bytes in the argument struct");


__device__ __forceinline__ unsigned opaque_u32(unsigned x) { unsigned v; asm volatile("v_mov_b32 %0, %1" : "=v"(v) : "s"(x)); return (unsigned)__builtin_amdgcn_readfirstlane((int)v); }
__device__ __forceinline__ unsigned long long opaque_u64(unsigned long long x) { return ((unsigned long long)opaque_u32((unsigned)(x >> 32)) << 32) | opaque_u32((unsigned)x); }
__device__ __forceinline__ void launder(Frame& F) {
    F.ws = (GAS unsigned char*)opaque_u64((unsigned long long)F.ws); F.H = (GAS float*)opaque_u64((unsigned long long)F.H);
    F.ctl = (gu32*)opaque_u64((unsigned long long)F.ctl);
    unsigned z0 = 0u; asm volatile("" : "+v"(z0)); int ln = (int)__builtin_amdgcn_mbcnt_hi(~0u, __builtin_amdgcn_mbcnt_lo(~0u, z0));
    F.wave = (int)opaque_u32((unsigned)F.wave); F.lane = ln; F.tid = F.wave * 64 + ln;
    F.G = (int)opaque_u32((unsigned)F.G); F.wg = (int)opaque_u32((unsigned)F.wg);
}
__global__ void __launch_bounds__(512, 2) mk_fwd(Args args) {
    extern __shared__ __attribute__((aligned(16))) unsigned char lds_raw[];
    Frame F;
    F.lds = (LAS unsigned char*)lds_raw;
    F.MISC = (volatile LAS unsigned*)(F.lds + MISC_OFF);
    F.tid = threadIdx.x; F.lane = F.tid & 63; F.wave = __builtin_amdgcn_readfirstlane(F.tid >> 6);
    F.G = gridDim.x; F.wg = blockIdx.x;
    F.in = args.in;
    F.pos = (const GAS int*)args.in[1];
    F.H = (GAS float*)args.out; F.ws = (GAS unsigned char*)args.ws;
    F.ctl = (gu32*)(args.ws + WS_CTL);
    for (int u = F.tid; u < (LDS_BYTES - MISC_OFF) / 4; u += 512) ((LAS unsigned*)(F.lds + MISC_OFF))[u] = 0u;
    __syncthreads();
    const int lo = args.ph_lo, hi = args.ph_hi;
    const bool multi = (hi - lo) > 1;
    XcdBarrier bar; bar.bar = (unsigned*)(F.ctl + CW_BAR); bar.x = 0; bar.st = nullptr;
    if (multi) bar = xcd_barrier_post((unsigned*)(F.ctl + CW_BAR), F.MISC + 8);
#define IN(k) (lo <= (k) && (k) < hi)
#define SEAM(k) do { if (IN(k) && IN((k) + 1)) xcd_barrier(bar); } while (0)

#ifdef DUP_P
    for (int rep = 0; rep < 2; ++rep)
#endif
    if (EN_P && IN(0)) { launder(F); phase_prologue(F); }
    SEAM(0);
#define HB ((GAS bf16*)(F.ws + WS_HB))
#define PA ((GAS bf16*)(F.ws + WS_PA))
#define Y ((GAS bf16*)(F.ws + WS_Y))
#define HM ((GAS bf16*)F.H + (size_t)NTOK * DM)
#define TT ((GAS bf16*)F.H)
    for (int l = 0; l < DEPTH; ++l) {
        const int pb = 1 + PPL * l;
#define wd (F.ws + WS_WDENSE + (size_t)l * WD_LAYER)
#ifdef DUP_A
        for (int rep = 0; rep < 2; ++rep)
#endif
        if (EN_A && IN(pb + 0)) { launder(F);
            DenseSched S; S.init(NTOK / 256, NPA / 256, F.G, F.wg, (const void*)HB, (size_t)256 * DM * 2, (const void*)(wd + WD_WA), (size_t)256 * DM * 2);
            EpiA E{PA, (GAS bf16*)(F.ws + WS_KA), (GAS bf16*)(F.ws + WS_VA), (GAS bf16*)(F.ws + WS_KI), (GAS float*)(F.ws + WS_WI), (GAS float*)(F.ws + WS_GLR), (const GAS float*)(F.ws + WS_ROPE), ((const GAS float*)F.in[5]) + l * 64};
            pg8::gemm_phase<EpiA, DenseSched, false>(F.lds, S, E, DM, DM, F.wave);
        }
        SEAM(pb + 0);
        if (EN_B && IN(pb + 1)) { launder(F); phase_mixer(F, l);
#ifdef DUP_B
            launder(F); phase_mixer(F, l, 1, DUP_B);
#endif
        }
        SEAM(pb + 1);
        if (EN_B && IN(pb + 2)) { launder(F); gla_scan_phase(F); }
        SEAM(pb + 2);
        if (EN_B && IN(pb + 3)) { launder(F); phase_gla_out(F, l); }
        SEAM(pb + 3);
#ifdef DUP_D
        for (int rep = 0; rep < 2; ++rep)
#endif
        if (EN_D && IN(pb + 4)) { launder(F);
            DenseSched S; S.init(NTOK / 256, DM / 256, F.G, F.wg, (const void*)Y, (size_t)256 * 1536 * 2, (const void*)(wd + WD_WBR), (size_t)256 * 512 * 2);
            S.nsub = 3; S.asub = 512 * 2; S.bsub = (size_t)1024 * 512 * 2;
            EpiP E{PA};
            pg8::gemm_phase<EpiP, DenseSched, false>(F.lds, S, E, 512, 1536, F.wave);
        }
#ifdef DUP_C
        for (int rep = 0; rep < 2; ++rep)
#endif
        if (EN_C && IN(pb + 4)) { launder(F);
            DenseSched S; S.init(NTOK / 256, DM / 256, F.G, F.wg, (const void*)HB, (size_t)256 * DM * 2, (const void*)(wd + WD_WG), (size_t)256 * DM * 2);
            S.nsub = 3; S.asub = 0; S.bsub = (size_t)1024 * DM * 2;
            EpiGM E{PA, HM};
            pg8::gemm_phase<EpiGM, DenseSched, false>(F.lds, S, E, DM, DM, F.wave);
        }
        SEAM(pb + 4);
        if (EN_E && IN(pb + 6)) { launder(F);
            DenseSched S; S.init(NTOK / 256, DM / 256, F.G, F.wg, (const void*)HM, (size_t)256 * DM * 2, (const void*)(wd + WD_WOUT), (size_t)256 * DM * 2);
            EpiO E{HB, TT};
            pg8::gemm_phase<EpiO, DenseSched, false>(F.lds, S, E, DM, DM, F.wave);
        }
        SEAM(pb + 6);
        if (EN_F && IN(pb + 7)) { launder(F); phase_ln_router(F, l); }
        SEAM(pb + 7);
        if (EN_G && IN(pb + 8)) { launder(F);
            { LAS float* scr = (LAS float*)(F.lds + F.wave * 16384); const int gw = F.wg * 8 + F.wave, NGW = F.G * 8;
              for (int it = gw; it < 12288; it += NGW) conv_moe_item(F, l, it, scr);
              __syncthreads(); }
            phase_dispatch(F); }
        SEAM(pb + 8);
#ifdef DUP_H
        for (int rep = 0; rep < 2; ++rep)
#endif
        if (EN_H && IN(pb + 9)) { launder(F);
            const GAS int* META = (const GAS int*)(F.ws + WS_META); const GAS int* ROWMAP = (const GAS int*)(F.ws + WS_ROWMAP);
            const int NT = ld_i32(META), NU = NT * 2;
            LAS int* meta = (LAS int*)(F.lds + AUX_OFF); LAS int* rows = (LAS int*)(F.lds + AUX_OFF + 64);
            for (int i = 0; i * F.G + F.wg < NU && i < 8; ++i) { const int L = i * F.G + F.wg, gt = L >> 1;
                if (F.tid == 0) meta[i] = ld_i32(META + 16 + gt);
                if (F.tid < 256) rows[i * 256 + F.tid] = ROWMAP[gt * 256 + F.tid]; }
            __syncthreads();
            GroupSched S{NU, F.G, F.wg, 2, (const char*)HB, (const char*)(F.ws + WS_WMOE + WM_GU), 0, (size_t)512 * DM * 2, (size_t)256 * DM * 2, meta, rows};
            EpiGU E{(GAS bf16*)(F.ws + WS_HID), (const GAS float*)(F.ws + WS_CWROW)};
            pg8::gemm_phase<EpiGU, GroupSched, true>(F.lds, S, E, DM, DM, F.wave);
        }
        SEAM(pb + 9);
#ifdef DUP_I
        for (int rep = 0; rep < 2; ++rep)
#endif
        if (EN_I && IN(pb + 10)) { launder(F);
            const GAS int* META = (const GAS int*)(F.ws + WS_META);
            const int NT = ld_i32(META), NU = NT * 4;
            LAS int* meta = (LAS int*)(F.lds + AUX_OFF);
            for (int i = 0; i * F.G + F.wg < NU && i < 8; ++i) { const int L = i * F.G + F.wg, gt = L >> 2; if (F.tid == 0) meta[i] = ld_i32(META + 16 + gt); }
            __syncthreads();
            GroupSched S{NU, F.G, F.wg, 4, (const char*)(F.ws + WS_HID), (const char*)(F.ws + WS_WMOE + WM_DN), (size_t)256 * DEXP * 2, (size_t)DM * DEXP * 2, (size_t)256 * DEXP * 2, meta, nullptr};
            EpiDN E{(GAS bf16*)(F.ws + WS_FF2)};
            pg8::gemm_phase<EpiDN, GroupSched, false>(F.lds, S, E, DEXP, DEXP, F.wave);
        }
        SEAM(pb + 10);
        if (EN_J && IN(pb + 11)) { launder(F); phase_ln2(F, l); }
        SEAM(pb + 11);
    }
#undef IN
#undef SEAM
#undef HB
#undef HM
#undef TT
#undef PA
#undef Y
#undef wd
}


#ifdef DUMP_OFF
__global__ void dump_k(const unsigned short* src, float* out) {
    for (size_t i = (size_t)blockIdx.x * blockDim.x + threadIdx.x; i < (size_t)NTOK * 1024; i += (size_t)gridDim.x * blockDim.x) { const size_t n = i >> 10, c = i & 1023; out[i] = __builtin_bit_cast(float, ((unsigned)src[n * DUMP_PITCH + c]) << 16); }
}
#endif
extern "C" void kernel_launch(void* const* d_in, const int* in_sizes, int n_in, void* d_out, int out_size, void* d_ws, size_t ws_size, hipStream_t stream) {
    static int grid = 0;
    if (grid == 0) {
        if (n_in != 28 || out_size != NTOK * DM || ws_size < WS_END) { fprintf(stderr, "kernel_launch: unexpected shapes (n_in %d out %d ws %zu); nothing launched\n", n_in, out_size, ws_size); grid = -1; return; }
        int dev = 0, cus = 0;
        if (hipGetDevice(&dev) != hipSuccess || hipDeviceGetAttribute(&cus, hipDeviceAttributeMultiprocessorCount, dev) != hipSuccess) { grid = -1; return; }
        if (hipFuncSetAttribute((const void*)mk_fwd, hipFuncAttributeMaxDynamicSharedMemorySize, LDS_BYTES) != hipSuccess) { fprintf(stderr, "kernel_launch: hipFuncSetAttribute failed\n"); grid = -1; return; }
        int per_cu = 0;
        if (hipOccupancyMaxActiveBlocksPerMultiprocessor(&per_cu, (const void*)mk_fwd, 512, LDS_BYTES) != hipSuccess || per_cu < 1) { fprintf(stderr, "kernel_launch: occupancy query says %d\n", per_cu); }
        (void)hipGetLastError();
        grid = cus;
        if (grid != 256) fprintf(stderr, "kernel_launch: %d CUs (built for 256)\n", grid);
    }
    if (grid < 0) return;
    if (hipMemsetAsync((char*)d_ws + WS_CTL, 0, CTL_ZERO_BYTES, stream) != hipSuccess) return;
    Args a{};
    for (int i = 0; i < 28; ++i) a.in[i] = (const float*)d_in[i];
    a.out = (float*)d_out; a.ws = (unsigned char*)d_ws;
#if MK_ONE_LAUNCH
    a.ph_lo = 0; a.ph_hi = N_PHASES;
    hipLaunchKernelGGL(mk_fwd, dim3(grid), dim3(512), LDS_BYTES, stream, a);
#else
#ifndef STOP_AFTER
#define STOP_AFTER (N_PHASES - 1)
#endif
#ifndef PHASE_MASK
#define PHASE_MASK 0xffffffffu
#endif
    for (int p = 0; p <= STOP_AFTER; ++p) { if (!((PHASE_MASK >> p) & 1u)) continue; a.ph_lo = p; a.ph_hi = p + 1; hipLaunchKernelGGL(mk_fwd, dim3(grid), dim3(512), LDS_BYTES, stream, a); }
#ifdef DUMP_OFF
    hipLaunchKernelGGL(dump_k, dim3(2048), dim3(256), 0, stream, (const unsigned short*)((const char*)d_ws + (size_t)(DUMP_OFF)), (float*)d_out);
#endif
#endif
}
```

```cpp
#define MK_ONE_LAUNCH 1
#include <hip/hip_runtime.h>
#include <cstdio>
#include <cstdint>

#define LAS __attribute__((address_space(3)))
#define GAS __attribute__((address_space(1)))
typedef unsigned short bf16;
typedef short bf16x8 __attribute__((ext_vector_type(8)));
typedef float f32x4 __attribute__((ext_vector_type(4)));
typedef float f32x2 __attribute__((ext_vector_type(2)));
typedef unsigned u32x4 __attribute__((ext_vector_type(4)));
typedef unsigned u32x2 __attribute__((ext_vector_type(2)));
typedef GAS unsigned gu32;

constexpr int NB = 8, SEQ = 4096, NTOK = NB * SEQ, DM = 1024, NIN = 6612, DEPTH = 2;
constexpr int NPA = 3584;
constexpr int NGT = 3072;
constexpr int NEXP = 32, DEXP = 256;
constexpr int MAXTILES = 288;
constexpr float DN_ALPHA = 1.41421356237309515f;
constexpr float LN_EPS = 1e-5f, RMS_EPS = 1e-6f;
constexpr int PA_Q = 0, PA_QI = 768, PA_BQ = 1024, PA_BK = 1280, PA_BV = 1536, PA_BR = 2048, PA_CU = 2560, PA_CV = 3072;

__device__ __forceinline__ unsigned f2bf(float f) { unsigned u = __builtin_bit_cast(unsigned, f); return (u + 0x7fffu + ((u >> 16) & 1u)) >> 16; }
__device__ __forceinline__ unsigned pk2(float lo, float hi) { return f2bf(lo) | (f2bf(hi) << 16); }
__device__ __forceinline__ float bflo(unsigned w) { return __builtin_bit_cast(float, w << 16); }
__device__ __forceinline__ float bfhi(unsigned w) { return __builtin_bit_cast(float, w & 0xffff0000u); }
__device__ __forceinline__ float bf1(bf16 h) { return __builtin_bit_cast(float, ((unsigned)h) << 16); }
typedef __bf16 bf16x2_t __attribute__((ext_vector_type(2)));
__device__ __forceinline__ unsigned cvt_pk_bf16(float lo, float hi) { const f32x2 v = {lo, hi}; const bf16x2_t b = __builtin_convertvector(v, bf16x2_t); return __builtin_bit_cast(unsigned, b); }
__device__ __forceinline__ float shx(float v, int mask, int lane) { return __builtin_bit_cast(float, __builtin_amdgcn_ds_bpermute((lane ^ mask) << 2, __builtin_bit_cast(int, v))); }
__device__ __forceinline__ int shxi(int v, int mask, int lane) { return __builtin_amdgcn_ds_bpermute((lane ^ mask) << 2, v); }
__device__ __forceinline__ float wave_sum(float v, int lane) {
#pragma unroll
    for (int o = 1; o < 64; o <<= 1) v += shx(v, o, lane);
    return v;
}
__device__ __forceinline__ float wave_max(float v, int lane) {
#pragma unroll
    for (int o = 1; o < 64; o <<= 1) v = fmaxf(v, shx(v, o, lane));
    return v;
}
__device__ __forceinline__ int wave_sum_i(int v, int lane) {
#pragma unroll
    for (int o = 1; o < 64; o <<= 1) v += shxi(v, o, lane);
    return v;
}
__device__ __forceinline__ int fresh_lane() { unsigned z0 = 0u; asm volatile("" : "+v"(z0)); return (int)__builtin_amdgcn_mbcnt_hi(~0u, __builtin_amdgcn_mbcnt_lo(~0u, z0)); }
__device__ __forceinline__ int ld_i32(const GAS int* p) { return __hip_atomic_load(p, __ATOMIC_RELAXED, __HIP_MEMORY_SCOPE_AGENT); }
__device__ __forceinline__ float ld_f32(const GAS float* p) { return __hip_atomic_load(p, __ATOMIC_RELAXED, __HIP_MEMORY_SCOPE_AGENT); }
__device__ __forceinline__ float sigmoidf_(float x) { return __builtin_amdgcn_rcpf(1.0f + __expf(-x)); }
__device__ __forceinline__ float siluf_(float x) { return x * sigmoidf_(x); }
__device__ __forceinline__ float gelu_tanh_(float x) { const float u = 0.7978845608028654f * (x + 0.044715f * x * x * x); return x * sigmoidf_(2.0f * u); }

namespace pg8 {
constexpr int BM = 256, BK = 64, HALF = 128, HTB = HALF * BK * 2, STAGE_BYTES = 8 * HTB;
__host__ __device__ __forceinline__ int lds_byte(int r, int c) { const int st = (r >> 4) * 2 + (c >> 5), rr = r & 15, cc = c & 31, ob = rr * 64 + cc * 2; return st * 1024 + (ob ^ (((ob >> 9) & 1) << 5)); }
__host__ __device__ __forceinline__ void stage_rc(int b, int& R, int& C) { const int st = b / 1024, sb = b % 1024, swz = sb ^ (((sb >> 9) & 1) << 5); R = (st >> 1) * 16 + swz / 64; C = (st & 1) * 32 + (swz % 64) / 2; }
__host__ __device__ __forceinline__ int perm32(int rho) { const int n = rho >> 4, i = rho & 15; return 8 * (i >> 2) + 4 * n + (i & 3); }

struct Unit { int pm, pn, e, slot; };

#ifndef PG8_ALIGN
#define PG8_ALIGN true
#endif
template <class Epi, class Sched, bool GATHER, bool ALIGN_EPI = PG8_ALIGN>
__device__ __forceinline__ void gemm_phase(LAS unsigned char* lds, const Sched& S, const Epi& E, const int K, const int lda, const int wave) {
    unsigned z0_ = 0u; asm volatile("" : "+v"(z0_)); const int lane_ = (int)__builtin_amdgcn_mbcnt_hi(~0u, __builtin_amdgcn_mbcnt_lo(~0u, z0_));
    const int wid = wave, lane = lane_, tid = wid * 64 + lane, wr = wid >> 2, wc = wid & 3, fr = lane & 15, fq = lane >> 4;
    const int nt = K / BK;
    int Rr[2], Cc[2];
    unsigned voffB[2];
#pragma unroll
    for (int i = 0; i < 2; ++i) { int R, C; stage_rc(tid * 16 + i * 8192, R, C); Rr[i] = R; Cc[i] = C; const int Rb = Epi::PERM ? ((R & ~31) + perm32(R & 31)) : R; voffB[i] = (unsigned)(Rb * K + C) * 2u; }
    const size_t kstep = (size_t)(BK * 2);
    const size_t hstepB = (size_t)HALF * K * 2;
    const unsigned ldsw = (unsigned)wid * 1024u;
    const int aoff = lds_byte(wr * 64 + fr, fq * 8), boff = lds_byte(wc * 32 + fr, fq * 8);
#define PG8_SA(b, h) (((b) * 2 + (h)) * HTB)
#define PG8_SB(b, h) ((4 + (b) * 2 + (h)) * HTB)
#define PG8_STAGE(bufoff, gbase, voff) do { _Pragma("unroll") for (int _i = 0; _i < 2; ++_i) \
        __builtin_amdgcn_global_load_lds((const unsigned*)((const char*)(gbase) + (voff)[_i]), (LAS unsigned*)(lds + (bufoff) + ldsw + _i * 8192), 16, 0, 0); } while (0)
#define PG8_LDA(dst, b, h) do { _Pragma("unroll") for (int m = 0; m < 4; ++m) _Pragma("unroll") for (int k = 0; k < 2; ++k) dst[m][k] = *(const LAS bf16x8*)(lds + PG8_SA(b, h) + aoff + m * 2048 + k * 1024); } while (0)
#define PG8_LDB(dst, b, h) do { _Pragma("unroll") for (int n = 0; n < 2; ++n) _Pragma("unroll") for (int k = 0; k < 2; ++k) dst[n][k] = *(const LAS bf16x8*)(lds + PG8_SB(b, h) + boff + n * 2048 + k * 1024); } while (0)
#define PG8_MMA(ai, bj, At, Bt) do { __builtin_amdgcn_s_setprio(1); _Pragma("unroll") for (int m = 0; m < 4; ++m) _Pragma("unroll") for (int n = 0; n < 2; ++n) _Pragma("unroll") for (int k = 0; k < 2; ++k) \
        acc[ai][bj][m][n] = __builtin_amdgcn_mfma_f32_16x16x32_bf16(Bt[n][k], At[m][k], acc[ai][bj][m][n], 0, 0, 0); __builtin_amdgcn_s_setprio(0); } while (0)
#define PG8_WAIT_V(n) asm volatile("s_waitcnt vmcnt(" #n ")" ::: "memory")
#define PG8_WAIT_L(n) asm volatile("s_waitcnt lgkmcnt(" #n ")" ::: "memory")
#define PG8_BAR do { asm volatile("" ::: "memory"); __builtin_amdgcn_s_barrier(); asm volatile("" ::: "memory"); } while (0)
#define PG8_SCHED __builtin_amdgcn_sched_barrier(0)
    Unit cur, nxt; int ui = 0;
    if (!S.next(0, cur)) return;
    f32x4 acc[2][2][4][2];
#pragma unroll
    for (int a = 0; a < 2; ++a)
#pragma unroll
        for (int b = 0; b < 2; ++b)
#pragma unroll
            for (int m = 0; m < 4; ++m)
#pragma unroll
                for (int n = 0; n < 2; ++n) acc[a][b][m][n] = (f32x4){0.f, 0.f, 0.f, 0.f};
    bf16x8 At[4][2], B0[2][2], B1[2][2];
    unsigned cA0[2], cA1[2], nA0[2], nA1[2];
#pragma unroll
    for (int i = 0; i < 2; ++i) {
        if (GATHER) { cA0[i] = (unsigned)(S.row_of(cur, Rr[i]) * lda + Cc[i]) * 2u; cA1[i] = (unsigned)(S.row_of(cur, HALF + Rr[i]) * lda + Cc[i]) * 2u; }
        else { cA0[i] = (unsigned)(Rr[i] * lda + Cc[i]) * 2u; cA1[i] = (unsigned)((HALF + Rr[i]) * lda + Cc[i]) * 2u; }
        nA0[i] = cA0[i]; nA1[i] = cA1[i];
    }
    const char* cA = S.a_base(cur); const char* cB = S.b_base(cur);
    PG8_STAGE(PG8_SB(0, 0), cB, voffB); PG8_STAGE(PG8_SB(0, 1), cB + hstepB, voffB); PG8_STAGE(PG8_SA(0, 0), cA, cA0); PG8_STAGE(PG8_SA(0, 1), cA, cA1);
    if (wr == 1) PG8_BAR;
    PG8_WAIT_V(2); PG8_BAR;
    PG8_STAGE(PG8_SB(1, 0), cB + kstep, voffB); PG8_STAGE(PG8_SA(1, 0), cA + kstep, cA0); PG8_STAGE(PG8_SB(1, 1), cB + hstepB + kstep, voffB);
    PG8_WAIT_V(6); PG8_BAR;
    for (;;) {
        const bool has_next = S.next(ui + 1, nxt);
        const char* nA = has_next ? S.a_base(nxt) : cA; const char* nB = has_next ? S.b_base(nxt) : cB;
        if (GATHER) {
#pragma unroll
            for (int i = 0; i < 2; ++i) {
                if (has_next) { nA0[i] = (unsigned)(S.row_of(nxt, Rr[i]) * lda + Cc[i]) * 2u; nA1[i] = (unsigned)(S.row_of(nxt, HALF + Rr[i]) * lda + Cc[i]) * 2u; }
                else { nA0[i] = cA0[i]; nA1[i] = cA1[i]; }
            }
        }
#pragma unroll 1
        for (int t = 0; t < nt; t += 2) {
            const bool last = (t == nt - 2);
            const char* a1 = cA + (size_t)(t + 1) * kstep;
            const char* a2 = last ? nA : cA + (size_t)(t + 2) * kstep; const char* b2 = last ? nB : cB + (size_t)(t + 2) * kstep;
            const char* a3 = a2 + kstep; const char* b3 = b2 + kstep;
            unsigned x0[2], x1[2];
#pragma unroll
            for (int i = 0; i < 2; ++i) { x0[i] = (GATHER && last) ? nA0[i] : cA0[i]; x1[i] = (GATHER && last) ? nA1[i] : cA1[i]; }
            PG8_LDB(B0, 0, 0); PG8_LDB(B1, 0, 1); PG8_SCHED; PG8_LDA(At, 0, 0); PG8_STAGE(PG8_SA(1, 1), a1, cA1);
            PG8_WAIT_V(8); PG8_WAIT_L(0); PG8_BAR; PG8_MMA(0, 0, At, B0); PG8_MMA(0, 1, At, B1); PG8_BAR; PG8_SCHED;
            PG8_LDA(At, 0, 1); PG8_STAGE(PG8_SB(0, 0), b2, voffB); PG8_STAGE(PG8_SB(0, 1), b2 + hstepB, voffB); PG8_STAGE(PG8_SA(0, 0), a2, x0);
            PG8_WAIT_V(8); PG8_WAIT_L(0); PG8_BAR; PG8_MMA(1, 0, At, B0); PG8_MMA(1, 1, At, B1); PG8_BAR; PG8_SCHED;
            PG8_LDB(B0, 1, 0); PG8_LDB(B1, 1, 1); PG8_SCHED; PG8_LDA(At, 1, 0); PG8_STAGE(PG8_SA(0, 1), a2, x1);
            PG8_WAIT_V(8); PG8_WAIT_L(0); PG8_BAR; PG8_MMA(0, 0, At, B0); PG8_MMA(0, 1, At, B1); PG8_BAR; PG8_SCHED;
            PG8_LDA(At, 1, 1); PG8_STAGE(PG8_SB(1, 0), b3, voffB); PG8_STAGE(PG8_SB(1, 1), b3 + hstepB, voffB); PG8_STAGE(PG8_SA(1, 0), a3, x0);
            PG8_WAIT_V(8); PG8_WAIT_L(0); PG8_BAR; PG8_MMA(1, 0, At, B0); PG8_MMA(1, 1, At, B1); PG8_BAR; PG8_SCHED;
        }
        if (ALIGN_EPI) { if (wr == 0) PG8_BAR; }
        E(acc, cur, wr, wc, fr, fq);
        if (!has_next) break;
#pragma unroll
        for (int a = 0; a < 2; ++a)
#pragma unroll
            for (int b = 0; b < 2; ++b)
#pragma unroll
                for (int m = 0; m < 4; ++m)
#pragma unroll
                    for (int n = 0; n < 2; ++n) acc[a][b][m][n] = (f32x4){0.f, 0.f, 0.f, 0.f};
        cur = nxt; cA = nA; cB = nB; ++ui;
#pragma unroll
        for (int i = 0; i < 2; ++i) { cA0[i] = nA0[i]; cA1[i] = nA1[i]; }
        if (ALIGN_EPI) { if (wr == 1) PG8_BAR; }
    }
    PG8_WAIT_V(0);
    if (!ALIGN_EPI) { if (wr == 0) PG8_BAR; }
    PG8_BAR;
#undef PG8_SA
#undef PG8_SB
#undef PG8_STAGE
#undef PG8_LDA
#undef PG8_LDB
#undef PG8_MMA
#undef PG8_WAIT_V
#undef PG8_WAIT_L
#undef PG8_BAR
#undef PG8_SCHED
}
}

#define XB_TMO      128
#define XB_XCNT(j)  (256  + 64 * (j))
#define XB_XSUB(j)  (1280 + 64 * (j))
#define XB_XGEN(j)  (2304 + 64 * (j))
#define XB_TOP      3328
#define XB_TOPGEN   3392
#define XCD_BAR_WORDS 3456
#define XB_SPIN_CAP (1u << 20)

__device__ __forceinline__ unsigned xb_ld(unsigned* p)              { return __hip_atomic_load(p, __ATOMIC_RELAXED, __HIP_MEMORY_SCOPE_AGENT); }
__device__ __forceinline__ unsigned xb_add(unsigned* p, unsigned v) { return __hip_atomic_fetch_add(p, v, __ATOMIC_RELAXED, __HIP_MEMORY_SCOPE_AGENT); }
__device__ __forceinline__ unsigned xb_xcc_id() { return (unsigned)__builtin_amdgcn_s_getreg((3 << 11) | 20) & 0xFu; }
#define XB_SPIN(cond, bar) do { unsigned _sp = 0; while (cond) { __builtin_amdgcn_s_sleep(1); \
    if ((++_sp & 255u) == 0u) { if (xb_ld(&(bar)[XB_TMO])) break; if (_sp > XB_SPIN_CAP) { atomicAdd(&(bar)[XB_TMO], 1u); break; } } } } while (0)

struct XcdBarrier { unsigned* bar; unsigned x; volatile LAS unsigned* st; };

__device__ __forceinline__ XcdBarrier xcd_barrier_post(unsigned* bar, volatile LAS unsigned* st) {
    XcdBarrier b; b.bar = bar; b.x = xb_xcc_id(); b.st = st;
    if (threadIdx.x == 0) (void)xb_add(&bar[XB_XCNT(b.x)], 1u);
    return b;
}
__device__ __forceinline__ void xcd_barrier_complete(unsigned* bar, unsigned x, unsigned& nloc, unsigned& nx) {
    const unsigned G = gridDim.x * gridDim.y * gridDim.z;
    unsigned sum, cnt, mine, sp = 0u;
    for (;;) {
        sum = 0u; cnt = 0u; mine = 0u;
#pragma unroll
        for (unsigned j = 0; j < 16; ++j) { const unsigned c = xb_ld(&bar[XB_XCNT(j)]); sum += c; cnt += (c > 0u) ? 1u : 0u; mine = (j == x) ? c : mine; }
        if (sum == G) break;
        __builtin_amdgcn_s_sleep(1);
        if ((++sp & 255u) == 0u) { if (xb_ld(&bar[XB_TMO])) break; if (sp > XB_SPIN_CAP) { atomicAdd(&bar[XB_TMO], 1u); break; } }
    }
    nloc = mine > 0u ? mine : 1u; nx = cnt > 0u ? cnt : 1u;
}
__device__ __forceinline__ void xcd_barrier(const XcdBarrier& b) {
    asm volatile("s_waitcnt vmcnt(0)" ::: "memory");
    __syncthreads();
    if (threadIdx.x == 0) {
        unsigned* bar = b.bar;
        __builtin_amdgcn_s_waitcnt(0);
        unsigned nloc = b.st[0], nx = b.st[1];
        if (nloc == 0u) { xcd_barrier_complete(bar, b.x, nloc, nx); b.st[0] = nloc; b.st[1] = nx; }
        const unsigned old = xb_add(&bar[XB_XSUB(b.x)], 1u);
        const unsigned gen = old / nloc;
        if (old + 1u == (gen + 1u) * nloc) {
            __builtin_amdgcn_fence(__ATOMIC_RELEASE, "agent");
            asm volatile("s_waitcnt vmcnt(0)" ::: "memory");
            const unsigned og = xb_add(&bar[XB_TOP], 1u);
            const unsigned tg = og / nx;
            if (og + 1u == (tg + 1u) * nx) xb_add(&bar[XB_TOPGEN], 1u);
            else XB_SPIN(xb_ld(&bar[XB_TOPGEN]) == tg, bar);
            __builtin_amdgcn_fence(__ATOMIC_ACQUIRE, "agent");
            xb_add(&bar[XB_XGEN(b.x)], 1u);
            asm volatile("s_waitcnt vmcnt(0)" ::: "memory");
        } else {
            XB_SPIN(xb_ld(&bar[XB_XGEN(b.x)]) == gen, bar);
            __builtin_amdgcn_fence(__ATOMIC_ACQUIRE, "agent");
            asm volatile("s_waitcnt vmcnt(0)" ::: "memory");
        }
    }
    __syncthreads();
}

constexpr size_t MiB = 1u << 20;
constexpr size_t WS_CTL = 0, CTL_ZERO_BYTES = 1 * MiB;
constexpr size_t WS_ROPE = 1 * MiB;
constexpr size_t WS_WI   = 3 * MiB;
constexpr size_t WS_ROUTE = 3 * MiB + 512 * 1024;
constexpr size_t WS_SROW = 4 * MiB;
constexpr size_t WS_ROWMAP = 4 * MiB + 256 * 1024;
constexpr size_t WS_CWROW = 4 * MiB + 640 * 1024;
constexpr size_t WS_CNTWG = 5 * MiB;
constexpr size_t WS_META = 5 * MiB + 64 * 1024;
constexpr size_t WS_WR = 5 * MiB + 128 * 1024;
constexpr size_t WS_GLR = 6 * MiB;
constexpr size_t WS_WDENSE = 8 * MiB;
constexpr size_t WD_WA = 0, WD_WG = 7 * MiB, WD_WBR = 13 * MiB, WD_WOUT = 16 * MiB, WD_LAYER = 18 * MiB;
constexpr size_t WS_WMOE = 44 * MiB;
constexpr size_t WM_GU = 0, WM_DN = 32 * MiB;
constexpr size_t WS_HB = 92 * MiB;
constexpr size_t WS_PA = 156 * MiB;
constexpr size_t WS_HID = WS_PA;
constexpr size_t WS_FF2 = WS_PA + 40 * MiB;
constexpr size_t WS_Y = 380 * MiB;
constexpr size_t WS_KA = 476 * MiB, WS_VA = 480 * MiB, WS_KI = 484 * MiB;
constexpr size_t WS_END = 512 * MiB;
static_assert(WS_WDENSE + 2 * WD_LAYER <= WS_WMOE && WS_WMOE + 48 * MiB <= WS_HB && WS_HB + 64 * MiB <= WS_PA && WS_PA + 224 * MiB <= WS_Y && WS_Y + 96 * MiB <= WS_KA && WS_KI + 4 * MiB <= WS_END, "ws map");
static_assert(WS_FF2 + (size_t)73728 * 1024 * 2 <= WS_Y, "ff2 fits");
constexpr int CW_BAR = 4096;
constexpr int CW_QUEUE = 16384;

constexpr int RING_BYTES = 131072;
constexpr int AUX_OFF = 131072;
constexpr int MISC_OFF = 147456;
constexpr int LDS_BYTES = 148480;

struct Frame {
    LAS unsigned char* lds;
    volatile LAS unsigned* MISC;
    gu32* ctl;
    int tid, lane, wave, G, wg;
    const float* const* in;
    const GAS int* pos;
    GAS float* H;
    GAS unsigned char* ws;
};

#define LDS_WAIT() asm volatile("s_waitcnt lgkmcnt(0)" ::: "memory")
#define VM_WAIT() asm volatile("s_waitcnt vmcnt(0)" ::: "memory")

__device__ __forceinline__ int pa_src_col(int c) {
    if (c < 512) return c;
    if (c < 768) { const int x = c - 512, half = x >> 7, y = x & 127, grp = y >> 5, d = (y & 31) + 32 * half;
        if (grp == 0) return 512 + d;
        if (grp == 1) return 576 + d;
        if (grp == 2) return 896 + d;
        if (half == 0) { const int z = y - 96; if (z < 4) return 960 + z; if (z < 20) return 1988 + (z - 4); }
        return -1; }
    if (c < 1024) return 640 + (c - 768);
    if (c < 1280) return 964 + (c - 1024);
    if (c < 1536) return 1220 + (c - 1280);
    if (c < 2048) return 1476 + (c - 1536);
    if (c < 2560) return 2004 + (c - 2048);
    return 2516 + (c - 2560);
}
__device__ __forceinline__ void transpose_item(const GAS float* W, int ldw, int K, GAS bf16* WT, int n0, int k0, int sc, LAS float* scr, int lane) {
#pragma unroll 8
    for (int i = 0; i < 32; ++i) { const int kk = 2 * i + (lane >> 5); scr[kk * 33 + (lane & 31)] = (sc >= 0) ? W[(size_t)(k0 + kk) * ldw + sc] : 0.f; }
    LDS_WAIT(); asm volatile("" ::: "memory");
    const int c = lane & 7;
#pragma unroll
    for (int j = 0; j < 4; ++j) { const int n = (lane >> 3) + 8 * j; const LAS float* s = scr + (8 * c) * 33 + n;
        u32x4 o; o.x = pk2(s[0 * 33], s[1 * 33]); o.y = pk2(s[2 * 33], s[3 * 33]); o.z = pk2(s[4 * 33], s[5 * 33]); o.w = pk2(s[6 * 33], s[7 * 33]);
        *(GAS u32x4*)(WT + (size_t)(n0 + n) * K + k0 + 8 * c) = o; }
    LDS_WAIT(); asm volatile("" ::: "memory");
}
__device__ __forceinline__ void conv_dense_item(Frame& F, int l, int it, LAS float* scr) {
    GAS bf16* base = (GAS bf16*)(F.ws + WS_WDENSE + (size_t)l * WD_LAYER);
    const int lane = F.lane;
    if (it < 1792) { const int kb = it / 112, nb = it % 112; const int sc = pa_src_col(32 * nb + (lane & 31));
        transpose_item(((const GAS float*)F.in[4]) + (size_t)l * DM * NIN, NIN, DM, base + WD_WA / 2, 32 * nb, 64 * kb, sc, scr, lane); return; }
    it -= 1792;
    if (it < 1536) { const int kb = it / 96, nb = it % 96; const int sc = 3540 + 32 * nb + (lane & 31);
        transpose_item(((const GAS float*)F.in[4]) + (size_t)l * DM * NIN, NIN, DM, base + WD_WG / 2, 32 * nb, 64 * kb, sc, scr, lane); return; }
    it -= 1536;
    if (it < 768) { const int br = it / 256, r = it % 256, kb = r / 32, nb = r % 32; const int sc = 32 * nb + (lane & 31);
        transpose_item((br == 0 ? ((const GAS float*)F.in[13]) : br == 1 ? ((const GAS float*)F.in[14]) : ((const GAS float*)F.in[15])) + (size_t)l * 512 * DM, DM, 512, base + WD_WBR / 2 + (size_t)br * 1024 * 512, 32 * nb, 64 * kb, sc, scr, lane); return; }
    it -= 768;
    { const int kb = it / 32, nb = it % 32; const int sc = 32 * nb + (lane & 31);
        transpose_item(((const GAS float*)F.in[16]) + (size_t)l * DM * DM, DM, DM, base + WD_WOUT / 2, 32 * nb, 64 * kb, sc, scr, lane); }
}
__device__ __forceinline__ void conv_moe_item(Frame& F, int l, int it, LAS float* scr) {
    const int lane = F.lane; const int e = it / 384; int r = it % 384;
    if (r < 256) { const int sub = r / 64, q = r % 64, ct = sub >> 1, bj = sub & 1, kb = q / 4, nb = q % 4;
        const GAS float* src = (bj ? ((const GAS float*)F.in[24]) : ((const GAS float*)F.in[23])) + (size_t)(l * NEXP + e) * DM * DEXP;
        GAS bf16* dst = (GAS bf16*)(F.ws + WS_WMOE + WM_GU) + (size_t)e * 512 * DM;
        transpose_item(src, DEXP, DM, dst, 256 * ct + 128 * bj + 32 * nb, 64 * kb, 128 * ct + 32 * nb + (lane & 31), scr, lane); return; }
    r -= 256;
    { const int kb = r / 32, nb = r % 32;
        const GAS float* src = ((const GAS float*)F.in[25]) + (size_t)(l * NEXP + e) * DEXP * DM;
        GAS bf16* dst = (GAS bf16*)(F.ws + WS_WMOE + WM_DN) + (size_t)e * DM * DEXP;
        transpose_item(src, DM, DEXP, dst, 32 * nb, 64 * kb, 32 * nb + (lane & 31), scr, lane); }
}

__device__ __forceinline__ void ln_row_regs(f32x4 (&v)[4], const GAS float* g, const GAS float* b, int lane) {
    float s = 0.f;
#pragma unroll
    for (int j = 0; j < 4; ++j) s += (v[j].x + v[j].y) + (v[j].z + v[j].w);
    const float mean = wave_sum(s, lane) * (1.f / DM); float s2 = 0.f;
#pragma unroll
    for (int j = 0; j < 4; ++j) { v[j] = v[j] - mean; s2 += (v[j].x * v[j].x + v[j].y * v[j].y) + (v[j].z * v[j].z + v[j].w * v[j].w); }
    const float rstd = 1.f / sqrtf(wave_sum(s2, lane) * (1.f / DM) + LN_EPS);
#pragma unroll
    for (int j = 0; j < 4; ++j) { const f32x4 gg = *(const GAS f32x4*)(g + 4 * lane + 256 * j), bb = *(const GAS f32x4*)(b + 4 * lane + 256 * j); v[j] = v[j] * rstd * gg + bb; }
}
__device__ __forceinline__ void store_row_f32_bf16(const f32x4 (&v)[4], GAS float* hrow, GAS bf16* brow, int lane) {
#pragma unroll
    for (int j = 0; j < 4; ++j) {
        if (hrow) *(GAS f32x4*)(hrow + 4 * lane + 256 * j) = v[j];
        if (brow) { u32x2 w; w.x = pk2(v[j].x, v[j].y); w.y = pk2(v[j].z, v[j].w); *(GAS u32x2*)(brow + 4 * lane + 256 * j) = w; }
    }
}

__device__ __forceinline__ void phase_prologue(Frame& F) {
    LAS float* scr = (LAS float*)(F.lds + F.wave * 16384);
    const int gw = F.wg * 8 + F.wave, NGW = F.G * 8;
    for (int it = gw; it < 2 * 4608; it += NGW) conv_dense_item(F, it / 4608, it % 4608, scr);
    { GAS bf16* WRB = (GAS bf16*)(F.ws + WS_WR);
      for (int i = gw * 64 + F.lane; i < DEPTH * 48 * DM; i += NGW * 64) { const int l = i / (48 * DM), r = i % (48 * DM), o = r / DM, k = r % DM;
          const float v = (o < 4) ? ((const GAS float*)F.in[19])[(size_t)l * DM * 4 + k * 4 + o] : (o < 36) ? ((const GAS float*)F.in[21])[(size_t)l * DM * 32 + k * 32 + (o - 4)] : 0.f;
          WRB[i] = (bf16)f2bf(v); } }
    { GAS float* RT = (GAS float*)(F.ws + WS_ROPE);
      for (int i = gw * 64 + F.lane; i < NTOK * 8; i += NGW * 64) { const int n = i >> 3, j = i & 7;
          const float invf[8] = {1.000000000e+00f, 1.939227432e-01f, 3.760603070e-02f, 7.292664610e-03f, 1.414213562e-03f, 2.742481884e-04f, 5.318295734e-05f, 1.031338525e-05f};
          float inv = invf[0];
#pragma unroll
          for (int q = 1; q < 8; ++q) inv = (j == q) ? invf[q] : inv;
          const float ang = (float)F.pos[n] * inv;
          const double kq = __builtin_rint((double)ang * 0.15915494309189535);
          double r = (double)ang - kq * 6.283185307179586; double csign = 1.0;
          if (r > 1.5707963267948966) { r = 3.141592653589793 - r; csign = -1.0; } else if (r < -1.5707963267948966) { r = -3.141592653589793 - r; csign = -1.0; }
          const double x2 = r * r;
          const double sn = r * (1.0 + x2 * (-1.0 / 6 + x2 * (1.0 / 120 + x2 * (-1.0 / 5040 + x2 * (1.0 / 362880 + x2 * (-1.0 / 39916800 + x2 * (1.0 / 6227020800.0 + x2 * (-1.0 / 1307674368000.0))))))));
          const double cs = 1.0 + x2 * (-0.5 + x2 * (1.0 / 24 + x2 * (-1.0 / 720 + x2 * (1.0 / 40320 + x2 * (-1.0 / 3628800 + x2 * (1.0 / 479001600.0 + x2 * (-1.0 / 87178291200.0 + x2 * (1.0 / 20922789888000.0))))))));
          RT[n * 16 + j] = (float)(csign * cs); RT[n * 16 + 8 + j] = (float)sn; } }
    GAS bf16* HB = (GAS bf16*)(F.ws + WS_HB);
    for (int m = gw; m < NTOK; m += NGW) { f32x4 v[4];
#pragma unroll
        for (int j = 0; j < 4; ++j) v[j] = *(const GAS f32x4*)(((const GAS float*)F.in[0]) + (size_t)m * DM + 4 * F.lane + 256 * j);
        ln_row_regs(v, ((const GAS float*)F.in[2]), ((const GAS float*)F.in[3]), F.lane);
        store_row_f32_bf16(v, (GAS float*)nullptr, HB + (size_t)m * DM, F.lane); }
}

struct DenseSched {
    int nM, nN, nwg, G, c; const char* A; const char* B; size_t atile, btile; int nsub = 1; size_t asub = 0, bsub = 0;
    __device__ void init(int nM_, int nN_, int G_, int c_, const void* A_, size_t atile_, const void* B_, size_t btile_) { nM = nM_; nN = nN_; nwg = nM * nN; G = G_; c = c_; A = (const char*)A_; B = (const char*)B_; atile = atile_; btile = btile_; }
    __device__ __forceinline__ bool next(int i, pg8::Unit& u) const {
        const int it = i / nsub, sb = i - it * nsub;
        const long L = (long)it * G + c; if (L >= nwg) return false;
        int wgid = (int)L; { const int q = nwg / 8, r = nwg % 8, xcd = wgid % 8, off = wgid / 8; wgid = (xcd < r ? xcd * (q + 1) : r * (q + 1) + (xcd - r) * q) + off; }
        const int nig = 8 * nN, gid = wgid / nig, fm = gid * 8, gsz = (nM - fm) < 8 ? (nM - fm) : 8;
        u.pm = fm + ((wgid % nig) % gsz); u.pn = (wgid % nig) / gsz; u.e = sb; u.slot = i; return true;
    }
    __device__ __forceinline__ const char* a_base(const pg8::Unit& u) const { return A + (size_t)u.pm * atile + (size_t)u.e * asub; }
    __device__ __forceinline__ const char* b_base(const pg8::Unit& u) const { return B + (size_t)u.pn * btile + (size_t)u.e * bsub; }
    __device__ __forceinline__ int row_of(const pg8::Unit&, int) const { return 0; }
};
struct GroupSched {
    int NU, G, c, ncol; const char* A; const char* B; size_t atile, erows_bytes, btile; const LAS int* meta; const LAS int* rows;
    __device__ __forceinline__ bool next(int i, pg8::Unit& u) const {
        const int L = i * G + c; if (L >= NU) return false;
        u.pm = L / ncol; u.pn = L % ncol; u.slot = i; u.e = meta[i]; return true;
    }
    __device__ __forceinline__ const char* a_base(const pg8::Unit& u) const { return A + (size_t)u.pm * atile; }
    __device__ __forceinline__ const char* b_base(const pg8::Unit& u) const { return B + (size_t)u.e * erows_bytes + (size_t)u.pn * btile; }
    __device__ __forceinline__ int row_of(const pg8::Unit& u, int r) const { return rows[u.slot * 256 + r]; }
};

struct EpiA {
    static constexpr bool PERM = true;
    GAS bf16* PA; GAS bf16* KA; GAS bf16* VA; GAS bf16* KI; GAS float* WI; GAS float* GLR; const GAS float* ROPE; const GAS float* ikg;
    __device__ __forceinline__ static void rope8(float (&x)[8], const GAS float* rt, int fq, int lane) {
        const f32x4 c0 = *(const GAS f32x4*)(rt), c1 = *(const GAS f32x4*)(rt + 4), s0 = *(const GAS f32x4*)(rt + 8), s1 = *(const GAS f32x4*)(rt + 12);
#pragma unroll
        for (int i = 0; i < 8; ++i) { const float p = shx(x[i], 16, lane); const float cc = (i < 4) ? c0[i & 3] : c1[i & 3], ss = (i < 4) ? s0[i & 3] : s1[i & 3];
            const float r = x[i] * cc + ((fq == 0) ? -p : p) * ss; x[i] = (fq < 2) ? r : x[i]; }
    }
    __device__ __forceinline__ static u32x4 pack8(const float (&x)[8]) { u32x4 w; w.x = cvt_pk_bf16(x[0], x[1]); w.y = cvt_pk_bf16(x[2], x[3]); w.z = cvt_pk_bf16(x[4], x[5]); w.w = cvt_pk_bf16(x[6], x[7]); return w; }
    __device__ __forceinline__ void operator()(const f32x4 (&acc)[2][2][4][2], const pg8::Unit& u, int wr, int wc, int fr, int fq) const {
        const int pn = u.pn; const int rowb = u.pm * 256 + wr * 64 + fr; const int lane = fq * 16 + fr;
        if (pn == 2) {
#pragma unroll
            for (int ai = 0; ai < 2; ++ai)
#pragma unroll
                for (int m = 0; m < 4; ++m) {
                    const int row = rowb + ai * 128 + m * 16;
                    float x0[8], x1[8];
#pragma unroll
                    for (int i = 0; i < 8; ++i) { x0[i] = acc[ai][0][m][i >> 2][i & 3]; x1[i] = acc[ai][1][m][i >> 2][i & 3]; }
                    if (wc == 2) {
                        float s = 0.f;
#pragma unroll
                        for (int i = 0; i < 8; ++i) s += x0[i] + x1[i];
                        s += shx(s, 16, lane); s += shx(s, 32, lane);
                        const float mean = s * (1.f / 64.f); float q = 0.f;
#pragma unroll
                        for (int i = 0; i < 8; ++i) { x0[i] -= mean; x1[i] -= mean; q += x0[i] * x0[i] + x1[i] * x1[i]; }
                        q += shx(q, 16, lane); q += shx(q, 32, lane);
                        const float rstd = 1.f / sqrtf(q * (1.f / 64.f) + LN_EPS);
#pragma unroll
                        for (int i = 0; i < 8; ++i) { x0[i] = x0[i] * rstd * ikg[8 * fq + i]; x1[i] = x1[i] * rstd * ikg[32 + 8 * fq + i]; }
                    }
                    if (wc == 0 || wc == 2) rope8(x0, ROPE + (size_t)row * 16, fq, lane);
                    if (wc < 3) {
                        GAS bf16* dst = (wc == 0) ? KA : (wc == 1) ? VA : KI;
                        *(GAS u32x4*)(dst + (size_t)row * 64 + 8 * fq) = pack8(x0); *(GAS u32x4*)(dst + (size_t)row * 64 + 32 + 8 * fq) = pack8(x1);
                    } else {
                        if (fq == 0) { *(GAS f32x4*)(WI + (size_t)row * 4) = (f32x4){x0[0], x0[1], x0[2], x0[3]} * 0.0625f; *(GAS f32x4*)(GLR + (size_t)row * 16) = (f32x4){x0[4], x0[5], x0[6], x0[7]}; }
                        else if (fq == 1) { *(GAS f32x4*)(GLR + (size_t)row * 16 + 4) = (f32x4){x0[0], x0[1], x0[2], x0[3]}; *(GAS f32x4*)(GLR + (size_t)row * 16 + 8) = (f32x4){x0[4], x0[5], x0[6], x0[7]}; }
                        else if (fq == 2) { *(GAS f32x4*)(GLR + (size_t)row * 16 + 12) = (f32x4){x0[0], x0[1], x0[2], x0[3]}; }
                    }
                    asm volatile("" ::: "memory");
                }
        } else if (pn < 2 || pn == 3) {
            const float sc = (pn == 3) ? 1.0f : 0.125f; const bool rope = !(wc & 1);
#pragma unroll
            for (int ai = 0; ai < 2; ++ai)
#pragma unroll
                for (int m = 0; m < 4; ++m) {
                    const int row = rowb + ai * 128 + m * 16;
#pragma unroll
                    for (int bj = 0; bj < 2; ++bj) { float x[8];
#pragma unroll
                        for (int i = 0; i < 8; ++i) x[i] = acc[ai][bj][m][i >> 2][i & 3];
                        if (rope) rope8(x, ROPE + (size_t)row * 16, fq, lane);
#pragma unroll
                        for (int i = 0; i < 8; ++i) x[i] *= sc;
                        *(GAS u32x4*)(PA + (size_t)row * NPA + 256 * pn + 128 * bj + 32 * wc + 8 * fq) = pack8(x); }
                    asm volatile("" ::: "memory");
                }
        } else {
            const int act = (pn == 8 || pn == 9) ? 1 : (pn >= 10) ? 2 : 0; const float sc = (pn == 4) ? 0.125f : 1.0f;
#pragma unroll
            for (int ai = 0; ai < 2; ++ai)
#pragma unroll
                for (int m = 0; m < 4; ++m) {
                    const int row = rowb + ai * 128 + m * 16;
#pragma unroll
                    for (int bj = 0; bj < 2; ++bj) { float x[8];
#pragma unroll
                        for (int i = 0; i < 8; ++i) { const float v = acc[ai][bj][m][i >> 2][i & 3]; x[i] = (act == 1) ? siluf_(v) : (act == 2) ? gelu_tanh_(v) : v * sc; }
                        *(GAS u32x4*)(PA + (size_t)row * NPA + 256 * pn + 128 * bj + 32 * wc + 8 * fq) = pack8(x); }
                    asm volatile("" ::: "memory");
                }
        }
    }
};
struct EpiPlainA {
    static constexpr bool PERM = true;
    GAS bf16* PA;
    __device__ __forceinline__ void operator()(const f32x4 (&acc)[2][2][4][2], const pg8::Unit& u, int wr, int wc, int fr, int fq) const {
        const int rowb = u.pm * 256 + wr * 64 + fr;
#pragma unroll
        for (int ai = 0; ai < 2; ++ai)
#pragma unroll
            for (int m = 0; m < 4; ++m) { const int row = rowb + ai * 128 + m * 16;
#pragma unroll
                for (int bj = 0; bj < 2; ++bj) { u32x4 w; w.x = cvt_pk_bf16(acc[ai][bj][m][0][0], acc[ai][bj][m][0][1]); w.y = cvt_pk_bf16(acc[ai][bj][m][0][2], acc[ai][bj][m][0][3]);
                    w.z = cvt_pk_bf16(acc[ai][bj][m][1][0], acc[ai][bj][m][1][1]); w.w = cvt_pk_bf16(acc[ai][bj][m][1][2], acc[ai][bj][m][1][3]);
                    *(GAS u32x4*)(PA + (size_t)row * NPA + 256 * u.pn + 128 * bj + 32 * wc + 8 * fq) = w; } }
    }
};
struct EpiP {
    static constexpr bool PERM = true;
    GAS bf16* P;
    __device__ __forceinline__ void operator()(const f32x4 (&acc)[2][2][4][2], const pg8::Unit& u, int wr, int wc, int fr, int fq) const {
        const int rowb = u.pm * 256 + wr * 64 + fr; GAS bf16* Pb = P + (size_t)u.e * NTOK * DM;
#pragma unroll
        for (int ai = 0; ai < 2; ++ai)
#pragma unroll
            for (int m = 0; m < 4; ++m) { const int row = rowb + ai * 128 + m * 16;
#pragma unroll
                for (int bj = 0; bj < 2; ++bj) { u32x4 w; w.x = cvt_pk_bf16(acc[ai][bj][m][0][0], acc[ai][bj][m][0][1]); w.y = cvt_pk_bf16(acc[ai][bj][m][0][2], acc[ai][bj][m][0][3]);
                    w.z = cvt_pk_bf16(acc[ai][bj][m][1][0], acc[ai][bj][m][1][1]); w.w = cvt_pk_bf16(acc[ai][bj][m][1][2], acc[ai][bj][m][1][3]);
                    *(GAS u32x4*)(Pb + (size_t)row * DM + 256 * u.pn + 128 * bj + 32 * wc + 8 * fq) = w; } }
    }
};
struct EpiGM {
    static constexpr bool PERM = true;
    const GAS bf16* P; GAS bf16* HM;
    __device__ __forceinline__ void operator()(const f32x4 (&acc)[2][2][4][2], const pg8::Unit& u, int wr, int wc, int fr, int fq) const {
        const int rowb = u.pm * 256 + wr * 64 + fr; const int br = u.e; const GAS bf16* Pb = P + (size_t)br * NTOK * DM;
        const int colb = 256 * u.pn + 32 * wc + 8 * fq;
#pragma unroll
        for (int ai = 0; ai < 2; ++ai) {
            u32x4 pv[4][2], ov[4][2];
#pragma unroll
            for (int m = 0; m < 4; ++m)
#pragma unroll
                for (int bj = 0; bj < 2; ++bj) { const size_t off = (size_t)(rowb + ai * 128 + m * 16) * DM + colb + 128 * bj;
                    pv[m][bj] = *(const GAS u32x4*)(Pb + off); ov[m][bj] = (br > 0) ? *(const GAS u32x4*)(HM + off) : (u32x4){0u, 0u, 0u, 0u}; }
            __builtin_amdgcn_sched_barrier(0);
#pragma unroll
            for (int m = 0; m < 4; ++m)
#pragma unroll
                for (int bj = 0; bj < 2; ++bj) { const size_t off = (size_t)(rowb + ai * 128 + m * 16) * DM + colb + 128 * bj;
                    const u32x4 p = pv[m][bj], o = ov[m][bj];
                    float x[8];
                    x[0] = bflo(p.x) * sigmoidf_(acc[ai][bj][m][0][0]) + bflo(o.x); x[1] = bfhi(p.x) * sigmoidf_(acc[ai][bj][m][0][1]) + bfhi(o.x); x[2] = bflo(p.y) * sigmoidf_(acc[ai][bj][m][0][2]) + bflo(o.y); x[3] = bfhi(p.y) * sigmoidf_(acc[ai][bj][m][0][3]) + bfhi(o.y);
                    x[4] = bflo(p.z) * sigmoidf_(acc[ai][bj][m][1][0]) + bflo(o.z); x[5] = bfhi(p.z) * sigmoidf_(acc[ai][bj][m][1][1]) + bfhi(o.z); x[6] = bflo(p.w) * sigmoidf_(acc[ai][bj][m][1][2]) + bflo(o.w); x[7] = bfhi(p.w) * sigmoidf_(acc[ai][bj][m][1][3]) + bfhi(o.w);
                    u32x4 w; w.x = cvt_pk_bf16(x[0], x[1]); w.y = cvt_pk_bf16(x[2], x[3]); w.z = cvt_pk_bf16(x[4], x[5]); w.w = cvt_pk_bf16(x[6], x[7]);
                    *(GAS u32x4*)(HM + off) = w; }
            asm volatile("" ::: "memory");
        }
    }
};
struct EpiO {
    static constexpr bool PERM = true;
    const GAS bf16* HBr; GAS bf16* T;
    __device__ __forceinline__ void operator()(const f32x4 (&acc)[2][2][4][2], const pg8::Unit& u, int wr, int wc, int fr, int fq) const {
        const int rowb = u.pm * 256 + wr * 64 + fr; const int colb = 256 * u.pn + 32 * wc + 8 * fq;
#pragma unroll
        for (int ai = 0; ai < 2; ++ai) {
            u32x4 hv[4][2];
#pragma unroll
            for (int m = 0; m < 4; ++m)
#pragma unroll
                for (int bj = 0; bj < 2; ++bj) hv[m][bj] = *(const GAS u32x4*)(HBr + (size_t)(rowb + ai * 128 + m * 16) * DM + colb + 128 * bj);
            __builtin_amdgcn_sched_barrier(0);
#pragma unroll
            for (int m = 0; m < 4; ++m)
#pragma unroll
                for (int bj = 0; bj < 2; ++bj) { const u32x4 h = hv[m][bj];
                    u32x4 w; w.x = cvt_pk_bf16(bflo(h.x) * DN_ALPHA + acc[ai][bj][m][0][0], bfhi(h.x) * DN_ALPHA + acc[ai][bj][m][0][1]); w.y = cvt_pk_bf16(bflo(h.y) * DN_ALPHA + acc[ai][bj][m][0][2], bfhi(h.y) * DN_ALPHA + acc[ai][bj][m][0][3]);
                    w.z = cvt_pk_bf16(bflo(h.z) * DN_ALPHA + acc[ai][bj][m][1][0], bfhi(h.z) * DN_ALPHA + acc[ai][bj][m][1][1]); w.w = cvt_pk_bf16(bflo(h.w) * DN_ALPHA + acc[ai][bj][m][1][2], bfhi(h.w) * DN_ALPHA + acc[ai][bj][m][1][3]);
                    *(GAS u32x4*)(T + (size_t)(rowb + ai * 128 + m * 16) * DM + colb + 128 * bj) = w; }
            asm volatile("" ::: "memory");
        }
    }
};
struct EpiGU {
    static constexpr bool PERM = true;
    GAS bf16* HID; const GAS float* CW;
    __device__ __forceinline__ void operator()(const f32x4 (&acc)[2][2][4][2], const pg8::Unit& u, int wr, int wc, int fr, int fq) const {
        const int rowb = u.pm * 256 + wr * 64 + fr;
        float cwv[2][4];
#pragma unroll
        for (int ai = 0; ai < 2; ++ai)
#pragma unroll
            for (int m = 0; m < 4; ++m) cwv[ai][m] = CW[rowb + ai * 128 + m * 16];
#pragma unroll
        for (int ai = 0; ai < 2; ++ai)
#pragma unroll
            for (int m = 0; m < 4; ++m) { const int row = rowb + ai * 128 + m * 16; const float cw = cwv[ai][m];
                float x[8];
#pragma unroll
                for (int i = 0; i < 8; ++i) x[i] = siluf_(acc[ai][0][m][i >> 2][i & 3]) * acc[ai][1][m][i >> 2][i & 3] * cw;
                u32x4 w; w.x = cvt_pk_bf16(x[0], x[1]); w.y = cvt_pk_bf16(x[2], x[3]); w.z = cvt_pk_bf16(x[4], x[5]); w.w = cvt_pk_bf16(x[6], x[7]);
                *(GAS u32x4*)(HID + (size_t)row * DEXP + 128 * u.pn + 32 * wc + 8 * fq) = w; }
    }
};
struct EpiDN {
    static constexpr bool PERM = true;
    GAS bf16* FF2;
    __device__ __forceinline__ void operator()(const f32x4 (&acc)[2][2][4][2], const pg8::Unit& u, int wr, int wc, int fr, int fq) const {
        const int rowb = u.pm * 256 + wr * 64 + fr;
#pragma unroll
        for (int ai = 0; ai < 2; ++ai)
#pragma unroll
            for (int m = 0; m < 4; ++m) { const int row = rowb + ai * 128 + m * 16;
#pragma unroll
                for (int bj = 0; bj < 2; ++bj) { u32x4 w; w.x = cvt_pk_bf16(acc[ai][bj][m][0][0], acc[ai][bj][m][0][1]); w.y = cvt_pk_bf16(acc[ai][bj][m][0][2], acc[ai][bj][m][0][3]);
                    w.z = cvt_pk_bf16(acc[ai][bj][m][1][0], acc[ai][bj][m][1][1]); w.w = cvt_pk_bf16(acc[ai][bj][m][1][2], acc[ai][bj][m][1][3]);
                    *(GAS u32x4*)(FF2 + (size_t)row * DM + 256 * u.pn + 128 * bj + 32 * wc + 8 * fq) = w; } }
    }
};
#ifndef EN_B1
#define EN_B1 1
#endif
#ifndef EN_B2
#define EN_B2 1
#endif
#ifndef EN_B3
#define EN_B3 1
#endif

template <int CTRL> __device__ __forceinline__ float dppf(float x) { return __builtin_bit_cast(float, __builtin_amdgcn_mov_dpp(__builtin_bit_cast(int, x), CTRL, 0xf, 0xf, true)); }
template <int CTRL> __device__ __forceinline__ int dppi(int x) { return __builtin_amdgcn_mov_dpp(x, CTRL, 0xf, 0xf, true); }
typedef short v4i16_t __attribute__((ext_vector_type(4)));
typedef unsigned short u16x2 __attribute__((ext_vector_type(2)));
__device__ __forceinline__ v4i16_t ldtr(const LAS unsigned char* p) { return __builtin_amdgcn_ds_read_tr16_b64_v4i16((LAS v4i16_t*)p); }
__device__ __forceinline__ bf16x8 cat8(v4i16_t lo, v4i16_t hi) { bf16x8 r; r[0] = lo[0]; r[1] = lo[1]; r[2] = lo[2]; r[3] = lo[3]; r[4] = hi[0]; r[5] = hi[1]; r[6] = hi[2]; r[7] = hi[3]; return r; }
__device__ __forceinline__ int wave_total_i(int v) {
    v += dppi<0xB1>(v); v += dppi<0x4E>(v); v += dppi<0x141>(v); v += dppi<0x140>(v);
    return __builtin_amdgcn_readlane(v, 0) + __builtin_amdgcn_readlane(v, 16) + __builtin_amdgcn_readlane(v, 32) + __builtin_amdgcn_readlane(v, 48);
}
__device__ __forceinline__ void gmlp_unit(Frame& F, int l, int unit) {
    int tid = F.tid; asm volatile("" : "+v"(tid)); const int lane = tid & 63;
    const int chunk = unit >> 2, g = unit & 3, n0 = chunk * 128;
    const GAS bf16* PA = (const GAS bf16*)(F.ws + WS_PA); GAS bf16* Y = (GAS bf16*)(F.ws + WS_Y);
    LAS float* vln = (LAS float*)F.lds;
    LAS float* wl = (LAS float*)(F.lds + 65536);
    LAS float* st = (LAS float*)(F.lds + AUX_OFF);
    const GAS float* lng = ((const GAS float*)F.in[9]) + l * 512; const GAS float* lnb = ((const GAS float*)F.in[10]) + l * 512;
    for (int j = 0; j < 16; ++j) { const int s = F.wave * 16 + j;
        const u32x4 w = *(const GAS u32x4*)(PA + (size_t)(n0 + s) * NPA + PA_CV + 8 * lane);
        float x[8] = {bflo(w.x), bfhi(w.x), bflo(w.y), bfhi(w.y), bflo(w.z), bfhi(w.z), bflo(w.w), bfhi(w.w)};
        float sm = 0.f;
#pragma unroll
        for (int i = 0; i < 8; ++i) sm += x[i];
        const float mean = wave_sum(sm, lane) * (1.f / 512.f); float q = 0.f;
#pragma unroll
        for (int i = 0; i < 8; ++i) { const float d = x[i] - mean; q += d * d; }
        const float rstd = 1.f / sqrtf(wave_sum(q, lane) * (1.f / 512.f) + LN_EPS);
        if (lane == 0) { st[2 * s] = mean; st[2 * s + 1] = rstd; } }
    __syncthreads();
#pragma unroll
    for (int i = 0; i < 4; ++i) { const int q = tid + 512 * i, s = q >> 4, d0 = (q & 15) * 8;
        const u32x4 w = *(const GAS u32x4*)(PA + (size_t)(n0 + s) * NPA + PA_CV + g * 128 + d0);
        const float mean = st[2 * s], rstd = st[2 * s + 1];
        float x[8] = {bflo(w.x), bfhi(w.x), bflo(w.y), bfhi(w.y), bflo(w.z), bfhi(w.z), bflo(w.w), bfhi(w.w)};
#pragma unroll
        for (int k = 0; k < 8; ++k) x[k] = (x[k] - mean) * rstd * lng[g * 128 + d0 + k] + lnb[g * 128 + d0 + k];
        *(LAS f32x4*)(vln + s * 128 + d0) = (f32x4){x[0], x[1], x[2], x[3]}; *(LAS f32x4*)(vln + s * 128 + d0 + 4) = (f32x4){x[4], x[5], x[6], x[7]}; }
    const GAS float* ws = ((const GAS float*)F.in[11]) + ((size_t)l * 4 + g) * 128 * 128;
#pragma unroll
    for (int i = 0; i < 8; ++i) { const int q = tid + 512 * i, t = q >> 5, s0 = (q & 31) * 4;
        f32x4 w = *(const GAS f32x4*)(ws + t * 128 + s0);
        if (s0 + 0 > t) w.x = 0.f; if (s0 + 1 > t) w.y = 0.f; if (s0 + 2 > t) w.z = 0.f; if (s0 + 3 > t) w.w = 0.f;
        *(LAS f32x4*)(wl + t * 128 + s0) = w; }
    __syncthreads();
    const int d = tid & 127, tq = __builtin_amdgcn_readfirstlane(tid >> 7);
    float vr[128];
#pragma unroll
    for (int sb = 0; sb < 4; ++sb)
        if (sb <= tq) {
#pragma unroll
            for (int s = 0; s < 32; ++s) vr[sb * 32 + s] = vln[(sb * 32 + s) * 128 + d];
        } else {
#pragma unroll
            for (int s = 0; s < 32; ++s) vr[sb * 32 + s] = 0.f;
        }
    const GAS float* bs = ((const GAS float*)F.in[12]) + ((size_t)l * 4 + g) * 128;
#pragma unroll 1
    for (int ti = 0; ti < 32; ++ti) { const int t = tq * 32 + ti; float a = 0.f;
#pragma unroll
        for (int sb = 0; sb < 4; ++sb)
            if (sb <= tq) {
#pragma unroll
                for (int s4 = 0; s4 < 8; ++s4) { const f32x4 w = *(const LAS f32x4*)(wl + t * 128 + sb * 32 + s4 * 4);
                    a += w.x * vr[sb * 32 + s4 * 4] + w.y * vr[sb * 32 + s4 * 4 + 1] + w.z * vr[sb * 32 + s4 * 4 + 2] + w.w * vr[sb * 32 + s4 * 4 + 3]; }
            }
        const float uu = bf1(PA[(size_t)(n0 + t) * NPA + PA_CU + g * 128 + d]);
        Y[(size_t)(n0 + t) * 1536 + 1024 + g * 128 + d] = (bf16)f2bf(uu * (a + bs[t])); }
    __syncthreads();
}

__device__ __forceinline__ void gmlp16_unit(Frame& F, int l, int chunk) {
    const int lane = fresh_lane(), w = F.wave, tid = w * 64 + lane, fr = lane & 15, fq = lane >> 4;
    const size_t n0 = (size_t)chunk * 128;
    const GAS bf16* PA = (const GAS bf16*)(F.ws + WS_PA); GAS bf16* Y = (GAS bf16*)(F.ws + WS_Y);
    LAS unsigned char* VT = F.lds;
    LAS unsigned char* WT = F.lds + 32768;
    LAS float* st = (LAS float*)(F.lds + AUX_OFF);
    const GAS float* lng = ((const GAS float*)F.in[9]) + l * 512; const GAS float* lnb = ((const GAS float*)F.in[10]) + l * 512;
    for (int j = 0; j < 16; ++j) { const int s = w * 16 + j;
        const u32x4 x4 = *(const GAS u32x4*)(PA + (n0 + s) * NPA + PA_CV + 8 * lane);
        float x[8] = {bflo(x4.x), bfhi(x4.x), bflo(x4.y), bfhi(x4.y), bflo(x4.z), bfhi(x4.z), bflo(x4.w), bfhi(x4.w)};
        float sm = 0.f;
#pragma unroll
        for (int i = 0; i < 8; ++i) sm += x[i];
        const float mean = wave_sum(sm, lane) * (1.f / 512.f); float q = 0.f;
#pragma unroll
        for (int i = 0; i < 8; ++i) { const float d = x[i] - mean; q += d * d; }
        const float rstd = 1.f / sqrtf(wave_sum(q, lane) * (1.f / 512.f) + LN_EPS);
        if (lane == 0) { st[2 * s] = mean; st[2 * s + 1] = rstd; } }
    __syncthreads();
#pragma unroll 1
    for (int g = 0; g < 4; ++g) {
        const GAS float* ws = ((const GAS float*)F.in[11]) + ((size_t)l * 4 + g) * 128 * 128;
#pragma unroll
        for (int i = 0; i < 4; ++i) { const int q = tid + 512 * i, s = q >> 4, d0 = (q & 15) * 8;
            const u32x4 x4 = *(const GAS u32x4*)(PA + (n0 + s) * NPA + PA_CV + g * 128 + d0);
            const float mean = st[2 * s], rstd = st[2 * s + 1];
            float x[8] = {bflo(x4.x), bfhi(x4.x), bflo(x4.y), bfhi(x4.y), bflo(x4.z), bfhi(x4.z), bflo(x4.w), bfhi(x4.w)};
            const f32x4 g0 = *(const GAS f32x4*)(lng + g * 128 + d0), g1 = *(const GAS f32x4*)(lng + g * 128 + d0 + 4), b0 = *(const GAS f32x4*)(lnb + g * 128 + d0), b1 = *(const GAS f32x4*)(lnb + g * 128 + d0 + 4);
#pragma unroll
            for (int k = 0; k < 8; ++k) x[k] = (x[k] - mean) * rstd * ((k < 4) ? g0[k & 3] : g1[k & 3]) + ((k < 4) ? b0[k & 3] : b1[k & 3]);
            u32x4 o; o.x = cvt_pk_bf16(x[0], x[1]); o.y = cvt_pk_bf16(x[2], x[3]); o.z = cvt_pk_bf16(x[4], x[5]); o.w = cvt_pk_bf16(x[6], x[7]);
            *(LAS u32x4*)(VT + s * 256 + d0 * 2) = o;
            const int t = s, s0 = d0;
            f32x4 w0 = *(const GAS f32x4*)(ws + t * 128 + s0), w1 = *(const GAS f32x4*)(ws + t * 128 + s0 + 4);
            float wv[8] = {w0.x, w0.y, w0.z, w0.w, w1.x, w1.y, w1.z, w1.w};
#pragma unroll
            for (int k = 0; k < 8; ++k) wv[k] = (s0 + k <= t) ? wv[k] : 0.f;
            u32x4 ow; ow.x = cvt_pk_bf16(wv[0], wv[1]); ow.y = cvt_pk_bf16(wv[2], wv[3]); ow.z = cvt_pk_bf16(wv[4], wv[5]); ow.w = cvt_pk_bf16(wv[6], wv[7]);
            *(LAS u32x4*)(WT + t * 256 + s0 * 2) = ow; }
        __syncthreads();
        f32x4 acc[8];
#pragma unroll
        for (int nt = 0; nt < 8; ++nt) acc[nt] = (f32x4){0.f, 0.f, 0.f, 0.f};
        const int nks = (16 * w + 15) / 32 + 1;
#pragma unroll
        for (int ks = 0; ks < 4; ++ks) if (ks < nks) {
            const bf16x8 a = *(const LAS bf16x8*)(WT + (16 * w + fr) * 256 + (8 * fq + 32 * ks) * 2);
            const int srow = 32 * ks + 8 * fq + (fr >> 2);
#pragma unroll
            for (int nt = 0; nt < 8; ++nt) { const bf16x8 bv = cat8(ldtr(VT + srow * 256 + (16 * nt + 4 * (fr & 3)) * 2), ldtr(VT + (srow + 4) * 256 + (16 * nt + 4 * (fr & 3)) * 2));
                acc[nt] = __builtin_amdgcn_mfma_f32_16x16x32_bf16(bv, a, acc[nt], 0, 0, 0); } }
        const GAS float* bs = ((const GAS float*)F.in[12]) + ((size_t)l * 4 + g) * 128;
        { const int t = 16 * w + fr; const float bt = bs[t];
#pragma unroll
          for (int nt = 0; nt < 8; ++nt) { const int d0 = 16 * nt + 4 * fq;
              const u32x2 uu = *(const GAS u32x2*)(PA + (n0 + t) * NPA + PA_CU + g * 128 + d0);
              u32x2 wv; wv.x = pk2(bflo(uu.x) * (acc[nt][0] + bt), bfhi(uu.x) * (acc[nt][1] + bt)); wv.y = pk2(bflo(uu.y) * (acc[nt][2] + bt), bfhi(uu.y) * (acc[nt][3] + bt));
              *(GAS u32x2*)(Y + (n0 + t) * 1536 + 1024 + g * 128 + d0) = wv; } }
        __syncthreads();
    }
}

__device__ __forceinline__ void gla_unit(Frame& F, int l, int unit) {
    int tid = F.tid; asm volatile("" : "+v"(tid));
    const int b = unit >> 2, h = unit & 3;
    const GAS bf16* PA = (const GAS bf16*)(F.ws + WS_PA); GAS bf16* Y = (GAS bf16*)(F.ws + WS_Y); const GAS float* GLR = (const GAS float*)(F.ws + WS_GLR);
    LAS float* wa = (LAS float*)F.lds;
    LAS float* ba = wa + 1024;
    LAS float* as_ = ba + 64;
    LAS float* qs = as_ + 1024;
    LAS float* ks = qs + 1024;
    LAS float* vs = ks + 1024;
    LAS float* part = vs + 2048;
    for (int i = tid; i < 1024; i += 512) wa[i] = ((const GAS float*)F.in[6])[(size_t)l * 16 * 256 + (i >> 6) * 256 + h * 64 + (i & 63)];
    if (tid < 64) ba[tid] = ((const GAS float*)F.in[7])[l * 256 + h * 64 + tid];
    const GAS float* gng = ((const GAS float*)F.in[8]) + l * 128;
    const int v = tid & 127, kq = __builtin_amdgcn_readfirstlane(tid >> 7);
    float S[16];
#pragma unroll
    for (int j = 0; j < 16; ++j) S[j] = 0.f;
    __syncthreads();
    for (int t0 = 0; t0 < SEQ; t0 += 16) {
        const size_t nb = (size_t)b * SEQ + t0;
#pragma unroll
        for (int i = 0; i < 2; ++i) { const int e = tid + 512 * i, t = e >> 6, k = e & 63; float z = ba[k];
#pragma unroll
            for (int r = 0; r < 16; ++r) z += GLR[(nb + t) * 16 + r] * wa[r * 64 + k];
            const float ls = fminf(z, 0.f) - log1pf(__expf(-fabsf(z)));
            as_[e] = __expf(ls * (1.f / 16.f));
            qs[e] = bf1(PA[(nb + t) * NPA + PA_BQ + h * 64 + k]); ks[e] = bf1(PA[(nb + t) * NPA + PA_BK + h * 64 + k]); }
#pragma unroll
        for (int i = 0; i < 4; ++i) { const int e = tid + 512 * i, t = e >> 7, vv = e & 127; vs[e] = bf1(PA[(nb + t) * NPA + PA_BV + h * 128 + vv]); }
        __syncthreads();
#pragma unroll 4
        for (int t = 0; t < 16; ++t) { const float vt = vs[t * 128 + v]; float p = 0.f;
#pragma unroll
            for (int j4 = 0; j4 < 4; ++j4) { const f32x4 a4 = *(const LAS f32x4*)(as_ + t * 64 + kq * 16 + j4 * 4), k4 = *(const LAS f32x4*)(ks + t * 64 + kq * 16 + j4 * 4), q4 = *(const LAS f32x4*)(qs + t * 64 + kq * 16 + j4 * 4);
#pragma unroll
                for (int j = 0; j < 4; ++j) { S[j4 * 4 + j] = a4[j] * S[j4 * 4 + j] + k4[j] * vt; p += q4[j] * S[j4 * 4 + j]; } }
            part[(kq * 16 + t) * 128 + v] = p; }
        __syncthreads();
        { const int t = tid >> 5, v4 = (tid & 31) * 4;
          f32x4 o = *(const LAS f32x4*)(part + (0 * 16 + t) * 128 + v4);
#pragma unroll
          for (int q = 1; q < 4; ++q) o += *(const LAS f32x4*)(part + (q * 16 + t) * 128 + v4);
          float ss = o.x * o.x + o.y * o.y + o.z * o.z + o.w * o.w;
#pragma unroll
          for (int sh = 1; sh < 32; sh <<= 1) ss += shx(ss, sh, tid & 63);
          const float r = 1.f / sqrtf(ss * (1.f / 128.f) + RMS_EPS);
          const f32x4 gg = *(const GAS f32x4*)(gng + v4);
          const u32x2 brw = *(const GAS u32x2*)(PA + (nb + t) * NPA + PA_BR + h * 128 + v4);
          u32x2 w; w.x = pk2(o.x * r * gg.x * bflo(brw.x), o.y * r * gg.y * bfhi(brw.x)); w.y = pk2(o.z * r * gg.z * bflo(brw.y), o.w * r * gg.w * bfhi(brw.y));
          *(GAS u32x2*)(Y + (nb + t) * 1536 + 512 + h * 128 + v4) = w; }
        __syncthreads();
    }
}

constexpr size_t WS_US = WS_WMOE, WS_DEC = WS_WMOE + 32 * MiB;
__device__ __forceinline__ void gla_local_unit(Frame& F, int l, int unit) {
    const int lane = fresh_lane(), w = F.wave, tid = w * 64 + lane, fr = lane & 15, fq = lane >> 4;
    const int b = unit >> 8, h = (unit >> 6) & 3, c = unit & 63; const size_t n0 = (size_t)b * SEQ + 64 * c;
    GAS bf16* PA = (GAS bf16*)(F.ws + WS_PA); GAS bf16* Y = (GAS bf16*)(F.ws + WS_Y); const GAS float* GLR = (const GAS float*)(F.ws + WS_GLR);
    GAS bf16* US = (GAS bf16*)(F.ws + WS_US) + (size_t)unit * 8192; GAS float* DEC = (GAS float*)(F.ws + WS_DEC) + unit * 64;
    LAS unsigned char* QT = F.lds; LAS unsigned char* KT = F.lds + 8192; LAS unsigned char* KD = F.lds + 16384; LAS unsigned char* VV = F.lds + 24576; LAS unsigned char* ATT = F.lds + 40960;
    LAS float* SEG = (LAS float*)(F.lds + 65536); LAS float* WA = (LAS float*)(F.lds + 67584); LAS float* BA = (LAS float*)(F.lds + 71680); LAS float* GL = (LAS float*)(F.lds + 71936);
    const int k = tid & 63, seg = w;
    float qv8[8], kv8[8];
#pragma unroll
    for (int i = 0; i < 8; ++i) { const int t = 8 * seg + i; qv8[i] = bf1(PA[(n0 + t) * NPA + PA_BQ + h * 64 + k]); kv8[i] = bf1(PA[(n0 + t) * NPA + PA_BK + h * 64 + k]); }
    if (tid < 256) *(LAS f32x4*)(GL + 4 * tid) = *(const GAS f32x4*)(GLR + n0 * 16 + 4 * tid);
#pragma unroll
    for (int i = 0; i < 2; ++i) { const int e = tid + 512 * i; WA[e] = ((const GAS float*)F.in[6])[(size_t)l * 16 * 256 + (e >> 6) * 256 + h * 64 + (e & 63)]; }
    if (tid < 64) BA[tid] = ((const GAS float*)F.in[7])[l * 256 + h * 64 + tid];
#pragma unroll
    for (int i = 0; i < 2; ++i) { const int piece = tid + 512 * i, row = piece >> 4, c16 = piece & 15;
        *(LAS u32x4*)(VV + row * 256 + c16 * 16) = *(const GAS u32x4*)(PA + (n0 + row) * NPA + PA_BV + h * 128 + 8 * c16); }
    __syncthreads();
    float cum[8];
    { float run = 0.f;
#pragma unroll
      for (int i = 0; i < 8; ++i) { const int t = 8 * seg + i; float z = BA[k];
          const f32x4 g0 = *(const LAS f32x4*)(GL + t * 16), g1 = *(const LAS f32x4*)(GL + t * 16 + 4), g2 = *(const LAS f32x4*)(GL + t * 16 + 8), g3 = *(const LAS f32x4*)(GL + t * 16 + 12);
#pragma unroll
          for (int r = 0; r < 4; ++r) { z += g0[r] * WA[r * 64 + k]; z += g1[r] * WA[(4 + r) * 64 + k]; z += g2[r] * WA[(8 + r) * 64 + k]; z += g3[r] * WA[(12 + r) * 64 + k]; }
          const float ls = fminf(z, 0.f) - log1pf(__expf(-fabsf(z)));
          run += ls * (1.f / 16.f); cum[i] = run; }
      SEG[seg * 64 + k] = run; }
    __syncthreads();
    { float off = 0.f, blast = 0.f;
#pragma unroll
      for (int s2 = 0; s2 < 8; ++s2) { const float sv = SEG[s2 * 64 + k]; blast += sv; off += (s2 < seg) ? sv : 0.f; }
#pragma unroll
      for (int i = 0; i < 8; ++i) { const int t = 8 * seg + i; const float bb = cum[i] + off;
          const float qv = qv8[i], kv = kv8[i];
          const unsigned qt = f2bf(qv * __expf(bb));
          ((LAS unsigned short*)QT)[t * 64 + k] = (unsigned short)qt; ((LAS unsigned short*)KT)[t * 64 + k] = (unsigned short)f2bf(kv * __expf(-bb)); ((LAS unsigned short*)KD)[t * 64 + k] = (unsigned short)f2bf(kv * __expf(blast - bb));
          PA[(n0 + t) * NPA + PA_BQ + h * 64 + k] = (bf16)qt; }
      if (seg == 0) DEC[k] = __expf(blast); }
    __syncthreads();
#pragma unroll
    for (int ii = 0; ii < 2; ++ii) { const int id = 2 * w + ii, ts = id >> 2, tt = id & 3;
        f32x4 d = {0.f, 0.f, 0.f, 0.f};
        if (ts <= tt) {
#pragma unroll
            for (int ks = 0; ks < 2; ++ks) { const bf16x8 a = *(const LAS bf16x8*)(KT + (16 * ts + fr) * 128 + (8 * fq + 32 * ks) * 2), bq = *(const LAS bf16x8*)(QT + (16 * tt + fr) * 128 + (8 * fq + 32 * ks) * 2);
                d = __builtin_amdgcn_mfma_f32_16x16x32_bf16(a, bq, d, 0, 0, 0); } }
        const int t = 16 * tt + fr, s0 = 16 * ts + 4 * fq;
        u32x2 pk; pk.x = cvt_pk_bf16((s0 <= t) ? d[0] : 0.f, (s0 + 1 <= t) ? d[1] : 0.f); pk.y = cvt_pk_bf16((s0 + 2 <= t) ? d[2] : 0.f, (s0 + 3 <= t) ? d[3] : 0.f);
        *(LAS u32x2*)(ATT + t * 128 + s0 * 2) = pk; }
    __syncthreads();
    { const int tr = w & 3, nh = w >> 2;
      f32x4 ao[4], au[4];
#pragma unroll
      for (int j = 0; j < 4; ++j) { ao[j] = (f32x4){0.f, 0.f, 0.f, 0.f}; au[j] = (f32x4){0.f, 0.f, 0.f, 0.f}; }
#pragma unroll
      for (int ks = 0; ks < 2; ++ks) {
          const bf16x8 aA = *(const LAS bf16x8*)(ATT + (16 * tr + fr) * 128 + (8 * fq + 32 * ks) * 2);
          const int srow = 32 * ks + 8 * fq + (fr >> 2);
          const bf16x8 aK = cat8(ldtr(KD + srow * 128 + (16 * tr + 4 * (fr & 3)) * 2), ldtr(KD + (srow + 4) * 128 + (16 * tr + 4 * (fr & 3)) * 2));
#pragma unroll
          for (int j = 0; j < 4; ++j) { const int nt = 4 * nh + j;
              const bf16x8 bv = cat8(ldtr(VV + srow * 256 + (16 * nt + 4 * (fr & 3)) * 2), ldtr(VV + (srow + 4) * 256 + (16 * nt + 4 * (fr & 3)) * 2));
              ao[j] = __builtin_amdgcn_mfma_f32_16x16x32_bf16(bv, aA, ao[j], 0, 0, 0);
              au[j] = __builtin_amdgcn_mfma_f32_16x16x32_bf16(bv, aK, au[j], 0, 0, 0); } }
#pragma unroll
      for (int j = 0; j < 4; ++j) { const int v0 = 16 * (4 * nh + j) + 4 * fq, row = 16 * tr + fr;
          u32x2 wo; wo.x = pk2(ao[j][0], ao[j][1]); wo.y = pk2(ao[j][2], ao[j][3]); *(GAS u32x2*)(Y + (n0 + row) * 1536 + 512 + h * 128 + v0) = wo;
          u32x2 wu; wu.x = pk2(au[j][0], au[j][1]); wu.y = pk2(au[j][2], au[j][3]); *(GAS u32x2*)(US + row * 128 + v0) = wu; } }
    __syncthreads();
}
__device__ __forceinline__ void gla_scan_phase(Frame& F) {
    GAS bf16* USb = (GAS bf16*)(F.ws + WS_US); const GAS float* DECb = (const GAS float*)(F.ws + WS_DEC);
    for (int gt = F.wg * 512 + F.tid; gt < 131072; gt += F.G * 512) { const int e0 = 2 * gt, bh = e0 >> 13, kv = e0 & 8191, k = kv >> 7;
        GAS unsigned* p = (GAS unsigned*)(USb + (size_t)bh * 64 * 8192 + kv); const GAS float* dp = DECb + bh * 64 * 64 + k;
        float s0 = 0.f, s1 = 0.f;
#pragma unroll 8
        for (int c = 0; c < 64; ++c) { const unsigned u = p[(size_t)c * 4096]; const float d = dp[c * 64];
            p[(size_t)c * 4096] = pk2(s0, s1);
            s0 = d * s0 + bflo(u); s1 = d * s1 + bfhi(u); } }
}
struct GlaOutRegs { u32x4 us[2]; bf16x8 aq[2]; u32x2 oi[4]; u32x2 br[4]; };
__device__ __forceinline__ void gla_out_load(Frame& F, int unit, int tid, int w, int fr, int fq, GlaOutRegs& R) {
    const int b = unit >> 8, h = (unit >> 6) & 3, c = unit & 63; const size_t n0 = (size_t)b * SEQ + 64 * c;
    const GAS bf16* PA = (const GAS bf16*)(F.ws + WS_PA); const GAS bf16* Y = (const GAS bf16*)(F.ws + WS_Y);
    const GAS bf16* US = (const GAS bf16*)(F.ws + WS_US) + (size_t)unit * 8192;
    const int tr = w >> 1, nh = w & 1, row = 16 * tr + fr;
#pragma unroll
    for (int i = 0; i < 2; ++i) R.us[i] = *(const GAS u32x4*)(US + (tid + 512 * i) * 8);
#pragma unroll
    for (int ks = 0; ks < 2; ++ks) R.aq[ks] = *(const GAS bf16x8*)(PA + (n0 + row) * NPA + PA_BQ + h * 64 + 8 * fq + 32 * ks);
#pragma unroll
    for (int j = 0; j < 4; ++j) { const int v0 = 16 * (4 * nh + j) + 4 * fq; R.oi[j] = *(const GAS u32x2*)(Y + (n0 + row) * 1536 + 512 + h * 128 + v0); R.br[j] = *(const GAS u32x2*)(PA + (n0 + row) * NPA + PA_BR + h * 128 + v0); }
}
__device__ __forceinline__ void gla_out_compute(Frame& F, int l, int unit, int tid, int lane, int w, int fr, int fq, const GlaOutRegs& R) {
    const int b = unit >> 8, h = (unit >> 6) & 3, c = unit & 63; const size_t n0 = (size_t)b * SEQ + 64 * c;
    GAS bf16* Y = (GAS bf16*)(F.ws + WS_Y);
    LAS unsigned char* SS = F.lds;
    LAS float* PS = (LAS float*)(F.lds + 16384);
    const GAS float* gng = ((const GAS float*)F.in[8]) + l * 128;
#pragma unroll
    for (int i = 0; i < 2; ++i) *(LAS u32x4*)(SS + (tid + 512 * i) * 16) = R.us[i];
    __syncthreads();
    const int tr = w >> 1, nh = w & 1, row = 16 * tr + fr;
    f32x4 acc[4];
#pragma unroll
    for (int j = 0; j < 4; ++j) acc[j] = (f32x4){0.f, 0.f, 0.f, 0.f};
#pragma unroll
    for (int ks = 0; ks < 2; ++ks) { const int krow = 32 * ks + 8 * fq + (fr >> 2);
#pragma unroll
        for (int j = 0; j < 4; ++j) { const int nt = 4 * nh + j;
            const bf16x8 bs = cat8(ldtr(SS + krow * 256 + (16 * nt + 4 * (fr & 3)) * 2), ldtr(SS + (krow + 4) * 256 + (16 * nt + 4 * (fr & 3)) * 2));
            acc[j] = __builtin_amdgcn_mfma_f32_16x16x32_bf16(bs, R.aq[ks], acc[j], 0, 0, 0); } }
    float ss = 0.f;
#pragma unroll
    for (int j = 0; j < 4; ++j) { const u32x2 oi = R.oi[j];
        acc[j][0] += bflo(oi.x); acc[j][1] += bfhi(oi.x); acc[j][2] += bflo(oi.y); acc[j][3] += bfhi(oi.y);
        ss += (acc[j][0] * acc[j][0] + acc[j][1] * acc[j][1]) + (acc[j][2] * acc[j][2] + acc[j][3] * acc[j][3]); }
    ss += shx(ss, 16, lane); ss += shx(ss, 32, lane);
    if (fq == 0) PS[row * 2 + nh] = ss;
    __syncthreads();
    { const float rinv = 1.f / sqrtf((PS[row * 2] + PS[row * 2 + 1]) * (1.f / 128.f) + RMS_EPS);
#pragma unroll
      for (int j = 0; j < 4; ++j) { const int v0 = 16 * (4 * nh + j) + 4 * fq; const f32x4 gg = *(const GAS f32x4*)(gng + v0); const u32x2 br = R.br[j];
          u32x2 wv; wv.x = pk2(acc[j][0] * rinv * gg[0] * bflo(br.x), acc[j][1] * rinv * gg[1] * bfhi(br.x)); wv.y = pk2(acc[j][2] * rinv * gg[2] * bflo(br.y), acc[j][3] * rinv * gg[3] * bfhi(br.y));
          *(GAS u32x2*)(Y + (n0 + row) * 1536 + 512 + h * 128 + v0) = wv; } }
    __syncthreads();
}
constexpr int DSA_WAVE_LDS = 17920;
__device__ __forceinline__ void dsa_unit(Frame& F, int unit) {
    int lane = F.lane; asm volatile("" : "+v"(lane)); const int w = F.wave;
    const int qb = 4095 - unit;
    const int b = qb & 7, t = (qb >> 3) * 8 + w;
    const size_t n = (size_t)b * SEQ + t, nb0 = (size_t)b * SEQ;
    const GAS bf16* PA = (const GAS bf16*)(F.ws + WS_PA); GAS bf16* Y = (GAS bf16*)(F.ws + WS_Y);
    const GAS bf16* KI = (const GAS bf16*)(F.ws + WS_KI); const GAS bf16* KA = (const GAS bf16*)(F.ws + WS_KA); const GAS bf16* VA = (const GAS bf16*)(F.ws + WS_VA);
    const GAS float* WI = (const GAS float*)(F.ws + WS_WI);
    LAS unsigned char* base = F.lds + w * DSA_WAVE_LDS;
    LAS unsigned* sc = (LAS unsigned*)base;
    LAS float* qi = (LAS float*)(base + 16384);
    LAS unsigned short* list = (LAS unsigned short*)(base + 16384 + 1024);
    { const u32x2 q2 = *(const GAS u32x2*)(PA + n * NPA + PA_QI + 4 * lane);
      *(LAS f32x4*)(qi + 4 * lane) = (f32x4){bflo(q2.x), bfhi(q2.x), bflo(q2.y), bfhi(q2.y)}; }
    asm volatile("s_waitcnt lgkmcnt(0)" ::: "memory");
    const f32x4 wi = {ld_f32(WI + n * 4), ld_f32(WI + n * 4 + 1), ld_f32(WI + n * 4 + 2), ld_f32(WI + n * 4 + 3)};
    const int nbat = (t >> 6) + 1;
    for (int kb = 0; kb < nbat; ++kb) { const int key = kb * 64 + lane, kc = key <= t ? key : t;
        const GAS u32x4* kp = (const GAS u32x4*)(KI + (nb0 + kc) * 64);
        float kf[64];
#pragma unroll
        for (int c = 0; c < 8; ++c) { const u32x4 kk = kp[c]; kf[8 * c] = bflo(kk.x); kf[8 * c + 1] = bfhi(kk.x); kf[8 * c + 2] = bflo(kk.y); kf[8 * c + 3] = bfhi(kk.y); kf[8 * c + 4] = bflo(kk.z); kf[8 * c + 5] = bfhi(kk.z); kf[8 * c + 6] = bflo(kk.w); kf[8 * c + 7] = bfhi(kk.w); }
        float score = 0.f;
#pragma unroll
        for (int h = 0; h < 4; ++h) { float d = 0.f;
#pragma unroll
            for (int c = 0; c < 16; ++c) { const f32x4 q4 = *(const LAS f32x4*)(qi + h * 64 + 4 * c); d += q4.x * kf[4 * c] + q4.y * kf[4 * c + 1] + q4.z * kf[4 * c + 2] + q4.w * kf[4 * c + 3]; }
            score += wi[h] * fmaxf(d, 0.f); }
        if (score == 0.f) score = 0.f;
        unsigned u = __builtin_bit_cast(unsigned, score); u = (u & 0x80000000u) ? ~u : (u | 0x80000000u);
        sc[key] = key <= t ? u : 0u; }
    asm volatile("s_waitcnt lgkmcnt(0)" ::: "memory");
    int nsel;
    if (t >= 256) {
        unsigned T = 0u;
        for (int bit = 31; bit >= 0; --bit) { const unsigned cand = T | (1u << bit); int cnt = 0;
            for (int j = 0; j < nbat; ++j) cnt += (sc[j * 64 + lane] >= cand) ? 1 : 0;
            if (wave_sum_i(cnt, lane) >= 256) T = cand; }
        int cgt = 0;
        for (int j = 0; j < nbat; ++j) cgt += (sc[j * 64 + lane] > T) ? 1 : 0;
        const int need = 256 - wave_sum_i(cgt, lane);
        int selbase = 0, tiebase = 0;
        for (int j = 0; j < nbat; ++j) { const unsigned x = sc[j * 64 + lane]; const bool eq = (x == T), gt = (x > T);
            const unsigned long long beq = __ballot(eq); const unsigned long long lt = (1ull << lane) - 1ull;
            const int trank = tiebase + __popcll(beq & lt);
            const bool sel = gt || (eq && trank < need);
            const unsigned long long bsel = __ballot(sel);
            if (sel) list[selbase + __popcll(bsel & lt)] = (unsigned short)(j * 64 + lane);
            selbase += __popcll(bsel); tiebase += __popcll(beq); }
        nsel = 256;
    } else {
        nsel = t + 1;
        for (int i = lane; i < 256; i += 64) list[i] = (unsigned short)(i <= t ? i : 0);
    }
    asm volatile("s_waitcnt lgkmcnt(0)" ::: "memory");
    LAS float* qm = (LAS float*)base;
    LAS float* Pl = (LAS float*)(base + 2048);
    { const u32x4 q8 = *(const GAS u32x4*)(PA + n * NPA + PA_Q + 8 * lane);
      *(LAS f32x4*)(qm + 8 * lane) = (f32x4){bflo(q8.x), bfhi(q8.x), bflo(q8.y), bfhi(q8.y)}; *(LAS f32x4*)(qm + 8 * lane + 4) = (f32x4){bflo(q8.z), bfhi(q8.z), bflo(q8.w), bfhi(q8.w)}; }
    asm volatile("s_waitcnt lgkmcnt(0)" ::: "memory");
#pragma unroll 1
    for (int bb = 0; bb < 4; ++bb) { const int i = bb * 64 + lane; const bool valid = i < nsel; const int key = valid ? (int)list[i] : 0;
        const GAS u32x4* kp = (const GAS u32x4*)(KA + (nb0 + key) * 64);
        float kf[64];
#pragma unroll
        for (int c = 0; c < 8; ++c) { const u32x4 kk = kp[c]; kf[8 * c] = bflo(kk.x); kf[8 * c + 1] = bfhi(kk.x); kf[8 * c + 2] = bflo(kk.y); kf[8 * c + 3] = bfhi(kk.y); kf[8 * c + 4] = bflo(kk.z); kf[8 * c + 5] = bfhi(kk.z); kf[8 * c + 6] = bflo(kk.w); kf[8 * c + 7] = bfhi(kk.w); }
        float lgv[8];
#pragma unroll
        for (int h = 0; h < 8; ++h) { float d = 0.f;
#pragma unroll
            for (int c = 0; c < 16; ++c) { const f32x4 q4 = *(const LAS f32x4*)(qm + h * 64 + 4 * c); d += q4.x * kf[4 * c] + q4.y * kf[4 * c + 1] + q4.z * kf[4 * c + 2] + q4.w * kf[4 * c + 3]; }
            lgv[h] = valid ? d : -INFINITY; }
        *(LAS f32x4*)(Pl + i * 8) = (f32x4){lgv[0], lgv[1], lgv[2], lgv[3]}; *(LAS f32x4*)(Pl + i * 8 + 4) = (f32x4){lgv[4], lgv[5], lgv[6], lgv[7]}; }
    asm volatile("s_waitcnt lgkmcnt(0)" ::: "memory");
    float lg[4][8];
#pragma unroll
    for (int bb = 0; bb < 4; ++bb) { const f32x4 a = *(const LAS f32x4*)(Pl + (bb * 64 + lane) * 8), c = *(const LAS f32x4*)(Pl + (bb * 64 + lane) * 8 + 4);
        lg[bb][0] = a.x; lg[bb][1] = a.y; lg[bb][2] = a.z; lg[bb][3] = a.w; lg[bb][4] = c.x; lg[bb][5] = c.y; lg[bb][6] = c.z; lg[bb][7] = c.w; }
    float den[8];
#pragma unroll
    for (int h = 0; h < 8; ++h) { float m = fmaxf(fmaxf(lg[0][h], lg[1][h]), fmaxf(lg[2][h], lg[3][h])); m = wave_max(m, lane); float s = 0.f;
#pragma unroll
        for (int bb = 0; bb < 4; ++bb) { lg[bb][h] = __expf(lg[bb][h] - m); s += lg[bb][h]; }
        den[h] = wave_sum(s, lane); }
#pragma unroll
    for (int bb = 0; bb < 4; ++bb) { const int i = bb * 64 + lane;
        *(LAS f32x4*)(Pl + i * 8) = (f32x4){lg[bb][0], lg[bb][1], lg[bb][2], lg[bb][3]}; *(LAS f32x4*)(Pl + i * 8 + 4) = (f32x4){lg[bb][4], lg[bb][5], lg[bb][6], lg[bb][7]}; }
    asm volatile("s_waitcnt lgkmcnt(0)" ::: "memory");
    float o[8];
#pragma unroll
    for (int h = 0; h < 8; ++h) o[h] = 0.f;
#pragma unroll 4
    for (int i = 0; i < nsel; ++i) { const int key = (int)list[i]; const float vv = bf1(VA[(nb0 + key) * 64 + lane]);
        const f32x4 p0 = *(const LAS f32x4*)(Pl + i * 8), p1 = *(const LAS f32x4*)(Pl + i * 8 + 4);
        o[0] += p0.x * vv; o[1] += p0.y * vv; o[2] += p0.z * vv; o[3] += p0.w * vv; o[4] += p1.x * vv; o[5] += p1.y * vv; o[6] += p1.z * vv; o[7] += p1.w * vv; }
#pragma unroll
    for (int h = 0; h < 8; ++h) Y[n * 1536 + h * 64 + lane] = (bf16)f2bf(o[h] / den[h]);
}

__device__ __forceinline__ bf16x8 scale_pack8(u32x4 raw, float s) {
    u32x4 o; o.x = cvt_pk_bf16(bflo(raw.x) * s, bfhi(raw.x) * s); o.y = cvt_pk_bf16(bflo(raw.y) * s, bfhi(raw.y) * s); o.z = cvt_pk_bf16(bflo(raw.z) * s, bfhi(raw.z) * s); o.w = cvt_pk_bf16(bflo(raw.w) * s, bfhi(raw.w) * s);
    return __builtin_bit_cast(bf16x8, o);
}
__device__ __forceinline__ void dsa16_unit(Frame& F, int unit) {
    const int lane = fresh_lane(); const int w = F.wave;
    const int qb = 2047 - unit;
    const int b = qb & 7, t0 = (qb >> 3) * 16;
    const size_t nb0 = (size_t)b * SEQ;
    const GAS bf16* PA = (const GAS bf16*)(F.ws + WS_PA); GAS bf16* Y = (GAS bf16*)(F.ws + WS_Y);
    const GAS bf16* KI = (const GAS bf16*)(F.ws + WS_KI); const GAS bf16* KA = (const GAS bf16*)(F.ws + WS_KA); const GAS bf16* VA = (const GAS bf16*)(F.ws + WS_VA);
    const GAS float* WI = (const GAS float*)(F.ws + WS_WI);
    LAS unsigned char* K16 = F.lds;
    LAS unsigned short* LIST = (LAS unsigned short*)(F.lds + AUX_OFF);
    const int fr = lane & 15, fq = lane >> 4;
#ifdef REP_S1
    for (int rep_ = 0; rep_ < REP_S1; ++rep_)
#endif
    {
        const int ql = fr >> 2, h = fr & 3;
        bf16x8 Bf[4][2]; float Linf[4];
#pragma unroll
        for (int g = 0; g < 4; ++g) { const size_t nq = nb0 + t0 + 4 * g + ql; const float wv = WI[nq * 4 + h];
#pragma unroll
            for (int ks = 0; ks < 2; ++ks) Bf[g][ks] = scale_pack8(*(const GAS u32x4*)(PA + nq * NPA + PA_QI + h * 64 + 8 * fq + 32 * ks), wv);
            Linf[g] = (wv >= 0.f) ? INFINITY : -INFINITY; }
        const int ntiles = (t0 >> 4) + 1;
        bf16x8 A0[4], A1[4];
#pragma unroll
        for (int j = 0; j < 4; ++j) { const int tile = (w + 8 * j < ntiles) ? w + 8 * j : ntiles - 1; const size_t krow = (nb0 + 16 * tile + fr) * 64;
            A0[j] = *(const GAS bf16x8*)(KI + krow + 8 * fq); A1[j] = *(const GAS bf16x8*)(KI + krow + 32 + 8 * fq); }
#pragma unroll 1
        for (int tb = w; tb < ntiles; tb += 32) {
            bf16x8 N0[4], N1[4];
#pragma unroll
            for (int j = 0; j < 4; ++j) { const int tn = tb + 32 + 8 * j; const int tile = (tn < ntiles) ? tn : ntiles - 1; const size_t krow = (nb0 + 16 * tile + fr) * 64;
                N0[j] = *(const GAS bf16x8*)(KI + krow + 8 * fq); N1[j] = *(const GAS bf16x8*)(KI + krow + 32 + 8 * fq); }
#pragma unroll
            for (int j = 0; j < 4; ++j) { const int tile = tb + 8 * j;
                if (tile < ntiles) {
                    const int kpos = 16 * tile + 4 * fq + h;
                    const int g7 = kpos >> 7, hf = (kpos >> 6) & 1, ln = kpos & 63;
                    const int koff = (g7 >> 2) * 1024 + ln * 16 + (g7 & 3) * 4 + hf * 2;
                    const bool lastt = (tile == ntiles - 1);
                    f32x4 d[4];
#pragma unroll
                    for (int g = 0; g < 4; ++g) d[g] = __builtin_amdgcn_mfma_f32_16x16x32_bf16(A0[j], Bf[g][0], (f32x4){0.f, 0.f, 0.f, 0.f}, 0, 0, 0);
#pragma unroll
                    for (int g = 0; g < 4; ++g) d[g] = __builtin_amdgcn_mfma_f32_16x16x32_bf16(A1[j], Bf[g][1], d[g], 0, 0, 0);
#define S1_STEP(g) const float a0##g = __builtin_amdgcn_fmed3f(d[g][0], 0.f, Linf[g]), a1##g = __builtin_amdgcn_fmed3f(d[g][1], 0.f, Linf[g]), a2##g = __builtin_amdgcn_fmed3f(d[g][2], 0.f, Linf[g]), a3##g = __builtin_amdgcn_fmed3f(d[g][3], 0.f, Linf[g]);
                    S1_STEP(0) S1_STEP(1) S1_STEP(2) S1_STEP(3)
#undef S1_STEP
#define S1_STEP(g) const float u0##g = a0##g + dppf<0xB1>(a0##g), u1##g = a1##g + dppf<0xB1>(a1##g), u2##g = a2##g + dppf<0xB1>(a2##g), u3##g = a3##g + dppf<0xB1>(a3##g);
                    S1_STEP(0) S1_STEP(1) S1_STEP(2) S1_STEP(3)
#undef S1_STEP
#define S1_STEP(g) const float p0##g = (h & 1) ? u1##g : u0##g, p1##g = (h & 1) ? u3##g : u2##g;
                    S1_STEP(0) S1_STEP(1) S1_STEP(2) S1_STEP(3)
#undef S1_STEP
#define S1_STEP(g) const float c0##g = p0##g + dppf<0x4E>(p0##g), c1##g = p1##g + dppf<0x4E>(p1##g);
                    S1_STEP(0) S1_STEP(1) S1_STEP(2) S1_STEP(3)
#undef S1_STEP
#define S1_STEP(g) const float s##g = ((h & 2) ? c1##g : c0##g) + 0.0f; const _Float16 hh##g = (_Float16)s##g; const unsigned hb##g = (unsigned)__builtin_bit_cast(unsigned short, hh##g); \
                    unsigned key##g = hb##g ^ ((unsigned)((int)(hb##g << 16) >> 31) | 0x8000u); if (lastt) key##g = (kpos <= t0 + 4 * g + ql) ? key##g : 0u;
                    S1_STEP(0) S1_STEP(1) S1_STEP(2) S1_STEP(3)
#undef S1_STEP
#define S1_STEP(g) *(LAS unsigned short*)(K16 + (4 * g + ql) * 8192 + koff) = (unsigned short)key##g;
                    S1_STEP(0) S1_STEP(1) S1_STEP(2) S1_STEP(3)
#undef S1_STEP
                }
            }
#pragma unroll
            for (int j = 0; j < 4; ++j) { A0[j] = N0[j]; A1[j] = N1[j]; }
        }
    }
    __syncthreads();
    if (t0 < 256) {
#pragma unroll 1
        for (int qq = 0; qq < 2; ++qq) { const int q = 2 * w + qq, nvalid = t0 + q + 1; LAS unsigned short* list = LIST + q * 256;
            for (int i = lane; i < 256; i += 64) list[i] = (unsigned short)(i < nvalid ? i : 0); }
    } else {
#ifndef REP_S2
#define REP_S2 1
#endif
#pragma unroll 1
        for (int qq = 0; qq < 2 * REP_S2; ++qq) {
            const int q = 2 * w + (qq & 1), nvalid = t0 + q + 1;
            LAS unsigned short* list = LIST + q * 256;
            const int ngrp = (nvalid + 511) >> 9;
            unsigned P[32];
#pragma unroll
            for (int grp = 0; grp < 8; ++grp) {
                if (grp < ngrp) { const u32x4 r = *(const LAS u32x4*)(K16 + q * 8192 + grp * 1024 + lane * 16);
#pragma unroll
                    for (int i = 0; i < 4; ++i) { const int g = 4 * grp + i; const int thr = nvalid - 128 * g; unsigned rr = r[i];
                        if (thr < 128) rr &= ((lane < thr) ? 0xffffu : 0u) | ((lane < thr - 64) ? 0xffff0000u : 0u);
                        P[g] = rr; }
                } else {
#pragma unroll
                    for (int i = 0; i < 4; ++i) P[4 * grp + i] = 0u;
                }
            }
            unsigned one2 = 0x00010001u; asm volatile("" : "+v"(one2));
#define DSA_PKCOUNT(dst, c1) do { const unsigned c1p_ = (c1) | ((c1) << 16); unsigned a_ = 0u; \
                _Pragma("unroll") for (int grp = 0; grp < 8; ++grp) if (grp < ngrp) { _Pragma("unroll") for (int i = 0; i < 4; ++i) { unsigned y_; \
                    asm("v_pk_sub_u16 %0, %1, %2 clamp\n\tv_pk_min_u16 %0, %0, %3" : "=&v"(y_) : "v"(P[4 * grp + i]), "v"(c1p_), "v"(one2)); a_ += y_; } } \
                dst = (int)((a_ & 0xffffu) + (a_ >> 16)); } while (0)
            LAS unsigned* hist = (LAS unsigned*)(F.lds + AUX_OFF + 8192) + w * 256;
            unsigned T; int tot_gt;
            { unsigned hi8 = 0u; int above = 0;
#pragma unroll
              for (int lvl = 0; lvl < 2; ++lvl) {
                  { unsigned z_ = 0u; asm volatile("" : "+v"(z_)); *(LAS u32x4*)(hist + 4 * lane) = (u32x4){z_, z_, z_, z_}; }
                  asm volatile("s_waitcnt lgkmcnt(0)" ::: "memory");
#pragma unroll
                  for (int grp = 0; grp < 8; ++grp) if (grp < ngrp) {
#pragma unroll
                      for (int i = 0; i < 4; ++i) { const unsigned lo = P[4 * grp + i] & 0xffffu, hi = P[4 * grp + i] >> 16;
                          if (lvl == 0) { __hip_atomic_fetch_add(hist + (lo >> 8), 1u, __ATOMIC_RELAXED, __HIP_MEMORY_SCOPE_WAVEFRONT); __hip_atomic_fetch_add(hist + (hi >> 8), 1u, __ATOMIC_RELAXED, __HIP_MEMORY_SCOPE_WAVEFRONT); }
                          else { if ((lo >> 8) == hi8) __hip_atomic_fetch_add(hist + (lo & 0xffu), 1u, __ATOMIC_RELAXED, __HIP_MEMORY_SCOPE_WAVEFRONT);
                                 if ((hi >> 8) == hi8) __hip_atomic_fetch_add(hist + (hi & 0xffu), 1u, __ATOMIC_RELAXED, __HIP_MEMORY_SCOPE_WAVEFRONT); } } }
                  asm volatile("s_waitcnt lgkmcnt(0)" ::: "memory");
                  const u32x4 hb = *(const LAS u32x4*)(hist + 4 * lane);
                  const int sl = (int)(hb.x + hb.y + hb.z + hb.w);
                  int inc = sl;
                  inc += __builtin_amdgcn_update_dpp(0, inc, 0x111, 0xf, 0xf, false); inc += __builtin_amdgcn_update_dpp(0, inc, 0x112, 0xf, 0xf, false);
                  inc += __builtin_amdgcn_update_dpp(0, inc, 0x114, 0xf, 0xf, false); inc += __builtin_amdgcn_update_dpp(0, inc, 0x118, 0xf, 0xf, false);
                  const int r0 = __builtin_amdgcn_readlane(inc, 15), r1 = __builtin_amdgcn_readlane(inc, 31), r2 = __builtin_amdgcn_readlane(inc, 47), r3 = __builtin_amdgcn_readlane(inc, 63);
                  inc += (fq >= 1 ? r0 : 0) + (fq >= 2 ? r1 : 0) + (fq >= 3 ? r2 : 0);
                  const int total = r0 + r1 + r2 + r3;
                  const int want = 256 - above;
                  int run = total - inc;
                  int fb = -1, fa = 0;
                  { const int h3 = (int)hb.w, h2 = (int)hb.z, h1 = (int)hb.y, h0 = (int)hb.x;
                    if (run < want && run + h3 >= want) { fb = 3; fa = run; } run += h3;
                    if (run < want && run + h2 >= want) { fb = 2; fa = run; } run += h2;
                    if (run < want && run + h1 >= want) { fb = 1; fa = run; } run += h1;
                    if (run < want && run + h0 >= want) { fb = 0; fa = run; } }
                  const unsigned long long fm = __ballot(fb >= 0);
                  const int src = (int)__builtin_ctzll(fm);
                  const int bstar = __builtin_amdgcn_readlane(4 * lane + fb, src), abv = __builtin_amdgcn_readlane(fa, src);
                  if (lvl == 0) { hi8 = (unsigned)bstar; above = abv; } else { T = (hi8 << 8) | (unsigned)bstar; tot_gt = above + abv; }
              } }
            int cge_l, cgt_l; DSA_PKCOUNT(cge_l, T - 1u); DSA_PKCOUNT(cgt_l, T);
            const int tot_ge = wave_total_i(cge_l);
            const bool alltie = (tot_ge == 256);
            const int c_l = alltie ? cge_l : cgt_l; const unsigned thrT = alltie ? T : T + 1u;
            int inc = c_l;
            inc += __builtin_amdgcn_update_dpp(0, inc, 0x111, 0xf, 0xf, false); inc += __builtin_amdgcn_update_dpp(0, inc, 0x112, 0xf, 0xf, false);
            inc += __builtin_amdgcn_update_dpp(0, inc, 0x114, 0xf, 0xf, false); inc += __builtin_amdgcn_update_dpp(0, inc, 0x118, 0xf, 0xf, false);
            { const int r0 = __builtin_amdgcn_readlane(inc, 15), r1 = __builtin_amdgcn_readlane(inc, 31), r2 = __builtin_amdgcn_readlane(inc, 47);
              inc += (fq >= 1 ? r0 : 0) + (fq >= 2 ? r1 : 0) + (fq >= 3 ? r2 : 0); }
            int kpos_ = inc - c_l;
#pragma unroll
            for (int grp = 0; grp < 8; ++grp) if (grp < ngrp) {
#pragma unroll
                for (int i = 0; i < 4; ++i) { const int g = 4 * grp + i; const unsigned lo = P[g] & 0xffffu, hi = P[g] >> 16;
                    if (lo >= thrT) { list[kpos_] = (unsigned short)(128 * g + lane); ++kpos_; }
                    if (hi >= thrT) { list[kpos_] = (unsigned short)(128 * g + 64 + lane); ++kpos_; } } }
            if (!alltie) {
                int rem = 256 - tot_gt, pos = tot_gt; const unsigned long long lt = (1ull << lane) - 1ull;
#pragma unroll
                for (int grp = 0; grp < 8; ++grp) if (grp < ngrp) {
#pragma unroll
                    for (int i = 0; i < 8; ++i) { const int g = 4 * grp + (i >> 1); const unsigned val = (i & 1) ? (P[g] >> 16) : (P[g] & 0xffffu);
                        const bool eq = (val == T); const unsigned long long beq = __ballot(eq);
                        if (beq != 0ull) { const int rank = __popcll(beq & lt); if (eq && rank < rem) list[pos + rank] = (unsigned short)(128 * g + 64 * (i & 1) + lane);
                            const int n = __popcll(beq), take = n < rem ? n : rem; pos += take; rem -= take; } } }
            }
#undef DSA_PKCOUNT
        }
    }
    asm volatile("s_waitcnt lgkmcnt(0)" ::: "memory");
    LAS unsigned char* Vs = F.lds + w * 16384;
#ifndef REP_S3
#define REP_S3 1
#endif
#pragma unroll 1
    for (int qq = 0; qq < 2 * REP_S3; ++qq) {
        const int q = 2 * w + (qq & 1), tq = t0 + q; const int nsel = (tq + 1 < 256) ? tq + 1 : 256;
        const size_t nq = nb0 + tq;
        const LAS unsigned short* list = LIST + q * 256;
        bf16x8 Qf[2];
#pragma unroll
        for (int ks = 0; ks < 2; ++ks) { u32x4 raw = {0u, 0u, 0u, 0u}; if (fr < 8) raw = *(const GAS u32x4*)(PA + nq * NPA + PA_Q + fr * 64 + 8 * fq + 32 * ks); Qf[ks] = __builtin_bit_cast(bf16x8, raw); }
        float lg[16][4];
#ifdef REP_S3K
#pragma unroll 1
        for (int repk = 0; repk < REP_S3K; ++repk)
#endif
        const int st_off = (lane >> 3) * 128 + (((lane & 7) ^ ((lane >> 3) & 7)) * 16);
        const int rd0 = fr * 128 + ((fq ^ (fr & 7)) * 16), rd1 = fr * 128 + (((fq + 4) ^ (fr & 7)) * 16);
#pragma unroll
        for (int hb = 0; hb < 2; ++hb) {
#pragma unroll
            for (int ib = 0; ib < 2; ++ib) { u32x4 kv[8];
#pragma unroll
                for (int i = 0; i < 8; ++i) { const int piece = (8 * ib + i) * 64 + lane; const int key = (int)list[128 * hb + (piece >> 3)];
                    kv[i] = *(const GAS u32x4*)(KA + (nb0 + key) * 64 + 8 * (lane & 7)); }
                __builtin_amdgcn_sched_barrier(0);
#pragma unroll
                for (int i = 0; i < 8; ++i) *(LAS u32x4*)(Vs + st_off + (8 * ib + i) * 1024) = kv[i];
            }
            asm volatile("s_waitcnt lgkmcnt(0)" ::: "memory");
#pragma unroll
            for (int j = 0; j < 8; ++j) { const int tt = 8 * hb + j;
                const bf16x8 A0 = *(const LAS bf16x8*)(Vs + rd0 + j * 2048), A1 = *(const LAS bf16x8*)(Vs + rd1 + j * 2048);
                f32x4 d = __builtin_amdgcn_mfma_f32_16x16x32_bf16(A0, Qf[0], (f32x4){0.f, 0.f, 0.f, 0.f}, 0, 0, 0);
                d = __builtin_amdgcn_mfma_f32_16x16x32_bf16(A1, Qf[1], d, 0, 0, 0);
#pragma unroll
                for (int r = 0; r < 4; ++r) lg[tt][r] = (16 * tt + 4 * fq + r < nsel) ? d[r] : -INFINITY; }
            asm volatile("s_waitcnt lgkmcnt(0)" ::: "memory");
        }
        float m = lg[0][0];
#pragma unroll
        for (int tt = 0; tt < 16; ++tt)
#pragma unroll
            for (int r = 0; r < 4; ++r) m = fmaxf(m, lg[tt][r]);
        m = fmaxf(m, shx(m, 16, lane)); m = fmaxf(m, shx(m, 32, lane));
        float den = 0.f;
#pragma unroll
        for (int tt = 0; tt < 16; ++tt)
#pragma unroll
            for (int r = 0; r < 4; ++r) { lg[tt][r] = __expf(lg[tt][r] - m); den += lg[tt][r]; }
        den += shx(den, 16, lane); den += shx(den, 32, lane);
        f32x4 acc[4];
#pragma unroll
        for (int nt = 0; nt < 4; ++nt) acc[nt] = (f32x4){0.f, 0.f, 0.f, 0.f};
#ifdef REP_S3V
#pragma unroll 1
        for (int repv = 0; repv < REP_S3V; ++repv) {
#pragma unroll
        for (int nt = 0; nt < 4; ++nt) acc[nt] = (f32x4){0.f, 0.f, 0.f, 0.f};
#endif
#pragma unroll
        for (int hh = 0; hh < 2; ++hh) {
#pragma unroll
            for (int ib = 0; ib < 2; ++ib) {
                u32x4 vv[8];
#pragma unroll
                for (int i = 0; i < 8; ++i) { const int piece = (8 * ib + i) * 64 + lane, row = piece >> 3, c = piece & 7; const int key = (int)list[128 * hh + row];
                    vv[i] = *(const GAS u32x4*)(VA + (nb0 + key) * 64 + 8 * c); }
                __builtin_amdgcn_sched_barrier(0);
#pragma unroll
                for (int i = 0; i < 8; ++i) { const int piece = (8 * ib + i) * 64 + lane; *(LAS u32x4*)(Vs + piece * 16) = vv[i]; }
            }
            asm volatile("s_waitcnt lgkmcnt(0)" ::: "memory");
#pragma unroll
            for (int s4 = 0; s4 < 4; ++s4) { const int s = 4 * hh + s4;
                u32x4 pa; pa.x = cvt_pk_bf16(lg[2 * s][0], lg[2 * s][1]); pa.y = cvt_pk_bf16(lg[2 * s][2], lg[2 * s][3]); pa.z = cvt_pk_bf16(lg[2 * s + 1][0], lg[2 * s + 1][1]); pa.w = cvt_pk_bf16(lg[2 * s + 1][2], lg[2 * s + 1][3]);
                const bf16x8 Pa = __builtin_bit_cast(bf16x8, pa);
                const int rowa = 32 * s4 + 4 * fq + (fr >> 2);
#pragma unroll
                for (int nt = 0; nt < 4; ++nt) {
                    const v4i16_t lo = __builtin_amdgcn_ds_read_tr16_b64_v4i16((LAS v4i16_t*)(Vs + rowa * 128 + (16 * nt + 4 * (fr & 3)) * 2));
                    const v4i16_t hi = __builtin_amdgcn_ds_read_tr16_b64_v4i16((LAS v4i16_t*)(Vs + (rowa + 16) * 128 + (16 * nt + 4 * (fr & 3)) * 2));
                    bf16x8 Bv; Bv[0] = lo[0]; Bv[1] = lo[1]; Bv[2] = lo[2]; Bv[3] = lo[3]; Bv[4] = hi[0]; Bv[5] = hi[1]; Bv[6] = hi[2]; Bv[7] = hi[3];
                    acc[nt] = __builtin_amdgcn_mfma_f32_16x16x32_bf16(Bv, Pa, acc[nt], 0, 0, 0); } }
            asm volatile("s_waitcnt lgkmcnt(0)" ::: "memory");
        }
#ifdef REP_S3V
        }
#endif
        if (fr < 8) { const float rden = 1.f / den;
#pragma unroll
            for (int nt = 0; nt < 4; ++nt) { u32x2 wv; wv.x = pk2(acc[nt][0] * rden, acc[nt][1] * rden); wv.y = pk2(acc[nt][2] * rden, acc[nt][3] * rden);
                *(GAS u32x2*)(Y + nq * 1536 + fr * 64 + 16 * nt + 4 * fq) = wv; } }
    }
}

#ifdef GLA_NAIVE
constexpr int NGLA = 32;
#else
constexpr int NGLA = 2048;
#endif
#ifdef DSA_NAIVE
constexpr int NDSA = 4096;
#else
constexpr int NDSA = 2048;
#endif
#ifdef GMLP_NAIVE
constexpr int NGM = 1024;
#else
constexpr int NGM = 256;
#endif
__device__ __forceinline__ void phase_mixer(Frame& F, int l, int slot = 0, int types = 7) {
    (void)slot;
    for (int j = 0; j * F.G < NDSA; ++j) { const int u = j * F.G + ((j & 1) ? (F.G - 1 - F.wg) : F.wg);
        if (u >= NDSA) continue;
        __syncthreads(); if (EN_B2 && (types & 2)) {
#ifdef DSA_NAIVE
        dsa_unit(F, u);
#else
        dsa16_unit(F, u);
#endif
    } }
    for (int u = F.wg; u < NGLA; u += F.G) { __syncthreads(); if (EN_B1 && (types & 1)) {
#ifdef GLA_NAIVE
        gla_unit(F, l, u);
#else
        gla_local_unit(F, l, u);
#endif
    } }
    for (int u = F.wg; u < NGM; u += F.G) { __syncthreads(); if (EN_B3 && (types & 4)) {
#ifdef GMLP_NAIVE
        gmlp_unit(F, l, u);
#else
        gmlp16_unit(F, l, u);
#endif
    } }
}
__device__ __forceinline__ void phase_gla_out(Frame& F, int l) {
#ifndef GLA_NAIVE
    const int lane = fresh_lane(), w = F.wave, tid = w * 64 + lane, fr = lane & 15, fq = lane >> 4;
    GlaOutRegs R, N;
    if (F.wg < 2048) gla_out_load(F, F.wg, tid, w, fr, fq, R);
#pragma unroll 1
    for (int u = F.wg; u < 2048; u += F.G) { const int un = (u + F.G < 2048) ? u + F.G : u;
        gla_out_load(F, un, tid, w, fr, fq, N);
        gla_out_compute(F, l, u, tid, lane, w, fr, fq, R);
        R = N; }
#endif
}

template <int CTRL> __device__ __forceinline__ float dpp_add(float v) { return v + dppf<CTRL>(v); }
__device__ __forceinline__ float row16_sum(float v) { v = dpp_add<0xB1>(v); v = dpp_add<0x4E>(v); v = dpp_add<0x141>(v); v = dpp_add<0x140>(v); return v; }
__device__ __forceinline__ void phase_ln_router(Frame& F, int l) {
    const GAS bf16* WRB = (const GAS bf16*)(F.ws + WS_WR) + (size_t)l * 48 * DM;
    LAS unsigned char* WB = F.lds;
    for (int i = F.tid; i < 48 * 128; i += 512) { const int n = i >> 7, c = i & 127; *(LAS u32x4*)(WB + n * 2048 + ((c ^ (n & 7)) * 16)) = *(const GAS u32x4*)(WRB + n * DM + 8 * c); }
    if (F.tid < 32) F.MISC[16 + F.tid] = 0u;
    __syncthreads();
    GAS bf16* HB = (GAS bf16*)(F.ws + WS_HB); const GAS bf16* T = (const GAS bf16*)F.H; GAS int* EID = (GAS int*)(F.ws + WS_ROUTE); GAS float* EW = (GAS float*)(F.ws + WS_ROUTE + 256 * 1024);
    const GAS float* g = ((const GAS float*)F.in[17]) + l * DM; const GAS float* bb = ((const GAS float*)F.in[18]) + l * DM; const GAS float* brg = ((const GAS float*)F.in[20]) + l * 4; const GAS float* bre = ((const GAS float*)F.in[22]) + l * 32;
    const int lane = fresh_lane();
    const int sub = lane & 15, rr = lane >> 4, fr = sub, fq = rr;
    LAS float* LG = (LAS float*)(F.lds + 98304) + F.wave * 768;
    for (int r0 = F.wg * 128; r0 < NTOK; r0 += F.G * 128) {
        const int m0 = r0 + F.wave * 16;
        u32x4 nx[8];
#pragma unroll
        for (int q = 0; q < 8; ++q) nx[q] = *(const GAS u32x4*)(T + (size_t)(m0 + rr) * DM + 8 * (sub + 16 * q));
#pragma unroll 1
        for (int j = 0; j < 4; ++j) { const int m = m0 + 4 * j + rr;
            float v[64]; float s = 0.f;
#pragma unroll
            for (int q = 0; q < 8; ++q) { const u32x4 x = nx[q]; v[8 * q] = bflo(x.x); v[8 * q + 1] = bfhi(x.x); v[8 * q + 2] = bflo(x.y); v[8 * q + 3] = bfhi(x.y); v[8 * q + 4] = bflo(x.z); v[8 * q + 5] = bfhi(x.z); v[8 * q + 6] = bflo(x.w); v[8 * q + 7] = bfhi(x.w); }
            { const int mn = (j < 3) ? m + 4 : m;
#pragma unroll
              for (int q = 0; q < 8; ++q) nx[q] = *(const GAS u32x4*)(T + (size_t)mn * DM + 8 * (sub + 16 * q)); }
#pragma unroll
            for (int i = 0; i < 64; ++i) s += v[i];
            const float mean = row16_sum(s) * (1.f / DM); float s2 = 0.f;
#pragma unroll
            for (int i = 0; i < 64; ++i) { v[i] -= mean; s2 += v[i] * v[i]; }
            const float rstd = 1.f / sqrtf(row16_sum(s2) * (1.f / DM) + LN_EPS);
#pragma unroll
            for (int q = 0; q < 8; ++q) { const int c = 8 * (sub + 16 * q); const f32x4 g0 = *(const GAS f32x4*)(g + c), g1 = *(const GAS f32x4*)(g + c + 4), b0 = *(const GAS f32x4*)(bb + c), b1 = *(const GAS f32x4*)(bb + c + 4);
#pragma unroll
                for (int i = 0; i < 4; ++i) { v[8 * q + i] = v[8 * q + i] * rstd * g0[i] + b0[i]; v[8 * q + 4 + i] = v[8 * q + 4 + i] * rstd * g1[i] + b1[i]; }
                u32x4 wv; wv.x = pk2(v[8 * q], v[8 * q + 1]); wv.y = pk2(v[8 * q + 2], v[8 * q + 3]); wv.z = pk2(v[8 * q + 4], v[8 * q + 5]); wv.w = pk2(v[8 * q + 6], v[8 * q + 7]);
                *(GAS u32x4*)(HB + (size_t)m * DM + c) = wv; } }
        asm volatile("s_waitcnt vmcnt(0)" ::: "memory");
        f32x4 acc[3];
#pragma unroll
        for (int nt = 0; nt < 3; ++nt) acc[nt] = (f32x4){0.f, 0.f, 0.f, 0.f};
#pragma unroll 1
        for (int kb = 0; kb < 4; ++kb) {
            bf16x8 af[8];
#pragma unroll
            for (int ks = 0; ks < 8; ++ks) af[ks] = *(const GAS bf16x8*)(HB + (size_t)(m0 + fr) * DM + 8 * fq + 32 * (8 * kb + ks));
#pragma unroll
            for (int ks = 0; ks < 8; ++ks) { const int c = fq + 4 * (8 * kb + ks);
#pragma unroll
                for (int nt = 0; nt < 3; ++nt) { const int n = 16 * nt + fr; const bf16x8 bw = *(const LAS bf16x8*)(WB + n * 2048 + ((c ^ (n & 7)) * 16));
                    acc[nt] = __builtin_amdgcn_mfma_f32_16x16x32_bf16(af[ks], bw, acc[nt], 0, 0, 0); } } }
#pragma unroll
        for (int nt = 0; nt < 3; ++nt)
#pragma unroll
            for (int r = 0; r < 4; ++r) LG[(4 * fq + r) * 48 + 16 * nt + fr] = acc[nt][r];
        asm volatile("s_waitcnt lgkmcnt(0)" ::: "memory");
        if (lane < 16) { const int m = m0 + lane; const LAS float* lgt = LG + lane * 48;
            int gi = 0; float gm = lgt[0] + brg[0];
#pragma unroll
            for (int q = 1; q < 4; ++q) { const float x = lgt[q] + brg[q]; if (x > gm) { gm = x; gi = q; } }
            float gs = 0.f;
#pragma unroll
            for (int q = 0; q < 4; ++q) gs += __expf(lgt[q] + brg[q] - gm);
            const float gp = 1.f / gs;
            float el[8];
#pragma unroll
            for (int q = 0; q < 8; ++q) el[q] = lgt[4 + 8 * gi + q] + bre[8 * gi + q];
            int i0 = 0; float v0 = el[0];
#pragma unroll
            for (int q = 1; q < 8; ++q) if (el[q] > v0) { v0 = el[q]; i0 = q; }
            int i1 = -1; float v1 = -INFINITY;
#pragma unroll
            for (int q = 0; q < 8; ++q) if (q != i0 && el[q] > v1) { v1 = el[q]; i1 = q; }
            const float ex = __expf(v1 - v0), w0 = gp / (1.f + ex), w1 = gp * ex / (1.f + ex);
            const int e0 = gi * 8 + i0, e1 = gi * 8 + i1;
            EID[2 * m] = e0; EID[2 * m + 1] = e1; EW[2 * m] = w0; EW[2 * m + 1] = w1;
            __hip_atomic_fetch_add((LAS unsigned*)(F.lds + MISC_OFF) + 16 + e0, 1u, __ATOMIC_RELAXED, __HIP_MEMORY_SCOPE_WORKGROUP);
            __hip_atomic_fetch_add((LAS unsigned*)(F.lds + MISC_OFF) + 16 + e1, 1u, __ATOMIC_RELAXED, __HIP_MEMORY_SCOPE_WORKGROUP); }
        asm volatile("s_waitcnt lgkmcnt(0)" ::: "memory");
    }
    __syncthreads();
    if (F.tid < 32) ((GAS int*)(F.ws + WS_CNTWG))[F.wg * 32 + F.tid] = (int)F.MISC[16 + F.tid];
}
__device__ __forceinline__ void phase_dispatch(Frame& F) {
    const GAS int* CNT = (const GAS int*)(F.ws + WS_CNTWG); const GAS int* EID = (const GAS int*)(F.ws + WS_ROUTE); const GAS float* EW = (const GAS float*)(F.ws + WS_ROUTE + 256 * 1024);
    GAS int* SROW = (GAS int*)(F.ws + WS_SROW); GAS int* ROWMAP = (GAS int*)(F.ws + WS_ROWMAP); GAS float* CWROW = (GAS float*)(F.ws + WS_CWROW); GAS int* META = (GAS int*)(F.ws + WS_META);
    LAS int* tot = (LAS int*)(F.lds + AUX_OFF);
    if (F.tid < 32) { int t = 0, mine = 0; for (int w = 0; w < F.G; ++w) { const int c = ld_i32(CNT + w * 32 + F.tid); t += c; if (w < F.wg) mine += c; } tot[F.tid] = t; tot[32 + F.tid] = mine; tot[96 + F.tid] = 0; }
    __syncthreads();
    if (F.tid == 0) { int rb = 0;
#pragma clang loop unroll(disable) vectorize(disable)
        for (int e = 0; e < 32; ++e) { tot[64 + e] = rb; rb += ((tot[e] + 255) >> 8) << 8; }
        tot[128] = rb; }
    __syncthreads();
    if (F.wg == 0) { const int nt = tot[128] >> 8; if (F.tid == 0) META[0] = nt;
        if (F.tid < nt) { int e = 0;
#pragma clang loop unroll(disable) vectorize(disable)
            for (int q = 1; q < 32; ++q) if (tot[64 + q] <= F.tid * 256) e = q;
            META[16 + F.tid] = e; } }
    for (int r0 = F.wg * 128; r0 < NTOK; r0 += F.G * 128) {
        if (F.tid < 256) { const int tok = r0 + (F.tid >> 1), slot = F.tid & 1; const int e = EID[2 * tok + slot];
            const int pos = (int)__hip_atomic_fetch_add((LAS unsigned*)&tot[96 + e], 1u, __ATOMIC_RELAXED, __HIP_MEMORY_SCOPE_WORKGROUP);
            const int sr = tot[64 + e] + tot[32 + e] + pos;
            ROWMAP[sr] = tok; CWROW[sr] = EW[2 * tok + slot]; SROW[2 * tok + slot] = sr; } }
    if (F.wg < 32) { const int e = F.wg; const int lo = tot[64 + e] + tot[e], hi = tot[64 + e] + (((tot[e] + 255) >> 8) << 8);
        for (int r = lo + F.tid; r < hi; r += 512) { ROWMAP[r] = 0; CWROW[r] = 0.f; } }
}
__device__ __forceinline__ void phase_ln2(Frame& F, int l) {
    GAS bf16* HB = (GAS bf16*)(F.ws + WS_HB); const GAS int* SROW = (const GAS int*)(F.ws + WS_SROW); const GAS bf16* FF2 = (const GAS bf16*)(F.ws + WS_FF2);
    const GAS float* g = ((const GAS float*)F.in[26]) + l * DM; const GAS float* bb = ((const GAS float*)F.in[27]) + l * DM; int lane = F.lane; asm volatile("" : "+v"(lane));
    const int gw = F.wg * 8 + F.wave, NGW = F.G * 8; const bool last = (l == DEPTH - 1);
    int m = gw;
    u32x4 hn[2], an[2], cn[2];
    if (m < NTOK) { const int s0 = ld_i32(SROW + 2 * m), s1 = ld_i32(SROW + 2 * m + 1);
#pragma unroll
        for (int j = 0; j < 2; ++j) { hn[j] = *(const GAS u32x4*)(HB + (size_t)m * DM + 8 * lane + 512 * j); an[j] = *(const GAS u32x4*)(FF2 + (size_t)s0 * DM + 8 * lane + 512 * j); cn[j] = *(const GAS u32x4*)(FF2 + (size_t)s1 * DM + 8 * lane + 512 * j); } }
#pragma unroll 1
    for (; m < NTOK; m += NGW) {
        float v[16];
#pragma unroll
        for (int j = 0; j < 2; ++j) { const u32x4 h = hn[j], a = an[j], c = cn[j];
            v[8 * j] = bflo(h.x) * DN_ALPHA + (bflo(a.x) + bflo(c.x)); v[8 * j + 1] = bfhi(h.x) * DN_ALPHA + (bfhi(a.x) + bfhi(c.x)); v[8 * j + 2] = bflo(h.y) * DN_ALPHA + (bflo(a.y) + bflo(c.y)); v[8 * j + 3] = bfhi(h.y) * DN_ALPHA + (bfhi(a.y) + bfhi(c.y));
            v[8 * j + 4] = bflo(h.z) * DN_ALPHA + (bflo(a.z) + bflo(c.z)); v[8 * j + 5] = bfhi(h.z) * DN_ALPHA + (bfhi(a.z) + bfhi(c.z)); v[8 * j + 6] = bflo(h.w) * DN_ALPHA + (bflo(a.w) + bflo(c.w)); v[8 * j + 7] = bfhi(h.w) * DN_ALPHA + (bfhi(a.w) + bfhi(c.w)); }
        const int mn = m + NGW;
        if (mn < NTOK) { const int s0 = ld_i32(SROW + 2 * mn), s1 = ld_i32(SROW + 2 * mn + 1);
#pragma unroll
            for (int j = 0; j < 2; ++j) { hn[j] = *(const GAS u32x4*)(HB + (size_t)mn * DM + 8 * lane + 512 * j); an[j] = *(const GAS u32x4*)(FF2 + (size_t)s0 * DM + 8 * lane + 512 * j); cn[j] = *(const GAS u32x4*)(FF2 + (size_t)s1 * DM + 8 * lane + 512 * j); } }
        float s = 0.f;
#pragma unroll
        for (int i = 0; i < 16; ++i) s += v[i];
        const float mean = wave_sum(s, lane) * (1.f / DM); float s2 = 0.f;
#pragma unroll
        for (int i = 0; i < 16; ++i) { v[i] -= mean; s2 += v[i] * v[i]; }
        const float rstd = 1.f / sqrtf(wave_sum(s2, lane) * (1.f / DM) + LN_EPS);
#pragma unroll
        for (int j = 0; j < 2; ++j) { const int c = 8 * lane + 512 * j; const f32x4 g0 = *(const GAS f32x4*)(g + c), g1 = *(const GAS f32x4*)(g + c + 4), b0 = *(const GAS f32x4*)(bb + c), b1 = *(const GAS f32x4*)(bb + c + 4);
#pragma unroll
            for (int i = 0; i < 4; ++i) { v[8 * j + i] = v[8 * j + i] * rstd * g0[i] + b0[i]; v[8 * j + 4 + i] = v[8 * j + 4 + i] * rstd * g1[i] + b1[i]; }
            if (last) { *(GAS f32x4*)(F.H + (size_t)m * DM + c) = (f32x4){v[8 * j], v[8 * j + 1], v[8 * j + 2], v[8 * j + 3]}; *(GAS f32x4*)(F.H + (size_t)m * DM + c + 4) = (f32x4){v[8 * j + 4], v[8 * j + 5], v[8 * j + 6], v[8 * j + 7]}; }
            else { u32x4 wv; wv.x = pk2(v[8 * j], v[8 * j + 1]); wv.y = pk2(v[8 * j + 2], v[8 * j + 3]); wv.z = pk2(v[8 * j + 4], v[8 * j + 5]); wv.w = pk2(v[8 * j + 6], v[8 * j + 7]); *(GAS u32x4*)(HB + (size_t)m * DM + c) = wv; } }
    }
}

#ifndef EN_P
#define EN_P 1
#endif
#ifndef EN_A
#define EN_A 1
#endif
#ifndef EN_B
#define EN_B 1
#endif
#ifndef EN_C
#define EN_C 1
#endif
#ifndef EN_D
#define EN_D 1
#endif
#ifndef EN_E
#define EN_E 1
#endif
#ifndef EN_F
#define EN_F 1
#endif
#ifndef EN_G
#define EN_G 1
#endif
#ifndef EN_H
#define EN_H 1
#endif
#ifndef EN_I
#define EN_I 1
#endif
#ifndef EN_J
#define EN_J 1
#endif
constexpr int PPL = 12;
constexpr int N_PHASES = 1 + PPL * DEPTH;
#ifndef MK_ONE_LAUNCH
#define MK_ONE_LAUNCH 0
#endif
struct Args { const float* in[28]; float* out; unsigned char* ws; int ph_lo, ph_hi; };
static_assert(sizeof(Args) == 28 * 8 + 8 + 8 + 8, "no padding bytes in the argument struct");


__device__ __forceinline__ unsigned opaque_u32(unsigned x) { unsigned v; asm volatile("v_mov_b32 %0, %1" : "=v"(v) : "s"(x)); return (unsigned)__builtin_amdgcn_readfirstlane((int)v); }
__device__ __forceinline__ unsigned long long opaque_u64(unsigned long long x) { return ((unsigned long long)opaque_u32((unsigned)(x >> 32)) << 32) | opaque_u32((unsigned)x); }
__device__ __forceinline__ void launder(Frame& F) {
    F.ws = (GAS unsigned char*)opaque_u64((unsigned long long)F.ws); F.H = (GAS float*)opaque_u64((unsigned long long)F.H);
    F.ctl = (gu32*)opaque_u64((unsigned long long)F.ctl);
    unsigned z0 = 0u; asm volatile("" : "+v"(z0)); int ln = (int)__builtin_amdgcn_mbcnt_hi(~0u, __builtin_amdgcn_mbcnt_lo(~0u, z0));
    F.wave = (int)opaque_u32((unsigned)F.wave); F.lane = ln; F.tid = F.wave * 64 + ln;
    F.G = (int)opaque_u32((unsigned)F.G); F.wg = (int)opaque_u32((unsigned)F.wg);
}
__global__ void __launch_bounds__(512, 2) mk_fwd(Args args) {
    extern __shared__ __attribute__((aligned(16))) unsigned char lds_raw[];
    Frame F;
    F.lds = (LAS unsigned char*)lds_raw;
    F.MISC = (volatile LAS unsigned*)(F.lds + MISC_OFF);
    F.tid = threadIdx.x; F.lane = F.tid & 63; F.wave = __builtin_amdgcn_readfirstlane(F.tid >> 6);
    F.G = gridDim.x; F.wg = blockIdx.x;
    F.in = args.in;
    F.pos = (const GAS int*)args.in[1];
    F.H = (GAS float*)args.out; F.ws = (GAS unsigned char*)args.ws;
    F.ctl = (gu32*)(args.ws + WS_CTL);
    for (int u = F.tid; u < (LDS_BYTES - MISC_OFF) / 4; u += 512) ((LAS unsigned*)(F.lds + MISC_OFF))[u] = 0u;
    __syncthreads();
    const int lo = args.ph_lo, hi = args.ph_hi;
    const bool multi = (hi - lo) > 1;
    XcdBarrier bar; bar.bar = (unsigned*)(F.ctl + CW_BAR); bar.x = 0; bar.st = nullptr;
    if (multi) bar = xcd_barrier_post((unsigned*)(F.ctl + CW_BAR), F.MISC + 8);
#define IN(k) (lo <= (k) && (k) < hi)
#ifdef DUP_BARRIER
#define SEAM(k) do { if (IN(k) && IN((k) + 1)) { xcd_barrier(bar); xcd_barrier(bar); } } while (0)
#else
#define SEAM(k) do { if (IN(k) && IN((k) + 1)) xcd_barrier(bar); } while (0)
#endif

#ifdef DUP_P
    for (int rep = 0; rep < 2; ++rep)
#endif
    if (EN_P && IN(0)) { launder(F); phase_prologue(F); }
    SEAM(0);
#define HB ((GAS bf16*)(F.ws + WS_HB))
#define PA ((GAS bf16*)(F.ws + WS_PA))
#define Y ((GAS bf16*)(F.ws + WS_Y))
#define HM ((GAS bf16*)F.H + (size_t)NTOK * DM)
#define TT ((GAS bf16*)F.H)
    for (int l = 0; l < DEPTH; ++l) {
        const int pb = 1 + PPL * l;
#define wd (F.ws + WS_WDENSE + (size_t)l * WD_LAYER)
#ifdef DUP_A
        for (int rep = 0; rep < 2; ++rep)
#endif
        if (EN_A && IN(pb + 0)) { launder(F);
            DenseSched S; S.init(NTOK / 256, NPA / 256, F.G, F.wg, (const void*)HB, (size_t)256 * DM * 2, (const void*)(wd + WD_WA), (size_t)256 * DM * 2);
            EpiA E{PA, (GAS bf16*)(F.ws + WS_KA), (GAS bf16*)(F.ws + WS_VA), (GAS bf16*)(F.ws + WS_KI), (GAS float*)(F.ws + WS_WI), (GAS float*)(F.ws + WS_GLR), (const GAS float*)(F.ws + WS_ROPE), ((const GAS float*)F.in[5]) + l * 64};
#ifdef DUP_APLAIN
            { EpiPlainA E0{PA}; pg8::gemm_phase<EpiPlainA, DenseSched, false>(F.lds, S, E0, DM, DM, F.wave); }
#endif
#ifdef STAGGER_US
            if (F.wg & 1) { const unsigned long long t0 = __builtin_amdgcn_s_memrealtime(); while (__builtin_amdgcn_s_memrealtime() - t0 < (unsigned long long)(STAGGER_US * 100)) __builtin_amdgcn_s_sleep(8); }
#endif
            pg8::gemm_phase<EpiA, DenseSched, false>(F.lds, S, E, DM, DM, F.wave);
        }
        SEAM(pb + 0);
        if (EN_B && IN(pb + 1)) { launder(F); phase_mixer(F, l);
#ifdef DUP_B
            launder(F); phase_mixer(F, l, 1, DUP_B);
#endif
        }
        SEAM(pb + 1);
        if (EN_B && IN(pb + 2)) { launder(F); gla_scan_phase(F); }
        SEAM(pb + 2);
        if (EN_B && IN(pb + 3)) { launder(F); phase_gla_out(F, l); }
        SEAM(pb + 3);
#ifdef DUP_D
        for (int rep = 0; rep < 2; ++rep)
#endif
        if (EN_D && IN(pb + 4)) { launder(F);
            DenseSched S; S.init(NTOK / 256, DM / 256, F.G, F.wg, (const void*)Y, (size_t)256 * 1536 * 2, (const void*)(wd + WD_WBR), (size_t)256 * 512 * 2);
            S.nsub = 3; S.asub = 512 * 2; S.bsub = (size_t)1024 * 512 * 2;
            EpiP E{PA};
            pg8::gemm_phase<EpiP, DenseSched, false>(F.lds, S, E, 512, 1536, F.wave);
        }
#ifdef DUP_C
        for (int rep = 0; rep < 2; ++rep)
#endif
        if (EN_C && IN(pb + 4)) { launder(F);
            DenseSched S; S.init(NTOK / 256, DM / 256, F.G, F.wg, (const void*)HB, (size_t)256 * DM * 2, (const void*)(wd + WD_WG), (size_t)256 * DM * 2);
            S.nsub = 3; S.asub = 0; S.bsub = (size_t)1024 * DM * 2;
            EpiGM E{PA, HM};
            pg8::gemm_phase<EpiGM, DenseSched, false>(F.lds, S, E, DM, DM, F.wave);
        }
        SEAM(pb + 4);
        if (EN_E && IN(pb + 6)) { launder(F);
            DenseSched S; S.init(NTOK / 256, DM / 256, F.G, F.wg, (const void*)HM, (size_t)256 * DM * 2, (const void*)(wd + WD_WOUT), (size_t)256 * DM * 2);
            EpiO E{HB, TT};
            pg8::gemm_phase<EpiO, DenseSched, false>(F.lds, S, E, DM, DM, F.wave);
        }
        SEAM(pb + 6);
        if (EN_F && IN(pb + 7)) { launder(F); phase_ln_router(F, l); }
        SEAM(pb + 7);
        if (EN_G && IN(pb + 8)) { launder(F);
            { LAS float* scr = (LAS float*)(F.lds + F.wave * 16384); const int gw = F.wg * 8 + F.wave, NGW = F.G * 8;
              for (int it = gw; it < 12288; it += NGW) conv_moe_item(F, l, it, scr);
              __syncthreads(); }
            phase_dispatch(F); }
        SEAM(pb + 8);
#ifdef DUP_H
        for (int rep = 0; rep < 2; ++rep)
#endif
        if (EN_H && IN(pb + 9)) { launder(F);
            const GAS int* META = (const GAS int*)(F.ws + WS_META); const GAS int* ROWMAP = (const GAS int*)(F.ws + WS_ROWMAP);
            const int NT = ld_i32(META), NU = NT * 2;
            LAS int* meta = (LAS int*)(F.lds + AUX_OFF); LAS int* rows = (LAS int*)(F.lds + AUX_OFF + 64);
            for (int i = 0; i * F.G + F.wg < NU && i < 8; ++i) { const int L = i * F.G + F.wg, gt = L >> 1;
                if (F.tid == 0) meta[i] = ld_i32(META + 16 + gt);
                if (F.tid < 256) rows[i * 256 + F.tid] = ROWMAP[gt * 256 + F.tid]; }
            __syncthreads();
            GroupSched S{NU, F.G, F.wg, 2, (const char*)HB, (const char*)(F.ws + WS_WMOE + WM_GU), 0, (size_t)512 * DM * 2, (size_t)256 * DM * 2, meta, rows};
            EpiGU E{(GAS bf16*)(F.ws + WS_HID), (const GAS float*)(F.ws + WS_CWROW)};
            pg8::gemm_phase<EpiGU, GroupSched, true>(F.lds, S, E, DM, DM, F.wave);
        }
        SEAM(pb + 9);
#ifdef DUP_I
        for (int rep = 0; rep < 2; ++rep)
#endif
        if (EN_I && IN(pb + 10)) { launder(F);
            const GAS int* META = (const GAS int*)(F.ws + WS_META);
            const int NT = ld_i32(META), NU = NT * 4;
            LAS int* meta = (LAS int*)(F.lds + AUX_OFF);
            for (int i = 0; i * F.G + F.wg < NU && i < 8; ++i) { const int L = i * F.G + F.wg, gt = L >> 2; if (F.tid == 0) meta[i] = ld_i32(META + 16 + gt); }
            __syncthreads();
            GroupSched S{NU, F.G, F.wg, 4, (const char*)(F.ws + WS_HID), (const char*)(F.ws + WS_WMOE + WM_DN), (size_t)256 * DEXP * 2, (size_t)DM * DEXP * 2, (size_t)256 * DEXP * 2, meta, nullptr};
            EpiDN E{(GAS bf16*)(F.ws + WS_FF2)};
            pg8::gemm_phase<EpiDN, GroupSched, false>(F.lds, S, E, DEXP, DEXP, F.wave);
        }
        SEAM(pb + 10);
        if (EN_J && IN(pb + 11)) { launder(F); phase_ln2(F, l); }
        SEAM(pb + 11);
    }
#undef IN
#undef SEAM
#undef HB
#undef HM
#undef TT
#undef PA
#undef Y
#undef wd
}


#ifdef DUMP_OFF
__global__ void dump_k(const unsigned short* src, float* out) {
    for (size_t i = (size_t)blockIdx.x * blockDim.x + threadIdx.x; i < (size_t)NTOK * 1024; i += (size_t)gridDim.x * blockDim.x) { const size_t n = i >> 10, c = i & 1023; out[i] = __builtin_bit_cast(float, ((unsigned)src[n * DUMP_PITCH + c]) << 16); }
}
#endif
extern "C" void kernel_launch(void* const* d_in, const int* in_sizes, int n_in, void* d_out, int out_size, void* d_ws, size_t ws_size, hipStream_t stream) {
    static int grid = 0;
    if (grid == 0) {
        if (n_in != 28 || out_size != NTOK * DM || ws_size < WS_END) { fprintf(stderr, "kernel_launch: unexpected shapes (n_in %d out %d ws %zu); nothing launched\n", n_in, out_size, ws_size); grid = -1; return; }
        int dev = 0, cus = 0;
        if (hipGetDevice(&dev) != hipSuccess || hipDeviceGetAttribute(&cus, hipDeviceAttributeMultiprocessorCount, dev) != hipSuccess) { grid = -1; return; }
        if (hipFuncSetAttribute((const void*)mk_fwd, hipFuncAttributeMaxDynamicSharedMemorySize, LDS_BYTES) != hipSuccess) { fprintf(stderr, "kernel_launch: hipFuncSetAttribute failed\n"); grid = -1; return; }
        int per_cu = 0;
        if (hipOccupancyMaxActiveBlocksPerMultiprocessor(&per_cu, (const void*)mk_fwd, 512, LDS_BYTES) != hipSuccess || per_cu < 1) { fprintf(stderr, "kernel_launch: occupancy query says %d\n", per_cu); }
        (void)hipGetLastError();
        grid = cus;
        if (grid != 256) fprintf(stderr, "kernel_launch: %d CUs (built for 256)\n", grid);
    }
    if (grid < 0) return;
    if (hipMemsetAsync((char*)d_ws + WS_CTL, 0, CTL_ZERO_BYTES, stream) != hipSuccess) return;
    Args a{};
    for (int i = 0; i < 28; ++i) a.in[i] = (const float*)d_in[i];
    a.out = (float*)d_out; a.ws = (unsigned char*)d_ws;
#if MK_ONE_LAUNCH
    a.ph_lo = 0; a.ph_hi = N_PHASES;
    hipLaunchKernelGGL(mk_fwd, dim3(grid), dim3(512), LDS_BYTES, stream, a);
#else
#ifndef STOP_AFTER
#define STOP_AFTER (N_PHASES - 1)
#endif
#ifndef PHASE_MASK
#define PHASE_MASK 0xffffffffu
#endif
    for (int p = 0; p <= STOP_AFTER; ++p) { if (!((PHASE_MASK >> p) & 1u)) continue; a.ph_lo = p; a.ph_hi = p + 1; hipLaunchKernelGGL(mk_fwd, dim3(grid), dim3(512), LDS_BYTES, stream, a); }
#ifdef DUMP_OFF
    hipLaunchKernelGGL(dump_k, dim3(2048), dim3(256), 0, stream, (const unsigned short*)((const char*)d_ws + (size_t)(DUMP_OFF)), (float*)d_out);
#endif
#endif
}
```

```cpp
#define MK_ONE_LAUNCH 1
#include <hip/hip_runtime.h>
#include <cstdio>
#include <cstdint>

#define LAS __attribute__((address_space(3)))
#define GAS __attribute__((address_space(1)))
typedef unsigned short bf16;
typedef short bf16x8 __attribute__((ext_vector_type(8)));
typedef float f32x4 __attribute__((ext_vector_type(4)));
typedef float f32x2 __attribute__((ext_vector_type(2)));
typedef unsigned u32x4 __attribute__((ext_vector_type(4)));
typedef unsigned u32x2 __attribute__((ext_vector_type(2)));
typedef GAS unsigned gu32;

constexpr int NB = 8, SEQ = 4096, NTOK = NB * SEQ, DM = 1024, NIN = 6612, DEPTH = 2;
constexpr int NPA = 3584;
constexpr int NGT = 3072;
constexpr int NEXP = 32, DEXP = 256;
constexpr int MAXTILES = 288;
constexpr float DN_ALPHA = 1.41421356237309515f;
constexpr float LN_EPS = 1e-5f, RMS_EPS = 1e-6f;
constexpr int PA_Q = 0, PA_QI = 768, PA_BQ = 1024, PA_BK = 1280, PA_BV = 1536, PA_BR = 2048, PA_CU = 2560, PA_CV = 3072;

__device__ __forceinline__ unsigned f2bf(float f) { unsigned u = __builtin_bit_cast(unsigned, f); return (u + 0x7fffu + ((u >> 16) & 1u)) >> 16; }
__device__ __forceinline__ unsigned pk2(float lo, float hi) { return f2bf(lo) | (f2bf(hi) << 16); }
__device__ __forceinline__ float bflo(unsigned w) { return __builtin_bit_cast(float, w << 16); }
__device__ __forceinline__ float bfhi(unsigned w) { return __builtin_bit_cast(float, w & 0xffff0000u); }
__device__ __forceinline__ float bf1(bf16 h) { return __builtin_bit_cast(float, ((unsigned)h) << 16); }
typedef __bf16 bf16x2_t __attribute__((ext_vector_type(2)));
__device__ __forceinline__ unsigned cvt_pk_bf16(float lo, float hi) { const f32x2 v = {lo, hi}; const bf16x2_t b = __builtin_convertvector(v, bf16x2_t); return __builtin_bit_cast(unsigned, b); }
__device__ __forceinline__ float shx(float v, int mask, int lane) { return __builtin_bit_cast(float, __builtin_amdgcn_ds_bpermute((lane ^ mask) << 2, __builtin_bit_cast(int, v))); }
__device__ __forceinline__ int shxi(int v, int mask, int lane) { return __builtin_amdgcn_ds_bpermute((lane ^ mask) << 2, v); }
__device__ __forceinline__ float wave_sum(float v, int lane) {
#pragma unroll
    for (int o = 1; o < 64; o <<= 1) v += shx(v, o, lane);
    return v;
}
__device__ __forceinline__ float wave_max(float v, int lane) {
#pragma unroll
    for (int o = 1; o < 64; o <<= 1) v = fmaxf(v, shx(v, o, lane));
    return v;
}
__device__ __forceinline__ int wave_sum_i(int v, int lane) {
#pragma unroll
    for (int o = 1; o < 64; o <<= 1) v += shxi(v, o, lane);
    return v;
}
__device__ __forceinline__ int fresh_lane() { unsigned z0 = 0u; asm volatile("" : "+v"(z0)); return (int)__builtin_amdgcn_mbcnt_hi(~0u, __builtin_amdgcn_mbcnt_lo(~0u, z0)); }
__device__ __forceinline__ int ld_i32(const GAS int* p) { return __hip_atomic_load(p, __ATOMIC_RELAXED, __HIP_MEMORY_SCOPE_AGENT); }
__device__ __forceinline__ float ld_f32(const GAS float* p) { return __hip_atomic_load(p, __ATOMIC_RELAXED, __HIP_MEMORY_SCOPE_AGENT); }
__device__ __forceinline__ float sigmoidf_(float x) { return __builtin_amdgcn_rcpf(1.0f + __expf(-x)); }
__device__ __forceinline__ float siluf_(float x) { return x * sigmoidf_(x); }
__device__ __forceinline__ float gelu_tanh_(float x) { const float u = 0.7978845608028654f * (x + 0.044715f * x * x * x); return x * sigmoidf_(2.0f * u); }

namespace pg8 {
constexpr int BM = 256, BK = 64, HALF = 128, HTB = HALF * BK * 2, STAGE_BYTES = 8 * HTB;
__host__ __device__ __forceinline__ int lds_byte(int r, int c) { const int st = (r >> 4) * 2 + (c >> 5), rr = r & 15, cc = c & 31, ob = rr * 64 + cc * 2; return st * 1024 + (ob ^ (((ob >> 9) & 1) << 5)); }
__host__ __device__ __forceinline__ void stage_rc(int b, int& R, int& C) { const int st = b / 1024, sb = b % 1024, swz = sb ^ (((sb >> 9) & 1) << 5); R = (st >> 1) * 16 + swz / 64; C = (st & 1) * 32 + (swz % 64) / 2; }
__host__ __device__ __forceinline__ int perm32(int rho) { const int n = rho >> 4, i = rho & 15; return 8 * (i >> 2) + 4 * n + (i & 3); }

struct Unit { int pm, pn, e, slot; };

#ifndef PG8_ALIGN
#define PG8_ALIGN true
#endif
template <class Epi, class Sched, bool GATHER, bool ALIGN_EPI = PG8_ALIGN>
__device__ __forceinline__ void gemm_phase(LAS unsigned char* lds, const Sched& S, const Epi& E, const int K, const int lda, const int wave) {
    unsigned z0_ = 0u; asm volatile("" : "+v"(z0_)); const int lane_ = (int)__builtin_amdgcn_mbcnt_hi(~0u, __builtin_amdgcn_mbcnt_lo(~0u, z0_));
    const int wid = wave, lane = lane_, tid = wid * 64 + lane, wr = wid >> 2, wc = wid & 3, fr = lane & 15, fq = lane >> 4;
    const int nt = K / BK;
    int Rr[2], Cc[2];
    unsigned voffB[2];
#pragma unroll
    for (int i = 0; i < 2; ++i) { int R, C; stage_rc(tid * 16 + i * 8192, R, C); Rr[i] = R; Cc[i] = C; const int Rb = Epi::PERM ? ((R & ~31) + perm32(R & 31)) : R; voffB[i] = (unsigned)(Rb * K + C) * 2u; }
    const size_t kstep = (size_t)(BK * 2);
    const size_t hstepB = (size_t)HALF * K * 2;
    const unsigned ldsw = (unsigned)wid * 1024u;
    const int aoff = lds_byte(wr * 64 + fr, fq * 8), boff = lds_byte(wc * 32 + fr, fq * 8);
#define PG8_SA(b, h) (((b) * 2 + (h)) * HTB)
#define PG8_SB(b, h) ((4 + (b) * 2 + (h)) * HTB)
#define PG8_STAGE(bufoff, gbase, voff) do { _Pragma("unroll") for (int _i = 0; _i < 2; ++_i) \
        __builtin_amdgcn_global_load_lds((const unsigned*)((const char*)(gbase) + (voff)[_i]), (LAS unsigned*)(lds + (bufoff) + ldsw + _i * 8192), 16, 0, 0); } while (0)
#define PG8_LDA(dst, b, h) do { _Pragma("unroll") for (int m = 0; m < 4; ++m) _Pragma("unroll") for (int k = 0; k < 2; ++k) dst[m][k] = *(const LAS bf16x8*)(lds + PG8_SA(b, h) + aoff + m * 2048 + k * 1024); } while (0)
#define PG8_LDB(dst, b, h) do { _Pragma("unroll") for (int n = 0; n < 2; ++n) _Pragma("unroll") for (int k = 0; k < 2; ++k) dst[n][k] = *(const LAS bf16x8*)(lds + PG8_SB(b, h) + boff + n * 2048 + k * 1024); } while (0)
#define PG8_MMA(ai, bj, At, Bt) do { __builtin_amdgcn_s_setprio(1); _Pragma("unroll") for (int m = 0; m < 4; ++m) _Pragma("unroll") for (int n = 0; n < 2; ++n) _Pragma("unroll") for (int k = 0; k < 2; ++k) \
        acc[ai][bj][m][n] = __builtin_amdgcn_mfma_f32_16x16x32_bf16(Bt[n][k], At[m][k], acc[ai][bj][m][n], 0, 0, 0); __builtin_amdgcn_s_setprio(0); } while (0)
#define PG8_WAIT_V(n) asm volatile("s_waitcnt vmcnt(" #n ")" ::: "memory")
#define PG8_WAIT_L(n) asm volatile("s_waitcnt lgkmcnt(" #n ")" ::: "memory")
#define PG8_BAR do { asm volatile("" ::: "memory"); __builtin_amdgcn_s_barrier(); asm volatile("" ::: "memory"); } while (0)
#define PG8_SCHED __builtin_amdgcn_sched_barrier(0)
    Unit cur, nxt; int ui = 0;
    if (!S.next(0, cur)) return;
    f32x4 acc[2][2][4][2];
#pragma unroll
    for (int a = 0; a < 2; ++a)
#pragma unroll
        for (int b = 0; b < 2; ++b)
#pragma unroll
            for (int m = 0; m < 4; ++m)
#pragma unroll
                for (int n = 0; n < 2; ++n) acc[a][b][m][n] = (f32x4){0.f, 0.f, 0.f, 0.f};
    bf16x8 At[4][2], B0[2][2], B1[2][2];
    unsigned cA0[2], cA1[2], nA0[2], nA1[2];
#pragma unroll
    for (int i = 0; i < 2; ++i) {
        if (GATHER) { cA0[i] = (unsigned)(S.row_of(cur, Rr[i]) * lda + Cc[i]) * 2u; cA1[i] = (unsigned)(S.row_of(cur, HALF + Rr[i]) * lda + Cc[i]) * 2u; }
        else { cA0[i] = (unsigned)(Rr[i] * lda + Cc[i]) * 2u; cA1[i] = (unsigned)((HALF + Rr[i]) * lda + Cc[i]) * 2u; }
        nA0[i] = cA0[i]; nA1[i] = cA1[i];
    }
    const char* cA = S.a_base(cur); const char* cB = S.b_base(cur);
    PG8_STAGE(PG8_SB(0, 0), cB, voffB); PG8_STAGE(PG8_SB(0, 1), cB + hstepB, voffB); PG8_STAGE(PG8_SA(0, 0), cA, cA0); PG8_STAGE(PG8_SA(0, 1), cA, cA1);
    if (wr == 1) PG8_BAR;
    PG8_WAIT_V(2); PG8_BAR;
    PG8_STAGE(PG8_SB(1, 0), cB + kstep, voffB); PG8_STAGE(PG8_SA(1, 0), cA + kstep, cA0); PG8_STAGE(PG8_SB(1, 1), cB + hstepB + kstep, voffB);
    PG8_WAIT_V(6); PG8_BAR;
    for (;;) {
        const bool has_next = S.next(ui + 1, nxt);
        const char* nA = has_next ? S.a_base(nxt) : cA; const char* nB = has_next ? S.b_base(nxt) : cB;
        if (GATHER) {
#pragma unroll
            for (int i = 0; i < 2; ++i) {
                if (has_next) { nA0[i] = (unsigned)(S.row_of(nxt, Rr[i]) * lda + Cc[i]) * 2u; nA1[i] = (unsigned)(S.row_of(nxt, HALF + Rr[i]) * lda + Cc[i]) * 2u; }
                else { nA0[i] = cA0[i]; nA1[i] = cA1[i]; }
            }
        }
#pragma unroll 1
        for (int t = 0; t < nt; t += 2) {
            const bool last = (t == nt - 2);
            const char* a1 = cA + (size_t)(t + 1) * kstep;
            const char* a2 = last ? nA : cA + (size_t)(t + 2) * kstep; const char* b2 = last ? nB : cB + (size_t)(t + 2) * kstep;
            const char* a3 = a2 + kstep; const char* b3 = b2 + kstep;
            unsigned x0[2], x1[2];
#pragma unroll
            for (int i = 0; i < 2; ++i) { x0[i] = (GATHER && last) ? nA0[i] : cA0[i]; x1[i] = (GATHER && last) ? nA1[i] : cA1[i]; }
            PG8_LDB(B0, 0, 0); PG8_LDB(B1, 0, 1); PG8_SCHED; PG8_LDA(At, 0, 0); PG8_STAGE(PG8_SA(1, 1), a1, cA1);
            PG8_WAIT_V(8); PG8_WAIT_L(0); PG8_BAR; PG8_MMA(0, 0, At, B0); PG8_MMA(0, 1, At, B1); PG8_BAR; PG8_SCHED;
            PG8_LDA(At, 0, 1); PG8_STAGE(PG8_SB(0, 0), b2, voffB); PG8_STAGE(PG8_SB(0, 1), b2 + hstepB, voffB); PG8_STAGE(PG8_SA(0, 0), a2, x0);
            PG8_WAIT_V(8); PG8_WAIT_L(0); PG8_BAR; PG8_MMA(1, 0, At, B0); PG8_MMA(1, 1, At, B1); PG8_BAR; PG8_SCHED;
            PG8_LDB(B0, 1, 0); PG8_LDB(B1, 1, 1); PG8_SCHED; PG8_LDA(At, 1, 0); PG8_STAGE(PG8_SA(0, 1), a2, x1);
            PG8_WAIT_V(8); PG8_WAIT_L(0); PG8_BAR; PG8_MMA(0, 0, At, B0); PG8_MMA(0, 1, At, B1); PG8_BAR; PG8_SCHED;
            PG8_LDA(At, 1, 1); PG8_STAGE(PG8_SB(1, 0), b3, voffB); PG8_STAGE(PG8_SB(1, 1), b3 + hstepB, voffB); PG8_STAGE(PG8_SA(1, 0), a3, x0);
            PG8_WAIT_V(8); PG8_WAIT_L(0); PG8_BAR; PG8_MMA(1, 0, At, B0); PG8_MMA(1, 1, At, B1); PG8_BAR; PG8_SCHED;
        }
        if (ALIGN_EPI) { if (wr == 0) PG8_BAR; }
        E(acc, cur, wr, wc, fr, fq);
        if (!has_next) break;
#pragma unroll
        for (int a = 0; a < 2; ++a)
#pragma unroll
            for (int b = 0; b < 2; ++b)
#pragma unroll
                for (int m = 0; m < 4; ++m)
#pragma unroll
                    for (int n = 0; n < 2; ++n) acc[a][b][m][n] = (f32x4){0.f, 0.f, 0.f, 0.f};
        cur = nxt; cA = nA; cB = nB; ++ui;
#pragma unroll
        for (int i = 0; i < 2; ++i) { cA0[i] = nA0[i]; cA1[i] = nA1[i]; }
        if (ALIGN_EPI) { if (wr == 1) PG8_BAR; }
    }
    PG8_WAIT_V(0);
    if (!ALIGN_EPI) { if (wr == 0) PG8_BAR; }
    PG8_BAR;
#undef PG8_SA
#undef PG8_SB
#undef PG8_STAGE
#undef PG8_LDA
#undef PG8_LDB
#undef PG8_MMA
#undef PG8_WAIT_V
#undef PG8_WAIT_L
#undef PG8_BAR
#undef PG8_SCHED
}
}

#define XB_TMO      128
#define XB_XCNT(j)  (256  + 64 * (j))
#define XB_XSUB(j)  (1280 + 64 * (j))
#define XB_XGEN(j)  (2304 + 64 * (j))
#define XB_TOP      3328
#define XB_TOPGEN   3392
#define XCD_BAR_WORDS 3456
#define XB_SPIN_CAP (1u << 20)

__device__ __forceinline__ unsigned xb_ld(unsigned* p)              { return __hip_atomic_load(p, __ATOMIC_RELAXED, __HIP_MEMORY_SCOPE_AGENT); }
__device__ __forceinline__ unsigned xb_add(unsigned* p, unsigned v) { return __hip_atomic_fetch_add(p, v, __ATOMIC_RELAXED, __HIP_MEMORY_SCOPE_AGENT); }
__device__ __forceinline__ unsigned xb_xcc_id() { return (unsigned)__builtin_amdgcn_s_getreg((3 << 11) | 20) & 0xFu; }
#define XB_SPIN(cond, bar) do { unsigned _sp = 0; while (cond) { __builtin_amdgcn_s_sleep(1); \
    if ((++_sp & 255u) == 0u) { if (xb_ld(&(bar)[XB_TMO])) break; if (_sp > XB_SPIN_CAP) { atomicAdd(&(bar)[XB_TMO], 1u); break; } } } } while (0)

struct XcdBarrier { unsigned* bar; unsigned x; volatile LAS unsigned* st; };

__device__ __forceinline__ XcdBarrier xcd_barrier_post(unsigned* bar, volatile LAS unsigned* st) {
    XcdBarrier b; b.bar = bar; b.x = xb_xcc_id(); b.st = st;
    if (threadIdx.x == 0) (void)xb_add(&bar[XB_XCNT(b.x)], 1u);
    return b;
}
__device__ __forceinline__ void xcd_barrier_complete(unsigned* bar, unsigned x, unsigned& nloc, unsigned& nx) {
    const unsigned G = gridDim.x * gridDim.y * gridDim.z;
    unsigned sum, cnt, mine, sp = 0u;
    for (;;) {
        sum = 0u; cnt = 0u; mine = 0u;
#pragma unroll
        for (unsigned j = 0; j < 16; ++j) { const unsigned c = xb_ld(&bar[XB_XCNT(j)]); sum += c; cnt += (c > 0u) ? 1u : 0u; mine = (j == x) ? c : mine; }
        if (sum == G) break;
        __builtin_amdgcn_s_sleep(1);
        if ((++sp & 255u) == 0u) { if (xb_ld(&bar[XB_TMO])) break; if (sp > XB_SPIN_CAP) { atomicAdd(&bar[XB_TMO], 1u); break; } }
    }
    nloc = mine > 0u ? mine : 1u; nx = cnt > 0u ? cnt : 1u;
}
__device__ __forceinline__ void xcd_barrier(const XcdBarrier& b) {
    asm volatile("s_waitcnt vmcnt(0)" ::: "memory");
    __syncthreads();
    if (threadIdx.x == 0) {
        unsigned* bar = b.bar;
        __builtin_amdgcn_s_waitcnt(0);
        unsigned nloc = b.st[0], nx = b.st[1];
        if (nloc == 0u) { xcd_barrier_complete(bar, b.x, nloc, nx); b.st[0] = nloc; b.st[1] = nx; }
        const unsigned old = xb_add(&bar[XB_XSUB(b.x)], 1u);
        const unsigned gen = old / nloc;
        if (old + 1u == (gen + 1u) * nloc) {
            __builtin_amdgcn_fence(__ATOMIC_RELEASE, "agent");
            asm volatile("s_waitcnt vmcnt(0)" ::: "memory");
            const unsigned og = xb_add(&bar[XB_TOP], 1u);
            const unsigned tg = og / nx;
            if (og + 1u == (tg + 1u) * nx) xb_add(&bar[XB_TOPGEN], 1u);
            else XB_SPIN(xb_ld(&bar[XB_TOPGEN]) == tg, bar);
            __builtin_amdgcn_fence(__ATOMIC_ACQUIRE, "agent");
            xb_add(&bar[XB_XGEN(b.x)], 1u);
            asm volatile("s_waitcnt vmcnt(0)" ::: "memory");
        } else {
            XB_SPIN(xb_ld(&bar[XB_XGEN(b.x)]) == gen, bar);
            __builtin_amdgcn_fence(__ATOMIC_ACQUIRE, "agent");
            asm volatile("s_waitcnt vmcnt(0)" ::: "memory");
        }
    }
    __syncthreads();
}

constexpr size_t MiB = 1u << 20;
constexpr size_t WS_CTL = 0, CTL_ZERO_BYTES = 1 * MiB;
constexpr size_t WS_ROPE = 1 * MiB;
constexpr size_t WS_WI   = 3 * MiB;
constexpr size_t WS_ROUTE = 3 * MiB + 512 * 1024;
constexpr size_t WS_SROW = 4 * MiB;
constexpr size_t WS_ROWMAP = 4 * MiB + 256 * 1024;
constexpr size_t WS_CWROW = 4 * MiB + 640 * 1024;
constexpr size_t WS_CNTWG = 5 * MiB;
constexpr size_t WS_META = 5 * MiB + 64 * 1024;
constexpr size_t WS_WR = 5 * MiB + 128 * 1024;
constexpr size_t WS_GLR = 6 * MiB;
constexpr size_t WS_WDENSE = 8 * MiB;
constexpr size_t WD_WA = 0, WD_WG = 7 * MiB, WD_WBR = 13 * MiB, WD_WOUT = 16 * MiB, WD_LAYER = 18 * MiB;
constexpr size_t WS_WMOE = 44 * MiB;
constexpr size_t WM_GU = 0, WM_DN = 32 * MiB;
constexpr size_t WS_HB = 92 * MiB;
constexpr size_t WS_PA = 156 * MiB;
constexpr size_t WS_HID = WS_PA;
constexpr size_t WS_FF2 = WS_PA + 40 * MiB;
constexpr size_t WS_Y = 380 * MiB;
constexpr size_t WS_KA = 476 * MiB, WS_VA = 480 * MiB, WS_KI = 484 * MiB;
constexpr size_t WS_END = 512 * MiB;
static_assert(WS_WDENSE + 2 * WD_LAYER <= WS_WMOE && WS_WMOE + 48 * MiB <= WS_HB && WS_HB + 64 * MiB <= WS_PA && WS_PA + 224 * MiB <= WS_Y && WS_Y + 96 * MiB <= WS_KA && WS_KI + 4 * MiB <= WS_END, "ws map");
static_assert(WS_FF2 + (size_t)73728 * 1024 * 2 <= WS_Y, "ff2 fits");
constexpr int CW_BAR = 4096;
constexpr int CW_QUEUE = 16384;

constexpr int RING_BYTES = 131072;
constexpr int AUX_OFF = 131072;
constexpr int MISC_OFF = 147456;
constexpr int LDS_BYTES = 148480;

struct Frame {
    LAS unsigned char* lds;
    volatile LAS unsigned* MISC;
    gu32* ctl;
    int tid, lane, wave, G, wg;
    const float* const* in;
    const GAS int* pos;
    GAS float* H;
    GAS unsigned char* ws;
};

#define LDS_WAIT() asm volatile("s_waitcnt lgkmcnt(0)" ::: "memory")
#define VM_WAIT() asm volatile("s_waitcnt vmcnt(0)" ::: "memory")

__device__ __forceinline__ int pa_src_col(int c) {
    if (c < 512) return c;
    if (c < 768) { const int x = c - 512, half = x >> 7, y = x & 127, grp = y >> 5, d = (y & 31) + 32 * half;
        if (grp == 0) return 512 + d;
        if (grp == 1) return 576 + d;
        if (grp == 2) return 896 + d;
        if (half == 0) { const int z = y - 96; if (z < 4) return 960 + z; if (z < 20) return 1988 + (z - 4); }
        return -1; }
    if (c < 1024) return 640 + (c - 768);
    if (c < 1280) return 964 + (c - 1024);
    if (c < 1536) return 1220 + (c - 1280);
    if (c < 2048) return 1476 + (c - 1536);
    if (c < 2560) return 2004 + (c - 2048);
    return 2516 + (c - 2560);
}
struct TItem { const GAS float* W; GAS bf16* WT; int ldw, K, n0, k0, sc0, mode; };
__device__ __forceinline__ void ti_load(const TItem& t, f32x4 (&v)[8], int lane) {
    if (t.mode == 0) { const int kr = lane >> 3, c4 = (lane & 7) * 4;
#pragma unroll
        for (int i = 0; i < 8; ++i) v[i] = *(const GAS f32x4*)(t.W + (size_t)(t.k0 + 8 * i + kr) * t.ldw + t.sc0 + c4); }
}
__device__ __forceinline__ void ti_finish(const TItem& t, const f32x4 (&v)[8], LAS float* scr, int lane) {
    if (t.mode == 0) { const int kr = lane >> 3, c4 = (lane & 7) * 4;
#pragma unroll
        for (int i = 0; i < 8; ++i) { LAS float* d = scr + (8 * i + kr) * 33 + c4; d[0] = v[i].x; d[1] = v[i].y; d[2] = v[i].z; d[3] = v[i].w; }
    } else { const int sc = pa_src_col(t.n0 + (lane & 31));
#pragma unroll 8
        for (int i = 0; i < 32; ++i) { const int kk = 2 * i + (lane >> 5); scr[kk * 33 + (lane & 31)] = (sc >= 0) ? t.W[(size_t)(t.k0 + kk) * t.ldw + sc] : 0.f; }
    }
    LDS_WAIT(); asm volatile("" ::: "memory");
    const int c = lane & 7;
#pragma unroll
    for (int j = 0; j < 4; ++j) { const int n = (lane >> 3) + 8 * j; const LAS float* s = scr + (8 * c) * 33 + n;
        u32x4 o; o.x = pk2(s[0 * 33], s[1 * 33]); o.y = pk2(s[2 * 33], s[3 * 33]); o.z = pk2(s[4 * 33], s[5 * 33]); o.w = pk2(s[6 * 33], s[7 * 33]);
        *(GAS u32x4*)(t.WT + (size_t)(t.n0 + n) * t.K + t.k0 + 8 * c) = o; }
    LDS_WAIT(); asm volatile("" ::: "memory");
}
__device__ __forceinline__ void dense_item(Frame& F, int l, int it, TItem& t) {
    GAS bf16* base = (GAS bf16*)(F.ws + WS_WDENSE + (size_t)l * WD_LAYER);
    const GAS float* win = ((const GAS float*)F.in[4]) + (size_t)l * DM * NIN;
    if (it < 1792) { const int kb = it / 112, nb = it % 112; const int s0 = pa_src_col(32 * nb), s31 = pa_src_col(32 * nb + 31);
        t = TItem{win, base + WD_WA / 2, NIN, DM, 32 * nb, 64 * kb, s0, (s0 >= 0 && s31 == s0 + 31) ? 0 : 1}; return; }
    it -= 1792;
    if (it < 1536) { const int kb = it / 96, nb = it % 96; t = TItem{win, base + WD_WG / 2, NIN, DM, 32 * nb, 64 * kb, 3540 + 32 * nb, 0}; return; }
    it -= 1536;
    if (it < 768) { const int br = it / 256, r = it % 256, kb = r / 32, nb = r % 32;
        t = TItem{(br == 0 ? ((const GAS float*)F.in[13]) : br == 1 ? ((const GAS float*)F.in[14]) : ((const GAS float*)F.in[15])) + (size_t)l * 512 * DM, base + WD_WBR / 2 + (size_t)br * 1024 * 512, DM, 512, 32 * nb, 64 * kb, 32 * nb, 0}; return; }
    it -= 768;
    { const int kb = it / 32, nb = it % 32; t = TItem{((const GAS float*)F.in[16]) + (size_t)l * DM * DM, base + WD_WOUT / 2, DM, DM, 32 * nb, 64 * kb, 32 * nb, 0}; }
}
__device__ __forceinline__ void moe_item(Frame& F, int l, int it, TItem& t) {
    const int e = it / 384; int r = it % 384;
    if (r < 256) { const int sub = r / 64, q = r % 64, ct = sub >> 1, bj = sub & 1, kb = q / 4, nb = q % 4;
        const GAS float* src = (bj ? ((const GAS float*)F.in[24]) : ((const GAS float*)F.in[23])) + (size_t)(l * NEXP + e) * DM * DEXP;
        t = TItem{src, (GAS bf16*)(F.ws + WS_WMOE + WM_GU) + (size_t)e * 512 * DM, DEXP, DM, 256 * ct + 128 * bj + 32 * nb, 64 * kb, 128 * ct + 32 * nb, 0}; return; }
    r -= 256;
    { const int kb = r / 32, nb = r % 32;
        t = TItem{((const GAS float*)F.in[25]) + (size_t)(l * NEXP + e) * DEXP * DM, (GAS bf16*)(F.ws + WS_WMOE + WM_DN) + (size_t)e * DM * DEXP, DM, DEXP, 32 * nb, 64 * kb, 32 * nb, 0}; }
}
template <bool MOE> __device__ __forceinline__ void conv_run(Frame& F, int l, int total, LAS float* scr) {
    const int gw = F.wg * 8 + F.wave, NGW = F.G * 8, lane = F.lane;
    TItem cur, nxt; f32x4 vc[8], vn[8];
    int it = gw; if (it >= total) return;
    if (MOE) moe_item(F, l, it, cur); else dense_item(F, it / 4608, it % 4608, cur);
    ti_load(cur, vc, lane);
#pragma unroll 1
    for (; it < total; it += NGW) { const int itn = it + NGW; const bool hn = itn < total;
        if (hn) { if (MOE) moe_item(F, l, itn, nxt); else dense_item(F, itn / 4608, itn % 4608, nxt); ti_load(nxt, vn, lane); }
        ti_finish(cur, vc, scr, lane);
        cur = nxt;
#pragma unroll
        for (int i = 0; i < 8; ++i) vc[i] = vn[i]; }
}

__device__ __forceinline__ void ln_row_regs(f32x4 (&v)[4], const GAS float* g, const GAS float* b, int lane) {
    float s = 0.f;
#pragma unroll
    for (int j = 0; j < 4; ++j) s += (v[j].x + v[j].y) + (v[j].z + v[j].w);
    const float mean = wave_sum(s, lane) * (1.f / DM); float s2 = 0.f;
#pragma unroll
    for (int j = 0; j < 4; ++j) { v[j] = v[j] - mean; s2 += (v[j].x * v[j].x + v[j].y * v[j].y) + (v[j].z * v[j].z + v[j].w * v[j].w); }
    const float rstd = 1.f / sqrtf(wave_sum(s2, lane) * (1.f / DM) + LN_EPS);
#pragma unroll
    for (int j = 0; j < 4; ++j) { const f32x4 gg = *(const GAS f32x4*)(g + 4 * lane + 256 * j), bb = *(const GAS f32x4*)(b + 4 * lane + 256 * j); v[j] = v[j] * rstd * gg + bb; }
}
__device__ __forceinline__ void store_row_f32_bf16(const f32x4 (&v)[4], GAS float* hrow, GAS bf16* brow, int lane) {
#pragma unroll
    for (int j = 0; j < 4; ++j) {
        if (hrow) *(GAS f32x4*)(hrow + 4 * lane + 256 * j) = v[j];
        if (brow) { u32x2 w; w.x = pk2(v[j].x, v[j].y); w.y = pk2(v[j].z, v[j].w); *(GAS u32x2*)(brow + 4 * lane + 256 * j) = w; }
    }
}

__device__ __forceinline__ void phase_prologue(Frame& F) {
    LAS float* scr = (LAS float*)(F.lds + F.wave * 16384);
    const int gw = F.wg * 8 + F.wave, NGW = F.G * 8;
    conv_run<false>(F, 0, 2 * 4608, scr);
    { GAS bf16* WRB = (GAS bf16*)(F.ws + WS_WR);
      for (int i = gw * 64 + F.lane; i < DEPTH * 48 * DM; i += NGW * 64) { const int l = i / (48 * DM), r = i % (48 * DM), o = r / DM, k = r % DM;
          const float v = (o < 4) ? ((const GAS float*)F.in[19])[(size_t)l * DM * 4 + k * 4 + o] : (o < 36) ? ((const GAS float*)F.in[21])[(size_t)l * DM * 32 + k * 32 + (o - 4)] : 0.f;
          WRB[i] = (bf16)f2bf(v); } }
    { GAS float* RT = (GAS float*)(F.ws + WS_ROPE);
      for (int i = gw * 64 + F.lane; i < NTOK * 8; i += NGW * 64) { const int n = i >> 3, j = i & 7;
          const float invf[8] = {1.000000000e+00f, 1.939227432e-01f, 3.760603070e-02f, 7.292664610e-03f, 1.414213562e-03f, 2.742481884e-04f, 5.318295734e-05f, 1.031338525e-05f};
          float inv = invf[0];
#pragma unroll
          for (int q = 1; q < 8; ++q) inv = (j == q) ? invf[q] : inv;
          const float ang = (float)F.pos[n] * inv;
          const double kq = __builtin_rint((double)ang * 0.15915494309189535);
          double r = (double)ang - kq * 6.283185307179586; double csign = 1.0;
          if (r > 1.5707963267948966) { r = 3.141592653589793 - r; csign = -1.0; } else if (r < -1.5707963267948966) { r = -3.141592653589793 - r; csign = -1.0; }
          const double x2 = r * r;
          const double sn = r * (1.0 + x2 * (-1.0 / 6 + x2 * (1.0 / 120 + x2 * (-1.0 / 5040 + x2 * (1.0 / 362880 + x2 * (-1.0 / 39916800 + x2 * (1.0 / 6227020800.0 + x2 * (-1.0 / 1307674368000.0))))))));
          const double cs = 1.0 + x2 * (-0.5 + x2 * (1.0 / 24 + x2 * (-1.0 / 720 + x2 * (1.0 / 40320 + x2 * (-1.0 / 3628800 + x2 * (1.0 / 479001600.0 + x2 * (-1.0 / 87178291200.0 + x2 * (1.0 / 20922789888000.0))))))));
          RT[n * 16 + j] = (float)(csign * cs); RT[n * 16 + 8 + j] = (float)sn; } }
    GAS bf16* HB = (GAS bf16*)(F.ws + WS_HB);
    for (int m = gw; m < NTOK; m += NGW) { f32x4 v[4];
#pragma unroll
        for (int j = 0; j < 4; ++j) v[j] = *(const GAS f32x4*)(((const GAS float*)F.in[0]) + (size_t)m * DM + 4 * F.lane + 256 * j);
        ln_row_regs(v, ((const GAS float*)F.in[2]), ((const GAS float*)F.in[3]), F.lane);
        store_row_f32_bf16(v, (GAS float*)nullptr, HB + (size_t)m * DM, F.lane); }
}

struct DenseSched {
    int nM, nN, nwg, G, c; const char* A; const char* B; size_t atile, btile; int nsub = 1; size_t asub = 0, bsub = 0;
    __device__ void init(int nM_, int nN_, int G_, int c_, const void* A_, size_t atile_, const void* B_, size_t btile_) { nM = nM_; nN = nN_; nwg = nM * nN; G = G_; c = c_; A = (const char*)A_; B = (const char*)B_; atile = atile_; btile = btile_; }
    __device__ __forceinline__ bool next(int i, pg8::Unit& u) const {
        const int it = i / nsub, sb = i - it * nsub;
        const long L = (long)it * G + c; if (L >= nwg) return false;
        int wgid = (int)L; { const int q = nwg / 8, r = nwg % 8, xcd = wgid % 8, off = wgid / 8; wgid = (xcd < r ? xcd * (q + 1) : r * (q + 1) + (xcd - r) * q) + off; }
        const int nig = 8 * nN, gid = wgid / nig, fm = gid * 8, gsz = (nM - fm) < 8 ? (nM - fm) : 8;
        u.pm = fm + ((wgid % nig) % gsz); u.pn = (wgid % nig) / gsz; u.e = sb; u.slot = i; return true;
    }
    __device__ __forceinline__ const char* a_base(const pg8::Unit& u) const { return A + (size_t)u.pm * atile + (size_t)u.e * asub; }
    __device__ __forceinline__ const char* b_base(const pg8::Unit& u) const { return B + (size_t)u.pn * btile + (size_t)u.e * bsub; }
    __device__ __forceinline__ int row_of(const pg8::Unit&, int) const { return 0; }
};
struct GroupSched {
    int NU, G, c, ncol; const char* A; const char* B; size_t atile, erows_bytes, btile; const LAS int* meta; const LAS int* rows;
    __device__ __forceinline__ bool next(int i, pg8::Unit& u) const {
        const int L = i * G + c; if (L >= NU) return false;
        u.pm = L / ncol; u.pn = L % ncol; u.slot = i; u.e = meta[i]; return true;
    }
    __device__ __forceinline__ const char* a_base(const pg8::Unit& u) const { return A + (size_t)u.pm * atile; }
    __device__ __forceinline__ const char* b_base(const pg8::Unit& u) const { return B + (size_t)u.e * erows_bytes + (size_t)u.pn * btile; }
    __device__ __forceinline__ int row_of(const pg8::Unit& u, int r) const { return rows[u.slot * 256 + r]; }
};

struct EpiA {
    static constexpr bool PERM = true;
    GAS bf16* PA; GAS bf16* KA; GAS bf16* VA; GAS bf16* KI; GAS float* WI; GAS float* GLR; const GAS float* ROPE; const GAS float* ikg;
    __device__ __forceinline__ static void rope8(float (&x)[8], const GAS float* rt, int fq, int lane) {
        const f32x4 c0 = *(const GAS f32x4*)(rt), c1 = *(const GAS f32x4*)(rt + 4), s0 = *(const GAS f32x4*)(rt + 8), s1 = *(const GAS f32x4*)(rt + 12);
#pragma unroll
        for (int i = 0; i < 8; ++i) { const float p = shx(x[i], 16, lane); const float cc = (i < 4) ? c0[i & 3] : c1[i & 3], ss = (i < 4) ? s0[i & 3] : s1[i & 3];
            const float r = x[i] * cc + ((fq == 0) ? -p : p) * ss; x[i] = (fq < 2) ? r : x[i]; }
    }
    __device__ __forceinline__ static u32x4 pack8(const float (&x)[8]) { u32x4 w; w.x = cvt_pk_bf16(x[0], x[1]); w.y = cvt_pk_bf16(x[2], x[3]); w.z = cvt_pk_bf16(x[4], x[5]); w.w = cvt_pk_bf16(x[6], x[7]); return w; }
    __device__ __forceinline__ void operator()(const f32x4 (&acc)[2][2][4][2], const pg8::Unit& u, int wr, int wc, int fr, int fq) const {
        const int pn = u.pn; const int rowb = u.pm * 256 + wr * 64 + fr; const int lane = fq * 16 + fr;
        if (pn == 2) {
#pragma unroll
            for (int ai = 0; ai < 2; ++ai)
#pragma unroll
                for (int m = 0; m < 4; ++m) {
                    const int row = rowb + ai * 128 + m * 16;
                    float x0[8], x1[8];
#pragma unroll
                    for (int i = 0; i < 8; ++i) { x0[i] = acc[ai][0][m][i >> 2][i & 3]; x1[i] = acc[ai][1][m][i >> 2][i & 3]; }
                    if (wc == 2) {
                        float s = 0.f;
#pragma unroll
                        for (int i = 0; i < 8; ++i) s += x0[i] + x1[i];
                        s += shx(s, 16, lane); s += shx(s, 32, lane);
                        const float mean = s * (1.f / 64.f); float q = 0.f;
#pragma unroll
                        for (int i = 0; i < 8; ++i) { x0[i] -= mean; x1[i] -= mean; q += x0[i] * x0[i] + x1[i] * x1[i]; }
                        q += shx(q, 16, lane); q += shx(q, 32, lane);
                        const float rstd = 1.f / sqrtf(q * (1.f / 64.f) + LN_EPS);
#pragma unroll
                        for (int i = 0; i < 8; ++i) { x0[i] = x0[i] * rstd * ikg[8 * fq + i]; x1[i] = x1[i] * rstd * ikg[32 + 8 * fq + i]; }
                    }
                    if (wc == 0 || wc == 2) rope8(x0, ROPE + (size_t)row * 16, fq, lane);
                    if (wc < 3) {
                        GAS bf16* dst = (wc == 0) ? KA : (wc == 1) ? VA : KI;
                        *(GAS u32x4*)(dst + (size_t)row * 64 + 8 * fq) = pack8(x0); *(GAS u32x4*)(dst + (size_t)row * 64 + 32 + 8 * fq) = pack8(x1);
                    } else {
                        if (fq == 0) { *(GAS f32x4*)(WI + (size_t)row * 4) = (f32x4){x0[0], x0[1], x0[2], x0[3]} * 0.0625f; *(GAS f32x4*)(GLR + (size_t)row * 16) = (f32x4){x0[4], x0[5], x0[6], x0[7]}; }
                        else if (fq == 1) { *(GAS f32x4*)(GLR + (size_t)row * 16 + 4) = (f32x4){x0[0], x0[1], x0[2], x0[3]}; *(GAS f32x4*)(GLR + (size_t)row * 16 + 8) = (f32x4){x0[4], x0[5], x0[6], x0[7]}; }
                        else if (fq == 2) { *(GAS f32x4*)(GLR + (size_t)row * 16 + 12) = (f32x4){x0[0], x0[1], x0[2], x0[3]}; }
                    }
                    asm volatile("" ::: "memory");
                }
        } else if (pn < 2 || pn == 3) {
            const float sc = (pn == 3) ? 1.0f : 0.125f; const bool rope = !(wc & 1);
#pragma unroll
            for (int ai = 0; ai < 2; ++ai)
#pragma unroll
                for (int m = 0; m < 4; ++m) {
                    const int row = rowb + ai * 128 + m * 16;
#pragma unroll
                    for (int bj = 0; bj < 2; ++bj) { float x[8];
#pragma unroll
                        for (int i = 0; i < 8; ++i) x[i] = acc[ai][bj][m][i >> 2][i & 3];
                        if (rope) rope8(x, ROPE + (size_t)row * 16, fq, lane);
#pragma unroll
                        for (int i = 0; i < 8; ++i) x[i] *= sc;
                        *(GAS u32x4*)(PA + (size_t)row * NPA + 256 * pn + 128 * bj + 32 * wc + 8 * fq) = pack8(x); }
                    asm volatile("" ::: "memory");
                }
        } else {
            const int act = (pn == 8 || pn == 9) ? 1 : (pn >= 10) ? 2 : 0; const float sc = (pn == 4) ? 0.125f : 1.0f;
#pragma unroll
            for (int ai = 0; ai < 2; ++ai)
#pragma unroll
                for (int m = 0; m < 4; ++m) {
                    const int row = rowb + ai * 128 + m * 16;
#pragma unroll
                    for (int bj = 0; bj < 2; ++bj) { float x[8];
#pragma unroll
                        for (int i = 0; i < 8; ++i) { const float v = acc[ai][bj][m][i >> 2][i & 3]; x[i] = (act == 1) ? siluf_(v) : (act == 2) ? gelu_tanh_(v) : v * sc; }
                        *(GAS u32x4*)(PA + (size_t)row * NPA + 256 * pn + 128 * bj + 32 * wc + 8 * fq) = pack8(x); }
                    asm volatile("" ::: "memory");
                }
        }
    }
};
struct EpiPlainA {
    static constexpr bool PERM = true;
    GAS bf16* PA;
    __device__ __forceinline__ void operator()(const f32x4 (&acc)[2][2][4][2], const pg8::Unit& u, int wr, int wc, int fr, int fq) const {
        const int rowb = u.pm * 256 + wr * 64 + fr;
#pragma unroll
        for (int ai = 0; ai < 2; ++ai)
#pragma unroll
            for (int m = 0; m < 4; ++m) { const int row = rowb + ai * 128 + m * 16;
#pragma unroll
                for (int bj = 0; bj < 2; ++bj) { u32x4 w; w.x = cvt_pk_bf16(acc[ai][bj][m][0][0], acc[ai][bj][m][0][1]); w.y = cvt_pk_bf16(acc[ai][bj][m][0][2], acc[ai][bj][m][0][3]);
                    w.z = cvt_pk_bf16(acc[ai][bj][m][1][0], acc[ai][bj][m][1][1]); w.w = cvt_pk_bf16(acc[ai][bj][m][1][2], acc[ai][bj][m][1][3]);
                    *(GAS u32x4*)(PA + (size_t)row * NPA + 256 * u.pn + 128 * bj + 32 * wc + 8 * fq) = w; } }
    }
};
struct EpiP {
    static constexpr bool PERM = true;
    GAS bf16* P;
    __device__ __forceinline__ void operator()(const f32x4 (&acc)[2][2][4][2], const pg8::Unit& u, int wr, int wc, int fr, int fq) const {
        const int rowb = u.pm * 256 + wr * 64 + fr; GAS bf16* Pb = P + (size_t)u.e * NTOK * DM;
#pragma unroll
        for (int ai = 0; ai < 2; ++ai)
#pragma unroll
            for (int m = 0; m < 4; ++m) { const int row = rowb + ai * 128 + m * 16;
#pragma unroll
                for (int bj = 0; bj < 2; ++bj) { u32x4 w; w.x = cvt_pk_bf16(acc[ai][bj][m][0][0], acc[ai][bj][m][0][1]); w.y = cvt_pk_bf16(acc[ai][bj][m][0][2], acc[ai][bj][m][0][3]);
                    w.z = cvt_pk_bf16(acc[ai][bj][m][1][0], acc[ai][bj][m][1][1]); w.w = cvt_pk_bf16(acc[ai][bj][m][1][2], acc[ai][bj][m][1][3]);
                    *(GAS u32x4*)(Pb + (size_t)row * DM + 256 * u.pn + 128 * bj + 32 * wc + 8 * fq) = w; } }
    }
};
struct EpiGM {
    static constexpr bool PERM = true;
    const GAS bf16* P; GAS bf16* HM;
    __device__ __forceinline__ void operator()(const f32x4 (&acc)[2][2][4][2], const pg8::Unit& u, int wr, int wc, int fr, int fq) const {
        const int rowb = u.pm * 256 + wr * 64 + fr; const int br = u.e; const GAS bf16* Pb = P + (size_t)br * NTOK * DM;
        const int colb = 256 * u.pn + 32 * wc + 8 * fq;
#pragma unroll
        for (int ai = 0; ai < 2; ++ai) {
            u32x4 pv[4][2], ov[4][2];
#pragma unroll
            for (int m = 0; m < 4; ++m)
#pragma unroll
                for (int bj = 0; bj < 2; ++bj) { const size_t off = (size_t)(rowb + ai * 128 + m * 16) * DM + colb + 128 * bj;
                    pv[m][bj] = *(const GAS u32x4*)(Pb + off); ov[m][bj] = (br > 0) ? *(const GAS u32x4*)(HM + off) : (u32x4){0u, 0u, 0u, 0u}; }
            __builtin_amdgcn_sched_barrier(0);
#pragma unroll
            for (int m = 0; m < 4; ++m)
#pragma unroll
                for (int bj = 0; bj < 2; ++bj) { const size_t off = (size_t)(rowb + ai * 128 + m * 16) * DM + colb + 128 * bj;
                    const u32x4 p = pv[m][bj], o = ov[m][bj];
                    float x[8];
                    x[0] = bflo(p.x) * sigmoidf_(acc[ai][bj][m][0][0]) + bflo(o.x); x[1] = bfhi(p.x) * sigmoidf_(acc[ai][bj][m][0][1]) + bfhi(o.x); x[2] = bflo(p.y) * sigmoidf_(acc[ai][bj][m][0][2]) + bflo(o.y); x[3] = bfhi(p.y) * sigmoidf_(acc[ai][bj][m][0][3]) + bfhi(o.y);
                    x[4] = bflo(p.z) * sigmoidf_(acc[ai][bj][m][1][0]) + bflo(o.z); x[5] = bfhi(p.z) * sigmoidf_(acc[ai][bj][m][1][1]) + bfhi(o.z); x[6] = bflo(p.w) * sigmoidf_(acc[ai][bj][m][1][2]) + bflo(o.w); x[7] = bfhi(p.w) * sigmoidf_(acc[ai][bj][m][1][3]) + bfhi(o.w);
                    u32x4 w; w.x = cvt_pk_bf16(x[0], x[1]); w.y = cvt_pk_bf16(x[2], x[3]); w.z = cvt_pk_bf16(x[4], x[5]); w.w = cvt_pk_bf16(x[6], x[7]);
                    *(GAS u32x4*)(HM + off) = w; }
            asm volatile("" ::: "memory");
        }
    }
};
struct EpiO {
    static constexpr bool PERM = true;
    const GAS bf16* HBr; GAS bf16* T;
    __device__ __forceinline__ void operator()(const f32x4 (&acc)[2][2][4][2], const pg8::Unit& u, int wr, int wc, int fr, int fq) const {
        const int rowb = u.pm * 256 + wr * 64 + fr; const int colb = 256 * u.pn + 32 * wc + 8 * fq;
#pragma unroll
        for (int ai = 0; ai < 2; ++ai) {
            u32x4 hv[4][2];
#pragma unroll
            for (int m = 0; m < 4; ++m)
#pragma unroll
                for (int bj = 0; bj < 2; ++bj) hv[m][bj] = *(const GAS u32x4*)(HBr + (size_t)(rowb + ai * 128 + m * 16) * DM + colb + 128 * bj);
            __builtin_amdgcn_sched_barrier(0);
#pragma unroll
            for (int m = 0; m < 4; ++m)
#pragma unroll
                for (int bj = 0; bj < 2; ++bj) { const u32x4 h = hv[m][bj];
                    u32x4 w; w.x = cvt_pk_bf16(bflo(h.x) * DN_ALPHA + acc[ai][bj][m][0][0], bfhi(h.x) * DN_ALPHA + acc[ai][bj][m][0][1]); w.y = cvt_pk_bf16(bflo(h.y) * DN_ALPHA + acc[ai][bj][m][0][2], bfhi(h.y) * DN_ALPHA + acc[ai][bj][m][0][3]);
                    w.z = cvt_pk_bf16(bflo(h.z) * DN_ALPHA + acc[ai][bj][m][1][0], bfhi(h.z) * DN_ALPHA + acc[ai][bj][m][1][1]); w.w = cvt_pk_bf16(bflo(h.w) * DN_ALPHA + acc[ai][bj][m][1][2], bfhi(h.w) * DN_ALPHA + acc[ai][bj][m][1][3]);
                    *(GAS u32x4*)(T + (size_t)(rowb + ai * 128 + m * 16) * DM + colb + 128 * bj) = w; }
            asm volatile("" ::: "memory");
        }
    }
};
struct EpiGU {
    static constexpr bool PERM = true;
    GAS bf16* HID; const GAS float* CW;
    __device__ __forceinline__ void operator()(const f32x4 (&acc)[2][2][4][2], const pg8::Unit& u, int wr, int wc, int fr, int fq) const {
        const int rowb = u.pm * 256 + wr * 64 + fr;
        float cwv[2][4];
#pragma unroll
        for (int ai = 0; ai < 2; ++ai)
#pragma unroll
            for (int m = 0; m < 4; ++m) cwv[ai][m] = CW[rowb + ai * 128 + m * 16];
#pragma unroll
        for (int ai = 0; ai < 2; ++ai)
#pragma unroll
            for (int m = 0; m < 4; ++m) { const int row = rowb + ai * 128 + m * 16; const float cw = cwv[ai][m];
                float x[8];
#pragma unroll
                for (int i = 0; i < 8; ++i) x[i] = siluf_(acc[ai][0][m][i >> 2][i & 3]) * acc[ai][1][m][i >> 2][i & 3] * cw;
                u32x4 w; w.x = cvt_pk_bf16(x[0], x[1]); w.y = cvt_pk_bf16(x[2], x[3]); w.z = cvt_pk_bf16(x[4], x[5]); w.w = cvt_pk_bf16(x[6], x[7]);
                *(GAS u32x4*)(HID + (size_t)row * DEXP + 128 * u.pn + 32 * wc + 8 * fq) = w; }
    }
};
struct EpiDN {
    static constexpr bool PERM = true;
    GAS bf16* FF2;
    __device__ __forceinline__ void operator()(const f32x4 (&acc)[2][2][4][2], const pg8::Unit& u, int wr, int wc, int fr, int fq) const {
        const int rowb = u.pm * 256 + wr * 64 + fr;
#pragma unroll
        for (int ai = 0; ai < 2; ++ai)
#pragma unroll
            for (int m = 0; m < 4; ++m) { const int row = rowb + ai * 128 + m * 16;
#pragma unroll
                for (int bj = 0; bj < 2; ++bj) { u32x4 w; w.x = cvt_pk_bf16(acc[ai][bj][m][0][0], acc[ai][bj][m][0][1]); w.y = cvt_pk_bf16(acc[ai][bj][m][0][2], acc[ai][bj][m][0][3]);
                    w.z = cvt_pk_bf16(acc[ai][bj][m][1][0], acc[ai][bj][m][1][1]); w.w = cvt_pk_bf16(acc[ai][bj][m][1][2], acc[ai][bj][m][1][3]);
                    *(GAS u32x4*)(FF2 + (size_t)row * DM + 256 * u.pn + 128 * bj + 32 * wc + 8 * fq) = w; } }
    }
};
#ifndef EN_B1
#define EN_B1 1
#endif
#ifndef EN_B2
#define EN_B2 1
#endif
#ifndef EN_B3
#define EN_B3 1
#endif

template <int CTRL> __device__ __forceinline__ float dppf(float x) { return __builtin_bit_cast(float, __builtin_amdgcn_mov_dpp(__builtin_bit_cast(int, x), CTRL, 0xf, 0xf, true)); }
template <int CTRL> __device__ __forceinline__ int dppi(int x) { return __builtin_amdgcn_mov_dpp(x, CTRL, 0xf, 0xf, true); }
typedef short v4i16_t __attribute__((ext_vector_type(4)));
typedef unsigned short u16x2 __attribute__((ext_vector_type(2)));
__device__ __forceinline__ v4i16_t ldtr(const LAS unsigned char* p) { return __builtin_amdgcn_ds_read_tr16_b64_v4i16((LAS v4i16_t*)p); }
__device__ __forceinline__ bf16x8 cat8(v4i16_t lo, v4i16_t hi) { bf16x8 r; r[0] = lo[0]; r[1] = lo[1]; r[2] = lo[2]; r[3] = lo[3]; r[4] = hi[0]; r[5] = hi[1]; r[6] = hi[2]; r[7] = hi[3]; return r; }
__device__ __forceinline__ int wave_total_i(int v) {
    v += dppi<0xB1>(v); v += dppi<0x4E>(v); v += dppi<0x141>(v); v += dppi<0x140>(v);
    return __builtin_amdgcn_readlane(v, 0) + __builtin_amdgcn_readlane(v, 16) + __builtin_amdgcn_readlane(v, 32) + __builtin_amdgcn_readlane(v, 48);
}
__device__ __forceinline__ void gmlp_unit(Frame& F, int l, int unit) {
    int tid = F.tid; asm volatile("" : "+v"(tid)); const int lane = tid & 63;
    const int chunk = unit >> 2, g = unit & 3, n0 = chunk * 128;
    const GAS bf16* PA = (const GAS bf16*)(F.ws + WS_PA); GAS bf16* Y = (GAS bf16*)(F.ws + WS_Y);
    LAS float* vln = (LAS float*)F.lds;
    LAS float* wl = (LAS float*)(F.lds + 65536);
    LAS float* st = (LAS float*)(F.lds + AUX_OFF);
    const GAS float* lng = ((const GAS float*)F.in[9]) + l * 512; const GAS float* lnb = ((const GAS float*)F.in[10]) + l * 512;
    for (int j = 0; j < 16; ++j) { const int s = F.wave * 16 + j;
        const u32x4 w = *(const GAS u32x4*)(PA + (size_t)(n0 + s) * NPA + PA_CV + 8 * lane);
        float x[8] = {bflo(w.x), bfhi(w.x), bflo(w.y), bfhi(w.y), bflo(w.z), bfhi(w.z), bflo(w.w), bfhi(w.w)};
        float sm = 0.f;
#pragma unroll
        for (int i = 0; i < 8; ++i) sm += x[i];
        const float mean = wave_sum(sm, lane) * (1.f / 512.f); float q = 0.f;
#pragma unroll
        for (int i = 0; i < 8; ++i) { const float d = x[i] - mean; q += d * d; }
        const float rstd = 1.f / sqrtf(wave_sum(q, lane) * (1.f / 512.f) + LN_EPS);
        if (lane == 0) { st[2 * s] = mean; st[2 * s + 1] = rstd; } }
    __syncthreads();
#pragma unroll
    for (int i = 0; i < 4; ++i) { const int q = tid + 512 * i, s = q >> 4, d0 = (q & 15) * 8;
        const u32x4 w = *(const GAS u32x4*)(PA + (size_t)(n0 + s) * NPA + PA_CV + g * 128 + d0);
        const float mean = st[2 * s], rstd = st[2 * s + 1];
        float x[8] = {bflo(w.x), bfhi(w.x), bflo(w.y), bfhi(w.y), bflo(w.z), bfhi(w.z), bflo(w.w), bfhi(w.w)};
#pragma unroll
        for (int k = 0; k < 8; ++k) x[k] = (x[k] - mean) * rstd * lng[g * 128 + d0 + k] + lnb[g * 128 + d0 + k];
        *(LAS f32x4*)(vln + s * 128 + d0) = (f32x4){x[0], x[1], x[2], x[3]}; *(LAS f32x4*)(vln + s * 128 + d0 + 4) = (f32x4){x[4], x[5], x[6], x[7]}; }
    const GAS float* ws = ((const GAS float*)F.in[11]) + ((size_t)l * 4 + g) * 128 * 128;
#pragma unroll
    for (int i = 0; i < 8; ++i) { const int q = tid + 512 * i, t = q >> 5, s0 = (q & 31) * 4;
        f32x4 w = *(const GAS f32x4*)(ws + t * 128 + s0);
        if (s0 + 0 > t) w.x = 0.f; if (s0 + 1 > t) w.y = 0.f; if (s0 + 2 > t) w.z = 0.f; if (s0 + 3 > t) w.w = 0.f;
        *(LAS f32x4*)(wl + t * 128 + s0) = w; }
    __syncthreads();
    const int d = tid & 127, tq = __builtin_amdgcn_readfirstlane(tid >> 7);
    float vr[128];
#pragma unroll
    for (int sb = 0; sb < 4; ++sb)
        if (sb <= tq) {
#pragma unroll
            for (int s = 0; s < 32; ++s) vr[sb * 32 + s] = vln[(sb * 32 + s) * 128 + d];
        } else {
#pragma unroll
            for (int s = 0; s < 32; ++s) vr[sb * 32 + s] = 0.f;
        }
    const GAS float* bs = ((const GAS float*)F.in[12]) + ((size_t)l * 4 + g) * 128;
#pragma unroll 1
    for (int ti = 0; ti < 32; ++ti) { const int t = tq * 32 + ti; float a = 0.f;
#pragma unroll
        for (int sb = 0; sb < 4; ++sb)
            if (sb <= tq) {
#pragma unroll
                for (int s4 = 0; s4 < 8; ++s4) { const f32x4 w = *(const LAS f32x4*)(wl + t * 128 + sb * 32 + s4 * 4);
                    a += w.x * vr[sb * 32 + s4 * 4] + w.y * vr[sb * 32 + s4 * 4 + 1] + w.z * vr[sb * 32 + s4 * 4 + 2] + w.w * vr[sb * 32 + s4 * 4 + 3]; }
            }
        const float uu = bf1(PA[(size_t)(n0 + t) * NPA + PA_CU + g * 128 + d]);
        Y[(size_t)(n0 + t) * 1536 + 1024 + g * 128 + d] = (bf16)f2bf(uu * (a + bs[t])); }
    __syncthreads();
}

__device__ __forceinline__ void gmlp16_unit(Frame& F, int l, int chunk) {
    const int lane = fresh_lane(), w = F.wave, tid = w * 64 + lane, fr = lane & 15, fq = lane >> 4;
    const size_t n0 = (size_t)chunk * 128;
    const GAS bf16* PA = (const GAS bf16*)(F.ws + WS_PA); GAS bf16* Y = (GAS bf16*)(F.ws + WS_Y);
    LAS unsigned char* VT = F.lds;
    LAS unsigned char* WT = F.lds + 32768;
    LAS float* st = (LAS float*)(F.lds + AUX_OFF);
    const GAS float* lng = ((const GAS float*)F.in[9]) + l * 512; const GAS float* lnb = ((const GAS float*)F.in[10]) + l * 512;
    for (int j = 0; j < 16; ++j) { const int s = w * 16 + j;
        const u32x4 x4 = *(const GAS u32x4*)(PA + (n0 + s) * NPA + PA_CV + 8 * lane);
        float x[8] = {bflo(x4.x), bfhi(x4.x), bflo(x4.y), bfhi(x4.y), bflo(x4.z), bfhi(x4.z), bflo(x4.w), bfhi(x4.w)};
        float sm = 0.f;
#pragma unroll
        for (int i = 0; i < 8; ++i) sm += x[i];
        const float mean = wave_sum(sm, lane) * (1.f / 512.f); float q = 0.f;
#pragma unroll
        for (int i = 0; i < 8; ++i) { const float d = x[i] - mean; q += d * d; }
        const float rstd = 1.f / sqrtf(wave_sum(q, lane) * (1.f / 512.f) + LN_EPS);
        if (lane == 0) { st[2 * s] = mean; st[2 * s + 1] = rstd; } }
    __syncthreads();
#pragma unroll 1
    for (int g = 0; g < 4; ++g) {
        const GAS float* ws = ((const GAS float*)F.in[11]) + ((size_t)l * 4 + g) * 128 * 128;
#pragma unroll
        for (int i = 0; i < 4; ++i) { const int q = tid + 512 * i, s = q >> 4, d0 = (q & 15) * 8;
            const u32x4 x4 = *(const GAS u32x4*)(PA + (n0 + s) * NPA + PA_CV + g * 128 + d0);
            const float mean = st[2 * s], rstd = st[2 * s + 1];
            float x[8] = {bflo(x4.x), bfhi(x4.x), bflo(x4.y), bfhi(x4.y), bflo(x4.z), bfhi(x4.z), bflo(x4.w), bfhi(x4.w)};
            const f32x4 g0 = *(const GAS f32x4*)(lng + g * 128 + d0), g1 = *(const GAS f32x4*)(lng + g * 128 + d0 + 4), b0 = *(const GAS f32x4*)(lnb + g * 128 + d0), b1 = *(const GAS f32x4*)(lnb + g * 128 + d0 + 4);
#pragma unroll
            for (int k = 0; k < 8; ++k) x[k] = (x[k] - mean) * rstd * ((k < 4) ? g0[k & 3] : g1[k & 3]) + ((k < 4) ? b0[k & 3] : b1[k & 3]);
            u32x4 o; o.x = cvt_pk_bf16(x[0], x[1]); o.y = cvt_pk_bf16(x[2], x[3]); o.z = cvt_pk_bf16(x[4], x[5]); o.w = cvt_pk_bf16(x[6], x[7]);
            *(LAS u32x4*)(VT + s * 256 + d0 * 2) = o;
            const int t = s, s0 = d0;
            f32x4 w0 = *(const GAS f32x4*)(ws + t * 128 + s0), w1 = *(const GAS f32x4*)(ws + t * 128 + s0 + 4);
            float wv[8] = {w0.x, w0.y, w0.z, w0.w, w1.x, w1.y, w1.z, w1.w};
#pragma unroll
            for (int k = 0; k < 8; ++k) wv[k] = (s0 + k <= t) ? wv[k] : 0.f;
            u32x4 ow; ow.x = cvt_pk_bf16(wv[0], wv[1]); ow.y = cvt_pk_bf16(wv[2], wv[3]); ow.z = cvt_pk_bf16(wv[4], wv[5]); ow.w = cvt_pk_bf16(wv[6], wv[7]);
            *(LAS u32x4*)(WT + t * 256 + s0 * 2) = ow; }
        __syncthreads();
        f32x4 acc[8];
#pragma unroll
        for (int nt = 0; nt < 8; ++nt) acc[nt] = (f32x4){0.f, 0.f, 0.f, 0.f};
        const int nks = (16 * w + 15) / 32 + 1;
#pragma unroll
        for (int ks = 0; ks < 4; ++ks) if (ks < nks) {
            const bf16x8 a = *(const LAS bf16x8*)(WT + (16 * w + fr) * 256 + (8 * fq + 32 * ks) * 2);
            const int srow = 32 * ks + 8 * fq + (fr >> 2);
#pragma unroll
            for (int nt = 0; nt < 8; ++nt) { const bf16x8 bv = cat8(ldtr(VT + srow * 256 + (16 * nt + 4 * (fr & 3)) * 2), ldtr(VT + (srow + 4) * 256 + (16 * nt + 4 * (fr & 3)) * 2));
                acc[nt] = __builtin_amdgcn_mfma_f32_16x16x32_bf16(bv, a, acc[nt], 0, 0, 0); } }
        const GAS float* bs = ((const GAS float*)F.in[12]) + ((size_t)l * 4 + g) * 128;
        { const int t = 16 * w + fr; const float bt = bs[t];
#pragma unroll
          for (int nt = 0; nt < 8; ++nt) { const int d0 = 16 * nt + 4 * fq;
              const u32x2 uu = *(const GAS u32x2*)(PA + (n0 + t) * NPA + PA_CU + g * 128 + d0);
              u32x2 wv; wv.x = pk2(bflo(uu.x) * (acc[nt][0] + bt), bfhi(uu.x) * (acc[nt][1] + bt)); wv.y = pk2(bflo(uu.y) * (acc[nt][2] + bt), bfhi(uu.y) * (acc[nt][3] + bt));
              *(GAS u32x2*)(Y + (n0 + t) * 1536 + 1024 + g * 128 + d0) = wv; } }
        __syncthreads();
    }
}

__device__ __forceinline__ void gla_unit(Frame& F, int l, int unit) {
    int tid = F.tid; asm volatile("" : "+v"(tid));
    const int b = unit >> 2, h = unit & 3;
    const GAS bf16* PA = (const GAS bf16*)(F.ws + WS_PA); GAS bf16* Y = (GAS bf16*)(F.ws + WS_Y); const GAS float* GLR = (const GAS float*)(F.ws + WS_GLR);
    LAS float* wa = (LAS float*)F.lds;
    LAS float* ba = wa + 1024;
    LAS float* as_ = ba + 64;
    LAS float* qs = as_ + 1024;
    LAS float* ks = qs + 1024;
    LAS float* vs = ks + 1024;
    LAS float* part = vs + 2048;
    for (int i = tid; i < 1024; i += 512) wa[i] = ((const GAS float*)F.in[6])[(size_t)l * 16 * 256 + (i >> 6) * 256 + h * 64 + (i & 63)];
    if (tid < 64) ba[tid] = ((const GAS float*)F.in[7])[l * 256 + h * 64 + tid];
    const GAS float* gng = ((const GAS float*)F.in[8]) + l * 128;
    const int v = tid & 127, kq = __builtin_amdgcn_readfirstlane(tid >> 7);
    float S[16];
#pragma unroll
    for (int j = 0; j < 16; ++j) S[j] = 0.f;
    __syncthreads();
    for (int t0 = 0; t0 < SEQ; t0 += 16) {
        const size_t nb = (size_t)b * SEQ + t0;
#pragma unroll
        for (int i = 0; i < 2; ++i) { const int e = tid + 512 * i, t = e >> 6, k = e & 63; float z = ba[k];
#pragma unroll
            for (int r = 0; r < 16; ++r) z += GLR[(nb + t) * 16 + r] * wa[r * 64 + k];
            const float ls = fminf(z, 0.f) - log1pf(__expf(-fabsf(z)));
            as_[e] = __expf(ls * (1.f / 16.f));
            qs[e] = bf1(PA[(nb + t) * NPA + PA_BQ + h * 64 + k]); ks[e] = bf1(PA[(nb + t) * NPA + PA_BK + h * 64 + k]); }
#pragma unroll
        for (int i = 0; i < 4; ++i) { const int e = tid + 512 * i, t = e >> 7, vv = e & 127; vs[e] = bf1(PA[(nb + t) * NPA + PA_BV + h * 128 + vv]); }
        __syncthreads();
#pragma unroll 4
        for (int t = 0; t < 16; ++t) { const float vt = vs[t * 128 + v]; float p = 0.f;
#pragma unroll
            for (int j4 = 0; j4 < 4; ++j4) { const f32x4 a4 = *(const LAS f32x4*)(as_ + t * 64 + kq * 16 + j4 * 4), k4 = *(const LAS f32x4*)(ks + t * 64 + kq * 16 + j4 * 4), q4 = *(const LAS f32x4*)(qs + t * 64 + kq * 16 + j4 * 4);
#pragma unroll
                for (int j = 0; j < 4; ++j) { S[j4 * 4 + j] = a4[j] * S[j4 * 4 + j] + k4[j] * vt; p += q4[j] * S[j4 * 4 + j]; } }
            part[(kq * 16 + t) * 128 + v] = p; }
        __syncthreads();
        { const int t = tid >> 5, v4 = (tid & 31) * 4;
          f32x4 o = *(const LAS f32x4*)(part + (0 * 16 + t) * 128 + v4);
#pragma unroll
          for (int q = 1; q < 4; ++q) o += *(const LAS f32x4*)(part + (q * 16 + t) * 128 + v4);
          float ss = o.x * o.x + o.y * o.y + o.z * o.z + o.w * o.w;
#pragma unroll
          for (int sh = 1; sh < 32; sh <<= 1) ss += shx(ss, sh, tid & 63);
          const float r = 1.f / sqrtf(ss * (1.f / 128.f) + RMS_EPS);
          const f32x4 gg = *(const GAS f32x4*)(gng + v4);
          const u32x2 brw = *(const GAS u32x2*)(PA + (nb + t) * NPA + PA_BR + h * 128 + v4);
          u32x2 w; w.x = pk2(o.x * r * gg.x * bflo(brw.x), o.y * r * gg.y * bfhi(brw.x)); w.y = pk2(o.z * r * gg.z * bflo(brw.y), o.w * r * gg.w * bfhi(brw.y));
          *(GAS u32x2*)(Y + (nb + t) * 1536 + 512 + h * 128 + v4) = w; }
        __syncthreads();
    }
}

constexpr size_t WS_US = WS_WMOE, WS_DEC = WS_WMOE + 32 * MiB;
__device__ __forceinline__ void gla_local_unit(Frame& F, int l, int unit, bool dry = false) {
    const int lane = fresh_lane(), w = F.wave, tid = w * 64 + lane, fr = lane & 15, fq = lane >> 4;
    const int b = unit >> 8, h = (unit >> 6) & 3, c = unit & 63; const size_t n0 = (size_t)b * SEQ + 64 * c;
    GAS bf16* PA = (GAS bf16*)(F.ws + WS_PA); GAS bf16* Y = (GAS bf16*)(F.ws + WS_Y); const GAS float* GLR = (const GAS float*)(F.ws + WS_GLR);
    GAS bf16* US = (GAS bf16*)(F.ws + WS_US) + (size_t)unit * 8192; GAS float* DEC = (GAS float*)(F.ws + WS_DEC) + unit * 64;
    LAS unsigned char* QT = F.lds; LAS unsigned char* KT = F.lds + 8192; LAS unsigned char* KD = F.lds + 16384; LAS unsigned char* VV = F.lds + 24576; LAS unsigned char* ATT = F.lds + 40960;
    LAS float* SEG = (LAS float*)(F.lds + 65536); LAS float* WA = (LAS float*)(F.lds + 67584); LAS float* BA = (LAS float*)(F.lds + 71680); LAS float* GL = (LAS float*)(F.lds + 71936);
    const int k = tid & 63, seg = w;
    float qv8[8], kv8[8];
#pragma unroll
    for (int i = 0; i < 8; ++i) { const int t = 8 * seg + i; qv8[i] = bf1(PA[(n0 + t) * NPA + PA_BQ + h * 64 + k]); kv8[i] = bf1(PA[(n0 + t) * NPA + PA_BK + h * 64 + k]); }
    if (tid < 256) *(LAS f32x4*)(GL + 4 * tid) = *(const GAS f32x4*)(GLR + n0 * 16 + 4 * tid);
#pragma unroll
    for (int i = 0; i < 2; ++i) { const int e = tid + 512 * i; WA[e] = ((const GAS float*)F.in[6])[(size_t)l * 16 * 256 + (e >> 6) * 256 + h * 64 + (e & 63)]; }
    if (tid < 64) BA[tid] = ((const GAS float*)F.in[7])[l * 256 + h * 64 + tid];
#pragma unroll
    for (int i = 0; i < 2; ++i) { const int piece = tid + 512 * i, row = piece >> 4, c16 = piece & 15;
        *(LAS u32x4*)(VV + row * 256 + c16 * 16) = *(const GAS u32x4*)(PA + (n0 + row) * NPA + PA_BV + h * 128 + 8 * c16); }
    __syncthreads();
    float cum[8];
    { float run = 0.f;
#pragma unroll
      for (int i = 0; i < 8; ++i) { const int t = 8 * seg + i; float z = BA[k];
          const f32x4 g0 = *(const LAS f32x4*)(GL + t * 16), g1 = *(const LAS f32x4*)(GL + t * 16 + 4), g2 = *(const LAS f32x4*)(GL + t * 16 + 8), g3 = *(const LAS f32x4*)(GL + t * 16 + 12);
#pragma unroll
          for (int r = 0; r < 4; ++r) { z += g0[r] * WA[r * 64 + k]; z += g1[r] * WA[(4 + r) * 64 + k]; z += g2[r] * WA[(8 + r) * 64 + k]; z += g3[r] * WA[(12 + r) * 64 + k]; }
          const float ls = fminf(z, 0.f) - log1pf(__expf(-fabsf(z)));
          run += ls * (1.f / 16.f); cum[i] = run; }
      SEG[seg * 64 + k] = run; }
    __syncthreads();
    { float off = 0.f, blast = 0.f;
#pragma unroll
      for (int s2 = 0; s2 < 8; ++s2) { const float sv = SEG[s2 * 64 + k]; blast += sv; off += (s2 < seg) ? sv : 0.f; }
#pragma unroll
      for (int i = 0; i < 8; ++i) { const int t = 8 * seg + i; const float bb = cum[i] + off;
          const float qv = qv8[i], kv = kv8[i];
          const unsigned qt = f2bf(qv * __expf(bb));
          ((LAS unsigned short*)QT)[t * 64 + k] = (unsigned short)qt; ((LAS unsigned short*)KT)[t * 64 + k] = (unsigned short)f2bf(kv * __expf(-bb)); ((LAS unsigned short*)KD)[t * 64 + k] = (unsigned short)f2bf(kv * __expf(blast - bb));
          if (!dry) PA[(n0 + t) * NPA + PA_BQ + h * 64 + k] = (bf16)qt; }
      if (seg == 0) DEC[k] = __expf(blast); }
    __syncthreads();
#pragma unroll
    for (int ii = 0; ii < 2; ++ii) { const int id = 2 * w + ii, ts = id >> 2, tt = id & 3;
        f32x4 d = {0.f, 0.f, 0.f, 0.f};
        if (ts <= tt) {
#pragma unroll
            for (int ks = 0; ks < 2; ++ks) { const bf16x8 a = *(const LAS bf16x8*)(KT + (16 * ts + fr) * 128 + (8 * fq + 32 * ks) * 2), bq = *(const LAS bf16x8*)(QT + (16 * tt + fr) * 128 + (8 * fq + 32 * ks) * 2);
                d = __builtin_amdgcn_mfma_f32_16x16x32_bf16(a, bq, d, 0, 0, 0); } }
        const int t = 16 * tt + fr, s0 = 16 * ts + 4 * fq;
        u32x2 pk; pk.x = cvt_pk_bf16((s0 <= t) ? d[0] : 0.f, (s0 + 1 <= t) ? d[1] : 0.f); pk.y = cvt_pk_bf16((s0 + 2 <= t) ? d[2] : 0.f, (s0 + 3 <= t) ? d[3] : 0.f);
        *(LAS u32x2*)(ATT + t * 128 + s0 * 2) = pk; }
    __syncthreads();
    { const int tr = w & 3, nh = w >> 2;
      f32x4 ao[4], au[4];
#pragma unroll
      for (int j = 0; j < 4; ++j) { ao[j] = (f32x4){0.f, 0.f, 0.f, 0.f}; au[j] = (f32x4){0.f, 0.f, 0.f, 0.f}; }
#pragma unroll
      for (int ks = 0; ks < 2; ++ks) {
          const bf16x8 aA = *(const LAS bf16x8*)(ATT + (16 * tr + fr) * 128 + (8 * fq + 32 * ks) * 2);
          const int srow = 32 * ks + 8 * fq + (fr >> 2);
          const bf16x8 aK = cat8(ldtr(KD + srow * 128 + (16 * tr + 4 * (fr & 3)) * 2), ldtr(KD + (srow + 4) * 128 + (16 * tr + 4 * (fr & 3)) * 2));
#pragma unroll
          for (int j = 0; j < 4; ++j) { const int nt = 4 * nh + j;
              const bf16x8 bv = cat8(ldtr(VV + srow * 256 + (16 * nt + 4 * (fr & 3)) * 2), ldtr(VV + (srow + 4) * 256 + (16 * nt + 4 * (fr & 3)) * 2));
              ao[j] = __builtin_amdgcn_mfma_f32_16x16x32_bf16(bv, aA, ao[j], 0, 0, 0);
              au[j] = __builtin_amdgcn_mfma_f32_16x16x32_bf16(bv, aK, au[j], 0, 0, 0); } }
#pragma unroll
      for (int j = 0; j < 4; ++j) { const int v0 = 16 * (4 * nh + j) + 4 * fq, row = 16 * tr + fr;
          u32x2 wo; wo.x = pk2(ao[j][0], ao[j][1]); wo.y = pk2(ao[j][2], ao[j][3]); *(GAS u32x2*)(Y + (n0 + row) * 1536 + 512 + h * 128 + v0) = wo;
          u32x2 wu; wu.x = pk2(au[j][0], au[j][1]); wu.y = pk2(au[j][2], au[j][3]); *(GAS u32x2*)(US + row * 128 + v0) = wu; } }
    __syncthreads();
}
__device__ __forceinline__ void gla_scan_phase(Frame& F, bool dry = false) {
    GAS bf16* USb = (GAS bf16*)(F.ws + WS_US); const GAS float* DECb = (const GAS float*)(F.ws + WS_DEC); const size_t dofs = dry ? (size_t)((GAS unsigned char*)F.H - (F.ws + WS_US)) / 4 : 0;
    for (int gt = F.wg * 512 + F.tid; gt < 131072; gt += F.G * 512) { const int e0 = 2 * gt, bh = e0 >> 13, kv = e0 & 8191, k = kv >> 7;
        GAS unsigned* p = (GAS unsigned*)(USb + (size_t)bh * 64 * 8192 + kv); const GAS float* dp = DECb + bh * 64 * 64 + k;
        float s0 = 0.f, s1 = 0.f;
#pragma unroll 8
        for (int c = 0; c < 64; ++c) { const unsigned u = p[(size_t)c * 4096]; const float d = dp[c * 64];
            p[(size_t)c * 4096 + dofs] = pk2(s0, s1);
            s0 = d * s0 + bflo(u); s1 = d * s1 + bfhi(u); } }
}
struct GlaOutRegs { u32x4 us[2]; bf16x8 aq[2]; u32x2 oi[4]; u32x2 br[4]; };
__device__ __forceinline__ void gla_out_load(Frame& F, int unit, int tid, int w, int fr, int fq, GlaOutRegs& R) {
    const int b = unit >> 8, h = (unit >> 6) & 3, c = unit & 63; const size_t n0 = (size_t)b * SEQ + 64 * c;
    const GAS bf16* PA = (const GAS bf16*)(F.ws + WS_PA); const GAS bf16* Y = (const GAS bf16*)(F.ws + WS_Y);
    const GAS bf16* US = (const GAS bf16*)(F.ws + WS_US) + (size_t)unit * 8192;
    const int tr = w >> 1, nh = w & 1, row = 16 * tr + fr;
#pragma unroll
    for (int i = 0; i < 2; ++i) R.us[i] = *(const GAS u32x4*)(US + (tid + 512 * i) * 8);
#pragma unroll
    for (int ks = 0; ks < 2; ++ks) R.aq[ks] = *(const GAS bf16x8*)(PA + (n0 + row) * NPA + PA_BQ + h * 64 + 8 * fq + 32 * ks);
#pragma unroll
    for (int j = 0; j < 4; ++j) { const int v0 = 16 * (4 * nh + j) + 4 * fq; R.oi[j] = *(const GAS u32x2*)(Y + (n0 + row) * 1536 + 512 + h * 128 + v0); R.br[j] = *(const GAS u32x2*)(PA + (n0 + row) * NPA + PA_BR + h * 128 + v0); }
}
__device__ __forceinline__ void gla_out_compute(Frame& F, int l, int unit, int tid, int lane, int w, int fr, int fq, const GlaOutRegs& R, bool dry = false) {
    const int b = unit >> 8, h = (unit >> 6) & 3, c = unit & 63; const size_t n0 = (size_t)b * SEQ + 64 * c;
    GAS bf16* Y = dry ? (GAS bf16*)F.H : (GAS bf16*)(F.ws + WS_Y);
    LAS unsigned char* SS = F.lds;
    LAS float* PS = (LAS float*)(F.lds + 16384);
    const GAS float* gng = ((const GAS float*)F.in[8]) + l * 128;
#pragma unroll
    for (int i = 0; i < 2; ++i) *(LAS u32x4*)(SS + (tid + 512 * i) * 16) = R.us[i];
    __syncthreads();
    const int tr = w >> 1, nh = w & 1, row = 16 * tr + fr;
    f32x4 acc[4];
#pragma unroll
    for (int j = 0; j < 4; ++j) acc[j] = (f32x4){0.f, 0.f, 0.f, 0.f};
#pragma unroll
    for (int ks = 0; ks < 2; ++ks) { const int krow = 32 * ks + 8 * fq + (fr >> 2);
#pragma unroll
        for (int j = 0; j < 4; ++j) { const int nt = 4 * nh + j;
            const bf16x8 bs = cat8(ldtr(SS + krow * 256 + (16 * nt + 4 * (fr & 3)) * 2), ldtr(SS + (krow + 4) * 256 + (16 * nt + 4 * (fr & 3)) * 2));
            acc[j] = __builtin_amdgcn_mfma_f32_16x16x32_bf16(bs, R.aq[ks], acc[j], 0, 0, 0); } }
    float ss = 0.f;
#pragma unroll
    for (int j = 0; j < 4; ++j) { const u32x2 oi = R.oi[j];
        acc[j][0] += bflo(oi.x); acc[j][1] += bfhi(oi.x); acc[j][2] += bflo(oi.y); acc[j][3] += bfhi(oi.y);
        ss += (acc[j][0] * acc[j][0] + acc[j][1] * acc[j][1]) + (acc[j][2] * acc[j][2] + acc[j][3] * acc[j][3]); }
    ss += shx(ss, 16, lane); ss += shx(ss, 32, lane);
    if (fq == 0) PS[row * 2 + nh] = ss;
    __syncthreads();
    { const float rinv = 1.f / sqrtf((PS[row * 2] + PS[row * 2 + 1]) * (1.f / 128.f) + RMS_EPS);
#pragma unroll
      for (int j = 0; j < 4; ++j) { const int v0 = 16 * (4 * nh + j) + 4 * fq; const f32x4 gg = *(const GAS f32x4*)(gng + v0); const u32x2 br = R.br[j];
          u32x2 wv; wv.x = pk2(acc[j][0] * rinv * gg[0] * bflo(br.x), acc[j][1] * rinv * gg[1] * bfhi(br.x)); wv.y = pk2(acc[j][2] * rinv * gg[2] * bflo(br.y), acc[j][3] * rinv * gg[3] * bfhi(br.y));
          *(GAS u32x2*)(Y + (n0 + row) * 1536 + 512 + h * 128 + v0) = wv; } }
    __syncthreads();
}
constexpr int DSA_WAVE_LDS = 17920;
__device__ __forceinline__ void dsa_unit(Frame& F, int unit) {
    int lane = F.lane; asm volatile("" : "+v"(lane)); const int w = F.wave;
    const int qb = 4095 - unit;
    const int b = qb & 7, t = (qb >> 3) * 8 + w;
    const size_t n = (size_t)b * SEQ + t, nb0 = (size_t)b * SEQ;
    const GAS bf16* PA = (const GAS bf16*)(F.ws + WS_PA); GAS bf16* Y = (GAS bf16*)(F.ws + WS_Y);
    const GAS bf16* KI = (const GAS bf16*)(F.ws + WS_KI); const GAS bf16* KA = (const GAS bf16*)(F.ws + WS_KA); const GAS bf16* VA = (const GAS bf16*)(F.ws + WS_VA);
    const GAS float* WI = (const GAS float*)(F.ws + WS_WI);
    LAS unsigned char* base = F.lds + w * DSA_WAVE_LDS;
    LAS unsigned* sc = (LAS unsigned*)base;
    LAS float* qi = (LAS float*)(base + 16384);
    LAS unsigned short* list = (LAS unsigned short*)(base + 16384 + 1024);
    { const u32x2 q2 = *(const GAS u32x2*)(PA + n * NPA + PA_QI + 4 * lane);
      *(LAS f32x4*)(qi + 4 * lane) = (f32x4){bflo(q2.x), bfhi(q2.x), bflo(q2.y), bfhi(q2.y)}; }
    asm volatile("s_waitcnt lgkmcnt(0)" ::: "memory");
    const f32x4 wi = {ld_f32(WI + n * 4), ld_f32(WI + n * 4 + 1), ld_f32(WI + n * 4 + 2), ld_f32(WI + n * 4 + 3)};
    const int nbat = (t >> 6) + 1;
    for (int kb = 0; kb < nbat; ++kb) { const int key = kb * 64 + lane, kc = key <= t ? key : t;
        const GAS u32x4* kp = (const GAS u32x4*)(KI + (nb0 + kc) * 64);
        float kf[64];
#pragma unroll
        for (int c = 0; c < 8; ++c) { const u32x4 kk = kp[c]; kf[8 * c] = bflo(kk.x); kf[8 * c + 1] = bfhi(kk.x); kf[8 * c + 2] = bflo(kk.y); kf[8 * c + 3] = bfhi(kk.y); kf[8 * c + 4] = bflo(kk.z); kf[8 * c + 5] = bfhi(kk.z); kf[8 * c + 6] = bflo(kk.w); kf[8 * c + 7] = bfhi(kk.w); }
        float score = 0.f;
#pragma unroll
        for (int h = 0; h < 4; ++h) { float d = 0.f;
#pragma unroll
            for (int c = 0; c < 16; ++c) { const f32x4 q4 = *(const LAS f32x4*)(qi + h * 64 + 4 * c); d += q4.x * kf[4 * c] + q4.y * kf[4 * c + 1] + q4.z * kf[4 * c + 2] + q4.w * kf[4 * c + 3]; }
            score += wi[h] * fmaxf(d, 0.f); }
        if (score == 0.f) score = 0.f;
        unsigned u = __builtin_bit_cast(unsigned, score); u = (u & 0x80000000u) ? ~u : (u | 0x80000000u);
        sc[key] = key <= t ? u : 0u; }
    asm volatile("s_waitcnt lgkmcnt(0)" ::: "memory");
    int nsel;
    if (t >= 256) {
        unsigned T = 0u;
        for (int bit = 31; bit >= 0; --bit) { const unsigned cand = T | (1u << bit); int cnt = 0;
            for (int j = 0; j < nbat; ++j) cnt += (sc[j * 64 + lane] >= cand) ? 1 : 0;
            if (wave_sum_i(cnt, lane) >= 256) T = cand; }
        int cgt = 0;
        for (int j = 0; j < nbat; ++j) cgt += (sc[j * 64 + lane] > T) ? 1 : 0;
        const int need = 256 - wave_sum_i(cgt, lane);
        int selbase = 0, tiebase = 0;
        for (int j = 0; j < nbat; ++j) { const unsigned x = sc[j * 64 + lane]; const bool eq = (x == T), gt = (x > T);
            const unsigned long long beq = __ballot(eq); const unsigned long long lt = (1ull << lane) - 1ull;
            const int trank = tiebase + __popcll(beq & lt);
            const bool sel = gt || (eq && trank < need);
            const unsigned long long bsel = __ballot(sel);
            if (sel) list[selbase + __popcll(bsel & lt)] = (unsigned short)(j * 64 + lane);
            selbase += __popcll(bsel); tiebase += __popcll(beq); }
        nsel = 256;
    } else {
        nsel = t + 1;
        for (int i = lane; i < 256; i += 64) list[i] = (unsigned short)(i <= t ? i : 0);
    }
    asm volatile("s_waitcnt lgkmcnt(0)" ::: "memory");
    LAS float* qm = (LAS float*)base;
    LAS float* Pl = (LAS float*)(base + 2048);
    { const u32x4 q8 = *(const GAS u32x4*)(PA + n * NPA + PA_Q + 8 * lane);
      *(LAS f32x4*)(qm + 8 * lane) = (f32x4){bflo(q8.x), bfhi(q8.x), bflo(q8.y), bfhi(q8.y)}; *(LAS f32x4*)(qm + 8 * lane + 4) = (f32x4){bflo(q8.z), bfhi(q8.z), bflo(q8.w), bfhi(q8.w)}; }
    asm volatile("s_waitcnt lgkmcnt(0)" ::: "memory");
#pragma unroll 1
    for (int bb = 0; bb < 4; ++bb) { const int i = bb * 64 + lane; const bool valid = i < nsel; const int key = valid ? (int)list[i] : 0;
        const GAS u32x4* kp = (const GAS u32x4*)(KA + (nb0 + key) * 64);
        float kf[64];
#pragma unroll
        for (int c = 0; c < 8; ++c) { const u32x4 kk = kp[c]; kf[8 * c] = bflo(kk.x); kf[8 * c + 1] = bfhi(kk.x); kf[8 * c + 2] = bflo(kk.y); kf[8 * c + 3] = bfhi(kk.y); kf[8 * c + 4] = bflo(kk.z); kf[8 * c + 5] = bfhi(kk.z); kf[8 * c + 6] = bflo(kk.w); kf[8 * c + 7] = bfhi(kk.w); }
        float lgv[8];
#pragma unroll
        for (int h = 0; h < 8; ++h) { float d = 0.f;
#pragma unroll
            for (int c = 0; c < 16; ++c) { const f32x4 q4 = *(const LAS f32x4*)(qm + h * 64 + 4 * c); d += q4.x * kf[4 * c] + q4.y * kf[4 * c + 1] + q4.z * kf[4 * c + 2] + q4.w * kf[4 * c + 3]; }
            lgv[h] = valid ? d : -INFINITY; }
        *(LAS f32x4*)(Pl + i * 8) = (f32x4){lgv[0], lgv[1], lgv[2], lgv[3]}; *(LAS f32x4*)(Pl + i * 8 + 4) = (f32x4){lgv[4], lgv[5], lgv[6], lgv[7]}; }
    asm volatile("s_waitcnt lgkmcnt(0)" ::: "memory");
    float lg[4][8];
#pragma unroll
    for (int bb = 0; bb < 4; ++bb) { const f32x4 a = *(const LAS f32x4*)(Pl + (bb * 64 + lane) * 8), c = *(const LAS f32x4*)(Pl + (bb * 64 + lane) * 8 + 4);
        lg[bb][0] = a.x; lg[bb][1] = a.y; lg[bb][2] = a.z; lg[bb][3] = a.w; lg[bb][4] = c.x; lg[bb][5] = c.y; lg[bb][6] = c.z; lg[bb][7] = c.w; }
    float den[8];
#pragma unroll
    for (int h = 0; h < 8; ++h) { float m = fmaxf(fmaxf(lg[0][h], lg[1][h]), fmaxf(lg[2][h], lg[3][h])); m = wave_max(m, lane); float s = 0.f;
#pragma unroll
        for (int bb = 0; bb < 4; ++bb) { lg[bb][h] = __expf(lg[bb][h] - m); s += lg[bb][h]; }
        den[h] = wave_sum(s, lane); }
#pragma unroll
    for (int bb = 0; bb < 4; ++bb) { const int i = bb * 64 + lane;
        *(LAS f32x4*)(Pl + i * 8) = (f32x4){lg[bb][0], lg[bb][1], lg[bb][2], lg[bb][3]}; *(LAS f32x4*)(Pl + i * 8 + 4) = (f32x4){lg[bb][4], lg[bb][5], lg[bb][6], lg[bb][7]}; }
    asm volatile("s_waitcnt lgkmcnt(0)" ::: "memory");
    float o[8];
#pragma unroll
    for (int h = 0; h < 8; ++h) o[h] = 0.f;
#pragma unroll 4
    for (int i = 0; i < nsel; ++i) { const int key = (int)list[i]; const float vv = bf1(VA[(nb0 + key) * 64 + lane]);
        const f32x4 p0 = *(const LAS f32x4*)(Pl + i * 8), p1 = *(const LAS f32x4*)(Pl + i * 8 + 4);
        o[0] += p0.x * vv; o[1] += p0.y * vv; o[2] += p0.z * vv; o[3] += p0.w * vv; o[4] += p1.x * vv; o[5] += p1.y * vv; o[6] += p1.z * vv; o[7] += p1.w * vv; }
#pragma unroll
    for (int h = 0; h < 8; ++h) Y[n * 1536 + h * 64 + lane] = (bf16)f2bf(o[h] / den[h]);
}

__device__ __forceinline__ bf16x8 scale_pack8(u32x4 raw, float s) {
    u32x4 o; o.x = cvt_pk_bf16(bflo(raw.x) * s, bfhi(raw.x) * s); o.y = cvt_pk_bf16(bflo(raw.y) * s, bfhi(raw.y) * s); o.z = cvt_pk_bf16(bflo(raw.z) * s, bfhi(raw.z) * s); o.w = cvt_pk_bf16(bflo(raw.w) * s, bfhi(raw.w) * s);
    return __builtin_bit_cast(bf16x8, o);
}
__device__ __forceinline__ void dsa16_unit(Frame& F, int unit) {
    const int lane = fresh_lane(); const int w = F.wave;
    const int qb = 2047 - unit;
    const int b = qb & 7, t0 = (qb >> 3) * 16;
    const size_t nb0 = (size_t)b * SEQ;
    const GAS bf16* PA = (const GAS bf16*)(F.ws + WS_PA); GAS bf16* Y = (GAS bf16*)(F.ws + WS_Y);
    const GAS bf16* KI = (const GAS bf16*)(F.ws + WS_KI); const GAS bf16* KA = (const GAS bf16*)(F.ws + WS_KA); const GAS bf16* VA = (const GAS bf16*)(F.ws + WS_VA);
    const GAS float* WI = (const GAS float*)(F.ws + WS_WI);
    LAS unsigned char* K16 = F.lds;
    LAS unsigned short* LIST = (LAS unsigned short*)(F.lds + AUX_OFF);
    const int fr = lane & 15, fq = lane >> 4;
#ifdef REP_S1
    for (int rep_ = 0; rep_ < REP_S1; ++rep_)
#endif
    {
        const int ql = fr >> 2, h = fr & 3;
        bf16x8 Bf[4][2]; float Linf[4];
#pragma unroll
        for (int g = 0; g < 4; ++g) { const size_t nq = nb0 + t0 + 4 * g + ql; const float wv = WI[nq * 4 + h];
#pragma unroll
            for (int ks = 0; ks < 2; ++ks) Bf[g][ks] = scale_pack8(*(const GAS u32x4*)(PA + nq * NPA + PA_QI + h * 64 + 8 * fq + 32 * ks), wv);
            Linf[g] = (wv >= 0.f) ? INFINITY : -INFINITY; }
        const int ntiles = (t0 >> 4) + 1;
        bf16x8 A0[4], A1[4];
#pragma unroll
        for (int j = 0; j < 4; ++j) { const int tile = (w + 8 * j < ntiles) ? w + 8 * j : ntiles - 1; const size_t krow = (nb0 + 16 * tile + fr) * 64;
            A0[j] = *(const GAS bf16x8*)(KI + krow + 8 * fq); A1[j] = *(const GAS bf16x8*)(KI + krow + 32 + 8 * fq); }
#pragma unroll 1
        for (int tb = w; tb < ntiles; tb += 32) {
            bf16x8 N0[4], N1[4];
#pragma unroll
            for (int j = 0; j < 4; ++j) { const int tn = tb + 32 + 8 * j; const int tile = (tn < ntiles) ? tn : ntiles - 1; const size_t krow = (nb0 + 16 * tile + fr) * 64;
                N0[j] = *(const GAS bf16x8*)(KI + krow + 8 * fq); N1[j] = *(const GAS bf16x8*)(KI + krow + 32 + 8 * fq); }
#pragma unroll
            for (int j = 0; j < 4; ++j) { const int tile = tb + 8 * j;
                if (tile < ntiles) {
                    const int kpos = 16 * tile + 4 * fq + h;
                    const int g7 = kpos >> 7, hf = (kpos >> 6) & 1, ln = kpos & 63;
                    const int koff = (g7 >> 2) * 1024 + ln * 16 + (g7 & 3) * 4 + hf * 2;
                    const bool lastt = (tile == ntiles - 1);
                    f32x4 d[4];
#pragma unroll
                    for (int g = 0; g < 4; ++g) d[g] = __builtin_amdgcn_mfma_f32_16x16x32_bf16(A0[j], Bf[g][0], (f32x4){0.f, 0.f, 0.f, 0.f}, 0, 0, 0);
#pragma unroll
                    for (int g = 0; g < 4; ++g) d[g] = __builtin_amdgcn_mfma_f32_16x16x32_bf16(A1[j], Bf[g][1], d[g], 0, 0, 0);
#define S1_STEP(g) const float a0##g = __builtin_amdgcn_fmed3f(d[g][0], 0.f, Linf[g]), a1##g = __builtin_amdgcn_fmed3f(d[g][1], 0.f, Linf[g]), a2##g = __builtin_amdgcn_fmed3f(d[g][2], 0.f, Linf[g]), a3##g = __builtin_amdgcn_fmed3f(d[g][3], 0.f, Linf[g]);
                    S1_STEP(0) S1_STEP(1) S1_STEP(2) S1_STEP(3)
#undef S1_STEP
#define S1_STEP(g) const float u0##g = a0##g + dppf<0xB1>(a0##g), u1##g = a1##g + dppf<0xB1>(a1##g), u2##g = a2##g + dppf<0xB1>(a2##g), u3##g = a3##g + dppf<0xB1>(a3##g);
                    S1_STEP(0) S1_STEP(1) S1_STEP(2) S1_STEP(3)
#undef S1_STEP
#define S1_STEP(g) const float p0##g = (h & 1) ? u1##g : u0##g, p1##g = (h & 1) ? u3##g : u2##g;
                    S1_STEP(0) S1_STEP(1) S1_STEP(2) S1_STEP(3)
#undef S1_STEP
#define S1_STEP(g) const float c0##g = p0##g + dppf<0x4E>(p0##g), c1##g = p1##g + dppf<0x4E>(p1##g);
                    S1_STEP(0) S1_STEP(1) S1_STEP(2) S1_STEP(3)
#undef S1_STEP
#define S1_STEP(g) const float s##g = ((h & 2) ? c1##g : c0##g) + 0.0f; const _Float16 hh##g = (_Float16)s##g; const unsigned hb##g = (unsigned)__builtin_bit_cast(unsigned short, hh##g); \
                    unsigned key##g = hb##g ^ ((unsigned)((int)(hb##g << 16) >> 31) | 0x8000u); if (lastt) key##g = (kpos <= t0 + 4 * g + ql) ? key##g : 0u;
                    S1_STEP(0) S1_STEP(1) S1_STEP(2) S1_STEP(3)
#undef S1_STEP
#define S1_STEP(g) *(LAS unsigned short*)(K16 + (4 * g + ql) * 8192 + koff) = (unsigned short)key##g;
                    S1_STEP(0) S1_STEP(1) S1_STEP(2) S1_STEP(3)
#undef S1_STEP
                }
            }
#pragma unroll
            for (int j = 0; j < 4; ++j) { A0[j] = N0[j]; A1[j] = N1[j]; }
        }
    }
    __syncthreads();
    if (t0 < 256) {
#pragma unroll 1
        for (int qq = 0; qq < 2; ++qq) { const int q = 2 * w + qq, nvalid = t0 + q + 1; LAS unsigned short* list = LIST + q * 256;
            for (int i = lane; i < 256; i += 64) list[i] = (unsigned short)(i < nvalid ? i : 0); }
    } else {
#ifndef REP_S2
#define REP_S2 1
#endif
#pragma unroll 1
        for (int qq = 0; qq < 2 * REP_S2; ++qq) {
            const int q = 2 * w + (qq & 1), nvalid = t0 + q + 1;
            LAS unsigned short* list = LIST + q * 256;
            const int ngrp = (nvalid + 511) >> 9;
            unsigned P[32];
#pragma unroll
            for (int grp = 0; grp < 8; ++grp) {
                if (grp < ngrp) { const u32x4 r = *(const LAS u32x4*)(K16 + q * 8192 + grp * 1024 + lane * 16);
#pragma unroll
                    for (int i = 0; i < 4; ++i) { const int g = 4 * grp + i; const int thr = nvalid - 128 * g; unsigned rr = r[i];
                        if (thr < 128) rr &= ((lane < thr) ? 0xffffu : 0u) | ((lane < thr - 64) ? 0xffff0000u : 0u);
                        P[g] = rr; }
                } else {
#pragma unroll
                    for (int i = 0; i < 4; ++i) P[4 * grp + i] = 0u;
                }
            }
            unsigned one2 = 0x00010001u; asm volatile("" : "+v"(one2));
#define DSA_PKCOUNT(dst, c1) do { const unsigned c1p_ = (c1) | ((c1) << 16); unsigned a_ = 0u; \
                _Pragma("unroll") for (int grp = 0; grp < 8; ++grp) if (grp < ngrp) { _Pragma("unroll") for (int i = 0; i < 4; ++i) { unsigned y_; \
                    asm("v_pk_sub_u16 %0, %1, %2 clamp\n\tv_pk_min_u16 %0, %0, %3" : "=&v"(y_) : "v"(P[4 * grp + i]), "v"(c1p_), "v"(one2)); a_ += y_; } } \
                dst = (int)((a_ & 0xffffu) + (a_ >> 16)); } while (0)
            LAS unsigned* hist = (LAS unsigned*)(F.lds + AUX_OFF + 8192) + w * 256;
            unsigned T; int tot_gt;
            { unsigned hi8 = 0u; int above = 0;
#pragma unroll
              for (int lvl = 0; lvl < 2; ++lvl) {
                  { unsigned z_ = 0u; asm volatile("" : "+v"(z_)); *(LAS u32x4*)(hist + 4 * lane) = (u32x4){z_, z_, z_, z_}; }
                  asm volatile("s_waitcnt lgkmcnt(0)" ::: "memory");
#pragma unroll
                  for (int grp = 0; grp < 8; ++grp) if (grp < ngrp) {
#pragma unroll
                      for (int i = 0; i < 4; ++i) { const unsigned lo = P[4 * grp + i] & 0xffffu, hi = P[4 * grp + i] >> 16;
                          if (lvl == 0) { __hip_atomic_fetch_add(hist + (lo >> 8), 1u, __ATOMIC_RELAXED, __HIP_MEMORY_SCOPE_WAVEFRONT); __hip_atomic_fetch_add(hist + (hi >> 8), 1u, __ATOMIC_RELAXED, __HIP_MEMORY_SCOPE_WAVEFRONT); }
                          else { if ((lo >> 8) == hi8) __hip_atomic_fetch_add(hist + (lo & 0xffu), 1u, __ATOMIC_RELAXED, __HIP_MEMORY_SCOPE_WAVEFRONT);
                                 if ((hi >> 8) == hi8) __hip_atomic_fetch_add(hist + (hi & 0xffu), 1u, __ATOMIC_RELAXED, __HIP_MEMORY_SCOPE_WAVEFRONT); } } }
                  asm volatile("s_waitcnt lgkmcnt(0)" ::: "memory");
                  const u32x4 hb = *(const LAS u32x4*)(hist + 4 * lane);
                  const int sl = (int)(hb.x + hb.y + hb.z + hb.w);
                  int inc = sl;
                  inc += __builtin_amdgcn_update_dpp(0, inc, 0x111, 0xf, 0xf, false); inc += __builtin_amdgcn_update_dpp(0, inc, 0x112, 0xf, 0xf, false);
                  inc += __builtin_amdgcn_update_dpp(0, inc, 0x114, 0xf, 0xf, false); inc += __builtin_amdgcn_update_dpp(0, inc, 0x118, 0xf, 0xf, false);
                  const int r0 = __builtin_amdgcn_readlane(inc, 15), r1 = __builtin_amdgcn_readlane(inc, 31), r2 = __builtin_amdgcn_readlane(inc, 47), r3 = __builtin_amdgcn_readlane(inc, 63);
                  inc += (fq >= 1 ? r0 : 0) + (fq >= 2 ? r1 : 0) + (fq >= 3 ? r2 : 0);
                  const int total = r0 + r1 + r2 + r3;
                  const int want = 256 - above;
                  int run = total - inc;
                  int fb = -1, fa = 0;
                  { const int h3 = (int)hb.w, h2 = (int)hb.z, h1 = (int)hb.y, h0 = (int)hb.x;
                    if (run < want && run + h3 >= want) { fb = 3; fa = run; } run += h3;
                    if (run < want && run + h2 >= want) { fb = 2; fa = run; } run += h2;
                    if (run < want && run + h1 >= want) { fb = 1; fa = run; } run += h1;
                    if (run < want && run + h0 >= want) { fb = 0; fa = run; } }
                  const unsigned long long fm = __ballot(fb >= 0);
                  const int src = (int)__builtin_ctzll(fm);
                  const int bstar = __builtin_amdgcn_readlane(4 * lane + fb, src), abv = __builtin_amdgcn_readlane(fa, src);
                  if (lvl == 0) { hi8 = (unsigned)bstar; above = abv; } else { T = (hi8 << 8) | (unsigned)bstar; tot_gt = above + abv; }
              } }
            int cge_l, cgt_l; DSA_PKCOUNT(cge_l, T - 1u); DSA_PKCOUNT(cgt_l, T);
            const int tot_ge = wave_total_i(cge_l);
            const bool alltie = (tot_ge == 256);
            const int c_l = alltie ? cge_l : cgt_l; const unsigned thrT = alltie ? T : T + 1u;
            int inc = c_l;
            inc += __builtin_amdgcn_update_dpp(0, inc, 0x111, 0xf, 0xf, false); inc += __builtin_amdgcn_update_dpp(0, inc, 0x112, 0xf, 0xf, false);
            inc += __builtin_amdgcn_update_dpp(0, inc, 0x114, 0xf, 0xf, false); inc += __builtin_amdgcn_update_dpp(0, inc, 0x118, 0xf, 0xf, false);
            { const int r0 = __builtin_amdgcn_readlane(inc, 15), r1 = __builtin_amdgcn_readlane(inc, 31), r2 = __builtin_amdgcn_readlane(inc, 47);
              inc += (fq >= 1 ? r0 : 0) + (fq >= 2 ? r1 : 0) + (fq >= 3 ? r2 : 0); }
            int kpos_ = inc - c_l;
#pragma unroll
            for (int grp = 0; grp < 8; ++grp) if (grp < ngrp) {
#pragma unroll
                for (int i = 0; i < 4; ++i) { const int g = 4 * grp + i; const unsigned lo = P[g] & 0xffffu, hi = P[g] >> 16;
                    if (lo >= thrT) { list[kpos_] = (unsigned short)(128 * g + lane); ++kpos_; }
                    if (hi >= thrT) { list[kpos_] = (unsigned short)(128 * g + 64 + lane); ++kpos_; } } }
            if (!alltie) {
                int rem = 256 - tot_gt, pos = tot_gt; const unsigned long long lt = (1ull << lane) - 1ull;
#pragma unroll
                for (int grp = 0; grp < 8; ++grp) if (grp < ngrp) {
#pragma unroll
                    for (int i = 0; i < 8; ++i) { const int g = 4 * grp + (i >> 1); const unsigned val = (i & 1) ? (P[g] >> 16) : (P[g] & 0xffffu);
                        const bool eq = (val == T); const unsigned long long beq = __ballot(eq);
                        if (beq != 0ull) { const int rank = __popcll(beq & lt); if (eq && rank < rem) list[pos + rank] = (unsigned short)(128 * g + 64 * (i & 1) + lane);
                            const int n = __popcll(beq), take = n < rem ? n : rem; pos += take; rem -= take; } } }
            }
#undef DSA_PKCOUNT
        }
    }
    asm volatile("s_waitcnt lgkmcnt(0)" ::: "memory");
    LAS unsigned char* Vs = F.lds + w * 16384;
#ifndef REP_S3
#define REP_S3 1
#endif
#pragma unroll 1
    for (int qq = 0; qq < 2 * REP_S3; ++qq) {
        const int q = 2 * w + (qq & 1), tq = t0 + q; const int nsel = (tq + 1 < 256) ? tq + 1 : 256;
        const size_t nq = nb0 + tq;
        const LAS unsigned short* list = LIST + q * 256;
        bf16x8 Qf[2];
#pragma unroll
        for (int ks = 0; ks < 2; ++ks) { u32x4 raw = {0u, 0u, 0u, 0u}; if (fr < 8) raw = *(const GAS u32x4*)(PA + nq * NPA + PA_Q + fr * 64 + 8 * fq + 32 * ks); Qf[ks] = __builtin_bit_cast(bf16x8, raw); }
        float lg[16][4];
#ifdef REP_S3K
#pragma unroll 1
        for (int repk = 0; repk < REP_S3K; ++repk)
#endif
        const int st_off = (lane >> 3) * 128 + (((lane & 7) ^ ((lane >> 3) & 7)) * 16);
        const int rd0 = fr * 128 + ((fq ^ (fr & 7)) * 16), rd1 = fr * 128 + (((fq + 4) ^ (fr & 7)) * 16);
#pragma unroll
        for (int hb = 0; hb < 2; ++hb) {
#pragma unroll
            for (int ib = 0; ib < 2; ++ib) { u32x4 kv[8];
#pragma unroll
                for (int i = 0; i < 8; ++i) { const int piece = (8 * ib + i) * 64 + lane; const int key = (int)list[128 * hb + (piece >> 3)];
                    kv[i] = *(const GAS u32x4*)(KA + (nb0 + key) * 64 + 8 * (lane & 7)); }
                __builtin_amdgcn_sched_barrier(0);
#pragma unroll
                for (int i = 0; i < 8; ++i) *(LAS u32x4*)(Vs + st_off + (8 * ib + i) * 1024) = kv[i];
            }
            asm volatile("s_waitcnt lgkmcnt(0)" ::: "memory");
#pragma unroll
            for (int j = 0; j < 8; ++j) { const int tt = 8 * hb + j;
                const bf16x8 A0 = *(const LAS bf16x8*)(Vs + rd0 + j * 2048), A1 = *(const LAS bf16x8*)(Vs + rd1 + j * 2048);
                f32x4 d = __builtin_amdgcn_mfma_f32_16x16x32_bf16(A0, Qf[0], (f32x4){0.f, 0.f, 0.f, 0.f}, 0, 0, 0);
                d = __builtin_amdgcn_mfma_f32_16x16x32_bf16(A1, Qf[1], d, 0, 0, 0);
#pragma unroll
                for (int r = 0; r < 4; ++r) lg[tt][r] = (16 * tt + 4 * fq + r < nsel) ? d[r] : -INFINITY; }
            asm volatile("s_waitcnt lgkmcnt(0)" ::: "memory");
        }
        float m = lg[0][0];
#pragma unroll
        for (int tt = 0; tt < 16; ++tt)
#pragma unroll
            for (int r = 0; r < 4; ++r) m = fmaxf(m, lg[tt][r]);
        m = fmaxf(m, shx(m, 16, lane)); m = fmaxf(m, shx(m, 32, lane));
        float den = 0.f;
#pragma unroll
        for (int tt = 0; tt < 16; ++tt)
#pragma unroll
            for (int r = 0; r < 4; ++r) { lg[tt][r] = __expf(lg[tt][r] - m); den += lg[tt][r]; }
        den += shx(den, 16, lane); den += shx(den, 32, lane);
        f32x4 acc[4];
#pragma unroll
        for (int nt = 0; nt < 4; ++nt) acc[nt] = (f32x4){0.f, 0.f, 0.f, 0.f};
#ifdef REP_S3V
#pragma unroll 1
        for (int repv = 0; repv < REP_S3V; ++repv) {
#pragma unroll
        for (int nt = 0; nt < 4; ++nt) acc[nt] = (f32x4){0.f, 0.f, 0.f, 0.f};
#endif
#pragma unroll
        for (int hh = 0; hh < 2; ++hh) {
#pragma unroll
            for (int ib = 0; ib < 2; ++ib) {
                u32x4 vv[8];
#pragma unroll
                for (int i = 0; i < 8; ++i) { const int piece = (8 * ib + i) * 64 + lane, row = piece >> 3, c = piece & 7; const int key = (int)list[128 * hh + row];
                    vv[i] = *(const GAS u32x4*)(VA + (nb0 + key) * 64 + 8 * c); }
                __builtin_amdgcn_sched_barrier(0);
#pragma unroll
                for (int i = 0; i < 8; ++i) { const int piece = (8 * ib + i) * 64 + lane; *(LAS u32x4*)(Vs + piece * 16) = vv[i]; }
            }
            asm volatile("s_waitcnt lgkmcnt(0)" ::: "memory");
#pragma unroll
            for (int s4 = 0; s4 < 4; ++s4) { const int s = 4 * hh + s4;
                u32x4 pa; pa.x = cvt_pk_bf16(lg[2 * s][0], lg[2 * s][1]); pa.y = cvt_pk_bf16(lg[2 * s][2], lg[2 * s][3]); pa.z = cvt_pk_bf16(lg[2 * s + 1][0], lg[2 * s + 1][1]); pa.w = cvt_pk_bf16(lg[2 * s + 1][2], lg[2 * s + 1][3]);
                const bf16x8 Pa = __builtin_bit_cast(bf16x8, pa);
                const int rowa = 32 * s4 + 4 * fq + (fr >> 2);
#pragma unroll
                for (int nt = 0; nt < 4; ++nt) {
                    const v4i16_t lo = __builtin_amdgcn_ds_read_tr16_b64_v4i16((LAS v4i16_t*)(Vs + rowa * 128 + (16 * nt + 4 * (fr & 3)) * 2));
                    const v4i16_t hi = __builtin_amdgcn_ds_read_tr16_b64_v4i16((LAS v4i16_t*)(Vs + (rowa + 16) * 128 + (16 * nt + 4 * (fr & 3)) * 2));
                    bf16x8 Bv; Bv[0] = lo[0]; Bv[1] = lo[1]; Bv[2] = lo[2]; Bv[3] = lo[3]; Bv[4] = hi[0]; Bv[5] = hi[1]; Bv[6] = hi[2]; Bv[7] = hi[3];
                    acc[nt] = __builtin_amdgcn_mfma_f32_16x16x32_bf16(Bv, Pa, acc[nt], 0, 0, 0); } }
            asm volatile("s_waitcnt lgkmcnt(0)" ::: "memory");
        }
#ifdef REP_S3V
        }
#endif
        if (fr < 8) { const float rden = 1.f / den;
#pragma unroll
            for (int nt = 0; nt < 4; ++nt) { u32x2 wv; wv.x = pk2(acc[nt][0] * rden, acc[nt][1] * rden); wv.y = pk2(acc[nt][2] * rden, acc[nt][3] * rden);
                *(GAS u32x2*)(Y + nq * 1536 + fr * 64 + 16 * nt + 4 * fq) = wv; } }
    }
}

#ifdef GLA_NAIVE
constexpr int NGLA = 32;
#else
constexpr int NGLA = 2048;
#endif
#ifdef DSA_NAIVE
constexpr int NDSA = 4096;
#else
constexpr int NDSA = 2048;
#endif
#ifdef GMLP_NAIVE
constexpr int NGM = 1024;
#else
constexpr int NGM = 256;
#endif
__device__ __forceinline__ void phase_mixer(Frame& F, int l, int slot = 0, int types = 7, bool dry = false) {
    (void)slot;
    for (int j = 0; j * F.G < NDSA; ++j) { const int u = j * F.G + ((j & 1) ? (F.G - 1 - F.wg) : F.wg);
        if (u >= NDSA) continue;
        __syncthreads(); if (EN_B2 && (types & 2)) {
#ifdef DSA_NAIVE
        dsa_unit(F, u);
#else
        dsa16_unit(F, u);
#endif
    } }
    for (int u = F.wg; u < NGLA; u += F.G) { __syncthreads(); if (EN_B1 && (types & 1)) {
#ifdef GLA_NAIVE
        gla_unit(F, l, u);
#else
        gla_local_unit(F, l, u, dry);
#endif
    } }
    for (int u = F.wg; u < NGM; u += F.G) { __syncthreads(); if (EN_B3 && (types & 4)) {
#ifdef GMLP_NAIVE
        gmlp_unit(F, l, u);
#else
        gmlp16_unit(F, l, u);
#endif
    } }
}
__device__ __forceinline__ void phase_gla_out(Frame& F, int l, bool dry = false) {
#ifndef GLA_NAIVE
    const int lane = fresh_lane(), w = F.wave, tid = w * 64 + lane, fr = lane & 15, fq = lane >> 4;
    GlaOutRegs R, N;
    if (F.wg < 2048) gla_out_load(F, F.wg, tid, w, fr, fq, R);
#pragma unroll 1
    for (int u = F.wg; u < 2048; u += F.G) { const int un = (u + F.G < 2048) ? u + F.G : u;
        gla_out_load(F, un, tid, w, fr, fq, N);
        gla_out_compute(F, l, u, tid, lane, w, fr, fq, R, dry);
        R = N; }
#endif
}

template <int CTRL> __device__ __forceinline__ float dpp_add(float v) { return v + dppf<CTRL>(v); }
__device__ __forceinline__ float row16_sum(float v) { v = dpp_add<0xB1>(v); v = dpp_add<0x4E>(v); v = dpp_add<0x141>(v); v = dpp_add<0x140>(v); return v; }
__device__ __forceinline__ void phase_ln_router(Frame& F, int l) {
    const GAS bf16* WRB = (const GAS bf16*)(F.ws + WS_WR) + (size_t)l * 48 * DM;
    LAS unsigned char* WB = F.lds;
    for (int i = F.tid; i < 48 * 128; i += 512) { const int n = i >> 7, c = i & 127; *(LAS u32x4*)(WB + n * 2048 + ((c ^ (n & 7)) * 16)) = *(const GAS u32x4*)(WRB + n * DM + 8 * c); }
    if (F.tid < 32) F.MISC[16 + F.tid] = 0u;
    __syncthreads();
    GAS bf16* HB = (GAS bf16*)(F.ws + WS_HB); const GAS bf16* T = (const GAS bf16*)F.H; GAS int* EID = (GAS int*)(F.ws + WS_ROUTE); GAS float* EW = (GAS float*)(F.ws + WS_ROUTE + 256 * 1024);
    const GAS float* g = ((const GAS float*)F.in[17]) + l * DM; const GAS float* bb = ((const GAS float*)F.in[18]) + l * DM; const GAS float* brg = ((const GAS float*)F.in[20]) + l * 4; const GAS float* bre = ((const GAS float*)F.in[22]) + l * 32;
    const int lane = fresh_lane();
    const int sub = lane & 15, rr = lane >> 4, fr = sub, fq = rr;
    LAS float* LG = (LAS float*)(F.lds + 98304) + F.wave * 768;
    for (int r0 = F.wg * 128; r0 < NTOK; r0 += F.G * 128) {
        const int m0 = r0 + F.wave * 16;
        u32x4 nx[8];
#pragma unroll
        for (int q = 0; q < 8; ++q) nx[q] = *(const GAS u32x4*)(T + (size_t)(m0 + rr) * DM + 8 * (sub + 16 * q));
#pragma unroll 1
        for (int j = 0; j < 4; ++j) { const int m = m0 + 4 * j + rr;
            float v[64]; float s = 0.f;
#pragma unroll
            for (int q = 0; q < 8; ++q) { const u32x4 x = nx[q]; v[8 * q] = bflo(x.x); v[8 * q + 1] = bfhi(x.x); v[8 * q + 2] = bflo(x.y); v[8 * q + 3] = bfhi(x.y); v[8 * q + 4] = bflo(x.z); v[8 * q + 5] = bfhi(x.z); v[8 * q + 6] = bflo(x.w); v[8 * q + 7] = bfhi(x.w); }
            { const int mn = (j < 3) ? m + 4 : m;
#pragma unroll
              for (int q = 0; q < 8; ++q) nx[q] = *(const GAS u32x4*)(T + (size_t)mn * DM + 8 * (sub + 16 * q)); }
#pragma unroll
            for (int i = 0; i < 64; ++i) s += v[i];
            const float mean = row16_sum(s) * (1.f / DM); float s2 = 0.f;
#pragma unroll
            for (int i = 0; i < 64; ++i) { v[i] -= mean; s2 += v[i] * v[i]; }
            const float rstd = 1.f / sqrtf(row16_sum(s2) * (1.f / DM) + LN_EPS);
#pragma unroll
            for (int q = 0; q < 8; ++q) { const int c = 8 * (sub + 16 * q); const f32x4 g0 = *(const GAS f32x4*)(g + c), g1 = *(const GAS f32x4*)(g + c + 4), b0 = *(const GAS f32x4*)(bb + c), b1 = *(const GAS f32x4*)(bb + c + 4);
#pragma unroll
                for (int i = 0; i < 4; ++i) { v[8 * q + i] = v[8 * q + i] * rstd * g0[i] + b0[i]; v[8 * q + 4 + i] = v[8 * q + 4 + i] * rstd * g1[i] + b1[i]; }
                u32x4 wv; wv.x = pk2(v[8 * q], v[8 * q + 1]); wv.y = pk2(v[8 * q + 2], v[8 * q + 3]); wv.z = pk2(v[8 * q + 4], v[8 * q + 5]); wv.w = pk2(v[8 * q + 6], v[8 * q + 7]);
                *(GAS u32x4*)(HB + (size_t)m * DM + c) = wv; } }
        asm volatile("s_waitcnt vmcnt(0)" ::: "memory");
        f32x4 acc[3];
#pragma unroll
        for (int nt = 0; nt < 3; ++nt) acc[nt] = (f32x4){0.f, 0.f, 0.f, 0.f};
#pragma unroll 1
        for (int kb = 0; kb < 4; ++kb) {
            bf16x8 af[8];
#pragma unroll
            for (int ks = 0; ks < 8; ++ks) af[ks] = *(const GAS bf16x8*)(HB + (size_t)(m0 + fr) * DM + 8 * fq + 32 * (8 * kb + ks));
#pragma unroll
            for (int ks = 0; ks < 8; ++ks) { const int c = fq + 4 * (8 * kb + ks);
#pragma unroll
                for (int nt = 0; nt < 3; ++nt) { const int n = 16 * nt + fr; const bf16x8 bw = *(const LAS bf16x8*)(WB + n * 2048 + ((c ^ (n & 7)) * 16));
                    acc[nt] = __builtin_amdgcn_mfma_f32_16x16x32_bf16(af[ks], bw, acc[nt], 0, 0, 0); } } }
#pragma unroll
        for (int nt = 0; nt < 3; ++nt)
#pragma unroll
            for (int r = 0; r < 4; ++r) LG[(4 * fq + r) * 48 + 16 * nt + fr] = acc[nt][r];
        asm volatile("s_waitcnt lgkmcnt(0)" ::: "memory");
        if (lane < 16) { const int m = m0 + lane; const LAS float* lgt = LG + lane * 48;
            int gi = 0; float gm = lgt[0] + brg[0];
#pragma unroll
            for (int q = 1; q < 4; ++q) { const float x = lgt[q] + brg[q]; if (x > gm) { gm = x; gi = q; } }
            float gs = 0.f;
#pragma unroll
            for (int q = 0; q < 4; ++q) gs += __expf(lgt[q] + brg[q] - gm);
            const float gp = 1.f / gs;
            float el[8];
#pragma unroll
            for (int q = 0; q < 8; ++q) el[q] = lgt[4 + 8 * gi + q] + bre[8 * gi + q];
            int i0 = 0; float v0 = el[0];
#pragma unroll
            for (int q = 1; q < 8; ++q) if (el[q] > v0) { v0 = el[q]; i0 = q; }
            int i1 = -1; float v1 = -INFINITY;
#pragma unroll
            for (int q = 0; q < 8; ++q) if (q != i0 && el[q] > v1) { v1 = el[q]; i1 = q; }
            const float ex = __expf(v1 - v0), w0 = gp / (1.f + ex), w1 = gp * ex / (1.f + ex);
            const int e0 = gi * 8 + i0, e1 = gi * 8 + i1;
            EID[2 * m] = e0; EID[2 * m + 1] = e1; EW[2 * m] = w0; EW[2 * m + 1] = w1;
            __hip_atomic_fetch_add((LAS unsigned*)(F.lds + MISC_OFF) + 16 + e0, 1u, __ATOMIC_RELAXED, __HIP_MEMORY_SCOPE_WORKGROUP);
            __hip_atomic_fetch_add((LAS unsigned*)(F.lds + MISC_OFF) + 16 + e1, 1u, __ATOMIC_RELAXED, __HIP_MEMORY_SCOPE_WORKGROUP); }
        asm volatile("s_waitcnt lgkmcnt(0)" ::: "memory");
    }
    __syncthreads();
    if (F.tid < 32) ((GAS int*)(F.ws + WS_CNTWG))[F.wg * 32 + F.tid] = (int)F.MISC[16 + F.tid];
}
__device__ __forceinline__ void phase_dispatch(Frame& F) {
    const GAS int* CNT = (const GAS int*)(F.ws + WS_CNTWG); const GAS int* EID = (const GAS int*)(F.ws + WS_ROUTE); const GAS float* EW = (const GAS float*)(F.ws + WS_ROUTE + 256 * 1024);
    GAS int* SROW = (GAS int*)(F.ws + WS_SROW); GAS int* ROWMAP = (GAS int*)(F.ws + WS_ROWMAP); GAS float* CWROW = (GAS float*)(F.ws + WS_CWROW); GAS int* META = (GAS int*)(F.ws + WS_META);
    LAS int* tot = (LAS int*)(F.lds + AUX_OFF);
    if (F.tid < 32) { int t = 0, mine = 0; for (int w = 0; w < F.G; ++w) { const int c = ld_i32(CNT + w * 32 + F.tid); t += c; if (w < F.wg) mine += c; } tot[F.tid] = t; tot[32 + F.tid] = mine; tot[96 + F.tid] = 0; }
    __syncthreads();
    if (F.tid == 0) { int rb = 0;
#pragma clang loop unroll(disable) vectorize(disable)
        for (int e = 0; e < 32; ++e) { tot[64 + e] = rb; rb += ((tot[e] + 255) >> 8) << 8; }
        tot[128] = rb; }
    __syncthreads();
    if (F.wg == 0) { const int nt = tot[128] >> 8; if (F.tid == 0) META[0] = nt;
        if (F.tid < nt) { int e = 0;
#pragma clang loop unroll(disable) vectorize(disable)
            for (int q = 1; q < 32; ++q) if (tot[64 + q] <= F.tid * 256) e = q;
            META[16 + F.tid] = e; } }
    for (int r0 = F.wg * 128; r0 < NTOK; r0 += F.G * 128) {
        if (F.tid < 256) { const int tok = r0 + (F.tid >> 1), slot = F.tid & 1; const int e = EID[2 * tok + slot];
            const int pos = (int)__hip_atomic_fetch_add((LAS unsigned*)&tot[96 + e], 1u, __ATOMIC_RELAXED, __HIP_MEMORY_SCOPE_WORKGROUP);
            const int sr = tot[64 + e] + tot[32 + e] + pos;
            ROWMAP[sr] = tok; CWROW[sr] = EW[2 * tok + slot]; SROW[2 * tok + slot] = sr; } }
    if (F.wg < 32) { const int e = F.wg; const int lo = tot[64 + e] + tot[e], hi = tot[64 + e] + (((tot[e] + 255) >> 8) << 8);
        for (int r = lo + F.tid; r < hi; r += 512) { ROWMAP[r] = 0; CWROW[r] = 0.f; } }
}
__device__ __forceinline__ void phase_ln2(Frame& F, int l, bool dry = false) {
    GAS bf16* HB = (GAS bf16*)(F.ws + WS_HB); GAS bf16* HBo = dry ? (GAS bf16*)(F.ws + WS_Y) : HB; GAS float* Ho = dry ? (GAS float*)(F.ws + WS_PA + 184 * MiB) : F.H; const GAS int* SROW = (const GAS int*)(F.ws + WS_SROW); const GAS bf16* FF2 = (const GAS bf16*)(F.ws + WS_FF2);
    const GAS float* g = ((const GAS float*)F.in[26]) + l * DM; const GAS float* bb = ((const GAS float*)F.in[27]) + l * DM; int lane = F.lane; asm volatile("" : "+v"(lane));
    const int gw = F.wg * 8 + F.wave, NGW = F.G * 8; const bool last = (l == DEPTH - 1);
    int m = gw;
    u32x4 hn[2], an[2], cn[2];
    if (m < NTOK) { const int s0 = ld_i32(SROW + 2 * m), s1 = ld_i32(SROW + 2 * m + 1);
#pragma unroll
        for (int j = 0; j < 2; ++j) { hn[j] = *(const GAS u32x4*)(HB + (size_t)m * DM + 8 * lane + 512 * j); an[j] = *(const GAS u32x4*)(FF2 + (size_t)s0 * DM + 8 * lane + 512 * j); cn[j] = *(const GAS u32x4*)(FF2 + (size_t)s1 * DM + 8 * lane + 512 * j); } }
#pragma unroll 1
    for (; m < NTOK; m += NGW) {
        float v[16];
#pragma unroll
        for (int j = 0; j < 2; ++j) { const u32x4 h = hn[j], a = an[j], c = cn[j];
            v[8 * j] = bflo(h.x) * DN_ALPHA + (bflo(a.x) + bflo(c.x)); v[8 * j + 1] = bfhi(h.x) * DN_ALPHA + (bfhi(a.x) + bfhi(c.x)); v[8 * j + 2] = bflo(h.y) * DN_ALPHA + (bflo(a.y) + bflo(c.y)); v[8 * j + 3] = bfhi(h.y) * DN_ALPHA + (bfhi(a.y) + bfhi(c.y));
            v[8 * j + 4] = bflo(h.z) * DN_ALPHA + (bflo(a.z) + bflo(c.z)); v[8 * j + 5] = bfhi(h.z) * DN_ALPHA + (bfhi(a.z) + bfhi(c.z)); v[8 * j + 6] = bflo(h.w) * DN_ALPHA + (bflo(a.w) + bflo(c.w)); v[8 * j + 7] = bfhi(h.w) * DN_ALPHA + (bfhi(a.w) + bfhi(c.w)); }
        const int mn = m + NGW;
        if (mn < NTOK) { const int s0 = ld_i32(SROW + 2 * mn), s1 = ld_i32(SROW + 2 * mn + 1);
#pragma unroll
            for (int j = 0; j < 2; ++j) { hn[j] = *(const GAS u32x4*)(HB + (size_t)mn * DM + 8 * lane + 512 * j); an[j] = *(const GAS u32x4*)(FF2 + (size_t)s0 * DM + 8 * lane + 512 * j); cn[j] = *(const GAS u32x4*)(FF2 + (size_t)s1 * DM + 8 * lane + 512 * j); } }
        float s = 0.f;
#pragma unroll
        for (int i = 0; i < 16; ++i) s += v[i];
        const float mean = wave_sum(s, lane) * (1.f / DM); float s2 = 0.f;
#pragma unroll
        for (int i = 0; i < 16; ++i) { v[i] -= mean; s2 += v[i] * v[i]; }
        const float rstd = 1.f / sqrtf(wave_sum(s2, lane) * (1.f / DM) + LN_EPS);
#pragma unroll
        for (int j = 0; j < 2; ++j) { const int c = 8 * lane + 512 * j; const f32x4 g0 = *(const GAS f32x4*)(g + c), g1 = *(const GAS f32x4*)(g + c + 4), b0 = *(const GAS f32x4*)(bb + c), b1 = *(const GAS f32x4*)(bb + c + 4);
#pragma unroll
            for (int i = 0; i < 4; ++i) { v[8 * j + i] = v[8 * j + i] * rstd * g0[i] + b0[i]; v[8 * j + 4 + i] = v[8 * j + 4 + i] * rstd * g1[i] + b1[i]; }
            if (last) { *(GAS f32x4*)(Ho + (size_t)m * DM + c) = (f32x4){v[8 * j], v[8 * j + 1], v[8 * j + 2], v[8 * j + 3]}; *(GAS f32x4*)(Ho + (size_t)m * DM + c + 4) = (f32x4){v[8 * j + 4], v[8 * j + 5], v[8 * j + 6], v[8 * j + 7]}; }
            else { u32x4 wv; wv.x = pk2(v[8 * j], v[8 * j + 1]); wv.y = pk2(v[8 * j + 2], v[8 * j + 3]); wv.z = pk2(v[8 * j + 4], v[8 * j + 5]); wv.w = pk2(v[8 * j + 6], v[8 * j + 7]); *(GAS u32x4*)(HBo + (size_t)m * DM + c) = wv; } }
    }
}

#ifndef EN_P
#define EN_P 1
#endif
#ifndef EN_A
#define EN_A 1
#endif
#ifndef EN_B
#define EN_B 1
#endif
#ifndef EN_C
#define EN_C 1
#endif
#ifndef EN_D
#define EN_D 1
#endif
#ifndef EN_E
#define EN_E 1
#endif
#ifndef EN_F
#define EN_F 1
#endif
#ifndef EN_G
#define EN_G 1
#endif
#ifndef EN_H
#define EN_H 1
#endif
#ifndef EN_I
#define EN_I 1
#endif
#ifndef EN_J
#define EN_J 1
#endif
constexpr int PPL = 12;
constexpr int N_PHASES = 1 + PPL * DEPTH;
#ifndef MK_ONE_LAUNCH
#define MK_ONE_LAUNCH 0
#endif
struct Args { const float* in[28]; float* out; unsigned char* ws; int ph_lo, ph_hi; };
static_assert(sizeof(Args) == 28 * 8 + 8 + 8 + 8, "no padding bytes in the argument struct");


__device__ __forceinline__ unsigned opaque_u32(unsigned x) { unsigned v; asm volatile("v_mov_b32 %0, %1" : "=v"(v) : "s"(x)); return (unsigned)__builtin_amdgcn_readfirstlane((int)v); }
__device__ __forceinline__ unsigned long long opaque_u64(unsigned long long x) { return ((unsigned long long)opaque_u32((unsigned)(x >> 32)) << 32) | opaque_u32((unsigned)x); }
__device__ __forceinline__ void launder(Frame& F) {
    F.ws = (GAS unsigned char*)opaque_u64((unsigned long long)F.ws); F.H = (GAS float*)opaque_u64((unsigned long long)F.H);
    F.ctl = (gu32*)opaque_u64((unsigned long long)F.ctl);
    unsigned z0 = 0u; asm volatile("" : "+v"(z0)); int ln = (int)__builtin_amdgcn_mbcnt_hi(~0u, __builtin_amdgcn_mbcnt_lo(~0u, z0));
    F.wave = (int)opaque_u32((unsigned)F.wave); F.lane = ln; F.tid = F.wave * 64 + ln;
    F.G = (int)opaque_u32((unsigned)F.G); F.wg = (int)opaque_u32((unsigned)F.wg);
}
__global__ void __launch_bounds__(512, 2) mk_fwd(Args args) {
    extern __shared__ __attribute__((aligned(16))) unsigned char lds_raw[];
    Frame F;
    F.lds = (LAS unsigned char*)lds_raw;
    F.MISC = (volatile LAS unsigned*)(F.lds + MISC_OFF);
    F.tid = threadIdx.x; F.lane = F.tid & 63; F.wave = __builtin_amdgcn_readfirstlane(F.tid >> 6);
    F.G = gridDim.x; F.wg = blockIdx.x;
    F.in = args.in;
    F.pos = (const GAS int*)args.in[1];
    F.H = (GAS float*)args.out; F.ws = (GAS unsigned char*)args.ws;
    F.ctl = (gu32*)(args.ws + WS_CTL);
    for (int u = F.tid; u < (LDS_BYTES - MISC_OFF) / 4; u += 512) ((LAS unsigned*)(F.lds + MISC_OFF))[u] = 0u;
    __syncthreads();
    const int lo = args.ph_lo, hi = args.ph_hi;
    const bool multi = (hi - lo) > 1;
    XcdBarrier bar; bar.bar = (unsigned*)(F.ctl + CW_BAR); bar.x = 0; bar.st = nullptr;
    if (multi) bar = xcd_barrier_post((unsigned*)(F.ctl + CW_BAR), F.MISC + 8);
#define IN(k) (lo <= (k) && (k) < hi)
#ifdef DUP_BARRIER
#define SEAM(k) do { if (IN(k) && IN((k) + 1)) { xcd_barrier(bar); xcd_barrier(bar); } } while (0)
#else
#define SEAM(k) do { if (IN(k) && IN((k) + 1)) xcd_barrier(bar); } while (0)
#endif

#ifdef DUP_P
    for (int rep = 0; rep < 2; ++rep)
#endif
    if (EN_P && IN(0)) { launder(F); phase_prologue(F); }
    SEAM(0);
#define HB ((GAS bf16*)(F.ws + WS_HB))
#define PA ((GAS bf16*)(F.ws + WS_PA))
#define Y ((GAS bf16*)(F.ws + WS_Y))
#define HM ((GAS bf16*)F.H + (size_t)NTOK * DM)
#define TT ((GAS bf16*)F.H)
    for (int l = 0; l < DEPTH; ++l) {
        const int pb = 1 + PPL * l;
#define wd (F.ws + WS_WDENSE + (size_t)l * WD_LAYER)
#ifdef DUP_A
        for (int rep = 0; rep < 2; ++rep)
#endif
        if (EN_A && IN(pb + 0)) { launder(F);
            DenseSched S; S.init(NTOK / 256, NPA / 256, F.G, F.wg, (const void*)HB, (size_t)256 * DM * 2, (const void*)(wd + WD_WA), (size_t)256 * DM * 2);
            EpiA E{PA, (GAS bf16*)(F.ws + WS_KA), (GAS bf16*)(F.ws + WS_VA), (GAS bf16*)(F.ws + WS_KI), (GAS float*)(F.ws + WS_WI), (GAS float*)(F.ws + WS_GLR), (const GAS float*)(F.ws + WS_ROPE), ((const GAS float*)F.in[5]) + l * 64};
#ifdef DUP_APLAIN
            { EpiPlainA E0{PA}; pg8::gemm_phase<EpiPlainA, DenseSched, false>(F.lds, S, E0, DM, DM, F.wave); }
#endif
#ifdef STAGGER_US
            if (F.wg & 1) { const unsigned long long t0 = __builtin_amdgcn_s_memrealtime(); while (__builtin_amdgcn_s_memrealtime() - t0 < (unsigned long long)(STAGGER_US * 100)) __builtin_amdgcn_s_sleep(8); }
#endif
            pg8::gemm_phase<EpiA, DenseSched, false>(F.lds, S, E, DM, DM, F.wave);
        }
        SEAM(pb + 0);
        if (EN_B && IN(pb + 1)) { launder(F);
#ifdef DUP_B
            phase_mixer(F, l, 1, DUP_B, true); launder(F);
#endif
            phase_mixer(F, l); }
        SEAM(pb + 1);
        if (EN_B && IN(pb + 2)) { launder(F);
#ifdef DUP_SCAN
            gla_scan_phase(F, true); launder(F);
#endif
            gla_scan_phase(F); }
        SEAM(pb + 2);
        if (EN_B && IN(pb + 3)) { launder(F);
#ifdef DUP_OUT
            phase_gla_out(F, l, true); launder(F);
#endif
            phase_gla_out(F, l); }
        SEAM(pb + 3);
#ifdef DUP_D
        for (int rep = 0; rep < 2; ++rep)
#endif
        if (EN_D && IN(pb + 4)) { launder(F);
            DenseSched S; S.init(NTOK / 256, DM / 256, F.G, F.wg, (const void*)Y, (size_t)256 * 1536 * 2, (const void*)(wd + WD_WBR), (size_t)256 * 512 * 2);
            S.nsub = 3; S.asub = 512 * 2; S.bsub = (size_t)1024 * 512 * 2;
            EpiP E{PA};
            pg8::gemm_phase<EpiP, DenseSched, false>(F.lds, S, E, 512, 1536, F.wave);
        }
#ifdef DUP_C
        for (int rep = 0; rep < 2; ++rep)
#endif
        if (EN_C && IN(pb + 4)) { launder(F);
            DenseSched S; S.init(NTOK / 256, DM / 256, F.G, F.wg, (const void*)HB, (size_t)256 * DM * 2, (const void*)(wd + WD_WG), (size_t)256 * DM * 2);
            S.nsub = 3; S.asub = 0; S.bsub = (size_t)1024 * DM * 2;
            EpiGM E{PA, HM};
            pg8::gemm_phase<EpiGM, DenseSched, false>(F.lds, S, E, DM, DM, F.wave);
        }
        SEAM(pb + 4);
#ifdef DUP_E
        for (int rep = 0; rep < 2; ++rep)
#endif
        if (EN_E && IN(pb + 6)) { launder(F);
            DenseSched S; S.init(NTOK / 256, DM / 256, F.G, F.wg, (const void*)HM, (size_t)256 * DM * 2, (const void*)(wd + WD_WOUT), (size_t)256 * DM * 2);
            EpiO E{HB, TT};
            pg8::gemm_phase<EpiO, DenseSched, false>(F.lds, S, E, DM, DM, F.wave);
        }
        SEAM(pb + 6);
#ifdef DUP_F
        for (int rep = 0; rep < 2; ++rep)
#endif
        if (EN_F && IN(pb + 7)) { launder(F); phase_ln_router(F, l); }
        SEAM(pb + 7);
#ifdef DUP_G
        for (int rep = 0; rep < 2; ++rep)
#endif
        if (EN_G && IN(pb + 8)) { launder(F);
            { LAS float* scr = (LAS float*)(F.lds + F.wave * 16384);
              conv_run<true>(F, l, 12288, scr);
              __syncthreads(); }
            phase_dispatch(F); }
        SEAM(pb + 8);
#ifdef DUP_H
        for (int rep = 0; rep < 2; ++rep)
#endif
        if (EN_H && IN(pb + 9)) { launder(F);
            const GAS int* META = (const GAS int*)(F.ws + WS_META); const GAS int* ROWMAP = (const GAS int*)(F.ws + WS_ROWMAP);
            const int NT = ld_i32(META), NU = NT * 2;
            LAS int* meta = (LAS int*)(F.lds + AUX_OFF); LAS int* rows = (LAS int*)(F.lds + AUX_OFF + 64);
            for (int i = 0; i * F.G + F.wg < NU && i < 8; ++i) { const int L = i * F.G + F.wg, gt = L >> 1;
                if (F.tid == 0) meta[i] = ld_i32(META + 16 + gt);
                if (F.tid < 256) rows[i * 256 + F.tid] = ROWMAP[gt * 256 + F.tid]; }
            __syncthreads();
            GroupSched S{NU, F.G, F.wg, 2, (const char*)HB, (const char*)(F.ws + WS_WMOE + WM_GU), 0, (size_t)512 * DM * 2, (size_t)256 * DM * 2, meta, rows};
            EpiGU E{(GAS bf16*)(F.ws + WS_HID), (const GAS float*)(F.ws + WS_CWROW)};
            pg8::gemm_phase<EpiGU, GroupSched, true>(F.lds, S, E, DM, DM, F.wave);
        }
        SEAM(pb + 9);
#ifdef DUP_I
        for (int rep = 0; rep < 2; ++rep)
#endif
        if (EN_I && IN(pb + 10)) { launder(F);
            const GAS int* META = (const GAS int*)(F.ws + WS_META);
            const int NT = ld_i32(META), NU = NT * 4;
            LAS int* meta = (LAS int*)(F.lds + AUX_OFF);
            for (int i = 0; i * F.G + F.wg < NU && i < 8; ++i) { const int L = i * F.G + F.wg, gt = L >> 2; if (F.tid == 0) meta[i] = ld_i32(META + 16 + gt); }
            __syncthreads();
            GroupSched S{NU, F.G, F.wg, 4, (const char*)(F.ws + WS_HID), (const char*)(F.ws + WS_WMOE + WM_DN), (size_t)256 * DEXP * 2, (size_t)DM * DEXP * 2, (size_t)256 * DEXP * 2, meta, nullptr};
            EpiDN E{(GAS bf16*)(F.ws + WS_FF2)};
            pg8::gemm_phase<EpiDN, GroupSched, false>(F.lds, S, E, DEXP, DEXP, F.wave);
        }
        SEAM(pb + 10);
        if (EN_J && IN(pb + 11)) { launder(F);
#ifdef DUP_J
            phase_ln2(F, l, true); launder(F);
#endif
            phase_ln2(F, l); }
        SEAM(pb + 11);
    }
#undef IN
#undef SEAM
#undef HB
#undef HM
#undef TT
#undef PA
#undef Y
#undef wd
}


#ifdef DUMP_OFF
__global__ void dump_k(const unsigned short* src, float* out) {
    for (size_t i = (size_t)blockIdx.x * blockDim.x + threadIdx.x; i < (size_t)NTOK * 1024; i += (size_t)gridDim.x * blockDim.x) { const size_t n = i >> 10, c = i & 1023; out[i] = __builtin_bit_cast(float, ((unsigned)src[n * DUMP_PITCH + c]) << 16); }
}
#endif
extern "C" void kernel_launch(void* const* d_in, const int* in_sizes, int n_in, void* d_out, int out_size, void* d_ws, size_t ws_size, hipStream_t stream) {
    static int grid = 0;
    if (grid == 0) {
        if (n_in != 28 || out_size != NTOK * DM || ws_size < WS_END) { fprintf(stderr, "kernel_launch: unexpected shapes (n_in %d out %d ws %zu); nothing launched\n", n_in, out_size, ws_size); grid = -1; return; }
        int dev = 0, cus = 0;
        if (hipGetDevice(&dev) != hipSuccess || hipDeviceGetAttribute(&cus, hipDeviceAttributeMultiprocessorCount, dev) != hipSuccess) { grid = -1; return; }
        if (hipFuncSetAttribute((const void*)mk_fwd, hipFuncAttributeMaxDynamicSharedMemorySize, LDS_BYTES) != hipSuccess) { fprintf(stderr, "kernel_launch: hipFuncSetAttribute failed\n"); grid = -1; return; }
        int per_cu = 0;
        if (hipOccupancyMaxActiveBlocksPerMultiprocessor(&per_cu, (const void*)mk_fwd, 512, LDS_BYTES) != hipSuccess || per_cu < 1) { fprintf(stderr, "kernel_launch: occupancy query says %d\n", per_cu); }
        (void)hipGetLastError();
        grid = cus;
        if (grid != 256) fprintf(stderr, "kernel_launch: %d CUs (built for 256)\n", grid);
    }
    if (grid < 0) return;
    if (hipMemsetAsync((char*)d_ws + WS_CTL, 0, CTL_ZERO_BYTES, stream) != hipSuccess) return;
    Args a{};
    for (int i = 0; i < 28; ++i) a.in[i] = (const float*)d_in[i];
    a.out = (float*)d_out; a.ws = (unsigned char*)d_ws;
#if MK_ONE_LAUNCH
    a.ph_lo = 0; a.ph_hi = N_PHASES;
    hipLaunchKernelGGL(mk_fwd, dim3(grid), dim3(512), LDS_BYTES, stream, a);
#else
#ifndef STOP_AFTER
#define STOP_AFTER (N_PHASES - 1)
#endif
#ifndef PHASE_MASK
#define PHASE_MASK 0xffffffffu
#endif
    for (int p = 0; p <= STOP_AFTER; ++p) { if (!((PHASE_MASK >> p) & 1u)) continue; a.ph_lo = p; a.ph_hi = p + 1; hipLaunchKernelGGL(mk_fwd, dim3(grid), dim3(512), LDS_BYTES, stream, a); }
#ifdef DUMP_OFF
    hipLaunchKernelGGL(dump_k, dim3(2048), dim3(256), 0, stream, (const unsigned short*)((const char*)d_ws + (size_t)(DUMP_OFF)), (float*)d_out);
#endif
#endif
}
```

```cpp
#define MK_ONE_LAUNCH 1
#include <hip/hip_runtime.h>
#include <cstdio>
#include <cstdint>

#define LAS __attribute__((address_space(3)))
#define GAS __attribute__((address_space(1)))
typedef unsigned short bf16;
typedef short bf16x8 __attribute__((ext_vector_type(8)));
typedef float f32x4 __attribute__((ext_vector_type(4)));
typedef float f32x2 __attribute__((ext_vector_type(2)));
typedef unsigned u32x4 __attribute__((ext_vector_type(4)));
typedef unsigned u32x2 __attribute__((ext_vector_type(2)));
typedef GAS unsigned gu32;

constexpr int NB = 8, SEQ = 4096, NTOK = NB * SEQ, DM = 1024, NIN = 6612, DEPTH = 2;
constexpr int NPA = 3584;
constexpr int NGT = 3072;
constexpr int NEXP = 32, DEXP = 256;
constexpr int MAXTILES = 288;
constexpr float DN_ALPHA = 1.41421356237309515f;
constexpr float LN_EPS = 1e-5f, RMS_EPS = 1e-6f;
constexpr int PA_Q = 0, PA_QI = 768, PA_BQ = 1024, PA_BK = 1280, PA_BV = 1536, PA_BR = 2048, PA_CU = 2560, PA_CV = 3072;

__device__ __forceinline__ unsigned f2bf(float f) { unsigned u = __builtin_bit_cast(unsigned, f); return (u + 0x7fffu + ((u >> 16) & 1u)) >> 16; }
__device__ __forceinline__ unsigned pk2(float lo, float hi) { return f2bf(lo) | (f2bf(hi) << 16); }
__device__ __forceinline__ float bflo(unsigned w) { return __builtin_bit_cast(float, w << 16); }
__device__ __forceinline__ float bfhi(unsigned w) { return __builtin_bit_cast(float, w & 0xffff0000u); }
__device__ __forceinline__ float bf1(bf16 h) { return __builtin_bit_cast(float, ((unsigned)h) << 16); }
typedef __bf16 bf16x2_t __attribute__((ext_vector_type(2)));
__device__ __forceinline__ unsigned cvt_pk_bf16(float lo, float hi) { const f32x2 v = {lo, hi}; const bf16x2_t b = __builtin_convertvector(v, bf16x2_t); return __builtin_bit_cast(unsigned, b); }
__device__ __forceinline__ float shx(float v, int mask, int lane) { return __builtin_bit_cast(float, __builtin_amdgcn_ds_bpermute((lane ^ mask) << 2, __builtin_bit_cast(int, v))); }
__device__ __forceinline__ int shxi(int v, int mask, int lane) { return __builtin_amdgcn_ds_bpermute((lane ^ mask) << 2, v); }
__device__ __forceinline__ float wave_sum(float v, int lane) {
#pragma unroll
    for (int o = 1; o < 64; o <<= 1) v += shx(v, o, lane);
    return v;
}
__device__ __forceinline__ float wave_max(float v, int lane) {
#pragma unroll
    for (int o = 1; o < 64; o <<= 1) v = fmaxf(v, shx(v, o, lane));
    return v;
}
__device__ __forceinline__ int wave_sum_i(int v, int lane) {
#pragma unroll
    for (int o = 1; o < 64; o <<= 1) v += shxi(v, o, lane);
    return v;
}
__device__ __forceinline__ int fresh_lane() { unsigned z0 = 0u; asm volatile("" : "+v"(z0)); return (int)__builtin_amdgcn_mbcnt_hi(~0u, __builtin_amdgcn_mbcnt_lo(~0u, z0)); }
__device__ __forceinline__ int ld_i32(const GAS int* p) { return __hip_atomic_load(p, __ATOMIC_RELAXED, __HIP_MEMORY_SCOPE_AGENT); }
__device__ __forceinline__ float ld_f32(const GAS float* p) { return __hip_atomic_load(p, __ATOMIC_RELAXED, __HIP_MEMORY_SCOPE_AGENT); }
__device__ __forceinline__ float sigmoidf_(float x) { return __builtin_amdgcn_rcpf(1.0f + __expf(-x)); }
__device__ __forceinline__ float siluf_(float x) { return x * sigmoidf_(x); }
__device__ __forceinline__ float gelu_tanh_(float x) { const float u = 0.7978845608028654f * (x + 0.044715f * x * x * x); return x * sigmoidf_(2.0f * u); }

namespace pg8 {
constexpr int BM = 256, BK = 64, HALF = 128, HTB = HALF * BK * 2, STAGE_BYTES = 8 * HTB;
__host__ __device__ __forceinline__ int lds_byte(int r, int c) { const int st = (r >> 4) * 2 + (c >> 5), rr = r & 15, cc = c & 31, ob = rr * 64 + cc * 2; return st * 1024 + (ob ^ (((ob >> 9) & 1) << 5)); }
__host__ __device__ __forceinline__ void stage_rc(int b, int& R, int& C) { const int st = b / 1024, sb = b % 1024, swz = sb ^ (((sb >> 9) & 1) << 5); R = (st >> 1) * 16 + swz / 64; C = (st & 1) * 32 + (swz % 64) / 2; }
__host__ __device__ __forceinline__ int perm32(int rho) { const int n = rho >> 4, i = rho & 15; return 8 * (i >> 2) + 4 * n + (i & 3); }

struct Unit { int pm, pn, e, slot; };

#ifndef PG8_ALIGN
#define PG8_ALIGN true
#endif
template <class Epi, class Sched, bool GATHER, bool ALIGN_EPI = PG8_ALIGN>
__device__ __forceinline__ void gemm_phase(LAS unsigned char* lds, const Sched& S, const Epi& E, const int K, const int lda, const int wave) {
    unsigned z0_ = 0u; asm volatile("" : "+v"(z0_)); const int lane_ = (int)__builtin_amdgcn_mbcnt_hi(~0u, __builtin_amdgcn_mbcnt_lo(~0u, z0_));
    const int wid = wave, lane = lane_, tid = wid * 64 + lane, wr = wid >> 2, wc = wid & 3, fr = lane & 15, fq = lane >> 4;
    const int nt = K / BK;
    int Rr[2], Cc[2];
    unsigned voffB[2];
#pragma unroll
    for (int i = 0; i < 2; ++i) { int R, C; stage_rc(tid * 16 + i * 8192, R, C); Rr[i] = R; Cc[i] = C; const int Rb = Epi::PERM ? ((R & ~31) + perm32(R & 31)) : R; voffB[i] = (unsigned)(Rb * K + C) * 2u; }
    const size_t kstep = (size_t)(BK * 2);
    const size_t hstepB = (size_t)HALF * K * 2;
    const unsigned ldsw = (unsigned)wid * 1024u;
    const int aoff = lds_byte(wr * 64 + fr, fq * 8), boff = lds_byte(wc * 32 + fr, fq * 8);
#define PG8_SA(b, h) (((b) * 2 + (h)) * HTB)
#define PG8_SB(b, h) ((4 + (b) * 2 + (h)) * HTB)
#define PG8_STAGE(bufoff, gbase, voff) do { _Pragma("unroll") for (int _i = 0; _i < 2; ++_i) \
        __builtin_amdgcn_global_load_lds((const unsigned*)((const char*)(gbase) + (voff)[_i]), (LAS unsigned*)(lds + (bufoff) + ldsw + _i * 8192), 16, 0, 0); } while (0)
#define PG8_LDA(dst, b, h) do { _Pragma("unroll") for (int m = 0; m < 4; ++m) _Pragma("unroll") for (int k = 0; k < 2; ++k) dst[m][k] = *(const LAS bf16x8*)(lds + PG8_SA(b, h) + aoff + m * 2048 + k * 1024); } while (0)
#define PG8_LDB(dst, b, h) do { _Pragma("unroll") for (int n = 0; n < 2; ++n) _Pragma("unroll") for (int k = 0; k < 2; ++k) dst[n][k] = *(const LAS bf16x8*)(lds + PG8_SB(b, h) + boff + n * 2048 + k * 1024); } while (0)
#define PG8_MMA(ai, bj, At, Bt) do { __builtin_amdgcn_s_setprio(1); _Pragma("unroll") for (int m = 0; m < 4; ++m) _Pragma("unroll") for (int n = 0; n < 2; ++n) _Pragma("unroll") for (int k = 0; k < 2; ++k) \
        acc[ai][bj][m][n] = __builtin_amdgcn_mfma_f32_16x16x32_bf16(Bt[n][k], At[m][k], acc[ai][bj][m][n], 0, 0, 0); __builtin_amdgcn_s_setprio(0); } while (0)
#define PG8_WAIT_V(n) asm volatile("s_waitcnt vmcnt(" #n ")" ::: "memory")
#define PG8_WAIT_L(n) asm volatile("s_waitcnt lgkmcnt(" #n ")" ::: "memory")
#define PG8_BAR do { asm volatile("" ::: "memory"); __builtin_amdgcn_s_barrier(); asm volatile("" ::: "memory"); } while (0)
#define PG8_SCHED __builtin_amdgcn_sched_barrier(0)
    Unit cur, nxt; int ui = 0;
    if (!S.next(0, cur)) return;
    f32x4 acc[2][2][4][2];
#pragma unroll
    for (int a = 0; a < 2; ++a)
#pragma unroll
        for (int b = 0; b < 2; ++b)
#pragma unroll
            for (int m = 0; m < 4; ++m)
#pragma unroll
                for (int n = 0; n < 2; ++n) acc[a][b][m][n] = (f32x4){0.f, 0.f, 0.f, 0.f};
    bf16x8 At[4][2], B0[2][2], B1[2][2];
    unsigned cA0[2], cA1[2], nA0[2], nA1[2];
#pragma unroll
    for (int i = 0; i < 2; ++i) {
        if (GATHER) { cA0[i] = (unsigned)(S.row_of(cur, Rr[i]) * lda + Cc[i]) * 2u; cA1[i] = (unsigned)(S.row_of(cur, HALF + Rr[i]) * lda + Cc[i]) * 2u; }
        else { cA0[i] = (unsigned)(Rr[i] * lda + Cc[i]) * 2u; cA1[i] = (unsigned)((HALF + Rr[i]) * lda + Cc[i]) * 2u; }
        nA0[i] = cA0[i]; nA1[i] = cA1[i];
    }
    const char* cA = S.a_base(cur); const char* cB = S.b_base(cur);
    PG8_STAGE(PG8_SB(0, 0), cB, voffB); PG8_STAGE(PG8_SB(0, 1), cB + hstepB, voffB); PG8_STAGE(PG8_SA(0, 0), cA, cA0); PG8_STAGE(PG8_SA(0, 1), cA, cA1);
    if (wr == 1) PG8_BAR;
    PG8_WAIT_V(2); PG8_BAR;
    PG8_STAGE(PG8_SB(1, 0), cB + kstep, voffB); PG8_STAGE(PG8_SA(1, 0), cA + kstep, cA0); PG8_STAGE(PG8_SB(1, 1), cB + hstepB + kstep, voffB);
    PG8_WAIT_V(6); PG8_BAR;
    for (;;) {
        const bool has_next = S.next(ui + 1, nxt);
        const char* nA = has_next ? S.a_base(nxt) : cA; const char* nB = has_next ? S.b_base(nxt) : cB;
        if (GATHER) {
#pragma unroll
            for (int i = 0; i < 2; ++i) {
                if (has_next) { nA0[i] = (unsigned)(S.row_of(nxt, Rr[i]) * lda + Cc[i]) * 2u; nA1[i] = (unsigned)(S.row_of(nxt, HALF + Rr[i]) * lda + Cc[i]) * 2u; }
                else { nA0[i] = cA0[i]; nA1[i] = cA1[i]; }
            }
        }
#pragma unroll 1
        for (int t = 0; t < nt; t += 2) {
            const bool last = (t == nt - 2);
            const char* a1 = cA + (size_t)(t + 1) * kstep;
            const char* a2 = last ? nA : cA + (size_t)(t + 2) * kstep; const char* b2 = last ? nB : cB + (size_t)(t + 2) * kstep;
            const char* a3 = a2 + kstep; const char* b3 = b2 + kstep;
            unsigned x0[2], x1[2];
#pragma unroll
            for (int i = 0; i < 2; ++i) { x0[i] = (GATHER && last) ? nA0[i] : cA0[i]; x1[i] = (GATHER && last) ? nA1[i] : cA1[i]; }
            PG8_LDB(B0, 0, 0); PG8_LDB(B1, 0, 1); PG8_SCHED; PG8_LDA(At, 0, 0); PG8_STAGE(PG8_SA(1, 1), a1, cA1);
            PG8_WAIT_V(8); PG8_WAIT_L(0); PG8_BAR; PG8_MMA(0, 0, At, B0); PG8_MMA(0, 1, At, B1); PG8_BAR; PG8_SCHED;
            PG8_LDA(At, 0, 1); PG8_STAGE(PG8_SB(0, 0), b2, voffB); PG8_STAGE(PG8_SB(0, 1), b2 + hstepB, voffB); PG8_STAGE(PG8_SA(0, 0), a2, x0);
            PG8_WAIT_V(8); PG8_WAIT_L(0); PG8_BAR; PG8_MMA(1, 0, At, B0); PG8_MMA(1, 1, At, B1); PG8_BAR; PG8_SCHED;
            PG8_LDB(B0, 1, 0); PG8_LDB(B1, 1, 1); PG8_SCHED; PG8_LDA(At, 1, 0); PG8_STAGE(PG8_SA(0, 1), a2, x1);
            PG8_WAIT_V(8); PG8_WAIT_L(0); PG8_BAR; PG8_MMA(0, 0, At, B0); PG8_MMA(0, 1, At, B1); PG8_BAR; PG8_SCHED;
            PG8_LDA(At, 1, 1); PG8_STAGE(PG8_SB(1, 0), b3, voffB); PG8_STAGE(PG8_SB(1, 1), b3 + hstepB, voffB); PG8_STAGE(PG8_SA(1, 0), a3, x0);
            PG8_WAIT_V(8); PG8_WAIT_L(0); PG8_BAR; PG8_MMA(1, 0, At, B0); PG8_MMA(1, 1, At, B1); PG8_BAR; PG8_SCHED;
        }
        if (ALIGN_EPI) { if (wr == 0) PG8_BAR; }
        E(acc, cur, wr, wc, fr, fq);
        if (!has_next) break;
#pragma unroll
        for (int a = 0; a < 2; ++a)
#pragma unroll
            for (int b = 0; b < 2; ++b)
#pragma unroll
                for (int m = 0; m < 4; ++m)
#pragma unroll
                    for (int n = 0; n < 2; ++n) acc[a][b][m][n] = (f32x4){0.f, 0.f, 0.f, 0.f};
        cur = nxt; cA = nA; cB = nB; ++ui;
#pragma unroll
        for (int i = 0; i < 2; ++i) { cA0[i] = nA0[i]; cA1[i] = nA1[i]; }
        if (ALIGN_EPI) { if (wr == 1) PG8_BAR; }
    }
    PG8_WAIT_V(0);
    if (!ALIGN_EPI) { if (wr == 0) PG8_BAR; }
    PG8_BAR;
#undef PG8_SA
#undef PG8_SB
#undef PG8_STAGE
#undef PG8_LDA
#undef PG8_LDB
#undef PG8_MMA
#undef PG8_WAIT_V
#undef PG8_WAIT_L
#undef PG8_BAR
#undef PG8_SCHED
}
}

#define XB_TMO      128
#define XB_XCNT(j)  (256  + 64 * (j))
#define XB_XSUB(j)  (1280 + 64 * (j))
#define XB_XGEN(j)  (2304 + 64 * (j))
#define XB_TOP      3328
#define XB_TOPGEN   3392
#define XCD_BAR_WORDS 3456
#define XB_SPIN_CAP (1u << 20)

__device__ __forceinline__ unsigned xb_ld(unsigned* p)              { return __hip_atomic_load(p, __ATOMIC_RELAXED, __HIP_MEMORY_SCOPE_AGENT); }
__device__ __forceinline__ unsigned xb_add(unsigned* p, unsigned v) { return __hip_atomic_fetch_add(p, v, __ATOMIC_RELAXED, __HIP_MEMORY_SCOPE_AGENT); }
__device__ __forceinline__ unsigned xb_xcc_id() { return (unsigned)__builtin_amdgcn_s_getreg((3 << 11) | 20) & 0xFu; }
#define XB_SPIN(cond, bar) do { unsigned _sp = 0; while (cond) { __builtin_amdgcn_s_sleep(1); \
    if ((++_sp & 255u) == 0u) { if (xb_ld(&(bar)[XB_TMO])) break; if (_sp > XB_SPIN_CAP) { atomicAdd(&(bar)[XB_TMO], 1u); break; } } } } while (0)

struct XcdBarrier { unsigned* bar; unsigned x; volatile LAS unsigned* st; };

__device__ __forceinline__ XcdBarrier xcd_barrier_post(unsigned* bar, volatile LAS unsigned* st) {
    XcdBarrier b; b.bar = bar; b.x = xb_xcc_id(); b.st = st;
    if (threadIdx.x == 0) (void)xb_add(&bar[XB_XCNT(b.x)], 1u);
    return b;
}
__device__ __forceinline__ void xcd_barrier_complete(unsigned* bar, unsigned x, unsigned& nloc, unsigned& nx) {
    const unsigned G = gridDim.x * gridDim.y * gridDim.z;
    unsigned sum, cnt, mine, sp = 0u;
    for (;;) {
        sum = 0u; cnt = 0u; mine = 0u;
#pragma unroll
        for (unsigned j = 0; j < 16; ++j) { const unsigned c = xb_ld(&bar[XB_XCNT(j)]); sum += c; cnt += (c > 0u) ? 1u : 0u; mine = (j == x) ? c : mine; }
        if (sum == G) break;
        __builtin_amdgcn_s_sleep(1);
        if ((++sp & 255u) == 0u) { if (xb_ld(&bar[XB_TMO])) break; if (sp > XB_SPIN_CAP) { atomicAdd(&bar[XB_TMO], 1u); break; } }
    }
    nloc = mine > 0u ? mine : 1u; nx = cnt > 0u ? cnt : 1u;
}
__device__ __forceinline__ void xcd_barrier(const XcdBarrier& b) {
    asm volatile("s_waitcnt vmcnt(0)" ::: "memory");
    __syncthreads();
    if (threadIdx.x == 0) {
        unsigned* bar = b.bar;
        __builtin_amdgcn_s_waitcnt(0);
        unsigned nloc = b.st[0], nx = b.st[1];
        if (nloc == 0u) { xcd_barrier_complete(bar, b.x, nloc, nx); b.st[0] = nloc; b.st[1] = nx; }
        const unsigned old = xb_add(&bar[XB_XSUB(b.x)], 1u);
        const unsigned gen = old / nloc;
        if (old + 1u == (gen + 1u) * nloc) {
            __builtin_amdgcn_fence(__ATOMIC_RELEASE, "agent");
            asm volatile("s_waitcnt vmcnt(0)" ::: "memory");
            const unsigned og = xb_add(&bar[XB_TOP], 1u);
            const unsigned tg = og / nx;
            if (og + 1u == (tg + 1u) * nx) xb_add(&bar[XB_TOPGEN], 1u);
            else XB_SPIN(xb_ld(&bar[XB_TOPGEN]) == tg, bar);
            __builtin_amdgcn_fence(__ATOMIC_ACQUIRE, "agent");
            xb_add(&bar[XB_XGEN(b.x)], 1u);
            asm volatile("s_waitcnt vmcnt(0)" ::: "memory");
        } else {
            XB_SPIN(xb_ld(&bar[XB_XGEN(b.x)]) == gen, bar);
            __builtin_amdgcn_fence(__ATOMIC_ACQUIRE, "agent");
            asm volatile("s_waitcnt vmcnt(0)" ::: "memory");
        }
    }
    __syncthreads();
}

constexpr size_t MiB = 1u << 20;
constexpr size_t WS_CTL = 0, CTL_ZERO_BYTES = 1 * MiB;
constexpr size_t WS_ROPE = 1 * MiB;
constexpr size_t WS_WI   = 3 * MiB;
constexpr size_t WS_ROUTE = 3 * MiB + 512 * 1024;
constexpr size_t WS_SROW = 4 * MiB;
constexpr size_t WS_ROWMAP = 4 * MiB + 256 * 1024;
constexpr size_t WS_CWROW = 4 * MiB + 640 * 1024;
constexpr size_t WS_CNTWG = 5 * MiB;
constexpr size_t WS_META = 5 * MiB + 64 * 1024;
constexpr size_t WS_WR = 5 * MiB + 128 * 1024;
constexpr size_t WS_GLR = 6 * MiB;
constexpr size_t WS_WDENSE = 8 * MiB;
constexpr size_t WD_WA = 0, WD_WG = 7 * MiB, WD_WBR = 13 * MiB, WD_WOUT = 16 * MiB, WD_LAYER = 18 * MiB;
constexpr size_t WS_WMOE = 44 * MiB;
constexpr size_t WM_GU = 0, WM_DN = 32 * MiB;
constexpr size_t WS_HB = 92 * MiB;
constexpr size_t WS_PA = 156 * MiB;
constexpr size_t WS_HID = WS_PA;
constexpr size_t WS_FF2 = WS_PA + 40 * MiB;
constexpr size_t WS_Y = 380 * MiB;
constexpr size_t WS_KA = 476 * MiB, WS_VA = 480 * MiB, WS_KI = 484 * MiB;
constexpr size_t WS_END = 512 * MiB;
static_assert(WS_WDENSE + 2 * WD_LAYER <= WS_WMOE && WS_WMOE + 48 * MiB <= WS_HB && WS_HB + 64 * MiB <= WS_PA && WS_PA + 224 * MiB <= WS_Y && WS_Y + 96 * MiB <= WS_KA && WS_KI + 4 * MiB <= WS_END, "ws map");
static_assert(WS_FF2 + (size_t)73728 * 1024 * 2 <= WS_Y, "ff2 fits");
constexpr int CW_BAR = 4096;
constexpr int CW_QUEUE = 16384;

constexpr int RING_BYTES = 131072;
constexpr int AUX_OFF = 131072;
constexpr int MISC_OFF = 147456;
constexpr int LDS_BYTES = 148480;

struct Frame {
    LAS unsigned char* lds;
    volatile LAS unsigned* MISC;
    gu32* ctl;
    int tid, lane, wave, G, wg;
    const float* const* in;
    const GAS int* pos;
    GAS float* H;
    GAS unsigned char* ws;
};

#define LDS_WAIT() asm volatile("s_waitcnt lgkmcnt(0)" ::: "memory")
#define VM_WAIT() asm volatile("s_waitcnt vmcnt(0)" ::: "memory")

__device__ __forceinline__ int pa_src_col(int c) {
    if (c < 512) return c;
    if (c < 768) { const int x = c - 512, half = x >> 7, y = x & 127, grp = y >> 5, d = (y & 31) + 32 * half;
        if (grp == 0) return 512 + d;
        if (grp == 1) return 576 + d;
        if (grp == 2) return 896 + d;
        if (half == 0) { const int z = y - 96; if (z < 4) return 960 + z; if (z < 20) return 1988 + (z - 4); }
        return -1; }
    if (c < 1024) return 640 + (c - 768);
    if (c < 1280) return 964 + (c - 1024);
    if (c < 1536) return 1220 + (c - 1280);
    if (c < 2048) return 1476 + (c - 1536);
    if (c < 2560) return 2004 + (c - 2048);
    return 2516 + (c - 2560);
}
struct TItem { const GAS float* W; GAS bf16* WT; int ldw, K, n0, k0, sc0, mode; };
__device__ __forceinline__ void ti_load(const TItem& t, f32x4 (&v)[8], int lane) {
    if (t.mode == 0) { const int kr = lane >> 3, c4 = (lane & 7) * 4;
#pragma unroll
        for (int i = 0; i < 8; ++i) v[i] = *(const GAS f32x4*)(t.W + (size_t)(t.k0 + 8 * i + kr) * t.ldw + t.sc0 + c4); }
}
__device__ __forceinline__ void ti_finish(const TItem& t, const f32x4 (&v)[8], LAS float* scr, int lane) {
    if (t.mode == 0) { const int kr = lane >> 3, c4 = (lane & 7) * 4;
#pragma unroll
        for (int i = 0; i < 8; ++i) { LAS float* d = scr + (8 * i + kr) * 33 + c4; d[0] = v[i].x; d[1] = v[i].y; d[2] = v[i].z; d[3] = v[i].w; }
    } else { const int sc = pa_src_col(t.n0 + (lane & 31));
#pragma unroll 8
        for (int i = 0; i < 32; ++i) { const int kk = 2 * i + (lane >> 5); scr[kk * 33 + (lane & 31)] = (sc >= 0) ? t.W[(size_t)(t.k0 + kk) * t.ldw + sc] : 0.f; }
    }
    LDS_WAIT(); asm volatile("" ::: "memory");
    const int c = lane & 7;
#pragma unroll
    for (int j = 0; j < 4; ++j) { const int n = (lane >> 3) + 8 * j; const LAS float* s = scr + (8 * c) * 33 + n;
        u32x4 o; o.x = pk2(s[0 * 33], s[1 * 33]); o.y = pk2(s[2 * 33], s[3 * 33]); o.z = pk2(s[4 * 33], s[5 * 33]); o.w = pk2(s[6 * 33], s[7 * 33]);
        *(GAS u32x4*)(t.WT + (size_t)(t.n0 + n) * t.K + t.k0 + 8 * c) = o; }
    LDS_WAIT(); asm volatile("" ::: "memory");
}
__device__ __forceinline__ void dense_item(Frame& F, int l, int it, TItem& t) {
    GAS bf16* base = (GAS bf16*)(F.ws + WS_WDENSE + (size_t)l * WD_LAYER);
    const GAS float* win = ((const GAS float*)F.in[4]) + (size_t)l * DM * NIN;
    if (it < 1792) { const int kb = it / 112, nb = it % 112; const int s0 = pa_src_col(32 * nb), s31 = pa_src_col(32 * nb + 31);
        t = TItem{win, base + WD_WA / 2, NIN, DM, 32 * nb, 64 * kb, s0, (s0 >= 0 && s31 == s0 + 31) ? 0 : 1}; return; }
    it -= 1792;
    if (it < 1536) { const int kb = it / 96, nb = it % 96; t = TItem{win, base + WD_WG / 2, NIN, DM, 32 * nb, 64 * kb, 3540 + 32 * nb, 0}; return; }
    it -= 1536;
    if (it < 768) { const int br = it / 256, r = it % 256, kb = r / 32, nb = r % 32;
        t = TItem{(br == 0 ? ((const GAS float*)F.in[13]) : br == 1 ? ((const GAS float*)F.in[14]) : ((const GAS float*)F.in[15])) + (size_t)l * 512 * DM, base + WD_WBR / 2 + (size_t)br * 1024 * 512, DM, 512, 32 * nb, 64 * kb, 32 * nb, 0}; return; }
    it -= 768;
    { const int kb = it / 32, nb = it % 32; t = TItem{((const GAS float*)F.in[16]) + (size_t)l * DM * DM, base + WD_WOUT / 2, DM, DM, 32 * nb, 64 * kb, 32 * nb, 0}; }
}
__device__ __forceinline__ void moe_item(Frame& F, int l, int it, TItem& t) {
    const int e = it / 384; int r = it % 384;
    if (r < 256) { const int sub = r / 64, q = r % 64, ct = sub >> 1, bj = sub & 1, kb = q / 4, nb = q % 4;
        const GAS float* src = (bj ? ((const GAS float*)F.in[24]) : ((const GAS float*)F.in[23])) + (size_t)(l * NEXP + e) * DM * DEXP;
        t = TItem{src, (GAS bf16*)(F.ws + WS_WMOE + WM_GU) + (size_t)e * 512 * DM, DEXP, DM, 256 * ct + 128 * bj + 32 * nb, 64 * kb, 128 * ct + 32 * nb, 0}; return; }
    r -= 256;
    { const int kb = r / 32, nb = r % 32;
        t = TItem{((const GAS float*)F.in[25]) + (size_t)(l * NEXP + e) * DEXP * DM, (GAS bf16*)(F.ws + WS_WMOE + WM_DN) + (size_t)e * DM * DEXP, DM, DEXP, 32 * nb, 64 * kb, 32 * nb, 0}; }
}
template <bool MOE> __device__ __forceinline__ void conv_run(Frame& F, int l, int total, LAS float* scr) {
    const int gw = F.wg * 8 + F.wave, NGW = F.G * 8, lane = F.lane;
    TItem cur, nxt; f32x4 vc[8], vn[8];
    int it = gw; if (it >= total) return;
    if (MOE) moe_item(F, l, it, cur); else dense_item(F, it / 4608, it % 4608, cur);
    ti_load(cur, vc, lane);
#pragma unroll 1
    for (; it < total; it += NGW) { const int itn = it + NGW; const bool hn = itn < total;
        if (hn) { if (MOE) moe_item(F, l, itn, nxt); else dense_item(F, itn / 4608, itn % 4608, nxt); ti_load(nxt, vn, lane); }
        ti_finish(cur, vc, scr, lane);
        cur = nxt;
#pragma unroll
        for (int i = 0; i < 8; ++i) vc[i] = vn[i]; }
}

__device__ __forceinline__ void ln_row_regs(f32x4 (&v)[4], const GAS float* g, const GAS float* b, int lane) {
    float s = 0.f;
#pragma unroll
    for (int j = 0; j < 4; ++j) s += (v[j].x + v[j].y) + (v[j].z + v[j].w);
    const float mean = wave_sum(s, lane) * (1.f / DM); float s2 = 0.f;
#pragma unroll
    for (int j = 0; j < 4; ++j) { v[j] = v[j] - mean; s2 += (v[j].x * v[j].x + v[j].y * v[j].y) + (v[j].z * v[j].z + v[j].w * v[j].w); }
    const float rstd = 1.f / sqrtf(wave_sum(s2, lane) * (1.f / DM) + LN_EPS);
#pragma unroll
    for (int j = 0; j < 4; ++j) { const f32x4 gg = *(const GAS f32x4*)(g + 4 * lane + 256 * j), bb = *(const GAS f32x4*)(b + 4 * lane + 256 * j); v[j] = v[j] * rstd * gg + bb; }
}
__device__ __forceinline__ void store_row_f32_bf16(const f32x4 (&v)[4], GAS float* hrow, GAS bf16* brow, int lane) {
#pragma unroll
    for (int j = 0; j < 4; ++j) {
        if (hrow) *(GAS f32x4*)(hrow + 4 * lane + 256 * j) = v[j];
        if (brow) { u32x2 w; w.x = pk2(v[j].x, v[j].y); w.y = pk2(v[j].z, v[j].w); *(GAS u32x2*)(brow + 4 * lane + 256 * j) = w; }
    }
}

__device__ __forceinline__ void phase_prologue(Frame& F) {
    LAS float* scr = (LAS float*)(F.lds + F.wave * 16384);
    const int gw = F.wg * 8 + F.wave, NGW = F.G * 8;
    conv_run<false>(F, 0, 2 * 4608, scr);
    { GAS bf16* WRB = (GAS bf16*)(F.ws + WS_WR);
      for (int i = gw * 64 + F.lane; i < DEPTH * 48 * DM; i += NGW * 64) { const int l = i / (48 * DM), r = i % (48 * DM), o = r / DM, k = r % DM;
          const float v = (o < 4) ? ((const GAS float*)F.in[19])[(size_t)l * DM * 4 + k * 4 + o] : (o < 36) ? ((const GAS float*)F.in[21])[(size_t)l * DM * 32 + k * 32 + (o - 4)] : 0.f;
          WRB[i] = (bf16)f2bf(v); } }
    { GAS float* RT = (GAS float*)(F.ws + WS_ROPE);
      for (int i = gw * 64 + F.lane; i < NTOK * 8; i += NGW * 64) { const int n = i >> 3, j = i & 7;
          const float invf[8] = {1.000000000e+00f, 1.939227432e-01f, 3.760603070e-02f, 7.292664610e-03f, 1.414213562e-03f, 2.742481884e-04f, 5.318295734e-05f, 1.031338525e-05f};
          float inv = invf[0];
#pragma unroll
          for (int q = 1; q < 8; ++q) inv = (j == q) ? invf[q] : inv;
          const float ang = (float)F.pos[n] * inv;
          const double kq = __builtin_rint((double)ang * 0.15915494309189535);
          double r = (double)ang - kq * 6.283185307179586; double csign = 1.0;
          if (r > 1.5707963267948966) { r = 3.141592653589793 - r; csign = -1.0; } else if (r < -1.5707963267948966) { r = -3.141592653589793 - r; csign = -1.0; }
          const double x2 = r * r;
          const double sn = r * (1.0 + x2 * (-1.0 / 6 + x2 * (1.0 / 120 + x2 * (-1.0 / 5040 + x2 * (1.0 / 362880 + x2 * (-1.0 / 39916800 + x2 * (1.0 / 6227020800.0 + x2 * (-1.0 / 1307674368000.0))))))));
          const double cs = 1.0 + x2 * (-0.5 + x2 * (1.0 / 24 + x2 * (-1.0 / 720 + x2 * (1.0 / 40320 + x2 * (-1.0 / 3628800 + x2 * (1.0 / 479001600.0 + x2 * (-1.0 / 87178291200.0 + x2 * (1.0 / 20922789888000.0))))))));
          RT[n * 16 + j] = (float)(csign * cs); RT[n * 16 + 8 + j] = (float)sn; } }
    GAS bf16* HB = (GAS bf16*)(F.ws + WS_HB);
    for (int m = gw; m < NTOK; m += NGW) { f32x4 v[4];
#pragma unroll
        for (int j = 0; j < 4; ++j) v[j] = *(const GAS f32x4*)(((const GAS float*)F.in[0]) + (size_t)m * DM + 4 * F.lane + 256 * j);
        ln_row_regs(v, ((const GAS float*)F.in[2]), ((const GAS float*)F.in[3]), F.lane);
        store_row_f32_bf16(v, (GAS float*)nullptr, HB + (size_t)m * DM, F.lane); }
}

struct DenseSched {
    int nM, nN, nwg, G, c; const char* A; const char* B; size_t atile, btile; int nsub = 1; size_t asub = 0, bsub = 0;
    __device__ void init(int nM_, int nN_, int G_, int c_, const void* A_, size_t atile_, const void* B_, size_t btile_) { nM = nM_; nN = nN_; nwg = nM * nN; G = G_; c = c_; A = (const char*)A_; B = (const char*)B_; atile = atile_; btile = btile_; }
    __device__ __forceinline__ bool next(int i, pg8::Unit& u) const {
        const int it = i / nsub, sb = i - it * nsub;
        const long L = (long)it * G + c; if (L >= nwg) return false;
        int wgid = (int)L; { const int q = nwg / 8, r = nwg % 8, xcd = wgid % 8, off = wgid / 8; wgid = (xcd < r ? xcd * (q + 1) : r * (q + 1) + (xcd - r) * q) + off; }
        const int nig = 8 * nN, gid = wgid / nig, fm = gid * 8, gsz = (nM - fm) < 8 ? (nM - fm) : 8;
        u.pm = fm + ((wgid % nig) % gsz); u.pn = (wgid % nig) / gsz; u.e = sb; u.slot = i; return true;
    }
    __device__ __forceinline__ const char* a_base(const pg8::Unit& u) const { return A + (size_t)u.pm * atile + (size_t)u.e * asub; }
    __device__ __forceinline__ const char* b_base(const pg8::Unit& u) const { return B + (size_t)u.pn * btile + (size_t)u.e * bsub; }
    __device__ __forceinline__ int row_of(const pg8::Unit&, int) const { return 0; }
};
struct GroupSched {
    int NU, G, c, ncol; const char* A; const char* B; size_t atile, erows_bytes, btile; const LAS int* meta; const LAS int* rows;
    __device__ __forceinline__ bool next(int i, pg8::Unit& u) const {
        const int L = i * G + c; if (L >= NU) return false;
        u.pm = L / ncol; u.pn = L % ncol; u.slot = i; u.e = meta[i]; return true;
    }
    __device__ __forceinline__ const char* a_base(const pg8::Unit& u) const { return A + (size_t)u.pm * atile; }
    __device__ __forceinline__ const char* b_base(const pg8::Unit& u) const { return B + (size_t)u.e * erows_bytes + (size_t)u.pn * btile; }
    __device__ __forceinline__ int row_of(const pg8::Unit& u, int r) const { return rows[u.slot * 256 + r]; }
};

struct EpiA {
    static constexpr bool PERM = true;
    GAS bf16* PA; GAS bf16* KA; GAS bf16* VA; GAS bf16* KI; GAS float* WI; GAS float* GLR; const GAS float* ROPE; const GAS float* ikg;
    __device__ __forceinline__ static void rope8(float (&x)[8], const GAS float* rt, int fq, int lane) {
        const f32x4 c0 = *(const GAS f32x4*)(rt), c1 = *(const GAS f32x4*)(rt + 4), s0 = *(const GAS f32x4*)(rt + 8), s1 = *(const GAS f32x4*)(rt + 12);
#pragma unroll
        for (int i = 0; i < 8; ++i) { const float p = shx(x[i], 16, lane); const float cc = (i < 4) ? c0[i & 3] : c1[i & 3], ss = (i < 4) ? s0[i & 3] : s1[i & 3];
            const float r = x[i] * cc + ((fq == 0) ? -p : p) * ss; x[i] = (fq < 2) ? r : x[i]; }
    }
    __device__ __forceinline__ static u32x4 pack8(const float (&x)[8]) { u32x4 w; w.x = cvt_pk_bf16(x[0], x[1]); w.y = cvt_pk_bf16(x[2], x[3]); w.z = cvt_pk_bf16(x[4], x[5]); w.w = cvt_pk_bf16(x[6], x[7]); return w; }
    __device__ __forceinline__ void operator()(const f32x4 (&acc)[2][2][4][2], const pg8::Unit& u, int wr, int wc, int fr, int fq) const {
        const int pn = u.pn; const int rowb = u.pm * 256 + wr * 64 + fr; const int lane = fq * 16 + fr;
        if (pn == 2) {
#pragma unroll
            for (int ai = 0; ai < 2; ++ai)
#pragma unroll
                for (int m = 0; m < 4; ++m) {
                    const int row = rowb + ai * 128 + m * 16;
                    float x0[8], x1[8];
#pragma unroll
                    for (int i = 0; i < 8; ++i) { x0[i] = acc[ai][0][m][i >> 2][i & 3]; x1[i] = acc[ai][1][m][i >> 2][i & 3]; }
                    if (wc == 2) {
                        float s = 0.f;
#pragma unroll
                        for (int i = 0; i < 8; ++i) s += x0[i] + x1[i];
                        s += shx(s, 16, lane); s += shx(s, 32, lane);
                        const float mean = s * (1.f / 64.f); float q = 0.f;
#pragma unroll
                        for (int i = 0; i < 8; ++i) { x0[i] -= mean; x1[i] -= mean; q += x0[i] * x0[i] + x1[i] * x1[i]; }
                        q += shx(q, 16, lane); q += shx(q, 32, lane);
                        const float rstd = 1.f / sqrtf(q * (1.f / 64.f) + LN_EPS);
#pragma unroll
                        for (int i = 0; i < 8; ++i) { x0[i] = x0[i] * rstd * ikg[8 * fq + i]; x1[i] = x1[i] * rstd * ikg[32 + 8 * fq + i]; }
                    }
                    if (wc == 0 || wc == 2) rope8(x0, ROPE + (size_t)row * 16, fq, lane);
                    if (wc < 3) {
                        GAS bf16* dst = (wc == 0) ? KA : (wc == 1) ? VA : KI;
                        *(GAS u32x4*)(dst + (size_t)row * 64 + 8 * fq) = pack8(x0); *(GAS u32x4*)(dst + (size_t)row * 64 + 32 + 8 * fq) = pack8(x1);
                    } else {
                        if (fq == 0) { *(GAS f32x4*)(WI + (size_t)row * 4) = (f32x4){x0[0], x0[1], x0[2], x0[3]} * 0.0625f; *(GAS f32x4*)(GLR + (size_t)row * 16) = (f32x4){x0[4], x0[5], x0[6], x0[7]}; }
                        else if (fq == 1) { *(GAS f32x4*)(GLR + (size_t)row * 16 + 4) = (f32x4){x0[0], x0[1], x0[2], x0[3]}; *(GAS f32x4*)(GLR + (size_t)row * 16 + 8) = (f32x4){x0[4], x0[5], x0[6], x0[7]}; }
                        else if (fq == 2) { *(GAS f32x4*)(GLR + (size_t)row * 16 + 12) = (f32x4){x0[0], x0[1], x0[2], x0[3]}; }
                    }
                    asm volatile("" ::: "memory");
                }
        } else if (pn < 2 || pn == 3) {
            const float sc = (pn == 3) ? 1.0f : 0.125f; const bool rope = !(wc & 1);
#pragma unroll
            for (int ai = 0; ai < 2; ++ai)
#pragma unroll
                for (int m = 0; m < 4; ++m) {
                    const int row = rowb + ai * 128 + m * 16;
#pragma unroll
                    for (int bj = 0; bj < 2; ++bj) { float x[8];
#pragma unroll
                        for (int i = 0; i < 8; ++i) x[i] = acc[ai][bj][m][i >> 2][i & 3];
                        if (rope) rope8(x, ROPE + (size_t)row * 16, fq, lane);
#pragma unroll
                        for (int i = 0; i < 8; ++i) x[i] *= sc;
                        *(GAS u32x4*)(PA + (size_t)row * NPA + 256 * pn + 128 * bj + 32 * wc + 8 * fq) = pack8(x); }
                    asm volatile("" ::: "memory");
                }
        } else {
            const int act = (pn == 8 || pn == 9) ? 1 : (pn >= 10) ? 2 : 0; const float sc = (pn == 4) ? 0.125f : 1.0f;
#pragma unroll
            for (int ai = 0; ai < 2; ++ai)
#pragma unroll
                for (int m = 0; m < 4; ++m) {
                    const int row = rowb + ai * 128 + m * 16;
#pragma unroll
                    for (int bj = 0; bj < 2; ++bj) { float x[8];
#pragma unroll
                        for (int i = 0; i < 8; ++i) { const float v = acc[ai][bj][m][i >> 2][i & 3]; x[i] = (act == 1) ? siluf_(v) : (act == 2) ? gelu_tanh_(v) : v * sc; }
                        *(GAS u32x4*)(PA + (size_t)row * NPA + 256 * pn + 128 * bj + 32 * wc + 8 * fq) = pack8(x); }
                    asm volatile("" ::: "memory");
                }
        }
    }
};
struct EpiPlainA {
    static constexpr bool PERM = true;
    GAS bf16* PA;
    __device__ __forceinline__ void operator()(const f32x4 (&acc)[2][2][4][2], const pg8::Unit& u, int wr, int wc, int fr, int fq) const {
        const int rowb = u.pm * 256 + wr * 64 + fr;
#pragma unroll
        for (int ai = 0; ai < 2; ++ai)
#pragma unroll
            for (int m = 0; m < 4; ++m) { const int row = rowb + ai * 128 + m * 16;
#pragma unroll
                for (int bj = 0; bj < 2; ++bj) { u32x4 w; w.x = cvt_pk_bf16(acc[ai][bj][m][0][0], acc[ai][bj][m][0][1]); w.y = cvt_pk_bf16(acc[ai][bj][m][0][2], acc[ai][bj][m][0][3]);
                    w.z = cvt_pk_bf16(acc[ai][bj][m][1][0], acc[ai][bj][m][1][1]); w.w = cvt_pk_bf16(acc[ai][bj][m][1][2], acc[ai][bj][m][1][3]);
                    *(GAS u32x4*)(PA + (size_t)row * NPA + 256 * u.pn + 128 * bj + 32 * wc + 8 * fq) = w; } }
    }
};
struct EpiP {
    static constexpr bool PERM = true;
    GAS bf16* P;
    __device__ __forceinline__ void operator()(const f32x4 (&acc)[2][2][4][2], const pg8::Unit& u, int wr, int wc, int fr, int fq) const {
        const int rowb = u.pm * 256 + wr * 64 + fr; GAS bf16* Pb = P + (size_t)u.e * NTOK * DM;
#pragma unroll
        for (int ai = 0; ai < 2; ++ai)
#pragma unroll
            for (int m = 0; m < 4; ++m) { const int row = rowb + ai * 128 + m * 16;
#pragma unroll
                for (int bj = 0; bj < 2; ++bj) { u32x4 w; w.x = cvt_pk_bf16(acc[ai][bj][m][0][0], acc[ai][bj][m][0][1]); w.y = cvt_pk_bf16(acc[ai][bj][m][0][2], acc[ai][bj][m][0][3]);
                    w.z = cvt_pk_bf16(acc[ai][bj][m][1][0], acc[ai][bj][m][1][1]); w.w = cvt_pk_bf16(acc[ai][bj][m][1][2], acc[ai][bj][m][1][3]);
                    *(GAS u32x4*)(Pb + (size_t)row * DM + 256 * u.pn + 128 * bj + 32 * wc + 8 * fq) = w; } }
    }
};
struct EpiGM {
    static constexpr bool PERM = true;
    const GAS bf16* P; GAS bf16* HM;
    __device__ __forceinline__ void operator()(const f32x4 (&acc)[2][2][4][2], const pg8::Unit& u, int wr, int wc, int fr, int fq) const {
        const int rowb = u.pm * 256 + wr * 64 + fr; const int br = u.e; const GAS bf16* Pb = P + (size_t)br * NTOK * DM;
        const int colb = 256 * u.pn + 32 * wc + 8 * fq;
#pragma unroll
        for (int ai = 0; ai < 2; ++ai) {
            u32x4 pv[4][2], ov[4][2];
#pragma unroll
            for (int m = 0; m < 4; ++m)
#pragma unroll
                for (int bj = 0; bj < 2; ++bj) { const size_t off = (size_t)(rowb + ai * 128 + m * 16) * DM + colb + 128 * bj;
                    pv[m][bj] = *(const GAS u32x4*)(Pb + off); ov[m][bj] = (br > 0) ? *(const GAS u32x4*)(HM + off) : (u32x4){0u, 0u, 0u, 0u}; }
            __builtin_amdgcn_sched_barrier(0);
#pragma unroll
            for (int m = 0; m < 4; ++m)
#pragma unroll
                for (int bj = 0; bj < 2; ++bj) { const size_t off = (size_t)(rowb + ai * 128 + m * 16) * DM + colb + 128 * bj;
                    const u32x4 p = pv[m][bj], o = ov[m][bj];
                    float x[8];
                    x[0] = bflo(p.x) * sigmoidf_(acc[ai][bj][m][0][0]) + bflo(o.x); x[1] = bfhi(p.x) * sigmoidf_(acc[ai][bj][m][0][1]) + bfhi(o.x); x[2] = bflo(p.y) * sigmoidf_(acc[ai][bj][m][0][2]) + bflo(o.y); x[3] = bfhi(p.y) * sigmoidf_(acc[ai][bj][m][0][3]) + bfhi(o.y);
                    x[4] = bflo(p.z) * sigmoidf_(acc[ai][bj][m][1][0]) + bflo(o.z); x[5] = bfhi(p.z) * sigmoidf_(acc[ai][bj][m][1][1]) + bfhi(o.z); x[6] = bflo(p.w) * sigmoidf_(acc[ai][bj][m][1][2]) + bflo(o.w); x[7] = bfhi(p.w) * sigmoidf_(acc[ai][bj][m][1][3]) + bfhi(o.w);
                    u32x4 w; w.x = cvt_pk_bf16(x[0], x[1]); w.y = cvt_pk_bf16(x[2], x[3]); w.z = cvt_pk_bf16(x[4], x[5]); w.w = cvt_pk_bf16(x[6], x[7]);
                    *(GAS u32x4*)(HM + off) = w; }
            asm volatile("" ::: "memory");
        }
    }
};
struct EpiO {
    static constexpr bool PERM = true;
    const GAS bf16* HBr; GAS bf16* T;
    __device__ __forceinline__ void operator()(const f32x4 (&acc)[2][2][4][2], const pg8::Unit& u, int wr, int wc, int fr, int fq) const {
        const int rowb = u.pm * 256 + wr * 64 + fr; const int colb = 256 * u.pn + 32 * wc + 8 * fq;
#pragma unroll
        for (int ai = 0; ai < 2; ++ai) {
            u32x4 hv[4][2];
#pragma unroll
            for (int m = 0; m < 4; ++m)
#pragma unroll
                for (int bj = 0; bj < 2; ++bj) hv[m][bj] = *(const GAS u32x4*)(HBr + (size_t)(rowb + ai * 128 + m * 16) * DM + colb + 128 * bj);
            __builtin_amdgcn_sched_barrier(0);
#pragma unroll
            for (int m = 0; m < 4; ++m)
#pragma unroll
                for (int bj = 0; bj < 2; ++bj) { const u32x4 h = hv[m][bj];
                    u32x4 w; w.x = cvt_pk_bf16(bflo(h.x) * DN_ALPHA + acc[ai][bj][m][0][0], bfhi(h.x) * DN_ALPHA + acc[ai][bj][m][0][1]); w.y = cvt_pk_bf16(bflo(h.y) * DN_ALPHA + acc[ai][bj][m][0][2], bfhi(h.y) * DN_ALPHA + acc[ai][bj][m][0][3]);
                    w.z = cvt_pk_bf16(bflo(h.z) * DN_ALPHA + acc[ai][bj][m][1][0], bfhi(h.z) * DN_ALPHA + acc[ai][bj][m][1][1]); w.w = cvt_pk_bf16(bflo(h.w) * DN_ALPHA + acc[ai][bj][m][1][2], bfhi(h.w) * DN_ALPHA + acc[ai][bj][m][1][3]);
                    *(GAS u32x4*)(T + (size_t)(rowb + ai * 128 + m * 16) * DM + colb + 128 * bj) = w; }
            asm volatile("" ::: "memory");
        }
    }
};
struct EpiGU {
    static constexpr bool PERM = true;
    GAS bf16* HID; const GAS float* CW;
    __device__ __forceinline__ void operator()(const f32x4 (&acc)[2][2][4][2], const pg8::Unit& u, int wr, int wc, int fr, int fq) const {
        const int rowb = u.pm * 256 + wr * 64 + fr;
        float cwv[2][4];
#pragma unroll
        for (int ai = 0; ai < 2; ++ai)
#pragma unroll
            for (int m = 0; m < 4; ++m) cwv[ai][m] = CW[rowb + ai * 128 + m * 16];
#pragma unroll
        for (int ai = 0; ai < 2; ++ai)
#pragma unroll
            for (int m = 0; m < 4; ++m) { const int row = rowb + ai * 128 + m * 16; const float cw = cwv[ai][m];
                float x[8];
#pragma unroll
                for (int i = 0; i < 8; ++i) x[i] = siluf_(acc[ai][0][m][i >> 2][i & 3]) * acc[ai][1][m][i >> 2][i & 3] * cw;
                u32x4 w; w.x = cvt_pk_bf16(x[0], x[1]); w.y = cvt_pk_bf16(x[2], x[3]); w.z = cvt_pk_bf16(x[4], x[5]); w.w = cvt_pk_bf16(x[6], x[7]);
                *(GAS u32x4*)(HID + (size_t)row * DEXP + 128 * u.pn + 32 * wc + 8 * fq) = w; }
    }
};
struct EpiDN {
    static constexpr bool PERM = true;
    GAS bf16* FF2;
    __device__ __forceinline__ void operator()(const f32x4 (&acc)[2][2][4][2], const pg8::Unit& u, int wr, int wc, int fr, int fq) const {
        const int rowb = u.pm * 256 + wr * 64 + fr;
#pragma unroll
        for (int ai = 0; ai < 2; ++ai)
#pragma unroll
            for (int m = 0; m < 4; ++m) { const int row = rowb + ai * 128 + m * 16;
#pragma unroll
                for (int bj = 0; bj < 2; ++bj) { u32x4 w; w.x = cvt_pk_bf16(acc[ai][bj][m][0][0], acc[ai][bj][m][0][1]); w.y = cvt_pk_bf16(acc[ai][bj][m][0][2], acc[ai][bj][m][0][3]);
                    w.z = cvt_pk_bf16(acc[ai][bj][m][1][0], acc[ai][bj][m][1][1]); w.w = cvt_pk_bf16(acc[ai][bj][m][1][2], acc[ai][bj][m][1][3]);
                    *(GAS u32x4*)(FF2 + (size_t)row * DM + 256 * u.pn + 128 * bj + 32 * wc + 8 * fq) = w; } }
    }
};
#ifndef EN_B1
#define EN_B1 1
#endif
#ifndef EN_B2
#define EN_B2 1
#endif
#ifndef EN_B3
#define EN_B3 1
#endif

template <int CTRL> __device__ __forceinline__ float dppf(float x) { return __builtin_bit_cast(float, __builtin_amdgcn_mov_dpp(__builtin_bit_cast(int, x), CTRL, 0xf, 0xf, true)); }
template <int CTRL> __device__ __forceinline__ int dppi(int x) { return __builtin_amdgcn_mov_dpp(x, CTRL, 0xf, 0xf, true); }
typedef short v4i16_t __attribute__((ext_vector_type(4)));
typedef unsigned short u16x2 __attribute__((ext_vector_type(2)));
__device__ __forceinline__ v4i16_t ldtr(const LAS unsigned char* p) { return __builtin_amdgcn_ds_read_tr16_b64_v4i16((LAS v4i16_t*)p); }
__device__ __forceinline__ bf16x8 cat8(v4i16_t lo, v4i16_t hi) { bf16x8 r; r[0] = lo[0]; r[1] = lo[1]; r[2] = lo[2]; r[3] = lo[3]; r[4] = hi[0]; r[5] = hi[1]; r[6] = hi[2]; r[7] = hi[3]; return r; }
__device__ __forceinline__ int wave_total_i(int v) {
    v += dppi<0xB1>(v); v += dppi<0x4E>(v); v += dppi<0x141>(v); v += dppi<0x140>(v);
    return __builtin_amdgcn_readlane(v, 0) + __builtin_amdgcn_readlane(v, 16) + __builtin_amdgcn_readlane(v, 32) + __builtin_amdgcn_readlane(v, 48);
}
__device__ __forceinline__ void gmlp_unit(Frame& F, int l, int unit) {
    int tid = F.tid; asm volatile("" : "+v"(tid)); const int lane = tid & 63;
    const int chunk = unit >> 2, g = unit & 3, n0 = chunk * 128;
    const GAS bf16* PA = (const GAS bf16*)(F.ws + WS_PA); GAS bf16* Y = (GAS bf16*)(F.ws + WS_Y);
    LAS float* vln = (LAS float*)F.lds;
    LAS float* wl = (LAS float*)(F.lds + 65536);
    LAS float* st = (LAS float*)(F.lds + AUX_OFF);
    const GAS float* lng = ((const GAS float*)F.in[9]) + l * 512; const GAS float* lnb = ((const GAS float*)F.in[10]) + l * 512;
    for (int j = 0; j < 16; ++j) { const int s = F.wave * 16 + j;
        const u32x4 w = *(const GAS u32x4*)(PA + (size_t)(n0 + s) * NPA + PA_CV + 8 * lane);
        float x[8] = {bflo(w.x), bfhi(w.x), bflo(w.y), bfhi(w.y), bflo(w.z), bfhi(w.z), bflo(w.w), bfhi(w.w)};
        float sm = 0.f;
#pragma unroll
        for (int i = 0; i < 8; ++i) sm += x[i];
        const float mean = wave_sum(sm, lane) * (1.f / 512.f); float q = 0.f;
#pragma unroll
        for (int i = 0; i < 8; ++i) { const float d = x[i] - mean; q += d * d; }
        const float rstd = 1.f / sqrtf(wave_sum(q, lane) * (1.f / 512.f) + LN_EPS);
        if (lane == 0) { st[2 * s] = mean; st[2 * s + 1] = rstd; } }
    __syncthreads();
#pragma unroll
    for (int i = 0; i < 4; ++i) { const int q = tid + 512 * i, s = q >> 4, d0 = (q & 15) * 8;
        const u32x4 w = *(const GAS u32x4*)(PA + (size_t)(n0 + s) * NPA + PA_CV + g * 128 + d0);
        const float mean = st[2 * s], rstd = st[2 * s + 1];
        float x[8] = {bflo(w.x), bfhi(w.x), bflo(w.y), bfhi(w.y), bflo(w.z), bfhi(w.z), bflo(w.w), bfhi(w.w)};
#pragma unroll
        for (int k = 0; k < 8; ++k) x[k] = (x[k] - mean) * rstd * lng[g * 128 + d0 + k] + lnb[g * 128 + d0 + k];
        *(LAS f32x4*)(vln + s * 128 + d0) = (f32x4){x[0], x[1], x[2], x[3]}; *(LAS f32x4*)(vln + s * 128 + d0 + 4) = (f32x4){x[4], x[5], x[6], x[7]}; }
    const GAS float* ws = ((const GAS float*)F.in[11]) + ((size_t)l * 4 + g) * 128 * 128;
#pragma unroll
    for (int i = 0; i < 8; ++i) { const int q = tid + 512 * i, t = q >> 5, s0 = (q & 31) * 4;
        f32x4 w = *(const GAS f32x4*)(ws + t * 128 + s0);
        if (s0 + 0 > t) w.x = 0.f; if (s0 + 1 > t) w.y = 0.f; if (s0 + 2 > t) w.z = 0.f; if (s0 + 3 > t) w.w = 0.f;
        *(LAS f32x4*)(wl + t * 128 + s0) = w; }
    __syncthreads();
    const int d = tid & 127, tq = __builtin_amdgcn_readfirstlane(tid >> 7);
    float vr[128];
#pragma unroll
    for (int sb = 0; sb < 4; ++sb)
        if (sb <= tq) {
#pragma unroll
            for (int s = 0; s < 32; ++s) vr[sb * 32 + s] = vln[(sb * 32 + s) * 128 + d];
        } else {
#pragma unroll
            for (int s = 0; s < 32; ++s) vr[sb * 32 + s] = 0.f;
        }
    const GAS float* bs = ((const GAS float*)F.in[12]) + ((size_t)l * 4 + g) * 128;
#pragma unroll 1
    for (int ti = 0; ti < 32; ++ti) { const int t = tq * 32 + ti; float a = 0.f;
#pragma unroll
        for (int sb = 0; sb < 4; ++sb)
            if (sb <= tq) {
#pragma unroll
                for (int s4 = 0; s4 < 8; ++s4) { const f32x4 w = *(const LAS f32x4*)(wl + t * 128 + sb * 32 + s4 * 4);
                    a += w.x * vr[sb * 32 + s4 * 4] + w.y * vr[sb * 32 + s4 * 4 + 1] + w.z * vr[sb * 32 + s4 * 4 + 2] + w.w * vr[sb * 32 + s4 * 4 + 3]; }
            }
        const float uu = bf1(PA[(size_t)(n0 + t) * NPA + PA_CU + g * 128 + d]);
        Y[(size_t)(n0 + t) * 1536 + 1024 + g * 128 + d] = (bf16)f2bf(uu * (a + bs[t])); }
    __syncthreads();
}

__device__ __forceinline__ void gmlp16_unit(Frame& F, int l, int chunk) {
    const int lane = fresh_lane(), w = F.wave, tid = w * 64 + lane, fr = lane & 15, fq = lane >> 4;
    const size_t n0 = (size_t)chunk * 128;
    const GAS bf16* PA = (const GAS bf16*)(F.ws + WS_PA); GAS bf16* Y = (GAS bf16*)(F.ws + WS_Y);
    LAS unsigned char* VT = F.lds;
    LAS unsigned char* WT = F.lds + 32768;
    LAS float* st = (LAS float*)(F.lds + AUX_OFF);
    const GAS float* lng = ((const GAS float*)F.in[9]) + l * 512; const GAS float* lnb = ((const GAS float*)F.in[10]) + l * 512;
    for (int j = 0; j < 16; ++j) { const int s = w * 16 + j;
        const u32x4 x4 = *(const GAS u32x4*)(PA + (n0 + s) * NPA + PA_CV + 8 * lane);
        float x[8] = {bflo(x4.x), bfhi(x4.x), bflo(x4.y), bfhi(x4.y), bflo(x4.z), bfhi(x4.z), bflo(x4.w), bfhi(x4.w)};
        float sm = 0.f;
#pragma unroll
        for (int i = 0; i < 8; ++i) sm += x[i];
        const float mean = wave_sum(sm, lane) * (1.f / 512.f); float q = 0.f;
#pragma unroll
        for (int i = 0; i < 8; ++i) { const float d = x[i] - mean; q += d * d; }
        const float rstd = 1.f / sqrtf(wave_sum(q, lane) * (1.f / 512.f) + LN_EPS);
        if (lane == 0) { st[2 * s] = mean; st[2 * s + 1] = rstd; } }
    __syncthreads();
#pragma unroll 1
    for (int g = 0; g < 4; ++g) {
        const GAS float* ws = ((const GAS float*)F.in[11]) + ((size_t)l * 4 + g) * 128 * 128;
#pragma unroll
        for (int i = 0; i < 4; ++i) { const int q = tid + 512 * i, s = q >> 4, d0 = (q & 15) * 8;
            const u32x4 x4 = *(const GAS u32x4*)(PA + (n0 + s) * NPA + PA_CV + g * 128 + d0);
            const float mean = st[2 * s], rstd = st[2 * s + 1];
            float x[8] = {bflo(x4.x), bfhi(x4.x), bflo(x4.y), bfhi(x4.y), bflo(x4.z), bfhi(x4.z), bflo(x4.w), bfhi(x4.w)};
            const f32x4 g0 = *(const GAS f32x4*)(lng + g * 128 + d0), g1 = *(const GAS f32x4*)(lng + g * 128 + d0 + 4), b0 = *(const GAS f32x4*)(lnb + g * 128 + d0), b1 = *(const GAS f32x4*)(lnb + g * 128 + d0 + 4);
#pragma unroll
            for (int k = 0; k < 8; ++k) x[k] = (x[k] - mean) * rstd * ((k < 4) ? g0[k & 3] : g1[k & 3]) + ((k < 4) ? b0[k & 3] : b1[k & 3]);
            u32x4 o; o.x = cvt_pk_bf16(x[0], x[1]); o.y = cvt_pk_bf16(x[2], x[3]); o.z = cvt_pk_bf16(x[4], x[5]); o.w = cvt_pk_bf16(x[6], x[7]);
            *(LAS u32x4*)(VT + s * 256 + d0 * 2) = o;
            const int t = s, s0 = d0;
            f32x4 w0 = *(const GAS f32x4*)(ws + t * 128 + s0), w1 = *(const GAS f32x4*)(ws + t * 128 + s0 + 4);
            float wv[8] = {w0.x, w0.y, w0.z, w0.w, w1.x, w1.y, w1.z, w1.w};
#pragma unroll
            for (int k = 0; k < 8; ++k) wv[k] = (s0 + k <= t) ? wv[k] : 0.f;
            u32x4 ow; ow.x = cvt_pk_bf16(wv[0], wv[1]); ow.y = cvt_pk_bf16(wv[2], wv[3]); ow.z = cvt_pk_bf16(wv[4], wv[5]); ow.w = cvt_pk_bf16(wv[6], wv[7]);
            *(LAS u32x4*)(WT + t * 256 + s0 * 2) = ow; }
        __syncthreads();
        f32x4 acc[8];
#pragma unroll
        for (int nt = 0; nt < 8; ++nt) acc[nt] = (f32x4){0.f, 0.f, 0.f, 0.f};
        const int nks = (16 * w + 15) / 32 + 1;
#pragma unroll
        for (int ks = 0; ks < 4; ++ks) if (ks < nks) {
            const bf16x8 a = *(const LAS bf16x8*)(WT + (16 * w + fr) * 256 + (8 * fq + 32 * ks) * 2);
            const int srow = 32 * ks + 8 * fq + (fr >> 2);
#pragma unroll
            for (int nt = 0; nt < 8; ++nt) { const bf16x8 bv = cat8(ldtr(VT + srow * 256 + (16 * nt + 4 * (fr & 3)) * 2), ldtr(VT + (srow + 4) * 256 + (16 * nt + 4 * (fr & 3)) * 2));
                acc[nt] = __builtin_amdgcn_mfma_f32_16x16x32_bf16(bv, a, acc[nt], 0, 0, 0); } }
        const GAS float* bs = ((const GAS float*)F.in[12]) + ((size_t)l * 4 + g) * 128;
        { const int t = 16 * w + fr; const float bt = bs[t];
#pragma unroll
          for (int nt = 0; nt < 8; ++nt) { const int d0 = 16 * nt + 4 * fq;
              const u32x2 uu = *(const GAS u32x2*)(PA + (n0 + t) * NPA + PA_CU + g * 128 + d0);
              u32x2 wv; wv.x = pk2(bflo(uu.x) * (acc[nt][0] + bt), bfhi(uu.x) * (acc[nt][1] + bt)); wv.y = pk2(bflo(uu.y) * (acc[nt][2] + bt), bfhi(uu.y) * (acc[nt][3] + bt));
              *(GAS u32x2*)(Y + (n0 + t) * 1536 + 1024 + g * 128 + d0) = wv; } }
        __syncthreads();
    }
}

__device__ __forceinline__ void gla_unit(Frame& F, int l, int unit) {
    int tid = F.tid; asm volatile("" : "+v"(tid));
    const int b = unit >> 2, h = unit & 3;
    const GAS bf16* PA = (const GAS bf16*)(F.ws + WS_PA); GAS bf16* Y = (GAS bf16*)(F.ws + WS_Y); const GAS float* GLR = (const GAS float*)(F.ws + WS_GLR);
    LAS float* wa = (LAS float*)F.lds;
    LAS float* ba = wa + 1024;
    LAS float* as_ = ba + 64;
    LAS float* qs = as_ + 1024;
    LAS float* ks = qs + 1024;
    LAS float* vs = ks + 1024;
    LAS float* part = vs + 2048;
    for (int i = tid; i < 1024; i += 512) wa[i] = ((const GAS float*)F.in[6])[(size_t)l * 16 * 256 + (i >> 6) * 256 + h * 64 + (i & 63)];
    if (tid < 64) ba[tid] = ((const GAS float*)F.in[7])[l * 256 + h * 64 + tid];
    const GAS float* gng = ((const GAS float*)F.in[8]) + l * 128;
    const int v = tid & 127, kq = __builtin_amdgcn_readfirstlane(tid >> 7);
    float S[16];
#pragma unroll
    for (int j = 0; j < 16; ++j) S[j] = 0.f;
    __syncthreads();
    for (int t0 = 0; t0 < SEQ; t0 += 16) {
        const size_t nb = (size_t)b * SEQ + t0;
#pragma unroll
        for (int i = 0; i < 2; ++i) { const int e = tid + 512 * i, t = e >> 6, k = e & 63; float z = ba[k];
#pragma unroll
            for (int r = 0; r < 16; ++r) z += GLR[(nb + t) * 16 + r] * wa[r * 64 + k];
            const float ls = fminf(z, 0.f) - log1pf(__expf(-fabsf(z)));
            as_[e] = __expf(ls * (1.f / 16.f));
            qs[e] = bf1(PA[(nb + t) * NPA + PA_BQ + h * 64 + k]); ks[e] = bf1(PA[(nb + t) * NPA + PA_BK + h * 64 + k]); }
#pragma unroll
        for (int i = 0; i < 4; ++i) { const int e = tid + 512 * i, t = e >> 7, vv = e & 127; vs[e] = bf1(PA[(nb + t) * NPA + PA_BV + h * 128 + vv]); }
        __syncthreads();
#pragma unroll 4
        for (int t = 0; t < 16; ++t) { const float vt = vs[t * 128 + v]; float p = 0.f;
#pragma unroll
            for (int j4 = 0; j4 < 4; ++j4) { const f32x4 a4 = *(const LAS f32x4*)(as_ + t * 64 + kq * 16 + j4 * 4), k4 = *(const LAS f32x4*)(ks + t * 64 + kq * 16 + j4 * 4), q4 = *(const LAS f32x4*)(qs + t * 64 + kq * 16 + j4 * 4);
#pragma unroll
                for (int j = 0; j < 4; ++j) { S[j4 * 4 + j] = a4[j] * S[j4 * 4 + j] + k4[j] * vt; p += q4[j] * S[j4 * 4 + j]; } }
            part[(kq * 16 + t) * 128 + v] = p; }
        __syncthreads();
        { const int t = tid >> 5, v4 = (tid & 31) * 4;
          f32x4 o = *(const LAS f32x4*)(part + (0 * 16 + t) * 128 + v4);
#pragma unroll
          for (int q = 1; q < 4; ++q) o += *(const LAS f32x4*)(part + (q * 16 + t) * 128 + v4);
          float ss = o.x * o.x + o.y * o.y + o.z * o.z + o.w * o.w;
#pragma unroll
          for (int sh = 1; sh < 32; sh <<= 1) ss += shx(ss, sh, tid & 63);
          const float r = 1.f / sqrtf(ss * (1.f / 128.f) + RMS_EPS);
          const f32x4 gg = *(const GAS f32x4*)(gng + v4);
          const u32x2 brw = *(const GAS u32x2*)(PA + (nb + t) * NPA + PA_BR + h * 128 + v4);
          u32x2 w; w.x = pk2(o.x * r * gg.x * bflo(brw.x), o.y * r * gg.y * bfhi(brw.x)); w.y = pk2(o.z * r * gg.z * bflo(brw.y), o.w * r * gg.w * bfhi(brw.y));
          *(GAS u32x2*)(Y + (nb + t) * 1536 + 512 + h * 128 + v4) = w; }
        __syncthreads();
    }
}

constexpr size_t WS_US = WS_WMOE, WS_DEC = WS_WMOE + 32 * MiB;
__device__ __forceinline__ void gla_local_unit(Frame& F, int l, int unit, bool dry = false) {
    const int lane = fresh_lane(), w = F.wave, tid = w * 64 + lane, fr = lane & 15, fq = lane >> 4;
    const int b = unit >> 8, h = (unit >> 6) & 3, c = unit & 63; const size_t n0 = (size_t)b * SEQ + 64 * c;
    GAS bf16* PA = (GAS bf16*)(F.ws + WS_PA); GAS bf16* Y = (GAS bf16*)(F.ws + WS_Y); const GAS float* GLR = (const GAS float*)(F.ws + WS_GLR);
    GAS bf16* US = (GAS bf16*)(F.ws + WS_US) + (size_t)unit * 8192; GAS float* DEC = (GAS float*)(F.ws + WS_DEC) + unit * 64;
    LAS unsigned char* QT = F.lds; LAS unsigned char* KT = F.lds + 8192; LAS unsigned char* KD = F.lds + 16384; LAS unsigned char* VV = F.lds + 24576; LAS unsigned char* ATT = F.lds + 40960;
    LAS float* SEG = (LAS float*)(F.lds + 65536); LAS float* WA = (LAS float*)(F.lds + 67584); LAS float* BA = (LAS float*)(F.lds + 71680); LAS float* GL = (LAS float*)(F.lds + 71936);
    const int k = tid & 63, seg = w;
    float qv8[8], kv8[8];
#pragma unroll
    for (int i = 0; i < 8; ++i) { const int t = 8 * seg + i; qv8[i] = bf1(PA[(n0 + t) * NPA + PA_BQ + h * 64 + k]); kv8[i] = bf1(PA[(n0 + t) * NPA + PA_BK + h * 64 + k]); }
    if (tid < 256) *(LAS f32x4*)(GL + 4 * tid) = *(const GAS f32x4*)(GLR + n0 * 16 + 4 * tid);
#pragma unroll
    for (int i = 0; i < 2; ++i) { const int e = tid + 512 * i; WA[e] = ((const GAS float*)F.in[6])[(size_t)l * 16 * 256 + (e >> 6) * 256 + h * 64 + (e & 63)]; }
    if (tid < 64) BA[tid] = ((const GAS float*)F.in[7])[l * 256 + h * 64 + tid];
#pragma unroll
    for (int i = 0; i < 2; ++i) { const int piece = tid + 512 * i, row = piece >> 4, c16 = piece & 15;
        *(LAS u32x4*)(VV + row * 256 + c16 * 16) = *(const GAS u32x4*)(PA + (n0 + row) * NPA + PA_BV + h * 128 + 8 * c16); }
    __syncthreads();
    float cum[8];
    { float run = 0.f;
#pragma unroll
      for (int i = 0; i < 8; ++i) { const int t = 8 * seg + i; float z = BA[k];
          const f32x4 g0 = *(const LAS f32x4*)(GL + t * 16), g1 = *(const LAS f32x4*)(GL + t * 16 + 4), g2 = *(const LAS f32x4*)(GL + t * 16 + 8), g3 = *(const LAS f32x4*)(GL + t * 16 + 12);
#pragma unroll
          for (int r = 0; r < 4; ++r) { z += g0[r] * WA[r * 64 + k]; z += g1[r] * WA[(4 + r) * 64 + k]; z += g2[r] * WA[(8 + r) * 64 + k]; z += g3[r] * WA[(12 + r) * 64 + k]; }
          const float ls = fminf(z, 0.f) - log1pf(__expf(-fabsf(z)));
          run += ls * (1.f / 16.f); cum[i] = run; }
      SEG[seg * 64 + k] = run; }
    __syncthreads();
    { float off = 0.f, blast = 0.f;
#pragma unroll
      for (int s2 = 0; s2 < 8; ++s2) { const float sv = SEG[s2 * 64 + k]; blast += sv; off += (s2 < seg) ? sv : 0.f; }
#pragma unroll
      for (int i = 0; i < 8; ++i) { const int t = 8 * seg + i; const float bb = cum[i] + off;
          const float qv = qv8[i], kv = kv8[i];
          const unsigned qt = f2bf(qv * __expf(bb));
          ((LAS unsigned short*)QT)[t * 64 + k] = (unsigned short)qt; ((LAS unsigned short*)KT)[t * 64 + k] = (unsigned short)f2bf(kv * __expf(-bb)); ((LAS unsigned short*)KD)[t * 64 + k] = (unsigned short)f2bf(kv * __expf(blast - bb));
          if (!dry) PA[(n0 + t) * NPA + PA_BQ + h * 64 + k] = (bf16)qt; }
      if (seg == 0) DEC[k] = __expf(blast); }
    __syncthreads();
#pragma unroll
    for (int ii = 0; ii < 2; ++ii) { const int id = 2 * w + ii, ts = id >> 2, tt = id & 3;
        f32x4 d = {0.f, 0.f, 0.f, 0.f};
        if (ts <= tt) {
#pragma unroll
            for (int ks = 0; ks < 2; ++ks) { const bf16x8 a = *(const LAS bf16x8*)(KT + (16 * ts + fr) * 128 + (8 * fq + 32 * ks) * 2), bq = *(const LAS bf16x8*)(QT + (16 * tt + fr) * 128 + (8 * fq + 32 * ks) * 2);
                d = __builtin_amdgcn_mfma_f32_16x16x32_bf16(a, bq, d, 0, 0, 0); } }
        const int t = 16 * tt + fr, s0 = 16 * ts + 4 * fq;
        u32x2 pk; pk.x = cvt_pk_bf16((s0 <= t) ? d[0] : 0.f, (s0 + 1 <= t) ? d[1] : 0.f); pk.y = cvt_pk_bf16((s0 + 2 <= t) ? d[2] : 0.f, (s0 + 3 <= t) ? d[3] : 0.f);
        *(LAS u32x2*)(ATT + t * 128 + s0 * 2) = pk; }
    __syncthreads();
    { const int tr = w & 3, nh = w >> 2;
      f32x4 ao[4], au[4];
#pragma unroll
      for (int j = 0; j < 4; ++j) { ao[j] = (f32x4){0.f, 0.f, 0.f, 0.f}; au[j] = (f32x4){0.f, 0.f, 0.f, 0.f}; }
#pragma unroll
      for (int ks = 0; ks < 2; ++ks) {
          const bf16x8 aA = *(const LAS bf16x8*)(ATT + (16 * tr + fr) * 128 + (8 * fq + 32 * ks) * 2);
          const int srow = 32 * ks + 8 * fq + (fr >> 2);
          const bf16x8 aK = cat8(ldtr(KD + srow * 128 + (16 * tr + 4 * (fr & 3)) * 2), ldtr(KD + (srow + 4) * 128 + (16 * tr + 4 * (fr & 3)) * 2));
#pragma unroll
          for (int j = 0; j < 4; ++j) { const int nt = 4 * nh + j;
              const bf16x8 bv = cat8(ldtr(VV + srow * 256 + (16 * nt + 4 * (fr & 3)) * 2), ldtr(VV + (srow + 4) * 256 + (16 * nt + 4 * (fr & 3)) * 2));
              ao[j] = __builtin_amdgcn_mfma_f32_16x16x32_bf16(bv, aA, ao[j], 0, 0, 0);
              au[j] = __builtin_amdgcn_mfma_f32_16x16x32_bf16(bv, aK, au[j], 0, 0, 0); } }
#pragma unroll
      for (int j = 0; j < 4; ++j) { const int v0 = 16 * (4 * nh + j) + 4 * fq, row = 16 * tr + fr;
          u32x2 wo; wo.x = pk2(ao[j][0], ao[j][1]); wo.y = pk2(ao[j][2], ao[j][3]); *(GAS u32x2*)(Y + (n0 + row) * 1536 + 512 + h * 128 + v0) = wo;
          u32x2 wu; wu.x = pk2(au[j][0], au[j][1]); wu.y = pk2(au[j][2], au[j][3]); *(GAS u32x2*)(US + row * 128 + v0) = wu; } }
    __syncthreads();
}
__device__ __forceinline__ void gla_scan_phase(Frame& F, bool dry = false) {
    GAS bf16* USb = (GAS bf16*)(F.ws + WS_US); const GAS float* DECb = (const GAS float*)(F.ws + WS_DEC); const size_t dofs = dry ? (size_t)((GAS unsigned char*)F.H - (F.ws + WS_US)) / 4 : 0;
    for (int gt = F.wg * 512 + F.tid; gt < 131072; gt += F.G * 512) { const int e0 = 2 * gt, bh = e0 >> 13, kv = e0 & 8191, k = kv >> 7;
        GAS unsigned* p = (GAS unsigned*)(USb + (size_t)bh * 64 * 8192 + kv); const GAS float* dp = DECb + bh * 64 * 64 + k;
        float s0 = 0.f, s1 = 0.f;
#pragma unroll 8
        for (int c = 0; c < 64; ++c) { const unsigned u = p[(size_t)c * 4096]; const float d = dp[c * 64];
            p[(size_t)c * 4096 + dofs] = pk2(s0, s1);
            s0 = d * s0 + bflo(u); s1 = d * s1 + bfhi(u); } }
}
struct GlaOutRegs { u32x4 us[2]; bf16x8 aq[2]; u32x2 oi[4]; u32x2 br[4]; };
__device__ __forceinline__ void gla_out_load(Frame& F, int unit, int tid, int w, int fr, int fq, GlaOutRegs& R) {
    const int b = unit >> 8, h = (unit >> 6) & 3, c = unit & 63; const size_t n0 = (size_t)b * SEQ + 64 * c;
    const GAS bf16* PA = (const GAS bf16*)(F.ws + WS_PA); const GAS bf16* Y = (const GAS bf16*)(F.ws + WS_Y);
    const GAS bf16* US = (const GAS bf16*)(F.ws + WS_US) + (size_t)unit * 8192;
    const int tr = w >> 1, nh = w & 1, row = 16 * tr + fr;
#pragma unroll
    for (int i = 0; i < 2; ++i) R.us[i] = *(const GAS u32x4*)(US + (tid + 512 * i) * 8);
#pragma unroll
    for (int ks = 0; ks < 2; ++ks) R.aq[ks] = *(const GAS bf16x8*)(PA + (n0 + row) * NPA + PA_BQ + h * 64 + 8 * fq + 32 * ks);
#pragma unroll
    for (int j = 0; j < 4; ++j) { const int v0 = 16 * (4 * nh + j) + 4 * fq; R.oi[j] = *(const GAS u32x2*)(Y + (n0 + row) * 1536 + 512 + h * 128 + v0); R.br[j] = *(const GAS u32x2*)(PA + (n0 + row) * NPA + PA_BR + h * 128 + v0); }
}
__device__ __forceinline__ void gla_out_compute(Frame& F, int l, int unit, int tid, int lane, int w, int fr, int fq, const GlaOutRegs& R, bool dry = false) {
    const int b = unit >> 8, h = (unit >> 6) & 3, c = unit & 63; const size_t n0 = (size_t)b * SEQ + 64 * c;
    GAS bf16* Y = dry ? (GAS bf16*)F.H : (GAS bf16*)(F.ws + WS_Y);
    LAS unsigned char* SS = F.lds;
    LAS float* PS = (LAS float*)(F.lds + 16384);
    const GAS float* gng = ((const GAS float*)F.in[8]) + l * 128;
#pragma unroll
    for (int i = 0; i < 2; ++i) *(LAS u32x4*)(SS + (tid + 512 * i) * 16) = R.us[i];
    __syncthreads();
    const int tr = w >> 1, nh = w & 1, row = 16 * tr + fr;
    f32x4 acc[4];
#pragma unroll
    for (int j = 0; j < 4; ++j) acc[j] = (f32x4){0.f, 0.f, 0.f, 0.f};
#pragma unroll
    for (int ks = 0; ks < 2; ++ks) { const int krow = 32 * ks + 8 * fq + (fr >> 2);
#pragma unroll
        for (int j = 0; j < 4; ++j) { const int nt = 4 * nh + j;
            const bf16x8 bs = cat8(ldtr(SS + krow * 256 + (16 * nt + 4 * (fr & 3)) * 2), ldtr(SS + (krow + 4) * 256 + (16 * nt + 4 * (fr & 3)) * 2));
            acc[j] = __builtin_amdgcn_mfma_f32_16x16x32_bf16(bs, R.aq[ks], acc[j], 0, 0, 0); } }
    float ss = 0.f;
#pragma unroll
    for (int j = 0; j < 4; ++j) { const u32x2 oi = R.oi[j];
        acc[j][0] += bflo(oi.x); acc[j][1] += bfhi(oi.x); acc[j][2] += bflo(oi.y); acc[j][3] += bfhi(oi.y);
        ss += (acc[j][0] * acc[j][0] + acc[j][1] * acc[j][1]) + (acc[j][2] * acc[j][2] + acc[j][3] * acc[j][3]); }
    ss += shx(ss, 16, lane); ss += shx(ss, 32, lane);
    if (fq == 0) PS[row * 2 + nh] = ss;
    __syncthreads();
    { const float rinv = 1.f / sqrtf((PS[row * 2] + PS[row * 2 + 1]) * (1.f / 128.f) + RMS_EPS);
#pragma unroll
      for (int j = 0; j < 4; ++j) { const int v0 = 16 * (4 * nh + j) + 4 * fq; const f32x4 gg = *(const GAS f32x4*)(gng + v0); const u32x2 br = R.br[j];
          u32x2 wv; wv.x = pk2(acc[j][0] * rinv * gg[0] * bflo(br.x), acc[j][1] * rinv * gg[1] * bfhi(br.x)); wv.y = pk2(acc[j][2] * rinv * gg[2] * bflo(br.y), acc[j][3] * rinv * gg[3] * bfhi(br.y));
          *(GAS u32x2*)(Y + (n0 + row) * 1536 + 512 + h * 128 + v0) = wv; } }
    __syncthreads();
}
constexpr int DSA_WAVE_LDS = 17920;
__device__ __forceinline__ void dsa_unit(Frame& F, int unit) {
    int lane = F.lane; asm volatile("" : "+v"(lane)); const int w = F.wave;
    const int qb = 4095 - unit;
    const int b = qb & 7, t = (qb >> 3) * 8 + w;
    const size_t n = (size_t)b * SEQ + t, nb0 = (size_t)b * SEQ;
    const GAS bf16* PA = (const GAS bf16*)(F.ws + WS_PA); GAS bf16* Y = (GAS bf16*)(F.ws + WS_Y);
    const GAS bf16* KI = (const GAS bf16*)(F.ws + WS_KI); const GAS bf16* KA = (const GAS bf16*)(F.ws + WS_KA); const GAS bf16* VA = (const GAS bf16*)(F.ws + WS_VA);
    const GAS float* WI = (const GAS float*)(F.ws + WS_WI);
    LAS unsigned char* base = F.lds + w * DSA_WAVE_LDS;
    LAS unsigned* sc = (LAS unsigned*)base;
    LAS float* qi = (LAS float*)(base + 16384);
    LAS unsigned short* list = (LAS unsigned short*)(base + 16384 + 1024);
    { const u32x2 q2 = *(const GAS u32x2*)(PA + n * NPA + PA_QI + 4 * lane);
      *(LAS f32x4*)(qi + 4 * lane) = (f32x4){bflo(q2.x), bfhi(q2.x), bflo(q2.y), bfhi(q2.y)}; }
    asm volatile("s_waitcnt lgkmcnt(0)" ::: "memory");
    const f32x4 wi = {ld_f32(WI + n * 4), ld_f32(WI + n * 4 + 1), ld_f32(WI + n * 4 + 2), ld_f32(WI + n * 4 + 3)};
    const int nbat = (t >> 6) + 1;
    for (int kb = 0; kb < nbat; ++kb) { const int key = kb * 64 + lane, kc = key <= t ? key : t;
        const GAS u32x4* kp = (const GAS u32x4*)(KI + (nb0 + kc) * 64);
        float kf[64];
#pragma unroll
        for (int c = 0; c < 8; ++c) { const u32x4 kk = kp[c]; kf[8 * c] = bflo(kk.x); kf[8 * c + 1] = bfhi(kk.x); kf[8 * c + 2] = bflo(kk.y); kf[8 * c + 3] = bfhi(kk.y); kf[8 * c + 4] = bflo(kk.z); kf[8 * c + 5] = bfhi(kk.z); kf[8 * c + 6] = bflo(kk.w); kf[8 * c + 7] = bfhi(kk.w); }
        float score = 0.f;
#pragma unroll
        for (int h = 0; h < 4; ++h) { float d = 0.f;
#pragma unroll
            for (int c = 0; c < 16; ++c) { const f32x4 q4 = *(const LAS f32x4*)(qi + h * 64 + 4 * c); d += q4.x * kf[4 * c] + q4.y * kf[4 * c + 1] + q4.z * kf[4 * c + 2] + q4.w * kf[4 * c + 3]; }
            score += wi[h] * fmaxf(d, 0.f); }
        if (score == 0.f) score = 0.f;
        unsigned u = __builtin_bit_cast(unsigned, score); u = (u & 0x80000000u) ? ~u : (u | 0x80000000u);
        sc[key] = key <= t ? u : 0u; }
    asm volatile("s_waitcnt lgkmcnt(0)" ::: "memory");
    int nsel;
    if (t >= 256) {
        unsigned T = 0u;
        for (int bit = 31; bit >= 0; --bit) { const unsigned cand = T | (1u << bit); int cnt = 0;
            for (int j = 0; j < nbat; ++j) cnt += (sc[j * 64 + lane] >= cand) ? 1 : 0;
            if (wave_sum_i(cnt, lane) >= 256) T = cand; }
        int cgt = 0;
        for (int j = 0; j < nbat; ++j) cgt += (sc[j * 64 + lane] > T) ? 1 : 0;
        const int need = 256 - wave_sum_i(cgt, lane);
        int selbase = 0, tiebase = 0;
        for (int j = 0; j < nbat; ++j) { const unsigned x = sc[j * 64 + lane]; const bool eq = (x == T), gt = (x > T);
            const unsigned long long beq = __ballot(eq); const unsigned long long lt = (1ull << lane) - 1ull;
            const int trank = tiebase + __popcll(beq & lt);
            const bool sel = gt || (eq && trank < need);
            const unsigned long long bsel = __ballot(sel);
            if (sel) list[selbase + __popcll(bsel & lt)] = (unsigned short)(j * 64 + lane);
            selbase += __popcll(bsel); tiebase += __popcll(beq); }
        nsel = 256;
    } else {
        nsel = t + 1;
        for (int i = lane; i < 256; i += 64) list[i] = (unsigned short)(i <= t ? i : 0);
    }
    asm volatile("s_waitcnt lgkmcnt(0)" ::: "memory");
    LAS float* qm = (LAS float*)base;
    LAS float* Pl = (LAS float*)(base + 2048);
    { const u32x4 q8 = *(const GAS u32x4*)(PA + n * NPA + PA_Q + 8 * lane);
      *(LAS f32x4*)(qm + 8 * lane) = (f32x4){bflo(q8.x), bfhi(q8.x), bflo(q8.y), bfhi(q8.y)}; *(LAS f32x4*)(qm + 8 * lane + 4) = (f32x4){bflo(q8.z), bfhi(q8.z), bflo(q8.w), bfhi(q8.w)}; }
    asm volatile("s_waitcnt lgkmcnt(0)" ::: "memory");
#pragma unroll 1
    for (int bb = 0; bb < 4; ++bb) { const int i = bb * 64 + lane; const bool valid = i < nsel; const int key = valid ? (int)list[i] : 0;
        const GAS u32x4* kp = (const GAS u32x4*)(KA + (nb0 + key) * 64);
        float kf[64];
#pragma unroll
        for (int c = 0; c < 8; ++c) { const u32x4 kk = kp[c]; kf[8 * c] = bflo(kk.x); kf[8 * c + 1] = bfhi(kk.x); kf[8 * c + 2] = bflo(kk.y); kf[8 * c + 3] = bfhi(kk.y); kf[8 * c + 4] = bflo(kk.z); kf[8 * c + 5] = bfhi(kk.z); kf[8 * c + 6] = bflo(kk.w); kf[8 * c + 7] = bfhi(kk.w); }
        float lgv[8];
#pragma unroll
        for (int h = 0; h < 8; ++h) { float d = 0.f;
#pragma unroll
            for (int c = 0; c < 16; ++c) { const f32x4 q4 = *(const LAS f32x4*)(qm + h * 64 + 4 * c); d += q4.x * kf[4 * c] + q4.y * kf[4 * c + 1] + q4.z * kf[4 * c + 2] + q4.w * kf[4 * c + 3]; }
            lgv[h] = valid ? d : -INFINITY; }
        *(LAS f32x4*)(Pl + i * 8) = (f32x4){lgv[0], lgv[1], lgv[2], lgv[3]}; *(LAS f32x4*)(Pl + i * 8 + 4) = (f32x4){lgv[4], lgv[5], lgv[6], lgv[7]}; }
    asm volatile("s_waitcnt lgkmcnt(0)" ::: "memory");
    float lg[4][8];
#pragma unroll
    for (int bb = 0; bb < 4; ++bb) { const f32x4 a = *(const LAS f32x4*)(Pl + (bb * 64 + lane) * 8), c = *(const LAS f32x4*)(Pl + (bb * 64 + lane) * 8 + 4);
        lg[bb][0] = a.x; lg[bb][1] = a.y; lg[bb][2] = a.z; lg[bb][3] = a.w; lg[bb][4] = c.x; lg[bb][5] = c.y; lg[bb][6] = c.z; lg[bb][7] = c.w; }
    float den[8];
#pragma unroll
    for (int h = 0; h < 8; ++h) { float m = fmaxf(fmaxf(lg[0][h], lg[1][h]), fmaxf(lg[2][h], lg[3][h])); m = wave_max(m, lane); float s = 0.f;
#pragma unroll
        for (int bb = 0; bb < 4; ++bb) { lg[bb][h] = __expf(lg[bb][h] - m); s += lg[bb][h]; }
        den[h] = wave_sum(s, lane); }
#pragma unroll
    for (int bb = 0; bb < 4; ++bb) { const int i = bb * 64 + lane;
        *(LAS f32x4*)(Pl + i * 8) = (f32x4){lg[bb][0], lg[bb][1], lg[bb][2], lg[bb][3]}; *(LAS f32x4*)(Pl + i * 8 + 4) = (f32x4){lg[bb][4], lg[bb][5], lg[bb][6], lg[bb][7]}; }
    asm volatile("s_waitcnt lgkmcnt(0)" ::: "memory");
    float o[8];
#pragma unroll
    for (int h = 0; h < 8; ++h) o[h] = 0.f;
#pragma unroll 4
    for (int i = 0; i < nsel; ++i) { const int key = (int)list[i]; const float vv = bf1(VA[(nb0 + key) * 64 + lane]);
        const f32x4 p0 = *(const LAS f32x4*)(Pl + i * 8), p1 = *(const LAS f32x4*)(Pl + i * 8 + 4);
        o[0] += p0.x * vv; o[1] += p0.y * vv; o[2] += p0.z * vv; o[3] += p0.w * vv; o[4] += p1.x * vv; o[5] += p1.y * vv; o[6] += p1.z * vv; o[7] += p1.w * vv; }
#pragma unroll
    for (int h = 0; h < 8; ++h) Y[n * 1536 + h * 64 + lane] = (bf16)f2bf(o[h] / den[h]);
}

__device__ __forceinline__ bf16x8 scale_pack8(u32x4 raw, float s) {
    u32x4 o; o.x = cvt_pk_bf16(bflo(raw.x) * s, bfhi(raw.x) * s); o.y = cvt_pk_bf16(bflo(raw.y) * s, bfhi(raw.y) * s); o.z = cvt_pk_bf16(bflo(raw.z) * s, bfhi(raw.z) * s); o.w = cvt_pk_bf16(bflo(raw.w) * s, bfhi(raw.w) * s);
    return __builtin_bit_cast(bf16x8, o);
}
__device__ __forceinline__ void dsa16_unit(Frame& F, int unit) {
    const int lane = fresh_lane(); const int w = F.wave;
    const int qb = 2047 - unit;
    const int b = qb & 7, t0 = (qb >> 3) * 16;
    const size_t nb0 = (size_t)b * SEQ;
    const GAS bf16* PA = (const GAS bf16*)(F.ws + WS_PA); GAS bf16* Y = (GAS bf16*)(F.ws + WS_Y);
    const GAS bf16* KI = (const GAS bf16*)(F.ws + WS_KI); const GAS bf16* KA = (const GAS bf16*)(F.ws + WS_KA); const GAS bf16* VA = (const GAS bf16*)(F.ws + WS_VA);
    const GAS float* WI = (const GAS float*)(F.ws + WS_WI);
    LAS unsigned char* K16 = F.lds;
    LAS unsigned short* LIST = (LAS unsigned short*)(F.lds + AUX_OFF);
    const int fr = lane & 15, fq = lane >> 4;
#ifdef REP_S1
    for (int rep_ = 0; rep_ < REP_S1; ++rep_)
#endif
    {
        const int ql = fr >> 2, h = fr & 3;
        bf16x8 Bf[4][2]; float Linf[4];
#pragma unroll
        for (int g = 0; g < 4; ++g) { const size_t nq = nb0 + t0 + 4 * g + ql; const float wv = WI[nq * 4 + h];
#pragma unroll
            for (int ks = 0; ks < 2; ++ks) Bf[g][ks] = scale_pack8(*(const GAS u32x4*)(PA + nq * NPA + PA_QI + h * 64 + 8 * fq + 32 * ks), wv);
            Linf[g] = (wv >= 0.f) ? INFINITY : -INFINITY; }
        const int ntiles = (t0 >> 4) + 1;
        bf16x8 A0[4], A1[4];
#pragma unroll
        for (int j = 0; j < 4; ++j) { const int tile = (w + 8 * j < ntiles) ? w + 8 * j : ntiles - 1; const size_t krow = (nb0 + 16 * tile + fr) * 64;
            A0[j] = *(const GAS bf16x8*)(KI + krow + 8 * fq); A1[j] = *(const GAS bf16x8*)(KI + krow + 32 + 8 * fq); }
#pragma unroll 1
        for (int tb = w; tb < ntiles; tb += 32) {
            bf16x8 N0[4], N1[4];
#pragma unroll
            for (int j = 0; j < 4; ++j) { const int tn = tb + 32 + 8 * j; const int tile = (tn < ntiles) ? tn : ntiles - 1; const size_t krow = (nb0 + 16 * tile + fr) * 64;
                N0[j] = *(const GAS bf16x8*)(KI + krow + 8 * fq); N1[j] = *(const GAS bf16x8*)(KI + krow + 32 + 8 * fq); }
#pragma unroll
            for (int j = 0; j < 4; ++j) { const int tile = tb + 8 * j;
                if (tile < ntiles) {
                    const int kpos = 16 * tile + 4 * fq + h;
                    const int g7 = kpos >> 7, hf = (kpos >> 6) & 1, ln = kpos & 63;
                    const int koff = (g7 >> 2) * 1024 + ln * 16 + (g7 & 3) * 4 + hf * 2;
                    const bool lastt = (tile == ntiles - 1);
                    f32x4 d[4];
#pragma unroll
                    for (int g = 0; g < 4; ++g) d[g] = __builtin_amdgcn_mfma_f32_16x16x32_bf16(A0[j], Bf[g][0], (f32x4){0.f, 0.f, 0.f, 0.f}, 0, 0, 0);
#pragma unroll
                    for (int g = 0; g < 4; ++g) d[g] = __builtin_amdgcn_mfma_f32_16x16x32_bf16(A1[j], Bf[g][1], d[g], 0, 0, 0);
#define S1_STEP(g) const float a0##g = __builtin_amdgcn_fmed3f(d[g][0], 0.f, Linf[g]), a1##g = __builtin_amdgcn_fmed3f(d[g][1], 0.f, Linf[g]), a2##g = __builtin_amdgcn_fmed3f(d[g][2], 0.f, Linf[g]), a3##g = __builtin_amdgcn_fmed3f(d[g][3], 0.f, Linf[g]);
                    S1_STEP(0) S1_STEP(1) S1_STEP(2) S1_STEP(3)
#undef S1_STEP
#define S1_STEP(g) const float u0##g = a0##g + dppf<0xB1>(a0##g), u1##g = a1##g + dppf<0xB1>(a1##g), u2##g = a2##g + dppf<0xB1>(a2##g), u3##g = a3##g + dppf<0xB1>(a3##g);
                    S1_STEP(0) S1_STEP(1) S1_STEP(2) S1_STEP(3)
#undef S1_STEP
#define S1_STEP(g) const float p0##g = (h & 1) ? u1##g : u0##g, p1##g = (h & 1) ? u3##g : u2##g;
                    S1_STEP(0) S1_STEP(1) S1_STEP(2) S1_STEP(3)
#undef S1_STEP
#define S1_STEP(g) const float c0##g = p0##g + dppf<0x4E>(p0##g), c1##g = p1##g + dppf<0x4E>(p1##g);
                    S1_STEP(0) S1_STEP(1) S1_STEP(2) S1_STEP(3)
#undef S1_STEP
#define S1_STEP(g) const float s##g = ((h & 2) ? c1##g : c0##g) + 0.0f; const _Float16 hh##g = (_Float16)s##g; const unsigned hb##g = (unsigned)__builtin_bit_cast(unsigned short, hh##g); \
                    unsigned key##g = hb##g ^ ((unsigned)((int)(hb##g << 16) >> 31) | 0x8000u); if (lastt) key##g = (kpos <= t0 + 4 * g + ql) ? key##g : 0u;
                    S1_STEP(0) S1_STEP(1) S1_STEP(2) S1_STEP(3)
#undef S1_STEP
#define S1_STEP(g) *(LAS unsigned short*)(K16 + (4 * g + ql) * 8192 + koff) = (unsigned short)key##g;
                    S1_STEP(0) S1_STEP(1) S1_STEP(2) S1_STEP(3)
#undef S1_STEP
                }
            }
#pragma unroll
            for (int j = 0; j < 4; ++j) { A0[j] = N0[j]; A1[j] = N1[j]; }
        }
    }
    __syncthreads();
    if (t0 < 256) {
#pragma unroll 1
        for (int qq = 0; qq < 2; ++qq) { const int q = 2 * w + qq, nvalid = t0 + q + 1; LAS unsigned short* list = LIST + q * 256;
            for (int i = lane; i < 256; i += 64) list[i] = (unsigned short)(i < nvalid ? i : 0); }
    } else {
#ifndef REP_S2
#define REP_S2 1
#endif
#pragma unroll 1
        for (int qq = 0; qq < 2 * REP_S2; ++qq) {
            const int q = 2 * w + (qq & 1), nvalid = t0 + q + 1;
            LAS unsigned short* list = LIST + q * 256;
            const int ngrp = (nvalid + 511) >> 9;
            unsigned P[32];
#pragma unroll
            for (int grp = 0; grp < 8; ++grp) {
                if (grp < ngrp) { const u32x4 r = *(const LAS u32x4*)(K16 + q * 8192 + grp * 1024 + lane * 16);
#pragma unroll
                    for (int i = 0; i < 4; ++i) { const int g = 4 * grp + i; const int thr = nvalid - 128 * g; unsigned rr = r[i];
                        if (thr < 128) rr &= ((lane < thr) ? 0xffffu : 0u) | ((lane < thr - 64) ? 0xffff0000u : 0u);
                        P[g] = rr; }
                } else {
#pragma unroll
                    for (int i = 0; i < 4; ++i) P[4 * grp + i] = 0u;
                }
            }
            unsigned one2 = 0x00010001u; asm volatile("" : "+v"(one2));
#define DSA_PKCOUNT(dst, c1) do { const unsigned c1p_ = (c1) | ((c1) << 16); unsigned a_ = 0u; \
                _Pragma("unroll") for (int grp = 0; grp < 8; ++grp) if (grp < ngrp) { _Pragma("unroll") for (int i = 0; i < 4; ++i) { unsigned y_; \
                    asm("v_pk_sub_u16 %0, %1, %2 clamp\n\tv_pk_min_u16 %0, %0, %3" : "=&v"(y_) : "v"(P[4 * grp + i]), "v"(c1p_), "v"(one2)); a_ += y_; } } \
                dst = (int)((a_ & 0xffffu) + (a_ >> 16)); } while (0)
            LAS unsigned* hist = (LAS unsigned*)(F.lds + AUX_OFF + 8192) + w * 256;
            unsigned T; int tot_gt;
            { unsigned hi8 = 0u; int above = 0;
#pragma unroll
              for (int lvl = 0; lvl < 2; ++lvl) {
                  { unsigned z_ = 0u; asm volatile("" : "+v"(z_)); *(LAS u32x4*)(hist + 4 * lane) = (u32x4){z_, z_, z_, z_}; }
                  asm volatile("s_waitcnt lgkmcnt(0)" ::: "memory");
#pragma unroll
                  for (int grp = 0; grp < 8; ++grp) if (grp < ngrp) {
#pragma unroll
                      for (int i = 0; i < 4; ++i) { const unsigned lo = P[4 * grp + i] & 0xffffu, hi = P[4 * grp + i] >> 16;
                          if (lvl == 0) { __hip_atomic_fetch_add(hist + (lo >> 8), 1u, __ATOMIC_RELAXED, __HIP_MEMORY_SCOPE_WAVEFRONT); __hip_atomic_fetch_add(hist + (hi >> 8), 1u, __ATOMIC_RELAXED, __HIP_MEMORY_SCOPE_WAVEFRONT); }
                          else { if ((lo >> 8) == hi8) __hip_atomic_fetch_add(hist + (lo & 0xffu), 1u, __ATOMIC_RELAXED, __HIP_MEMORY_SCOPE_WAVEFRONT);
                                 if ((hi >> 8) == hi8) __hip_atomic_fetch_add(hist + (hi & 0xffu), 1u, __ATOMIC_RELAXED, __HIP_MEMORY_SCOPE_WAVEFRONT); } } }
                  asm volatile("s_waitcnt lgkmcnt(0)" ::: "memory");
                  const u32x4 hb = *(const LAS u32x4*)(hist + 4 * lane);
                  const int sl = (int)(hb.x + hb.y + hb.z + hb.w);
                  int inc = sl;
                  inc += __builtin_amdgcn_update_dpp(0, inc, 0x111, 0xf, 0xf, false); inc += __builtin_amdgcn_update_dpp(0, inc, 0x112, 0xf, 0xf, false);
                  inc += __builtin_amdgcn_update_dpp(0, inc, 0x114, 0xf, 0xf, false); inc += __builtin_amdgcn_update_dpp(0, inc, 0x118, 0xf, 0xf, false);
                  const int r0 = __builtin_amdgcn_readlane(inc, 15), r1 = __builtin_amdgcn_readlane(inc, 31), r2 = __builtin_amdgcn_readlane(inc, 47), r3 = __builtin_amdgcn_readlane(inc, 63);
                  inc += (fq >= 1 ? r0 : 0) + (fq >= 2 ? r1 : 0) + (fq >= 3 ? r2 : 0);
                  const int total = r0 + r1 + r2 + r3;
                  const int want = 256 - above;
                  int run = total - inc;
                  int fb = -1, fa = 0;
                  { const int h3 = (int)hb.w, h2 = (int)hb.z, h1 = (int)hb.y, h0 = (int)hb.x;
                    if (run < want && run + h3 >= want) { fb = 3; fa = run; } run += h3;
                    if (run < want && run + h2 >= want) { fb = 2; fa = run; } run += h2;
                    if (run < want && run + h1 >= want) { fb = 1; fa = run; } run += h1;
                    if (run < want && run + h0 >= want) { fb = 0; fa = run; } }
                  const unsigned long long fm = __ballot(fb >= 0);
                  const int src = (int)__builtin_ctzll(fm);
                  const int bstar = __builtin_amdgcn_readlane(4 * lane + fb, src), abv = __builtin_amdgcn_readlane(fa, src);
                  if (lvl == 0) { hi8 = (unsigned)bstar; above = abv; } else { T = (hi8 << 8) | (unsigned)bstar; tot_gt = above + abv; }
              } }
            int cge_l, cgt_l; DSA_PKCOUNT(cge_l, T - 1u); DSA_PKCOUNT(cgt_l, T);
            const int tot_ge = wave_total_i(cge_l);
            const bool alltie = (tot_ge == 256);
            const int c_l = alltie ? cge_l : cgt_l; const unsigned thrT = alltie ? T : T + 1u;
            int inc = c_l;
            inc += __builtin_amdgcn_update_dpp(0, inc, 0x111, 0xf, 0xf, false); inc += __builtin_amdgcn_update_dpp(0, inc, 0x112, 0xf, 0xf, false);
            inc += __builtin_amdgcn_update_dpp(0, inc, 0x114, 0xf, 0xf, false); inc += __builtin_amdgcn_update_dpp(0, inc, 0x118, 0xf, 0xf, false);
            { const int r0 = __builtin_amdgcn_readlane(inc, 15), r1 = __builtin_amdgcn_readlane(inc, 31), r2 = __builtin_amdgcn_readlane(inc, 47);
              inc += (fq >= 1 ? r0 : 0) + (fq >= 2 ? r1 : 0) + (fq >= 3 ? r2 : 0); }
            int kpos_ = inc - c_l;
#pragma unroll
            for (int grp = 0; grp < 8; ++grp) if (grp < ngrp) {
#pragma unroll
                for (int i = 0; i < 4; ++i) { const int g = 4 * grp + i; const unsigned lo = P[g] & 0xffffu, hi = P[g] >> 16;
                    if (lo >= thrT) { list[kpos_] = (unsigned short)(128 * g + lane); ++kpos_; }
                    if (hi >= thrT) { list[kpos_] = (unsigned short)(128 * g + 64 + lane); ++kpos_; } } }
            if (!alltie) {
                int rem = 256 - tot_gt, pos = tot_gt; const unsigned long long lt = (1ull << lane) - 1ull;
#pragma unroll
                for (int grp = 0; grp < 8; ++grp) if (grp < ngrp) {
#pragma unroll
                    for (int i = 0; i < 8; ++i) { const int g = 4 * grp + (i >> 1); const unsigned val = (i & 1) ? (P[g] >> 16) : (P[g] & 0xffffu);
                        const bool eq = (val == T); const unsigned long long beq = __ballot(eq);
                        if (beq != 0ull) { const int rank = __popcll(beq & lt); if (eq && rank < rem) list[pos + rank] = (unsigned short)(128 * g + 64 * (i & 1) + lane);
                            const int n = __popcll(beq), take = n < rem ? n : rem; pos += take; rem -= take; } } }
            }
#undef DSA_PKCOUNT
        }
    }
    asm volatile("s_waitcnt lgkmcnt(0)" ::: "memory");
    LAS unsigned char* Vs = F.lds + w * 16384;
#ifndef REP_S3
#define REP_S3 1
#endif
#pragma unroll 1
    for (int qq = 0; qq < 2 * REP_S3; ++qq) {
        const int q = 2 * w + (qq & 1), tq = t0 + q; const int nsel = (tq + 1 < 256) ? tq + 1 : 256;
        const size_t nq = nb0 + tq;
        const LAS unsigned short* list = LIST + q * 256;
        bf16x8 Qf[2];
#pragma unroll
        for (int ks = 0; ks < 2; ++ks) { u32x4 raw = {0u, 0u, 0u, 0u}; if (fr < 8) raw = *(const GAS u32x4*)(PA + nq * NPA + PA_Q + fr * 64 + 8 * fq + 32 * ks); Qf[ks] = __builtin_bit_cast(bf16x8, raw); }
        float lg[16][4];
#ifdef REP_S3K
#pragma unroll 1
        for (int repk = 0; repk < REP_S3K; ++repk)
#endif
        const int st_off = (lane >> 3) * 128 + (((lane & 7) ^ ((lane >> 3) & 7)) * 16);
        const int rd0 = fr * 128 + ((fq ^ (fr & 7)) * 16), rd1 = fr * 128 + (((fq + 4) ^ (fr & 7)) * 16);
#pragma unroll
        for (int hb = 0; hb < 2; ++hb) {
#pragma unroll
            for (int ib = 0; ib < 2; ++ib) { u32x4 kv[8];
#pragma unroll
                for (int i = 0; i < 8; ++i) { const int piece = (8 * ib + i) * 64 + lane; const int key = (int)list[128 * hb + (piece >> 3)];
                    kv[i] = *(const GAS u32x4*)(KA + (nb0 + key) * 64 + 8 * (lane & 7)); }
                __builtin_amdgcn_sched_barrier(0);
#pragma unroll
                for (int i = 0; i < 8; ++i) *(LAS u32x4*)(Vs + st_off + (8 * ib + i) * 1024) = kv[i];
            }
            asm volatile("s_waitcnt lgkmcnt(0)" ::: "memory");
#pragma unroll
            for (int j = 0; j < 8; ++j) { const int tt = 8 * hb + j;
                const bf16x8 A0 = *(const LAS bf16x8*)(Vs + rd0 + j * 2048), A1 = *(const LAS bf16x8*)(Vs + rd1 + j * 2048);
                f32x4 d = __builtin_amdgcn_mfma_f32_16x16x32_bf16(A0, Qf[0], (f32x4){0.f, 0.f, 0.f, 0.f}, 0, 0, 0);
                d = __builtin_amdgcn_mfma_f32_16x16x32_bf16(A1, Qf[1], d, 0, 0, 0);
#pragma unroll
                for (int r = 0; r < 4; ++r) lg[tt][r] = (16 * tt + 4 * fq + r < nsel) ? d[r] : -INFINITY; }
            asm volatile("s_waitcnt lgkmcnt(0)" ::: "memory");
        }
        float m = lg[0][0];
#pragma unroll
        for (int tt = 0; tt < 16; ++tt)
#pragma unroll
            for (int r = 0; r < 4; ++r) m = fmaxf(m, lg[tt][r]);
        m = fmaxf(m, shx(m, 16, lane)); m = fmaxf(m, shx(m, 32, lane));
        float den = 0.f;
#pragma unroll
        for (int tt = 0; tt < 16; ++tt)
#pragma unroll
            for (int r = 0; r < 4; ++r) { lg[tt][r] = __expf(lg[tt][r] - m); den += lg[tt][r]; }
        den += shx(den, 16, lane); den += shx(den, 32, lane);
        f32x4 acc[4];
#pragma unroll
        for (int nt = 0; nt < 4; ++nt) acc[nt] = (f32x4){0.f, 0.f, 0.f, 0.f};
#ifdef REP_S3V
#pragma unroll 1
        for (int repv = 0; repv < REP_S3V; ++repv) {
#pragma unroll
        for (int nt = 0; nt < 4; ++nt) acc[nt] = (f32x4){0.f, 0.f, 0.f, 0.f};
#endif
#pragma unroll
        for (int hh = 0; hh < 2; ++hh) {
#pragma unroll
            for (int ib = 0; ib < 2; ++ib) {
                u32x4 vv[8];
#pragma unroll
                for (int i = 0; i < 8; ++i) { const int piece = (8 * ib + i) * 64 + lane, row = piece >> 3, c = piece & 7; const int key = (int)list[128 * hh + row];
                    vv[i] = *(const GAS u32x4*)(VA + (nb0 + key) * 64 + 8 * c); }
                __builtin_amdgcn_sched_barrier(0);
#pragma unroll
                for (int i = 0; i < 8; ++i) { const int piece = (8 * ib + i) * 64 + lane; *(LAS u32x4*)(Vs + piece * 16) = vv[i]; }
            }
            asm volatile("s_waitcnt lgkmcnt(0)" ::: "memory");
#pragma unroll
            for (int s4 = 0; s4 < 4; ++s4) { const int s = 4 * hh + s4;
                u32x4 pa; pa.x = cvt_pk_bf16(lg[2 * s][0], lg[2 * s][1]); pa.y = cvt_pk_bf16(lg[2 * s][2], lg[2 * s][3]); pa.z = cvt_pk_bf16(lg[2 * s + 1][0], lg[2 * s + 1][1]); pa.w = cvt_pk_bf16(lg[2 * s + 1][2], lg[2 * s + 1][3]);
                const bf16x8 Pa = __builtin_bit_cast(bf16x8, pa);
                const int rowa = 32 * s4 + 4 * fq + (fr >> 2);
#pragma unroll
                for (int nt = 0; nt < 4; ++nt) {
                    const v4i16_t lo = __builtin_amdgcn_ds_read_tr16_b64_v4i16((LAS v4i16_t*)(Vs + rowa * 128 + (16 * nt + 4 * (fr & 3)) * 2));
                    const v4i16_t hi = __builtin_amdgcn_ds_read_tr16_b64_v4i16((LAS v4i16_t*)(Vs + (rowa + 16) * 128 + (16 * nt + 4 * (fr & 3)) * 2));
                    bf16x8 Bv; Bv[0] = lo[0]; Bv[1] = lo[1]; Bv[2] = lo[2]; Bv[3] = lo[3]; Bv[4] = hi[0]; Bv[5] = hi[1]; Bv[6] = hi[2]; Bv[7] = hi[3];
                    acc[nt] = __builtin_amdgcn_mfma_f32_16x16x32_bf16(Bv, Pa, acc[nt], 0, 0, 0); } }
            asm volatile("s_waitcnt lgkmcnt(0)" ::: "memory");
        }
#ifdef REP_S3V
        }
#endif
        if (fr < 8) { const float rden = 1.f / den;
#pragma unroll
            for (int nt = 0; nt < 4; ++nt) { u32x2 wv; wv.x = pk2(acc[nt][0] * rden, acc[nt][1] * rden); wv.y = pk2(acc[nt][2] * rden, acc[nt][3] * rden);
                *(GAS u32x2*)(Y + nq * 1536 + fr * 64 + 16 * nt + 4 * fq) = wv; } }
    }
}

#ifdef GLA_NAIVE
constexpr int NGLA = 32;
#else
constexpr int NGLA = 2048;
#endif
#ifdef DSA_NAIVE
constexpr int NDSA = 4096;
#else
constexpr int NDSA = 2048;
#endif
#ifdef GMLP_NAIVE
constexpr int NGM = 1024;
#else
constexpr int NGM = 256;
#endif
__device__ __forceinline__ void phase_mixer(Frame& F, int l, int slot = 0, int types = 7, bool dry = false) {
    (void)slot;
    for (int j = 0; j * F.G < NDSA; ++j) { const int u = j * F.G + ((j & 1) ? (F.G - 1 - F.wg) : F.wg);
        if (u >= NDSA) continue;
        __syncthreads(); if (EN_B2 && (types & 2)) {
#ifdef DSA_NAIVE
        dsa_unit(F, u);
#else
        dsa16_unit(F, u);
#endif
    } }
    for (int u = F.wg; u < NGLA; u += F.G) { __syncthreads(); if (EN_B1 && (types & 1)) {
#ifdef GLA_NAIVE
        gla_unit(F, l, u);
#else
        gla_local_unit(F, l, u, dry);
#endif
    } }
    for (int u = F.wg; u < NGM; u += F.G) { __syncthreads(); if (EN_B3 && (types & 4)) {
#ifdef GMLP_NAIVE
        gmlp_unit(F, l, u);
#else
        gmlp16_unit(F, l, u);
#endif
    } }
}
__device__ __forceinline__ void phase_gla_out(Frame& F, int l, bool dry = false) {
#ifndef GLA_NAIVE
    const int lane = fresh_lane(), w = F.wave, tid = w * 64 + lane, fr = lane & 15, fq = lane >> 4;
    GlaOutRegs R, N;
    if (F.wg < 2048) gla_out_load(F, F.wg, tid, w, fr, fq, R);
#pragma unroll 1
    for (int u = F.wg; u < 2048; u += F.G) { const int un = (u + F.G < 2048) ? u + F.G : u;
        gla_out_load(F, un, tid, w, fr, fq, N);
        gla_out_compute(F, l, u, tid, lane, w, fr, fq, R, dry);
        R = N; }
#endif
}

template <int CTRL> __device__ __forceinline__ float dpp_add(float v) { return v + dppf<CTRL>(v); }
__device__ __forceinline__ float row16_sum(float v) { v = dpp_add<0xB1>(v); v = dpp_add<0x4E>(v); v = dpp_add<0x141>(v); v = dpp_add<0x140>(v); return v; }
__device__ __forceinline__ void phase_ln_router(Frame& F, int l) {
    const GAS bf16* WRB = (const GAS bf16*)(F.ws + WS_WR) + (size_t)l * 48 * DM;
    LAS unsigned char* WB = F.lds;
    for (int i = F.tid; i < 48 * 128; i += 512) { const int n = i >> 7, c = i & 127; *(LAS u32x4*)(WB + n * 2048 + ((c ^ (n & 7)) * 16)) = *(const GAS u32x4*)(WRB + n * DM + 8 * c); }
    if (F.tid < 32) F.MISC[16 + F.tid] = 0u;
    __syncthreads();
    GAS bf16* HB = (GAS bf16*)(F.ws + WS_HB); const GAS bf16* T = (const GAS bf16*)F.H; GAS int* EID = (GAS int*)(F.ws + WS_ROUTE); GAS float* EW = (GAS float*)(F.ws + WS_ROUTE + 256 * 1024);
    const GAS float* g = ((const GAS float*)F.in[17]) + l * DM; const GAS float* bb = ((const GAS float*)F.in[18]) + l * DM; const GAS float* brg = ((const GAS float*)F.in[20]) + l * 4; const GAS float* bre = ((const GAS float*)F.in[22]) + l * 32;
    const int lane = fresh_lane();
    const int sub = lane & 15, rr = lane >> 4, fr = sub, fq = rr;
    LAS float* LG = (LAS float*)(F.lds + 98304) + F.wave * 768;
    for (int r0 = F.wg * 128; r0 < NTOK; r0 += F.G * 128) {
        const int m0 = r0 + F.wave * 16;
        u32x4 nx[8];
#pragma unroll
        for (int q = 0; q < 8; ++q) nx[q] = *(const GAS u32x4*)(T + (size_t)(m0 + rr) * DM + 8 * (sub + 16 * q));
#pragma unroll 1
        for (int j = 0; j < 4; ++j) { const int m = m0 + 4 * j + rr;
            float v[64]; float s = 0.f;
#pragma unroll
            for (int q = 0; q < 8; ++q) { const u32x4 x = nx[q]; v[8 * q] = bflo(x.x); v[8 * q + 1] = bfhi(x.x); v[8 * q + 2] = bflo(x.y); v[8 * q + 3] = bfhi(x.y); v[8 * q + 4] = bflo(x.z); v[8 * q + 5] = bfhi(x.z); v[8 * q + 6] = bflo(x.w); v[8 * q + 7] = bfhi(x.w); }
            { const int mn = (j < 3) ? m + 4 : m;
#pragma unroll
              for (int q = 0; q < 8; ++q) nx[q] = *(const GAS u32x4*)(T + (size_t)mn * DM + 8 * (sub + 16 * q)); }
#pragma unroll
            for (int i = 0; i < 64; ++i) s += v[i];
            const float mean = row16_sum(s) * (1.f / DM); float s2 = 0.f;
#pragma unroll
            for (int i = 0; i < 64; ++i) { v[i] -= mean; s2 += v[i] * v[i]; }
            const float rstd = 1.f / sqrtf(row16_sum(s2) * (1.f / DM) + LN_EPS);
#pragma unroll
            for (int q = 0; q < 8; ++q) { const int c = 8 * (sub + 16 * q); const f32x4 g0 = *(const GAS f32x4*)(g + c), g1 = *(const GAS f32x4*)(g + c + 4), b0 = *(const GAS f32x4*)(bb + c), b1 = *(const GAS f32x4*)(bb + c + 4);
#pragma unroll
                for (int i = 0; i < 4; ++i) { v[8 * q + i] = v[8 * q + i] * rstd * g0[i] + b0[i]; v[8 * q + 4 + i] = v[8 * q + 4 + i] * rstd * g1[i] + b1[i]; }
                u32x4 wv; wv.x = pk2(v[8 * q], v[8 * q + 1]); wv.y = pk2(v[8 * q + 2], v[8 * q + 3]); wv.z = pk2(v[8 * q + 4], v[8 * q + 5]); wv.w = pk2(v[8 * q + 6], v[8 * q + 7]);
                *(GAS u32x4*)(HB + (size_t)m * DM + c) = wv; } }
        asm volatile("s_waitcnt vmcnt(0)" ::: "memory");
        f32x4 acc[3];
#pragma unroll
        for (int nt = 0; nt < 3; ++nt) acc[nt] = (f32x4){0.f, 0.f, 0.f, 0.f};
#pragma unroll 1
        for (int kb = 0; kb < 4; ++kb) {
            bf16x8 af[8];
#pragma unroll
            for (int ks = 0; ks < 8; ++ks) af[ks] = *(const GAS bf16x8*)(HB + (size_t)(m0 + fr) * DM + 8 * fq + 32 * (8 * kb + ks));
#pragma unroll
            for (int ks = 0; ks < 8; ++ks) { const int c = fq + 4 * (8 * kb + ks);
#pragma unroll
                for (int nt = 0; nt < 3; ++nt) { const int n = 16 * nt + fr; const bf16x8 bw = *(const LAS bf16x8*)(WB + n * 2048 + ((c ^ (n & 7)) * 16));
                    acc[nt] = __builtin_amdgcn_mfma_f32_16x16x32_bf16(af[ks], bw, acc[nt], 0, 0, 0); } } }
#pragma unroll
        for (int nt = 0; nt < 3; ++nt)
#pragma unroll
            for (int r = 0; r < 4; ++r) LG[(4 * fq + r) * 48 + 16 * nt + fr] = acc[nt][r];
        asm volatile("s_waitcnt lgkmcnt(0)" ::: "memory");
        if (lane < 16) { const int m = m0 + lane; const LAS float* lgt = LG + lane * 48;
            int gi = 0; float gm = lgt[0] + brg[0];
#pragma unroll
            for (int q = 1; q < 4; ++q) { const float x = lgt[q] + brg[q]; if (x > gm) { gm = x; gi = q; } }
            float gs = 0.f;
#pragma unroll
            for (int q = 0; q < 4; ++q) gs += __expf(lgt[q] + brg[q] - gm);
            const float gp = 1.f / gs;
            float el[8];
#pragma unroll
            for (int q = 0; q < 8; ++q) el[q] = lgt[4 + 8 * gi + q] + bre[8 * gi + q];
            int i0 = 0; float v0 = el[0];
#pragma unroll
            for (int q = 1; q < 8; ++q) if (el[q] > v0) { v0 = el[q]; i0 = q; }
            int i1 = -1; float v1 = -INFINITY;
#pragma unroll
            for (int q = 0; q < 8; ++q) if (q != i0 && el[q] > v1) { v1 = el[q]; i1 = q; }
            const float ex = __expf(v1 - v0), w0 = gp / (1.f + ex), w1 = gp * ex / (1.f + ex);
            const int e0 = gi * 8 + i0, e1 = gi * 8 + i1;
            EID[2 * m] = e0; EID[2 * m + 1] = e1; EW[2 * m] = w0; EW[2 * m + 1] = w1;
            __hip_atomic_fetch_add((LAS unsigned*)(F.lds + MISC_OFF) + 16 + e0, 1u, __ATOMIC_RELAXED, __HIP_MEMORY_SCOPE_WORKGROUP);
            __hip_atomic_fetch_add((LAS unsigned*)(F.lds + MISC_OFF) + 16 + e1, 1u, __ATOMIC_RELAXED, __HIP_MEMORY_SCOPE_WORKGROUP); }
        asm volatile("s_waitcnt lgkmcnt(0)" ::: "memory");
    }
    __syncthreads();
    if (F.tid < 32) ((GAS int*)(F.ws + WS_CNTWG))[F.wg * 32 + F.tid] = (int)F.MISC[16 + F.tid];
}
__device__ __forceinline__ void phase_dispatch(Frame& F) {
    const GAS int* CNT = (const GAS int*)(F.ws + WS_CNTWG); const GAS int* EID = (const GAS int*)(F.ws + WS_ROUTE); const GAS float* EW = (const GAS float*)(F.ws + WS_ROUTE + 256 * 1024);
    GAS int* SROW = (GAS int*)(F.ws + WS_SROW); GAS int* ROWMAP = (GAS int*)(F.ws + WS_ROWMAP); GAS float* CWROW = (GAS float*)(F.ws + WS_CWROW); GAS int* META = (GAS int*)(F.ws + WS_META);
    LAS int* tot = (LAS int*)(F.lds + AUX_OFF);
    { const int e = F.tid & 31, part = F.tid >> 5; int t = 0, mine = 0;
      int cv[16];
#pragma unroll
      for (int j = 0; j < 16; ++j) { const int w = part * 16 + j; cv[j] = (w < F.G) ? ld_i32(CNT + w * 32 + e) : 0; }
#pragma unroll
      for (int j = 0; j < 16; ++j) { const int w = part * 16 + j; t += cv[j]; mine += (w < F.wg) ? cv[j] : 0; }
      tot[160 + F.tid] = t; tot[160 + 512 + F.tid] = mine; }
    __syncthreads();
    if (F.tid < 32) { int t = 0, mine = 0;
#pragma unroll
        for (int p = 0; p < 16; ++p) { t += tot[160 + p * 32 + F.tid]; mine += tot[160 + 512 + p * 32 + F.tid]; }
        tot[F.tid] = t; tot[32 + F.tid] = mine; tot[96 + F.tid] = 0; }
    __syncthreads();
    if (F.tid == 0) { int rb = 0;
#pragma clang loop unroll(disable) vectorize(disable)
        for (int e = 0; e < 32; ++e) { tot[64 + e] = rb; rb += ((tot[e] + 255) >> 8) << 8; }
        tot[128] = rb; }
    __syncthreads();
    if (F.wg == 0) { const int nt = tot[128] >> 8; if (F.tid == 0) META[0] = nt;
        if (F.tid < nt) { int e = 0;
#pragma clang loop unroll(disable) vectorize(disable)
            for (int q = 1; q < 32; ++q) if (tot[64 + q] <= F.tid * 256) e = q;
            META[16 + F.tid] = e; } }
    for (int r0 = F.wg * 128; r0 < NTOK; r0 += F.G * 128) {
        if (F.tid < 256) { const int tok = r0 + (F.tid >> 1), slot = F.tid & 1; const int e = EID[2 * tok + slot];
            const int pos = (int)__hip_atomic_fetch_add((LAS unsigned*)&tot[96 + e], 1u, __ATOMIC_RELAXED, __HIP_MEMORY_SCOPE_WORKGROUP);
            const int sr = tot[64 + e] + tot[32 + e] + pos;
            ROWMAP[sr] = tok; CWROW[sr] = EW[2 * tok + slot]; SROW[2 * tok + slot] = sr; } }
    if (F.wg < 32) { const int e = F.wg; const int lo = tot[64 + e] + tot[e], hi = tot[64 + e] + (((tot[e] + 255) >> 8) << 8);
        for (int r = lo + F.tid; r < hi; r += 512) { ROWMAP[r] = 0; CWROW[r] = 0.f; } }
}
__device__ __forceinline__ void phase_ln2(Frame& F, int l, bool dry = false) {
    GAS bf16* HB = (GAS bf16*)(F.ws + WS_HB); GAS bf16* HBo = dry ? (GAS bf16*)(F.ws + WS_Y) : HB; GAS float* Ho = dry ? (GAS float*)(F.ws + WS_PA + 184 * MiB) : F.H; const GAS int* SROW = (const GAS int*)(F.ws + WS_SROW); const GAS bf16* FF2 = (const GAS bf16*)(F.ws + WS_FF2);
    const GAS float* g = ((const GAS float*)F.in[26]) + l * DM; const GAS float* bb = ((const GAS float*)F.in[27]) + l * DM; int lane = F.lane; asm volatile("" : "+v"(lane));
    const int gw = F.wg * 8 + F.wave, NGW = F.G * 8; const bool last = (l == DEPTH - 1);
    int m = gw;
    u32x4 hn[2], an[2], cn[2];
    if (m < NTOK) { const int s0 = ld_i32(SROW + 2 * m), s1 = ld_i32(SROW + 2 * m + 1);
#pragma unroll
        for (int j = 0; j < 2; ++j) { hn[j] = *(const GAS u32x4*)(HB + (size_t)m * DM + 8 * lane + 512 * j); an[j] = *(const GAS u32x4*)(FF2 + (size_t)s0 * DM + 8 * lane + 512 * j); cn[j] = *(const GAS u32x4*)(FF2 + (size_t)s1 * DM + 8 * lane + 512 * j); } }
#pragma unroll 1
    for (; m < NTOK; m += NGW) {
        float v[16];
#pragma unroll
        for (int j = 0; j < 2; ++j) { const u32x4 h = hn[j], a = an[j], c = cn[j];
            v[8 * j] = bflo(h.x) * DN_ALPHA + (bflo(a.x) + bflo(c.x)); v[8 * j + 1] = bfhi(h.x) * DN_ALPHA + (bfhi(a.x) + bfhi(c.x)); v[8 * j + 2] = bflo(h.y) * DN_ALPHA + (bflo(a.y) + bflo(c.y)); v[8 * j + 3] = bfhi(h.y) * DN_ALPHA + (bfhi(a.y) + bfhi(c.y));
            v[8 * j + 4] = bflo(h.z) * DN_ALPHA + (bflo(a.z) + bflo(c.z)); v[8 * j + 5] = bfhi(h.z) * DN_ALPHA + (bfhi(a.z) + bfhi(c.z)); v[8 * j + 6] = bflo(h.w) * DN_ALPHA + (bflo(a.w) + bflo(c.w)); v[8 * j + 7] = bfhi(h.w) * DN_ALPHA + (bfhi(a.w) + bfhi(c.w)); }
        const int mn = m + NGW;
        if (mn < NTOK) { const int s0 = ld_i32(SROW + 2 * mn), s1 = ld_i32(SROW + 2 * mn + 1);
#pragma unroll
            for (int j = 0; j < 2; ++j) { hn[j] = *(const GAS u32x4*)(HB + (size_t)mn * DM + 8 * lane + 512 * j); an[j] = *(const GAS u32x4*)(FF2 + (size_t)s0 * DM + 8 * lane + 512 * j); cn[j] = *(const GAS u32x4*)(FF2 + (size_t)s1 * DM + 8 * lane + 512 * j); } }
        float s = 0.f;
#pragma unroll
        for (int i = 0; i < 16; ++i) s += v[i];
        const float mean = wave_sum(s, lane) * (1.f / DM); float s2 = 0.f;
#pragma unroll
        for (int i = 0; i < 16; ++i) { v[i] -= mean; s2 += v[i] * v[i]; }
        const float rstd = 1.f / sqrtf(wave_sum(s2, lane) * (1.f / DM) + LN_EPS);
#pragma unroll
        for (int j = 0; j < 2; ++j) { const int c = 8 * lane + 512 * j; const f32x4 g0 = *(const GAS f32x4*)(g + c), g1 = *(const GAS f32x4*)(g + c + 4), b0 = *(const GAS f32x4*)(bb + c), b1 = *(const GAS f32x4*)(bb + c + 4);
#pragma unroll
            for (int i = 0; i < 4; ++i) { v[8 * j + i] = v[8 * j + i] * rstd * g0[i] + b0[i]; v[8 * j + 4 + i] = v[8 * j + 4 + i] * rstd * g1[i] + b1[i]; }
            if (last) { *(GAS f32x4*)(Ho + (size_t)m * DM + c) = (f32x4){v[8 * j], v[8 * j + 1], v[8 * j + 2], v[8 * j + 3]}; *(GAS f32x4*)(Ho + (size_t)m * DM + c + 4) = (f32x4){v[8 * j + 4], v[8 * j + 5], v[8 * j + 6], v[8 * j + 7]}; }
            else { u32x4 wv; wv.x = pk2(v[8 * j], v[8 * j + 1]); wv.y = pk2(v[8 * j + 2], v[8 * j + 3]); wv.z = pk2(v[8 * j + 4], v[8 * j + 5]); wv.w = pk2(v[8 * j + 6], v[8 * j + 7]); *(GAS u32x4*)(HBo + (size_t)m * DM + c) = wv; } }
    }
}

#ifndef EN_P
#define EN_P 1
#endif
#ifndef EN_A
#define EN_A 1
#endif
#ifndef EN_B
#define EN_B 1
#endif
#ifndef EN_C
#define EN_C 1
#endif
#ifndef EN_D
#define EN_D 1
#endif
#ifndef EN_E
#define EN_E 1
#endif
#ifndef EN_F
#define EN_F 1
#endif
#ifndef EN_G
#define EN_G 1
#endif
#ifndef EN_H
#define EN_H 1
#endif
#ifndef EN_I
#define EN_I 1
#endif
#ifndef EN_J
#define EN_J 1
#endif
constexpr int PPL = 12;
constexpr int N_PHASES = 1 + PPL * DEPTH;
#ifndef MK_ONE_LAUNCH
#define MK_ONE_LAUNCH 0
#endif
struct Args { const float* in[28]; float* out; unsigned char* ws; int ph_lo, ph_hi; };
static_assert(sizeof(Args) == 28 * 8 + 8 + 8 + 8, "no padding bytes in the argument struct");


__device__ __forceinline__ unsigned opaque_u32(unsigned x) { unsigned v; asm volatile("v_mov_b32 %0, %1" : "=v"(v) : "s"(x)); return (unsigned)__builtin_amdgcn_readfirstlane((int)v); }
__device__ __forceinline__ unsigned long long opaque_u64(unsigned long long x) { return ((unsigned long long)opaque_u32((unsigned)(x >> 32)) << 32) | opaque_u32((unsigned)x); }
__device__ __forceinline__ void launder(Frame& F) {
    F.ws = (GAS unsigned char*)opaque_u64((unsigned long long)F.ws); F.H = (GAS float*)opaque_u64((unsigned long long)F.H);
    F.ctl = (gu32*)opaque_u64((unsigned long long)F.ctl);
    unsigned z0 = 0u; asm volatile("" : "+v"(z0)); int ln = (int)__builtin_amdgcn_mbcnt_hi(~0u, __builtin_amdgcn_mbcnt_lo(~0u, z0));
    F.wave = (int)opaque_u32((unsigned)F.wave); F.lane = ln; F.tid = F.wave * 64 + ln;
    F.G = (int)opaque_u32((unsigned)F.G); F.wg = (int)opaque_u32((unsigned)F.wg);
}
__global__ void __launch_bounds__(512, 2) mk_fwd(Args args) {
    extern __shared__ __attribute__((aligned(16))) unsigned char lds_raw[];
    Frame F;
    F.lds = (LAS unsigned char*)lds_raw;
    F.MISC = (volatile LAS unsigned*)(F.lds + MISC_OFF);
    F.tid = threadIdx.x; F.lane = F.tid & 63; F.wave = __builtin_amdgcn_readfirstlane(F.tid >> 6);
    F.G = gridDim.x; F.wg = blockIdx.x;
    F.in = args.in;
    F.pos = (const GAS int*)args.in[1];
    F.H = (GAS float*)args.out; F.ws = (GAS unsigned char*)args.ws;
    F.ctl = (gu32*)(args.ws + WS_CTL);
    for (int u = F.tid; u < (LDS_BYTES - MISC_OFF) / 4; u += 512) ((LAS unsigned*)(F.lds + MISC_OFF))[u] = 0u;
    __syncthreads();
    const int lo = args.ph_lo, hi = args.ph_hi;
    const bool multi = (hi - lo) > 1;
    XcdBarrier bar; bar.bar = (unsigned*)(F.ctl + CW_BAR); bar.x = 0; bar.st = nullptr;
    if (multi) bar = xcd_barrier_post((unsigned*)(F.ctl + CW_BAR), F.MISC + 8);
#define IN(k) (lo <= (k) && (k) < hi)
#ifdef DUP_BARRIER
#define SEAM(k) do { if (IN(k) && IN((k) + 1)) { xcd_barrier(bar); xcd_barrier(bar); } } while (0)
#else
#define SEAM(k) do { if (IN(k) && IN((k) + 1)) xcd_barrier(bar); } while (0)
#endif

#ifdef DUP_P
    for (int rep = 0; rep < 2; ++rep)
#endif
    if (EN_P && IN(0)) { launder(F); phase_prologue(F); }
    SEAM(0);
#define HB ((GAS bf16*)(F.ws + WS_HB))
#define PA ((GAS bf16*)(F.ws + WS_PA))
#define Y ((GAS bf16*)(F.ws + WS_Y))
#define HM ((GAS bf16*)F.H + (size_t)NTOK * DM)
#define TT ((GAS bf16*)F.H)
    for (int l = 0; l < DEPTH; ++l) {
        const int pb = 1 + PPL * l;
#define wd (F.ws + WS_WDENSE + (size_t)l * WD_LAYER)
#ifdef DUP_A
        for (int rep = 0; rep < 2; ++rep)
#endif
        if (EN_A && IN(pb + 0)) { launder(F);
            DenseSched S; S.init(NTOK / 256, NPA / 256, F.G, F.wg, (const void*)HB, (size_t)256 * DM * 2, (const void*)(wd + WD_WA), (size_t)256 * DM * 2);
            EpiA E{PA, (GAS bf16*)(F.ws + WS_KA), (GAS bf16*)(F.ws + WS_VA), (GAS bf16*)(F.ws + WS_KI), (GAS float*)(F.ws + WS_WI), (GAS float*)(F.ws + WS_GLR), (const GAS float*)(F.ws + WS_ROPE), ((const GAS float*)F.in[5]) + l * 64};
#ifdef DUP_APLAIN
            { EpiPlainA E0{PA}; pg8::gemm_phase<EpiPlainA, DenseSched, false>(F.lds, S, E0, DM, DM, F.wave); }
#endif
#ifdef STAGGER_US
            if (F.wg & 1) { const unsigned long long t0 = __builtin_amdgcn_s_memrealtime(); while (__builtin_amdgcn_s_memrealtime() - t0 < (unsigned long long)(STAGGER_US * 100)) __builtin_amdgcn_s_sleep(8); }
#endif
            pg8::gemm_phase<EpiA, DenseSched, false>(F.lds, S, E, DM, DM, F.wave);
        }
        SEAM(pb + 0);
        if (EN_B && IN(pb + 1)) { launder(F);
#ifdef DUP_B
            phase_mixer(F, l, 1, DUP_B, true); launder(F);
#endif
            phase_mixer(F, l); }
        SEAM(pb + 1);
        if (EN_B && IN(pb + 2)) { launder(F);
#ifdef DUP_SCAN
            gla_scan_phase(F, true); launder(F);
#endif
            gla_scan_phase(F); }
        SEAM(pb + 2);
        if (EN_B && IN(pb + 3)) { launder(F);
#ifdef DUP_OUT
            phase_gla_out(F, l, true); launder(F);
#endif
            phase_gla_out(F, l); }
        SEAM(pb + 3);
#ifdef DUP_D
        for (int rep = 0; rep < 2; ++rep)
#endif
        if (EN_D && IN(pb + 4)) { launder(F);
            DenseSched S; S.init(NTOK / 256, DM / 256, F.G, F.wg, (const void*)Y, (size_t)256 * 1536 * 2, (const void*)(wd + WD_WBR), (size_t)256 * 512 * 2);
            S.nsub = 3; S.asub = 512 * 2; S.bsub = (size_t)1024 * 512 * 2;
            EpiP E{PA};
            pg8::gemm_phase<EpiP, DenseSched, false>(F.lds, S, E, 512, 1536, F.wave);
        }
#ifdef DUP_C
        for (int rep = 0; rep < 2; ++rep)
#endif
        if (EN_C && IN(pb + 4)) { launder(F);
            DenseSched S; S.init(NTOK / 256, DM / 256, F.G, F.wg, (const void*)HB, (size_t)256 * DM * 2, (const void*)(wd + WD_WG), (size_t)256 * DM * 2);
            S.nsub = 3; S.asub = 0; S.bsub = (size_t)1024 * DM * 2;
            EpiGM E{PA, HM};
            pg8::gemm_phase<EpiGM, DenseSched, false>(F.lds, S, E, DM, DM, F.wave);
        }
        SEAM(pb + 4);
#ifdef DUP_E
        for (int rep = 0; rep < 2; ++rep)
#endif
        if (EN_E && IN(pb + 6)) { launder(F);
            DenseSched S; S.init(NTOK / 256, DM / 256, F.G, F.wg, (const void*)HM, (size_t)256 * DM * 2, (const void*)(wd + WD_WOUT), (size_t)256 * DM * 2);
            EpiO E{HB, TT};
            pg8::gemm_phase<EpiO, DenseSched, false>(F.lds, S, E, DM, DM, F.wave);
        }
        SEAM(pb + 6);
#ifdef DUP_F
        for (int rep = 0; rep < 2; ++rep)
#endif
        if (EN_F && IN(pb + 7)) { launder(F); phase_ln_router(F, l); }
        SEAM(pb + 7);
#ifdef DUP_G
        for (int rep = 0; rep < 2; ++rep)
#endif
        if (EN_G && IN(pb + 8)) { launder(F);
            { LAS float* scr = (LAS float*)(F.lds + F.wave * 16384);
              conv_run<true>(F, l, 12288, scr);
              __syncthreads(); }
            phase_dispatch(F); }
        SEAM(pb + 8);
#ifdef DUP_H
        for (int rep = 0; rep < 2; ++rep)
#endif
        if (EN_H && IN(pb + 9)) { launder(F);
            const GAS int* META = (const GAS int*)(F.ws + WS_META); const GAS int* ROWMAP = (const GAS int*)(F.ws + WS_ROWMAP);
            const int NT = ld_i32(META), NU = NT * 2;
            LAS int* meta = (LAS int*)(F.lds + AUX_OFF); LAS int* rows = (LAS int*)(F.lds + AUX_OFF + 64);
            for (int i = 0; i * F.G + F.wg < NU && i < 8; ++i) { const int L = i * F.G + F.wg, gt = L >> 1;
                if (F.tid == 0) meta[i] = ld_i32(META + 16 + gt);
                if (F.tid < 256) rows[i * 256 + F.tid] = ROWMAP[gt * 256 + F.tid]; }
            __syncthreads();
            GroupSched S{NU, F.G, F.wg, 2, (const char*)HB, (const char*)(F.ws + WS_WMOE + WM_GU), 0, (size_t)512 * DM * 2, (size_t)256 * DM * 2, meta, rows};
            EpiGU E{(GAS bf16*)(F.ws + WS_HID), (const GAS float*)(F.ws + WS_CWROW)};
            pg8::gemm_phase<EpiGU, GroupSched, true>(F.lds, S, E, DM, DM, F.wave);
        }
        SEAM(pb + 9);
#ifdef DUP_I
        for (int rep = 0; rep < 2; ++rep)
#endif
        if (EN_I && IN(pb + 10)) { launder(F);
            const GAS int* META = (const GAS int*)(F.ws + WS_META);
            const int NT = ld_i32(META), NU = NT * 4;
            LAS int* meta = (LAS int*)(F.lds + AUX_OFF);
            for (int i = 0; i * F.G + F.wg < NU && i < 8; ++i) { const int L = i * F.G + F.wg, gt = L >> 2; if (F.tid == 0) meta[i] = ld_i32(META + 16 + gt); }
            __syncthreads();
            GroupSched S{NU, F.G, F.wg, 4, (const char*)(F.ws + WS_HID), (const char*)(F.ws + WS_WMOE + WM_DN), (size_t)256 * DEXP * 2, (size_t)DM * DEXP * 2, (size_t)256 * DEXP * 2, meta, nullptr};
            EpiDN E{(GAS bf16*)(F.ws + WS_FF2)};
            pg8::gemm_phase<EpiDN, GroupSched, false>(F.lds, S, E, DEXP, DEXP, F.wave);
        }
        SEAM(pb + 10);
        if (EN_J && IN(pb + 11)) { launder(F);
#ifdef DUP_J
            phase_ln2(F, l, true); launder(F);
#endif
            phase_ln2(F, l); }
        SEAM(pb + 11);
    }
#undef IN
#undef SEAM
#undef HB
#undef HM
#undef TT
#undef PA
#undef Y
#undef wd
}


#ifdef DUMP_OFF
__global__ void dump_k(const unsigned short* src, float* out) {
    for (size_t i = (size_t)blockIdx.x * blockDim.x + threadIdx.x; i < (size_t)NTOK * 1024; i += (size_t)gridDim.x * blockDim.x) { const size_t n = i >> 10, c = i & 1023; out[i] = __builtin_bit_cast(float, ((unsigned)src[n * DUMP_PITCH + c]) << 16); }
}
#endif
extern "C" void kernel_launch(void* const* d_in, const int* in_sizes, int n_in, void* d_out, int out_size, void* d_ws, size_t ws_size, hipStream_t stream) {
    static int grid = 0;
    if (grid == 0) {
        if (n_in != 28 || out_size != NTOK * DM || ws_size < WS_END) { fprintf(stderr, "kernel_launch: unexpected shapes (n_in %d out %d ws %zu); nothing launched\n", n_in, out_size, ws_size); grid = -1; return; }
        int dev = 0, cus = 0;
        if (hipGetDevice(&dev) != hipSuccess || hipDeviceGetAttribute(&cus, hipDeviceAttributeMultiprocessorCount, dev) != hipSuccess) { grid = -1; return; }
        if (hipFuncSetAttribute((const void*)mk_fwd, hipFuncAttributeMaxDynamicSharedMemorySize, LDS_BYTES) != hipSuccess) { fprintf(stderr, "kernel_launch: hipFuncSetAttribute failed\n"); grid = -1; return; }
        int per_cu = 0;
        if (hipOccupancyMaxActiveBlocksPerMultiprocessor(&per_cu, (const void*)mk_fwd, 512, LDS_BYTES) != hipSuccess || per_cu < 1) { fprintf(stderr, "kernel_launch: occupancy query says %d\n", per_cu); }
        (void)hipGetLastError();
        grid = cus;
        if (grid != 256) fprintf(stderr, "kernel_launch: %d CUs (built for 256)\n", grid);
    }
    if (grid < 0) return;
    if (hipMemsetAsync((char*)d_ws + WS_CTL, 0, CTL_ZERO_BYTES, stream) != hipSuccess) return;
    Args a{};
    for (int i = 0; i < 28; ++i) a.in[i] = (const float*)d_in[i];
    a.out = (float*)d_out; a.ws = (unsigned char*)d_ws;
#if MK_ONE_LAUNCH
    a.ph_lo = 0; a.ph_hi = N_PHASES;
    hipLaunchKernelGGL(mk_fwd, dim3(grid), dim3(512), LDS_BYTES, stream, a);
#else
#ifndef STOP_AFTER
#define STOP_AFTER (N_PHASES - 1)
#endif
#ifndef PHASE_MASK
#define PHASE_MASK 0xffffffffu
#endif
    for (int p = 0; p <= STOP_AFTER; ++p) { if (!((PHASE_MASK >> p) & 1u)) continue; a.ph_lo = p; a.ph_hi = p + 1; hipLaunchKernelGGL(mk_fwd, dim3(grid), dim3(512), LDS_BYTES, stream, a); }
#ifdef DUMP_OFF
    hipLaunchKernelGGL(dump_k, dim3(2048), dim3(256), 0, stream, (const unsigned short*)((const char*)d_ws + (size_t)(DUMP_OFF)), (float*)d_out);
#endif
#endif
}
```

```cpp
#define MK_ONE_LAUNCH 1
#include <hip/hip_runtime.h>
#include <cstdio>
#include <cstdint>

#define LAS __attribute__((address_space(3)))
#define GAS __attribute__((address_space(1)))
typedef unsigned short bf16;
typedef short bf16x8 __attribute__((ext_vector_type(8)));
typedef float f32x4 __attribute__((ext_vector_type(4)));
typedef float f32x2 __attribute__((ext_vector_type(2)));
typedef unsigned u32x4 __attribute__((ext_vector_type(4)));
typedef unsigned u32x2 __attribute__((ext_vector_type(2)));
typedef GAS unsigned gu32;

constexpr int NB = 8, SEQ = 4096, NTOK = NB * SEQ, DM = 1024, NIN = 6612, DEPTH = 2;
constexpr int NPA = 3584;
constexpr int NGT = 3072;
constexpr int NEXP = 32, DEXP = 256;
constexpr int MAXTILES = 288;
constexpr float DN_ALPHA = 1.41421356237309515f;
constexpr float LN_EPS = 1e-5f, RMS_EPS = 1e-6f;
constexpr int PA_Q = 0, PA_QI = 768, PA_BQ = 1024, PA_BK = 1280, PA_BV = 1536, PA_BR = 2048, PA_CU = 2560, PA_CV = 3072;

__device__ __forceinline__ unsigned f2bf(float f) { unsigned u = __builtin_bit_cast(unsigned, f); return (u + 0x7fffu + ((u >> 16) & 1u)) >> 16; }
__device__ __forceinline__ unsigned pk2(float lo, float hi) { return f2bf(lo) | (f2bf(hi) << 16); }
__device__ __forceinline__ float bflo(unsigned w) { return __builtin_bit_cast(float, w << 16); }
__device__ __forceinline__ float bfhi(unsigned w) { return __builtin_bit_cast(float, w & 0xffff0000u); }
__device__ __forceinline__ float bf1(bf16 h) { return __builtin_bit_cast(float, ((unsigned)h) << 16); }
typedef __bf16 bf16x2_t __attribute__((ext_vector_type(2)));
__device__ __forceinline__ unsigned cvt_pk_bf16(float lo, float hi) { const f32x2 v = {lo, hi}; const bf16x2_t b = __builtin_convertvector(v, bf16x2_t); return __builtin_bit_cast(unsigned, b); }
__device__ __forceinline__ float shx(float v, int mask, int lane) { return __builtin_bit_cast(float, __builtin_amdgcn_ds_bpermute((lane ^ mask) << 2, __builtin_bit_cast(int, v))); }
__device__ __forceinline__ int shxi(int v, int mask, int lane) { return __builtin_amdgcn_ds_bpermute((lane ^ mask) << 2, v); }
__device__ __forceinline__ float wave_sum(float v, int lane) {
#pragma unroll
    for (int o = 1; o < 64; o <<= 1) v += shx(v, o, lane);
    return v;
}
__device__ __forceinline__ float wave_max(float v, int lane) {
#pragma unroll
    for (int o = 1; o < 64; o <<= 1) v = fmaxf(v, shx(v, o, lane));
    return v;
}
__device__ __forceinline__ int wave_sum_i(int v, int lane) {
#pragma unroll
    for (int o = 1; o < 64; o <<= 1) v += shxi(v, o, lane);
    return v;
}
__device__ __forceinline__ int fresh_lane() { unsigned z0 = 0u; asm volatile("" : "+v"(z0)); return (int)__builtin_amdgcn_mbcnt_hi(~0u, __builtin_amdgcn_mbcnt_lo(~0u, z0)); }
__device__ __forceinline__ int ld_i32(const GAS int* p) { return __hip_atomic_load(p, __ATOMIC_RELAXED, __HIP_MEMORY_SCOPE_AGENT); }
__device__ __forceinline__ float ld_f32(const GAS float* p) { return __hip_atomic_load(p, __ATOMIC_RELAXED, __HIP_MEMORY_SCOPE_AGENT); }
__device__ __forceinline__ float sigmoidf_(float x) { return __builtin_amdgcn_rcpf(1.0f + __expf(-x)); }
__device__ __forceinline__ float siluf_(float x) { return x * sigmoidf_(x); }
__device__ __forceinline__ float gelu_tanh_(float x) { const float u = 0.7978845608028654f * (x + 0.044715f * x * x * x); return x * sigmoidf_(2.0f * u); }

namespace pg8 {
constexpr int BM = 256, BK = 64, HALF = 128, HTB = HALF * BK * 2, STAGE_BYTES = 8 * HTB;
__host__ __device__ __forceinline__ int lds_byte(int r, int c) { const int st = (r >> 4) * 2 + (c >> 5), rr = r & 15, cc = c & 31, ob = rr * 64 + cc * 2; return st * 1024 + (ob ^ (((ob >> 9) & 1) << 5)); }
__host__ __device__ __forceinline__ void stage_rc(int b, int& R, int& C) { const int st = b / 1024, sb = b % 1024, swz = sb ^ (((sb >> 9) & 1) << 5); R = (st >> 1) * 16 + swz / 64; C = (st & 1) * 32 + (swz % 64) / 2; }
__host__ __device__ __forceinline__ int perm32(int rho) { const int n = rho >> 4, i = rho & 15; return 8 * (i >> 2) + 4 * n + (i & 3); }

struct Unit { int pm, pn, e, slot; };

#ifndef PG8_ALIGN
#define PG8_ALIGN true
#endif
template <class Epi, class Sched, bool GATHER, bool ALIGN_EPI = PG8_ALIGN>
__device__ __forceinline__ void gemm_phase(LAS unsigned char* lds, const Sched& S, const Epi& E, const int K, const int lda, const int wave) {
    unsigned z0_ = 0u; asm volatile("" : "+v"(z0_)); const int lane_ = (int)__builtin_amdgcn_mbcnt_hi(~0u, __builtin_amdgcn_mbcnt_lo(~0u, z0_));
    const int wid = wave, lane = lane_, tid = wid * 64 + lane, wr = wid >> 2, wc = wid & 3, fr = lane & 15, fq = lane >> 4;
    const int nt = K / BK;
    int Rr[2], Cc[2];
    unsigned voffB[2];
#pragma unroll
    for (int i = 0; i < 2; ++i) { int R, C; stage_rc(tid * 16 + i * 8192, R, C); Rr[i] = R; Cc[i] = C; const int Rb = Epi::PERM ? ((R & ~31) + perm32(R & 31)) : R; voffB[i] = (unsigned)(Rb * K + C) * 2u; }
    const size_t kstep = (size_t)(BK * 2);
    const size_t hstepB = (size_t)HALF * K * 2;
    const unsigned ldsw = (unsigned)wid * 1024u;
    const int aoff = lds_byte(wr * 64 + fr, fq * 8), boff = lds_byte(wc * 32 + fr, fq * 8);
#define PG8_SA(b, h) (((b) * 2 + (h)) * HTB)
#define PG8_SB(b, h) ((4 + (b) * 2 + (h)) * HTB)
#define PG8_STAGE(bufoff, gbase, voff) do { _Pragma("unroll") for (int _i = 0; _i < 2; ++_i) \
        __builtin_amdgcn_global_load_lds((const unsigned*)((const char*)(gbase) + (voff)[_i]), (LAS unsigned*)(lds + (bufoff) + ldsw + _i * 8192), 16, 0, 0); } while (0)
#define PG8_LDA(dst, b, h) do { _Pragma("unroll") for (int m = 0; m < 4; ++m) _Pragma("unroll") for (int k = 0; k < 2; ++k) dst[m][k] = *(const LAS bf16x8*)(lds + PG8_SA(b, h) + aoff + m * 2048 + k * 1024); } while (0)
#define PG8_LDB(dst, b, h) do { _Pragma("unroll") for (int n = 0; n < 2; ++n) _Pragma("unroll") for (int k = 0; k < 2; ++k) dst[n][k] = *(const LAS bf16x8*)(lds + PG8_SB(b, h) + boff + n * 2048 + k * 1024); } while (0)
#define PG8_MMA(ai, bj, At, Bt) do { __builtin_amdgcn_s_setprio(1); _Pragma("unroll") for (int m = 0; m < 4; ++m) _Pragma("unroll") for (int n = 0; n < 2; ++n) _Pragma("unroll") for (int k = 0; k < 2; ++k) \
        acc[ai][bj][m][n] = __builtin_amdgcn_mfma_f32_16x16x32_bf16(Bt[n][k], At[m][k], acc[ai][bj][m][n], 0, 0, 0); __builtin_amdgcn_s_setprio(0); } while (0)
#define PG8_WAIT_V(n) asm volatile("s_waitcnt vmcnt(" #n ")" ::: "memory")
#define PG8_WAIT_L(n) asm volatile("s_waitcnt lgkmcnt(" #n ")" ::: "memory")
#define PG8_BAR do { asm volatile("" ::: "memory"); __builtin_amdgcn_s_barrier(); asm volatile("" ::: "memory"); } while (0)
#define PG8_SCHED __builtin_amdgcn_sched_barrier(0)
    Unit cur, nxt; int ui = 0;
    if (!S.next(0, cur)) return;
    f32x4 acc[2][2][4][2];
#pragma unroll
    for (int a = 0; a < 2; ++a)
#pragma unroll
        for (int b = 0; b < 2; ++b)
#pragma unroll
            for (int m = 0; m < 4; ++m)
#pragma unroll
                for (int n = 0; n < 2; ++n) acc[a][b][m][n] = (f32x4){0.f, 0.f, 0.f, 0.f};
    bf16x8 At[4][2], B0[2][2], B1[2][2];
    unsigned cA0[2], cA1[2], nA0[2], nA1[2];
#pragma unroll
    for (int i = 0; i < 2; ++i) {
        if (GATHER) { cA0[i] = (unsigned)(S.row_of(cur, Rr[i]) * lda + Cc[i]) * 2u; cA1[i] = (unsigned)(S.row_of(cur, HALF + Rr[i]) * lda + Cc[i]) * 2u; }
        else { cA0[i] = (unsigned)(Rr[i] * lda + Cc[i]) * 2u; cA1[i] = (unsigned)((HALF + Rr[i]) * lda + Cc[i]) * 2u; }
        nA0[i] = cA0[i]; nA1[i] = cA1[i];
    }
    const char* cA = S.a_base(cur); const char* cB = S.b_base(cur);
    PG8_STAGE(PG8_SB(0, 0), cB, voffB); PG8_STAGE(PG8_SB(0, 1), cB + hstepB, voffB); PG8_STAGE(PG8_SA(0, 0), cA, cA0); PG8_STAGE(PG8_SA(0, 1), cA, cA1);
    if (wr == 1) PG8_BAR;
    PG8_WAIT_V(2); PG8_BAR;
    PG8_STAGE(PG8_SB(1, 0), cB + kstep, voffB); PG8_STAGE(PG8_SA(1, 0), cA + kstep, cA0); PG8_STAGE(PG8_SB(1, 1), cB + hstepB + kstep, voffB);
    PG8_WAIT_V(6); PG8_BAR;
    for (;;) {
        const bool has_next = S.next(ui + 1, nxt);
        const char* nA = has_next ? S.a_base(nxt) : cA; const char* nB = has_next ? S.b_base(nxt) : cB;
        if (GATHER) {
#pragma unroll
            for (int i = 0; i < 2; ++i) {
                if (has_next) { nA0[i] = (unsigned)(S.row_of(nxt, Rr[i]) * lda + Cc[i]) * 2u; nA1[i] = (unsigned)(S.row_of(nxt, HALF + Rr[i]) * lda + Cc[i]) * 2u; }
                else { nA0[i] = cA0[i]; nA1[i] = cA1[i]; }
            }
        }
#pragma unroll 1
        for (int t = 0; t < nt; t += 2) {
            const bool last = (t == nt - 2);
            const char* a1 = cA + (size_t)(t + 1) * kstep;
            const char* a2 = last ? nA : cA + (size_t)(t + 2) * kstep; const char* b2 = last ? nB : cB + (size_t)(t + 2) * kstep;
            const char* a3 = a2 + kstep; const char* b3 = b2 + kstep;
            unsigned x0[2], x1[2];
#pragma unroll
            for (int i = 0; i < 2; ++i) { x0[i] = (GATHER && last) ? nA0[i] : cA0[i]; x1[i] = (GATHER && last) ? nA1[i] : cA1[i]; }
            PG8_LDB(B0, 0, 0); PG8_LDB(B1, 0, 1); PG8_SCHED; PG8_LDA(At, 0, 0); PG8_STAGE(PG8_SA(1, 1), a1, cA1);
            PG8_WAIT_V(8); PG8_WAIT_L(0); PG8_BAR; PG8_MMA(0, 0, At, B0); PG8_MMA(0, 1, At, B1); PG8_BAR; PG8_SCHED;
            PG8_LDA(At, 0, 1); PG8_STAGE(PG8_SB(0, 0), b2, voffB); PG8_STAGE(PG8_SB(0, 1), b2 + hstepB, voffB); PG8_STAGE(PG8_SA(0, 0), a2, x0);
            PG8_WAIT_V(8); PG8_WAIT_L(0); PG8_BAR; PG8_MMA(1, 0, At, B0); PG8_MMA(1, 1, At, B1); PG8_BAR; PG8_SCHED;
            PG8_LDB(B0, 1, 0); PG8_LDB(B1, 1, 1); PG8_SCHED; PG8_LDA(At, 1, 0); PG8_STAGE(PG8_SA(0, 1), a2, x1);
            PG8_WAIT_V(8); PG8_WAIT_L(0); PG8_BAR; PG8_MMA(0, 0, At, B0); PG8_MMA(0, 1, At, B1); PG8_BAR; PG8_SCHED;
            PG8_LDA(At, 1, 1); PG8_STAGE(PG8_SB(1, 0), b3, voffB); PG8_STAGE(PG8_SB(1, 1), b3 + hstepB, voffB); PG8_STAGE(PG8_SA(1, 0), a3, x0);
            PG8_WAIT_V(8); PG8_WAIT_L(0); PG8_BAR; PG8_MMA(1, 0, At, B0); PG8_MMA(1, 1, At, B1); PG8_BAR; PG8_SCHED;
        }
        if (ALIGN_EPI) { if (wr == 0) PG8_BAR; }
        E(acc, cur, wr, wc, fr, fq);
        if (!has_next) break;
#pragma unroll
        for (int a = 0; a < 2; ++a)
#pragma unroll
            for (int b = 0; b < 2; ++b)
#pragma unroll
                for (int m = 0; m < 4; ++m)
#pragma unroll
                    for (int n = 0; n < 2; ++n) acc[a][b][m][n] = (f32x4){0.f, 0.f, 0.f, 0.f};
        cur = nxt; cA = nA; cB = nB; ++ui;
#pragma unroll
        for (int i = 0; i < 2; ++i) { cA0[i] = nA0[i]; cA1[i] = nA1[i]; }
        if (ALIGN_EPI) { if (wr == 1) PG8_BAR; }
    }
    PG8_WAIT_V(0);
    if (!ALIGN_EPI) { if (wr == 0) PG8_BAR; }
    PG8_BAR;
#undef PG8_SA
#undef PG8_SB
#undef PG8_STAGE
#undef PG8_LDA
#undef PG8_LDB
#undef PG8_MMA
#undef PG8_WAIT_V
#undef PG8_WAIT_L
#undef PG8_BAR
#undef PG8_SCHED
}
}

#define XB_TMO      128
#define XB_XCNT(j)  (256  + 64 * (j))
#define XB_XSUB(j)  (1280 + 64 * (j))
#define XB_XGEN(j)  (2304 + 64 * (j))
#define XB_TOP      3328
#define XB_TOPGEN   3392
#define XCD_BAR_WORDS 3456
#define XB_SPIN_CAP (1u << 20)

__device__ __forceinline__ unsigned xb_ld(unsigned* p)              { return __hip_atomic_load(p, __ATOMIC_RELAXED, __HIP_MEMORY_SCOPE_AGENT); }
__device__ __forceinline__ unsigned xb_add(unsigned* p, unsigned v) { return __hip_atomic_fetch_add(p, v, __ATOMIC_RELAXED, __HIP_MEMORY_SCOPE_AGENT); }
__device__ __forceinline__ unsigned xb_xcc_id() { return (unsigned)__builtin_amdgcn_s_getreg((3 << 11) | 20) & 0xFu; }
#define XB_SPIN(cond, bar) do { unsigned _sp = 0; while (cond) { __builtin_amdgcn_s_sleep(1); \
    if ((++_sp & 255u) == 0u) { if (xb_ld(&(bar)[XB_TMO])) break; if (_sp > XB_SPIN_CAP) { atomicAdd(&(bar)[XB_TMO], 1u); break; } } } } while (0)

struct XcdBarrier { unsigned* bar; unsigned x; volatile LAS unsigned* st; };

__device__ __forceinline__ XcdBarrier xcd_barrier_post(unsigned* bar, volatile LAS unsigned* st) {
    XcdBarrier b; b.bar = bar; b.x = xb_xcc_id(); b.st = st;
    if (threadIdx.x == 0) (void)xb_add(&bar[XB_XCNT(b.x)], 1u);
    return b;
}
__device__ __forceinline__ void xcd_barrier_complete(unsigned* bar, unsigned x, unsigned& nloc, unsigned& nx) {
    const unsigned G = gridDim.x * gridDim.y * gridDim.z;
    unsigned sum, cnt, mine, sp = 0u;
    for (;;) {
        sum = 0u; cnt = 0u; mine = 0u;
#pragma unroll
        for (unsigned j = 0; j < 16; ++j) { const unsigned c = xb_ld(&bar[XB_XCNT(j)]); sum += c; cnt += (c > 0u) ? 1u : 0u; mine = (j == x) ? c : mine; }
        if (sum == G) break;
        __builtin_amdgcn_s_sleep(1);
        if ((++sp & 255u) == 0u) { if (xb_ld(&bar[XB_TMO])) break; if (sp > XB_SPIN_CAP) { atomicAdd(&bar[XB_TMO], 1u); break; } }
    }
    nloc = mine > 0u ? mine : 1u; nx = cnt > 0u ? cnt : 1u;
}
__device__ __forceinline__ void xcd_barrier(const XcdBarrier& b) {
    asm volatile("s_waitcnt vmcnt(0)" ::: "memory");
    __syncthreads();
    if (threadIdx.x == 0) {
        unsigned* bar = b.bar;
        __builtin_amdgcn_s_waitcnt(0);
        unsigned nloc = b.st[0], nx = b.st[1];
        if (nloc == 0u) { xcd_barrier_complete(bar, b.x, nloc, nx); b.st[0] = nloc; b.st[1] = nx; }
        const unsigned old = xb_add(&bar[XB_XSUB(b.x)], 1u);
        const unsigned gen = old / nloc;
        if (old + 1u == (gen + 1u) * nloc) {
            __builtin_amdgcn_fence(__ATOMIC_RELEASE, "agent");
            asm volatile("s_waitcnt vmcnt(0)" ::: "memory");
            const unsigned og = xb_add(&bar[XB_TOP], 1u);
            const unsigned tg = og / nx;
            if (og + 1u == (tg + 1u) * nx) xb_add(&bar[XB_TOPGEN], 1u);
            else XB_SPIN(xb_ld(&bar[XB_TOPGEN]) == tg, bar);
            __builtin_amdgcn_fence(__ATOMIC_ACQUIRE, "agent");
            xb_add(&bar[XB_XGEN(b.x)], 1u);
            asm volatile("s_waitcnt vmcnt(0)" ::: "memory");
        } else {
            XB_SPIN(xb_ld(&bar[XB_XGEN(b.x)]) == gen, bar);
            __builtin_amdgcn_fence(__ATOMIC_ACQUIRE, "agent");
            asm volatile("s_waitcnt vmcnt(0)" ::: "memory");
        }
    }
    __syncthreads();
}

constexpr size_t MiB = 1u << 20;
constexpr size_t WS_CTL = 0, CTL_ZERO_BYTES = 1 * MiB;
constexpr size_t WS_ROPE = 1 * MiB;
constexpr size_t WS_WI   = 3 * MiB;
constexpr size_t WS_ROUTE = 3 * MiB + 512 * 1024;
constexpr size_t WS_SROW = 4 * MiB;
constexpr size_t WS_ROWMAP = 4 * MiB + 256 * 1024;
constexpr size_t WS_CWROW = 4 * MiB + 640 * 1024;
constexpr size_t WS_CNTWG = 5 * MiB;
constexpr size_t WS_META = 5 * MiB + 64 * 1024;
constexpr size_t WS_WR = 5 * MiB + 128 * 1024;
constexpr size_t WS_GLR = 6 * MiB;
constexpr size_t WS_WDENSE = 8 * MiB;
constexpr size_t WD_WA = 0, WD_WG = 7 * MiB, WD_WBR = 13 * MiB, WD_WOUT = 16 * MiB, WD_LAYER = 18 * MiB;
constexpr size_t WS_WMOE = 44 * MiB;
constexpr size_t WM_GU = 0, WM_DN = 32 * MiB;
constexpr size_t WS_HB = 92 * MiB;
constexpr size_t WS_PA = 156 * MiB;
constexpr size_t WS_HID = WS_PA;
constexpr size_t WS_FF2 = WS_PA + 40 * MiB;
constexpr size_t WS_Y = 380 * MiB;
constexpr size_t WS_KA = 476 * MiB, WS_VA = 480 * MiB, WS_KI = 484 * MiB;
constexpr size_t WS_END = 512 * MiB;
static_assert(WS_WDENSE + 2 * WD_LAYER <= WS_WMOE && WS_WMOE + 48 * MiB <= WS_HB && WS_HB + 64 * MiB <= WS_PA && WS_PA + 224 * MiB <= WS_Y && WS_Y + 96 * MiB <= WS_KA && WS_KI + 4 * MiB <= WS_END, "ws map");
static_assert(WS_FF2 + (size_t)73728 * 1024 * 2 <= WS_Y, "ff2 fits");
constexpr int CW_BAR = 4096;
constexpr int CW_QUEUE = 16384;

constexpr int RING_BYTES = 131072;
constexpr int AUX_OFF = 131072;
constexpr int MISC_OFF = 155648;
constexpr int LDS_BYTES = 156672;

struct Frame {
    LAS unsigned char* lds;
    volatile LAS unsigned* MISC;
    gu32* ctl;
    int tid, lane, wave, G, wg;
    const float* const* in;
    const GAS int* pos;
    GAS float* H;
    GAS unsigned char* ws;
};

#define LDS_WAIT() asm volatile("s_waitcnt lgkmcnt(0)" ::: "memory")
#define VM_WAIT() asm volatile("s_waitcnt vmcnt(0)" ::: "memory")

__device__ __forceinline__ int pa_src_col(int c) {
    if (c < 512) return c;
    if (c < 768) { const int x = c - 512, half = x >> 7, y = x & 127, grp = y >> 5, d = (y & 31) + 32 * half;
        if (grp == 0) return 512 + d;
        if (grp == 1) return 576 + d;
        if (grp == 2) return 896 + d;
        if (half == 0) { const int z = y - 96; if (z < 4) return 960 + z; if (z < 20) return 1988 + (z - 4); }
        return -1; }
    if (c < 1024) return 640 + (c - 768);
    if (c < 1280) return 964 + (c - 1024);
    if (c < 1536) return 1220 + (c - 1280);
    if (c < 2048) return 1476 + (c - 1536);
    if (c < 2560) return 2004 + (c - 2048);
    return 2516 + (c - 2560);
}
struct TItem { const GAS float* W; GAS bf16* WT; int ldw, K, n0, k0, sc0, mode; };
__device__ __forceinline__ void ti_load(const TItem& t, f32x4 (&v)[8], int lane) {
    if (t.mode == 0) { const int kr = lane >> 3, c4 = (lane & 7) * 4;
#pragma unroll
        for (int i = 0; i < 8; ++i) v[i] = *(const GAS f32x4*)(t.W + (size_t)(t.k0 + 8 * i + kr) * t.ldw + t.sc0 + c4); }
}
__device__ __forceinline__ void ti_finish(const TItem& t, const f32x4 (&v)[8], LAS float* scr, int lane) {
    if (t.mode == 0) { const int kr = lane >> 3, c4 = (lane & 7) * 4;
#pragma unroll
        for (int i = 0; i < 8; ++i) { LAS float* d = scr + (8 * i + kr) * 33 + c4; d[0] = v[i].x; d[1] = v[i].y; d[2] = v[i].z; d[3] = v[i].w; }
    } else { const int sc = pa_src_col(t.n0 + (lane & 31));
#pragma unroll 8
        for (int i = 0; i < 32; ++i) { const int kk = 2 * i + (lane >> 5); scr[kk * 33 + (lane & 31)] = (sc >= 0) ? t.W[(size_t)(t.k0 + kk) * t.ldw + sc] : 0.f; }
    }
    LDS_WAIT(); asm volatile("" ::: "memory");
    const int c = lane & 7;
#pragma unroll
    for (int j = 0; j < 4; ++j) { const int n = (lane >> 3) + 8 * j; const LAS float* s = scr + (8 * c) * 33 + n;
        u32x4 o; o.x = pk2(s[0 * 33], s[1 * 33]); o.y = pk2(s[2 * 33], s[3 * 33]); o.z = pk2(s[4 * 33], s[5 * 33]); o.w = pk2(s[6 * 33], s[7 * 33]);
        *(GAS u32x4*)(t.WT + (size_t)(t.n0 + n) * t.K + t.k0 + 8 * c) = o; }
    LDS_WAIT(); asm volatile("" ::: "memory");
}
__device__ __forceinline__ void dense_item(Frame& F, int l, int it, TItem& t) {
    GAS bf16* base = (GAS bf16*)(F.ws + WS_WDENSE + (size_t)l * WD_LAYER);
    const GAS float* win = ((const GAS float*)F.in[4]) + (size_t)l * DM * NIN;
    if (it < 1792) { const int kb = it / 112, nb = it % 112; const int s0 = pa_src_col(32 * nb), s31 = pa_src_col(32 * nb + 31);
        t = TItem{win, base + WD_WA / 2, NIN, DM, 32 * nb, 64 * kb, s0, (s0 >= 0 && s31 == s0 + 31) ? 0 : 1}; return; }
    it -= 1792;
    if (it < 1536) { const int kb = it / 96, nb = it % 96; t = TItem{win, base + WD_WG / 2, NIN, DM, 32 * nb, 64 * kb, 3540 + 32 * nb, 0}; return; }
    it -= 1536;
    if (it < 768) { const int br = it / 256, r = it % 256, kb = r / 32, nb = r % 32;
        t = TItem{(br == 0 ? ((const GAS float*)F.in[13]) : br == 1 ? ((const GAS float*)F.in[14]) : ((const GAS float*)F.in[15])) + (size_t)l * 512 * DM, base + WD_WBR / 2 + (size_t)br * 1024 * 512, DM, 512, 32 * nb, 64 * kb, 32 * nb, 0}; return; }
    it -= 768;
    { const int kb = it / 32, nb = it % 32; t = TItem{((const GAS float*)F.in[16]) + (size_t)l * DM * DM, base + WD_WOUT / 2, DM, DM, 32 * nb, 64 * kb, 32 * nb, 0}; }
}
__device__ __forceinline__ void moe_item(Frame& F, int l, int it, TItem& t) {
    const int e = it / 384; int r = it % 384;
    if (r < 256) { const int sub = r / 64, q = r % 64, ct = sub >> 1, bj = sub & 1, kb = q / 4, nb = q % 4;
        const GAS float* src = (bj ? ((const GAS float*)F.in[24]) : ((const GAS float*)F.in[23])) + (size_t)(l * NEXP + e) * DM * DEXP;
        t = TItem{src, (GAS bf16*)(F.ws + WS_WMOE + WM_GU) + (size_t)e * 512 * DM, DEXP, DM, 256 * ct + 128 * bj + 32 * nb, 64 * kb, 128 * ct + 32 * nb, 0}; return; }
    r -= 256;
    { const int kb = r / 32, nb = r % 32;
        t = TItem{((const GAS float*)F.in[25]) + (size_t)(l * NEXP + e) * DEXP * DM, (GAS bf16*)(F.ws + WS_WMOE + WM_DN) + (size_t)e * DM * DEXP, DM, DEXP, 32 * nb, 64 * kb, 32 * nb, 0}; }
}
template <bool MOE> __device__ __forceinline__ void conv_run(Frame& F, int l, int total, LAS float* scr) {
    const int gw = F.wg * 8 + F.wave, NGW = F.G * 8, lane = F.lane;
    TItem cur, nxt; f32x4 vc[8], vn[8];
    int it = gw; if (it >= total) return;
    if (MOE) moe_item(F, l, it, cur); else dense_item(F, it / 4608, it % 4608, cur);
    ti_load(cur, vc, lane);
#pragma unroll 1
    for (; it < total; it += NGW) { const int itn = it + NGW; const bool hn = itn < total;
        if (hn) { if (MOE) moe_item(F, l, itn, nxt); else dense_item(F, itn / 4608, itn % 4608, nxt); ti_load(nxt, vn, lane); }
        ti_finish(cur, vc, scr, lane);
        cur = nxt;
#pragma unroll
        for (int i = 0; i < 8; ++i) vc[i] = vn[i]; }
}

__device__ __forceinline__ void ln_row_regs(f32x4 (&v)[4], const GAS float* g, const GAS float* b, int lane) {
    float s = 0.f;
#pragma unroll
    for (int j = 0; j < 4; ++j) s += (v[j].x + v[j].y) + (v[j].z + v[j].w);
    const float mean = wave_sum(s, lane) * (1.f / DM); float s2 = 0.f;
#pragma unroll
    for (int j = 0; j < 4; ++j) { v[j] = v[j] - mean; s2 += (v[j].x * v[j].x + v[j].y * v[j].y) + (v[j].z * v[j].z + v[j].w * v[j].w); }
    const float rstd = 1.f / sqrtf(wave_sum(s2, lane) * (1.f / DM) + LN_EPS);
#pragma unroll
    for (int j = 0; j < 4; ++j) { const f32x4 gg = *(const GAS f32x4*)(g + 4 * lane + 256 * j), bb = *(const GAS f32x4*)(b + 4 * lane + 256 * j); v[j] = v[j] * rstd * gg + bb; }
}
__device__ __forceinline__ void store_row_f32_bf16(const f32x4 (&v)[4], GAS float* hrow, GAS bf16* brow, int lane) {
#pragma unroll
    for (int j = 0; j < 4; ++j) {
        if (hrow) *(GAS f32x4*)(hrow + 4 * lane + 256 * j) = v[j];
        if (brow) { u32x2 w; w.x = pk2(v[j].x, v[j].y); w.y = pk2(v[j].z, v[j].w); *(GAS u32x2*)(brow + 4 * lane + 256 * j) = w; }
    }
}

__device__ __forceinline__ void phase_prologue(Frame& F) {
    LAS float* scr = (LAS float*)(F.lds + F.wave * 16384);
    const int gw = F.wg * 8 + F.wave, NGW = F.G * 8;
    conv_run<false>(F, 0, 2 * 4608, scr);
    { GAS bf16* WRB = (GAS bf16*)(F.ws + WS_WR);
      for (int i = gw * 64 + F.lane; i < DEPTH * 48 * DM; i += NGW * 64) { const int l = i / (48 * DM), r = i % (48 * DM), o = r / DM, k = r % DM;
          const float v = (o < 4) ? ((const GAS float*)F.in[19])[(size_t)l * DM * 4 + k * 4 + o] : (o < 36) ? ((const GAS float*)F.in[21])[(size_t)l * DM * 32 + k * 32 + (o - 4)] : 0.f;
          WRB[i] = (bf16)f2bf(v); } }
    { GAS float* RT = (GAS float*)(F.ws + WS_ROPE);
      for (int i = gw * 64 + F.lane; i < NTOK * 8; i += NGW * 64) { const int n = i >> 3, j = i & 7;
          const float invf[8] = {1.000000000e+00f, 1.939227432e-01f, 3.760603070e-02f, 7.292664610e-03f, 1.414213562e-03f, 2.742481884e-04f, 5.318295734e-05f, 1.031338525e-05f};
          float inv = invf[0];
#pragma unroll
          for (int q = 1; q < 8; ++q) inv = (j == q) ? invf[q] : inv;
          const float ang = (float)F.pos[n] * inv;
          const double kq = __builtin_rint((double)ang * 0.15915494309189535);
          double r = (double)ang - kq * 6.283185307179586; double csign = 1.0;
          if (r > 1.5707963267948966) { r = 3.141592653589793 - r; csign = -1.0; } else if (r < -1.5707963267948966) { r = -3.141592653589793 - r; csign = -1.0; }
          const double x2 = r * r;
          const double sn = r * (1.0 + x2 * (-1.0 / 6 + x2 * (1.0 / 120 + x2 * (-1.0 / 5040 + x2 * (1.0 / 362880 + x2 * (-1.0 / 39916800 + x2 * (1.0 / 6227020800.0 + x2 * (-1.0 / 1307674368000.0))))))));
          const double cs = 1.0 + x2 * (-0.5 + x2 * (1.0 / 24 + x2 * (-1.0 / 720 + x2 * (1.0 / 40320 + x2 * (-1.0 / 3628800 + x2 * (1.0 / 479001600.0 + x2 * (-1.0 / 87178291200.0 + x2 * (1.0 / 20922789888000.0))))))));
          RT[n * 16 + j] = (float)(csign * cs); RT[n * 16 + 8 + j] = (float)sn; } }
    GAS bf16* HB = (GAS bf16*)(F.ws + WS_HB);
    for (int m = gw; m < NTOK; m += NGW) { f32x4 v[4];
#pragma unroll
        for (int j = 0; j < 4; ++j) v[j] = *(const GAS f32x4*)(((const GAS float*)F.in[0]) + (size_t)m * DM + 4 * F.lane + 256 * j);
        ln_row_regs(v, ((const GAS float*)F.in[2]), ((const GAS float*)F.in[3]), F.lane);
        store_row_f32_bf16(v, (GAS float*)nullptr, HB + (size_t)m * DM, F.lane); }
}

struct DenseSched {
    int nM, nN, nwg, G, c; const char* A; const char* B; size_t atile, btile; int nsub = 1; size_t asub = 0, bsub = 0;
    __device__ void init(int nM_, int nN_, int G_, int c_, const void* A_, size_t atile_, const void* B_, size_t btile_) { nM = nM_; nN = nN_; nwg = nM * nN; G = G_; c = c_; A = (const char*)A_; B = (const char*)B_; atile = atile_; btile = btile_; }
    __device__ __forceinline__ bool next(int i, pg8::Unit& u) const {
        const int it = i / nsub, sb = i - it * nsub;
        const long L = (long)it * G + c; if (L >= nwg) return false;
        int wgid = (int)L; { const int q = nwg / 8, r = nwg % 8, xcd = wgid % 8, off = wgid / 8; wgid = (xcd < r ? xcd * (q + 1) : r * (q + 1) + (xcd - r) * q) + off; }
        const int nig = 8 * nN, gid = wgid / nig, fm = gid * 8, gsz = (nM - fm) < 8 ? (nM - fm) : 8;
        u.pm = fm + ((wgid % nig) % gsz); u.pn = (wgid % nig) / gsz; u.e = sb; u.slot = i; return true;
    }
    __device__ __forceinline__ const char* a_base(const pg8::Unit& u) const { return A + (size_t)u.pm * atile + (size_t)u.e * asub; }
    __device__ __forceinline__ const char* b_base(const pg8::Unit& u) const { return B + (size_t)u.pn * btile + (size_t)u.e * bsub; }
    __device__ __forceinline__ int row_of(const pg8::Unit&, int) const { return 0; }
};
struct GroupSched {
    int NU, G, c, ncol; const char* A; const char* B; size_t atile, erows_bytes, btile; const LAS int* meta; const LAS int* rows;
    __device__ __forceinline__ bool next(int i, pg8::Unit& u) const {
        const int L = i * G + c; if (L >= NU) return false;
        u.pm = L / ncol; u.pn = L % ncol; u.slot = i; u.e = meta[i]; return true;
    }
    __device__ __forceinline__ const char* a_base(const pg8::Unit& u) const { return A + (size_t)u.pm * atile; }
    __device__ __forceinline__ const char* b_base(const pg8::Unit& u) const { return B + (size_t)u.e * erows_bytes + (size_t)u.pn * btile; }
    __device__ __forceinline__ int row_of(const pg8::Unit& u, int r) const { return rows[u.slot * 256 + r]; }
};

struct EpiA {
    static constexpr bool PERM = true; static constexpr int NST = 16;
    GAS bf16* PA; GAS bf16* KA; GAS bf16* VA; GAS bf16* KI; GAS float* WI; GAS float* GLR; const GAS float* ROPE; const GAS float* ikg;
    __device__ __forceinline__ static void rope8(float (&x)[8], const GAS float* rt, int fq, int lane) {
        const f32x4 c0 = *(const GAS f32x4*)(rt), c1 = *(const GAS f32x4*)(rt + 4), s0 = *(const GAS f32x4*)(rt + 8), s1 = *(const GAS f32x4*)(rt + 12);
#pragma unroll
        for (int i = 0; i < 8; ++i) { const float p = shx(x[i], 16, lane); const float cc = (i < 4) ? c0[i & 3] : c1[i & 3], ss = (i < 4) ? s0[i & 3] : s1[i & 3];
            const float r = x[i] * cc + ((fq == 0) ? -p : p) * ss; x[i] = (fq < 2) ? r : x[i]; }
    }
    __device__ __forceinline__ static u32x4 pack8(const float (&x)[8]) { u32x4 w; w.x = cvt_pk_bf16(x[0], x[1]); w.y = cvt_pk_bf16(x[2], x[3]); w.z = cvt_pk_bf16(x[4], x[5]); w.w = cvt_pk_bf16(x[6], x[7]); return w; }
    __device__ __forceinline__ void operator()(const f32x4 (&acc)[2][2][4][2], const pg8::Unit& u, int wr, int wc, int fr, int fq) const {
        const int pn = u.pn; const int rowb = u.pm * 256 + wr * 64 + fr; const int lane = fq * 16 + fr;
        if (pn == 2) {
#pragma unroll
            for (int ai = 0; ai < 2; ++ai)
#pragma unroll
                for (int m = 0; m < 4; ++m) {
                    const int row = rowb + ai * 128 + m * 16;
                    float x0[8], x1[8];
#pragma unroll
                    for (int i = 0; i < 8; ++i) { x0[i] = acc[ai][0][m][i >> 2][i & 3]; x1[i] = acc[ai][1][m][i >> 2][i & 3]; }
                    if (wc == 2) {
                        float s = 0.f;
#pragma unroll
                        for (int i = 0; i < 8; ++i) s += x0[i] + x1[i];
                        s += shx(s, 16, lane); s += shx(s, 32, lane);
                        const float mean = s * (1.f / 64.f); float q = 0.f;
#pragma unroll
                        for (int i = 0; i < 8; ++i) { x0[i] -= mean; x1[i] -= mean; q += x0[i] * x0[i] + x1[i] * x1[i]; }
                        q += shx(q, 16, lane); q += shx(q, 32, lane);
                        const float rstd = 1.f / sqrtf(q * (1.f / 64.f) + LN_EPS);
#pragma unroll
                        for (int i = 0; i < 8; ++i) { x0[i] = x0[i] * rstd * ikg[8 * fq + i]; x1[i] = x1[i] * rstd * ikg[32 + 8 * fq + i]; }
                    }
                    if (wc == 0 || wc == 2) rope8(x0, ROPE + (size_t)row * 16, fq, lane);
                    if (wc < 3) {
                        GAS bf16* dst = (wc == 0) ? KA : (wc == 1) ? VA : KI;
                        *(GAS u32x4*)(dst + (size_t)row * 64 + 8 * fq) = pack8(x0); *(GAS u32x4*)(dst + (size_t)row * 64 + 32 + 8 * fq) = pack8(x1);
                    } else {
                        if (fq == 0) { *(GAS f32x4*)(WI + (size_t)row * 4) = (f32x4){x0[0], x0[1], x0[2], x0[3]} * 0.0625f; *(GAS f32x4*)(GLR + (size_t)row * 16) = (f32x4){x0[4], x0[5], x0[6], x0[7]}; }
                        else if (fq == 1) { *(GAS f32x4*)(GLR + (size_t)row * 16 + 4) = (f32x4){x0[0], x0[1], x0[2], x0[3]}; *(GAS f32x4*)(GLR + (size_t)row * 16 + 8) = (f32x4){x0[4], x0[5], x0[6], x0[7]}; }
                        else if (fq == 2) { *(GAS f32x4*)(GLR + (size_t)row * 16 + 12) = (f32x4){x0[0], x0[1], x0[2], x0[3]}; }
                    }
                    asm volatile("" ::: "memory");
                }
        } else if (pn < 2 || pn == 3) {
            const float sc = (pn == 3) ? 1.0f : 0.125f; const bool rope = !(wc & 1);
#pragma unroll
            for (int ai = 0; ai < 2; ++ai)
#pragma unroll
                for (int m = 0; m < 4; ++m) {
                    const int row = rowb + ai * 128 + m * 16;
#pragma unroll
                    for (int bj = 0; bj < 2; ++bj) { float x[8];
#pragma unroll
                        for (int i = 0; i < 8; ++i) x[i] = acc[ai][bj][m][i >> 2][i & 3];
                        if (rope) rope8(x, ROPE + (size_t)row * 16, fq, lane);
#pragma unroll
                        for (int i = 0; i < 8; ++i) x[i] *= sc;
                        *(GAS u32x4*)(PA + (size_t)row * NPA + 256 * pn + 128 * bj + 32 * wc + 8 * fq) = pack8(x); }
                    asm volatile("" ::: "memory");
                }
        } else {
            const int act = (pn == 8 || pn == 9) ? 1 : (pn >= 10) ? 2 : 0; const float sc = (pn == 4) ? 0.125f : 1.0f;
#pragma unroll
            for (int ai = 0; ai < 2; ++ai)
#pragma unroll
                for (int m = 0; m < 4; ++m) {
                    const int row = rowb + ai * 128 + m * 16;
#pragma unroll
                    for (int bj = 0; bj < 2; ++bj) { float x[8];
#pragma unroll
                        for (int i = 0; i < 8; ++i) { const float v = acc[ai][bj][m][i >> 2][i & 3]; x[i] = (act == 1) ? siluf_(v) : (act == 2) ? gelu_tanh_(v) : v * sc; }
                        *(GAS u32x4*)(PA + (size_t)row * NPA + 256 * pn + 128 * bj + 32 * wc + 8 * fq) = pack8(x); }
                    asm volatile("" ::: "memory");
                }
        }
    }
};
struct EpiPlainA {
    static constexpr bool PERM = true; static constexpr int NST = 16;
    GAS bf16* PA;
    __device__ __forceinline__ void operator()(const f32x4 (&acc)[2][2][4][2], const pg8::Unit& u, int wr, int wc, int fr, int fq) const {
        const int rowb = u.pm * 256 + wr * 64 + fr;
#pragma unroll
        for (int ai = 0; ai < 2; ++ai)
#pragma unroll
            for (int m = 0; m < 4; ++m) { const int row = rowb + ai * 128 + m * 16;
#pragma unroll
                for (int bj = 0; bj < 2; ++bj) { u32x4 w; w.x = cvt_pk_bf16(acc[ai][bj][m][0][0], acc[ai][bj][m][0][1]); w.y = cvt_pk_bf16(acc[ai][bj][m][0][2], acc[ai][bj][m][0][3]);
                    w.z = cvt_pk_bf16(acc[ai][bj][m][1][0], acc[ai][bj][m][1][1]); w.w = cvt_pk_bf16(acc[ai][bj][m][1][2], acc[ai][bj][m][1][3]);
                    *(GAS u32x4*)(PA + (size_t)row * NPA + 256 * u.pn + 128 * bj + 32 * wc + 8 * fq) = w; } }
    }
};
struct EpiNoneA {
    static constexpr bool PERM = true; static constexpr int NST = 0;
    GAS bf16* PA;
    __device__ __forceinline__ void operator()(const f32x4 (&acc)[2][2][4][2], const pg8::Unit& u, int wr, int wc, int fr, int fq) const {
        float s = 0.f;
#pragma unroll
        for (int ai = 0; ai < 2; ++ai)
#pragma unroll
            for (int m = 0; m < 4; ++m)
#pragma unroll
                for (int bj = 0; bj < 2; ++bj)
#pragma unroll
                    for (int n = 0; n < 2; ++n) s += (acc[ai][bj][m][n][0] + acc[ai][bj][m][n][1]) + (acc[ai][bj][m][n][2] + acc[ai][bj][m][n][3]);
        if (s == 1.2345e30f) PA[u.pm + wr + wc + fr + fq] = (bf16)1;
    }
};
struct EpiP {
    static constexpr bool PERM = true; static constexpr int NST = 16;
    GAS bf16* P;
    __device__ __forceinline__ void operator()(const f32x4 (&acc)[2][2][4][2], const pg8::Unit& u, int wr, int wc, int fr, int fq) const {
        const int rowb = u.pm * 256 + wr * 64 + fr; GAS bf16* Pb = P + (size_t)u.e * NTOK * DM;
#pragma unroll
        for (int ai = 0; ai < 2; ++ai)
#pragma unroll
            for (int m = 0; m < 4; ++m) { const int row = rowb + ai * 128 + m * 16;
#pragma unroll
                for (int bj = 0; bj < 2; ++bj) { u32x4 w; w.x = cvt_pk_bf16(acc[ai][bj][m][0][0], acc[ai][bj][m][0][1]); w.y = cvt_pk_bf16(acc[ai][bj][m][0][2], acc[ai][bj][m][0][3]);
                    w.z = cvt_pk_bf16(acc[ai][bj][m][1][0], acc[ai][bj][m][1][1]); w.w = cvt_pk_bf16(acc[ai][bj][m][1][2], acc[ai][bj][m][1][3]);
                    *(GAS u32x4*)(Pb + (size_t)row * DM + 256 * u.pn + 128 * bj + 32 * wc + 8 * fq) = w; } }
    }
};
struct EpiGM {
    static constexpr bool PERM = true; static constexpr int NST = 16;
    const GAS bf16* P; GAS bf16* HM;
    __device__ __forceinline__ void operator()(const f32x4 (&acc)[2][2][4][2], const pg8::Unit& u, int wr, int wc, int fr, int fq) const {
        const int rowb = u.pm * 256 + wr * 64 + fr; const int br = u.e; const GAS bf16* Pb = P + (size_t)br * NTOK * DM;
        const int colb = 256 * u.pn + 32 * wc + 8 * fq;
#pragma unroll
        for (int ai = 0; ai < 2; ++ai) {
            u32x4 pv[4][2], ov[4][2];
#pragma unroll
            for (int m = 0; m < 4; ++m)
#pragma unroll
                for (int bj = 0; bj < 2; ++bj) { const size_t off = (size_t)(rowb + ai * 128 + m * 16) * DM + colb + 128 * bj;
                    pv[m][bj] = *(const GAS u32x4*)(Pb + off); ov[m][bj] = (br > 0) ? *(const GAS u32x4*)(HM + off) : (u32x4){0u, 0u, 0u, 0u}; }
            __builtin_amdgcn_sched_barrier(0);
#pragma unroll
            for (int m = 0; m < 4; ++m)
#pragma unroll
                for (int bj = 0; bj < 2; ++bj) { const size_t off = (size_t)(rowb + ai * 128 + m * 16) * DM + colb + 128 * bj;
                    const u32x4 p = pv[m][bj], o = ov[m][bj];
                    float x[8];
                    x[0] = bflo(p.x) * sigmoidf_(acc[ai][bj][m][0][0]) + bflo(o.x); x[1] = bfhi(p.x) * sigmoidf_(acc[ai][bj][m][0][1]) + bfhi(o.x); x[2] = bflo(p.y) * sigmoidf_(acc[ai][bj][m][0][2]) + bflo(o.y); x[3] = bfhi(p.y) * sigmoidf_(acc[ai][bj][m][0][3]) + bfhi(o.y);
                    x[4] = bflo(p.z) * sigmoidf_(acc[ai][bj][m][1][0]) + bflo(o.z); x[5] = bfhi(p.z) * sigmoidf_(acc[ai][bj][m][1][1]) + bfhi(o.z); x[6] = bflo(p.w) * sigmoidf_(acc[ai][bj][m][1][2]) + bflo(o.w); x[7] = bfhi(p.w) * sigmoidf_(acc[ai][bj][m][1][3]) + bfhi(o.w);
                    u32x4 w; w.x = cvt_pk_bf16(x[0], x[1]); w.y = cvt_pk_bf16(x[2], x[3]); w.z = cvt_pk_bf16(x[4], x[5]); w.w = cvt_pk_bf16(x[6], x[7]);
                    *(GAS u32x4*)(HM + off) = w; }
            asm volatile("" ::: "memory");
        }
    }
};
struct EpiO {
    static constexpr bool PERM = true; static constexpr int NST = 16;
    const GAS bf16* HBr; GAS bf16* T;
    __device__ __forceinline__ void operator()(const f32x4 (&acc)[2][2][4][2], const pg8::Unit& u, int wr, int wc, int fr, int fq) const {
        const int rowb = u.pm * 256 + wr * 64 + fr; const int colb = 256 * u.pn + 32 * wc + 8 * fq;
#pragma unroll
        for (int ai = 0; ai < 2; ++ai) {
            u32x4 hv[4][2];
#pragma unroll
            for (int m = 0; m < 4; ++m)
#pragma unroll
                for (int bj = 0; bj < 2; ++bj) hv[m][bj] = *(const GAS u32x4*)(HBr + (size_t)(rowb + ai * 128 + m * 16) * DM + colb + 128 * bj);
            __builtin_amdgcn_sched_barrier(0);
#pragma unroll
            for (int m = 0; m < 4; ++m)
#pragma unroll
                for (int bj = 0; bj < 2; ++bj) { const u32x4 h = hv[m][bj];
                    u32x4 w; w.x = cvt_pk_bf16(bflo(h.x) * DN_ALPHA + acc[ai][bj][m][0][0], bfhi(h.x) * DN_ALPHA + acc[ai][bj][m][0][1]); w.y = cvt_pk_bf16(bflo(h.y) * DN_ALPHA + acc[ai][bj][m][0][2], bfhi(h.y) * DN_ALPHA + acc[ai][bj][m][0][3]);
                    w.z = cvt_pk_bf16(bflo(h.z) * DN_ALPHA + acc[ai][bj][m][1][0], bfhi(h.z) * DN_ALPHA + acc[ai][bj][m][1][1]); w.w = cvt_pk_bf16(bflo(h.w) * DN_ALPHA + acc[ai][bj][m][1][2], bfhi(h.w) * DN_ALPHA + acc[ai][bj][m][1][3]);
                    *(GAS u32x4*)(T + (size_t)(rowb + ai * 128 + m * 16) * DM + colb + 128 * bj) = w; }
            asm volatile("" ::: "memory");
        }
    }
};
struct EpiGU {
    static constexpr bool PERM = true; static constexpr int NST = 8;
    GAS bf16* HID; const GAS float* CW;
    __device__ __forceinline__ void operator()(const f32x4 (&acc)[2][2][4][2], const pg8::Unit& u, int wr, int wc, int fr, int fq) const {
        const int rowb = u.pm * 256 + wr * 64 + fr;
        float cwv[2][4];
#pragma unroll
        for (int ai = 0; ai < 2; ++ai)
#pragma unroll
            for (int m = 0; m < 4; ++m) cwv[ai][m] = CW[rowb + ai * 128 + m * 16];
#pragma unroll
        for (int ai = 0; ai < 2; ++ai)
#pragma unroll
            for (int m = 0; m < 4; ++m) { const int row = rowb + ai * 128 + m * 16; const float cw = cwv[ai][m];
                float x[8];
#pragma unroll
                for (int i = 0; i < 8; ++i) x[i] = siluf_(acc[ai][0][m][i >> 2][i & 3]) * acc[ai][1][m][i >> 2][i & 3] * cw;
                u32x4 w; w.x = cvt_pk_bf16(x[0], x[1]); w.y = cvt_pk_bf16(x[2], x[3]); w.z = cvt_pk_bf16(x[4], x[5]); w.w = cvt_pk_bf16(x[6], x[7]);
                *(GAS u32x4*)(HID + (size_t)row * DEXP + 128 * u.pn + 32 * wc + 8 * fq) = w; }
    }
};
struct EpiDN {
    static constexpr bool PERM = true; static constexpr int NST = 16;
    GAS bf16* FF2;
    __device__ __forceinline__ void operator()(const f32x4 (&acc)[2][2][4][2], const pg8::Unit& u, int wr, int wc, int fr, int fq) const {
        const int rowb = u.pm * 256 + wr * 64 + fr;
#pragma unroll
        for (int ai = 0; ai < 2; ++ai)
#pragma unroll
            for (int m = 0; m < 4; ++m) { const int row = rowb + ai * 128 + m * 16;
#pragma unroll
                for (int bj = 0; bj < 2; ++bj) { u32x4 w; w.x = cvt_pk_bf16(acc[ai][bj][m][0][0], acc[ai][bj][m][0][1]); w.y = cvt_pk_bf16(acc[ai][bj][m][0][2], acc[ai][bj][m][0][3]);
                    w.z = cvt_pk_bf16(acc[ai][bj][m][1][0], acc[ai][bj][m][1][1]); w.w = cvt_pk_bf16(acc[ai][bj][m][1][2], acc[ai][bj][m][1][3]);
                    *(GAS u32x4*)(FF2 + (size_t)row * DM + 256 * u.pn + 128 * bj + 32 * wc + 8 * fq) = w; } }
    }
};
#ifndef EN_B1
#define EN_B1 1
#endif
#ifndef EN_B2
#define EN_B2 1
#endif
#ifndef EN_B3
#define EN_B3 1
#endif

template <int CTRL> __device__ __forceinline__ float dppf(float x) { return __builtin_bit_cast(float, __builtin_amdgcn_mov_dpp(__builtin_bit_cast(int, x), CTRL, 0xf, 0xf, true)); }
template <int CTRL> __device__ __forceinline__ int dppi(int x) { return __builtin_amdgcn_mov_dpp(x, CTRL, 0xf, 0xf, true); }
typedef short v4i16_t __attribute__((ext_vector_type(4)));
typedef unsigned short u16x2 __attribute__((ext_vector_type(2)));
__device__ __forceinline__ v4i16_t ldtr(const LAS unsigned char* p) { return __builtin_amdgcn_ds_read_tr16_b64_v4i16((LAS v4i16_t*)p); }
__device__ __forceinline__ bf16x8 cat8(v4i16_t lo, v4i16_t hi) { bf16x8 r; r[0] = lo[0]; r[1] = lo[1]; r[2] = lo[2]; r[3] = lo[3]; r[4] = hi[0]; r[5] = hi[1]; r[6] = hi[2]; r[7] = hi[3]; return r; }
__device__ __forceinline__ int wave_total_i(int v) {
    v += dppi<0xB1>(v); v += dppi<0x4E>(v); v += dppi<0x141>(v); v += dppi<0x140>(v);
    return __builtin_amdgcn_readlane(v, 0) + __builtin_amdgcn_readlane(v, 16) + __builtin_amdgcn_readlane(v, 32) + __builtin_amdgcn_readlane(v, 48);
}
__device__ __forceinline__ void gmlp_unit(Frame& F, int l, int unit) {
    int tid = F.tid; asm volatile("" : "+v"(tid)); const int lane = tid & 63;
    const int chunk = unit >> 2, g = unit & 3, n0 = chunk * 128;
    const GAS bf16* PA = (const GAS bf16*)(F.ws + WS_PA); GAS bf16* Y = (GAS bf16*)(F.ws + WS_Y);
    LAS float* vln = (LAS float*)F.lds;
    LAS float* wl = (LAS float*)(F.lds + 65536);
    LAS float* st = (LAS float*)(F.lds + AUX_OFF);
    const GAS float* lng = ((const GAS float*)F.in[9]) + l * 512; const GAS float* lnb = ((const GAS float*)F.in[10]) + l * 512;
    for (int j = 0; j < 16; ++j) { const int s = F.wave * 16 + j;
        const u32x4 w = *(const GAS u32x4*)(PA + (size_t)(n0 + s) * NPA + PA_CV + 8 * lane);
        float x[8] = {bflo(w.x), bfhi(w.x), bflo(w.y), bfhi(w.y), bflo(w.z), bfhi(w.z), bflo(w.w), bfhi(w.w)};
        float sm = 0.f;
#pragma unroll
        for (int i = 0; i < 8; ++i) sm += x[i];
        const float mean = wave_sum(sm, lane) * (1.f / 512.f); float q = 0.f;
#pragma unroll
        for (int i = 0; i < 8; ++i) { const float d = x[i] - mean; q += d * d; }
        const float rstd = 1.f / sqrtf(wave_sum(q, lane) * (1.f / 512.f) + LN_EPS);
        if (lane == 0) { st[2 * s] = mean; st[2 * s + 1] = rstd; } }
    __syncthreads();
#pragma unroll
    for (int i = 0; i < 4; ++i) { const int q = tid + 512 * i, s = q >> 4, d0 = (q & 15) * 8;
        const u32x4 w = *(const GAS u32x4*)(PA + (size_t)(n0 + s) * NPA + PA_CV + g * 128 + d0);
        const float mean = st[2 * s], rstd = st[2 * s + 1];
        float x[8] = {bflo(w.x), bfhi(w.x), bflo(w.y), bfhi(w.y), bflo(w.z), bfhi(w.z), bflo(w.w), bfhi(w.w)};
#pragma unroll
        for (int k = 0; k < 8; ++k) x[k] = (x[k] - mean) * rstd * lng[g * 128 + d0 + k] + lnb[g * 128 + d0 + k];
        *(LAS f32x4*)(vln + s * 128 + d0) = (f32x4){x[0], x[1], x[2], x[3]}; *(LAS f32x4*)(vln + s * 128 + d0 + 4) = (f32x4){x[4], x[5], x[6], x[7]}; }
    const GAS float* ws = ((const GAS float*)F.in[11]) + ((size_t)l * 4 + g) * 128 * 128;
#pragma unroll
    for (int i = 0; i < 8; ++i) { const int q = tid + 512 * i, t = q >> 5, s0 = (q & 31) * 4;
        f32x4 w = *(const GAS f32x4*)(ws + t * 128 + s0);
        if (s0 + 0 > t) w.x = 0.f; if (s0 + 1 > t) w.y = 0.f; if (s0 + 2 > t) w.z = 0.f; if (s0 + 3 > t) w.w = 0.f;
        *(LAS f32x4*)(wl + t * 128 + s0) = w; }
    __syncthreads();
    const int d = tid & 127, tq = __builtin_amdgcn_readfirstlane(tid >> 7);
    float vr[128];
#pragma unroll
    for (int sb = 0; sb < 4; ++sb)
        if (sb <= tq) {
#pragma unroll
            for (int s = 0; s < 32; ++s) vr[sb * 32 + s] = vln[(sb * 32 + s) * 128 + d];
        } else {
#pragma unroll
            for (int s = 0; s < 32; ++s) vr[sb * 32 + s] = 0.f;
        }
    const GAS float* bs = ((const GAS float*)F.in[12]) + ((size_t)l * 4 + g) * 128;
#pragma unroll 1
    for (int ti = 0; ti < 32; ++ti) { const int t = tq * 32 + ti; float a = 0.f;
#pragma unroll
        for (int sb = 0; sb < 4; ++sb)
            if (sb <= tq) {
#pragma unroll
                for (int s4 = 0; s4 < 8; ++s4) { const f32x4 w = *(const LAS f32x4*)(wl + t * 128 + sb * 32 + s4 * 4);
                    a += w.x * vr[sb * 32 + s4 * 4] + w.y * vr[sb * 32 + s4 * 4 + 1] + w.z * vr[sb * 32 + s4 * 4 + 2] + w.w * vr[sb * 32 + s4 * 4 + 3]; }
            }
        const float uu = bf1(PA[(size_t)(n0 + t) * NPA + PA_CU + g * 128 + d]);
        Y[(size_t)(n0 + t) * 1536 + 1024 + g * 128 + d] = (bf16)f2bf(uu * (a + bs[t])); }
    __syncthreads();
}

__device__ __forceinline__ void gmlp16_unit(Frame& F, int l, int chunk) {
    const int lane = fresh_lane(), w = F.wave, tid = w * 64 + lane, fr = lane & 15, fq = lane >> 4;
    const size_t n0 = (size_t)chunk * 128;
    const GAS bf16* PA = (const GAS bf16*)(F.ws + WS_PA); GAS bf16* Y = (GAS bf16*)(F.ws + WS_Y);
    LAS unsigned char* VT = F.lds;
    LAS unsigned char* WT = F.lds + 32768;
    LAS float* st = (LAS float*)(F.lds + AUX_OFF);
    const GAS float* lng = ((const GAS float*)F.in[9]) + l * 512; const GAS float* lnb = ((const GAS float*)F.in[10]) + l * 512;
    for (int j = 0; j < 16; ++j) { const int s = w * 16 + j;
        const u32x4 x4 = *(const GAS u32x4*)(PA + (n0 + s) * NPA + PA_CV + 8 * lane);
        float x[8] = {bflo(x4.x), bfhi(x4.x), bflo(x4.y), bfhi(x4.y), bflo(x4.z), bfhi(x4.z), bflo(x4.w), bfhi(x4.w)};
        float sm = 0.f;
#pragma unroll
        for (int i = 0; i < 8; ++i) sm += x[i];
        const float mean = wave_sum(sm, lane) * (1.f / 512.f); float q = 0.f;
#pragma unroll
        for (int i = 0; i < 8; ++i) { const float d = x[i] - mean; q += d * d; }
        const float rstd = 1.f / sqrtf(wave_sum(q, lane) * (1.f / 512.f) + LN_EPS);
        if (lane == 0) { st[2 * s] = mean; st[2 * s + 1] = rstd; } }
    __syncthreads();
#pragma unroll 1
    for (int g = 0; g < 4; ++g) {
        const GAS float* ws = ((const GAS float*)F.in[11]) + ((size_t)l * 4 + g) * 128 * 128;
#pragma unroll
        for (int i = 0; i < 4; ++i) { const int q = tid + 512 * i, s = q >> 4, d0 = (q & 15) * 8;
            const u32x4 x4 = *(const GAS u32x4*)(PA + (n0 + s) * NPA + PA_CV + g * 128 + d0);
            const float mean = st[2 * s], rstd = st[2 * s + 1];
            float x[8] = {bflo(x4.x), bfhi(x4.x), bflo(x4.y), bfhi(x4.y), bflo(x4.z), bfhi(x4.z), bflo(x4.w), bfhi(x4.w)};
            const f32x4 g0 = *(const GAS f32x4*)(lng + g * 128 + d0), g1 = *(const GAS f32x4*)(lng + g * 128 + d0 + 4), b0 = *(const GAS f32x4*)(lnb + g * 128 + d0), b1 = *(const GAS f32x4*)(lnb + g * 128 + d0 + 4);
#pragma unroll
            for (int k = 0; k < 8; ++k) x[k] = (x[k] - mean) * rstd * ((k < 4) ? g0[k & 3] : g1[k & 3]) + ((k < 4) ? b0[k & 3] : b1[k & 3]);
            u32x4 o; o.x = cvt_pk_bf16(x[0], x[1]); o.y = cvt_pk_bf16(x[2], x[3]); o.z = cvt_pk_bf16(x[4], x[5]); o.w = cvt_pk_bf16(x[6], x[7]);
            *(LAS u32x4*)(VT + s * 256 + d0 * 2) = o;
            const int t = s, s0 = d0;
            f32x4 w0 = *(const GAS f32x4*)(ws + t * 128 + s0), w1 = *(const GAS f32x4*)(ws + t * 128 + s0 + 4);
            float wv[8] = {w0.x, w0.y, w0.z, w0.w, w1.x, w1.y, w1.z, w1.w};
#pragma unroll
            for (int k = 0; k < 8; ++k) wv[k] = (s0 + k <= t) ? wv[k] : 0.f;
            u32x4 ow; ow.x = cvt_pk_bf16(wv[0], wv[1]); ow.y = cvt_pk_bf16(wv[2], wv[3]); ow.z = cvt_pk_bf16(wv[4], wv[5]); ow.w = cvt_pk_bf16(wv[6], wv[7]);
            *(LAS u32x4*)(WT + t * 256 + s0 * 2) = ow; }
        __syncthreads();
        f32x4 acc[8];
#pragma unroll
        for (int nt = 0; nt < 8; ++nt) acc[nt] = (f32x4){0.f, 0.f, 0.f, 0.f};
        const int nks = (16 * w + 15) / 32 + 1;
#pragma unroll
        for (int ks = 0; ks < 4; ++ks) if (ks < nks) {
            const bf16x8 a = *(const LAS bf16x8*)(WT + (16 * w + fr) * 256 + (8 * fq + 32 * ks) * 2);
            const int srow = 32 * ks + 8 * fq + (fr >> 2);
#pragma unroll
            for (int nt = 0; nt < 8; ++nt) { const bf16x8 bv = cat8(ldtr(VT + srow * 256 + (16 * nt + 4 * (fr & 3)) * 2), ldtr(VT + (srow + 4) * 256 + (16 * nt + 4 * (fr & 3)) * 2));
                acc[nt] = __builtin_amdgcn_mfma_f32_16x16x32_bf16(bv, a, acc[nt], 0, 0, 0); } }
        const GAS float* bs = ((const GAS float*)F.in[12]) + ((size_t)l * 4 + g) * 128;
        { const int t = 16 * w + fr; const float bt = bs[t];
#pragma unroll
          for (int nt = 0; nt < 8; ++nt) { const int d0 = 16 * nt + 4 * fq;
              const u32x2 uu = *(const GAS u32x2*)(PA + (n0 + t) * NPA + PA_CU + g * 128 + d0);
              u32x2 wv; wv.x = pk2(bflo(uu.x) * (acc[nt][0] + bt), bfhi(uu.x) * (acc[nt][1] + bt)); wv.y = pk2(bflo(uu.y) * (acc[nt][2] + bt), bfhi(uu.y) * (acc[nt][3] + bt));
              *(GAS u32x2*)(Y + (n0 + t) * 1536 + 1024 + g * 128 + d0) = wv; } }
        __syncthreads();
    }
}

__device__ __forceinline__ void gla_unit(Frame& F, int l, int unit) {
    int tid = F.tid; asm volatile("" : "+v"(tid));
    const int b = unit >> 2, h = unit & 3;
    const GAS bf16* PA = (const GAS bf16*)(F.ws + WS_PA); GAS bf16* Y = (GAS bf16*)(F.ws + WS_Y); const GAS float* GLR = (const GAS float*)(F.ws + WS_GLR);
    LAS float* wa = (LAS float*)F.lds;
    LAS float* ba = wa + 1024;
    LAS float* as_ = ba + 64;
    LAS float* qs = as_ + 1024;
    LAS float* ks = qs + 1024;
    LAS float* vs = ks + 1024;
    LAS float* part = vs + 2048;
    for (int i = tid; i < 1024; i += 512) wa[i] = ((const GAS float*)F.in[6])[(size_t)l * 16 * 256 + (i >> 6) * 256 + h * 64 + (i & 63)];
    if (tid < 64) ba[tid] = ((const GAS float*)F.in[7])[l * 256 + h * 64 + tid];
    const GAS float* gng = ((const GAS float*)F.in[8]) + l * 128;
    const int v = tid & 127, kq = __builtin_amdgcn_readfirstlane(tid >> 7);
    float S[16];
#pragma unroll
    for (int j = 0; j < 16; ++j) S[j] = 0.f;
    __syncthreads();
    for (int t0 = 0; t0 < SEQ; t0 += 16) {
        const size_t nb = (size_t)b * SEQ + t0;
#pragma unroll
        for (int i = 0; i < 2; ++i) { const int e = tid + 512 * i, t = e >> 6, k = e & 63; float z = ba[k];
#pragma unroll
            for (int r = 0; r < 16; ++r) z += GLR[(nb + t) * 16 + r] * wa[r * 64 + k];
            const float ls = fminf(z, 0.f) - log1pf(__expf(-fabsf(z)));
            as_[e] = __expf(ls * (1.f / 16.f));
            qs[e] = bf1(PA[(nb + t) * NPA + PA_BQ + h * 64 + k]); ks[e] = bf1(PA[(nb + t) * NPA + PA_BK + h * 64 + k]); }
#pragma unroll
        for (int i = 0; i < 4; ++i) { const int e = tid + 512 * i, t = e >> 7, vv = e & 127; vs[e] = bf1(PA[(nb + t) * NPA + PA_BV + h * 128 + vv]); }
        __syncthreads();
#pragma unroll 4
        for (int t = 0; t < 16; ++t) { const float vt = vs[t * 128 + v]; float p = 0.f;
#pragma unroll
            for (int j4 = 0; j4 < 4; ++j4) { const f32x4 a4 = *(const LAS f32x4*)(as_ + t * 64 + kq * 16 + j4 * 4), k4 = *(const LAS f32x4*)(ks + t * 64 + kq * 16 + j4 * 4), q4 = *(const LAS f32x4*)(qs + t * 64 + kq * 16 + j4 * 4);
#pragma unroll
                for (int j = 0; j < 4; ++j) { S[j4 * 4 + j] = a4[j] * S[j4 * 4 + j] + k4[j] * vt; p += q4[j] * S[j4 * 4 + j]; } }
            part[(kq * 16 + t) * 128 + v] = p; }
        __syncthreads();
        { const int t = tid >> 5, v4 = (tid & 31) * 4;
          f32x4 o = *(const LAS f32x4*)(part + (0 * 16 + t) * 128 + v4);
#pragma unroll
          for (int q = 1; q < 4; ++q) o += *(const LAS f32x4*)(part + (q * 16 + t) * 128 + v4);
          float ss = o.x * o.x + o.y * o.y + o.z * o.z + o.w * o.w;
#pragma unroll
          for (int sh = 1; sh < 32; sh <<= 1) ss += shx(ss, sh, tid & 63);
          const float r = 1.f / sqrtf(ss * (1.f / 128.f) + RMS_EPS);
          const f32x4 gg = *(const GAS f32x4*)(gng + v4);
          const u32x2 brw = *(const GAS u32x2*)(PA + (nb + t) * NPA + PA_BR + h * 128 + v4);
          u32x2 w; w.x = pk2(o.x * r * gg.x * bflo(brw.x), o.y * r * gg.y * bfhi(brw.x)); w.y = pk2(o.z * r * gg.z * bflo(brw.y), o.w * r * gg.w * bfhi(brw.y));
          *(GAS u32x2*)(Y + (nb + t) * 1536 + 512 + h * 128 + v4) = w; }
        __syncthreads();
    }
}

constexpr size_t WS_US = WS_WMOE, WS_DEC = WS_WMOE + 32 * MiB;
__device__ __forceinline__ void gla_local_unit(Frame& F, int l, int unit, bool dry = false) {
    const int lane = fresh_lane(), w = F.wave, tid = w * 64 + lane, fr = lane & 15, fq = lane >> 4;
    const int b = unit >> 8, h = (unit >> 6) & 3, c = unit & 63; const size_t n0 = (size_t)b * SEQ + 64 * c;
    GAS bf16* PA = (GAS bf16*)(F.ws + WS_PA); GAS bf16* Y = (GAS bf16*)(F.ws + WS_Y); const GAS float* GLR = (const GAS float*)(F.ws + WS_GLR);
    GAS bf16* US = (GAS bf16*)(F.ws + WS_US) + (size_t)unit * 8192; GAS float* DEC = (GAS float*)(F.ws + WS_DEC) + unit * 64;
    LAS unsigned char* QT = F.lds; LAS unsigned char* KT = F.lds + 8192; LAS unsigned char* KD = F.lds + 16384; LAS unsigned char* VV = F.lds + 24576; LAS unsigned char* ATT = F.lds + 40960;
    LAS float* SEG = (LAS float*)(F.lds + 65536); LAS float* WA = (LAS float*)(F.lds + 67584); LAS float* BA = (LAS float*)(F.lds + 71680); LAS float* GL = (LAS float*)(F.lds + 71936);
    const int k = tid & 63, seg = w;
    float qv8[8], kv8[8];
#pragma unroll
    for (int i = 0; i < 8; ++i) { const int t = 8 * seg + i; qv8[i] = bf1(PA[(n0 + t) * NPA + PA_BQ + h * 64 + k]); kv8[i] = bf1(PA[(n0 + t) * NPA + PA_BK + h * 64 + k]); }
    if (tid < 256) *(LAS f32x4*)(GL + 4 * tid) = *(const GAS f32x4*)(GLR + n0 * 16 + 4 * tid);
#pragma unroll
    for (int i = 0; i < 2; ++i) { const int e = tid + 512 * i; WA[e] = ((const GAS float*)F.in[6])[(size_t)l * 16 * 256 + (e >> 6) * 256 + h * 64 + (e & 63)]; }
    if (tid < 64) BA[tid] = ((const GAS float*)F.in[7])[l * 256 + h * 64 + tid];
#pragma unroll
    for (int i = 0; i < 2; ++i) { const int piece = tid + 512 * i, row = piece >> 4, c16 = piece & 15;
        *(LAS u32x4*)(VV + row * 256 + c16 * 16) = *(const GAS u32x4*)(PA + (n0 + row) * NPA + PA_BV + h * 128 + 8 * c16); }
    __syncthreads();
    float cum[8];
    { float run = 0.f;
#pragma unroll
      for (int i = 0; i < 8; ++i) { const int t = 8 * seg + i; float z = BA[k];
          const f32x4 g0 = *(const LAS f32x4*)(GL + t * 16), g1 = *(const LAS f32x4*)(GL + t * 16 + 4), g2 = *(const LAS f32x4*)(GL + t * 16 + 8), g3 = *(const LAS f32x4*)(GL + t * 16 + 12);
#pragma unroll
          for (int r = 0; r < 4; ++r) { z += g0[r] * WA[r * 64 + k]; z += g1[r] * WA[(4 + r) * 64 + k]; z += g2[r] * WA[(8 + r) * 64 + k]; z += g3[r] * WA[(12 + r) * 64 + k]; }
          const float ls = fminf(z, 0.f) - log1pf(__expf(-fabsf(z)));
          run += ls * (1.f / 16.f); cum[i] = run; }
      SEG[seg * 64 + k] = run; }
    __syncthreads();
    { float off = 0.f, blast = 0.f;
#pragma unroll
      for (int s2 = 0; s2 < 8; ++s2) { const float sv = SEG[s2 * 64 + k]; blast += sv; off += (s2 < seg) ? sv : 0.f; }
#pragma unroll
      for (int i = 0; i < 8; ++i) { const int t = 8 * seg + i; const float bb = cum[i] + off;
          const float qv = qv8[i], kv = kv8[i];
          const unsigned qt = f2bf(qv * __expf(bb));
          ((LAS unsigned short*)QT)[t * 64 + k] = (unsigned short)qt; ((LAS unsigned short*)KT)[t * 64 + k] = (unsigned short)f2bf(kv * __expf(-bb)); ((LAS unsigned short*)KD)[t * 64 + k] = (unsigned short)f2bf(kv * __expf(blast - bb));
          if (!dry) PA[(n0 + t) * NPA + PA_BQ + h * 64 + k] = (bf16)qt; }
      if (seg == 0) DEC[k] = __expf(blast); }
    __syncthreads();
#pragma unroll
    for (int ii = 0; ii < 2; ++ii) { const int id = 2 * w + ii, ts = id >> 2, tt = id & 3;
        f32x4 d = {0.f, 0.f, 0.f, 0.f};
        if (ts <= tt) {
#pragma unroll
            for (int ks = 0; ks < 2; ++ks) { const bf16x8 a = *(const LAS bf16x8*)(KT + (16 * ts + fr) * 128 + (8 * fq + 32 * ks) * 2), bq = *(const LAS bf16x8*)(QT + (16 * tt + fr) * 128 + (8 * fq + 32 * ks) * 2);
                d = __builtin_amdgcn_mfma_f32_16x16x32_bf16(a, bq, d, 0, 0, 0); } }
        const int t = 16 * tt + fr, s0 = 16 * ts + 4 * fq;
        u32x2 pk; pk.x = cvt_pk_bf16((s0 <= t) ? d[0] : 0.f, (s0 + 1 <= t) ? d[1] : 0.f); pk.y = cvt_pk_bf16((s0 + 2 <= t) ? d[2] : 0.f, (s0 + 3 <= t) ? d[3] : 0.f);
        *(LAS u32x2*)(ATT + t * 128 + s0 * 2) = pk; }
    __syncthreads();
    { const int tr = w & 3, nh = w >> 2;
      f32x4 ao[4], au[4];
#pragma unroll
      for (int j = 0; j < 4; ++j) { ao[j] = (f32x4){0.f, 0.f, 0.f, 0.f}; au[j] = (f32x4){0.f, 0.f, 0.f, 0.f}; }
#pragma unroll
      for (int ks = 0; ks < 2; ++ks) {
          const bf16x8 aA = *(const LAS bf16x8*)(ATT + (16 * tr + fr) * 128 + (8 * fq + 32 * ks) * 2);
          const int srow = 32 * ks + 8 * fq + (fr >> 2);
          const bf16x8 aK = cat8(ldtr(KD + srow * 128 + (16 * tr + 4 * (fr & 3)) * 2), ldtr(KD + (srow + 4) * 128 + (16 * tr + 4 * (fr & 3)) * 2));
#pragma unroll
          for (int j = 0; j < 4; ++j) { const int nt = 4 * nh + j;
              const bf16x8 bv = cat8(ldtr(VV + srow * 256 + (16 * nt + 4 * (fr & 3)) * 2), ldtr(VV + (srow + 4) * 256 + (16 * nt + 4 * (fr & 3)) * 2));
              ao[j] = __builtin_amdgcn_mfma_f32_16x16x32_bf16(bv, aA, ao[j], 0, 0, 0);
              au[j] = __builtin_amdgcn_mfma_f32_16x16x32_bf16(bv, aK, au[j], 0, 0, 0); } }
#pragma unroll
      for (int j = 0; j < 4; ++j) { const int v0 = 16 * (4 * nh + j) + 4 * fq, row = 16 * tr + fr;
          u32x2 wo; wo.x = pk2(ao[j][0], ao[j][1]); wo.y = pk2(ao[j][2], ao[j][3]); *(GAS u32x2*)(Y + (n0 + row) * 1536 + 512 + h * 128 + v0) = wo;
          u32x2 wu; wu.x = pk2(au[j][0], au[j][1]); wu.y = pk2(au[j][2], au[j][3]); *(GAS u32x2*)(US + row * 128 + v0) = wu; } }
    __syncthreads();
}
__device__ __forceinline__ void gla_scan_phase(Frame& F, bool dry = false) {
    GAS bf16* USb = (GAS bf16*)(F.ws + WS_US); const GAS float* DECb = (const GAS float*)(F.ws + WS_DEC); const size_t dofs = dry ? (size_t)((GAS unsigned char*)F.H - (F.ws + WS_US)) / 4 : 0;
    for (int gt = F.wg * 512 + F.tid; gt < 131072; gt += F.G * 512) { const int e0 = 2 * gt, bh = e0 >> 13, kv = e0 & 8191, k = kv >> 7;
        GAS unsigned* p = (GAS unsigned*)(USb + (size_t)bh * 64 * 8192 + kv); const GAS float* dp = DECb + bh * 64 * 64 + k;
        float s0 = 0.f, s1 = 0.f;
#pragma unroll 8
        for (int c = 0; c < 64; ++c) { const unsigned u = p[(size_t)c * 4096]; const float d = dp[c * 64];
            p[(size_t)c * 4096 + dofs] = pk2(s0, s1);
            s0 = d * s0 + bflo(u); s1 = d * s1 + bfhi(u); } }
}
struct GlaOutRegs { u32x4 us[2]; bf16x8 aq[2]; u32x2 oi[4]; u32x2 br[4]; };
__device__ __forceinline__ void gla_out_load(Frame& F, int unit, int tid, int w, int fr, int fq, GlaOutRegs& R) {
    const int b = unit >> 8, h = (unit >> 6) & 3, c = unit & 63; const size_t n0 = (size_t)b * SEQ + 64 * c;
    const GAS bf16* PA = (const GAS bf16*)(F.ws + WS_PA); const GAS bf16* Y = (const GAS bf16*)(F.ws + WS_Y);
    const GAS bf16* US = (const GAS bf16*)(F.ws + WS_US) + (size_t)unit * 8192;
    const int tr = w >> 1, nh = w & 1, row = 16 * tr + fr;
#pragma unroll
    for (int i = 0; i < 2; ++i) R.us[i] = *(const GAS u32x4*)(US + (tid + 512 * i) * 8);
#pragma unroll
    for (int ks = 0; ks < 2; ++ks) R.aq[ks] = *(const GAS bf16x8*)(PA + (n0 + row) * NPA + PA_BQ + h * 64 + 8 * fq + 32 * ks);
#pragma unroll
    for (int j = 0; j < 4; ++j) { const int v0 = 16 * (4 * nh + j) + 4 * fq; R.oi[j] = *(const GAS u32x2*)(Y + (n0 + row) * 1536 + 512 + h * 128 + v0); R.br[j] = *(const GAS u32x2*)(PA + (n0 + row) * NPA + PA_BR + h * 128 + v0); }
}
__device__ __forceinline__ void gla_out_compute(Frame& F, int l, int unit, int tid, int lane, int w, int fr, int fq, const GlaOutRegs& R, bool dry = false) {
    const int b = unit >> 8, h = (unit >> 6) & 3, c = unit & 63; const size_t n0 = (size_t)b * SEQ + 64 * c;
    GAS bf16* Y = dry ? (GAS bf16*)F.H : (GAS bf16*)(F.ws + WS_Y);
    LAS unsigned char* SS = F.lds;
    LAS float* PS = (LAS float*)(F.lds + 16384);
    const GAS float* gng = ((const GAS float*)F.in[8]) + l * 128;
#pragma unroll
    for (int i = 0; i < 2; ++i) *(LAS u32x4*)(SS + (tid + 512 * i) * 16) = R.us[i];
    __syncthreads();
    const int tr = w >> 1, nh = w & 1, row = 16 * tr + fr;
    f32x4 acc[4];
#pragma unroll
    for (int j = 0; j < 4; ++j) acc[j] = (f32x4){0.f, 0.f, 0.f, 0.f};
#pragma unroll
    for (int ks = 0; ks < 2; ++ks) { const int krow = 32 * ks + 8 * fq + (fr >> 2);
#pragma unroll
        for (int j = 0; j < 4; ++j) { const int nt = 4 * nh + j;
            const bf16x8 bs = cat8(ldtr(SS + krow * 256 + (16 * nt + 4 * (fr & 3)) * 2), ldtr(SS + (krow + 4) * 256 + (16 * nt + 4 * (fr & 3)) * 2));
            acc[j] = __builtin_amdgcn_mfma_f32_16x16x32_bf16(bs, R.aq[ks], acc[j], 0, 0, 0); } }
    float ss = 0.f;
#pragma unroll
    for (int j = 0; j < 4; ++j) { const u32x2 oi = R.oi[j];
        acc[j][0] += bflo(oi.x); acc[j][1] += bfhi(oi.x); acc[j][2] += bflo(oi.y); acc[j][3] += bfhi(oi.y);
        ss += (acc[j][0] * acc[j][0] + acc[j][1] * acc[j][1]) + (acc[j][2] * acc[j][2] + acc[j][3] * acc[j][3]); }
    ss += shx(ss, 16, lane); ss += shx(ss, 32, lane);
    if (fq == 0) PS[row * 2 + nh] = ss;
    __syncthreads();
    { const float rinv = 1.f / sqrtf((PS[row * 2] + PS[row * 2 + 1]) * (1.f / 128.f) + RMS_EPS);
#pragma unroll
      for (int j = 0; j < 4; ++j) { const int v0 = 16 * (4 * nh + j) + 4 * fq; const f32x4 gg = *(const GAS f32x4*)(gng + v0); const u32x2 br = R.br[j];
          u32x2 wv; wv.x = pk2(acc[j][0] * rinv * gg[0] * bflo(br.x), acc[j][1] * rinv * gg[1] * bfhi(br.x)); wv.y = pk2(acc[j][2] * rinv * gg[2] * bflo(br.y), acc[j][3] * rinv * gg[3] * bfhi(br.y));
          *(GAS u32x2*)(Y + (n0 + row) * 1536 + 512 + h * 128 + v0) = wv; } }
    __syncthreads();
}
constexpr int DSA_WAVE_LDS = 17920;
__device__ __forceinline__ void dsa_unit(Frame& F, int unit) {
    int lane = F.lane; asm volatile("" : "+v"(lane)); const int w = F.wave;
    const int qb = 4095 - unit;
    const int b = qb & 7, t = (qb >> 3) * 8 + w;
    const size_t n = (size_t)b * SEQ + t, nb0 = (size_t)b * SEQ;
    const GAS bf16* PA = (const GAS bf16*)(F.ws + WS_PA); GAS bf16* Y = (GAS bf16*)(F.ws + WS_Y);
    const GAS bf16* KI = (const GAS bf16*)(F.ws + WS_KI); const GAS bf16* KA = (const GAS bf16*)(F.ws + WS_KA); const GAS bf16* VA = (const GAS bf16*)(F.ws + WS_VA);
    const GAS float* WI = (const GAS float*)(F.ws + WS_WI);
    LAS unsigned char* base = F.lds + w * DSA_WAVE_LDS;
    LAS unsigned* sc = (LAS unsigned*)base;
    LAS float* qi = (LAS float*)(base + 16384);
    LAS unsigned short* list = (LAS unsigned short*)(base + 16384 + 1024);
    { const u32x2 q2 = *(const GAS u32x2*)(PA + n * NPA + PA_QI + 4 * lane);
      *(LAS f32x4*)(qi + 4 * lane) = (f32x4){bflo(q2.x), bfhi(q2.x), bflo(q2.y), bfhi(q2.y)}; }
    asm volatile("s_waitcnt lgkmcnt(0)" ::: "memory");
    const f32x4 wi = {ld_f32(WI + n * 4), ld_f32(WI + n * 4 + 1), ld_f32(WI + n * 4 + 2), ld_f32(WI + n * 4 + 3)};
    const int nbat = (t >> 6) + 1;
    for (int kb = 0; kb < nbat; ++kb) { const int key = kb * 64 + lane, kc = key <= t ? key : t;
        const GAS u32x4* kp = (const GAS u32x4*)(KI + (nb0 + kc) * 64);
        float kf[64];
#pragma unroll
        for (int c = 0; c < 8; ++c) { const u32x4 kk = kp[c]; kf[8 * c] = bflo(kk.x); kf[8 * c + 1] = bfhi(kk.x); kf[8 * c + 2] = bflo(kk.y); kf[8 * c + 3] = bfhi(kk.y); kf[8 * c + 4] = bflo(kk.z); kf[8 * c + 5] = bfhi(kk.z); kf[8 * c + 6] = bflo(kk.w); kf[8 * c + 7] = bfhi(kk.w); }
        float score = 0.f;
#pragma unroll
        for (int h = 0; h < 4; ++h) { float d = 0.f;
#pragma unroll
            for (int c = 0; c < 16; ++c) { const f32x4 q4 = *(const LAS f32x4*)(qi + h * 64 + 4 * c); d += q4.x * kf[4 * c] + q4.y * kf[4 * c + 1] + q4.z * kf[4 * c + 2] + q4.w * kf[4 * c + 3]; }
            score += wi[h] * fmaxf(d, 0.f); }
        if (score == 0.f) score = 0.f;
        unsigned u = __builtin_bit_cast(unsigned, score); u = (u & 0x80000000u) ? ~u : (u | 0x80000000u);
        sc[key] = key <= t ? u : 0u; }
    asm volatile("s_waitcnt lgkmcnt(0)" ::: "memory");
    int nsel;
    if (t >= 256) {
        unsigned T = 0u;
        for (int bit = 31; bit >= 0; --bit) { const unsigned cand = T | (1u << bit); int cnt = 0;
            for (int j = 0; j < nbat; ++j) cnt += (sc[j * 64 + lane] >= cand) ? 1 : 0;
            if (wave_sum_i(cnt, lane) >= 256) T = cand; }
        int cgt = 0;
        for (int j = 0; j < nbat; ++j) cgt += (sc[j * 64 + lane] > T) ? 1 : 0;
        const int need = 256 - wave_sum_i(cgt, lane);
        int selbase = 0, tiebase = 0;
        for (int j = 0; j < nbat; ++j) { const unsigned x = sc[j * 64 + lane]; const bool eq = (x == T), gt = (x > T);
            const unsigned long long beq = __ballot(eq); const unsigned long long lt = (1ull << lane) - 1ull;
            const int trank = tiebase + __popcll(beq & lt);
            const bool sel = gt || (eq && trank < need);
            const unsigned long long bsel = __ballot(sel);
            if (sel) list[selbase + __popcll(bsel & lt)] = (unsigned short)(j * 64 + lane);
            selbase += __popcll(bsel); tiebase += __popcll(beq); }
        nsel = 256;
    } else {
        nsel = t + 1;
        for (int i = lane; i < 256; i += 64) list[i] = (unsigned short)(i <= t ? i : 0);
    }
    asm volatile("s_waitcnt lgkmcnt(0)" ::: "memory");
    LAS float* qm = (LAS float*)base;
    LAS float* Pl = (LAS float*)(base + 2048);
    { const u32x4 q8 = *(const GAS u32x4*)(PA + n * NPA + PA_Q + 8 * lane);
      *(LAS f32x4*)(qm + 8 * lane) = (f32x4){bflo(q8.x), bfhi(q8.x), bflo(q8.y), bfhi(q8.y)}; *(LAS f32x4*)(qm + 8 * lane + 4) = (f32x4){bflo(q8.z), bfhi(q8.z), bflo(q8.w), bfhi(q8.w)}; }
    asm volatile("s_waitcnt lgkmcnt(0)" ::: "memory");
#pragma unroll 1
    for (int bb = 0; bb < 4; ++bb) { const int i = bb * 64 + lane; const bool valid = i < nsel; const int key = valid ? (int)list[i] : 0;
        const GAS u32x4* kp = (const GAS u32x4*)(KA + (nb0 + key) * 64);
        float kf[64];
#pragma unroll
        for (int c = 0; c < 8; ++c) { const u32x4 kk = kp[c]; kf[8 * c] = bflo(kk.x); kf[8 * c + 1] = bfhi(kk.x); kf[8 * c + 2] = bflo(kk.y); kf[8 * c + 3] = bfhi(kk.y); kf[8 * c + 4] = bflo(kk.z); kf[8 * c + 5] = bfhi(kk.z); kf[8 * c + 6] = bflo(kk.w); kf[8 * c + 7] = bfhi(kk.w); }
        float lgv[8];
#pragma unroll
        for (int h = 0; h < 8; ++h) { float d = 0.f;
#pragma unroll
            for (int c = 0; c < 16; ++c) { const f32x4 q4 = *(const LAS f32x4*)(qm + h * 64 + 4 * c); d += q4.x * kf[4 * c] + q4.y * kf[4 * c + 1] + q4.z * kf[4 * c + 2] + q4.w * kf[4 * c + 3]; }
            lgv[h] = valid ? d : -INFINITY; }
        *(LAS f32x4*)(Pl + i * 8) = (f32x4){lgv[0], lgv[1], lgv[2], lgv[3]}; *(LAS f32x4*)(Pl + i * 8 + 4) = (f32x4){lgv[4], lgv[5], lgv[6], lgv[7]}; }
    asm volatile("s_waitcnt lgkmcnt(0)" ::: "memory");
    float lg[4][8];
#pragma unroll
    for (int bb = 0; bb < 4; ++bb) { const f32x4 a = *(const LAS f32x4*)(Pl + (bb * 64 + lane) * 8), c = *(const LAS f32x4*)(Pl + (bb * 64 + lane) * 8 + 4);
        lg[bb][0] = a.x; lg[bb][1] = a.y; lg[bb][2] = a.z; lg[bb][3] = a.w; lg[bb][4] = c.x; lg[bb][5] = c.y; lg[bb][6] = c.z; lg[bb][7] = c.w; }
    float den[8];
#pragma unroll
    for (int h = 0; h < 8; ++h) { float m = fmaxf(fmaxf(lg[0][h], lg[1][h]), fmaxf(lg[2][h], lg[3][h])); m = wave_max(m, lane); float s = 0.f;
#pragma unroll
        for (int bb = 0; bb < 4; ++bb) { lg[bb][h] = __expf(lg[bb][h] - m); s += lg[bb][h]; }
        den[h] = wave_sum(s, lane); }
#pragma unroll
    for (int bb = 0; bb < 4; ++bb) { const int i = bb * 64 + lane;
        *(LAS f32x4*)(Pl + i * 8) = (f32x4){lg[bb][0], lg[bb][1], lg[bb][2], lg[bb][3]}; *(LAS f32x4*)(Pl + i * 8 + 4) = (f32x4){lg[bb][4], lg[bb][5], lg[bb][6], lg[bb][7]}; }
    asm volatile("s_waitcnt lgkmcnt(0)" ::: "memory");
    float o[8];
#pragma unroll
    for (int h = 0; h < 8; ++h) o[h] = 0.f;
#pragma unroll 4
    for (int i = 0; i < nsel; ++i) { const int key = (int)list[i]; const float vv = bf1(VA[(nb0 + key) * 64 + lane]);
        const f32x4 p0 = *(const LAS f32x4*)(Pl + i * 8), p1 = *(const LAS f32x4*)(Pl + i * 8 + 4);
        o[0] += p0.x * vv; o[1] += p0.y * vv; o[2] += p0.z * vv; o[3] += p0.w * vv; o[4] += p1.x * vv; o[5] += p1.y * vv; o[6] += p1.z * vv; o[7] += p1.w * vv; }
#pragma unroll
    for (int h = 0; h < 8; ++h) Y[n * 1536 + h * 64 + lane] = (bf16)f2bf(o[h] / den[h]);
}

__device__ __forceinline__ bf16x8 scale_pack8(u32x4 raw, float s) {
    u32x4 o; o.x = cvt_pk_bf16(bflo(raw.x) * s, bfhi(raw.x) * s); o.y = cvt_pk_bf16(bflo(raw.y) * s, bfhi(raw.y) * s); o.z = cvt_pk_bf16(bflo(raw.z) * s, bfhi(raw.z) * s); o.w = cvt_pk_bf16(bflo(raw.w) * s, bfhi(raw.w) * s);
    return __builtin_bit_cast(bf16x8, o);
}
__device__ __forceinline__ void dsa16_unit(Frame& F, int unit) {
    const int lane = fresh_lane(); const int w = F.wave;
    const int qb = 2047 - unit;
    const int b = qb & 7, t0 = (qb >> 3) * 16;
    const size_t nb0 = (size_t)b * SEQ;
    const GAS bf16* PA = (const GAS bf16*)(F.ws + WS_PA); GAS bf16* Y = (GAS bf16*)(F.ws + WS_Y);
    const GAS bf16* KI = (const GAS bf16*)(F.ws + WS_KI); const GAS bf16* KA = (const GAS bf16*)(F.ws + WS_KA); const GAS bf16* VA = (const GAS bf16*)(F.ws + WS_VA);
    const GAS float* WI = (const GAS float*)(F.ws + WS_WI);
    LAS unsigned char* K16 = F.lds;
    LAS unsigned short* LIST = (LAS unsigned short*)(F.lds + AUX_OFF);
    const int fr = lane & 15, fq = lane >> 4;
#ifdef REP_S1
    for (int rep_ = 0; rep_ < REP_S1; ++rep_)
#endif
    {
        const int ql = fr >> 2, h = fr & 3;
        bf16x8 Bf[4][2]; float Linf[4];
#pragma unroll
        for (int g = 0; g < 4; ++g) { const size_t nq = nb0 + t0 + 4 * g + ql; const float wv = WI[nq * 4 + h];
#pragma unroll
            for (int ks = 0; ks < 2; ++ks) Bf[g][ks] = scale_pack8(*(const GAS u32x4*)(PA + nq * NPA + PA_QI + h * 64 + 8 * fq + 32 * ks), wv);
            Linf[g] = (wv >= 0.f) ? INFINITY : -INFINITY; }
        const int ntiles = (t0 >> 4) + 1;
        bf16x8 A0[4], A1[4];
#pragma unroll
        for (int j = 0; j < 4; ++j) { const int tile = (w + 8 * j < ntiles) ? w + 8 * j : ntiles - 1; const size_t krow = (nb0 + 16 * tile + fr) * 64;
            A0[j] = *(const GAS bf16x8*)(KI + krow + 8 * fq); A1[j] = *(const GAS bf16x8*)(KI + krow + 32 + 8 * fq); }
#pragma unroll 1
        for (int tb = w; tb < ntiles; tb += 32) {
            bf16x8 N0[4], N1[4];
#pragma unroll
            for (int j = 0; j < 4; ++j) { const int tn = tb + 32 + 8 * j; const int tile = (tn < ntiles) ? tn : ntiles - 1; const size_t krow = (nb0 + 16 * tile + fr) * 64;
                N0[j] = *(const GAS bf16x8*)(KI + krow + 8 * fq); N1[j] = *(const GAS bf16x8*)(KI + krow + 32 + 8 * fq); }
#pragma unroll
            for (int j = 0; j < 4; ++j) { const int tile = tb + 8 * j;
                if (tile < ntiles) {
                    const int kpos = 16 * tile + 4 * fq + h;
                    const int g7 = kpos >> 7, hf = (kpos >> 6) & 1, ln = kpos & 63;
                    const int koff = (g7 >> 2) * 1024 + ln * 16 + (g7 & 3) * 4 + hf * 2;
                    const bool lastt = (tile == ntiles - 1);
                    f32x4 d[4];
#pragma unroll
                    for (int g = 0; g < 4; ++g) d[g] = __builtin_amdgcn_mfma_f32_16x16x32_bf16(A0[j], Bf[g][0], (f32x4){0.f, 0.f, 0.f, 0.f}, 0, 0, 0);
#pragma unroll
                    for (int g = 0; g < 4; ++g) d[g] = __builtin_amdgcn_mfma_f32_16x16x32_bf16(A1[j], Bf[g][1], d[g], 0, 0, 0);
#define S1_STEP(g) const float a0##g = __builtin_amdgcn_fmed3f(d[g][0], 0.f, Linf[g]), a1##g = __builtin_amdgcn_fmed3f(d[g][1], 0.f, Linf[g]), a2##g = __builtin_amdgcn_fmed3f(d[g][2], 0.f, Linf[g]), a3##g = __builtin_amdgcn_fmed3f(d[g][3], 0.f, Linf[g]);
                    S1_STEP(0) S1_STEP(1) S1_STEP(2) S1_STEP(3)
#undef S1_STEP
#define S1_STEP(g) const float u0##g = a0##g + dppf<0xB1>(a0##g), u1##g = a1##g + dppf<0xB1>(a1##g), u2##g = a2##g + dppf<0xB1>(a2##g), u3##g = a3##g + dppf<0xB1>(a3##g);
                    S1_STEP(0) S1_STEP(1) S1_STEP(2) S1_STEP(3)
#undef S1_STEP
#define S1_STEP(g) const float p0##g = (h & 1) ? u1##g : u0##g, p1##g = (h & 1) ? u3##g : u2##g;
                    S1_STEP(0) S1_STEP(1) S1_STEP(2) S1_STEP(3)
#undef S1_STEP
#define S1_STEP(g) const float c0##g = p0##g + dppf<0x4E>(p0##g), c1##g = p1##g + dppf<0x4E>(p1##g);
                    S1_STEP(0) S1_STEP(1) S1_STEP(2) S1_STEP(3)
#undef S1_STEP
#define S1_STEP(g) const float s##g = ((h & 2) ? c1##g : c0##g) + 0.0f; const _Float16 hh##g = (_Float16)s##g; const unsigned hb##g = (unsigned)__builtin_bit_cast(unsigned short, hh##g); \
                    unsigned key##g = hb##g ^ ((unsigned)((int)(hb##g << 16) >> 31) | 0x8000u); if (lastt) key##g = (kpos <= t0 + 4 * g + ql) ? key##g : 0u;
                    S1_STEP(0) S1_STEP(1) S1_STEP(2) S1_STEP(3)
#undef S1_STEP
#define S1_STEP(g) *(LAS unsigned short*)(K16 + (4 * g + ql) * 8192 + koff) = (unsigned short)key##g;
                    S1_STEP(0) S1_STEP(1) S1_STEP(2) S1_STEP(3)
#undef S1_STEP
                }
            }
#pragma unroll
            for (int j = 0; j < 4; ++j) { A0[j] = N0[j]; A1[j] = N1[j]; }
        }
    }
    __syncthreads();
    if (t0 < 256) {
#pragma unroll 1
        for (int qq = 0; qq < 2; ++qq) { const int q = 2 * w + qq, nvalid = t0 + q + 1; LAS unsigned short* list = LIST + q * 256;
            for (int i = lane; i < 256; i += 64) list[i] = (unsigned short)(i < nvalid ? i : 0); }
    } else {
#ifndef REP_S2
#define REP_S2 1
#endif
#pragma unroll 1
        for (int qq = 0; qq < 2 * REP_S2; ++qq) {
            const int q = 2 * w + (qq & 1), nvalid = t0 + q + 1;
            LAS unsigned short* list = LIST + q * 256;
            const int ngrp = (nvalid + 511) >> 9;
            unsigned P[32];
#pragma unroll
            for (int grp = 0; grp < 8; ++grp) {
                if (grp < ngrp) { const u32x4 r = *(const LAS u32x4*)(K16 + q * 8192 + grp * 1024 + lane * 16);
#pragma unroll
                    for (int i = 0; i < 4; ++i) { const int g = 4 * grp + i; const int thr = nvalid - 128 * g; unsigned rr = r[i];
                        if (thr < 128) rr &= ((lane < thr) ? 0xffffu : 0u) | ((lane < thr - 64) ? 0xffff0000u : 0u);
                        P[g] = rr; }
                } else {
#pragma unroll
                    for (int i = 0; i < 4; ++i) P[4 * grp + i] = 0u;
                }
            }
            unsigned one2 = 0x00010001u; asm volatile("" : "+v"(one2));
#define DSA_PKCOUNT(dst, c1) do { const unsigned c1p_ = (c1) | ((c1) << 16); unsigned a_ = 0u; \
                _Pragma("unroll") for (int grp = 0; grp < 8; ++grp) if (grp < ngrp) { _Pragma("unroll") for (int i = 0; i < 4; ++i) { unsigned y_; \
                    asm("v_pk_sub_u16 %0, %1, %2 clamp\n\tv_pk_min_u16 %0, %0, %3" : "=&v"(y_) : "v"(P[4 * grp + i]), "v"(c1p_), "v"(one2)); a_ += y_; } } \
                dst = (int)((a_ & 0xffffu) + (a_ >> 16)); } while (0)
            LAS unsigned* hist = (LAS unsigned*)(F.lds + AUX_OFF + 8192) + w * 512;
            LAS unsigned* histl = hist + (lane & 1) * 256;
            unsigned T; int tot_gt;
            { unsigned hi8 = 0u; int above = 0;
#pragma unroll
              for (int lvl = 0; lvl < 2; ++lvl) {
                  { unsigned z_ = 0u; asm volatile("" : "+v"(z_)); *(LAS u32x4*)(hist + 4 * lane) = (u32x4){z_, z_, z_, z_}; *(LAS u32x4*)(hist + 256 + 4 * lane) = (u32x4){z_, z_, z_, z_}; }
                  asm volatile("s_waitcnt lgkmcnt(0)" ::: "memory");
#pragma unroll
                  for (int grp = 0; grp < 8; ++grp) if (grp < ngrp) {
#pragma unroll
                      for (int i = 0; i < 4; ++i) { const unsigned lo = P[4 * grp + i] & 0xffffu, hi = P[4 * grp + i] >> 16;
                          if (lvl == 0) { __hip_atomic_fetch_add(histl + (lo >> 8), 1u, __ATOMIC_RELAXED, __HIP_MEMORY_SCOPE_WAVEFRONT); __hip_atomic_fetch_add(histl + (hi >> 8), 1u, __ATOMIC_RELAXED, __HIP_MEMORY_SCOPE_WAVEFRONT); }
                          else { if ((lo >> 8) == hi8) __hip_atomic_fetch_add(histl + (lo & 0xffu), 1u, __ATOMIC_RELAXED, __HIP_MEMORY_SCOPE_WAVEFRONT);
                                 if ((hi >> 8) == hi8) __hip_atomic_fetch_add(histl + (hi & 0xffu), 1u, __ATOMIC_RELAXED, __HIP_MEMORY_SCOPE_WAVEFRONT); } } }
                  asm volatile("s_waitcnt lgkmcnt(0)" ::: "memory");
                  const u32x4 hb = *(const LAS u32x4*)(hist + 4 * lane) + *(const LAS u32x4*)(hist + 256 + 4 * lane);
                  const int sl = (int)(hb.x + hb.y + hb.z + hb.w);
                  int inc = sl;
                  inc += __builtin_amdgcn_update_dpp(0, inc, 0x111, 0xf, 0xf, false); inc += __builtin_amdgcn_update_dpp(0, inc, 0x112, 0xf, 0xf, false);
                  inc += __builtin_amdgcn_update_dpp(0, inc, 0x114, 0xf, 0xf, false); inc += __builtin_amdgcn_update_dpp(0, inc, 0x118, 0xf, 0xf, false);
                  const int r0 = __builtin_amdgcn_readlane(inc, 15), r1 = __builtin_amdgcn_readlane(inc, 31), r2 = __builtin_amdgcn_readlane(inc, 47), r3 = __builtin_amdgcn_readlane(inc, 63);
                  inc += (fq >= 1 ? r0 : 0) + (fq >= 2 ? r1 : 0) + (fq >= 3 ? r2 : 0);
                  const int total = r0 + r1 + r2 + r3;
                  const int want = 256 - above;
                  int run = total - inc;
                  int fb = -1, fa = 0;
                  { const int h3 = (int)hb.w, h2 = (int)hb.z, h1 = (int)hb.y, h0 = (int)hb.x;
                    if (run < want && run + h3 >= want) { fb = 3; fa = run; } run += h3;
                    if (run < want && run + h2 >= want) { fb = 2; fa = run; } run += h2;
                    if (run < want && run + h1 >= want) { fb = 1; fa = run; } run += h1;
                    if (run < want && run + h0 >= want) { fb = 0; fa = run; } }
                  const unsigned long long fm = __ballot(fb >= 0);
                  const int src = (int)__builtin_ctzll(fm);
                  const int bstar = __builtin_amdgcn_readlane(4 * lane + fb, src), abv = __builtin_amdgcn_readlane(fa, src);
                  if (lvl == 0) { hi8 = (unsigned)bstar; above = abv; } else { T = (hi8 << 8) | (unsigned)bstar; tot_gt = above + abv; }
              } }
            int cge_l, cgt_l; DSA_PKCOUNT(cge_l, T - 1u); DSA_PKCOUNT(cgt_l, T);
            const int tot_ge = wave_total_i(cge_l);
            const bool alltie = (tot_ge == 256);
            const int c_l = alltie ? cge_l : cgt_l; const unsigned thrT = alltie ? T : T + 1u;
            int inc = c_l;
            inc += __builtin_amdgcn_update_dpp(0, inc, 0x111, 0xf, 0xf, false); inc += __builtin_amdgcn_update_dpp(0, inc, 0x112, 0xf, 0xf, false);
            inc += __builtin_amdgcn_update_dpp(0, inc, 0x114, 0xf, 0xf, false); inc += __builtin_amdgcn_update_dpp(0, inc, 0x118, 0xf, 0xf, false);
            { const int r0 = __builtin_amdgcn_readlane(inc, 15), r1 = __builtin_amdgcn_readlane(inc, 31), r2 = __builtin_amdgcn_readlane(inc, 47);
              inc += (fq >= 1 ? r0 : 0) + (fq >= 2 ? r1 : 0) + (fq >= 3 ? r2 : 0); }
            int kpos_ = inc - c_l;
#pragma unroll
            for (int grp = 0; grp < 8; ++grp) if (grp < ngrp) {
#pragma unroll
                for (int i = 0; i < 4; ++i) { const int g = 4 * grp + i; const unsigned lo = P[g] & 0xffffu, hi = P[g] >> 16;
                    if (lo >= thrT) { list[kpos_] = (unsigned short)(128 * g + lane); ++kpos_; }
                    if (hi >= thrT) { list[kpos_] = (unsigned short)(128 * g + 64 + lane); ++kpos_; } } }
            if (!alltie) {
                int rem = 256 - tot_gt, pos = tot_gt; const unsigned long long lt = (1ull << lane) - 1ull;
#pragma unroll
                for (int grp = 0; grp < 8; ++grp) if (grp < ngrp) {
#pragma unroll
                    for (int i = 0; i < 8; ++i) { const int g = 4 * grp + (i >> 1); const unsigned val = (i & 1) ? (P[g] >> 16) : (P[g] & 0xffffu);
                        const bool eq = (val == T); const unsigned long long beq = __ballot(eq);
                        if (beq != 0ull) { const int rank = __popcll(beq & lt); if (eq && rank < rem) list[pos + rank] = (unsigned short)(128 * g + 64 * (i & 1) + lane);
                            const int n = __popcll(beq), take = n < rem ? n : rem; pos += take; rem -= take; } } }
            }
#undef DSA_PKCOUNT
        }
    }
    asm volatile("s_waitcnt lgkmcnt(0)" ::: "memory");
    LAS unsigned char* Vs = F.lds + w * 16384;
#ifndef REP_S3
#define REP_S3 1
#endif
#pragma unroll 1
    for (int qq = 0; qq < 2 * REP_S3; ++qq) {
        const int q = 2 * w + (qq & 1), tq = t0 + q; const int nsel = (tq + 1 < 256) ? tq + 1 : 256;
        const size_t nq = nb0 + tq;
        const LAS unsigned short* list = LIST + q * 256;
        bf16x8 Qf[2];
#pragma unroll
        for (int ks = 0; ks < 2; ++ks) { u32x4 raw = {0u, 0u, 0u, 0u}; if (fr < 8) raw = *(const GAS u32x4*)(PA + nq * NPA + PA_Q + fr * 64 + 8 * fq + 32 * ks); Qf[ks] = __builtin_bit_cast(bf16x8, raw); }
        float lg[16][4];
#ifdef REP_S3K
#pragma unroll 1
        for (int repk = 0; repk < REP_S3K; ++repk)
#endif
        const int st_off = (lane >> 3) * 128 + (((lane & 7) ^ ((lane >> 3) & 7)) * 16);
        const int rd0 = fr * 128 + ((fq ^ (fr & 7)) * 16), rd1 = fr * 128 + (((fq + 4) ^ (fr & 7)) * 16);
#pragma unroll
        for (int hb = 0; hb < 2; ++hb) {
#pragma unroll
            for (int ib = 0; ib < 2; ++ib) { u32x4 kv[8];
#pragma unroll
                for (int i = 0; i < 8; ++i) { const int piece = (8 * ib + i) * 64 + lane; const int key = (int)list[128 * hb + (piece >> 3)];
                    kv[i] = *(const GAS u32x4*)(KA + (nb0 + key) * 64 + 8 * (lane & 7)); }
                __builtin_amdgcn_sched_barrier(0);
#pragma unroll
                for (int i = 0; i < 8; ++i) *(LAS u32x4*)(Vs + st_off + (8 * ib + i) * 1024) = kv[i];
            }
            asm volatile("s_waitcnt lgkmcnt(0)" ::: "memory");
#pragma unroll
            for (int j = 0; j < 8; ++j) { const int tt = 8 * hb + j;
                const bf16x8 A0 = *(const LAS bf16x8*)(Vs + rd0 + j * 2048), A1 = *(const LAS bf16x8*)(Vs + rd1 + j * 2048);
                f32x4 d = __builtin_amdgcn_mfma_f32_16x16x32_bf16(A0, Qf[0], (f32x4){0.f, 0.f, 0.f, 0.f}, 0, 0, 0);
                d = __builtin_amdgcn_mfma_f32_16x16x32_bf16(A1, Qf[1], d, 0, 0, 0);
#pragma unroll
                for (int r = 0; r < 4; ++r) lg[tt][r] = (16 * tt + 4 * fq + r < nsel) ? d[r] : -INFINITY; }
            asm volatile("s_waitcnt lgkmcnt(0)" ::: "memory");
        }
        float m = lg[0][0];
#pragma unroll
        for (int tt = 0; tt < 16; ++tt)
#pragma unroll
            for (int r = 0; r < 4; ++r) m = fmaxf(m, lg[tt][r]);
        m = fmaxf(m, shx(m, 16, lane)); m = fmaxf(m, shx(m, 32, lane));
        float den = 0.f;
#pragma unroll
        for (int tt = 0; tt < 16; ++tt)
#pragma unroll
            for (int r = 0; r < 4; ++r) { lg[tt][r] = __expf(lg[tt][r] - m); den += lg[tt][r]; }
        den += shx(den, 16, lane); den += shx(den, 32, lane);
        f32x4 acc[4];
#pragma unroll
        for (int nt = 0; nt < 4; ++nt) acc[nt] = (f32x4){0.f, 0.f, 0.f, 0.f};
#ifdef REP_S3V
#pragma unroll 1
        for (int repv = 0; repv < REP_S3V; ++repv) {
#pragma unroll
        for (int nt = 0; nt < 4; ++nt) acc[nt] = (f32x4){0.f, 0.f, 0.f, 0.f};
#endif
#pragma unroll
        for (int hh = 0; hh < 2; ++hh) {
#pragma unroll
            for (int ib = 0; ib < 2; ++ib) {
                u32x4 vv[8];
#pragma unroll
                for (int i = 0; i < 8; ++i) { const int piece = (8 * ib + i) * 64 + lane, row = piece >> 3, c = piece & 7; const int key = (int)list[128 * hh + row];
                    vv[i] = *(const GAS u32x4*)(VA + (nb0 + key) * 64 + 8 * c); }
                __builtin_amdgcn_sched_barrier(0);
#pragma unroll
                for (int i = 0; i < 8; ++i) { const int piece = (8 * ib + i) * 64 + lane; *(LAS u32x4*)(Vs + piece * 16) = vv[i]; }
            }
            asm volatile("s_waitcnt lgkmcnt(0)" ::: "memory");
#pragma unroll
            for (int s4 = 0; s4 < 4; ++s4) { const int s = 4 * hh + s4;
                u32x4 pa; pa.x = cvt_pk_bf16(lg[2 * s][0], lg[2 * s][1]); pa.y = cvt_pk_bf16(lg[2 * s][2], lg[2 * s][3]); pa.z = cvt_pk_bf16(lg[2 * s + 1][0], lg[2 * s + 1][1]); pa.w = cvt_pk_bf16(lg[2 * s + 1][2], lg[2 * s + 1][3]);
                const bf16x8 Pa = __builtin_bit_cast(bf16x8, pa);
                const int rowa = 32 * s4 + 4 * fq + (fr >> 2);
#pragma unroll
                for (int nt = 0; nt < 4; ++nt) {
                    const v4i16_t lo = __builtin_amdgcn_ds_read_tr16_b64_v4i16((LAS v4i16_t*)(Vs + rowa * 128 + (16 * nt + 4 * (fr & 3)) * 2));
                    const v4i16_t hi = __builtin_amdgcn_ds_read_tr16_b64_v4i16((LAS v4i16_t*)(Vs + (rowa + 16) * 128 + (16 * nt + 4 * (fr & 3)) * 2));
                    bf16x8 Bv; Bv[0] = lo[0]; Bv[1] = lo[1]; Bv[2] = lo[2]; Bv[3] = lo[3]; Bv[4] = hi[0]; Bv[5] = hi[1]; Bv[6] = hi[2]; Bv[7] = hi[3];
                    acc[nt] = __builtin_amdgcn_mfma_f32_16x16x32_bf16(Bv, Pa, acc[nt], 0, 0, 0); } }
            asm volatile("s_waitcnt lgkmcnt(0)" ::: "memory");
        }
#ifdef REP_S3V
        }
#endif
        if (fr < 8) { const float rden = 1.f / den;
#pragma unroll
            for (int nt = 0; nt < 4; ++nt) { u32x2 wv; wv.x = pk2(acc[nt][0] * rden, acc[nt][1] * rden); wv.y = pk2(acc[nt][2] * rden, acc[nt][3] * rden);
                *(GAS u32x2*)(Y + nq * 1536 + fr * 64 + 16 * nt + 4 * fq) = wv; } }
    }
}

#ifdef GLA_NAIVE
constexpr int NGLA = 32;
#else
constexpr int NGLA = 2048;
#endif
#ifdef DSA_NAIVE
constexpr int NDSA = 4096;
#else
constexpr int NDSA = 2048;
#endif
#ifdef GMLP_NAIVE
constexpr int NGM = 1024;
#else
constexpr int NGM = 256;
#endif
__device__ __forceinline__ void phase_mixer(Frame& F, int l, int slot = 0, int types = 7, bool dry = false) {
    (void)slot;
    for (int j = 0; j * F.G < NDSA; ++j) { const int u = j * F.G + ((j & 1) ? (F.G - 1 - F.wg) : F.wg);
        if (u >= NDSA) continue;
        __syncthreads(); if (EN_B2 && (types & 2)) {
#ifdef DSA_NAIVE
        dsa_unit(F, u);
#else
        dsa16_unit(F, u);
#endif
    } }
    for (int u = F.wg; u < NGLA; u += F.G) { __syncthreads(); if (EN_B1 && (types & 1)) {
#ifdef GLA_NAIVE
        gla_unit(F, l, u);
#else
        gla_local_unit(F, l, u, dry);
#endif
    } }
    for (int u = F.wg; u < NGM; u += F.G) { __syncthreads(); if (EN_B3 && (types & 4)) {
#ifdef GMLP_NAIVE
        gmlp_unit(F, l, u);
#else
        gmlp16_unit(F, l, u);
#endif
    } }
}
__device__ __forceinline__ void phase_gla_out(Frame& F, int l, bool dry = false) {
#ifndef GLA_NAIVE
    const int lane = fresh_lane(), w = F.wave, tid = w * 64 + lane, fr = lane & 15, fq = lane >> 4;
    GlaOutRegs R, N;
    if (F.wg < 2048) gla_out_load(F, F.wg, tid, w, fr, fq, R);
#pragma unroll 1
    for (int u = F.wg; u < 2048; u += F.G) { const int un = (u + F.G < 2048) ? u + F.G : u;
        gla_out_load(F, un, tid, w, fr, fq, N);
        gla_out_compute(F, l, u, tid, lane, w, fr, fq, R, dry);
        R = N; }
#endif
}

template <int CTRL> __device__ __forceinline__ float dpp_add(float v) { return v + dppf<CTRL>(v); }
__device__ __forceinline__ float row16_sum(float v) { v = dpp_add<0xB1>(v); v = dpp_add<0x4E>(v); v = dpp_add<0x141>(v); v = dpp_add<0x140>(v); return v; }
__device__ __forceinline__ void phase_ln_router(Frame& F, int l) {
    const GAS bf16* WRB = (const GAS bf16*)(F.ws + WS_WR) + (size_t)l * 48 * DM;
    LAS unsigned char* WB = F.lds;
    for (int i = F.tid; i < 48 * 128; i += 512) { const int n = i >> 7, c = i & 127; *(LAS u32x4*)(WB + n * 2048 + ((c ^ (n & 7)) * 16)) = *(const GAS u32x4*)(WRB + n * DM + 8 * c); }
    if (F.tid < 32) F.MISC[16 + F.tid] = 0u;
    __syncthreads();
    GAS bf16* HB = (GAS bf16*)(F.ws + WS_HB); const GAS bf16* T = (const GAS bf16*)F.H; GAS int* EID = (GAS int*)(F.ws + WS_ROUTE); GAS float* EW = (GAS float*)(F.ws + WS_ROUTE + 256 * 1024);
    const GAS float* g = ((const GAS float*)F.in[17]) + l * DM; const GAS float* bb = ((const GAS float*)F.in[18]) + l * DM; const GAS float* brg = ((const GAS float*)F.in[20]) + l * 4; const GAS float* bre = ((const GAS float*)F.in[22]) + l * 32;
    const int lane = fresh_lane();
    const int sub = lane & 15, rr = lane >> 4, fr = sub, fq = rr;
    LAS float* LG = (LAS float*)(F.lds + 98304) + F.wave * 768;
    for (int r0 = F.wg * 128; r0 < NTOK; r0 += F.G * 128) {
        const int m0 = r0 + F.wave * 16;
        u32x4 nx[8];
#pragma unroll
        for (int q = 0; q < 8; ++q) nx[q] = *(const GAS u32x4*)(T + (size_t)(m0 + rr) * DM + 8 * (sub + 16 * q));
#pragma unroll 1
        for (int j = 0; j < 4; ++j) { const int m = m0 + 4 * j + rr;
            float v[64]; float s = 0.f;
#pragma unroll
            for (int q = 0; q < 8; ++q) { const u32x4 x = nx[q]; v[8 * q] = bflo(x.x); v[8 * q + 1] = bfhi(x.x); v[8 * q + 2] = bflo(x.y); v[8 * q + 3] = bfhi(x.y); v[8 * q + 4] = bflo(x.z); v[8 * q + 5] = bfhi(x.z); v[8 * q + 6] = bflo(x.w); v[8 * q + 7] = bfhi(x.w); }
            { const int mn = (j < 3) ? m + 4 : m;
#pragma unroll
              for (int q = 0; q < 8; ++q) nx[q] = *(const GAS u32x4*)(T + (size_t)mn * DM + 8 * (sub + 16 * q)); }
#pragma unroll
            for (int i = 0; i < 64; ++i) s += v[i];
            const float mean = row16_sum(s) * (1.f / DM); float s2 = 0.f;
#pragma unroll
            for (int i = 0; i < 64; ++i) { v[i] -= mean; s2 += v[i] * v[i]; }
            const float rstd = 1.f / sqrtf(row16_sum(s2) * (1.f / DM) + LN_EPS);
#pragma unroll
            for (int q = 0; q < 8; ++q) { const int c = 8 * (sub + 16 * q); const f32x4 g0 = *(const GAS f32x4*)(g + c), g1 = *(const GAS f32x4*)(g + c + 4), b0 = *(const GAS f32x4*)(bb + c), b1 = *(const GAS f32x4*)(bb + c + 4);
#pragma unroll
                for (int i = 0; i < 4; ++i) { v[8 * q + i] = v[8 * q + i] * rstd * g0[i] + b0[i]; v[8 * q + 4 + i] = v[8 * q + 4 + i] * rstd * g1[i] + b1[i]; }
                u32x4 wv; wv.x = pk2(v[8 * q], v[8 * q + 1]); wv.y = pk2(v[8 * q + 2], v[8 * q + 3]); wv.z = pk2(v[8 * q + 4], v[8 * q + 5]); wv.w = pk2(v[8 * q + 6], v[8 * q + 7]);
                *(GAS u32x4*)(HB + (size_t)m * DM + c) = wv; } }
        asm volatile("s_waitcnt vmcnt(0)" ::: "memory");
        f32x4 acc[3];
#pragma unroll
        for (int nt = 0; nt < 3; ++nt) acc[nt] = (f32x4){0.f, 0.f, 0.f, 0.f};
#pragma unroll 1
        for (int kb = 0; kb < 4; ++kb) {
            bf16x8 af[8];
#pragma unroll
            for (int ks = 0; ks < 8; ++ks) af[ks] = *(const GAS bf16x8*)(HB + (size_t)(m0 + fr) * DM + 8 * fq + 32 * (8 * kb + ks));
#pragma unroll
            for (int ks = 0; ks < 8; ++ks) { const int c = fq + 4 * (8 * kb + ks);
#pragma unroll
                for (int nt = 0; nt < 3; ++nt) { const int n = 16 * nt + fr; const bf16x8 bw = *(const LAS bf16x8*)(WB + n * 2048 + ((c ^ (n & 7)) * 16));
                    acc[nt] = __builtin_amdgcn_mfma_f32_16x16x32_bf16(af[ks], bw, acc[nt], 0, 0, 0); } } }
#pragma unroll
        for (int nt = 0; nt < 3; ++nt)
#pragma unroll
            for (int r = 0; r < 4; ++r) LG[(4 * fq + r) * 48 + 16 * nt + fr] = acc[nt][r];
        asm volatile("s_waitcnt lgkmcnt(0)" ::: "memory");
        if (lane < 16) { const int m = m0 + lane; const LAS float* lgt = LG + lane * 48;
            int gi = 0; float gm = lgt[0] + brg[0];
#pragma unroll
            for (int q = 1; q < 4; ++q) { const float x = lgt[q] + brg[q]; if (x > gm) { gm = x; gi = q; } }
            float gs = 0.f;
#pragma unroll
            for (int q = 0; q < 4; ++q) gs += __expf(lgt[q] + brg[q] - gm);
            const float gp = 1.f / gs;
            float el[8];
#pragma unroll
            for (int q = 0; q < 8; ++q) el[q] = lgt[4 + 8 * gi + q] + bre[8 * gi + q];
            int i0 = 0; float v0 = el[0];
#pragma unroll
            for (int q = 1; q < 8; ++q) if (el[q] > v0) { v0 = el[q]; i0 = q; }
            int i1 = -1; float v1 = -INFINITY;
#pragma unroll
            for (int q = 0; q < 8; ++q) if (q != i0 && el[q] > v1) { v1 = el[q]; i1 = q; }
            const float ex = __expf(v1 - v0), w0 = gp / (1.f + ex), w1 = gp * ex / (1.f + ex);
            const int e0 = gi * 8 + i0, e1 = gi * 8 + i1;
            EID[2 * m] = e0; EID[2 * m + 1] = e1; EW[2 * m] = w0; EW[2 * m + 1] = w1;
            __hip_atomic_fetch_add((LAS unsigned*)(F.lds + MISC_OFF) + 16 + e0, 1u, __ATOMIC_RELAXED, __HIP_MEMORY_SCOPE_WORKGROUP);
            __hip_atomic_fetch_add((LAS unsigned*)(F.lds + MISC_OFF) + 16 + e1, 1u, __ATOMIC_RELAXED, __HIP_MEMORY_SCOPE_WORKGROUP); }
        asm volatile("s_waitcnt lgkmcnt(0)" ::: "memory");
    }
    __syncthreads();
    if (F.tid < 32) ((GAS int*)(F.ws + WS_CNTWG))[F.wg * 32 + F.tid] = (int)F.MISC[16 + F.tid];
}
__device__ __forceinline__ void phase_dispatch(Frame& F) {
    const GAS int* CNT = (const GAS int*)(F.ws + WS_CNTWG); const GAS int* EID = (const GAS int*)(F.ws + WS_ROUTE); const GAS float* EW = (const GAS float*)(F.ws + WS_ROUTE + 256 * 1024);
    GAS int* SROW = (GAS int*)(F.ws + WS_SROW); GAS int* ROWMAP = (GAS int*)(F.ws + WS_ROWMAP); GAS float* CWROW = (GAS float*)(F.ws + WS_CWROW); GAS int* META = (GAS int*)(F.ws + WS_META);
    LAS int* tot = (LAS int*)(F.lds + AUX_OFF);
    { const int e = F.tid & 31, part = F.tid >> 5; int t = 0, mine = 0;
      int cv[16];
#pragma unroll
      for (int j = 0; j < 16; ++j) { const int w = part * 16 + j; cv[j] = (w < F.G) ? ld_i32(CNT + w * 32 + e) : 0; }
#pragma unroll
      for (int j = 0; j < 16; ++j) { const int w = part * 16 + j; t += cv[j]; mine += (w < F.wg) ? cv[j] : 0; }
      tot[160 + F.tid] = t; tot[160 + 512 + F.tid] = mine; }
    __syncthreads();
    if (F.tid < 32) { int t = 0, mine = 0;
#pragma unroll
        for (int p = 0; p < 16; ++p) { t += tot[160 + p * 32 + F.tid]; mine += tot[160 + 512 + p * 32 + F.tid]; }
        tot[F.tid] = t; tot[32 + F.tid] = mine; tot[96 + F.tid] = 0; }
    __syncthreads();
    if (F.tid == 0) { int rb = 0;
#pragma clang loop unroll(disable) vectorize(disable)
        for (int e = 0; e < 32; ++e) { tot[64 + e] = rb; rb += ((tot[e] + 255) >> 8) << 8; }
        tot[128] = rb; }
    __syncthreads();
    if (F.wg == 0) { const int nt = tot[128] >> 8; if (F.tid == 0) META[0] = nt;
        if (F.tid < nt) { int e = 0;
#pragma clang loop unroll(disable) vectorize(disable)
            for (int q = 1; q < 32; ++q) if (tot[64 + q] <= F.tid * 256) e = q;
            META[16 + F.tid] = e; } }
    for (int r0 = F.wg * 128; r0 < NTOK; r0 += F.G * 128) {
        if (F.tid < 256) { const int tok = r0 + (F.tid >> 1), slot = F.tid & 1; const int e = EID[2 * tok + slot];
            const int pos = (int)__hip_atomic_fetch_add((LAS unsigned*)&tot[96 + e], 1u, __ATOMIC_RELAXED, __HIP_MEMORY_SCOPE_WORKGROUP);
            const int sr = tot[64 + e] + tot[32 + e] + pos;
            ROWMAP[sr] = tok; CWROW[sr] = EW[2 * tok + slot]; SROW[2 * tok + slot] = sr; } }
    if (F.wg < 32) { const int e = F.wg; const int lo = tot[64 + e] + tot[e], hi = tot[64 + e] + (((tot[e] + 255) >> 8) << 8);
        for (int r = lo + F.tid; r < hi; r += 512) { ROWMAP[r] = 0; CWROW[r] = 0.f; } }
}
__device__ __forceinline__ void phase_ln2(Frame& F, int l, bool dry = false) {
    GAS bf16* HB = (GAS bf16*)(F.ws + WS_HB); GAS bf16* HBo = dry ? (GAS bf16*)(F.ws + WS_Y) : HB; GAS float* Ho = dry ? (GAS float*)(F.ws + WS_PA + 184 * MiB) : F.H; const GAS int* SROW = (const GAS int*)(F.ws + WS_SROW); const GAS bf16* FF2 = (const GAS bf16*)(F.ws + WS_FF2);
    const GAS float* g = ((const GAS float*)F.in[26]) + l * DM; const GAS float* bb = ((const GAS float*)F.in[27]) + l * DM; int lane = F.lane; asm volatile("" : "+v"(lane));
    const int gw = F.wg * 8 + F.wave, NGW = F.G * 8; const bool last = (l == DEPTH - 1);
    const int nrow = (NTOK - gw + NGW - 1) / NGW;
    const int srv = (2 * (gw + (lane >> 1) * NGW) + (lane & 1) < 2 * NTOK) ? ld_i32(SROW + 2 * (gw + (lane >> 1) * NGW) + (lane & 1)) : 0;
    u32x4 hn[2][2], an[2][2], cn[2][2];
#define LN2_ISSUE(jj, slot) do { const int j_ = (jj); if (j_ < nrow) { const int m_ = gw + j_ * NGW; const int s0_ = __builtin_amdgcn_readlane(srv, 2 * j_), s1_ = __builtin_amdgcn_readlane(srv, 2 * j_ + 1); \
        _Pragma("unroll") for (int q_ = 0; q_ < 2; ++q_) { hn[slot][q_] = *(const GAS u32x4*)(HB + (size_t)m_ * DM + 8 * lane + 512 * q_); an[slot][q_] = *(const GAS u32x4*)(FF2 + (size_t)s0_ * DM + 8 * lane + 512 * q_); cn[slot][q_] = *(const GAS u32x4*)(FF2 + (size_t)s1_ * DM + 8 * lane + 512 * q_); } } } while (0)
    LN2_ISSUE(0, 0); LN2_ISSUE(1, 1);
#pragma unroll 1
    for (int jr = 0; jr < nrow; jr += 2)
#pragma unroll
    for (int slot = 0; slot < 2; ++slot) { const int jrow = jr + slot; if (jrow >= nrow) break; const int m = gw + jrow * NGW;
        float v[16];
#pragma unroll
        for (int j = 0; j < 2; ++j) { const u32x4 h = hn[slot][j], a = an[slot][j], c = cn[slot][j];
            v[8 * j] = bflo(h.x) * DN_ALPHA + (bflo(a.x) + bflo(c.x)); v[8 * j + 1] = bfhi(h.x) * DN_ALPHA + (bfhi(a.x) + bfhi(c.x)); v[8 * j + 2] = bflo(h.y) * DN_ALPHA + (bflo(a.y) + bflo(c.y)); v[8 * j + 3] = bfhi(h.y) * DN_ALPHA + (bfhi(a.y) + bfhi(c.y));
            v[8 * j + 4] = bflo(h.z) * DN_ALPHA + (bflo(a.z) + bflo(c.z)); v[8 * j + 5] = bfhi(h.z) * DN_ALPHA + (bfhi(a.z) + bfhi(c.z)); v[8 * j + 6] = bflo(h.w) * DN_ALPHA + (bflo(a.w) + bflo(c.w)); v[8 * j + 7] = bfhi(h.w) * DN_ALPHA + (bfhi(a.w) + bfhi(c.w)); }
        LN2_ISSUE(jrow + 2, slot);
        float s = 0.f;
#pragma unroll
        for (int i = 0; i < 16; ++i) s += v[i];
        const float mean = wave_sum(s, lane) * (1.f / DM); float s2 = 0.f;
#pragma unroll
        for (int i = 0; i < 16; ++i) { v[i] -= mean; s2 += v[i] * v[i]; }
        const float rstd = 1.f / sqrtf(wave_sum(s2, lane) * (1.f / DM) + LN_EPS);
#pragma unroll
        for (int j = 0; j < 2; ++j) { const int c = 8 * lane + 512 * j; const f32x4 g0 = *(const GAS f32x4*)(g + c), g1 = *(const GAS f32x4*)(g + c + 4), b0 = *(const GAS f32x4*)(bb + c), b1 = *(const GAS f32x4*)(bb + c + 4);
#pragma unroll
            for (int i = 0; i < 4; ++i) { v[8 * j + i] = v[8 * j + i] * rstd * g0[i] + b0[i]; v[8 * j + 4 + i] = v[8 * j + 4 + i] * rstd * g1[i] + b1[i]; }
            if (last) { *(GAS f32x4*)(Ho + (size_t)m * DM + c) = (f32x4){v[8 * j], v[8 * j + 1], v[8 * j + 2], v[8 * j + 3]}; *(GAS f32x4*)(Ho + (size_t)m * DM + c + 4) = (f32x4){v[8 * j + 4], v[8 * j + 5], v[8 * j + 6], v[8 * j + 7]}; }
            else { u32x4 wv; wv.x = pk2(v[8 * j], v[8 * j + 1]); wv.y = pk2(v[8 * j + 2], v[8 * j + 3]); wv.z = pk2(v[8 * j + 4], v[8 * j + 5]); wv.w = pk2(v[8 * j + 6], v[8 * j + 7]); *(GAS u32x4*)(HBo + (size_t)m * DM + c) = wv; } }
    }
#undef LN2_ISSUE
}

#ifndef EN_P
#define EN_P 1
#endif
#ifndef EN_A
#define EN_A 1
#endif
#ifndef EN_B
#define EN_B 1
#endif
#ifndef EN_C
#define EN_C 1
#endif
#ifndef EN_D
#define EN_D 1
#endif
#ifndef EN_E
#define EN_E 1
#endif
#ifndef EN_F
#define EN_F 1
#endif
#ifndef EN_G
#define EN_G 1
#endif
#ifndef EN_H
#define EN_H 1
#endif
#ifndef EN_I
#define EN_I 1
#endif
#ifndef EN_J
#define EN_J 1
#endif
constexpr int PPL = 12;
constexpr int N_PHASES = 1 + PPL * DEPTH;
#ifndef MK_ONE_LAUNCH
#define MK_ONE_LAUNCH 0
#endif
struct Args { const float* in[28]; float* out; unsigned char* ws; int ph_lo, ph_hi; };
static_assert(sizeof(Args) == 28 * 8 + 8 + 8 + 8, "no padding bytes in the argument struct");


__device__ __forceinline__ unsigned opaque_u32(unsigned x) { unsigned v; asm volatile("v_mov_b32 %0, %1" : "=v"(v) : "s"(x)); return (unsigned)__builtin_amdgcn_readfirstlane((int)v); }
__device__ __forceinline__ unsigned long long opaque_u64(unsigned long long x) { return ((unsigned long long)opaque_u32((unsigned)(x >> 32)) << 32) | opaque_u32((unsigned)x); }
__device__ __forceinline__ void launder(Frame& F) {
    F.ws = (GAS unsigned char*)opaque_u64((unsigned long long)F.ws); F.H = (GAS float*)opaque_u64((unsigned long long)F.H);
    F.ctl = (gu32*)opaque_u64((unsigned long long)F.ctl);
    unsigned z0 = 0u; asm volatile("" : "+v"(z0)); int ln = (int)__builtin_amdgcn_mbcnt_hi(~0u, __builtin_amdgcn_mbcnt_lo(~0u, z0));
    F.wave = (int)opaque_u32((unsigned)F.wave); F.lane = ln; F.tid = F.wave * 64 + ln;
    F.G = (int)opaque_u32((unsigned)F.G); F.wg = (int)opaque_u32((unsigned)F.wg);
}
__global__ void __launch_bounds__(512, 2) mk_fwd(Args args) {
    extern __shared__ __attribute__((aligned(16))) unsigned char lds_raw[];
    Frame F;
    F.lds = (LAS unsigned char*)lds_raw;
    F.MISC = (volatile LAS unsigned*)(F.lds + MISC_OFF);
    F.tid = threadIdx.x; F.lane = F.tid & 63; F.wave = __builtin_amdgcn_readfirstlane(F.tid >> 6);
    F.G = gridDim.x; F.wg = blockIdx.x;
    F.in = args.in;
    F.pos = (const GAS int*)args.in[1];
    F.H = (GAS float*)args.out; F.ws = (GAS unsigned char*)args.ws;
    F.ctl = (gu32*)(args.ws + WS_CTL);
    for (int u = F.tid; u < (LDS_BYTES - MISC_OFF) / 4; u += 512) ((LAS unsigned*)(F.lds + MISC_OFF))[u] = 0u;
    __syncthreads();
    const int lo = args.ph_lo, hi = args.ph_hi;
    const bool multi = (hi - lo) > 1;
    XcdBarrier bar; bar.bar = (unsigned*)(F.ctl + CW_BAR); bar.x = 0; bar.st = nullptr;
    if (multi) bar = xcd_barrier_post((unsigned*)(F.ctl + CW_BAR), F.MISC + 8);
#define IN(k) (lo <= (k) && (k) < hi)
#ifdef DUP_BARRIER
#define SEAM(k) do { if (IN(k) && IN((k) + 1)) { xcd_barrier(bar); xcd_barrier(bar); } } while (0)
#else
#define SEAM(k) do { if (IN(k) && IN((k) + 1)) xcd_barrier(bar); } while (0)
#endif

#ifdef DUP_P
    for (int rep = 0; rep < 2; ++rep)
#endif
    if (EN_P && IN(0)) { launder(F); phase_prologue(F); }
    SEAM(0);
#define HB ((GAS bf16*)(F.ws + WS_HB))
#define PA ((GAS bf16*)(F.ws + WS_PA))
#define Y ((GAS bf16*)(F.ws + WS_Y))
#define HM ((GAS bf16*)F.H + (size_t)NTOK * DM)
#define TT ((GAS bf16*)F.H)
    for (int l = 0; l < DEPTH; ++l) {
        const int pb = 1 + PPL * l;
#define wd (F.ws + WS_WDENSE + (size_t)l * WD_LAYER)
#ifdef DUP_A
        for (int rep = 0; rep < 2; ++rep)
#endif
        if (EN_A && IN(pb + 0)) { launder(F);
            DenseSched S; S.init(NTOK / 256, NPA / 256, F.G, F.wg, (const void*)HB, (size_t)256 * DM * 2, (const void*)(wd + WD_WA), (size_t)256 * DM * 2);
            EpiA E{PA, (GAS bf16*)(F.ws + WS_KA), (GAS bf16*)(F.ws + WS_VA), (GAS bf16*)(F.ws + WS_KI), (GAS float*)(F.ws + WS_WI), (GAS float*)(F.ws + WS_GLR), (const GAS float*)(F.ws + WS_ROPE), ((const GAS float*)F.in[5]) + l * 64};
#ifdef DUP_ANONE
            { EpiNoneA E0{PA}; pg8::gemm_phase<EpiNoneA, DenseSched, false>(F.lds, S, E0, DM, DM, F.wave); }
#endif
#ifdef DUP_APLAIN
            { EpiPlainA E0{PA}; pg8::gemm_phase<EpiPlainA, DenseSched, false>(F.lds, S, E0, DM, DM, F.wave); }
#endif
#ifdef STAGGER_US
            if (F.wg & 1) { const unsigned long long t0 = __builtin_amdgcn_s_memrealtime(); while (__builtin_amdgcn_s_memrealtime() - t0 < (unsigned long long)(STAGGER_US * 100)) __builtin_amdgcn_s_sleep(8); }
#endif
            pg8::gemm_phase<EpiA, DenseSched, false>(F.lds, S, E, DM, DM, F.wave);
        }
        SEAM(pb + 0);
        if (EN_B && IN(pb + 1)) { launder(F);
#ifdef DUP_B
            phase_mixer(F, l, 1, DUP_B, true); launder(F);
#endif
            phase_mixer(F, l); }
        SEAM(pb + 1);
        if (EN_B && IN(pb + 2)) { launder(F);
#ifdef DUP_SCAN
            gla_scan_phase(F, true); launder(F);
#endif
            gla_scan_phase(F); }
        SEAM(pb + 2);
        if (EN_B && IN(pb + 3)) { launder(F);
#ifdef DUP_OUT
            phase_gla_out(F, l, true); launder(F);
#endif
            phase_gla_out(F, l); }
        SEAM(pb + 3);
#ifdef DUP_D
        for (int rep = 0; rep < 2; ++rep)
#endif
        if (EN_D && IN(pb + 4)) { launder(F);
            DenseSched S; S.init(NTOK / 256, DM / 256, F.G, F.wg, (const void*)Y, (size_t)256 * 1536 * 2, (const void*)(wd + WD_WBR), (size_t)256 * 512 * 2);
            S.nsub = 3; S.asub = 512 * 2; S.bsub = (size_t)1024 * 512 * 2;
            EpiP E{PA};
            pg8::gemm_phase<EpiP, DenseSched, false>(F.lds, S, E, 512, 1536, F.wave);
        }
#ifdef DUP_C
        for (int rep = 0; rep < 2; ++rep)
#endif
        if (EN_C && IN(pb + 4)) { launder(F);
            DenseSched S; S.init(NTOK / 256, DM / 256, F.G, F.wg, (const void*)HB, (size_t)256 * DM * 2, (const void*)(wd + WD_WG), (size_t)256 * DM * 2);
            S.nsub = 3; S.asub = 0; S.bsub = (size_t)1024 * DM * 2;
            EpiGM E{PA, HM};
            pg8::gemm_phase<EpiGM, DenseSched, false>(F.lds, S, E, DM, DM, F.wave);
        }
        SEAM(pb + 4);
#ifdef DUP_E
        for (int rep = 0; rep < 2; ++rep)
#endif
        if (EN_E && IN(pb + 6)) { launder(F);
            DenseSched S; S.init(NTOK / 256, DM / 256, F.G, F.wg, (const void*)HM, (size_t)256 * DM * 2, (const void*)(wd + WD_WOUT), (size_t)256 * DM * 2);
            EpiO E{HB, TT};
            pg8::gemm_phase<EpiO, DenseSched, false>(F.lds, S, E, DM, DM, F.wave);
        }
        SEAM(pb + 6);
#ifdef DUP_F
        for (int rep = 0; rep < 2; ++rep)
#endif
        if (EN_F && IN(pb + 7)) { launder(F); phase_ln_router(F, l); }
        SEAM(pb + 7);
#ifdef DUP_G
        for (int rep = 0; rep < 2; ++rep)
#endif
        if (EN_G && IN(pb + 8)) { launder(F);
            { LAS float* scr = (LAS float*)(F.lds + F.wave * 16384);
              conv_run<true>(F, l, 12288, scr);
              __syncthreads(); }
            phase_dispatch(F); }
        SEAM(pb + 8);
#ifdef DUP_H
        for (int rep = 0; rep < 2; ++rep)
#endif
        if (EN_H && IN(pb + 9)) { launder(F);
            const GAS int* META = (const GAS int*)(F.ws + WS_META); const GAS int* ROWMAP = (const GAS int*)(F.ws + WS_ROWMAP);
            LAS int* meta = (LAS int*)(F.lds + AUX_OFF); LAS int* rows = (LAS int*)(F.lds + AUX_OFF + 64);
            { int rv[3]; int mv = 0;
#pragma unroll
              for (int i = 0; i < 3; ++i) { const int gt0 = (i * F.G + F.wg) >> 1, gt = gt0 < MAXTILES ? gt0 : MAXTILES - 1; rv[i] = (F.tid < 256) ? ROWMAP[gt * 256 + F.tid] : 0; }
              if (F.tid < 3) { const int gt0 = (F.tid * F.G + F.wg) >> 1, gt = gt0 < MAXTILES ? gt0 : MAXTILES - 1; mv = ld_i32(META + 16 + gt); }
              if (F.tid < 3) meta[F.tid] = mv;
#pragma unroll
              for (int i = 0; i < 3; ++i) if (F.tid < 256) rows[i * 256 + F.tid] = rv[i]; }
            const int NT = ld_i32(META), NU = NT * 2;
            __syncthreads();
            GroupSched S{NU, F.G, F.wg, 2, (const char*)HB, (const char*)(F.ws + WS_WMOE + WM_GU), 0, (size_t)512 * DM * 2, (size_t)256 * DM * 2, meta, rows};
            EpiGU E{(GAS bf16*)(F.ws + WS_HID), (const GAS float*)(F.ws + WS_CWROW)};
            pg8::gemm_phase<EpiGU, GroupSched, true>(F.lds, S, E, DM, DM, F.wave);
        }
        SEAM(pb + 9);
#ifdef DUP_I
        for (int rep = 0; rep < 2; ++rep)
#endif
        if (EN_I && IN(pb + 10)) { launder(F);
            const GAS int* META = (const GAS int*)(F.ws + WS_META);
            LAS int* meta = (LAS int*)(F.lds + AUX_OFF);
            if (F.tid < 5) { const int gt0 = (F.tid * F.G + F.wg) >> 2, gt = gt0 < MAXTILES ? gt0 : MAXTILES - 1; meta[F.tid] = ld_i32(META + 16 + gt); }
            const int NT = ld_i32(META), NU = NT * 4;
            __syncthreads();
            GroupSched S{NU, F.G, F.wg, 4, (const char*)(F.ws + WS_HID), (const char*)(F.ws + WS_WMOE + WM_DN), (size_t)256 * DEXP * 2, (size_t)DM * DEXP * 2, (size_t)256 * DEXP * 2, meta, nullptr};
            EpiDN E{(GAS bf16*)(F.ws + WS_FF2)};
            pg8::gemm_phase<EpiDN, GroupSched, false>(F.lds, S, E, DEXP, DEXP, F.wave);
        }
        SEAM(pb + 10);
        if (EN_J && IN(pb + 11)) { launder(F);
#ifdef DUP_J
            phase_ln2(F, l, true); launder(F);
#endif
            phase_ln2(F, l); }
        SEAM(pb + 11);
    }
#undef IN
#undef SEAM
#undef HB
#undef HM
#undef TT
#undef PA
#undef Y
#undef wd
}


#ifdef DUMP_OFF
__global__ void dump_k(const unsigned short* src, float* out) {
    for (size_t i = (size_t)blockIdx.x * blockDim.x + threadIdx.x; i < (size_t)NTOK * 1024; i += (size_t)gridDim.x * blockDim.x) { const size_t n = i >> 10, c = i & 1023; out[i] = __builtin_bit_cast(float, ((unsigned)src[n * DUMP_PITCH + c]) << 16); }
}
#endif
extern "C" void kernel_launch(void* const* d_in, const int* in_sizes, int n_in, void* d_out, int out_size, void* d_ws, size_t ws_size, hipStream_t stream) {
    static int grid = 0;
    if (grid == 0) {
        if (n_in != 28 || out_size != NTOK * DM || ws_size < WS_END) { fprintf(stderr, "kernel_launch: unexpected shapes (n_in %d out %d ws %zu); nothing launched\n", n_in, out_size, ws_size); grid = -1; return; }
        int dev = 0, cus = 0;
        if (hipGetDevice(&dev) != hipSuccess || hipDeviceGetAttribute(&cus, hipDeviceAttributeMultiprocessorCount, dev) != hipSuccess) { grid = -1; return; }
        if (hipFuncSetAttribute((const void*)mk_fwd, hipFuncAttributeMaxDynamicSharedMemorySize, LDS_BYTES) != hipSuccess) { fprintf(stderr, "kernel_launch: hipFuncSetAttribute failed\n"); grid = -1; return; }
        int per_cu = 0;
        if (hipOccupancyMaxActiveBlocksPerMultiprocessor(&per_cu, (const void*)mk_fwd, 512, LDS_BYTES) != hipSuccess || per_cu < 1) { fprintf(stderr, "kernel_launch: occupancy query says %d\n", per_cu); }
        (void)hipGetLastError();
        grid = cus;
        if (grid != 256) fprintf(stderr, "kernel_launch: %d CUs (built for 256)\n", grid);
    }
    if (grid < 0) return;
    if (hipMemsetAsync((char*)d_ws + WS_CTL, 0, CTL_ZERO_BYTES, stream) != hipSuccess) return;
    Args a{};
    for (int i = 0; i < 28; ++i) a.in[i] = (const float*)d_in[i];
    a.out = (float*)d_out; a.ws = (unsigned char*)d_ws;
#if MK_ONE_LAUNCH
    a.ph_lo = 0; a.ph_hi = N_PHASES;
    hipLaunchKernelGGL(mk_fwd, dim3(grid), dim3(512), LDS_BYTES, stream, a);
#else
#ifndef STOP_AFTER
#define STOP_AFTER (N_PHASES - 1)
#endif
#ifndef PHASE_MASK
#define PHASE_MASK 0xffffffffu
#endif
    for (int p = 0; p <= STOP_AFTER; ++p) { if (!((PHASE_MASK >> p) & 1u)) continue; a.ph_lo = p; a.ph_hi = p + 1; hipLaunchKernelGGL(mk_fwd, dim3(grid), dim3(512), LDS_BYTES, stream, a); }
#ifdef DUMP_OFF
    hipLaunchKernelGGL(dump_k, dim3(2048), dim3(256), 0, stream, (const unsigned short*)((const char*)d_ws + (size_t)(DUMP_OFF)), (float*)d_out);
#endif
#endif
}
```

```cpp
#define MK_ONE_LAUNCH 1
#include <hip/hip_runtime.h>
#include <cstdio>
#include <cstdint>

#define LAS __attribute__((address_space(3)))
#define GAS __attribute__((address_space(1)))
typedef unsigned short bf16;
typedef short bf16x8 __attribute__((ext_vector_type(8)));
typedef float f32x4 __attribute__((ext_vector_type(4)));
typedef float f32x2 __attribute__((ext_vector_type(2)));
typedef unsigned u32x4 __attribute__((ext_vector_type(4)));
typedef unsigned u32x2 __attribute__((ext_vector_type(2)));
typedef GAS unsigned gu32;

constexpr int NB = 8, SEQ = 4096, NTOK = NB * SEQ, DM = 1024, NIN = 6612, DEPTH = 2;
constexpr int NPA = 3584;
constexpr int NGT = 3072;
constexpr int NEXP = 32, DEXP = 256;
constexpr int MAXTILES = 288;
constexpr float DN_ALPHA = 1.41421356237309515f;
constexpr float LN_EPS = 1e-5f, RMS_EPS = 1e-6f;
constexpr int PA_Q = 0, PA_QI = 768, PA_BQ = 1024, PA_BK = 1280, PA_BV = 1536, PA_BR = 2048, PA_CU = 2560, PA_CV = 3072;

__device__ __forceinline__ unsigned f2bf(float f) { unsigned u = __builtin_bit_cast(unsigned, f); return (u + 0x7fffu + ((u >> 16) & 1u)) >> 16; }
__device__ __forceinline__ unsigned pk2(float lo, float hi) { return f2bf(lo) | (f2bf(hi) << 16); }
__device__ __forceinline__ float bflo(unsigned w) { return __builtin_bit_cast(float, w << 16); }
__device__ __forceinline__ float bfhi(unsigned w) { return __builtin_bit_cast(float, w & 0xffff0000u); }
__device__ __forceinline__ float bf1(bf16 h) { return __builtin_bit_cast(float, ((unsigned)h) << 16); }
typedef __bf16 bf16x2_t __attribute__((ext_vector_type(2)));
__device__ __forceinline__ unsigned cvt_pk_bf16(float lo, float hi) { const f32x2 v = {lo, hi}; const bf16x2_t b = __builtin_convertvector(v, bf16x2_t); return __builtin_bit_cast(unsigned, b); }
__device__ __forceinline__ float shx(float v, int mask, int lane) { return __builtin_bit_cast(float, __builtin_amdgcn_ds_bpermute((lane ^ mask) << 2, __builtin_bit_cast(int, v))); }
__device__ __forceinline__ int shxi(int v, int mask, int lane) { return __builtin_amdgcn_ds_bpermute((lane ^ mask) << 2, v); }
__device__ __forceinline__ float wave_sum(float v, int lane) {
#pragma unroll
    for (int o = 1; o < 64; o <<= 1) v += shx(v, o, lane);
    return v;
}
__device__ __forceinline__ float wave_max(float v, int lane) {
#pragma unroll
    for (int o = 1; o < 64; o <<= 1) v = fmaxf(v, shx(v, o, lane));
    return v;
}
__device__ __forceinline__ int wave_sum_i(int v, int lane) {
#pragma unroll
    for (int o = 1; o < 64; o <<= 1) v += shxi(v, o, lane);
    return v;
}
__device__ __forceinline__ int fresh_lane() { unsigned z0 = 0u; asm volatile("" : "+v"(z0)); return (int)__builtin_amdgcn_mbcnt_hi(~0u, __builtin_amdgcn_mbcnt_lo(~0u, z0)); }
__device__ __forceinline__ int ld_i32(const GAS int* p) { return __hip_atomic_load(p, __ATOMIC_RELAXED, __HIP_MEMORY_SCOPE_AGENT); }
__device__ __forceinline__ float ld_f32(const GAS float* p) { return __hip_atomic_load(p, __ATOMIC_RELAXED, __HIP_MEMORY_SCOPE_AGENT); }
__device__ __forceinline__ float sigmoidf_(float x) { return __builtin_amdgcn_rcpf(1.0f + __expf(-x)); }
__device__ __forceinline__ float siluf_(float x) { return x * sigmoidf_(x); }
__device__ __forceinline__ float gelu_tanh_(float x) { const float u = 0.7978845608028654f * (x + 0.044715f * x * x * x); return x * sigmoidf_(2.0f * u); }

namespace pg8 {
constexpr int BM = 256, BK = 64, HALF = 128, HTB = HALF * BK * 2, STAGE_BYTES = 8 * HTB;
__host__ __device__ __forceinline__ int lds_byte(int r, int c) { const int st = (r >> 4) * 2 + (c >> 5), rr = r & 15, cc = c & 31, ob = rr * 64 + cc * 2; return st * 1024 + (ob ^ (((ob >> 9) & 1) << 5)); }
__host__ __device__ __forceinline__ void stage_rc(int b, int& R, int& C) { const int st = b / 1024, sb = b % 1024, swz = sb ^ (((sb >> 9) & 1) << 5); R = (st >> 1) * 16 + swz / 64; C = (st & 1) * 32 + (swz % 64) / 2; }
__host__ __device__ __forceinline__ int perm32(int rho) { const int n = rho >> 4, i = rho & 15; return 8 * (i >> 2) + 4 * n + (i & 3); }

struct Unit { int pm, pn, e, slot; };

#ifndef PG8_ALIGN
#define PG8_ALIGN true
#endif
template <class Epi, class Sched, bool GATHER, bool ALIGN_EPI = PG8_ALIGN>
__device__ __forceinline__ void gemm_phase(LAS unsigned char* lds, const Sched& S, const Epi& E, const int K, const int lda, const int wave) {
    unsigned z0_ = 0u; asm volatile("" : "+v"(z0_)); const int lane_ = (int)__builtin_amdgcn_mbcnt_hi(~0u, __builtin_amdgcn_mbcnt_lo(~0u, z0_));
    const int wid = wave, lane = lane_, tid = wid * 64 + lane, wr = wid >> 2, wc = wid & 3, fr = lane & 15, fq = lane >> 4;
    const int nt = K / BK;
    int Rr[2], Cc[2];
    unsigned voffB[2];
#pragma unroll
    for (int i = 0; i < 2; ++i) { int R, C; stage_rc(tid * 16 + i * 8192, R, C); Rr[i] = R; Cc[i] = C; const int Rb = Epi::PERM ? ((R & ~31) + perm32(R & 31)) : R; voffB[i] = (unsigned)(Rb * K + C) * 2u; }
    const size_t kstep = (size_t)(BK * 2);
    const size_t hstepB = (size_t)HALF * K * 2;
    const unsigned ldsw = (unsigned)wid * 1024u;
    const int aoff = lds_byte(wr * 64 + fr, fq * 8), boff = lds_byte(wc * 32 + fr, fq * 8);
#define PG8_SA(b, h) (((b) * 2 + (h)) * HTB)
#define PG8_SB(b, h) ((4 + (b) * 2 + (h)) * HTB)
#define PG8_STAGE(bufoff, gbase, voff) do { _Pragma("unroll") for (int _i = 0; _i < 2; ++_i) \
        __builtin_amdgcn_global_load_lds((const unsigned*)((const char*)(gbase) + (voff)[_i]), (LAS unsigned*)(lds + (bufoff) + ldsw + _i * 8192), 16, 0, 0); } while (0)
#define PG8_LDA(dst, b, h) do { _Pragma("unroll") for (int m = 0; m < 4; ++m) _Pragma("unroll") for (int k = 0; k < 2; ++k) dst[m][k] = *(const LAS bf16x8*)(lds + PG8_SA(b, h) + aoff + m * 2048 + k * 1024); } while (0)
#define PG8_LDB(dst, b, h) do { _Pragma("unroll") for (int n = 0; n < 2; ++n) _Pragma("unroll") for (int k = 0; k < 2; ++k) dst[n][k] = *(const LAS bf16x8*)(lds + PG8_SB(b, h) + boff + n * 2048 + k * 1024); } while (0)
#define PG8_MMA(ai, bj, At, Bt) do { __builtin_amdgcn_s_setprio(1); _Pragma("unroll") for (int m = 0; m < 4; ++m) _Pragma("unroll") for (int n = 0; n < 2; ++n) _Pragma("unroll") for (int k = 0; k < 2; ++k) \
        acc[ai][bj][m][n] = __builtin_amdgcn_mfma_f32_16x16x32_bf16(Bt[n][k], At[m][k], acc[ai][bj][m][n], 0, 0, 0); __builtin_amdgcn_s_setprio(0); } while (0)
#define PG8_WAIT_V(n) asm volatile("s_waitcnt vmcnt(" #n ")" ::: "memory")
#define PG8_WAIT_L(n) asm volatile("s_waitcnt lgkmcnt(" #n ")" ::: "memory")
#define PG8_BAR do { asm volatile("" ::: "memory"); __builtin_amdgcn_s_barrier(); asm volatile("" ::: "memory"); } while (0)
#define PG8_SCHED __builtin_amdgcn_sched_barrier(0)
    Unit cur, nxt; int ui = 0;
    if (!S.next(0, cur)) return;
    f32x4 acc[2][2][4][2];
#pragma unroll
    for (int a = 0; a < 2; ++a)
#pragma unroll
        for (int b = 0; b < 2; ++b)
#pragma unroll
            for (int m = 0; m < 4; ++m)
#pragma unroll
                for (int n = 0; n < 2; ++n) acc[a][b][m][n] = (f32x4){0.f, 0.f, 0.f, 0.f};
    bf16x8 At[4][2], B0[2][2], B1[2][2];
    unsigned cA0[2], cA1[2], nA0[2], nA1[2];
#pragma unroll
    for (int i = 0; i < 2; ++i) {
        if (GATHER) { cA0[i] = (unsigned)(S.row_of(cur, Rr[i]) * lda + Cc[i]) * 2u; cA1[i] = (unsigned)(S.row_of(cur, HALF + Rr[i]) * lda + Cc[i]) * 2u; }
        else { cA0[i] = (unsigned)(Rr[i] * lda + Cc[i]) * 2u; cA1[i] = (unsigned)((HALF + Rr[i]) * lda + Cc[i]) * 2u; }
        nA0[i] = cA0[i]; nA1[i] = cA1[i];
    }
    const char* cA = S.a_base(cur); const char* cB = S.b_base(cur);
    PG8_STAGE(PG8_SB(0, 0), cB, voffB); PG8_STAGE(PG8_SB(0, 1), cB + hstepB, voffB); PG8_STAGE(PG8_SA(0, 0), cA, cA0); PG8_STAGE(PG8_SA(0, 1), cA, cA1);
    if (wr == 1) PG8_BAR;
    PG8_WAIT_V(2); PG8_BAR;
    PG8_STAGE(PG8_SB(1, 0), cB + kstep, voffB); PG8_STAGE(PG8_SA(1, 0), cA + kstep, cA0); PG8_STAGE(PG8_SB(1, 1), cB + hstepB + kstep, voffB);
    PG8_WAIT_V(6); PG8_BAR;
    for (;;) {
        const bool has_next = S.next(ui + 1, nxt);
        const char* nA = has_next ? S.a_base(nxt) : cA; const char* nB = has_next ? S.b_base(nxt) : cB;
        if (GATHER) {
#pragma unroll
            for (int i = 0; i < 2; ++i) {
                if (has_next) { nA0[i] = (unsigned)(S.row_of(nxt, Rr[i]) * lda + Cc[i]) * 2u; nA1[i] = (unsigned)(S.row_of(nxt, HALF + Rr[i]) * lda + Cc[i]) * 2u; }
                else { nA0[i] = cA0[i]; nA1[i] = cA1[i]; }
            }
        }
#pragma unroll 1
        for (int t = 0; t < nt; t += 2) {
            const bool last = (t == nt - 2);
            const char* a1 = cA + (size_t)(t + 1) * kstep;
            const char* a2 = last ? nA : cA + (size_t)(t + 2) * kstep; const char* b2 = last ? nB : cB + (size_t)(t + 2) * kstep;
            const char* a3 = a2 + kstep; const char* b3 = b2 + kstep;
            unsigned x0[2], x1[2];
#pragma unroll
            for (int i = 0; i < 2; ++i) { x0[i] = (GATHER && last) ? nA0[i] : cA0[i]; x1[i] = (GATHER && last) ? nA1[i] : cA1[i]; }
            PG8_LDB(B0, 0, 0); PG8_LDB(B1, 0, 1); PG8_SCHED; PG8_LDA(At, 0, 0); PG8_STAGE(PG8_SA(1, 1), a1, cA1);
            PG8_WAIT_V(8); PG8_WAIT_L(0); PG8_BAR; PG8_MMA(0, 0, At, B0); PG8_MMA(0, 1, At, B1); PG8_BAR; PG8_SCHED;
            PG8_LDA(At, 0, 1); PG8_STAGE(PG8_SB(0, 0), b2, voffB); PG8_STAGE(PG8_SB(0, 1), b2 + hstepB, voffB); PG8_STAGE(PG8_SA(0, 0), a2, x0);
            PG8_WAIT_V(8); PG8_WAIT_L(0); PG8_BAR; PG8_MMA(1, 0, At, B0); PG8_MMA(1, 1, At, B1); PG8_BAR; PG8_SCHED;
            PG8_LDB(B0, 1, 0); PG8_LDB(B1, 1, 1); PG8_SCHED; PG8_LDA(At, 1, 0); PG8_STAGE(PG8_SA(0, 1), a2, x1);
            PG8_WAIT_V(8); PG8_WAIT_L(0); PG8_BAR; PG8_MMA(0, 0, At, B0); PG8_MMA(0, 1, At, B1); PG8_BAR; PG8_SCHED;
            PG8_LDA(At, 1, 1); PG8_STAGE(PG8_SB(1, 0), b3, voffB); PG8_STAGE(PG8_SB(1, 1), b3 + hstepB, voffB); PG8_STAGE(PG8_SA(1, 0), a3, x0);
            PG8_WAIT_V(8); PG8_WAIT_L(0); PG8_BAR; PG8_MMA(1, 0, At, B0); PG8_MMA(1, 1, At, B1); PG8_BAR; PG8_SCHED;
        }
        if (ALIGN_EPI) { if (wr == 0) PG8_BAR; }
        E(acc, cur, wr, wc, fr, fq);
        if (!has_next) break;
#pragma unroll
        for (int a = 0; a < 2; ++a)
#pragma unroll
            for (int b = 0; b < 2; ++b)
#pragma unroll
                for (int m = 0; m < 4; ++m)
#pragma unroll
                    for (int n = 0; n < 2; ++n) acc[a][b][m][n] = (f32x4){0.f, 0.f, 0.f, 0.f};
        cur = nxt; cA = nA; cB = nB; ++ui;
#pragma unroll
        for (int i = 0; i < 2; ++i) { cA0[i] = nA0[i]; cA1[i] = nA1[i]; }
        if (ALIGN_EPI) { if (wr == 1) PG8_BAR; }
    }
    PG8_WAIT_V(0);
    if (!ALIGN_EPI) { if (wr == 0) PG8_BAR; }
    PG8_BAR;
#undef PG8_SA
#undef PG8_SB
#undef PG8_STAGE
#undef PG8_LDA
#undef PG8_LDB
#undef PG8_MMA
#undef PG8_WAIT_V
#undef PG8_WAIT_L
#undef PG8_BAR
#undef PG8_SCHED
}
}

#define XB_TMO      128
#define XB_XCNT(j)  (256  + 64 * (j))
#define XB_XSUB(j)  (1280 + 64 * (j))
#define XB_XGEN(j)  (2304 + 64 * (j))
#define XB_TOP      3328
#define XB_TOPGEN   3392
#define XCD_BAR_WORDS 3456
#define XB_SPIN_CAP (1u << 20)

__device__ __forceinline__ unsigned xb_ld(unsigned* p)              { return __hip_atomic_load(p, __ATOMIC_RELAXED, __HIP_MEMORY_SCOPE_AGENT); }
__device__ __forceinline__ unsigned xb_add(unsigned* p, unsigned v) { return __hip_atomic_fetch_add(p, v, __ATOMIC_RELAXED, __HIP_MEMORY_SCOPE_AGENT); }
__device__ __forceinline__ unsigned xb_xcc_id() { return (unsigned)__builtin_amdgcn_s_getreg((3 << 11) | 20) & 0xFu; }
#define XB_SPIN(cond, bar) do { unsigned _sp = 0; while (cond) { __builtin_amdgcn_s_sleep(1); \
    if ((++_sp & 255u) == 0u) { if (xb_ld(&(bar)[XB_TMO])) break; if (_sp > XB_SPIN_CAP) { atomicAdd(&(bar)[XB_TMO], 1u); break; } } } } while (0)

struct XcdBarrier { unsigned* bar; unsigned x; volatile LAS unsigned* st; };

__device__ __forceinline__ XcdBarrier xcd_barrier_post(unsigned* bar, volatile LAS unsigned* st) {
    XcdBarrier b; b.bar = bar; b.x = xb_xcc_id(); b.st = st;
    if (threadIdx.x == 0) (void)xb_add(&bar[XB_XCNT(b.x)], 1u);
    return b;
}
__device__ __forceinline__ void xcd_barrier_complete(unsigned* bar, unsigned x, unsigned& nloc, unsigned& nx) {
    const unsigned G = gridDim.x * gridDim.y * gridDim.z;
    unsigned sum, cnt, mine, sp = 0u;
    for (;;) {
        sum = 0u; cnt = 0u; mine = 0u;
#pragma unroll
        for (unsigned j = 0; j < 16; ++j) { const unsigned c = xb_ld(&bar[XB_XCNT(j)]); sum += c; cnt += (c > 0u) ? 1u : 0u; mine = (j == x) ? c : mine; }
        if (sum == G) break;
        __builtin_amdgcn_s_sleep(1);
        if ((++sp & 255u) == 0u) { if (xb_ld(&bar[XB_TMO])) break; if (sp > XB_SPIN_CAP) { atomicAdd(&bar[XB_TMO], 1u); break; } }
    }
    nloc = mine > 0u ? mine : 1u; nx = cnt > 0u ? cnt : 1u;
}
__device__ __forceinline__ void xcd_barrier(const XcdBarrier& b) {
    asm volatile("s_waitcnt vmcnt(0)" ::: "memory");
    __syncthreads();
    if (threadIdx.x == 0) {
        unsigned* bar = b.bar;
        __builtin_amdgcn_s_waitcnt(0);
        unsigned nloc = b.st[0], nx = b.st[1];
        if (nloc == 0u) { xcd_barrier_complete(bar, b.x, nloc, nx); b.st[0] = nloc; b.st[1] = nx; }
        const unsigned old = xb_add(&bar[XB_XSUB(b.x)], 1u);
        const unsigned gen = old / nloc;
        if (old + 1u == (gen + 1u) * nloc) {
            __builtin_amdgcn_fence(__ATOMIC_RELEASE, "agent");
            asm volatile("s_waitcnt vmcnt(0)" ::: "memory");
            const unsigned og = xb_add(&bar[XB_TOP], 1u);
            const unsigned tg = og / nx;
            if (og + 1u == (tg + 1u) * nx) xb_add(&bar[XB_TOPGEN], 1u);
            else XB_SPIN(xb_ld(&bar[XB_TOPGEN]) == tg, bar);
            __builtin_amdgcn_fence(__ATOMIC_ACQUIRE, "agent");
            xb_add(&bar[XB_XGEN(b.x)], 1u);
            asm volatile("s_waitcnt vmcnt(0)" ::: "memory");
        } else {
            XB_SPIN(xb_ld(&bar[XB_XGEN(b.x)]) == gen, bar);
            __builtin_amdgcn_fence(__ATOMIC_ACQUIRE, "agent");
            asm volatile("s_waitcnt vmcnt(0)" ::: "memory");
        }
    }
    __syncthreads();
}

constexpr size_t MiB = 1u << 20;
constexpr size_t WS_CTL = 0, CTL_ZERO_BYTES = 1 * MiB;
constexpr size_t WS_ROPE = 1 * MiB;
constexpr size_t WS_WI   = 3 * MiB;
constexpr size_t WS_ROUTE = 3 * MiB + 512 * 1024;
constexpr size_t WS_SROW = 4 * MiB;
constexpr size_t WS_ROWMAP = 4 * MiB + 256 * 1024;
constexpr size_t WS_CWROW = 4 * MiB + 640 * 1024;
constexpr size_t WS_CNTWG = 5 * MiB;
constexpr size_t WS_META = 5 * MiB + 64 * 1024;
constexpr size_t WS_WR = 5 * MiB + 128 * 1024;
constexpr size_t WS_GLR = 6 * MiB;
constexpr size_t WS_WDENSE = 8 * MiB;
constexpr size_t WD_WA = 0, WD_WG = 7 * MiB, WD_WBR = 13 * MiB, WD_WOUT = 16 * MiB, WD_LAYER = 18 * MiB;
constexpr size_t WS_WMOE = 44 * MiB;
constexpr size_t WM_GU = 0, WM_DN = 32 * MiB;
constexpr size_t WS_HB = 92 * MiB;
constexpr size_t WS_PA = 156 * MiB;
constexpr size_t WS_HID = WS_PA;
constexpr size_t WS_FF2 = WS_PA + 40 * MiB;
constexpr size_t WS_Y = 380 * MiB;
constexpr size_t WS_KA = 476 * MiB, WS_VA = 480 * MiB, WS_KI = 484 * MiB;
constexpr size_t WS_END = 512 * MiB;
static_assert(WS_WDENSE + 2 * WD_LAYER <= WS_WMOE && WS_WMOE + 48 * MiB <= WS_HB && WS_HB + 64 * MiB <= WS_PA && WS_PA + 224 * MiB <= WS_Y && WS_Y + 96 * MiB <= WS_KA && WS_KI + 4 * MiB <= WS_END, "ws map");
static_assert(WS_FF2 + (size_t)73728 * 1024 * 2 <= WS_Y, "ff2 fits");
constexpr int CW_BAR = 4096;
constexpr int CW_QUEUE = 16384;

constexpr int RING_BYTES = 131072;
constexpr int AUX_OFF = 131072;
constexpr int MISC_OFF = 155648;
constexpr int LDS_BYTES = 156672;

struct Frame {
    LAS unsigned char* lds;
    volatile LAS unsigned* MISC;
    gu32* ctl;
    int tid, lane, wave, G, wg;
    const float* const* in;
    const GAS int* pos;
    GAS float* H;
    GAS unsigned char* ws;
};

#define LDS_WAIT() asm volatile("s_waitcnt lgkmcnt(0)" ::: "memory")
#define VM_WAIT() asm volatile("s_waitcnt vmcnt(0)" ::: "memory")

__device__ __forceinline__ int pa_src_col(int c) {
    if (c < 512) return c;
    if (c < 768) { const int x = c - 512, half = x >> 7, y = x & 127, grp = y >> 5, d = (y & 31) + 32 * half;
        if (grp == 0) return 512 + d;
        if (grp == 1) return 576 + d;
        if (grp == 2) return 896 + d;
        if (half == 0) { const int z = y - 96; if (z < 4) return 960 + z; if (z < 20) return 1988 + (z - 4); }
        return -1; }
    if (c < 1024) return 640 + (c - 768);
    if (c < 1280) return 964 + (c - 1024);
    if (c < 1536) return 1220 + (c - 1280);
    if (c < 2048) return 1476 + (c - 1536);
    if (c < 2560) return 2004 + (c - 2048);
    return 2516 + (c - 2560);
}
struct TItem { const GAS float* W; GAS bf16* WT; int ldw, K, n0, k0, sc0, mode; };
__device__ __forceinline__ void ti_load(const TItem& t, f32x4 (&v)[8], int lane) {
    if (t.mode == 0) { const int kr = lane >> 3, c4 = (lane & 7) * 4;
#pragma unroll
        for (int i = 0; i < 8; ++i) v[i] = *(const GAS f32x4*)(t.W + (size_t)(t.k0 + 8 * i + kr) * t.ldw + t.sc0 + c4); }
}
__device__ __forceinline__ void ti_finish(const TItem& t, const f32x4 (&v)[8], LAS float* scr, int lane) {
    if (t.mode == 0) { const int kr = lane >> 3, c4 = (lane & 7) * 4;
#pragma unroll
        for (int i = 0; i < 8; ++i) { LAS float* d = scr + (8 * i + kr) * 33 + c4; d[0] = v[i].x; d[1] = v[i].y; d[2] = v[i].z; d[3] = v[i].w; }
    } else { const int sc = pa_src_col(t.n0 + (lane & 31));
#pragma unroll 8
        for (int i = 0; i < 32; ++i) { const int kk = 2 * i + (lane >> 5); scr[kk * 33 + (lane & 31)] = (sc >= 0) ? t.W[(size_t)(t.k0 + kk) * t.ldw + sc] : 0.f; }
    }
    LDS_WAIT(); asm volatile("" ::: "memory");
    const int c = lane & 7;
#pragma unroll
    for (int j = 0; j < 4; ++j) { const int n = (lane >> 3) + 8 * j; const LAS float* s = scr + (8 * c) * 33 + n;
        u32x4 o; o.x = pk2(s[0 * 33], s[1 * 33]); o.y = pk2(s[2 * 33], s[3 * 33]); o.z = pk2(s[4 * 33], s[5 * 33]); o.w = pk2(s[6 * 33], s[7 * 33]);
        *(GAS u32x4*)(t.WT + (size_t)(t.n0 + n) * t.K + t.k0 + 8 * c) = o; }
    LDS_WAIT(); asm volatile("" ::: "memory");
}
__device__ __forceinline__ void dense_item(Frame& F, int l, int it, TItem& t) {
    GAS bf16* base = (GAS bf16*)(F.ws + WS_WDENSE + (size_t)l * WD_LAYER);
    const GAS float* win = ((const GAS float*)F.in[4]) + (size_t)l * DM * NIN;
    if (it < 1792) { const int kb = it / 112, nb = it % 112; const int s0 = pa_src_col(32 * nb), s31 = pa_src_col(32 * nb + 31);
        t = TItem{win, base + WD_WA / 2, NIN, DM, 32 * nb, 64 * kb, s0, (s0 >= 0 && s31 == s0 + 31) ? 0 : 1}; return; }
    it -= 1792;
    if (it < 1536) { const int kb = it / 96, nb = it % 96; t = TItem{win, base + WD_WG / 2, NIN, DM, 32 * nb, 64 * kb, 3540 + 32 * nb, 0}; return; }
    it -= 1536;
    if (it < 768) { const int br = it / 256, r = it % 256, kb = r / 32, nb = r % 32;
        t = TItem{(br == 0 ? ((const GAS float*)F.in[13]) : br == 1 ? ((const GAS float*)F.in[14]) : ((const GAS float*)F.in[15])) + (size_t)l * 512 * DM, base + WD_WBR / 2 + (size_t)br * 1024 * 512, DM, 512, 32 * nb, 64 * kb, 32 * nb, 0}; return; }
    it -= 768;
    { const int kb = it / 32, nb = it % 32; t = TItem{((const GAS float*)F.in[16]) + (size_t)l * DM * DM, base + WD_WOUT / 2, DM, DM, 32 * nb, 64 * kb, 32 * nb, 0}; }
}
__device__ __forceinline__ void moe_item(Frame& F, int l, int it, TItem& t) {
    const int e = it / 384; int r = it % 384;
    if (r < 256) { const int sub = r / 64, q = r % 64, ct = sub >> 1, bj = sub & 1, kb = q / 4, nb = q % 4;
        const GAS float* src = (bj ? ((const GAS float*)F.in[24]) : ((const GAS float*)F.in[23])) + (size_t)(l * NEXP + e) * DM * DEXP;
        t = TItem{src, (GAS bf16*)(F.ws + WS_WMOE + WM_GU) + (size_t)e * 512 * DM, DEXP, DM, 256 * ct + 128 * bj + 32 * nb, 64 * kb, 128 * ct + 32 * nb, 0}; return; }
    r -= 256;
    { const int kb = r / 32, nb = r % 32;
        t = TItem{((const GAS float*)F.in[25]) + (size_t)(l * NEXP + e) * DEXP * DM, (GAS bf16*)(F.ws + WS_WMOE + WM_DN) + (size_t)e * DM * DEXP, DM, DEXP, 32 * nb, 64 * kb, 32 * nb, 0}; }
}
template <bool MOE> __device__ __forceinline__ void conv_run(Frame& F, int l, int total, LAS float* scr) {
    const int gw = F.wg * 8 + F.wave, NGW = F.G * 8, lane = F.lane;
    TItem cur, nxt; f32x4 vc[8], vn[8];
    int it = gw; if (it >= total) return;
    if (MOE) moe_item(F, l, it, cur); else dense_item(F, it / 4608, it % 4608, cur);
    ti_load(cur, vc, lane);
#pragma unroll 1
    for (; it < total; it += NGW) { const int itn = it + NGW; const bool hn = itn < total;
        if (hn) { if (MOE) moe_item(F, l, itn, nxt); else dense_item(F, itn / 4608, itn % 4608, nxt); ti_load(nxt, vn, lane); }
        ti_finish(cur, vc, scr, lane);
        cur = nxt;
#pragma unroll
        for (int i = 0; i < 8; ++i) vc[i] = vn[i]; }
}

__device__ __forceinline__ void ln_row_regs(f32x4 (&v)[4], const GAS float* g, const GAS float* b, int lane) {
    float s = 0.f;
#pragma unroll
    for (int j = 0; j < 4; ++j) s += (v[j].x + v[j].y) + (v[j].z + v[j].w);
    const float mean = wave_sum(s, lane) * (1.f / DM); float s2 = 0.f;
#pragma unroll
    for (int j = 0; j < 4; ++j) { v[j] = v[j] - mean; s2 += (v[j].x * v[j].x + v[j].y * v[j].y) + (v[j].z * v[j].z + v[j].w * v[j].w); }
    const float rstd = 1.f / sqrtf(wave_sum(s2, lane) * (1.f / DM) + LN_EPS);
#pragma unroll
    for (int j = 0; j < 4; ++j) { const f32x4 gg = *(const GAS f32x4*)(g + 4 * lane + 256 * j), bb = *(const GAS f32x4*)(b + 4 * lane + 256 * j); v[j] = v[j] * rstd * gg + bb; }
}
__device__ __forceinline__ void store_row_f32_bf16(const f32x4 (&v)[4], GAS float* hrow, GAS bf16* brow, int lane) {
#pragma unroll
    for (int j = 0; j < 4; ++j) {
        if (hrow) *(GAS f32x4*)(hrow + 4 * lane + 256 * j) = v[j];
        if (brow) { u32x2 w; w.x = pk2(v[j].x, v[j].y); w.y = pk2(v[j].z, v[j].w); *(GAS u32x2*)(brow + 4 * lane + 256 * j) = w; }
    }
}

__device__ __forceinline__ void phase_prologue(Frame& F) {
    LAS float* scr = (LAS float*)(F.lds + F.wave * 16384);
    const int gw = F.wg * 8 + F.wave, NGW = F.G * 8;
    conv_run<false>(F, 0, 2 * 4608, scr);
    { GAS bf16* WRB = (GAS bf16*)(F.ws + WS_WR);
      for (int i = gw * 64 + F.lane; i < DEPTH * 48 * DM; i += NGW * 64) { const int l = i / (48 * DM), r = i % (48 * DM), o = r / DM, k = r % DM;
          const float v = (o < 4) ? ((const GAS float*)F.in[19])[(size_t)l * DM * 4 + k * 4 + o] : (o < 36) ? ((const GAS float*)F.in[21])[(size_t)l * DM * 32 + k * 32 + (o - 4)] : 0.f;
          WRB[i] = (bf16)f2bf(v); } }
    { GAS float* RT = (GAS float*)(F.ws + WS_ROPE);
      for (int i = gw * 64 + F.lane; i < NTOK * 8; i += NGW * 64) { const int n = i >> 3, j = i & 7;
          const float invf[8] = {1.000000000e+00f, 1.939227432e-01f, 3.760603070e-02f, 7.292664610e-03f, 1.414213562e-03f, 2.742481884e-04f, 5.318295734e-05f, 1.031338525e-05f};
          float inv = invf[0];
#pragma unroll
          for (int q = 1; q < 8; ++q) inv = (j == q) ? invf[q] : inv;
          const float ang = (float)F.pos[n] * inv;
          const double kq = __builtin_rint((double)ang * 0.15915494309189535);
          double r = (double)ang - kq * 6.283185307179586; double csign = 1.0;
          if (r > 1.5707963267948966) { r = 3.141592653589793 - r; csign = -1.0; } else if (r < -1.5707963267948966) { r = -3.141592653589793 - r; csign = -1.0; }
          const double x2 = r * r;
          const double sn = r * (1.0 + x2 * (-1.0 / 6 + x2 * (1.0 / 120 + x2 * (-1.0 / 5040 + x2 * (1.0 / 362880 + x2 * (-1.0 / 39916800 + x2 * (1.0 / 6227020800.0 + x2 * (-1.0 / 1307674368000.0))))))));
          const double cs = 1.0 + x2 * (-0.5 + x2 * (1.0 / 24 + x2 * (-1.0 / 720 + x2 * (1.0 / 40320 + x2 * (-1.0 / 3628800 + x2 * (1.0 / 479001600.0 + x2 * (-1.0 / 87178291200.0 + x2 * (1.0 / 20922789888000.0))))))));
          RT[n * 16 + j] = (float)(csign * cs); RT[n * 16 + 8 + j] = (float)sn; } }
    GAS bf16* HB = (GAS bf16*)(F.ws + WS_HB);
    for (int m = gw; m < NTOK; m += NGW) { f32x4 v[4];
#pragma unroll
        for (int j = 0; j < 4; ++j) v[j] = *(const GAS f32x4*)(((const GAS float*)F.in[0]) + (size_t)m * DM + 4 * F.lane + 256 * j);
        ln_row_regs(v, ((const GAS float*)F.in[2]), ((const GAS float*)F.in[3]), F.lane);
        store_row_f32_bf16(v, (GAS float*)nullptr, HB + (size_t)m * DM, F.lane); }
}

struct DenseSched {
    int nM, nN, nwg, G, c; const char* A; const char* B; size_t atile, btile; int nsub = 1; size_t asub = 0, bsub = 0;
    __device__ void init(int nM_, int nN_, int G_, int c_, const void* A_, size_t atile_, const void* B_, size_t btile_) { nM = nM_; nN = nN_; nwg = nM * nN; G = G_; c = c_; A = (const char*)A_; B = (const char*)B_; atile = atile_; btile = btile_; }
    __device__ __forceinline__ bool next(int i, pg8::Unit& u) const {
        const int it = i / nsub, sb = i - it * nsub;
        const long L = (long)it * G + c; if (L >= nwg) return false;
        int wgid = (int)L; { const int q = nwg / 8, r = nwg % 8, xcd = wgid % 8, off = wgid / 8; wgid = (xcd < r ? xcd * (q + 1) : r * (q + 1) + (xcd - r) * q) + off; }
        const int nig = 8 * nN, gid = wgid / nig, fm = gid * 8, gsz = (nM - fm) < 8 ? (nM - fm) : 8;
        u.pm = fm + ((wgid % nig) % gsz); u.pn = (wgid % nig) / gsz; u.e = sb; u.slot = i; return true;
    }
    __device__ __forceinline__ const char* a_base(const pg8::Unit& u) const { return A + (size_t)u.pm * atile + (size_t)u.e * asub; }
    __device__ __forceinline__ const char* b_base(const pg8::Unit& u) const { return B + (size_t)u.pn * btile + (size_t)u.e * bsub; }
    __device__ __forceinline__ int row_of(const pg8::Unit&, int) const { return 0; }
};
struct GroupSched {
    int NU, G, c, ncol; const char* A; const char* B; size_t atile, erows_bytes, btile; const LAS int* meta; const LAS int* rows;
    __device__ __forceinline__ bool next(int i, pg8::Unit& u) const {
        const int L = i * G + c; if (L >= NU) return false;
        u.pm = L / ncol; u.pn = L % ncol; u.slot = i; u.e = meta[i]; return true;
    }
    __device__ __forceinline__ const char* a_base(const pg8::Unit& u) const { return A + (size_t)u.pm * atile; }
    __device__ __forceinline__ const char* b_base(const pg8::Unit& u) const { return B + (size_t)u.e * erows_bytes + (size_t)u.pn * btile; }
    __device__ __forceinline__ int row_of(const pg8::Unit& u, int r) const { return rows[u.slot * 256 + r]; }
};

#ifndef NT_MASK
#define NT_MASK 0
#endif
template <int BIT> __device__ __forceinline__ void st16(GAS u32x4* p, const u32x4 v) { if (NT_MASK & (1 << BIT)) __builtin_nontemporal_store(v, p); else *p = v; }
struct EpiA {
    static constexpr bool PERM = true; static constexpr int NST = 16;
    GAS bf16* PA; GAS bf16* KA; GAS bf16* VA; GAS bf16* KI; GAS float* WI; GAS float* GLR; const GAS float* ROPE; const GAS float* ikg;
    __device__ __forceinline__ static void rope8(float (&x)[8], const GAS float* rt, int fq, int lane) {
        const f32x4 c0 = *(const GAS f32x4*)(rt), c1 = *(const GAS f32x4*)(rt + 4), s0 = *(const GAS f32x4*)(rt + 8), s1 = *(const GAS f32x4*)(rt + 12);
#pragma unroll
        for (int i = 0; i < 8; ++i) { const float p = shx(x[i], 16, lane); const float cc = (i < 4) ? c0[i & 3] : c1[i & 3], ss = (i < 4) ? s0[i & 3] : s1[i & 3];
            const float r = x[i] * cc + ((fq == 0) ? -p : p) * ss; x[i] = (fq < 2) ? r : x[i]; }
    }
    __device__ __forceinline__ static u32x4 pack8(const float (&x)[8]) { u32x4 w; w.x = cvt_pk_bf16(x[0], x[1]); w.y = cvt_pk_bf16(x[2], x[3]); w.z = cvt_pk_bf16(x[4], x[5]); w.w = cvt_pk_bf16(x[6], x[7]); return w; }
    __device__ __forceinline__ void operator()(const f32x4 (&acc)[2][2][4][2], const pg8::Unit& u, int wr, int wc, int fr, int fq) const {
        const int pn = u.pn; const int rowb = u.pm * 256 + wr * 64 + fr; const int lane = fq * 16 + fr;
        if (pn == 2) {
#pragma unroll
            for (int ai = 0; ai < 2; ++ai)
#pragma unroll
                for (int m = 0; m < 4; ++m) {
                    const int row = rowb + ai * 128 + m * 16;
                    float x0[8], x1[8];
#pragma unroll
                    for (int i = 0; i < 8; ++i) { x0[i] = acc[ai][0][m][i >> 2][i & 3]; x1[i] = acc[ai][1][m][i >> 2][i & 3]; }
                    if (wc == 2) {
                        float s = 0.f;
#pragma unroll
                        for (int i = 0; i < 8; ++i) s += x0[i] + x1[i];
                        s += shx(s, 16, lane); s += shx(s, 32, lane);
                        const float mean = s * (1.f / 64.f); float q = 0.f;
#pragma unroll
                        for (int i = 0; i < 8; ++i) { x0[i] -= mean; x1[i] -= mean; q += x0[i] * x0[i] + x1[i] * x1[i]; }
                        q += shx(q, 16, lane); q += shx(q, 32, lane);
                        const float rstd = 1.f / sqrtf(q * (1.f / 64.f) + LN_EPS);
#pragma unroll
                        for (int i = 0; i < 8; ++i) { x0[i] = x0[i] * rstd * ikg[8 * fq + i]; x1[i] = x1[i] * rstd * ikg[32 + 8 * fq + i]; }
                    }
                    if (wc == 0 || wc == 2) rope8(x0, ROPE + (size_t)row * 16, fq, lane);
                    if (wc < 3) {
                        GAS bf16* dst = (wc == 0) ? KA : (wc == 1) ? VA : KI;
                        *(GAS u32x4*)(dst + (size_t)row * 64 + 8 * fq) = pack8(x0); *(GAS u32x4*)(dst + (size_t)row * 64 + 32 + 8 * fq) = pack8(x1);
                    } else {
                        if (fq == 0) { *(GAS f32x4*)(WI + (size_t)row * 4) = (f32x4){x0[0], x0[1], x0[2], x0[3]} * 0.0625f; *(GAS f32x4*)(GLR + (size_t)row * 16) = (f32x4){x0[4], x0[5], x0[6], x0[7]}; }
                        else if (fq == 1) { *(GAS f32x4*)(GLR + (size_t)row * 16 + 4) = (f32x4){x0[0], x0[1], x0[2], x0[3]}; *(GAS f32x4*)(GLR + (size_t)row * 16 + 8) = (f32x4){x0[4], x0[5], x0[6], x0[7]}; }
                        else if (fq == 2) { *(GAS f32x4*)(GLR + (size_t)row * 16 + 12) = (f32x4){x0[0], x0[1], x0[2], x0[3]}; }
                    }
                    asm volatile("" ::: "memory");
                }
        } else if (pn < 2 || pn == 3) {
            const float sc = (pn == 3) ? 1.0f : 0.125f; const bool rope = !(wc & 1);
#pragma unroll
            for (int ai = 0; ai < 2; ++ai)
#pragma unroll
                for (int m = 0; m < 4; ++m) {
                    const int row = rowb + ai * 128 + m * 16;
#pragma unroll
                    for (int bj = 0; bj < 2; ++bj) { float x[8];
#pragma unroll
                        for (int i = 0; i < 8; ++i) x[i] = acc[ai][bj][m][i >> 2][i & 3];
                        if (rope) rope8(x, ROPE + (size_t)row * 16, fq, lane);
#pragma unroll
                        for (int i = 0; i < 8; ++i) x[i] *= sc;
                        st16<0>((GAS u32x4*)(PA + (size_t)row * NPA + 256 * pn + 128 * bj + 32 * wc + 8 * fq), pack8(x)); }
                    asm volatile("" ::: "memory");
                }
        } else {
            const int act = (pn == 8 || pn == 9) ? 1 : (pn >= 10) ? 2 : 0; const float sc = (pn == 4) ? 0.125f : 1.0f;
#pragma unroll
            for (int ai = 0; ai < 2; ++ai)
#pragma unroll
                for (int m = 0; m < 4; ++m) {
                    const int row = rowb + ai * 128 + m * 16;
#pragma unroll
                    for (int bj = 0; bj < 2; ++bj) { float x[8];
#pragma unroll
                        for (int i = 0; i < 8; ++i) { const float v = acc[ai][bj][m][i >> 2][i & 3]; x[i] = (act == 1) ? siluf_(v) : (act == 2) ? gelu_tanh_(v) : v * sc; }
                        st16<0>((GAS u32x4*)(PA + (size_t)row * NPA + 256 * pn + 128 * bj + 32 * wc + 8 * fq), pack8(x)); }
                    asm volatile("" ::: "memory");
                }
        }
    }
};
struct EpiPlainA {
    static constexpr bool PERM = true; static constexpr int NST = 16;
    GAS bf16* PA;
    __device__ __forceinline__ void operator()(const f32x4 (&acc)[2][2][4][2], const pg8::Unit& u, int wr, int wc, int fr, int fq) const {
        const int rowb = u.pm * 256 + wr * 64 + fr;
#pragma unroll
        for (int ai = 0; ai < 2; ++ai)
#pragma unroll
            for (int m = 0; m < 4; ++m) { const int row = rowb + ai * 128 + m * 16;
#pragma unroll
                for (int bj = 0; bj < 2; ++bj) { u32x4 w; w.x = cvt_pk_bf16(acc[ai][bj][m][0][0], acc[ai][bj][m][0][1]); w.y = cvt_pk_bf16(acc[ai][bj][m][0][2], acc[ai][bj][m][0][3]);
                    w.z = cvt_pk_bf16(acc[ai][bj][m][1][0], acc[ai][bj][m][1][1]); w.w = cvt_pk_bf16(acc[ai][bj][m][1][2], acc[ai][bj][m][1][3]);
                    *(GAS u32x4*)(PA + (size_t)row * NPA + 256 * u.pn + 128 * bj + 32 * wc + 8 * fq) = w; } }
    }
};
struct EpiNoneA {
    static constexpr bool PERM = true; static constexpr int NST = 0;
    GAS bf16* PA;
    __device__ __forceinline__ void operator()(const f32x4 (&acc)[2][2][4][2], const pg8::Unit& u, int wr, int wc, int fr, int fq) const {
        float s = 0.f;
#pragma unroll
        for (int ai = 0; ai < 2; ++ai)
#pragma unroll
            for (int m = 0; m < 4; ++m)
#pragma unroll
                for (int bj = 0; bj < 2; ++bj)
#pragma unroll
                    for (int n = 0; n < 2; ++n) s += (acc[ai][bj][m][n][0] + acc[ai][bj][m][n][1]) + (acc[ai][bj][m][n][2] + acc[ai][bj][m][n][3]);
        if (s == 1.2345e30f) PA[u.pm + wr + wc + fr + fq] = (bf16)1;
    }
};
#ifdef PPITCH
#ifndef EPIP_MODE
#define EPIP_MODE 0
#endif
struct EpiPPad {
    static constexpr bool PERM = true; static constexpr int NST = 16;
    GAS bf16* P;
    __device__ __forceinline__ void operator()(const f32x4 (&acc)[2][2][4][2], const pg8::Unit& u, int wr, int wc, int fr, int fq) const {
        const int rowb = u.pm * 256 + wr * 64 + fr; GAS bf16* Pb = P + (size_t)u.e * NTOK * PPITCH;
#pragma unroll
        for (int ai = 0; ai < 2; ++ai)
#pragma unroll
            for (int m = 0; m < 4; ++m) {
#if EPIP_MODE == 2
                const int row = (rowb + ai * 128 + m * 16) & 31;
#else
                const int row = rowb + ai * 128 + m * 16;
#endif
#pragma unroll
                for (int bj = 0; bj < 2; ++bj) { u32x4 w; w.x = cvt_pk_bf16(acc[ai][bj][m][0][0], acc[ai][bj][m][0][1]); w.y = cvt_pk_bf16(acc[ai][bj][m][0][2], acc[ai][bj][m][0][3]);
                    w.z = cvt_pk_bf16(acc[ai][bj][m][1][0], acc[ai][bj][m][1][1]); w.w = cvt_pk_bf16(acc[ai][bj][m][1][2], acc[ai][bj][m][1][3]);
#if EPIP_MODE == 3
                    __builtin_nontemporal_store(w, (GAS u32x4*)(Pb + (size_t)row * PPITCH + 256 * u.pn + 128 * bj + 32 * wc + 8 * fq));
#elif EPIP_MODE == 4
                    { GAS u32x4* ap_ = (GAS u32x4*)(Pb + (size_t)row * PPITCH + 256 * u.pn + 128 * bj + 32 * wc + 8 * fq); asm volatile("global_store_dwordx4 %0, %1, off sc0 sc1" :: "v"(ap_), "v"(w) : "memory"); }
#elif EPIP_MODE == 5
                    { GAS u32x4* ap_ = (GAS u32x4*)(Pb + (size_t)row * PPITCH + 256 * u.pn + 128 * bj + 32 * wc + 8 * fq); asm volatile("global_store_dwordx4 %0, %1, off sc1" :: "v"(ap_), "v"(w) : "memory"); }
#elif EPIP_MODE == 1
                    if (ai == 0) *(GAS u32x4*)(Pb + (size_t)row * PPITCH + 256 * u.pn + 128 * bj + 32 * wc + 8 * fq) = w; else if (w.x == 0x12345678u && w.y == w.z && w.w == 77u) Pb[0] = (bf16)1;
#else
                    *(GAS u32x4*)(Pb + (size_t)row * PPITCH + 256 * u.pn + 128 * bj + 32 * wc + 8 * fq) = w;
#endif
                } }
    }
};
#endif
struct EpiP {
    static constexpr bool PERM = true; static constexpr int NST = 16;
    GAS bf16* P;
    __device__ __forceinline__ void operator()(const f32x4 (&acc)[2][2][4][2], const pg8::Unit& u, int wr, int wc, int fr, int fq) const {
        const int rowb = u.pm * 256 + wr * 64 + fr; GAS bf16* Pb = P + (size_t)u.e * NTOK * DM;
#pragma unroll
        for (int ai = 0; ai < 2; ++ai)
#pragma unroll
            for (int m = 0; m < 4; ++m) { const int row = rowb + ai * 128 + m * 16;
#pragma unroll
                for (int bj = 0; bj < 2; ++bj) { u32x4 w; w.x = cvt_pk_bf16(acc[ai][bj][m][0][0], acc[ai][bj][m][0][1]); w.y = cvt_pk_bf16(acc[ai][bj][m][0][2], acc[ai][bj][m][0][3]);
                    w.z = cvt_pk_bf16(acc[ai][bj][m][1][0], acc[ai][bj][m][1][1]); w.w = cvt_pk_bf16(acc[ai][bj][m][1][2], acc[ai][bj][m][1][3]);
                    st16<1>((GAS u32x4*)(Pb + (size_t)row * DM + 256 * u.pn + 128 * bj + 32 * wc + 8 * fq), w); } }
    }
};
struct EpiGM {
    static constexpr bool PERM = true; static constexpr int NST = 16;
    const GAS bf16* P; GAS bf16* HM;
    __device__ __forceinline__ void operator()(const f32x4 (&acc)[2][2][4][2], const pg8::Unit& u, int wr, int wc, int fr, int fq) const {
        const int rowb = u.pm * 256 + wr * 64 + fr; const int br = u.e; const GAS bf16* Pb = P + (size_t)br * NTOK * DM;
        const int colb = 256 * u.pn + 32 * wc + 8 * fq;
#pragma unroll
        for (int ai = 0; ai < 2; ++ai) {
            u32x4 pv[4][2], ov[4][2];
#pragma unroll
            for (int m = 0; m < 4; ++m)
#pragma unroll
                for (int bj = 0; bj < 2; ++bj) { const size_t off = (size_t)(rowb + ai * 128 + m * 16) * DM + colb + 128 * bj;
                    pv[m][bj] = *(const GAS u32x4*)(Pb + off); ov[m][bj] = (br > 0) ? *(const GAS u32x4*)(HM + off) : (u32x4){0u, 0u, 0u, 0u}; }
            __builtin_amdgcn_sched_barrier(0);
#pragma unroll
            for (int m = 0; m < 4; ++m)
#pragma unroll
                for (int bj = 0; bj < 2; ++bj) { const size_t off = (size_t)(rowb + ai * 128 + m * 16) * DM + colb + 128 * bj;
                    const u32x4 p = pv[m][bj], o = ov[m][bj];
                    float x[8];
                    x[0] = bflo(p.x) * sigmoidf_(acc[ai][bj][m][0][0]) + bflo(o.x); x[1] = bfhi(p.x) * sigmoidf_(acc[ai][bj][m][0][1]) + bfhi(o.x); x[2] = bflo(p.y) * sigmoidf_(acc[ai][bj][m][0][2]) + bflo(o.y); x[3] = bfhi(p.y) * sigmoidf_(acc[ai][bj][m][0][3]) + bfhi(o.y);
                    x[4] = bflo(p.z) * sigmoidf_(acc[ai][bj][m][1][0]) + bflo(o.z); x[5] = bfhi(p.z) * sigmoidf_(acc[ai][bj][m][1][1]) + bfhi(o.z); x[6] = bflo(p.w) * sigmoidf_(acc[ai][bj][m][1][2]) + bflo(o.w); x[7] = bfhi(p.w) * sigmoidf_(acc[ai][bj][m][1][3]) + bfhi(o.w);
                    u32x4 w; w.x = cvt_pk_bf16(x[0], x[1]); w.y = cvt_pk_bf16(x[2], x[3]); w.z = cvt_pk_bf16(x[4], x[5]); w.w = cvt_pk_bf16(x[6], x[7]);
                    st16<2>((GAS u32x4*)(HM + off), w); }
            asm volatile("" ::: "memory");
        }
    }
};
struct EpiO {
    static constexpr bool PERM = true; static constexpr int NST = 16;
    const GAS bf16* HBr; GAS bf16* T;
    __device__ __forceinline__ void operator()(const f32x4 (&acc)[2][2][4][2], const pg8::Unit& u, int wr, int wc, int fr, int fq) const {
        const int rowb = u.pm * 256 + wr * 64 + fr; const int colb = 256 * u.pn + 32 * wc + 8 * fq;
#pragma unroll
        for (int ai = 0; ai < 2; ++ai) {
            u32x4 hv[4][2];
#pragma unroll
            for (int m = 0; m < 4; ++m)
#pragma unroll
                for (int bj = 0; bj < 2; ++bj) hv[m][bj] = *(const GAS u32x4*)(HBr + (size_t)(rowb + ai * 128 + m * 16) * DM + colb + 128 * bj);
            __builtin_amdgcn_sched_barrier(0);
#pragma unroll
            for (int m = 0; m < 4; ++m)
#pragma unroll
                for (int bj = 0; bj < 2; ++bj) { const u32x4 h = hv[m][bj];
                    u32x4 w; w.x = cvt_pk_bf16(bflo(h.x) * DN_ALPHA + acc[ai][bj][m][0][0], bfhi(h.x) * DN_ALPHA + acc[ai][bj][m][0][1]); w.y = cvt_pk_bf16(bflo(h.y) * DN_ALPHA + acc[ai][bj][m][0][2], bfhi(h.y) * DN_ALPHA + acc[ai][bj][m][0][3]);
                    w.z = cvt_pk_bf16(bflo(h.z) * DN_ALPHA + acc[ai][bj][m][1][0], bfhi(h.z) * DN_ALPHA + acc[ai][bj][m][1][1]); w.w = cvt_pk_bf16(bflo(h.w) * DN_ALPHA + acc[ai][bj][m][1][2], bfhi(h.w) * DN_ALPHA + acc[ai][bj][m][1][3]);
                    st16<3>((GAS u32x4*)(T + (size_t)(rowb + ai * 128 + m * 16) * DM + colb + 128 * bj), w); }
            asm volatile("" ::: "memory");
        }
    }
};
struct EpiGU {
    static constexpr bool PERM = true; static constexpr int NST = 8;
    GAS bf16* HID; const GAS float* CW;
    __device__ __forceinline__ void operator()(const f32x4 (&acc)[2][2][4][2], const pg8::Unit& u, int wr, int wc, int fr, int fq) const {
        const int rowb = u.pm * 256 + wr * 64 + fr;
        float cwv[2][4];
#pragma unroll
        for (int ai = 0; ai < 2; ++ai)
#pragma unroll
            for (int m = 0; m < 4; ++m) cwv[ai][m] = CW[rowb + ai * 128 + m * 16];
#pragma unroll
        for (int ai = 0; ai < 2; ++ai)
#pragma unroll
            for (int m = 0; m < 4; ++m) { const int row = rowb + ai * 128 + m * 16; const float cw = cwv[ai][m];
                float x[8];
#pragma unroll
                for (int i = 0; i < 8; ++i) x[i] = siluf_(acc[ai][0][m][i >> 2][i & 3]) * acc[ai][1][m][i >> 2][i & 3] * cw;
                u32x4 w; w.x = cvt_pk_bf16(x[0], x[1]); w.y = cvt_pk_bf16(x[2], x[3]); w.z = cvt_pk_bf16(x[4], x[5]); w.w = cvt_pk_bf16(x[6], x[7]);
                st16<4>((GAS u32x4*)(HID + (size_t)row * DEXP + 128 * u.pn + 32 * wc + 8 * fq), w); }
    }
};
struct EpiDN {
    static constexpr bool PERM = true; static constexpr int NST = 16;
    GAS bf16* FF2;
    __device__ __forceinline__ void operator()(const f32x4 (&acc)[2][2][4][2], const pg8::Unit& u, int wr, int wc, int fr, int fq) const {
        const int rowb = u.pm * 256 + wr * 64 + fr;
#pragma unroll
        for (int ai = 0; ai < 2; ++ai)
#pragma unroll
            for (int m = 0; m < 4; ++m) { const int row = rowb + ai * 128 + m * 16;
#pragma unroll
                for (int bj = 0; bj < 2; ++bj) { u32x4 w; w.x = cvt_pk_bf16(acc[ai][bj][m][0][0], acc[ai][bj][m][0][1]); w.y = cvt_pk_bf16(acc[ai][bj][m][0][2], acc[ai][bj][m][0][3]);
                    w.z = cvt_pk_bf16(acc[ai][bj][m][1][0], acc[ai][bj][m][1][1]); w.w = cvt_pk_bf16(acc[ai][bj][m][1][2], acc[ai][bj][m][1][3]);
                    st16<5>((GAS u32x4*)(FF2 + (size_t)row * DM + 256 * u.pn + 128 * bj + 32 * wc + 8 * fq), w); } }
    }
};
#ifndef EN_B1
#define EN_B1 1
#endif
#ifndef EN_B2
#define EN_B2 1
#endif
#ifndef EN_B3
#define EN_B3 1
#endif

template <int CTRL> __device__ __forceinline__ float dppf(float x) { return __builtin_bit_cast(float, __builtin_amdgcn_mov_dpp(__builtin_bit_cast(int, x), CTRL, 0xf, 0xf, true)); }
template <int CTRL> __device__ __forceinline__ int dppi(int x) { return __builtin_amdgcn_mov_dpp(x, CTRL, 0xf, 0xf, true); }
typedef short v4i16_t __attribute__((ext_vector_type(4)));
typedef unsigned short u16x2 __attribute__((ext_vector_type(2)));
__device__ __forceinline__ v4i16_t ldtr(const LAS unsigned char* p) { return __builtin_amdgcn_ds_read_tr16_b64_v4i16((LAS v4i16_t*)p); }
__device__ __forceinline__ bf16x8 cat8(v4i16_t lo, v4i16_t hi) { bf16x8 r; r[0] = lo[0]; r[1] = lo[1]; r[2] = lo[2]; r[3] = lo[3]; r[4] = hi[0]; r[5] = hi[1]; r[6] = hi[2]; r[7] = hi[3]; return r; }
__device__ __forceinline__ int wave_total_i(int v) {
    v += dppi<0xB1>(v); v += dppi<0x4E>(v); v += dppi<0x141>(v); v += dppi<0x140>(v);
    return __builtin_amdgcn_readlane(v, 0) + __builtin_amdgcn_readlane(v, 16) + __builtin_amdgcn_readlane(v, 32) + __builtin_amdgcn_readlane(v, 48);
}
__device__ __forceinline__ void gmlp_unit(Frame& F, int l, int unit) {
    int tid = F.tid; asm volatile("" : "+v"(tid)); const int lane = tid & 63;
    const int chunk = unit >> 2, g = unit & 3, n0 = chunk * 128;
    const GAS bf16* PA = (const GAS bf16*)(F.ws + WS_PA); GAS bf16* Y = (GAS bf16*)(F.ws + WS_Y);
    LAS float* vln = (LAS float*)F.lds;
    LAS float* wl = (LAS float*)(F.lds + 65536);
    LAS float* st = (LAS float*)(F.lds + AUX_OFF);
    const GAS float* lng = ((const GAS float*)F.in[9]) + l * 512; const GAS float* lnb = ((const GAS float*)F.in[10]) + l * 512;
    for (int j = 0; j < 16; ++j) { const int s = F.wave * 16 + j;
        const u32x4 w = *(const GAS u32x4*)(PA + (size_t)(n0 + s) * NPA + PA_CV + 8 * lane);
        float x[8] = {bflo(w.x), bfhi(w.x), bflo(w.y), bfhi(w.y), bflo(w.z), bfhi(w.z), bflo(w.w), bfhi(w.w)};
        float sm = 0.f;
#pragma unroll
        for (int i = 0; i < 8; ++i) sm += x[i];
        const float mean = wave_sum(sm, lane) * (1.f / 512.f); float q = 0.f;
#pragma unroll
        for (int i = 0; i < 8; ++i) { const float d = x[i] - mean; q += d * d; }
        const float rstd = 1.f / sqrtf(wave_sum(q, lane) * (1.f / 512.f) + LN_EPS);
        if (lane == 0) { st[2 * s] = mean; st[2 * s + 1] = rstd; } }
    __syncthreads();
#pragma unroll
    for (int i = 0; i < 4; ++i) { const int q = tid + 512 * i, s = q >> 4, d0 = (q & 15) * 8;
        const u32x4 w = *(const GAS u32x4*)(PA + (size_t)(n0 + s) * NPA + PA_CV + g * 128 + d0);
        const float mean = st[2 * s], rstd = st[2 * s + 1];
        float x[8] = {bflo(w.x), bfhi(w.x), bflo(w.y), bfhi(w.y), bflo(w.z), bfhi(w.z), bflo(w.w), bfhi(w.w)};
#pragma unroll
        for (int k = 0; k < 8; ++k) x[k] = (x[k] - mean) * rstd * lng[g * 128 + d0 + k] + lnb[g * 128 + d0 + k];
        *(LAS f32x4*)(vln + s * 128 + d0) = (f32x4){x[0], x[1], x[2], x[3]}; *(LAS f32x4*)(vln + s * 128 + d0 + 4) = (f32x4){x[4], x[5], x[6], x[7]}; }
    const GAS float* ws = ((const GAS float*)F.in[11]) + ((size_t)l * 4 + g) * 128 * 128;
#pragma unroll
    for (int i = 0; i < 8; ++i) { const int q = tid + 512 * i, t = q >> 5, s0 = (q & 31) * 4;
        f32x4 w = *(const GAS f32x4*)(ws + t * 128 + s0);
        if (s0 + 0 > t) w.x = 0.f; if (s0 + 1 > t) w.y = 0.f; if (s0 + 2 > t) w.z = 0.f; if (s0 + 3 > t) w.w = 0.f;
        *(LAS f32x4*)(wl + t * 128 + s0) = w; }
    __syncthreads();
    const int d = tid & 127, tq = __builtin_amdgcn_readfirstlane(tid >> 7);
    float vr[128];
#pragma unroll
    for (int sb = 0; sb < 4; ++sb)
        if (sb <= tq) {
#pragma unroll
            for (int s = 0; s < 32; ++s) vr[sb * 32 + s] = vln[(sb * 32 + s) * 128 + d];
        } else {
#pragma unroll
            for (int s = 0; s < 32; ++s) vr[sb * 32 + s] = 0.f;
        }
    const GAS float* bs = ((const GAS float*)F.in[12]) + ((size_t)l * 4 + g) * 128;
#pragma unroll 1
    for (int ti = 0; ti < 32; ++ti) { const int t = tq * 32 + ti; float a = 0.f;
#pragma unroll
        for (int sb = 0; sb < 4; ++sb)
            if (sb <= tq) {
#pragma unroll
                for (int s4 = 0; s4 < 8; ++s4) { const f32x4 w = *(const LAS f32x4*)(wl + t * 128 + sb * 32 + s4 * 4);
                    a += w.x * vr[sb * 32 + s4 * 4] + w.y * vr[sb * 32 + s4 * 4 + 1] + w.z * vr[sb * 32 + s4 * 4 + 2] + w.w * vr[sb * 32 + s4 * 4 + 3]; }
            }
        const float uu = bf1(PA[(size_t)(n0 + t) * NPA + PA_CU + g * 128 + d]);
        Y[(size_t)(n0 + t) * 1536 + 1024 + g * 128 + d] = (bf16)f2bf(uu * (a + bs[t])); }
    __syncthreads();
}

__device__ __forceinline__ void gmlp16_unit(Frame& F, int l, int chunk) {
    const int lane = fresh_lane(), w = F.wave, tid = w * 64 + lane, fr = lane & 15, fq = lane >> 4;
    const size_t n0 = (size_t)chunk * 128;
    const GAS bf16* PA = (const GAS bf16*)(F.ws + WS_PA); GAS bf16* Y = (GAS bf16*)(F.ws + WS_Y);
    LAS unsigned char* VT = F.lds;
    LAS unsigned char* WT = F.lds + 32768;
    LAS float* st = (LAS float*)(F.lds + AUX_OFF);
    const GAS float* lng = ((const GAS float*)F.in[9]) + l * 512; const GAS float* lnb = ((const GAS float*)F.in[10]) + l * 512;
    for (int j = 0; j < 16; ++j) { const int s = w * 16 + j;
        const u32x4 x4 = *(const GAS u32x4*)(PA + (n0 + s) * NPA + PA_CV + 8 * lane);
        float x[8] = {bflo(x4.x), bfhi(x4.x), bflo(x4.y), bfhi(x4.y), bflo(x4.z), bfhi(x4.z), bflo(x4.w), bfhi(x4.w)};
        float sm = 0.f;
#pragma unroll
        for (int i = 0; i < 8; ++i) sm += x[i];
        const float mean = wave_sum(sm, lane) * (1.f / 512.f); float q = 0.f;
#pragma unroll
        for (int i = 0; i < 8; ++i) { const float d = x[i] - mean; q += d * d; }
        const float rstd = 1.f / sqrtf(wave_sum(q, lane) * (1.f / 512.f) + LN_EPS);
        if (lane == 0) { st[2 * s] = mean; st[2 * s + 1] = rstd; } }
    __syncthreads();
#pragma unroll 1
    for (int g = 0; g < 4; ++g) {
        const GAS float* ws = ((const GAS float*)F.in[11]) + ((size_t)l * 4 + g) * 128 * 128;
#pragma unroll
        for (int i = 0; i < 4; ++i) { const int q = tid + 512 * i, s = q >> 4, d0 = (q & 15) * 8;
            const u32x4 x4 = *(const GAS u32x4*)(PA + (n0 + s) * NPA + PA_CV + g * 128 + d0);
            const float mean = st[2 * s], rstd = st[2 * s + 1];
            float x[8] = {bflo(x4.x), bfhi(x4.x), bflo(x4.y), bfhi(x4.y), bflo(x4.z), bfhi(x4.z), bflo(x4.w), bfhi(x4.w)};
            const f32x4 g0 = *(const GAS f32x4*)(lng + g * 128 + d0), g1 = *(const GAS f32x4*)(lng + g * 128 + d0 + 4), b0 = *(const GAS f32x4*)(lnb + g * 128 + d0), b1 = *(const GAS f32x4*)(lnb + g * 128 + d0 + 4);
#pragma unroll
            for (int k = 0; k < 8; ++k) x[k] = (x[k] - mean) * rstd * ((k < 4) ? g0[k & 3] : g1[k & 3]) + ((k < 4) ? b0[k & 3] : b1[k & 3]);
            u32x4 o; o.x = cvt_pk_bf16(x[0], x[1]); o.y = cvt_pk_bf16(x[2], x[3]); o.z = cvt_pk_bf16(x[4], x[5]); o.w = cvt_pk_bf16(x[6], x[7]);
            *(LAS u32x4*)(VT + s * 256 + d0 * 2) = o;
            const int t = s, s0 = d0;
            f32x4 w0 = *(const GAS f32x4*)(ws + t * 128 + s0), w1 = *(const GAS f32x4*)(ws + t * 128 + s0 + 4);
            float wv[8] = {w0.x, w0.y, w0.z, w0.w, w1.x, w1.y, w1.z, w1.w};
#pragma unroll
            for (int k = 0; k < 8; ++k) wv[k] = (s0 + k <= t) ? wv[k] : 0.f;
            u32x4 ow; ow.x = cvt_pk_bf16(wv[0], wv[1]); ow.y = cvt_pk_bf16(wv[2], wv[3]); ow.z = cvt_pk_bf16(wv[4], wv[5]); ow.w = cvt_pk_bf16(wv[6], wv[7]);
            *(LAS u32x4*)(WT + t * 256 + s0 * 2) = ow; }
        __syncthreads();
        f32x4 acc[8];
#pragma unroll
        for (int nt = 0; nt < 8; ++nt) acc[nt] = (f32x4){0.f, 0.f, 0.f, 0.f};
        const int nks = (16 * w + 15) / 32 + 1;
#pragma unroll
        for (int ks = 0; ks < 4; ++ks) if (ks < nks) {
            const bf16x8 a = *(const LAS bf16x8*)(WT + (16 * w + fr) * 256 + (8 * fq + 32 * ks) * 2);
            const int srow = 32 * ks + 8 * fq + (fr >> 2);
#pragma unroll
            for (int nt = 0; nt < 8; ++nt) { const bf16x8 bv = cat8(ldtr(VT + srow * 256 + (16 * nt + 4 * (fr & 3)) * 2), ldtr(VT + (srow + 4) * 256 + (16 * nt + 4 * (fr & 3)) * 2));
                acc[nt] = __builtin_amdgcn_mfma_f32_16x16x32_bf16(bv, a, acc[nt], 0, 0, 0); } }
        const GAS float* bs = ((const GAS float*)F.in[12]) + ((size_t)l * 4 + g) * 128;
        { const int t = 16 * w + fr; const float bt = bs[t];
#pragma unroll
          for (int nt = 0; nt < 8; ++nt) { const int d0 = 16 * nt + 4 * fq;
              const u32x2 uu = *(const GAS u32x2*)(PA + (n0 + t) * NPA + PA_CU + g * 128 + d0);
              u32x2 wv; wv.x = pk2(bflo(uu.x) * (acc[nt][0] + bt), bfhi(uu.x) * (acc[nt][1] + bt)); wv.y = pk2(bflo(uu.y) * (acc[nt][2] + bt), bfhi(uu.y) * (acc[nt][3] + bt));
              *(GAS u32x2*)(Y + (n0 + t) * 1536 + 1024 + g * 128 + d0) = wv; } }
        __syncthreads();
    }
}

__device__ __forceinline__ void gla_unit(Frame& F, int l, int unit) {
    int tid = F.tid; asm volatile("" : "+v"(tid));
    const int b = unit >> 2, h = unit & 3;
    const GAS bf16* PA = (const GAS bf16*)(F.ws + WS_PA); GAS bf16* Y = (GAS bf16*)(F.ws + WS_Y); const GAS float* GLR = (const GAS float*)(F.ws + WS_GLR);
    LAS float* wa = (LAS float*)F.lds;
    LAS float* ba = wa + 1024;
    LAS float* as_ = ba + 64;
    LAS float* qs = as_ + 1024;
    LAS float* ks = qs + 1024;
    LAS float* vs = ks + 1024;
    LAS float* part = vs + 2048;
    for (int i = tid; i < 1024; i += 512) wa[i] = ((const GAS float*)F.in[6])[(size_t)l * 16 * 256 + (i >> 6) * 256 + h * 64 + (i & 63)];
    if (tid < 64) ba[tid] = ((const GAS float*)F.in[7])[l * 256 + h * 64 + tid];
    const GAS float* gng = ((const GAS float*)F.in[8]) + l * 128;
    const int v = tid & 127, kq = __builtin_amdgcn_readfirstlane(tid >> 7);
    float S[16];
#pragma unroll
    for (int j = 0; j < 16; ++j) S[j] = 0.f;
    __syncthreads();
    for (int t0 = 0; t0 < SEQ; t0 += 16) {
        const size_t nb = (size_t)b * SEQ + t0;
#pragma unroll
        for (int i = 0; i < 2; ++i) { const int e = tid + 512 * i, t = e >> 6, k = e & 63; float z = ba[k];
#pragma unroll
            for (int r = 0; r < 16; ++r) z += GLR[(nb + t) * 16 + r] * wa[r * 64 + k];
            const float ls = fminf(z, 0.f) - log1pf(__expf(-fabsf(z)));
            as_[e] = __expf(ls * (1.f / 16.f));
            qs[e] = bf1(PA[(nb + t) * NPA + PA_BQ + h * 64 + k]); ks[e] = bf1(PA[(nb + t) * NPA + PA_BK + h * 64 + k]); }
#pragma unroll
        for (int i = 0; i < 4; ++i) { const int e = tid + 512 * i, t = e >> 7, vv = e & 127; vs[e] = bf1(PA[(nb + t) * NPA + PA_BV + h * 128 + vv]); }
        __syncthreads();
#pragma unroll 4
        for (int t = 0; t < 16; ++t) { const float vt = vs[t * 128 + v]; float p = 0.f;
#pragma unroll
            for (int j4 = 0; j4 < 4; ++j4) { const f32x4 a4 = *(const LAS f32x4*)(as_ + t * 64 + kq * 16 + j4 * 4), k4 = *(const LAS f32x4*)(ks + t * 64 + kq * 16 + j4 * 4), q4 = *(const LAS f32x4*)(qs + t * 64 + kq * 16 + j4 * 4);
#pragma unroll
                for (int j = 0; j < 4; ++j) { S[j4 * 4 + j] = a4[j] * S[j4 * 4 + j] + k4[j] * vt; p += q4[j] * S[j4 * 4 + j]; } }
            part[(kq * 16 + t) * 128 + v] = p; }
        __syncthreads();
        { const int t = tid >> 5, v4 = (tid & 31) * 4;
          f32x4 o = *(const LAS f32x4*)(part + (0 * 16 + t) * 128 + v4);
#pragma unroll
          for (int q = 1; q < 4; ++q) o += *(const LAS f32x4*)(part + (q * 16 + t) * 128 + v4);
          float ss = o.x * o.x + o.y * o.y + o.z * o.z + o.w * o.w;
#pragma unroll
          for (int sh = 1; sh < 32; sh <<= 1) ss += shx(ss, sh, tid & 63);
          const float r = 1.f / sqrtf(ss * (1.f / 128.f) + RMS_EPS);
          const f32x4 gg = *(const GAS f32x4*)(gng + v4);
          const u32x2 brw = *(const GAS u32x2*)(PA + (nb + t) * NPA + PA_BR + h * 128 + v4);
          u32x2 w; w.x = pk2(o.x * r * gg.x * bflo(brw.x), o.y * r * gg.y * bfhi(brw.x)); w.y = pk2(o.z * r * gg.z * bflo(brw.y), o.w * r * gg.w * bfhi(brw.y));
          *(GAS u32x2*)(Y + (nb + t) * 1536 + 512 + h * 128 + v4) = w; }
        __syncthreads();
    }
}

constexpr size_t WS_US = WS_WMOE, WS_DEC = WS_WMOE + 32 * MiB;
__device__ __forceinline__ void gla_local_unit(Frame& F, int l, int unit, bool dry = false) {
    const int lane = fresh_lane(), w = F.wave, tid = w * 64 + lane, fr = lane & 15, fq = lane >> 4;
    const int b = unit >> 8, h = (unit >> 6) & 3, c = unit & 63; const size_t n0 = (size_t)b * SEQ + 64 * c;
    GAS bf16* PA = (GAS bf16*)(F.ws + WS_PA); GAS bf16* Y = (GAS bf16*)(F.ws + WS_Y); const GAS float* GLR = (const GAS float*)(F.ws + WS_GLR);
    GAS bf16* US = (GAS bf16*)(F.ws + WS_US) + (size_t)unit * 8192; GAS float* DEC = (GAS float*)(F.ws + WS_DEC) + unit * 64;
    LAS unsigned char* QT = F.lds; LAS unsigned char* KT = F.lds + 8192; LAS unsigned char* KD = F.lds + 16384; LAS unsigned char* VV = F.lds + 24576; LAS unsigned char* ATT = F.lds + 40960;
    LAS float* SEG = (LAS float*)(F.lds + 65536); LAS float* WA = (LAS float*)(F.lds + 67584); LAS float* BA = (LAS float*)(F.lds + 71680); LAS float* GL = (LAS float*)(F.lds + 71936);
    const int k = tid & 63, seg = w;
    float qv8[8], kv8[8];
#pragma unroll
    for (int i = 0; i < 8; ++i) { const int t = 8 * seg + i; qv8[i] = bf1(PA[(n0 + t) * NPA + PA_BQ + h * 64 + k]); kv8[i] = bf1(PA[(n0 + t) * NPA + PA_BK + h * 64 + k]); }
    if (tid < 256) *(LAS f32x4*)(GL + 4 * tid) = *(const GAS f32x4*)(GLR + n0 * 16 + 4 * tid);
#pragma unroll
    for (int i = 0; i < 2; ++i) { const int e = tid + 512 * i; WA[e] = ((const GAS float*)F.in[6])[(size_t)l * 16 * 256 + (e >> 6) * 256 + h * 64 + (e & 63)]; }
    if (tid < 64) BA[tid] = ((const GAS float*)F.in[7])[l * 256 + h * 64 + tid];
#pragma unroll
    for (int i = 0; i < 2; ++i) { const int piece = tid + 512 * i, row = piece >> 4, c16 = piece & 15;
        *(LAS u32x4*)(VV + row * 256 + c16 * 16) = *(const GAS u32x4*)(PA + (n0 + row) * NPA + PA_BV + h * 128 + 8 * c16); }
    __syncthreads();
    float cum[8];
    { float run = 0.f;
#pragma unroll
      for (int i = 0; i < 8; ++i) { const int t = 8 * seg + i; float z = BA[k];
          const f32x4 g0 = *(const LAS f32x4*)(GL + t * 16), g1 = *(const LAS f32x4*)(GL + t * 16 + 4), g2 = *(const LAS f32x4*)(GL + t * 16 + 8), g3 = *(const LAS f32x4*)(GL + t * 16 + 12);
#pragma unroll
          for (int r = 0; r < 4; ++r) { z += g0[r] * WA[r * 64 + k]; z += g1[r] * WA[(4 + r) * 64 + k]; z += g2[r] * WA[(8 + r) * 64 + k]; z += g3[r] * WA[(12 + r) * 64 + k]; }
          const float ls = fminf(z, 0.f) - log1pf(__expf(-fabsf(z)));
          run += ls * (1.f / 16.f); cum[i] = run; }
      SEG[seg * 64 + k] = run; }
    __syncthreads();
    { float off = 0.f, blast = 0.f;
#pragma unroll
      for (int s2 = 0; s2 < 8; ++s2) { const float sv = SEG[s2 * 64 + k]; blast += sv; off += (s2 < seg) ? sv : 0.f; }
#pragma unroll
      for (int i = 0; i < 8; ++i) { const int t = 8 * seg + i; const float bb = cum[i] + off;
          const float qv = qv8[i], kv = kv8[i];
          const unsigned qt = f2bf(qv * __expf(bb));
          ((LAS unsigned short*)QT)[t * 64 + k] = (unsigned short)qt; ((LAS unsigned short*)KT)[t * 64 + k] = (unsigned short)f2bf(kv * __expf(-bb)); ((LAS unsigned short*)KD)[t * 64 + k] = (unsigned short)f2bf(kv * __expf(blast - bb));
          if (!dry) PA[(n0 + t) * NPA + PA_BQ + h * 64 + k] = (bf16)qt; }
      if (seg == 0) DEC[k] = __expf(blast); }
    __syncthreads();
#pragma unroll
    for (int ii = 0; ii < 2; ++ii) { const int id = 2 * w + ii, ts = id >> 2, tt = id & 3;
        f32x4 d = {0.f, 0.f, 0.f, 0.f};
        if (ts <= tt) {
#pragma unroll
            for (int ks = 0; ks < 2; ++ks) { const bf16x8 a = *(const LAS bf16x8*)(KT + (16 * ts + fr) * 128 + (8 * fq + 32 * ks) * 2), bq = *(const LAS bf16x8*)(QT + (16 * tt + fr) * 128 + (8 * fq + 32 * ks) * 2);
                d = __builtin_amdgcn_mfma_f32_16x16x32_bf16(a, bq, d, 0, 0, 0); } }
        const int t = 16 * tt + fr, s0 = 16 * ts + 4 * fq;
        u32x2 pk; pk.x = cvt_pk_bf16((s0 <= t) ? d[0] : 0.f, (s0 + 1 <= t) ? d[1] : 0.f); pk.y = cvt_pk_bf16((s0 + 2 <= t) ? d[2] : 0.f, (s0 + 3 <= t) ? d[3] : 0.f);
        *(LAS u32x2*)(ATT + t * 128 + s0 * 2) = pk; }
    __syncthreads();
    { const int tr = w & 3, nh = w >> 2;
      f32x4 ao[4], au[4];
#pragma unroll
      for (int j = 0; j < 4; ++j) { ao[j] = (f32x4){0.f, 0.f, 0.f, 0.f}; au[j] = (f32x4){0.f, 0.f, 0.f, 0.f}; }
#pragma unroll
      for (int ks = 0; ks < 2; ++ks) {
          const bf16x8 aA = *(const LAS bf16x8*)(ATT + (16 * tr + fr) * 128 + (8 * fq + 32 * ks) * 2);
          const int srow = 32 * ks + 8 * fq + (fr >> 2);
          const bf16x8 aK = cat8(ldtr(KD + srow * 128 + (16 * tr + 4 * (fr & 3)) * 2), ldtr(KD + (srow + 4) * 128 + (16 * tr + 4 * (fr & 3)) * 2));
#pragma unroll
          for (int j = 0; j < 4; ++j) { const int nt = 4 * nh + j;
              const bf16x8 bv = cat8(ldtr(VV + srow * 256 + (16 * nt + 4 * (fr & 3)) * 2), ldtr(VV + (srow + 4) * 256 + (16 * nt + 4 * (fr & 3)) * 2));
              ao[j] = __builtin_amdgcn_mfma_f32_16x16x32_bf16(bv, aA, ao[j], 0, 0, 0);
              au[j] = __builtin_amdgcn_mfma_f32_16x16x32_bf16(bv, aK, au[j], 0, 0, 0); } }
#pragma unroll
      for (int j = 0; j < 4; ++j) { const int v0 = 16 * (4 * nh + j) + 4 * fq, row = 16 * tr + fr;
          u32x2 wo; wo.x = pk2(ao[j][0], ao[j][1]); wo.y = pk2(ao[j][2], ao[j][3]); *(GAS u32x2*)(Y + (n0 + row) * 1536 + 512 + h * 128 + v0) = wo;
          u32x2 wu; wu.x = pk2(au[j][0], au[j][1]); wu.y = pk2(au[j][2], au[j][3]); *(GAS u32x2*)(US + row * 128 + v0) = wu; } }
    __syncthreads();
}
__device__ __forceinline__ void gla_scan_phase(Frame& F, bool dry = false) {
    GAS bf16* USb = (GAS bf16*)(F.ws + WS_US); const GAS float* DECb = (const GAS float*)(F.ws + WS_DEC); const size_t dofs = dry ? (size_t)((GAS unsigned char*)F.H - (F.ws + WS_US)) / 4 : 0;
    for (int gt = F.wg * 512 + F.tid; gt < 131072; gt += F.G * 512) { const int e0 = 2 * gt, bh = e0 >> 13, kv = e0 & 8191, k = kv >> 7;
        GAS unsigned* p = (GAS unsigned*)(USb + (size_t)bh * 64 * 8192 + kv); const GAS float* dp = DECb + bh * 64 * 64 + k;
        float s0 = 0.f, s1 = 0.f;
#pragma unroll 8
        for (int c = 0; c < 64; ++c) { const unsigned u = p[(size_t)c * 4096]; const float d = dp[c * 64];
            p[(size_t)c * 4096 + dofs] = pk2(s0, s1);
            s0 = d * s0 + bflo(u); s1 = d * s1 + bfhi(u); } }
}
struct GlaOutRegs { u32x4 us[2]; bf16x8 aq[2]; u32x2 oi[4]; u32x2 br[4]; };
__device__ __forceinline__ void gla_out_load(Frame& F, int unit, int tid, int w, int fr, int fq, GlaOutRegs& R) {
    const int b = unit >> 8, h = (unit >> 6) & 3, c = unit & 63; const size_t n0 = (size_t)b * SEQ + 64 * c;
    const GAS bf16* PA = (const GAS bf16*)(F.ws + WS_PA); const GAS bf16* Y = (const GAS bf16*)(F.ws + WS_Y);
    const GAS bf16* US = (const GAS bf16*)(F.ws + WS_US) + (size_t)unit * 8192;
    const int tr = w >> 1, nh = w & 1, row = 16 * tr + fr;
#pragma unroll
    for (int i = 0; i < 2; ++i) R.us[i] = *(const GAS u32x4*)(US + (tid + 512 * i) * 8);
#pragma unroll
    for (int ks = 0; ks < 2; ++ks) R.aq[ks] = *(const GAS bf16x8*)(PA + (n0 + row) * NPA + PA_BQ + h * 64 + 8 * fq + 32 * ks);
#pragma unroll
    for (int j = 0; j < 4; ++j) { const int v0 = 16 * (4 * nh + j) + 4 * fq; R.oi[j] = *(const GAS u32x2*)(Y + (n0 + row) * 1536 + 512 + h * 128 + v0); R.br[j] = *(const GAS u32x2*)(PA + (n0 + row) * NPA + PA_BR + h * 128 + v0); }
}
__device__ __forceinline__ void gla_out_compute(Frame& F, int l, int unit, int tid, int lane, int w, int fr, int fq, const GlaOutRegs& R, bool dry = false) {
    const int b = unit >> 8, h = (unit >> 6) & 3, c = unit & 63; const size_t n0 = (size_t)b * SEQ + 64 * c;
    GAS bf16* Y = dry ? (GAS bf16*)F.H : (GAS bf16*)(F.ws + WS_Y);
    LAS unsigned char* SS = F.lds;
    LAS float* PS = (LAS float*)(F.lds + 16384);
    const GAS float* gng = ((const GAS float*)F.in[8]) + l * 128;
#pragma unroll
    for (int i = 0; i < 2; ++i) *(LAS u32x4*)(SS + (tid + 512 * i) * 16) = R.us[i];
    __syncthreads();
    const int tr = w >> 1, nh = w & 1, row = 16 * tr + fr;
    f32x4 acc[4];
#pragma unroll
    for (int j = 0; j < 4; ++j) acc[j] = (f32x4){0.f, 0.f, 0.f, 0.f};
#pragma unroll
    for (int ks = 0; ks < 2; ++ks) { const int krow = 32 * ks + 8 * fq + (fr >> 2);
#pragma unroll
        for (int j = 0; j < 4; ++j) { const int nt = 4 * nh + j;
            const bf16x8 bs = cat8(ldtr(SS + krow * 256 + (16 * nt + 4 * (fr & 3)) * 2), ldtr(SS + (krow + 4) * 256 + (16 * nt + 4 * (fr & 3)) * 2));
            acc[j] = __builtin_amdgcn_mfma_f32_16x16x32_bf16(bs, R.aq[ks], acc[j], 0, 0, 0); } }
    float ss = 0.f;
#pragma unroll
    for (int j = 0; j < 4; ++j) { const u32x2 oi = R.oi[j];
        acc[j][0] += bflo(oi.x); acc[j][1] += bfhi(oi.x); acc[j][2] += bflo(oi.y); acc[j][3] += bfhi(oi.y);
        ss += (acc[j][0] * acc[j][0] + acc[j][1] * acc[j][1]) + (acc[j][2] * acc[j][2] + acc[j][3] * acc[j][3]); }
    ss += shx(ss, 16, lane); ss += shx(ss, 32, lane);
    if (fq == 0) PS[row * 2 + nh] = ss;
    __syncthreads();
    { const float rinv = 1.f / sqrtf((PS[row * 2] + PS[row * 2 + 1]) * (1.f / 128.f) + RMS_EPS);
#pragma unroll
      for (int j = 0; j < 4; ++j) { const int v0 = 16 * (4 * nh + j) + 4 * fq; const f32x4 gg = *(const GAS f32x4*)(gng + v0); const u32x2 br = R.br[j];
          u32x2 wv; wv.x = pk2(acc[j][0] * rinv * gg[0] * bflo(br.x), acc[j][1] * rinv * gg[1] * bfhi(br.x)); wv.y = pk2(acc[j][2] * rinv * gg[2] * bflo(br.y), acc[j][3] * rinv * gg[3] * bfhi(br.y));
          *(GAS u32x2*)(Y + (n0 + row) * 1536 + 512 + h * 128 + v0) = wv; } }
    __syncthreads();
}
constexpr int DSA_WAVE_LDS = 17920;
__device__ __forceinline__ void dsa_unit(Frame& F, int unit) {
    int lane = F.lane; asm volatile("" : "+v"(lane)); const int w = F.wave;
    const int qb = 4095 - unit;
    const int b = qb & 7, t = (qb >> 3) * 8 + w;
    const size_t n = (size_t)b * SEQ + t, nb0 = (size_t)b * SEQ;
    const GAS bf16* PA = (const GAS bf16*)(F.ws + WS_PA); GAS bf16* Y = (GAS bf16*)(F.ws + WS_Y);
    const GAS bf16* KI = (const GAS bf16*)(F.ws + WS_KI); const GAS bf16* KA = (const GAS bf16*)(F.ws + WS_KA); const GAS bf16* VA = (const GAS bf16*)(F.ws + WS_VA);
    const GAS float* WI = (const GAS float*)(F.ws + WS_WI);
    LAS unsigned char* base = F.lds + w * DSA_WAVE_LDS;
    LAS unsigned* sc = (LAS unsigned*)base;
    LAS float* qi = (LAS float*)(base + 16384);
    LAS unsigned short* list = (LAS unsigned short*)(base + 16384 + 1024);
    { const u32x2 q2 = *(const GAS u32x2*)(PA + n * NPA + PA_QI + 4 * lane);
      *(LAS f32x4*)(qi + 4 * lane) = (f32x4){bflo(q2.x), bfhi(q2.x), bflo(q2.y), bfhi(q2.y)}; }
    asm volatile("s_waitcnt lgkmcnt(0)" ::: "memory");
    const f32x4 wi = {ld_f32(WI + n * 4), ld_f32(WI + n * 4 + 1), ld_f32(WI + n * 4 + 2), ld_f32(WI + n * 4 + 3)};
    const int nbat = (t >> 6) + 1;
    for (int kb = 0; kb < nbat; ++kb) { const int key = kb * 64 + lane, kc = key <= t ? key : t;
        const GAS u32x4* kp = (const GAS u32x4*)(KI + (nb0 + kc) * 64);
        float kf[64];
#pragma unroll
        for (int c = 0; c < 8; ++c) { const u32x4 kk = kp[c]; kf[8 * c] = bflo(kk.x); kf[8 * c + 1] = bfhi(kk.x); kf[8 * c + 2] = bflo(kk.y); kf[8 * c + 3] = bfhi(kk.y); kf[8 * c + 4] = bflo(kk.z); kf[8 * c + 5] = bfhi(kk.z); kf[8 * c + 6] = bflo(kk.w); kf[8 * c + 7] = bfhi(kk.w); }
        float score = 0.f;
#pragma unroll
        for (int h = 0; h < 4; ++h) { float d = 0.f;
#pragma unroll
            for (int c = 0; c < 16; ++c) { const f32x4 q4 = *(const LAS f32x4*)(qi + h * 64 + 4 * c); d += q4.x * kf[4 * c] + q4.y * kf[4 * c + 1] + q4.z * kf[4 * c + 2] + q4.w * kf[4 * c + 3]; }
            score += wi[h] * fmaxf(d, 0.f); }
        if (score == 0.f) score = 0.f;
        unsigned u = __builtin_bit_cast(unsigned, score); u = (u & 0x80000000u) ? ~u : (u | 0x80000000u);
        sc[key] = key <= t ? u : 0u; }
    asm volatile("s_waitcnt lgkmcnt(0)" ::: "memory");
    int nsel;
    if (t >= 256) {
        unsigned T = 0u;
        for (int bit = 31; bit >= 0; --bit) { const unsigned cand = T | (1u << bit); int cnt = 0;
            for (int j = 0; j < nbat; ++j) cnt += (sc[j * 64 + lane] >= cand) ? 1 : 0;
            if (wave_sum_i(cnt, lane) >= 256) T = cand; }
        int cgt = 0;
        for (int j = 0; j < nbat; ++j) cgt += (sc[j * 64 + lane] > T) ? 1 : 0;
        const int need = 256 - wave_sum_i(cgt, lane);
        int selbase = 0, tiebase = 0;
        for (int j = 0; j < nbat; ++j) { const unsigned x = sc[j * 64 + lane]; const bool eq = (x == T), gt = (x > T);
            const unsigned long long beq = __ballot(eq); const unsigned long long lt = (1ull << lane) - 1ull;
            const int trank = tiebase + __popcll(beq & lt);
            const bool sel = gt || (eq && trank < need);
            const unsigned long long bsel = __ballot(sel);
            if (sel) list[selbase + __popcll(bsel & lt)] = (unsigned short)(j * 64 + lane);
            selbase += __popcll(bsel); tiebase += __popcll(beq); }
        nsel = 256;
    } else {
        nsel = t + 1;
        for (int i = lane; i < 256; i += 64) list[i] = (unsigned short)(i <= t ? i : 0);
    }
    asm volatile("s_waitcnt lgkmcnt(0)" ::: "memory");
    LAS float* qm = (LAS float*)base;
    LAS float* Pl = (LAS float*)(base + 2048);
    { const u32x4 q8 = *(const GAS u32x4*)(PA + n * NPA + PA_Q + 8 * lane);
      *(LAS f32x4*)(qm + 8 * lane) = (f32x4){bflo(q8.x), bfhi(q8.x), bflo(q8.y), bfhi(q8.y)}; *(LAS f32x4*)(qm + 8 * lane + 4) = (f32x4){bflo(q8.z), bfhi(q8.z), bflo(q8.w), bfhi(q8.w)}; }
    asm volatile("s_waitcnt lgkmcnt(0)" ::: "memory");
#pragma unroll 1
    for (int bb = 0; bb < 4; ++bb) { const int i = bb * 64 + lane; const bool valid = i < nsel; const int key = valid ? (int)list[i] : 0;
        const GAS u32x4* kp = (const GAS u32x4*)(KA + (nb0 + key) * 64);
        float kf[64];
#pragma unroll
        for (int c = 0; c < 8; ++c) { const u32x4 kk = kp[c]; kf[8 * c] = bflo(kk.x); kf[8 * c + 1] = bfhi(kk.x); kf[8 * c + 2] = bflo(kk.y); kf[8 * c + 3] = bfhi(kk.y); kf[8 * c + 4] = bflo(kk.z); kf[8 * c + 5] = bfhi(kk.z); kf[8 * c + 6] = bflo(kk.w); kf[8 * c + 7] = bfhi(kk.w); }
        float lgv[8];
#pragma unroll
        for (int h = 0; h < 8; ++h) { float d = 0.f;
#pragma unroll
            for (int c = 0; c < 16; ++c) { const f32x4 q4 = *(const LAS f32x4*)(qm + h * 64 + 4 * c); d += q4.x * kf[4 * c] + q4.y * kf[4 * c + 1] + q4.z * kf[4 * c + 2] + q4.w * kf[4 * c + 3]; }
            lgv[h] = valid ? d : -INFINITY; }
        *(LAS f32x4*)(Pl + i * 8) = (f32x4){lgv[0], lgv[1], lgv[2], lgv[3]}; *(LAS f32x4*)(Pl + i * 8 + 4) = (f32x4){lgv[4], lgv[5], lgv[6], lgv[7]}; }
    asm volatile("s_waitcnt lgkmcnt(0)" ::: "memory");
    float lg[4][8];
#pragma unroll
    for (int bb = 0; bb < 4; ++bb) { const f32x4 a = *(const LAS f32x4*)(Pl + (bb * 64 + lane) * 8), c = *(const LAS f32x4*)(Pl + (bb * 64 + lane) * 8 + 4);
        lg[bb][0] = a.x; lg[bb][1] = a.y; lg[bb][2] = a.z; lg[bb][3] = a.w; lg[bb][4] = c.x; lg[bb][5] = c.y; lg[bb][6] = c.z; lg[bb][7] = c.w; }
    float den[8];
#pragma unroll
    for (int h = 0; h < 8; ++h) { float m = fmaxf(fmaxf(lg[0][h], lg[1][h]), fmaxf(lg[2][h], lg[3][h])); m = wave_max(m, lane); float s = 0.f;
#pragma unroll
        for (int bb = 0; bb < 4; ++bb) { lg[bb][h] = __expf(lg[bb][h] - m); s += lg[bb][h]; }
        den[h] = wave_sum(s, lane); }
#pragma unroll
    for (int bb = 0; bb < 4; ++bb) { const int i = bb * 64 + lane;
        *(LAS f32x4*)(Pl + i * 8) = (f32x4){lg[bb][0], lg[bb][1], lg[bb][2], lg[bb][3]}; *(LAS f32x4*)(Pl + i * 8 + 4) = (f32x4){lg[bb][4], lg[bb][5], lg[bb][6], lg[bb][7]}; }
    asm volatile("s_waitcnt lgkmcnt(0)" ::: "memory");
    float o[8];
#pragma unroll
    for (int h = 0; h < 8; ++h) o[h] = 0.f;
#pragma unroll 4
    for (int i = 0; i < nsel; ++i) { const int key = (int)list[i]; const float vv = bf1(VA[(nb0 + key) * 64 + lane]);
        const f32x4 p0 = *(const LAS f32x4*)(Pl + i * 8), p1 = *(const LAS f32x4*)(Pl + i * 8 + 4);
        o[0] += p0.x * vv; o[1] += p0.y * vv; o[2] += p0.z * vv; o[3] += p0.w * vv; o[4] += p1.x * vv; o[5] += p1.y * vv; o[6] += p1.z * vv; o[7] += p1.w * vv; }
#pragma unroll
    for (int h = 0; h < 8; ++h) Y[n * 1536 + h * 64 + lane] = (bf16)f2bf(o[h] / den[h]);
}

__device__ __forceinline__ bf16x8 scale_pack8(u32x4 raw, float s) {
    u32x4 o; o.x = cvt_pk_bf16(bflo(raw.x) * s, bfhi(raw.x) * s); o.y = cvt_pk_bf16(bflo(raw.y) * s, bfhi(raw.y) * s); o.z = cvt_pk_bf16(bflo(raw.z) * s, bfhi(raw.z) * s); o.w = cvt_pk_bf16(bflo(raw.w) * s, bfhi(raw.w) * s);
    return __builtin_bit_cast(bf16x8, o);
}
__device__ __forceinline__ void dsa16_unit(Frame& F, int unit) {
    const int lane = fresh_lane(); const int w = F.wave;
    const int qb = 2047 - unit;
    const int b = qb & 7, t0 = (qb >> 3) * 16;
    const size_t nb0 = (size_t)b * SEQ;
    const GAS bf16* PA = (const GAS bf16*)(F.ws + WS_PA); GAS bf16* Y = (GAS bf16*)(F.ws + WS_Y);
    const GAS bf16* KI = (const GAS bf16*)(F.ws + WS_KI); const GAS bf16* KA = (const GAS bf16*)(F.ws + WS_KA); const GAS bf16* VA = (const GAS bf16*)(F.ws + WS_VA);
    const GAS float* WI = (const GAS float*)(F.ws + WS_WI);
    LAS unsigned char* K16 = F.lds;
    LAS unsigned short* LIST = (LAS unsigned short*)(F.lds + AUX_OFF);
    const int fr = lane & 15, fq = lane >> 4;
    {
        const int ql = fr >> 2, h = fr & 3;
        bf16x8 Bf[4][2]; f32x4 Linf[4];
#pragma unroll
        for (int g = 0; g < 4; ++g) { const size_t nq = nb0 + t0 + 4 * g + ql; const float wv = WI[nq * 4 + h];
#pragma unroll
            for (int ks = 0; ks < 2; ++ks) Bf[g][ks] = scale_pack8(*(const GAS u32x4*)(PA + nq * NPA + PA_QI + h * 64 + 8 * fq + 32 * ks), wv);
            const f32x4 w4 = *(const GAS f32x4*)(WI + (nb0 + t0 + 4 * g + fq) * 4);
#pragma unroll
            for (int r = 0; r < 4; ++r) Linf[g][r] = (w4[r] >= 0.f) ? INFINITY : -INFINITY; }
        const int ntiles = (t0 >> 4) + 1;
        const bool hist_on = (t0 >= 256); LAS unsigned* H0f = (LAS unsigned*)(F.lds + AUX_OFF + 8192) + fq * 256;
        bf16x8 A0[4], A1[4];
#pragma unroll
        for (int j = 0; j < 4; ++j) { const int tile = (w + 8 * j < ntiles) ? w + 8 * j : ntiles - 1; const size_t krow = (nb0 + 16 * tile + fr) * 64;
            A0[j] = *(const GAS bf16x8*)(KI + krow + 8 * fq); A1[j] = *(const GAS bf16x8*)(KI + krow + 32 + 8 * fq); }
#pragma unroll 1
        for (int tb = w; tb < ntiles; tb += 32) {
            bf16x8 N0[4], N1[4];
#pragma unroll
            for (int j = 0; j < 4; ++j) { const int tn = tb + 32 + 8 * j; const int tile = (tn < ntiles) ? tn : ntiles - 1; const size_t krow = (nb0 + 16 * tile + fr) * 64;
                N0[j] = *(const GAS bf16x8*)(KI + krow + 8 * fq); N1[j] = *(const GAS bf16x8*)(KI + krow + 32 + 8 * fq); }
#pragma unroll
            for (int j = 0; j < 4; ++j) { const int tile = tb + 8 * j;
                if (tile < ntiles) {
                    const int kpos = 16 * tile + fr;
                    const int g7 = kpos >> 7, hf = (kpos >> 6) & 1, ln = kpos & 63;
                    const int koff = (g7 >> 2) * 1024 + ln * 16 + (g7 & 3) * 4 + hf * 2 + fq * 8192;
                    const bool lastt = (tile == ntiles - 1);
                    f32x4 d[4];
#pragma unroll
                    for (int g = 0; g < 4; ++g) d[g] = __builtin_amdgcn_mfma_f32_16x16x32_bf16(Bf[g][0], A0[j], (f32x4){0.f, 0.f, 0.f, 0.f}, 0, 0, 0);
#pragma unroll
                    for (int g = 0; g < 4; ++g) d[g] = __builtin_amdgcn_mfma_f32_16x16x32_bf16(Bf[g][1], A1[j], d[g], 0, 0, 0);
#pragma unroll
                    for (int g = 0; g < 4; ++g) {
                        const float s = ((__builtin_amdgcn_fmed3f(d[g][0], 0.f, Linf[g][0]) + __builtin_amdgcn_fmed3f(d[g][1], 0.f, Linf[g][1])) + (__builtin_amdgcn_fmed3f(d[g][2], 0.f, Linf[g][2]) + __builtin_amdgcn_fmed3f(d[g][3], 0.f, Linf[g][3]))) + 0.0f;
                        const _Float16 hh = (_Float16)s; const unsigned hb = (unsigned)__builtin_bit_cast(unsigned short, hh);
                        unsigned key = (hb ^ ((unsigned)((int)(hb << 16) >> 31) | 0x8000u)) & 0xffffu; if (lastt) key = (kpos <= t0 + 4 * g + fq) ? key : 0u;
                        *(LAS unsigned short*)(K16 + koff + g * 32768) = (unsigned short)key;
                        if (hist_on) __hip_atomic_fetch_add(H0f + g * 1024 + (key >> 8), 1u, __ATOMIC_RELAXED, __HIP_MEMORY_SCOPE_WORKGROUP); }
                }
            }
#pragma unroll
            for (int j = 0; j < 4; ++j) { A0[j] = N0[j]; A1[j] = N1[j]; }
        }
    }
    __syncthreads();
    if (t0 < 256) {
#pragma unroll 1
        for (int qq = 0; qq < 2; ++qq) { const int q = 2 * w + qq, nvalid = t0 + q + 1; LAS unsigned short* list = LIST + q * 256;
            for (int i = lane; i < 256; i += 64) list[i] = (unsigned short)(i < nvalid ? i : 0); }
    } else {
#ifndef REP_S2
#define REP_S2 1
#endif
        LAS unsigned* hist = (LAS unsigned*)(F.lds + AUX_OFF + 8192) + w * 512;
        u32x4 hb0[2];
        hb0[0] = *(const LAS u32x4*)(hist + 4 * lane); hb0[1] = *(const LAS u32x4*)(hist + 256 + 4 * lane);
#pragma unroll 1
        for (int qq = 0; qq < 2 * REP_S2; ++qq) {
            const int q = 2 * w + (qq & 1), nvalid = t0 + q + 1;
            LAS unsigned short* list = LIST + q * 256;
            const int ngrp = (nvalid + 511) >> 9;
            unsigned P[32];
#pragma unroll
            for (int grp = 0; grp < 8; ++grp) {
                if (grp < ngrp) { const u32x4 r = *(const LAS u32x4*)(K16 + q * 8192 + grp * 1024 + lane * 16);
#pragma unroll
                    for (int i = 0; i < 4; ++i) { const int g = 4 * grp + i; const int thr = nvalid - 128 * g; unsigned rr = r[i];
                        if (thr < 128) rr &= ((lane < thr) ? 0xffffu : 0u) | ((lane < thr - 64) ? 0xffff0000u : 0u);
                        P[g] = rr; }
                } else {
#pragma unroll
                    for (int i = 0; i < 4; ++i) P[4 * grp + i] = 0u;
                }
            }
            unsigned one2 = 0x00010001u; asm volatile("" : "+v"(one2));
#define DSA_PKCOUNT(dst, c1) do { const unsigned c1p_ = (c1) | ((c1) << 16); unsigned a_ = 0u; \
                _Pragma("unroll") for (int grp = 0; grp < 8; ++grp) if (grp < ngrp) { _Pragma("unroll") for (int i = 0; i < 4; ++i) { unsigned y_; \
                    asm("v_pk_sub_u16 %0, %1, %2 clamp\n\tv_pk_min_u16 %0, %0, %3" : "=&v"(y_) : "v"(P[4 * grp + i]), "v"(c1p_), "v"(one2)); a_ += y_; } } \
                dst = (int)((a_ & 0xffffu) + (a_ >> 16)); } while (0)
            LAS unsigned* histl = hist + (lane & 1) * 256;
            unsigned T; int tot_gt;
            { unsigned hi8 = 0u; int above = 0;
#pragma unroll
              for (int lvl = 0; lvl < 2; ++lvl) {
                  u32x4 hb;
                  if (lvl == 0) hb = (qq & 1) ? hb0[1] : hb0[0];
                  else {
                      { unsigned z_ = 0u; asm volatile("" : "+v"(z_)); *(LAS u32x4*)(hist + 4 * lane) = (u32x4){z_, z_, z_, z_}; *(LAS u32x4*)(hist + 256 + 4 * lane) = (u32x4){z_, z_, z_, z_}; }
                      asm volatile("s_waitcnt lgkmcnt(0)" ::: "memory");
#pragma unroll
                      for (int grp = 0; grp < 8; ++grp) if (grp < ngrp) {
#pragma unroll
                          for (int i = 0; i < 4; ++i) { const unsigned lo = P[4 * grp + i] & 0xffffu, hi = P[4 * grp + i] >> 16;
                              if ((lo >> 8) == hi8) __hip_atomic_fetch_add(histl + (lo & 0xffu), 1u, __ATOMIC_RELAXED, __HIP_MEMORY_SCOPE_WAVEFRONT);
                              if ((hi >> 8) == hi8) __hip_atomic_fetch_add(histl + (hi & 0xffu), 1u, __ATOMIC_RELAXED, __HIP_MEMORY_SCOPE_WAVEFRONT); } }
                      asm volatile("s_waitcnt lgkmcnt(0)" ::: "memory");
                      hb = *(const LAS u32x4*)(hist + 4 * lane) + *(const LAS u32x4*)(hist + 256 + 4 * lane);
                      { unsigned z_ = 0u; asm volatile("" : "+v"(z_)); *(LAS u32x4*)(hist + 4 * lane) = (u32x4){z_, z_, z_, z_}; *(LAS u32x4*)(hist + 256 + 4 * lane) = (u32x4){z_, z_, z_, z_}; }
                  }
                  const int sl = (int)(hb.x + hb.y + hb.z + hb.w);
                  int inc = sl;
                  inc += __builtin_amdgcn_update_dpp(0, inc, 0x111, 0xf, 0xf, false); inc += __builtin_amdgcn_update_dpp(0, inc, 0x112, 0xf, 0xf, false);
                  inc += __builtin_amdgcn_update_dpp(0, inc, 0x114, 0xf, 0xf, false); inc += __builtin_amdgcn_update_dpp(0, inc, 0x118, 0xf, 0xf, false);
                  const int r0 = __builtin_amdgcn_readlane(inc, 15), r1 = __builtin_amdgcn_readlane(inc, 31), r2 = __builtin_amdgcn_readlane(inc, 47), r3 = __builtin_amdgcn_readlane(inc, 63);
                  inc += (fq >= 1 ? r0 : 0) + (fq >= 2 ? r1 : 0) + (fq >= 3 ? r2 : 0);
                  const int total = r0 + r1 + r2 + r3;
                  const int want = 256 - above;
                  int run = total - inc;
                  int fb = -1, fa = 0;
                  { const int h3 = (int)hb.w, h2 = (int)hb.z, h1 = (int)hb.y, h0 = (int)hb.x;
                    if (run < want && run + h3 >= want) { fb = 3; fa = run; } run += h3;
                    if (run < want && run + h2 >= want) { fb = 2; fa = run; } run += h2;
                    if (run < want && run + h1 >= want) { fb = 1; fa = run; } run += h1;
                    if (run < want && run + h0 >= want) { fb = 0; fa = run; } }
                  const unsigned long long fm = __ballot(fb >= 0);
                  const int src = (int)__builtin_ctzll(fm);
                  const int bstar = __builtin_amdgcn_readlane(4 * lane + fb, src), abv = __builtin_amdgcn_readlane(fa, src);
                  if (lvl == 0) { hi8 = (unsigned)bstar; above = abv; } else { T = (hi8 << 8) | (unsigned)bstar; tot_gt = above + abv; }
              } }
            int cge_l, cgt_l; DSA_PKCOUNT(cge_l, T - 1u); DSA_PKCOUNT(cgt_l, T);
            const int tot_ge = wave_total_i(cge_l);
            const bool alltie = (tot_ge == 256);
            const int c_l = alltie ? cge_l : cgt_l; const unsigned thrT = alltie ? T : T + 1u;
            int inc = c_l;
            inc += __builtin_amdgcn_update_dpp(0, inc, 0x111, 0xf, 0xf, false); inc += __builtin_amdgcn_update_dpp(0, inc, 0x112, 0xf, 0xf, false);
            inc += __builtin_amdgcn_update_dpp(0, inc, 0x114, 0xf, 0xf, false); inc += __builtin_amdgcn_update_dpp(0, inc, 0x118, 0xf, 0xf, false);
            { const int r0 = __builtin_amdgcn_readlane(inc, 15), r1 = __builtin_amdgcn_readlane(inc, 31), r2 = __builtin_amdgcn_readlane(inc, 47);
              inc += (fq >= 1 ? r0 : 0) + (fq >= 2 ? r1 : 0) + (fq >= 3 ? r2 : 0); }
            int kpos_ = inc - c_l;
#pragma unroll
            for (int grp = 0; grp < 8; ++grp) if (grp < ngrp) {
#pragma unroll
                for (int i = 0; i < 4; ++i) { const int g = 4 * grp + i; const unsigned lo = P[g] & 0xffffu, hi = P[g] >> 16;
                    if (lo >= thrT) { list[kpos_] = (unsigned short)(128 * g + lane); ++kpos_; }
                    if (hi >= thrT) { list[kpos_] = (unsigned short)(128 * g + 64 + lane); ++kpos_; } } }
            if (!alltie) {
                int rem = 256 - tot_gt, pos = tot_gt; const unsigned long long lt = (1ull << lane) - 1ull;
#pragma unroll
                for (int grp = 0; grp < 8; ++grp) if (grp < ngrp) {
#pragma unroll
                    for (int i = 0; i < 8; ++i) { const int g = 4 * grp + (i >> 1); const unsigned val = (i & 1) ? (P[g] >> 16) : (P[g] & 0xffffu);
                        const bool eq = (val == T); const unsigned long long beq = __ballot(eq);
                        if (beq != 0ull) { const int rank = __popcll(beq & lt); if (eq && rank < rem) list[pos + rank] = (unsigned short)(128 * g + 64 * (i & 1) + lane);
                            const int n = __popcll(beq), take = n < rem ? n : rem; pos += take; rem -= take; } } }
            }
#undef DSA_PKCOUNT
        }
    }
    asm volatile("s_waitcnt lgkmcnt(0)" ::: "memory");
    LAS unsigned char* Vs = F.lds + w * 16384;
#ifndef REP_S3
#define REP_S3 1
#endif
#pragma unroll 1
    for (int qq = 0; qq < 2 * REP_S3; ++qq) {
        const int q = 2 * w + (qq & 1), tq = t0 + q; const int nsel = (tq + 1 < 256) ? tq + 1 : 256;
        const size_t nq = nb0 + tq;
        const LAS unsigned short* list = LIST + q * 256;
        bf16x8 Qf[2];
#pragma unroll
        for (int ks = 0; ks < 2; ++ks) { u32x4 raw = {0u, 0u, 0u, 0u}; if (fr < 8) raw = *(const GAS u32x4*)(PA + nq * NPA + PA_Q + fr * 64 + 8 * fq + 32 * ks); Qf[ks] = __builtin_bit_cast(bf16x8, raw); }
        float lg[16][4];
#ifdef REP_S3K
#pragma unroll 1
        for (int repk = 0; repk < REP_S3K; ++repk)
#endif
        const int st_off = (lane >> 3) * 128 + (((lane & 7) ^ ((lane >> 3) & 7)) * 16);
        const int rd0 = fr * 128 + ((fq ^ (fr & 7)) * 16), rd1 = fr * 128 + (((fq + 4) ^ (fr & 7)) * 16);
#pragma unroll
        for (int hb = 0; hb < 2; ++hb) {
#pragma unroll
            for (int ib = 0; ib < 2; ++ib) { u32x4 kv[8];
#pragma unroll
                for (int i = 0; i < 8; ++i) { const int piece = (8 * ib + i) * 64 + lane; const int key = (int)list[128 * hb + (piece >> 3)];
                    kv[i] = *(const GAS u32x4*)(KA + (nb0 + key) * 64 + 8 * (lane & 7)); }
                __builtin_amdgcn_sched_barrier(0);
#pragma unroll
                for (int i = 0; i < 8; ++i) *(LAS u32x4*)(Vs + st_off + (8 * ib + i) * 1024) = kv[i];
            }
            asm volatile("s_waitcnt lgkmcnt(0)" ::: "memory");
#pragma unroll
            for (int j = 0; j < 8; ++j) { const int tt = 8 * hb + j;
                const bf16x8 A0 = *(const LAS bf16x8*)(Vs + rd0 + j * 2048), A1 = *(const LAS bf16x8*)(Vs + rd1 + j * 2048);
                f32x4 d = __builtin_amdgcn_mfma_f32_16x16x32_bf16(A0, Qf[0], (f32x4){0.f, 0.f, 0.f, 0.f}, 0, 0, 0);
                d = __builtin_amdgcn_mfma_f32_16x16x32_bf16(A1, Qf[1], d, 0, 0, 0);
#pragma unroll
                for (int r = 0; r < 4; ++r) lg[tt][r] = (16 * tt + 4 * fq + r < nsel) ? d[r] : -INFINITY; }
            asm volatile("s_waitcnt lgkmcnt(0)" ::: "memory");
        }
        float m = lg[0][0];
#pragma unroll
        for (int tt = 0; tt < 16; ++tt)
#pragma unroll
            for (int r = 0; r < 4; ++r) m = fmaxf(m, lg[tt][r]);
        m = fmaxf(m, shx(m, 16, lane)); m = fmaxf(m, shx(m, 32, lane));
        float den = 0.f;
#pragma unroll
        for (int tt = 0; tt < 16; ++tt)
#pragma unroll
            for (int r = 0; r < 4; ++r) { lg[tt][r] = __expf(lg[tt][r] - m); den += lg[tt][r]; }
        den += shx(den, 16, lane); den += shx(den, 32, lane);
        f32x4 acc[4];
#pragma unroll
        for (int nt = 0; nt < 4; ++nt) acc[nt] = (f32x4){0.f, 0.f, 0.f, 0.f};
#ifdef REP_S3V
#pragma unroll 1
        for (int repv = 0; repv < REP_S3V; ++repv) {
#pragma unroll
        for (int nt = 0; nt < 4; ++nt) acc[nt] = (f32x4){0.f, 0.f, 0.f, 0.f};
#endif
#pragma unroll
        for (int hh = 0; hh < 2; ++hh) {
#pragma unroll
            for (int ib = 0; ib < 2; ++ib) {
                u32x4 vv[8];
#pragma unroll
                for (int i = 0; i < 8; ++i) { const int piece = (8 * ib + i) * 64 + lane, row = piece >> 3, c = piece & 7; const int key = (int)list[128 * hh + row];
                    vv[i] = *(const GAS u32x4*)(VA + (nb0 + key) * 64 + 8 * c); }
                __builtin_amdgcn_sched_barrier(0);
#pragma unroll
                for (int i = 0; i < 8; ++i) { const int piece = (8 * ib + i) * 64 + lane; *(LAS u32x4*)(Vs + piece * 16) = vv[i]; }
            }
            asm volatile("s_waitcnt lgkmcnt(0)" ::: "memory");
#pragma unroll
            for (int s4 = 0; s4 < 4; ++s4) { const int s = 4 * hh + s4;
                u32x4 pa; pa.x = cvt_pk_bf16(lg[2 * s][0], lg[2 * s][1]); pa.y = cvt_pk_bf16(lg[2 * s][2], lg[2 * s][3]); pa.z = cvt_pk_bf16(lg[2 * s + 1][0], lg[2 * s + 1][1]); pa.w = cvt_pk_bf16(lg[2 * s + 1][2], lg[2 * s + 1][3]);
                const bf16x8 Pa = __builtin_bit_cast(bf16x8, pa);
                const int rowa = 32 * s4 + 4 * fq + (fr >> 2);
#pragma unroll
                for (int nt = 0; nt < 4; ++nt) {
                    const v4i16_t lo = __builtin_amdgcn_ds_read_tr16_b64_v4i16((LAS v4i16_t*)(Vs + rowa * 128 + (16 * nt + 4 * (fr & 3)) * 2));
                    const v4i16_t hi = __builtin_amdgcn_ds_read_tr16_b64_v4i16((LAS v4i16_t*)(Vs + (rowa + 16) * 128 + (16 * nt + 4 * (fr & 3)) * 2));
                    bf16x8 Bv; Bv[0] = lo[0]; Bv[1] = lo[1]; Bv[2] = lo[2]; Bv[3] = lo[3]; Bv[4] = hi[0]; Bv[5] = hi[1]; Bv[6] = hi[2]; Bv[7] = hi[3];
                    acc[nt] = __builtin_amdgcn_mfma_f32_16x16x32_bf16(Bv, Pa, acc[nt], 0, 0, 0); } }
            asm volatile("s_waitcnt lgkmcnt(0)" ::: "memory");
        }
#ifdef REP_S3V
        }
#endif
        if (fr < 8) { const float rden = 1.f / den;
#pragma unroll
            for (int nt = 0; nt < 4; ++nt) { u32x2 wv; wv.x = pk2(acc[nt][0] * rden, acc[nt][1] * rden); wv.y = pk2(acc[nt][2] * rden, acc[nt][3] * rden);
                *(GAS u32x2*)(Y + nq * 1536 + fr * 64 + 16 * nt + 4 * fq) = wv; } }
    }
}

#ifdef GLA_NAIVE
constexpr int NGLA = 32;
#else
constexpr int NGLA = 2048;
#endif
#ifdef DSA_NAIVE
constexpr int NDSA = 4096;
#else
constexpr int NDSA = 2048;
#endif
#ifdef GMLP_NAIVE
constexpr int NGM = 1024;
#else
constexpr int NGM = 256;
#endif
__device__ __forceinline__ void phase_mixer(Frame& F, int l, int slot = 0, int types = 7, bool dry = false) {
    (void)slot;
    for (int i = F.tid; i < 4096; i += 512) ((LAS unsigned*)(F.lds + AUX_OFF + 8192))[i] = 0u;
    for (int j = 0; j * F.G < NDSA; ++j) { const int u = j * F.G + ((j & 1) ? (F.G - 1 - F.wg) : F.wg);
        if (u >= NDSA) continue;
        __syncthreads(); if (EN_B2 && (types & 2)) {
#ifdef DSA_NAIVE
        dsa_unit(F, u);
#else
        dsa16_unit(F, u);
#endif
    } }
    for (int u = F.wg; u < NGLA; u += F.G) { __syncthreads(); if (EN_B1 && (types & 1)) {
#ifdef GLA_NAIVE
        gla_unit(F, l, u);
#else
        gla_local_unit(F, l, u, dry);
#endif
    } }
    for (int u = F.wg; u < NGM; u += F.G) { __syncthreads(); if (EN_B3 && (types & 4)) {
#ifdef GMLP_NAIVE
        gmlp_unit(F, l, u);
#else
        gmlp16_unit(F, l, u);
#endif
    } }
}
__device__ __forceinline__ void phase_gla_out(Frame& F, int l, bool dry = false) {
#ifndef GLA_NAIVE
    const int lane = fresh_lane(), w = F.wave, tid = w * 64 + lane, fr = lane & 15, fq = lane >> 4;
    GlaOutRegs R, N;
    if (F.wg < 2048) gla_out_load(F, F.wg, tid, w, fr, fq, R);
#pragma unroll 1
    for (int u = F.wg; u < 2048; u += F.G) { const int un = (u + F.G < 2048) ? u + F.G : u;
        gla_out_load(F, un, tid, w, fr, fq, N);
        gla_out_compute(F, l, u, tid, lane, w, fr, fq, R, dry);
        R = N; }
#endif
}

template <int CTRL> __device__ __forceinline__ float dpp_add(float v) { return v + dppf<CTRL>(v); }
__device__ __forceinline__ float row16_sum(float v) { v = dpp_add<0xB1>(v); v = dpp_add<0x4E>(v); v = dpp_add<0x141>(v); v = dpp_add<0x140>(v); return v; }
__device__ __forceinline__ void phase_ln_router(Frame& F, int l) {
    const GAS bf16* WRB = (const GAS bf16*)(F.ws + WS_WR) + (size_t)l * 48 * DM;
    LAS unsigned char* WB = F.lds;
    for (int i = F.tid; i < 48 * 128; i += 512) { const int n = i >> 7, c = i & 127; *(LAS u32x4*)(WB + n * 2048 + ((c ^ (n & 7)) * 16)) = *(const GAS u32x4*)(WRB + n * DM + 8 * c); }
    if (F.tid < 32) F.MISC[16 + F.tid] = 0u;
    __syncthreads();
    GAS bf16* HB = (GAS bf16*)(F.ws + WS_HB); const GAS bf16* T = (const GAS bf16*)F.H; GAS int* EID = (GAS int*)(F.ws + WS_ROUTE); GAS float* EW = (GAS float*)(F.ws + WS_ROUTE + 256 * 1024);
    const GAS float* g = ((const GAS float*)F.in[17]) + l * DM; const GAS float* bb = ((const GAS float*)F.in[18]) + l * DM; const GAS float* brg = ((const GAS float*)F.in[20]) + l * 4; const GAS float* bre = ((const GAS float*)F.in[22]) + l * 32;
    const int lane = fresh_lane();
    const int sub = lane & 15, rr = lane >> 4, fr = sub, fq = rr;
    LAS float* LG = (LAS float*)(F.lds + 98304) + F.wave * 768;
    for (int r0 = F.wg * 128; r0 < NTOK; r0 += F.G * 128) {
        const int m0 = r0 + F.wave * 16;
        u32x4 nx[8];
#pragma unroll
        for (int q = 0; q < 8; ++q) nx[q] = *(const GAS u32x4*)(T + (size_t)(m0 + rr) * DM + 8 * (sub + 16 * q));
#pragma unroll 1
        for (int j = 0; j < 4; ++j) { const int m = m0 + 4 * j + rr;
            float v[64]; float s = 0.f;
#pragma unroll
            for (int q = 0; q < 8; ++q) { const u32x4 x = nx[q]; v[8 * q] = bflo(x.x); v[8 * q + 1] = bfhi(x.x); v[8 * q + 2] = bflo(x.y); v[8 * q + 3] = bfhi(x.y); v[8 * q + 4] = bflo(x.z); v[8 * q + 5] = bfhi(x.z); v[8 * q + 6] = bflo(x.w); v[8 * q + 7] = bfhi(x.w); }
            { const int mn = (j < 3) ? m + 4 : m;
#pragma unroll
              for (int q = 0; q < 8; ++q) nx[q] = *(const GAS u32x4*)(T + (size_t)mn * DM + 8 * (sub + 16 * q)); }
#pragma unroll
            for (int i = 0; i < 64; ++i) s += v[i];
            const float mean = row16_sum(s) * (1.f / DM); float s2 = 0.f;
#pragma unroll
            for (int i = 0; i < 64; ++i) { v[i] -= mean; s2 += v[i] * v[i]; }
            const float rstd = 1.f / sqrtf(row16_sum(s2) * (1.f / DM) + LN_EPS);
#pragma unroll
            for (int q = 0; q < 8; ++q) { const int c = 8 * (sub + 16 * q); const f32x4 g0 = *(const GAS f32x4*)(g + c), g1 = *(const GAS f32x4*)(g + c + 4), b0 = *(const GAS f32x4*)(bb + c), b1 = *(const GAS f32x4*)(bb + c + 4);
#pragma unroll
                for (int i = 0; i < 4; ++i) { v[8 * q + i] = v[8 * q + i] * rstd * g0[i] + b0[i]; v[8 * q + 4 + i] = v[8 * q + 4 + i] * rstd * g1[i] + b1[i]; }
                u32x4 wv; wv.x = pk2(v[8 * q], v[8 * q + 1]); wv.y = pk2(v[8 * q + 2], v[8 * q + 3]); wv.z = pk2(v[8 * q + 4], v[8 * q + 5]); wv.w = pk2(v[8 * q + 6], v[8 * q + 7]);
                *(GAS u32x4*)(HB + (size_t)m * DM + c) = wv; } }
        asm volatile("s_waitcnt vmcnt(0)" ::: "memory");
        f32x4 acc[3];
#pragma unroll
        for (int nt = 0; nt < 3; ++nt) acc[nt] = (f32x4){0.f, 0.f, 0.f, 0.f};
#pragma unroll 1
        for (int kb = 0; kb < 4; ++kb) {
            bf16x8 af[8];
#pragma unroll
            for (int ks = 0; ks < 8; ++ks) af[ks] = *(const GAS bf16x8*)(HB + (size_t)(m0 + fr) * DM + 8 * fq + 32 * (8 * kb + ks));
#pragma unroll
            for (int ks = 0; ks < 8; ++ks) { const int c = fq + 4 * (8 * kb + ks);
#pragma unroll
                for (int nt = 0; nt < 3; ++nt) { const int n = 16 * nt + fr; const bf16x8 bw = *(const LAS bf16x8*)(WB + n * 2048 + ((c ^ (n & 7)) * 16));
                    acc[nt] = __builtin_amdgcn_mfma_f32_16x16x32_bf16(af[ks], bw, acc[nt], 0, 0, 0); } } }
#pragma unroll
        for (int nt = 0; nt < 3; ++nt)
#pragma unroll
            for (int r = 0; r < 4; ++r) LG[(4 * fq + r) * 48 + 16 * nt + fr] = acc[nt][r];
        asm volatile("s_waitcnt lgkmcnt(0)" ::: "memory");
        if (lane < 16) { const int m = m0 + lane; const LAS float* lgt = LG + lane * 48;
            int gi = 0; float gm = lgt[0] + brg[0];
#pragma unroll
            for (int q = 1; q < 4; ++q) { const float x = lgt[q] + brg[q]; if (x > gm) { gm = x; gi = q; } }
            float gs = 0.f;
#pragma unroll
            for (int q = 0; q < 4; ++q) gs += __expf(lgt[q] + brg[q] - gm);
            const float gp = 1.f / gs;
            float el[8];
#pragma unroll
            for (int q = 0; q < 8; ++q) el[q] = lgt[4 + 8 * gi + q] + bre[8 * gi + q];
            int i0 = 0; float v0 = el[0];
#pragma unroll
            for (int q = 1; q < 8; ++q) if (el[q] > v0) { v0 = el[q]; i0 = q; }
            int i1 = -1; float v1 = -INFINITY;
#pragma unroll
            for (int q = 0; q < 8; ++q) if (q != i0 && el[q] > v1) { v1 = el[q]; i1 = q; }
            const float ex = __expf(v1 - v0), w0 = gp / (1.f + ex), w1 = gp * ex / (1.f + ex);
            const int e0 = gi * 8 + i0, e1 = gi * 8 + i1;
            EID[2 * m] = e0; EID[2 * m + 1] = e1; EW[2 * m] = w0; EW[2 * m + 1] = w1;
            __hip_atomic_fetch_add((LAS unsigned*)(F.lds + MISC_OFF) + 16 + e0, 1u, __ATOMIC_RELAXED, __HIP_MEMORY_SCOPE_WORKGROUP);
            __hip_atomic_fetch_add((LAS unsigned*)(F.lds + MISC_OFF) + 16 + e1, 1u, __ATOMIC_RELAXED, __HIP_MEMORY_SCOPE_WORKGROUP); }
        asm volatile("s_waitcnt lgkmcnt(0)" ::: "memory");
    }
    __syncthreads();
    if (F.tid < 32) ((GAS int*)(F.ws + WS_CNTWG))[F.wg * 32 + F.tid] = (int)F.MISC[16 + F.tid];
}
__device__ __forceinline__ void phase_dispatch(Frame& F) {
    const GAS int* CNT = (const GAS int*)(F.ws + WS_CNTWG); const GAS int* EID = (const GAS int*)(F.ws + WS_ROUTE); const GAS float* EW = (const GAS float*)(F.ws + WS_ROUTE + 256 * 1024);
    GAS int* SROW = (GAS int*)(F.ws + WS_SROW); GAS int* ROWMAP = (GAS int*)(F.ws + WS_ROWMAP); GAS float* CWROW = (GAS float*)(F.ws + WS_CWROW); GAS int* META = (GAS int*)(F.ws + WS_META);
    LAS int* tot = (LAS int*)(F.lds + AUX_OFF);
    { const int e = F.tid & 31, part = F.tid >> 5; int t = 0, mine = 0;
      int cv[16];
#pragma unroll
      for (int j = 0; j < 16; ++j) { const int w = part * 16 + j; cv[j] = (w < F.G) ? ld_i32(CNT + w * 32 + e) : 0; }
#pragma unroll
      for (int j = 0; j < 16; ++j) { const int w = part * 16 + j; t += cv[j]; mine += (w < F.wg) ? cv[j] : 0; }
      tot[160 + F.tid] = t; tot[160 + 512 + F.tid] = mine; }
    __syncthreads();
    if (F.tid < 32) { int t = 0, mine = 0;
#pragma unroll
        for (int p = 0; p < 16; ++p) { t += tot[160 + p * 32 + F.tid]; mine += tot[160 + 512 + p * 32 + F.tid]; }
        tot[F.tid] = t; tot[32 + F.tid] = mine; tot[96 + F.tid] = 0; }
    __syncthreads();
    if (F.tid == 0) { int rb = 0;
#pragma clang loop unroll(disable) vectorize(disable)
        for (int e = 0; e < 32; ++e) { tot[64 + e] = rb; rb += ((tot[e] + 255) >> 8) << 8; }
        tot[128] = rb; }
    __syncthreads();
    if (F.wg == 0) { const int nt = tot[128] >> 8; if (F.tid == 0) META[0] = nt;
        if (F.tid < nt) { int e = 0;
#pragma clang loop unroll(disable) vectorize(disable)
            for (int q = 1; q < 32; ++q) if (tot[64 + q] <= F.tid * 256) e = q;
            META[16 + F.tid] = e; } }
    for (int r0 = F.wg * 128; r0 < NTOK; r0 += F.G * 128) {
        if (F.tid < 256) { const int tok = r0 + (F.tid >> 1), slot = F.tid & 1; const int e = EID[2 * tok + slot];
            const int pos = (int)__hip_atomic_fetch_add((LAS unsigned*)&tot[96 + e], 1u, __ATOMIC_RELAXED, __HIP_MEMORY_SCOPE_WORKGROUP);
            const int sr = tot[64 + e] + tot[32 + e] + pos;
            ROWMAP[sr] = tok; CWROW[sr] = EW[2 * tok + slot]; SROW[2 * tok + slot] = sr; } }
    if (F.wg < 32) { const int e = F.wg; const int lo = tot[64 + e] + tot[e], hi = tot[64 + e] + (((tot[e] + 255) >> 8) << 8);
        for (int r = lo + F.tid; r < hi; r += 512) { ROWMAP[r] = 0; CWROW[r] = 0.f; } }
}
__device__ __forceinline__ void phase_ln2(Frame& F, int l, bool dry = false) {
    GAS bf16* HB = (GAS bf16*)(F.ws + WS_HB); GAS bf16* HBo = dry ? (GAS bf16*)(F.ws + WS_Y) : HB; GAS float* Ho = dry ? (GAS float*)(F.ws + WS_PA + 184 * MiB) : F.H; const GAS int* SROW = (const GAS int*)(F.ws + WS_SROW); const GAS bf16* FF2 = (const GAS bf16*)(F.ws + WS_FF2);
    const GAS float* g = ((const GAS float*)F.in[26]) + l * DM; const GAS float* bb = ((const GAS float*)F.in[27]) + l * DM; int lane = F.lane; asm volatile("" : "+v"(lane));
    const int gw = F.wg * 8 + F.wave, NGW = F.G * 8; const bool last = (l == DEPTH - 1);
    const int nrow = (NTOK - gw + NGW - 1) / NGW;
    const int srv = (2 * (gw + (lane >> 1) * NGW) + (lane & 1) < 2 * NTOK) ? ld_i32(SROW + 2 * (gw + (lane >> 1) * NGW) + (lane & 1)) : 0;
    u32x4 hn[2][2], an[2][2], cn[2][2];
#define LN2_ISSUE(jj, slot) do { const int j_ = (jj); if (j_ < nrow) { const int m_ = gw + j_ * NGW; const int s0_ = __builtin_amdgcn_readlane(srv, 2 * j_), s1_ = __builtin_amdgcn_readlane(srv, 2 * j_ + 1); \
        _Pragma("unroll") for (int q_ = 0; q_ < 2; ++q_) { hn[slot][q_] = *(const GAS u32x4*)(HB + (size_t)m_ * DM + 8 * lane + 512 * q_); an[slot][q_] = *(const GAS u32x4*)(FF2 + (size_t)s0_ * DM + 8 * lane + 512 * q_); cn[slot][q_] = *(const GAS u32x4*)(FF2 + (size_t)s1_ * DM + 8 * lane + 512 * q_); } } } while (0)
    LN2_ISSUE(0, 0); LN2_ISSUE(1, 1);
#pragma unroll 1
    for (int jr = 0; jr < nrow; jr += 2)
#pragma unroll
    for (int slot = 0; slot < 2; ++slot) { const int jrow = jr + slot; if (jrow >= nrow) break; const int m = gw + jrow * NGW;
        float v[16];
#pragma unroll
        for (int j = 0; j < 2; ++j) { const u32x4 h = hn[slot][j], a = an[slot][j], c = cn[slot][j];
            v[8 * j] = bflo(h.x) * DN_ALPHA + (bflo(a.x) + bflo(c.x)); v[8 * j + 1] = bfhi(h.x) * DN_ALPHA + (bfhi(a.x) + bfhi(c.x)); v[8 * j + 2] = bflo(h.y) * DN_ALPHA + (bflo(a.y) + bflo(c.y)); v[8 * j + 3] = bfhi(h.y) * DN_ALPHA + (bfhi(a.y) + bfhi(c.y));
            v[8 * j + 4] = bflo(h.z) * DN_ALPHA + (bflo(a.z) + bflo(c.z)); v[8 * j + 5] = bfhi(h.z) * DN_ALPHA + (bfhi(a.z) + bfhi(c.z)); v[8 * j + 6] = bflo(h.w) * DN_ALPHA + (bflo(a.w) + bflo(c.w)); v[8 * j + 7] = bfhi(h.w) * DN_ALPHA + (bfhi(a.w) + bfhi(c.w)); }
        LN2_ISSUE(jrow + 2, slot);
        float s = 0.f;
#pragma unroll
        for (int i = 0; i < 16; ++i) s += v[i];
        const float mean = wave_sum(s, lane) * (1.f / DM); float s2 = 0.f;
#pragma unroll
        for (int i = 0; i < 16; ++i) { v[i] -= mean; s2 += v[i] * v[i]; }
        const float rstd = 1.f / sqrtf(wave_sum(s2, lane) * (1.f / DM) + LN_EPS);
#pragma unroll
        for (int j = 0; j < 2; ++j) { const int c = 8 * lane + 512 * j; const f32x4 g0 = *(const GAS f32x4*)(g + c), g1 = *(const GAS f32x4*)(g + c + 4), b0 = *(const GAS f32x4*)(bb + c), b1 = *(const GAS f32x4*)(bb + c + 4);
#pragma unroll
            for (int i = 0; i < 4; ++i) { v[8 * j + i] = v[8 * j + i] * rstd * g0[i] + b0[i]; v[8 * j + 4 + i] = v[8 * j + 4 + i] * rstd * g1[i] + b1[i]; }
            if (last) { *(GAS f32x4*)(Ho + (size_t)m * DM + c) = (f32x4){v[8 * j], v[8 * j + 1], v[8 * j + 2], v[8 * j + 3]}; *(GAS f32x4*)(Ho + (size_t)m * DM + c + 4) = (f32x4){v[8 * j + 4], v[8 * j + 5], v[8 * j + 6], v[8 * j + 7]}; }
            else { u32x4 wv; wv.x = pk2(v[8 * j], v[8 * j + 1]); wv.y = pk2(v[8 * j + 2], v[8 * j + 3]); wv.z = pk2(v[8 * j + 4], v[8 * j + 5]); wv.w = pk2(v[8 * j + 6], v[8 * j + 7]); *(GAS u32x4*)(HBo + (size_t)m * DM + c) = wv; } }
    }
#undef LN2_ISSUE
}

#ifndef EN_P
#define EN_P 1
#endif
#ifndef EN_A
#define EN_A 1
#endif
#ifndef EN_B
#define EN_B 1
#endif
#ifndef EN_C
#define EN_C 1
#endif
#ifndef EN_D
#define EN_D 1
#endif
#ifndef EN_E
#define EN_E 1
#endif
#ifndef EN_F
#define EN_F 1
#endif
#ifndef EN_G
#define EN_G 1
#endif
#ifndef EN_H
#define EN_H 1
#endif
#ifndef EN_I
#define EN_I 1
#endif
#ifndef EN_J
#define EN_J 1
#endif
constexpr int PPL = 12;
constexpr int N_PHASES = 1 + PPL * DEPTH;
#ifndef MK_ONE_LAUNCH
#define MK_ONE_LAUNCH 0
#endif
struct Args { const float* in[28]; float* out; unsigned char* ws; int ph_lo, ph_hi; };
static_assert(sizeof(Args) == 28 * 8 + 8 + 8 + 8, "no padding bytes in the argument struct");


__device__ __forceinline__ unsigned opaque_u32(unsigned x) { unsigned v; asm volatile("v_mov_b32 %0, %1" : "=v"(v) : "s"(x)); return (unsigned)__builtin_amdgcn_readfirstlane((int)v); }
__device__ __forceinline__ unsigned long long opaque_u64(unsigned long long x) { return ((unsigned long long)opaque_u32((unsigned)(x >> 32)) << 32) | opaque_u32((unsigned)x); }
__device__ __forceinline__ void launder(Frame& F) {
    F.ws = (GAS unsigned char*)opaque_u64((unsigned long long)F.ws); F.H = (GAS float*)opaque_u64((unsigned long long)F.H);
    F.ctl = (gu32*)opaque_u64((unsigned long long)F.ctl);
    unsigned z0 = 0u; asm volatile("" : "+v"(z0)); int ln = (int)__builtin_amdgcn_mbcnt_hi(~0u, __builtin_amdgcn_mbcnt_lo(~0u, z0));
    F.wave = (int)opaque_u32((unsigned)F.wave); F.lane = ln; F.tid = F.wave * 64 + ln;
    F.G = (int)opaque_u32((unsigned)F.G); F.wg = (int)opaque_u32((unsigned)F.wg);
}
#ifndef SG_N
#define SG_N 1
#endif
#ifndef SG_US
#define SG_US 0
#endif
__device__ __forceinline__ void gemm_stagger(const Frame& F) {
    if (SG_N > 1) { const int g = (F.wg >> 3) & (SG_N - 1);
        if (g) { const unsigned long long t0 = __builtin_amdgcn_s_memrealtime(), dt = (unsigned long long)(g * SG_US * 100); while (__builtin_amdgcn_s_memrealtime() - t0 < dt) __builtin_amdgcn_s_sleep(4); } }
}
__global__ void __launch_bounds__(512, 2) mk_fwd(Args args) {
    extern __shared__ __attribute__((aligned(16))) unsigned char lds_raw[];
    Frame F;
    F.lds = (LAS unsigned char*)lds_raw;
    F.MISC = (volatile LAS unsigned*)(F.lds + MISC_OFF);
    F.tid = threadIdx.x; F.lane = F.tid & 63; F.wave = __builtin_amdgcn_readfirstlane(F.tid >> 6);
    F.G = gridDim.x; F.wg = blockIdx.x;
    F.in = args.in;
    F.pos = (const GAS int*)args.in[1];
    F.H = (GAS float*)args.out; F.ws = (GAS unsigned char*)args.ws;
    F.ctl = (gu32*)(args.ws + WS_CTL);
    for (int u = F.tid; u < (LDS_BYTES - MISC_OFF) / 4; u += 512) ((LAS unsigned*)(F.lds + MISC_OFF))[u] = 0u;
    __syncthreads();
    const int lo = args.ph_lo, hi = args.ph_hi;
    const bool multi = (hi - lo) > 1;
    XcdBarrier bar; bar.bar = (unsigned*)(F.ctl + CW_BAR); bar.x = 0; bar.st = nullptr;
    if (multi) bar = xcd_barrier_post((unsigned*)(F.ctl + CW_BAR), F.MISC + 8);
#define IN(k) (lo <= (k) && (k) < hi)
#ifdef DUP_BARRIER
#define SEAM(k) do { if (IN(k) && IN((k) + 1)) { xcd_barrier(bar); xcd_barrier(bar); } } while (0)
#else
#define SEAM(k) do { if (IN(k) && IN((k) + 1)) xcd_barrier(bar); } while (0)
#endif

#ifdef DUP_P
    for (int rep = 0; rep < 2; ++rep)
#endif
    if (EN_P && IN(0)) { launder(F); phase_prologue(F); }
    SEAM(0);
#define HB ((GAS bf16*)(F.ws + WS_HB))
#define PA ((GAS bf16*)(F.ws + WS_PA))
#define Y ((GAS bf16*)(F.ws + WS_Y))
#define HM ((GAS bf16*)F.H + (size_t)NTOK * DM)
#define TT ((GAS bf16*)F.H)
    for (int l = 0; l < DEPTH; ++l) {
        const int pb = 1 + PPL * l;
#define wd (F.ws + WS_WDENSE + (size_t)l * WD_LAYER)
#ifdef DUP_A
        for (int rep = 0; rep < 2; ++rep)
#endif
        if (EN_A && IN(pb + 0)) { launder(F);
            DenseSched S; S.init(NTOK / 256, NPA / 256, F.G, F.wg, (const void*)HB, (size_t)256 * DM * 2, (const void*)(wd + WD_WA), (size_t)256 * DM * 2);
            EpiA E{PA, (GAS bf16*)(F.ws + WS_KA), (GAS bf16*)(F.ws + WS_VA), (GAS bf16*)(F.ws + WS_KI), (GAS float*)(F.ws + WS_WI), (GAS float*)(F.ws + WS_GLR), (const GAS float*)(F.ws + WS_ROPE), ((const GAS float*)F.in[5]) + l * 64};
#ifdef DUP_ANONE
            { EpiNoneA E0{PA}; pg8::gemm_phase<EpiNoneA, DenseSched, false>(F.lds, S, E0, DM, DM, F.wave); }
#endif
#ifdef DUP_APLAIN
            { EpiPlainA E0{PA}; pg8::gemm_phase<EpiPlainA, DenseSched, false>(F.lds, S, E0, DM, DM, F.wave); }
#endif
            gemm_stagger(F);
            pg8::gemm_phase<EpiA, DenseSched, false>(F.lds, S, E, DM, DM, F.wave);
        }
        SEAM(pb + 0);
        if (EN_B && IN(pb + 1)) { launder(F);
#ifdef DUP_B
            phase_mixer(F, l, 1, DUP_B, true); launder(F);
#endif
            phase_mixer(F, l); }
        SEAM(pb + 1);
        if (EN_B && IN(pb + 2)) { launder(F);
#ifdef DUP_SCAN
            gla_scan_phase(F, true); launder(F);
#endif
            gla_scan_phase(F); }
        SEAM(pb + 2);
        if (EN_B && IN(pb + 3)) { launder(F);
#ifdef DUP_OUT
            phase_gla_out(F, l, true); launder(F);
#endif
            phase_gla_out(F, l); }
        SEAM(pb + 3);
#ifdef DUP_D
        for (int rep = 0; rep < 2; ++rep)
#endif
        if (EN_D && IN(pb + 4)) { launder(F);
            DenseSched S; S.init(NTOK / 256, DM / 256, F.G, F.wg, (const void*)Y, (size_t)256 * 1536 * 2, (const void*)(wd + WD_WBR), (size_t)256 * 512 * 2);
            S.nsub = 3; S.asub = 512 * 2; S.bsub = (size_t)1024 * 512 * 2;
#ifdef DUP_DPAD
            { EpiPPad E0{PA}; pg8::gemm_phase<EpiPPad, DenseSched, false>(F.lds, S, E0, 512, 1536, F.wave); }
#endif
#ifdef DUP_DNONE
            { EpiNoneA E0{PA}; pg8::gemm_phase<EpiNoneA, DenseSched, false>(F.lds, S, E0, 512, 1536, F.wave); }
#endif
            gemm_stagger(F);
            EpiP E{PA};
            pg8::gemm_phase<EpiP, DenseSched, false>(F.lds, S, E, 512, 1536, F.wave);
        }
#ifdef DUP_C
        for (int rep = 0; rep < 2; ++rep)
#endif
        if (EN_C && IN(pb + 4)) { launder(F);
            DenseSched S; S.init(NTOK / 256, DM / 256, F.G, F.wg, (const void*)HB, (size_t)256 * DM * 2, (const void*)(wd + WD_WG), (size_t)256 * DM * 2);
            S.nsub = 3; S.asub = 0; S.bsub = (size_t)1024 * DM * 2;
#ifdef DUP_CNONE
            { EpiNoneA E0{PA}; pg8::gemm_phase<EpiNoneA, DenseSched, false>(F.lds, S, E0, DM, DM, F.wave); }
#endif
            EpiGM E{PA, HM};
            pg8::gemm_phase<EpiGM, DenseSched, false>(F.lds, S, E, DM, DM, F.wave);
        }
        SEAM(pb + 4);
#ifdef DUP_E
        for (int rep = 0; rep < 2; ++rep)
#endif
        if (EN_E && IN(pb + 6)) { launder(F);
            DenseSched S; S.init(NTOK / 256, DM / 256, F.G, F.wg, (const void*)HM, (size_t)256 * DM * 2, (const void*)(wd + WD_WOUT), (size_t)256 * DM * 2);
            EpiO E{HB, TT};
            gemm_stagger(F);
            pg8::gemm_phase<EpiO, DenseSched, false>(F.lds, S, E, DM, DM, F.wave);
        }
        SEAM(pb + 6);
#ifdef DUP_F
        for (int rep = 0; rep < 2; ++rep)
#endif
        if (EN_F && IN(pb + 7)) { launder(F); phase_ln_router(F, l); }
        SEAM(pb + 7);
#ifdef DUP_G
        for (int rep = 0; rep < 2; ++rep)
#endif
        if (EN_G && IN(pb + 8)) { launder(F);
            { LAS float* scr = (LAS float*)(F.lds + F.wave * 16384);
              conv_run<true>(F, l, 12288, scr);
              __syncthreads(); }
            phase_dispatch(F); }
        SEAM(pb + 8);
#ifdef DUP_H
        for (int rep = 0; rep < 2; ++rep)
#endif
        if (EN_H && IN(pb + 9)) { launder(F);
            const GAS int* META = (const GAS int*)(F.ws + WS_META); const GAS int* ROWMAP = (const GAS int*)(F.ws + WS_ROWMAP);
            LAS int* meta = (LAS int*)(F.lds + AUX_OFF); LAS int* rows = (LAS int*)(F.lds + AUX_OFF + 64);
            { int rv[3]; int mv = 0;
#pragma unroll
              for (int i = 0; i < 3; ++i) { const int gt0 = (i * F.G + F.wg) >> 1, gt = gt0 < MAXTILES ? gt0 : MAXTILES - 1; rv[i] = (F.tid < 256) ? ROWMAP[gt * 256 + F.tid] : 0; }
              if (F.tid < 3) { const int gt0 = (F.tid * F.G + F.wg) >> 1, gt = gt0 < MAXTILES ? gt0 : MAXTILES - 1; mv = ld_i32(META + 16 + gt); }
              if (F.tid < 3) meta[F.tid] = mv;
#pragma unroll
              for (int i = 0; i < 3; ++i) if (F.tid < 256) rows[i * 256 + F.tid] = rv[i]; }
            const int NT = ld_i32(META), NU = NT * 2;
            __syncthreads();
            GroupSched S{NU, F.G, F.wg, 2, (const char*)HB, (const char*)(F.ws + WS_WMOE + WM_GU), 0, (size_t)512 * DM * 2, (size_t)256 * DM * 2, meta, rows};
            EpiGU E{(GAS bf16*)(F.ws + WS_HID), (const GAS float*)(F.ws + WS_CWROW)};
            gemm_stagger(F);
            pg8::gemm_phase<EpiGU, GroupSched, true>(F.lds, S, E, DM, DM, F.wave);
        }
        SEAM(pb + 9);
#ifdef DUP_I
        for (int rep = 0; rep < 2; ++rep)
#endif
        if (EN_I && IN(pb + 10)) { launder(F);
            const GAS int* META = (const GAS int*)(F.ws + WS_META);
            LAS int* meta = (LAS int*)(F.lds + AUX_OFF);
            if (F.tid < 5) { const int gt0 = (F.tid * F.G + F.wg) >> 2, gt = gt0 < MAXTILES ? gt0 : MAXTILES - 1; meta[F.tid] = ld_i32(META + 16 + gt); }
            const int NT = ld_i32(META), NU = NT * 4;
            __syncthreads();
            GroupSched S{NU, F.G, F.wg, 4, (const char*)(F.ws + WS_HID), (const char*)(F.ws + WS_WMOE + WM_DN), (size_t)256 * DEXP * 2, (size_t)DM * DEXP * 2, (size_t)256 * DEXP * 2, meta, nullptr};
            EpiDN E{(GAS bf16*)(F.ws + WS_FF2)};
            gemm_stagger(F);
            pg8::gemm_phase<EpiDN, GroupSched, false>(F.lds, S, E, DEXP, DEXP, F.wave);
        }
        SEAM(pb + 10);
        if (EN_J && IN(pb + 11)) { launder(F);
#ifdef DUP_J
            phase_ln2(F, l, true); launder(F);
#endif
            phase_ln2(F, l); }
        SEAM(pb + 11);
    }
#undef IN
#undef SEAM
#undef HB
#undef HM
#undef TT
#undef PA
#undef Y
#undef wd
}


#ifdef DUMP_OFF
__global__ void dump_k(const unsigned short* src, float* out) {
    for (size_t i = (size_t)blockIdx.x * blockDim.x + threadIdx.x; i < (size_t)NTOK * 1024; i += (size_t)gridDim.x * blockDim.x) { const size_t n = i >> 10, c = i & 1023; out[i] = __builtin_bit_cast(float, ((unsigned)src[n * DUMP_PITCH + c]) << 16); }
}
#endif
extern "C" void kernel_launch(void* const* d_in, const int* in_sizes, int n_in, void* d_out, int out_size, void* d_ws, size_t ws_size, hipStream_t stream) {
    static int grid = 0;
    if (grid == 0) {
        if (n_in != 28 || out_size != NTOK * DM || ws_size < WS_END) { fprintf(stderr, "kernel_launch: unexpected shapes (n_in %d out %d ws %zu); nothing launched\n", n_in, out_size, ws_size); grid = -1; return; }
        int dev = 0, cus = 0;
        if (hipGetDevice(&dev) != hipSuccess || hipDeviceGetAttribute(&cus, hipDeviceAttributeMultiprocessorCount, dev) != hipSuccess) { grid = -1; return; }
        if (hipFuncSetAttribute((const void*)mk_fwd, hipFuncAttributeMaxDynamicSharedMemorySize, LDS_BYTES) != hipSuccess) { fprintf(stderr, "kernel_launch: hipFuncSetAttribute failed\n"); grid = -1; return; }
        int per_cu = 0;
        if (hipOccupancyMaxActiveBlocksPerMultiprocessor(&per_cu, (const void*)mk_fwd, 512, LDS_BYTES) != hipSuccess || per_cu < 1) { fprintf(stderr, "kernel_launch: occupancy query says %d\n", per_cu); }
        (void)hipGetLastError();
        grid = cus;
        if (grid != 256) fprintf(stderr, "kernel_launch: %d CUs (built for 256)\n", grid);
    }
    if (grid < 0) return;
    if (hipMemsetAsync((char*)d_ws + WS_CTL, 0, CTL_ZERO_BYTES, stream) != hipSuccess) return;
    Args a{};
    for (int i = 0; i < 28; ++i) a.in[i] = (const float*)d_in[i];
    a.out = (float*)d_out; a.ws = (unsigned char*)d_ws;
#if MK_ONE_LAUNCH
    a.ph_lo = 0; a.ph_hi = N_PHASES;
    hipLaunchKernelGGL(mk_fwd, dim3(grid), dim3(512), LDS_BYTES, stream, a);
#else
#ifndef STOP_AFTER
#define STOP_AFTER (N_PHASES - 1)
#endif
#ifndef PHASE_MASK
#define PHASE_MASK 0xffffffffu
#endif
    for (int p = 0; p <= STOP_AFTER; ++p) { if (!((PHASE_MASK >> p) & 1u)) continue; a.ph_lo = p; a.ph_hi = p + 1; hipLaunchKernelGGL(mk_fwd, dim3(grid), dim3(512), LDS_BYTES, stream, a); }
#ifdef DUMP_OFF
    hipLaunchKernelGGL(dump_k, dim3(2048), dim3(256), 0, stream, (const unsigned short*)((const char*)d_ws + (size_t)(DUMP_OFF)), (float*)d_out);
#endif
#endif
}
```

```cpp
#define MK_ONE_LAUNCH 1
#include <hip/hip_runtime.h>
#include <cstdio>
#include <cstdint>

#define LAS __attribute__((address_space(3)))
#define GAS __attribute__((address_space(1)))
typedef unsigned short bf16;
typedef short bf16x8 __attribute__((ext_vector_type(8)));
typedef float f32x4 __attribute__((ext_vector_type(4)));
typedef float f32x2 __attribute__((ext_vector_type(2)));
typedef unsigned u32x4 __attribute__((ext_vector_type(4)));
typedef unsigned u32x2 __attribute__((ext_vector_type(2)));
typedef GAS unsigned gu32;

constexpr int NB = 8, SEQ = 4096, NTOK = NB * SEQ, DM = 1024, NIN = 6612, DEPTH = 2;
constexpr int NPA = 3584;
constexpr int NGT = 3072;
constexpr int NEXP = 32, DEXP = 256;
constexpr int MAXTILES = 288;
constexpr float DN_ALPHA = 1.41421356237309515f;
constexpr float LN_EPS = 1e-5f, RMS_EPS = 1e-6f;
constexpr int PA_Q = 0, PA_QI = 768, PA_BQ = 1024, PA_BK = 1280, PA_BV = 1536, PA_BR = 2048, PA_CU = 2560, PA_CV = 3072;

__device__ __forceinline__ unsigned f2bf(float f) { unsigned u = __builtin_bit_cast(unsigned, f); return (u + 0x7fffu + ((u >> 16) & 1u)) >> 16; }
__device__ __forceinline__ unsigned pk2(float lo, float hi) { return f2bf(lo) | (f2bf(hi) << 16); }
__device__ __forceinline__ float bflo(unsigned w) { return __builtin_bit_cast(float, w << 16); }
__device__ __forceinline__ float bfhi(unsigned w) { return __builtin_bit_cast(float, w & 0xffff0000u); }
__device__ __forceinline__ float bf1(bf16 h) { return __builtin_bit_cast(float, ((unsigned)h) << 16); }
typedef __bf16 bf16x2_t __attribute__((ext_vector_type(2)));
__device__ __forceinline__ unsigned cvt_pk_bf16(float lo, float hi) { const f32x2 v = {lo, hi}; const bf16x2_t b = __builtin_convertvector(v, bf16x2_t); return __builtin_bit_cast(unsigned, b); }
__device__ __forceinline__ float shx(float v, int mask, int lane) { return __builtin_bit_cast(float, __builtin_amdgcn_ds_bpermute((lane ^ mask) << 2, __builtin_bit_cast(int, v))); }
__device__ __forceinline__ int shxi(int v, int mask, int lane) { return __builtin_amdgcn_ds_bpermute((lane ^ mask) << 2, v); }
__device__ __forceinline__ float wave_sum(float v, int lane) {
#pragma unroll
    for (int o = 1; o < 64; o <<= 1) v += shx(v, o, lane);
    return v;
}
__device__ __forceinline__ float wave_max(float v, int lane) {
#pragma unroll
    for (int o = 1; o < 64; o <<= 1) v = fmaxf(v, shx(v, o, lane));
    return v;
}
__device__ __forceinline__ int wave_sum_i(int v, int lane) {
#pragma unroll
    for (int o = 1; o < 64; o <<= 1) v += shxi(v, o, lane);
    return v;
}
__device__ __forceinline__ int fresh_lane() { unsigned z0 = 0u; asm volatile("" : "+v"(z0)); return (int)__builtin_amdgcn_mbcnt_hi(~0u, __builtin_amdgcn_mbcnt_lo(~0u, z0)); }
__device__ __forceinline__ int ld_i32(const GAS int* p) { return __hip_atomic_load(p, __ATOMIC_RELAXED, __HIP_MEMORY_SCOPE_AGENT); }
__device__ __forceinline__ float ld_f32(const GAS float* p) { return __hip_atomic_load(p, __ATOMIC_RELAXED, __HIP_MEMORY_SCOPE_AGENT); }
__device__ __forceinline__ float sigmoidf_(float x) { return __builtin_amdgcn_rcpf(1.0f + __expf(-x)); }
__device__ __forceinline__ float siluf_(float x) { return x * sigmoidf_(x); }
__device__ __forceinline__ float gelu_tanh_(float x) { const float u = 0.7978845608028654f * (x + 0.044715f * x * x * x); return x * sigmoidf_(2.0f * u); }

namespace pg8 {
constexpr int BM = 256, BK = 64, HALF = 128, HTB = HALF * BK * 2, STAGE_BYTES = 8 * HTB;
__host__ __device__ __forceinline__ int lds_byte(int r, int c) { const int st = (r >> 4) * 2 + (c >> 5), rr = r & 15, cc = c & 31, ob = rr * 64 + cc * 2; return st * 1024 + (ob ^ (((ob >> 9) & 1) << 5)); }
__host__ __device__ __forceinline__ void stage_rc(int b, int& R, int& C) { const int st = b / 1024, sb = b % 1024, swz = sb ^ (((sb >> 9) & 1) << 5); R = (st >> 1) * 16 + swz / 64; C = (st & 1) * 32 + (swz % 64) / 2; }
__host__ __device__ __forceinline__ int perm32(int rho) { const int n = rho >> 4, i = rho & 15; return 8 * (i >> 2) + 4 * n + (i & 3); }

struct Unit { int pm, pn, e, slot; };

#ifndef PG8_ALIGN
#define PG8_ALIGN true
#endif
template <class Epi, class Sched, bool GATHER, bool ALIGN_EPI = PG8_ALIGN>
__device__ __forceinline__ void gemm_phase(LAS unsigned char* lds, const Sched& S, const Epi& E, const int K, const int lda, const int wave) {
    unsigned z0_ = 0u; asm volatile("" : "+v"(z0_)); const int lane_ = (int)__builtin_amdgcn_mbcnt_hi(~0u, __builtin_amdgcn_mbcnt_lo(~0u, z0_));
    const int wid = wave, lane = lane_, tid = wid * 64 + lane, wr = wid >> 2, wc = wid & 3, fr = lane & 15, fq = lane >> 4;
    const int nt = K / BK;
    int Rr[2], Cc[2];
    unsigned voffB[2];
#pragma unroll
    for (int i = 0; i < 2; ++i) { int R, C; stage_rc(tid * 16 + i * 8192, R, C); Rr[i] = R; Cc[i] = C; const int Rb = Epi::PERM ? ((R & ~31) + perm32(R & 31)) : R; voffB[i] = (unsigned)(Rb * K + C) * 2u; }
    const size_t kstep = (size_t)(BK * 2);
    const size_t hstepB = (size_t)HALF * K * 2;
    const unsigned ldsw = (unsigned)wid * 1024u;
    const int aoff = lds_byte(wr * 64 + fr, fq * 8), boff = lds_byte(wc * 32 + fr, fq * 8);
#define PG8_SA(b, h) (((b) * 2 + (h)) * HTB)
#define PG8_SB(b, h) ((4 + (b) * 2 + (h)) * HTB)
#define PG8_STAGE(bufoff, gbase, voff) do { _Pragma("unroll") for (int _i = 0; _i < 2; ++_i) \
        __builtin_amdgcn_global_load_lds((const unsigned*)((const char*)(gbase) + (voff)[_i]), (LAS unsigned*)(lds + (bufoff) + ldsw + _i * 8192), 16, 0, 0); } while (0)
#define PG8_LDA(dst, b, h) do { _Pragma("unroll") for (int m = 0; m < 4; ++m) _Pragma("unroll") for (int k = 0; k < 2; ++k) dst[m][k] = *(const LAS bf16x8*)(lds + PG8_SA(b, h) + aoff + m * 2048 + k * 1024); } while (0)
#define PG8_LDB(dst, b, h) do { _Pragma("unroll") for (int n = 0; n < 2; ++n) _Pragma("unroll") for (int k = 0; k < 2; ++k) dst[n][k] = *(const LAS bf16x8*)(lds + PG8_SB(b, h) + boff + n * 2048 + k * 1024); } while (0)
#define PG8_MMA(ai, bj, At, Bt) do { __builtin_amdgcn_s_setprio(1); _Pragma("unroll") for (int m = 0; m < 4; ++m) _Pragma("unroll") for (int n = 0; n < 2; ++n) _Pragma("unroll") for (int k = 0; k < 2; ++k) \
        acc[ai][bj][m][n] = __builtin_amdgcn_mfma_f32_16x16x32_bf16(Bt[n][k], At[m][k], acc[ai][bj][m][n], 0, 0, 0); __builtin_amdgcn_s_setprio(0); } while (0)
#define PG8_WAIT_V(n) asm volatile("s_waitcnt vmcnt(" #n ")" ::: "memory")
#define PG8_WAIT_L(n) asm volatile("s_waitcnt lgkmcnt(" #n ")" ::: "memory")
#define PG8_BAR do { asm volatile("" ::: "memory"); __builtin_amdgcn_s_barrier(); asm volatile("" ::: "memory"); } while (0)
#define PG8_SCHED __builtin_amdgcn_sched_barrier(0)
    Unit cur, nxt; int ui = 0;
    if (!S.next(0, cur)) return;
    f32x4 acc[2][2][4][2];
#pragma unroll
    for (int a = 0; a < 2; ++a)
#pragma unroll
        for (int b = 0; b < 2; ++b)
#pragma unroll
            for (int m = 0; m < 4; ++m)
#pragma unroll
                for (int n = 0; n < 2; ++n) acc[a][b][m][n] = (f32x4){0.f, 0.f, 0.f, 0.f};
    bf16x8 At[4][2], B0[2][2], B1[2][2];
    unsigned cA0[2], cA1[2], nA0[2], nA1[2];
#pragma unroll
    for (int i = 0; i < 2; ++i) {
        if (GATHER) { cA0[i] = (unsigned)(S.row_of(cur, Rr[i]) * lda + Cc[i]) * 2u; cA1[i] = (unsigned)(S.row_of(cur, HALF + Rr[i]) * lda + Cc[i]) * 2u; }
        else { cA0[i] = (unsigned)(Rr[i] * lda + Cc[i]) * 2u; cA1[i] = (unsigned)((HALF + Rr[i]) * lda + Cc[i]) * 2u; }
        nA0[i] = cA0[i]; nA1[i] = cA1[i];
    }
    const char* cA = S.a_base(cur); const char* cB = S.b_base(cur);
    PG8_STAGE(PG8_SB(0, 0), cB, voffB); PG8_STAGE(PG8_SB(0, 1), cB + hstepB, voffB); PG8_STAGE(PG8_SA(0, 0), cA, cA0); PG8_STAGE(PG8_SA(0, 1), cA, cA1);
    if (wr == 1) PG8_BAR;
    PG8_WAIT_V(2); PG8_BAR;
    PG8_STAGE(PG8_SB(1, 0), cB + kstep, voffB); PG8_STAGE(PG8_SA(1, 0), cA + kstep, cA0); PG8_STAGE(PG8_SB(1, 1), cB + hstepB + kstep, voffB);
    PG8_WAIT_V(6); PG8_BAR;
    for (;;) {
        const bool has_next = S.next(ui + 1, nxt);
        const char* nA = has_next ? S.a_base(nxt) : cA; const char* nB = has_next ? S.b_base(nxt) : cB;
        if (GATHER) {
#pragma unroll
            for (int i = 0; i < 2; ++i) {
                if (has_next) { nA0[i] = (unsigned)(S.row_of(nxt, Rr[i]) * lda + Cc[i]) * 2u; nA1[i] = (unsigned)(S.row_of(nxt, HALF + Rr[i]) * lda + Cc[i]) * 2u; }
                else { nA0[i] = cA0[i]; nA1[i] = cA1[i]; }
            }
        }
#pragma unroll 1
        for (int t = 0; t < nt; t += 2) {
            const bool last = (t == nt - 2);
            const char* a1 = cA + (size_t)(t + 1) * kstep;
            const char* a2 = last ? nA : cA + (size_t)(t + 2) * kstep; const char* b2 = last ? nB : cB + (size_t)(t + 2) * kstep;
            const char* a3 = a2 + kstep; const char* b3 = b2 + kstep;
            unsigned x0[2], x1[2];
#pragma unroll
            for (int i = 0; i < 2; ++i) { x0[i] = (GATHER && last) ? nA0[i] : cA0[i]; x1[i] = (GATHER && last) ? nA1[i] : cA1[i]; }
            PG8_LDB(B0, 0, 0); PG8_LDB(B1, 0, 1); PG8_SCHED; PG8_LDA(At, 0, 0); PG8_STAGE(PG8_SA(1, 1), a1, cA1);
            PG8_WAIT_V(8); PG8_WAIT_L(0); PG8_BAR; PG8_MMA(0, 0, At, B0); PG8_MMA(0, 1, At, B1); PG8_BAR; PG8_SCHED;
            PG8_LDA(At, 0, 1); PG8_STAGE(PG8_SB(0, 0), b2, voffB); PG8_STAGE(PG8_SB(0, 1), b2 + hstepB, voffB); PG8_STAGE(PG8_SA(0, 0), a2, x0);
            PG8_WAIT_V(8); PG8_WAIT_L(0); PG8_BAR; PG8_MMA(1, 0, At, B0); PG8_MMA(1, 1, At, B1); PG8_BAR; PG8_SCHED;
            PG8_LDB(B0, 1, 0); PG8_LDB(B1, 1, 1); PG8_SCHED; PG8_LDA(At, 1, 0); PG8_STAGE(PG8_SA(0, 1), a2, x1);
            PG8_WAIT_V(8); PG8_WAIT_L(0); PG8_BAR; PG8_MMA(0, 0, At, B0); PG8_MMA(0, 1, At, B1); PG8_BAR; PG8_SCHED;
            PG8_LDA(At, 1, 1); PG8_STAGE(PG8_SB(1, 0), b3, voffB); PG8_STAGE(PG8_SB(1, 1), b3 + hstepB, voffB); PG8_STAGE(PG8_SA(1, 0), a3, x0);
            PG8_WAIT_V(8); PG8_WAIT_L(0); PG8_BAR; PG8_MMA(1, 0, At, B0); PG8_MMA(1, 1, At, B1); PG8_BAR; PG8_SCHED;
        }
        if (ALIGN_EPI) { if (wr == 0) PG8_BAR; }
        E(acc, cur, wr, wc, fr, fq);
        if (!has_next) break;
#pragma unroll
        for (int a = 0; a < 2; ++a)
#pragma unroll
            for (int b = 0; b < 2; ++b)
#pragma unroll
                for (int m = 0; m < 4; ++m)
#pragma unroll
                    for (int n = 0; n < 2; ++n) acc[a][b][m][n] = (f32x4){0.f, 0.f, 0.f, 0.f};
        cur = nxt; cA = nA; cB = nB; ++ui;
#pragma unroll
        for (int i = 0; i < 2; ++i) { cA0[i] = nA0[i]; cA1[i] = nA1[i]; }
        if (ALIGN_EPI) { if (wr == 1) PG8_BAR; }
    }
    PG8_WAIT_V(0);
    if (!ALIGN_EPI) { if (wr == 0) PG8_BAR; }
    PG8_BAR;
#undef PG8_SA
#undef PG8_SB
#undef PG8_STAGE
#undef PG8_LDA
#undef PG8_LDB
#undef PG8_MMA
#undef PG8_WAIT_V
#undef PG8_WAIT_L
#undef PG8_BAR
#undef PG8_SCHED
}
}

#define XB_TMO      128
#define XB_XCNT(j)  (256  + 64 * (j))
#define XB_XSUB(j)  (1280 + 64 * (j))
#define XB_XGEN(j)  (2304 + 64 * (j))
#define XB_TOP      3328
#define XB_TOPGEN   3392
#define XCD_BAR_WORDS 3456
#define XB_SPIN_CAP (1u << 20)

__device__ __forceinline__ unsigned xb_ld(unsigned* p)              { return __hip_atomic_load(p, __ATOMIC_RELAXED, __HIP_MEMORY_SCOPE_AGENT); }
__device__ __forceinline__ unsigned xb_add(unsigned* p, unsigned v) { return __hip_atomic_fetch_add(p, v, __ATOMIC_RELAXED, __HIP_MEMORY_SCOPE_AGENT); }
__device__ __forceinline__ unsigned xb_xcc_id() { return (unsigned)__builtin_amdgcn_s_getreg((3 << 11) | 20) & 0xFu; }
#define XB_SPIN(cond, bar) do { unsigned _sp = 0; while (cond) { __builtin_amdgcn_s_sleep(1); \
    if ((++_sp & 255u) == 0u) { if (xb_ld(&(bar)[XB_TMO])) break; if (_sp > XB_SPIN_CAP) { atomicAdd(&(bar)[XB_TMO], 1u); break; } } } } while (0)

struct XcdBarrier { unsigned* bar; unsigned x; volatile LAS unsigned* st; };

__device__ __forceinline__ XcdBarrier xcd_barrier_post(unsigned* bar, volatile LAS unsigned* st) {
    XcdBarrier b; b.bar = bar; b.x = xb_xcc_id(); b.st = st;
    if (threadIdx.x == 0) (void)xb_add(&bar[XB_XCNT(b.x)], 1u);
    return b;
}
__device__ __forceinline__ void xcd_barrier_complete(unsigned* bar, unsigned x, unsigned& nloc, unsigned& nx) {
    const unsigned G = gridDim.x * gridDim.y * gridDim.z;
    unsigned sum, cnt, mine, sp = 0u;
    for (;;) {
        sum = 0u; cnt = 0u; mine = 0u;
#pragma unroll
        for (unsigned j = 0; j < 16; ++j) { const unsigned c = xb_ld(&bar[XB_XCNT(j)]); sum += c; cnt += (c > 0u) ? 1u : 0u; mine = (j == x) ? c : mine; }
        if (sum == G) break;
        __builtin_amdgcn_s_sleep(1);
        if ((++sp & 255u) == 0u) { if (xb_ld(&bar[XB_TMO])) break; if (sp > XB_SPIN_CAP) { atomicAdd(&bar[XB_TMO], 1u); break; } }
    }
    nloc = mine > 0u ? mine : 1u; nx = cnt > 0u ? cnt : 1u;
}
__device__ __forceinline__ void xcd_barrier(const XcdBarrier& b) {
    asm volatile("s_waitcnt vmcnt(0)" ::: "memory");
    __syncthreads();
    if (threadIdx.x == 0) {
        unsigned* bar = b.bar;
        __builtin_amdgcn_s_waitcnt(0);
        unsigned nloc = b.st[0], nx = b.st[1];
        if (nloc == 0u) { xcd_barrier_complete(bar, b.x, nloc, nx); b.st[0] = nloc; b.st[1] = nx; }
        const unsigned old = xb_add(&bar[XB_XSUB(b.x)], 1u);
        const unsigned gen = old / nloc;
        if (old + 1u == (gen + 1u) * nloc) {
            __builtin_amdgcn_fence(__ATOMIC_RELEASE, "agent");
            asm volatile("s_waitcnt vmcnt(0)" ::: "memory");
            const unsigned og = xb_add(&bar[XB_TOP], 1u);
            const unsigned tg = og / nx;
            if (og + 1u == (tg + 1u) * nx) xb_add(&bar[XB_TOPGEN], 1u);
            else XB_SPIN(xb_ld(&bar[XB_TOPGEN]) == tg, bar);
            __builtin_amdgcn_fence(__ATOMIC_ACQUIRE, "agent");
            xb_add(&bar[XB_XGEN(b.x)], 1u);
            asm volatile("s_waitcnt vmcnt(0)" ::: "memory");
        } else {
            XB_SPIN(xb_ld(&bar[XB_XGEN(b.x)]) == gen, bar);
            __builtin_amdgcn_fence(__ATOMIC_ACQUIRE, "agent");
            asm volatile("s_waitcnt vmcnt(0)" ::: "memory");
        }
    }
    __syncthreads();
}

constexpr size_t MiB = 1u << 20;
constexpr size_t WS_CTL = 0, CTL_ZERO_BYTES = 1 * MiB;
constexpr size_t WS_ROPE = 1 * MiB;
constexpr size_t WS_WI   = 3 * MiB;
constexpr size_t WS_ROUTE = 3 * MiB + 512 * 1024;
constexpr size_t WS_SROW = 4 * MiB;
constexpr size_t WS_ROWMAP = 4 * MiB + 256 * 1024;
constexpr size_t WS_CWROW = 4 * MiB + 640 * 1024;
constexpr size_t WS_CNTWG = 5 * MiB;
constexpr size_t WS_META = 5 * MiB + 64 * 1024;
constexpr size_t WS_WR = 5 * MiB + 128 * 1024;
constexpr size_t WS_GLR = 6 * MiB;
constexpr size_t WS_WDENSE = 8 * MiB;
constexpr size_t WD_WA = 0, WD_WG = 7 * MiB, WD_WBR = 13 * MiB, WD_WOUT = 16 * MiB, WD_LAYER = 18 * MiB;
constexpr size_t WS_WMOE = 44 * MiB;
constexpr size_t WM_GU = 0, WM_DN = 32 * MiB;
constexpr size_t WS_HB = 92 * MiB;
constexpr size_t WS_PA = 156 * MiB;
constexpr size_t WS_HID = WS_PA;
constexpr size_t WS_FF2 = WS_PA + 40 * MiB;
constexpr size_t WS_Y = 380 * MiB;
constexpr size_t WS_KA = 476 * MiB, WS_VA = 480 * MiB, WS_KI = 484 * MiB;
constexpr size_t WS_END = 512 * MiB;
static_assert(WS_WDENSE + 2 * WD_LAYER <= WS_WMOE && WS_WMOE + 48 * MiB <= WS_HB && WS_HB + 64 * MiB <= WS_PA && WS_PA + 224 * MiB <= WS_Y && WS_Y + 96 * MiB <= WS_KA && WS_KI + 4 * MiB <= WS_END, "ws map");
static_assert(WS_FF2 + (size_t)73728 * 1024 * 2 <= WS_Y, "ff2 fits");
constexpr int CW_BAR = 4096;
constexpr int CW_QUEUE = 16384;

constexpr int RING_BYTES = 131072;
constexpr int AUX_OFF = 131072;
constexpr int MISC_OFF = 155648;
constexpr int LDS_BYTES = 156672;

struct Frame {
    LAS unsigned char* lds;
    volatile LAS unsigned* MISC;
    gu32* ctl;
    int tid, lane, wave, G, wg;
    const float* const* in;
    const GAS int* pos;
    GAS float* H;
    GAS unsigned char* ws;
};

#define LDS_WAIT() asm volatile("s_waitcnt lgkmcnt(0)" ::: "memory")
#define VM_WAIT() asm volatile("s_waitcnt vmcnt(0)" ::: "memory")

__device__ __forceinline__ int pa_src_col(int c) {
    if (c < 512) return c;
    if (c < 768) { const int x = c - 512, half = x >> 7, y = x & 127, grp = y >> 5, d = (y & 31) + 32 * half;
        if (grp == 0) return 512 + d;
        if (grp == 1) return 576 + d;
        if (grp == 2) return 896 + d;
        if (half == 0) { const int z = y - 96; if (z < 4) return 960 + z; if (z < 20) return 1988 + (z - 4); }
        return -1; }
    if (c < 1024) return 640 + (c - 768);
    if (c < 1280) return 964 + (c - 1024);
    if (c < 1536) return 1220 + (c - 1280);
    if (c < 2048) return 1476 + (c - 1536);
    if (c < 2560) return 2004 + (c - 2048);
    return 2516 + (c - 2560);
}
struct TItem { const GAS float* W; GAS bf16* WT; int ldw, K, n0, k0, sc0, mode; };
__device__ __forceinline__ void ti_load(const TItem& t, f32x4 (&v)[8], int lane) {
    if (t.mode == 0) { const int kr = lane >> 3, c4 = (lane & 7) * 4;
#pragma unroll
        for (int i = 0; i < 8; ++i) v[i] = *(const GAS f32x4*)(t.W + (size_t)(t.k0 + 8 * i + kr) * t.ldw + t.sc0 + c4); }
}
__device__ __forceinline__ void ti_finish(const TItem& t, const f32x4 (&v)[8], LAS float* scr, int lane) {
    if (t.mode == 0) { const int kr = lane >> 3, c4 = (lane & 7) * 4;
#pragma unroll
        for (int i = 0; i < 8; ++i) { LAS float* d = scr + (8 * i + kr) * 33 + c4; d[0] = v[i].x; d[1] = v[i].y; d[2] = v[i].z; d[3] = v[i].w; }
    } else { const int sc = pa_src_col(t.n0 + (lane & 31));
#pragma unroll 8
        for (int i = 0; i < 32; ++i) { const int kk = 2 * i + (lane >> 5); scr[kk * 33 + (lane & 31)] = (sc >= 0) ? t.W[(size_t)(t.k0 + kk) * t.ldw + sc] : 0.f; }
    }
    LDS_WAIT(); asm volatile("" ::: "memory");
    const int c = lane & 7;
#pragma unroll
    for (int j = 0; j < 4; ++j) { const int n = (lane >> 3) + 8 * j; const LAS float* s = scr + (8 * c) * 33 + n;
        u32x4 o; o.x = pk2(s[0 * 33], s[1 * 33]); o.y = pk2(s[2 * 33], s[3 * 33]); o.z = pk2(s[4 * 33], s[5 * 33]); o.w = pk2(s[6 * 33], s[7 * 33]);
        *(GAS u32x4*)(t.WT + (size_t)(t.n0 + n) * t.K + t.k0 + 8 * c) = o; }
    LDS_WAIT(); asm volatile("" ::: "memory");
}
__device__ __forceinline__ void dense_item(Frame& F, int l, int it, TItem& t) {
    GAS bf16* base = (GAS bf16*)(F.ws + WS_WDENSE + (size_t)l * WD_LAYER);
    const GAS float* win = ((const GAS float*)F.in[4]) + (size_t)l * DM * NIN;
    if (it < 1792) { const int kb = it / 112, nb = it % 112; const int s0 = pa_src_col(32 * nb), s31 = pa_src_col(32 * nb + 31);
        t = TItem{win, base + WD_WA / 2, NIN, DM, 32 * nb, 64 * kb, s0, (s0 >= 0 && s31 == s0 + 31) ? 0 : 1}; return; }
    it -= 1792;
    if (it < 1536) { const int kb = it / 96, nb = it % 96; t = TItem{win, base + WD_WG / 2, NIN, DM, 32 * nb, 64 * kb, 3540 + 32 * nb, 0}; return; }
    it -= 1536;
    if (it < 768) { const int br = it / 256, r = it % 256, kb = r / 32, nb = r % 32;
        t = TItem{(br == 0 ? ((const GAS float*)F.in[13]) : br == 1 ? ((const GAS float*)F.in[14]) : ((const GAS float*)F.in[15])) + (size_t)l * 512 * DM, base + WD_WBR / 2 + (size_t)br * 1024 * 512, DM, 512, 32 * nb, 64 * kb, 32 * nb, 0}; return; }
    it -= 768;
    { const int kb = it / 32, nb = it % 32; t = TItem{((const GAS float*)F.in[16]) + (size_t)l * DM * DM, base + WD_WOUT / 2, DM, DM, 32 * nb, 64 * kb, 32 * nb, 0}; }
}
__device__ __forceinline__ void moe_item(Frame& F, int l, int it, TItem& t) {
    const int e = it / 384; int r = it % 384;
    if (r < 256) { const int sub = r / 64, q = r % 64, ct = sub >> 1, bj = sub & 1, kb = q / 4, nb = q % 4;
        const GAS float* src = (bj ? ((const GAS float*)F.in[24]) : ((const GAS float*)F.in[23])) + (size_t)(l * NEXP + e) * DM * DEXP;
        t = TItem{src, (GAS bf16*)(F.ws + WS_WMOE + WM_GU) + (size_t)e * 512 * DM, DEXP, DM, 256 * ct + 128 * bj + 32 * nb, 64 * kb, 128 * ct + 32 * nb, 0}; return; }
    r -= 256;
    { const int kb = r / 32, nb = r % 32;
        t = TItem{((const GAS float*)F.in[25]) + (size_t)(l * NEXP + e) * DEXP * DM, (GAS bf16*)(F.ws + WS_WMOE + WM_DN) + (size_t)e * DM * DEXP, DM, DEXP, 32 * nb, 64 * kb, 32 * nb, 0}; }
}
template <bool MOE> __device__ __forceinline__ void conv_run(Frame& F, int l, int total, LAS float* scr) {
    const int gw = F.wg * 8 + F.wave, NGW = F.G * 8, lane = F.lane;
    TItem cur, nxt; f32x4 vc[8], vn[8];
    int it = gw; if (it >= total) return;
    if (MOE) moe_item(F, l, it, cur); else dense_item(F, it / 4608, it % 4608, cur);
    ti_load(cur, vc, lane);
#pragma unroll 1
    for (; it < total; it += NGW) { const int itn = it + NGW; const bool hn = itn < total;
        if (hn) { if (MOE) moe_item(F, l, itn, nxt); else dense_item(F, itn / 4608, itn % 4608, nxt); ti_load(nxt, vn, lane); }
        ti_finish(cur, vc, scr, lane);
        cur = nxt;
#pragma unroll
        for (int i = 0; i < 8; ++i) vc[i] = vn[i]; }
}

__device__ __forceinline__ void ln_row_regs(f32x4 (&v)[4], const GAS float* g, const GAS float* b, int lane) {
    float s = 0.f;
#pragma unroll
    for (int j = 0; j < 4; ++j) s += (v[j].x + v[j].y) + (v[j].z + v[j].w);
    const float mean = wave_sum(s, lane) * (1.f / DM); float s2 = 0.f;
#pragma unroll
    for (int j = 0; j < 4; ++j) { v[j] = v[j] - mean; s2 += (v[j].x * v[j].x + v[j].y * v[j].y) + (v[j].z * v[j].z + v[j].w * v[j].w); }
    const float rstd = 1.f / sqrtf(wave_sum(s2, lane) * (1.f / DM) + LN_EPS);
#pragma unroll
    for (int j = 0; j < 4; ++j) { const f32x4 gg = *(const GAS f32x4*)(g + 4 * lane + 256 * j), bb = *(const GAS f32x4*)(b + 4 * lane + 256 * j); v[j] = v[j] * rstd * gg + bb; }
}
__device__ __forceinline__ void store_row_f32_bf16(const f32x4 (&v)[4], GAS float* hrow, GAS bf16* brow, int lane) {
#pragma unroll
    for (int j = 0; j < 4; ++j) {
        if (hrow) *(GAS f32x4*)(hrow + 4 * lane + 256 * j) = v[j];
        if (brow) { u32x2 w; w.x = pk2(v[j].x, v[j].y); w.y = pk2(v[j].z, v[j].w); *(GAS u32x2*)(brow + 4 * lane + 256 * j) = w; }
    }
}

__device__ __forceinline__ void phase_prologue(Frame& F) {
    LAS float* scr = (LAS float*)(F.lds + F.wave * 16384);
    const int gw = F.wg * 8 + F.wave, NGW = F.G * 8;
    conv_run<false>(F, 0, 2 * 4608, scr);
    { GAS bf16* WRB = (GAS bf16*)(F.ws + WS_WR);
      for (int i = gw * 64 + F.lane; i < DEPTH * 48 * DM; i += NGW * 64) { const int l = i / (48 * DM), r = i % (48 * DM), o = r / DM, k = r % DM;
          const float v = (o < 4) ? ((const GAS float*)F.in[19])[(size_t)l * DM * 4 + k * 4 + o] : (o < 36) ? ((const GAS float*)F.in[21])[(size_t)l * DM * 32 + k * 32 + (o - 4)] : 0.f;
          WRB[i] = (bf16)f2bf(v); } }
    { GAS float* RT = (GAS float*)(F.ws + WS_ROPE);
      for (int i = gw * 64 + F.lane; i < NTOK * 8; i += NGW * 64) { const int n = i >> 3, j = i & 7;
          const float invf[8] = {1.000000000e+00f, 1.939227432e-01f, 3.760603070e-02f, 7.292664610e-03f, 1.414213562e-03f, 2.742481884e-04f, 5.318295734e-05f, 1.031338525e-05f};
          float inv = invf[0];
#pragma unroll
          for (int q = 1; q < 8; ++q) inv = (j == q) ? invf[q] : inv;
          const float ang = (float)F.pos[n] * inv;
          const double kq = __builtin_rint((double)ang * 0.15915494309189535);
          double r = (double)ang - kq * 6.283185307179586; double csign = 1.0;
          if (r > 1.5707963267948966) { r = 3.141592653589793 - r; csign = -1.0; } else if (r < -1.5707963267948966) { r = -3.141592653589793 - r; csign = -1.0; }
          const double x2 = r * r;
          const double sn = r * (1.0 + x2 * (-1.0 / 6 + x2 * (1.0 / 120 + x2 * (-1.0 / 5040 + x2 * (1.0 / 362880 + x2 * (-1.0 / 39916800 + x2 * (1.0 / 6227020800.0 + x2 * (-1.0 / 1307674368000.0))))))));
          const double cs = 1.0 + x2 * (-0.5 + x2 * (1.0 / 24 + x2 * (-1.0 / 720 + x2 * (1.0 / 40320 + x2 * (-1.0 / 3628800 + x2 * (1.0 / 479001600.0 + x2 * (-1.0 / 87178291200.0 + x2 * (1.0 / 20922789888000.0))))))));
          RT[n * 16 + j] = (float)(csign * cs); RT[n * 16 + 8 + j] = (float)sn; } }
    GAS bf16* HB = (GAS bf16*)(F.ws + WS_HB);
    for (int m = gw; m < NTOK; m += NGW) { f32x4 v[4];
#pragma unroll
        for (int j = 0; j < 4; ++j) v[j] = *(const GAS f32x4*)(((const GAS float*)F.in[0]) + (size_t)m * DM + 4 * F.lane + 256 * j);
        ln_row_regs(v, ((const GAS float*)F.in[2]), ((const GAS float*)F.in[3]), F.lane);
        store_row_f32_bf16(v, (GAS float*)nullptr, HB + (size_t)m * DM, F.lane); }
}

struct DenseSched {
    int nM, nN, nwg, G, c; const char* A; const char* B; size_t atile, btile; int nsub = 1; size_t asub = 0, bsub = 0;
    __device__ void init(int nM_, int nN_, int G_, int c_, const void* A_, size_t atile_, const void* B_, size_t btile_) { nM = nM_; nN = nN_; nwg = nM * nN; G = G_; c = c_; A = (const char*)A_; B = (const char*)B_; atile = atile_; btile = btile_; }
    __device__ __forceinline__ bool next(int i, pg8::Unit& u) const {
        const int it = i / nsub, sb = i - it * nsub;
        const long L = (long)it * G + c; if (L >= nwg) return false;
        int wgid = (int)L; { const int q = nwg / 8, r = nwg % 8, xcd = wgid % 8, off = wgid / 8; wgid = (xcd < r ? xcd * (q + 1) : r * (q + 1) + (xcd - r) * q) + off; }
        const int nig = 8 * nN, gid = wgid / nig, fm = gid * 8, gsz = (nM - fm) < 8 ? (nM - fm) : 8;
        u.pm = fm + ((wgid % nig) % gsz); u.pn = (wgid % nig) / gsz; u.e = sb; u.slot = i; return true;
    }
    __device__ __forceinline__ const char* a_base(const pg8::Unit& u) const { return A + (size_t)u.pm * atile + (size_t)u.e * asub; }
    __device__ __forceinline__ const char* b_base(const pg8::Unit& u) const { return B + (size_t)u.pn * btile + (size_t)u.e * bsub; }
    __device__ __forceinline__ int row_of(const pg8::Unit&, int) const { return 0; }
};
struct GroupSched {
    int NU, G, c, ncol; const char* A; const char* B; size_t atile, erows_bytes, btile; const LAS int* meta; const LAS int* rows;
    __device__ __forceinline__ bool next(int i, pg8::Unit& u) const {
        const int L = i * G + c; if (L >= NU) return false;
        u.pm = L / ncol; u.pn = L % ncol; u.slot = i; u.e = meta[i]; return true;
    }
    __device__ __forceinline__ const char* a_base(const pg8::Unit& u) const { return A + (size_t)u.pm * atile; }
    __device__ __forceinline__ const char* b_base(const pg8::Unit& u) const { return B + (size_t)u.e * erows_bytes + (size_t)u.pn * btile; }
    __device__ __forceinline__ int row_of(const pg8::Unit& u, int r) const { return rows[u.slot * 256 + r]; }
};

#ifndef NT_MASK
#define NT_MASK 0
#endif
template <int BIT> __device__ __forceinline__ void st16(GAS u32x4* p, const u32x4 v) { if (NT_MASK & (1 << BIT)) __builtin_nontemporal_store(v, p); else *p = v; }
struct EpiA {
    static constexpr bool PERM = true; static constexpr int NST = 16;
    GAS bf16* PA; GAS bf16* KA; GAS bf16* VA; GAS bf16* KI; GAS float* WI; GAS float* GLR; const GAS float* ROPE; const GAS float* ikg;
    __device__ __forceinline__ static void rope8(float (&x)[8], const GAS float* rt, int fq, int lane) {
        const f32x4 c0 = *(const GAS f32x4*)(rt), c1 = *(const GAS f32x4*)(rt + 4), s0 = *(const GAS f32x4*)(rt + 8), s1 = *(const GAS f32x4*)(rt + 12);
#pragma unroll
        for (int i = 0; i < 8; ++i) { const float p = shx(x[i], 16, lane); const float cc = (i < 4) ? c0[i & 3] : c1[i & 3], ss = (i < 4) ? s0[i & 3] : s1[i & 3];
            const float r = x[i] * cc + ((fq == 0) ? -p : p) * ss; x[i] = (fq < 2) ? r : x[i]; }
    }
    __device__ __forceinline__ static u32x4 pack8(const float (&x)[8]) { u32x4 w; w.x = cvt_pk_bf16(x[0], x[1]); w.y = cvt_pk_bf16(x[2], x[3]); w.z = cvt_pk_bf16(x[4], x[5]); w.w = cvt_pk_bf16(x[6], x[7]); return w; }
    __device__ __forceinline__ void operator()(const f32x4 (&acc)[2][2][4][2], const pg8::Unit& u, int wr, int wc, int fr, int fq) const {
        const int pn = u.pn; const int rowb = u.pm * 256 + wr * 64 + fr; const int lane = fq * 16 + fr;
        if (pn == 2) {
#pragma unroll
            for (int ai = 0; ai < 2; ++ai)
#pragma unroll
                for (int m = 0; m < 4; ++m) {
                    const int row = rowb + ai * 128 + m * 16;
                    float x0[8], x1[8];
#pragma unroll
                    for (int i = 0; i < 8; ++i) { x0[i] = acc[ai][0][m][i >> 2][i & 3]; x1[i] = acc[ai][1][m][i >> 2][i & 3]; }
                    if (wc == 2) {
                        float s = 0.f;
#pragma unroll
                        for (int i = 0; i < 8; ++i) s += x0[i] + x1[i];
                        s += shx(s, 16, lane); s += shx(s, 32, lane);
                        const float mean = s * (1.f / 64.f); float q = 0.f;
#pragma unroll
                        for (int i = 0; i < 8; ++i) { x0[i] -= mean; x1[i] -= mean; q += x0[i] * x0[i] + x1[i] * x1[i]; }
                        q += shx(q, 16, lane); q += shx(q, 32, lane);
                        const float rstd = 1.f / sqrtf(q * (1.f / 64.f) + LN_EPS);
#pragma unroll
                        for (int i = 0; i < 8; ++i) { x0[i] = x0[i] * rstd * ikg[8 * fq + i]; x1[i] = x1[i] * rstd * ikg[32 + 8 * fq + i]; }
                    }
                    if (wc == 0 || wc == 2) rope8(x0, ROPE + (size_t)row * 16, fq, lane);
                    if (wc < 3) {
                        GAS bf16* dst = (wc == 0) ? KA : (wc == 1) ? VA : KI;
                        *(GAS u32x4*)(dst + (size_t)row * 64 + 8 * fq) = pack8(x0); *(GAS u32x4*)(dst + (size_t)row * 64 + 32 + 8 * fq) = pack8(x1);
                    } else {
                        if (fq == 0) { *(GAS f32x4*)(WI + (size_t)row * 4) = (f32x4){x0[0], x0[1], x0[2], x0[3]} * 0.0625f; *(GAS f32x4*)(GLR + (size_t)row * 16) = (f32x4){x0[4], x0[5], x0[6], x0[7]}; }
                        else if (fq == 1) { *(GAS f32x4*)(GLR + (size_t)row * 16 + 4) = (f32x4){x0[0], x0[1], x0[2], x0[3]}; *(GAS f32x4*)(GLR + (size_t)row * 16 + 8) = (f32x4){x0[4], x0[5], x0[6], x0[7]}; }
                        else if (fq == 2) { *(GAS f32x4*)(GLR + (size_t)row * 16 + 12) = (f32x4){x0[0], x0[1], x0[2], x0[3]}; }
                    }
                    asm volatile("" ::: "memory");
                }
        } else if (pn < 2 || pn == 3) {
            const float sc = (pn == 3) ? 1.0f : 0.125f; const bool rope = !(wc & 1);
#pragma unroll
            for (int ai = 0; ai < 2; ++ai)
#pragma unroll
                for (int m = 0; m < 4; ++m) {
                    const int row = rowb + ai * 128 + m * 16;
#pragma unroll
                    for (int bj = 0; bj < 2; ++bj) { float x[8];
#pragma unroll
                        for (int i = 0; i < 8; ++i) x[i] = acc[ai][bj][m][i >> 2][i & 3];
                        if (rope) rope8(x, ROPE + (size_t)row * 16, fq, lane);
#pragma unroll
                        for (int i = 0; i < 8; ++i) x[i] *= sc;
                        st16<0>((GAS u32x4*)(PA + (size_t)row * NPA + 256 * pn + 128 * bj + 32 * wc + 8 * fq), pack8(x)); }
                    asm volatile("" ::: "memory");
                }
        } else {
            const int act = (pn == 8 || pn == 9) ? 1 : (pn >= 10) ? 2 : 0; const float sc = (pn == 4) ? 0.125f : 1.0f;
#pragma unroll
            for (int ai = 0; ai < 2; ++ai)
#pragma unroll
                for (int m = 0; m < 4; ++m) {
                    const int row = rowb + ai * 128 + m * 16;
#pragma unroll
                    for (int bj = 0; bj < 2; ++bj) { float x[8];
#pragma unroll
                        for (int i = 0; i < 8; ++i) { const float v = acc[ai][bj][m][i >> 2][i & 3]; x[i] = (act == 1) ? siluf_(v) : (act == 2) ? gelu_tanh_(v) : v * sc; }
                        st16<0>((GAS u32x4*)(PA + (size_t)row * NPA + 256 * pn + 128 * bj + 32 * wc + 8 * fq), pack8(x)); }
                    asm volatile("" ::: "memory");
                }
        }
    }
};
struct EpiPlainA {
    static constexpr bool PERM = true; static constexpr int NST = 16;
    GAS bf16* PA;
    __device__ __forceinline__ void operator()(const f32x4 (&acc)[2][2][4][2], const pg8::Unit& u, int wr, int wc, int fr, int fq) const {
        const int rowb = u.pm * 256 + wr * 64 + fr;
#pragma unroll
        for (int ai = 0; ai < 2; ++ai)
#pragma unroll
            for (int m = 0; m < 4; ++m) { const int row = rowb + ai * 128 + m * 16;
#pragma unroll
                for (int bj = 0; bj < 2; ++bj) { u32x4 w; w.x = cvt_pk_bf16(acc[ai][bj][m][0][0], acc[ai][bj][m][0][1]); w.y = cvt_pk_bf16(acc[ai][bj][m][0][2], acc[ai][bj][m][0][3]);
                    w.z = cvt_pk_bf16(acc[ai][bj][m][1][0], acc[ai][bj][m][1][1]); w.w = cvt_pk_bf16(acc[ai][bj][m][1][2], acc[ai][bj][m][1][3]);
                    *(GAS u32x4*)(PA + (size_t)row * NPA + 256 * u.pn + 128 * bj + 32 * wc + 8 * fq) = w; } }
    }
};
struct EpiNoneA {
    static constexpr bool PERM = true; static constexpr int NST = 0;
    GAS bf16* PA;
    __device__ __forceinline__ void operator()(const f32x4 (&acc)[2][2][4][2], const pg8::Unit& u, int wr, int wc, int fr, int fq) const {
        float s = 0.f;
#pragma unroll
        for (int ai = 0; ai < 2; ++ai)
#pragma unroll
            for (int m = 0; m < 4; ++m)
#pragma unroll
                for (int bj = 0; bj < 2; ++bj)
#pragma unroll
                    for (int n = 0; n < 2; ++n) s += (acc[ai][bj][m][n][0] + acc[ai][bj][m][n][1]) + (acc[ai][bj][m][n][2] + acc[ai][bj][m][n][3]);
        if (s == 1.2345e30f) PA[u.pm + wr + wc + fr + fq] = (bf16)1;
    }
};
#ifdef PPITCH
#ifndef EPIP_MODE
#define EPIP_MODE 0
#endif
struct EpiPPad {
    static constexpr bool PERM = true; static constexpr int NST = 16;
    GAS bf16* P;
    __device__ __forceinline__ void operator()(const f32x4 (&acc)[2][2][4][2], const pg8::Unit& u, int wr, int wc, int fr, int fq) const {
        const int rowb = u.pm * 256 + wr * 64 + fr; GAS bf16* Pb = P + (size_t)u.e * NTOK * PPITCH;
#pragma unroll
        for (int ai = 0; ai < 2; ++ai)
#pragma unroll
            for (int m = 0; m < 4; ++m) {
#if EPIP_MODE == 2
                const int row = (rowb + ai * 128 + m * 16) & 31;
#else
                const int row = rowb + ai * 128 + m * 16;
#endif
#pragma unroll
                for (int bj = 0; bj < 2; ++bj) { u32x4 w; w.x = cvt_pk_bf16(acc[ai][bj][m][0][0], acc[ai][bj][m][0][1]); w.y = cvt_pk_bf16(acc[ai][bj][m][0][2], acc[ai][bj][m][0][3]);
                    w.z = cvt_pk_bf16(acc[ai][bj][m][1][0], acc[ai][bj][m][1][1]); w.w = cvt_pk_bf16(acc[ai][bj][m][1][2], acc[ai][bj][m][1][3]);
#if EPIP_MODE == 3
                    __builtin_nontemporal_store(w, (GAS u32x4*)(Pb + (size_t)row * PPITCH + 256 * u.pn + 128 * bj + 32 * wc + 8 * fq));
#elif EPIP_MODE == 4
                    { GAS u32x4* ap_ = (GAS u32x4*)(Pb + (size_t)row * PPITCH + 256 * u.pn + 128 * bj + 32 * wc + 8 * fq); asm volatile("global_store_dwordx4 %0, %1, off sc0 sc1" :: "v"(ap_), "v"(w) : "memory"); }
#elif EPIP_MODE == 5
                    { GAS u32x4* ap_ = (GAS u32x4*)(Pb + (size_t)row * PPITCH + 256 * u.pn + 128 * bj + 32 * wc + 8 * fq); asm volatile("global_store_dwordx4 %0, %1, off sc1" :: "v"(ap_), "v"(w) : "memory"); }
#elif EPIP_MODE == 1
                    if (ai == 0) *(GAS u32x4*)(Pb + (size_t)row * PPITCH + 256 * u.pn + 128 * bj + 32 * wc + 8 * fq) = w; else if (w.x == 0x12345678u && w.y == w.z && w.w == 77u) Pb[0] = (bf16)1;
#else
                    *(GAS u32x4*)(Pb + (size_t)row * PPITCH + 256 * u.pn + 128 * bj + 32 * wc + 8 * fq) = w;
#endif
                } }
    }
};
#endif
struct EpiP {
    static constexpr bool PERM = true; static constexpr int NST = 16;
    GAS bf16* P;
    __device__ __forceinline__ void operator()(const f32x4 (&acc)[2][2][4][2], const pg8::Unit& u, int wr, int wc, int fr, int fq) const {
        const int rowb = u.pm * 256 + wr * 64 + fr; GAS bf16* Pb = P + (size_t)u.e * NTOK * DM;
#pragma unroll
        for (int ai = 0; ai < 2; ++ai)
#pragma unroll
            for (int m = 0; m < 4; ++m) { const int row = rowb + ai * 128 + m * 16;
#pragma unroll
                for (int bj = 0; bj < 2; ++bj) { u32x4 w; w.x = cvt_pk_bf16(acc[ai][bj][m][0][0], acc[ai][bj][m][0][1]); w.y = cvt_pk_bf16(acc[ai][bj][m][0][2], acc[ai][bj][m][0][3]);
                    w.z = cvt_pk_bf16(acc[ai][bj][m][1][0], acc[ai][bj][m][1][1]); w.w = cvt_pk_bf16(acc[ai][bj][m][1][2], acc[ai][bj][m][1][3]);
                    st16<1>((GAS u32x4*)(Pb + (size_t)row * DM + 256 * u.pn + 128 * bj + 32 * wc + 8 * fq), w); } }
    }
};
struct EpiGM {
    static constexpr bool PERM = true; static constexpr int NST = 16;
    const GAS bf16* P; GAS bf16* HM;
    __device__ __forceinline__ void operator()(const f32x4 (&acc)[2][2][4][2], const pg8::Unit& u, int wr, int wc, int fr, int fq) const {
        const int rowb = u.pm * 256 + wr * 64 + fr; const int br = u.e; const GAS bf16* Pb = P + (size_t)br * NTOK * DM;
        const int colb = 256 * u.pn + 32 * wc + 8 * fq;
#pragma unroll
        for (int ai = 0; ai < 2; ++ai) {
            u32x4 pv[4][2], ov[4][2];
#pragma unroll
            for (int m = 0; m < 4; ++m)
#pragma unroll
                for (int bj = 0; bj < 2; ++bj) { const size_t off = (size_t)(rowb + ai * 128 + m * 16) * DM + colb + 128 * bj;
                    pv[m][bj] = *(const GAS u32x4*)(Pb + off); ov[m][bj] = (br > 0) ? *(const GAS u32x4*)(HM + off) : (u32x4){0u, 0u, 0u, 0u}; }
            __builtin_amdgcn_sched_barrier(0);
#pragma unroll
            for (int m = 0; m < 4; ++m)
#pragma unroll
                for (int bj = 0; bj < 2; ++bj) { const size_t off = (size_t)(rowb + ai * 128 + m * 16) * DM + colb + 128 * bj;
                    const u32x4 p = pv[m][bj], o = ov[m][bj];
                    float x[8];
                    x[0] = bflo(p.x) * sigmoidf_(acc[ai][bj][m][0][0]) + bflo(o.x); x[1] = bfhi(p.x) * sigmoidf_(acc[ai][bj][m][0][1]) + bfhi(o.x); x[2] = bflo(p.y) * sigmoidf_(acc[ai][bj][m][0][2]) + bflo(o.y); x[3] = bfhi(p.y) * sigmoidf_(acc[ai][bj][m][0][3]) + bfhi(o.y);
                    x[4] = bflo(p.z) * sigmoidf_(acc[ai][bj][m][1][0]) + bflo(o.z); x[5] = bfhi(p.z) * sigmoidf_(acc[ai][bj][m][1][1]) + bfhi(o.z); x[6] = bflo(p.w) * sigmoidf_(acc[ai][bj][m][1][2]) + bflo(o.w); x[7] = bfhi(p.w) * sigmoidf_(acc[ai][bj][m][1][3]) + bfhi(o.w);
                    u32x4 w; w.x = cvt_pk_bf16(x[0], x[1]); w.y = cvt_pk_bf16(x[2], x[3]); w.z = cvt_pk_bf16(x[4], x[5]); w.w = cvt_pk_bf16(x[6], x[7]);
                    st16<2>((GAS u32x4*)(HM + off), w); }
            asm volatile("" ::: "memory");
        }
    }
};
struct EpiO {
    static constexpr bool PERM = true; static constexpr int NST = 16;
    const GAS bf16* HBr; GAS bf16* T;
    __device__ __forceinline__ void operator()(const f32x4 (&acc)[2][2][4][2], const pg8::Unit& u, int wr, int wc, int fr, int fq) const {
        const int rowb = u.pm * 256 + wr * 64 + fr; const int colb = 256 * u.pn + 32 * wc + 8 * fq;
#pragma unroll
        for (int ai = 0; ai < 2; ++ai) {
            u32x4 hv[4][2];
#pragma unroll
            for (int m = 0; m < 4; ++m)
#pragma unroll
                for (int bj = 0; bj < 2; ++bj) hv[m][bj] = *(const GAS u32x4*)(HBr + (size_t)(rowb + ai * 128 + m * 16) * DM + colb + 128 * bj);
            __builtin_amdgcn_sched_barrier(0);
#pragma unroll
            for (int m = 0; m < 4; ++m)
#pragma unroll
                for (int bj = 0; bj < 2; ++bj) { const u32x4 h = hv[m][bj];
                    u32x4 w; w.x = cvt_pk_bf16(bflo(h.x) * DN_ALPHA + acc[ai][bj][m][0][0], bfhi(h.x) * DN_ALPHA + acc[ai][bj][m][0][1]); w.y = cvt_pk_bf16(bflo(h.y) * DN_ALPHA + acc[ai][bj][m][0][2], bfhi(h.y) * DN_ALPHA + acc[ai][bj][m][0][3]);
                    w.z = cvt_pk_bf16(bflo(h.z) * DN_ALPHA + acc[ai][bj][m][1][0], bfhi(h.z) * DN_ALPHA + acc[ai][bj][m][1][1]); w.w = cvt_pk_bf16(bflo(h.w) * DN_ALPHA + acc[ai][bj][m][1][2], bfhi(h.w) * DN_ALPHA + acc[ai][bj][m][1][3]);
                    st16<3>((GAS u32x4*)(T + (size_t)(rowb + ai * 128 + m * 16) * DM + colb + 128 * bj), w); }
            asm volatile("" ::: "memory");
        }
    }
};
struct EpiGU {
    static constexpr bool PERM = true; static constexpr int NST = 8;
    GAS bf16* HID; const GAS float* CW;
    __device__ __forceinline__ void operator()(const f32x4 (&acc)[2][2][4][2], const pg8::Unit& u, int wr, int wc, int fr, int fq) const {
        const int rowb = u.pm * 256 + wr * 64 + fr;
        float cwv[2][4];
#pragma unroll
        for (int ai = 0; ai < 2; ++ai)
#pragma unroll
            for (int m = 0; m < 4; ++m) cwv[ai][m] = CW[rowb + ai * 128 + m * 16];
#pragma unroll
        for (int ai = 0; ai < 2; ++ai)
#pragma unroll
            for (int m = 0; m < 4; ++m) { const int row = rowb + ai * 128 + m * 16; const float cw = cwv[ai][m];
                float x[8];
#pragma unroll
                for (int i = 0; i < 8; ++i) x[i] = siluf_(acc[ai][0][m][i >> 2][i & 3]) * acc[ai][1][m][i >> 2][i & 3] * cw;
                u32x4 w; w.x = cvt_pk_bf16(x[0], x[1]); w.y = cvt_pk_bf16(x[2], x[3]); w.z = cvt_pk_bf16(x[4], x[5]); w.w = cvt_pk_bf16(x[6], x[7]);
                st16<4>((GAS u32x4*)(HID + (size_t)row * DEXP + 128 * u.pn + 32 * wc + 8 * fq), w); }
    }
};
struct EpiDN {
    static constexpr bool PERM = true; static constexpr int NST = 16;
    GAS bf16* FF2;
    __device__ __forceinline__ void operator()(const f32x4 (&acc)[2][2][4][2], const pg8::Unit& u, int wr, int wc, int fr, int fq) const {
        const int rowb = u.pm * 256 + wr * 64 + fr;
#pragma unroll
        for (int ai = 0; ai < 2; ++ai)
#pragma unroll
            for (int m = 0; m < 4; ++m) { const int row = rowb + ai * 128 + m * 16;
#pragma unroll
                for (int bj = 0; bj < 2; ++bj) { u32x4 w; w.x = cvt_pk_bf16(acc[ai][bj][m][0][0], acc[ai][bj][m][0][1]); w.y = cvt_pk_bf16(acc[ai][bj][m][0][2], acc[ai][bj][m][0][3]);
                    w.z = cvt_pk_bf16(acc[ai][bj][m][1][0], acc[ai][bj][m][1][1]); w.w = cvt_pk_bf16(acc[ai][bj][m][1][2], acc[ai][bj][m][1][3]);
                    st16<5>((GAS u32x4*)(FF2 + (size_t)row * DM + 256 * u.pn + 128 * bj + 32 * wc + 8 * fq), w); } }
    }
};
#ifndef EN_B1
#define EN_B1 1
#endif
#ifndef EN_B2
#define EN_B2 1
#endif
#ifndef EN_B3
#define EN_B3 1
#endif

template <int CTRL> __device__ __forceinline__ float dppf(float x) { return __builtin_bit_cast(float, __builtin_amdgcn_mov_dpp(__builtin_bit_cast(int, x), CTRL, 0xf, 0xf, true)); }
template <int CTRL> __device__ __forceinline__ int dppi(int x) { return __builtin_amdgcn_mov_dpp(x, CTRL, 0xf, 0xf, true); }
typedef short v4i16_t __attribute__((ext_vector_type(4)));
typedef unsigned short u16x2 __attribute__((ext_vector_type(2)));
__device__ __forceinline__ v4i16_t ldtr(const LAS unsigned char* p) { return __builtin_amdgcn_ds_read_tr16_b64_v4i16((LAS v4i16_t*)p); }
__device__ __forceinline__ bf16x8 cat8(v4i16_t lo, v4i16_t hi) { bf16x8 r; r[0] = lo[0]; r[1] = lo[1]; r[2] = lo[2]; r[3] = lo[3]; r[4] = hi[0]; r[5] = hi[1]; r[6] = hi[2]; r[7] = hi[3]; return r; }
__device__ __forceinline__ int wave_total_i(int v) {
    v += dppi<0xB1>(v); v += dppi<0x4E>(v); v += dppi<0x141>(v); v += dppi<0x140>(v);
    return __builtin_amdgcn_readlane(v, 0) + __builtin_amdgcn_readlane(v, 16) + __builtin_amdgcn_readlane(v, 32) + __builtin_amdgcn_readlane(v, 48);
}
__device__ __forceinline__ void gmlp_unit(Frame& F, int l, int unit) {
    int tid = F.tid; asm volatile("" : "+v"(tid)); const int lane = tid & 63;
    const int chunk = unit >> 2, g = unit & 3, n0 = chunk * 128;
    const GAS bf16* PA = (const GAS bf16*)(F.ws + WS_PA); GAS bf16* Y = (GAS bf16*)(F.ws + WS_Y);
    LAS float* vln = (LAS float*)F.lds;
    LAS float* wl = (LAS float*)(F.lds + 65536);
    LAS float* st = (LAS float*)(F.lds + AUX_OFF);
    const GAS float* lng = ((const GAS float*)F.in[9]) + l * 512; const GAS float* lnb = ((const GAS float*)F.in[10]) + l * 512;
    for (int j = 0; j < 16; ++j) { const int s = F.wave * 16 + j;
        const u32x4 w = *(const GAS u32x4*)(PA + (size_t)(n0 + s) * NPA + PA_CV + 8 * lane);
        float x[8] = {bflo(w.x), bfhi(w.x), bflo(w.y), bfhi(w.y), bflo(w.z), bfhi(w.z), bflo(w.w), bfhi(w.w)};
        float sm = 0.f;
#pragma unroll
        for (int i = 0; i < 8; ++i) sm += x[i];
        const float mean = wave_sum(sm, lane) * (1.f / 512.f); float q = 0.f;
#pragma unroll
        for (int i = 0; i < 8; ++i) { const float d = x[i] - mean; q += d * d; }
        const float rstd = 1.f / sqrtf(wave_sum(q, lane) * (1.f / 512.f) + LN_EPS);
        if (lane == 0) { st[2 * s] = mean; st[2 * s + 1] = rstd; } }
    __syncthreads();
#pragma unroll
    for (int i = 0; i < 4; ++i) { const int q = tid + 512 * i, s = q >> 4, d0 = (q & 15) * 8;
        const u32x4 w = *(const GAS u32x4*)(PA + (size_t)(n0 + s) * NPA + PA_CV + g * 128 + d0);
        const float mean = st[2 * s], rstd = st[2 * s + 1];
        float x[8] = {bflo(w.x), bfhi(w.x), bflo(w.y), bfhi(w.y), bflo(w.z), bfhi(w.z), bflo(w.w), bfhi(w.w)};
#pragma unroll
        for (int k = 0; k < 8; ++k) x[k] = (x[k] - mean) * rstd * lng[g * 128 + d0 + k] + lnb[g * 128 + d0 + k];
        *(LAS f32x4*)(vln + s * 128 + d0) = (f32x4){x[0], x[1], x[2], x[3]}; *(LAS f32x4*)(vln + s * 128 + d0 + 4) = (f32x4){x[4], x[5], x[6], x[7]}; }
    const GAS float* ws = ((const GAS float*)F.in[11]) + ((size_t)l * 4 + g) * 128 * 128;
#pragma unroll
    for (int i = 0; i < 8; ++i) { const int q = tid + 512 * i, t = q >> 5, s0 = (q & 31) * 4;
        f32x4 w = *(const GAS f32x4*)(ws + t * 128 + s0);
        if (s0 + 0 > t) w.x = 0.f; if (s0 + 1 > t) w.y = 0.f; if (s0 + 2 > t) w.z = 0.f; if (s0 + 3 > t) w.w = 0.f;
        *(LAS f32x4*)(wl + t * 128 + s0) = w; }
    __syncthreads();
    const int d = tid & 127, tq = __builtin_amdgcn_readfirstlane(tid >> 7);
    float vr[128];
#pragma unroll
    for (int sb = 0; sb < 4; ++sb)
        if (sb <= tq) {
#pragma unroll
            for (int s = 0; s < 32; ++s) vr[sb * 32 + s] = vln[(sb * 32 + s) * 128 + d];
        } else {
#pragma unroll
            for (int s = 0; s < 32; ++s) vr[sb * 32 + s] = 0.f;
        }
    const GAS float* bs = ((const GAS float*)F.in[12]) + ((size_t)l * 4 + g) * 128;
#pragma unroll 1
    for (int ti = 0; ti < 32; ++ti) { const int t = tq * 32 + ti; float a = 0.f;
#pragma unroll
        for (int sb = 0; sb < 4; ++sb)
            if (sb <= tq) {
#pragma unroll
                for (int s4 = 0; s4 < 8; ++s4) { const f32x4 w = *(const LAS f32x4*)(wl + t * 128 + sb * 32 + s4 * 4);
                    a += w.x * vr[sb * 32 + s4 * 4] + w.y * vr[sb * 32 + s4 * 4 + 1] + w.z * vr[sb * 32 + s4 * 4 + 2] + w.w * vr[sb * 32 + s4 * 4 + 3]; }
            }
        const float uu = bf1(PA[(size_t)(n0 + t) * NPA + PA_CU + g * 128 + d]);
        Y[(size_t)(n0 + t) * 1536 + 1024 + g * 128 + d] = (bf16)f2bf(uu * (a + bs[t])); }
    __syncthreads();
}

__device__ __forceinline__ void gmlp16_unit(Frame& F, int l, int chunk) {
    const int lane = fresh_lane(), w = F.wave, tid = w * 64 + lane, fr = lane & 15, fq = lane >> 4;
    const size_t n0 = (size_t)chunk * 128;
    const GAS bf16* PA = (const GAS bf16*)(F.ws + WS_PA); GAS bf16* Y = (GAS bf16*)(F.ws + WS_Y);
    LAS unsigned char* VT = F.lds;
    LAS unsigned char* WT = F.lds + 32768;
    LAS float* st = (LAS float*)(F.lds + AUX_OFF);
    const GAS float* lng = ((const GAS float*)F.in[9]) + l * 512; const GAS float* lnb = ((const GAS float*)F.in[10]) + l * 512;
    for (int j = 0; j < 16; ++j) { const int s = w * 16 + j;
        const u32x4 x4 = *(const GAS u32x4*)(PA + (n0 + s) * NPA + PA_CV + 8 * lane);
        float x[8] = {bflo(x4.x), bfhi(x4.x), bflo(x4.y), bfhi(x4.y), bflo(x4.z), bfhi(x4.z), bflo(x4.w), bfhi(x4.w)};
        float sm = 0.f;
#pragma unroll
        for (int i = 0; i < 8; ++i) sm += x[i];
        const float mean = wave_sum(sm, lane) * (1.f / 512.f); float q = 0.f;
#pragma unroll
        for (int i = 0; i < 8; ++i) { const float d = x[i] - mean; q += d * d; }
        const float rstd = 1.f / sqrtf(wave_sum(q, lane) * (1.f / 512.f) + LN_EPS);
        if (lane == 0) { st[2 * s] = mean; st[2 * s + 1] = rstd; } }
    __syncthreads();
#pragma unroll 1
    for (int g = 0; g < 4; ++g) {
        const GAS float* ws = ((const GAS float*)F.in[11]) + ((size_t)l * 4 + g) * 128 * 128;
#pragma unroll
        for (int i = 0; i < 4; ++i) { const int q = tid + 512 * i, s = q >> 4, d0 = (q & 15) * 8;
            const u32x4 x4 = *(const GAS u32x4*)(PA + (n0 + s) * NPA + PA_CV + g * 128 + d0);
            const float mean = st[2 * s], rstd = st[2 * s + 1];
            float x[8] = {bflo(x4.x), bfhi(x4.x), bflo(x4.y), bfhi(x4.y), bflo(x4.z), bfhi(x4.z), bflo(x4.w), bfhi(x4.w)};
            const f32x4 g0 = *(const GAS f32x4*)(lng + g * 128 + d0), g1 = *(const GAS f32x4*)(lng + g * 128 + d0 + 4), b0 = *(const GAS f32x4*)(lnb + g * 128 + d0), b1 = *(const GAS f32x4*)(lnb + g * 128 + d0 + 4);
#pragma unroll
            for (int k = 0; k < 8; ++k) x[k] = (x[k] - mean) * rstd * ((k < 4) ? g0[k & 3] : g1[k & 3]) + ((k < 4) ? b0[k & 3] : b1[k & 3]);
            u32x4 o; o.x = cvt_pk_bf16(x[0], x[1]); o.y = cvt_pk_bf16(x[2], x[3]); o.z = cvt_pk_bf16(x[4], x[5]); o.w = cvt_pk_bf16(x[6], x[7]);
            *(LAS u32x4*)(VT + s * 256 + d0 * 2) = o;
            const int t = s, s0 = d0;
            f32x4 w0 = *(const GAS f32x4*)(ws + t * 128 + s0), w1 = *(const GAS f32x4*)(ws + t * 128 + s0 + 4);
            float wv[8] = {w0.x, w0.y, w0.z, w0.w, w1.x, w1.y, w1.z, w1.w};
#pragma unroll
            for (int k = 0; k < 8; ++k) wv[k] = (s0 + k <= t) ? wv[k] : 0.f;
            u32x4 ow; ow.x = cvt_pk_bf16(wv[0], wv[1]); ow.y = cvt_pk_bf16(wv[2], wv[3]); ow.z = cvt_pk_bf16(wv[4], wv[5]); ow.w = cvt_pk_bf16(wv[6], wv[7]);
            *(LAS u32x4*)(WT + t * 256 + s0 * 2) = ow; }
        __syncthreads();
        f32x4 acc[8];
#pragma unroll
        for (int nt = 0; nt < 8; ++nt) acc[nt] = (f32x4){0.f, 0.f, 0.f, 0.f};
        const int nks = (16 * w + 15) / 32 + 1;
#pragma unroll
        for (int ks = 0; ks < 4; ++ks) if (ks < nks) {
            const bf16x8 a = *(const LAS bf16x8*)(WT + (16 * w + fr) * 256 + (8 * fq + 32 * ks) * 2);
            const int srow = 32 * ks + 8 * fq + (fr >> 2);
#pragma unroll
            for (int nt = 0; nt < 8; ++nt) { const bf16x8 bv = cat8(ldtr(VT + srow * 256 + (16 * nt + 4 * (fr & 3)) * 2), ldtr(VT + (srow + 4) * 256 + (16 * nt + 4 * (fr & 3)) * 2));
                acc[nt] = __builtin_amdgcn_mfma_f32_16x16x32_bf16(bv, a, acc[nt], 0, 0, 0); } }
        const GAS float* bs = ((const GAS float*)F.in[12]) + ((size_t)l * 4 + g) * 128;
        { const int t = 16 * w + fr; const float bt = bs[t];
#pragma unroll
          for (int nt = 0; nt < 8; ++nt) { const int d0 = 16 * nt + 4 * fq;
              const u32x2 uu = *(const GAS u32x2*)(PA + (n0 + t) * NPA + PA_CU + g * 128 + d0);
              u32x2 wv; wv.x = pk2(bflo(uu.x) * (acc[nt][0] + bt), bfhi(uu.x) * (acc[nt][1] + bt)); wv.y = pk2(bflo(uu.y) * (acc[nt][2] + bt), bfhi(uu.y) * (acc[nt][3] + bt));
              *(GAS u32x2*)(Y + (n0 + t) * 1536 + 1024 + g * 128 + d0) = wv; } }
        __syncthreads();
    }
}

__device__ __forceinline__ void gla_unit(Frame& F, int l, int unit) {
    int tid = F.tid; asm volatile("" : "+v"(tid));
    const int b = unit >> 2, h = unit & 3;
    const GAS bf16* PA = (const GAS bf16*)(F.ws + WS_PA); GAS bf16* Y = (GAS bf16*)(F.ws + WS_Y); const GAS float* GLR = (const GAS float*)(F.ws + WS_GLR);
    LAS float* wa = (LAS float*)F.lds;
    LAS float* ba = wa + 1024;
    LAS float* as_ = ba + 64;
    LAS float* qs = as_ + 1024;
    LAS float* ks = qs + 1024;
    LAS float* vs = ks + 1024;
    LAS float* part = vs + 2048;
    for (int i = tid; i < 1024; i += 512) wa[i] = ((const GAS float*)F.in[6])[(size_t)l * 16 * 256 + (i >> 6) * 256 + h * 64 + (i & 63)];
    if (tid < 64) ba[tid] = ((const GAS float*)F.in[7])[l * 256 + h * 64 + tid];
    const GAS float* gng = ((const GAS float*)F.in[8]) + l * 128;
    const int v = tid & 127, kq = __builtin_amdgcn_readfirstlane(tid >> 7);
    float S[16];
#pragma unroll
    for (int j = 0; j < 16; ++j) S[j] = 0.f;
    __syncthreads();
    for (int t0 = 0; t0 < SEQ; t0 += 16) {
        const size_t nb = (size_t)b * SEQ + t0;
#pragma unroll
        for (int i = 0; i < 2; ++i) { const int e = tid + 512 * i, t = e >> 6, k = e & 63; float z = ba[k];
#pragma unroll
            for (int r = 0; r < 16; ++r) z += GLR[(nb + t) * 16 + r] * wa[r * 64 + k];
            const float ls = fminf(z, 0.f) - log1pf(__expf(-fabsf(z)));
            as_[e] = __expf(ls * (1.f / 16.f));
            qs[e] = bf1(PA[(nb + t) * NPA + PA_BQ + h * 64 + k]); ks[e] = bf1(PA[(nb + t) * NPA + PA_BK + h * 64 + k]); }
#pragma unroll
        for (int i = 0; i < 4; ++i) { const int e = tid + 512 * i, t = e >> 7, vv = e & 127; vs[e] = bf1(PA[(nb + t) * NPA + PA_BV + h * 128 + vv]); }
        __syncthreads();
#pragma unroll 4
        for (int t = 0; t < 16; ++t) { const float vt = vs[t * 128 + v]; float p = 0.f;
#pragma unroll
            for (int j4 = 0; j4 < 4; ++j4) { const f32x4 a4 = *(const LAS f32x4*)(as_ + t * 64 + kq * 16 + j4 * 4), k4 = *(const LAS f32x4*)(ks + t * 64 + kq * 16 + j4 * 4), q4 = *(const LAS f32x4*)(qs + t * 64 + kq * 16 + j4 * 4);
#pragma unroll
                for (int j = 0; j < 4; ++j) { S[j4 * 4 + j] = a4[j] * S[j4 * 4 + j] + k4[j] * vt; p += q4[j] * S[j4 * 4 + j]; } }
            part[(kq * 16 + t) * 128 + v] = p; }
        __syncthreads();
        { const int t = tid >> 5, v4 = (tid & 31) * 4;
          f32x4 o = *(const LAS f32x4*)(part + (0 * 16 + t) * 128 + v4);
#pragma unroll
          for (int q = 1; q < 4; ++q) o += *(const LAS f32x4*)(part + (q * 16 + t) * 128 + v4);
          float ss = o.x * o.x + o.y * o.y + o.z * o.z + o.w * o.w;
#pragma unroll
          for (int sh = 1; sh < 32; sh <<= 1) ss += shx(ss, sh, tid & 63);
          const float r = 1.f / sqrtf(ss * (1.f / 128.f) + RMS_EPS);
          const f32x4 gg = *(const GAS f32x4*)(gng + v4);
          const u32x2 brw = *(const GAS u32x2*)(PA + (nb + t) * NPA + PA_BR + h * 128 + v4);
          u32x2 w; w.x = pk2(o.x * r * gg.x * bflo(brw.x), o.y * r * gg.y * bfhi(brw.x)); w.y = pk2(o.z * r * gg.z * bflo(brw.y), o.w * r * gg.w * bfhi(brw.y));
          *(GAS u32x2*)(Y + (nb + t) * 1536 + 512 + h * 128 + v4) = w; }
        __syncthreads();
    }
}

constexpr size_t WS_US = WS_WMOE, WS_DEC = WS_WMOE + 32 * MiB;
__device__ __forceinline__ void gla_local_unit(Frame& F, int l, int unit, bool dry = false) {
    const int lane = fresh_lane(), w = F.wave, tid = w * 64 + lane, fr = lane & 15, fq = lane >> 4;
    const int b = unit >> 8, h = (unit >> 6) & 3, c = unit & 63; const size_t n0 = (size_t)b * SEQ + 64 * c;
    GAS bf16* PA = (GAS bf16*)(F.ws + WS_PA); GAS bf16* Y = (GAS bf16*)(F.ws + WS_Y); const GAS float* GLR = (const GAS float*)(F.ws + WS_GLR);
    GAS bf16* US = (GAS bf16*)(F.ws + WS_US) + (size_t)unit * 8192; GAS float* DEC = (GAS float*)(F.ws + WS_DEC) + unit * 64;
    LAS unsigned char* QT = F.lds; LAS unsigned char* KT = F.lds + 8192; LAS unsigned char* KD = F.lds + 16384; LAS unsigned char* VV = F.lds + 24576; LAS unsigned char* ATT = F.lds + 40960;
    LAS float* SEG = (LAS float*)(F.lds + 65536); LAS float* WA = (LAS float*)(F.lds + 67584); LAS float* BA = (LAS float*)(F.lds + 71680); LAS float* GL = (LAS float*)(F.lds + 71936);
    const int k = tid & 63, seg = w;
    float qv8[8], kv8[8];
#pragma unroll
    for (int i = 0; i < 8; ++i) { const int t = 8 * seg + i; qv8[i] = bf1(PA[(n0 + t) * NPA + PA_BQ + h * 64 + k]); kv8[i] = bf1(PA[(n0 + t) * NPA + PA_BK + h * 64 + k]); }
    if (tid < 256) *(LAS f32x4*)(GL + 4 * tid) = *(const GAS f32x4*)(GLR + n0 * 16 + 4 * tid);
#pragma unroll
    for (int i = 0; i < 2; ++i) { const int e = tid + 512 * i; WA[e] = ((const GAS float*)F.in[6])[(size_t)l * 16 * 256 + (e >> 6) * 256 + h * 64 + (e & 63)]; }
    if (tid < 64) BA[tid] = ((const GAS float*)F.in[7])[l * 256 + h * 64 + tid];
#pragma unroll
    for (int i = 0; i < 2; ++i) { const int piece = tid + 512 * i, row = piece >> 4, c16 = piece & 15;
        *(LAS u32x4*)(VV + row * 256 + c16 * 16) = *(const GAS u32x4*)(PA + (n0 + row) * NPA + PA_BV + h * 128 + 8 * c16); }
    __syncthreads();
    float cum[8];
    { float run = 0.f;
#pragma unroll
      for (int i = 0; i < 8; ++i) { const int t = 8 * seg + i; float z = BA[k];
          const f32x4 g0 = *(const LAS f32x4*)(GL + t * 16), g1 = *(const LAS f32x4*)(GL + t * 16 + 4), g2 = *(const LAS f32x4*)(GL + t * 16 + 8), g3 = *(const LAS f32x4*)(GL + t * 16 + 12);
#pragma unroll
          for (int r = 0; r < 4; ++r) { z += g0[r] * WA[r * 64 + k]; z += g1[r] * WA[(4 + r) * 64 + k]; z += g2[r] * WA[(8 + r) * 64 + k]; z += g3[r] * WA[(12 + r) * 64 + k]; }
          const float ls = fminf(z, 0.f) - __logf(1.f + __expf(-fabsf(z)));
          run += ls * (1.f / 16.f); cum[i] = run; }
      SEG[seg * 64 + k] = run; }
    __syncthreads();
    { float off = 0.f, blast = 0.f;
#pragma unroll
      for (int s2 = 0; s2 < 8; ++s2) { const float sv = SEG[s2 * 64 + k]; blast += sv; off += (s2 < seg) ? sv : 0.f; }
#pragma unroll
      for (int i = 0; i < 8; ++i) { const int t = 8 * seg + i; const float bb = cum[i] + off;
          const float qv = qv8[i], kv = kv8[i];
          const unsigned qt = f2bf(qv * __expf(bb));
          ((LAS unsigned short*)QT)[t * 64 + k] = (unsigned short)qt; ((LAS unsigned short*)KT)[t * 64 + k] = (unsigned short)f2bf(kv * __expf(-bb)); ((LAS unsigned short*)KD)[t * 64 + k] = (unsigned short)f2bf(kv * __expf(blast - bb));
          if (!dry) PA[(n0 + t) * NPA + PA_BQ + h * 64 + k] = (bf16)qt; }
      if (seg == 0) DEC[k] = __expf(blast); }
    __syncthreads();
#pragma unroll
    for (int ii = 0; ii < 2; ++ii) { const int id = 2 * w + ii, ts = id >> 2, tt = id & 3;
        f32x4 d = {0.f, 0.f, 0.f, 0.f};
        if (ts <= tt) {
#pragma unroll
            for (int ks = 0; ks < 2; ++ks) { const bf16x8 a = *(const LAS bf16x8*)(KT + (16 * ts + fr) * 128 + (8 * fq + 32 * ks) * 2), bq = *(const LAS bf16x8*)(QT + (16 * tt + fr) * 128 + (8 * fq + 32 * ks) * 2);
                d = __builtin_amdgcn_mfma_f32_16x16x32_bf16(a, bq, d, 0, 0, 0); } }
        const int t = 16 * tt + fr, s0 = 16 * ts + 4 * fq;
        u32x2 pk; pk.x = cvt_pk_bf16((s0 <= t) ? d[0] : 0.f, (s0 + 1 <= t) ? d[1] : 0.f); pk.y = cvt_pk_bf16((s0 + 2 <= t) ? d[2] : 0.f, (s0 + 3 <= t) ? d[3] : 0.f);
        *(LAS u32x2*)(ATT + t * 128 + s0 * 2) = pk; }
    __syncthreads();
    { const int tr = w & 3, nh = w >> 2;
      f32x4 ao[4], au[4];
#pragma unroll
      for (int j = 0; j < 4; ++j) { ao[j] = (f32x4){0.f, 0.f, 0.f, 0.f}; au[j] = (f32x4){0.f, 0.f, 0.f, 0.f}; }
#pragma unroll
      for (int ks = 0; ks < 2; ++ks) {
          const bf16x8 aA = *(const LAS bf16x8*)(ATT + (16 * tr + fr) * 128 + (8 * fq + 32 * ks) * 2);
          const int srow = 32 * ks + 8 * fq + (fr >> 2);
          const bf16x8 aK = cat8(ldtr(KD + srow * 128 + (16 * tr + 4 * (fr & 3)) * 2), ldtr(KD + (srow + 4) * 128 + (16 * tr + 4 * (fr & 3)) * 2));
#pragma unroll
          for (int j = 0; j < 4; ++j) { const int nt = 4 * nh + j;
              const bf16x8 bv = cat8(ldtr(VV + srow * 256 + (16 * nt + 4 * (fr & 3)) * 2), ldtr(VV + (srow + 4) * 256 + (16 * nt + 4 * (fr & 3)) * 2));
              ao[j] = __builtin_amdgcn_mfma_f32_16x16x32_bf16(bv, aA, ao[j], 0, 0, 0);
              au[j] = __builtin_amdgcn_mfma_f32_16x16x32_bf16(bv, aK, au[j], 0, 0, 0); } }
#pragma unroll
      for (int j = 0; j < 4; ++j) { const int v0 = 16 * (4 * nh + j) + 4 * fq, row = 16 * tr + fr;
          u32x2 wo; wo.x = pk2(ao[j][0], ao[j][1]); wo.y = pk2(ao[j][2], ao[j][3]); *(GAS u32x2*)(Y + (n0 + row) * 1536 + 512 + h * 128 + v0) = wo;
          u32x2 wu; wu.x = pk2(au[j][0], au[j][1]); wu.y = pk2(au[j][2], au[j][3]); *(GAS u32x2*)(US + row * 128 + v0) = wu; } }
    __syncthreads();
}
__device__ __forceinline__ void gla_scan_phase(Frame& F, bool dry = false) {
    GAS bf16* USb = (GAS bf16*)(F.ws + WS_US); const GAS float* DECb = (const GAS float*)(F.ws + WS_DEC); const size_t dofs = dry ? (size_t)((GAS unsigned char*)F.H - (F.ws + WS_US)) / 4 : 0;
    for (int gt = F.wg * 512 + F.tid; gt < 131072; gt += F.G * 512) { const int e0 = 2 * gt, bh = e0 >> 13, kv = e0 & 8191, k = kv >> 7;
        GAS unsigned* p = (GAS unsigned*)(USb + (size_t)bh * 64 * 8192 + kv); const GAS float* dp = DECb + bh * 64 * 64 + k;
        float s0 = 0.f, s1 = 0.f;
#pragma unroll 8
        for (int c = 0; c < 64; ++c) { const unsigned u = p[(size_t)c * 4096]; const float d = dp[c * 64];
            p[(size_t)c * 4096 + dofs] = pk2(s0, s1);
            s0 = d * s0 + bflo(u); s1 = d * s1 + bfhi(u); } }
}
struct GlaOutRegs { u32x4 us[2]; bf16x8 aq[2]; u32x2 oi[4]; u32x2 br[4]; };
__device__ __forceinline__ void gla_out_load(Frame& F, int unit, int tid, int w, int fr, int fq, GlaOutRegs& R) {
    const int b = unit >> 8, h = (unit >> 6) & 3, c = unit & 63; const size_t n0 = (size_t)b * SEQ + 64 * c;
    const GAS bf16* PA = (const GAS bf16*)(F.ws + WS_PA); const GAS bf16* Y = (const GAS bf16*)(F.ws + WS_Y);
    const GAS bf16* US = (const GAS bf16*)(F.ws + WS_US) + (size_t)unit * 8192;
    const int tr = w >> 1, nh = w & 1, row = 16 * tr + fr;
#pragma unroll
    for (int i = 0; i < 2; ++i) R.us[i] = *(const GAS u32x4*)(US + (tid + 512 * i) * 8);
#pragma unroll
    for (int ks = 0; ks < 2; ++ks) R.aq[ks] = *(const GAS bf16x8*)(PA + (n0 + row) * NPA + PA_BQ + h * 64 + 8 * fq + 32 * ks);
#pragma unroll
    for (int j = 0; j < 4; ++j) { const int v0 = 16 * (4 * nh + j) + 4 * fq; R.oi[j] = *(const GAS u32x2*)(Y + (n0 + row) * 1536 + 512 + h * 128 + v0); R.br[j] = *(const GAS u32x2*)(PA + (n0 + row) * NPA + PA_BR + h * 128 + v0); }
}
__device__ __forceinline__ void gla_out_compute(Frame& F, int l, int unit, int tid, int lane, int w, int fr, int fq, const GlaOutRegs& R, bool dry = false) {
    const int b = unit >> 8, h = (unit >> 6) & 3, c = unit & 63; const size_t n0 = (size_t)b * SEQ + 64 * c;
    GAS bf16* Y = dry ? (GAS bf16*)F.H : (GAS bf16*)(F.ws + WS_Y);
    LAS unsigned char* SS = F.lds;
    LAS float* PS = (LAS float*)(F.lds + 16384);
    const GAS float* gng = ((const GAS float*)F.in[8]) + l * 128;
#pragma unroll
    for (int i = 0; i < 2; ++i) *(LAS u32x4*)(SS + (tid + 512 * i) * 16) = R.us[i];
    __syncthreads();
    const int tr = w >> 1, nh = w & 1, row = 16 * tr + fr;
    f32x4 acc[4];
#pragma unroll
    for (int j = 0; j < 4; ++j) acc[j] = (f32x4){0.f, 0.f, 0.f, 0.f};
#pragma unroll
    for (int ks = 0; ks < 2; ++ks) { const int krow = 32 * ks + 8 * fq + (fr >> 2);
#pragma unroll
        for (int j = 0; j < 4; ++j) { const int nt = 4 * nh + j;
            const bf16x8 bs = cat8(ldtr(SS + krow * 256 + (16 * nt + 4 * (fr & 3)) * 2), ldtr(SS + (krow + 4) * 256 + (16 * nt + 4 * (fr & 3)) * 2));
            acc[j] = __builtin_amdgcn_mfma_f32_16x16x32_bf16(bs, R.aq[ks], acc[j], 0, 0, 0); } }
    float ss = 0.f;
#pragma unroll
    for (int j = 0; j < 4; ++j) { const u32x2 oi = R.oi[j];
        acc[j][0] += bflo(oi.x); acc[j][1] += bfhi(oi.x); acc[j][2] += bflo(oi.y); acc[j][3] += bfhi(oi.y);
        ss += (acc[j][0] * acc[j][0] + acc[j][1] * acc[j][1]) + (acc[j][2] * acc[j][2] + acc[j][3] * acc[j][3]); }
    ss += shx(ss, 16, lane); ss += shx(ss, 32, lane);
    if (fq == 0) PS[row * 2 + nh] = ss;
    __syncthreads();
    { const float rinv = 1.f / sqrtf((PS[row * 2] + PS[row * 2 + 1]) * (1.f / 128.f) + RMS_EPS);
#pragma unroll
      for (int j = 0; j < 4; ++j) { const int v0 = 16 * (4 * nh + j) + 4 * fq; const f32x4 gg = *(const GAS f32x4*)(gng + v0); const u32x2 br = R.br[j];
          u32x2 wv; wv.x = pk2(acc[j][0] * rinv * gg[0] * bflo(br.x), acc[j][1] * rinv * gg[1] * bfhi(br.x)); wv.y = pk2(acc[j][2] * rinv * gg[2] * bflo(br.y), acc[j][3] * rinv * gg[3] * bfhi(br.y));
          *(GAS u32x2*)(Y + (n0 + row) * 1536 + 512 + h * 128 + v0) = wv; } }
    __syncthreads();
}
constexpr int DSA_WAVE_LDS = 17920;
__device__ __forceinline__ void dsa_unit(Frame& F, int unit) {
    int lane = F.lane; asm volatile("" : "+v"(lane)); const int w = F.wave;
    const int qb = 4095 - unit;
    const int b = qb & 7, t = (qb >> 3) * 8 + w;
    const size_t n = (size_t)b * SEQ + t, nb0 = (size_t)b * SEQ;
    const GAS bf16* PA = (const GAS bf16*)(F.ws + WS_PA); GAS bf16* Y = (GAS bf16*)(F.ws + WS_Y);
    const GAS bf16* KI = (const GAS bf16*)(F.ws + WS_KI); const GAS bf16* KA = (const GAS bf16*)(F.ws + WS_KA); const GAS bf16* VA = (const GAS bf16*)(F.ws + WS_VA);
    const GAS float* WI = (const GAS float*)(F.ws + WS_WI);
    LAS unsigned char* base = F.lds + w * DSA_WAVE_LDS;
    LAS unsigned* sc = (LAS unsigned*)base;
    LAS float* qi = (LAS float*)(base + 16384);
    LAS unsigned short* list = (LAS unsigned short*)(base + 16384 + 1024);
    { const u32x2 q2 = *(const GAS u32x2*)(PA + n * NPA + PA_QI + 4 * lane);
      *(LAS f32x4*)(qi + 4 * lane) = (f32x4){bflo(q2.x), bfhi(q2.x), bflo(q2.y), bfhi(q2.y)}; }
    asm volatile("s_waitcnt lgkmcnt(0)" ::: "memory");
    const f32x4 wi = {ld_f32(WI + n * 4), ld_f32(WI + n * 4 + 1), ld_f32(WI + n * 4 + 2), ld_f32(WI + n * 4 + 3)};
    const int nbat = (t >> 6) + 1;
    for (int kb = 0; kb < nbat; ++kb) { const int key = kb * 64 + lane, kc = key <= t ? key : t;
        const GAS u32x4* kp = (const GAS u32x4*)(KI + (nb0 + kc) * 64);
        float kf[64];
#pragma unroll
        for (int c = 0; c < 8; ++c) { const u32x4 kk = kp[c]; kf[8 * c] = bflo(kk.x); kf[8 * c + 1] = bfhi(kk.x); kf[8 * c + 2] = bflo(kk.y); kf[8 * c + 3] = bfhi(kk.y); kf[8 * c + 4] = bflo(kk.z); kf[8 * c + 5] = bfhi(kk.z); kf[8 * c + 6] = bflo(kk.w); kf[8 * c + 7] = bfhi(kk.w); }
        float score = 0.f;
#pragma unroll
        for (int h = 0; h < 4; ++h) { float d = 0.f;
#pragma unroll
            for (int c = 0; c < 16; ++c) { const f32x4 q4 = *(const LAS f32x4*)(qi + h * 64 + 4 * c); d += q4.x * kf[4 * c] + q4.y * kf[4 * c + 1] + q4.z * kf[4 * c + 2] + q4.w * kf[4 * c + 3]; }
            score += wi[h] * fmaxf(d, 0.f); }
        if (score == 0.f) score = 0.f;
        unsigned u = __builtin_bit_cast(unsigned, score); u = (u & 0x80000000u) ? ~u : (u | 0x80000000u);
        sc[key] = key <= t ? u : 0u; }
    asm volatile("s_waitcnt lgkmcnt(0)" ::: "memory");
    int nsel;
    if (t >= 256) {
        unsigned T = 0u;
        for (int bit = 31; bit >= 0; --bit) { const unsigned cand = T | (1u << bit); int cnt = 0;
            for (int j = 0; j < nbat; ++j) cnt += (sc[j * 64 + lane] >= cand) ? 1 : 0;
            if (wave_sum_i(cnt, lane) >= 256) T = cand; }
        int cgt = 0;
        for (int j = 0; j < nbat; ++j) cgt += (sc[j * 64 + lane] > T) ? 1 : 0;
        const int need = 256 - wave_sum_i(cgt, lane);
        int selbase = 0, tiebase = 0;
        for (int j = 0; j < nbat; ++j) { const unsigned x = sc[j * 64 + lane]; const bool eq = (x == T), gt = (x > T);
            const unsigned long long beq = __ballot(eq); const unsigned long long lt = (1ull << lane) - 1ull;
            const int trank = tiebase + __popcll(beq & lt);
            const bool sel = gt || (eq && trank < need);
            const unsigned long long bsel = __ballot(sel);
            if (sel) list[selbase + __popcll(bsel & lt)] = (unsigned short)(j * 64 + lane);
            selbase += __popcll(bsel); tiebase += __popcll(beq); }
        nsel = 256;
    } else {
        nsel = t + 1;
        for (int i = lane; i < 256; i += 64) list[i] = (unsigned short)(i <= t ? i : 0);
    }
    asm volatile("s_waitcnt lgkmcnt(0)" ::: "memory");
    LAS float* qm = (LAS float*)base;
    LAS float* Pl = (LAS float*)(base + 2048);
    { const u32x4 q8 = *(const GAS u32x4*)(PA + n * NPA + PA_Q + 8 * lane);
      *(LAS f32x4*)(qm + 8 * lane) = (f32x4){bflo(q8.x), bfhi(q8.x), bflo(q8.y), bfhi(q8.y)}; *(LAS f32x4*)(qm + 8 * lane + 4) = (f32x4){bflo(q8.z), bfhi(q8.z), bflo(q8.w), bfhi(q8.w)}; }
    asm volatile("s_waitcnt lgkmcnt(0)" ::: "memory");
#pragma unroll 1
    for (int bb = 0; bb < 4; ++bb) { const int i = bb * 64 + lane; const bool valid = i < nsel; const int key = valid ? (int)list[i] : 0;
        const GAS u32x4* kp = (const GAS u32x4*)(KA + (nb0 + key) * 64);
        float kf[64];
#pragma unroll
        for (int c = 0; c < 8; ++c) { const u32x4 kk = kp[c]; kf[8 * c] = bflo(kk.x); kf[8 * c + 1] = bfhi(kk.x); kf[8 * c + 2] = bflo(kk.y); kf[8 * c + 3] = bfhi(kk.y); kf[8 * c + 4] = bflo(kk.z); kf[8 * c + 5] = bfhi(kk.z); kf[8 * c + 6] = bflo(kk.w); kf[8 * c + 7] = bfhi(kk.w); }
        float lgv[8];
#pragma unroll
        for (int h = 0; h < 8; ++h) { float d = 0.f;
#pragma unroll
            for (int c = 0; c < 16; ++c) { const f32x4 q4 = *(const LAS f32x4*)(qm + h * 64 + 4 * c); d += q4.x * kf[4 * c] + q4.y * kf[4 * c + 1] + q4.z * kf[4 * c + 2] + q4.w * kf[4 * c + 3]; }
            lgv[h] = valid ? d : -INFINITY; }
        *(LAS f32x4*)(Pl + i * 8) = (f32x4){lgv[0], lgv[1], lgv[2], lgv[3]}; *(LAS f32x4*)(Pl + i * 8 + 4) = (f32x4){lgv[4], lgv[5], lgv[6], lgv[7]}; }
    asm volatile("s_waitcnt lgkmcnt(0)" ::: "memory");
    float lg[4][8];
#pragma unroll
    for (int bb = 0; bb < 4; ++bb) { const f32x4 a = *(const LAS f32x4*)(Pl + (bb * 64 + lane) * 8), c = *(const LAS f32x4*)(Pl + (bb * 64 + lane) * 8 + 4);
        lg[bb][0] = a.x; lg[bb][1] = a.y; lg[bb][2] = a.z; lg[bb][3] = a.w; lg[bb][4] = c.x; lg[bb][5] = c.y; lg[bb][6] = c.z; lg[bb][7] = c.w; }
    float den[8];
#pragma unroll
    for (int h = 0; h < 8; ++h) { float m = fmaxf(fmaxf(lg[0][h], lg[1][h]), fmaxf(lg[2][h], lg[3][h])); m = wave_max(m, lane); float s = 0.f;
#pragma unroll
        for (int bb = 0; bb < 4; ++bb) { lg[bb][h] = __expf(lg[bb][h] - m); s += lg[bb][h]; }
        den[h] = wave_sum(s, lane); }
#pragma unroll
    for (int bb = 0; bb < 4; ++bb) { const int i = bb * 64 + lane;
        *(LAS f32x4*)(Pl + i * 8) = (f32x4){lg[bb][0], lg[bb][1], lg[bb][2], lg[bb][3]}; *(LAS f32x4*)(Pl + i * 8 + 4) = (f32x4){lg[bb][4], lg[bb][5], lg[bb][6], lg[bb][7]}; }
    asm volatile("s_waitcnt lgkmcnt(0)" ::: "memory");
    float o[8];
#pragma unroll
    for (int h = 0; h < 8; ++h) o[h] = 0.f;
#pragma unroll 4
    for (int i = 0; i < nsel; ++i) { const int key = (int)list[i]; const float vv = bf1(VA[(nb0 + key) * 64 + lane]);
        const f32x4 p0 = *(const LAS f32x4*)(Pl + i * 8), p1 = *(const LAS f32x4*)(Pl + i * 8 + 4);
        o[0] += p0.x * vv; o[1] += p0.y * vv; o[2] += p0.z * vv; o[3] += p0.w * vv; o[4] += p1.x * vv; o[5] += p1.y * vv; o[6] += p1.z * vv; o[7] += p1.w * vv; }
#pragma unroll
    for (int h = 0; h < 8; ++h) Y[n * 1536 + h * 64 + lane] = (bf16)f2bf(o[h] / den[h]);
}

__device__ __forceinline__ bf16x8 scale_pack8(u32x4 raw, float s) {
    u32x4 o; o.x = cvt_pk_bf16(bflo(raw.x) * s, bfhi(raw.x) * s); o.y = cvt_pk_bf16(bflo(raw.y) * s, bfhi(raw.y) * s); o.z = cvt_pk_bf16(bflo(raw.z) * s, bfhi(raw.z) * s); o.w = cvt_pk_bf16(bflo(raw.w) * s, bfhi(raw.w) * s);
    return __builtin_bit_cast(bf16x8, o);
}
__device__ __forceinline__ void dsa16_unit(Frame& F, int unit) {
    const int lane = fresh_lane(); const int w = F.wave;
    const int qb = 2047 - unit;
    const int b = qb & 7, t0 = (qb >> 3) * 16;
    const size_t nb0 = (size_t)b * SEQ;
    const GAS bf16* PA = (const GAS bf16*)(F.ws + WS_PA); GAS bf16* Y = (GAS bf16*)(F.ws + WS_Y);
    const GAS bf16* KI = (const GAS bf16*)(F.ws + WS_KI); const GAS bf16* KA = (const GAS bf16*)(F.ws + WS_KA); const GAS bf16* VA = (const GAS bf16*)(F.ws + WS_VA);
    const GAS float* WI = (const GAS float*)(F.ws + WS_WI);
    LAS unsigned char* K16 = F.lds;
    LAS unsigned short* LIST = (LAS unsigned short*)(F.lds + AUX_OFF);
    const int fr = lane & 15, fq = lane >> 4;
    {
        const int ql = fr >> 2, h = fr & 3;
        bf16x8 Bf[4][2]; f32x4 Linf[4];
#pragma unroll
        for (int g = 0; g < 4; ++g) { const size_t nq = nb0 + t0 + 4 * g + ql; const float wv = WI[nq * 4 + h];
#pragma unroll
            for (int ks = 0; ks < 2; ++ks) Bf[g][ks] = scale_pack8(*(const GAS u32x4*)(PA + nq * NPA + PA_QI + h * 64 + 8 * fq + 32 * ks), wv);
            const f32x4 w4 = *(const GAS f32x4*)(WI + (nb0 + t0 + 4 * g + fq) * 4);
#pragma unroll
            for (int r = 0; r < 4; ++r) Linf[g][r] = (w4[r] >= 0.f) ? INFINITY : -INFINITY; }
        const int ntiles = (t0 >> 4) + 1;
        const bool hist_on = (t0 >= 256); LAS unsigned* H0f = (LAS unsigned*)(F.lds + AUX_OFF + 8192) + fq * 256;
        bf16x8 A0[4], A1[4];
#pragma unroll
        for (int j = 0; j < 4; ++j) { const int tile = (w + 8 * j < ntiles) ? w + 8 * j : ntiles - 1; const size_t krow = (nb0 + 16 * tile + fr) * 64;
            A0[j] = *(const GAS bf16x8*)(KI + krow + 8 * fq); A1[j] = *(const GAS bf16x8*)(KI + krow + 32 + 8 * fq); }
#pragma unroll 1
        for (int tb = w; tb < ntiles; tb += 32) {
            bf16x8 N0[4], N1[4];
#pragma unroll
            for (int j = 0; j < 4; ++j) { const int tn = tb + 32 + 8 * j; const int tile = (tn < ntiles) ? tn : ntiles - 1; const size_t krow = (nb0 + 16 * tile + fr) * 64;
                N0[j] = *(const GAS bf16x8*)(KI + krow + 8 * fq); N1[j] = *(const GAS bf16x8*)(KI + krow + 32 + 8 * fq); }
#pragma unroll
            for (int j = 0; j < 4; ++j) { const int tile = tb + 8 * j;
                if (tile < ntiles) {
                    const int kpos = 16 * tile + fr;
                    const int g7 = kpos >> 7, hf = (kpos >> 6) & 1, ln = kpos & 63;
                    const int koff = (g7 >> 2) * 1024 + ln * 16 + (g7 & 3) * 4 + hf * 2 + fq * 8192;
                    const bool lastt = (tile == ntiles - 1);
                    f32x4 d[4];
#pragma unroll
                    for (int g = 0; g < 4; ++g) d[g] = __builtin_amdgcn_mfma_f32_16x16x32_bf16(Bf[g][0], A0[j], (f32x4){0.f, 0.f, 0.f, 0.f}, 0, 0, 0);
#pragma unroll
                    for (int g = 0; g < 4; ++g) d[g] = __builtin_amdgcn_mfma_f32_16x16x32_bf16(Bf[g][1], A1[j], d[g], 0, 0, 0);
#pragma unroll
                    for (int g = 0; g < 4; ++g) {
                        const float s = ((__builtin_amdgcn_fmed3f(d[g][0], 0.f, Linf[g][0]) + __builtin_amdgcn_fmed3f(d[g][1], 0.f, Linf[g][1])) + (__builtin_amdgcn_fmed3f(d[g][2], 0.f, Linf[g][2]) + __builtin_amdgcn_fmed3f(d[g][3], 0.f, Linf[g][3]))) + 0.0f;
                        const _Float16 hh = (_Float16)s; const unsigned hb = (unsigned)__builtin_bit_cast(unsigned short, hh);
                        unsigned key = (hb ^ ((unsigned)((int)(hb << 16) >> 31) | 0x8000u)) & 0xffffu; if (lastt) key = (kpos <= t0 + 4 * g + fq) ? key : 0u;
                        *(LAS unsigned short*)(K16 + koff + g * 32768) = (unsigned short)key;
                        if (hist_on) __hip_atomic_fetch_add(H0f + g * 1024 + (key >> 8), 1u, __ATOMIC_RELAXED, __HIP_MEMORY_SCOPE_WORKGROUP); }
                }
            }
#pragma unroll
            for (int j = 0; j < 4; ++j) { A0[j] = N0[j]; A1[j] = N1[j]; }
        }
    }
    __syncthreads();
    if (t0 < 256) {
#pragma unroll 1
        for (int qq = 0; qq < 2; ++qq) { const int q = 2 * w + qq, nvalid = t0 + q + 1; LAS unsigned short* list = LIST + q * 256;
            for (int i = lane; i < 256; i += 64) list[i] = (unsigned short)(i < nvalid ? i : 0); }
    } else {
#ifndef REP_S2
#define REP_S2 1
#endif
        LAS unsigned* hist = (LAS unsigned*)(F.lds + AUX_OFF + 8192) + w * 512;
        u32x4 hb0[2];
        hb0[0] = *(const LAS u32x4*)(hist + 4 * lane); hb0[1] = *(const LAS u32x4*)(hist + 256 + 4 * lane);
#pragma unroll 1
        for (int qq = 0; qq < 2 * REP_S2; ++qq) {
            const int q = 2 * w + (qq & 1), nvalid = t0 + q + 1;
            LAS unsigned short* list = LIST + q * 256;
            const int ngrp = (nvalid + 511) >> 9;
            unsigned P[32];
#pragma unroll
            for (int grp = 0; grp < 8; ++grp) {
                if (grp < ngrp) { const u32x4 r = *(const LAS u32x4*)(K16 + q * 8192 + grp * 1024 + lane * 16);
#pragma unroll
                    for (int i = 0; i < 4; ++i) { const int g = 4 * grp + i; const int thr = nvalid - 128 * g; unsigned rr = r[i];
                        if (thr < 128) rr &= ((lane < thr) ? 0xffffu : 0u) | ((lane < thr - 64) ? 0xffff0000u : 0u);
                        P[g] = rr; }
                } else {
#pragma unroll
                    for (int i = 0; i < 4; ++i) P[4 * grp + i] = 0u;
                }
            }
            unsigned one2 = 0x00010001u; asm volatile("" : "+v"(one2));
#define DSA_PKCOUNT(dst, c1) do { const unsigned c1p_ = (c1) | ((c1) << 16); unsigned a_ = 0u; \
                _Pragma("unroll") for (int grp = 0; grp < 8; ++grp) if (grp < ngrp) { _Pragma("unroll") for (int i = 0; i < 4; ++i) { unsigned y_; \
                    asm("v_pk_sub_u16 %0, %1, %2 clamp\n\tv_pk_min_u16 %0, %0, %3" : "=&v"(y_) : "v"(P[4 * grp + i]), "v"(c1p_), "v"(one2)); a_ += y_; } } \
                dst = (int)((a_ & 0xffffu) + (a_ >> 16)); } while (0)
            LAS unsigned* histl = hist + (lane & 1) * 256;
            unsigned T; int tot_gt;
            { unsigned hi8 = 0u; int above = 0;
#pragma unroll
              for (int lvl = 0; lvl < 2; ++lvl) {
                  u32x4 hb;
                  if (lvl == 0) hb = (qq & 1) ? hb0[1] : hb0[0];
                  else {
                      { unsigned z_ = 0u; asm volatile("" : "+v"(z_)); *(LAS u32x4*)(hist + 4 * lane) = (u32x4){z_, z_, z_, z_}; *(LAS u32x4*)(hist + 256 + 4 * lane) = (u32x4){z_, z_, z_, z_}; }
                      asm volatile("s_waitcnt lgkmcnt(0)" ::: "memory");
#pragma unroll
                      for (int grp = 0; grp < 8; ++grp) if (grp < ngrp) {
#pragma unroll
                          for (int i = 0; i < 4; ++i) { const unsigned lo = P[4 * grp + i] & 0xffffu, hi = P[4 * grp + i] >> 16;
                              if ((lo >> 8) == hi8) __hip_atomic_fetch_add(histl + (lo & 0xffu), 1u, __ATOMIC_RELAXED, __HIP_MEMORY_SCOPE_WAVEFRONT);
                              if ((hi >> 8) == hi8) __hip_atomic_fetch_add(histl + (hi & 0xffu), 1u, __ATOMIC_RELAXED, __HIP_MEMORY_SCOPE_WAVEFRONT); } }
                      asm volatile("s_waitcnt lgkmcnt(0)" ::: "memory");
                      hb = *(const LAS u32x4*)(hist + 4 * lane) + *(const LAS u32x4*)(hist + 256 + 4 * lane);
                      { unsigned z_ = 0u; asm volatile("" : "+v"(z_)); *(LAS u32x4*)(hist + 4 * lane) = (u32x4){z_, z_, z_, z_}; *(LAS u32x4*)(hist + 256 + 4 * lane) = (u32x4){z_, z_, z_, z_}; }
                  }
                  const int sl = (int)(hb.x + hb.y + hb.z + hb.w);
                  int inc = sl;
                  inc += __builtin_amdgcn_update_dpp(0, inc, 0x111, 0xf, 0xf, false); inc += __builtin_amdgcn_update_dpp(0, inc, 0x112, 0xf, 0xf, false);
                  inc += __builtin_amdgcn_update_dpp(0, inc, 0x114, 0xf, 0xf, false); inc += __builtin_amdgcn_update_dpp(0, inc, 0x118, 0xf, 0xf, false);
                  const int r0 = __builtin_amdgcn_readlane(inc, 15), r1 = __builtin_amdgcn_readlane(inc, 31), r2 = __builtin_amdgcn_readlane(inc, 47), r3 = __builtin_amdgcn_readlane(inc, 63);
                  inc += (fq >= 1 ? r0 : 0) + (fq >= 2 ? r1 : 0) + (fq >= 3 ? r2 : 0);
                  const int total = r0 + r1 + r2 + r3;
                  const int want = 256 - above;
                  int run = total - inc;
                  int fb = -1, fa = 0;
                  { const int h3 = (int)hb.w, h2 = (int)hb.z, h1 = (int)hb.y, h0 = (int)hb.x;
                    if (run < want && run + h3 >= want) { fb = 3; fa = run; } run += h3;
                    if (run < want && run + h2 >= want) { fb = 2; fa = run; } run += h2;
                    if (run < want && run + h1 >= want) { fb = 1; fa = run; } run += h1;
                    if (run < want && run + h0 >= want) { fb = 0; fa = run; } }
                  const unsigned long long fm = __ballot(fb >= 0);
                  const int src = (int)__builtin_ctzll(fm);
                  const int bstar = __builtin_amdgcn_readlane(4 * lane + fb, src), abv = __builtin_amdgcn_readlane(fa, src);
                  if (lvl == 0) { hi8 = (unsigned)bstar; above = abv; } else { T = (hi8 << 8) | (unsigned)bstar; tot_gt = above + abv; }
              } }
            int cge_l, cgt_l; DSA_PKCOUNT(cge_l, T - 1u); DSA_PKCOUNT(cgt_l, T);
            const int tot_ge = wave_total_i(cge_l);
            const bool alltie = (tot_ge == 256);
            const int c_l = alltie ? cge_l : cgt_l; const unsigned thrT = alltie ? T : T + 1u;
            int inc = c_l;
            inc += __builtin_amdgcn_update_dpp(0, inc, 0x111, 0xf, 0xf, false); inc += __builtin_amdgcn_update_dpp(0, inc, 0x112, 0xf, 0xf, false);
            inc += __builtin_amdgcn_update_dpp(0, inc, 0x114, 0xf, 0xf, false); inc += __builtin_amdgcn_update_dpp(0, inc, 0x118, 0xf, 0xf, false);
            { const int r0 = __builtin_amdgcn_readlane(inc, 15), r1 = __builtin_amdgcn_readlane(inc, 31), r2 = __builtin_amdgcn_readlane(inc, 47);
              inc += (fq >= 1 ? r0 : 0) + (fq >= 2 ? r1 : 0) + (fq >= 3 ? r2 : 0); }
            int kpos_ = inc - c_l;
#pragma unroll
            for (int grp = 0; grp < 8; ++grp) if (grp < ngrp) {
#pragma unroll
                for (int i = 0; i < 4; ++i) { const int g = 4 * grp + i; const unsigned lo = P[g] & 0xffffu, hi = P[g] >> 16;
                    if (lo >= thrT) { list[kpos_] = (unsigned short)(128 * g + lane); ++kpos_; }
                    if (hi >= thrT) { list[kpos_] = (unsigned short)(128 * g + 64 + lane); ++kpos_; } } }
            if (!alltie) {
                int rem = 256 - tot_gt, pos = tot_gt; const unsigned long long lt = (1ull << lane) - 1ull;
#pragma unroll
                for (int grp = 0; grp < 8; ++grp) if (grp < ngrp) {
#pragma unroll
                    for (int i = 0; i < 8; ++i) { const int g = 4 * grp + (i >> 1); const unsigned val = (i & 1) ? (P[g] >> 16) : (P[g] & 0xffffu);
                        const bool eq = (val == T); const unsigned long long beq = __ballot(eq);
                        if (beq != 0ull) { const int rank = __popcll(beq & lt); if (eq && rank < rem) list[pos + rank] = (unsigned short)(128 * g + 64 * (i & 1) + lane);
                            const int n = __popcll(beq), take = n < rem ? n : rem; pos += take; rem -= take; } } }
            }
#undef DSA_PKCOUNT
        }
    }
    asm volatile("s_waitcnt lgkmcnt(0)" ::: "memory");
    LAS unsigned char* Vs = F.lds + w * 16384;
#ifndef REP_S3
#define REP_S3 1
#endif
#pragma unroll 1
    for (int qq = 0; qq < 2 * REP_S3; ++qq) {
        const int q = 2 * w + (qq & 1), tq = t0 + q; const int nsel = (tq + 1 < 256) ? tq + 1 : 256;
        const size_t nq = nb0 + tq;
        const LAS unsigned short* list = LIST + q * 256;
        bf16x8 Qf[2];
#pragma unroll
        for (int ks = 0; ks < 2; ++ks) { u32x4 raw = {0u, 0u, 0u, 0u}; if (fr < 8) raw = *(const GAS u32x4*)(PA + nq * NPA + PA_Q + fr * 64 + 8 * fq + 32 * ks); Qf[ks] = __builtin_bit_cast(bf16x8, raw); }
        float lg[16][4];
#ifdef REP_S3K
#pragma unroll 1
        for (int repk = 0; repk < REP_S3K; ++repk)
#endif
        const int st_off = (lane >> 3) * 128 + (((lane & 7) ^ ((lane >> 3) & 7)) * 16);
        const int rd0 = fr * 128 + ((fq ^ (fr & 7)) * 16), rd1 = fr * 128 + (((fq + 4) ^ (fr & 7)) * 16);
#pragma unroll
        for (int hb = 0; hb < 2; ++hb) {
#pragma unroll
            for (int ib = 0; ib < 2; ++ib) { u32x4 kv[8];
#pragma unroll
                for (int i = 0; i < 8; ++i) { const int piece = (8 * ib + i) * 64 + lane; const int key = (int)list[128 * hb + (piece >> 3)];
                    kv[i] = *(const GAS u32x4*)(KA + (nb0 + key) * 64 + 8 * (lane & 7)); }
                __builtin_amdgcn_sched_barrier(0);
#pragma unroll
                for (int i = 0; i < 8; ++i) *(LAS u32x4*)(Vs + st_off + (8 * ib + i) * 1024) = kv[i];
            }
            asm volatile("s_waitcnt lgkmcnt(0)" ::: "memory");
#pragma unroll
            for (int j = 0; j < 8; ++j) { const int tt = 8 * hb + j;
                const bf16x8 A0 = *(const LAS bf16x8*)(Vs + rd0 + j * 2048), A1 = *(const LAS bf16x8*)(Vs + rd1 + j * 2048);
                f32x4 d = __builtin_amdgcn_mfma_f32_16x16x32_bf16(A0, Qf[0], (f32x4){0.f, 0.f, 0.f, 0.f}, 0, 0, 0);
                d = __builtin_amdgcn_mfma_f32_16x16x32_bf16(A1, Qf[1], d, 0, 0, 0);
#pragma unroll
                for (int r = 0; r < 4; ++r) lg[tt][r] = (16 * tt + 4 * fq + r < nsel) ? d[r] : -INFINITY; }
            asm volatile("s_waitcnt lgkmcnt(0)" ::: "memory");
        }
        float m = lg[0][0];
#pragma unroll
        for (int tt = 0; tt < 16; ++tt)
#pragma unroll
            for (int r = 0; r < 4; ++r) m = fmaxf(m, lg[tt][r]);
        m = fmaxf(m, shx(m, 16, lane)); m = fmaxf(m, shx(m, 32, lane));
        float den = 0.f;
#pragma unroll
        for (int tt = 0; tt < 16; ++tt)
#pragma unroll
            for (int r = 0; r < 4; ++r) { lg[tt][r] = __expf(lg[tt][r] - m); den += lg[tt][r]; }
        den += shx(den, 16, lane); den += shx(den, 32, lane);
        f32x4 acc[4];
#pragma unroll
        for (int nt = 0; nt < 4; ++nt) acc[nt] = (f32x4){0.f, 0.f, 0.f, 0.f};
#ifdef REP_S3V
#pragma unroll 1
        for (int repv = 0; repv < REP_S3V; ++repv) {
#pragma unroll
        for (int nt = 0; nt < 4; ++nt) acc[nt] = (f32x4){0.f, 0.f, 0.f, 0.f};
#endif
#pragma unroll
        for (int hh = 0; hh < 2; ++hh) {
#pragma unroll
            for (int ib = 0; ib < 2; ++ib) {
                u32x4 vv[8];
#pragma unroll
                for (int i = 0; i < 8; ++i) { const int piece = (8 * ib + i) * 64 + lane, row = piece >> 3, c = piece & 7; const int key = (int)list[128 * hh + row];
                    vv[i] = *(const GAS u32x4*)(VA + (nb0 + key) * 64 + 8 * c); }
                __builtin_amdgcn_sched_barrier(0);
#pragma unroll
                for (int i = 0; i < 8; ++i) { const int piece = (8 * ib + i) * 64 + lane; *(LAS u32x4*)(Vs + piece * 16) = vv[i]; }
            }
            asm volatile("s_waitcnt lgkmcnt(0)" ::: "memory");
#pragma unroll
            for (int s4 = 0; s4 < 4; ++s4) { const int s = 4 * hh + s4;
                u32x4 pa; pa.x = cvt_pk_bf16(lg[2 * s][0], lg[2 * s][1]); pa.y = cvt_pk_bf16(lg[2 * s][2], lg[2 * s][3]); pa.z = cvt_pk_bf16(lg[2 * s + 1][0], lg[2 * s + 1][1]); pa.w = cvt_pk_bf16(lg[2 * s + 1][2], lg[2 * s + 1][3]);
                const bf16x8 Pa = __builtin_bit_cast(bf16x8, pa);
                const int rowa = 32 * s4 + 4 * fq + (fr >> 2);
#pragma unroll
                for (int nt = 0; nt < 4; ++nt) {
                    const v4i16_t lo = __builtin_amdgcn_ds_read_tr16_b64_v4i16((LAS v4i16_t*)(Vs + rowa * 128 + (16 * nt + 4 * (fr & 3)) * 2));
                    const v4i16_t hi = __builtin_amdgcn_ds_read_tr16_b64_v4i16((LAS v4i16_t*)(Vs + (rowa + 16) * 128 + (16 * nt + 4 * (fr & 3)) * 2));
                    bf16x8 Bv; Bv[0] = lo[0]; Bv[1] = lo[1]; Bv[2] = lo[2]; Bv[3] = lo[3]; Bv[4] = hi[0]; Bv[5] = hi[1]; Bv[6] = hi[2]; Bv[7] = hi[3];
                    acc[nt] = __builtin_amdgcn_mfma_f32_16x16x32_bf16(Bv, Pa, acc[nt], 0, 0, 0); } }
            asm volatile("s_waitcnt lgkmcnt(0)" ::: "memory");
        }
#ifdef REP_S3V
        }
#endif
        if (fr < 8) { const float rden = 1.f / den;
#pragma unroll
            for (int nt = 0; nt < 4; ++nt) { u32x2 wv; wv.x = pk2(acc[nt][0] * rden, acc[nt][1] * rden); wv.y = pk2(acc[nt][2] * rden, acc[nt][3] * rden);
                *(GAS u32x2*)(Y + nq * 1536 + fr * 64 + 16 * nt + 4 * fq) = wv; } }
    }
}

#ifdef GLA_NAIVE
constexpr int NGLA = 32;
#else
constexpr int NGLA = 2048;
#endif
#ifdef DSA_NAIVE
constexpr int NDSA = 4096;
#else
constexpr int NDSA = 2048;
#endif
#ifdef GMLP_NAIVE
constexpr int NGM = 1024;
#else
constexpr int NGM = 256;
#endif
__device__ __forceinline__ void phase_mixer(Frame& F, int l, int slot = 0, int types = 7, bool dry = false) {
    (void)slot;
    for (int i = F.tid; i < 4096; i += 512) ((LAS unsigned*)(F.lds + AUX_OFF + 8192))[i] = 0u;
    for (int j = 0; j * F.G < NDSA; ++j) { const int u = j * F.G + ((j & 1) ? (F.G - 1 - F.wg) : F.wg);
        if (u >= NDSA) continue;
        __syncthreads(); if (EN_B2 && (types & 2)) {
#ifdef DSA_NAIVE
        dsa_unit(F, u);
#else
        dsa16_unit(F, u);
#endif
    } }
    for (int u = F.wg; u < NGLA; u += F.G) { __syncthreads(); if (EN_B1 && (types & 1)) {
#ifdef GLA_NAIVE
        gla_unit(F, l, u);
#else
        gla_local_unit(F, l, u, dry);
#endif
    } }
    for (int u = F.wg; u < NGM; u += F.G) { __syncthreads(); if (EN_B3 && (types & 4)) {
#ifdef GMLP_NAIVE
        gmlp_unit(F, l, u);
#else
        gmlp16_unit(F, l, u);
#endif
    } }
}
__device__ __forceinline__ void phase_gla_out(Frame& F, int l, bool dry = false) {
#ifndef GLA_NAIVE
    const int lane = fresh_lane(), w = F.wave, tid = w * 64 + lane, fr = lane & 15, fq = lane >> 4;
    GlaOutRegs R, N;
    if (F.wg < 2048) gla_out_load(F, F.wg, tid, w, fr, fq, R);
#pragma unroll 1
    for (int u = F.wg; u < 2048; u += F.G) { const int un = (u + F.G < 2048) ? u + F.G : u;
        gla_out_load(F, un, tid, w, fr, fq, N);
        gla_out_compute(F, l, u, tid, lane, w, fr, fq, R, dry);
        R = N; }
#endif
}

template <int CTRL> __device__ __forceinline__ float dpp_add(float v) { return v + dppf<CTRL>(v); }
__device__ __forceinline__ float row16_sum(float v) { v = dpp_add<0xB1>(v); v = dpp_add<0x4E>(v); v = dpp_add<0x141>(v); v = dpp_add<0x140>(v); return v; }
__device__ __forceinline__ void phase_ln_router(Frame& F, int l) {
    const GAS bf16* WRB = (const GAS bf16*)(F.ws + WS_WR) + (size_t)l * 48 * DM;
    LAS unsigned char* WB = F.lds;
    for (int i = F.tid; i < 48 * 128; i += 512) { const int n = i >> 7, c = i & 127; *(LAS u32x4*)(WB + n * 2048 + ((c ^ (n & 7)) * 16)) = *(const GAS u32x4*)(WRB + n * DM + 8 * c); }
    if (F.tid < 32) F.MISC[16 + F.tid] = 0u;
    __syncthreads();
    GAS bf16* HB = (GAS bf16*)(F.ws + WS_HB); const GAS bf16* T = (const GAS bf16*)F.H; GAS int* EID = (GAS int*)(F.ws + WS_ROUTE); GAS float* EW = (GAS float*)(F.ws + WS_ROUTE + 256 * 1024);
    const GAS float* g = ((const GAS float*)F.in[17]) + l * DM; const GAS float* bb = ((const GAS float*)F.in[18]) + l * DM; const GAS float* brg = ((const GAS float*)F.in[20]) + l * 4; const GAS float* bre = ((const GAS float*)F.in[22]) + l * 32;
    const int lane = fresh_lane();
    const int sub = lane & 15, rr = lane >> 4, fr = sub, fq = rr;
    LAS float* LG = (LAS float*)(F.lds + 98304) + F.wave * 768;
    for (int r0 = F.wg * 128; r0 < NTOK; r0 += F.G * 128) {
        const int m0 = r0 + F.wave * 16;
        u32x4 nx[8];
#pragma unroll
        for (int q = 0; q < 8; ++q) nx[q] = *(const GAS u32x4*)(T + (size_t)(m0 + rr) * DM + 8 * (sub + 16 * q));
#pragma unroll 1
        for (int j = 0; j < 4; ++j) { const int m = m0 + 4 * j + rr;
            float v[64]; float s = 0.f;
#pragma unroll
            for (int q = 0; q < 8; ++q) { const u32x4 x = nx[q]; v[8 * q] = bflo(x.x); v[8 * q + 1] = bfhi(x.x); v[8 * q + 2] = bflo(x.y); v[8 * q + 3] = bfhi(x.y); v[8 * q + 4] = bflo(x.z); v[8 * q + 5] = bfhi(x.z); v[8 * q + 6] = bflo(x.w); v[8 * q + 7] = bfhi(x.w); }
            { const int mn = (j < 3) ? m + 4 : m;
#pragma unroll
              for (int q = 0; q < 8; ++q) nx[q] = *(const GAS u32x4*)(T + (size_t)mn * DM + 8 * (sub + 16 * q)); }
#pragma unroll
            for (int i = 0; i < 64; ++i) s += v[i];
            const float mean = row16_sum(s) * (1.f / DM); float s2 = 0.f;
#pragma unroll
            for (int i = 0; i < 64; ++i) { v[i] -= mean; s2 += v[i] * v[i]; }
            const float rstd = 1.f / sqrtf(row16_sum(s2) * (1.f / DM) + LN_EPS);
#pragma unroll
            for (int q = 0; q < 8; ++q) { const int c = 8 * (sub + 16 * q); const f32x4 g0 = *(const GAS f32x4*)(g + c), g1 = *(const GAS f32x4*)(g + c + 4), b0 = *(const GAS f32x4*)(bb + c), b1 = *(const GAS f32x4*)(bb + c + 4);
#pragma unroll
                for (int i = 0; i < 4; ++i) { v[8 * q + i] = v[8 * q + i] * rstd * g0[i] + b0[i]; v[8 * q + 4 + i] = v[8 * q + 4 + i] * rstd * g1[i] + b1[i]; }
                u32x4 wv; wv.x = pk2(v[8 * q], v[8 * q + 1]); wv.y = pk2(v[8 * q + 2], v[8 * q + 3]); wv.z = pk2(v[8 * q + 4], v[8 * q + 5]); wv.w = pk2(v[8 * q + 6], v[8 * q + 7]);
                *(GAS u32x4*)(HB + (size_t)m * DM + c) = wv; } }
        asm volatile("s_waitcnt vmcnt(0)" ::: "memory");
        f32x4 acc[3];
#pragma unroll
        for (int nt = 0; nt < 3; ++nt) acc[nt] = (f32x4){0.f, 0.f, 0.f, 0.f};
#pragma unroll 1
        for (int kb = 0; kb < 4; ++kb) {
            bf16x8 af[8];
#pragma unroll
            for (int ks = 0; ks < 8; ++ks) af[ks] = *(const GAS bf16x8*)(HB + (size_t)(m0 + fr) * DM + 8 * fq + 32 * (8 * kb + ks));
#pragma unroll
            for (int ks = 0; ks < 8; ++ks) { const int c = fq + 4 * (8 * kb + ks);
#pragma unroll
                for (int nt = 0; nt < 3; ++nt) { const int n = 16 * nt + fr; const bf16x8 bw = *(const LAS bf16x8*)(WB + n * 2048 + ((c ^ (n & 7)) * 16));
                    acc[nt] = __builtin_amdgcn_mfma_f32_16x16x32_bf16(af[ks], bw, acc[nt], 0, 0, 0); } } }
#pragma unroll
        for (int nt = 0; nt < 3; ++nt)
#pragma unroll
            for (int r = 0; r < 4; ++r) LG[(4 * fq + r) * 48 + 16 * nt + fr] = acc[nt][r];
        asm volatile("s_waitcnt lgkmcnt(0)" ::: "memory");
        if (lane < 16) { const int m = m0 + lane; const LAS float* lgt = LG + lane * 48;
            int gi = 0; float gm = lgt[0] + brg[0];
#pragma unroll
            for (int q = 1; q < 4; ++q) { const float x = lgt[q] + brg[q]; if (x > gm) { gm = x; gi = q; } }
            float gs = 0.f;
#pragma unroll
            for (int q = 0; q < 4; ++q) gs += __expf(lgt[q] + brg[q] - gm);
            const float gp = 1.f / gs;
            float el[8];
#pragma unroll
            for (int q = 0; q < 8; ++q) el[q] = lgt[4 + 8 * gi + q] + bre[8 * gi + q];
            int i0 = 0; float v0 = el[0];
#pragma unroll
            for (int q = 1; q < 8; ++q) if (el[q] > v0) { v0 = el[q]; i0 = q; }
            int i1 = -1; float v1 = -INFINITY;
#pragma unroll
            for (int q = 0; q < 8; ++q) if (q != i0 && el[q] > v1) { v1 = el[q]; i1 = q; }
            const float ex = __expf(v1 - v0), w0 = gp / (1.f + ex), w1 = gp * ex / (1.f + ex);
            const int e0 = gi * 8 + i0, e1 = gi * 8 + i1;
            EID[2 * m] = e0; EID[2 * m + 1] = e1; EW[2 * m] = w0; EW[2 * m + 1] = w1;
            __hip_atomic_fetch_add((LAS unsigned*)(F.lds + MISC_OFF) + 16 + e0, 1u, __ATOMIC_RELAXED, __HIP_MEMORY_SCOPE_WORKGROUP);
            __hip_atomic_fetch_add((LAS unsigned*)(F.lds + MISC_OFF) + 16 + e1, 1u, __ATOMIC_RELAXED, __HIP_MEMORY_SCOPE_WORKGROUP); }
        asm volatile("s_waitcnt lgkmcnt(0)" ::: "memory");
    }
    __syncthreads();
    if (F.tid < 32) ((GAS int*)(F.ws + WS_CNTWG))[F.wg * 32 + F.tid] = (int)F.MISC[16 + F.tid];
}
__device__ __forceinline__ void phase_dispatch(Frame& F) {
    const GAS int* CNT = (const GAS int*)(F.ws + WS_CNTWG); const GAS int* EID = (const GAS int*)(F.ws + WS_ROUTE); const GAS float* EW = (const GAS float*)(F.ws + WS_ROUTE + 256 * 1024);
    GAS int* SROW = (GAS int*)(F.ws + WS_SROW); GAS int* ROWMAP = (GAS int*)(F.ws + WS_ROWMAP); GAS float* CWROW = (GAS float*)(F.ws + WS_CWROW); GAS int* META = (GAS int*)(F.ws + WS_META);
    LAS int* tot = (LAS int*)(F.lds + AUX_OFF);
    { const int e = F.tid & 31, part = F.tid >> 5; int t = 0, mine = 0;
      int cv[16];
#pragma unroll
      for (int j = 0; j < 16; ++j) { const int w = part * 16 + j; cv[j] = (w < F.G) ? ld_i32(CNT + w * 32 + e) : 0; }
#pragma unroll
      for (int j = 0; j < 16; ++j) { const int w = part * 16 + j; t += cv[j]; mine += (w < F.wg) ? cv[j] : 0; }
      tot[160 + F.tid] = t; tot[160 + 512 + F.tid] = mine; }
    __syncthreads();
    if (F.tid < 32) { int t = 0, mine = 0;
#pragma unroll
        for (int p = 0; p < 16; ++p) { t += tot[160 + p * 32 + F.tid]; mine += tot[160 + 512 + p * 32 + F.tid]; }
        tot[F.tid] = t; tot[32 + F.tid] = mine; tot[96 + F.tid] = 0; }
    __syncthreads();
    if (F.tid == 0) { int rb = 0;
#pragma clang loop unroll(disable) vectorize(disable)
        for (int e = 0; e < 32; ++e) { tot[64 + e] = rb; rb += ((tot[e] + 255) >> 8) << 8; }
        tot[128] = rb; }
    __syncthreads();
    if (F.wg == 0) { const int nt = tot[128] >> 8; if (F.tid == 0) META[0] = nt;
        if (F.tid < nt) { int e = 0;
#pragma clang loop unroll(disable) vectorize(disable)
            for (int q = 1; q < 32; ++q) if (tot[64 + q] <= F.tid * 256) e = q;
            META[16 + F.tid] = e; } }
    for (int r0 = F.wg * 128; r0 < NTOK; r0 += F.G * 128) {
        if (F.tid < 256) { const int tok = r0 + (F.tid >> 1), slot = F.tid & 1; const int e = EID[2 * tok + slot];
            const int pos = (int)__hip_atomic_fetch_add((LAS unsigned*)&tot[96 + e], 1u, __ATOMIC_RELAXED, __HIP_MEMORY_SCOPE_WORKGROUP);
            const int sr = tot[64 + e] + tot[32 + e] + pos;
            ROWMAP[sr] = tok; CWROW[sr] = EW[2 * tok + slot]; SROW[2 * tok + slot] = sr; } }
    if (F.wg < 32) { const int e = F.wg; const int lo = tot[64 + e] + tot[e], hi = tot[64 + e] + (((tot[e] + 255) >> 8) << 8);
        for (int r = lo + F.tid; r < hi; r += 512) { ROWMAP[r] = 0; CWROW[r] = 0.f; } }
}
__device__ __forceinline__ void phase_ln2(Frame& F, int l, bool dry = false) {
    GAS bf16* HB = (GAS bf16*)(F.ws + WS_HB); GAS bf16* HBo = dry ? (GAS bf16*)(F.ws + WS_Y) : HB; GAS float* Ho = dry ? (GAS float*)(F.ws + WS_PA + 184 * MiB) : F.H; const GAS int* SROW = (const GAS int*)(F.ws + WS_SROW); const GAS bf16* FF2 = (const GAS bf16*)(F.ws + WS_FF2);
    const GAS float* g = ((const GAS float*)F.in[26]) + l * DM; const GAS float* bb = ((const GAS float*)F.in[27]) + l * DM; int lane = F.lane; asm volatile("" : "+v"(lane));
    const int gw = F.wg * 8 + F.wave, NGW = F.G * 8; const bool last = (l == DEPTH - 1);
    const int nrow = (NTOK - gw + NGW - 1) / NGW;
    const int srv = (2 * (gw + (lane >> 1) * NGW) + (lane & 1) < 2 * NTOK) ? ld_i32(SROW + 2 * (gw + (lane >> 1) * NGW) + (lane & 1)) : 0;
    u32x4 hn[2][2], an[2][2], cn[2][2];
#define LN2_ISSUE(jj, slot) do { const int j_ = (jj); if (j_ < nrow) { const int m_ = gw + j_ * NGW; const int s0_ = __builtin_amdgcn_readlane(srv, 2 * j_), s1_ = __builtin_amdgcn_readlane(srv, 2 * j_ + 1); \
        _Pragma("unroll") for (int q_ = 0; q_ < 2; ++q_) { hn[slot][q_] = *(const GAS u32x4*)(HB + (size_t)m_ * DM + 8 * lane + 512 * q_); an[slot][q_] = *(const GAS u32x4*)(FF2 + (size_t)s0_ * DM + 8 * lane + 512 * q_); cn[slot][q_] = *(const GAS u32x4*)(FF2 + (size_t)s1_ * DM + 8 * lane + 512 * q_); } } } while (0)
    LN2_ISSUE(0, 0); LN2_ISSUE(1, 1);
#pragma unroll 1
    for (int jr = 0; jr < nrow; jr += 2)
#pragma unroll
    for (int slot = 0; slot < 2; ++slot) { const int jrow = jr + slot; if (jrow >= nrow) break; const int m = gw + jrow * NGW;
        float v[16];
#pragma unroll
        for (int j = 0; j < 2; ++j) { const u32x4 h = hn[slot][j], a = an[slot][j], c = cn[slot][j];
            v[8 * j] = bflo(h.x) * DN_ALPHA + (bflo(a.x) + bflo(c.x)); v[8 * j + 1] = bfhi(h.x) * DN_ALPHA + (bfhi(a.x) + bfhi(c.x)); v[8 * j + 2] = bflo(h.y) * DN_ALPHA + (bflo(a.y) + bflo(c.y)); v[8 * j + 3] = bfhi(h.y) * DN_ALPHA + (bfhi(a.y) + bfhi(c.y));
            v[8 * j + 4] = bflo(h.z) * DN_ALPHA + (bflo(a.z) + bflo(c.z)); v[8 * j + 5] = bfhi(h.z) * DN_ALPHA + (bfhi(a.z) + bfhi(c.z)); v[8 * j + 6] = bflo(h.w) * DN_ALPHA + (bflo(a.w) + bflo(c.w)); v[8 * j + 7] = bfhi(h.w) * DN_ALPHA + (bfhi(a.w) + bfhi(c.w)); }
        LN2_ISSUE(jrow + 2, slot);
        float s = 0.f;
#pragma unroll
        for (int i = 0; i < 16; ++i) s += v[i];
        const float mean = wave_sum(s, lane) * (1.f / DM); float s2 = 0.f;
#pragma unroll
        for (int i = 0; i < 16; ++i) { v[i] -= mean; s2 += v[i] * v[i]; }
        const float rstd = 1.f / sqrtf(wave_sum(s2, lane) * (1.f / DM) + LN_EPS);
#pragma unroll
        for (int j = 0; j < 2; ++j) { const int c = 8 * lane + 512 * j; const f32x4 g0 = *(const GAS f32x4*)(g + c), g1 = *(const GAS f32x4*)(g + c + 4), b0 = *(const GAS f32x4*)(bb + c), b1 = *(const GAS f32x4*)(bb + c + 4);
#pragma unroll
            for (int i = 0; i < 4; ++i) { v[8 * j + i] = v[8 * j + i] * rstd * g0[i] + b0[i]; v[8 * j + 4 + i] = v[8 * j + 4 + i] * rstd * g1[i] + b1[i]; }
            if (last) { *(GAS f32x4*)(Ho + (size_t)m * DM + c) = (f32x4){v[8 * j], v[8 * j + 1], v[8 * j + 2], v[8 * j + 3]}; *(GAS f32x4*)(Ho + (size_t)m * DM + c + 4) = (f32x4){v[8 * j + 4], v[8 * j + 5], v[8 * j + 6], v[8 * j + 7]}; }
            else { u32x4 wv; wv.x = pk2(v[8 * j], v[8 * j + 1]); wv.y = pk2(v[8 * j + 2], v[8 * j + 3]); wv.z = pk2(v[8 * j + 4], v[8 * j + 5]); wv.w = pk2(v[8 * j + 6], v[8 * j + 7]); *(GAS u32x4*)(HBo + (size_t)m * DM + c) = wv; } }
    }
#undef LN2_ISSUE
}

#ifndef EN_P
#define EN_P 1
#endif
#ifndef EN_A
#define EN_A 1
#endif
#ifndef EN_B
#define EN_B 1
#endif
#ifndef EN_C
#define EN_C 1
#endif
#ifndef EN_D
#define EN_D 1
#endif
#ifndef EN_E
#define EN_E 1
#endif
#ifndef EN_F
#define EN_F 1
#endif
#ifndef EN_G
#define EN_G 1
#endif
#ifndef EN_H
#define EN_H 1
#endif
#ifndef EN_I
#define EN_I 1
#endif
#ifndef EN_J
#define EN_J 1
#endif
constexpr int PPL = 12;
constexpr int N_PHASES = 1 + PPL * DEPTH;
#ifndef MK_ONE_LAUNCH
#define MK_ONE_LAUNCH 0
#endif
struct Args { const float* in[28]; float* out; unsigned char* ws; int ph_lo, ph_hi; };
static_assert(sizeof(Args) == 28 * 8 + 8 + 8 + 8, "no padding bytes in the argument struct");


__device__ __forceinline__ unsigned opaque_u32(unsigned x) { unsigned v; asm volatile("v_mov_b32 %0, %1" : "=v"(v) : "s"(x)); return (unsigned)__builtin_amdgcn_readfirstlane((int)v); }
__device__ __forceinline__ unsigned long long opaque_u64(unsigned long long x) { return ((unsigned long long)opaque_u32((unsigned)(x >> 32)) << 32) | opaque_u32((unsigned)x); }
__device__ __forceinline__ void launder(Frame& F) {
    F.ws = (GAS unsigned char*)opaque_u64((unsigned long long)F.ws); F.H = (GAS float*)opaque_u64((unsigned long long)F.H);
    F.ctl = (gu32*)opaque_u64((unsigned long long)F.ctl);
    unsigned z0 = 0u; asm volatile("" : "+v"(z0)); int ln = (int)__builtin_amdgcn_mbcnt_hi(~0u, __builtin_amdgcn_mbcnt_lo(~0u, z0));
    F.wave = (int)opaque_u32((unsigned)F.wave); F.lane = ln; F.tid = F.wave * 64 + ln;
    F.G = (int)opaque_u32((unsigned)F.G); F.wg = (int)opaque_u32((unsigned)F.wg);
}
#ifndef SG_N
#define SG_N 1
#endif
#ifndef SG_US
#define SG_US 0
#endif
__device__ __forceinline__ void gemm_stagger(const Frame& F) {
    if (SG_N > 1) { const int g = (F.wg >> 3) & (SG_N - 1);
        if (g) { const unsigned long long t0 = __builtin_amdgcn_s_memrealtime(), dt = (unsigned long long)(g * SG_US * 100); while (__builtin_amdgcn_s_memrealtime() - t0 < dt) __builtin_amdgcn_s_sleep(4); } }
}
__global__ void __launch_bounds__(512, 2) mk_fwd(Args args) {
    extern __shared__ __attribute__((aligned(16))) unsigned char lds_raw[];
    Frame F;
    F.lds = (LAS unsigned char*)lds_raw;
    F.MISC = (volatile LAS unsigned*)(F.lds + MISC_OFF);
    F.tid = threadIdx.x; F.lane = F.tid & 63; F.wave = __builtin_amdgcn_readfirstlane(F.tid >> 6);
    F.G = gridDim.x; F.wg = blockIdx.x;
    F.in = args.in;
    F.pos = (const GAS int*)args.in[1];
    F.H = (GAS float*)args.out; F.ws = (GAS unsigned char*)args.ws;
    F.ctl = (gu32*)(args.ws + WS_CTL);
    for (int u = F.tid; u < (LDS_BYTES - MISC_OFF) / 4; u += 512) ((LAS unsigned*)(F.lds + MISC_OFF))[u] = 0u;
    __syncthreads();
    const int lo = args.ph_lo, hi = args.ph_hi;
    const bool multi = (hi - lo) > 1;
    XcdBarrier bar; bar.bar = (unsigned*)(F.ctl + CW_BAR); bar.x = 0; bar.st = nullptr;
    if (multi) bar = xcd_barrier_post((unsigned*)(F.ctl + CW_BAR), F.MISC + 8);
#define IN(k) (lo <= (k) && (k) < hi)
#ifdef DUP_BARRIER
#define SEAM(k) do { if (IN(k) && IN((k) + 1)) { xcd_barrier(bar); xcd_barrier(bar); } } while (0)
#else
#define SEAM(k) do { if (IN(k) && IN((k) + 1)) xcd_barrier(bar); } while (0)
#endif

#ifdef DUP_P
    for (int rep = 0; rep < 2; ++rep)
#endif
    if (EN_P && IN(0)) { launder(F); phase_prologue(F); }
    SEAM(0);
#define HB ((GAS bf16*)(F.ws + WS_HB))
#define PA ((GAS bf16*)(F.ws + WS_PA))
#define Y ((GAS bf16*)(F.ws + WS_Y))
#define HM ((GAS bf16*)F.H + (size_t)NTOK * DM)
#define TT ((GAS bf16*)F.H)
    for (int l = 0; l < DEPTH; ++l) {
        const int pb = 1 + PPL * l;
#define wd (F.ws + WS_WDENSE + (size_t)l * WD_LAYER)
#ifdef DUP_A
        for (int rep = 0; rep < 2; ++rep)
#endif
        if (EN_A && IN(pb + 0)) { launder(F);
            DenseSched S; S.init(NTOK / 256, NPA / 256, F.G, F.wg, (const void*)HB, (size_t)256 * DM * 2, (const void*)(wd + WD_WA), (size_t)256 * DM * 2);
            EpiA E{PA, (GAS bf16*)(F.ws + WS_KA), (GAS bf16*)(F.ws + WS_VA), (GAS bf16*)(F.ws + WS_KI), (GAS float*)(F.ws + WS_WI), (GAS float*)(F.ws + WS_GLR), (const GAS float*)(F.ws + WS_ROPE), ((const GAS float*)F.in[5]) + l * 64};
#ifdef DUP_ANONE
            { EpiNoneA E0{PA}; pg8::gemm_phase<EpiNoneA, DenseSched, false>(F.lds, S, E0, DM, DM, F.wave); }
#endif
#ifdef DUP_APLAIN
            { EpiPlainA E0{PA}; pg8::gemm_phase<EpiPlainA, DenseSched, false>(F.lds, S, E0, DM, DM, F.wave); }
#endif
            gemm_stagger(F);
            pg8::gemm_phase<EpiA, DenseSched, false>(F.lds, S, E, DM, DM, F.wave);
        }
        SEAM(pb + 0);
        if (EN_B && IN(pb + 1)) { launder(F);
#ifdef DUP_B
            phase_mixer(F, l, 1, DUP_B, true); launder(F);
#endif
            phase_mixer(F, l); }
        SEAM(pb + 1);
        if (EN_B && IN(pb + 2)) { launder(F);
#ifdef DUP_SCAN
            gla_scan_phase(F, true); launder(F);
#endif
            gla_scan_phase(F); }
        SEAM(pb + 2);
        if (EN_B && IN(pb + 3)) { launder(F);
#ifdef DUP_OUT
            phase_gla_out(F, l, true); launder(F);
#endif
            phase_gla_out(F, l); }
        SEAM(pb + 3);
#ifdef DUP_D
        for (int rep = 0; rep < 2; ++rep)
#endif
        if (EN_D && IN(pb + 4)) { launder(F);
            DenseSched S; S.init(NTOK / 256, DM / 256, F.G, F.wg, (const void*)Y, (size_t)256 * 1536 * 2, (const void*)(wd + WD_WBR), (size_t)256 * 512 * 2);
            S.nsub = 3; S.asub = 512 * 2; S.bsub = (size_t)1024 * 512 * 2;
#ifdef DUP_DPAD
            { EpiPPad E0{PA}; pg8::gemm_phase<EpiPPad, DenseSched, false>(F.lds, S, E0, 512, 1536, F.wave); }
#endif
#ifdef DUP_DNONE
            { EpiNoneA E0{PA}; pg8::gemm_phase<EpiNoneA, DenseSched, false>(F.lds, S, E0, 512, 1536, F.wave); }
#endif
            gemm_stagger(F);
            EpiP E{PA};
            pg8::gemm_phase<EpiP, DenseSched, false>(F.lds, S, E, 512, 1536, F.wave);
        }
#ifdef DUP_C
        for (int rep = 0; rep < 2; ++rep)
#endif
        if (EN_C && IN(pb + 4)) { launder(F);
            DenseSched S; S.init(NTOK / 256, DM / 256, F.G, F.wg, (const void*)HB, (size_t)256 * DM * 2, (const void*)(wd + WD_WG), (size_t)256 * DM * 2);
            S.nsub = 3; S.asub = 0; S.bsub = (size_t)1024 * DM * 2;
#ifdef DUP_CNONE
            { EpiNoneA E0{PA}; pg8::gemm_phase<EpiNoneA, DenseSched, false>(F.lds, S, E0, DM, DM, F.wave); }
#endif
            EpiGM E{PA, HM};
            pg8::gemm_phase<EpiGM, DenseSched, false>(F.lds, S, E, DM, DM, F.wave);
        }
        SEAM(pb + 4);
#ifdef DUP_E
        for (int rep = 0; rep < 2; ++rep)
#endif
        if (EN_E && IN(pb + 6)) { launder(F);
            DenseSched S; S.init(NTOK / 256, DM / 256, F.G, F.wg, (const void*)HM, (size_t)256 * DM * 2, (const void*)(wd + WD_WOUT), (size_t)256 * DM * 2);
            EpiO E{HB, TT};
            gemm_stagger(F);
            pg8::gemm_phase<EpiO, DenseSched, false>(F.lds, S, E, DM, DM, F.wave);
        }
        SEAM(pb + 6);
#ifdef DUP_F
        for (int rep = 0; rep < 2; ++rep)
#endif
        if (EN_F && IN(pb + 7)) { launder(F); phase_ln_router(F, l); }
        SEAM(pb + 7);
#ifdef DUP_G
        for (int rep = 0; rep < 2; ++rep)
#endif
        if (EN_G && IN(pb + 8)) { launder(F);
            { LAS float* scr = (LAS float*)(F.lds + F.wave * 16384);
              conv_run<true>(F, l, 12288, scr);
              __syncthreads(); }
            phase_dispatch(F); }
        SEAM(pb + 8);
#ifdef DUP_H
        for (int rep = 0; rep < 2; ++rep)
#endif
        if (EN_H && IN(pb + 9)) { launder(F);
            const GAS int* META = (const GAS int*)(F.ws + WS_META); const GAS int* ROWMAP = (const GAS int*)(F.ws + WS_ROWMAP);
            LAS int* meta = (LAS int*)(F.lds + AUX_OFF); LAS int* rows = (LAS int*)(F.lds + AUX_OFF + 64);
            { int rv[3]; int mv = 0;
#pragma unroll
              for (int i = 0; i < 3; ++i) { const int gt0 = (i * F.G + F.wg) >> 1, gt = gt0 < MAXTILES ? gt0 : MAXTILES - 1; rv[i] = (F.tid < 256) ? ROWMAP[gt * 256 + F.tid] : 0; }
              if (F.tid < 3) { const int gt0 = (F.tid * F.G + F.wg) >> 1, gt = gt0 < MAXTILES ? gt0 : MAXTILES - 1; mv = ld_i32(META + 16 + gt); }
              if (F.tid < 3) meta[F.tid] = mv;
#pragma unroll
              for (int i = 0; i < 3; ++i) if (F.tid < 256) rows[i * 256 + F.tid] = rv[i]; }
            const int NT = ld_i32(META), NU = NT * 2;
            __syncthreads();
            GroupSched S{NU, F.G, F.wg, 2, (const char*)HB, (const char*)(F.ws + WS_WMOE + WM_GU), 0, (size_t)512 * DM * 2, (size_t)256 * DM * 2, meta, rows};
            EpiGU E{(GAS bf16*)(F.ws + WS_HID), (const GAS float*)(F.ws + WS_CWROW)};
            gemm_stagger(F);
            pg8::gemm_phase<EpiGU, GroupSched, true>(F.lds, S, E, DM, DM, F.wave);
        }
        SEAM(pb + 9);
#ifdef DUP_I
        for (int rep = 0; rep < 2; ++rep)
#endif
        if (EN_I && IN(pb + 10)) { launder(F);
            const GAS int* META = (const GAS int*)(F.ws + WS_META);
            LAS int* meta = (LAS int*)(F.lds + AUX_OFF);
            if (F.tid < 5) { const int gt0 = (F.tid * F.G + F.wg) >> 2, gt = gt0 < MAXTILES ? gt0 : MAXTILES - 1; meta[F.tid] = ld_i32(META + 16 + gt); }
            const int NT = ld_i32(META), NU = NT * 4;
            __syncthreads();
            GroupSched S{NU, F.G, F.wg, 4, (const char*)(F.ws + WS_HID), (const char*)(F.ws + WS_WMOE + WM_DN), (size_t)256 * DEXP * 2, (size_t)DM * DEXP * 2, (size_t)256 * DEXP * 2, meta, nullptr};
            EpiDN E{(GAS bf16*)(F.ws + WS_FF2)};
            gemm_stagger(F);
            pg8::gemm_phase<EpiDN, GroupSched, false>(F.lds, S, E, DEXP, DEXP, F.wave);
        }
        SEAM(pb + 10);
        if (EN_J && IN(pb + 11)) { launder(F);
#ifdef DUP_J
            phase_ln2(F, l, true); launder(F);
#endif
            phase_ln2(F, l); }
        SEAM(pb + 11);
    }
#undef IN
#undef SEAM
#undef HB
#undef HM
#undef TT
#undef PA
#undef Y
#undef wd
}


#ifdef DUMP_OFF
__global__ void dump_k(const unsigned short* src, float* out) {
    for (size_t i = (size_t)blockIdx.x * blockDim.x + threadIdx.x; i < (size_t)NTOK * 1024; i += (size_t)gridDim.x * blockDim.x) { const size_t n = i >> 10, c = i & 1023; out[i] = __builtin_bit_cast(float, ((unsigned)src[n * DUMP_PITCH + c]) << 16); }
}
#endif
extern "C" void kernel_launch(void* const* d_in, const int* in_sizes, int n_in, void* d_out, int out_size, void* d_ws, size_t ws_size, hipStream_t stream) {
    static int grid = 0;
    if (grid == 0) {
        if (n_in != 28 || out_size != NTOK * DM || ws_size < WS_END) { fprintf(stderr, "kernel_launch: unexpected shapes (n_in %d out %d ws %zu); nothing launched\n", n_in, out_size, ws_size); grid = -1; return; }
        int dev = 0, cus = 0;
        if (hipGetDevice(&dev) != hipSuccess || hipDeviceGetAttribute(&cus, hipDeviceAttributeMultiprocessorCount, dev) != hipSuccess) { grid = -1; return; }
        if (hipFuncSetAttribute((const void*)mk_fwd, hipFuncAttributeMaxDynamicSharedMemorySize, LDS_BYTES) != hipSuccess) { fprintf(stderr, "kernel_launch: hipFuncSetAttribute failed\n"); grid = -1; return; }
        int per_cu = 0;
        if (hipOccupancyMaxActiveBlocksPerMultiprocessor(&per_cu, (const void*)mk_fwd, 512, LDS_BYTES) != hipSuccess || per_cu < 1) { fprintf(stderr, "kernel_launch: occupancy query says %d\n", per_cu); }
        (void)hipGetLastError();
        grid = cus;
        if (grid != 256) fprintf(stderr, "kernel_launch: %d CUs (built for 256)\n", grid);
    }
    if (grid < 0) return;
    if (hipMemsetAsync((char*)d_ws + WS_CTL, 0, CTL_ZERO_BYTES, stream) != hipSuccess) return;
    Args a{};
    for (int i = 0; i < 28; ++i) a.in[i] = (const float*)d_in[i];
    a.out = (float*)d_out; a.ws = (unsigned char*)d_ws;
#if MK_ONE_LAUNCH
    a.ph_lo = 0; a.ph_hi = N_PHASES;
    hipLaunchKernelGGL(mk_fwd, dim3(grid), dim3(512), LDS_BYTES, stream, a);
#else
#ifndef STOP_AFTER
#define STOP_AFTER (N_PHASES - 1)
#endif
#ifndef PHASE_MASK
#define PHASE_MASK 0xffffffffu
#endif
    for (int p = 0; p <= STOP_AFTER; ++p) { if (!((PHASE_MASK >> p) & 1u)) continue; a.ph_lo = p; a.ph_hi = p + 1; hipLaunchKernelGGL(mk_fwd, dim3(grid), dim3(512), LDS_BYTES, stream, a); }
#ifdef DUMP_OFF
    hipLaunchKernelGGL(dump_k, dim3(2048), dim3(256), 0, stream, (const unsigned short*)((const char*)d_ws + (size_t)(DUMP_OFF)), (float*)d_out);
#endif
#endif
}
```

```cpp
#define MK_ONE_LAUNCH 1
#include <hip/hip_runtime.h>
#include <cstdio>
#include <cstdint>

#define LAS __attribute__((address_space(3)))
#define GAS __attribute__((address_space(1)))
typedef unsigned short bf16;
typedef short bf16x8 __attribute__((ext_vector_type(8)));
typedef float f32x4 __attribute__((ext_vector_type(4)));
typedef float f32x2 __attribute__((ext_vector_type(2)));
typedef unsigned u32x4 __attribute__((ext_vector_type(4)));
typedef unsigned u32x2 __attribute__((ext_vector_type(2)));
typedef GAS unsigned gu32;

constexpr int NB = 8, SEQ = 4096, NTOK = NB * SEQ, DM = 1024, NIN = 6612, DEPTH = 2;
constexpr int NPA = 3584;
constexpr int NGT = 3072;
constexpr int NEXP = 32, DEXP = 256;
constexpr int MAXTILES = 288;
constexpr float DN_ALPHA = 1.41421356237309515f;
constexpr float LN_EPS = 1e-5f, RMS_EPS = 1e-6f;
constexpr int PA_Q = 0, PA_QI = 768, PA_BQ = 1024, PA_BK = 1280, PA_BV = 1536, PA_BR = 2048, PA_CU = 2560, PA_CV = 3072;

__device__ __forceinline__ unsigned f2bf(float f) { unsigned u = __builtin_bit_cast(unsigned, f); return (u + 0x7fffu + ((u >> 16) & 1u)) >> 16; }
__device__ __forceinline__ unsigned pk2(float lo, float hi) { return f2bf(lo) | (f2bf(hi) << 16); }
__device__ __forceinline__ float bflo(unsigned w) { return __builtin_bit_cast(float, w << 16); }
__device__ __forceinline__ float bfhi(unsigned w) { return __builtin_bit_cast(float, w & 0xffff0000u); }
__device__ __forceinline__ float bf1(bf16 h) { return __builtin_bit_cast(float, ((unsigned)h) << 16); }
typedef __bf16 bf16x2_t __attribute__((ext_vector_type(2)));
__device__ __forceinline__ unsigned cvt_pk_bf16(float lo, float hi) { const f32x2 v = {lo, hi}; const bf16x2_t b = __builtin_convertvector(v, bf16x2_t); return __builtin_bit_cast(unsigned, b); }
__device__ __forceinline__ float shx(float v, int mask, int lane) { return __builtin_bit_cast(float, __builtin_amdgcn_ds_bpermute((lane ^ mask) << 2, __builtin_bit_cast(int, v))); }
__device__ __forceinline__ int shxi(int v, int mask, int lane) { return __builtin_amdgcn_ds_bpermute((lane ^ mask) << 2, v); }
__device__ __forceinline__ float wave_sum(float v, int lane) {
#pragma unroll
    for (int o = 1; o < 64; o <<= 1) v += shx(v, o, lane);
    return v;
}
__device__ __forceinline__ float wave_max(float v, int lane) {
#pragma unroll
    for (int o = 1; o < 64; o <<= 1) v = fmaxf(v, shx(v, o, lane));
    return v;
}
__device__ __forceinline__ int wave_sum_i(int v, int lane) {
#pragma unroll
    for (int o = 1; o < 64; o <<= 1) v += shxi(v, o, lane);
    return v;
}
__device__ __forceinline__ int fresh_lane() { unsigned z0 = 0u; asm volatile("" : "+v"(z0)); return (int)__builtin_amdgcn_mbcnt_hi(~0u, __builtin_amdgcn_mbcnt_lo(~0u, z0)); }
__device__ __forceinline__ int ld_i32(const GAS int* p) { return __hip_atomic_load(p, __ATOMIC_RELAXED, __HIP_MEMORY_SCOPE_AGENT); }
__device__ __forceinline__ float ld_f32(const GAS float* p) { return __hip_atomic_load(p, __ATOMIC_RELAXED, __HIP_MEMORY_SCOPE_AGENT); }
__device__ __forceinline__ float sigmoidf_(float x) { return __builtin_amdgcn_rcpf(1.0f + __expf(-x)); }
__device__ __forceinline__ float siluf_(float x) { return x * sigmoidf_(x); }
__device__ __forceinline__ float gelu_tanh_(float x) { const float u = 0.7978845608028654f * (x + 0.044715f * x * x * x); return x * sigmoidf_(2.0f * u); }

namespace pg8 {
constexpr int BM = 256, BK = 64, HALF = 128, HTB = HALF * BK * 2, STAGE_BYTES = 8 * HTB;
__host__ __device__ __forceinline__ int lds_byte(int r, int c) { const int st = (r >> 4) * 2 + (c >> 5), rr = r & 15, cc = c & 31, ob = rr * 64 + cc * 2; return st * 1024 + (ob ^ (((ob >> 9) & 1) << 5)); }
__host__ __device__ __forceinline__ void stage_rc(int b, int& R, int& C) { const int st = b / 1024, sb = b % 1024, swz = sb ^ (((sb >> 9) & 1) << 5); R = (st >> 1) * 16 + swz / 64; C = (st & 1) * 32 + (swz % 64) / 2; }
__host__ __device__ __forceinline__ int perm32(int rho) { const int n = rho >> 4, i = rho & 15; return 8 * (i >> 2) + 4 * n + (i & 3); }

struct Unit { int pm, pn, e, slot; };

#ifndef PG8_ALIGN
#define PG8_ALIGN true
#endif
template <class Epi, class Sched, bool GATHER, bool ALIGN_EPI = PG8_ALIGN>
__device__ __forceinline__ void gemm_phase(LAS unsigned char* lds, const Sched& S, const Epi& E, const int K, const int lda, const int wave) {
    unsigned z0_ = 0u; asm volatile("" : "+v"(z0_)); const int lane_ = (int)__builtin_amdgcn_mbcnt_hi(~0u, __builtin_amdgcn_mbcnt_lo(~0u, z0_));
    const int wid = wave, lane = lane_, tid = wid * 64 + lane, wr = wid >> 2, wc = wid & 3, fr = lane & 15, fq = lane >> 4;
    const int nt = K / BK;
    int Rr[2], Cc[2];
    unsigned voffB[2];
#pragma unroll
    for (int i = 0; i < 2; ++i) { int R, C; stage_rc(tid * 16 + i * 8192, R, C); Rr[i] = R; Cc[i] = C; const int Rb = Epi::PERM ? ((R & ~31) + perm32(R & 31)) : R; voffB[i] = (unsigned)(Rb * K + C) * 2u; }
    const size_t kstep = (size_t)(BK * 2);
    const size_t hstepB = (size_t)HALF * K * 2;
    const unsigned ldsw = (unsigned)wid * 1024u;
    const int aoff = lds_byte(wr * 64 + fr, fq * 8), boff = lds_byte(wc * 32 + fr, fq * 8);
#define PG8_SA(b, h) (((b) * 2 + (h)) * HTB)
#define PG8_SB(b, h) ((4 + (b) * 2 + (h)) * HTB)
#define PG8_STAGE(bufoff, gbase, voff) do { _Pragma("unroll") for (int _i = 0; _i < 2; ++_i) \
        __builtin_amdgcn_global_load_lds((const unsigned*)((const char*)(gbase) + (voff)[_i]), (LAS unsigned*)(lds + (bufoff) + ldsw + _i * 8192), 16, 0, 0); } while (0)
#define PG8_LDA(dst, b, h) do { _Pragma("unroll") for (int m = 0; m < 4; ++m) _Pragma("unroll") for (int k = 0; k < 2; ++k) dst[m][k] = *(const LAS bf16x8*)(lds + PG8_SA(b, h) + aoff + m * 2048 + k * 1024); } while (0)
#define PG8_LDB(dst, b, h) do { _Pragma("unroll") for (int n = 0; n < 2; ++n) _Pragma("unroll") for (int k = 0; k < 2; ++k) dst[n][k] = *(const LAS bf16x8*)(lds + PG8_SB(b, h) + boff + n * 2048 + k * 1024); } while (0)
#define PG8_MMA(ai, bj, At, Bt) do { __builtin_amdgcn_s_setprio(1); _Pragma("unroll") for (int m = 0; m < 4; ++m) _Pragma("unroll") for (int n = 0; n < 2; ++n) _Pragma("unroll") for (int k = 0; k < 2; ++k) \
        acc[ai][bj][m][n] = __builtin_amdgcn_mfma_f32_16x16x32_bf16(Bt[n][k], At[m][k], acc[ai][bj][m][n], 0, 0, 0); __builtin_amdgcn_s_setprio(0); } while (0)
#define PG8_WAIT_V(n) asm volatile("s_waitcnt vmcnt(" #n ")" ::: "memory")
#define PG8_WAIT_L(n) asm volatile("s_waitcnt lgkmcnt(" #n ")" ::: "memory")
#define PG8_BAR do { asm volatile("" ::: "memory"); __builtin_amdgcn_s_barrier(); asm volatile("" ::: "memory"); } while (0)
#define PG8_SCHED __builtin_amdgcn_sched_barrier(0)
    Unit cur, nxt; int ui = 0;
    if (!S.next(0, cur)) return;
    f32x4 acc[2][2][4][2];
#pragma unroll
    for (int a = 0; a < 2; ++a)
#pragma unroll
        for (int b = 0; b < 2; ++b)
#pragma unroll
            for (int m = 0; m < 4; ++m)
#pragma unroll
                for (int n = 0; n < 2; ++n) acc[a][b][m][n] = (f32x4){0.f, 0.f, 0.f, 0.f};
    bf16x8 At[4][2], B0[2][2], B1[2][2];
    unsigned cA0[2], cA1[2], nA0[2], nA1[2];
#pragma unroll
    for (int i = 0; i < 2; ++i) {
        if (GATHER) { cA0[i] = (unsigned)(S.row_of(cur, Rr[i]) * lda + Cc[i]) * 2u; cA1[i] = (unsigned)(S.row_of(cur, HALF + Rr[i]) * lda + Cc[i]) * 2u; }
        else { cA0[i] = (unsigned)(Rr[i] * lda + Cc[i]) * 2u; cA1[i] = (unsigned)((HALF + Rr[i]) * lda + Cc[i]) * 2u; }
        nA0[i] = cA0[i]; nA1[i] = cA1[i];
    }
    const char* cA = S.a_base(cur); const char* cB = S.b_base(cur);
    PG8_STAGE(PG8_SB(0, 0), cB, voffB); PG8_STAGE(PG8_SB(0, 1), cB + hstepB, voffB); PG8_STAGE(PG8_SA(0, 0), cA, cA0); PG8_STAGE(PG8_SA(0, 1), cA, cA1);
    if (wr == 1) PG8_BAR;
    PG8_WAIT_V(2); PG8_BAR;
    PG8_STAGE(PG8_SB(1, 0), cB + kstep, voffB); PG8_STAGE(PG8_SA(1, 0), cA + kstep, cA0); PG8_STAGE(PG8_SB(1, 1), cB + hstepB + kstep, voffB);
    PG8_WAIT_V(6); PG8_BAR;
    for (;;) {
        const bool has_next = S.next(ui + 1, nxt);
        const char* nA = has_next ? S.a_base(nxt) : cA; const char* nB = has_next ? S.b_base(nxt) : cB;
        if (GATHER) {
#pragma unroll
            for (int i = 0; i < 2; ++i) {
                if (has_next) { nA0[i] = (unsigned)(S.row_of(nxt, Rr[i]) * lda + Cc[i]) * 2u; nA1[i] = (unsigned)(S.row_of(nxt, HALF + Rr[i]) * lda + Cc[i]) * 2u; }
                else { nA0[i] = cA0[i]; nA1[i] = cA1[i]; }
            }
        }
#pragma unroll 1
        for (int t = 0; t < nt; t += 2) {
            const bool last = (t == nt - 2);
            const char* a1 = cA + (size_t)(t + 1) * kstep;
            const char* a2 = last ? nA : cA + (size_t)(t + 2) * kstep; const char* b2 = last ? nB : cB + (size_t)(t + 2) * kstep;
            const char* a3 = a2 + kstep; const char* b3 = b2 + kstep;
            unsigned x0[2], x1[2];
#pragma unroll
            for (int i = 0; i < 2; ++i) { x0[i] = (GATHER && last) ? nA0[i] : cA0[i]; x1[i] = (GATHER && last) ? nA1[i] : cA1[i]; }
            PG8_LDB(B0, 0, 0); PG8_LDB(B1, 0, 1); PG8_SCHED; PG8_LDA(At, 0, 0); PG8_STAGE(PG8_SA(1, 1), a1, cA1);
            PG8_WAIT_V(8); PG8_WAIT_L(0); PG8_BAR; PG8_MMA(0, 0, At, B0); PG8_MMA(0, 1, At, B1); PG8_BAR; PG8_SCHED;
            PG8_LDA(At, 0, 1); PG8_STAGE(PG8_SB(0, 0), b2, voffB); PG8_STAGE(PG8_SB(0, 1), b2 + hstepB, voffB); PG8_STAGE(PG8_SA(0, 0), a2, x0);
            PG8_WAIT_V(8); PG8_WAIT_L(0); PG8_BAR; PG8_MMA(1, 0, At, B0); PG8_MMA(1, 1, At, B1); PG8_BAR; PG8_SCHED;
            PG8_LDB(B0, 1, 0); PG8_LDB(B1, 1, 1); PG8_SCHED; PG8_LDA(At, 1, 0); PG8_STAGE(PG8_SA(0, 1), a2, x1);
            PG8_WAIT_V(8); PG8_WAIT_L(0); PG8_BAR; PG8_MMA(0, 0, At, B0); PG8_MMA(0, 1, At, B1); PG8_BAR; PG8_SCHED;
            PG8_LDA(At, 1, 1); PG8_STAGE(PG8_SB(1, 0), b3, voffB); PG8_STAGE(PG8_SB(1, 1), b3 + hstepB, voffB); PG8_STAGE(PG8_SA(1, 0), a3, x0);
            PG8_WAIT_V(8); PG8_WAIT_L(0); PG8_BAR; PG8_MMA(1, 0, At, B0); PG8_MMA(1, 1, At, B1); PG8_BAR; PG8_SCHED;
        }
        if (ALIGN_EPI) { if (wr == 0) PG8_BAR; }
        E(acc, cur, wr, wc, fr, fq);
        if (!has_next) break;
#pragma unroll
        for (int a = 0; a < 2; ++a)
#pragma unroll
            for (int b = 0; b < 2; ++b)
#pragma unroll
                for (int m = 0; m < 4; ++m)
#pragma unroll
                    for (int n = 0; n < 2; ++n) acc[a][b][m][n] = (f32x4){0.f, 0.f, 0.f, 0.f};
        cur = nxt; cA = nA; cB = nB; ++ui;
#pragma unroll
        for (int i = 0; i < 2; ++i) { cA0[i] = nA0[i]; cA1[i] = nA1[i]; }
        if (ALIGN_EPI) { if (wr == 1) PG8_BAR; }
    }
    PG8_WAIT_V(0);
    if (!ALIGN_EPI) { if (wr == 0) PG8_BAR; }
    PG8_BAR;
#undef PG8_SA
#undef PG8_SB
#undef PG8_STAGE
#undef PG8_LDA
#undef PG8_LDB
#undef PG8_MMA
#undef PG8_WAIT_V
#undef PG8_WAIT_L
#undef PG8_BAR
#undef PG8_SCHED
}
}

#define XB_TMO      128
#define XB_XCNT(j)  (256  + 64 * (j))
#define XB_XSUB(j)  (1280 + 64 * (j))
#define XB_XGEN(j)  (2304 + 64 * (j))
#define XB_TOP      3328
#define XB_TOPGEN   3392
#define XCD_BAR_WORDS 3456
#define XB_SPIN_CAP (1u << 20)

__device__ __forceinline__ unsigned xb_ld(unsigned* p)              { return __hip_atomic_load(p, __ATOMIC_RELAXED, __HIP_MEMORY_SCOPE_AGENT); }
__device__ __forceinline__ unsigned xb_add(unsigned* p, unsigned v) { return __hip_atomic_fetch_add(p, v, __ATOMIC_RELAXED, __HIP_MEMORY_SCOPE_AGENT); }
__device__ __forceinline__ unsigned xb_xcc_id() { return (unsigned)__builtin_amdgcn_s_getreg((3 << 11) | 20) & 0xFu; }
#define XB_SPIN(cond, bar) do { unsigned _sp = 0; while (cond) { __builtin_amdgcn_s_sleep(1); \
    if ((++_sp & 255u) == 0u) { if (xb_ld(&(bar)[XB_TMO])) break; if (_sp > XB_SPIN_CAP) { atomicAdd(&(bar)[XB_TMO], 1u); break; } } } } while (0)

struct XcdBarrier { unsigned* bar; unsigned x; volatile LAS unsigned* st; };

__device__ __forceinline__ XcdBarrier xcd_barrier_post(unsigned* bar, volatile LAS unsigned* st) {
    XcdBarrier b; b.bar = bar; b.x = xb_xcc_id(); b.st = st;
    if (threadIdx.x == 0) (void)xb_add(&bar[XB_XCNT(b.x)], 1u);
    return b;
}
__device__ __forceinline__ void xcd_barrier_complete(unsigned* bar, unsigned x, unsigned& nloc, unsigned& nx) {
    const unsigned G = gridDim.x * gridDim.y * gridDim.z;
    unsigned sum, cnt, mine, sp = 0u;
    for (;;) {
        sum = 0u; cnt = 0u; mine = 0u;
#pragma unroll
        for (unsigned j = 0; j < 16; ++j) { const unsigned c = xb_ld(&bar[XB_XCNT(j)]); sum += c; cnt += (c > 0u) ? 1u : 0u; mine = (j == x) ? c : mine; }
        if (sum == G) break;
        __builtin_amdgcn_s_sleep(1);
        if ((++sp & 255u) == 0u) { if (xb_ld(&bar[XB_TMO])) break; if (sp > XB_SPIN_CAP) { atomicAdd(&bar[XB_TMO], 1u); break; } }
    }
    nloc = mine > 0u ? mine : 1u; nx = cnt > 0u ? cnt : 1u;
}
__device__ __forceinline__ void xcd_barrier(const XcdBarrier& b) {
    asm volatile("s_waitcnt vmcnt(0)" ::: "memory");
    __syncthreads();
    if (threadIdx.x == 0) {
        unsigned* bar = b.bar;
        __builtin_amdgcn_s_waitcnt(0);
        unsigned nloc = b.st[0], nx = b.st[1];
        if (nloc == 0u) { xcd_barrier_complete(bar, b.x, nloc, nx); b.st[0] = nloc; b.st[1] = nx; }
        const unsigned old = xb_add(&bar[XB_XSUB(b.x)], 1u);
        const unsigned gen = old / nloc;
        if (old + 1u == (gen + 1u) * nloc) {
            __builtin_amdgcn_fence(__ATOMIC_RELEASE, "agent");
            asm volatile("s_waitcnt vmcnt(0)" ::: "memory");
            const unsigned og = xb_add(&bar[XB_TOP], 1u);
            const unsigned tg = og / nx;
            if (og + 1u == (tg + 1u) * nx) xb_add(&bar[XB_TOPGEN], 1u);
            else XB_SPIN(xb_ld(&bar[XB_TOPGEN]) == tg, bar);
            __builtin_amdgcn_fence(__ATOMIC_ACQUIRE, "agent");
            xb_add(&bar[XB_XGEN(b.x)], 1u);
            asm volatile("s_waitcnt vmcnt(0)" ::: "memory");
        } else {
            XB_SPIN(xb_ld(&bar[XB_XGEN(b.x)]) == gen, bar);
            __builtin_amdgcn_fence(__ATOMIC_ACQUIRE, "agent");
            asm volatile("s_waitcnt vmcnt(0)" ::: "memory");
        }
    }
    __syncthreads();
}

constexpr size_t MiB = 1u << 20;
constexpr size_t WS_CTL = 0, CTL_ZERO_BYTES = 1 * MiB;
constexpr size_t WS_ROPE = 1 * MiB;
constexpr size_t WS_WI   = 3 * MiB;
constexpr size_t WS_ROUTE = 3 * MiB + 512 * 1024;
constexpr size_t WS_SROW = 4 * MiB;
constexpr size_t WS_ROWMAP = 4 * MiB + 256 * 1024;
constexpr size_t WS_CWROW = 4 * MiB + 640 * 1024;
constexpr size_t WS_CNTWG = 5 * MiB;
constexpr size_t WS_META = 5 * MiB + 64 * 1024;
constexpr size_t WS_WR = 5 * MiB + 128 * 1024;
constexpr size_t WS_GLR = 6 * MiB;
constexpr size_t WS_WDENSE = 8 * MiB;
constexpr size_t WD_WA = 0, WD_WG = 7 * MiB, WD_WBR = 13 * MiB, WD_WOUT = 16 * MiB, WD_LAYER = 18 * MiB;
constexpr size_t WS_WMOE = 44 * MiB;
constexpr size_t WM_GU = 0, WM_DN = 32 * MiB;
constexpr size_t WS_HB = 92 * MiB;
constexpr size_t WS_PA = 156 * MiB;
constexpr size_t WS_HID = WS_PA;
constexpr size_t WS_FF2 = WS_PA + 40 * MiB;
constexpr size_t WS_Y = 380 * MiB;
constexpr size_t WS_KA = 476 * MiB, WS_VA = 480 * MiB, WS_KI = 484 * MiB;
constexpr size_t WS_END = 512 * MiB;
static_assert(WS_WDENSE + 2 * WD_LAYER <= WS_WMOE && WS_WMOE + 48 * MiB <= WS_HB && WS_HB + 64 * MiB <= WS_PA && WS_PA + 224 * MiB <= WS_Y && WS_Y + 96 * MiB <= WS_KA && WS_KI + 4 * MiB <= WS_END, "ws map");
static_assert(WS_FF2 + (size_t)73728 * 1024 * 2 <= WS_Y, "ff2 fits");
constexpr int CW_BAR = 4096;
constexpr int CW_QUEUE = 16384;

constexpr int RING_BYTES = 131072;
constexpr int AUX_OFF = 131072;
constexpr int MISC_OFF = 155648;
constexpr int LDS_BYTES = 156672;

struct Frame {
    LAS unsigned char* lds;
    volatile LAS unsigned* MISC;
    gu32* ctl;
    int tid, lane, wave, G, wg;
    const float* const* in;
    const GAS int* pos;
    GAS float* H;
    GAS unsigned char* ws;
};

#define LDS_WAIT() asm volatile("s_waitcnt lgkmcnt(0)" ::: "memory")
#define VM_WAIT() asm volatile("s_waitcnt vmcnt(0)" ::: "memory")

__device__ __forceinline__ int pa_src_col(int c) {
    if (c < 512) return c;
    if (c < 768) { const int x = c - 512, half = x >> 7, y = x & 127, grp = y >> 5, d = (y & 31) + 32 * half;
        if (grp == 0) return 512 + d;
        if (grp == 1) return 576 + d;
        if (grp == 2) return 896 + d;
        if (half == 0) { const int z = y - 96; if (z < 4) return 960 + z; if (z < 20) return 1988 + (z - 4); }
        return -1; }
    if (c < 1024) return 640 + (c - 768);
    if (c < 1280) return 964 + (c - 1024);
    if (c < 1536) return 1220 + (c - 1280);
    if (c < 2048) return 1476 + (c - 1536);
    if (c < 2560) return 2004 + (c - 2048);
    return 2516 + (c - 2560);
}
struct TItem { const GAS float* W; GAS bf16* WT; int ldw, K, n0, k0, sc0, mode; };
__device__ __forceinline__ void ti_load(const TItem& t, f32x4 (&v)[8], int lane) {
    if (t.mode == 0) { const int kr = lane >> 3, c4 = (lane & 7) * 4;
#pragma unroll
        for (int i = 0; i < 8; ++i) v[i] = *(const GAS f32x4*)(t.W + (size_t)(t.k0 + 8 * i + kr) * t.ldw + t.sc0 + c4); }
}
__device__ __forceinline__ void ti_finish(const TItem& t, const f32x4 (&v)[8], LAS float* scr, int lane) {
    if (t.mode == 0) { const int kr = lane >> 3, c4 = (lane & 7) * 4;
#pragma unroll
        for (int i = 0; i < 8; ++i) { LAS float* d = scr + (8 * i + kr) * 33 + c4; d[0] = v[i].x; d[1] = v[i].y; d[2] = v[i].z; d[3] = v[i].w; }
    } else { const int sc = pa_src_col(t.n0 + (lane & 31));
#pragma unroll 8
        for (int i = 0; i < 32; ++i) { const int kk = 2 * i + (lane >> 5); scr[kk * 33 + (lane & 31)] = (sc >= 0) ? t.W[(size_t)(t.k0 + kk) * t.ldw + sc] : 0.f; }
    }
    LDS_WAIT(); asm volatile("" ::: "memory");
    const int c = lane & 7;
#pragma unroll
    for (int j = 0; j < 4; ++j) { const int n = (lane >> 3) + 8 * j; const LAS float* s = scr + (8 * c) * 33 + n;
        u32x4 o; o.x = pk2(s[0 * 33], s[1 * 33]); o.y = pk2(s[2 * 33], s[3 * 33]); o.z = pk2(s[4 * 33], s[5 * 33]); o.w = pk2(s[6 * 33], s[7 * 33]);
        *(GAS u32x4*)(t.WT + (size_t)(t.n0 + n) * t.K + t.k0 + 8 * c) = o; }
    LDS_WAIT(); asm volatile("" ::: "memory");
}
__device__ __forceinline__ void dense_item(Frame& F, int l, int it, TItem& t) {
    GAS bf16* base = (GAS bf16*)(F.ws + WS_WDENSE + (size_t)l * WD_LAYER);
    const GAS float* win = ((const GAS float*)F.in[4]) + (size_t)l * DM * NIN;
    if (it < 1792) { const int kb = it / 112, nb = it % 112; const int s0 = pa_src_col(32 * nb), s31 = pa_src_col(32 * nb + 31);
        t = TItem{win, base + WD_WA / 2, NIN, DM, 32 * nb, 64 * kb, s0, (s0 >= 0 && s31 == s0 + 31) ? 0 : 1}; return; }
    it -= 1792;
    if (it < 1536) { const int kb = it / 96, nb = it % 96; t = TItem{win, base + WD_WG / 2, NIN, DM, 32 * nb, 64 * kb, 3540 + 32 * nb, 0}; return; }
    it -= 1536;
    if (it < 768) { const int br = it / 256, r = it % 256, kb = r / 32, nb = r % 32;
        t = TItem{(br == 0 ? ((const GAS float*)F.in[13]) : br == 1 ? ((const GAS float*)F.in[14]) : ((const GAS float*)F.in[15])) + (size_t)l * 512 * DM, base + WD_WBR / 2 + (size_t)br * 1024 * 512, DM, 512, 32 * nb, 64 * kb, 32 * nb, 0}; return; }
    it -= 768;
    { const int kb = it / 32, nb = it % 32; t = TItem{((const GAS float*)F.in[16]) + (size_t)l * DM * DM, base + WD_WOUT / 2, DM, DM, 32 * nb, 64 * kb, 32 * nb, 0}; }
}
__device__ __forceinline__ void moe_item(Frame& F, int l, int it, TItem& t) {
    const int e = it / 384; int r = it % 384;
    if (r < 256) { const int sub = r / 64, q = r % 64, ct = sub >> 1, bj = sub & 1, kb = q / 4, nb = q % 4;
        const GAS float* src = (bj ? ((const GAS float*)F.in[24]) : ((const GAS float*)F.in[23])) + (size_t)(l * NEXP + e) * DM * DEXP;
        t = TItem{src, (GAS bf16*)(F.ws + WS_WMOE + WM_GU) + (size_t)e * 512 * DM, DEXP, DM, 256 * ct + 128 * bj + 32 * nb, 64 * kb, 128 * ct + 32 * nb, 0}; return; }
    r -= 256;
    { const int kb = r / 32, nb = r % 32;
        t = TItem{((const GAS float*)F.in[25]) + (size_t)(l * NEXP + e) * DEXP * DM, (GAS bf16*)(F.ws + WS_WMOE + WM_DN) + (size_t)e * DM * DEXP, DM, DEXP, 32 * nb, 64 * kb, 32 * nb, 0}; }
}
template <bool MOE> __device__ __forceinline__ void conv_run(Frame& F, int l, int total, LAS float* scr) {
    const int gw = F.wg * 8 + F.wave, NGW = F.G * 8, lane = F.lane;
    TItem cur, nxt; f32x4 vc[8], vn[8];
    int it = gw; if (it >= total) return;
    if (MOE) moe_item(F, l, it, cur); else dense_item(F, it / 4608, it % 4608, cur);
    ti_load(cur, vc, lane);
#pragma unroll 1
    for (; it < total; it += NGW) { const int itn = it + NGW; const bool hn = itn < total;
        if (hn) { if (MOE) moe_item(F, l, itn, nxt); else dense_item(F, itn / 4608, itn % 4608, nxt); ti_load(nxt, vn, lane); }
        ti_finish(cur, vc, scr, lane);
        cur = nxt;
#pragma unroll
        for (int i = 0; i < 8; ++i) vc[i] = vn[i]; }
}

__device__ __forceinline__ void ln_row_regs(f32x4 (&v)[4], const GAS float* g, const GAS float* b, int lane) {
    float s = 0.f;
#pragma unroll
    for (int j = 0; j < 4; ++j) s += (v[j].x + v[j].y) + (v[j].z + v[j].w);
    const float mean = wave_sum(s, lane) * (1.f / DM); float s2 = 0.f;
#pragma unroll
    for (int j = 0; j < 4; ++j) { v[j] = v[j] - mean; s2 += (v[j].x * v[j].x + v[j].y * v[j].y) + (v[j].z * v[j].z + v[j].w * v[j].w); }
    const float rstd = 1.f / sqrtf(wave_sum(s2, lane) * (1.f / DM) + LN_EPS);
#pragma unroll
    for (int j = 0; j < 4; ++j) { const f32x4 gg = *(const GAS f32x4*)(g + 4 * lane + 256 * j), bb = *(const GAS f32x4*)(b + 4 * lane + 256 * j); v[j] = v[j] * rstd * gg + bb; }
}
__device__ __forceinline__ void store_row_f32_bf16(const f32x4 (&v)[4], GAS float* hrow, GAS bf16* brow, int lane) {
#pragma unroll
    for (int j = 0; j < 4; ++j) {
        if (hrow) *(GAS f32x4*)(hrow + 4 * lane + 256 * j) = v[j];
        if (brow) { u32x2 w; w.x = pk2(v[j].x, v[j].y); w.y = pk2(v[j].z, v[j].w); *(GAS u32x2*)(brow + 4 * lane + 256 * j) = w; }
    }
}

__device__ __forceinline__ void phase_prologue(Frame& F) {
    LAS float* scr = (LAS float*)(F.lds + F.wave * 16384);
    const int gw = F.wg * 8 + F.wave, NGW = F.G * 8;
    conv_run<false>(F, 0, 2 * 4608, scr);
    { GAS bf16* WRB = (GAS bf16*)(F.ws + WS_WR);
      for (int i = gw * 64 + F.lane; i < DEPTH * 48 * DM; i += NGW * 64) { const int l = i / (48 * DM), r = i % (48 * DM), o = r / DM, k = r % DM;
          const float v = (o < 4) ? ((const GAS float*)F.in[19])[(size_t)l * DM * 4 + k * 4 + o] : (o < 36) ? ((const GAS float*)F.in[21])[(size_t)l * DM * 32 + k * 32 + (o - 4)] : 0.f;
          WRB[i] = (bf16)f2bf(v); } }
    { GAS float* RT = (GAS float*)(F.ws + WS_ROPE);
      for (int i = gw * 64 + F.lane; i < NTOK * 8; i += NGW * 64) { const int n = i >> 3, j = i & 7;
          const float invf[8] = {1.000000000e+00f, 1.939227432e-01f, 3.760603070e-02f, 7.292664610e-03f, 1.414213562e-03f, 2.742481884e-04f, 5.318295734e-05f, 1.031338525e-05f};
          float inv = invf[0];
#pragma unroll
          for (int q = 1; q < 8; ++q) inv = (j == q) ? invf[q] : inv;
          const float ang = (float)F.pos[n] * inv;
          const double kq = __builtin_rint((double)ang * 0.15915494309189535);
          double r = (double)ang - kq * 6.283185307179586; double csign = 1.0;
          if (r > 1.5707963267948966) { r = 3.141592653589793 - r; csign = -1.0; } else if (r < -1.5707963267948966) { r = -3.141592653589793 - r; csign = -1.0; }
          const double x2 = r * r;
          const double sn = r * (1.0 + x2 * (-1.0 / 6 + x2 * (1.0 / 120 + x2 * (-1.0 / 5040 + x2 * (1.0 / 362880 + x2 * (-1.0 / 39916800 + x2 * (1.0 / 6227020800.0 + x2 * (-1.0 / 1307674368000.0))))))));
          const double cs = 1.0 + x2 * (-0.5 + x2 * (1.0 / 24 + x2 * (-1.0 / 720 + x2 * (1.0 / 40320 + x2 * (-1.0 / 3628800 + x2 * (1.0 / 479001600.0 + x2 * (-1.0 / 87178291200.0 + x2 * (1.0 / 20922789888000.0))))))));
          RT[n * 16 + j] = (float)(csign * cs); RT[n * 16 + 8 + j] = (float)sn; } }
    GAS bf16* HB = (GAS bf16*)(F.ws + WS_HB);
    for (int m = gw; m < NTOK; m += NGW) { f32x4 v[4];
#pragma unroll
        for (int j = 0; j < 4; ++j) v[j] = *(const GAS f32x4*)(((const GAS float*)F.in[0]) + (size_t)m * DM + 4 * F.lane + 256 * j);
        ln_row_regs(v, ((const GAS float*)F.in[2]), ((const GAS float*)F.in[3]), F.lane);
        store_row_f32_bf16(v, (GAS float*)nullptr, HB + (size_t)m * DM, F.lane); }
}

struct DenseSched {
    int nM, nN, nwg, G, c; const char* A; const char* B; size_t atile, btile; int nsub = 1; size_t asub = 0, bsub = 0;
    __device__ void init(int nM_, int nN_, int G_, int c_, const void* A_, size_t atile_, const void* B_, size_t btile_) { nM = nM_; nN = nN_; nwg = nM * nN; G = G_; c = c_; A = (const char*)A_; B = (const char*)B_; atile = atile_; btile = btile_; }
    __device__ __forceinline__ bool next(int i, pg8::Unit& u) const {
        const int it = i / nsub, sb = i - it * nsub;
        const long L = (long)it * G + c; if (L >= nwg) return false;
        int wgid = (int)L; { const int q = nwg / 8, r = nwg % 8, xcd = wgid % 8, off = wgid / 8; wgid = (xcd < r ? xcd * (q + 1) : r * (q + 1) + (xcd - r) * q) + off; }
        const int nig = 8 * nN, gid = wgid / nig, fm = gid * 8, gsz = (nM - fm) < 8 ? (nM - fm) : 8;
        u.pm = fm + ((wgid % nig) % gsz); u.pn = (wgid % nig) / gsz; u.e = sb; u.slot = i; return true;
    }
    __device__ __forceinline__ const char* a_base(const pg8::Unit& u) const { return A + (size_t)u.pm * atile + (size_t)u.e * asub; }
    __device__ __forceinline__ const char* b_base(const pg8::Unit& u) const { return B + (size_t)u.pn * btile + (size_t)u.e * bsub; }
    __device__ __forceinline__ int row_of(const pg8::Unit&, int) const { return 0; }
};
struct GroupSched {
    int NU, G, c, ncol; const char* A; const char* B; size_t atile, erows_bytes, btile; const LAS int* meta; const LAS int* rows;
    __device__ __forceinline__ bool next(int i, pg8::Unit& u) const {
        const int L = i * G + c; if (L >= NU) return false;
        u.pm = L / ncol; u.pn = L % ncol; u.slot = i; u.e = meta[i]; return true;
    }
    __device__ __forceinline__ const char* a_base(const pg8::Unit& u) const { return A + (size_t)u.pm * atile; }
    __device__ __forceinline__ const char* b_base(const pg8::Unit& u) const { return B + (size_t)u.e * erows_bytes + (size_t)u.pn * btile; }
    __device__ __forceinline__ int row_of(const pg8::Unit& u, int r) const { return rows[u.slot * 256 + r]; }
};

#ifndef NT_MASK
#define NT_MASK 0
#endif
template <int BIT> __device__ __forceinline__ void st16(GAS u32x4* p, const u32x4 v) { if (NT_MASK & (1 << BIT)) __builtin_nontemporal_store(v, p); else *p = v; }
struct EpiA {
    static constexpr bool PERM = true; static constexpr int NST = 16;
    GAS bf16* PA; GAS bf16* KA; GAS bf16* VA; GAS bf16* KI; GAS float* WI; GAS float* GLR; const GAS float* ROPE; const GAS float* ikg;
    __device__ __forceinline__ static void rope8(float (&x)[8], const GAS float* rt, int fq, int lane) {
        const f32x4 c0 = *(const GAS f32x4*)(rt), c1 = *(const GAS f32x4*)(rt + 4), s0 = *(const GAS f32x4*)(rt + 8), s1 = *(const GAS f32x4*)(rt + 12);
#pragma unroll
        for (int i = 0; i < 8; ++i) { const float p = shx(x[i], 16, lane); const float cc = (i < 4) ? c0[i & 3] : c1[i & 3], ss = (i < 4) ? s0[i & 3] : s1[i & 3];
            const float r = x[i] * cc + ((fq == 0) ? -p : p) * ss; x[i] = (fq < 2) ? r : x[i]; }
    }
    __device__ __forceinline__ static u32x4 pack8(const float (&x)[8]) { u32x4 w; w.x = cvt_pk_bf16(x[0], x[1]); w.y = cvt_pk_bf16(x[2], x[3]); w.z = cvt_pk_bf16(x[4], x[5]); w.w = cvt_pk_bf16(x[6], x[7]); return w; }
    __device__ __forceinline__ void operator()(const f32x4 (&acc)[2][2][4][2], const pg8::Unit& u, int wr, int wc, int fr, int fq) const {
        const int pn = u.pn; const int rowb = u.pm * 256 + wr * 64 + fr; const int lane = fq * 16 + fr;
        if (pn == 2) {
#pragma unroll
            for (int ai = 0; ai < 2; ++ai)
#pragma unroll
                for (int m = 0; m < 4; ++m) {
                    const int row = rowb + ai * 128 + m * 16;
                    float x0[8], x1[8];
#pragma unroll
                    for (int i = 0; i < 8; ++i) { x0[i] = acc[ai][0][m][i >> 2][i & 3]; x1[i] = acc[ai][1][m][i >> 2][i & 3]; }
                    if (wc == 2) {
                        float s = 0.f;
#pragma unroll
                        for (int i = 0; i < 8; ++i) s += x0[i] + x1[i];
                        s += shx(s, 16, lane); s += shx(s, 32, lane);
                        const float mean = s * (1.f / 64.f); float q = 0.f;
#pragma unroll
                        for (int i = 0; i < 8; ++i) { x0[i] -= mean; x1[i] -= mean; q += x0[i] * x0[i] + x1[i] * x1[i]; }
                        q += shx(q, 16, lane); q += shx(q, 32, lane);
                        const float rstd = 1.f / sqrtf(q * (1.f / 64.f) + LN_EPS);
#pragma unroll
                        for (int i = 0; i < 8; ++i) { x0[i] = x0[i] * rstd * ikg[8 * fq + i]; x1[i] = x1[i] * rstd * ikg[32 + 8 * fq + i]; }
                    }
                    if (wc == 0 || wc == 2) rope8(x0, ROPE + (size_t)row * 16, fq, lane);
                    if (wc < 3) {
                        GAS bf16* dst = (wc == 0) ? KA : (wc == 1) ? VA : KI;
                        *(GAS u32x4*)(dst + (size_t)row * 64 + 8 * fq) = pack8(x0); *(GAS u32x4*)(dst + (size_t)row * 64 + 32 + 8 * fq) = pack8(x1);
                    } else {
                        if (fq == 0) { *(GAS f32x4*)(WI + (size_t)row * 4) = (f32x4){x0[0], x0[1], x0[2], x0[3]} * 0.0625f; *(GAS f32x4*)(GLR + (size_t)row * 16) = (f32x4){x0[4], x0[5], x0[6], x0[7]}; }
                        else if (fq == 1) { *(GAS f32x4*)(GLR + (size_t)row * 16 + 4) = (f32x4){x0[0], x0[1], x0[2], x0[3]}; *(GAS f32x4*)(GLR + (size_t)row * 16 + 8) = (f32x4){x0[4], x0[5], x0[6], x0[7]}; }
                        else if (fq == 2) { *(GAS f32x4*)(GLR + (size_t)row * 16 + 12) = (f32x4){x0[0], x0[1], x0[2], x0[3]}; }
                    }
                    asm volatile("" ::: "memory");
                }
        } else if (pn < 2 || pn == 3) {
            const float sc = (pn == 3) ? 1.0f : 0.125f; const bool rope = !(wc & 1);
#pragma unroll
            for (int ai = 0; ai < 2; ++ai)
#pragma unroll
                for (int m = 0; m < 4; ++m) {
                    const int row = rowb + ai * 128 + m * 16;
#pragma unroll
                    for (int bj = 0; bj < 2; ++bj) { float x[8];
#pragma unroll
                        for (int i = 0; i < 8; ++i) x[i] = acc[ai][bj][m][i >> 2][i & 3];
                        if (rope) rope8(x, ROPE + (size_t)row * 16, fq, lane);
#pragma unroll
                        for (int i = 0; i < 8; ++i) x[i] *= sc;
                        st16<0>((GAS u32x4*)(PA + (size_t)row * NPA + 256 * pn + 128 * bj + 32 * wc + 8 * fq), pack8(x)); }
                    asm volatile("" ::: "memory");
                }
        } else {
            const int act = (pn == 8 || pn == 9) ? 1 : (pn >= 10) ? 2 : 0; const float sc = (pn == 4) ? 0.125f : 1.0f;
#pragma unroll
            for (int ai = 0; ai < 2; ++ai)
#pragma unroll
                for (int m = 0; m < 4; ++m) {
                    const int row = rowb + ai * 128 + m * 16;
#pragma unroll
                    for (int bj = 0; bj < 2; ++bj) { float x[8];
#pragma unroll
                        for (int i = 0; i < 8; ++i) { const float v = acc[ai][bj][m][i >> 2][i & 3]; x[i] = (act == 1) ? siluf_(v) : (act == 2) ? gelu_tanh_(v) : v * sc; }
                        st16<0>((GAS u32x4*)(PA + (size_t)row * NPA + 256 * pn + 128 * bj + 32 * wc + 8 * fq), pack8(x)); }
                    asm volatile("" ::: "memory");
                }
        }
    }
};
struct EpiPlainA {
    static constexpr bool PERM = true; static constexpr int NST = 16;
    GAS bf16* PA;
    __device__ __forceinline__ void operator()(const f32x4 (&acc)[2][2][4][2], const pg8::Unit& u, int wr, int wc, int fr, int fq) const {
        const int rowb = u.pm * 256 + wr * 64 + fr;
#pragma unroll
        for (int ai = 0; ai < 2; ++ai)
#pragma unroll
            for (int m = 0; m < 4; ++m) { const int row = rowb + ai * 128 + m * 16;
#pragma unroll
                for (int bj = 0; bj < 2; ++bj) { u32x4 w; w.x = cvt_pk_bf16(acc[ai][bj][m][0][0], acc[ai][bj][m][0][1]); w.y = cvt_pk_bf16(acc[ai][bj][m][0][2], acc[ai][bj][m][0][3]);
                    w.z = cvt_pk_bf16(acc[ai][bj][m][1][0], acc[ai][bj][m][1][1]); w.w = cvt_pk_bf16(acc[ai][bj][m][1][2], acc[ai][bj][m][1][3]);
                    *(GAS u32x4*)(PA + (size_t)row * NPA + 256 * u.pn + 128 * bj + 32 * wc + 8 * fq) = w; } }
    }
};
struct EpiNoneA {
    static constexpr bool PERM = true; static constexpr int NST = 0;
    GAS bf16* PA;
    __device__ __forceinline__ void operator()(const f32x4 (&acc)[2][2][4][2], const pg8::Unit& u, int wr, int wc, int fr, int fq) const {
        float s = 0.f;
#pragma unroll
        for (int ai = 0; ai < 2; ++ai)
#pragma unroll
            for (int m = 0; m < 4; ++m)
#pragma unroll
                for (int bj = 0; bj < 2; ++bj)
#pragma unroll
                    for (int n = 0; n < 2; ++n) s += (acc[ai][bj][m][n][0] + acc[ai][bj][m][n][1]) + (acc[ai][bj][m][n][2] + acc[ai][bj][m][n][3]);
        if (s == 1.2345e30f) PA[u.pm + wr + wc + fr + fq] = (bf16)1;
    }
};
#ifdef PPITCH
#ifndef EPIP_MODE
#define EPIP_MODE 0
#endif
struct EpiPPad {
    static constexpr bool PERM = true; static constexpr int NST = 16;
    GAS bf16* P;
    __device__ __forceinline__ void operator()(const f32x4 (&acc)[2][2][4][2], const pg8::Unit& u, int wr, int wc, int fr, int fq) const {
        const int rowb = u.pm * 256 + wr * 64 + fr; GAS bf16* Pb = P + (size_t)u.e * NTOK * PPITCH;
#pragma unroll
        for (int ai = 0; ai < 2; ++ai)
#pragma unroll
            for (int m = 0; m < 4; ++m) {
#if EPIP_MODE == 2
                const int row = (rowb + ai * 128 + m * 16) & 31;
#else
                const int row = rowb + ai * 128 + m * 16;
#endif
#pragma unroll
                for (int bj = 0; bj < 2; ++bj) { u32x4 w; w.x = cvt_pk_bf16(acc[ai][bj][m][0][0], acc[ai][bj][m][0][1]); w.y = cvt_pk_bf16(acc[ai][bj][m][0][2], acc[ai][bj][m][0][3]);
                    w.z = cvt_pk_bf16(acc[ai][bj][m][1][0], acc[ai][bj][m][1][1]); w.w = cvt_pk_bf16(acc[ai][bj][m][1][2], acc[ai][bj][m][1][3]);
#if EPIP_MODE == 3
                    __builtin_nontemporal_store(w, (GAS u32x4*)(Pb + (size_t)row * PPITCH + 256 * u.pn + 128 * bj + 32 * wc + 8 * fq));
#elif EPIP_MODE == 4
                    { GAS u32x4* ap_ = (GAS u32x4*)(Pb + (size_t)row * PPITCH + 256 * u.pn + 128 * bj + 32 * wc + 8 * fq); asm volatile("global_store_dwordx4 %0, %1, off sc0 sc1" :: "v"(ap_), "v"(w) : "memory"); }
#elif EPIP_MODE == 5
                    { GAS u32x4* ap_ = (GAS u32x4*)(Pb + (size_t)row * PPITCH + 256 * u.pn + 128 * bj + 32 * wc + 8 * fq); asm volatile("global_store_dwordx4 %0, %1, off sc1" :: "v"(ap_), "v"(w) : "memory"); }
#elif EPIP_MODE == 1
                    if (ai == 0) *(GAS u32x4*)(Pb + (size_t)row * PPITCH + 256 * u.pn + 128 * bj + 32 * wc + 8 * fq) = w; else if (w.x == 0x12345678u && w.y == w.z && w.w == 77u) Pb[0] = (bf16)1;
#else
                    *(GAS u32x4*)(Pb + (size_t)row * PPITCH + 256 * u.pn + 128 * bj + 32 * wc + 8 * fq) = w;
#endif
                } }
    }
};
#endif
struct EpiP {
    static constexpr bool PERM = true; static constexpr int NST = 16;
    GAS bf16* P;
    __device__ __forceinline__ void operator()(const f32x4 (&acc)[2][2][4][2], const pg8::Unit& u, int wr, int wc, int fr, int fq) const {
        const int rowb = u.pm * 256 + wr * 64 + fr; GAS bf16* Pb = P + (size_t)u.e * NTOK * DM;
#pragma unroll
        for (int ai = 0; ai < 2; ++ai)
#pragma unroll
            for (int m = 0; m < 4; ++m) { const int row = rowb + ai * 128 + m * 16;
#pragma unroll
                for (int bj = 0; bj < 2; ++bj) { u32x4 w; w.x = cvt_pk_bf16(acc[ai][bj][m][0][0], acc[ai][bj][m][0][1]); w.y = cvt_pk_bf16(acc[ai][bj][m][0][2], acc[ai][bj][m][0][3]);
                    w.z = cvt_pk_bf16(acc[ai][bj][m][1][0], acc[ai][bj][m][1][1]); w.w = cvt_pk_bf16(acc[ai][bj][m][1][2], acc[ai][bj][m][1][3]);
                    st16<1>((GAS u32x4*)(Pb + (size_t)row * DM + 256 * u.pn + 128 * bj + 32 * wc + 8 * fq), w); } }
    }
};
struct EpiGM {
    static constexpr bool PERM = true; static constexpr int NST = 16;
    const GAS bf16* P; GAS bf16* HM;
    __device__ __forceinline__ void operator()(const f32x4 (&acc)[2][2][4][2], const pg8::Unit& u, int wr, int wc, int fr, int fq) const {
        const int rowb = u.pm * 256 + wr * 64 + fr; const int br = u.e; const GAS bf16* Pb = P + (size_t)br * NTOK * DM;
        const int colb = 256 * u.pn + 32 * wc + 8 * fq;
#pragma unroll
        for (int ai = 0; ai < 2; ++ai) {
            u32x4 pv[4][2], ov[4][2];
#pragma unroll
            for (int m = 0; m < 4; ++m)
#pragma unroll
                for (int bj = 0; bj < 2; ++bj) { const size_t off = (size_t)(rowb + ai * 128 + m * 16) * DM + colb + 128 * bj;
                    pv[m][bj] = *(const GAS u32x4*)(Pb + off); ov[m][bj] = (br > 0) ? *(const GAS u32x4*)(HM + off) : (u32x4){0u, 0u, 0u, 0u}; }
            __builtin_amdgcn_sched_barrier(0);
#pragma unroll
            for (int m = 0; m < 4; ++m)
#pragma unroll
                for (int bj = 0; bj < 2; ++bj) { const size_t off = (size_t)(rowb + ai * 128 + m * 16) * DM + colb + 128 * bj;
                    const u32x4 p = pv[m][bj], o = ov[m][bj];
                    float x[8];
                    x[0] = bflo(p.x) * sigmoidf_(acc[ai][bj][m][0][0]) + bflo(o.x); x[1] = bfhi(p.x) * sigmoidf_(acc[ai][bj][m][0][1]) + bfhi(o.x); x[2] = bflo(p.y) * sigmoidf_(acc[ai][bj][m][0][2]) + bflo(o.y); x[3] = bfhi(p.y) * sigmoidf_(acc[ai][bj][m][0][3]) + bfhi(o.y);
                    x[4] = bflo(p.z) * sigmoidf_(acc[ai][bj][m][1][0]) + bflo(o.z); x[5] = bfhi(p.z) * sigmoidf_(acc[ai][bj][m][1][1]) + bfhi(o.z); x[6] = bflo(p.w) * sigmoidf_(acc[ai][bj][m][1][2]) + bflo(o.w); x[7] = bfhi(p.w) * sigmoidf_(acc[ai][bj][m][1][3]) + bfhi(o.w);
                    u32x4 w; w.x = cvt_pk_bf16(x[0], x[1]); w.y = cvt_pk_bf16(x[2], x[3]); w.z = cvt_pk_bf16(x[4], x[5]); w.w = cvt_pk_bf16(x[6], x[7]);
                    st16<2>((GAS u32x4*)(HM + off), w); }
            asm volatile("" ::: "memory");
        }
    }
};
struct EpiO {
    static constexpr bool PERM = true; static constexpr int NST = 16;
    const GAS bf16* HBr; GAS bf16* T;
    __device__ __forceinline__ void operator()(const f32x4 (&acc)[2][2][4][2], const pg8::Unit& u, int wr, int wc, int fr, int fq) const {
        const int rowb = u.pm * 256 + wr * 64 + fr; const int colb = 256 * u.pn + 32 * wc + 8 * fq;
#pragma unroll
        for (int ai = 0; ai < 2; ++ai) {
            u32x4 hv[4][2];
#pragma unroll
            for (int m = 0; m < 4; ++m)
#pragma unroll
                for (int bj = 0; bj < 2; ++bj) hv[m][bj] = *(const GAS u32x4*)(HBr + (size_t)(rowb + ai * 128 + m * 16) * DM + colb + 128 * bj);
            __builtin_amdgcn_sched_barrier(0);
#pragma unroll
            for (int m = 0; m < 4; ++m)
#pragma unroll
                for (int bj = 0; bj < 2; ++bj) { const u32x4 h = hv[m][bj];
                    u32x4 w; w.x = cvt_pk_bf16(bflo(h.x) * DN_ALPHA + acc[ai][bj][m][0][0], bfhi(h.x) * DN_ALPHA + acc[ai][bj][m][0][1]); w.y = cvt_pk_bf16(bflo(h.y) * DN_ALPHA + acc[ai][bj][m][0][2], bfhi(h.y) * DN_ALPHA + acc[ai][bj][m][0][3]);
                    w.z = cvt_pk_bf16(bflo(h.z) * DN_ALPHA + acc[ai][bj][m][1][0], bfhi(h.z) * DN_ALPHA + acc[ai][bj][m][1][1]); w.w = cvt_pk_bf16(bflo(h.w) * DN_ALPHA + acc[ai][bj][m][1][2], bfhi(h.w) * DN_ALPHA + acc[ai][bj][m][1][3]);
                    st16<3>((GAS u32x4*)(T + (size_t)(rowb + ai * 128 + m * 16) * DM + colb + 128 * bj), w); }
            asm volatile("" ::: "memory");
        }
    }
};
struct EpiGU {
    static constexpr bool PERM = true; static constexpr int NST = 8;
    GAS bf16* HID; const GAS float* CW;
    __device__ __forceinline__ void operator()(const f32x4 (&acc)[2][2][4][2], const pg8::Unit& u, int wr, int wc, int fr, int fq) const {
        const int rowb = u.pm * 256 + wr * 64 + fr;
        float cwv[2][4];
#pragma unroll
        for (int ai = 0; ai < 2; ++ai)
#pragma unroll
            for (int m = 0; m < 4; ++m) cwv[ai][m] = CW[rowb + ai * 128 + m * 16];
#pragma unroll
        for (int ai = 0; ai < 2; ++ai)
#pragma unroll
            for (int m = 0; m < 4; ++m) { const int row = rowb + ai * 128 + m * 16; const float cw = cwv[ai][m];
                float x[8];
#pragma unroll
                for (int i = 0; i < 8; ++i) x[i] = siluf_(acc[ai][0][m][i >> 2][i & 3]) * acc[ai][1][m][i >> 2][i & 3] * cw;
                u32x4 w; w.x = cvt_pk_bf16(x[0], x[1]); w.y = cvt_pk_bf16(x[2], x[3]); w.z = cvt_pk_bf16(x[4], x[5]); w.w = cvt_pk_bf16(x[6], x[7]);
                st16<4>((GAS u32x4*)(HID + (size_t)row * DEXP + 128 * u.pn + 32 * wc + 8 * fq), w); }
    }
};
struct EpiDN {
    static constexpr bool PERM = true; static constexpr int NST = 16;
    GAS bf16* FF2;
    __device__ __forceinline__ void operator()(const f32x4 (&acc)[2][2][4][2], const pg8::Unit& u, int wr, int wc, int fr, int fq) const {
        const int rowb = u.pm * 256 + wr * 64 + fr;
#pragma unroll
        for (int ai = 0; ai < 2; ++ai)
#pragma unroll
            for (int m = 0; m < 4; ++m) { const int row = rowb + ai * 128 + m * 16;
#pragma unroll
                for (int bj = 0; bj < 2; ++bj) { u32x4 w; w.x = cvt_pk_bf16(acc[ai][bj][m][0][0], acc[ai][bj][m][0][1]); w.y = cvt_pk_bf16(acc[ai][bj][m][0][2], acc[ai][bj][m][0][3]);
                    w.z = cvt_pk_bf16(acc[ai][bj][m][1][0], acc[ai][bj][m][1][1]); w.w = cvt_pk_bf16(acc[ai][bj][m][1][2], acc[ai][bj][m][1][3]);
                    st16<5>((GAS u32x4*)(FF2 + (size_t)row * DM + 256 * u.pn + 128 * bj + 32 * wc + 8 * fq), w); } }
    }
};
#ifndef EN_B1
#define EN_B1 1
#endif
#ifndef EN_B2
#define EN_B2 1
#endif
#ifndef EN_B3
#define EN_B3 1
#endif

template <int CTRL> __device__ __forceinline__ float dppf(float x) { return __builtin_bit_cast(float, __builtin_amdgcn_mov_dpp(__builtin_bit_cast(int, x), CTRL, 0xf, 0xf, true)); }
template <int CTRL> __device__ __forceinline__ int dppi(int x) { return __builtin_amdgcn_mov_dpp(x, CTRL, 0xf, 0xf, true); }
typedef short v4i16_t __attribute__((ext_vector_type(4)));
typedef unsigned short u16x2 __attribute__((ext_vector_type(2)));
__device__ __forceinline__ v4i16_t ldtr(const LAS unsigned char* p) { return __builtin_amdgcn_ds_read_tr16_b64_v4i16((LAS v4i16_t*)p); }
__device__ __forceinline__ bf16x8 cat8(v4i16_t lo, v4i16_t hi) { bf16x8 r; r[0] = lo[0]; r[1] = lo[1]; r[2] = lo[2]; r[3] = lo[3]; r[4] = hi[0]; r[5] = hi[1]; r[6] = hi[2]; r[7] = hi[3]; return r; }
__device__ __forceinline__ int wave_total_i(int v) {
    v += dppi<0xB1>(v); v += dppi<0x4E>(v); v += dppi<0x141>(v); v += dppi<0x140>(v);
    return __builtin_amdgcn_readlane(v, 0) + __builtin_amdgcn_readlane(v, 16) + __builtin_amdgcn_readlane(v, 32) + __builtin_amdgcn_readlane(v, 48);
}
__device__ __forceinline__ void gmlp_unit(Frame& F, int l, int unit) {
    int tid = F.tid; asm volatile("" : "+v"(tid)); const int lane = tid & 63;
    const int chunk = unit >> 2, g = unit & 3, n0 = chunk * 128;
    const GAS bf16* PA = (const GAS bf16*)(F.ws + WS_PA); GAS bf16* Y = (GAS bf16*)(F.ws + WS_Y);
    LAS float* vln = (LAS float*)F.lds;
    LAS float* wl = (LAS float*)(F.lds + 65536);
    LAS float* st = (LAS float*)(F.lds + AUX_OFF);
    const GAS float* lng = ((const GAS float*)F.in[9]) + l * 512; const GAS float* lnb = ((const GAS float*)F.in[10]) + l * 512;
    for (int j = 0; j < 16; ++j) { const int s = F.wave * 16 + j;
        const u32x4 w = *(const GAS u32x4*)(PA + (size_t)(n0 + s) * NPA + PA_CV + 8 * lane);
        float x[8] = {bflo(w.x), bfhi(w.x), bflo(w.y), bfhi(w.y), bflo(w.z), bfhi(w.z), bflo(w.w), bfhi(w.w)};
        float sm = 0.f;
#pragma unroll
        for (int i = 0; i < 8; ++i) sm += x[i];
        const float mean = wave_sum(sm, lane) * (1.f / 512.f); float q = 0.f;
#pragma unroll
        for (int i = 0; i < 8; ++i) { const float d = x[i] - mean; q += d * d; }
        const float rstd = 1.f / sqrtf(wave_sum(q, lane) * (1.f / 512.f) + LN_EPS);
        if (lane == 0) { st[2 * s] = mean; st[2 * s + 1] = rstd; } }
    __syncthreads();
#pragma unroll
    for (int i = 0; i < 4; ++i) { const int q = tid + 512 * i, s = q >> 4, d0 = (q & 15) * 8;
        const u32x4 w = *(const GAS u32x4*)(PA + (size_t)(n0 + s) * NPA + PA_CV + g * 128 + d0);
        const float mean = st[2 * s], rstd = st[2 * s + 1];
        float x[8] = {bflo(w.x), bfhi(w.x), bflo(w.y), bfhi(w.y), bflo(w.z), bfhi(w.z), bflo(w.w), bfhi(w.w)};
#pragma unroll
        for (int k = 0; k < 8; ++k) x[k] = (x[k] - mean) * rstd * lng[g * 128 + d0 + k] + lnb[g * 128 + d0 + k];
        *(LAS f32x4*)(vln + s * 128 + d0) = (f32x4){x[0], x[1], x[2], x[3]}; *(LAS f32x4*)(vln + s * 128 + d0 + 4) = (f32x4){x[4], x[5], x[6], x[7]}; }
    const GAS float* ws = ((const GAS float*)F.in[11]) + ((size_t)l * 4 + g) * 128 * 128;
#pragma unroll
    for (int i = 0; i < 8; ++i) { const int q = tid + 512 * i, t = q >> 5, s0 = (q & 31) * 4;
        f32x4 w = *(const GAS f32x4*)(ws + t * 128 + s0);
        if (s0 + 0 > t) w.x = 0.f; if (s0 + 1 > t) w.y = 0.f; if (s0 + 2 > t) w.z = 0.f; if (s0 + 3 > t) w.w = 0.f;
        *(LAS f32x4*)(wl + t * 128 + s0) = w; }
    __syncthreads();
    const int d = tid & 127, tq = __builtin_amdgcn_readfirstlane(tid >> 7);
    float vr[128];
#pragma unroll
    for (int sb = 0; sb < 4; ++sb)
        if (sb <= tq) {
#pragma unroll
            for (int s = 0; s < 32; ++s) vr[sb * 32 + s] = vln[(sb * 32 + s) * 128 + d];
        } else {
#pragma unroll
            for (int s = 0; s < 32; ++s) vr[sb * 32 + s] = 0.f;
        }
    const GAS float* bs = ((const GAS float*)F.in[12]) + ((size_t)l * 4 + g) * 128;
#pragma unroll 1
    for (int ti = 0; ti < 32; ++ti) { const int t = tq * 32 + ti; float a = 0.f;
#pragma unroll
        for (int sb = 0; sb < 4; ++sb)
            if (sb <= tq) {
#pragma unroll
                for (int s4 = 0; s4 < 8; ++s4) { const f32x4 w = *(const LAS f32x4*)(wl + t * 128 + sb * 32 + s4 * 4);
                    a += w.x * vr[sb * 32 + s4 * 4] + w.y * vr[sb * 32 + s4 * 4 + 1] + w.z * vr[sb * 32 + s4 * 4 + 2] + w.w * vr[sb * 32 + s4 * 4 + 3]; }
            }
        const float uu = bf1(PA[(size_t)(n0 + t) * NPA + PA_CU + g * 128 + d]);
        Y[(size_t)(n0 + t) * 1536 + 1024 + g * 128 + d] = (bf16)f2bf(uu * (a + bs[t])); }
    __syncthreads();
}

__device__ __forceinline__ void gmlp16_unit(Frame& F, int l, int chunk) {
    const int lane = fresh_lane(), w = F.wave, tid = w * 64 + lane, fr = lane & 15, fq = lane >> 4;
    const size_t n0 = (size_t)chunk * 128;
    const GAS bf16* PA = (const GAS bf16*)(F.ws + WS_PA); GAS bf16* Y = (GAS bf16*)(F.ws + WS_Y);
    LAS unsigned char* VT = F.lds;
    LAS unsigned char* WT = F.lds + 32768;
    LAS float* st = (LAS float*)(F.lds + AUX_OFF);
    const GAS float* lng = ((const GAS float*)F.in[9]) + l * 512; const GAS float* lnb = ((const GAS float*)F.in[10]) + l * 512;
    u32x4 xv[4]; f32x4 wv0[4], wv1[4];
#define GM_LOAD(g_) do { const GAS float* ws_ = ((const GAS float*)F.in[11]) + ((size_t)l * 4 + (g_)) * 128 * 128; \
        _Pragma("unroll") for (int i = 0; i < 4; ++i) { const int q = tid + 512 * i, s = q >> 4, d0 = (q & 15) * 8; \
            xv[i] = *(const GAS u32x4*)(PA + (n0 + s) * NPA + PA_CV + (g_) * 128 + d0); wv0[i] = *(const GAS f32x4*)(ws_ + s * 128 + d0); wv1[i] = *(const GAS f32x4*)(ws_ + s * 128 + d0 + 4); } } while (0)
    { u32x4 rw[16];
#pragma unroll
      for (int j = 0; j < 16; ++j) rw[j] = *(const GAS u32x4*)(PA + (n0 + w * 16 + j) * NPA + PA_CV + 8 * lane);
      GM_LOAD(0);
      float a[16], b2[16];
#pragma unroll
      for (int j = 0; j < 16; ++j) { const u32x4 x4 = rw[j];
          const float x[8] = {bflo(x4.x), bfhi(x4.x), bflo(x4.y), bfhi(x4.y), bflo(x4.z), bfhi(x4.z), bflo(x4.w), bfhi(x4.w)};
          float sm = 0.f, sq = 0.f;
#pragma unroll
          for (int i = 0; i < 8; ++i) { sm += x[i]; sq += x[i] * x[i]; }
          a[j] = sm; b2[j] = sq; }
#define GM_HALVE(n_, mask_, bit_) do { const bool hi_ = (lane >> (bit_)) & 1; _Pragma("unroll") for (int j = 0; j < (n_); ++j) { \
          const float sa_ = hi_ ? a[j] : a[j + (n_)], ka_ = hi_ ? a[j + (n_)] : a[j]; a[j] = ka_ + shx(sa_, (mask_), lane); \
          const float sb_ = hi_ ? b2[j] : b2[j + (n_)], kb_ = hi_ ? b2[j + (n_)] : b2[j]; b2[j] = kb_ + shx(sb_, (mask_), lane); } } while (0)
      GM_HALVE(8, 32, 5); GM_HALVE(4, 16, 4); GM_HALVE(2, 8, 3); GM_HALVE(1, 4, 2);
#undef GM_HALVE
      float sa = a[0], sb = b2[0];
      sa += shx(sa, 2, lane); sb += shx(sb, 2, lane); sa += shx(sa, 1, lane); sb += shx(sb, 1, lane);
      const float mean = sa * (1.f / 512.f); const float var = fmaxf(sb * (1.f / 512.f) - mean * mean, 0.f);
      if ((lane & 3) == 0) { const int s = w * 16 + ((lane >> 2) & 15); st[2 * s] = mean; st[2 * s + 1] = 1.f / sqrtf(var + LN_EPS); } }
    __syncthreads();
#pragma unroll 1
    for (int g = 0; g < 4; ++g) {
        const GAS float* bs = ((const GAS float*)F.in[12]) + ((size_t)l * 4 + g) * 128;
        const int t_ = 16 * w + fr; const float bt = bs[t_];
        u32x2 uu[8];
#pragma unroll
        for (int nt = 0; nt < 8; ++nt) uu[nt] = *(const GAS u32x2*)(PA + (n0 + t_) * NPA + PA_CU + g * 128 + 16 * nt + 4 * fq);
#pragma unroll
        for (int i = 0; i < 4; ++i) { const int q = tid + 512 * i, s = q >> 4, d0 = (q & 15) * 8;
            const u32x4 x4 = xv[i];
            const float mean = st[2 * s], rstd = st[2 * s + 1];
            float x[8] = {bflo(x4.x), bfhi(x4.x), bflo(x4.y), bfhi(x4.y), bflo(x4.z), bfhi(x4.z), bflo(x4.w), bfhi(x4.w)};
            const f32x4 g0 = *(const GAS f32x4*)(lng + g * 128 + d0), g1 = *(const GAS f32x4*)(lng + g * 128 + d0 + 4), b0 = *(const GAS f32x4*)(lnb + g * 128 + d0), b1 = *(const GAS f32x4*)(lnb + g * 128 + d0 + 4);
#pragma unroll
            for (int k = 0; k < 8; ++k) x[k] = (x[k] - mean) * rstd * ((k < 4) ? g0[k & 3] : g1[k & 3]) + ((k < 4) ? b0[k & 3] : b1[k & 3]);
            u32x4 o; o.x = cvt_pk_bf16(x[0], x[1]); o.y = cvt_pk_bf16(x[2], x[3]); o.z = cvt_pk_bf16(x[4], x[5]); o.w = cvt_pk_bf16(x[6], x[7]);
            *(LAS u32x4*)(VT + s * 256 + d0 * 2) = o;
            const int t = s, s0 = d0;
            const f32x4 w0 = wv0[i], w1 = wv1[i];
            float wv[8] = {w0.x, w0.y, w0.z, w0.w, w1.x, w1.y, w1.z, w1.w};
#pragma unroll
            for (int k = 0; k < 8; ++k) wv[k] = (s0 + k <= t) ? wv[k] : 0.f;
            u32x4 ow; ow.x = cvt_pk_bf16(wv[0], wv[1]); ow.y = cvt_pk_bf16(wv[2], wv[3]); ow.z = cvt_pk_bf16(wv[4], wv[5]); ow.w = cvt_pk_bf16(wv[6], wv[7]);
            *(LAS u32x4*)(WT + t * 256 + s0 * 2) = ow; }
        if (g < 3) GM_LOAD(g + 1);
        __syncthreads();
        f32x4 acc[8];
#pragma unroll
        for (int nt = 0; nt < 8; ++nt) acc[nt] = (f32x4){0.f, 0.f, 0.f, 0.f};
        const int nks = (16 * w + 15) / 32 + 1;
#pragma unroll
        for (int ks = 0; ks < 4; ++ks) if (ks < nks) {
            const bf16x8 a = *(const LAS bf16x8*)(WT + (16 * w + fr) * 256 + (8 * fq + 32 * ks) * 2);
            const int srow = 32 * ks + 8 * fq + (fr >> 2);
#pragma unroll
            for (int nt = 0; nt < 8; ++nt) { const bf16x8 bv = cat8(ldtr(VT + srow * 256 + (16 * nt + 4 * (fr & 3)) * 2), ldtr(VT + (srow + 4) * 256 + (16 * nt + 4 * (fr & 3)) * 2));
                acc[nt] = __builtin_amdgcn_mfma_f32_16x16x32_bf16(bv, a, acc[nt], 0, 0, 0); } }
#pragma unroll
        for (int nt = 0; nt < 8; ++nt) { const int d0 = 16 * nt + 4 * fq; const u32x2 u2 = uu[nt];
            u32x2 wv; wv.x = pk2(bflo(u2.x) * (acc[nt][0] + bt), bfhi(u2.x) * (acc[nt][1] + bt)); wv.y = pk2(bflo(u2.y) * (acc[nt][2] + bt), bfhi(u2.y) * (acc[nt][3] + bt));
            *(GAS u32x2*)(Y + (n0 + t_) * 1536 + 1024 + g * 128 + d0) = wv; }
        __syncthreads();
    }
#undef GM_LOAD
}

__device__ __forceinline__ void gla_unit(Frame& F, int l, int unit) {
    int tid = F.tid; asm volatile("" : "+v"(tid));
    const int b = unit >> 2, h = unit & 3;
    const GAS bf16* PA = (const GAS bf16*)(F.ws + WS_PA); GAS bf16* Y = (GAS bf16*)(F.ws + WS_Y); const GAS float* GLR = (const GAS float*)(F.ws + WS_GLR);
    LAS float* wa = (LAS float*)F.lds;
    LAS float* ba = wa + 1024;
    LAS float* as_ = ba + 64;
    LAS float* qs = as_ + 1024;
    LAS float* ks = qs + 1024;
    LAS float* vs = ks + 1024;
    LAS float* part = vs + 2048;
    for (int i = tid; i < 1024; i += 512) wa[i] = ((const GAS float*)F.in[6])[(size_t)l * 16 * 256 + (i >> 6) * 256 + h * 64 + (i & 63)];
    if (tid < 64) ba[tid] = ((const GAS float*)F.in[7])[l * 256 + h * 64 + tid];
    const GAS float* gng = ((const GAS float*)F.in[8]) + l * 128;
    const int v = tid & 127, kq = __builtin_amdgcn_readfirstlane(tid >> 7);
    float S[16];
#pragma unroll
    for (int j = 0; j < 16; ++j) S[j] = 0.f;
    __syncthreads();
    for (int t0 = 0; t0 < SEQ; t0 += 16) {
        const size_t nb = (size_t)b * SEQ + t0;
#pragma unroll
        for (int i = 0; i < 2; ++i) { const int e = tid + 512 * i, t = e >> 6, k = e & 63; float z = ba[k];
#pragma unroll
            for (int r = 0; r < 16; ++r) z += GLR[(nb + t) * 16 + r] * wa[r * 64 + k];
            const float ls = fminf(z, 0.f) - log1pf(__expf(-fabsf(z)));
            as_[e] = __expf(ls * (1.f / 16.f));
            qs[e] = bf1(PA[(nb + t) * NPA + PA_BQ + h * 64 + k]); ks[e] = bf1(PA[(nb + t) * NPA + PA_BK + h * 64 + k]); }
#pragma unroll
        for (int i = 0; i < 4; ++i) { const int e = tid + 512 * i, t = e >> 7, vv = e & 127; vs[e] = bf1(PA[(nb + t) * NPA + PA_BV + h * 128 + vv]); }
        __syncthreads();
#pragma unroll 4
        for (int t = 0; t < 16; ++t) { const float vt = vs[t * 128 + v]; float p = 0.f;
#pragma unroll
            for (int j4 = 0; j4 < 4; ++j4) { const f32x4 a4 = *(const LAS f32x4*)(as_ + t * 64 + kq * 16 + j4 * 4), k4 = *(const LAS f32x4*)(ks + t * 64 + kq * 16 + j4 * 4), q4 = *(const LAS f32x4*)(qs + t * 64 + kq * 16 + j4 * 4);
#pragma unroll
                for (int j = 0; j < 4; ++j) { S[j4 * 4 + j] = a4[j] * S[j4 * 4 + j] + k4[j] * vt; p += q4[j] * S[j4 * 4 + j]; } }
            part[(kq * 16 + t) * 128 + v] = p; }
        __syncthreads();
        { const int t = tid >> 5, v4 = (tid & 31) * 4;
          f32x4 o = *(const LAS f32x4*)(part + (0 * 16 + t) * 128 + v4);
#pragma unroll
          for (int q = 1; q < 4; ++q) o += *(const LAS f32x4*)(part + (q * 16 + t) * 128 + v4);
          float ss = o.x * o.x + o.y * o.y + o.z * o.z + o.w * o.w;
#pragma unroll
          for (int sh = 1; sh < 32; sh <<= 1) ss += shx(ss, sh, tid & 63);
          const float r = 1.f / sqrtf(ss * (1.f / 128.f) + RMS_EPS);
          const f32x4 gg = *(const GAS f32x4*)(gng + v4);
          const u32x2 brw = *(const GAS u32x2*)(PA + (nb + t) * NPA + PA_BR + h * 128 + v4);
          u32x2 w; w.x = pk2(o.x * r * gg.x * bflo(brw.x), o.y * r * gg.y * bfhi(brw.x)); w.y = pk2(o.z * r * gg.z * bflo(brw.y), o.w * r * gg.w * bfhi(brw.y));
          *(GAS u32x2*)(Y + (nb + t) * 1536 + 512 + h * 128 + v4) = w; }
        __syncthreads();
    }
}

constexpr size_t WS_US = WS_WMOE, WS_DEC = WS_WMOE + 32 * MiB;
__device__ __forceinline__ void gla_local_unit(Frame& F, int l, int unit, bool dry = false) {
    const int lane = fresh_lane(), w = F.wave, tid = w * 64 + lane, fr = lane & 15, fq = lane >> 4;
    const int b = unit >> 8, h = (unit >> 6) & 3, c = unit & 63; const size_t n0 = (size_t)b * SEQ + 64 * c;
    GAS bf16* PA = (GAS bf16*)(F.ws + WS_PA); GAS bf16* Y = (GAS bf16*)(F.ws + WS_Y); const GAS float* GLR = (const GAS float*)(F.ws + WS_GLR);
    GAS bf16* US = (GAS bf16*)(F.ws + WS_US) + (size_t)unit * 8192; GAS float* DEC = (GAS float*)(F.ws + WS_DEC) + unit * 64;
    LAS unsigned char* QT = F.lds; LAS unsigned char* KT = F.lds + 8192; LAS unsigned char* KD = F.lds + 16384; LAS unsigned char* VV = F.lds + 24576; LAS unsigned char* ATT = F.lds + 40960;
    LAS float* SEG = (LAS float*)(F.lds + 65536); LAS float* WA = (LAS float*)(F.lds + 67584); LAS float* BA = (LAS float*)(F.lds + 71680); LAS float* GL = (LAS float*)(F.lds + 71936);
    const int k = tid & 63, seg = w;
    float qv8[8], kv8[8];
#pragma unroll
    for (int i = 0; i < 8; ++i) { const int t = 8 * seg + i; qv8[i] = bf1(PA[(n0 + t) * NPA + PA_BQ + h * 64 + k]); kv8[i] = bf1(PA[(n0 + t) * NPA + PA_BK + h * 64 + k]); }
    if (tid < 256) *(LAS f32x4*)(GL + 4 * tid) = *(const GAS f32x4*)(GLR + n0 * 16 + 4 * tid);
#pragma unroll
    for (int i = 0; i < 2; ++i) { const int e = tid + 512 * i; WA[e] = ((const GAS float*)F.in[6])[(size_t)l * 16 * 256 + (e >> 6) * 256 + h * 64 + (e & 63)]; }
    if (tid < 64) BA[tid] = ((const GAS float*)F.in[7])[l * 256 + h * 64 + tid];
#pragma unroll
    for (int i = 0; i < 2; ++i) { const int piece = tid + 512 * i, row = piece >> 4, c16 = piece & 15;
        *(LAS u32x4*)(VV + row * 256 + c16 * 16) = *(const GAS u32x4*)(PA + (n0 + row) * NPA + PA_BV + h * 128 + 8 * c16); }
    __syncthreads();
    float cum[8];
    { float run = 0.f;
#pragma unroll
      for (int i = 0; i < 8; ++i) { const int t = 8 * seg + i; float z = BA[k];
          const f32x4 g0 = *(const LAS f32x4*)(GL + t * 16), g1 = *(const LAS f32x4*)(GL + t * 16 + 4), g2 = *(const LAS f32x4*)(GL + t * 16 + 8), g3 = *(const LAS f32x4*)(GL + t * 16 + 12);
#pragma unroll
          for (int r = 0; r < 4; ++r) { z += g0[r] * WA[r * 64 + k]; z += g1[r] * WA[(4 + r) * 64 + k]; z += g2[r] * WA[(8 + r) * 64 + k]; z += g3[r] * WA[(12 + r) * 64 + k]; }
          const float ls = fminf(z, 0.f) - __logf(1.f + __expf(-fabsf(z)));
          run += ls * (1.f / 16.f); cum[i] = run; }
      SEG[seg * 64 + k] = run; }
    __syncthreads();
    { float off = 0.f, blast = 0.f;
#pragma unroll
      for (int s2 = 0; s2 < 8; ++s2) { const float sv = SEG[s2 * 64 + k]; blast += sv; off += (s2 < seg) ? sv : 0.f; }
      const float eblast = __expf(blast);
#pragma unroll
      for (int i = 0; i < 8; ++i) { const int t = 8 * seg + i; const float bb = cum[i] + off;
          const float qv = qv8[i], kv = kv8[i];
          const float kt = kv * __expf(-bb);
          const unsigned qk = cvt_pk_bf16(qv * __expf(bb), kt), kd = cvt_pk_bf16(kt * eblast, 0.f);
          ((LAS unsigned short*)QT)[t * 64 + k] = (unsigned short)qk; ((LAS unsigned short*)KT)[t * 64 + k] = (unsigned short)(qk >> 16); ((LAS unsigned short*)KD)[t * 64 + k] = (unsigned short)kd;
          if (!dry) PA[(n0 + t) * NPA + PA_BQ + h * 64 + k] = (bf16)qk; }
      if (seg == 0) DEC[k] = eblast; }
    __syncthreads();
#pragma unroll
    for (int ii = 0; ii < 2; ++ii) { const int id = 2 * w + ii, ts = id >> 2, tt = id & 3;
        f32x4 d = {0.f, 0.f, 0.f, 0.f};
        if (ts <= tt) {
#pragma unroll
            for (int ks = 0; ks < 2; ++ks) { const bf16x8 a = *(const LAS bf16x8*)(KT + (16 * ts + fr) * 128 + (8 * fq + 32 * ks) * 2), bq = *(const LAS bf16x8*)(QT + (16 * tt + fr) * 128 + (8 * fq + 32 * ks) * 2);
                d = __builtin_amdgcn_mfma_f32_16x16x32_bf16(a, bq, d, 0, 0, 0); } }
        const int t = 16 * tt + fr, s0 = 16 * ts + 4 * fq;
        u32x2 pk; pk.x = cvt_pk_bf16((s0 <= t) ? d[0] : 0.f, (s0 + 1 <= t) ? d[1] : 0.f); pk.y = cvt_pk_bf16((s0 + 2 <= t) ? d[2] : 0.f, (s0 + 3 <= t) ? d[3] : 0.f);
        *(LAS u32x2*)(ATT + t * 128 + s0 * 2) = pk; }
    __syncthreads();
    { const int tr = w & 3, nh = w >> 2;
      f32x4 ao[4], au[4];
#pragma unroll
      for (int j = 0; j < 4; ++j) { ao[j] = (f32x4){0.f, 0.f, 0.f, 0.f}; au[j] = (f32x4){0.f, 0.f, 0.f, 0.f}; }
#pragma unroll
      for (int ks = 0; ks < 2; ++ks) {
          const bf16x8 aA = *(const LAS bf16x8*)(ATT + (16 * tr + fr) * 128 + (8 * fq + 32 * ks) * 2);
          const int srow = 32 * ks + 8 * fq + (fr >> 2);
          const bf16x8 aK = cat8(ldtr(KD + srow * 128 + (16 * tr + 4 * (fr & 3)) * 2), ldtr(KD + (srow + 4) * 128 + (16 * tr + 4 * (fr & 3)) * 2));
#pragma unroll
          for (int j = 0; j < 4; ++j) { const int nt = 4 * nh + j;
              const bf16x8 bv = cat8(ldtr(VV + srow * 256 + (16 * nt + 4 * (fr & 3)) * 2), ldtr(VV + (srow + 4) * 256 + (16 * nt + 4 * (fr & 3)) * 2));
              ao[j] = __builtin_amdgcn_mfma_f32_16x16x32_bf16(bv, aA, ao[j], 0, 0, 0);
              au[j] = __builtin_amdgcn_mfma_f32_16x16x32_bf16(bv, aK, au[j], 0, 0, 0); } }
#pragma unroll
      for (int j = 0; j < 4; ++j) { const int v0 = 16 * (4 * nh + j) + 4 * fq, row = 16 * tr + fr;
          u32x2 wo; wo.x = pk2(ao[j][0], ao[j][1]); wo.y = pk2(ao[j][2], ao[j][3]); *(GAS u32x2*)(Y + (n0 + row) * 1536 + 512 + h * 128 + v0) = wo;
          u32x2 wu; wu.x = pk2(au[j][0], au[j][1]); wu.y = pk2(au[j][2], au[j][3]); *(GAS u32x2*)(US + row * 128 + v0) = wu; } }
    __syncthreads();
}
__device__ __forceinline__ void gla_scan_phase(Frame& F, bool dry = false) {
    GAS bf16* USb = (GAS bf16*)(F.ws + WS_US); const GAS float* DECb = (const GAS float*)(F.ws + WS_DEC); const size_t dofs = dry ? (size_t)((GAS unsigned char*)F.H - (F.ws + WS_US)) / 4 : 0;
    for (int gt = F.wg * 512 + F.tid; gt < 131072; gt += F.G * 512) { const int e0 = 2 * gt, bh = e0 >> 13, kv = e0 & 8191, k = kv >> 7;
        GAS unsigned* p = (GAS unsigned*)(USb + (size_t)bh * 64 * 8192 + kv); const GAS float* dp = DECb + bh * 64 * 64 + k;
        float s0 = 0.f, s1 = 0.f;
#pragma unroll 8
        for (int c = 0; c < 64; ++c) { const unsigned u = p[(size_t)c * 4096]; const float d = dp[c * 64];
            p[(size_t)c * 4096 + dofs] = pk2(s0, s1);
            s0 = d * s0 + bflo(u); s1 = d * s1 + bfhi(u); } }
}
struct GlaOutRegs { u32x4 us[2]; bf16x8 aq[2]; u32x2 oi[4]; u32x2 br[4]; };
__device__ __forceinline__ void gla_out_load(Frame& F, int unit, int tid, int w, int fr, int fq, GlaOutRegs& R) {
    const int b = unit >> 8, h = (unit >> 6) & 3, c = unit & 63; const size_t n0 = (size_t)b * SEQ + 64 * c;
    const GAS bf16* PA = (const GAS bf16*)(F.ws + WS_PA); const GAS bf16* Y = (const GAS bf16*)(F.ws + WS_Y);
    const GAS bf16* US = (const GAS bf16*)(F.ws + WS_US) + (size_t)unit * 8192;
    const int tr = w >> 1, nh = w & 1, row = 16 * tr + fr;
#pragma unroll
    for (int i = 0; i < 2; ++i) R.us[i] = *(const GAS u32x4*)(US + (tid + 512 * i) * 8);
#pragma unroll
    for (int ks = 0; ks < 2; ++ks) R.aq[ks] = *(const GAS bf16x8*)(PA + (n0 + row) * NPA + PA_BQ + h * 64 + 8 * fq + 32 * ks);
#pragma unroll
    for (int j = 0; j < 4; ++j) { const int v0 = 16 * (4 * nh + j) + 4 * fq; R.oi[j] = *(const GAS u32x2*)(Y + (n0 + row) * 1536 + 512 + h * 128 + v0); R.br[j] = *(const GAS u32x2*)(PA + (n0 + row) * NPA + PA_BR + h * 128 + v0); }
}
__device__ __forceinline__ void gla_out_compute(Frame& F, int l, int unit, int tid, int lane, int w, int fr, int fq, const GlaOutRegs& R, bool dry = false) {
    const int b = unit >> 8, h = (unit >> 6) & 3, c = unit & 63; const size_t n0 = (size_t)b * SEQ + 64 * c;
    GAS bf16* Y = dry ? (GAS bf16*)F.H : (GAS bf16*)(F.ws + WS_Y);
    LAS unsigned char* SS = F.lds;
    LAS float* PS = (LAS float*)(F.lds + 16384);
    const GAS float* gng = ((const GAS float*)F.in[8]) + l * 128;
#pragma unroll
    for (int i = 0; i < 2; ++i) *(LAS u32x4*)(SS + (tid + 512 * i) * 16) = R.us[i];
    __syncthreads();
    const int tr = w >> 1, nh = w & 1, row = 16 * tr + fr;
    f32x4 acc[4];
#pragma unroll
    for (int j = 0; j < 4; ++j) acc[j] = (f32x4){0.f, 0.f, 0.f, 0.f};
#pragma unroll
    for (int ks = 0; ks < 2; ++ks) { const int krow = 32 * ks + 8 * fq + (fr >> 2);
#pragma unroll
        for (int j = 0; j < 4; ++j) { const int nt = 4 * nh + j;
            const bf16x8 bs = cat8(ldtr(SS + krow * 256 + (16 * nt + 4 * (fr & 3)) * 2), ldtr(SS + (krow + 4) * 256 + (16 * nt + 4 * (fr & 3)) * 2));
            acc[j] = __builtin_amdgcn_mfma_f32_16x16x32_bf16(bs, R.aq[ks], acc[j], 0, 0, 0); } }
    float ss = 0.f;
#pragma unroll
    for (int j = 0; j < 4; ++j) { const u32x2 oi = R.oi[j];
        acc[j][0] += bflo(oi.x); acc[j][1] += bfhi(oi.x); acc[j][2] += bflo(oi.y); acc[j][3] += bfhi(oi.y);
        ss += (acc[j][0] * acc[j][0] + acc[j][1] * acc[j][1]) + (acc[j][2] * acc[j][2] + acc[j][3] * acc[j][3]); }
    ss += shx(ss, 16, lane); ss += shx(ss, 32, lane);
    if (fq == 0) PS[row * 2 + nh] = ss;
    __syncthreads();
    { const float rinv = 1.f / sqrtf((PS[row * 2] + PS[row * 2 + 1]) * (1.f / 128.f) + RMS_EPS);
#pragma unroll
      for (int j = 0; j < 4; ++j) { const int v0 = 16 * (4 * nh + j) + 4 * fq; const f32x4 gg = *(const GAS f32x4*)(gng + v0); const u32x2 br = R.br[j];
          u32x2 wv; wv.x = pk2(acc[j][0] * rinv * gg[0] * bflo(br.x), acc[j][1] * rinv * gg[1] * bfhi(br.x)); wv.y = pk2(acc[j][2] * rinv * gg[2] * bflo(br.y), acc[j][3] * rinv * gg[3] * bfhi(br.y));
          *(GAS u32x2*)(Y + (n0 + row) * 1536 + 512 + h * 128 + v0) = wv; } }
    __syncthreads();
}
constexpr int DSA_WAVE_LDS = 17920;
__device__ __forceinline__ void dsa_unit(Frame& F, int unit) {
    int lane = F.lane; asm volatile("" : "+v"(lane)); const int w = F.wave;
    const int qb = 4095 - unit;
    const int b = qb & 7, t = (qb >> 3) * 8 + w;
    const size_t n = (size_t)b * SEQ + t, nb0 = (size_t)b * SEQ;
    const GAS bf16* PA = (const GAS bf16*)(F.ws + WS_PA); GAS bf16* Y = (GAS bf16*)(F.ws + WS_Y);
    const GAS bf16* KI = (const GAS bf16*)(F.ws + WS_KI); const GAS bf16* KA = (const GAS bf16*)(F.ws + WS_KA); const GAS bf16* VA = (const GAS bf16*)(F.ws + WS_VA);
    const GAS float* WI = (const GAS float*)(F.ws + WS_WI);
    LAS unsigned char* base = F.lds + w * DSA_WAVE_LDS;
    LAS unsigned* sc = (LAS unsigned*)base;
    LAS float* qi = (LAS float*)(base + 16384);
    LAS unsigned short* list = (LAS unsigned short*)(base + 16384 + 1024);
    { const u32x2 q2 = *(const GAS u32x2*)(PA + n * NPA + PA_QI + 4 * lane);
      *(LAS f32x4*)(qi + 4 * lane) = (f32x4){bflo(q2.x), bfhi(q2.x), bflo(q2.y), bfhi(q2.y)}; }
    asm volatile("s_waitcnt lgkmcnt(0)" ::: "memory");
    const f32x4 wi = {ld_f32(WI + n * 4), ld_f32(WI + n * 4 + 1), ld_f32(WI + n * 4 + 2), ld_f32(WI + n * 4 + 3)};
    const int nbat = (t >> 6) + 1;
    for (int kb = 0; kb < nbat; ++kb) { const int key = kb * 64 + lane, kc = key <= t ? key : t;
        const GAS u32x4* kp = (const GAS u32x4*)(KI + (nb0 + kc) * 64);
        float kf[64];
#pragma unroll
        for (int c = 0; c < 8; ++c) { const u32x4 kk = kp[c]; kf[8 * c] = bflo(kk.x); kf[8 * c + 1] = bfhi(kk.x); kf[8 * c + 2] = bflo(kk.y); kf[8 * c + 3] = bfhi(kk.y); kf[8 * c + 4] = bflo(kk.z); kf[8 * c + 5] = bfhi(kk.z); kf[8 * c + 6] = bflo(kk.w); kf[8 * c + 7] = bfhi(kk.w); }
        float score = 0.f;
#pragma unroll
        for (int h = 0; h < 4; ++h) { float d = 0.f;
#pragma unroll
            for (int c = 0; c < 16; ++c) { const f32x4 q4 = *(const LAS f32x4*)(qi + h * 64 + 4 * c); d += q4.x * kf[4 * c] + q4.y * kf[4 * c + 1] + q4.z * kf[4 * c + 2] + q4.w * kf[4 * c + 3]; }
            score += wi[h] * fmaxf(d, 0.f); }
        if (score == 0.f) score = 0.f;
        unsigned u = __builtin_bit_cast(unsigned, score); u = (u & 0x80000000u) ? ~u : (u | 0x80000000u);
        sc[key] = key <= t ? u : 0u; }
    asm volatile("s_waitcnt lgkmcnt(0)" ::: "memory");
    int nsel;
    if (t >= 256) {
        unsigned T = 0u;
        for (int bit = 31; bit >= 0; --bit) { const unsigned cand = T | (1u << bit); int cnt = 0;
            for (int j = 0; j < nbat; ++j) cnt += (sc[j * 64 + lane] >= cand) ? 1 : 0;
            if (wave_sum_i(cnt, lane) >= 256) T = cand; }
        int cgt = 0;
        for (int j = 0; j < nbat; ++j) cgt += (sc[j * 64 + lane] > T) ? 1 : 0;
        const int need = 256 - wave_sum_i(cgt, lane);
        int selbase = 0, tiebase = 0;
        for (int j = 0; j < nbat; ++j) { const unsigned x = sc[j * 64 + lane]; const bool eq = (x == T), gt = (x > T);
            const unsigned long long beq = __ballot(eq); const unsigned long long lt = (1ull << lane) - 1ull;
            const int trank = tiebase + __popcll(beq & lt);
            const bool sel = gt || (eq && trank < need);
            const unsigned long long bsel = __ballot(sel);
            if (sel) list[selbase + __popcll(bsel & lt)] = (unsigned short)(j * 64 + lane);
            selbase += __popcll(bsel); tiebase += __popcll(beq); }
        nsel = 256;
    } else {
        nsel = t + 1;
        for (int i = lane; i < 256; i += 64) list[i] = (unsigned short)(i <= t ? i : 0);
    }
    asm volatile("s_waitcnt lgkmcnt(0)" ::: "memory");
    LAS float* qm = (LAS float*)base;
    LAS float* Pl = (LAS float*)(base + 2048);
    { const u32x4 q8 = *(const GAS u32x4*)(PA + n * NPA + PA_Q + 8 * lane);
      *(LAS f32x4*)(qm + 8 * lane) = (f32x4){bflo(q8.x), bfhi(q8.x), bflo(q8.y), bfhi(q8.y)}; *(LAS f32x4*)(qm + 8 * lane + 4) = (f32x4){bflo(q8.z), bfhi(q8.z), bflo(q8.w), bfhi(q8.w)}; }
    asm volatile("s_waitcnt lgkmcnt(0)" ::: "memory");
#pragma unroll 1
    for (int bb = 0; bb < 4; ++bb) { const int i = bb * 64 + lane; const bool valid = i < nsel; const int key = valid ? (int)list[i] : 0;
        const GAS u32x4* kp = (const GAS u32x4*)(KA + (nb0 + key) * 64);
        float kf[64];
#pragma unroll
        for (int c = 0; c < 8; ++c) { const u32x4 kk = kp[c]; kf[8 * c] = bflo(kk.x); kf[8 * c + 1] = bfhi(kk.x); kf[8 * c + 2] = bflo(kk.y); kf[8 * c + 3] = bfhi(kk.y); kf[8 * c + 4] = bflo(kk.z); kf[8 * c + 5] = bfhi(kk.z); kf[8 * c + 6] = bflo(kk.w); kf[8 * c + 7] = bfhi(kk.w); }
        float lgv[8];
#pragma unroll
        for (int h = 0; h < 8; ++h) { float d = 0.f;
#pragma unroll
            for (int c = 0; c < 16; ++c) { const f32x4 q4 = *(const LAS f32x4*)(qm + h * 64 + 4 * c); d += q4.x * kf[4 * c] + q4.y * kf[4 * c + 1] + q4.z * kf[4 * c + 2] + q4.w * kf[4 * c + 3]; }
            lgv[h] = valid ? d : -INFINITY; }
        *(LAS f32x4*)(Pl + i * 8) = (f32x4){lgv[0], lgv[1], lgv[2], lgv[3]}; *(LAS f32x4*)(Pl + i * 8 + 4) = (f32x4){lgv[4], lgv[5], lgv[6], lgv[7]}; }
    asm volatile("s_waitcnt lgkmcnt(0)" ::: "memory");
    float lg[4][8];
#pragma unroll
    for (int bb = 0; bb < 4; ++bb) { const f32x4 a = *(const LAS f32x4*)(Pl + (bb * 64 + lane) * 8), c = *(const LAS f32x4*)(Pl + (bb * 64 + lane) * 8 + 4);
        lg[bb][0] = a.x; lg[bb][1] = a.y; lg[bb][2] = a.z; lg[bb][3] = a.w; lg[bb][4] = c.x; lg[bb][5] = c.y; lg[bb][6] = c.z; lg[bb][7] = c.w; }
    float den[8];
#pragma unroll
    for (int h = 0; h < 8; ++h) { float m = fmaxf(fmaxf(lg[0][h], lg[1][h]), fmaxf(lg[2][h], lg[3][h])); m = wave_max(m, lane); float s = 0.f;
#pragma unroll
        for (int bb = 0; bb < 4; ++bb) { lg[bb][h] = __expf(lg[bb][h] - m); s += lg[bb][h]; }
        den[h] = wave_sum(s, lane); }
#pragma unroll
    for (int bb = 0; bb < 4; ++bb) { const int i = bb * 64 + lane;
        *(LAS f32x4*)(Pl + i * 8) = (f32x4){lg[bb][0], lg[bb][1], lg[bb][2], lg[bb][3]}; *(LAS f32x4*)(Pl + i * 8 + 4) = (f32x4){lg[bb][4], lg[bb][5], lg[bb][6], lg[bb][7]}; }
    asm volatile("s_waitcnt lgkmcnt(0)" ::: "memory");
    float o[8];
#pragma unroll
    for (int h = 0; h < 8; ++h) o[h] = 0.f;
#pragma unroll 4
    for (int i = 0; i < nsel; ++i) { const int key = (int)list[i]; const float vv = bf1(VA[(nb0 + key) * 64 + lane]);
        const f32x4 p0 = *(const LAS f32x4*)(Pl + i * 8), p1 = *(const LAS f32x4*)(Pl + i * 8 + 4);
        o[0] += p0.x * vv; o[1] += p0.y * vv; o[2] += p0.z * vv; o[3] += p0.w * vv; o[4] += p1.x * vv; o[5] += p1.y * vv; o[6] += p1.z * vv; o[7] += p1.w * vv; }
#pragma unroll
    for (int h = 0; h < 8; ++h) Y[n * 1536 + h * 64 + lane] = (bf16)f2bf(o[h] / den[h]);
}

__device__ __forceinline__ bf16x8 scale_pack8(u32x4 raw, float s) {
    u32x4 o; o.x = cvt_pk_bf16(bflo(raw.x) * s, bfhi(raw.x) * s); o.y = cvt_pk_bf16(bflo(raw.y) * s, bfhi(raw.y) * s); o.z = cvt_pk_bf16(bflo(raw.z) * s, bfhi(raw.z) * s); o.w = cvt_pk_bf16(bflo(raw.w) * s, bfhi(raw.w) * s);
    return __builtin_bit_cast(bf16x8, o);
}
__device__ __forceinline__ void dsa16_unit(Frame& F, int unit) {
    const int lane = fresh_lane(); const int w = F.wave;
    const int qb = 2047 - unit;
    const int b = qb & 7, t0 = (qb >> 3) * 16;
    const size_t nb0 = (size_t)b * SEQ;
    const GAS bf16* PA = (const GAS bf16*)(F.ws + WS_PA); GAS bf16* Y = (GAS bf16*)(F.ws + WS_Y);
    const GAS bf16* KI = (const GAS bf16*)(F.ws + WS_KI); const GAS bf16* KA = (const GAS bf16*)(F.ws + WS_KA); const GAS bf16* VA = (const GAS bf16*)(F.ws + WS_VA);
    const GAS float* WI = (const GAS float*)(F.ws + WS_WI);
    LAS unsigned char* K16 = F.lds;
    LAS unsigned short* LIST = (LAS unsigned short*)(F.lds + AUX_OFF);
    const int fr = lane & 15, fq = lane >> 4;
    {
        const int ql = fr >> 2, h = fr & 3;
        bf16x8 Bf[4][2]; f32x4 Linf[4];
#pragma unroll
        for (int g = 0; g < 4; ++g) { const size_t nq = nb0 + t0 + 4 * g + ql; const float wv = WI[nq * 4 + h];
#pragma unroll
            for (int ks = 0; ks < 2; ++ks) Bf[g][ks] = scale_pack8(*(const GAS u32x4*)(PA + nq * NPA + PA_QI + h * 64 + 8 * fq + 32 * ks), wv);
            const f32x4 w4 = *(const GAS f32x4*)(WI + (nb0 + t0 + 4 * g + fq) * 4);
#pragma unroll
            for (int r = 0; r < 4; ++r) Linf[g][r] = (w4[r] >= 0.f) ? INFINITY : -INFINITY; }
        const int ntiles = (t0 >> 4) + 1;
        const bool hist_on = (t0 >= 256); LAS unsigned* H0f = (LAS unsigned*)(F.lds + AUX_OFF + 8192) + fq * 256;
        bf16x8 A0[4], A1[4];
#pragma unroll
        for (int j = 0; j < 4; ++j) { const int tile = (w + 8 * j < ntiles) ? w + 8 * j : ntiles - 1; const size_t krow = (nb0 + 16 * tile + fr) * 64;
            A0[j] = *(const GAS bf16x8*)(KI + krow + 8 * fq); A1[j] = *(const GAS bf16x8*)(KI + krow + 32 + 8 * fq); }
#pragma unroll 1
        for (int tb = w; tb < ntiles; tb += 32) {
            bf16x8 N0[4], N1[4];
#pragma unroll
            for (int j = 0; j < 4; ++j) { const int tn = tb + 32 + 8 * j; const int tile = (tn < ntiles) ? tn : ntiles - 1; const size_t krow = (nb0 + 16 * tile + fr) * 64;
                N0[j] = *(const GAS bf16x8*)(KI + krow + 8 * fq); N1[j] = *(const GAS bf16x8*)(KI + krow + 32 + 8 * fq); }
#pragma unroll
            for (int j = 0; j < 4; ++j) { const int tile = tb + 8 * j;
                if (tile < ntiles) {
                    const int kpos = 16 * tile + fr;
                    const int g7 = kpos >> 7, hf = (kpos >> 6) & 1, ln = kpos & 63;
                    const int koff = (g7 >> 2) * 1024 + ln * 16 + (g7 & 3) * 4 + hf * 2 + fq * 8192;
                    const bool lastt = (tile == ntiles - 1);
                    f32x4 d[4];
#pragma unroll
                    for (int g = 0; g < 4; ++g) d[g] = __builtin_amdgcn_mfma_f32_16x16x32_bf16(Bf[g][0], A0[j], (f32x4){0.f, 0.f, 0.f, 0.f}, 0, 0, 0);
#pragma unroll
                    for (int g = 0; g < 4; ++g) d[g] = __builtin_amdgcn_mfma_f32_16x16x32_bf16(Bf[g][1], A1[j], d[g], 0, 0, 0);
#pragma unroll
                    for (int g = 0; g < 4; ++g) {
                        const float s = ((__builtin_amdgcn_fmed3f(d[g][0], 0.f, Linf[g][0]) + __builtin_amdgcn_fmed3f(d[g][1], 0.f, Linf[g][1])) + (__builtin_amdgcn_fmed3f(d[g][2], 0.f, Linf[g][2]) + __builtin_amdgcn_fmed3f(d[g][3], 0.f, Linf[g][3]))) + 0.0f;
                        const _Float16 hh = (_Float16)s; const unsigned hb = (unsigned)__builtin_bit_cast(unsigned short, hh);
                        unsigned key = (hb ^ ((unsigned)((int)(hb << 16) >> 31) | 0x8000u)) & 0xffffu; if (lastt) key = (kpos <= t0 + 4 * g + fq) ? key : 0u;
                        *(LAS unsigned short*)(K16 + koff + g * 32768) = (unsigned short)key;
                        if (hist_on) __hip_atomic_fetch_add(H0f + g * 1024 + (key >> 8), 1u, __ATOMIC_RELAXED, __HIP_MEMORY_SCOPE_WORKGROUP); }
                }
            }
#pragma unroll
            for (int j = 0; j < 4; ++j) { A0[j] = N0[j]; A1[j] = N1[j]; }
        }
    }
    __syncthreads();
    if (t0 < 256) {
#pragma unroll 1
        for (int qq = 0; qq < 2; ++qq) { const int q = 2 * w + qq, nvalid = t0 + q + 1; LAS unsigned short* list = LIST + q * 256;
            for (int i = lane; i < 256; i += 64) list[i] = (unsigned short)(i < nvalid ? i : 0); }
    } else {
#ifndef REP_S2
#define REP_S2 1
#endif
        LAS unsigned* hist = (LAS unsigned*)(F.lds + AUX_OFF + 8192) + w * 512;
        u32x4 hb0[2];
        hb0[0] = *(const LAS u32x4*)(hist + 4 * lane); hb0[1] = *(const LAS u32x4*)(hist + 256 + 4 * lane);
#pragma unroll 1
        for (int qq = 0; qq < 2 * REP_S2; ++qq) {
            const int q = 2 * w + (qq & 1), nvalid = t0 + q + 1;
            LAS unsigned short* list = LIST + q * 256;
            const int ngrp = (nvalid + 511) >> 9;
            unsigned P[32];
#pragma unroll
            for (int grp = 0; grp < 8; ++grp) {
                if (grp < ngrp) { const u32x4 r = *(const LAS u32x4*)(K16 + q * 8192 + grp * 1024 + lane * 16);
#pragma unroll
                    for (int i = 0; i < 4; ++i) { const int g = 4 * grp + i; const int thr = nvalid - 128 * g; unsigned rr = r[i];
                        if (thr < 128) rr &= ((lane < thr) ? 0xffffu : 0u) | ((lane < thr - 64) ? 0xffff0000u : 0u);
                        P[g] = rr; }
                } else {
#pragma unroll
                    for (int i = 0; i < 4; ++i) P[4 * grp + i] = 0u;
                }
            }
            unsigned one2 = 0x00010001u; asm volatile("" : "+v"(one2));
#define DSA_PKCOUNT(dst, c1) do { const unsigned c1p_ = (c1) | ((c1) << 16); unsigned a_ = 0u; \
                _Pragma("unroll") for (int grp = 0; grp < 8; ++grp) if (grp < ngrp) { _Pragma("unroll") for (int i = 0; i < 4; ++i) { unsigned y_; \
                    asm("v_pk_sub_u16 %0, %1, %2 clamp\n\tv_pk_min_u16 %0, %0, %3" : "=&v"(y_) : "v"(P[4 * grp + i]), "v"(c1p_), "v"(one2)); a_ += y_; } } \
                dst = (int)((a_ & 0xffffu) + (a_ >> 16)); } while (0)
            LAS unsigned* histl = hist + (lane & 1) * 256;
            unsigned T; int tot_gt;
            { unsigned hi8 = 0u; int above = 0;
#pragma unroll
              for (int lvl = 0; lvl < 2; ++lvl) {
                  u32x4 hb;
                  if (lvl == 0) hb = (qq & 1) ? hb0[1] : hb0[0];
                  else {
                      { unsigned z_ = 0u; asm volatile("" : "+v"(z_)); *(LAS u32x4*)(hist + 4 * lane) = (u32x4){z_, z_, z_, z_}; *(LAS u32x4*)(hist + 256 + 4 * lane) = (u32x4){z_, z_, z_, z_}; }
                      asm volatile("s_waitcnt lgkmcnt(0)" ::: "memory");
#pragma unroll
                      for (int grp = 0; grp < 8; ++grp) if (grp < ngrp) {
#pragma unroll
                          for (int i = 0; i < 4; ++i) { const unsigned lo = P[4 * grp + i] & 0xffffu, hi = P[4 * grp + i] >> 16;
                              if ((lo >> 8) == hi8) __hip_atomic_fetch_add(histl + (lo & 0xffu), 1u, __ATOMIC_RELAXED, __HIP_MEMORY_SCOPE_WAVEFRONT);
                              if ((hi >> 8) == hi8) __hip_atomic_fetch_add(histl + (hi & 0xffu), 1u, __ATOMIC_RELAXED, __HIP_MEMORY_SCOPE_WAVEFRONT); } }
                      asm volatile("s_waitcnt lgkmcnt(0)" ::: "memory");
                      hb = *(const LAS u32x4*)(hist + 4 * lane) + *(const LAS u32x4*)(hist + 256 + 4 * lane);
                      { unsigned z_ = 0u; asm volatile("" : "+v"(z_)); *(LAS u32x4*)(hist + 4 * lane) = (u32x4){z_, z_, z_, z_}; *(LAS u32x4*)(hist + 256 + 4 * lane) = (u32x4){z_, z_, z_, z_}; }
                  }
                  const int sl = (int)(hb.x + hb.y + hb.z + hb.w);
                  int inc = sl;
                  inc += __builtin_amdgcn_update_dpp(0, inc, 0x111, 0xf, 0xf, false); inc += __builtin_amdgcn_update_dpp(0, inc, 0x112, 0xf, 0xf, false);
                  inc += __builtin_amdgcn_update_dpp(0, inc, 0x114, 0xf, 0xf, false); inc += __builtin_amdgcn_update_dpp(0, inc, 0x118, 0xf, 0xf, false);
                  const int r0 = __builtin_amdgcn_readlane(inc, 15), r1 = __builtin_amdgcn_readlane(inc, 31), r2 = __builtin_amdgcn_readlane(inc, 47), r3 = __builtin_amdgcn_readlane(inc, 63);
                  inc += (fq >= 1 ? r0 : 0) + (fq >= 2 ? r1 : 0) + (fq >= 3 ? r2 : 0);
                  const int total = r0 + r1 + r2 + r3;
                  const int want = 256 - above;
                  int run = total - inc;
                  int fb = -1, fa = 0;
                  { const int h3 = (int)hb.w, h2 = (int)hb.z, h1 = (int)hb.y, h0 = (int)hb.x;
                    if (run < want && run + h3 >= want) { fb = 3; fa = run; } run += h3;
                    if (run < want && run + h2 >= want) { fb = 2; fa = run; } run += h2;
                    if (run < want && run + h1 >= want) { fb = 1; fa = run; } run += h1;
                    if (run < want && run + h0 >= want) { fb = 0; fa = run; } }
                  const unsigned long long fm = __ballot(fb >= 0);
                  const int src = (int)__builtin_ctzll(fm);
                  const int bstar = __builtin_amdgcn_readlane(4 * lane + fb, src), abv = __builtin_amdgcn_readlane(fa, src);
                  if (lvl == 0) { hi8 = (unsigned)bstar; above = abv; } else { T = (hi8 << 8) | (unsigned)bstar; tot_gt = above + abv; }
              } }
            int cge_l, cgt_l; DSA_PKCOUNT(cge_l, T - 1u); DSA_PKCOUNT(cgt_l, T);
            const int tot_ge = wave_total_i(cge_l);
            const bool alltie = (tot_ge == 256);
            const int c_l = alltie ? cge_l : cgt_l; const unsigned thrT = alltie ? T : T + 1u;
            int inc = c_l;
            inc += __builtin_amdgcn_update_dpp(0, inc, 0x111, 0xf, 0xf, false); inc += __builtin_amdgcn_update_dpp(0, inc, 0x112, 0xf, 0xf, false);
            inc += __builtin_amdgcn_update_dpp(0, inc, 0x114, 0xf, 0xf, false); inc += __builtin_amdgcn_update_dpp(0, inc, 0x118, 0xf, 0xf, false);
            { const int r0 = __builtin_amdgcn_readlane(inc, 15), r1 = __builtin_amdgcn_readlane(inc, 31), r2 = __builtin_amdgcn_readlane(inc, 47);
              inc += (fq >= 1 ? r0 : 0) + (fq >= 2 ? r1 : 0) + (fq >= 3 ? r2 : 0); }
            int kpos_ = inc - c_l;
#pragma unroll
            for (int grp = 0; grp < 8; ++grp) if (grp < ngrp) {
#pragma unroll
                for (int i = 0; i < 4; ++i) { const int g = 4 * grp + i; const unsigned lo = P[g] & 0xffffu, hi = P[g] >> 16;
                    if (lo >= thrT) { list[kpos_] = (unsigned short)(128 * g + lane); ++kpos_; }
                    if (hi >= thrT) { list[kpos_] = (unsigned short)(128 * g + 64 + lane); ++kpos_; } } }
            if (!alltie) {
                int rem = 256 - tot_gt, pos = tot_gt; const unsigned long long lt = (1ull << lane) - 1ull;
#pragma unroll
                for (int grp = 0; grp < 8; ++grp) if (grp < ngrp) {
#pragma unroll
                    for (int i = 0; i < 8; ++i) { const int g = 4 * grp + (i >> 1); const unsigned val = (i & 1) ? (P[g] >> 16) : (P[g] & 0xffffu);
                        const bool eq = (val == T); const unsigned long long beq = __ballot(eq);
                        if (beq != 0ull) { const int rank = __popcll(beq & lt); if (eq && rank < rem) list[pos + rank] = (unsigned short)(128 * g + 64 * (i & 1) + lane);
                            const int n = __popcll(beq), take = n < rem ? n : rem; pos += take; rem -= take; } } }
            }
#undef DSA_PKCOUNT
        }
    }
    asm volatile("s_waitcnt lgkmcnt(0)" ::: "memory");
    LAS unsigned char* Vs = F.lds + w * 16384;
#ifndef REP_S3
#define REP_S3 1
#endif
#pragma unroll 1
    for (int qq = 0; qq < 2 * REP_S3; ++qq) {
        const int q = 2 * w + (qq & 1), tq = t0 + q; const int nsel = (tq + 1 < 256) ? tq + 1 : 256;
        const size_t nq = nb0 + tq;
        const LAS unsigned short* list = LIST + q * 256;
        bf16x8 Qf[2];
#pragma unroll
        for (int ks = 0; ks < 2; ++ks) { u32x4 raw = {0u, 0u, 0u, 0u}; if (fr < 8) raw = *(const GAS u32x4*)(PA + nq * NPA + PA_Q + fr * 64 + 8 * fq + 32 * ks); Qf[ks] = __builtin_bit_cast(bf16x8, raw); }
        float lg[16][4];
#ifdef REP_S3K
#pragma unroll 1
        for (int repk = 0; repk < REP_S3K; ++repk)
#endif
        const int st_off = (lane >> 3) * 128 + (((lane & 7) ^ ((lane >> 3) & 7)) * 16);
        const int rd0 = fr * 128 + ((fq ^ (fr & 7)) * 16), rd1 = fr * 128 + (((fq + 4) ^ (fr & 7)) * 16);
#pragma unroll
        for (int hb = 0; hb < 2; ++hb) {
#pragma unroll
            for (int ib = 0; ib < 2; ++ib) { u32x4 kv[8];
#pragma unroll
                for (int i = 0; i < 8; ++i) { const int piece = (8 * ib + i) * 64 + lane; const int key = (int)list[128 * hb + (piece >> 3)];
                    kv[i] = *(const GAS u32x4*)(KA + (nb0 + key) * 64 + 8 * (lane & 7)); }
                __builtin_amdgcn_sched_barrier(0);
#pragma unroll
                for (int i = 0; i < 8; ++i) *(LAS u32x4*)(Vs + st_off + (8 * ib + i) * 1024) = kv[i];
            }
            asm volatile("s_waitcnt lgkmcnt(0)" ::: "memory");
#pragma unroll
            for (int j = 0; j < 8; ++j) { const int tt = 8 * hb + j;
                const bf16x8 A0 = *(const LAS bf16x8*)(Vs + rd0 + j * 2048), A1 = *(const LAS bf16x8*)(Vs + rd1 + j * 2048);
                f32x4 d = __builtin_amdgcn_mfma_f32_16x16x32_bf16(A0, Qf[0], (f32x4){0.f, 0.f, 0.f, 0.f}, 0, 0, 0);
                d = __builtin_amdgcn_mfma_f32_16x16x32_bf16(A1, Qf[1], d, 0, 0, 0);
#pragma unroll
                for (int r = 0; r < 4; ++r) lg[tt][r] = (16 * tt + 4 * fq + r < nsel) ? d[r] : -INFINITY; }
            asm volatile("s_waitcnt lgkmcnt(0)" ::: "memory");
        }
        float m = lg[0][0];
#pragma unroll
        for (int tt = 0; tt < 16; ++tt)
#pragma unroll
            for (int r = 0; r < 4; ++r) m = fmaxf(m, lg[tt][r]);
        m = fmaxf(m, shx(m, 16, lane)); m = fmaxf(m, shx(m, 32, lane));
        float den = 0.f;
#pragma unroll
        for (int tt = 0; tt < 16; ++tt)
#pragma unroll
            for (int r = 0; r < 4; ++r) { lg[tt][r] = __expf(lg[tt][r] - m); den += lg[tt][r]; }
        den += shx(den, 16, lane); den += shx(den, 32, lane);
        f32x4 acc[4];
#pragma unroll
        for (int nt = 0; nt < 4; ++nt) acc[nt] = (f32x4){0.f, 0.f, 0.f, 0.f};
#ifdef REP_S3V
#pragma unroll 1
        for (int repv = 0; repv < REP_S3V; ++repv) {
#pragma unroll
        for (int nt = 0; nt < 4; ++nt) acc[nt] = (f32x4){0.f, 0.f, 0.f, 0.f};
#endif
#pragma unroll
        for (int hh = 0; hh < 2; ++hh) {
#pragma unroll
            for (int ib = 0; ib < 2; ++ib) {
                u32x4 vv[8];
#pragma unroll
                for (int i = 0; i < 8; ++i) { const int piece = (8 * ib + i) * 64 + lane, row = piece >> 3, c = piece & 7; const int key = (int)list[128 * hh + row];
                    vv[i] = *(const GAS u32x4*)(VA + (nb0 + key) * 64 + 8 * c); }
                __builtin_amdgcn_sched_barrier(0);
#pragma unroll
                for (int i = 0; i < 8; ++i) { const int piece = (8 * ib + i) * 64 + lane; *(LAS u32x4*)(Vs + piece * 16) = vv[i]; }
            }
            asm volatile("s_waitcnt lgkmcnt(0)" ::: "memory");
#pragma unroll
            for (int s4 = 0; s4 < 4; ++s4) { const int s = 4 * hh + s4;
                u32x4 pa; pa.x = cvt_pk_bf16(lg[2 * s][0], lg[2 * s][1]); pa.y = cvt_pk_bf16(lg[2 * s][2], lg[2 * s][3]); pa.z = cvt_pk_bf16(lg[2 * s + 1][0], lg[2 * s + 1][1]); pa.w = cvt_pk_bf16(lg[2 * s + 1][2], lg[2 * s + 1][3]);
                const bf16x8 Pa = __builtin_bit_cast(bf16x8, pa);
                const int rowa = 32 * s4 + 4 * fq + (fr >> 2);
#pragma unroll
                for (int nt = 0; nt < 4; ++nt) {
                    const v4i16_t lo = __builtin_amdgcn_ds_read_tr16_b64_v4i16((LAS v4i16_t*)(Vs + rowa * 128 + (16 * nt + 4 * (fr & 3)) * 2));
                    const v4i16_t hi = __builtin_amdgcn_ds_read_tr16_b64_v4i16((LAS v4i16_t*)(Vs + (rowa + 16) * 128 + (16 * nt + 4 * (fr & 3)) * 2));
                    bf16x8 Bv; Bv[0] = lo[0]; Bv[1] = lo[1]; Bv[2] = lo[2]; Bv[3] = lo[3]; Bv[4] = hi[0]; Bv[5] = hi[1]; Bv[6] = hi[2]; Bv[7] = hi[3];
                    acc[nt] = __builtin_amdgcn_mfma_f32_16x16x32_bf16(Bv, Pa, acc[nt], 0, 0, 0); } }
            asm volatile("s_waitcnt lgkmcnt(0)" ::: "memory");
        }
#ifdef REP_S3V
        }
#endif
        if (fr < 8) { const float rden = 1.f / den;
#pragma unroll
            for (int nt = 0; nt < 4; ++nt) { u32x2 wv; wv.x = pk2(acc[nt][0] * rden, acc[nt][1] * rden); wv.y = pk2(acc[nt][2] * rden, acc[nt][3] * rden);
                *(GAS u32x2*)(Y + nq * 1536 + fr * 64 + 16 * nt + 4 * fq) = wv; } }
    }
}

#ifdef GLA_NAIVE
constexpr int NGLA = 32;
#else
constexpr int NGLA = 2048;
#endif
#ifdef DSA_NAIVE
constexpr int NDSA = 4096;
#else
constexpr int NDSA = 2048;
#endif
#ifdef GMLP_NAIVE
constexpr int NGM = 1024;
#else
constexpr int NGM = 256;
#endif
__device__ __forceinline__ void phase_mixer(Frame& F, int l, int slot = 0, int types = 7, bool dry = false) {
    (void)slot;
    for (int i = F.tid; i < 4096; i += 512) ((LAS unsigned*)(F.lds + AUX_OFF + 8192))[i] = 0u;
    for (int j = 0; j * F.G < NDSA; ++j) { const int u = j * F.G + ((j & 1) ? (F.G - 1 - F.wg) : F.wg);
        if (u >= NDSA) continue;
        __syncthreads(); if (EN_B2 && (types & 2)) {
#ifdef DSA_NAIVE
        dsa_unit(F, u);
#else
        dsa16_unit(F, u);
#endif
    } }
    for (int u = F.wg; u < NGLA; u += F.G) { __syncthreads(); if (EN_B1 && (types & 1)) {
#ifdef GLA_NAIVE
        gla_unit(F, l, u);
#else
        gla_local_unit(F, l, u, dry);
#endif
    } }
    for (int u = F.wg; u < NGM; u += F.G) { __syncthreads(); if (EN_B3 && (types & 4)) {
#ifdef GMLP_NAIVE
        gmlp_unit(F, l, u);
#else
        gmlp16_unit(F, l, u);
#endif
    } }
}
__device__ __forceinline__ void phase_gla_out(Frame& F, int l, bool dry = false) {
#ifndef GLA_NAIVE
    const int lane = fresh_lane(), w = F.wave, tid = w * 64 + lane, fr = lane & 15, fq = lane >> 4;
    GlaOutRegs R, N;
    if (F.wg < 2048) gla_out_load(F, F.wg, tid, w, fr, fq, R);
#pragma unroll 1
    for (int u = F.wg; u < 2048; u += F.G) { const int un = (u + F.G < 2048) ? u + F.G : u;
        gla_out_load(F, un, tid, w, fr, fq, N);
        gla_out_compute(F, l, u, tid, lane, w, fr, fq, R, dry);
        R = N; }
#endif
}

template <int CTRL> __device__ __forceinline__ float dpp_add(float v) { return v + dppf<CTRL>(v); }
__device__ __forceinline__ float row16_sum(float v) { v = dpp_add<0xB1>(v); v = dpp_add<0x4E>(v); v = dpp_add<0x141>(v); v = dpp_add<0x140>(v); return v; }
__device__ __forceinline__ void phase_ln_router(Frame& F, int l) {
    const GAS bf16* WRB = (const GAS bf16*)(F.ws + WS_WR) + (size_t)l * 48 * DM;
    LAS unsigned char* WB = F.lds;
    for (int i = F.tid; i < 48 * 128; i += 512) { const int n = i >> 7, c = i & 127; *(LAS u32x4*)(WB + n * 2048 + ((c ^ (n & 7)) * 16)) = *(const GAS u32x4*)(WRB + n * DM + 8 * c); }
    if (F.tid < 32) F.MISC[16 + F.tid] = 0u;
    __syncthreads();
    GAS bf16* HB = (GAS bf16*)(F.ws + WS_HB); const GAS bf16* T = (const GAS bf16*)F.H; GAS int* EID = (GAS int*)(F.ws + WS_ROUTE); GAS float* EW = (GAS float*)(F.ws + WS_ROUTE + 256 * 1024);
    const GAS float* g = ((const GAS float*)F.in[17]) + l * DM; const GAS float* bb = ((const GAS float*)F.in[18]) + l * DM; const GAS float* brg = ((const GAS float*)F.in[20]) + l * 4; const GAS float* bre = ((const GAS float*)F.in[22]) + l * 32;
    const int lane = fresh_lane();
    const int sub = lane & 15, rr = lane >> 4, fr = sub, fq = rr;
    LAS float* LG = (LAS float*)(F.lds + 98304) + F.wave * 768;
    for (int r0 = F.wg * 128; r0 < NTOK; r0 += F.G * 128) {
        const int m0 = r0 + F.wave * 16;
        u32x4 nx[8];
#pragma unroll
        for (int q = 0; q < 8; ++q) nx[q] = *(const GAS u32x4*)(T + (size_t)(m0 + rr) * DM + 8 * (sub + 16 * q));
#pragma unroll 1
        for (int j = 0; j < 4; ++j) { const int m = m0 + 4 * j + rr;
            float v[64]; float s = 0.f;
#pragma unroll
            for (int q = 0; q < 8; ++q) { const u32x4 x = nx[q]; v[8 * q] = bflo(x.x); v[8 * q + 1] = bfhi(x.x); v[8 * q + 2] = bflo(x.y); v[8 * q + 3] = bfhi(x.y); v[8 * q + 4] = bflo(x.z); v[8 * q + 5] = bfhi(x.z); v[8 * q + 6] = bflo(x.w); v[8 * q + 7] = bfhi(x.w); }
            { const int mn = (j < 3) ? m + 4 : m;
#pragma unroll
              for (int q = 0; q < 8; ++q) nx[q] = *(const GAS u32x4*)(T + (size_t)mn * DM + 8 * (sub + 16 * q)); }
#pragma unroll
            for (int i = 0; i < 64; ++i) s += v[i];
            const float mean = row16_sum(s) * (1.f / DM); float s2 = 0.f;
#pragma unroll
            for (int i = 0; i < 64; ++i) { v[i] -= mean; s2 += v[i] * v[i]; }
            const float rstd = 1.f / sqrtf(row16_sum(s2) * (1.f / DM) + LN_EPS);
#pragma unroll
            for (int q = 0; q < 8; ++q) { const int c = 8 * (sub + 16 * q); const f32x4 g0 = *(const GAS f32x4*)(g + c), g1 = *(const GAS f32x4*)(g + c + 4), b0 = *(const GAS f32x4*)(bb + c), b1 = *(const GAS f32x4*)(bb + c + 4);
#pragma unroll
                for (int i = 0; i < 4; ++i) { v[8 * q + i] = v[8 * q + i] * rstd * g0[i] + b0[i]; v[8 * q + 4 + i] = v[8 * q + 4 + i] * rstd * g1[i] + b1[i]; }
                u32x4 wv; wv.x = pk2(v[8 * q], v[8 * q + 1]); wv.y = pk2(v[8 * q + 2], v[8 * q + 3]); wv.z = pk2(v[8 * q + 4], v[8 * q + 5]); wv.w = pk2(v[8 * q + 6], v[8 * q + 7]);
                *(GAS u32x4*)(HB + (size_t)m * DM + c) = wv; } }
        asm volatile("s_waitcnt vmcnt(0)" ::: "memory");
        f32x4 acc[3];
#pragma unroll
        for (int nt = 0; nt < 3; ++nt) acc[nt] = (f32x4){0.f, 0.f, 0.f, 0.f};
#pragma unroll 1
        for (int kb = 0; kb < 4; ++kb) {
            bf16x8 af[8];
#pragma unroll
            for (int ks = 0; ks < 8; ++ks) af[ks] = *(const GAS bf16x8*)(HB + (size_t)(m0 + fr) * DM + 8 * fq + 32 * (8 * kb + ks));
#pragma unroll
            for (int ks = 0; ks < 8; ++ks) { const int c = fq + 4 * (8 * kb + ks);
#pragma unroll
                for (int nt = 0; nt < 3; ++nt) { const int n = 16 * nt + fr; const bf16x8 bw = *(const LAS bf16x8*)(WB + n * 2048 + ((c ^ (n & 7)) * 16));
                    acc[nt] = __builtin_amdgcn_mfma_f32_16x16x32_bf16(af[ks], bw, acc[nt], 0, 0, 0); } } }
#pragma unroll
        for (int nt = 0; nt < 3; ++nt)
#pragma unroll
            for (int r = 0; r < 4; ++r) LG[(4 * fq + r) * 48 + 16 * nt + fr] = acc[nt][r];
        asm volatile("s_waitcnt lgkmcnt(0)" ::: "memory");
        if (lane < 16) { const int m = m0 + lane; const LAS float* lgt = LG + lane * 48;
            int gi = 0; float gm = lgt[0] + brg[0];
#pragma unroll
            for (int q = 1; q < 4; ++q) { const float x = lgt[q] + brg[q]; if (x > gm) { gm = x; gi = q; } }
            float gs = 0.f;
#pragma unroll
            for (int q = 0; q < 4; ++q) gs += __expf(lgt[q] + brg[q] - gm);
            const float gp = 1.f / gs;
            float el[8];
#pragma unroll
            for (int q = 0; q < 8; ++q) el[q] = lgt[4 + 8 * gi + q] + bre[8 * gi + q];
            int i0 = 0; float v0 = el[0];
#pragma unroll
            for (int q = 1; q < 8; ++q) if (el[q] > v0) { v0 = el[q]; i0 = q; }
            int i1 = -1; float v1 = -INFINITY;
#pragma unroll
            for (int q = 0; q < 8; ++q) if (q != i0 && el[q] > v1) { v1 = el[q]; i1 = q; }
            const float ex = __expf(v1 - v0), w0 = gp / (1.f + ex), w1 = gp * ex / (1.f + ex);
            const int e0 = gi * 8 + i0, e1 = gi * 8 + i1;
            EID[2 * m] = e0; EID[2 * m + 1] = e1; EW[2 * m] = w0; EW[2 * m + 1] = w1;
            __hip_atomic_fetch_add((LAS unsigned*)(F.lds + MISC_OFF) + 16 + e0, 1u, __ATOMIC_RELAXED, __HIP_MEMORY_SCOPE_WORKGROUP);
            __hip_atomic_fetch_add((LAS unsigned*)(F.lds + MISC_OFF) + 16 + e1, 1u, __ATOMIC_RELAXED, __HIP_MEMORY_SCOPE_WORKGROUP); }
        asm volatile("s_waitcnt lgkmcnt(0)" ::: "memory");
    }
    __syncthreads();
    if (F.tid < 32) ((GAS int*)(F.ws + WS_CNTWG))[F.wg * 32 + F.tid] = (int)F.MISC[16 + F.tid];
}
__device__ __forceinline__ void phase_dispatch(Frame& F) {
    const GAS int* CNT = (const GAS int*)(F.ws + WS_CNTWG); const GAS int* EID = (const GAS int*)(F.ws + WS_ROUTE); const GAS float* EW = (const GAS float*)(F.ws + WS_ROUTE + 256 * 1024);
    GAS int* SROW = (GAS int*)(F.ws + WS_SROW); GAS int* ROWMAP = (GAS int*)(F.ws + WS_ROWMAP); GAS float* CWROW = (GAS float*)(F.ws + WS_CWROW); GAS int* META = (GAS int*)(F.ws + WS_META);
    LAS int* tot = (LAS int*)(F.lds + AUX_OFF);
    { const int e = F.tid & 31, part = F.tid >> 5; int t = 0, mine = 0;
      int cv[16];
#pragma unroll
      for (int j = 0; j < 16; ++j) { const int w = part * 16 + j; cv[j] = (w < F.G) ? ld_i32(CNT + w * 32 + e) : 0; }
#pragma unroll
      for (int j = 0; j < 16; ++j) { const int w = part * 16 + j; t += cv[j]; mine += (w < F.wg) ? cv[j] : 0; }
      tot[160 + F.tid] = t; tot[160 + 512 + F.tid] = mine; }
    __syncthreads();
    if (F.tid < 32) { int t = 0, mine = 0;
#pragma unroll
        for (int p = 0; p < 16; ++p) { t += tot[160 + p * 32 + F.tid]; mine += tot[160 + 512 + p * 32 + F.tid]; }
        tot[F.tid] = t; tot[32 + F.tid] = mine; tot[96 + F.tid] = 0; }
    __syncthreads();
    if (F.tid == 0) { int rb = 0;
#pragma clang loop unroll(disable) vectorize(disable)
        for (int e = 0; e < 32; ++e) { tot[64 + e] = rb; rb += ((tot[e] + 255) >> 8) << 8; }
        tot[128] = rb; }
    __syncthreads();
    if (F.wg == 0) { const int nt = tot[128] >> 8; if (F.tid == 0) META[0] = nt;
        if (F.tid < nt) { int e = 0;
#pragma clang loop unroll(disable) vectorize(disable)
            for (int q = 1; q < 32; ++q) if (tot[64 + q] <= F.tid * 256) e = q;
            META[16 + F.tid] = e; } }
    for (int r0 = F.wg * 128; r0 < NTOK; r0 += F.G * 128) {
        if (F.tid < 256) { const int tok = r0 + (F.tid >> 1), slot = F.tid & 1; const int e = EID[2 * tok + slot];
            const int pos = (int)__hip_atomic_fetch_add((LAS unsigned*)&tot[96 + e], 1u, __ATOMIC_RELAXED, __HIP_MEMORY_SCOPE_WORKGROUP);
            const int sr = tot[64 + e] + tot[32 + e] + pos;
            ROWMAP[sr] = tok; CWROW[sr] = EW[2 * tok + slot]; SROW[2 * tok + slot] = sr; } }
    if (F.wg < 32) { const int e = F.wg; const int lo = tot[64 + e] + tot[e], hi = tot[64 + e] + (((tot[e] + 255) >> 8) << 8);
        for (int r = lo + F.tid; r < hi; r += 512) { ROWMAP[r] = 0; CWROW[r] = 0.f; } }
}
__device__ __forceinline__ void phase_ln2(Frame& F, int l, bool dry = false) {
    GAS bf16* HB = (GAS bf16*)(F.ws + WS_HB); GAS bf16* HBo = dry ? (GAS bf16*)(F.ws + WS_Y) : HB; GAS float* Ho = dry ? (GAS float*)(F.ws + WS_PA + 184 * MiB) : F.H; const GAS int* SROW = (const GAS int*)(F.ws + WS_SROW); const GAS bf16* FF2 = (const GAS bf16*)(F.ws + WS_FF2);
    const GAS float* g = ((const GAS float*)F.in[26]) + l * DM; const GAS float* bb = ((const GAS float*)F.in[27]) + l * DM; int lane = F.lane; asm volatile("" : "+v"(lane));
    const int gw = F.wg * 8 + F.wave, NGW = F.G * 8; const bool last = (l == DEPTH - 1);
    const int nrow = (NTOK - gw + NGW - 1) / NGW;
    const int srv = (2 * (gw + (lane >> 1) * NGW) + (lane & 1) < 2 * NTOK) ? ld_i32(SROW + 2 * (gw + (lane >> 1) * NGW) + (lane & 1)) : 0;
    u32x4 hn[2][2], an[2][2], cn[2][2];
#define LN2_ISSUE(jj, slot) do { const int j_ = (jj); if (j_ < nrow) { const int m_ = gw + j_ * NGW; const int s0_ = __builtin_amdgcn_readlane(srv, 2 * j_), s1_ = __builtin_amdgcn_readlane(srv, 2 * j_ + 1); \
        _Pragma("unroll") for (int q_ = 0; q_ < 2; ++q_) { hn[slot][q_] = *(const GAS u32x4*)(HB + (size_t)m_ * DM + 8 * lane + 512 * q_); an[slot][q_] = *(const GAS u32x4*)(FF2 + (size_t)s0_ * DM + 8 * lane + 512 * q_); cn[slot][q_] = *(const GAS u32x4*)(FF2 + (size_t)s1_ * DM + 8 * lane + 512 * q_); } } } while (0)
    LN2_ISSUE(0, 0); LN2_ISSUE(1, 1);
#pragma unroll 1
    for (int jr = 0; jr < nrow; jr += 2)
#pragma unroll
    for (int slot = 0; slot < 2; ++slot) { const int jrow = jr + slot; if (jrow >= nrow) break; const int m = gw + jrow * NGW;
        float v[16];
#pragma unroll
        for (int j = 0; j < 2; ++j) { const u32x4 h = hn[slot][j], a = an[slot][j], c = cn[slot][j];
            v[8 * j] = bflo(h.x) * DN_ALPHA + (bflo(a.x) + bflo(c.x)); v[8 * j + 1] = bfhi(h.x) * DN_ALPHA + (bfhi(a.x) + bfhi(c.x)); v[8 * j + 2] = bflo(h.y) * DN_ALPHA + (bflo(a.y) + bflo(c.y)); v[8 * j + 3] = bfhi(h.y) * DN_ALPHA + (bfhi(a.y) + bfhi(c.y));
            v[8 * j + 4] = bflo(h.z) * DN_ALPHA + (bflo(a.z) + bflo(c.z)); v[8 * j + 5] = bfhi(h.z) * DN_ALPHA + (bfhi(a.z) + bfhi(c.z)); v[8 * j + 6] = bflo(h.w) * DN_ALPHA + (bflo(a.w) + bflo(c.w)); v[8 * j + 7] = bfhi(h.w) * DN_ALPHA + (bfhi(a.w) + bfhi(c.w)); }
        LN2_ISSUE(jrow + 2, slot);
        float s = 0.f;
#pragma unroll
        for (int i = 0; i < 16; ++i) s += v[i];
        const float mean = wave_sum(s, lane) * (1.f / DM); float s2 = 0.f;
#pragma unroll
        for (int i = 0; i < 16; ++i) { v[i] -= mean; s2 += v[i] * v[i]; }
        const float rstd = 1.f / sqrtf(wave_sum(s2, lane) * (1.f / DM) + LN_EPS);
#pragma unroll
        for (int j = 0; j < 2; ++j) { const int c = 8 * lane + 512 * j; const f32x4 g0 = *(const GAS f32x4*)(g + c), g1 = *(const GAS f32x4*)(g + c + 4), b0 = *(const GAS f32x4*)(bb + c), b1 = *(const GAS f32x4*)(bb + c + 4);
#pragma unroll
            for (int i = 0; i < 4; ++i) { v[8 * j + i] = v[8 * j + i] * rstd * g0[i] + b0[i]; v[8 * j + 4 + i] = v[8 * j + 4 + i] * rstd * g1[i] + b1[i]; }
            if (last) { *(GAS f32x4*)(Ho + (size_t)m * DM + c) = (f32x4){v[8 * j], v[8 * j + 1], v[8 * j + 2], v[8 * j + 3]}; *(GAS f32x4*)(Ho + (size_t)m * DM + c + 4) = (f32x4){v[8 * j + 4], v[8 * j + 5], v[8 * j + 6], v[8 * j + 7]}; }
            else { u32x4 wv; wv.x = pk2(v[8 * j], v[8 * j + 1]); wv.y = pk2(v[8 * j + 2], v[8 * j + 3]); wv.z = pk2(v[8 * j + 4], v[8 * j + 5]); wv.w = pk2(v[8 * j + 6], v[8 * j + 7]); *(GAS u32x4*)(HBo + (size_t)m * DM + c) = wv; } }
    }
#undef LN2_ISSUE
}

#ifndef EN_P
#define EN_P 1
#endif
#ifndef EN_A
#define EN_A 1
#endif
#ifndef EN_B
#define EN_B 1
#endif
#ifndef EN_C
#define EN_C 1
#endif
#ifndef EN_D
#define EN_D 1
#endif
#ifndef EN_E
#define EN_E 1
#endif
#ifndef EN_F
#define EN_F 1
#endif
#ifndef EN_G
#define EN_G 1
#endif
#ifndef EN_H
#define EN_H 1
#endif
#ifndef EN_I
#define EN_I 1
#endif
#ifndef EN_J
#define EN_J 1
#endif
constexpr int PPL = 12;
constexpr int N_PHASES = 1 + PPL * DEPTH;
#ifndef MK_ONE_LAUNCH
#define MK_ONE_LAUNCH 0
#endif
struct Args { const float* in[28]; float* out; unsigned char* ws; int ph_lo, ph_hi; };
static_assert(sizeof(Args) == 28 * 8 + 8 + 8 + 8, "no padding bytes in the argument struct");


__device__ __forceinline__ unsigned opaque_u32(unsigned x) { unsigned v; asm volatile("v_mov_b32 %0, %1" : "=v"(v) : "s"(x)); return (unsigned)__builtin_amdgcn_readfirstlane((int)v); }
__device__ __forceinline__ unsigned long long opaque_u64(unsigned long long x) { return ((unsigned long long)opaque_u32((unsigned)(x >> 32)) << 32) | opaque_u32((unsigned)x); }
__device__ __forceinline__ void launder(Frame& F) {
    F.ws = (GAS unsigned char*)opaque_u64((unsigned long long)F.ws); F.H = (GAS float*)opaque_u64((unsigned long long)F.H);
    F.ctl = (gu32*)opaque_u64((unsigned long long)F.ctl);
    unsigned z0 = 0u; asm volatile("" : "+v"(z0)); int ln = (int)__builtin_amdgcn_mbcnt_hi(~0u, __builtin_amdgcn_mbcnt_lo(~0u, z0));
    F.wave = (int)opaque_u32((unsigned)F.wave); F.lane = ln; F.tid = F.wave * 64 + ln;
    F.G = (int)opaque_u32((unsigned)F.G); F.wg = (int)opaque_u32((unsigned)F.wg);
}
#ifndef SG_N
#define SG_N 1
#endif
#ifndef SG_US
#define SG_US 0
#endif
__device__ __forceinline__ void gemm_stagger(const Frame& F) {
    if (SG_N > 1) { const int g = (F.wg >> 3) & (SG_N - 1);
        if (g) { const unsigned long long t0 = __builtin_amdgcn_s_memrealtime(), dt = (unsigned long long)(g * SG_US * 100); while (__builtin_amdgcn_s_memrealtime() - t0 < dt) __builtin_amdgcn_s_sleep(4); } }
}
__global__ void __launch_bounds__(512, 2) mk_fwd(Args args) {
    extern __shared__ __attribute__((aligned(16))) unsigned char lds_raw[];
    Frame F;
    F.lds = (LAS unsigned char*)lds_raw;
    F.MISC = (volatile LAS unsigned*)(F.lds + MISC_OFF);
    F.tid = threadIdx.x; F.lane = F.tid & 63; F.wave = __builtin_amdgcn_readfirstlane(F.tid >> 6);
    F.G = gridDim.x; F.wg = blockIdx.x;
    F.in = args.in;
    F.pos = (const GAS int*)args.in[1];
    F.H = (GAS float*)args.out; F.ws = (GAS unsigned char*)args.ws;
    F.ctl = (gu32*)(args.ws + WS_CTL);
    for (int u = F.tid; u < (LDS_BYTES - MISC_OFF) / 4; u += 512) ((LAS unsigned*)(F.lds + MISC_OFF))[u] = 0u;
    __syncthreads();
    const int lo = args.ph_lo, hi = args.ph_hi;
    const bool multi = (hi - lo) > 1;
    XcdBarrier bar; bar.bar = (unsigned*)(F.ctl + CW_BAR); bar.x = 0; bar.st = nullptr;
    if (multi) bar = xcd_barrier_post((unsigned*)(F.ctl + CW_BAR), F.MISC + 8);
#define IN(k) (lo <= (k) && (k) < hi)
#ifdef DUP_BARRIER
#define SEAM(k) do { if (IN(k) && IN((k) + 1)) { xcd_barrier(bar); xcd_barrier(bar); } } while (0)
#else
#define SEAM(k) do { if (IN(k) && IN((k) + 1)) xcd_barrier(bar); } while (0)
#endif

#ifdef DUP_P
    for (int rep = 0; rep < 2; ++rep)
#endif
    if (EN_P && IN(0)) { launder(F); phase_prologue(F); }
    SEAM(0);
#define HB ((GAS bf16*)(F.ws + WS_HB))
#define PA ((GAS bf16*)(F.ws + WS_PA))
#define Y ((GAS bf16*)(F.ws + WS_Y))
#define HM ((GAS bf16*)F.H + (size_t)NTOK * DM)
#define TT ((GAS bf16*)F.H)
    for (int l = 0; l < DEPTH; ++l) {
        const int pb = 1 + PPL * l;
#define wd (F.ws + WS_WDENSE + (size_t)l * WD_LAYER)
#ifdef DUP_A
        for (int rep = 0; rep < 2; ++rep)
#endif
        if (EN_A && IN(pb + 0)) { launder(F);
            DenseSched S; S.init(NTOK / 256, NPA / 256, F.G, F.wg, (const void*)HB, (size_t)256 * DM * 2, (const void*)(wd + WD_WA), (size_t)256 * DM * 2);
            EpiA E{PA, (GAS bf16*)(F.ws + WS_KA), (GAS bf16*)(F.ws + WS_VA), (GAS bf16*)(F.ws + WS_KI), (GAS float*)(F.ws + WS_WI), (GAS float*)(F.ws + WS_GLR), (const GAS float*)(F.ws + WS_ROPE), ((const GAS float*)F.in[5]) + l * 64};
#ifdef DUP_ANONE
            { EpiNoneA E0{PA}; pg8::gemm_phase<EpiNoneA, DenseSched, false>(F.lds, S, E0, DM, DM, F.wave); }
#endif
#ifdef DUP_APLAIN
            { EpiPlainA E0{PA}; pg8::gemm_phase<EpiPlainA, DenseSched, false>(F.lds, S, E0, DM, DM, F.wave); }
#endif
            gemm_stagger(F);
            pg8::gemm_phase<EpiA, DenseSched, false>(F.lds, S, E, DM, DM, F.wave);
        }
        SEAM(pb + 0);
        if (EN_B && IN(pb + 1)) { launder(F);
#ifdef DUP_B
            phase_mixer(F, l, 1, DUP_B, true); launder(F);
#endif
            phase_mixer(F, l); }
        SEAM(pb + 1);
        if (EN_B && IN(pb + 2)) { launder(F);
#ifdef DUP_SCAN
            gla_scan_phase(F, true); launder(F);
#endif
            gla_scan_phase(F); }
        SEAM(pb + 2);
        if (EN_B && IN(pb + 3)) { launder(F);
#ifdef DUP_OUT
            phase_gla_out(F, l, true); launder(F);
#endif
            phase_gla_out(F, l); }
        SEAM(pb + 3);
#ifdef DUP_D
        for (int rep = 0; rep < 2; ++rep)
#endif
        if (EN_D && IN(pb + 4)) { launder(F);
            DenseSched S; S.init(NTOK / 256, DM / 256, F.G, F.wg, (const void*)Y, (size_t)256 * 1536 * 2, (const void*)(wd + WD_WBR), (size_t)256 * 512 * 2);
            S.nsub = 3; S.asub = 512 * 2; S.bsub = (size_t)1024 * 512 * 2;
#ifdef DUP_DPAD
            { EpiPPad E0{PA}; pg8::gemm_phase<EpiPPad, DenseSched, false>(F.lds, S, E0, 512, 1536, F.wave); }
#endif
#ifdef DUP_DNONE
            { EpiNoneA E0{PA}; pg8::gemm_phase<EpiNoneA, DenseSched, false>(F.lds, S, E0, 512, 1536, F.wave); }
#endif
            gemm_stagger(F);
            EpiP E{PA};
            pg8::gemm_phase<EpiP, DenseSched, false>(F.lds, S, E, 512, 1536, F.wave);
        }
#ifdef DUP_C
        for (int rep = 0; rep < 2; ++rep)
#endif
        if (EN_C && IN(pb + 4)) { launder(F);
            DenseSched S; S.init(NTOK / 256, DM / 256, F.G, F.wg, (const void*)HB, (size_t)256 * DM * 2, (const void*)(wd + WD_WG), (size_t)256 * DM * 2);
            S.nsub = 3; S.asub = 0; S.bsub = (size_t)1024 * DM * 2;
#ifdef DUP_CNONE
            { EpiNoneA E0{PA}; pg8::gemm_phase<EpiNoneA, DenseSched, false>(F.lds, S, E0, DM, DM, F.wave); }
#endif
            EpiGM E{PA, HM};
            pg8::gemm_phase<EpiGM, DenseSched, false>(F.lds, S, E, DM, DM, F.wave);
        }
        SEAM(pb + 4);
#ifdef DUP_E
        for (int rep = 0; rep < 2; ++rep)
#endif
        if (EN_E && IN(pb + 6)) { launder(F);
            DenseSched S; S.init(NTOK / 256, DM / 256, F.G, F.wg, (const void*)HM, (size_t)256 * DM * 2, (const void*)(wd + WD_WOUT), (size_t)256 * DM * 2);
            EpiO E{HB, TT};
            gemm_stagger(F);
            pg8::gemm_phase<EpiO, DenseSched, false>(F.lds, S, E, DM, DM, F.wave);
        }
        SEAM(pb + 6);
#ifdef DUP_F
        for (int rep = 0; rep < 2; ++rep)
#endif
        if (EN_F && IN(pb + 7)) { launder(F); phase_ln_router(F, l); }
        SEAM(pb + 7);
#ifdef DUP_G
        for (int rep = 0; rep < 2; ++rep)
#endif
        if (EN_G && IN(pb + 8)) { launder(F);
            { LAS float* scr = (LAS float*)(F.lds + F.wave * 16384);
              conv_run<true>(F, l, 12288, scr);
              __syncthreads(); }
            phase_dispatch(F); }
        SEAM(pb + 8);
#ifdef DUP_H
        for (int rep = 0; rep < 2; ++rep)
#endif
        if (EN_H && IN(pb + 9)) { launder(F);
            const GAS int* META = (const GAS int*)(F.ws + WS_META); const GAS int* ROWMAP = (const GAS int*)(F.ws + WS_ROWMAP);
            LAS int* meta = (LAS int*)(F.lds + AUX_OFF); LAS int* rows = (LAS int*)(F.lds + AUX_OFF + 64);
            { int rv[3]; int mv = 0;
#pragma unroll
              for (int i = 0; i < 3; ++i) { const int gt0 = (i * F.G + F.wg) >> 1, gt = gt0 < MAXTILES ? gt0 : MAXTILES - 1; rv[i] = (F.tid < 256) ? ROWMAP[gt * 256 + F.tid] : 0; }
              if (F.tid < 3) { const int gt0 = (F.tid * F.G + F.wg) >> 1, gt = gt0 < MAXTILES ? gt0 : MAXTILES - 1; mv = ld_i32(META + 16 + gt); }
              if (F.tid < 3) meta[F.tid] = mv;
#pragma unroll
              for (int i = 0; i < 3; ++i) if (F.tid < 256) rows[i * 256 + F.tid] = rv[i]; }
            const int NT = ld_i32(META), NU = NT * 2;
            __syncthreads();
            GroupSched S{NU, F.G, F.wg, 2, (const char*)HB, (const char*)(F.ws + WS_WMOE + WM_GU), 0, (size_t)512 * DM * 2, (size_t)256 * DM * 2, meta, rows};
            EpiGU E{(GAS bf16*)(F.ws + WS_HID), (const GAS float*)(F.ws + WS_CWROW)};
            gemm_stagger(F);
            pg8::gemm_phase<EpiGU, GroupSched, true>(F.lds, S, E, DM, DM, F.wave);
        }
        SEAM(pb + 9);
#ifdef DUP_I
        for (int rep = 0; rep < 2; ++rep)
#endif
        if (EN_I && IN(pb + 10)) { launder(F);
            const GAS int* META = (const GAS int*)(F.ws + WS_META);
            LAS int* meta = (LAS int*)(F.lds + AUX_OFF);
            if (F.tid < 5) { const int gt0 = (F.tid * F.G + F.wg) >> 2, gt = gt0 < MAXTILES ? gt0 : MAXTILES - 1; meta[F.tid] = ld_i32(META + 16 + gt); }
            const int NT = ld_i32(META), NU = NT * 4;
            __syncthreads();
            GroupSched S{NU, F.G, F.wg, 4, (const char*)(F.ws + WS_HID), (const char*)(F.ws + WS_WMOE + WM_DN), (size_t)256 * DEXP * 2, (size_t)DM * DEXP * 2, (size_t)256 * DEXP * 2, meta, nullptr};
            EpiDN E{(GAS bf16*)(F.ws + WS_FF2)};
            gemm_stagger(F);
            pg8::gemm_phase<EpiDN, GroupSched, false>(F.lds, S, E, DEXP, DEXP, F.wave);
        }
        SEAM(pb + 10);
        if (EN_J && IN(pb + 11)) { launder(F);
#ifdef DUP_J
            phase_ln2(F, l, true); launder(F);
#endif
            phase_ln2(F, l); }
        SEAM(pb + 11);
    }
#undef IN
#undef SEAM
#undef HB
#undef HM
#undef TT
#undef PA
#undef Y
#undef wd
}


#ifdef DUMP_OFF
__global__ void dump_k(const unsigned short* src, float* out) {
    for (size_t i = (size_t)blockIdx.x * blockDim.x + threadIdx.x; i < (size_t)NTOK * 1024; i += (size_t)gridDim.x * blockDim.x) { const size_t n = i >> 10, c = i & 1023; out[i] = __builtin_bit_cast(float, ((unsigned)src[n * DUMP_PITCH + c]) << 16); }
}
#endif
extern "C" void kernel_launch(void* const* d_in, const int* in_sizes, int n_in, void* d_out, int out_size, void* d_ws, size_t ws_size, hipStream_t stream) {
    static int grid = 0;
    if (grid == 0) {
        if (n_in != 28 || out_size != NTOK * DM || ws_size < WS_END) { fprintf(stderr, "kernel_launch: unexpected shapes (n_in %d out %d ws %zu); nothing launched\n", n_in, out_size, ws_size); grid = -1; return; }
        int dev = 0, cus = 0;
        if (hipGetDevice(&dev) != hipSuccess || hipDeviceGetAttribute(&cus, hipDeviceAttributeMultiprocessorCount, dev) != hipSuccess) { grid = -1; return; }
        if (hipFuncSetAttribute((const void*)mk_fwd, hipFuncAttributeMaxDynamicSharedMemorySize, LDS_BYTES) != hipSuccess) { fprintf(stderr, "kernel_launch: hipFuncSetAttribute failed\n"); grid = -1; return; }
        int per_cu = 0;
        if (hipOccupancyMaxActiveBlocksPerMultiprocessor(&per_cu, (const void*)mk_fwd, 512, LDS_BYTES) != hipSuccess || per_cu < 1) { fprintf(stderr, "kernel_launch: occupancy query says %d\n", per_cu); }
        (void)hipGetLastError();
        grid = cus;
        if (grid != 256) fprintf(stderr, "kernel_launch: %d CUs (built for 256)\n", grid);
    }
    if (grid < 0) return;
    if (hipMemsetAsync((char*)d_ws + WS_CTL, 0, CTL_ZERO_BYTES, stream) != hipSuccess) return;
    Args a{};
    for (int i = 0; i < 28; ++i) a.in[i] = (const float*)d_in[i];
    a.out = (float*)d_out; a.ws = (unsigned char*)d_ws;
#if MK_ONE_LAUNCH
    a.ph_lo = 0; a.ph_hi = N_PHASES;
    hipLaunchKernelGGL(mk_fwd, dim3(grid), dim3(512), LDS_BYTES, stream, a);
#else
#ifndef STOP_AFTER
#define STOP_AFTER (N_PHASES - 1)
#endif
#ifndef PHASE_MASK
#define PHASE_MASK 0xffffffffu
#endif
    for (int p = 0; p <= STOP_AFTER; ++p) { if (!((PHASE_MASK >> p) & 1u)) continue; a.ph_lo = p; a.ph_hi = p + 1; hipLaunchKernelGGL(mk_fwd, dim3(grid), dim3(512), LDS_BYTES, stream, a); }
#ifdef DUMP_OFF
    hipLaunchKernelGGL(dump_k, dim3(2048), dim3(256), 0, stream, (const unsigned short*)((const char*)d_ws + (size_t)(DUMP_OFF)), (float*)d_out);
#endif
#endif
}
```

```cpp
#define MK_ONE_LAUNCH 1
#include <hip/hip_runtime.h>
#include <cstdio>
#include <cstdint>

#define LAS __attribute__((address_space(3)))
#define GAS __attribute__((address_space(1)))
typedef unsigned short bf16;
typedef short bf16x8 __attribute__((ext_vector_type(8)));
typedef float f32x4 __attribute__((ext_vector_type(4)));
typedef float f32x2 __attribute__((ext_vector_type(2)));
typedef unsigned u32x4 __attribute__((ext_vector_type(4)));
typedef unsigned u32x2 __attribute__((ext_vector_type(2)));
typedef GAS unsigned gu32;

constexpr int NB = 8, SEQ = 4096, NTOK = NB * SEQ, DM = 1024, NIN = 6612, DEPTH = 2;
constexpr int NPA = 3584;
constexpr int NGT = 3072;
constexpr int NEXP = 32, DEXP = 256;
constexpr int MAXTILES = 288;
constexpr float DN_ALPHA = 1.41421356237309515f;
constexpr float LN_EPS = 1e-5f, RMS_EPS = 1e-6f;
constexpr int PA_Q = 0, PA_QI = 768, PA_BQ = 1024, PA_BK = 1280, PA_BV = 1536, PA_BR = 2048, PA_CU = 2560, PA_CV = 3072;
__host__ __device__ constexpr int pa8(int c) { return 512 * (c >> 8) + (c & 255); }
constexpr int PA_ROWB = NPA * 2;

__device__ __forceinline__ unsigned f2bf(float f) { unsigned u = __builtin_bit_cast(unsigned, f); return (u + 0x7fffu + ((u >> 16) & 1u)) >> 16; }
__device__ __forceinline__ unsigned pk2(float lo, float hi) { return f2bf(lo) | (f2bf(hi) << 16); }
__device__ __forceinline__ float bflo(unsigned w) { return __builtin_bit_cast(float, w << 16); }
__device__ __forceinline__ float bfhi(unsigned w) { return __builtin_bit_cast(float, w & 0xffff0000u); }
__device__ __forceinline__ float bf1(bf16 h) { return __builtin_bit_cast(float, ((unsigned)h) << 16); }
typedef __bf16 bf16x2_t __attribute__((ext_vector_type(2)));
__device__ __forceinline__ unsigned cvt_pk_bf16(float lo, float hi) { const f32x2 v = {lo, hi}; const bf16x2_t b = __builtin_convertvector(v, bf16x2_t); return __builtin_bit_cast(unsigned, b); }
__device__ __forceinline__ unsigned pk4_fp8(float a, float b, float c, float d) { int p = __builtin_amdgcn_cvt_pk_fp8_f32(a, b, 0, false); p = __builtin_amdgcn_cvt_pk_fp8_f32(c, d, p, true); return (unsigned)p; }
__device__ __forceinline__ float shx(float v, int mask, int lane) { return __builtin_bit_cast(float, __builtin_amdgcn_ds_bpermute((lane ^ mask) << 2, __builtin_bit_cast(int, v))); }
__device__ __forceinline__ int shxi(int v, int mask, int lane) { return __builtin_amdgcn_ds_bpermute((lane ^ mask) << 2, v); }
__device__ __forceinline__ float wave_sum(float v, int lane) {
#pragma unroll
    for (int o = 1; o < 64; o <<= 1) v += shx(v, o, lane);
    return v;
}
__device__ __forceinline__ float wave_max(float v, int lane) {
#pragma unroll
    for (int o = 1; o < 64; o <<= 1) v = fmaxf(v, shx(v, o, lane));
    return v;
}
__device__ __forceinline__ int wave_sum_i(int v, int lane) {
#pragma unroll
    for (int o = 1; o < 64; o <<= 1) v += shxi(v, o, lane);
    return v;
}
__device__ __forceinline__ int fresh_lane() { unsigned z0 = 0u; asm volatile("" : "+v"(z0)); return (int)__builtin_amdgcn_mbcnt_hi(~0u, __builtin_amdgcn_mbcnt_lo(~0u, z0)); }
__device__ __forceinline__ int ld_i32(const GAS int* p) { return __hip_atomic_load(p, __ATOMIC_RELAXED, __HIP_MEMORY_SCOPE_AGENT); }
__device__ __forceinline__ float ld_f32(const GAS float* p) { return __hip_atomic_load(p, __ATOMIC_RELAXED, __HIP_MEMORY_SCOPE_AGENT); }
__device__ __forceinline__ float sigmoidf_(float x) { return __builtin_amdgcn_rcpf(1.0f + __expf(-x)); }
__device__ __forceinline__ float siluf_(float x) { return x * sigmoidf_(x); }
__device__ __forceinline__ f32x2 sig_pk_(f32x2 z) { f32x2 e; e.x = __builtin_amdgcn_exp2f(z.x); e.y = __builtin_amdgcn_exp2f(z.y); const f32x2 d = e + 1.0f; f32x2 r; r.x = __builtin_amdgcn_rcpf(d.x); r.y = __builtin_amdgcn_rcpf(d.y); return r; }
__device__ __forceinline__ f32x2 silu_pk_(f32x2 v) { return v * sig_pk_(v * (-1.4426950408889634f)); }
__device__ __forceinline__ f32x2 gelu_pk_(f32x2 v) { const f32x2 t = v * v; const f32x2 p = t * (-0.10294324f) + (-2.3022082f); return v * sig_pk_(v * p); }
__device__ __forceinline__ float gelu_tanh_(float x) { const float u = 0.7978845608028654f * (x + 0.044715f * x * x * x); return x * sigmoidf_(2.0f * u); }

namespace pg8 {
constexpr int BM = 256, BK = 64, HALF = 128, HTB = HALF * BK * 2, STAGE_BYTES = 8 * HTB;
__host__ __device__ __forceinline__ int lds_byte(int r, int c) { const int st = (r >> 4) * 2 + (c >> 5), rr = r & 15, cc = c & 31, ob = rr * 64 + cc * 2; return st * 1024 + (ob ^ (((ob >> 9) & 1) << 5)); }
__host__ __device__ __forceinline__ void stage_rc(int b, int& R, int& C) { const int st = b / 1024, sb = b % 1024, swz = sb ^ (((sb >> 9) & 1) << 5); R = (st >> 1) * 16 + swz / 64; C = (st & 1) * 32 + (swz % 64) / 2; }
__host__ __device__ __forceinline__ int perm32(int rho) { const int n = rho >> 4, i = rho & 15; return 8 * (i >> 2) + 4 * n + (i & 3); }

struct Unit { int pm, pn, e, slot; };

#ifndef PG8_ALIGN
#define PG8_ALIGN true
#endif
template <class E, class = void> struct Perm2 { static constexpr bool v = false; };
template <class E> struct Perm2<E, decltype((void)E::PERM2)> { static constexpr bool v = E::PERM2; };
template <class Epi, class Sched, bool GATHER, bool ALIGN_EPI = PG8_ALIGN>
__device__ __forceinline__ void gemm_phase(LAS unsigned char* lds, const Sched& S, const Epi& E, const int K, const int lda, const int wave) {
    unsigned z0_ = 0u; asm volatile("" : "+v"(z0_)); const int lane_ = (int)__builtin_amdgcn_mbcnt_hi(~0u, __builtin_amdgcn_mbcnt_lo(~0u, z0_));
    const int wid = wave, lane = lane_, tid = wid * 64 + lane, wr = wid >> 2, wc = wid & 3, fr = lane & 15, fq = lane >> 4;
    const int nt = K / BK;
    int Rr[2], Cc[2];
    unsigned voffB[2];
#pragma unroll
    for (int i = 0; i < 2; ++i) { int R, C; stage_rc(tid * 16 + i * 8192, R, C); Rr[i] = R; Cc[i] = C; int Rb = Epi::PERM ? ((R & ~31) + perm32(R & 31)) : R; if (Perm2<Epi>::v) Rb = (Rb >> 3) * 16 + (Rb & 7); voffB[i] = (unsigned)(Rb * K + C) * 2u; }
    const size_t kstep = (size_t)(BK * 2);
    const size_t hstepB = Perm2<Epi>::v ? (size_t)8 * K * 2 : (size_t)HALF * K * 2;
    const unsigned ldsw = (unsigned)wid * 1024u;
    const int aoff = lds_byte(wr * 64 + fr, fq * 8), boff = lds_byte(wc * 32 + fr, fq * 8);
#define PG8_SA(b, h) (((b) * 2 + (h)) * HTB)
#define PG8_SB(b, h) ((4 + (b) * 2 + (h)) * HTB)
#define PG8_STAGE(bufoff, gbase, voff) do { _Pragma("unroll") for (int _i = 0; _i < 2; ++_i) \
        __builtin_amdgcn_global_load_lds((const unsigned*)((const char*)(gbase) + (voff)[_i]), (LAS unsigned*)(lds + (bufoff) + ldsw + _i * 8192), 16, 0, 0); } while (0)
#define PG8_LDA(dst, b, h) do { _Pragma("unroll") for (int m = 0; m < 4; ++m) _Pragma("unroll") for (int k = 0; k < 2; ++k) dst[m][k] = *(const LAS bf16x8*)(lds + PG8_SA(b, h) + aoff + m * 2048 + k * 1024); } while (0)
#define PG8_LDB(dst, b, h) do { _Pragma("unroll") for (int n = 0; n < 2; ++n) _Pragma("unroll") for (int k = 0; k < 2; ++k) dst[n][k] = *(const LAS bf16x8*)(lds + PG8_SB(b, h) + boff + n * 2048 + k * 1024); } while (0)
#define PG8_MMA(ai, bj, At, Bt) do { __builtin_amdgcn_s_setprio(1); _Pragma("unroll") for (int m = 0; m < 4; ++m) _Pragma("unroll") for (int n = 0; n < 2; ++n) _Pragma("unroll") for (int k = 0; k < 2; ++k) \
        acc[ai][bj][m][n] = __builtin_amdgcn_mfma_f32_16x16x32_bf16(Bt[n][k], At[m][k], acc[ai][bj][m][n], 0, 0, 0); __builtin_amdgcn_s_setprio(0); } while (0)
#define PG8_WAIT_V(n) asm volatile("s_waitcnt vmcnt(" #n ")" ::: "memory")
#define PG8_WAIT_L(n) asm volatile("s_waitcnt lgkmcnt(" #n ")" ::: "memory")
#define PG8_BAR do { asm volatile("" ::: "memory"); __builtin_amdgcn_s_barrier(); asm volatile("" ::: "memory"); } while (0)
#define PG8_SCHED __builtin_amdgcn_sched_barrier(0)
    Unit cur, nxt; int ui = 0;
    if (!S.next(0, cur)) return;
    f32x4 acc[2][2][4][2];
#pragma unroll
    for (int a = 0; a < 2; ++a)
#pragma unroll
        for (int b = 0; b < 2; ++b)
#pragma unroll
            for (int m = 0; m < 4; ++m)
#pragma unroll
                for (int n = 0; n < 2; ++n) acc[a][b][m][n] = (f32x4){0.f, 0.f, 0.f, 0.f};
    bf16x8 At[4][2], B0[2][2], B1[2][2];
    unsigned cA0[2], cA1[2], nA0[2], nA1[2];
#pragma unroll
    for (int i = 0; i < 2; ++i) {
        if (GATHER) { cA0[i] = (unsigned)(S.row_of(cur, Rr[i]) * lda + Cc[i]) * 2u; cA1[i] = (unsigned)(S.row_of(cur, HALF + Rr[i]) * lda + Cc[i]) * 2u; }
        else { cA0[i] = (unsigned)(Rr[i] * lda + Cc[i]) * 2u; cA1[i] = (unsigned)((HALF + Rr[i]) * lda + Cc[i]) * 2u; }
        nA0[i] = cA0[i]; nA1[i] = cA1[i];
    }
    const char* cA = S.a_base(cur); const char* cB = S.b_base(cur);
    PG8_STAGE(PG8_SB(0, 0), cB, voffB); PG8_STAGE(PG8_SB(0, 1), cB + hstepB, voffB); PG8_STAGE(PG8_SA(0, 0), cA, cA0); PG8_STAGE(PG8_SA(0, 1), cA, cA1);
    if (wr == 1) PG8_BAR;
    PG8_WAIT_V(2); PG8_BAR;
    PG8_STAGE(PG8_SB(1, 0), cB + kstep, voffB); PG8_STAGE(PG8_SA(1, 0), cA + kstep, cA0); PG8_STAGE(PG8_SB(1, 1), cB + hstepB + kstep, voffB);
    PG8_WAIT_V(6); PG8_BAR;
    for (;;) {
        const bool has_next = S.next(ui + 1, nxt);
        const char* nA = has_next ? S.a_base(nxt) : cA; const char* nB = has_next ? S.b_base(nxt) : cB;
        if (GATHER) {
#pragma unroll
            for (int i = 0; i < 2; ++i) {
                if (has_next) { nA0[i] = (unsigned)(S.row_of(nxt, Rr[i]) * lda + Cc[i]) * 2u; nA1[i] = (unsigned)(S.row_of(nxt, HALF + Rr[i]) * lda + Cc[i]) * 2u; }
                else { nA0[i] = cA0[i]; nA1[i] = cA1[i]; }
            }
        }
#pragma unroll 1
        for (int t = 0; t < nt; t += 2) {
            const bool last = (t == nt - 2);
            const char* a1 = cA + (size_t)(t + 1) * kstep;
            const char* a2 = last ? nA : cA + (size_t)(t + 2) * kstep; const char* b2 = last ? nB : cB + (size_t)(t + 2) * kstep;
            const char* a3 = a2 + kstep; const char* b3 = b2 + kstep;
            unsigned x0[2], x1[2];
#pragma unroll
            for (int i = 0; i < 2; ++i) { x0[i] = (GATHER && last) ? nA0[i] : cA0[i]; x1[i] = (GATHER && last) ? nA1[i] : cA1[i]; }
            PG8_LDB(B0, 0, 0); PG8_LDB(B1, 0, 1); PG8_SCHED; PG8_LDA(At, 0, 0); PG8_STAGE(PG8_SA(1, 1), a1, cA1);
            PG8_WAIT_V(8); PG8_WAIT_L(0); PG8_BAR; PG8_MMA(0, 0, At, B0); PG8_MMA(0, 1, At, B1); PG8_BAR; PG8_SCHED;
            PG8_LDA(At, 0, 1); PG8_STAGE(PG8_SB(0, 0), b2, voffB); PG8_STAGE(PG8_SB(0, 1), b2 + hstepB, voffB); PG8_STAGE(PG8_SA(0, 0), a2, x0);
            PG8_WAIT_V(8); PG8_WAIT_L(0); PG8_BAR; PG8_MMA(1, 0, At, B0); PG8_MMA(1, 1, At, B1); PG8_BAR; PG8_SCHED;
            PG8_LDB(B0, 1, 0); PG8_LDB(B1, 1, 1); PG8_SCHED; PG8_LDA(At, 1, 0); PG8_STAGE(PG8_SA(0, 1), a2, x1);
            PG8_WAIT_V(8); PG8_WAIT_L(0); PG8_BAR; PG8_MMA(0, 0, At, B0); PG8_MMA(0, 1, At, B1); PG8_BAR; PG8_SCHED;
            PG8_LDA(At, 1, 1); PG8_STAGE(PG8_SB(1, 0), b3, voffB); PG8_STAGE(PG8_SB(1, 1), b3 + hstepB, voffB); PG8_STAGE(PG8_SA(1, 0), a3, x0);
            PG8_WAIT_V(8); PG8_WAIT_L(0); PG8_BAR; PG8_MMA(1, 0, At, B0); PG8_MMA(1, 1, At, B1); PG8_BAR; PG8_SCHED;
        }
        if (ALIGN_EPI) { if (wr == 0) PG8_BAR; }
        E(acc, cur, wr, wc, fr, fq);
        if (!has_next) break;
#pragma unroll
        for (int a = 0; a < 2; ++a)
#pragma unroll
            for (int b = 0; b < 2; ++b)
#pragma unroll
                for (int m = 0; m < 4; ++m)
#pragma unroll
                    for (int n = 0; n < 2; ++n) acc[a][b][m][n] = (f32x4){0.f, 0.f, 0.f, 0.f};
        cur = nxt; cA = nA; cB = nB; ++ui;
#pragma unroll
        for (int i = 0; i < 2; ++i) { cA0[i] = nA0[i]; cA1[i] = nA1[i]; }
        if (ALIGN_EPI) { if (wr == 1) PG8_BAR; }
    }
    PG8_WAIT_V(0);
    if (!ALIGN_EPI) { if (wr == 0) PG8_BAR; }
    PG8_BAR;
#undef PG8_SA
#undef PG8_SB
#undef PG8_STAGE
#undef PG8_LDA
#undef PG8_LDB
#undef PG8_MMA
#undef PG8_WAIT_V
#undef PG8_WAIT_L
#undef PG8_BAR
#undef PG8_SCHED
}
}

#define XB_TMO      128
#define XB_XCNT(j)  (256  + 64 * (j))
#define XB_XSUB(j)  (1280 + 64 * (j))
#define XB_XGEN(j)  (2304 + 64 * (j))
#define XB_TOP      3328
#define XB_TOPGEN   3392
#define XCD_BAR_WORDS 3456
#define XB_SPIN_CAP (1u << 20)

__device__ __forceinline__ unsigned xb_ld(unsigned* p)              { return __hip_atomic_load(p, __ATOMIC_RELAXED, __HIP_MEMORY_SCOPE_AGENT); }
__device__ __forceinline__ unsigned xb_add(unsigned* p, unsigned v) { return __hip_atomic_fetch_add(p, v, __ATOMIC_RELAXED, __HIP_MEMORY_SCOPE_AGENT); }
__device__ __forceinline__ unsigned xb_xcc_id() { return (unsigned)__builtin_amdgcn_s_getreg((3 << 11) | 20) & 0xFu; }
#define XB_SPIN(cond, bar) do { unsigned _sp = 0; while (cond) { __builtin_amdgcn_s_sleep(1); \
    if ((++_sp & 255u) == 0u) { if (xb_ld(&(bar)[XB_TMO])) break; if (_sp > XB_SPIN_CAP) { atomicAdd(&(bar)[XB_TMO], 1u); break; } } } } while (0)

struct XcdBarrier { unsigned* bar; unsigned x; volatile LAS unsigned* st; };

__device__ __forceinline__ XcdBarrier xcd_barrier_post(unsigned* bar, volatile LAS unsigned* st) {
    XcdBarrier b; b.bar = bar; b.x = xb_xcc_id(); b.st = st;
    if (threadIdx.x == 0) (void)xb_add(&bar[XB_XCNT(b.x)], 1u);
    return b;
}
__device__ __forceinline__ void xcd_barrier_complete(unsigned* bar, unsigned x, unsigned& nloc, unsigned& nx) {
    const unsigned G = gridDim.x * gridDim.y * gridDim.z;
    unsigned sum, cnt, mine, sp = 0u;
    for (;;) {
        sum = 0u; cnt = 0u; mine = 0u;
#pragma unroll
        for (unsigned j = 0; j < 16; ++j) { const unsigned c = xb_ld(&bar[XB_XCNT(j)]); sum += c; cnt += (c > 0u) ? 1u : 0u; mine = (j == x) ? c : mine; }
        if (sum == G) break;
        __builtin_amdgcn_s_sleep(1);
        if ((++sp & 255u) == 0u) { if (xb_ld(&bar[XB_TMO])) break; if (sp > XB_SPIN_CAP) { atomicAdd(&bar[XB_TMO], 1u); break; } }
    }
    nloc = mine > 0u ? mine : 1u; nx = cnt > 0u ? cnt : 1u;
}
#ifndef LATE_INV
#define EARLY_INV 1
#endif
__device__ __forceinline__ void xcd_barrier(const XcdBarrier& b) {
    asm volatile("s_waitcnt vmcnt(0)" ::: "memory");
    __syncthreads();
    if (threadIdx.x == 0) {
        unsigned* bar = b.bar;
        __builtin_amdgcn_s_waitcnt(0);
        unsigned nloc = b.st[0], nx = b.st[1];
        if (nloc == 0u) { xcd_barrier_complete(bar, b.x, nloc, nx); b.st[0] = nloc; b.st[1] = nx; }
        const unsigned old = xb_add(&bar[XB_XSUB(b.x)], 1u);
        const unsigned gen = old / nloc;
        if (old + 1u == (gen + 1u) * nloc) {
            __builtin_amdgcn_fence(__ATOMIC_RELEASE, "agent");
            asm volatile("s_waitcnt vmcnt(0)" ::: "memory");
            const unsigned og = xb_add(&bar[XB_TOP], 1u);
            const unsigned tg = og / nx;
#ifdef EARLY_INV
            __builtin_amdgcn_fence(__ATOMIC_ACQUIRE, "agent");
#endif
            if (og + 1u == (tg + 1u) * nx) xb_add(&bar[XB_TOPGEN], 1u);
            else XB_SPIN(xb_ld(&bar[XB_TOPGEN]) == tg, bar);
#ifndef EARLY_INV
            __builtin_amdgcn_fence(__ATOMIC_ACQUIRE, "agent");
#endif
            xb_add(&bar[XB_XGEN(b.x)], 1u);
            asm volatile("s_waitcnt vmcnt(0)" ::: "memory");
        } else {
#ifdef EARLY_INV
            __builtin_amdgcn_fence(__ATOMIC_ACQUIRE, "agent");
#endif
            XB_SPIN(xb_ld(&bar[XB_XGEN(b.x)]) == gen, bar);
#ifndef EARLY_INV
            __builtin_amdgcn_fence(__ATOMIC_ACQUIRE, "agent");
#endif
            asm volatile("s_waitcnt vmcnt(0)" ::: "memory");
        }
    }
    __syncthreads();
}

__device__ __forceinline__ void hi_arrive(gu32* cnt) {
    if (threadIdx.x == 0) { __builtin_amdgcn_fence(__ATOMIC_RELEASE, "agent"); asm volatile("s_waitcnt vmcnt(0)" ::: "memory"); (void)xb_add((unsigned*)cnt, 1u); }
}
__device__ __forceinline__ void hi_arrive_xcd(gu32* cnt, gu32* sub, unsigned nloc) {
    if (threadIdx.x == 0) { const unsigned old = xb_add((unsigned*)sub, 1u);
        if (old + 1u == nloc) { __builtin_amdgcn_fence(__ATOMIC_RELEASE, "agent"); asm volatile("s_waitcnt vmcnt(0)" ::: "memory"); (void)xb_add((unsigned*)cnt, nloc); } }
}
__device__ __forceinline__ void hi_wait(gu32* cnt, unsigned need, unsigned* bar) {
    if (threadIdx.x == 0) { XB_SPIN(xb_ld((unsigned*)cnt) < need, bar); __builtin_amdgcn_fence(__ATOMIC_ACQUIRE, "agent"); asm volatile("s_waitcnt vmcnt(0)" ::: "memory"); }
    __syncthreads();
}

constexpr size_t MiB = 1u << 20;
constexpr size_t WS_CTL = 0, CTL_ZERO_BYTES = 1 * MiB;
constexpr size_t WS_ROPE = 1 * MiB;
constexpr size_t WS_WI   = 3 * MiB;
constexpr size_t WS_ROUTE = 3 * MiB + 512 * 1024;
constexpr size_t WS_SROW = 4 * MiB;
constexpr size_t WS_ROWMAP = 4 * MiB + 256 * 1024;
constexpr size_t WS_CWROW = 4 * MiB + 640 * 1024;
constexpr size_t WS_CNTWG = 5 * MiB;
constexpr size_t WS_META = 5 * MiB + 64 * 1024;
constexpr size_t WS_WR = 5 * MiB + 128 * 1024;
constexpr size_t WS_GLR = 6 * MiB;
constexpr size_t WS_WDENSE = 8 * MiB;
constexpr size_t WD_WA = 0, WD_WG = 7 * MiB, WD_WBR = 13 * MiB, WD_WOUT = 16 * MiB, WD_LAYER = 18 * MiB;
constexpr size_t WS_WMOE = 44 * MiB;
constexpr size_t WM_GU = 0, WM_DN = 32 * MiB;
constexpr size_t WS_HB = 92 * MiB;
constexpr size_t WS_PA = 156 * MiB;
constexpr size_t WS_HID = WS_PA;
constexpr size_t WS_FF2 = WS_PA + 40 * MiB;
constexpr size_t WS_Y = 380 * MiB;
constexpr size_t WS_KA = 476 * MiB, WS_VA = 480 * MiB, WS_KI = 484 * MiB;
constexpr size_t WS_END = 512 * MiB;
static_assert(WS_WDENSE + 2 * WD_LAYER <= WS_WMOE && WS_WMOE + 48 * MiB <= WS_HB && WS_HB + 64 * MiB <= WS_PA && WS_PA + 224 * MiB <= WS_Y && WS_Y + 96 * MiB <= WS_KA && WS_KI + 4 * MiB <= WS_END, "ws map");
static_assert(WS_FF2 + (size_t)73728 * 1024 * 2 <= WS_Y, "ff2 fits");
constexpr int CW_BAR = 4096;
constexpr int CW_QUEUE = 16384;
constexpr int CW_HI = 24576;

constexpr int RING_BYTES = 131072;
constexpr int AUX_OFF = 131072;
constexpr int MISC_OFF = 155648;
constexpr int LDS_BYTES = 156672;

struct Frame {
    LAS unsigned char* lds;
    volatile LAS unsigned* MISC;
    gu32* ctl;
    int tid, lane, wave, G, wg;
    const float* const* in;
    const GAS int* pos;
    GAS float* H;
    GAS unsigned char* ws;
};

#define LDS_WAIT() asm volatile("s_waitcnt lgkmcnt(0)" ::: "memory")
#define VM_WAIT() asm volatile("s_waitcnt vmcnt(0)" ::: "memory")

__device__ __forceinline__ int pa_src_col0(int c) {
    if (c < 512) return c;
    if (c < 768) { const int x = c - 512, grp = x >> 6, d = x & 63;
        if (grp == 0) return 512 + d;
        if (grp == 1) return 576 + d;
        if (grp == 2) return 896 + d;
        if (d < 4) return 960 + d;
        if (d < 20) return 1988 + (d - 4);
        return -1; }
    if (c < 1024) return 640 + (c - 768);
    if (c < 1280) return 964 + (c - 1024);
    if (c < 1536) return 1220 + (c - 1280);
    if (c < 2048) return 1476 + (c - 1536);
    if (c < 2560) return 2004 + (c - 2048);
    return 2516 + (c - 2560);
}
__device__ __forceinline__ int pa_src_col(int c) { return pa_src_col0(c); }
struct TItem { const GAS float* W; GAS bf16* WT; int ldw, K, n0, k0, sc0, mode; };
__device__ __forceinline__ void ti_load(const TItem& t, f32x4 (&v)[8], int lane) {
    if (t.mode == 0) { const int kr = lane >> 3, c4 = (lane & 7) * 4;
#pragma unroll
        for (int i = 0; i < 8; ++i) v[i] = *(const GAS f32x4*)(t.W + (size_t)(t.k0 + 8 * i + kr) * t.ldw + t.sc0 + c4); }
}
__device__ __forceinline__ void ti_finish(const TItem& t, const f32x4 (&v)[8], LAS float* scr, int lane) {
    if (t.mode == 0) { const int kr = lane >> 3, c4 = (lane & 7) * 4;
#pragma unroll
        for (int i = 0; i < 8; ++i) { LAS float* d = scr + (8 * i + kr) * 33 + c4; d[0] = v[i].x; d[1] = v[i].y; d[2] = v[i].z; d[3] = v[i].w; }
    } else { const int sc = pa_src_col(t.n0 + (lane & 31));
        float gv[32];
#pragma unroll
        for (int i = 0; i < 32; ++i) { const int kk = 2 * i + (lane >> 5); gv[i] = (sc >= 0) ? t.W[(size_t)(t.k0 + kk) * t.ldw + sc] : 0.f; }
#pragma unroll
        for (int i = 0; i < 32; ++i) { const int kk = 2 * i + (lane >> 5); scr[kk * 33 + (lane & 31)] = gv[i]; }
    }
    LDS_WAIT(); asm volatile("" ::: "memory");
    const int c = lane & 7;
#pragma unroll
    for (int j = 0; j < 4; ++j) { const int n = (lane >> 3) + 8 * j; const LAS float* s = scr + (8 * c) * 33 + n;
        u32x4 o; o.x = pk2(s[0 * 33], s[1 * 33]); o.y = pk2(s[2 * 33], s[3 * 33]); o.z = pk2(s[4 * 33], s[5 * 33]); o.w = pk2(s[6 * 33], s[7 * 33]);
        *(GAS u32x4*)(t.WT + (size_t)(t.n0 + n) * t.K + t.k0 + 8 * c) = o; }
    LDS_WAIT(); asm volatile("" ::: "memory");
}
__device__ __forceinline__ void dense_item(Frame& F, int l, int it, TItem& t) {
    GAS bf16* base = (GAS bf16*)(F.ws + WS_WDENSE + (size_t)l * WD_LAYER);
    const GAS float* win = ((const GAS float*)F.in[4]) + (size_t)l * DM * NIN;
    if (it < 1792) { const int kb = it / 112, nb = it % 112; const int s0 = pa_src_col(32 * nb), s31 = pa_src_col(32 * nb + 31);
        t = TItem{win, base + WD_WA / 2, NIN, DM, 32 * nb, 64 * kb, s0, (s0 >= 0 && s31 == s0 + 31) ? 0 : 1}; return; }
    it -= 1792;
    if (it < 1536) { const int kb = it / 96, nb = it % 96; t = TItem{win, base + WD_WG / 2, NIN, DM, 32 * nb, 64 * kb, 3540 + 32 * nb, 0}; return; }
    it -= 1536;
    if (it < 768) { const int br = it / 256, r = it % 256, kb = r / 32, nb = r % 32;
        t = TItem{(br == 0 ? ((const GAS float*)F.in[13]) : br == 1 ? ((const GAS float*)F.in[14]) : ((const GAS float*)F.in[15])) + (size_t)l * 512 * DM, base + WD_WBR / 2 + (size_t)br * 1024 * 512, DM, 512, 32 * nb, 64 * kb, 32 * nb, 0}; return; }
    it -= 768;
    { const int kb = it / 32, nb = it % 32; t = TItem{((const GAS float*)F.in[16]) + (size_t)l * DM * DM, base + WD_WOUT / 2, DM, DM, 32 * nb, 64 * kb, 32 * nb, 0}; }
}
__device__ __forceinline__ void moe_item(Frame& F, int l, int it, TItem& t) {
    const int e = it / 384; int r = it % 384;
    if (r < 256) { const int sub = r / 64, q = r % 64, ct = sub >> 1, bj = sub & 1, kb = q / 4, nb = q % 4;
        const GAS float* src = (bj ? ((const GAS float*)F.in[24]) : ((const GAS float*)F.in[23])) + (size_t)(l * NEXP + e) * DM * DEXP;
        t = TItem{src, (GAS bf16*)(F.ws + WS_WMOE + WM_GU) + (size_t)e * 512 * DM, DEXP, DM, 256 * ct + 128 * bj + 32 * nb, 64 * kb, 128 * ct + 32 * nb, 0}; return; }
    r -= 256;
    { const int kb = r / 32, nb = r % 32;
        t = TItem{((const GAS float*)F.in[25]) + (size_t)(l * NEXP + e) * DEXP * DM, (GAS bf16*)(F.ws + WS_WMOE + WM_DN) + (size_t)e * DM * DEXP, DM, DEXP, 32 * nb, 64 * kb, 32 * nb, 0}; }
}
template <bool MOE> __device__ __forceinline__ void conv_run(Frame& F, int l, int total, LAS float* scr) {
    const int gw = F.wg * 8 + F.wave, NGW = F.G * 8, lane = F.lane;
    TItem cur, nxt; f32x4 vc[8], vn[8];
    int it = gw; if (it >= total) return;
    if (MOE) moe_item(F, l, it, cur); else dense_item(F, it / 4608, it % 4608, cur);
    ti_load(cur, vc, lane);
#pragma unroll 1
    for (; it < total; it += NGW) { const int itn = it + NGW; const bool hn = itn < total;
        if (hn) { if (MOE) moe_item(F, l, itn, nxt); else dense_item(F, itn / 4608, itn % 4608, nxt); ti_load(nxt, vn, lane); }
        ti_finish(cur, vc, scr, lane);
        cur = nxt;
#pragma unroll
        for (int i = 0; i < 8; ++i) vc[i] = vn[i]; }
}

__device__ __forceinline__ void ln_row_regs(f32x4 (&v)[4], const GAS float* g, const GAS float* b, int lane) {
    float s = 0.f;
#pragma unroll
    for (int j = 0; j < 4; ++j) s += (v[j].x + v[j].y) + (v[j].z + v[j].w);
    const float mean = wave_sum(s, lane) * (1.f / DM); float s2 = 0.f;
#pragma unroll
    for (int j = 0; j < 4; ++j) { v[j] = v[j] - mean; s2 += (v[j].x * v[j].x + v[j].y * v[j].y) + (v[j].z * v[j].z + v[j].w * v[j].w); }
    const float rstd = 1.f / sqrtf(wave_sum(s2, lane) * (1.f / DM) + LN_EPS);
#pragma unroll
    for (int j = 0; j < 4; ++j) { const f32x4 gg = *(const GAS f32x4*)(g + 4 * lane + 256 * j), bb = *(const GAS f32x4*)(b + 4 * lane + 256 * j); v[j] = v[j] * rstd * gg + bb; }
}
__device__ __forceinline__ void store_row_f32_bf16(const f32x4 (&v)[4], GAS float* hrow, GAS bf16* brow, int lane) {
#pragma unroll
    for (int j = 0; j < 4; ++j) {
        if (hrow) *(GAS f32x4*)(hrow + 4 * lane + 256 * j) = v[j];
        if (brow) { u32x2 w; w.x = pk2(v[j].x, v[j].y); w.y = pk2(v[j].z, v[j].w); *(GAS u32x2*)(brow + 4 * lane + 256 * j) = w; }
    }
}

__device__ __forceinline__ void phase_prologue(Frame& F) {
    LAS float* scr = (LAS float*)(F.lds + F.wave * 16384);
    const int gw = F.wg * 8 + F.wave, NGW = F.G * 8;
    conv_run<false>(F, 0, 2 * 4608, scr);
    { GAS bf16* WRB = (GAS bf16*)(F.ws + WS_WR);
      for (int i = gw * 64 + F.lane; i < DEPTH * 48 * DM; i += NGW * 64) { const int l = i / (48 * DM), r = i % (48 * DM), o = r / DM, k = r % DM;
          const float v = (o < 4) ? ((const GAS float*)F.in[19])[(size_t)l * DM * 4 + k * 4 + o] : (o < 36) ? ((const GAS float*)F.in[21])[(size_t)l * DM * 32 + k * 32 + (o - 4)] : 0.f;
          WRB[i] = (bf16)f2bf(v); } }
    { GAS float* RT = (GAS float*)(F.ws + WS_ROPE);
      for (int i = gw * 64 + F.lane; i < NTOK * 8; i += NGW * 64) { const int n = i >> 3, j = i & 7;
          const float invf[8] = {1.000000000e+00f, 1.939227432e-01f, 3.760603070e-02f, 7.292664610e-03f, 1.414213562e-03f, 2.742481884e-04f, 5.318295734e-05f, 1.031338525e-05f};
          float inv = invf[0];
#pragma unroll
          for (int q = 1; q < 8; ++q) inv = (j == q) ? invf[q] : inv;
          const float ang = (float)F.pos[n] * inv;
          const double kq = __builtin_rint((double)ang * 0.15915494309189535);
          double r = (double)ang - kq * 6.283185307179586; double csign = 1.0;
          if (r > 1.5707963267948966) { r = 3.141592653589793 - r; csign = -1.0; } else if (r < -1.5707963267948966) { r = -3.141592653589793 - r; csign = -1.0; }
          const double x2 = r * r;
          const double sn = r * (1.0 + x2 * (-1.0 / 6 + x2 * (1.0 / 120 + x2 * (-1.0 / 5040 + x2 * (1.0 / 362880 + x2 * (-1.0 / 39916800 + x2 * (1.0 / 6227020800.0 + x2 * (-1.0 / 1307674368000.0))))))));
          const double cs = 1.0 + x2 * (-0.5 + x2 * (1.0 / 24 + x2 * (-1.0 / 720 + x2 * (1.0 / 40320 + x2 * (-1.0 / 3628800 + x2 * (1.0 / 479001600.0 + x2 * (-1.0 / 87178291200.0 + x2 * (1.0 / 20922789888000.0))))))));
          RT[n * 16 + j] = (float)(csign * cs); RT[n * 16 + 8 + j] = (float)sn; } }
    GAS bf16* HB = (GAS bf16*)(F.ws + WS_HB);
    for (int m = gw; m < NTOK; m += NGW) { f32x4 v[4];
#pragma unroll
        for (int j = 0; j < 4; ++j) v[j] = *(const GAS f32x4*)(((const GAS float*)F.in[0]) + (size_t)m * DM + 4 * F.lane + 256 * j);
        ln_row_regs(v, ((const GAS float*)F.in[2]), ((const GAS float*)F.in[3]), F.lane);
        store_row_f32_bf16(v, (GAS float*)nullptr, HB + (size_t)m * DM, F.lane); }
}

struct DenseSched {
    int nM, nN, nwg, G, c; const char* A; const char* B; size_t atile, btile; int nsub = 1; size_t asub = 0, bsub = 0;
    __device__ void init(int nM_, int nN_, int G_, int c_, const void* A_, size_t atile_, const void* B_, size_t btile_) { nM = nM_; nN = nN_; nwg = nM * nN; G = G_; c = c_; A = (const char*)A_; B = (const char*)B_; atile = atile_; btile = btile_; }
    __device__ __forceinline__ bool next(int i, pg8::Unit& u) const {
        const int it = i / nsub, sb = i - it * nsub;
        const long L = (long)it * G + c; if (L >= nwg) return false;
        int wgid = (int)L; { const int q = nwg / 8, r = nwg % 8, xcd = wgid % 8, off = wgid / 8; wgid = (xcd < r ? xcd * (q + 1) : r * (q + 1) + (xcd - r) * q) + off; }
        const int nig = 8 * nN, gid = wgid / nig, fm = gid * 8, gsz = (nM - fm) < 8 ? (nM - fm) : 8;
        u.pm = fm + ((wgid % nig) % gsz); u.pn = (wgid % nig) / gsz; u.e = sb; u.slot = i; return true;
    }
    __device__ __forceinline__ const char* a_base(const pg8::Unit& u) const { return A + (size_t)u.pm * atile + (size_t)u.e * asub; }
    __device__ __forceinline__ const char* b_base(const pg8::Unit& u) const { return B + (size_t)u.pn * btile + (size_t)u.e * bsub; }
    __device__ __forceinline__ int row_of(const pg8::Unit&, int) const { return 0; }
};
struct GroupSched {
    int NU, G, c, ncol; const char* A; const char* B; size_t atile, erows_bytes, btile; const LAS int* meta; const LAS int* rows;
    int i0 = 0, i1 = 1 << 20; const LAS int* uid = nullptr;
    __device__ __forceinline__ bool next(int i, pg8::Unit& u) const {
        const int s = i + i0; if (s >= i1) return false;
        const int L = uid ? uid[s] : s * G + c; if (L >= NU || L < 0) return false;
        u.pm = L / ncol; u.pn = L % ncol; u.slot = s; u.e = meta[s]; return true;
    }
    __device__ __forceinline__ const char* a_base(const pg8::Unit& u) const { return A + (size_t)u.pm * atile; }
    __device__ __forceinline__ const char* b_base(const pg8::Unit& u) const { return B + (size_t)u.e * erows_bytes + (size_t)u.pn * btile; }
    __device__ __forceinline__ int row_of(const pg8::Unit& u, int r) const { return rows[u.slot * 256 + r]; }
};

#ifndef NT_MASK
#define NT_MASK 0
#endif
template <int BIT> __device__ __forceinline__ void st16(GAS u32x4* p, const u32x4 v) { if (NT_MASK & (1 << BIT)) __builtin_nontemporal_store(v, p); else *p = v; }
struct EpiA {
    static constexpr bool PERM = true; static constexpr bool PERM2 = true; static constexpr int NST = 16;
    GAS bf16* PA; GAS bf16* KA; GAS bf16* VA; GAS bf16* KI; GAS float* WI; GAS float* GLR; const GAS float* ROPE; const GAS float* ikg;
    __device__ __forceinline__ static void rope8(float (&x)[8], const GAS float* rt, int fq, int lane) {
        const f32x4 c0 = *(const GAS f32x4*)(rt), c1 = *(const GAS f32x4*)(rt + 4), s0 = *(const GAS f32x4*)(rt + 8), s1 = *(const GAS f32x4*)(rt + 12);
#pragma unroll
        for (int i = 0; i < 8; ++i) { const float p = shx(x[i], 16, lane); const float cc = (i < 4) ? c0[i & 3] : c1[i & 3], ss = (i < 4) ? s0[i & 3] : s1[i & 3];
            const float r = x[i] * cc + ((fq == 0) ? -p : p) * ss; x[i] = (fq < 2) ? r : x[i]; }
    }
    __device__ __forceinline__ static u32x4 pack8(const float (&x)[8]) { u32x4 w; w.x = cvt_pk_bf16(x[0], x[1]); w.y = cvt_pk_bf16(x[2], x[3]); w.z = cvt_pk_bf16(x[4], x[5]); w.w = cvt_pk_bf16(x[6], x[7]); return w; }
    __device__ __forceinline__ void operator()(const f32x4 (&acc)[2][2][4][2], const pg8::Unit& u, int wr, int wc, int fr, int fq) const {
        const int pn = u.pn; const int rowb = u.pm * 256 + wr * 64 + fr; const int lane = fq * 16 + fr;
        if (pn == 2) {
#pragma unroll
            for (int ai = 0; ai < 2; ++ai)
#pragma unroll
                for (int m = 0; m < 4; ++m) {
                    const int row = rowb + ai * 128 + m * 16;
                    float x0[8], x1[8];
#pragma unroll
                    for (int i = 0; i < 8; ++i) { x0[i] = acc[ai][0][m][i >> 2][i & 3]; x1[i] = acc[ai][1][m][i >> 2][i & 3]; }
                    if (wc == 2) {
                        float s = 0.f;
#pragma unroll
                        for (int i = 0; i < 8; ++i) s += x0[i] + x1[i];
                        s += shx(s, 16, lane); s += shx(s, 32, lane);
                        const float mean = s * (1.f / 64.f); float q = 0.f;
#pragma unroll
                        for (int i = 0; i < 8; ++i) { x0[i] -= mean; x1[i] -= mean; q += x0[i] * x0[i] + x1[i] * x1[i]; }
                        q += shx(q, 16, lane); q += shx(q, 32, lane);
                        const float rstd = 1.f / sqrtf(q * (1.f / 64.f) + LN_EPS);
#pragma unroll
                        for (int i = 0; i < 8; ++i) { x0[i] = x0[i] * rstd * ikg[16 * fq + i]; x1[i] = x1[i] * rstd * ikg[16 * fq + 8 + i]; }
                    }
                    if (wc == 0 || wc == 2) {
                        const GAS float* rt = ROPE + (size_t)row * 16;
                        const f32x4 c0 = *(const GAS f32x4*)(rt), c1 = *(const GAS f32x4*)(rt + 4), s0 = *(const GAS f32x4*)(rt + 8), s1 = *(const GAS f32x4*)(rt + 12);
#pragma unroll
                        for (int i = 0; i < 8; ++i) { const float a = x0[i], b = x1[i]; const float cc = (i < 4) ? c0[i & 3] : c1[i & 3], ss = (i < 4) ? s0[i & 3] : s1[i & 3];
                            const float r0 = a * cc - b * ss, r1 = b * cc + a * ss; x0[i] = (fq == 0) ? r0 : a; x1[i] = (fq == 0) ? r1 : b; }
                    }
                    if (wc < 2) {
                        GAS unsigned char* dst8 = (GAS unsigned char*)KA + (size_t)row * 128 + 64 * wc;
                        u32x4 b; b.x = pk4_fp8(x0[0], x0[1], x0[2], x0[3]); b.y = pk4_fp8(x0[4], x0[5], x0[6], x0[7]); b.z = pk4_fp8(x1[0], x1[1], x1[2], x1[3]); b.w = pk4_fp8(x1[4], x1[5], x1[6], x1[7]);
                        *(GAS u32x4*)(dst8 + 16 * fq) = b;
                    } else if (wc == 2) {
                        *(GAS u32x4*)(KI + (size_t)row * 64 + 16 * fq) = pack8(x0); *(GAS u32x4*)(KI + (size_t)row * 64 + 16 * fq + 8) = pack8(x1);
                    } else {
                        if (fq == 0) { *(GAS f32x4*)(WI + (size_t)row * 4) = (f32x4){x0[0], x0[1], x0[2], x0[3]} * 0.0625f; *(GAS f32x4*)(GLR + (size_t)row * 16) = (f32x4){x0[4], x0[5], x0[6], x0[7]};
                            *(GAS f32x4*)(GLR + (size_t)row * 16 + 4) = (f32x4){x1[0], x1[1], x1[2], x1[3]}; *(GAS f32x4*)(GLR + (size_t)row * 16 + 8) = (f32x4){x1[4], x1[5], x1[6], x1[7]}; }
                        else if (fq == 1) { *(GAS f32x4*)(GLR + (size_t)row * 16 + 12) = (f32x4){x0[0], x0[1], x0[2], x0[3]}; }
                    }
                    asm volatile("" ::: "memory");
                }
        } else if (pn < 2 || pn == 3) {
#pragma unroll
            for (int ai = 0; ai < 2; ++ai)
#pragma unroll
                for (int m = 0; m < 4; ++m) {
                    const int row = rowb + ai * 128 + m * 16;
                    const GAS float* rt = ROPE + (size_t)row * 16;
                    const f32x4 c0 = *(const GAS f32x4*)(rt), c1 = *(const GAS f32x4*)(rt + 4), s0 = *(const GAS f32x4*)(rt + 8), s1 = *(const GAS f32x4*)(rt + 12);
                    float x0[8], x1[8];
#pragma unroll
                    for (int i = 0; i < 8; ++i) { const float a = acc[ai][0][m][i >> 2][i & 3], b = acc[ai][1][m][i >> 2][i & 3]; const float cc = (i < 4) ? c0[i & 3] : c1[i & 3], ss = (i < 4) ? s0[i & 3] : s1[i & 3];
                        const float r0 = a * cc - b * ss, r1 = b * cc + a * ss; x0[i] = (fq == 0) ? r0 : a; x1[i] = (fq == 0) ? r1 : b; }
                    if (pn == 3) { GAS bf16* d = PA + (size_t)row * NPA + 256 * pn + 64 * wc + 16 * fq; st16<0>((GAS u32x4*)d, pack8(x0)); st16<0>((GAS u32x4*)(d + 8), pack8(x1)); }
                    else { u32x4 b; b.x = pk4_fp8(x0[0], x0[1], x0[2], x0[3]); b.y = pk4_fp8(x0[4], x0[5], x0[6], x0[7]); b.z = pk4_fp8(x1[0], x1[1], x1[2], x1[3]); b.w = pk4_fp8(x1[4], x1[5], x1[6], x1[7]);
                        *(GAS u32x4*)((GAS unsigned char*)PA + (size_t)row * PA_ROWB + 512 * pn + 64 * wc + 16 * fq) = b; }
                    asm volatile("" ::: "memory");
                }
        } else {
            const int act = (pn == 8 || pn == 9) ? 1 : (pn >= 10) ? 2 : 0; const float sc = (pn == 4) ? 0.125f : 1.0f;
            if (act == 0) {
#pragma unroll
                for (int ai = 0; ai < 2; ++ai)
#pragma unroll
                    for (int m = 0; m < 4; ++m) {
                        const int row = rowb + ai * 128 + m * 16;
#pragma unroll
                        for (int bj = 0; bj < 2; ++bj) { float x[8];
#pragma unroll
                            for (int i = 0; i < 8; ++i) x[i] = acc[ai][bj][m][i >> 2][i & 3] * sc;
                            st16<0>((GAS u32x4*)(PA + (size_t)row * NPA + 256 * pn + 64 * wc + 16 * fq + 8 * bj), pack8(x)); }
                        asm volatile("" ::: "memory");
                    }
            } else {
                const float ca = (act == 2) ? -0.10294324f : 0.f, cb = (act == 2) ? -2.3022082f : -1.4426950408889634f;
#pragma unroll
                for (int ai = 0; ai < 2; ++ai)
#pragma unroll
                    for (int m = 0; m < 4; ++m) {
                        const int row = rowb + ai * 128 + m * 16;
                        u32x4 b8;
#pragma unroll
                        for (int bj = 0; bj < 2; ++bj) { float x[8];
#pragma unroll
                            for (int i = 0; i < 8; i += 2) { const f32x2 v = {acc[ai][bj][m][i >> 2][i & 3], acc[ai][bj][m][i >> 2][(i & 3) + 1]};
                                const f32x2 t = v * v, p = t * ca + cb, o = v * sig_pk_(v * p); x[i] = o.x; x[i + 1] = o.y; }
                            const unsigned a_ = pk4_fp8(x[0], x[1], x[2], x[3]), b_ = pk4_fp8(x[4], x[5], x[6], x[7]);
                            if (bj == 0) { b8.x = a_; b8.y = b_; } else { b8.z = a_; b8.w = b_; } }
                        *(GAS u32x4*)((GAS unsigned char*)PA + (size_t)row * PA_ROWB + 512 * pn + 64 * wc + 16 * fq) = b8;
                        asm volatile("" ::: "memory");
                    }
            }
        }
    }
};
struct EpiPlainA {
    static constexpr bool PERM = true; static constexpr int NST = 16;
    GAS bf16* PA;
    __device__ __forceinline__ void operator()(const f32x4 (&acc)[2][2][4][2], const pg8::Unit& u, int wr, int wc, int fr, int fq) const {
        const int rowb = u.pm * 256 + wr * 64 + fr;
#pragma unroll
        for (int ai = 0; ai < 2; ++ai)
#pragma unroll
            for (int m = 0; m < 4; ++m) { const int row = rowb + ai * 128 + m * 16;
#pragma unroll
                for (int bj = 0; bj < 2; ++bj) { u32x4 w; w.x = cvt_pk_bf16(acc[ai][bj][m][0][0], acc[ai][bj][m][0][1]); w.y = cvt_pk_bf16(acc[ai][bj][m][0][2], acc[ai][bj][m][0][3]);
                    w.z = cvt_pk_bf16(acc[ai][bj][m][1][0], acc[ai][bj][m][1][1]); w.w = cvt_pk_bf16(acc[ai][bj][m][1][2], acc[ai][bj][m][1][3]);
                    *(GAS u32x4*)(PA + (size_t)row * NPA + 256 * u.pn + 128 * bj + 32 * wc + 8 * fq) = w; } }
    }
};
struct EpiNoneA {
    static constexpr bool PERM = true; static constexpr int NST = 0;
    GAS bf16* PA;
    __device__ __forceinline__ void operator()(const f32x4 (&acc)[2][2][4][2], const pg8::Unit& u, int wr, int wc, int fr, int fq) const {
        float s = 0.f;
#pragma unroll
        for (int ai = 0; ai < 2; ++ai)
#pragma unroll
            for (int m = 0; m < 4; ++m)
#pragma unroll
                for (int bj = 0; bj < 2; ++bj)
#pragma unroll
                    for (int n = 0; n < 2; ++n) s += (acc[ai][bj][m][n][0] + acc[ai][bj][m][n][1]) + (acc[ai][bj][m][n][2] + acc[ai][bj][m][n][3]);
        if (s == 1.2345e30f) PA[u.pm + wr + wc + fr + fq] = (bf16)1;
    }
};
#ifdef PPITCH
#ifndef EPIP_MODE
#define EPIP_MODE 0
#endif
struct EpiPPad {
    static constexpr bool PERM = true; static constexpr int NST = 16;
    GAS bf16* P;
    __device__ __forceinline__ void operator()(const f32x4 (&acc)[2][2][4][2], const pg8::Unit& u, int wr, int wc, int fr, int fq) const {
        const int rowb = u.pm * 256 + wr * 64 + fr; GAS bf16* Pb = P + (size_t)u.e * NTOK * PPITCH;
#pragma unroll
        for (int ai = 0; ai < 2; ++ai)
#pragma unroll
            for (int m = 0; m < 4; ++m) {
#if EPIP_MODE == 2
                const int row = (rowb + ai * 128 + m * 16) & 31;
#else
                const int row = rowb + ai * 128 + m * 16;
#endif
#pragma unroll
                for (int bj = 0; bj < 2; ++bj) { u32x4 w; w.x = cvt_pk_bf16(acc[ai][bj][m][0][0], acc[ai][bj][m][0][1]); w.y = cvt_pk_bf16(acc[ai][bj][m][0][2], acc[ai][bj][m][0][3]);
                    w.z = cvt_pk_bf16(acc[ai][bj][m][1][0], acc[ai][bj][m][1][1]); w.w = cvt_pk_bf16(acc[ai][bj][m][1][2], acc[ai][bj][m][1][3]);
#if EPIP_MODE == 3
                    __builtin_nontemporal_store(w, (GAS u32x4*)(Pb + (size_t)row * PPITCH + 256 * u.pn + 128 * bj + 32 * wc + 8 * fq));
#elif EPIP_MODE == 4
                    { GAS u32x4* ap_ = (GAS u32x4*)(Pb + (size_t)row * PPITCH + 256 * u.pn + 128 * bj + 32 * wc + 8 * fq); asm volatile("global_store_dwordx4 %0, %1, off sc0 sc1" :: "v"(ap_), "v"(w) : "memory"); }
#elif EPIP_MODE == 5
                    { GAS u32x4* ap_ = (GAS u32x4*)(Pb + (size_t)row * PPITCH + 256 * u.pn + 128 * bj + 32 * wc + 8 * fq); asm volatile("global_store_dwordx4 %0, %1, off sc1" :: "v"(ap_), "v"(w) : "memory"); }
#elif EPIP_MODE == 1
                    if (ai == 0) *(GAS u32x4*)(Pb + (size_t)row * PPITCH + 256 * u.pn + 128 * bj + 32 * wc + 8 * fq) = w; else if (w.x == 0x12345678u && w.y == w.z && w.w == 77u) Pb[0] = (bf16)1;
#else
                    *(GAS u32x4*)(Pb + (size_t)row * PPITCH + 256 * u.pn + 128 * bj + 32 * wc + 8 * fq) = w;
#endif
                } }
    }
};
#endif
struct EpiP {
    static constexpr bool PERM = true; static constexpr bool PERM2 = true; static constexpr int NST = 8;
    GAS bf16* P;
    __device__ __forceinline__ void operator()(const f32x4 (&acc)[2][2][4][2], const pg8::Unit& u, int wr, int wc, int fr, int fq) const {
        GAS unsigned char* Pb = (GAS unsigned char*)P + (size_t)u.e * NTOK * DM + (size_t)(u.pm * 4 + u.pn) * 65536 + (size_t)(((wr * 4 + wc) * 64 + fq * 16 + fr) * 16);
#pragma unroll
        for (int ai = 0; ai < 2; ++ai)
#pragma unroll
            for (int m = 0; m < 4; ++m) {
                u32x4 w; w.x = pk4_fp8(acc[ai][0][m][0][0], acc[ai][0][m][0][1], acc[ai][0][m][0][2], acc[ai][0][m][0][3]); w.y = pk4_fp8(acc[ai][0][m][1][0], acc[ai][0][m][1][1], acc[ai][0][m][1][2], acc[ai][0][m][1][3]);
                w.z = pk4_fp8(acc[ai][1][m][0][0], acc[ai][1][m][0][1], acc[ai][1][m][0][2], acc[ai][1][m][0][3]); w.w = pk4_fp8(acc[ai][1][m][1][0], acc[ai][1][m][1][1], acc[ai][1][m][1][2], acc[ai][1][m][1][3]);
                __builtin_nontemporal_store(w, (GAS u32x4*)(Pb + (ai * 4 + m) * 8192)); }
    }
};
struct EpiGM {
    static constexpr bool PERM = true; static constexpr bool PERM2 = true; static constexpr int NST = 8;
    const GAS bf16* P; GAS bf16* HM;
    __device__ __forceinline__ void operator()(const f32x4 (&acc)[2][2][4][2], const pg8::Unit& u, int wr, int wc, int fr, int fq) const {
        const int rowb = u.pm * 256 + wr * 64 + fr; const int br = u.e;
        const size_t lm = (size_t)(u.pm * 4 + u.pn) * 65536 + (size_t)(((wr * 4 + wc) * 64 + fq * 16 + fr) * 16);
        const GAS unsigned char* Pb = (const GAS unsigned char*)P + (size_t)br * NTOK * DM + lm;
        GAS unsigned char* HP = (GAS unsigned char*)P + (size_t)3 * NTOK * DM + lm;
        const int colb = 256 * u.pn + 64 * wc + 16 * fq;
#pragma unroll
        for (int ai = 0; ai < 2; ++ai) {
            u32x4 pv[4], ov[4];
#pragma unroll
            for (int m = 0; m < 4; ++m) { const int offp = (ai * 4 + m) * 8192;
                pv[m] = __builtin_nontemporal_load((const GAS u32x4*)(Pb + offp)); ov[m] = (br > 0) ? *(const GAS u32x4*)(HP + offp) : (u32x4){0u, 0u, 0u, 0u}; }
            __builtin_amdgcn_sched_barrier(0);
#pragma unroll
            for (int m = 0; m < 4; ++m) { const size_t off = (size_t)(rowb + ai * 128 + m * 16) * DM + colb; const int offp = (ai * 4 + m) * 8192;
                u32x4 w8;
#pragma unroll
                for (int bj = 0; bj < 2; ++bj) {
                    const unsigned px = bj ? pv[m].z : pv[m].x, py = bj ? pv[m].w : pv[m].y, ox = bj ? ov[m].z : ov[m].x, oy = bj ? ov[m].w : ov[m].y;
                    const f32x2 p01 = __builtin_amdgcn_cvt_pk_f32_fp8((int)px, false), p23 = __builtin_amdgcn_cvt_pk_f32_fp8((int)px, true), p45 = __builtin_amdgcn_cvt_pk_f32_fp8((int)py, false), p67 = __builtin_amdgcn_cvt_pk_f32_fp8((int)py, true);
                    const f32x2 o01 = __builtin_amdgcn_cvt_pk_f32_fp8((int)ox, false), o23 = __builtin_amdgcn_cvt_pk_f32_fp8((int)ox, true), o45 = __builtin_amdgcn_cvt_pk_f32_fp8((int)oy, false), o67 = __builtin_amdgcn_cvt_pk_f32_fp8((int)oy, true);
                    float x[8];
                    x[0] = p01.x * sigmoidf_(acc[ai][bj][m][0][0]) + o01.x; x[1] = p01.y * sigmoidf_(acc[ai][bj][m][0][1]) + o01.y; x[2] = p23.x * sigmoidf_(acc[ai][bj][m][0][2]) + o23.x; x[3] = p23.y * sigmoidf_(acc[ai][bj][m][0][3]) + o23.y;
                    x[4] = p45.x * sigmoidf_(acc[ai][bj][m][1][0]) + o45.x; x[5] = p45.y * sigmoidf_(acc[ai][bj][m][1][1]) + o45.y; x[6] = p67.x * sigmoidf_(acc[ai][bj][m][1][2]) + o67.x; x[7] = p67.y * sigmoidf_(acc[ai][bj][m][1][3]) + o67.y;
                    if (br < 2) { const unsigned a_ = pk4_fp8(x[0], x[1], x[2], x[3]), b_ = pk4_fp8(x[4], x[5], x[6], x[7]); if (bj == 0) { w8.x = a_; w8.y = b_; } else { w8.z = a_; w8.w = b_; } }
                    else { u32x4 w; w.x = cvt_pk_bf16(x[0], x[1]); w.y = cvt_pk_bf16(x[2], x[3]); w.z = cvt_pk_bf16(x[4], x[5]); w.w = cvt_pk_bf16(x[6], x[7]);
                        st16<2>((GAS u32x4*)(HM + off + 8 * bj), w); } }
                if (br < 2) *(GAS u32x4*)(HP + offp) = w8; }
            asm volatile("" ::: "memory");
        }
    }
};
struct EpiO {
    static constexpr bool PERM = true; static constexpr bool PERM2 = true; static constexpr int NST = 16;
    const GAS bf16* HBr; GAS bf16* T;
    __device__ __forceinline__ void operator()(const f32x4 (&acc)[2][2][4][2], const pg8::Unit& u, int wr, int wc, int fr, int fq) const {
        const int rowb = u.pm * 256 + wr * 64 + fr; const int colb = 256 * u.pn + 64 * wc + 16 * fq; GAS unsigned char* M8 = (GAS unsigned char*)T;
#pragma unroll
        for (int ai = 0; ai < 2; ++ai)
#pragma unroll
            for (int m = 0; m < 4; ++m) {
                u32x4 w; w.x = pk4_fp8(acc[ai][0][m][0][0], acc[ai][0][m][0][1], acc[ai][0][m][0][2], acc[ai][0][m][0][3]); w.y = pk4_fp8(acc[ai][0][m][1][0], acc[ai][0][m][1][1], acc[ai][0][m][1][2], acc[ai][0][m][1][3]);
                w.z = pk4_fp8(acc[ai][1][m][0][0], acc[ai][1][m][0][1], acc[ai][1][m][0][2], acc[ai][1][m][0][3]); w.w = pk4_fp8(acc[ai][1][m][1][0], acc[ai][1][m][1][1], acc[ai][1][m][1][2], acc[ai][1][m][1][3]);
                *(GAS u32x4*)(M8 + (size_t)(rowb + ai * 128 + m * 16) * DM + colb) = w; }
    }
};
struct EpiGU {
    static constexpr bool PERM = true; static constexpr int NST = 8;
    GAS bf16* HID; const GAS float* CW;
    __device__ __forceinline__ void operator()(const f32x4 (&acc)[2][2][4][2], const pg8::Unit& u, int wr, int wc, int fr, int fq) const {
        const int rowb = u.pm * 256 + wr * 64 + fr;
#pragma unroll
        for (int ai = 0; ai < 2; ++ai)
#pragma unroll
            for (int m = 0; m < 4; ++m) { const int row = rowb + ai * 128 + m * 16;
                float x[8];
#pragma unroll
                for (int i = 0; i < 8; ++i) x[i] = siluf_(acc[ai][0][m][i >> 2][i & 3]) * acc[ai][1][m][i >> 2][i & 3];
                u32x4 w; w.x = cvt_pk_bf16(x[0], x[1]); w.y = cvt_pk_bf16(x[2], x[3]); w.z = cvt_pk_bf16(x[4], x[5]); w.w = cvt_pk_bf16(x[6], x[7]);
                st16<4>((GAS u32x4*)(HID + (size_t)row * DEXP + 128 * u.pn + 32 * wc + 8 * fq), w); }
    }
};
struct EpiDN {
    static constexpr bool PERM = true; static constexpr bool PERM2 = true; static constexpr int NST = 16;
    GAS bf16* FF2;
    __device__ __forceinline__ void operator()(const f32x4 (&acc)[2][2][4][2], const pg8::Unit& u, int wr, int wc, int fr, int fq) const {
        const int rowb = u.pm * 256 + wr * 64 + fr; GAS unsigned char* F8 = (GAS unsigned char*)FF2;
#pragma unroll
        for (int ai = 0; ai < 2; ++ai)
#pragma unroll
            for (int m = 0; m < 4; ++m) { const int row = rowb + ai * 128 + m * 16;
                u32x4 w; w.x = pk4_fp8(acc[ai][0][m][0][0], acc[ai][0][m][0][1], acc[ai][0][m][0][2], acc[ai][0][m][0][3]); w.y = pk4_fp8(acc[ai][0][m][1][0], acc[ai][0][m][1][1], acc[ai][0][m][1][2], acc[ai][0][m][1][3]);
                w.z = pk4_fp8(acc[ai][1][m][0][0], acc[ai][1][m][0][1], acc[ai][1][m][0][2], acc[ai][1][m][0][3]); w.w = pk4_fp8(acc[ai][1][m][1][0], acc[ai][1][m][1][1], acc[ai][1][m][1][2], acc[ai][1][m][1][3]);
                *(GAS u32x4*)(F8 + (size_t)row * DM + 256 * u.pn + 64 * wc + 16 * fq) = w; }
    }
};
#ifndef EN_B1
#define EN_B1 1
#endif
#ifndef EN_B2
#define EN_B2 1
#endif
#ifndef EN_B3
#define EN_B3 1
#endif

template <int CTRL> __device__ __forceinline__ float dppf(float x) { return __builtin_bit_cast(float, __builtin_amdgcn_mov_dpp(__builtin_bit_cast(int, x), CTRL, 0xf, 0xf, true)); }
template <int CTRL> __device__ __forceinline__ int dppi(int x) { return __builtin_amdgcn_mov_dpp(x, CTRL, 0xf, 0xf, true); }
typedef short v4i16_t __attribute__((ext_vector_type(4)));
typedef int v2i_t __attribute__((ext_vector_type(2)));
typedef unsigned short u16x2 __attribute__((ext_vector_type(2)));
__device__ __forceinline__ v4i16_t ldtr(const LAS unsigned char* p) { return __builtin_amdgcn_ds_read_tr16_b64_v4i16((LAS v4i16_t*)p); }
__device__ __forceinline__ bf16x8 cat8(v4i16_t lo, v4i16_t hi) { bf16x8 r; r[0] = lo[0]; r[1] = lo[1]; r[2] = lo[2]; r[3] = lo[3]; r[4] = hi[0]; r[5] = hi[1]; r[6] = hi[2]; r[7] = hi[3]; return r; }
__device__ __forceinline__ int wave_total_i(int v) {
    v += dppi<0xB1>(v); v += dppi<0x4E>(v); v += dppi<0x141>(v); v += dppi<0x140>(v);
    return __builtin_amdgcn_readlane(v, 0) + __builtin_amdgcn_readlane(v, 16) + __builtin_amdgcn_readlane(v, 32) + __builtin_amdgcn_readlane(v, 48);
}
__device__ __forceinline__ void gmlp_unit(Frame& F, int l, int unit) {
    int tid = F.tid; asm volatile("" : "+v"(tid)); const int lane = tid & 63;
    const int chunk = unit >> 2, g = unit & 3, n0 = chunk * 128;
    const GAS bf16* PA = (const GAS bf16*)(F.ws + WS_PA); GAS bf16* Y = (GAS bf16*)(F.ws + WS_Y);
    LAS float* vln = (LAS float*)F.lds;
    LAS float* wl = (LAS float*)(F.lds + 65536);
    LAS float* st = (LAS float*)(F.lds + AUX_OFF);
    const GAS float* lng = ((const GAS float*)F.in[9]) + l * 512; const GAS float* lnb = ((const GAS float*)F.in[10]) + l * 512;
    for (int j = 0; j < 16; ++j) { const int s = F.wave * 16 + j;
        const u32x4 w = *(const GAS u32x4*)(PA + (size_t)(n0 + s) * NPA + PA_CV + 8 * lane);
        float x[8] = {bflo(w.x), bfhi(w.x), bflo(w.y), bfhi(w.y), bflo(w.z), bfhi(w.z), bflo(w.w), bfhi(w.w)};
        float sm = 0.f;
#pragma unroll
        for (int i = 0; i < 8; ++i) sm += x[i];
        const float mean = wave_sum(sm, lane) * (1.f / 512.f); float q = 0.f;
#pragma unroll
        for (int i = 0; i < 8; ++i) { const float d = x[i] - mean; q += d * d; }
        const float rstd = 1.f / sqrtf(wave_sum(q, lane) * (1.f / 512.f) + LN_EPS);
        if (lane == 0) { st[2 * s] = mean; st[2 * s + 1] = rstd; } }
    __syncthreads();
#pragma unroll
    for (int i = 0; i < 4; ++i) { const int q = tid + 512 * i, s = q >> 4, d0 = (q & 15) * 8;
        const u32x4 w = *(const GAS u32x4*)(PA + (size_t)(n0 + s) * NPA + PA_CV + g * 128 + d0);
        const float mean = st[2 * s], rstd = st[2 * s + 1];
        float x[8] = {bflo(w.x), bfhi(w.x), bflo(w.y), bfhi(w.y), bflo(w.z), bfhi(w.z), bflo(w.w), bfhi(w.w)};
#pragma unroll
        for (int k = 0; k < 8; ++k) x[k] = (x[k] - mean) * rstd * lng[g * 128 + d0 + k] + lnb[g * 128 + d0 + k];
        *(LAS f32x4*)(vln + s * 128 + d0) = (f32x4){x[0], x[1], x[2], x[3]}; *(LAS f32x4*)(vln + s * 128 + d0 + 4) = (f32x4){x[4], x[5], x[6], x[7]}; }
    const GAS float* ws = ((const GAS float*)F.in[11]) + ((size_t)l * 4 + g) * 128 * 128;
#pragma unroll
    for (int i = 0; i < 8; ++i) { const int q = tid + 512 * i, t = q >> 5, s0 = (q & 31) * 4;
        f32x4 w = *(const GAS f32x4*)(ws + t * 128 + s0);
        if (s0 + 0 > t) w.x = 0.f; if (s0 + 1 > t) w.y = 0.f; if (s0 + 2 > t) w.z = 0.f; if (s0 + 3 > t) w.w = 0.f;
        *(LAS f32x4*)(wl + t * 128 + s0) = w; }
    __syncthreads();
    const int d = tid & 127, tq = __builtin_amdgcn_readfirstlane(tid >> 7);
    float vr[128];
#pragma unroll
    for (int sb = 0; sb < 4; ++sb)
        if (sb <= tq) {
#pragma unroll
            for (int s = 0; s < 32; ++s) vr[sb * 32 + s] = vln[(sb * 32 + s) * 128 + d];
        } else {
#pragma unroll
            for (int s = 0; s < 32; ++s) vr[sb * 32 + s] = 0.f;
        }
    const GAS float* bs = ((const GAS float*)F.in[12]) + ((size_t)l * 4 + g) * 128;
#pragma unroll 1
    for (int ti = 0; ti < 32; ++ti) { const int t = tq * 32 + ti; float a = 0.f;
#pragma unroll
        for (int sb = 0; sb < 4; ++sb)
            if (sb <= tq) {
#pragma unroll
                for (int s4 = 0; s4 < 8; ++s4) { const f32x4 w = *(const LAS f32x4*)(wl + t * 128 + sb * 32 + s4 * 4);
                    a += w.x * vr[sb * 32 + s4 * 4] + w.y * vr[sb * 32 + s4 * 4 + 1] + w.z * vr[sb * 32 + s4 * 4 + 2] + w.w * vr[sb * 32 + s4 * 4 + 3]; }
            }
        const float uu = bf1(PA[(size_t)(n0 + t) * NPA + PA_CU + g * 128 + d]);
        Y[(size_t)(n0 + t) * 1536 + 1024 + g * 128 + d] = (bf16)f2bf(uu * (a + bs[t])); }
    __syncthreads();
}

__device__ __forceinline__ void gmlp16_unit(Frame& F, int l, int chunk) {
    const int lane = fresh_lane(), w = F.wave, tid = w * 64 + lane, fr = lane & 15, fq = lane >> 4;
    const size_t n0 = (size_t)chunk * 128;
    const GAS bf16* PA = (const GAS bf16*)(F.ws + WS_PA); GAS bf16* Y = (GAS bf16*)(F.ws + WS_Y);
    LAS unsigned char* VT = F.lds;
    LAS unsigned char* WT = F.lds + 32768;
    LAS float* st = (LAS float*)(F.lds + AUX_OFF);
    const GAS float* lng = ((const GAS float*)F.in[9]) + l * 512; const GAS float* lnb = ((const GAS float*)F.in[10]) + l * 512;
    u32x2 xv[4]; f32x4 wv0[4], wv1[4];
#define GM_LOAD(g_) do { const GAS float* ws_ = ((const GAS float*)F.in[11]) + ((size_t)l * 4 + (g_)) * 128 * 128; \
        _Pragma("unroll") for (int i = 0; i < 4; ++i) { const int q = tid + 512 * i, s = q >> 4, d0 = (q & 15) * 8; \
            xv[i] = __builtin_nontemporal_load((const GAS u32x2*)((const GAS unsigned char*)PA + (n0 + s) * PA_ROWB + pa8(PA_CV + (g_) * 128) + d0)); wv0[i] = *(const GAS f32x4*)(ws_ + s * 128 + d0); wv1[i] = *(const GAS f32x4*)(ws_ + s * 128 + d0 + 4); } } while (0)
    { u32x2 rw[16];
#pragma unroll
      for (int j = 0; j < 16; ++j) rw[j] = __builtin_nontemporal_load((const GAS u32x2*)((const GAS unsigned char*)PA + (n0 + w * 16 + j) * PA_ROWB + 512 * (12 + (lane >> 5)) + 8 * (lane & 31)));
      GM_LOAD(0);
      float a[16], b2[16];
#pragma unroll
      for (int j = 0; j < 16; ++j) { const u32x2 x4 = rw[j];
          const f32x2 e0 = __builtin_amdgcn_cvt_pk_f32_fp8((int)x4.x, false), e1 = __builtin_amdgcn_cvt_pk_f32_fp8((int)x4.x, true), e2 = __builtin_amdgcn_cvt_pk_f32_fp8((int)x4.y, false), e3 = __builtin_amdgcn_cvt_pk_f32_fp8((int)x4.y, true);
          const float x[8] = {e0.x, e0.y, e1.x, e1.y, e2.x, e2.y, e3.x, e3.y};
          float sm = 0.f, sq = 0.f;
#pragma unroll
          for (int i = 0; i < 8; ++i) { sm += x[i]; sq += x[i] * x[i]; }
          a[j] = sm; b2[j] = sq; }
#define GM_HALVE(n_, mask_, bit_) do { const bool hi_ = (lane >> (bit_)) & 1; _Pragma("unroll") for (int j = 0; j < (n_); ++j) { \
          const float sa_ = hi_ ? a[j] : a[j + (n_)], ka_ = hi_ ? a[j + (n_)] : a[j]; a[j] = ka_ + shx(sa_, (mask_), lane); \
          const float sb_ = hi_ ? b2[j] : b2[j + (n_)], kb_ = hi_ ? b2[j + (n_)] : b2[j]; b2[j] = kb_ + shx(sb_, (mask_), lane); } } while (0)
      GM_HALVE(8, 32, 5); GM_HALVE(4, 16, 4); GM_HALVE(2, 8, 3); GM_HALVE(1, 4, 2);
#undef GM_HALVE
      float sa = a[0], sb = b2[0];
      sa += shx(sa, 2, lane); sb += shx(sb, 2, lane); sa += shx(sa, 1, lane); sb += shx(sb, 1, lane);
      const float mean = sa * (1.f / 512.f); const float var = fmaxf(sb * (1.f / 512.f) - mean * mean, 0.f);
      if ((lane & 3) == 0) { const int s = w * 16 + ((lane >> 2) & 15); st[2 * s] = mean; st[2 * s + 1] = 1.f / sqrtf(var + LN_EPS); } }
    __syncthreads();
#pragma unroll 1
    for (int g = 0; g < 4; ++g) {
        const GAS float* bs = ((const GAS float*)F.in[12]) + ((size_t)l * 4 + g) * 128;
        const int t_ = 16 * w + fr; const float bt = bs[t_];
        unsigned uu[8];
#pragma unroll
        for (int nt = 0; nt < 8; ++nt) uu[nt] = *(const GAS unsigned*)((const GAS unsigned char*)PA + (n0 + t_) * PA_ROWB + pa8(PA_CU + g * 128) + 16 * nt + 4 * fq);
#pragma unroll
        for (int i = 0; i < 4; ++i) { const int q = tid + 512 * i, s = q >> 4, d0 = (q & 15) * 8;
            const u32x2 x4 = xv[i];
            const float mean = st[2 * s], rstd = st[2 * s + 1];
            const f32x2 e0 = __builtin_amdgcn_cvt_pk_f32_fp8((int)x4.x, false), e1 = __builtin_amdgcn_cvt_pk_f32_fp8((int)x4.x, true), e2 = __builtin_amdgcn_cvt_pk_f32_fp8((int)x4.y, false), e3 = __builtin_amdgcn_cvt_pk_f32_fp8((int)x4.y, true);
            float x[8] = {e0.x, e0.y, e1.x, e1.y, e2.x, e2.y, e3.x, e3.y};
            const f32x4 g0 = *(const GAS f32x4*)(lng + g * 128 + d0), g1 = *(const GAS f32x4*)(lng + g * 128 + d0 + 4), b0 = *(const GAS f32x4*)(lnb + g * 128 + d0), b1 = *(const GAS f32x4*)(lnb + g * 128 + d0 + 4);
#pragma unroll
            for (int k = 0; k < 8; ++k) x[k] = (x[k] - mean) * rstd * ((k < 4) ? g0[k & 3] : g1[k & 3]) + ((k < 4) ? b0[k & 3] : b1[k & 3]);
            u32x4 o; o.x = cvt_pk_bf16(x[0], x[1]); o.y = cvt_pk_bf16(x[2], x[3]); o.z = cvt_pk_bf16(x[4], x[5]); o.w = cvt_pk_bf16(x[6], x[7]);
            *(LAS u32x4*)(VT + s * 256 + d0 * 2) = o;
            const int t = s, s0 = d0;
            const f32x4 w0 = wv0[i], w1 = wv1[i];
            float wv[8] = {w0.x, w0.y, w0.z, w0.w, w1.x, w1.y, w1.z, w1.w};
#pragma unroll
            for (int k = 0; k < 8; ++k) wv[k] = (s0 + k <= t) ? wv[k] : 0.f;
            u32x4 ow; ow.x = cvt_pk_bf16(wv[0], wv[1]); ow.y = cvt_pk_bf16(wv[2], wv[3]); ow.z = cvt_pk_bf16(wv[4], wv[5]); ow.w = cvt_pk_bf16(wv[6], wv[7]);
            *(LAS u32x4*)(WT + t * 256 + s0 * 2) = ow; }
        if (g < 3) GM_LOAD(g + 1);
        __syncthreads();
        f32x4 acc[8];
#pragma unroll
        for (int nt = 0; nt < 8; ++nt) acc[nt] = (f32x4){0.f, 0.f, 0.f, 0.f};
        const int nks = (16 * w + 15) / 32 + 1;
#pragma unroll
        for (int ks = 0; ks < 4; ++ks) if (ks < nks) {
            const bf16x8 a = *(const LAS bf16x8*)(WT + (16 * w + fr) * 256 + (8 * fq + 32 * ks) * 2);
            const int srow = 32 * ks + 8 * fq + (fr >> 2);
#pragma unroll
            for (int nt = 0; nt < 8; ++nt) { const bf16x8 bv = cat8(ldtr(VT + srow * 256 + (16 * nt + 4 * (fr & 3)) * 2), ldtr(VT + (srow + 4) * 256 + (16 * nt + 4 * (fr & 3)) * 2));
                acc[nt] = __builtin_amdgcn_mfma_f32_16x16x32_bf16(bv, a, acc[nt], 0, 0, 0); } }
#pragma unroll
        for (int nt = 0; nt < 8; ++nt) { const int d0 = 16 * nt + 4 * fq; const f32x2 u01 = __builtin_amdgcn_cvt_pk_f32_fp8((int)uu[nt], false), u23 = __builtin_amdgcn_cvt_pk_f32_fp8((int)uu[nt], true);
            u32x2 wv; wv.x = pk2(u01.x * (acc[nt][0] + bt), u01.y * (acc[nt][1] + bt)); wv.y = pk2(u23.x * (acc[nt][2] + bt), u23.y * (acc[nt][3] + bt));
            *(GAS u32x2*)(Y + (n0 + t_) * 1536 + 1024 + g * 128 + d0) = wv; }
        __syncthreads();
    }
#undef GM_LOAD
}

__device__ __forceinline__ void gla_unit(Frame& F, int l, int unit) {
    int tid = F.tid; asm volatile("" : "+v"(tid));
    const int b = unit >> 2, h = unit & 3;
    const GAS bf16* PA = (const GAS bf16*)(F.ws + WS_PA); GAS bf16* Y = (GAS bf16*)(F.ws + WS_Y); const GAS float* GLR = (const GAS float*)(F.ws + WS_GLR);
    LAS float* wa = (LAS float*)F.lds;
    LAS float* ba = wa + 1024;
    LAS float* as_ = ba + 64;
    LAS float* qs = as_ + 1024;
    LAS float* ks = qs + 1024;
    LAS float* vs = ks + 1024;
    LAS float* part = vs + 2048;
    for (int i = tid; i < 1024; i += 512) wa[i] = ((const GAS float*)F.in[6])[(size_t)l * 16 * 256 + (i >> 6) * 256 + h * 64 + (i & 63)];
    if (tid < 64) ba[tid] = ((const GAS float*)F.in[7])[l * 256 + h * 64 + tid];
    const GAS float* gng = ((const GAS float*)F.in[8]) + l * 128;
    const int v = tid & 127, kq = __builtin_amdgcn_readfirstlane(tid >> 7);
    float S[16];
#pragma unroll
    for (int j = 0; j < 16; ++j) S[j] = 0.f;
    __syncthreads();
    for (int t0 = 0; t0 < SEQ; t0 += 16) {
        const size_t nb = (size_t)b * SEQ + t0;
#pragma unroll
        for (int i = 0; i < 2; ++i) { const int e = tid + 512 * i, t = e >> 6, k = e & 63; float z = ba[k];
#pragma unroll
            for (int r = 0; r < 16; ++r) z += GLR[(nb + t) * 16 + r] * wa[r * 64 + k];
            const float ls = fminf(z, 0.f) - log1pf(__expf(-fabsf(z)));
            as_[e] = __expf(ls * (1.f / 16.f));
            qs[e] = bf1(PA[(nb + t) * NPA + PA_BQ + h * 64 + k]); ks[e] = bf1(PA[(nb + t) * NPA + PA_BK + h * 64 + k]); }
#pragma unroll
        for (int i = 0; i < 4; ++i) { const int e = tid + 512 * i, t = e >> 7, vv = e & 127; vs[e] = bf1(PA[(nb + t) * NPA + PA_BV + h * 128 + vv]); }
        __syncthreads();
#pragma unroll 4
        for (int t = 0; t < 16; ++t) { const float vt = vs[t * 128 + v]; float p = 0.f;
#pragma unroll
            for (int j4 = 0; j4 < 4; ++j4) { const f32x4 a4 = *(const LAS f32x4*)(as_ + t * 64 + kq * 16 + j4 * 4), k4 = *(const LAS f32x4*)(ks + t * 64 + kq * 16 + j4 * 4), q4 = *(const LAS f32x4*)(qs + t * 64 + kq * 16 + j4 * 4);
#pragma unroll
                for (int j = 0; j < 4; ++j) { S[j4 * 4 + j] = a4[j] * S[j4 * 4 + j] + k4[j] * vt; p += q4[j] * S[j4 * 4 + j]; } }
            part[(kq * 16 + t) * 128 + v] = p; }
        __syncthreads();
        { const int t = tid >> 5, v4 = (tid & 31) * 4;
          f32x4 o = *(const LAS f32x4*)(part + (0 * 16 + t) * 128 + v4);
#pragma unroll
          for (int q = 1; q < 4; ++q) o += *(const LAS f32x4*)(part + (q * 16 + t) * 128 + v4);
          float ss = o.x * o.x + o.y * o.y + o.z * o.z + o.w * o.w;
#pragma unroll
          for (int sh = 1; sh < 32; sh <<= 1) ss += shx(ss, sh, tid & 63);
          const float r = 1.f / sqrtf(ss * (1.f / 128.f) + RMS_EPS);
          const f32x4 gg = *(const GAS f32x4*)(gng + v4);
          const u32x2 brw = *(const GAS u32x2*)(PA + (nb + t) * NPA + PA_BR + h * 128 + v4);
          u32x2 w; w.x = pk2(o.x * r * gg.x * bflo(brw.x), o.y * r * gg.y * bfhi(brw.x)); w.y = pk2(o.z * r * gg.z * bflo(brw.y), o.w * r * gg.w * bfhi(brw.y));
          *(GAS u32x2*)(Y + (nb + t) * 1536 + 512 + h * 128 + v4) = w; }
        __syncthreads();
    }
}

constexpr size_t WS_US = WS_WMOE, WS_DEC = WS_WMOE + 32 * MiB;
struct GlaLocRegs { bf16 q[8], k[8]; f32x4 gl; u32x4 vv[2]; };
struct GlaLocW { float wa[16]; float ba; int h; };
__device__ __forceinline__ void gla_local_load(Frame& F, int unit, int tid, int w, GlaLocRegs& R) {
    const int b = unit >> 8, h = (unit >> 6) & 3, c = unit & 63; const size_t n0 = (size_t)b * SEQ + 64 * c;
    const GAS bf16* PA = (const GAS bf16*)(F.ws + WS_PA); const GAS float* GLR = (const GAS float*)(F.ws + WS_GLR);
    const int k = tid & 63, seg = w;
#pragma unroll
    for (int i = 0; i < 8; ++i) { const int t = 8 * seg + i; R.q[i] = __builtin_nontemporal_load(PA + (n0 + t) * NPA + PA_BQ + h * 64 + k); R.k[i] = __builtin_nontemporal_load(PA + (n0 + t) * NPA + PA_BK + h * 64 + k); }
    R.gl = (tid < 256) ? *(const GAS f32x4*)(GLR + n0 * 16 + 4 * tid) : (f32x4){0.f, 0.f, 0.f, 0.f};
#pragma unroll
    for (int i = 0; i < 2; ++i) { const int piece = tid + 512 * i, row = piece >> 4, c16 = piece & 15; R.vv[i] = __builtin_nontemporal_load((const GAS u32x4*)(PA + (n0 + row) * NPA + PA_BV + h * 128 + 8 * c16)); }
}
__device__ __forceinline__ void gla_local_w(Frame& F, int l, int h, int tid, GlaLocW& W) {
    const int k = tid & 63;
#pragma unroll
    for (int r = 0; r < 16; ++r) W.wa[r] = ((const GAS float*)F.in[6])[(size_t)l * 16 * 256 + r * 256 + h * 64 + k];
    W.ba = ((const GAS float*)F.in[7])[l * 256 + h * 64 + k]; W.h = h;
}
__device__ __forceinline__ void gla_local_compute(Frame& F, int l, int unit, int lane, int tid, int w, const GlaLocRegs& R, const GlaLocW& W, bool dry = false) {
    const int fr = lane & 15, fq = lane >> 4;
    const int b = unit >> 8, h = (unit >> 6) & 3, c = unit & 63; const size_t n0 = (size_t)b * SEQ + 64 * c;
    GAS bf16* PA = (GAS bf16*)(F.ws + WS_PA); GAS bf16* Y = (GAS bf16*)(F.ws + WS_Y);
    GAS bf16* US = (GAS bf16*)(F.ws + WS_US) + (size_t)unit * 8192; GAS float* DEC = (GAS float*)(F.ws + WS_DEC) + unit * 64;
    LAS unsigned char* QT = F.lds; LAS unsigned char* KT = F.lds + 8192; LAS unsigned char* KD = F.lds + 16384; LAS unsigned char* VV = F.lds + 24576; LAS unsigned char* ATT = F.lds + 40960;
    LAS float* SEG = (LAS float*)(F.lds + 65536); LAS float* GL = (LAS float*)(F.lds + 71936);
    const int k = tid & 63, seg = w;
    float qv8[8], kv8[8];
#pragma unroll
    for (int i = 0; i < 8; ++i) { qv8[i] = bf1(R.q[i]); kv8[i] = bf1(R.k[i]); }
    if (tid < 256) *(LAS f32x4*)(GL + 4 * tid) = R.gl;
#pragma unroll
    for (int i = 0; i < 2; ++i) { const int piece = tid + 512 * i, row = piece >> 4, c16 = piece & 15; *(LAS u32x4*)(VV + row * 256 + c16 * 16) = R.vv[i]; }
    __syncthreads();
    float cum[8];
    { float run = 0.f;
#pragma unroll
      for (int i = 0; i < 8; ++i) { const int t = 8 * seg + i; float z = W.ba;
          const f32x4 g0 = *(const LAS f32x4*)(GL + t * 16), g1 = *(const LAS f32x4*)(GL + t * 16 + 4), g2 = *(const LAS f32x4*)(GL + t * 16 + 8), g3 = *(const LAS f32x4*)(GL + t * 16 + 12);
#pragma unroll
          for (int r = 0; r < 4; ++r) { z += g0[r] * W.wa[r]; z += g1[r] * W.wa[4 + r]; z += g2[r] * W.wa[8 + r]; z += g3[r] * W.wa[12 + r]; }
          const float ls = fminf(z, 0.f) - __logf(1.f + __expf(-fabsf(z)));
          run += ls * (1.f / 16.f); cum[i] = run; }
      SEG[seg * 64 + k] = run; }
    __syncthreads();
    { float off = 0.f, blast = 0.f;
#pragma unroll
      for (int s2 = 0; s2 < 8; ++s2) { const float sv = SEG[s2 * 64 + k]; blast += sv; off += (s2 < seg) ? sv : 0.f; }
      const float eblast = __expf(blast);
#pragma unroll
      for (int i = 0; i < 8; ++i) { const int t = 8 * seg + i; const float bb = cum[i] + off;
          const float qv = qv8[i], kv = kv8[i];
          const float kt = kv * __expf(-bb);
          const unsigned qk = cvt_pk_bf16(qv * __expf(bb), kt), kd = cvt_pk_bf16(kt * eblast, 0.f);
          ((LAS unsigned short*)QT)[t * 64 + k] = (unsigned short)qk; ((LAS unsigned short*)KT)[t * 64 + k] = (unsigned short)(qk >> 16); ((LAS unsigned short*)KD)[t * 64 + k] = (unsigned short)kd;
          if (!dry) PA[(n0 + t) * NPA + PA_BQ + h * 64 + k] = (bf16)qk; }
      if (seg == 0) DEC[k] = eblast; }
    __syncthreads();
#pragma unroll
    for (int ii = 0; ii < 2; ++ii) { const int id = 2 * w + ii, ts = id >> 2, tt = id & 3;
        f32x4 d = {0.f, 0.f, 0.f, 0.f};
        if (ts <= tt) {
#pragma unroll
            for (int ks = 0; ks < 2; ++ks) { const bf16x8 a = *(const LAS bf16x8*)(KT + (16 * ts + fr) * 128 + (8 * fq + 32 * ks) * 2), bq = *(const LAS bf16x8*)(QT + (16 * tt + fr) * 128 + (8 * fq + 32 * ks) * 2);
                d = __builtin_amdgcn_mfma_f32_16x16x32_bf16(a, bq, d, 0, 0, 0); } }
        const int t = 16 * tt + fr, s0 = 16 * ts + 4 * fq;
        u32x2 pk; pk.x = cvt_pk_bf16((s0 <= t) ? d[0] : 0.f, (s0 + 1 <= t) ? d[1] : 0.f); pk.y = cvt_pk_bf16((s0 + 2 <= t) ? d[2] : 0.f, (s0 + 3 <= t) ? d[3] : 0.f);
        *(LAS u32x2*)(ATT + t * 128 + s0 * 2) = pk; }
    __syncthreads();
    { const int tr = w & 3, nh = w >> 2;
      f32x4 ao[4], au[4];
#pragma unroll
      for (int j = 0; j < 4; ++j) { ao[j] = (f32x4){0.f, 0.f, 0.f, 0.f}; au[j] = (f32x4){0.f, 0.f, 0.f, 0.f}; }
#pragma unroll
      for (int ks = 0; ks < 2; ++ks) {
          const bf16x8 aA = *(const LAS bf16x8*)(ATT + (16 * tr + fr) * 128 + (8 * fq + 32 * ks) * 2);
          const int srow = 32 * ks + 8 * fq + (fr >> 2);
          const bf16x8 aK = cat8(ldtr(KD + srow * 128 + (16 * tr + 4 * (fr & 3)) * 2), ldtr(KD + (srow + 4) * 128 + (16 * tr + 4 * (fr & 3)) * 2));
#pragma unroll
          for (int j = 0; j < 4; ++j) { const int nt = 4 * nh + j;
              const bf16x8 bv = cat8(ldtr(VV + srow * 256 + (16 * nt + 4 * (fr & 3)) * 2), ldtr(VV + (srow + 4) * 256 + (16 * nt + 4 * (fr & 3)) * 2));
              ao[j] = __builtin_amdgcn_mfma_f32_16x16x32_bf16(bv, aA, ao[j], 0, 0, 0);
              au[j] = __builtin_amdgcn_mfma_f32_16x16x32_bf16(bv, aK, au[j], 0, 0, 0); } }
#pragma unroll
      for (int j = 0; j < 4; ++j) { const int v0 = 16 * (4 * nh + j) + 4 * fq, row = 16 * tr + fr;
          u32x2 wo; wo.x = pk2(ao[j][0], ao[j][1]); wo.y = pk2(ao[j][2], ao[j][3]); *(GAS u32x2*)(Y + (n0 + row) * 1536 + 512 + h * 128 + v0) = wo;
          u32x2 wu; wu.x = pk2(au[j][0], au[j][1]); wu.y = pk2(au[j][2], au[j][3]); *(GAS u32x2*)(US + row * 128 + v0) = wu; } }
    __syncthreads();
}
__device__ __forceinline__ void gla_scan_phase(Frame& F, bool dry = false) {
    GAS bf16* USb = (GAS bf16*)(F.ws + WS_US); const GAS float* DECb = (const GAS float*)(F.ws + WS_DEC); const size_t dofs = dry ? (size_t)((GAS unsigned char*)F.H - (F.ws + WS_US)) / 4 : 0;
    for (int gt = F.wg * 512 + F.tid; gt < 131072; gt += F.G * 512) { const int e0 = 2 * gt, bh = e0 >> 13, kv = e0 & 8191, k = kv >> 7;
        GAS unsigned* p = (GAS unsigned*)(USb + (size_t)bh * 64 * 8192 + kv); const GAS float* dp = DECb + bh * 64 * 64 + k;
        float s0 = 0.f, s1 = 0.f;
#pragma unroll 8
        for (int c = 0; c < 64; ++c) { const unsigned u = p[(size_t)c * 4096]; const float d = dp[c * 64];
            p[(size_t)c * 4096 + dofs] = pk2(s0, s1);
            s0 = d * s0 + bflo(u); s1 = d * s1 + bfhi(u); } }
}
struct GlaOutRegs { u32x4 us[2]; bf16x8 aq[2]; u32x2 oi[4]; unsigned br[4]; };
__device__ __forceinline__ void gla_out_load(Frame& F, int unit, int tid, int w, int fr, int fq, GlaOutRegs& R) {
    const int b = unit >> 8, h = (unit >> 6) & 3, c = unit & 63; const size_t n0 = (size_t)b * SEQ + 64 * c;
    const GAS bf16* PA = (const GAS bf16*)(F.ws + WS_PA); const GAS bf16* Y = (const GAS bf16*)(F.ws + WS_Y);
    const GAS bf16* US = (const GAS bf16*)(F.ws + WS_US) + (size_t)unit * 8192;
    const int tr = w >> 1, nh = w & 1, row = 16 * tr + fr;
#pragma unroll
    for (int i = 0; i < 2; ++i) R.us[i] = *(const GAS u32x4*)(US + (tid + 512 * i) * 8);
#pragma unroll
    for (int ks = 0; ks < 2; ++ks) R.aq[ks] = *(const GAS bf16x8*)(PA + (n0 + row) * NPA + PA_BQ + h * 64 + 8 * fq + 32 * ks);
#pragma unroll
    for (int j = 0; j < 4; ++j) { const int v0 = 16 * (4 * nh + j) + 4 * fq; R.oi[j] = *(const GAS u32x2*)(Y + (n0 + row) * 1536 + 512 + h * 128 + v0); R.br[j] = *(const GAS unsigned*)((const GAS unsigned char*)PA + (n0 + row) * PA_ROWB + pa8(PA_BR + h * 128) + v0); }
}
__device__ __forceinline__ void gla_out_compute(Frame& F, int l, int unit, int tid, int lane, int w, int fr, int fq, const GlaOutRegs& R, bool dry = false) {
    const int b = unit >> 8, h = (unit >> 6) & 3, c = unit & 63; const size_t n0 = (size_t)b * SEQ + 64 * c;
    GAS bf16* Y = dry ? (GAS bf16*)F.H : (GAS bf16*)(F.ws + WS_Y);
    LAS unsigned char* SS = F.lds;
    LAS float* PS = (LAS float*)(F.lds + 16384);
    const GAS float* gng = ((const GAS float*)F.in[8]) + l * 128;
#pragma unroll
    for (int i = 0; i < 2; ++i) *(LAS u32x4*)(SS + (tid + 512 * i) * 16) = R.us[i];
    __syncthreads();
    const int tr = w >> 1, nh = w & 1, row = 16 * tr + fr;
    f32x4 acc[4];
#pragma unroll
    for (int j = 0; j < 4; ++j) acc[j] = (f32x4){0.f, 0.f, 0.f, 0.f};
#pragma unroll
    for (int ks = 0; ks < 2; ++ks) { const int krow = 32 * ks + 8 * fq + (fr >> 2);
#pragma unroll
        for (int j = 0; j < 4; ++j) { const int nt = 4 * nh + j;
            const bf16x8 bs = cat8(ldtr(SS + krow * 256 + (16 * nt + 4 * (fr & 3)) * 2), ldtr(SS + (krow + 4) * 256 + (16 * nt + 4 * (fr & 3)) * 2));
            acc[j] = __builtin_amdgcn_mfma_f32_16x16x32_bf16(bs, R.aq[ks], acc[j], 0, 0, 0); } }
    float ss = 0.f;
#pragma unroll
    for (int j = 0; j < 4; ++j) { const u32x2 oi = R.oi[j];
        acc[j][0] += bflo(oi.x); acc[j][1] += bfhi(oi.x); acc[j][2] += bflo(oi.y); acc[j][3] += bfhi(oi.y);
        ss += (acc[j][0] * acc[j][0] + acc[j][1] * acc[j][1]) + (acc[j][2] * acc[j][2] + acc[j][3] * acc[j][3]); }
    ss += shx(ss, 16, lane); ss += shx(ss, 32, lane);
    if (fq == 0) PS[row * 2 + nh] = ss;
    __syncthreads();
    { const float rinv = 1.f / sqrtf((PS[row * 2] + PS[row * 2 + 1]) * (1.f / 128.f) + RMS_EPS);
#pragma unroll
      for (int j = 0; j < 4; ++j) { const int v0 = 16 * (4 * nh + j) + 4 * fq; const f32x4 gg = *(const GAS f32x4*)(gng + v0); const f32x2 b01 = __builtin_amdgcn_cvt_pk_f32_fp8((int)R.br[j], false), b23 = __builtin_amdgcn_cvt_pk_f32_fp8((int)R.br[j], true);
          u32x2 wv; wv.x = pk2(acc[j][0] * rinv * gg[0] * b01.x, acc[j][1] * rinv * gg[1] * b01.y); wv.y = pk2(acc[j][2] * rinv * gg[2] * b23.x, acc[j][3] * rinv * gg[3] * b23.y);
          *(GAS u32x2*)(Y + (n0 + row) * 1536 + 512 + h * 128 + v0) = wv; } }
    __syncthreads();
}
constexpr int DSA_WAVE_LDS = 17920;
__device__ __forceinline__ void dsa_unit(Frame& F, int unit) {
    int lane = F.lane; asm volatile("" : "+v"(lane)); const int w = F.wave;
    const int qb = 4095 - unit;
    const int b = qb & 7, t = (qb >> 3) * 8 + w;
    const size_t n = (size_t)b * SEQ + t, nb0 = (size_t)b * SEQ;
    const GAS bf16* PA = (const GAS bf16*)(F.ws + WS_PA); GAS bf16* Y = (GAS bf16*)(F.ws + WS_Y);
    const GAS bf16* KI = (const GAS bf16*)(F.ws + WS_KI); const GAS bf16* KA = (const GAS bf16*)(F.ws + WS_KA); const GAS bf16* VA = (const GAS bf16*)(F.ws + WS_VA);
    const GAS float* WI = (const GAS float*)(F.ws + WS_WI);
    LAS unsigned char* base = F.lds + w * DSA_WAVE_LDS;
    LAS unsigned* sc = (LAS unsigned*)base;
    LAS float* qi = (LAS float*)(base + 16384);
    LAS unsigned short* list = (LAS unsigned short*)(base + 16384 + 1024);
    { const u32x2 q2 = *(const GAS u32x2*)(PA + n * NPA + PA_QI + 4 * lane);
      *(LAS f32x4*)(qi + 4 * lane) = (f32x4){bflo(q2.x), bfhi(q2.x), bflo(q2.y), bfhi(q2.y)}; }
    asm volatile("s_waitcnt lgkmcnt(0)" ::: "memory");
    const f32x4 wi = {ld_f32(WI + n * 4), ld_f32(WI + n * 4 + 1), ld_f32(WI + n * 4 + 2), ld_f32(WI + n * 4 + 3)};
    const int nbat = (t >> 6) + 1;
    for (int kb = 0; kb < nbat; ++kb) { const int key = kb * 64 + lane, kc = key <= t ? key : t;
        const GAS u32x4* kp = (const GAS u32x4*)(KI + (nb0 + kc) * 64);
        float kf[64];
#pragma unroll
        for (int c = 0; c < 8; ++c) { const u32x4 kk = kp[c]; kf[8 * c] = bflo(kk.x); kf[8 * c + 1] = bfhi(kk.x); kf[8 * c + 2] = bflo(kk.y); kf[8 * c + 3] = bfhi(kk.y); kf[8 * c + 4] = bflo(kk.z); kf[8 * c + 5] = bfhi(kk.z); kf[8 * c + 6] = bflo(kk.w); kf[8 * c + 7] = bfhi(kk.w); }
        float score = 0.f;
#pragma unroll
        for (int h = 0; h < 4; ++h) { float d = 0.f;
#pragma unroll
            for (int c = 0; c < 16; ++c) { const f32x4 q4 = *(const LAS f32x4*)(qi + h * 64 + 4 * c); d += q4.x * kf[4 * c] + q4.y * kf[4 * c + 1] + q4.z * kf[4 * c + 2] + q4.w * kf[4 * c + 3]; }
            score += wi[h] * fmaxf(d, 0.f); }
        if (score == 0.f) score = 0.f;
        unsigned u = __builtin_bit_cast(unsigned, score); u = (u & 0x80000000u) ? ~u : (u | 0x80000000u);
        sc[key] = key <= t ? u : 0u; }
    asm volatile("s_waitcnt lgkmcnt(0)" ::: "memory");
    int nsel;
    if (t >= 256) {
        unsigned T = 0u;
        for (int bit = 31; bit >= 0; --bit) { const unsigned cand = T | (1u << bit); int cnt = 0;
            for (int j = 0; j < nbat; ++j) cnt += (sc[j * 64 + lane] >= cand) ? 1 : 0;
            if (wave_sum_i(cnt, lane) >= 256) T = cand; }
        int cgt = 0;
        for (int j = 0; j < nbat; ++j) cgt += (sc[j * 64 + lane] > T) ? 1 : 0;
        const int need = 256 - wave_sum_i(cgt, lane);
        int selbase = 0, tiebase = 0;
        for (int j = 0; j < nbat; ++j) { const unsigned x = sc[j * 64 + lane]; const bool eq = (x == T), gt = (x > T);
            const unsigned long long beq = __ballot(eq); const unsigned long long lt = (1ull << lane) - 1ull;
            const int trank = tiebase + __popcll(beq & lt);
            const bool sel = gt || (eq && trank < need);
            const unsigned long long bsel = __ballot(sel);
            if (sel) list[selbase + __popcll(bsel & lt)] = (unsigned short)(j * 64 + lane);
            selbase += __popcll(bsel); tiebase += __popcll(beq); }
        nsel = 256;
    } else {
        nsel = t + 1;
        for (int i = lane; i < 256; i += 64) list[i] = (unsigned short)(i <= t ? i : 0);
    }
    asm volatile("s_waitcnt lgkmcnt(0)" ::: "memory");
    LAS float* qm = (LAS float*)base;
    LAS float* Pl = (LAS float*)(base + 2048);
    { const u32x4 q8 = *(const GAS u32x4*)(PA + n * NPA + PA_Q + 8 * lane);
      *(LAS f32x4*)(qm + 8 * lane) = (f32x4){bflo(q8.x), bfhi(q8.x), bflo(q8.y), bfhi(q8.y)}; *(LAS f32x4*)(qm + 8 * lane + 4) = (f32x4){bflo(q8.z), bfhi(q8.z), bflo(q8.w), bfhi(q8.w)}; }
    asm volatile("s_waitcnt lgkmcnt(0)" ::: "memory");
#pragma unroll 1
    for (int bb = 0; bb < 4; ++bb) { const int i = bb * 64 + lane; const bool valid = i < nsel; const int key = valid ? (int)list[i] : 0;
        const GAS u32x4* kp = (const GAS u32x4*)(KA + (nb0 + key) * 64);
        float kf[64];
#pragma unroll
        for (int c = 0; c < 8; ++c) { const u32x4 kk = kp[c]; kf[8 * c] = bflo(kk.x); kf[8 * c + 1] = bfhi(kk.x); kf[8 * c + 2] = bflo(kk.y); kf[8 * c + 3] = bfhi(kk.y); kf[8 * c + 4] = bflo(kk.z); kf[8 * c + 5] = bfhi(kk.z); kf[8 * c + 6] = bflo(kk.w); kf[8 * c + 7] = bfhi(kk.w); }
        float lgv[8];
#pragma unroll
        for (int h = 0; h < 8; ++h) { float d = 0.f;
#pragma unroll
            for (int c = 0; c < 16; ++c) { const f32x4 q4 = *(const LAS f32x4*)(qm + h * 64 + 4 * c); d += q4.x * kf[4 * c] + q4.y * kf[4 * c + 1] + q4.z * kf[4 * c + 2] + q4.w * kf[4 * c + 3]; }
            lgv[h] = valid ? d : -INFINITY; }
        *(LAS f32x4*)(Pl + i * 8) = (f32x4){lgv[0], lgv[1], lgv[2], lgv[3]}; *(LAS f32x4*)(Pl + i * 8 + 4) = (f32x4){lgv[4], lgv[5], lgv[6], lgv[7]}; }
    asm volatile("s_waitcnt lgkmcnt(0)" ::: "memory");
    float lg[4][8];
#pragma unroll
    for (int bb = 0; bb < 4; ++bb) { const f32x4 a = *(const LAS f32x4*)(Pl + (bb * 64 + lane) * 8), c = *(const LAS f32x4*)(Pl + (bb * 64 + lane) * 8 + 4);
        lg[bb][0] = a.x; lg[bb][1] = a.y; lg[bb][2] = a.z; lg[bb][3] = a.w; lg[bb][4] = c.x; lg[bb][5] = c.y; lg[bb][6] = c.z; lg[bb][7] = c.w; }
    float den[8];
#pragma unroll
    for (int h = 0; h < 8; ++h) { float m = fmaxf(fmaxf(lg[0][h], lg[1][h]), fmaxf(lg[2][h], lg[3][h])); m = wave_max(m, lane); float s = 0.f;
#pragma unroll
        for (int bb = 0; bb < 4; ++bb) { lg[bb][h] = __expf(lg[bb][h] - m); s += lg[bb][h]; }
        den[h] = wave_sum(s, lane); }
#pragma unroll
    for (int bb = 0; bb < 4; ++bb) { const int i = bb * 64 + lane;
        *(LAS f32x4*)(Pl + i * 8) = (f32x4){lg[bb][0], lg[bb][1], lg[bb][2], lg[bb][3]}; *(LAS f32x4*)(Pl + i * 8 + 4) = (f32x4){lg[bb][4], lg[bb][5], lg[bb][6], lg[bb][7]}; }
    asm volatile("s_waitcnt lgkmcnt(0)" ::: "memory");
    float o[8];
#pragma unroll
    for (int h = 0; h < 8; ++h) o[h] = 0.f;
#pragma unroll 4
    for (int i = 0; i < nsel; ++i) { const int key = (int)list[i]; const float vv = bf1(VA[(nb0 + key) * 64 + lane]);
        const f32x4 p0 = *(const LAS f32x4*)(Pl + i * 8), p1 = *(const LAS f32x4*)(Pl + i * 8 + 4);
        o[0] += p0.x * vv; o[1] += p0.y * vv; o[2] += p0.z * vv; o[3] += p0.w * vv; o[4] += p1.x * vv; o[5] += p1.y * vv; o[6] += p1.z * vv; o[7] += p1.w * vv; }
#pragma unroll
    for (int h = 0; h < 8; ++h) Y[n * 1536 + h * 64 + lane] = (bf16)f2bf(o[h] / den[h]);
}

__device__ __forceinline__ bf16x8 scale_pack8(u32x4 raw, float s) {
    u32x4 o; o.x = cvt_pk_bf16(bflo(raw.x) * s, bfhi(raw.x) * s); o.y = cvt_pk_bf16(bflo(raw.y) * s, bfhi(raw.y) * s); o.z = cvt_pk_bf16(bflo(raw.z) * s, bfhi(raw.z) * s); o.w = cvt_pk_bf16(bflo(raw.w) * s, bfhi(raw.w) * s);
    return __builtin_bit_cast(bf16x8, o);
}
__device__ __forceinline__ void dsa16_unit(Frame& F, int unit) {
    const int lane = fresh_lane(); const int w = F.wave;
    const int qb = 2047 - unit;
    const int b = qb & 7, t0 = (qb >> 3) * 16;
    const size_t nb0 = (size_t)b * SEQ;
    const GAS bf16* PA = (const GAS bf16*)(F.ws + WS_PA); GAS bf16* Y = (GAS bf16*)(F.ws + WS_Y);
    const GAS bf16* KI = (const GAS bf16*)(F.ws + WS_KI); const GAS bf16* KA = (const GAS bf16*)(F.ws + WS_KA); const GAS bf16* VA = (const GAS bf16*)(F.ws + WS_VA);
    const GAS float* WI = (const GAS float*)(F.ws + WS_WI);
    LAS unsigned char* K16 = F.lds;
    LAS unsigned short* LIST = (LAS unsigned short*)(F.lds + AUX_OFF);
    const int fr = lane & 15, fq = lane >> 4;
    {
        const int ql = fr >> 2, h = fr & 3;
        bf16x8 Bf[4][2]; f32x4 Linf[4];
#pragma unroll
        for (int g = 0; g < 4; ++g) { const size_t nq = nb0 + t0 + 4 * g + ql; const float wv = WI[nq * 4 + h];
#pragma unroll
            for (int ks = 0; ks < 2; ++ks) Bf[g][ks] = scale_pack8(*(const GAS u32x4*)(PA + nq * NPA + PA_QI + h * 64 + 8 * fq + 32 * ks), wv);
            const f32x4 w4 = *(const GAS f32x4*)(WI + (nb0 + t0 + 4 * g + fq) * 4);
#pragma unroll
            for (int r = 0; r < 4; ++r) Linf[g][r] = (w4[r] >= 0.f) ? INFINITY : -INFINITY; }
        const int ntiles = (t0 >> 4) + 1;
        const bool hist_on = (t0 >= 256); LAS unsigned* H0f = (LAS unsigned*)(F.lds + AUX_OFF + 8192) + fq * 256;
#ifndef S1_TT
#define S1_TT 2
#endif
        bf16x8 A0[S1_TT], A1[S1_TT];
#pragma unroll
        for (int j = 0; j < S1_TT; ++j) { const int tile = (w + 8 * j < ntiles) ? w + 8 * j : ntiles - 1; const size_t krow = (nb0 + 16 * tile + fr) * 64;
            A0[j] = *(const GAS bf16x8*)(KI + krow + 8 * fq); A1[j] = *(const GAS bf16x8*)(KI + krow + 32 + 8 * fq); }
#pragma unroll 1
        for (int tb = w; tb < ntiles; tb += 8 * S1_TT) {
            bf16x8 N0[S1_TT], N1[S1_TT];
#pragma unroll
            for (int j = 0; j < S1_TT; ++j) { const int tn = tb + 8 * S1_TT + 8 * j; const int tile = (tn < ntiles) ? tn : ntiles - 1; const size_t krow = (nb0 + 16 * tile + fr) * 64;
                N0[j] = *(const GAS bf16x8*)(KI + krow + 8 * fq); N1[j] = *(const GAS bf16x8*)(KI + krow + 32 + 8 * fq); }
#pragma unroll
            for (int j = 0; j < S1_TT; ++j) { const int tile = tb + 8 * j;
                if (tile < ntiles) {
                    const int kpos = 16 * tile + fr;
                    const int g7 = kpos >> 7, hf = (kpos >> 6) & 1, ln = kpos & 63;
                    const int koff = (g7 >> 2) * 1024 + ln * 16 + (g7 & 3) * 4 + hf * 2 + fq * 8192;
                    const bool lastt = (tile == ntiles - 1);
                    f32x4 d[4];
#pragma unroll
                    for (int g = 0; g < 4; ++g) d[g] = __builtin_amdgcn_mfma_f32_16x16x32_bf16(Bf[g][0], A0[j], (f32x4){0.f, 0.f, 0.f, 0.f}, 0, 0, 0);
#pragma unroll
                    for (int g = 0; g < 4; ++g) d[g] = __builtin_amdgcn_mfma_f32_16x16x32_bf16(Bf[g][1], A1[j], d[g], 0, 0, 0);
#pragma unroll
                    for (int g = 0; g < 4; ++g) {
                        const float s = ((__builtin_amdgcn_fmed3f(d[g][0], 0.f, Linf[g][0]) + __builtin_amdgcn_fmed3f(d[g][1], 0.f, Linf[g][1])) + (__builtin_amdgcn_fmed3f(d[g][2], 0.f, Linf[g][2]) + __builtin_amdgcn_fmed3f(d[g][3], 0.f, Linf[g][3]))) + 0.0f;
                        const _Float16 hh = (_Float16)s; const unsigned hb = (unsigned)__builtin_bit_cast(unsigned short, hh);
                        unsigned key = (hb ^ ((unsigned)((int)(hb << 16) >> 31) | 0x8000u)) & 0xffffu; if (lastt) key = (kpos <= t0 + 4 * g + fq) ? key : 0u;
                        *(LAS unsigned short*)(K16 + koff + g * 32768) = (unsigned short)key;
                        if (hist_on) __hip_atomic_fetch_add(H0f + g * 1024 + (key >> 8), 1u, __ATOMIC_RELAXED, __HIP_MEMORY_SCOPE_WORKGROUP); }
                }
            }
#pragma unroll
            for (int j = 0; j < S1_TT; ++j) { A0[j] = N0[j]; A1[j] = N1[j]; }
        }
    }
    __syncthreads();
    unsigned qwarm = 0u; if (lane < 8) qwarm = *(const GAS unsigned*)((const GAS unsigned char*)PA + (nb0 + t0 + 2 * w + (lane >> 2)) * PA_ROWB + 512 * ((lane >> 1) & 1) + 128 * (lane & 1));
    if (t0 < 256) {
#pragma unroll 1
        for (int qq = 0; qq < 2; ++qq) { const int q = 2 * w + qq, nvalid = t0 + q + 1; LAS unsigned short* list = LIST + q * 256;
            for (int i = lane; i < 256; i += 64) list[i] = (unsigned short)(i < nvalid ? i : 0); }
    } else {
#ifndef REP_S2
#define REP_S2 1
#endif
        LAS unsigned* hist = (LAS unsigned*)(F.lds + AUX_OFF + 8192) + w * 512;
        u32x4 hb0[2];
        hb0[0] = *(const LAS u32x4*)(hist + 4 * lane); hb0[1] = *(const LAS u32x4*)(hist + 256 + 4 * lane);
#pragma unroll 1
        for (int qq = 0; qq < 2 * REP_S2; ++qq) {
            const int q = 2 * w + (qq & 1), nvalid = t0 + q + 1;
            LAS unsigned short* list = LIST + q * 256;
            const int ngrp = (nvalid + 511) >> 9;
            unsigned P[32];
#pragma unroll
            for (int grp = 0; grp < 8; ++grp) {
                if (grp < ngrp) { const u32x4 r = *(const LAS u32x4*)(K16 + q * 8192 + grp * 1024 + lane * 16);
#pragma unroll
                    for (int i = 0; i < 4; ++i) { const int g = 4 * grp + i; const int thr = nvalid - 128 * g; unsigned rr = r[i];
                        if (thr < 128) rr &= ((lane < thr) ? 0xffffu : 0u) | ((lane < thr - 64) ? 0xffff0000u : 0u);
                        P[g] = rr; }
                } else {
#pragma unroll
                    for (int i = 0; i < 4; ++i) P[4 * grp + i] = 0u;
                }
            }
            unsigned one2 = 0x00010001u; asm volatile("" : "+v"(one2));
#define DSA_PKCOUNT(dst, c1) do { const unsigned c1p_ = (c1) | ((c1) << 16); unsigned a_ = 0u; \
                _Pragma("unroll") for (int grp = 0; grp < 8; ++grp) if (grp < ngrp) { _Pragma("unroll") for (int i = 0; i < 4; ++i) { unsigned y_; \
                    asm("v_pk_sub_u16 %0, %1, %2 clamp\n\tv_pk_min_u16 %0, %0, %3" : "=&v"(y_) : "v"(P[4 * grp + i]), "v"(c1p_), "v"(one2)); a_ += y_; } } \
                dst = (int)((a_ & 0xffffu) + (a_ >> 16)); } while (0)
            LAS unsigned* dmy4 = (LAS unsigned*)(K16 + q * 8192 + 512) + lane; LAS unsigned short* dmy2 = (LAS unsigned short*)(K16 + q * 8192) + lane;
            LAS unsigned* histl = hist + (lane & 1) * 256;
            unsigned T; int tot_gt, ties;
            { unsigned hi8 = 0u; int above = 0;
#pragma unroll
              for (int lvl = 0; lvl < 2; ++lvl) {
                  u32x4 hb;
                  if (lvl == 0) hb = (qq & 1) ? hb0[1] : hb0[0];
                  else {
                      { unsigned z_ = 0u; asm volatile("" : "+v"(z_)); *(LAS u32x4*)(hist + 4 * lane) = (u32x4){z_, z_, z_, z_}; *(LAS u32x4*)(hist + 256 + 4 * lane) = (u32x4){z_, z_, z_, z_}; }
                      asm volatile("s_waitcnt lgkmcnt(0)" ::: "memory");
#pragma unroll
                      for (int grp = 0; grp < 8; ++grp) if (grp < ngrp) {
#pragma unroll
                          for (int i = 0; i < 4; ++i) { const unsigned lo = P[4 * grp + i] & 0xffffu, hi = P[4 * grp + i] >> 16;
                              LAS unsigned* pl = ((lo >> 8) == hi8) ? histl + (lo & 0xffu) : dmy4; LAS unsigned* ph = ((hi >> 8) == hi8) ? histl + (hi & 0xffu) : dmy4;
                              __hip_atomic_fetch_add(pl, 1u, __ATOMIC_RELAXED, __HIP_MEMORY_SCOPE_WAVEFRONT); __hip_atomic_fetch_add(ph, 1u, __ATOMIC_RELAXED, __HIP_MEMORY_SCOPE_WAVEFRONT); } }
                      asm volatile("s_waitcnt lgkmcnt(0)" ::: "memory");
                      hb = *(const LAS u32x4*)(hist + 4 * lane) + *(const LAS u32x4*)(hist + 256 + 4 * lane);
                      { unsigned z_ = 0u; asm volatile("" : "+v"(z_)); *(LAS u32x4*)(hist + 4 * lane) = (u32x4){z_, z_, z_, z_}; *(LAS u32x4*)(hist + 256 + 4 * lane) = (u32x4){z_, z_, z_, z_}; }
                  }
                  const int sl = (int)(hb.x + hb.y + hb.z + hb.w);
                  int inc = sl;
                  inc += __builtin_amdgcn_update_dpp(0, inc, 0x111, 0xf, 0xf, false); inc += __builtin_amdgcn_update_dpp(0, inc, 0x112, 0xf, 0xf, false);
                  inc += __builtin_amdgcn_update_dpp(0, inc, 0x114, 0xf, 0xf, false); inc += __builtin_amdgcn_update_dpp(0, inc, 0x118, 0xf, 0xf, false);
                  const int r0 = __builtin_amdgcn_readlane(inc, 15), r1 = __builtin_amdgcn_readlane(inc, 31), r2 = __builtin_amdgcn_readlane(inc, 47), r3 = __builtin_amdgcn_readlane(inc, 63);
                  inc += (fq >= 1 ? r0 : 0) + (fq >= 2 ? r1 : 0) + (fq >= 3 ? r2 : 0);
                  const int total = r0 + r1 + r2 + r3;
                  const int want = 256 - above;
                  int run = total - inc;
                  int fb = -1, fa = 0;
                  { const int h3 = (int)hb.w, h2 = (int)hb.z, h1 = (int)hb.y, h0 = (int)hb.x;
                    if (run < want && run + h3 >= want) { fb = 3; fa = run; } run += h3;
                    if (run < want && run + h2 >= want) { fb = 2; fa = run; } run += h2;
                    if (run < want && run + h1 >= want) { fb = 1; fa = run; } run += h1;
                    if (run < want && run + h0 >= want) { fb = 0; fa = run; } }
                  const unsigned long long fm = __ballot(fb >= 0);
                  const int src = (int)__builtin_ctzll(fm);
                  const int bstar = __builtin_amdgcn_readlane(4 * lane + fb, src), abv = __builtin_amdgcn_readlane(fa, src);
                  const int hcnt = (fb == 3) ? (int)hb.w : (fb == 2) ? (int)hb.z : (fb == 1) ? (int)hb.y : (int)hb.x;
                  if (lvl == 0) { hi8 = (unsigned)bstar; above = abv; } else { T = (hi8 << 8) | (unsigned)bstar; tot_gt = above + abv; ties = __builtin_amdgcn_readlane(hcnt, src); }
              } }
            const bool alltie = (tot_gt + ties == 256);
            const unsigned thrT = alltie ? T : T + 1u;
            int c_l; DSA_PKCOUNT(c_l, thrT - 1u);
            int inc = c_l;
            inc += __builtin_amdgcn_update_dpp(0, inc, 0x111, 0xf, 0xf, false); inc += __builtin_amdgcn_update_dpp(0, inc, 0x112, 0xf, 0xf, false);
            inc += __builtin_amdgcn_update_dpp(0, inc, 0x114, 0xf, 0xf, false); inc += __builtin_amdgcn_update_dpp(0, inc, 0x118, 0xf, 0xf, false);
            { const int r0 = __builtin_amdgcn_readlane(inc, 15), r1 = __builtin_amdgcn_readlane(inc, 31), r2 = __builtin_amdgcn_readlane(inc, 47);
              inc += (fq >= 1 ? r0 : 0) + (fq >= 2 ? r1 : 0) + (fq >= 3 ? r2 : 0); }
            int kpos_ = inc - c_l;
#pragma unroll
            for (int grp = 0; grp < 8; ++grp) if (grp < ngrp) {
#pragma unroll
                for (int i = 0; i < 4; ++i) { const int g = 4 * grp + i; const unsigned lo = P[g] & 0xffffu, hi = P[g] >> 16;
                    { const bool s_ = lo >= thrT; LAS unsigned short* p_ = s_ ? list + kpos_ : dmy2; *p_ = (unsigned short)(128 * g + lane); kpos_ += s_ ? 1 : 0; }
                    { const bool s_ = hi >= thrT; LAS unsigned short* p_ = s_ ? list + kpos_ : dmy2; *p_ = (unsigned short)(128 * g + 64 + lane); kpos_ += s_ ? 1 : 0; } } }
            if (!alltie) {
                int rem = 256 - tot_gt, pos = tot_gt; const unsigned long long lt = (1ull << lane) - 1ull;
#pragma unroll
                for (int grp = 0; grp < 8; ++grp) if (grp < ngrp) {
#pragma unroll
                    for (int i = 0; i < 8; ++i) { const int g = 4 * grp + (i >> 1); const unsigned val = (i & 1) ? (P[g] >> 16) : (P[g] & 0xffffu);
                        const bool eq = (val == T); const unsigned long long beq = __ballot(eq);
                        if (beq != 0ull) { const int rank = __popcll(beq & lt); if (eq && rank < rem) list[pos + rank] = (unsigned short)(128 * g + 64 * (i & 1) + lane);
                            const int n = __popcll(beq), take = n < rem ? n : rem; pos += take; rem -= take; } } }
            }
#undef DSA_PKCOUNT
        }
    }
    asm volatile("s_waitcnt lgkmcnt(0)" ::: "memory");
    asm volatile("" :: "v"(qwarm));
    LAS unsigned char* Vs = F.lds + w * 16384;
#ifndef REP_S3
#define REP_S3 1
#endif
    const GAS unsigned char* KV8 = (const GAS unsigned char*)KA;
    const int st_off = (lane >> 3) * 128 + (((lane & 7) ^ ((lane >> 3) & 7)) * 16);
    const int rdk0 = fr * 128 + (((fq >> 1) ^ (fr & 7)) * 16) + 8 * (fq & 1), rdk1 = fr * 128 + (((2 + (fq >> 1)) ^ (fr & 7)) * 16) + 8 * (fq & 1);
    const int tr_r = (lane & 15) >> 1, tr_c = lane & 1;
    const int tr_row = 16 * (tr_r >> 2) + 4 * fq + (tr_r & 3);
    const int tr_sw = (4 * (fq & 1) + (tr_r & 3));
#pragma unroll 1
    for (int qq = 0; qq < 2 * REP_S3; ++qq) {
        const int q = 2 * w + (qq & 1), tq = t0 + q; const int nsel = (tq + 1 < 256) ? tq + 1 : 256;
        const size_t nq = nb0 + tq;
        const LAS unsigned short* list = LIST + q * 256;
        long Q8[2];
#pragma unroll
        for (int ks = 0; ks < 2; ++ks) { u32x2 raw = {0u, 0u}; if (fr < 8) raw = *(const GAS u32x2*)((const GAS unsigned char*)PA + nq * PA_ROWB + pa8(fr * 64) + 8 * fq + 32 * ks);
            Q8[ks] = (long)(((unsigned long long)raw.y << 32) | raw.x); }
        f32x4 acc[4];
#pragma unroll
        for (int nt = 0; nt < 4; ++nt) acc[nt] = (f32x4){0.f, 0.f, 0.f, 0.f};
        float mrun = -INFINITY, den = 0.f;
#pragma unroll
        for (int hb = 0; hb < 2; ++hb) {
#pragma unroll
            for (int ib = 0; ib < 2; ++ib) { u32x4 kv[8];
#pragma unroll
                for (int i = 0; i < 8; ++i) { const int piece = (8 * ib + i) * 64 + lane; const int key = (int)list[128 * hb + (piece >> 3)];
                    kv[i] = *(const GAS u32x4*)(KV8 + (nb0 + key) * 128 + 16 * (lane & 7)); }
                __builtin_amdgcn_sched_barrier(0);
#pragma unroll
                for (int i = 0; i < 8; ++i) *(LAS u32x4*)(Vs + st_off + (8 * ib + i) * 1024) = kv[i];
            }
            asm volatile("s_waitcnt lgkmcnt(0)" ::: "memory");
            float lh[8][4];
#pragma unroll
            for (int j = 0; j < 8; ++j) { const int tt = 8 * hb + j;
                const long A0 = *(const LAS long*)(Vs + rdk0 + j * 2048), A1 = *(const LAS long*)(Vs + rdk1 + j * 2048);
                f32x4 d = __builtin_amdgcn_mfma_f32_16x16x32_fp8_fp8(A0, Q8[0], (f32x4){0.f, 0.f, 0.f, 0.f}, 0, 0, 0);
                d = __builtin_amdgcn_mfma_f32_16x16x32_fp8_fp8(A1, Q8[1], d, 0, 0, 0);
#pragma unroll
                for (int r = 0; r < 4; ++r) lh[j][r] = (16 * tt + 4 * fq + r < nsel) ? d[r] * 0.125f : -INFINITY; }
            float mh = lh[0][0];
#pragma unroll
            for (int j = 0; j < 8; ++j)
#pragma unroll
                for (int r = 0; r < 4; ++r) mh = fmaxf(mh, lh[j][r]);
            mh = fmaxf(mh, shx(mh, 16, lane)); mh = fmaxf(mh, shx(mh, 32, lane));
            const float mnew = fmaxf(mrun, mh);
            const float scl = __expf(mrun - mnew);
            float dh = 0.f;
#pragma unroll
            for (int j = 0; j < 8; ++j)
#pragma unroll
                for (int r = 0; r < 4; ++r) { lh[j][r] = __expf(lh[j][r] - mnew); dh += lh[j][r]; }
            den = den * scl + dh; mrun = mnew;
#pragma unroll
            for (int nt = 0; nt < 4; ++nt) acc[nt] = acc[nt] * scl;
#pragma unroll
            for (int s4 = 0; s4 < 4; ++s4) {
                const unsigned plo = pk4_fp8(lh[2 * s4][0] * 256.f, lh[2 * s4][1] * 256.f, lh[2 * s4][2] * 256.f, lh[2 * s4][3] * 256.f), phi = pk4_fp8(lh[2 * s4 + 1][0] * 256.f, lh[2 * s4 + 1][1] * 256.f, lh[2 * s4 + 1][2] * 256.f, lh[2 * s4 + 1][3] * 256.f);
                const long P8 = (long)(((unsigned long long)phi << 32) | plo);
#pragma unroll
                for (int nt = 0; nt < 4; ++nt) {
                    const v2i_t vt = __builtin_amdgcn_ds_read_tr8_b64_v2i32((LAS v2i_t*)(Vs + (32 * s4 + tr_row) * 128 + (((4 + nt) ^ tr_sw) * 16) + 8 * tr_c));
                    const long V8 = (long)(((unsigned long long)(unsigned)vt[1] << 32) | (unsigned)vt[0]);
                    acc[nt] = __builtin_amdgcn_mfma_f32_16x16x32_fp8_fp8(V8, P8, acc[nt], 0, 0, 0); } }
            asm volatile("s_waitcnt lgkmcnt(0)" ::: "memory");
        }
        den += shx(den, 16, lane); den += shx(den, 32, lane);
        if (fr < 8) { const float rden = 1.f / (den * 256.f);
#pragma unroll
            for (int nt = 0; nt < 4; ++nt) { u32x2 wv; wv.x = pk2(acc[nt][0] * rden, acc[nt][1] * rden); wv.y = pk2(acc[nt][2] * rden, acc[nt][3] * rden);
                *(GAS u32x2*)(Y + nq * 1536 + fr * 64 + 16 * nt + 4 * fq) = wv; } }
    }
}

#ifdef GLA_NAIVE
constexpr int NGLA = 32;
#else
constexpr int NGLA = 2048;
#endif
#ifdef DSA_NAIVE
constexpr int NDSA = 4096;
#else
constexpr int NDSA = 2048;
#endif
#ifdef GMLP_NAIVE
constexpr int NGM = 1024;
#else
constexpr int NGM = 256;
#endif
__device__ __forceinline__ void phase_mixer(Frame& F, int l, int slot = 0, int types = 7, bool dry = false) {
    (void)slot;
    for (int i = F.tid; i < 4096; i += 512) ((LAS unsigned*)(F.lds + AUX_OFF + 8192))[i] = 0u;
    for (int j = 0; j * F.G < NDSA; ++j) { const int u = j * F.G + ((j & 1) ? (F.G - 1 - F.wg) : F.wg);
        if (u >= NDSA) continue;
        __syncthreads(); if (EN_B2 && (types & 2)) {
#ifdef DSA_NAIVE
        dsa_unit(F, u);
#else
        dsa16_unit(F, u);
#endif
    } }
#ifdef GLA_NAIVE
    for (int u = F.wg; u < NGLA; u += F.G) { __syncthreads(); if (EN_B1 && (types & 1)) gla_unit(F, l, u); }
#else
    if (EN_B1 && (types & 1)) { const int lane = fresh_lane(), w = F.wave, tid = w * 64 + lane;
        GlaLocRegs R, N; GlaLocW W; W.h = -1;
        if (F.wg < NGLA) gla_local_load(F, F.wg, tid, w, R);
#pragma unroll 1
        for (int u = F.wg; u < NGLA; u += F.G) { const int un = (u + F.G < NGLA) ? u + F.G : u;
            const int h = (u >> 6) & 3; if (h != W.h) gla_local_w(F, l, h, tid, W);
            gla_local_load(F, un, tid, w, N);
            __syncthreads();
            gla_local_compute(F, l, u, lane, tid, w, R, W, dry);
            R = N; } }
#endif
    for (int u = F.wg; u < NGM; u += F.G) { __syncthreads(); if (EN_B3 && (types & 4)) {
#ifdef GMLP_NAIVE
        gmlp_unit(F, l, u);
#else
        gmlp16_unit(F, l, u);
#endif
    } }
}
__device__ __forceinline__ void phase_gla_out(Frame& F, int l, bool dry = false) {
#ifndef GLA_NAIVE
    const int lane = fresh_lane(), w = F.wave, tid = w * 64 + lane, fr = lane & 15, fq = lane >> 4;
    GlaOutRegs R, N;
    if (F.wg < 2048) gla_out_load(F, F.wg, tid, w, fr, fq, R);
#pragma unroll 1
    for (int u = F.wg; u < 2048; u += F.G) { const int un = (u + F.G < 2048) ? u + F.G : u;
        gla_out_load(F, un, tid, w, fr, fq, N);
        gla_out_compute(F, l, u, tid, lane, w, fr, fq, R, dry);
        R = N; }
#endif
}

__device__ __forceinline__ void phase_mixer_merged(Frame& F, int l, const XcdBarrier& bar, gu32* cw) {
    const unsigned nloc = bar.st ? bar.st[0] : 0u;
    { const int lane = fresh_lane(), w = F.wave, tid = w * 64 + lane;
      GlaLocRegs R, N; GlaLocW W; W.h = -1;
      if (F.wg < NGLA) gla_local_load(F, F.wg, tid, w, R);
#pragma unroll 1
      for (int u = F.wg; u < NGLA; u += F.G) { const int un = (u + F.G < NGLA) ? u + F.G : u;
          const int h = (u >> 6) & 3; if (h != W.h) gla_local_w(F, l, h, tid, W);
          gla_local_load(F, un, tid, w, N);
          __syncthreads();
          gla_local_compute(F, l, u, lane, tid, w, R, W, false);
          R = N; } }
    for (int u = F.wg; u < NGM; u += F.G) { __syncthreads(); gmlp16_unit(F, l, u); }
    asm volatile("s_waitcnt vmcnt(0)" ::: "memory"); __syncthreads();
    if (nloc) hi_arrive_xcd(cw, cw + 128 + 4 * bar.x, nloc); else hi_arrive(cw);
    __syncthreads();
    for (int i = F.tid; i < 4096; i += 512) ((LAS unsigned*)(F.lds + AUX_OFF + 8192))[i] = 0u;
    for (int j = 0; j * F.G < NDSA; ++j) { const int u = j * F.G + ((j & 1) ? (F.G - 1 - F.wg) : F.wg);
        if (j == 2) { __syncthreads(); hi_wait(cw, (unsigned)F.G, (unsigned*)(F.ctl + CW_BAR));
            gla_scan_phase(F);
            asm volatile("s_waitcnt vmcnt(0)" ::: "memory"); __syncthreads();
            if (nloc) hi_arrive_xcd(cw + 64, cw + 192 + 4 * bar.x, nloc); else hi_arrive(cw + 64); }
        if (j == 4) { __syncthreads(); hi_wait(cw + 64, (unsigned)F.G, (unsigned*)(F.ctl + CW_BAR)); phase_gla_out(F, l); }
        if (u >= NDSA) continue;
        __syncthreads(); dsa16_unit(F, u); }
}

template <int CTRL> __device__ __forceinline__ float dpp_add(float v) { return v + dppf<CTRL>(v); }
__device__ __forceinline__ float row16_sum(float v) { v = dpp_add<0xB1>(v); v = dpp_add<0x4E>(v); v = dpp_add<0x141>(v); v = dpp_add<0x140>(v); return v; }
__device__ __forceinline__ void phase_ln_router(Frame& F, int l) {
    const GAS bf16* WRB = (const GAS bf16*)(F.ws + WS_WR) + (size_t)l * 48 * DM;
    LAS unsigned char* WB = F.lds;
    for (int i = F.tid; i < 48 * 128; i += 512) { const int n = i >> 7, c = i & 127; *(LAS u32x4*)(WB + n * 2048 + ((c ^ (n & 7)) * 16)) = *(const GAS u32x4*)(WRB + n * DM + 8 * c); }
    if (F.tid < 32) F.MISC[16 + F.tid] = 0u;
    __syncthreads();
    GAS bf16* HB = (GAS bf16*)(F.ws + WS_HB); const GAS unsigned char* M8 = (const GAS unsigned char*)F.H; GAS int* EID = (GAS int*)(F.ws + WS_ROUTE); GAS float* EW = (GAS float*)(F.ws + WS_ROUTE + 256 * 1024);
    const GAS float* g = ((const GAS float*)F.in[17]) + l * DM; const GAS float* bb = ((const GAS float*)F.in[18]) + l * DM; const GAS float* brg = ((const GAS float*)F.in[20]) + l * 4; const GAS float* bre = ((const GAS float*)F.in[22]) + l * 32;
    const int lane = fresh_lane();
    const int sub = lane & 15, rr = lane >> 4, fr = sub, fq = rr;
    LAS float* LG = (LAS float*)(F.lds + 98304) + F.wave * 768;
    for (int r0 = F.wg * 128; r0 < NTOK; r0 += F.G * 128) {
        const int m0 = r0 + F.wave * 16;
        u32x4 nx[8]; u32x2 nm[8];
#pragma unroll
        for (int q = 0; q < 8; ++q) { nx[q] = *(const GAS u32x4*)(HB + (size_t)(m0 + rr) * DM + 8 * (sub + 16 * q)); nm[q] = *(const GAS u32x2*)(M8 + (size_t)(m0 + rr) * DM + 8 * (sub + 16 * q)); }
#pragma unroll 1
        for (int j = 0; j < 4; ++j) { const int m = m0 + 4 * j + rr;
            float v[64]; float s = 0.f;
#pragma unroll
            for (int q = 0; q < 8; ++q) { const u32x4 x = nx[q]; const u32x2 mm = nm[q];
                const f32x2 m01 = __builtin_amdgcn_cvt_pk_f32_fp8((int)mm.x, false), m23 = __builtin_amdgcn_cvt_pk_f32_fp8((int)mm.x, true), m45 = __builtin_amdgcn_cvt_pk_f32_fp8((int)mm.y, false), m67 = __builtin_amdgcn_cvt_pk_f32_fp8((int)mm.y, true);
                v[8 * q] = bflo(x.x) * DN_ALPHA + m01.x; v[8 * q + 1] = bfhi(x.x) * DN_ALPHA + m01.y; v[8 * q + 2] = bflo(x.y) * DN_ALPHA + m23.x; v[8 * q + 3] = bfhi(x.y) * DN_ALPHA + m23.y;
                v[8 * q + 4] = bflo(x.z) * DN_ALPHA + m45.x; v[8 * q + 5] = bfhi(x.z) * DN_ALPHA + m45.y; v[8 * q + 6] = bflo(x.w) * DN_ALPHA + m67.x; v[8 * q + 7] = bfhi(x.w) * DN_ALPHA + m67.y; }
            { const int mn = (j < 3) ? m + 4 : m;
#pragma unroll
              for (int q = 0; q < 8; ++q) { nx[q] = *(const GAS u32x4*)(HB + (size_t)mn * DM + 8 * (sub + 16 * q)); nm[q] = *(const GAS u32x2*)(M8 + (size_t)mn * DM + 8 * (sub + 16 * q)); } }
#pragma unroll
            for (int i = 0; i < 64; ++i) s += v[i];
            const float mean = row16_sum(s) * (1.f / DM); float s2 = 0.f;
#pragma unroll
            for (int i = 0; i < 64; ++i) { v[i] -= mean; s2 += v[i] * v[i]; }
            const float rstd = 1.f / sqrtf(row16_sum(s2) * (1.f / DM) + LN_EPS);
#pragma unroll
            for (int q = 0; q < 8; ++q) { const int c = 8 * (sub + 16 * q); const f32x4 g0 = *(const GAS f32x4*)(g + c), g1 = *(const GAS f32x4*)(g + c + 4), b0 = *(const GAS f32x4*)(bb + c), b1 = *(const GAS f32x4*)(bb + c + 4);
#pragma unroll
                for (int i = 0; i < 4; ++i) { v[8 * q + i] = v[8 * q + i] * rstd * g0[i] + b0[i]; v[8 * q + 4 + i] = v[8 * q + 4 + i] * rstd * g1[i] + b1[i]; }
                u32x4 wv; wv.x = pk2(v[8 * q], v[8 * q + 1]); wv.y = pk2(v[8 * q + 2], v[8 * q + 3]); wv.z = pk2(v[8 * q + 4], v[8 * q + 5]); wv.w = pk2(v[8 * q + 6], v[8 * q + 7]);
                *(GAS u32x4*)(HB + (size_t)m * DM + c) = wv; } }
        asm volatile("s_waitcnt vmcnt(0)" ::: "memory");
        f32x4 acc[3];
#pragma unroll
        for (int nt = 0; nt < 3; ++nt) acc[nt] = (f32x4){0.f, 0.f, 0.f, 0.f};
#pragma unroll 1
        for (int kb = 0; kb < 4; ++kb) {
            bf16x8 af[8];
#pragma unroll
            for (int ks = 0; ks < 8; ++ks) af[ks] = *(const GAS bf16x8*)(HB + (size_t)(m0 + fr) * DM + 8 * fq + 32 * (8 * kb + ks));
#pragma unroll
            for (int ks = 0; ks < 8; ++ks) { const int c = fq + 4 * (8 * kb + ks);
#pragma unroll
                for (int nt = 0; nt < 3; ++nt) { const int n = 16 * nt + fr; const bf16x8 bw = *(const LAS bf16x8*)(WB + n * 2048 + ((c ^ (n & 7)) * 16));
                    acc[nt] = __builtin_amdgcn_mfma_f32_16x16x32_bf16(af[ks], bw, acc[nt], 0, 0, 0); } } }
#pragma unroll
        for (int nt = 0; nt < 3; ++nt)
#pragma unroll
            for (int r = 0; r < 4; ++r) LG[(4 * fq + r) * 48 + 16 * nt + fr] = acc[nt][r];
        asm volatile("s_waitcnt lgkmcnt(0)" ::: "memory");
        if (lane < 16) { const int m = m0 + lane; const LAS float* lgt = LG + lane * 48;
            int gi = 0; float gm = lgt[0] + brg[0];
#pragma unroll
            for (int q = 1; q < 4; ++q) { const float x = lgt[q] + brg[q]; if (x > gm) { gm = x; gi = q; } }
            float gs = 0.f;
#pragma unroll
            for (int q = 0; q < 4; ++q) gs += __expf(lgt[q] + brg[q] - gm);
            const float gp = 1.f / gs;
            float el[8];
#pragma unroll
            for (int q = 0; q < 8; ++q) el[q] = lgt[4 + 8 * gi + q] + bre[8 * gi + q];
            int i0 = 0; float v0 = el[0];
#pragma unroll
            for (int q = 1; q < 8; ++q) if (el[q] > v0) { v0 = el[q]; i0 = q; }
            int i1 = -1; float v1 = -INFINITY;
#pragma unroll
            for (int q = 0; q < 8; ++q) if (q != i0 && el[q] > v1) { v1 = el[q]; i1 = q; }
            const float ex = __expf(v1 - v0), w0 = gp / (1.f + ex), w1 = gp * ex / (1.f + ex);
            const int e0 = gi * 8 + i0, e1 = gi * 8 + i1;
            EID[2 * m] = e0; EID[2 * m + 1] = e1; EW[2 * m] = w0; EW[2 * m + 1] = w1;
            __hip_atomic_fetch_add((LAS unsigned*)(F.lds + MISC_OFF) + 16 + e0, 1u, __ATOMIC_RELAXED, __HIP_MEMORY_SCOPE_WORKGROUP);
            __hip_atomic_fetch_add((LAS unsigned*)(F.lds + MISC_OFF) + 16 + e1, 1u, __ATOMIC_RELAXED, __HIP_MEMORY_SCOPE_WORKGROUP); }
        asm volatile("s_waitcnt lgkmcnt(0)" ::: "memory");
    }
    __syncthreads();
    if (F.tid < 32) ((GAS int*)(F.ws + WS_CNTWG))[F.wg * 32 + F.tid] = (int)F.MISC[16 + F.tid];
}
__device__ __forceinline__ void phase_dispatch(Frame& F) {
    const GAS int* CNT = (const GAS int*)(F.ws + WS_CNTWG); const GAS int* EID = (const GAS int*)(F.ws + WS_ROUTE); const GAS float* EW = (const GAS float*)(F.ws + WS_ROUTE + 256 * 1024);
    GAS int* SROW = (GAS int*)(F.ws + WS_SROW); GAS int* ROWMAP = (GAS int*)(F.ws + WS_ROWMAP); GAS float* CWROW = (GAS float*)(F.ws + WS_CWROW); GAS int* META = (GAS int*)(F.ws + WS_META);
    LAS int* tot = (LAS int*)(F.lds + AUX_OFF);
    { const int e = F.tid & 31, part = F.tid >> 5; int t = 0, mine = 0;
      int cv[16];
#pragma unroll
      for (int j = 0; j < 16; ++j) { const int w = part * 16 + j; cv[j] = (w < F.G) ? ld_i32(CNT + w * 32 + e) : 0; }
#pragma unroll
      for (int j = 0; j < 16; ++j) { const int w = part * 16 + j; t += cv[j]; mine += (w < F.wg) ? cv[j] : 0; }
      tot[160 + F.tid] = t; tot[160 + 512 + F.tid] = mine; }
    __syncthreads();
    if (F.tid < 32) { int t = 0, mine = 0;
#pragma unroll
        for (int p = 0; p < 16; ++p) { t += tot[160 + p * 32 + F.tid]; mine += tot[160 + 512 + p * 32 + F.tid]; }
        tot[F.tid] = t; tot[32 + F.tid] = mine; tot[96 + F.tid] = 0; }
    __syncthreads();
    if (F.tid == 0) { int rb = 0;
#pragma clang loop unroll(disable) vectorize(disable)
        for (int e = 0; e < 32; ++e) { tot[64 + e] = rb; rb += ((tot[e] + 255) >> 8) << 8; }
        tot[128] = rb; }
    __syncthreads();
    if (F.wg == 0) { const int nt = tot[128] >> 8; if (F.tid == 0) META[0] = nt;
        if (F.tid < nt) { int e = 0;
#pragma clang loop unroll(disable) vectorize(disable)
            for (int q = 1; q < 32; ++q) if (tot[64 + q] <= F.tid * 256) e = q;
            META[16 + F.tid] = e; } }
    for (int r0 = F.wg * 128; r0 < NTOK; r0 += F.G * 128) {
        if (F.tid < 256) { const int tok = r0 + (F.tid >> 1), slot = F.tid & 1; const int e = EID[2 * tok + slot];
            const int pos = (int)__hip_atomic_fetch_add((LAS unsigned*)&tot[96 + e], 1u, __ATOMIC_RELAXED, __HIP_MEMORY_SCOPE_WORKGROUP);
            const int sr = tot[64 + e] + tot[32 + e] + pos;
            ROWMAP[sr] = tok; CWROW[sr] = EW[2 * tok + slot]; SROW[2 * tok + slot] = sr; } }
    if (F.wg < 32) { const int e = F.wg; const int lo = tot[64 + e] + tot[e], hi = tot[64 + e] + (((tot[e] + 255) >> 8) << 8);
        for (int r = lo + F.tid; r < hi; r += 512) { ROWMAP[r] = 0; CWROW[r] = 0.f; } }
}

#ifdef FP8_SELFTEST
__device__ __forceinline__ int fp8_selftest(LAS unsigned char* lds, int lane) {
    int code = 0;
    { float a = 1.5f, b = -2.0f, c = 5.0f, d = 0.0625f; asm volatile("" : "+v"(a), "+v"(b), "+v"(c), "+v"(d));
      int p = __builtin_amdgcn_cvt_pk_fp8_f32(a, b, 0, false); p = __builtin_amdgcn_cvt_pk_fp8_f32(c, d, p, true);
      if ((unsigned)p != 0x184AC03Cu) code = 1; }
    { const int i = lane & 15, kq = lane >> 4; unsigned aw[2] = {0u, 0u}, bw[2] = {0u, 0u};
#pragma unroll
      for (int e = 0; e < 8; ++e) { const int k = 8 * kq + e; float av = (k == i) ? 1.0f : 0.0f; float bv = (k < 16) ? (float)(1 + ((k + 2 * i) % 7)) : 0.0f;
          const int pa = __builtin_amdgcn_cvt_pk_fp8_f32(av, 0.f, 0, false) & 0xff, pb = __builtin_amdgcn_cvt_pk_fp8_f32(bv, 0.f, 0, false) & 0xff;
          aw[e >> 2] |= (unsigned)pa << (8 * (e & 3)); bw[e >> 2] |= (unsigned)pb << (8 * (e & 3)); }
      const long A = (long)(((unsigned long long)aw[1] << 32) | aw[0]), B = (long)(((unsigned long long)bw[1] << 32) | bw[0]);
      f32x4 d = __builtin_amdgcn_mfma_f32_16x16x32_fp8_fp8(A, B, (f32x4){0.f, 0.f, 0.f, 0.f}, 0, 0, 0);
      bool ok = true;
#pragma unroll
      for (int r = 0; r < 4; ++r) { const int row = 4 * kq + r; const float want = (float)(1 + ((row + 2 * i) % 7)); ok = ok && (d[r] == want); }
      if (__ballot(!ok) != 0ull && code == 0) code = 2; }
    { for (int b = 0; b < 8; ++b) lds[lane * 8 + b] = (unsigned char)(8 * (lane & 15) + b + ((lane >> 4) & 1) * 128);
      asm volatile("s_waitcnt lgkmcnt(0)" ::: "memory");
      const v2i_t t = __builtin_amdgcn_ds_read_tr8_b64_v2i32((LAS v2i_t*)(lds + lane * 8));
      asm volatile("s_waitcnt lgkmcnt(0)" ::: "memory");
      const int l = lane & 15, off = ((lane >> 4) & 1) * 128; bool h1 = true, h2 = true;
#pragma unroll
      for (int e = 0; e < 8; ++e) { const int got = (int)(((unsigned)t[e >> 2] >> (8 * (e & 3))) & 0xffu);
          const int w1 = 8 * (2 * e + (l >> 3)) + (l & 7) + off;
          const int w2 = 8 * (e + 8 * (l >> 3)) + (l & 7) + off;
          h1 = h1 && (got == w1); h2 = h2 && (got == w2); }
      const bool a1 = (__ballot(!h1) == 0ull), a2 = (__ballot(!h2) == 0ull);
      if (code == 0 && !a1) code = a2 ? 3 : 4; }
    return code;
}
#endif
__device__ __forceinline__ void phase_ln2(Frame& F, int l, bool dry = false) {
    GAS bf16* HB = (GAS bf16*)(F.ws + WS_HB); GAS bf16* HBo = dry ? (GAS bf16*)(F.ws + WS_Y) : HB; GAS float* Ho = dry ? (GAS float*)(F.ws + WS_PA + 184 * MiB) : F.H; const GAS int* SROW = (const GAS int*)(F.ws + WS_SROW); const GAS unsigned char* FF2 = (const GAS unsigned char*)(F.ws + WS_FF2);
    const GAS float* g = ((const GAS float*)F.in[26]) + l * DM; const GAS float* bb = ((const GAS float*)F.in[27]) + l * DM; int lane = F.lane; asm volatile("" : "+v"(lane));
    const int gw = F.wg * 8 + F.wave, NGW = F.G * 8; const bool last = (l == DEPTH - 1);
#ifdef FP8_SELFTEST
    const float tscale = 1.0f + 0.1f * (float)ld_i32((const GAS int*)(F.ctl + 20000));
#else
    const float tscale = 1.0f;
#endif
    const int nrow = (NTOK - gw + NGW - 1) / NGW;
    const int srv = (2 * (gw + (lane >> 1) * NGW) + (lane & 1) < 2 * NTOK) ? ld_i32(SROW + 2 * (gw + (lane >> 1) * NGW) + (lane & 1)) : 0;
    const float ewv = (2 * (gw + (lane >> 1) * NGW) + (lane & 1) < 2 * NTOK) ? ld_f32((const GAS float*)(F.ws + WS_ROUTE + 256 * 1024) + 2 * (gw + (lane >> 1) * NGW) + (lane & 1)) : 0.f;
    u32x4 hn[2][2]; u32x2 an[2][2], cn[2][2];
#define LN2_ISSUE(jj, slot) do { const int j_ = (jj); if (j_ < nrow) { const int m_ = gw + j_ * NGW; const int s0_ = __builtin_amdgcn_readlane(srv, 2 * j_), s1_ = __builtin_amdgcn_readlane(srv, 2 * j_ + 1); \
        _Pragma("unroll") for (int q_ = 0; q_ < 2; ++q_) { hn[slot][q_] = __builtin_nontemporal_load((const GAS u32x4*)(HB + (size_t)m_ * DM + 8 * lane + 512 * q_)); an[slot][q_] = *(const GAS u32x2*)(FF2 + (size_t)s0_ * DM + 8 * lane + 512 * q_); cn[slot][q_] = *(const GAS u32x2*)(FF2 + (size_t)s1_ * DM + 8 * lane + 512 * q_); } } } while (0)
    LN2_ISSUE(0, 0); LN2_ISSUE(1, 1);
#pragma unroll 1
    for (int jr = 0; jr < nrow; jr += 2)
#pragma unroll
    for (int slot = 0; slot < 2; ++slot) { const int jrow = jr + slot; if (jrow >= nrow) break; const int m = gw + jrow * NGW;
        const float cw0 = __builtin_bit_cast(float, __builtin_amdgcn_readlane(__builtin_bit_cast(int, ewv), 2 * jrow)), cw1 = __builtin_bit_cast(float, __builtin_amdgcn_readlane(__builtin_bit_cast(int, ewv), 2 * jrow + 1));
        float v[16];
#pragma unroll
        for (int j = 0; j < 2; ++j) { const u32x4 h = hn[slot][j]; const u32x2 a = an[slot][j], c = cn[slot][j];
            const f32x2 a01 = __builtin_amdgcn_cvt_pk_f32_fp8((int)a.x, false), a23 = __builtin_amdgcn_cvt_pk_f32_fp8((int)a.x, true), a45 = __builtin_amdgcn_cvt_pk_f32_fp8((int)a.y, false), a67 = __builtin_amdgcn_cvt_pk_f32_fp8((int)a.y, true);
            const f32x2 c01 = __builtin_amdgcn_cvt_pk_f32_fp8((int)c.x, false), c23 = __builtin_amdgcn_cvt_pk_f32_fp8((int)c.x, true), c45 = __builtin_amdgcn_cvt_pk_f32_fp8((int)c.y, false), c67 = __builtin_amdgcn_cvt_pk_f32_fp8((int)c.y, true);
            v[8 * j] = bflo(h.x) * DN_ALPHA + (a01.x * cw0 + c01.x * cw1); v[8 * j + 1] = bfhi(h.x) * DN_ALPHA + (a01.y * cw0 + c01.y * cw1); v[8 * j + 2] = bflo(h.y) * DN_ALPHA + (a23.x * cw0 + c23.x * cw1); v[8 * j + 3] = bfhi(h.y) * DN_ALPHA + (a23.y * cw0 + c23.y * cw1);
            v[8 * j + 4] = bflo(h.z) * DN_ALPHA + (a45.x * cw0 + c45.x * cw1); v[8 * j + 5] = bfhi(h.z) * DN_ALPHA + (a45.y * cw0 + c45.y * cw1); v[8 * j + 6] = bflo(h.w) * DN_ALPHA + (a67.x * cw0 + c67.x * cw1); v[8 * j + 7] = bfhi(h.w) * DN_ALPHA + (a67.y * cw0 + c67.y * cw1); }
        LN2_ISSUE(jrow + 2, slot);
        float s = 0.f;
#pragma unroll
        for (int i = 0; i < 16; ++i) s += v[i];
        const float mean = wave_sum(s, lane) * (1.f / DM); float s2 = 0.f;
#pragma unroll
        for (int i = 0; i < 16; ++i) { v[i] -= mean; s2 += v[i] * v[i]; }
        const float rstd = 1.f / sqrtf(wave_sum(s2, lane) * (1.f / DM) + LN_EPS);
#pragma unroll
        for (int j = 0; j < 2; ++j) { const int c = 8 * lane + 512 * j; const f32x4 g0 = *(const GAS f32x4*)(g + c), g1 = *(const GAS f32x4*)(g + c + 4), b0 = *(const GAS f32x4*)(bb + c), b1 = *(const GAS f32x4*)(bb + c + 4);
#pragma unroll
            for (int i = 0; i < 4; ++i) { v[8 * j + i] = v[8 * j + i] * rstd * g0[i] + b0[i]; v[8 * j + 4 + i] = v[8 * j + 4 + i] * rstd * g1[i] + b1[i]; }
            if (last) {
#pragma unroll
                for (int i = 0; i < 8; ++i) v[8 * j + i] *= tscale;
                *(GAS f32x4*)(Ho + (size_t)m * DM + c) = (f32x4){v[8 * j], v[8 * j + 1], v[8 * j + 2], v[8 * j + 3]}; *(GAS f32x4*)(Ho + (size_t)m * DM + c + 4) = (f32x4){v[8 * j + 4], v[8 * j + 5], v[8 * j + 6], v[8 * j + 7]}; }
            else { u32x4 wv; wv.x = pk2(v[8 * j], v[8 * j + 1]); wv.y = pk2(v[8 * j + 2], v[8 * j + 3]); wv.z = pk2(v[8 * j + 4], v[8 * j + 5]); wv.w = pk2(v[8 * j + 6], v[8 * j + 7]); *(GAS u32x4*)(HBo + (size_t)m * DM + c) = wv; } }
    }
#undef LN2_ISSUE
}

#ifndef EN_P
#define EN_P 1
#endif
#ifndef EN_A
#define EN_A 1
#endif
#ifndef EN_B
#define EN_B 1
#endif
#ifndef EN_C
#define EN_C 1
#endif
#ifndef EN_D
#define EN_D 1
#endif
#ifndef EN_E
#define EN_E 1
#endif
#ifndef EN_F
#define EN_F 1
#endif
#ifndef EN_G
#define EN_G 1
#endif
#ifndef EN_H
#define EN_H 1
#endif
#ifndef EN_I
#define EN_I 1
#endif
#ifndef EN_J
#define EN_J 1
#endif
constexpr int PPL = 12;
constexpr int N_PHASES = 1 + PPL * DEPTH;
#ifndef MK_ONE_LAUNCH
#define MK_ONE_LAUNCH 0
#endif
struct Args { const float* in[28]; float* out; unsigned char* ws; int ph_lo, ph_hi; };
static_assert(sizeof(Args) == 28 * 8 + 8 + 8 + 8, "no padding bytes in the argument struct");


__device__ __forceinline__ unsigned opaque_u32(unsigned x) { unsigned v; asm volatile("v_mov_b32 %0, %1" : "=v"(v) : "s"(x)); return (unsigned)__builtin_amdgcn_readfirstlane((int)v); }
__device__ __forceinline__ unsigned long long opaque_u64(unsigned long long x) { return ((unsigned long long)opaque_u32((unsigned)(x >> 32)) << 32) | opaque_u32((unsigned)x); }
__device__ __forceinline__ void launder(Frame& F) {
    F.ws = (GAS unsigned char*)opaque_u64((unsigned long long)F.ws); F.H = (GAS float*)opaque_u64((unsigned long long)F.H);
    F.ctl = (gu32*)opaque_u64((unsigned long long)F.ctl);
    unsigned z0 = 0u; asm volatile("" : "+v"(z0)); int ln = (int)__builtin_amdgcn_mbcnt_hi(~0u, __builtin_amdgcn_mbcnt_lo(~0u, z0));
    F.wave = (int)opaque_u32((unsigned)F.wave); F.lane = ln; F.tid = F.wave * 64 + ln;
    F.G = (int)opaque_u32((unsigned)F.G); F.wg = (int)opaque_u32((unsigned)F.wg);
}
#ifndef SG_N
#define SG_N 1
#endif
#ifndef SG_US
#define SG_US 0
#endif
__device__ __forceinline__ void gemm_stagger(const Frame& F) {
    if (SG_N > 1) { const int g = (F.wg >> 3) & (SG_N - 1);
        if (g) { const unsigned long long t0 = __builtin_amdgcn_s_memrealtime(), dt = (unsigned long long)(g * SG_US * 100); while (__builtin_amdgcn_s_memrealtime() - t0 < dt) __builtin_amdgcn_s_sleep(4); } }
}
__global__ void __launch_bounds__(512, 2) mk_fwd(Args args) {
    extern __shared__ __attribute__((aligned(16))) unsigned char lds_raw[];
    Frame F;
    F.lds = (LAS unsigned char*)lds_raw;
    F.MISC = (volatile LAS unsigned*)(F.lds + MISC_OFF);
    F.tid = threadIdx.x; F.lane = F.tid & 63; F.wave = __builtin_amdgcn_readfirstlane(F.tid >> 6);
    F.G = gridDim.x; F.wg = blockIdx.x;
    F.in = args.in;
    F.pos = (const GAS int*)args.in[1];
    F.H = (GAS float*)args.out; F.ws = (GAS unsigned char*)args.ws;
    F.ctl = (gu32*)(args.ws + WS_CTL);
    for (int u = F.tid; u < (LDS_BYTES - MISC_OFF) / 4; u += 512) ((LAS unsigned*)(F.lds + MISC_OFF))[u] = 0u;
    __syncthreads();
    const int lo = args.ph_lo, hi = args.ph_hi;
    const bool multi = (hi - lo) > 1;
    XcdBarrier bar; bar.bar = (unsigned*)(F.ctl + CW_BAR); bar.x = 0; bar.st = nullptr;
    if (multi) bar = xcd_barrier_post((unsigned*)(F.ctl + CW_BAR), F.MISC + 8);
#define IN(k) (lo <= (k) && (k) < hi)
#ifdef DUP_BARRIER
#define SEAM(k) do { if (IN(k) && IN((k) + 1)) { xcd_barrier(bar); xcd_barrier(bar); } } while (0)
#else
#define SEAM(k) do { if (IN(k) && IN((k) + 1)) xcd_barrier(bar); } while (0)
#endif

#ifdef DUP_P
    for (int rep = 0; rep < 2; ++rep)
#endif
    if (EN_P && IN(0)) { launder(F); phase_prologue(F);
#ifdef FP8_SELFTEST
        __syncthreads(); if (F.wg == 0 && F.wave == 0) { const int code = fp8_selftest(F.lds, F.lane); if (F.lane == 0) __hip_atomic_store((GAS int*)(F.ctl + 20000), code, __ATOMIC_RELAXED, __HIP_MEMORY_SCOPE_AGENT); } __syncthreads();
#endif
    }
    SEAM(0);
#define HB ((GAS bf16*)(F.ws + WS_HB))
#define PA ((GAS bf16*)(F.ws + WS_PA))
#define Y ((GAS bf16*)(F.ws + WS_Y))
#define HM ((GAS bf16*)F.H + (size_t)NTOK * DM)
#define TT ((GAS bf16*)F.H)
    for (int l = 0; l < DEPTH; ++l) {
        const int pb = 1 + PPL * l;
#define wd (F.ws + WS_WDENSE + (size_t)l * WD_LAYER)
#ifdef DUP_A
        for (int rep = 0; rep < 2; ++rep)
#endif
        if (EN_A && IN(pb + 0)) { launder(F);
            DenseSched S; S.init(NTOK / 256, NPA / 256, F.G, F.wg, (const void*)HB, (size_t)256 * DM * 2, (const void*)(wd + WD_WA), (size_t)256 * DM * 2);
            EpiA E{PA, (GAS bf16*)(F.ws + WS_KA), (GAS bf16*)(F.ws + WS_VA), (GAS bf16*)(F.ws + WS_KI), (GAS float*)(F.ws + WS_WI), (GAS float*)(F.ws + WS_GLR), (const GAS float*)(F.ws + WS_ROPE), ((const GAS float*)F.in[5]) + l * 64};
#ifdef DUP_ANONE
            { EpiNoneA E0{PA}; pg8::gemm_phase<EpiNoneA, DenseSched, false>(F.lds, S, E0, DM, DM, F.wave); }
#endif
#ifdef DUP_APLAIN
            { EpiPlainA E0{PA}; pg8::gemm_phase<EpiPlainA, DenseSched, false>(F.lds, S, E0, DM, DM, F.wave); }
#endif
            gemm_stagger(F);
            pg8::gemm_phase<EpiA, DenseSched, false>(F.lds, S, E, DM, DM, F.wave);
        }
        SEAM(pb + 0);
        if (EN_B && IN(pb + 1)) { launder(F);
#ifdef DUP_B
            phase_mixer(F, l, 1, DUP_B, true); launder(F);
#endif
            phase_mixer_merged(F, l, bar, F.ctl + CW_HI + 2048 + 256 * l); }
        if (IN(pb + 1) && IN(pb + 4)) xcd_barrier(bar);
#ifdef DUP_D
        for (int rep = 0; rep < 2; ++rep)
#endif
        if (EN_D && IN(pb + 4)) { launder(F);
            DenseSched S; S.init(NTOK / 256, DM / 256, F.G, F.wg, (const void*)Y, (size_t)256 * 1536 * 2, (const void*)(wd + WD_WBR), (size_t)256 * 512 * 2);
            S.nsub = 3; S.asub = 512 * 2; S.bsub = (size_t)1024 * 512 * 2;
#ifdef DUP_DPAD
            { EpiPPad E0{PA}; pg8::gemm_phase<EpiPPad, DenseSched, false>(F.lds, S, E0, 512, 1536, F.wave); }
#endif
#ifdef DUP_DNONE
            { EpiNoneA E0{PA}; pg8::gemm_phase<EpiNoneA, DenseSched, false>(F.lds, S, E0, 512, 1536, F.wave); }
#endif
            gemm_stagger(F);
            EpiP E{PA};
            pg8::gemm_phase<EpiP, DenseSched, false>(F.lds, S, E, 512, 1536, F.wave);
        }
#ifdef DUP_C
        for (int rep = 0; rep < 2; ++rep)
#endif
        if (EN_C && IN(pb + 4)) { launder(F);
            DenseSched S; S.init(NTOK / 256, DM / 256, F.G, F.wg, (const void*)HB, (size_t)256 * DM * 2, (const void*)(wd + WD_WG), (size_t)256 * DM * 2);
            S.nsub = 3; S.asub = 0; S.bsub = (size_t)1024 * DM * 2;
#ifdef DUP_CNONE
            { EpiNoneA E0{PA}; pg8::gemm_phase<EpiNoneA, DenseSched, false>(F.lds, S, E0, DM, DM, F.wave); }
#endif
            EpiGM E{PA, HM};
            pg8::gemm_phase<EpiGM, DenseSched, false>(F.lds, S, E, DM, DM, F.wave);
        }
        SEAM(pb + 4);
#ifdef DUP_E
        for (int rep = 0; rep < 2; ++rep)
#endif
        if (EN_E && IN(pb + 6)) { launder(F);
            DenseSched S; S.init(NTOK / 256, DM / 256, F.G, F.wg, (const void*)HM, (size_t)256 * DM * 2, (const void*)(wd + WD_WOUT), (size_t)256 * DM * 2);
            EpiO E{HB, TT};
            gemm_stagger(F);
            pg8::gemm_phase<EpiO, DenseSched, false>(F.lds, S, E, DM, DM, F.wave);
        }
        SEAM(pb + 6);
#ifdef DUP_F
        for (int rep = 0; rep < 2; ++rep)
#endif
        if (EN_F && IN(pb + 7)) { launder(F); phase_ln_router(F, l); }
        SEAM(pb + 7);
#ifdef DUP_G
        for (int rep = 0; rep < 2; ++rep)
#endif
        if (EN_G && IN(pb + 8)) { launder(F);
            { LAS float* scr = (LAS float*)(F.lds + F.wave * 16384);
              conv_run<true>(F, l, 12288, scr);
              __syncthreads(); }
            phase_dispatch(F); }
        SEAM(pb + 8);
        gu32* hic = F.ctl + CW_HI + 256 * l;
#ifdef DUP_H
        for (int rep = 0; rep < 2; ++rep)
#endif
        if (EN_H && IN(pb + 9)) { launder(F);
            const GAS int* META = (const GAS int*)(F.ws + WS_META); const GAS int* ROWMAP = (const GAS int*)(F.ws + WS_ROWMAP);
            LAS int* meta = (LAS int*)(F.lds + AUX_OFF); LAS int* rows = (LAS int*)(F.lds + AUX_OFF + 64);
            { int rv[3]; int mv = 0;
#pragma unroll
              for (int i = 0; i < 3; ++i) { const int gt0 = (i * F.G + F.wg) >> 1, gt = gt0 < MAXTILES ? gt0 : MAXTILES - 1; rv[i] = (F.tid < 256) ? ROWMAP[gt * 256 + F.tid] : 0; }
              if (F.tid < 3) { const int gt0 = (F.tid * F.G + F.wg) >> 1, gt = gt0 < MAXTILES ? gt0 : MAXTILES - 1; mv = ld_i32(META + 16 + gt); }
              if (F.tid < 3) meta[F.tid] = mv;
#pragma unroll
              for (int i = 0; i < 3; ++i) if (F.tid < 256) rows[i * 256 + F.tid] = rv[i]; }
            const int NT = ld_i32(META), NU = NT * 2;
            __syncthreads();
            GroupSched S{NU, F.G, F.wg, 2, (const char*)HB, (const char*)(F.ws + WS_WMOE + WM_GU), 0, (size_t)512 * DM * 2, (size_t)256 * DM * 2, meta, rows};
            EpiGU E{(GAS bf16*)(F.ws + WS_HID), (const GAS float*)(F.ws + WS_CWROW)};
            S.i0 = 0; S.i1 = 2;
            pg8::gemm_phase<EpiGU, GroupSched, true>(F.lds, S, E, DM, DM, F.wave);
#ifdef DUP_H
            if (rep == 0)
#endif
            { const unsigned nloc = bar.st ? bar.st[0] : 0u; if (nloc) hi_arrive_xcd(hic, hic + 128 + 8 * bar.x, nloc); else hi_arrive(hic); }
            if (2 * F.G + F.wg < NU) { S.i0 = 2; S.i1 = 3;
                pg8::gemm_phase<EpiGU, GroupSched, true>(F.lds, S, E, DM, DM, F.wave);
#ifdef DUP_H
                if (rep == 0)
#endif
                hi_arrive(hic + 64); }
        }
#ifdef DUP_I
        for (int rep = 0; rep < 2; ++rep)
#endif
        if (EN_I && IN(pb + 10)) { launder(F);
            const GAS int* META = (const GAS int*)(F.ws + WS_META);
            LAS int* meta = (LAS int*)(F.lds + AUX_OFF); LAS int* uid = (LAS int*)(F.lds + AUX_OFF + 64);
            const int NT = ld_i32(META), NU = NT * 4; const int n3 = 2 * NT - 2 * F.G > 0 ? 2 * NT - 2 * F.G : 0;
            const bool late = F.wg < n3;
            if (F.tid < 8) { int id;
                if (late) id = (F.tid < 2) ? 4 * F.G + 2 * F.wg + F.tid : -1;
                else { const int nfree = F.G - n3; id = (F.wg - n3) + F.tid * nfree; if (id >= 4 * F.G || id >= NU) id = -1; }
                uid[F.tid] = id; const int gt = id >= 0 ? (id >> 2) : 0; meta[F.tid] = ld_i32(META + 16 + (gt < MAXTILES ? gt : MAXTILES - 1)); }
            hi_wait(hic, (unsigned)F.G, (unsigned*)(F.ctl + CW_BAR));
            if (late) hi_wait(hic + 64, (unsigned)n3, (unsigned*)(F.ctl + CW_BAR));
            GroupSched S{NU, F.G, F.wg, 4, (const char*)(F.ws + WS_HID), (const char*)(F.ws + WS_WMOE + WM_DN), (size_t)256 * DEXP * 2, (size_t)DM * DEXP * 2, (size_t)256 * DEXP * 2, meta, nullptr};
            S.i0 = 0; S.i1 = 8; S.uid = uid;
            EpiDN E{(GAS bf16*)(F.ws + WS_FF2)};
            gemm_stagger(F);
            pg8::gemm_phase<EpiDN, GroupSched, false>(F.lds, S, E, DEXP, DEXP, F.wave);
        }
        SEAM(pb + 10);
        if (EN_J && IN(pb + 11)) { launder(F);
#ifdef DUP_J
            phase_ln2(F, l, true); launder(F);
#endif
            phase_ln2(F, l); }
        SEAM(pb + 11);
    }
#undef IN
#undef SEAM
#undef HB
#undef HM
#undef TT
#undef PA
#undef Y
#undef wd
}


#ifdef DUMP_OFF
__global__ void dump_k(const unsigned short* src, float* out) {
    for (size_t i = (size_t)blockIdx.x * blockDim.x + threadIdx.x; i < (size_t)NTOK * 1024; i += (size_t)gridDim.x * blockDim.x) { const size_t n = i >> 10, c = i & 1023; out[i] = __builtin_bit_cast(float, ((unsigned)src[n * DUMP_PITCH + c]) << 16); }
}
#endif
extern "C" void kernel_launch(void* const* d_in, const int* in_sizes, int n_in, void* d_out, int out_size, void* d_ws, size_t ws_size, hipStream_t stream) {
    static int grid = 0;
    if (grid == 0) {
        if (n_in != 28 || out_size != NTOK * DM || ws_size < WS_END) { fprintf(stderr, "kernel_launch: unexpected shapes (n_in %d out %d ws %zu); nothing launched\n", n_in, out_size, ws_size); grid = -1; return; }
        int dev = 0, cus = 0;
        if (hipGetDevice(&dev) != hipSuccess || hipDeviceGetAttribute(&cus, hipDeviceAttributeMultiprocessorCount, dev) != hipSuccess) { grid = -1; return; }
        if (hipFuncSetAttribute((const void*)mk_fwd, hipFuncAttributeMaxDynamicSharedMemorySize, LDS_BYTES) != hipSuccess) { fprintf(stderr, "kernel_launch: hipFuncSetAttribute failed\n"); grid = -1; return; }
        int per_cu = 0;
        if (hipOccupancyMaxActiveBlocksPerMultiprocessor(&per_cu, (const void*)mk_fwd, 512, LDS_BYTES) != hipSuccess || per_cu < 1) { fprintf(stderr, "kernel_launch: occupancy query says %d\n", per_cu); }
        (void)hipGetLastError();
        grid = cus;
        if (grid != 256) fprintf(stderr, "kernel_launch: %d CUs (built for 256)\n", grid);
    }
    if (grid < 0) return;
    if (hipMemsetAsync((char*)d_ws + WS_CTL, 0, CTL_ZERO_BYTES, stream) != hipSuccess) return;
    Args a{};
    for (int i = 0; i < 28; ++i) a.in[i] = (const float*)d_in[i];
    a.out = (float*)d_out; a.ws = (unsigned char*)d_ws;
#if MK_ONE_LAUNCH
    a.ph_lo = 0; a.ph_hi = N_PHASES;
    hipLaunchKernelGGL(mk_fwd, dim3(grid), dim3(512), LDS_BYTES, stream, a);
#else
#ifndef STOP_AFTER
#define STOP_AFTER (N_PHASES - 1)
#endif
#ifndef PHASE_MASK
#define PHASE_MASK 0xffffffffu
#endif
    for (int p = 0; p <= STOP_AFTER; ++p) { if (!((PHASE_MASK >> p) & 1u)) continue; a.ph_lo = p; a.ph_hi = p + 1; hipLaunchKernelGGL(mk_fwd, dim3(grid), dim3(512), LDS_BYTES, stream, a); }
#ifdef DUMP_OFF
    hipLaunchKernelGGL(dump_k, dim3(2048), dim3(256), 0, stream, (const unsigned short*)((const char*)d_ws + (size_t)(DUMP_OFF)), (float*)d_out);
#endif
#endif
}
```
